# Optimizing an MI355X kernel written in HIP

```python
import jax, jax.numpy as jnp
from jax import lax
import numpy as np

D_MODEL = 1024
BATCH = 2
SEQ = 8192
DEPTH = 2

GLA_HEADS = 4
GLA_DK = 64
GLA_DV = 128
GLA_GATE_RANK = 16
GLA_TAU = 16.0
GLA_CHUNK = 64
NSA_HEADS = 8
NSA_KV_GROUPS = 2
NSA_HPG = NSA_HEADS // NSA_KV_GROUPS
NSA_DH = 64
CMP_LEN = 32
CMP_STRIDE = 16
CMP_HIDDEN = 256
SEL_BLOCK = 64
SEL_TOPK = 16
WINDOW = 512
Q_BLOCK = 128
ROPE_THETA = 500000.0
ROT_DIM = NSA_DH // 4
SGU_CHUNK = 128
SGU_GROUPS = 8
SGU_WIDTH = 2048
SGU_GROUP_DIM = SGU_WIDTH // SGU_GROUPS
N_EXPERTS = 16
N_EXPERT_GROUPS = 4
EXPERTS_PER_GROUP = N_EXPERTS // N_EXPERT_GROUPS
MOE_TOPK = 2
EXPERT_HIDDEN = 512

GLA_QK_W = GLA_HEADS * GLA_DK
GLA_V_W = GLA_HEADS * GLA_DV
NSA_Q_W = NSA_HEADS * NSA_DH
NSA_KV_W = NSA_KV_GROUPS * NSA_DH
AB_SPLITS = (GLA_QK_W, GLA_QK_W, GLA_V_W, GLA_GATE_RANK, GLA_V_W,
             NSA_Q_W, NSA_KV_W, NSA_KV_W, NSA_KV_W, NSA_KV_W, NSA_KV_W, NSA_KV_W,
             NSA_HEADS * 3)
AB_IN_WIDTH = sum(AB_SPLITS)
AB_MIX_WIDTH = GLA_V_W + NSA_Q_W

NORM_EPS = 1e-6
NEG_INF = -1e30
FORCE_BONUS = 1e4

kernel_name = "hybrid_gla_nsa_gmlp_moe_trunk"


def rms_norm(x, g):
    xf = x.astype(jnp.float32)
    y = xf * lax.rsqrt(jnp.mean(xf * xf, axis=-1, keepdims=True) + NORM_EPS)
    return (y * g.astype(jnp.float32)).astype(x.dtype)


def modulate(h, shift, scale):
    return h * (1 + scale[:, None, :]) + shift[:, None, :]


def rope(x, pos):
    half = ROT_DIM // 2
    inv_freq = jnp.float32(ROPE_THETA) ** (-jnp.arange(half, dtype=jnp.float32) / half)
    ang = pos.astype(jnp.float32)[..., None] * inv_freq
    cos = jnp.cos(ang)[..., None, :]
    sin = jnp.sin(ang)[..., None, :]
    xr = x[..., :ROT_DIM].astype(jnp.float32)
    x1, x2 = xr[..., :half], xr[..., half:]
    rot = jnp.concatenate([x1 * cos - x2 * sin, x2 * cos + x1 * sin], axis=-1).astype(x.dtype)
    return jnp.concatenate([rot, x[..., ROT_DIM:]], axis=-1)


def masked_softmax(s, mask):
    s = jnp.where(mask, s.astype(jnp.float32), NEG_INF)
    return jax.nn.softmax(s, axis=-1) * mask


def gla_mixer(q, k, v, g_lr, r, w_gate2, b_gate, out_g):
    B, S, _ = q.shape
    n = S // GLA_CHUNK
    f32 = jnp.float32
    shp = (B, n, GLA_CHUNK, GLA_HEADS, -1)
    qf = q.astype(f32).reshape(shp) * (GLA_DK ** -0.5)
    kf = k.astype(f32).reshape(shp)
    vf = v.astype(f32).reshape(shp)
    log_a = jax.nn.log_sigmoid((g_lr @ w_gate2 + b_gate).astype(f32)) / GLA_TAU
    b = jnp.cumsum(log_a.reshape(shp), axis=2)
    b_last = b[:, :, -1:]
    b_mid = b[:, :, GLA_CHUNK // 2:GLA_CHUNK // 2 + 1]
    scores = jnp.einsum("bnihd,bnjhd->bnhij", qf * jnp.exp(b - b_mid), kf * jnp.exp(b_mid - b))
    causal = jnp.tril(jnp.ones((GLA_CHUNK, GLA_CHUNK), dtype=bool))
    scores = jnp.where(causal, scores, 0.0)
    o_intra = jnp.einsum("bnhij,bnjhe->bnihe", scores, vf)
    kv = jnp.einsum("bnchd,bnche->bnhde", kf * jnp.exp(b_last - b), vf)
    decay = jnp.exp(b_last[:, :, 0])

    def step(state, inp):
        dec, kv_n = inp
        return dec[..., None] * state + kv_n, state

    init = jnp.zeros((B, GLA_HEADS, GLA_DK, GLA_DV), f32)
    _, states = lax.scan(step, init, (jnp.moveaxis(decay, 1, 0), jnp.moveaxis(kv, 1, 0)))
    states = jnp.moveaxis(states, 0, 1)
    o_inter = jnp.einsum("bnchd,bnhde->bnche", qf * jnp.exp(b), states)
    o = (o_intra + o_inter).reshape(B, S, GLA_HEADS, GLA_DV)
    o = rms_norm(o, out_g) * jax.nn.silu(r.astype(f32)).reshape(B, S, GLA_HEADS, GLA_DV)
    return o.reshape(B, S, GLA_V_W)


def nsa_mixer(q, kc, vc, ks, vs, kw, vw, g_logits, positions,
              q_gain, k_gain, cmp_pe, cmp_w1, cmp_w2):
    B, S, _ = q.shape
    G, HPG, DH = NSA_KV_GROUPS, NSA_HPG, NSA_DH
    scale = DH ** -0.5
    heads_kv = lambda t: t.reshape(B, S, G, DH)
    qh = rope(rms_norm(q.reshape(B, S, NSA_HEADS, DH), q_gain), positions)
    k_win = rope(rms_norm(heads_kv(kw), k_gain[2]), positions)
    v_win = heads_kv(vw)
    k_sel = rope(rms_norm(heads_kv(ks), k_gain[1]), positions)
    v_sel = heads_kv(vs)
    n_cmp = (S - CMP_LEN) // CMP_STRIDE + 1
    starts = jnp.arange(n_cmp) * CMP_STRIDE
    tok = starts[:, None] + jnp.arange(CMP_LEN)[None, :]

    def compress(t, pe, w1, w2):
        blk = heads_kv(t)[:, tok] + pe[None, None, :, None, :]
        blk = jnp.moveaxis(blk, 3, 2).reshape(B, n_cmp, G, CMP_LEN * DH)
        return jax.nn.gelu(blk @ w1) @ w2

    k_cmp = compress(kc, cmp_pe[0], cmp_w1[0], cmp_w2[0])
    k_cmp = rope(rms_norm(k_cmp, k_gain[0]), positions[:, tok[:, -1]])
    v_cmp = compress(vc, cmp_pe[1], cmp_w1[1], cmp_w2[1])

    q_g = qh.reshape(B, S, G, HPG, DH).transpose(0, 2, 3, 1, 4)
    gm = lambda t: t.transpose(0, 2, 1, 3)
    kcg, vcg = gm(k_cmp), gm(v_cmp)
    n_sel = S // SEL_BLOCK
    topk = min(SEL_TOPK, n_sel)
    ksb = gm(k_sel).reshape(B, G, n_sel, SEL_BLOCK, DH)
    vsb = gm(v_sel).reshape(B, G, n_sel, SEL_BLOCK, DH)
    pad = ((0, 0), (0, 0), (WINDOW, 0), (0, 0))
    kwp = jnp.pad(gm(k_win), pad)
    vwp = jnp.pad(gm(v_win), pad)
    gates = jax.nn.sigmoid(g_logits.astype(jnp.float32)).reshape(B, S, G, HPG, 3).transpose(0, 2, 3, 1, 4)
    ci = starts[:, None]
    sj = jnp.arange(n_sel)[None, :] * SEL_BLOCK
    cover = ((ci < sj + SEL_BLOCK) & (ci + CMP_LEN > sj)).astype(jnp.float32)
    cmp_end = starts + CMP_LEN - 1
    jj = jnp.arange(n_sel)
    bi = jnp.arange(B)[:, None, None, None]
    gi = jnp.arange(G)[None, :, None, None]

    def block(i):
        qs = i * Q_BLOCK
        qb = lax.dynamic_slice_in_dim(q_g, qs, Q_BLOCK, axis=3)
        t = qs + jnp.arange(Q_BLOCK)
        s_c = jnp.einsum("bghqd,bgkd->bghqk", qb, kcg).astype(jnp.float32) * scale
        p_c = masked_softmax(s_c, cmp_end[None, :] <= t[:, None])
        o_c = jnp.einsum("bghqk,bgkd->bghqd", p_c, vcg)
        imp = jnp.einsum("bghqk,kj->bgqj", p_c, cover)
        cur = t // SEL_BLOCK
        forced = (jj[None] == 0) | (jj[None] == cur[:, None]) | (jj[None] == cur[:, None] - 1)
        valid = jj[None] * SEL_BLOCK <= t[:, None]
        sel_score = jnp.where(valid, imp + jnp.where(forced, FORCE_BONUS, 0.0), NEG_INF)
        _, idx = lax.top_k(sel_score, topk)
        kb = ksb[bi, gi, idx]
        vb = vsb[bi, gi, idx]
        kpos = idx[..., None] * SEL_BLOCK + jnp.arange(SEL_BLOCK)
        smask = (kpos <= t[:, None, None]).reshape(B, G, 1, Q_BLOCK, topk * SEL_BLOCK)
        s_s = jnp.einsum("bghqd,bgqnkd->bghqnk", qb, kb).astype(jnp.float32) * scale
        p_s = masked_softmax(s_s.reshape(B, G, HPG, Q_BLOCK, topk * SEL_BLOCK), smask)
        o_s = jnp.einsum("bghqm,bgqmd->bghqd", p_s,
                         vb.reshape(B, G, Q_BLOCK, topk * SEL_BLOCK, DH))
        kwb = lax.dynamic_slice_in_dim(kwp, qs, WINDOW + Q_BLOCK, axis=2)
        vwb = lax.dynamic_slice_in_dim(vwp, qs, WINDOW + Q_BLOCK, axis=2)
        kpw = qs - WINDOW + jnp.arange(WINDOW + Q_BLOCK)
        diff = t[:, None] - kpw[None, :]
        wmask = (diff >= 0) & (diff < WINDOW) & (kpw[None, :] >= 0)
        s_w = jnp.einsum("bghqd,bgkd->bghqk", qb, kwb).astype(jnp.float32) * scale
        p_w = masked_softmax(s_w, wmask)
        o_w = jnp.einsum("bghqk,bgkd->bghqd", p_w, vwb)
        gb = lax.dynamic_slice_in_dim(gates, qs, Q_BLOCK, axis=3)
        return gb[..., 0:1] * o_c + gb[..., 1:2] * o_s + gb[..., 2:3] * o_w

    outs = lax.map(block, jnp.arange(S // Q_BLOCK))
    return outs.transpose(1, 0, 4, 2, 3, 5).reshape(B, S, NSA_Q_W)


def mixer_ab(h, positions, w_in, w_out, gla_w_gate2, gla_b_gate, gla_norm_g,
             q_gain, k_gain, cmp_pe, cmp_w1, cmp_w2):
    offs = np.cumsum(AB_SPLITS)[:-1].tolist()
    (gq, gk, gv, g_lr, g_r, nq, kc, vc, ks, vs, kw, vw, ng) = jnp.split(h @ w_in, offs, axis=-1)
    o_a = gla_mixer(gq, gk, gv, g_lr, g_r, gla_w_gate2, gla_b_gate, gla_norm_g)
    o_b = nsa_mixer(nq, kc, vc, ks, vs, kw, vw, ng, positions, q_gain, k_gain, cmp_pe, cmp_w1, cmp_w2)
    return jnp.concatenate([o_a.astype(h.dtype), o_b.astype(h.dtype)], axis=-1) @ w_out


def mixer_c(h, w_in, norm_g, w_s, b_s, w_out):
    B, S, _ = h.shape
    z = jax.nn.gelu(h @ w_in)
    u, v = jnp.split(z, 2, axis=-1)
    v = rms_norm(v, norm_g)
    n = S // SGU_CHUNK
    v = v.reshape(B, n, SGU_CHUNK, SGU_GROUPS, SGU_GROUP_DIM)
    w = w_s * jnp.tril(jnp.ones((SGU_CHUNK, SGU_CHUNK), dtype=w_s.dtype))
    mix = jnp.einsum("gts,bnsgc->bntgc", w, v) + b_s.T[None, None, :, :, None]
    return (u * mix.reshape(B, S, SGU_WIDTH)) @ w_out


def moe(h, w_router, router_bias, w_gate, w_up, w_down):
    B, S, D = h.shape
    ht = h.reshape(B * S, D)
    scores = jax.nn.sigmoid((ht @ w_router).astype(jnp.float32))
    sel = scores + router_bias.astype(jnp.float32)
    grp = sel.reshape(-1, N_EXPERT_GROUPS, EXPERTS_PER_GROUP)
    group_score = lax.top_k(grp, MOE_TOPK)[0].sum(-1)
    g_idx = jnp.argmax(group_score, axis=-1)
    in_grp = (jnp.arange(N_EXPERTS) // EXPERTS_PER_GROUP)[None, :] == g_idx[:, None]
    _, e_idx = lax.top_k(jnp.where(in_grp, sel, NEG_INF), MOE_TOPK)
    wts = jnp.take_along_axis(scores, e_idx, axis=-1)
    wts = wts / jnp.sum(wts, axis=-1, keepdims=True)
    combine = jnp.sum(jax.nn.one_hot(e_idx, N_EXPERTS, dtype=jnp.float32) * wts[..., None], axis=1)
    out = jnp.zeros((B * S, D), jnp.float32)
    for e in range(N_EXPERTS):
        hid = jax.nn.silu(ht @ w_gate[e]) * (ht @ w_up[e])
        out = out + combine[:, e:e + 1] * (hid @ w_down[e])
    return out.reshape(B, S, D).astype(h.dtype)


def setup_inputs(seed: int = 0) -> dict:
    key = jax.random.key(seed)
    ks = jax.random.split(key, 32)
    f32 = jnp.float32
    n_even = (DEPTH + 1) // 2
    n_odd = DEPTH // 2
    nrm = lambda k, shape, s: jax.random.normal(k, shape, f32) * s
    x = nrm(ks[0], (BATCH, SEQ, D_MODEL), 1.0)
    c = nrm(ks[1], (BATCH, D_MODEL), 1.0)
    positions = (jax.random.randint(ks[2], (BATCH, 1), 0, 4096)
                 + jnp.arange(SEQ, dtype=jnp.int32)[None, :]).astype(jnp.int32)
    return {
        "x": x,
        "c": c,
        "positions": positions,
        "w_ada": nrm(ks[3], (DEPTH, D_MODEL, 6 * D_MODEL), 0.5 * D_MODEL ** -0.5),
        "b_ada": nrm(ks[4], (DEPTH, 6 * D_MODEL), 0.02),
        "norm_g": 1.0 + nrm(ks[5], (DEPTH, 2, D_MODEL), 0.01),
        "w_in_ab": nrm(ks[6], (n_even, D_MODEL, AB_IN_WIDTH), D_MODEL ** -0.5),
        "w_out_ab": nrm(ks[7], (n_even, AB_MIX_WIDTH, D_MODEL), AB_MIX_WIDTH ** -0.5),
        "gla_w_gate2": nrm(ks[8], (n_even, GLA_GATE_RANK, GLA_QK_W), GLA_GATE_RANK ** -0.5),
        "gla_b_gate": nrm(ks[9], (n_even, GLA_QK_W), 0.1),
        "gla_norm_g": 1.0 + nrm(ks[10], (n_even, GLA_DV), 0.01),
        "nsa_q_gain": 1.0 + nrm(ks[11], (n_even, NSA_DH), 0.01),
        "nsa_k_gain": 1.0 + nrm(ks[12], (n_even, 3, NSA_DH), 0.01),
        "nsa_cmp_pe": nrm(ks[13], (n_even, 2, CMP_LEN, NSA_DH), 0.1),
        "nsa_cmp_w1": nrm(ks[14], (n_even, 2, CMP_LEN * NSA_DH, CMP_HIDDEN), (CMP_LEN * NSA_DH) ** -0.5),
        "nsa_cmp_w2": nrm(ks[15], (n_even, 2, CMP_HIDDEN, NSA_DH), CMP_HIDDEN ** -0.5),
        "w_in_c": nrm(ks[16], (n_odd, D_MODEL, 2 * SGU_WIDTH), D_MODEL ** -0.5),
        "sgu_norm_g": 1.0 + nrm(ks[17], (n_odd, SGU_WIDTH), 0.01),
        "sgu_w_s": nrm(ks[18], (n_odd, SGU_GROUPS, SGU_CHUNK, SGU_CHUNK), SGU_CHUNK ** -0.5),
        "sgu_b_s": 1.0 + nrm(ks[19], (n_odd, SGU_GROUPS, SGU_CHUNK), 0.02),
        "w_out_c": nrm(ks[20], (n_odd, SGU_WIDTH, D_MODEL), SGU_WIDTH ** -0.5),
        "w_router": nrm(ks[21], (D_MODEL, N_EXPERTS), D_MODEL ** -0.5),
        "router_bias": nrm(ks[22], (N_EXPERTS,), 0.01),
        "w_gate": nrm(ks[23], (DEPTH, N_EXPERTS, D_MODEL, EXPERT_HIDDEN), D_MODEL ** -0.5),
        "w_up": nrm(ks[24], (DEPTH, N_EXPERTS, D_MODEL, EXPERT_HIDDEN), D_MODEL ** -0.5),
        "w_down": nrm(ks[25], (DEPTH, N_EXPERTS, EXPERT_HIDDEN, D_MODEL), EXPERT_HIDDEN ** -0.5),
    }


def reference(x, c, positions, w_ada, b_ada, norm_g, w_in_ab, w_out_ab, gla_w_gate2,
              gla_b_gate, gla_norm_g, nsa_q_gain, nsa_k_gain, nsa_cmp_pe, nsa_cmp_w1,
              nsa_cmp_w2, w_in_c, sgu_norm_g, sgu_w_s, sgu_b_s, w_out_c, w_router,
              router_bias, w_gate, w_up, w_down):
    cond = jax.nn.silu(c)
    for layer in range(DEPTH):
        mod = cond @ w_ada[layer] + b_ada[layer]
        shift_t, scale_t, gate_t, shift_c, scale_c, gate_c = jnp.split(mod, 6, axis=-1)
        h = modulate(rms_norm(x, norm_g[layer, 0]), shift_t, scale_t)
        i = layer // 2
        if layer % 2 == 0:
            y = mixer_ab(h, positions, w_in_ab[i], w_out_ab[i], gla_w_gate2[i], gla_b_gate[i],
                         gla_norm_g[i], nsa_q_gain[i], nsa_k_gain[i], nsa_cmp_pe[i],
                         nsa_cmp_w1[i], nsa_cmp_w2[i])
        else:
            y = mixer_c(h, w_in_c[i], sgu_norm_g[i], sgu_w_s[i], sgu_b_s[i], w_out_c[i])
        x = x + gate_t[:, None, :] * y.astype(x.dtype)
        h = modulate(rms_norm(x, norm_g[layer, 1]), shift_c, scale_c)
        x = x + gate_c[:, None, :] * moe(h, w_router, router_bias, w_gate[layer], w_up[layer], w_down[layer])
    return x
```

```cpp
#include <hip/hip_runtime.h>
#include <cstdio>
#include <cstdint>
namespace pg8 {
#define PG8_LAS __attribute__((address_space(3)))
typedef unsigned short bf16_t;
typedef short bf16x8 __attribute__((ext_vector_type(8)));
typedef float f32x4 __attribute__((ext_vector_type(4)));
typedef unsigned u32x4 __attribute__((ext_vector_type(4)));
constexpr int BM = 256, BK = 64, HALF = 128, HTB = HALF * BK * 2  , STAGE_BYTES = 8 * HTB, NXCD = 8, WGM = 8;

__host__ __device__ __forceinline__ int lds_byte(int r, int c) { const int st = (r >> 4) * 2 + (c >> 5), rr = r & 15, cc = c & 31, ob = rr * 64 + cc * 2; return st * 1024 + (ob ^ (((ob >> 9) & 1) << 5)); }
__host__ __device__ __forceinline__ void stage_rc(int b, int& R, int& C) { const int st = b / 1024, sb = b % 1024, swz = sb ^ (((sb >> 9) & 1) << 5); R = (st >> 1) * 16 + swz / 64; C = (st & 1) * 32 + (swz % 64) / 2; }
__host__ __device__ __forceinline__ int perm32(int rho) { const int n = rho >> 4, i = rho & 15; return 8 * (i >> 2) + 4 * n + (i & 3); }

struct Unit { int pm, pn; };
struct Gemm { const bf16_t* A; const bf16_t* Bt; int M, N, K; };

struct StaticOrder {
    int nM, nN, nwg, G, c;
    __host__ __device__ void init(int M, int N, int G_, int c_) { nM = M / BM; nN = N / BM; nwg = nM * nN; G = G_; c = c_; }
    __host__ __device__ bool next(int i, Unit& u) const {
        const long L = (long)i * G + c; if (L >= nwg) return false;
        int wgid = (int)L; { const int q = nwg / NXCD, r = nwg % NXCD, xcd = wgid % NXCD, off = wgid / NXCD; wgid = (xcd < r ? xcd * (q + 1) : r * (q + 1) + (xcd - r) * q) + off; }
        const int nig = WGM * nN, gid = wgid / nig, fm = gid * WGM, gsz = (nM - fm) < WGM ? (nM - fm) : WGM;
        u.pm = fm + ((wgid % nig) % gsz); u.pn = (wgid % nig) / gsz; return true;
    }
    __device__ __forceinline__ void a_ready(const Unit&) const {}
    __device__ __forceinline__ void done(const Unit&) const {}
};

__device__ __forceinline__ unsigned cvt_pk_bf16(float lo, float hi) { unsigned r; asm volatile("v_cvt_pk_bf16_f32 %0, %1, %2" : "=v"(r) : "v"(lo), "v"(hi)); return r; }
typedef float f32x2 __attribute__((ext_vector_type(2)));
__device__ __forceinline__ f32x2 gelu_pk(f32x2 v) {
    const f32x2 av = __builtin_elementwise_abs(v), d = av * 0.2316418882f + 1.0f;
    f32x2 t; t.x = __builtin_amdgcn_rcpf(d.x); t.y = __builtin_amdgcn_rcpf(d.y);
    f32x2 q = t * 0.5307027145f + (-0.7265760135f); q = q * t + 0.7107068705f; q = q * t + (-0.142248368f); q = q * t + 0.127414796f; q = q * t;
    const f32x2 s = (v * v) * (-0.72134752044f);
    f32x2 e; e.x = __builtin_amdgcn_exp2f(s.x); e.y = __builtin_amdgcn_exp2f(s.y);
    const f32x2 m = v * (q * e), r = v - m;
    f32x2 o; o.x = v.x < 0.f ? m.x : r.x; o.y = v.y < 0.f ? m.y : r.y; return o;
}

template <int ACT  > struct EpiBf16 {
    static constexpr bool PERM = true, AFTER_DRAIN = false; static_assert(ACT == 0 || ACT == 1, "EpiBf16: ACT is 0 (none) or 1 (gelu_pk)");
    bf16_t* O; int ldc; const float* bias; int split_cols; size_t split_stride; float scale0;
    __device__ __forceinline__ void operator()(const f32x4 (&acc)[2][2][4][2], const Unit& u, int wr, int wc, int fr, int fq) const {
        const int row0 = u.pm * BM + wr * 64 + fr; int colt = u.pn * BM; bf16_t* base = O;
        float sc = 1.f; if (split_cols) { const int t = colt / split_cols; base += (size_t)t * split_stride; colt -= t * split_cols; if (t == 0) sc = scale0; }
        const int col0 = colt + wc * 32 + 8 * fq, bcol0 = u.pn * BM + wc * 32 + 8 * fq;
        f32x4 bv[2][2];
#pragma unroll
        for (int bj = 0; bj < 2; ++bj)
#pragma unroll
            for (int n = 0; n < 2; ++n) bv[bj][n] = bias ? *(const f32x4*)(bias + bcol0 + bj * HALF + 4 * n) : (f32x4){0.f, 0.f, 0.f, 0.f};
#pragma unroll
        for (int ai = 0; ai < 2; ++ai)
#pragma unroll
            for (int m = 0; m < 4; ++m) { bf16_t* rowp = base + (size_t)(row0 + ai * HALF + m * 16) * ldc + col0;
#pragma unroll
                for (int bj = 0; bj < 2; ++bj) { f32x4 v0 = acc[ai][bj][m][0] + bv[bj][0], v1 = acc[ai][bj][m][1] + bv[bj][1];
                    if (ACT == 1) { f32x2 a = gelu_pk((f32x2){v0[0], v0[1]}), b = gelu_pk((f32x2){v0[2], v0[3]}), c = gelu_pk((f32x2){v1[0], v1[1]}), d = gelu_pk((f32x2){v1[2], v1[3]});
                        v0 = (f32x4){a.x, a.y, b.x, b.y}; v1 = (f32x4){c.x, c.y, d.x, d.y}; }
                    v0 = v0 * sc; v1 = v1 * sc; u32x4 w; w.x = cvt_pk_bf16(v0[0], v0[1]); w.y = cvt_pk_bf16(v0[2], v0[3]); w.z = cvt_pk_bf16(v1[0], v1[1]); w.w = cvt_pk_bf16(v1[2], v1[3]);
                    *(u32x4*)(rowp + bj * HALF) = w; } }
    }
};

template <class Epi, class Sched, bool ALIGN_EPI = false, bool SP2 = false>
__device__ __forceinline__ void gemm_phase(PG8_LAS unsigned char* lds, const Gemm g, const Sched& S, const Epi& E) {
    const int tid = threadIdx.x, wid = __builtin_amdgcn_readfirstlane(tid >> 6), lane = tid & 63, wr = wid >> 2, wc = wid & 3, fr = lane & 15, fq = lane >> 4;
    const int K = g.K, nt = K / BK;
    unsigned voffA[2], voffB[2];
#pragma unroll
    for (int i = 0; i < 2; ++i) { int R, C; stage_rc(tid * 16 + i * 8192, R, C); const int Rb = Epi::PERM ? ((R & ~31) + perm32(R & 31)) : R;
        voffA[i] = (unsigned)(R * K + C) * 2u; voffB[i] = (unsigned)(Rb * K + C) * 2u; }
    const size_t kstep = (size_t)(BK * 2);
    const size_t hstep = (size_t)HALF * K * 2;
    const size_t tstep = 2 * hstep;
    const unsigned ldsw = (unsigned)wid * 1024u;
    const int aoff = lds_byte(wr * 64 + fr, fq * 8), boff = lds_byte(wc * 32 + fr, fq * 8);
#define PG8_SA(b, h) (((b) * 2 + (h)) * HTB)
#define PG8_SB(b, h) ((4 + (b) * 2 + (h)) * HTB)
#define PG8_STAGE(bufoff, gbase, voff) do { _Pragma("unroll") for (int _i = 0; _i < 2; ++_i) \
        __builtin_amdgcn_global_load_lds((const unsigned*)((const char*)(gbase) + (voff)[_i]), (PG8_LAS unsigned*)(lds + (bufoff) + ldsw + _i * 8192), 16, 0, 0); } while (0)
#define PG8_LDA(dst, b, h) do { _Pragma("unroll") for (int m = 0; m < 4; ++m) _Pragma("unroll") for (int k = 0; k < 2; ++k) dst[m][k] = *(const PG8_LAS bf16x8*)(lds + PG8_SA(b, h) + aoff + m * 2048 + k * 1024); } while (0)
#define PG8_LDB(dst, b, h) do { _Pragma("unroll") for (int n = 0; n < 2; ++n) _Pragma("unroll") for (int k = 0; k < 2; ++k) dst[n][k] = *(const PG8_LAS bf16x8*)(lds + PG8_SB(b, h) + boff + n * 2048 + k * 1024); } while (0)
#define PG8_MMA(ai, bj, At, Bt) do { __builtin_amdgcn_s_setprio(1); _Pragma("unroll") for (int m = 0; m < 4; ++m) _Pragma("unroll") for (int n = 0; n < 2; ++n) _Pragma("unroll") for (int k = 0; k < 2; ++k) \
        acc[ai][bj][m][n] = __builtin_amdgcn_mfma_f32_16x16x32_bf16(Bt[n][k], At[m][k], acc[ai][bj][m][n], 0, 0, 0); __builtin_amdgcn_s_setprio(0); } while (0)
#define PG8_WAIT_V(n) asm volatile("s_waitcnt vmcnt(" #n ")" ::: "memory")
#define PG8_WAIT_L(n) asm volatile("s_waitcnt lgkmcnt(" #n ")" ::: "memory")
#define PG8_BAR __builtin_amdgcn_s_barrier()
#define PG8_SCHED __builtin_amdgcn_sched_barrier(0)
    Unit cur, nxt; int ui = 0;
    if (!S.next(0, cur)) return;
    f32x4 acc[2][2][4][2];
#pragma unroll
    for (int a = 0; a < 2; ++a)
#pragma unroll
        for (int b = 0; b < 2; ++b)
#pragma unroll
            for (int m = 0; m < 4; ++m)
#pragma unroll
                for (int n = 0; n < 2; ++n) acc[a][b][m][n] = (f32x4){0.f, 0.f, 0.f, 0.f};
    bf16x8 At[4][2], B0[2][2], B1[2][2];
    const char* cA = (const char*)g.A + (size_t)cur.pm * tstep; const char* cB = (const char*)g.Bt + (size_t)cur.pn * tstep;
    S.a_ready(cur);
    if constexpr (SP2) {
        PG8_STAGE(PG8_SB(0, 0), cB, voffB); PG8_STAGE(PG8_SB(0, 1), cB + hstep, voffB); PG8_STAGE(PG8_SA(0, 0), cA, voffA); PG8_STAGE(PG8_SA(0, 1), cA + hstep, voffA);
        if (wr == 1) PG8_BAR;
        PG8_WAIT_V(2); PG8_BAR;
        PG8_STAGE(PG8_SB(1, 0), cB + kstep, voffB); PG8_STAGE(PG8_SA(1, 0), cA + kstep, voffA); PG8_STAGE(PG8_SB(1, 1), cB + hstep + kstep, voffB);
        PG8_WAIT_V(6); PG8_BAR;
    } else {
        PG8_STAGE(PG8_SB(0, 0), cB, voffB); PG8_STAGE(PG8_SA(0, 0), cA, voffA); PG8_STAGE(PG8_SB(0, 1), cB + hstep, voffB); PG8_STAGE(PG8_SA(0, 1), cA + hstep, voffA);
        if (wr == 1) PG8_BAR;
        PG8_WAIT_V(4); PG8_BAR;
        PG8_STAGE(PG8_SB(1, 0), cB + kstep, voffB); PG8_STAGE(PG8_SA(1, 0), cA + kstep, voffA); PG8_STAGE(PG8_SB(1, 1), cB + hstep + kstep, voffB);
        PG8_WAIT_V(6); PG8_BAR;
    }
    for (;;) {
        const bool has_next = S.next(ui + 1, nxt);
        const char* nA = has_next ? (const char*)g.A + (size_t)nxt.pm * tstep : cA; const char* nB = has_next ? (const char*)g.Bt + (size_t)nxt.pn * tstep : cB;
        for (int t = 0; t < nt; t += 2) {
            const bool last = (t == nt - 2);
            const char* a1 = cA + (size_t)(t + 1) * kstep;
            const char* a2 = last ? nA : cA + (size_t)(t + 2) * kstep; const char* b2 = last ? nB : cB + (size_t)(t + 2) * kstep;
            const char* a3 = a2 + kstep; const char* b3 = b2 + kstep;
            if (last && has_next) S.a_ready(nxt);
            if constexpr (SP2) {
            PG8_LDB(B0, 0, 0); PG8_LDB(B1, 0, 1); PG8_SCHED; PG8_LDA(At, 0, 0); PG8_STAGE(PG8_SA(1, 1), a1 + hstep, voffA);
            PG8_WAIT_V(8); PG8_WAIT_L(0); PG8_BAR; PG8_MMA(0, 0, At, B0); PG8_MMA(0, 1, At, B1); PG8_BAR; PG8_SCHED;
            PG8_LDA(At, 0, 1); PG8_STAGE(PG8_SB(0, 0), b2, voffB); PG8_STAGE(PG8_SB(0, 1), b2 + hstep, voffB); PG8_STAGE(PG8_SA(0, 0), a2, voffA);
            PG8_WAIT_V(8); PG8_WAIT_L(0); PG8_BAR; PG8_MMA(1, 0, At, B0); PG8_MMA(1, 1, At, B1); PG8_BAR; PG8_SCHED;
            PG8_LDB(B0, 1, 0); PG8_LDB(B1, 1, 1); PG8_SCHED; PG8_LDA(At, 1, 0); PG8_STAGE(PG8_SA(0, 1), a2 + hstep, voffA);
            PG8_WAIT_V(8); PG8_WAIT_L(0); PG8_BAR; PG8_MMA(0, 0, At, B0); PG8_MMA(0, 1, At, B1); PG8_BAR; PG8_SCHED;
            PG8_LDA(At, 1, 1); PG8_STAGE(PG8_SB(1, 0), b3, voffB); PG8_STAGE(PG8_SB(1, 1), b3 + hstep, voffB); PG8_STAGE(PG8_SA(1, 0), a3, voffA);
            PG8_WAIT_V(8); PG8_WAIT_L(0); PG8_BAR; PG8_MMA(1, 0, At, B0); PG8_MMA(1, 1, At, B1); PG8_BAR; PG8_SCHED;
            } else {
            PG8_LDB(B0, 0, 0); PG8_SCHED; PG8_LDA(At, 0, 0); PG8_STAGE(PG8_SA(1, 1), a1 + hstep, voffA);
            PG8_WAIT_L(8); PG8_BAR; PG8_WAIT_L(0); PG8_MMA(0, 0, At, B0); PG8_BAR; PG8_SCHED;
            PG8_LDB(B1, 0, 1); PG8_STAGE(PG8_SB(0, 0), b2, voffB);
            PG8_BAR; PG8_WAIT_L(0); PG8_MMA(0, 1, At, B1); PG8_BAR;
            PG8_LDA(At, 0, 1); PG8_STAGE(PG8_SA(0, 0), a2, voffA);
            PG8_BAR; PG8_WAIT_L(0); PG8_MMA(1, 0, At, B0); PG8_BAR; PG8_SCHED;
            PG8_STAGE(PG8_SB(0, 1), b2 + hstep, voffB);
            PG8_WAIT_V(6); PG8_BAR; PG8_MMA(1, 1, At, B1); PG8_BAR;
            PG8_LDB(B0, 1, 0); PG8_SCHED; PG8_LDA(At, 1, 0); PG8_STAGE(PG8_SA(0, 1), a2 + hstep, voffA);
            PG8_WAIT_L(8); PG8_BAR; PG8_WAIT_L(0); PG8_MMA(0, 0, At, B0); PG8_BAR; PG8_SCHED;
            PG8_LDB(B1, 1, 1); PG8_STAGE(PG8_SB(1, 0), b3, voffB);
            PG8_BAR; PG8_WAIT_L(0); PG8_MMA(0, 1, At, B1); PG8_BAR;
            PG8_LDA(At, 1, 1); PG8_STAGE(PG8_SA(1, 0), a3, voffA);
            PG8_BAR; PG8_WAIT_L(0); PG8_MMA(1, 0, At, B0); PG8_BAR; PG8_SCHED;
            PG8_STAGE(PG8_SB(1, 1), b3 + hstep, voffB);
            PG8_WAIT_V(6); PG8_BAR; PG8_MMA(1, 1, At, B1); PG8_BAR;
            }
        }
        if constexpr (ALIGN_EPI) { if (wr == 0) PG8_BAR; }
        if constexpr (!Epi::AFTER_DRAIN) { E(acc, cur, wr, wc, fr, fq); S.done(cur); }
        if (!has_next) break;
#pragma unroll
        for (int a = 0; a < 2; ++a)
#pragma unroll
            for (int b = 0; b < 2; ++b)
#pragma unroll
                for (int m = 0; m < 4; ++m)
#pragma unroll
                    for (int n = 0; n < 2; ++n) acc[a][b][m][n] = (f32x4){0.f, 0.f, 0.f, 0.f};
        cur = nxt; cA = nA; cB = nB; ++ui;
        if constexpr (ALIGN_EPI) { if (wr == 1) PG8_BAR; }
    }
    PG8_WAIT_V(0);
    if constexpr (!ALIGN_EPI) { if (wr == 0) PG8_BAR; }
    PG8_BAR;
    if constexpr (Epi::AFTER_DRAIN) { E.fused(acc, cur, wr, wc, fr, fq, lds, wid, lane); S.done(cur); }
#undef PG8_SA
#undef PG8_SB
#undef PG8_STAGE
#undef PG8_LDA
#undef PG8_LDB
#undef PG8_MMA
#undef PG8_WAIT_V
#undef PG8_WAIT_L
#undef PG8_BAR
#undef PG8_SCHED
}
}

#ifndef PG8_SP2
#define PG8_SP2 true
#endif

constexpr int NB = 2, SEQ = 8192, DM = 1024, NTOK = NB * SEQ;
constexpr int NPROJ = 3072;
constexpr int C_GQ = 0, C_GK = 256, C_GV = 512, C_GR = 1024, C_NQ = 1536, C_KC = 2048, C_VC = 2176, C_KS = 2304, C_VS = 2432, C_KW = 2560, C_VW = 2688, C_GLR = 2816, C_NG = 2832, C_END = 2856;
constexpr int SGW = 2048;
constexpr int NEXP = 16, EHID = 512;
constexpr int MOE_ROWS = 36864;
constexpr float NORM_EPS = 1e-6f;
constexpr float NEGBIG = -1e30f;

constexpr size_t MiB = 1u << 20;
constexpr size_t WS_CTL = 0, CTL_ZERO_BYTES = 1 * MiB;
constexpr size_t WS_MOD = 1 * MiB;
constexpr size_t WS_ROUTE = 2 * MiB;
constexpr size_t WS_GATES = 3 * MiB;
constexpr size_t WS_STATS = 5 * MiB;
constexpr size_t WS_DEC = 7 * MiB;
constexpr size_t WS_WIN = 8 * MiB;
constexpr size_t WS_WOUT = 14 * MiB;
constexpr size_t WS_WINC = 16 * MiB;
constexpr size_t WS_WOUTC = 24 * MiB;
constexpr size_t WS_WCW1 = 28 * MiB;
constexpr size_t WS_WGU = 30 * MiB;
constexpr size_t WS_WDN = 94 * MiB;
constexpr size_t WS_A = 126 * MiB;
constexpr size_t WS_O = 254 * MiB;
constexpr size_t WS_END = 318 * MiB;
constexpr size_t A_HID_OFF = 72 * MiB;
constexpr size_t DO_QN = 0;
constexpr size_t DO_KSEL = 16 * MiB, DO_VSEL = 20 * MiB, DO_KWIN = 24 * MiB, DO_VWIN = 28 * MiB;
constexpr size_t DO_KC = 32 * MiB, DO_VC = 36 * MiB + 65536;
constexpr size_t DO_KCMP = 41 * MiB, DO_VCMP = 41 * MiB + 512 * 1024;

constexpr int CW_TMO = 0, CW_CODE = 1;
constexpr int CW_BAR = 4096;
constexpr int CW_CNT = 8192;

constexpr int RING_OFF = 0, RING_BYTES = 131072;
constexpr int LDSCTL_OFF = RING_BYTES, MISC_OFF = LDSCTL_OFF + 320;
constexpr int TAB_OFF = LDSCTL_OFF + 1024;
constexpr int LDS_BYTES = 147456;

#define GAS __attribute__((address_space(1)))
#define LAS __attribute__((address_space(3)))
typedef unsigned short bf16;
typedef unsigned v4u __attribute__((ext_vector_type(4)));
typedef unsigned v2u __attribute__((ext_vector_type(2)));
typedef float f32x4 __attribute__((ext_vector_type(4)));
typedef float f32x2 __attribute__((ext_vector_type(2)));
typedef float f32x16 __attribute__((ext_vector_type(16)));
typedef short bf16x8 __attribute__((ext_vector_type(8)));
typedef short s16x4 __attribute__((ext_vector_type(4)));
typedef GAS unsigned gu32;
#define RLX_AGENT __ATOMIC_RELAXED, __HIP_MEMORY_SCOPE_AGENT
#define LDS_WAIT() asm volatile("s_waitcnt lgkmcnt(0)" ::: "memory")
#define VM_WAIT() asm volatile("s_waitcnt vmcnt(0)" ::: "memory")
__device__ __forceinline__ unsigned f2bf(float f) { unsigned u = __builtin_bit_cast(unsigned, f); return (u + 0x7fffu + ((u >> 16) & 1u)) >> 16; }
__device__ __forceinline__ unsigned pk2(float lo, float hi) { return f2bf(lo) | (f2bf(hi) << 16); }
__device__ __forceinline__ float bf2f(unsigned short b) { return __builtin_bit_cast(float, (unsigned)b << 16); }
__device__ __forceinline__ float bflo(unsigned w) { return __builtin_bit_cast(float, w << 16); }
__device__ __forceinline__ float bfhi(unsigned w) { return __builtin_bit_cast(float, w & 0xffff0000u); }
__device__ __forceinline__ float fexp2(float x) { return __builtin_amdgcn_exp2f(x); }
__device__ __forceinline__ float fexp(float x) { return __builtin_amdgcn_exp2f(x * 1.4426950408889634f); }
__device__ __forceinline__ float frcp(float x) { return __builtin_amdgcn_rcpf(x); }
__device__ __forceinline__ float sigmoidf_(float x) { return 1.0f / (1.0f + __expf(-x)); }
__device__ __forceinline__ float siluf_(float x) { return x / (1.0f + __expf(-x)); }
__device__ __forceinline__ float gelu_tanh(float x) {
    const float u = 0.7978845608028654f * (x + 0.044715f * x * x * x);
    return x / (1.0f + __expf(-2.0f * u));
}
__device__ __forceinline__ float wave_sum(float v) {
#pragma unroll
    for (int o = 1; o < 64; o <<= 1) v += __shfl_xor(v, o);
    return v;
}
__device__ __forceinline__ void unpack8(const v4u w, float (&f)[8]) {
    f[0] = bflo(w.x); f[1] = bfhi(w.x); f[2] = bflo(w.y); f[3] = bfhi(w.y); f[4] = bflo(w.z); f[5] = bfhi(w.z); f[6] = bflo(w.w); f[7] = bfhi(w.w);
}
__device__ __forceinline__ v4u pack8(const float (&f)[8]) { v4u w; w.x = pk2(f[0], f[1]); w.y = pk2(f[2], f[3]); w.z = pk2(f[4], f[5]); w.w = pk2(f[6], f[7]); return w; }

#define XB_TMO      128
#define XB_XCNT(j)  (256  + 64 * (j))
#define XB_XSUB(j)  (1280 + 64 * (j))
#define XB_XGEN(j)  (2304 + 64 * (j))
#define XB_TOP      3328
#define XB_TOPGEN   3392
#define XCD_BAR_WORDS 3456
#define XB_SPIN_CAP (1u << 18)

__device__ __forceinline__ unsigned xb_ld(unsigned* p)              { return __hip_atomic_load(p, __ATOMIC_RELAXED, __HIP_MEMORY_SCOPE_AGENT); }
__device__ __forceinline__ unsigned xb_add(unsigned* p, unsigned v) { return __hip_atomic_fetch_add(p, v, __ATOMIC_RELAXED, __HIP_MEMORY_SCOPE_AGENT); }
__device__ __forceinline__ unsigned xb_xcc_id() { return (unsigned)__builtin_amdgcn_s_getreg((3 << 11) | 20) & 0xFu; }
#define XB_SPIN(cond, bar) do { unsigned _sp = 0; while (cond) { __builtin_amdgcn_s_sleep(1); \
    if ((++_sp & 255u) == 0u) { if (xb_ld(&(bar)[XB_TMO])) break; if (_sp > XB_SPIN_CAP) { atomicAdd(&(bar)[XB_TMO], 1u); break; } } } } while (0)

struct XcdBarrier {
    unsigned* bar; unsigned x;
    volatile LAS unsigned* st;
};
__device__ __forceinline__ XcdBarrier xcd_barrier_post(unsigned* bar, volatile LAS unsigned* st) {
    XcdBarrier b; b.bar = bar; b.x = xb_xcc_id(); b.st = st;
    if (threadIdx.x == 0) (void)xb_add(&bar[XB_XCNT(b.x)], 1u);
    return b;
}
__device__ __forceinline__ void xcd_barrier_complete(unsigned* bar, unsigned x, unsigned& nloc, unsigned& nx) {
    const unsigned G = gridDim.x * gridDim.y * gridDim.z;
    unsigned sum, cnt, mine, sp = 0u;
    for (;;) {
        sum = 0u; cnt = 0u; mine = 0u;
#pragma unroll
        for (unsigned j = 0; j < 16; ++j) { const unsigned c = xb_ld(&bar[XB_XCNT(j)]); sum += c; cnt += (c > 0u) ? 1u : 0u; mine = (j == x) ? c : mine; }
        if (sum == G) break;
        __builtin_amdgcn_s_sleep(1);
        if ((++sp & 255u) == 0u) { if (xb_ld(&bar[XB_TMO])) break; if (sp > XB_SPIN_CAP) { atomicAdd(&bar[XB_TMO], 1u); break; } }
    }
    nloc = mine > 0u ? mine : 1u; nx = cnt > 0u ? cnt : 1u;
}
__device__ __forceinline__ void xcd_barrier(const XcdBarrier& b) {
    asm volatile("s_waitcnt vmcnt(0)" ::: "memory");
    __syncthreads();
    if (threadIdx.x == 0) {
        unsigned* bar = b.bar;
        __builtin_amdgcn_s_waitcnt(0);
        unsigned nloc = b.st[0], nx = b.st[1];
        if (nloc == 0u) { xcd_barrier_complete(bar, b.x, nloc, nx); b.st[0] = nloc; b.st[1] = nx; }
        const unsigned old = xb_add(&bar[XB_XSUB(b.x)], 1u);
        const unsigned gen = old / nloc;
        if (old + 1u == (gen + 1u) * nloc) {
            __builtin_amdgcn_fence(__ATOMIC_RELEASE, "agent");
            asm volatile("s_waitcnt vmcnt(0)" ::: "memory");
            const unsigned og = xb_add(&bar[XB_TOP], 1u);
            const unsigned tg = og / nx;
            if (og + 1u == (tg + 1u) * nx) xb_add(&bar[XB_TOPGEN], 1u);
            else XB_SPIN(xb_ld(&bar[XB_TOPGEN]) == tg, bar);
            __builtin_amdgcn_fence(__ATOMIC_ACQUIRE, "agent");
            xb_add(&bar[XB_XGEN(b.x)], 1u);
            asm volatile("s_waitcnt vmcnt(0)" ::: "memory");
        } else {
            XB_SPIN(xb_ld(&bar[XB_XGEN(b.x)]) == gen, bar);
            __builtin_amdgcn_fence(__ATOMIC_ACQUIRE, "agent");
            asm volatile("s_waitcnt vmcnt(0)" ::: "memory");
        }
    }
    __syncthreads();
}

struct Frame {
    LAS unsigned char* lds;
    volatile LAS unsigned* MISC;
    gu32* ctl;
    int tid, lane, wave;
    int bid, G;
    unsigned char* ws;
    unsigned char* dout_b;
    float* out;
    const float *x, *c, *w_ada, *b_ada, *norm_g, *w_in_ab, *w_out_ab, *gla_w2, *gla_bg, *gla_ng, *q_gain, *k_gain, *cmp_pe, *cmp_w1, *cmp_w2, *w_in_c, *sgu_ng, *sgu_ws, *sgu_bs, *w_out_c, *w_router, *r_bias, *w_gate, *w_up, *w_down;
    const int* positions;
};

struct EpiResid {
    static constexpr bool PERM = false, AFTER_DRAIN = false;
    const float* xin; float* xout; const float* gate;
    __device__ __forceinline__ void operator()(const pg8::f32x4 (&acc)[2][2][4][2], const pg8::Unit& u, int wr, int wc, int fr, int fq) const {
        const int row0 = u.pm * 256 + wr * 64 + fr, col0 = u.pn * 256 + wc * 32 + 4 * fq;
        const float* gb = gate + ((u.pm * 256 >= SEQ) ? 6144 : 0);
        f32x4 gv[2][2];
#pragma unroll
        for (int bj = 0; bj < 2; ++bj)
#pragma unroll
            for (int n = 0; n < 2; ++n) gv[bj][n] = *(const f32x4*)(gb + col0 + bj * 128 + n * 16);
#pragma unroll
        for (int ai = 0; ai < 2; ++ai)
#pragma unroll
            for (int m = 0; m < 4; ++m) {
                const size_t rb = (size_t)(row0 + ai * 128 + m * 16) * DM;
#pragma unroll
                for (int bj = 0; bj < 2; ++bj)
#pragma unroll
                    for (int n = 0; n < 2; ++n) {
                        const size_t p = rb + col0 + bj * 128 + n * 16;
                        const f32x4 xi = *(const f32x4*)(xin + p);
                        *(f32x4*)(xout + p) = xi + gv[bj][n] * acc[ai][bj][m][n];
                    }
            }
    }
};
struct EpiGeluStats {
    static constexpr bool PERM = true, AFTER_DRAIN = false;
    bf16* Z; float* stats;
    __device__ __forceinline__ void operator()(const pg8::f32x4 (&acc)[2][2][4][2], const pg8::Unit& u, int wr, int wc, int fr, int fq) const {
        const int row0 = u.pm * 256 + wr * 64 + fr, col0 = u.pn * 256 + wc * 32 + 8 * fq;
#pragma unroll
        for (int ai = 0; ai < 2; ++ai)
#pragma unroll
            for (int m = 0; m < 4; ++m) {
                const int row = row0 + ai * 128 + m * 16; float ss = 0.f;
#pragma unroll
                for (int bj = 0; bj < 2; ++bj) {
                    float g[8];
#pragma unroll
                    for (int n = 0; n < 2; ++n)
#pragma unroll
                        for (int i = 0; i < 4; ++i) { g[n * 4 + i] = gelu_tanh(acc[ai][bj][m][n][i]); ss += g[n * 4 + i] * g[n * 4 + i]; }
                    *(v4u*)(Z + (size_t)row * 4096 + col0 + bj * 128) = pack8(g);
                }
                if (u.pn >= 8) {
                    ss += __shfl_xor(ss, 16); ss += __shfl_xor(ss, 32);
                    if (fq == 0) stats[(size_t)row * 32 + (u.pn - 8) * 4 + wc] = ss;
                }
            }
    }
};
struct EpiMoeGU {
    static constexpr bool PERM = true, AFTER_DRAIN = false;
    bf16* HID;
    __device__ __forceinline__ void operator()(const pg8::f32x4 (&acc)[2][2][4][2], const pg8::Unit& u, int wr, int wc, int fr, int fq) const {
        const int row0 = u.pm * 256 + wr * 64 + fr, col0 = (u.pn & 3) * 128 + wc * 32 + 8 * fq;
#pragma unroll
        for (int ai = 0; ai < 2; ++ai)
#pragma unroll
            for (int m = 0; m < 4; ++m) {
                float h[8];
#pragma unroll
                for (int n = 0; n < 2; ++n)
#pragma unroll
                    for (int i = 0; i < 4; ++i) h[n * 4 + i] = siluf_(acc[ai][0][m][n][i]) * acc[ai][1][m][n][i];
                *(v4u*)(HID + (size_t)(row0 + ai * 128 + m * 16) * EHID + col0) = pack8(h);
            }
    }
};
struct EpiMoeDn {
    static constexpr bool PERM = true, AFTER_DRAIN = false;
    bf16* YM;
    __device__ __forceinline__ void operator()(const pg8::f32x4 (&acc)[2][2][4][2], const pg8::Unit& u, int wr, int wc, int fr, int fq) const {
        const int row0 = u.pm * 256 + wr * 64 + fr, col0 = (u.pn & 3) * 256 + wc * 32 + 8 * fq;
#pragma unroll
        for (int ai = 0; ai < 2; ++ai)
#pragma unroll
            for (int m = 0; m < 4; ++m)
#pragma unroll
                for (int bj = 0; bj < 2; ++bj) {
                    float h[8];
#pragma unroll
                    for (int n = 0; n < 2; ++n)
#pragma unroll
                        for (int i = 0; i < 4; ++i) h[n * 4 + i] = acc[ai][bj][m][n][i];
                    *(v4u*)(YM + (size_t)(row0 + ai * 128 + m * 16) * DM + col0 + bj * 128) = pack8(h);
                }
    }
};
struct MoeOrder {
    const LAS int* ppre; int G, c;
    __device__ __forceinline__ bool next(int i, pg8::Unit& u) const {
        const int L = i * G + c, np = ppre[16];
        if (L >= np * 4) return false;
        const int pm = L >> 2; int e = 0;
#pragma unroll
        for (int k = 1; k < 16; ++k) e += (ppre[k] <= pm) ? 1 : 0;
        u.pm = pm; u.pn = e * 4 + (L & 3); return true;
    }
    __device__ __forceinline__ void a_ready(const pg8::Unit&) const {}
    __device__ __forceinline__ void done(const pg8::Unit&) const {}
};

__device__ __forceinline__ int dest_row(int mode, int n) {
    if (mode == 1) return (n < 1024) ? n : (n < 1040) ? n + 1792 : (n < 2832) ? n - 16 : n;
    if (mode == 2) return (n >> 7) * 256 + (n & 127);
    if (mode == 3) return (n >> 7) * 256 + 128 + (n & 127);
    return n;
}
__device__ __forceinline__ void transpose_item(const float* W, int K, int N, bf16* WT, int mode, LAS float* scr, int item, int lane) {
    const int nblk = (N + 31) / 32, kb = item / nblk, nb = item % nblk, k0 = 64 * kb, n0 = 32 * nb;
    const int col = n0 + (lane & 31);
#pragma unroll 8
    for (int i = 0; i < 32; ++i) { const int kk = 2 * i + (lane >> 5); scr[kk * 33 + (lane & 31)] = (col < N) ? W[(size_t)(k0 + kk) * N + col] : 0.f; }
    LDS_WAIT(); asm volatile("" ::: "memory");
    const int c = lane & 7;
#pragma unroll
    for (int j = 0; j < 4; ++j) { const int n = (lane >> 3) + 8 * j; const LAS float* s = scr + (8 * c) * 33 + n;
        v4u o; o.x = pk2(s[0 * 33], s[1 * 33]); o.y = pk2(s[2 * 33], s[3 * 33]); o.z = pk2(s[4 * 33], s[5 * 33]); o.w = pk2(s[6 * 33], s[7 * 33]);
        if (n0 + n < N) *(GAS v4u*)(WT + (size_t)dest_row(mode, n0 + n) * K + k0 + 8 * c) = o; }
    LDS_WAIT(); asm volatile("" ::: "memory");
}
__device__ __forceinline__ void p0_prologue(Frame& F) {
    LAS float* red = (LAS float*)(F.lds + RING_OFF);
    float* mod = (float*)(F.ws + WS_MOD);
    float* bias1 = (float*)(F.ws + WS_MOD + 131072);
    for (int bi = F.bid; bi < 200; bi += F.G) {
        if (bi < 192) {
            const int l = bi / 96, cg = bi % 96, j = cg * 64 + F.lane;
            float a0 = 0.f, a1 = 0.f;
            const float* wp = F.w_ada + ((size_t)l * 1024 + F.wave * 128) * 6144 + j;
#pragma unroll 8
            for (int k = 0; k < 128; ++k) { const float wv = wp[(size_t)k * 6144]; const float c0 = F.c[F.wave * 128 + k], c1 = F.c[1024 + F.wave * 128 + k];
                a0 += siluf_(c0) * wv; a1 += siluf_(c1) * wv; }
            red[(F.wave * 2 + 0) * 64 + F.lane] = a0; red[(F.wave * 2 + 1) * 64 + F.lane] = a1;
            __syncthreads();
            if (F.tid < 128) { const int b = F.tid >> 6, ln = F.tid & 63; float s = 0.f;
#pragma unroll
                for (int w = 0; w < 8; ++w) s += red[(w * 2 + b) * 64 + ln];
                mod[(size_t)(l * 2 + b) * 6144 + cg * 64 + ln] = s + F.b_ada[l * 6144 + cg * 64 + ln]; }
            __syncthreads();
        } else {
            const int kv = (bi - 192) >> 2, cg = (bi - 192) & 3, j = cg * 64 + F.lane;
            float a0 = 0.f;
            const float* wp = F.cmp_w1 + ((size_t)kv * 2048 + F.wave * 256) * 256 + j; const float* pe = F.cmp_pe + kv * 2048 + F.wave * 256;
#pragma unroll 8
            for (int k = 0; k < 256; ++k) a0 += pe[k] * wp[(size_t)k * 256];
            red[F.wave * 64 + F.lane] = a0;
            __syncthreads();
            if (F.tid < 64) { float s = 0.f;
#pragma unroll
                for (int w = 0; w < 8; ++w) s += red[w * 64 + F.tid];
                bias1[kv * 256 + cg * 64 + F.tid] = s; }
            __syncthreads();
        }
    }
    { bf16* wi = (bf16*)(F.ws + WS_WIN); const int npieces = (NPROJ - C_END) * (DM / 8);
      for (int p = F.bid * 512 + F.tid; p < npieces; p += F.G * 512) *(GAS v4u*)(wi + (size_t)C_END * DM + (size_t)p * 8) = (v4u){0u, 0u, 0u, 0u}; }
    LAS float* scr = (LAS float*)(F.lds + RING_OFF + 8192 + F.wave * 12288);
    const int gw = F.bid * 8 + F.wave, NGW = F.G * 8;
    constexpr int I_IN = 16 * 90, I_OUT = 16 * 32, I_INC = 16 * 128, I_OUTC = 32 * 32, I_CW1 = 2 * 32 * 8, I_G = 32 * 256, I_U = 32 * 256, I_D = 32 * 256;
    constexpr int NITEMS = I_IN + I_OUT + I_INC + I_OUTC + I_CW1 + I_G + I_U + I_D;
    for (int it = gw; it < NITEMS; it += NGW) {
        int r = it; const float* src; bf16* dst; int K, N, mode = 0;
        if (r < I_IN) { src = F.w_in_ab; dst = (bf16*)(F.ws + WS_WIN); K = 1024; N = 2856; mode = 1; }
        else if ((r -= I_IN) < I_OUT) { src = F.w_out_ab; dst = (bf16*)(F.ws + WS_WOUT); K = 1024; N = 1024; }
        else if ((r -= I_OUT) < I_INC) { src = F.w_in_c; dst = (bf16*)(F.ws + WS_WINC); K = 1024; N = 4096; }
        else if ((r -= I_INC) < I_OUTC) { src = F.w_out_c; dst = (bf16*)(F.ws + WS_WOUTC); K = 2048; N = 1024; }
        else if ((r -= I_OUTC) < I_CW1) { const int m = r >> 8; r &= 255; src = F.cmp_w1 + (size_t)m * 2048 * 256; dst = (bf16*)(F.ws + WS_WCW1) + (size_t)m * 256 * 2048; K = 2048; N = 256; }
        else if ((r -= I_CW1) < I_G) { const int m = r >> 8; r &= 255; src = F.w_gate + (size_t)m * 1024 * 512; dst = (bf16*)(F.ws + WS_WGU) + (size_t)m * 1024 * 1024; K = 1024; N = 512; mode = 2; }
        else if ((r -= I_G) < I_U) { const int m = r >> 8; r &= 255; src = F.w_up + (size_t)m * 1024 * 512; dst = (bf16*)(F.ws + WS_WGU) + (size_t)m * 1024 * 1024; K = 1024; N = 512; mode = 3; }
        else { r -= I_U; const int m = r >> 8; r &= 255; src = F.w_down + (size_t)m * 512 * 1024; dst = (bf16*)(F.ws + WS_WDN) + (size_t)m * 1024 * 512; K = 512; N = 1024; }
        transpose_item(src, K, N, dst, mode, scr, r, F.lane);
    }
}

struct RouteRec { int e0, e1, pos0, pos1; float w0, w1; int slot0, slot1; };
template <bool COMBINE, bool NORM, bool ROUTE>
__device__ __forceinline__ void row_pass(Frame& F, const float* xin, const float* modn  , int sh_off, const float* ng,
                                         const float* modc  , int layer) {
    float* xout = F.out; bf16* H = (bf16*)(F.ws + WS_O);
    const bf16* YM = (const bf16*)(F.ws + WS_A);
    RouteRec* route = (RouteRec*)(F.ws + WS_ROUTE);
    LAS float* wr = (LAS float*)(F.lds + RING_OFF);
    if (ROUTE) {
        for (int idx = F.tid; idx < 16384; idx += 512) wr[(idx & 15) * 1024 + (idx >> 4)] = F.w_router[idx];
        __syncthreads();
    }
    const int gw = F.bid * 8 + F.wave, NGW = F.G * 8;
#pragma unroll 1
    for (int b = 0; b < NB; ++b) {
        f32x4 cs[4], sh[4], gc[4];
#pragma unroll
        for (int j = 0; j < 4; ++j) {
            const int col = 4 * F.lane + 256 * j;
            if (NORM) { const f32x4 g = *(const f32x4*)(ng + col), sc = *(const f32x4*)(modn + b * 6144 + sh_off + 1024 + col); cs[j] = g * (sc + 1.0f); sh[j] = *(const f32x4*)(modn + b * 6144 + sh_off + col); }
            if (COMBINE) gc[j] = *(const f32x4*)(modc + b * 6144 + 5 * 1024 + col);
        }
#pragma unroll 1
        for (int m = b * SEQ + gw; m < (b + 1) * SEQ; m += NGW) {
            f32x4 v[4];
#pragma unroll
            for (int j = 0; j < 4; ++j) v[j] = *(const f32x4*)(xin + (size_t)m * DM + 4 * F.lane + 256 * j);
            if (COMBINE) {
                const RouteRec rr = route[m];
#pragma unroll
                for (int j = 0; j < 4; ++j) {
                    const v2u y0 = *(const v2u*)(YM + (size_t)rr.slot0 * DM + 4 * F.lane + 256 * j), y1 = *(const v2u*)(YM + (size_t)rr.slot1 * DM + 4 * F.lane + 256 * j);
                    f32x4 yy; yy.x = rr.w0 * bflo(y0.x) + rr.w1 * bflo(y1.x); yy.y = rr.w0 * bfhi(y0.x) + rr.w1 * bfhi(y1.x); yy.z = rr.w0 * bflo(y0.y) + rr.w1 * bflo(y1.y); yy.w = rr.w0 * bfhi(y0.y) + rr.w1 * bfhi(y1.y);
                    v[j] = v[j] + gc[j] * yy;
                    *(f32x4*)(xout + (size_t)m * DM + 4 * F.lane + 256 * j) = v[j];
                }
            }
            if (NORM) {
                float s = 0.f;
#pragma unroll
                for (int j = 0; j < 4; ++j) s += (v[j].x * v[j].x + v[j].y * v[j].y) + (v[j].z * v[j].z + v[j].w * v[j].w);
                const float rstd = 1.0f / sqrtf(wave_sum(s) * (1.0f / DM) + NORM_EPS);
#pragma unroll
                for (int j = 0; j < 4; ++j) { v[j] = v[j] * rstd * cs[j] + sh[j];
                    v2u o; o.x = pk2(v[j].x, v[j].y); o.y = pk2(v[j].z, v[j].w);
                    *(v2u*)(H + (size_t)m * DM + 4 * F.lane + 256 * j) = o; }
            }
            if (ROUTE) {
                float lg[16];
#pragma unroll
                for (int eg = 0; eg < 4; ++eg) {
                    float a4[4] = {0.f, 0.f, 0.f, 0.f};
#pragma unroll
                    for (int j = 0; j < 4; ++j)
#pragma unroll
                        for (int ee = 0; ee < 4; ++ee) { const f32x4 w = *(const LAS f32x4*)(wr + (eg * 4 + ee) * 1024 + 4 * F.lane + 256 * j); a4[ee] += (v[j].x * w.x + v[j].y * w.y) + (v[j].z * w.z + v[j].w * w.w); }
#pragma unroll
                    for (int ee = 0; ee < 4; ++ee) lg[eg * 4 + ee] = wave_sum(a4[ee]);
                    __builtin_amdgcn_sched_barrier(0);
                }
                float sc[16], sl[16];
#pragma unroll
                for (int e = 0; e < 16; ++e) { sc[e] = 1.0f / (1.0f + expf(-lg[e])); sl[e] = sc[e] + F.r_bias[e]; }
                float gs[4]; int ge1[4], ge2[4]; float gw1[4], gw2[4];
#pragma unroll
                for (int g = 0; g < 4; ++g) {
                    int i1 = 0; float m1 = sl[4 * g];
#pragma unroll
                    for (int k = 1; k < 4; ++k) if (sl[4 * g + k] > m1) { m1 = sl[4 * g + k]; i1 = k; }
                    int i2 = -1; float m2 = 0.f;
#pragma unroll
                    for (int k = 0; k < 4; ++k) if (k != i1 && (i2 < 0 || sl[4 * g + k] > m2)) { m2 = sl[4 * g + k]; i2 = k; }
                    gs[g] = m1 + m2; ge1[g] = 4 * g + i1; ge2[g] = 4 * g + i2;
                    float w1 = 0.f, w2 = 0.f;
#pragma unroll
                    for (int k = 0; k < 4; ++k) { w1 = (k == i1) ? sc[4 * g + k] : w1; w2 = (k == i2) ? sc[4 * g + k] : w2; }
                    gw1[g] = w1; gw2[g] = w2;
                }
                int gi = 0; float gm = gs[0];
#pragma unroll
                for (int g = 1; g < 4; ++g) if (gs[g] > gm) { gm = gs[g]; gi = g; }
                int e1 = ge1[0], e2 = ge2[0]; float w1 = gw1[0], w2 = gw2[0];
#pragma unroll
                for (int g = 1; g < 4; ++g) if (gi == g) { e1 = ge1[g]; e2 = ge2[g]; w1 = gw1[g]; w2 = gw2[g]; }
                const float ws_ = w1 + w2;
                if (F.lane == 0) {
                    unsigned* cnt = (unsigned*)(F.ctl + CW_CNT + 64 * layer);
                    RouteRec rr; rr.e0 = e1; rr.e1 = e2; rr.pos0 = (int)atomicAdd(cnt + e1, 1u); rr.pos1 = (int)atomicAdd(cnt + e2, 1u); rr.w0 = w1 / ws_; rr.w1 = w2 / ws_; rr.slot0 = 0; rr.slot1 = 0;
                    route[m] = rr;
                }
            }
        }
    }
}

__device__ __forceinline__ void moe_tables(Frame& F, int layer) {
    LAS int* ppre = (LAS int*)(F.lds + TAB_OFF);
    if (F.tid == 0) { const unsigned* cnt = (const unsigned*)(F.ctl + CW_CNT + 64 * layer); int acc = 0;
        for (int e = 0; e < 16; ++e) { ppre[e] = acc; acc += ((int)cnt[e] + 255) >> 8; }
        ppre[16] = acc; }
    __syncthreads();
}
__device__ __forceinline__ void moe_gather(Frame& F, int layer) {
    moe_tables(F, layer);
    const LAS int* ppre = (const LAS int*)(F.lds + TAB_OFF);
    RouteRec* route = (RouteRec*)(F.ws + WS_ROUTE);
    const bf16* H = (const bf16*)(F.ws + WS_O); bf16* HS = (bf16*)(F.ws + WS_A);
    const int gw = F.bid * 8 + F.wave, NGW = F.G * 8;
    for (int m = gw; m < NTOK; m += NGW) {
        RouteRec rr = route[m];
        int p0 = 0, p1 = 0;
#pragma unroll
        for (int e = 0; e < 16; ++e) { p0 = (rr.e0 == e) ? ppre[e] : p0; p1 = (rr.e1 == e) ? ppre[e] : p1; }
        const int s0 = p0 * 256 + rr.pos0, s1 = p1 * 256 + rr.pos1;
        const v4u a = *(const v4u*)(H + (size_t)m * DM + 8 * F.lane), b = *(const v4u*)(H + (size_t)m * DM + 512 + 8 * F.lane);
        *(v4u*)(HS + (size_t)s0 * DM + 8 * F.lane) = a; *(v4u*)(HS + (size_t)s0 * DM + 512 + 8 * F.lane) = b;
        *(v4u*)(HS + (size_t)s1 * DM + 8 * F.lane) = a; *(v4u*)(HS + (size_t)s1 * DM + 512 + 8 * F.lane) = b;
        if (F.lane == 0) { route[m].slot0 = s0; route[m].slot1 = s1; }
    }
}

__device__ __forceinline__ f32x4 mma16(const LAS bf16* A, int lda, const LAS bf16* Bt, int ldb, int K, f32x4 acc, int lane) {
    const LAS bf16* ap = A + (lane & 15) * lda + (lane >> 4) * 8;
    const LAS bf16* bp = Bt + (lane & 15) * ldb + (lane >> 4) * 8;
    for (int k = 0; k < K; k += 32) {
        const bf16x8 a = *(const LAS bf16x8*)(ap + k), b = *(const LAS bf16x8*)(bp + k);
        acc = __builtin_amdgcn_mfma_f32_16x16x32_bf16(a, b, acc, 0, 0, 0);
    }
    return acc;
}

__device__ __forceinline__ void gla_bcum(Frame& F, const bf16* prow  , int h, float (&bc)[8]) {
    float gl[16];
    { const v4u a = *(const v4u*)(prow + C_GLR), b = *(const v4u*)(prow + C_GLR + 8); float t0[8], t1[8]; unpack8(a, t0); unpack8(b, t1);
#pragma unroll
      for (int i = 0; i < 8; ++i) { gl[i] = t0[i]; gl[8 + i] = t1[i]; } }
#pragma unroll
    for (int i = 0; i < 8; ++i) {
        const int col = h * 64 + F.wave * 8 + i;
        float z = F.gla_bg[col];
#pragma unroll
        for (int r = 0; r < 16; ++r) z += gl[r] * F.gla_w2[r * 256 + col];
        const float ls = fminf(z, 0.f) - log1pf(__expf(-fabsf(z)));
        float v = ls * (1.0f / 16.0f);
#pragma unroll
        for (int off = 1; off < 64; off <<= 1) { const float o = __shfl_up(v, off); v += (F.lane >= off) ? o : 0.f; }
        bc[i] = v;
    }
}
__device__ __forceinline__ void gla_stage_vT(Frame& F, const bf16* prow, int h, LAS bf16* VT) {
    const v4u a = *(const v4u*)(prow + C_GV + h * 128 + F.wave * 16), b = *(const v4u*)(prow + C_GV + h * 128 + F.wave * 16 + 8);
    const unsigned w[8] = {a.x, a.y, a.z, a.w, b.x, b.y, b.z, b.w};
#pragma unroll
    for (int i = 0; i < 8; ++i) { VT[(F.wave * 16 + 2 * i) * 72 + F.lane] = (bf16)(w[i] & 0xffffu); VT[(F.wave * 16 + 2 * i + 1) * 72 + F.lane] = (bf16)(w[i] >> 16); }
}
__device__ __forceinline__ void gla_prep_item(Frame& F, int item) {
    const int h = item & 3, n = (item >> 2) & 127, b = item >> 9;
    const bf16* proj = (const bf16*)(F.ws + WS_A);
    const bf16* prow = proj + (size_t)(b * SEQ + n * 64 + F.lane) * NPROJ;
    LAS bf16* KT = (LAS bf16*)(F.lds + RING_OFF);
    LAS bf16* VT = (LAS bf16*)(F.lds + RING_OFF + 9216);
    float bc[8]; gla_bcum(F, prow, h, bc);
    float kf[8]; { const v4u kk = *(const v4u*)(prow + C_GK + h * 64 + F.wave * 8); unpack8(kk, kf); }
    float* DEC = (float*)(F.ws + WS_DEC) + ((size_t)(b * 128 + n) * 4 + h) * 64;
#pragma unroll
    for (int i = 0; i < 8; ++i) {
        const float bl = __shfl(bc[i], 63);
        KT[(F.wave * 8 + i) * 72 + F.lane] = (bf16)f2bf(kf[i] * __expf(bl - bc[i]));
        if (F.lane == 63) DEC[F.wave * 8 + i] = __expf(bl);
    }
    gla_stage_vT(F, prow, h, VT);
    __syncthreads();
    float* KV = (float*)(F.ws + WS_O) + ((size_t)(b * 128 + n) * 4 + h) * 8192;
    const int dt = F.wave >> 1;
#pragma unroll
    for (int j = 0; j < 4; ++j) {
        const int et = (F.wave & 1) * 4 + j;
        f32x4 acc = {0.f, 0.f, 0.f, 0.f};
        acc = mma16(KT + dt * 16 * 72, 72, VT + et * 16 * 72, 72, 64, acc, F.lane);
#pragma unroll
        for (int i = 0; i < 4; ++i) KV[(dt * 16 + 4 * (F.lane >> 4) + i) * 128 + et * 16 + (F.lane & 15)] = acc[i];
    }
    __syncthreads();
}
__device__ __forceinline__ void gla_scan(Frame& F, int gidx) {
    const int bh = gidx >> 13, de = gidx & 8191, b = bh >> 2, h = bh & 3;
    float* KV = (float*)(F.ws + WS_O) + ((size_t)(b * 128) * 4 + h) * 8192 + de;
    const float* DEC = (const float*)(F.ws + WS_DEC) + ((size_t)(b * 128) * 4 + h) * 64 + (de >> 7);
    float st = 0.f;
#pragma unroll 1
    for (int n0 = 0; n0 < 128; n0 += 8) {
        float kv[8], dc[8];
#pragma unroll
        for (int i = 0; i < 8; ++i) { kv[i] = KV[(size_t)(n0 + i) * 4 * 8192]; dc[i] = DEC[(size_t)(n0 + i) * 4 * 64]; }
#pragma unroll
        for (int i = 0; i < 8; ++i) { KV[(size_t)(n0 + i) * 4 * 8192] = st; st = dc[i] * st + kv[i]; }
    }
}
__device__ __forceinline__ void gla_out_item(Frame& F, int item) {
    const int h = item & 3, n = (item >> 2) & 127, b = item >> 9;
    const bf16* proj = (const bf16*)(F.ws + WS_A);
    const size_t tok = (size_t)b * SEQ + n * 64 + F.lane;
    const bf16* prow = proj + tok * NPROJ;
    LAS bf16* A1 = (LAS bf16*)(F.lds + RING_OFF);
    LAS bf16* B1 = (LAS bf16*)(F.lds + RING_OFF + 9216);
    LAS bf16* A2 = (LAS bf16*)(F.lds + RING_OFF + 18432);
    LAS bf16* SC = (LAS bf16*)(F.lds + RING_OFF + 27648);
    LAS bf16* VT = (LAS bf16*)(F.lds + RING_OFF + 36864);
    LAS bf16* ST = (LAS bf16*)(F.lds + RING_OFF + 55296);
    LAS float* OS = (LAS float*)(F.lds + RING_OFF + 73728);
    float bc[8]; gla_bcum(F, prow, h, bc);
    float qf[8], kf[8];
    { const v4u qq = *(const v4u*)(prow + C_GQ + h * 64 + F.wave * 8), kk = *(const v4u*)(prow + C_GK + h * 64 + F.wave * 8); unpack8(qq, qf); unpack8(kk, kf); }
    float a1[8], b1[8], a2[8];
#pragma unroll
    for (int i = 0; i < 8; ++i) {
        const float bm = __shfl(bc[i], 32);
        a1[i] = qf[i] * 0.125f * __expf(bc[i] - bm); b1[i] = kf[i] * __expf(bm - bc[i]); a2[i] = qf[i] * 0.125f * __expf(bc[i]);
    }
    *(LAS v4u*)(A1 + F.lane * 72 + F.wave * 8) = pack8(a1);
    *(LAS v4u*)(B1 + F.lane * 72 + F.wave * 8) = pack8(b1);
    *(LAS v4u*)(A2 + F.lane * 72 + F.wave * 8) = pack8(a2);
    gla_stage_vT(F, prow, h, VT);
    { const float* KV = (const float*)(F.ws + WS_O) + ((size_t)(b * 128 + n) * 4 + h) * 8192;
#pragma unroll
      for (int k = 0; k < 16; ++k) { const int p = F.tid + 512 * k, e = p & 127, d = p >> 7; ST[e * 72 + d] = (bf16)f2bf(KV[d * 128 + e]); } }
    __syncthreads();
    const int it = F.wave >> 1;
#pragma unroll
    for (int jj = 0; jj < 2; ++jj) {
        const int jt = (F.wave & 1) * 2 + jj;
        f32x4 acc = {0.f, 0.f, 0.f, 0.f};
        if (jt <= it) acc = mma16(A1 + it * 16 * 72, 72, B1 + jt * 16 * 72, 72, 64, acc, F.lane);
#pragma unroll
        for (int i = 0; i < 4; ++i) { const int ri = it * 16 + 4 * (F.lane >> 4) + i, cj = jt * 16 + (F.lane & 15); SC[ri * 72 + cj] = (bf16)f2bf((cj <= ri) ? acc[i] : 0.f); }
    }
    __syncthreads();
#pragma unroll
    for (int j = 0; j < 4; ++j) {
        const int et = (F.wave & 1) * 4 + j;
        f32x4 acc = {0.f, 0.f, 0.f, 0.f};
        acc = mma16(SC + it * 16 * 72, 72, VT + et * 16 * 72, 72, 64, acc, F.lane);
        acc = mma16(A2 + it * 16 * 72, 72, ST + et * 16 * 72, 72, 64, acc, F.lane);
#pragma unroll
        for (int i = 0; i < 4; ++i) OS[(it * 16 + 4 * (F.lane >> 4) + i) * 132 + et * 16 + (F.lane & 15)] = acc[i];
    }
    __syncthreads();
    { const int row = F.tid >> 3, c0 = (F.tid & 7) * 16;
      float v[16]; float ss = 0.f;
#pragma unroll
      for (int i = 0; i < 16; ++i) { v[i] = OS[row * 132 + c0 + i]; ss += v[i] * v[i]; }
      ss += __shfl_xor(ss, 1); ss += __shfl_xor(ss, 2); ss += __shfl_xor(ss, 4);
      const float rstd = 1.0f / sqrtf(ss * (1.0f / 128.0f) + NORM_EPS);
      const size_t tk = (size_t)b * SEQ + n * 64 + row;
      const bf16* rrow = proj + tk * NPROJ + C_GR + h * 128 + c0;
      float r0[8], r1[8]; unpack8(*(const v4u*)rrow, r0); unpack8(*(const v4u*)(rrow + 8), r1);
      float o0[8], o1[8];
#pragma unroll
      for (int i = 0; i < 8; ++i) { o0[i] = v[i] * rstd * F.gla_ng[c0 + i] * siluf_(r0[i]); o1[i] = v[8 + i] * rstd * F.gla_ng[c0 + 8 + i] * siluf_(r1[i]); }
      bf16* orow = (bf16*)(F.ws + WS_O + 32 * MiB) + tk * DM + h * 128 + c0;
      *(v4u*)orow = pack8(o0); *(v4u*)(orow + 8) = pack8(o1); }
    __syncthreads();
}

__device__ __forceinline__ double inv_freq_d(int i) {
    return (i == 0) ? 1.0 : (i == 1) ? 0.19392547740471268 : (i == 2) ? 0.037606090787015346 : (i == 3) ? 0.0072927791106285765 :
           (i == 4) ? 0.0014142135623730951 : (i == 5) ? 0.00027425197177757796 : (i == 6) ? 5.318404375373266e-05 : 1.0313741203148838e-05;
}
__device__ __forceinline__ void rope_sincos(int pos, int i, float& cs, float& sn) {
    const double rev = (double)pos * inv_freq_d(i) * 0.15915494309189535;
    const float fr = (float)(rev - rint(rev));
    cs = __builtin_amdgcn_cosf(fr); sn = __builtin_amdgcn_sinf(fr);
}
__device__ __forceinline__ void nsa_prep_token(Frame& F, int tok) {
    const int b = tok >> 13, t = tok & 8191, sub = F.lane & 7, vid = F.lane >> 3;
    const bf16* prow = (const bf16*)(F.ws + WS_A) + (size_t)tok * NPROJ;
    const int pos = F.positions[tok];
    float cs_l, sn_l; rope_sincos(pos, sub, cs_l, sn_l);
    float cs[8], sn[8];
#pragma unroll
    for (int i = 0; i < 8; ++i) { cs[i] = __shfl(cs_l, (F.lane & ~7) + i); sn[i] = __shfl(sn_l, (F.lane & ~7) + i); }
    unsigned char* dob = F.dout_b;
    const size_t ktile_off = (size_t)(t >> 6) * 8192 + sub * 1024 + (t & 63) * 16;
    const size_t vtile_off = (size_t)(t >> 6) * 8192 + (sub >> 2) * 4096 + (t & 63) * 64 + (sub & 3) * 16;
#pragma unroll
    for (int round = 0; round < 3; ++round) {
        int col; int kind; unsigned char* dst; const float* gain = nullptr;
        if (round == 0) { col = C_NQ + vid * 64; kind = 0; gain = F.q_gain; const int g = vid >> 2, hh = vid & 3;
            dst = dob + DO_QN + ((((size_t)(b * 2 + g) * SEQ + t) * 4 + hh) * 64 + sub * 8) * 2; }
        else if (round == 1) {
            const int g = vid & 1, which = vid >> 1;
            const size_t img = (size_t)(b * 2 + g) * (1u << 20);
            if (which == 0) { col = C_KS + g * 64; kind = 1; gain = F.k_gain + 64; dst = dob + DO_KSEL + img + ktile_off; }
            else if (which == 1) { col = C_KW + g * 64; kind = 1; gain = F.k_gain + 128; dst = dob + DO_KWIN + img + ktile_off; }
            else if (which == 2) { col = C_VS + g * 64; kind = 2; dst = dob + DO_VSEL + img + vtile_off; }
            else { col = C_VW + g * 64; kind = 2; dst = dob + DO_VWIN + img + vtile_off; }
        } else {
            const int g = vid & 1, which = (vid >> 1) & 1;
            col = (which ? C_VC : C_KC) + g * 64; kind = 2;
            dst = dob + (which ? DO_VC : DO_KC) + (((size_t)(b * 2 + g) * SEQ + t) * 64 + sub * 8) * 2;
        }
        float x[8]; unpack8(*(const v4u*)(prow + col + sub * 8), x);
        if (kind != 2) {
            float ss = 0.f;
#pragma unroll
            for (int i = 0; i < 8; ++i) ss += x[i] * x[i];
            ss += __shfl_xor(ss, 1); ss += __shfl_xor(ss, 2); ss += __shfl_xor(ss, 4);
            const float rstd = 1.0f / sqrtf(ss * (1.0f / 64.0f) + NORM_EPS);
#pragma unroll
            for (int i = 0; i < 8; ++i) x[i] = x[i] * rstd * gain[sub * 8 + i];
            float xo[8];
#pragma unroll
            for (int i = 0; i < 8; ++i) xo[i] = __shfl_xor(x[i], 1);
            if (sub == 0) {
#pragma unroll
                for (int i = 0; i < 8; ++i) x[i] = x[i] * cs[i] - xo[i] * sn[i];
            } else if (sub == 1) {
#pragma unroll
                for (int i = 0; i < 8; ++i) x[i] = x[i] * cs[i] + xo[i] * sn[i];
            }
            if (kind == 0) {
#pragma unroll
                for (int i = 0; i < 8; ++i) x[i] *= 0.125f * 1.4426950408889634f;
            }
        }
        if (round < 2 || F.lane < 32) *(v4u*)dst = pack8(x);
    }
    if (F.lane < 24) { float* gt = (float*)(F.ws + WS_GATES) + (size_t)tok * 24; gt[F.lane] = sigmoidf_(bf2f(prow[C_NG + F.lane])); }
}

__device__ __forceinline__ void nsa_compress_item(Frame& F, int item) {
    const int kv = item >> 6, b = (item >> 5) & 1, g = (item >> 4) & 1, rt = item & 15, n0 = rt * 32;
    const bf16* Asrc = (const bf16*)(F.dout_b + (kv ? DO_VC : DO_KC)) + ((size_t)(b * 2 + g) * SEQ + 16 * n0) * 64;
    const bf16* Bsrc = (const bf16*)(F.ws + WS_WCW1) + (size_t)kv * 256 * 2048;
    LAS bf16* As = (LAS bf16*)(F.lds + RING_OFF);
    LAS bf16* Bs = (LAS bf16*)(F.lds + RING_OFF + 2 * 32 * 72 * 2);
    LAS float* Hs = (LAS float*)(F.lds + RING_OFF + 86016);
    LAS float* W2s = (LAS float*)(F.lds + RING_OFF);
    const int ar = F.tid >> 3, ac = (F.tid & 7) * 8;
    v4u areg = {0u, 0u, 0u, 0u}, breg[4];
#define CMP_GLOAD(kc) do { if (F.tid < 256) areg = *(const v4u*)(Asrc + (size_t)ar * 1024 + (kc) * 64 + ac); \
        _Pragma("unroll") for (int i_ = 0; i_ < 4; ++i_) { const int p_ = F.tid + 512 * i_, br_ = p_ >> 3, bc_ = (p_ & 7) * 8; breg[i_] = *(const v4u*)(Bsrc + (size_t)br_ * 2048 + (kc) * 64 + bc_); } } while (0)
#define CMP_LSTORE(buf) do { if (F.tid < 256) *(LAS v4u*)(As + (buf) * 32 * 72 + ar * 72 + ac) = areg; \
        _Pragma("unroll") for (int i_ = 0; i_ < 4; ++i_) { const int p_ = F.tid + 512 * i_, br_ = p_ >> 3, bc_ = (p_ & 7) * 8; *(LAS v4u*)(Bs + (buf) * 256 * 72 + br_ * 72 + bc_) = breg[i_]; } } while (0)
    f32x4 acc[2][2];
#pragma unroll
    for (int mt = 0; mt < 2; ++mt)
#pragma unroll
        for (int nt = 0; nt < 2; ++nt) acc[mt][nt] = (f32x4){0.f, 0.f, 0.f, 0.f};
    CMP_GLOAD(0); CMP_LSTORE(0); __syncthreads();
#pragma unroll 1
    for (int kc = 0; kc < 32; ++kc) {
        const int buf = kc & 1;
        if (kc + 1 < 32) CMP_GLOAD(kc + 1);
#pragma unroll
        for (int mt = 0; mt < 2; ++mt)
#pragma unroll
            for (int nt = 0; nt < 2; ++nt)
                acc[mt][nt] = mma16(As + buf * 32 * 72 + mt * 16 * 72, 72, Bs + buf * 256 * 72 + (F.wave * 32 + nt * 16) * 72, 72, 64, acc[mt][nt], F.lane);
        if (kc + 1 < 32) CMP_LSTORE(buf ^ 1);
        __syncthreads();
    }
    const float* bias1 = (const float*)(F.ws + WS_MOD + 131072) + kv * 256;
#pragma unroll
    for (int mt = 0; mt < 2; ++mt)
#pragma unroll
        for (int nt = 0; nt < 2; ++nt) { const int col = F.wave * 32 + nt * 16 + (F.lane & 15);
#pragma unroll
            for (int i = 0; i < 4; ++i) Hs[(mt * 16 + 4 * (F.lane >> 4) + i) * 260 + col] = gelu_tanh(acc[mt][nt][i] + bias1[col]); }
    { const float* w2 = F.cmp_w2 + (size_t)kv * 256 * 64;
#pragma unroll
      for (int i = 0; i < 8; ++i) *(LAS f32x4*)(W2s + (F.tid + 512 * i) * 4) = *(const f32x4*)(w2 + (size_t)(F.tid + 512 * i) * 4); }
    __syncthreads();
    const int r = F.tid >> 4, dq = F.tid & 15;
    f32x4 o = {0.f, 0.f, 0.f, 0.f};
#pragma unroll 8
    for (int j = 0; j < 256; ++j) { const float hv = Hs[r * 260 + j]; const f32x4 w = *(const LAS f32x4*)(W2s + j * 64 + 4 * dq); o = o + w * hv; }
    const int n = n0 + r;
    if (kv == 0) {
        float ss = (o.x * o.x + o.y * o.y) + (o.z * o.z + o.w * o.w);
        ss += __shfl_xor(ss, 1); ss += __shfl_xor(ss, 2); ss += __shfl_xor(ss, 4); ss += __shfl_xor(ss, 8);
        const float rstd = 1.0f / sqrtf(ss * (1.0f / 64.0f) + NORM_EPS);
        const f32x4 gn = *(const f32x4*)(F.k_gain + 4 * dq);
        o = o * rstd * gn;
        const int tlast = (16 * n + 31 < SEQ) ? 16 * n + 31 : SEQ - 1;
        const int pos = F.positions[b * SEQ + tlast];
        f32x4 po; po.x = __shfl_xor(o.x, 2); po.y = __shfl_xor(o.y, 2); po.z = __shfl_xor(o.z, 2); po.w = __shfl_xor(o.w, 2);
        if (dq < 4) {
            const int i0 = 4 * (dq & 1);
            float c0, s0, c1, s1, c2, s2, c3, s3;
            rope_sincos(pos, i0, c0, s0); rope_sincos(pos, i0 + 1, c1, s1); rope_sincos(pos, i0 + 2, c2, s2); rope_sincos(pos, i0 + 3, c3, s3);
            if (dq < 2) { o.x = o.x * c0 - po.x * s0; o.y = o.y * c1 - po.y * s1; o.z = o.z * c2 - po.z * s2; o.w = o.w * c3 - po.w * s3; }
            else { o.x = o.x * c0 + po.x * s0; o.y = o.y * c1 + po.y * s1; o.z = o.z * c2 + po.z * s2; o.w = o.w * c3 + po.w * s3; }
        }
    }
    if (n == 511) o = (f32x4){0.f, 0.f, 0.f, 0.f};
    v2u pk; pk.x = pk2(o.x, o.y); pk.y = pk2(o.z, o.w);
    const int c = dq >> 1;
    unsigned char* img = F.dout_b + (kv ? DO_VCMP : DO_KCMP) + (size_t)(b * 2 + g) * 65536 + (size_t)(n >> 6) * 8192;
    if (kv == 0) *(v2u*)(img + c * 1024 + (n & 63) * 16 + (dq & 1) * 8) = pk;
    else *(v2u*)(img + (c >> 2) * 4096 + (n & 63) * 64 + (c & 3) * 16 + (dq & 1) * 8) = pk;
    __syncthreads();
}

constexpr int NSA_KB = 0, NSA_VB = 16384, NSA_IMP = 32768, NSA_SELM = 65536;
__device__ __forceinline__ int crow(int r, int hi) { return (r & 3) + 8 * (r >> 2) + 4 * hi; }
__device__ __forceinline__ s16x4 ds_tr16(const LAS unsigned char* p) { return __builtin_bit_cast(s16x4, __builtin_amdgcn_ds_read_tr16_b64_v4i16((LAS s16x4*)p)); }

template <int MODE>
__device__ __forceinline__ void nsa_branch(Frame& F, const unsigned char* Kimg, const unsigned char* Vimg, int kt0, int kt1, const bf16x8 (&qr)[4],
                                           float& m, float& l, f32x16 (&o)[2], int t, int tw0, int nv, int nvw,
                                           unsigned mk0, unsigned mk1, unsigned mk2, unsigned mk3, unsigned wo0, unsigned wo1, unsigned wo2, unsigned wo3,
                                           float inv_l, LAS float* impw) {
    const int r32 = F.lane & 31, hi = F.lane >> 5, tokl = r32 >> 2;
    LAS unsigned char* KB = F.lds + RING_OFF + NSA_KB; LAS unsigned char* VB = F.lds + RING_OFF + NSA_VB;
    const v4u* kg = (const v4u*)Kimg + F.tid; const v4u* vg = (const v4u*)Vimg + F.tid;
    v4u kreg = kg[(size_t)kt0 * 512], vreg = {0u, 0u, 0u, 0u};
    if (MODE != 0) vreg = vg[(size_t)kt0 * 512];
    *(LAS v4u*)(KB + F.tid * 16) = kreg; if (MODE != 0) *(LAS v4u*)(VB + F.tid * 16) = vreg;
    __syncthreads();
#pragma unroll 1
    for (int kt = kt0; kt < kt1; ++kt) {
        const int buf = (kt - kt0) & 1; const bool has_next = kt + 1 < kt1;
        if (has_next) { kreg = kg[(size_t)(kt + 1) * 512]; if (MODE != 0) vreg = vg[(size_t)(kt + 1) * 512]; }
        const LAS unsigned char* Kb = KB + buf * 8192; const LAS unsigned char* Vb = VB + buf * 8192;
        bool need;
        if (MODE <= 1) need = kt * 64 < nvw;
        else if (MODE == 2) { const unsigned w = (kt < 32) ? wo0 : (kt < 64) ? wo1 : (kt < 96) ? wo2 : wo3; need = (w >> (kt & 31)) & 1u; }
        else need = (kt * 64 <= tw0 + 7) && (kt * 64 + 63 + 512 > tw0);
        bool selbit = true;
        if (MODE == 2) { const unsigned w = (kt < 32) ? mk0 : (kt < 64) ? mk1 : (kt < 96) ? mk2 : mk3; selbit = (w >> (kt & 31)) & 1u; }
        if (need) {
#pragma unroll 1
            for (int kb = 0; kb < 2; ++kb) {
                const int key0 = kt * 64 + kb * 32;
                f32x16 p = {0.f, 0.f, 0.f, 0.f, 0.f, 0.f, 0.f, 0.f, 0.f, 0.f, 0.f, 0.f, 0.f, 0.f, 0.f, 0.f};
#pragma unroll
                for (int d0 = 0; d0 < 4; ++d0) {
                    const bf16x8 kf = *(const LAS bf16x8*)(Kb + (2 * d0 + hi) * 1024 + (32 * kb + r32) * 16);
                    p = __builtin_amdgcn_mfma_f32_32x32x16_bf16(kf, qr[d0], p, 0, 0, 0);
                }
                float pe[16];
                if (MODE == 1) {
#pragma unroll
                    for (int r = 0; r < 16; ++r) { const int key = key0 + crow(r, hi); pe[r] = (key < nv) ? fexp2(p[r] - m) * inv_l : 0.f; }
#pragma unroll
                    for (int rg = 0; rg < 4; ++rg) {
                        float a = (pe[4 * rg] + pe[4 * rg + 1]) + (pe[4 * rg + 2] + pe[4 * rg + 3]), sp = pe[4 * rg + 3];
                        a += __shfl_xor(a, 1); a += __shfl_xor(a, 2); sp += __shfl_xor(sp, 1); sp += __shfl_xor(sp, 2);
                        if ((r32 & 3) == 0) { const int jp = (key0 >> 2) + 2 * rg + hi;
                            __hip_atomic_fetch_add(impw + tokl * 128 + jp, a, __ATOMIC_RELAXED, __HIP_MEMORY_SCOPE_WORKGROUP);
                            if (jp + 1 < 128) __hip_atomic_fetch_add(impw + tokl * 128 + jp + 1, sp, __ATOMIC_RELAXED, __HIP_MEMORY_SCOPE_WORKGROUP); }
                    }
                } else {
                    float mx = NEGBIG;
#pragma unroll
                    for (int r = 0; r < 16; ++r) {
                        const int key = key0 + crow(r, hi); bool ok;
                        if (MODE == 0) ok = key < nv;
                        else if (MODE == 2) ok = selbit && (kt < (t >> 6) || key <= t);
                        else ok = (key <= t) && (key + 512 > t);
                        p[r] = ok ? p[r] : NEGBIG; mx = fmaxf(mx, p[r]);
                    }
                    mx = fmaxf(mx, __shfl_xor(mx, 32));
                    const float mn = fmaxf(m, mx), alpha = fexp2(m - mn);
                    float ps = 0.f;
#pragma unroll
                    for (int r = 0; r < 16; ++r) { pe[r] = (p[r] > -1e29f) ? fexp2(p[r] - mn) : 0.f; ps += pe[r]; }
                    l = l * alpha + ps; m = mn;
                    if (MODE != 0) {
#pragma unroll
                        for (int r = 0; r < 16; ++r) { o[0][r] *= alpha; o[1][r] *= alpha; }
                    }
                }
                if (MODE != 0) {
                    v4u pw0, pw1;
                    pw0.x = pk2(pe[0], pe[1]); pw0.y = pk2(pe[2], pe[3]); pw0.z = pk2(pe[4], pe[5]); pw0.w = pk2(pe[6], pe[7]);
                    pw1.x = pk2(pe[8], pe[9]); pw1.y = pk2(pe[10], pe[11]); pw1.z = pk2(pe[12], pe[13]); pw1.w = pk2(pe[14], pe[15]);
                    const bf16x8 pf0 = __builtin_bit_cast(bf16x8, pw0), pf1 = __builtin_bit_cast(bf16x8, pw1);
                    const LAS unsigned char* vb = Vb + (32 * kb + 4 * hi + ((F.lane & 15) >> 2)) * 64 + ((F.lane >> 4) & 1) * 32 + (F.lane & 3) * 8;
#pragma unroll
                    for (int dh = 0; dh < 2; ++dh) {
                        const s16x4 a0 = ds_tr16(vb + dh * 4096), a1 = ds_tr16(vb + dh * 4096 + 512), b0 = ds_tr16(vb + dh * 4096 + 1024), b1 = ds_tr16(vb + dh * 4096 + 1024 + 512);
                        const bf16x8 vf0 = {a0[0], a0[1], a0[2], a0[3], a1[0], a1[1], a1[2], a1[3]}, vf1 = {b0[0], b0[1], b0[2], b0[3], b1[0], b1[1], b1[2], b1[3]};
                        o[dh] = __builtin_amdgcn_mfma_f32_32x32x16_bf16(vf0, pf0, o[dh], 0, 0, 0);
                        o[dh] = __builtin_amdgcn_mfma_f32_32x32x16_bf16(vf1, pf1, o[dh], 0, 0, 0);
                    }
                }
            }
        }
        if (has_next) { *(LAS v4u*)(KB + (buf ^ 1) * 8192 + F.tid * 16) = kreg; if (MODE != 0) *(LAS v4u*)(VB + (buf ^ 1) * 8192 + F.tid * 16) = vreg; }
        __syncthreads();
    }
}

__device__ __forceinline__ void nsa_item(Frame& F, int b, int g, int qi) {
    const int r32 = F.lane & 31, hi = F.lane >> 5, tokl = r32 >> 2, hh = r32 & 3;
    const int t0 = qi * 64, tw0 = t0 + 8 * F.wave, t = tw0 + tokl;
    const unsigned char* dob = F.dout_b;
    const size_t img = (size_t)(b * 2 + g) * (1u << 20);
    LAS float* impw = (LAS float*)(F.lds + RING_OFF + NSA_IMP) + F.wave * 1024;
    LAS unsigned* selm = (LAS unsigned*)(F.lds + RING_OFF + NSA_SELM) + F.wave * 32;
#pragma unroll
    for (int i = 0; i < 16; ++i) impw[F.lane + 64 * i] = 0.f;
    bf16x8 qr[4];
    { const bf16* qrow = (const bf16*)(dob + DO_QN) + (((size_t)(b * 2 + g) * SEQ + tw0) * 4 + r32) * 64;
#pragma unroll
      for (int d0 = 0; d0 < 4; ++d0) qr[d0] = *(const bf16x8*)(qrow + 16 * d0 + 8 * hi); }
    const float* gt = (const float*)(F.ws + WS_GATES) + ((size_t)b * SEQ + t) * 24 + (g * 4 + hh) * 3;
    const float g0 = gt[0], g1 = gt[1], g2 = gt[2];
    f32x16 oacc[2], o[2];
#pragma unroll
    for (int r = 0; r < 16; ++r) { oacc[0][r] = 0.f; oacc[1][r] = 0.f; }
    const int nv = (t >= 31) ? ((t - 31) >> 4) + 1 : 0, nvw = (tw0 + 7 >= 31) ? ((tw0 + 7 - 31) >> 4) + 1 : 0;
    const int nct = (4 * qi + 3 + 63) >> 6;
    const unsigned char* Kc = dob + DO_KCMP + (size_t)(b * 2 + g) * 65536; const unsigned char* Vc = dob + DO_VCMP + (size_t)(b * 2 + g) * 65536;
    float m = NEGBIG, l = 0.f;
    nsa_branch<0>(F, Kc, Vc, 0, nct, qr, m, l, o, t, tw0, nv, nvw, 0u, 0u, 0u, 0u, 0u, 0u, 0u, 0u, 0.f, impw);
    { const float lt = l + __shfl_xor(l, 32); const float inv_l = (lt > 0.f) ? 1.0f / lt : 0.f;
#pragma unroll
      for (int r = 0; r < 16; ++r) { o[0][r] = 0.f; o[1][r] = 0.f; }
      nsa_branch<1>(F, Kc, Vc, 0, nct, qr, m, l, o, t, tw0, nv, nvw, 0u, 0u, 0u, 0u, 0u, 0u, 0u, 0u, inv_l, impw);
#pragma unroll
      for (int r = 0; r < 16; ++r) { oacc[0][r] += g0 * o[0][r]; oacc[1][r] += g0 * o[1][r]; } }
    __syncthreads();
#pragma unroll 1
    for (int tl = 0; tl < 8; ++tl) {
        const int tt = tw0 + tl, cur = tt >> 6, j0 = F.lane, j1 = F.lane + 64;
        const float NINF = -3.0e38f;
        float v0 = (j0 <= cur) ? impw[tl * 128 + j0] + ((j0 == 0 || j0 == cur || j0 == cur - 1) ? 1e4f : 0.f) : NINF;
        float v1 = (j1 <= cur) ? impw[tl * 128 + j1] + ((j1 == cur || j1 == cur - 1) ? 1e4f : 0.f) : NINF;
        bool s0 = false, s1 = false;
        if (cur < 16) { s0 = (j0 <= cur); }
        else {
#pragma unroll 1
            for (int round = 0; round < 16; ++round) {
                float bv; int bj;
                if (v0 >= v1) { bv = v0; bj = j0; } else { bv = v1; bj = j1; }
#pragma unroll
                for (int off = 32; off >= 1; off >>= 1) { const float ov = __shfl_xor(bv, off); const int oj = __shfl_xor(bj, off); if (ov > bv || (ov == bv && oj < bj)) { bv = ov; bj = oj; } }
                if (bj == j0) { s0 = true; v0 = NINF; }
                if (bj == j1) { s1 = true; v1 = NINF; }
            }
        }
        const unsigned long long m0 = __ballot(s0), m1 = __ballot(s1);
        if (F.lane == 0) { selm[tl * 4 + 0] = (unsigned)m0; selm[tl * 4 + 1] = (unsigned)(m0 >> 32); selm[tl * 4 + 2] = (unsigned)m1; selm[tl * 4 + 3] = (unsigned)(m1 >> 32); }
    }
    __syncthreads();
    const unsigned mk0 = selm[tokl * 4 + 0], mk1 = selm[tokl * 4 + 1], mk2 = selm[tokl * 4 + 2], mk3 = selm[tokl * 4 + 3];
    unsigned wo0 = 0u, wo1 = 0u, wo2 = 0u, wo3 = 0u;
#pragma unroll
    for (int tl = 0; tl < 8; ++tl) { wo0 |= selm[tl * 4 + 0]; wo1 |= selm[tl * 4 + 1]; wo2 |= selm[tl * 4 + 2]; wo3 |= selm[tl * 4 + 3]; }
    wo0 = __builtin_amdgcn_readfirstlane(wo0); wo1 = __builtin_amdgcn_readfirstlane(wo1); wo2 = __builtin_amdgcn_readfirstlane(wo2); wo3 = __builtin_amdgcn_readfirstlane(wo3);
    { m = NEGBIG; l = 0.f;
#pragma unroll
      for (int r = 0; r < 16; ++r) { o[0][r] = 0.f; o[1][r] = 0.f; }
      nsa_branch<2>(F, dob + DO_KSEL + img, dob + DO_VSEL + img, 0, qi + 1, qr, m, l, o, t, tw0, nv, nvw, mk0, mk1, mk2, mk3, wo0, wo1, wo2, wo3, 0.f, impw);
      const float lt = l + __shfl_xor(l, 32); const float sc = (lt > 0.f) ? g1 / lt : 0.f;
#pragma unroll
      for (int r = 0; r < 16; ++r) { oacc[0][r] += sc * o[0][r]; oacc[1][r] += sc * o[1][r]; } }
    { m = NEGBIG; l = 0.f;
#pragma unroll
      for (int r = 0; r < 16; ++r) { o[0][r] = 0.f; o[1][r] = 0.f; }
      nsa_branch<3>(F, dob + DO_KWIN + img, dob + DO_VWIN + img, (qi >= 8) ? qi - 8 : 0, qi + 1, qr, m, l, o, t, tw0, nv, nvw, 0u, 0u, 0u, 0u, 0u, 0u, 0u, 0u, 0.f, impw);
      const float lt = l + __shfl_xor(l, 32); const float sc = (lt > 0.f) ? g2 / lt : 0.f;
#pragma unroll
      for (int r = 0; r < 16; ++r) { oacc[0][r] += sc * o[0][r]; oacc[1][r] += sc * o[1][r]; } }
    bf16* orow = (bf16*)(F.ws + WS_O + 32 * MiB) + ((size_t)b * SEQ + t) * DM + 512 + (g * 4 + hh) * 64;
#pragma unroll
    for (int dh = 0; dh < 2; ++dh)
#pragma unroll
        for (int rg = 0; rg < 4; ++rg) { v2u w; w.x = pk2(oacc[dh][4 * rg], oacc[dh][4 * rg + 1]); w.y = pk2(oacc[dh][4 * rg + 2], oacc[dh][4 * rg + 3]);
            *(v2u*)(orow + 32 * dh + 8 * rg + 4 * hi) = w; }
    __syncthreads();
}

__device__ __forceinline__ void sgu_item(Frame& F, int item) {
    const int gg = item & 7, ck = (item >> 3) & 63, b = item >> 9;
    const size_t tok0 = (size_t)b * SEQ + ck * 128;
    const bf16* Z = (const bf16*)(F.ws + WS_A);
    LAS bf16* Ws = (LAS bf16*)(F.lds + RING_OFF);
    LAS bf16* VT = (LAS bf16*)(F.lds + RING_OFF + 34816);
    LAS float* rs = (LAS float*)(F.lds + RING_OFF + 34816 + 69632);
    if (F.tid < 128) { const float* st = (const float*)(F.ws + WS_STATS) + (tok0 + F.tid) * 32; float s = 0.f;
#pragma unroll
        for (int k = 0; k < 32; k += 4) { const f32x4 v = *(const f32x4*)(st + k); s += (v.x + v.y) + (v.z + v.w); }
        rs[F.tid] = 1.0f / sqrtf(s * (1.0f / SGW) + NORM_EPS); }
    { const float* wsrc = F.sgu_ws + (size_t)gg * 128 * 128;
#pragma unroll
      for (int k = 0; k < 8; ++k) { const int p = F.tid + 512 * k, tr = p >> 5, sc = (p & 31) * 4; const f32x4 w = *(const f32x4*)(wsrc + tr * 128 + sc);
          v2u o; o.x = pk2((sc <= tr) ? w.x : 0.f, (sc + 1 <= tr) ? w.y : 0.f); o.y = pk2((sc + 2 <= tr) ? w.z : 0.f, (sc + 3 <= tr) ? w.w : 0.f);
          *(LAS v2u*)(Ws + tr * 136 + sc) = o; } }
    __syncthreads();
#pragma unroll 2
    for (int k = 0; k < 8; ++k) {
        const int p = F.tid + 512 * k, s = p & 127, cc = p >> 7;
        float x[8]; unpack8(*(const v4u*)(Z + (tok0 + s) * 4096 + 2048 + gg * 256 + cc * 8), x);
        const float rr = rs[s];
#pragma unroll
        for (int i = 0; i < 8; ++i) VT[(cc * 8 + i) * 136 + s] = (bf16)f2bf(x[i] * rr * F.sgu_ng[gg * 256 + cc * 8 + i]);
    }
    __syncthreads();
    f32x4 acc[16];
#pragma unroll
    for (int nt = 0; nt < 16; ++nt) acc[nt] = (f32x4){0.f, 0.f, 0.f, 0.f};
    const int ksteps = (16 * F.wave + 16 + 31) >> 5;
    const LAS bf16* ap = Ws + (16 * F.wave + (F.lane & 15)) * 136 + (F.lane >> 4) * 8;
    const LAS bf16* bp = VT + (F.lane & 15) * 136 + (F.lane >> 4) * 8;
#pragma unroll 1
    for (int kk = 0; kk < ksteps; ++kk) {
        const bf16x8 a = *(const LAS bf16x8*)(ap + kk * 32);
#pragma unroll
        for (int nt = 0; nt < 16; ++nt) { const bf16x8 bb = *(const LAS bf16x8*)(bp + nt * 16 * 136 + kk * 32); acc[nt] = __builtin_amdgcn_mfma_f32_16x16x32_bf16(a, bb, acc[nt], 0, 0, 0); }
    }
    bf16* UM = (bf16*)(F.ws + WS_O);
#pragma unroll
    for (int i = 0; i < 4; ++i) {
        const int tr = 16 * F.wave + 4 * (F.lane >> 4) + i; const float bs = F.sgu_bs[gg * 128 + tr];
        const bf16* urow = Z + (tok0 + tr) * 4096 + gg * 256; bf16* orow = UM + (tok0 + tr) * SGW + gg * 256;
#pragma unroll
        for (int nt = 0; nt < 16; ++nt) { const int c = nt * 16 + (F.lane & 15); orow[c] = (bf16)f2bf(bf2f(urow[c]) * (acc[nt][i] + bs)); }
    }
    __syncthreads();
}

constexpr int NPHASE = 20;
struct Args { const void* in[26]; float* out; unsigned char* ws; int ph_lo, ph_hi, use_bar, pad; };
__global__ void __launch_bounds__(512, 2) trunk_fwd(Args args) {
    extern __shared__ __attribute__((aligned(16))) unsigned char lds[];
    Frame F;
    F.lds = (LAS unsigned char*)lds;
    F.MISC = (volatile LAS unsigned*)(F.lds + MISC_OFF);
    F.tid = threadIdx.x; F.lane = F.tid & 63; F.wave = __builtin_amdgcn_readfirstlane(F.tid >> 6);
    F.G = gridDim.x; F.bid = blockIdx.x;
    F.ws = args.ws; F.out = args.out; F.dout_b = (unsigned char*)args.out;
    F.ctl = (gu32*)(args.ws + WS_CTL);
    F.x = (const float*)args.in[0]; F.c = (const float*)args.in[1]; F.positions = (const int*)args.in[2]; F.w_ada = (const float*)args.in[3]; F.b_ada = (const float*)args.in[4];
    F.norm_g = (const float*)args.in[5]; F.w_in_ab = (const float*)args.in[6]; F.w_out_ab = (const float*)args.in[7]; F.gla_w2 = (const float*)args.in[8]; F.gla_bg = (const float*)args.in[9];
    F.gla_ng = (const float*)args.in[10]; F.q_gain = (const float*)args.in[11]; F.k_gain = (const float*)args.in[12]; F.cmp_pe = (const float*)args.in[13]; F.cmp_w1 = (const float*)args.in[14];
    F.cmp_w2 = (const float*)args.in[15]; F.w_in_c = (const float*)args.in[16]; F.sgu_ng = (const float*)args.in[17]; F.sgu_ws = (const float*)args.in[18]; F.sgu_bs = (const float*)args.in[19];
    F.w_out_c = (const float*)args.in[20]; F.w_router = (const float*)args.in[21]; F.r_bias = (const float*)args.in[22]; F.w_gate = (const float*)args.in[23]; F.w_up = (const float*)args.in[24];
    F.w_down = (const float*)args.in[25];
    for (int u = F.tid; u < (LDS_BYTES - LDSCTL_OFF) / 4; u += 512) ((LAS unsigned*)(F.lds + LDSCTL_OFF))[u] = 0u;
    __syncthreads();
    XcdBarrier bar; bar.bar = (unsigned*)(F.ctl + CW_BAR); bar.x = 0; bar.st = nullptr;
    if (args.use_bar) bar = xcd_barrier_post((unsigned*)(F.ctl + CW_BAR), F.MISC + 8);
    const int lo = args.ph_lo, hi = args.ph_hi;
#ifndef PH_MASK
#define PH_MASK 0xFFFFFu
#endif
#define IN(k) ((((PH_MASK) >> (k)) & 1u) && lo <= (k) && (k) < hi)
#define SEAM(k) do { if (IN(k) && IN((k) + 1)) xcd_barrier(bar); } while (0)
    float* mod = (float*)(F.ws + WS_MOD);
    bf16* Hb = (bf16*)(F.ws + WS_O);
    bf16* Ab = (bf16*)(F.ws + WS_A);

    if (IN(0)) { p0_prologue(F); } SEAM(0);
    if (IN(1)) { row_pass<false, true, false>(F, F.x, mod, 0, F.norm_g, mod, 0); } SEAM(1);
    if (IN(2)) { pg8::Gemm g{Hb, (const bf16*)(F.ws + WS_WIN), NTOK, NPROJ, DM}; pg8::StaticOrder S; S.init(NTOK, NPROJ, F.G, F.bid);
        pg8::EpiBf16<0> E{Ab, NPROJ, nullptr, 0, 0, 1.f};
        pg8::gemm_phase<pg8::EpiBf16<0>, pg8::StaticOrder, true, true>(F.lds + RING_OFF, g, S, E); } SEAM(2);
    if (IN(3)) {
        for (int it = F.bid; it < 1024; it += F.G) gla_prep_item(F, it);
        for (int tok = F.bid * 8 + F.wave; tok < NTOK; tok += F.G * 8) nsa_prep_token(F, tok);
    } SEAM(3);
    if (IN(4)) {
        const int half = F.G >> 1;
        if (F.bid < half) { for (int it = F.bid; it < 128; it += half) nsa_compress_item(F, it); }
        else { for (int gi = (F.bid - half) * 512 + F.tid; gi < 65536; gi += (F.G - half) * 512) gla_scan(F, gi); }
    } SEAM(4);
    if (IN(5)) {
#ifndef NO_NSA
        for (int p = F.bid; p < 256; p += F.G) { const int bg = p >> 6, i = p & 63; nsa_item(F, bg >> 1, bg & 1, i); nsa_item(F, bg >> 1, bg & 1, 127 - i); }
#endif
#ifndef NO_GLAOUT
        for (int it = F.bid; it < 1024; it += F.G) gla_out_item(F, it);
#endif
    } SEAM(5);
    if (IN(6)) { pg8::Gemm g{(const bf16*)(F.ws + WS_O + 32 * MiB), (const bf16*)(F.ws + WS_WOUT), NTOK, DM, DM}; pg8::StaticOrder S; S.init(NTOK, DM, F.G, F.bid);
        EpiResid E{F.x, F.out, mod + 2 * 1024};
        pg8::gemm_phase<EpiResid, pg8::StaticOrder, true, true>(F.lds + RING_OFF, g, S, E); } SEAM(6);
#define MOE_BLOCK(P, LAYER) \
    if (IN(P)) { row_pass<false, true, true>(F, F.out, mod + (LAYER) * 2 * 6144, 3 * 1024, F.norm_g + ((LAYER) * 2 + 1) * 1024, mod, (LAYER)); } SEAM(P); \
    if (IN((P) + 1)) { moe_gather(F, (LAYER)); } SEAM((P) + 1); \
    if (IN((P) + 2)) { moe_tables(F, (LAYER)); MoeOrder S{(const LAS int*)(F.lds + TAB_OFF), F.G, F.bid}; \
        pg8::Gemm g{Ab, (const bf16*)(F.ws + WS_WGU) + (size_t)(LAYER) * 16 * 1024 * 1024, MOE_ROWS, 1024, DM}; EpiMoeGU E{(bf16*)(F.ws + WS_A + A_HID_OFF)}; \
        pg8::gemm_phase<EpiMoeGU, MoeOrder, true, true>(F.lds + RING_OFF, g, S, E); } SEAM((P) + 2); \
    if (IN((P) + 3)) { moe_tables(F, (LAYER)); MoeOrder S{(const LAS int*)(F.lds + TAB_OFF), F.G, F.bid}; \
        pg8::Gemm g{(const bf16*)(F.ws + WS_A + A_HID_OFF), (const bf16*)(F.ws + WS_WDN) + (size_t)(LAYER) * 16 * 1024 * 512, MOE_ROWS, 1024, EHID}; EpiMoeDn E{Ab}; \
        pg8::gemm_phase<EpiMoeDn, MoeOrder, true, true>(F.lds + RING_OFF, g, S, E); } SEAM((P) + 3);
    MOE_BLOCK(7, 0)
    if (IN(11)) { row_pass<true, true, false>(F, F.out, mod + 2 * 6144, 0, F.norm_g + 2 * 1024, mod, 1); } SEAM(11);
    if (IN(12)) { pg8::Gemm g{Hb, (const bf16*)(F.ws + WS_WINC), NTOK, 4096, DM}; pg8::StaticOrder S; S.init(NTOK, 4096, F.G, F.bid);
        EpiGeluStats E{Ab, (float*)(F.ws + WS_STATS)};
        pg8::gemm_phase<EpiGeluStats, pg8::StaticOrder, true, true>(F.lds + RING_OFF, g, S, E); } SEAM(12);
    if (IN(13)) { for (int it = F.bid; it < 1024; it += F.G) sgu_item(F, it); } SEAM(13);
    if (IN(14)) { pg8::Gemm g{Hb, (const bf16*)(F.ws + WS_WOUTC), NTOK, DM, SGW}; pg8::StaticOrder S; S.init(NTOK, DM, F.G, F.bid);
        EpiResid E{F.out, F.out, mod + 2 * 6144 + 2 * 1024};
        pg8::gemm_phase<EpiResid, pg8::StaticOrder, true, true>(F.lds + RING_OFF, g, S, E); } SEAM(14);
    MOE_BLOCK(15, 1)
    if (IN(19)) { row_pass<true, false, false>(F, F.out, mod, 0, F.norm_g, mod + 2 * 6144, 1); }
#undef IN
#undef SEAM
#undef MOE_BLOCK
}

#ifndef MK_N_LAUNCHES
#define MK_N_LAUNCHES 20
#endif
extern "C" void kernel_launch(void* const* d_in, const int* in_sizes, int n_in, void* d_out, int out_size, void* d_ws, size_t ws_size, hipStream_t stream) {
    static int grid = 0;
    if (grid == 0) {
        if (n_in != 26 || out_size != NTOK * DM || ws_size < WS_END) { fprintf(stderr, "kernel_launch: unexpected problem shape / workspace (%d inputs, out %d, ws %zu)\n", n_in, out_size, ws_size); grid = -1; return; }
        int dev = 0, cus = 0, per_cu = 0;
        if (hipGetDevice(&dev) != hipSuccess || hipDeviceGetAttribute(&cus, hipDeviceAttributeMultiprocessorCount, dev) != hipSuccess) { grid = -1; return; }
        if (hipFuncSetAttribute((const void*)trunk_fwd, hipFuncAttributeMaxDynamicSharedMemorySize, LDS_BYTES) != hipSuccess) { fprintf(stderr, "kernel_launch: hipFuncSetAttribute failed\n"); grid = -1; return; }
        if (hipOccupancyMaxActiveBlocksPerMultiprocessor(&per_cu, (const void*)trunk_fwd, 512, LDS_BYTES) != hipSuccess || per_cu < 1) { fprintf(stderr, "kernel_launch: occupancy query says %d blocks per CU\n", per_cu); }
        (void)hipGetLastError();
        grid = cus;
        if (grid != 256) { fprintf(stderr, "kernel_launch: built for a 256-CU device, found %d CUs\n", cus); grid = -1; return; }
    }
    if (grid < 0) return;
    (void)hipMemsetAsync((char*)d_ws + WS_CTL, 0, CTL_ZERO_BYTES, stream);
    Args a{};
    for (int i = 0; i < 26; ++i) a.in[i] = d_in[i];
    a.out = (float*)d_out; a.ws = (unsigned char*)d_ws; a.pad = 0;
    if (MK_N_LAUNCHES == 1) {
        a.ph_lo = 0; a.ph_hi = NPHASE; a.use_bar = 1;
        hipLaunchKernelGGL(trunk_fwd, dim3(grid), dim3(512), LDS_BYTES, stream, a);
    } else {
        for (int p = 0; p < NPHASE; ++p) { a.ph_lo = p; a.ph_hi = p + 1; a.use_bar = 0; hipLaunchKernelGGL(trunk_fwd, dim3(grid), dim3(512), LDS_BYTES, stream, a); }
    }
}
```

```cpp
#include <hip/hip_runtime.h>
#include <cstdio>
#include <cstdint>
namespace pg8 {
#define PG8_LAS __attribute__((address_space(3)))
typedef unsigned short bf16_t;
typedef short bf16x8 __attribute__((ext_vector_type(8)));
typedef float f32x4 __attribute__((ext_vector_type(4)));
typedef unsigned u32x4 __attribute__((ext_vector_type(4)));
constexpr int BM = 256, BK = 64, HALF = 128, HTB = HALF * BK * 2  , STAGE_BYTES = 8 * HTB, NXCD = 8, WGM = 8;

__host__ __device__ __forceinline__ int lds_byte(int r, int c) { const int st = (r >> 4) * 2 + (c >> 5), rr = r & 15, cc = c & 31, ob = rr * 64 + cc * 2; return st * 1024 + (ob ^ (((ob >> 9) & 1) << 5)); }
__host__ __device__ __forceinline__ void stage_rc(int b, int& R, int& C) { const int st = b / 1024, sb = b % 1024, swz = sb ^ (((sb >> 9) & 1) << 5); R = (st >> 1) * 16 + swz / 64; C = (st & 1) * 32 + (swz % 64) / 2; }
__host__ __device__ __forceinline__ int perm32(int rho) { const int n = rho >> 4, i = rho & 15; return 8 * (i >> 2) + 4 * n + (i & 3); }

struct Unit { int pm, pn; };
struct Gemm { const bf16_t* A; const bf16_t* Bt; int M, N, K; };

struct StaticOrder {
    int nM, nN, nwg, G, c;
    __host__ __device__ void init(int M, int N, int G_, int c_) { nM = M / BM; nN = N / BM; nwg = nM * nN; G = G_; c = c_; }
    __host__ __device__ bool next(int i, Unit& u) const {
        const long L = (long)i * G + c; if (L >= nwg) return false;
        int wgid = (int)L; { const int q = nwg / NXCD, r = nwg % NXCD, xcd = wgid % NXCD, off = wgid / NXCD; wgid = (xcd < r ? xcd * (q + 1) : r * (q + 1) + (xcd - r) * q) + off; }
        const int nig = WGM * nN, gid = wgid / nig, fm = gid * WGM, gsz = (nM - fm) < WGM ? (nM - fm) : WGM;
        u.pm = fm + ((wgid % nig) % gsz); u.pn = (wgid % nig) / gsz; return true;
    }
    __device__ __forceinline__ void a_ready(const Unit&) const {}
    __device__ __forceinline__ void done(const Unit&) const {}
};

__device__ __forceinline__ unsigned cvt_pk_bf16(float lo, float hi) { unsigned r; asm volatile("v_cvt_pk_bf16_f32 %0, %1, %2" : "=v"(r) : "v"(lo), "v"(hi)); return r; }
typedef float f32x2 __attribute__((ext_vector_type(2)));
__device__ __forceinline__ f32x2 gelu_pk(f32x2 v) {
    const f32x2 av = __builtin_elementwise_abs(v), d = av * 0.2316418882f + 1.0f;
    f32x2 t; t.x = __builtin_amdgcn_rcpf(d.x); t.y = __builtin_amdgcn_rcpf(d.y);
    f32x2 q = t * 0.5307027145f + (-0.7265760135f); q = q * t + 0.7107068705f; q = q * t + (-0.142248368f); q = q * t + 0.127414796f; q = q * t;
    const f32x2 s = (v * v) * (-0.72134752044f);
    f32x2 e; e.x = __builtin_amdgcn_exp2f(s.x); e.y = __builtin_amdgcn_exp2f(s.y);
    const f32x2 m = v * (q * e), r = v - m;
    f32x2 o; o.x = v.x < 0.f ? m.x : r.x; o.y = v.y < 0.f ? m.y : r.y; return o;
}

template <int ACT  > struct EpiBf16 {
    static constexpr bool PERM = true, AFTER_DRAIN = false; static_assert(ACT == 0 || ACT == 1, "EpiBf16: ACT is 0 (none) or 1 (gelu_pk)");
    bf16_t* O; int ldc; const float* bias; int split_cols; size_t split_stride; float scale0;
    __device__ __forceinline__ void operator()(const f32x4 (&acc)[2][2][4][2], const Unit& u, int wr, int wc, int fr, int fq) const {
        const int row0 = u.pm * BM + wr * 64 + fr; int colt = u.pn * BM; bf16_t* base = O;
        float sc = 1.f; if (split_cols) { const int t = colt / split_cols; base += (size_t)t * split_stride; colt -= t * split_cols; if (t == 0) sc = scale0; }
        const int col0 = colt + wc * 32 + 8 * fq, bcol0 = u.pn * BM + wc * 32 + 8 * fq;
        f32x4 bv[2][2];
#pragma unroll
        for (int bj = 0; bj < 2; ++bj)
#pragma unroll
            for (int n = 0; n < 2; ++n) bv[bj][n] = bias ? *(const f32x4*)(bias + bcol0 + bj * HALF + 4 * n) : (f32x4){0.f, 0.f, 0.f, 0.f};
#pragma unroll
        for (int ai = 0; ai < 2; ++ai)
#pragma unroll
            for (int m = 0; m < 4; ++m) { bf16_t* rowp = base + (size_t)(row0 + ai * HALF + m * 16) * ldc + col0;
#pragma unroll
                for (int bj = 0; bj < 2; ++bj) { f32x4 v0 = acc[ai][bj][m][0] + bv[bj][0], v1 = acc[ai][bj][m][1] + bv[bj][1];
                    if (ACT == 1) { f32x2 a = gelu_pk((f32x2){v0[0], v0[1]}), b = gelu_pk((f32x2){v0[2], v0[3]}), c = gelu_pk((f32x2){v1[0], v1[1]}), d = gelu_pk((f32x2){v1[2], v1[3]});
                        v0 = (f32x4){a.x, a.y, b.x, b.y}; v1 = (f32x4){c.x, c.y, d.x, d.y}; }
                    v0 = v0 * sc; v1 = v1 * sc; u32x4 w; w.x = cvt_pk_bf16(v0[0], v0[1]); w.y = cvt_pk_bf16(v0[2], v0[3]); w.z = cvt_pk_bf16(v1[0], v1[1]); w.w = cvt_pk_bf16(v1[2], v1[3]);
                    *(u32x4*)(rowp + bj * HALF) = w; } }
    }
};

template <class Epi, class Sched, bool ALIGN_EPI = false, bool SP2 = false>
__device__ __forceinline__ void gemm_phase(PG8_LAS unsigned char* lds, const Gemm g, const Sched& S, const Epi& E) {
    const int tid = threadIdx.x, wid = __builtin_amdgcn_readfirstlane(tid >> 6), lane = tid & 63, wr = wid >> 2, wc = wid & 3, fr = lane & 15, fq = lane >> 4;
    const int K = g.K, nt = K / BK;
    unsigned voffA[2], voffB[2];
#pragma unroll
    for (int i = 0; i < 2; ++i) { int R, C; stage_rc(tid * 16 + i * 8192, R, C); const int Rb = Epi::PERM ? ((R & ~31) + perm32(R & 31)) : R;
        voffA[i] = (unsigned)(R * K + C) * 2u; voffB[i] = (unsigned)(Rb * K + C) * 2u; }
    const size_t kstep = (size_t)(BK * 2);
    const size_t hstep = (size_t)HALF * K * 2;
    const size_t tstep = 2 * hstep;
    const unsigned ldsw = (unsigned)wid * 1024u;
    const int aoff = lds_byte(wr * 64 + fr, fq * 8), boff = lds_byte(wc * 32 + fr, fq * 8);
#define PG8_SA(b, h) (((b) * 2 + (h)) * HTB)
#define PG8_SB(b, h) ((4 + (b) * 2 + (h)) * HTB)
#define PG8_STAGE(bufoff, gbase, voff) do { _Pragma("unroll") for (int _i = 0; _i < 2; ++_i) \
        __builtin_amdgcn_global_load_lds((const unsigned*)((const char*)(gbase) + (voff)[_i]), (PG8_LAS unsigned*)(lds + (bufoff) + ldsw + _i * 8192), 16, 0, 0); } while (0)
#define PG8_LDA(dst, b, h) do { _Pragma("unroll") for (int m = 0; m < 4; ++m) _Pragma("unroll") for (int k = 0; k < 2; ++k) dst[m][k] = *(const PG8_LAS bf16x8*)(lds + PG8_SA(b, h) + aoff + m * 2048 + k * 1024); } while (0)
#define PG8_LDB(dst, b, h) do { _Pragma("unroll") for (int n = 0; n < 2; ++n) _Pragma("unroll") for (int k = 0; k < 2; ++k) dst[n][k] = *(const PG8_LAS bf16x8*)(lds + PG8_SB(b, h) + boff + n * 2048 + k * 1024); } while (0)
#define PG8_MMA(ai, bj, At, Bt) do { __builtin_amdgcn_s_setprio(1); _Pragma("unroll") for (int m = 0; m < 4; ++m) _Pragma("unroll") for (int n = 0; n < 2; ++n) _Pragma("unroll") for (int k = 0; k < 2; ++k) \
        acc[ai][bj][m][n] = __builtin_amdgcn_mfma_f32_16x16x32_bf16(Bt[n][k], At[m][k], acc[ai][bj][m][n], 0, 0, 0); __builtin_amdgcn_s_setprio(0); } while (0)
#define PG8_WAIT_V(n) asm volatile("s_waitcnt vmcnt(" #n ")" ::: "memory")
#define PG8_WAIT_L(n) asm volatile("s_waitcnt lgkmcnt(" #n ")" ::: "memory")
#define PG8_BAR __builtin_amdgcn_s_barrier()
#define PG8_SCHED __builtin_amdgcn_sched_barrier(0)
    Unit cur, nxt; int ui = 0;
    if (!S.next(0, cur)) return;
    f32x4 acc[2][2][4][2];
#pragma unroll
    for (int a = 0; a < 2; ++a)
#pragma unroll
        for (int b = 0; b < 2; ++b)
#pragma unroll
            for (int m = 0; m < 4; ++m)
#pragma unroll
                for (int n = 0; n < 2; ++n) acc[a][b][m][n] = (f32x4){0.f, 0.f, 0.f, 0.f};
    bf16x8 At[4][2], B0[2][2], B1[2][2];
    const char* cA = (const char*)g.A + (size_t)cur.pm * tstep; const char* cB = (const char*)g.Bt + (size_t)cur.pn * tstep;
    S.a_ready(cur);
    if constexpr (SP2) {
        PG8_STAGE(PG8_SB(0, 0), cB, voffB); PG8_STAGE(PG8_SB(0, 1), cB + hstep, voffB); PG8_STAGE(PG8_SA(0, 0), cA, voffA); PG8_STAGE(PG8_SA(0, 1), cA + hstep, voffA);
        if (wr == 1) PG8_BAR;
        PG8_WAIT_V(2); PG8_BAR;
        PG8_STAGE(PG8_SB(1, 0), cB + kstep, voffB); PG8_STAGE(PG8_SA(1, 0), cA + kstep, voffA); PG8_STAGE(PG8_SB(1, 1), cB + hstep + kstep, voffB);
        PG8_WAIT_V(6); PG8_BAR;
    } else {
        PG8_STAGE(PG8_SB(0, 0), cB, voffB); PG8_STAGE(PG8_SA(0, 0), cA, voffA); PG8_STAGE(PG8_SB(0, 1), cB + hstep, voffB); PG8_STAGE(PG8_SA(0, 1), cA + hstep, voffA);
        if (wr == 1) PG8_BAR;
        PG8_WAIT_V(4); PG8_BAR;
        PG8_STAGE(PG8_SB(1, 0), cB + kstep, voffB); PG8_STAGE(PG8_SA(1, 0), cA + kstep, voffA); PG8_STAGE(PG8_SB(1, 1), cB + hstep + kstep, voffB);
        PG8_WAIT_V(6); PG8_BAR;
    }
    for (;;) {
        const bool has_next = S.next(ui + 1, nxt);
        const char* nA = has_next ? (const char*)g.A + (size_t)nxt.pm * tstep : cA; const char* nB = has_next ? (const char*)g.Bt + (size_t)nxt.pn * tstep : cB;
        for (int t = 0; t < nt; t += 2) {
            const bool last = (t == nt - 2);
            const char* a1 = cA + (size_t)(t + 1) * kstep;
            const char* a2 = last ? nA : cA + (size_t)(t + 2) * kstep; const char* b2 = last ? nB : cB + (size_t)(t + 2) * kstep;
            const char* a3 = a2 + kstep; const char* b3 = b2 + kstep;
            if (last && has_next) S.a_ready(nxt);
            if constexpr (SP2) {
            PG8_LDB(B0, 0, 0); PG8_LDB(B1, 0, 1); PG8_SCHED; PG8_LDA(At, 0, 0); PG8_STAGE(PG8_SA(1, 1), a1 + hstep, voffA);
            PG8_WAIT_V(8); PG8_WAIT_L(0); PG8_BAR; PG8_MMA(0, 0, At, B0); PG8_MMA(0, 1, At, B1); PG8_BAR; PG8_SCHED;
            PG8_LDA(At, 0, 1); PG8_STAGE(PG8_SB(0, 0), b2, voffB); PG8_STAGE(PG8_SB(0, 1), b2 + hstep, voffB); PG8_STAGE(PG8_SA(0, 0), a2, voffA);
            PG8_WAIT_V(8); PG8_WAIT_L(0); PG8_BAR; PG8_MMA(1, 0, At, B0); PG8_MMA(1, 1, At, B1); PG8_BAR; PG8_SCHED;
            PG8_LDB(B0, 1, 0); PG8_LDB(B1, 1, 1); PG8_SCHED; PG8_LDA(At, 1, 0); PG8_STAGE(PG8_SA(0, 1), a2 + hstep, voffA);
            PG8_WAIT_V(8); PG8_WAIT_L(0); PG8_BAR; PG8_MMA(0, 0, At, B0); PG8_MMA(0, 1, At, B1); PG8_BAR; PG8_SCHED;
            PG8_LDA(At, 1, 1); PG8_STAGE(PG8_SB(1, 0), b3, voffB); PG8_STAGE(PG8_SB(1, 1), b3 + hstep, voffB); PG8_STAGE(PG8_SA(1, 0), a3, voffA);
            PG8_WAIT_V(8); PG8_WAIT_L(0); PG8_BAR; PG8_MMA(1, 0, At, B0); PG8_MMA(1, 1, At, B1); PG8_BAR; PG8_SCHED;
            } else {
            PG8_LDB(B0, 0, 0); PG8_SCHED; PG8_LDA(At, 0, 0); PG8_STAGE(PG8_SA(1, 1), a1 + hstep, voffA);
            PG8_WAIT_L(8); PG8_BAR; PG8_WAIT_L(0); PG8_MMA(0, 0, At, B0); PG8_BAR; PG8_SCHED;
            PG8_LDB(B1, 0, 1); PG8_STAGE(PG8_SB(0, 0), b2, voffB);
            PG8_BAR; PG8_WAIT_L(0); PG8_MMA(0, 1, At, B1); PG8_BAR;
            PG8_LDA(At, 0, 1); PG8_STAGE(PG8_SA(0, 0), a2, voffA);
            PG8_BAR; PG8_WAIT_L(0); PG8_MMA(1, 0, At, B0); PG8_BAR; PG8_SCHED;
            PG8_STAGE(PG8_SB(0, 1), b2 + hstep, voffB);
            PG8_WAIT_V(6); PG8_BAR; PG8_MMA(1, 1, At, B1); PG8_BAR;
            PG8_LDB(B0, 1, 0); PG8_SCHED; PG8_LDA(At, 1, 0); PG8_STAGE(PG8_SA(0, 1), a2 + hstep, voffA);
            PG8_WAIT_L(8); PG8_BAR; PG8_WAIT_L(0); PG8_MMA(0, 0, At, B0); PG8_BAR; PG8_SCHED;
            PG8_LDB(B1, 1, 1); PG8_STAGE(PG8_SB(1, 0), b3, voffB);
            PG8_BAR; PG8_WAIT_L(0); PG8_MMA(0, 1, At, B1); PG8_BAR;
            PG8_LDA(At, 1, 1); PG8_STAGE(PG8_SA(1, 0), a3, voffA);
            PG8_BAR; PG8_WAIT_L(0); PG8_MMA(1, 0, At, B0); PG8_BAR; PG8_SCHED;
            PG8_STAGE(PG8_SB(1, 1), b3 + hstep, voffB);
            PG8_WAIT_V(6); PG8_BAR; PG8_MMA(1, 1, At, B1); PG8_BAR;
            }
        }
        if constexpr (ALIGN_EPI) { if (wr == 0) PG8_BAR; }
        if constexpr (!Epi::AFTER_DRAIN) { E(acc, cur, wr, wc, fr, fq); S.done(cur); }
        if (!has_next) break;
#pragma unroll
        for (int a = 0; a < 2; ++a)
#pragma unroll
            for (int b = 0; b < 2; ++b)
#pragma unroll
                for (int m = 0; m < 4; ++m)
#pragma unroll
                    for (int n = 0; n < 2; ++n) acc[a][b][m][n] = (f32x4){0.f, 0.f, 0.f, 0.f};
        cur = nxt; cA = nA; cB = nB; ++ui;
        if constexpr (ALIGN_EPI) { if (wr == 1) PG8_BAR; }
    }
    PG8_WAIT_V(0);
    if constexpr (!ALIGN_EPI) { if (wr == 0) PG8_BAR; }
    PG8_BAR;
    if constexpr (Epi::AFTER_DRAIN) { E.fused(acc, cur, wr, wc, fr, fq, lds, wid, lane); S.done(cur); }
#undef PG8_SA
#undef PG8_SB
#undef PG8_STAGE
#undef PG8_LDA
#undef PG8_LDB
#undef PG8_MMA
#undef PG8_WAIT_V
#undef PG8_WAIT_L
#undef PG8_BAR
#undef PG8_SCHED
}
}

#ifndef PG8_SP2
#define PG8_SP2 true
#endif

constexpr int NB = 2, SEQ = 8192, DM = 1024, NTOK = NB * SEQ;
constexpr int NPROJ = 3072;
constexpr int C_GQ = 0, C_GK = 256, C_GV = 512, C_GR = 1024, C_NQ = 1536, C_KC = 2048, C_VC = 2176, C_KS = 2304, C_VS = 2432, C_KW = 2560, C_VW = 2688, C_GLR = 2816, C_NG = 2832, C_END = 2856;
constexpr int SGW = 2048;
constexpr int NEXP = 16, EHID = 512;
constexpr int MOE_ROWS = 36864;
constexpr float NORM_EPS = 1e-6f;
constexpr float NEGBIG = -1e30f;

constexpr size_t MiB = 1u << 20;
constexpr size_t WS_CTL = 0, CTL_ZERO_BYTES = 1 * MiB;
constexpr size_t WS_MOD = 1 * MiB;
constexpr size_t WS_ROUTE = 2 * MiB;
constexpr size_t WS_GATES = 3 * MiB;
constexpr size_t WS_STATS = 5 * MiB;
constexpr size_t WS_DEC = 7 * MiB;
constexpr size_t WS_WIN = 8 * MiB;
constexpr size_t WS_WOUT = 14 * MiB;
constexpr size_t WS_WINC = 16 * MiB;
constexpr size_t WS_WOUTC = 24 * MiB;
constexpr size_t WS_WCW1 = 28 * MiB;
constexpr size_t WS_WGU = 30 * MiB;
constexpr size_t WS_WDN = 94 * MiB;
constexpr size_t WS_A = 126 * MiB;
constexpr size_t WS_O = 254 * MiB;
constexpr size_t WS_END = 318 * MiB;
constexpr size_t A_HID_OFF = 72 * MiB;
constexpr size_t DO_QN = 0;
constexpr size_t DO_KSEL = 16 * MiB, DO_VSEL = 20 * MiB, DO_KWIN = 24 * MiB, DO_VWIN = 28 * MiB;
constexpr size_t DO_KC = 32 * MiB, DO_VC = 36 * MiB + 65536;
constexpr size_t DO_KCMP = 41 * MiB, DO_VCMP = 41 * MiB + 512 * 1024;

constexpr int CW_TMO = 0, CW_CODE = 1;
constexpr int CW_BAR = 4096;
constexpr int CW_CNT = 8192;

constexpr int RING_OFF = 0, RING_BYTES = 131072;
constexpr int LDSCTL_OFF = RING_BYTES, MISC_OFF = LDSCTL_OFF + 320;
constexpr int TAB_OFF = LDSCTL_OFF + 1024;
constexpr int LDS_BYTES = 147456;

#define GAS __attribute__((address_space(1)))
#define LAS __attribute__((address_space(3)))
typedef unsigned short bf16;
typedef unsigned v4u __attribute__((ext_vector_type(4)));
typedef unsigned v2u __attribute__((ext_vector_type(2)));
typedef float f32x4 __attribute__((ext_vector_type(4)));
typedef float f32x2 __attribute__((ext_vector_type(2)));
typedef float f32x16 __attribute__((ext_vector_type(16)));
typedef short bf16x8 __attribute__((ext_vector_type(8)));
typedef short s16x4 __attribute__((ext_vector_type(4)));
typedef GAS unsigned gu32;
#define RLX_AGENT __ATOMIC_RELAXED, __HIP_MEMORY_SCOPE_AGENT
#define LDS_WAIT() asm volatile("s_waitcnt lgkmcnt(0)" ::: "memory")
#define VM_WAIT() asm volatile("s_waitcnt vmcnt(0)" ::: "memory")
__device__ __forceinline__ unsigned f2bf(float f) { unsigned u = __builtin_bit_cast(unsigned, f); return (u + 0x7fffu + ((u >> 16) & 1u)) >> 16; }
__device__ __forceinline__ unsigned pk2(float lo, float hi) { return f2bf(lo) | (f2bf(hi) << 16); }
__device__ __forceinline__ float bf2f(unsigned short b) { return __builtin_bit_cast(float, (unsigned)b << 16); }
__device__ __forceinline__ float bflo(unsigned w) { return __builtin_bit_cast(float, w << 16); }
__device__ __forceinline__ float bfhi(unsigned w) { return __builtin_bit_cast(float, w & 0xffff0000u); }
__device__ __forceinline__ float fexp2(float x) { return __builtin_amdgcn_exp2f(x); }
__device__ __forceinline__ float fexp(float x) { return __builtin_amdgcn_exp2f(x * 1.4426950408889634f); }
__device__ __forceinline__ float frcp(float x) { return __builtin_amdgcn_rcpf(x); }
__device__ __forceinline__ float sigmoidf_(float x) { return 1.0f / (1.0f + __expf(-x)); }
__device__ __forceinline__ float siluf_(float x) { return x / (1.0f + __expf(-x)); }
__device__ __forceinline__ float gelu_tanh(float x) {
    const float u = 0.7978845608028654f * (x + 0.044715f * x * x * x);
    return x / (1.0f + __expf(-2.0f * u));
}
__device__ __forceinline__ float wave_sum(float v) {
#pragma unroll
    for (int o = 1; o < 64; o <<= 1) v += __shfl_xor(v, o);
    return v;
}
__device__ __forceinline__ void unpack8(const v4u w, float (&f)[8]) {
    f[0] = bflo(w.x); f[1] = bfhi(w.x); f[2] = bflo(w.y); f[3] = bfhi(w.y); f[4] = bflo(w.z); f[5] = bfhi(w.z); f[6] = bflo(w.w); f[7] = bfhi(w.w);
}
__device__ __forceinline__ v4u pack8(const float (&f)[8]) { v4u w; w.x = pk2(f[0], f[1]); w.y = pk2(f[2], f[3]); w.z = pk2(f[4], f[5]); w.w = pk2(f[6], f[7]); return w; }

#define XB_TMO      128
#define XB_XCNT(j)  (256  + 64 * (j))
#define XB_XSUB(j)  (1280 + 64 * (j))
#define XB_XGEN(j)  (2304 + 64 * (j))
#define XB_TOP      3328
#define XB_TOPGEN   3392
#define XCD_BAR_WORDS 3456
#define XB_SPIN_CAP (1u << 18)

__device__ __forceinline__ unsigned xb_ld(unsigned* p)              { return __hip_atomic_load(p, __ATOMIC_RELAXED, __HIP_MEMORY_SCOPE_AGENT); }
__device__ __forceinline__ unsigned xb_add(unsigned* p, unsigned v) { return __hip_atomic_fetch_add(p, v, __ATOMIC_RELAXED, __HIP_MEMORY_SCOPE_AGENT); }
__device__ __forceinline__ unsigned xb_xcc_id() { return (unsigned)__builtin_amdgcn_s_getreg((3 << 11) | 20) & 0xFu; }
#define XB_SPIN(cond, bar) do { unsigned _sp = 0; while (cond) { __builtin_amdgcn_s_sleep(1); \
    if ((++_sp & 255u) == 0u) { if (xb_ld(&(bar)[XB_TMO])) break; if (_sp > XB_SPIN_CAP) { atomicAdd(&(bar)[XB_TMO], 1u); break; } } } } while (0)

struct XcdBarrier {
    unsigned* bar; unsigned x;
    volatile LAS unsigned* st;
};
__device__ __forceinline__ XcdBarrier xcd_barrier_post(unsigned* bar, volatile LAS unsigned* st) {
    XcdBarrier b; b.bar = bar; b.x = xb_xcc_id(); b.st = st;
    if (threadIdx.x == 0) (void)xb_add(&bar[XB_XCNT(b.x)], 1u);
    return b;
}
__device__ __forceinline__ void xcd_barrier_complete(unsigned* bar, unsigned x, unsigned& nloc, unsigned& nx) {
    const unsigned G = gridDim.x * gridDim.y * gridDim.z;
    unsigned sum, cnt, mine, sp = 0u;
    for (;;) {
        sum = 0u; cnt = 0u; mine = 0u;
#pragma unroll
        for (unsigned j = 0; j < 16; ++j) { const unsigned c = xb_ld(&bar[XB_XCNT(j)]); sum += c; cnt += (c > 0u) ? 1u : 0u; mine = (j == x) ? c : mine; }
        if (sum == G) break;
        __builtin_amdgcn_s_sleep(1);
        if ((++sp & 255u) == 0u) { if (xb_ld(&bar[XB_TMO])) break; if (sp > XB_SPIN_CAP) { atomicAdd(&bar[XB_TMO], 1u); break; } }
    }
    nloc = mine > 0u ? mine : 1u; nx = cnt > 0u ? cnt : 1u;
}
__device__ __forceinline__ void xcd_barrier(const XcdBarrier& b) {
    asm volatile("s_waitcnt vmcnt(0)" ::: "memory");
    __syncthreads();
    if (threadIdx.x == 0) {
        unsigned* bar = b.bar;
        __builtin_amdgcn_s_waitcnt(0);
        unsigned nloc = b.st[0], nx = b.st[1];
        if (nloc == 0u) { xcd_barrier_complete(bar, b.x, nloc, nx); b.st[0] = nloc; b.st[1] = nx; }
        const unsigned old = xb_add(&bar[XB_XSUB(b.x)], 1u);
        const unsigned gen = old / nloc;
        if (old + 1u == (gen + 1u) * nloc) {
            __builtin_amdgcn_fence(__ATOMIC_RELEASE, "agent");
            asm volatile("s_waitcnt vmcnt(0)" ::: "memory");
            const unsigned og = xb_add(&bar[XB_TOP], 1u);
            const unsigned tg = og / nx;
            if (og + 1u == (tg + 1u) * nx) xb_add(&bar[XB_TOPGEN], 1u);
            else XB_SPIN(xb_ld(&bar[XB_TOPGEN]) == tg, bar);
            __builtin_amdgcn_fence(__ATOMIC_ACQUIRE, "agent");
            xb_add(&bar[XB_XGEN(b.x)], 1u);
            asm volatile("s_waitcnt vmcnt(0)" ::: "memory");
        } else {
            XB_SPIN(xb_ld(&bar[XB_XGEN(b.x)]) == gen, bar);
            __builtin_amdgcn_fence(__ATOMIC_ACQUIRE, "agent");
            asm volatile("s_waitcnt vmcnt(0)" ::: "memory");
        }
    }
    __syncthreads();
}

struct Frame {
    LAS unsigned char* lds;
    volatile LAS unsigned* MISC;
    gu32* ctl;
    int tid, lane, wave;
    int bid, G;
    unsigned char* ws;
    unsigned char* dout_b;
    float* out;
    const float *x, *c, *w_ada, *b_ada, *norm_g, *w_in_ab, *w_out_ab, *gla_w2, *gla_bg, *gla_ng, *q_gain, *k_gain, *cmp_pe, *cmp_w1, *cmp_w2, *w_in_c, *sgu_ng, *sgu_ws, *sgu_bs, *w_out_c, *w_router, *r_bias, *w_gate, *w_up, *w_down;
    const int* positions;
};

struct EpiResid {
    static constexpr bool PERM = false, AFTER_DRAIN = false;
    const float* xin; float* xout; const float* gate;
    __device__ __forceinline__ void operator()(const pg8::f32x4 (&acc)[2][2][4][2], const pg8::Unit& u, int wr, int wc, int fr, int fq) const {
        const int row0 = u.pm * 256 + wr * 64 + fr, col0 = u.pn * 256 + wc * 32 + 4 * fq;
        const float* gb = gate + ((u.pm * 256 >= SEQ) ? 6144 : 0);
        f32x4 gv[2][2];
#pragma unroll
        for (int bj = 0; bj < 2; ++bj)
#pragma unroll
            for (int n = 0; n < 2; ++n) gv[bj][n] = *(const f32x4*)(gb + col0 + bj * 128 + n * 16);
#pragma unroll
        for (int ai = 0; ai < 2; ++ai)
#pragma unroll
            for (int m = 0; m < 4; ++m) {
                const size_t rb = (size_t)(row0 + ai * 128 + m * 16) * DM;
#pragma unroll
                for (int bj = 0; bj < 2; ++bj)
#pragma unroll
                    for (int n = 0; n < 2; ++n) {
                        const size_t p = rb + col0 + bj * 128 + n * 16;
                        const f32x4 xi = *(const f32x4*)(xin + p);
                        *(f32x4*)(xout + p) = xi + gv[bj][n] * acc[ai][bj][m][n];
                    }
            }
    }
};
struct EpiGeluStats {
    static constexpr bool PERM = true, AFTER_DRAIN = false;
    bf16* Z; float* stats;
    __device__ __forceinline__ void operator()(const pg8::f32x4 (&acc)[2][2][4][2], const pg8::Unit& u, int wr, int wc, int fr, int fq) const {
        const int row0 = u.pm * 256 + wr * 64 + fr, col0 = u.pn * 256 + wc * 32 + 8 * fq;
#pragma unroll
        for (int ai = 0; ai < 2; ++ai)
#pragma unroll
            for (int m = 0; m < 4; ++m) {
                const int row = row0 + ai * 128 + m * 16; float ss = 0.f;
#pragma unroll
                for (int bj = 0; bj < 2; ++bj) {
                    float g[8];
#pragma unroll
                    for (int n = 0; n < 2; ++n)
#pragma unroll
                        for (int i = 0; i < 4; ++i) { g[n * 4 + i] = gelu_tanh(acc[ai][bj][m][n][i]); ss += g[n * 4 + i] * g[n * 4 + i]; }
                    *(v4u*)(Z + (size_t)row * 4096 + col0 + bj * 128) = pack8(g);
                }
                if (u.pn >= 8) {
                    ss += __shfl_xor(ss, 16); ss += __shfl_xor(ss, 32);
                    if (fq == 0) stats[(size_t)row * 32 + (u.pn - 8) * 4 + wc] = ss;
                }
            }
    }
};
struct EpiMoeGU {
    static constexpr bool PERM = true, AFTER_DRAIN = false;
    bf16* HID;
    __device__ __forceinline__ void operator()(const pg8::f32x4 (&acc)[2][2][4][2], const pg8::Unit& u, int wr, int wc, int fr, int fq) const {
        const int row0 = u.pm * 256 + wr * 64 + fr, col0 = (u.pn & 3) * 128 + wc * 32 + 8 * fq;
#pragma unroll
        for (int ai = 0; ai < 2; ++ai)
#pragma unroll
            for (int m = 0; m < 4; ++m) {
                float h[8];
#pragma unroll
                for (int n = 0; n < 2; ++n)
#pragma unroll
                    for (int i = 0; i < 4; ++i) h[n * 4 + i] = siluf_(acc[ai][0][m][n][i]) * acc[ai][1][m][n][i];
                *(v4u*)(HID + (size_t)(row0 + ai * 128 + m * 16) * EHID + col0) = pack8(h);
            }
    }
};
struct EpiMoeDn {
    static constexpr bool PERM = true, AFTER_DRAIN = false;
    bf16* YM;
    __device__ __forceinline__ void operator()(const pg8::f32x4 (&acc)[2][2][4][2], const pg8::Unit& u, int wr, int wc, int fr, int fq) const {
        const int row0 = u.pm * 256 + wr * 64 + fr, col0 = (u.pn & 3) * 256 + wc * 32 + 8 * fq;
#pragma unroll
        for (int ai = 0; ai < 2; ++ai)
#pragma unroll
            for (int m = 0; m < 4; ++m)
#pragma unroll
                for (int bj = 0; bj < 2; ++bj) {
                    float h[8];
#pragma unroll
                    for (int n = 0; n < 2; ++n)
#pragma unroll
                        for (int i = 0; i < 4; ++i) h[n * 4 + i] = acc[ai][bj][m][n][i];
                    *(v4u*)(YM + (size_t)(row0 + ai * 128 + m * 16) * DM + col0 + bj * 128) = pack8(h);
                }
    }
};
struct MoeOrder {
    const LAS int* ppre; int G, c;
    __device__ __forceinline__ bool next(int i, pg8::Unit& u) const {
        const int L = i * G + c, np = ppre[16];
        if (L >= np * 4) return false;
        const int pm = L >> 2; int e = 0;
#pragma unroll
        for (int k = 1; k < 16; ++k) e += (ppre[k] <= pm) ? 1 : 0;
        u.pm = pm; u.pn = e * 4 + (L & 3); return true;
    }
    __device__ __forceinline__ void a_ready(const pg8::Unit&) const {}
    __device__ __forceinline__ void done(const pg8::Unit&) const {}
};

__device__ __forceinline__ int dest_row(int mode, int n) {
    if (mode == 1) return (n < 1024) ? n : (n < 1040) ? n + 1792 : (n < 2832) ? n - 16 : n;
    if (mode == 2) return (n >> 7) * 256 + (n & 127);
    if (mode == 3) return (n >> 7) * 256 + 128 + (n & 127);
    return n;
}
__device__ __forceinline__ void transpose_item(const float* W, int K, int N, bf16* WT, int mode, LAS float* scr, int item, int lane) {
    const int nblk = (N + 31) / 32, kb = item / nblk, nb = item % nblk, k0 = 64 * kb, n0 = 32 * nb;
    const int col = n0 + (lane & 31);
#pragma unroll 8
    for (int i = 0; i < 32; ++i) { const int kk = 2 * i + (lane >> 5); scr[kk * 33 + (lane & 31)] = (col < N) ? W[(size_t)(k0 + kk) * N + col] : 0.f; }
    LDS_WAIT(); asm volatile("" ::: "memory");
    const int c = lane & 7;
#pragma unroll
    for (int j = 0; j < 4; ++j) { const int n = (lane >> 3) + 8 * j; const LAS float* s = scr + (8 * c) * 33 + n;
        v4u o; o.x = pk2(s[0 * 33], s[1 * 33]); o.y = pk2(s[2 * 33], s[3 * 33]); o.z = pk2(s[4 * 33], s[5 * 33]); o.w = pk2(s[6 * 33], s[7 * 33]);
        if (n0 + n < N) *(GAS v4u*)(WT + (size_t)dest_row(mode, n0 + n) * K + k0 + 8 * c) = o; }
    LDS_WAIT(); asm volatile("" ::: "memory");
}
__device__ __forceinline__ void p0_prologue(Frame& F) {
    LAS float* red = (LAS float*)(F.lds + RING_OFF);
    float* mod = (float*)(F.ws + WS_MOD);
    float* bias1 = (float*)(F.ws + WS_MOD + 131072);
    for (int bi = F.bid; bi < 200; bi += F.G) {
        if (bi < 192) {
            const int l = bi / 96, cg = bi % 96, j = cg * 64 + F.lane;
            float a0 = 0.f, a1 = 0.f;
            const float* wp = F.w_ada + ((size_t)l * 1024 + F.wave * 128) * 6144 + j;
#pragma unroll 8
            for (int k = 0; k < 128; ++k) { const float wv = wp[(size_t)k * 6144]; const float c0 = F.c[F.wave * 128 + k], c1 = F.c[1024 + F.wave * 128 + k];
                a0 += siluf_(c0) * wv; a1 += siluf_(c1) * wv; }
            red[(F.wave * 2 + 0) * 64 + F.lane] = a0; red[(F.wave * 2 + 1) * 64 + F.lane] = a1;
            __syncthreads();
            if (F.tid < 128) { const int b = F.tid >> 6, ln = F.tid & 63; float s = 0.f;
#pragma unroll
                for (int w = 0; w < 8; ++w) s += red[(w * 2 + b) * 64 + ln];
                mod[(size_t)(l * 2 + b) * 6144 + cg * 64 + ln] = s + F.b_ada[l * 6144 + cg * 64 + ln]; }
            __syncthreads();
        } else {
            const int kv = (bi - 192) >> 2, cg = (bi - 192) & 3, j = cg * 64 + F.lane;
            float a0 = 0.f;
            const float* wp = F.cmp_w1 + ((size_t)kv * 2048 + F.wave * 256) * 256 + j; const float* pe = F.cmp_pe + kv * 2048 + F.wave * 256;
#pragma unroll 8
            for (int k = 0; k < 256; ++k) a0 += pe[k] * wp[(size_t)k * 256];
            red[F.wave * 64 + F.lane] = a0;
            __syncthreads();
            if (F.tid < 64) { float s = 0.f;
#pragma unroll
                for (int w = 0; w < 8; ++w) s += red[w * 64 + F.tid];
                bias1[kv * 256 + cg * 64 + F.tid] = s; }
            __syncthreads();
        }
    }
    { bf16* wi = (bf16*)(F.ws + WS_WIN); const int npieces = (NPROJ - C_END) * (DM / 8);
      for (int p = F.bid * 512 + F.tid; p < npieces; p += F.G * 512) *(GAS v4u*)(wi + (size_t)C_END * DM + (size_t)p * 8) = (v4u){0u, 0u, 0u, 0u}; }
    LAS float* scr = (LAS float*)(F.lds + RING_OFF + 8192 + F.wave * 12288);
    const int gw = F.bid * 8 + F.wave, NGW = F.G * 8;
    constexpr int I_IN = 16 * 90, I_OUT = 16 * 32, I_INC = 16 * 128, I_OUTC = 32 * 32, I_CW1 = 2 * 32 * 8, I_G = 32 * 256, I_U = 32 * 256, I_D = 32 * 256;
    constexpr int NITEMS = I_IN + I_OUT + I_INC + I_OUTC + I_CW1 + I_G + I_U + I_D;
    for (int it = gw; it < NITEMS; it += NGW) {
        int r = it; const float* src; bf16* dst; int K, N, mode = 0;
        if (r < I_IN) { src = F.w_in_ab; dst = (bf16*)(F.ws + WS_WIN); K = 1024; N = 2856; mode = 1; }
        else if ((r -= I_IN) < I_OUT) { src = F.w_out_ab; dst = (bf16*)(F.ws + WS_WOUT); K = 1024; N = 1024; }
        else if ((r -= I_OUT) < I_INC) { src = F.w_in_c; dst = (bf16*)(F.ws + WS_WINC); K = 1024; N = 4096; }
        else if ((r -= I_INC) < I_OUTC) { src = F.w_out_c; dst = (bf16*)(F.ws + WS_WOUTC); K = 2048; N = 1024; }
        else if ((r -= I_OUTC) < I_CW1) { const int m = r >> 8; r &= 255; src = F.cmp_w1 + (size_t)m * 2048 * 256; dst = (bf16*)(F.ws + WS_WCW1) + (size_t)m * 256 * 2048; K = 2048; N = 256; }
        else if ((r -= I_CW1) < I_G) { const int m = r >> 8; r &= 255; src = F.w_gate + (size_t)m * 1024 * 512; dst = (bf16*)(F.ws + WS_WGU) + (size_t)m * 1024 * 1024; K = 1024; N = 512; mode = 2; }
        else if ((r -= I_G) < I_U) { const int m = r >> 8; r &= 255; src = F.w_up + (size_t)m * 1024 * 512; dst = (bf16*)(F.ws + WS_WGU) + (size_t)m * 1024 * 1024; K = 1024; N = 512; mode = 3; }
        else { r -= I_U; const int m = r >> 8; r &= 255; src = F.w_down + (size_t)m * 512 * 1024; dst = (bf16*)(F.ws + WS_WDN) + (size_t)m * 1024 * 512; K = 512; N = 1024; }
        transpose_item(src, K, N, dst, mode, scr, r, F.lane);
    }
}

struct RouteRec { int e0, e1, pos0, pos1; float w0, w1; int slot0, slot1; };
template <bool COMBINE, bool NORM, bool ROUTE>
__device__ __forceinline__ void row_pass(Frame& F, const float* xin, const float* modn  , int sh_off, const float* ng,
                                         const float* modc  , int layer) {
    float* xout = F.out; bf16* H = (bf16*)(F.ws + WS_O);
    const bf16* YM = (const bf16*)(F.ws + WS_A);
    RouteRec* route = (RouteRec*)(F.ws + WS_ROUTE);
    LAS float* wr = (LAS float*)(F.lds + RING_OFF);
    if (ROUTE) {
        for (int idx = F.tid; idx < 16384; idx += 512) wr[(idx & 15) * 1024 + (idx >> 4)] = F.w_router[idx];
        __syncthreads();
    }
    const int gw = F.bid * 8 + F.wave, NGW = F.G * 8;
#pragma unroll 1
    for (int b = 0; b < NB; ++b) {
        f32x4 cs[4], sh[4], gc[4];
#pragma unroll
        for (int j = 0; j < 4; ++j) {
            const int col = 4 * F.lane + 256 * j;
            if (NORM) { const f32x4 g = *(const f32x4*)(ng + col), sc = *(const f32x4*)(modn + b * 6144 + sh_off + 1024 + col); cs[j] = g * (sc + 1.0f); sh[j] = *(const f32x4*)(modn + b * 6144 + sh_off + col); }
            if (COMBINE) gc[j] = *(const f32x4*)(modc + b * 6144 + 5 * 1024 + col);
        }
#pragma unroll 1
        for (int m = b * SEQ + gw; m < (b + 1) * SEQ; m += NGW) {
            f32x4 v[4];
#pragma unroll
            for (int j = 0; j < 4; ++j) v[j] = *(const f32x4*)(xin + (size_t)m * DM + 4 * F.lane + 256 * j);
            if (COMBINE) {
                const RouteRec rr = route[m];
#pragma unroll
                for (int j = 0; j < 4; ++j) {
                    const v2u y0 = *(const v2u*)(YM + (size_t)rr.slot0 * DM + 4 * F.lane + 256 * j), y1 = *(const v2u*)(YM + (size_t)rr.slot1 * DM + 4 * F.lane + 256 * j);
                    f32x4 yy; yy.x = rr.w0 * bflo(y0.x) + rr.w1 * bflo(y1.x); yy.y = rr.w0 * bfhi(y0.x) + rr.w1 * bfhi(y1.x); yy.z = rr.w0 * bflo(y0.y) + rr.w1 * bflo(y1.y); yy.w = rr.w0 * bfhi(y0.y) + rr.w1 * bfhi(y1.y);
                    v[j] = v[j] + gc[j] * yy;
                    *(f32x4*)(xout + (size_t)m * DM + 4 * F.lane + 256 * j) = v[j];
                }
            }
            if (NORM) {
                float s = 0.f;
#pragma unroll
                for (int j = 0; j < 4; ++j) s += (v[j].x * v[j].x + v[j].y * v[j].y) + (v[j].z * v[j].z + v[j].w * v[j].w);
                const float rstd = 1.0f / sqrtf(wave_sum(s) * (1.0f / DM) + NORM_EPS);
#pragma unroll
                for (int j = 0; j < 4; ++j) { v[j] = v[j] * rstd * cs[j] + sh[j];
                    v2u o; o.x = pk2(v[j].x, v[j].y); o.y = pk2(v[j].z, v[j].w);
                    *(v2u*)(H + (size_t)m * DM + 4 * F.lane + 256 * j) = o; }
            }
            if (ROUTE) {
                float lg[16];
#pragma unroll
                for (int eg = 0; eg < 4; ++eg) {
                    float a4[4] = {0.f, 0.f, 0.f, 0.f};
#pragma unroll
                    for (int j = 0; j < 4; ++j)
#pragma unroll
                        for (int ee = 0; ee < 4; ++ee) { const f32x4 w = *(const LAS f32x4*)(wr + (eg * 4 + ee) * 1024 + 4 * F.lane + 256 * j); a4[ee] += (v[j].x * w.x + v[j].y * w.y) + (v[j].z * w.z + v[j].w * w.w); }
#pragma unroll
                    for (int ee = 0; ee < 4; ++ee) lg[eg * 4 + ee] = wave_sum(a4[ee]);
                    __builtin_amdgcn_sched_barrier(0);
                }
                float sc[16], sl[16];
#pragma unroll
                for (int e = 0; e < 16; ++e) { sc[e] = 1.0f / (1.0f + expf(-lg[e])); sl[e] = sc[e] + F.r_bias[e]; }
                float gs[4]; int ge1[4], ge2[4]; float gw1[4], gw2[4];
#pragma unroll
                for (int g = 0; g < 4; ++g) {
                    int i1 = 0; float m1 = sl[4 * g];
#pragma unroll
                    for (int k = 1; k < 4; ++k) if (sl[4 * g + k] > m1) { m1 = sl[4 * g + k]; i1 = k; }
                    int i2 = -1; float m2 = 0.f;
#pragma unroll
                    for (int k = 0; k < 4; ++k) if (k != i1 && (i2 < 0 || sl[4 * g + k] > m2)) { m2 = sl[4 * g + k]; i2 = k; }
                    gs[g] = m1 + m2; ge1[g] = 4 * g + i1; ge2[g] = 4 * g + i2;
                    float w1 = 0.f, w2 = 0.f;
#pragma unroll
                    for (int k = 0; k < 4; ++k) { w1 = (k == i1) ? sc[4 * g + k] : w1; w2 = (k == i2) ? sc[4 * g + k] : w2; }
                    gw1[g] = w1; gw2[g] = w2;
                }
                int gi = 0; float gm = gs[0];
#pragma unroll
                for (int g = 1; g < 4; ++g) if (gs[g] > gm) { gm = gs[g]; gi = g; }
                int e1 = ge1[0], e2 = ge2[0]; float w1 = gw1[0], w2 = gw2[0];
#pragma unroll
                for (int g = 1; g < 4; ++g) if (gi == g) { e1 = ge1[g]; e2 = ge2[g]; w1 = gw1[g]; w2 = gw2[g]; }
                const float ws_ = w1 + w2;
                if (F.lane == 0) {
                    unsigned* cnt = (unsigned*)(F.ctl + CW_CNT + 64 * layer);
                    RouteRec rr; rr.e0 = e1; rr.e1 = e2; rr.pos0 = (int)atomicAdd(cnt + e1, 1u); rr.pos1 = (int)atomicAdd(cnt + e2, 1u); rr.w0 = w1 / ws_; rr.w1 = w2 / ws_; rr.slot0 = 0; rr.slot1 = 0;
                    route[m] = rr;
                }
            }
        }
    }
}

__device__ __forceinline__ void moe_tables(Frame& F, int layer) {
    LAS int* ppre = (LAS int*)(F.lds + TAB_OFF);
    if (F.tid == 0) { const unsigned* cnt = (const unsigned*)(F.ctl + CW_CNT + 64 * layer); int acc = 0;
        for (int e = 0; e < 16; ++e) { ppre[e] = acc; acc += ((int)cnt[e] + 255) >> 8; }
        ppre[16] = acc; }
    __syncthreads();
}
__device__ __forceinline__ void moe_gather(Frame& F, int layer) {
    moe_tables(F, layer);
    const LAS int* ppre = (const LAS int*)(F.lds + TAB_OFF);
    RouteRec* route = (RouteRec*)(F.ws + WS_ROUTE);
    const bf16* H = (const bf16*)(F.ws + WS_O); bf16* HS = (bf16*)(F.ws + WS_A);
    const int gw = F.bid * 8 + F.wave, NGW = F.G * 8;
    for (int m = gw; m < NTOK; m += NGW) {
        RouteRec rr = route[m];
        int p0 = 0, p1 = 0;
#pragma unroll
        for (int e = 0; e < 16; ++e) { p0 = (rr.e0 == e) ? ppre[e] : p0; p1 = (rr.e1 == e) ? ppre[e] : p1; }
        const int s0 = p0 * 256 + rr.pos0, s1 = p1 * 256 + rr.pos1;
        const v4u a = *(const v4u*)(H + (size_t)m * DM + 8 * F.lane), b = *(const v4u*)(H + (size_t)m * DM + 512 + 8 * F.lane);
        *(v4u*)(HS + (size_t)s0 * DM + 8 * F.lane) = a; *(v4u*)(HS + (size_t)s0 * DM + 512 + 8 * F.lane) = b;
        *(v4u*)(HS + (size_t)s1 * DM + 8 * F.lane) = a; *(v4u*)(HS + (size_t)s1 * DM + 512 + 8 * F.lane) = b;
        if (F.lane == 0) { route[m].slot0 = s0; route[m].slot1 = s1; }
    }
}

__device__ __forceinline__ f32x4 mma16(const LAS bf16* A, int lda, const LAS bf16* Bt, int ldb, int K, f32x4 acc, int lane) {
    const LAS bf16* ap = A + (lane & 15) * lda + (lane >> 4) * 8;
    const LAS bf16* bp = Bt + (lane & 15) * ldb + (lane >> 4) * 8;
    for (int k = 0; k < K; k += 32) {
        const bf16x8 a = *(const LAS bf16x8*)(ap + k), b = *(const LAS bf16x8*)(bp + k);
        acc = __builtin_amdgcn_mfma_f32_16x16x32_bf16(a, b, acc, 0, 0, 0);
    }
    return acc;
}

__device__ __forceinline__ void gla_bcum(Frame& F, const bf16* prow  , int h, float (&bc)[8]) {
    float gl[16];
    { const v4u a = *(const v4u*)(prow + C_GLR), b = *(const v4u*)(prow + C_GLR + 8); float t0[8], t1[8]; unpack8(a, t0); unpack8(b, t1);
#pragma unroll
      for (int i = 0; i < 8; ++i) { gl[i] = t0[i]; gl[8 + i] = t1[i]; } }
#pragma unroll
    for (int i = 0; i < 8; ++i) {
        const int col = h * 64 + F.wave * 8 + i;
        float z = F.gla_bg[col];
#pragma unroll
        for (int r = 0; r < 16; ++r) z += gl[r] * F.gla_w2[r * 256 + col];
        const float ls = fminf(z, 0.f) - log1pf(__expf(-fabsf(z)));
        float v = ls * (1.0f / 16.0f);
#pragma unroll
        for (int off = 1; off < 64; off <<= 1) { const float o = __shfl_up(v, off); v += (F.lane >= off) ? o : 0.f; }
        bc[i] = v;
    }
}
__device__ __forceinline__ void gla_stage_vT(Frame& F, const bf16* prow, int h, LAS bf16* VT) {
    const v4u a = *(const v4u*)(prow + C_GV + h * 128 + F.wave * 16), b = *(const v4u*)(prow + C_GV + h * 128 + F.wave * 16 + 8);
    const unsigned w[8] = {a.x, a.y, a.z, a.w, b.x, b.y, b.z, b.w};
#pragma unroll
    for (int i = 0; i < 8; ++i) { VT[(F.wave * 16 + 2 * i) * 72 + F.lane] = (bf16)(w[i] & 0xffffu); VT[(F.wave * 16 + 2 * i + 1) * 72 + F.lane] = (bf16)(w[i] >> 16); }
}
__device__ __forceinline__ void gla_prep_item(Frame& F, int item) {
    const int h = item & 3, n = (item >> 2) & 127, b = item >> 9;
    const bf16* proj = (const bf16*)(F.ws + WS_A);
    const bf16* prow = proj + (size_t)(b * SEQ + n * 64 + F.lane) * NPROJ;
    LAS bf16* KT = (LAS bf16*)(F.lds + RING_OFF);
    LAS bf16* VT = (LAS bf16*)(F.lds + RING_OFF + 9216);
    float bc[8]; gla_bcum(F, prow, h, bc);
    float kf[8]; { const v4u kk = *(const v4u*)(prow + C_GK + h * 64 + F.wave * 8); unpack8(kk, kf); }
    float* DEC = (float*)(F.ws + WS_DEC) + ((size_t)(b * 128 + n) * 4 + h) * 64;
#pragma unroll
    for (int i = 0; i < 8; ++i) {
        const float bl = __shfl(bc[i], 63);
        KT[(F.wave * 8 + i) * 72 + F.lane] = (bf16)f2bf(kf[i] * __expf(bl - bc[i]));
        if (F.lane == 63) DEC[F.wave * 8 + i] = __expf(bl);
    }
    gla_stage_vT(F, prow, h, VT);
    __syncthreads();
    float* KV = (float*)(F.ws + WS_O) + ((size_t)(b * 128 + n) * 4 + h) * 8192;
    const int dt = F.wave >> 1;
#pragma unroll
    for (int j = 0; j < 4; ++j) {
        const int et = (F.wave & 1) * 4 + j;
        f32x4 acc = {0.f, 0.f, 0.f, 0.f};
        acc = mma16(KT + dt * 16 * 72, 72, VT + et * 16 * 72, 72, 64, acc, F.lane);
#pragma unroll
        for (int i = 0; i < 4; ++i) KV[(dt * 16 + 4 * (F.lane >> 4) + i) * 128 + et * 16 + (F.lane & 15)] = acc[i];
    }
    __syncthreads();
}
__device__ __forceinline__ void gla_scan(Frame& F, int gidx) {
    const int bh = gidx >> 13, de = gidx & 8191, b = bh >> 2, h = bh & 3;
    float* KV = (float*)(F.ws + WS_O) + ((size_t)(b * 128) * 4 + h) * 8192 + de;
    const float* DEC = (const float*)(F.ws + WS_DEC) + ((size_t)(b * 128) * 4 + h) * 64 + (de >> 7);
    float st = 0.f;
#pragma unroll 1
    for (int n0 = 0; n0 < 128; n0 += 8) {
        float kv[8], dc[8];
#pragma unroll
        for (int i = 0; i < 8; ++i) { kv[i] = KV[(size_t)(n0 + i) * 4 * 8192]; dc[i] = DEC[(size_t)(n0 + i) * 4 * 64]; }
#pragma unroll
        for (int i = 0; i < 8; ++i) { KV[(size_t)(n0 + i) * 4 * 8192] = st; st = dc[i] * st + kv[i]; }
    }
}
__device__ __forceinline__ void gla_out_item(Frame& F, int item) {
    const int h = item & 3, n = (item >> 2) & 127, b = item >> 9;
    const bf16* proj = (const bf16*)(F.ws + WS_A);
    const size_t tok = (size_t)b * SEQ + n * 64 + F.lane;
    const bf16* prow = proj + tok * NPROJ;
    LAS bf16* A1 = (LAS bf16*)(F.lds + RING_OFF);
    LAS bf16* B1 = (LAS bf16*)(F.lds + RING_OFF + 9216);
    LAS bf16* A2 = (LAS bf16*)(F.lds + RING_OFF + 18432);
    LAS bf16* SC = (LAS bf16*)(F.lds + RING_OFF + 27648);
    LAS bf16* VT = (LAS bf16*)(F.lds + RING_OFF + 36864);
    LAS bf16* ST = (LAS bf16*)(F.lds + RING_OFF + 55296);
    LAS float* OS = (LAS float*)(F.lds + RING_OFF + 73728);
    float bc[8]; gla_bcum(F, prow, h, bc);
    float qf[8], kf[8];
    { const v4u qq = *(const v4u*)(prow + C_GQ + h * 64 + F.wave * 8), kk = *(const v4u*)(prow + C_GK + h * 64 + F.wave * 8); unpack8(qq, qf); unpack8(kk, kf); }
    float a1[8], b1[8], a2[8];
#pragma unroll
    for (int i = 0; i < 8; ++i) {
        const float bm = __shfl(bc[i], 32);
        a1[i] = qf[i] * 0.125f * __expf(bc[i] - bm); b1[i] = kf[i] * __expf(bm - bc[i]); a2[i] = qf[i] * 0.125f * __expf(bc[i]);
    }
    *(LAS v4u*)(A1 + F.lane * 72 + F.wave * 8) = pack8(a1);
    *(LAS v4u*)(B1 + F.lane * 72 + F.wave * 8) = pack8(b1);
    *(LAS v4u*)(A2 + F.lane * 72 + F.wave * 8) = pack8(a2);
    gla_stage_vT(F, prow, h, VT);
    { const float* KV = (const float*)(F.ws + WS_O) + ((size_t)(b * 128 + n) * 4 + h) * 8192;
#pragma unroll
      for (int k = 0; k < 16; ++k) { const int p = F.tid + 512 * k, e = p & 127, d = p >> 7; ST[e * 72 + d] = (bf16)f2bf(KV[d * 128 + e]); } }
    __syncthreads();
    const int it = F.wave >> 1;
#pragma unroll
    for (int jj = 0; jj < 2; ++jj) {
        const int jt = (F.wave & 1) * 2 + jj;
        f32x4 acc = {0.f, 0.f, 0.f, 0.f};
        if (jt <= it) acc = mma16(A1 + it * 16 * 72, 72, B1 + jt * 16 * 72, 72, 64, acc, F.lane);
#pragma unroll
        for (int i = 0; i < 4; ++i) { const int ri = it * 16 + 4 * (F.lane >> 4) + i, cj = jt * 16 + (F.lane & 15); SC[ri * 72 + cj] = (bf16)f2bf((cj <= ri) ? acc[i] : 0.f); }
    }
    __syncthreads();
#pragma unroll
    for (int j = 0; j < 4; ++j) {
        const int et = (F.wave & 1) * 4 + j;
        f32x4 acc = {0.f, 0.f, 0.f, 0.f};
        acc = mma16(SC + it * 16 * 72, 72, VT + et * 16 * 72, 72, 64, acc, F.lane);
        acc = mma16(A2 + it * 16 * 72, 72, ST + et * 16 * 72, 72, 64, acc, F.lane);
#pragma unroll
        for (int i = 0; i < 4; ++i) OS[(it * 16 + 4 * (F.lane >> 4) + i) * 132 + et * 16 + (F.lane & 15)] = acc[i];
    }
    __syncthreads();
    { const int row = F.tid >> 3, c0 = (F.tid & 7) * 16;
      float v[16]; float ss = 0.f;
#pragma unroll
      for (int i = 0; i < 16; ++i) { v[i] = OS[row * 132 + c0 + i]; ss += v[i] * v[i]; }
      ss += __shfl_xor(ss, 1); ss += __shfl_xor(ss, 2); ss += __shfl_xor(ss, 4);
      const float rstd = 1.0f / sqrtf(ss * (1.0f / 128.0f) + NORM_EPS);
      const size_t tk = (size_t)b * SEQ + n * 64 + row;
      const bf16* rrow = proj + tk * NPROJ + C_GR + h * 128 + c0;
      float r0[8], r1[8]; unpack8(*(const v4u*)rrow, r0); unpack8(*(const v4u*)(rrow + 8), r1);
      float o0[8], o1[8];
#pragma unroll
      for (int i = 0; i < 8; ++i) { o0[i] = v[i] * rstd * F.gla_ng[c0 + i] * siluf_(r0[i]); o1[i] = v[8 + i] * rstd * F.gla_ng[c0 + 8 + i] * siluf_(r1[i]); }
      bf16* orow = (bf16*)(F.ws + WS_O + 32 * MiB) + tk * DM + h * 128 + c0;
      *(v4u*)orow = pack8(o0); *(v4u*)(orow + 8) = pack8(o1); }
    __syncthreads();
}

__device__ __forceinline__ double inv_freq_d(int i) {
    return (i == 0) ? 1.0 : (i == 1) ? 0.19392547740471268 : (i == 2) ? 0.037606090787015346 : (i == 3) ? 0.0072927791106285765 :
           (i == 4) ? 0.0014142135623730951 : (i == 5) ? 0.00027425197177757796 : (i == 6) ? 5.318404375373266e-05 : 1.0313741203148838e-05;
}
__device__ __forceinline__ void rope_sincos(int pos, int i, float& cs, float& sn) {
    const double rev = (double)pos * inv_freq_d(i) * 0.15915494309189535;
    const float fr = (float)(rev - rint(rev));
    cs = __builtin_amdgcn_cosf(fr); sn = __builtin_amdgcn_sinf(fr);
}
__device__ __forceinline__ void nsa_prep_token(Frame& F, int tok) {
    const int b = tok >> 13, t = tok & 8191, sub = F.lane & 7, vid = F.lane >> 3;
    const bf16* prow = (const bf16*)(F.ws + WS_A) + (size_t)tok * NPROJ;
    const int pos = F.positions[tok];
    float cs_l, sn_l; rope_sincos(pos, sub, cs_l, sn_l);
    float cs[8], sn[8];
#pragma unroll
    for (int i = 0; i < 8; ++i) { cs[i] = __shfl(cs_l, (F.lane & ~7) + i); sn[i] = __shfl(sn_l, (F.lane & ~7) + i); }
    unsigned char* dob = F.dout_b;
    const size_t ktile_off = (size_t)(t >> 6) * 8192 + sub * 1024 + (t & 63) * 16;
    const size_t vtile_off = (size_t)(t >> 6) * 8192 + (sub >> 2) * 4096 + (t & 63) * 64 + (sub & 3) * 16;
#pragma unroll
    for (int round = 0; round < 3; ++round) {
        int col; int kind; unsigned char* dst; const float* gain = nullptr;
        if (round == 0) { col = C_NQ + vid * 64; kind = 0; gain = F.q_gain; const int g = vid >> 2, hh = vid & 3;
            dst = dob + DO_QN + ((((size_t)(b * 2 + g) * SEQ + t) * 4 + hh) * 64 + sub * 8) * 2; }
        else if (round == 1) {
            const int g = vid & 1, which = vid >> 1;
            const size_t img = (size_t)(b * 2 + g) * (1u << 20);
            if (which == 0) { col = C_KS + g * 64; kind = 1; gain = F.k_gain + 64; dst = dob + DO_KSEL + img + ktile_off; }
            else if (which == 1) { col = C_KW + g * 64; kind = 1; gain = F.k_gain + 128; dst = dob + DO_KWIN + img + ktile_off; }
            else if (which == 2) { col = C_VS + g * 64; kind = 2; dst = dob + DO_VSEL + img + vtile_off; }
            else { col = C_VW + g * 64; kind = 2; dst = dob + DO_VWIN + img + vtile_off; }
        } else {
            const int g = vid & 1, which = (vid >> 1) & 1;
            col = (which ? C_VC : C_KC) + g * 64; kind = 2;
            dst = dob + (which ? DO_VC : DO_KC) + (((size_t)(b * 2 + g) * SEQ + t) * 64 + sub * 8) * 2;
        }
        float x[8]; unpack8(*(const v4u*)(prow + col + sub * 8), x);
        if (kind != 2) {
            float ss = 0.f;
#pragma unroll
            for (int i = 0; i < 8; ++i) ss += x[i] * x[i];
            ss += __shfl_xor(ss, 1); ss += __shfl_xor(ss, 2); ss += __shfl_xor(ss, 4);
            const float rstd = 1.0f / sqrtf(ss * (1.0f / 64.0f) + NORM_EPS);
#pragma unroll
            for (int i = 0; i < 8; ++i) x[i] = x[i] * rstd * gain[sub * 8 + i];
            float xo[8];
#pragma unroll
            for (int i = 0; i < 8; ++i) xo[i] = __shfl_xor(x[i], 1);
            if (sub == 0) {
#pragma unroll
                for (int i = 0; i < 8; ++i) x[i] = x[i] * cs[i] - xo[i] * sn[i];
            } else if (sub == 1) {
#pragma unroll
                for (int i = 0; i < 8; ++i) x[i] = x[i] * cs[i] + xo[i] * sn[i];
            }
            if (kind == 0) {
#pragma unroll
                for (int i = 0; i < 8; ++i) x[i] *= 0.125f * 1.4426950408889634f;
            }
        }
        if (round < 2 || F.lane < 32) *(v4u*)dst = pack8(x);
    }
    if (F.lane < 24) { float* gt = (float*)(F.ws + WS_GATES) + (size_t)tok * 24; gt[F.lane] = sigmoidf_(bf2f(prow[C_NG + F.lane])); }
}

__device__ __forceinline__ void nsa_compress_item(Frame& F, int item) {
    const int kv = item >> 6, b = (item >> 5) & 1, g = (item >> 4) & 1, rt = item & 15, n0 = rt * 32;
    const bf16* Asrc = (const bf16*)(F.dout_b + (kv ? DO_VC : DO_KC)) + ((size_t)(b * 2 + g) * SEQ + 16 * n0) * 64;
    const bf16* Bsrc = (const bf16*)(F.ws + WS_WCW1) + (size_t)kv * 256 * 2048;
    LAS bf16* As = (LAS bf16*)(F.lds + RING_OFF);
    LAS bf16* Bs = (LAS bf16*)(F.lds + RING_OFF + 2 * 32 * 72 * 2);
    LAS float* Hs = (LAS float*)(F.lds + RING_OFF + 86016);
    LAS float* W2s = (LAS float*)(F.lds + RING_OFF);
    const int ar = F.tid >> 3, ac = (F.tid & 7) * 8;
    v4u areg = {0u, 0u, 0u, 0u}, breg[4];
#define CMP_GLOAD(kc) do { if (F.tid < 256) areg = *(const v4u*)(Asrc + (size_t)ar * 1024 + (kc) * 64 + ac); \
        _Pragma("unroll") for (int i_ = 0; i_ < 4; ++i_) { const int p_ = F.tid + 512 * i_, br_ = p_ >> 3, bc_ = (p_ & 7) * 8; breg[i_] = *(const v4u*)(Bsrc + (size_t)br_ * 2048 + (kc) * 64 + bc_); } } while (0)
#define CMP_LSTORE(buf) do { if (F.tid < 256) *(LAS v4u*)(As + (buf) * 32 * 72 + ar * 72 + ac) = areg; \
        _Pragma("unroll") for (int i_ = 0; i_ < 4; ++i_) { const int p_ = F.tid + 512 * i_, br_ = p_ >> 3, bc_ = (p_ & 7) * 8; *(LAS v4u*)(Bs + (buf) * 256 * 72 + br_ * 72 + bc_) = breg[i_]; } } while (0)
    f32x4 acc[2][2];
#pragma unroll
    for (int mt = 0; mt < 2; ++mt)
#pragma unroll
        for (int nt = 0; nt < 2; ++nt) acc[mt][nt] = (f32x4){0.f, 0.f, 0.f, 0.f};
    CMP_GLOAD(0); CMP_LSTORE(0); __syncthreads();
#pragma unroll 1
    for (int kc = 0; kc < 32; ++kc) {
        const int buf = kc & 1;
        if (kc + 1 < 32) CMP_GLOAD(kc + 1);
#pragma unroll
        for (int mt = 0; mt < 2; ++mt)
#pragma unroll
            for (int nt = 0; nt < 2; ++nt)
                acc[mt][nt] = mma16(As + buf * 32 * 72 + mt * 16 * 72, 72, Bs + buf * 256 * 72 + (F.wave * 32 + nt * 16) * 72, 72, 64, acc[mt][nt], F.lane);
        if (kc + 1 < 32) CMP_LSTORE(buf ^ 1);
        __syncthreads();
    }
    const float* bias1 = (const float*)(F.ws + WS_MOD + 131072) + kv * 256;
#pragma unroll
    for (int mt = 0; mt < 2; ++mt)
#pragma unroll
        for (int nt = 0; nt < 2; ++nt) { const int col = F.wave * 32 + nt * 16 + (F.lane & 15);
#pragma unroll
            for (int i = 0; i < 4; ++i) Hs[(mt * 16 + 4 * (F.lane >> 4) + i) * 260 + col] = gelu_tanh(acc[mt][nt][i] + bias1[col]); }
    { const float* w2 = F.cmp_w2 + (size_t)kv * 256 * 64;
#pragma unroll
      for (int i = 0; i < 8; ++i) *(LAS f32x4*)(W2s + (F.tid + 512 * i) * 4) = *(const f32x4*)(w2 + (size_t)(F.tid + 512 * i) * 4); }
    __syncthreads();
    const int r = F.tid >> 4, dq = F.tid & 15;
    f32x4 o = {0.f, 0.f, 0.f, 0.f};
#pragma unroll 8
    for (int j = 0; j < 256; ++j) { const float hv = Hs[r * 260 + j]; const f32x4 w = *(const LAS f32x4*)(W2s + j * 64 + 4 * dq); o = o + w * hv; }
    const int n = n0 + r;
    if (kv == 0) {
        float ss = (o.x * o.x + o.y * o.y) + (o.z * o.z + o.w * o.w);
        ss += __shfl_xor(ss, 1); ss += __shfl_xor(ss, 2); ss += __shfl_xor(ss, 4); ss += __shfl_xor(ss, 8);
        const float rstd = 1.0f / sqrtf(ss * (1.0f / 64.0f) + NORM_EPS);
        const f32x4 gn = *(const f32x4*)(F.k_gain + 4 * dq);
        o = o * rstd * gn;
        const int tlast = (16 * n + 31 < SEQ) ? 16 * n + 31 : SEQ - 1;
        const int pos = F.positions[b * SEQ + tlast];
        f32x4 po; po.x = __shfl_xor(o.x, 2); po.y = __shfl_xor(o.y, 2); po.z = __shfl_xor(o.z, 2); po.w = __shfl_xor(o.w, 2);
        if (dq < 4) {
            const int i0 = 4 * (dq & 1);
            float c0, s0, c1, s1, c2, s2, c3, s3;
            rope_sincos(pos, i0, c0, s0); rope_sincos(pos, i0 + 1, c1, s1); rope_sincos(pos, i0 + 2, c2, s2); rope_sincos(pos, i0 + 3, c3, s3);
            if (dq < 2) { o.x = o.x * c0 - po.x * s0; o.y = o.y * c1 - po.y * s1; o.z = o.z * c2 - po.z * s2; o.w = o.w * c3 - po.w * s3; }
            else { o.x = o.x * c0 + po.x * s0; o.y = o.y * c1 + po.y * s1; o.z = o.z * c2 + po.z * s2; o.w = o.w * c3 + po.w * s3; }
        }
    }
    if (n == 511) o = (f32x4){0.f, 0.f, 0.f, 0.f};
    v2u pk; pk.x = pk2(o.x, o.y); pk.y = pk2(o.z, o.w);
    const int c = dq >> 1;
    unsigned char* img = F.dout_b + (kv ? DO_VCMP : DO_KCMP) + (size_t)(b * 2 + g) * 65536 + (size_t)(n >> 6) * 8192;
    if (kv == 0) *(v2u*)(img + c * 1024 + (n & 63) * 16 + (dq & 1) * 8) = pk;
    else *(v2u*)(img + (c >> 2) * 4096 + (n & 63) * 64 + (c & 3) * 16 + (dq & 1) * 8) = pk;
    __syncthreads();
}

constexpr int NSA_KB = 0, NSA_VB = 16384, NSA_IMP = 32768, NSA_SELM = 65536;
__device__ __forceinline__ int crow(int r, int hi) { return (r & 3) + 8 * (r >> 2) + 4 * hi; }
__device__ __forceinline__ s16x4 ds_tr16(const LAS unsigned char* p) { return __builtin_bit_cast(s16x4, __builtin_amdgcn_ds_read_tr16_b64_v4i16((LAS s16x4*)p)); }

template <int MODE>
__device__ __forceinline__ void nsa_branch(Frame& F, const unsigned char* Kimg, const unsigned char* Vimg, int kt0, int kt1, const bf16x8 (&qr)[4],
                                           float& m, float& l, f32x16 (&o)[2], int t, int tw0, int nv, int nvw,
                                           unsigned mk0, unsigned mk1, unsigned mk2, unsigned mk3, unsigned wo0, unsigned wo1, unsigned wo2, unsigned wo3,
                                           float inv_l, LAS float* impw) {
    const int r32 = F.lane & 31, hi = F.lane >> 5, tokl = r32 >> 2;
    LAS unsigned char* KB = F.lds + RING_OFF + NSA_KB; LAS unsigned char* VB = F.lds + RING_OFF + NSA_VB;
    const v4u* kg = (const v4u*)Kimg + F.tid; const v4u* vg = (const v4u*)Vimg + F.tid;
    v4u kreg = kg[(size_t)kt0 * 512], vreg = {0u, 0u, 0u, 0u};
    if (MODE != 0) vreg = vg[(size_t)kt0 * 512];
    *(LAS v4u*)(KB + F.tid * 16) = kreg; if (MODE != 0) *(LAS v4u*)(VB + F.tid * 16) = vreg;
    __syncthreads();
#pragma unroll 1
    for (int kt = kt0; kt < kt1; ++kt) {
        const int buf = (kt - kt0) & 1; const bool has_next = kt + 1 < kt1;
        if (has_next) { kreg = kg[(size_t)(kt + 1) * 512]; if (MODE != 0) vreg = vg[(size_t)(kt + 1) * 512]; }
        const LAS unsigned char* Kb = KB + buf * 8192; const LAS unsigned char* Vb = VB + buf * 8192;
        bool need;
        if (MODE <= 1) need = kt * 64 < nvw;
        else if (MODE == 2) { const unsigned w = (kt < 32) ? wo0 : (kt < 64) ? wo1 : (kt < 96) ? wo2 : wo3; need = (w >> (kt & 31)) & 1u; }
        else need = (kt * 64 <= tw0 + 7) && (kt * 64 + 63 + 512 > tw0);
        bool selbit = true;
        if (MODE == 2) { const unsigned w = (kt < 32) ? mk0 : (kt < 64) ? mk1 : (kt < 96) ? mk2 : mk3; selbit = (w >> (kt & 31)) & 1u; }
        if (need) {
#pragma unroll 1
            for (int kb = 0; kb < 2; ++kb) {
                const int key0 = kt * 64 + kb * 32;
                f32x16 p = {0.f, 0.f, 0.f, 0.f, 0.f, 0.f, 0.f, 0.f, 0.f, 0.f, 0.f, 0.f, 0.f, 0.f, 0.f, 0.f};
#pragma unroll
                for (int d0 = 0; d0 < 4; ++d0) {
                    const bf16x8 kf = *(const LAS bf16x8*)(Kb + (2 * d0 + hi) * 1024 + (32 * kb + r32) * 16);
                    p = __builtin_amdgcn_mfma_f32_32x32x16_bf16(kf, qr[d0], p, 0, 0, 0);
                }
                float pe[16];
                if (MODE == 1) {
#pragma unroll
                    for (int r = 0; r < 16; ++r) { const int key = key0 + crow(r, hi); pe[r] = (key < nv) ? fexp2(p[r] - m) * inv_l : 0.f; }
#pragma unroll
                    for (int rg = 0; rg < 4; ++rg) {
                        float a = (pe[4 * rg] + pe[4 * rg + 1]) + (pe[4 * rg + 2] + pe[4 * rg + 3]), sp = pe[4 * rg + 3];
                        a += __shfl_xor(a, 1); a += __shfl_xor(a, 2); sp += __shfl_xor(sp, 1); sp += __shfl_xor(sp, 2);
                        if ((r32 & 3) == 0) { const int jp = (key0 >> 2) + 2 * rg + hi;
                            __hip_atomic_fetch_add(impw + tokl * 128 + jp, a, __ATOMIC_RELAXED, __HIP_MEMORY_SCOPE_WORKGROUP);
                            if (jp + 1 < 128) __hip_atomic_fetch_add(impw + tokl * 128 + jp + 1, sp, __ATOMIC_RELAXED, __HIP_MEMORY_SCOPE_WORKGROUP); }
                    }
                } else {
                    float mx = NEGBIG;
#pragma unroll
                    for (int r = 0; r < 16; ++r) {
                        const int key = key0 + crow(r, hi); bool ok;
                        if (MODE == 0) ok = key < nv;
                        else if (MODE == 2) ok = selbit && (kt < (t >> 6) || key <= t);
                        else ok = (key <= t) && (key + 512 > t);
                        p[r] = ok ? p[r] : NEGBIG; mx = fmaxf(mx, p[r]);
                    }
                    mx = fmaxf(mx, __shfl_xor(mx, 32));
                    const float mn = fmaxf(m, mx), alpha = fexp2(m - mn);
                    float ps = 0.f;
#pragma unroll
                    for (int r = 0; r < 16; ++r) { pe[r] = (p[r] > -1e29f) ? fexp2(p[r] - mn) : 0.f; ps += pe[r]; }
                    l = l * alpha + ps; m = mn;
                    if (MODE != 0) {
#pragma unroll
                        for (int r = 0; r < 16; ++r) { o[0][r] *= alpha; o[1][r] *= alpha; }
                    }
                }
                if (MODE != 0) {
                    v4u pw0, pw1;
                    pw0.x = pk2(pe[0], pe[1]); pw0.y = pk2(pe[2], pe[3]); pw0.z = pk2(pe[4], pe[5]); pw0.w = pk2(pe[6], pe[7]);
                    pw1.x = pk2(pe[8], pe[9]); pw1.y = pk2(pe[10], pe[11]); pw1.z = pk2(pe[12], pe[13]); pw1.w = pk2(pe[14], pe[15]);
                    const bf16x8 pf0 = __builtin_bit_cast(bf16x8, pw0), pf1 = __builtin_bit_cast(bf16x8, pw1);
                    const LAS unsigned char* vb = Vb + (32 * kb + 4 * hi + ((F.lane & 15) >> 2)) * 64 + ((F.lane >> 4) & 1) * 32 + (F.lane & 3) * 8;
#pragma unroll
                    for (int dh = 0; dh < 2; ++dh) {
                        const s16x4 a0 = ds_tr16(vb + dh * 4096), a1 = ds_tr16(vb + dh * 4096 + 512), b0 = ds_tr16(vb + dh * 4096 + 1024), b1 = ds_tr16(vb + dh * 4096 + 1024 + 512);
                        const bf16x8 vf0 = {a0[0], a0[1], a0[2], a0[3], a1[0], a1[1], a1[2], a1[3]}, vf1 = {b0[0], b0[1], b0[2], b0[3], b1[0], b1[1], b1[2], b1[3]};
                        o[dh] = __builtin_amdgcn_mfma_f32_32x32x16_bf16(vf0, pf0, o[dh], 0, 0, 0);
                        o[dh] = __builtin_amdgcn_mfma_f32_32x32x16_bf16(vf1, pf1, o[dh], 0, 0, 0);
                    }
                }
            }
        }
        if (has_next) { *(LAS v4u*)(KB + (buf ^ 1) * 8192 + F.tid * 16) = kreg; if (MODE != 0) *(LAS v4u*)(VB + (buf ^ 1) * 8192 + F.tid * 16) = vreg; }
        __syncthreads();
    }
}

__device__ __forceinline__ void nsa_item(Frame& F, int b, int g, int qi) {
    const int r32 = F.lane & 31, hi = F.lane >> 5, tokl = r32 >> 2, hh = r32 & 3;
    const int t0 = qi * 64, tw0 = t0 + 8 * F.wave, t = tw0 + tokl;
    const unsigned char* dob = F.dout_b;
    const size_t img = (size_t)(b * 2 + g) * (1u << 20);
    LAS float* impw = (LAS float*)(F.lds + RING_OFF + NSA_IMP) + F.wave * 1024;
    LAS unsigned* selm = (LAS unsigned*)(F.lds + RING_OFF + NSA_SELM) + F.wave * 32;
#pragma unroll
    for (int i = 0; i < 16; ++i) impw[F.lane + 64 * i] = 0.f;
    bf16x8 qr[4];
    { const bf16* qrow = (const bf16*)(dob + DO_QN) + (((size_t)(b * 2 + g) * SEQ + tw0) * 4 + r32) * 64;
#pragma unroll
      for (int d0 = 0; d0 < 4; ++d0) qr[d0] = *(const bf16x8*)(qrow + 16 * d0 + 8 * hi); }
    const float* gt = (const float*)(F.ws + WS_GATES) + ((size_t)b * SEQ + t) * 24 + (g * 4 + hh) * 3;
    const float g0 = gt[0], g1 = gt[1], g2 = gt[2];
    f32x16 oacc[2], o[2];
#pragma unroll
    for (int r = 0; r < 16; ++r) { oacc[0][r] = 0.f; oacc[1][r] = 0.f; }
    const int nv = (t >= 31) ? ((t - 31) >> 4) + 1 : 0, nvw = (tw0 + 7 >= 31) ? ((tw0 + 7 - 31) >> 4) + 1 : 0;
    const int nct = (4 * qi + 3 + 63) >> 6;
    const unsigned char* Kc = dob + DO_KCMP + (size_t)(b * 2 + g) * 65536; const unsigned char* Vc = dob + DO_VCMP + (size_t)(b * 2 + g) * 65536;
    float m = NEGBIG, l = 0.f;
    nsa_branch<0>(F, Kc, Vc, 0, nct, qr, m, l, o, t, tw0, nv, nvw, 0u, 0u, 0u, 0u, 0u, 0u, 0u, 0u, 0.f, impw);
    { const float lt = l + __shfl_xor(l, 32); const float inv_l = (lt > 0.f) ? 1.0f / lt : 0.f;
#pragma unroll
      for (int r = 0; r < 16; ++r) { o[0][r] = 0.f; o[1][r] = 0.f; }
      nsa_branch<1>(F, Kc, Vc, 0, nct, qr, m, l, o, t, tw0, nv, nvw, 0u, 0u, 0u, 0u, 0u, 0u, 0u, 0u, inv_l, impw);
#pragma unroll
      for (int r = 0; r < 16; ++r) { oacc[0][r] += g0 * o[0][r]; oacc[1][r] += g0 * o[1][r]; } }
    __syncthreads();
#pragma unroll 1
    for (int tl = 0; tl < 8; ++tl) {
        const int tt = tw0 + tl, cur = tt >> 6, j0 = F.lane, j1 = F.lane + 64;
        const float NINF = -3.0e38f;
        float v0 = (j0 <= cur) ? impw[tl * 128 + j0] + ((j0 == 0 || j0 == cur || j0 == cur - 1) ? 1e4f : 0.f) : NINF;
        float v1 = (j1 <= cur) ? impw[tl * 128 + j1] + ((j1 == cur || j1 == cur - 1) ? 1e4f : 0.f) : NINF;
        bool s0 = false, s1 = false;
        if (cur < 16) { s0 = (j0 <= cur); }
        else {
#pragma unroll 1
            for (int round = 0; round < 16; ++round) {
                float bv; int bj;
                if (v0 >= v1) { bv = v0; bj = j0; } else { bv = v1; bj = j1; }
#pragma unroll
                for (int off = 32; off >= 1; off >>= 1) { const float ov = __shfl_xor(bv, off); const int oj = __shfl_xor(bj, off); if (ov > bv || (ov == bv && oj < bj)) { bv = ov; bj = oj; } }
                if (bj == j0) { s0 = true; v0 = NINF; }
                if (bj == j1) { s1 = true; v1 = NINF; }
            }
        }
        const unsigned long long m0 = __ballot(s0), m1 = __ballot(s1);
        if (F.lane == 0) { selm[tl * 4 + 0] = (unsigned)m0; selm[tl * 4 + 1] = (unsigned)(m0 >> 32); selm[tl * 4 + 2] = (unsigned)m1; selm[tl * 4 + 3] = (unsigned)(m1 >> 32); }
    }
    __syncthreads();
    const unsigned mk0 = selm[tokl * 4 + 0], mk1 = selm[tokl * 4 + 1], mk2 = selm[tokl * 4 + 2], mk3 = selm[tokl * 4 + 3];
    unsigned wo0 = 0u, wo1 = 0u, wo2 = 0u, wo3 = 0u;
#pragma unroll
    for (int tl = 0; tl < 8; ++tl) { wo0 |= selm[tl * 4 + 0]; wo1 |= selm[tl * 4 + 1]; wo2 |= selm[tl * 4 + 2]; wo3 |= selm[tl * 4 + 3]; }
    wo0 = __builtin_amdgcn_readfirstlane(wo0); wo1 = __builtin_amdgcn_readfirstlane(wo1); wo2 = __builtin_amdgcn_readfirstlane(wo2); wo3 = __builtin_amdgcn_readfirstlane(wo3);
    { m = NEGBIG; l = 0.f;
#pragma unroll
      for (int r = 0; r < 16; ++r) { o[0][r] = 0.f; o[1][r] = 0.f; }
      nsa_branch<2>(F, dob + DO_KSEL + img, dob + DO_VSEL + img, 0, qi + 1, qr, m, l, o, t, tw0, nv, nvw, mk0, mk1, mk2, mk3, wo0, wo1, wo2, wo3, 0.f, impw);
      const float lt = l + __shfl_xor(l, 32); const float sc = (lt > 0.f) ? g1 / lt : 0.f;
#pragma unroll
      for (int r = 0; r < 16; ++r) { oacc[0][r] += sc * o[0][r]; oacc[1][r] += sc * o[1][r]; } }
    { m = NEGBIG; l = 0.f;
#pragma unroll
      for (int r = 0; r < 16; ++r) { o[0][r] = 0.f; o[1][r] = 0.f; }
      nsa_branch<3>(F, dob + DO_KWIN + img, dob + DO_VWIN + img, (qi >= 8) ? qi - 8 : 0, qi + 1, qr, m, l, o, t, tw0, nv, nvw, 0u, 0u, 0u, 0u, 0u, 0u, 0u, 0u, 0.f, impw);
      const float lt = l + __shfl_xor(l, 32); const float sc = (lt > 0.f) ? g2 / lt : 0.f;
#pragma unroll
      for (int r = 0; r < 16; ++r) { oacc[0][r] += sc * o[0][r]; oacc[1][r] += sc * o[1][r]; } }
    bf16* orow = (bf16*)(F.ws + WS_O + 32 * MiB) + ((size_t)b * SEQ + t) * DM + 512 + (g * 4 + hh) * 64;
#pragma unroll
    for (int dh = 0; dh < 2; ++dh)
#pragma unroll
        for (int rg = 0; rg < 4; ++rg) { v2u w; w.x = pk2(oacc[dh][4 * rg], oacc[dh][4 * rg + 1]); w.y = pk2(oacc[dh][4 * rg + 2], oacc[dh][4 * rg + 3]);
            *(v2u*)(orow + 32 * dh + 8 * rg + 4 * hi) = w; }
    __syncthreads();
}

__device__ __forceinline__ void sgu_item(Frame& F, int item) {
    const int gg = item & 7, ck = (item >> 3) & 63, b = item >> 9;
    const size_t tok0 = (size_t)b * SEQ + ck * 128;
    const bf16* Z = (const bf16*)(F.ws + WS_A);
    LAS bf16* Ws = (LAS bf16*)(F.lds + RING_OFF);
    LAS bf16* VT = (LAS bf16*)(F.lds + RING_OFF + 34816);
    LAS float* rs = (LAS float*)(F.lds + RING_OFF + 34816 + 69632);
    if (F.tid < 128) { const float* st = (const float*)(F.ws + WS_STATS) + (tok0 + F.tid) * 32; float s = 0.f;
#pragma unroll
        for (int k = 0; k < 32; k += 4) { const f32x4 v = *(const f32x4*)(st + k); s += (v.x + v.y) + (v.z + v.w); }
        rs[F.tid] = 1.0f / sqrtf(s * (1.0f / SGW) + NORM_EPS); }
    { const float* wsrc = F.sgu_ws + (size_t)gg * 128 * 128;
#pragma unroll
      for (int k = 0; k < 8; ++k) { const int p = F.tid + 512 * k, tr = p >> 5, sc = (p & 31) * 4; const f32x4 w = *(const f32x4*)(wsrc + tr * 128 + sc);
          v2u o; o.x = pk2((sc <= tr) ? w.x : 0.f, (sc + 1 <= tr) ? w.y : 0.f); o.y = pk2((sc + 2 <= tr) ? w.z : 0.f, (sc + 3 <= tr) ? w.w : 0.f);
          *(LAS v2u*)(Ws + tr * 136 + sc) = o; } }
    __syncthreads();
#pragma unroll 2
    for (int k = 0; k < 8; ++k) {
        const int p = F.tid + 512 * k, s = p & 127, cc = p >> 7;
        float x[8]; unpack8(*(const v4u*)(Z + (tok0 + s) * 4096 + 2048 + gg * 256 + cc * 8), x);
        const float rr = rs[s];
#pragma unroll
        for (int i = 0; i < 8; ++i) VT[(cc * 8 + i) * 136 + s] = (bf16)f2bf(x[i] * rr * F.sgu_ng[gg * 256 + cc * 8 + i]);
    }
    __syncthreads();
    f32x4 acc[16];
#pragma unroll
    for (int nt = 0; nt < 16; ++nt) acc[nt] = (f32x4){0.f, 0.f, 0.f, 0.f};
    const int ksteps = (16 * F.wave + 16 + 31) >> 5;
    const LAS bf16* ap = Ws + (16 * F.wave + (F.lane & 15)) * 136 + (F.lane >> 4) * 8;
    const LAS bf16* bp = VT + (F.lane & 15) * 136 + (F.lane >> 4) * 8;
#pragma unroll 1
    for (int kk = 0; kk < ksteps; ++kk) {
        const bf16x8 a = *(const LAS bf16x8*)(ap + kk * 32);
#pragma unroll
        for (int nt = 0; nt < 16; ++nt) { const bf16x8 bb = *(const LAS bf16x8*)(bp + nt * 16 * 136 + kk * 32); acc[nt] = __builtin_amdgcn_mfma_f32_16x16x32_bf16(a, bb, acc[nt], 0, 0, 0); }
    }
    bf16* UM = (bf16*)(F.ws + WS_O);
#pragma unroll
    for (int i = 0; i < 4; ++i) {
        const int tr = 16 * F.wave + 4 * (F.lane >> 4) + i; const float bs = F.sgu_bs[gg * 128 + tr];
        const bf16* urow = Z + (tok0 + tr) * 4096 + gg * 256; bf16* orow = UM + (tok0 + tr) * SGW + gg * 256;
#pragma unroll
        for (int nt = 0; nt < 16; ++nt) { const int c = nt * 16 + (F.lane & 15); orow[c] = (bf16)f2bf(bf2f(urow[c]) * (acc[nt][i] + bs)); }
    }
    __syncthreads();
}

constexpr int NPHASE = 20;
struct Args { const void* in[26]; float* out; unsigned char* ws; int ph_lo, ph_hi, use_bar, pad; };
__global__ void __launch_bounds__(512, 2) trunk_fwd(Args args) {
    extern __shared__ __attribute__((aligned(16))) unsigned char lds[];
    Frame F;
    F.lds = (LAS unsigned char*)lds;
    F.MISC = (volatile LAS unsigned*)(F.lds + MISC_OFF);
    F.tid = threadIdx.x; F.lane = F.tid & 63; F.wave = __builtin_amdgcn_readfirstlane(F.tid >> 6);
    F.G = gridDim.x; F.bid = blockIdx.x;
    F.ws = args.ws; F.out = args.out; F.dout_b = (unsigned char*)args.out;
    F.ctl = (gu32*)(args.ws + WS_CTL);
    F.x = (const float*)args.in[0]; F.c = (const float*)args.in[1]; F.positions = (const int*)args.in[2]; F.w_ada = (const float*)args.in[3]; F.b_ada = (const float*)args.in[4];
    F.norm_g = (const float*)args.in[5]; F.w_in_ab = (const float*)args.in[6]; F.w_out_ab = (const float*)args.in[7]; F.gla_w2 = (const float*)args.in[8]; F.gla_bg = (const float*)args.in[9];
    F.gla_ng = (const float*)args.in[10]; F.q_gain = (const float*)args.in[11]; F.k_gain = (const float*)args.in[12]; F.cmp_pe = (const float*)args.in[13]; F.cmp_w1 = (const float*)args.in[14];
    F.cmp_w2 = (const float*)args.in[15]; F.w_in_c = (const float*)args.in[16]; F.sgu_ng = (const float*)args.in[17]; F.sgu_ws = (const float*)args.in[18]; F.sgu_bs = (const float*)args.in[19];
    F.w_out_c = (const float*)args.in[20]; F.w_router = (const float*)args.in[21]; F.r_bias = (const float*)args.in[22]; F.w_gate = (const float*)args.in[23]; F.w_up = (const float*)args.in[24];
    F.w_down = (const float*)args.in[25];
    for (int u = F.tid; u < (LDS_BYTES - LDSCTL_OFF) / 4; u += 512) ((LAS unsigned*)(F.lds + LDSCTL_OFF))[u] = 0u;
    __syncthreads();
    XcdBarrier bar; bar.bar = (unsigned*)(F.ctl + CW_BAR); bar.x = 0; bar.st = nullptr;
    if (args.use_bar) bar = xcd_barrier_post((unsigned*)(F.ctl + CW_BAR), F.MISC + 8);
    const int lo = args.ph_lo, hi = args.ph_hi;
#ifndef PH_MASK
#define PH_MASK 0xFFFFFu
#endif
#define IN(k) ((((PH_MASK) >> (k)) & 1u) && lo <= (k) && (k) < hi)
#define SEAM(k) do { if (IN(k) && IN((k) + 1)) xcd_barrier(bar); } while (0)
    float* mod = (float*)(F.ws + WS_MOD);
    bf16* Hb = (bf16*)(F.ws + WS_O);
    bf16* Ab = (bf16*)(F.ws + WS_A);

    if (IN(0)) { p0_prologue(F); } SEAM(0);
    if (IN(1)) { row_pass<false, true, false>(F, F.x, mod, 0, F.norm_g, mod, 0); } SEAM(1);
    if (IN(2)) { pg8::Gemm g{Hb, (const bf16*)(F.ws + WS_WIN), NTOK, NPROJ, DM}; pg8::StaticOrder S; S.init(NTOK, NPROJ, F.G, F.bid);
        pg8::EpiBf16<0> E{Ab, NPROJ, nullptr, 0, 0, 1.f};
        pg8::gemm_phase<pg8::EpiBf16<0>, pg8::StaticOrder, true, true>(F.lds + RING_OFF, g, S, E); } SEAM(2);
    if (IN(3)) {
        for (int it = F.bid; it < 1024; it += F.G) gla_prep_item(F, it);
        for (int tok = F.bid * 8 + F.wave; tok < NTOK; tok += F.G * 8) nsa_prep_token(F, tok);
    } SEAM(3);
    if (IN(4)) {
        const int half = F.G >> 1;
        if (F.bid < half) { for (int it = F.bid; it < 128; it += half) nsa_compress_item(F, it); }
        else { for (int gi = (F.bid - half) * 512 + F.tid; gi < 65536; gi += (F.G - half) * 512) gla_scan(F, gi); }
    } SEAM(4);
    if (IN(5)) {
#ifndef NO_NSA
        for (int p = F.bid; p < 256; p += F.G) { const int bg = p >> 6, i = p & 63; nsa_item(F, bg >> 1, bg & 1, i); nsa_item(F, bg >> 1, bg & 1, 127 - i); }
#endif
#ifndef NO_GLAOUT
        for (int it = F.bid; it < 1024; it += F.G) gla_out_item(F, it);
#endif
    } SEAM(5);
    if (IN(6)) { pg8::Gemm g{(const bf16*)(F.ws + WS_O + 32 * MiB), (const bf16*)(F.ws + WS_WOUT), NTOK, DM, DM}; pg8::StaticOrder S; S.init(NTOK, DM, F.G, F.bid);
        EpiResid E{F.x, F.out, mod + 2 * 1024};
        pg8::gemm_phase<EpiResid, pg8::StaticOrder, true, true>(F.lds + RING_OFF, g, S, E); } SEAM(6);
#define MOE_BLOCK(P, LAYER) \
    if (IN(P)) { row_pass<false, true, true>(F, F.out, mod + (LAYER) * 2 * 6144, 3 * 1024, F.norm_g + ((LAYER) * 2 + 1) * 1024, mod, (LAYER)); } SEAM(P); \
    if (IN((P) + 1)) { moe_gather(F, (LAYER)); } SEAM((P) + 1); \
    if (IN((P) + 2)) { moe_tables(F, (LAYER)); MoeOrder S{(const LAS int*)(F.lds + TAB_OFF), F.G, F.bid}; \
        pg8::Gemm g{Ab, (const bf16*)(F.ws + WS_WGU) + (size_t)(LAYER) * 16 * 1024 * 1024, MOE_ROWS, 1024, DM}; EpiMoeGU E{(bf16*)(F.ws + WS_A + A_HID_OFF)}; \
        pg8::gemm_phase<EpiMoeGU, MoeOrder, true, true>(F.lds + RING_OFF, g, S, E); } SEAM((P) + 2); \
    if (IN((P) + 3)) { moe_tables(F, (LAYER)); MoeOrder S{(const LAS int*)(F.lds + TAB_OFF), F.G, F.bid}; \
        pg8::Gemm g{(const bf16*)(F.ws + WS_A + A_HID_OFF), (const bf16*)(F.ws + WS_WDN) + (size_t)(LAYER) * 16 * 1024 * 512, MOE_ROWS, 1024, EHID}; EpiMoeDn E{Ab}; \
        pg8::gemm_phase<EpiMoeDn, MoeOrder, true, true>(F.lds + RING_OFF, g, S, E); } SEAM((P) + 3);
    MOE_BLOCK(7, 0)
    if (IN(11)) { row_pass<true, true, false>(F, F.out, mod + 2 * 6144, 0, F.norm_g + 2 * 1024, mod, 1); } SEAM(11);
    if (IN(12)) { pg8::Gemm g{Hb, (const bf16*)(F.ws + WS_WINC), NTOK, 4096, DM}; pg8::StaticOrder S; S.init(NTOK, 4096, F.G, F.bid);
        EpiGeluStats E{Ab, (float*)(F.ws + WS_STATS)};
        pg8::gemm_phase<EpiGeluStats, pg8::StaticOrder, true, true>(F.lds + RING_OFF, g, S, E); } SEAM(12);
    if (IN(13)) { for (int it = F.bid; it < 1024; it += F.G) sgu_item(F, it); } SEAM(13);
    if (IN(14)) { pg8::Gemm g{Hb, (const bf16*)(F.ws + WS_WOUTC), NTOK, DM, SGW}; pg8::StaticOrder S; S.init(NTOK, DM, F.G, F.bid);
        EpiResid E{F.out, F.out, mod + 2 * 6144 + 2 * 1024};
        pg8::gemm_phase<EpiResid, pg8::StaticOrder, true, true>(F.lds + RING_OFF, g, S, E); } SEAM(14);
    MOE_BLOCK(15, 1)
    if (IN(19)) { row_pass<true, false, false>(F, F.out, mod, 0, F.norm_g, mod + 2 * 6144, 1); }
#undef IN
#undef SEAM
#undef MOE_BLOCK
}

#ifndef MK_N_LAUNCHES
#define MK_N_LAUNCHES 1
#endif
extern "C" void kernel_launch(void* const* d_in, const int* in_sizes, int n_in, void* d_out, int out_size, void* d_ws, size_t ws_size, hipStream_t stream) {
    static int grid = 0;
    if (grid == 0) {
        if (n_in != 26 || out_size != NTOK * DM || ws_size < WS_END) { fprintf(stderr, "kernel_launch: unexpected problem shape / workspace (%d inputs, out %d, ws %zu)\n", n_in, out_size, ws_size); grid = -1; return; }
        int dev = 0, cus = 0, per_cu = 0;
        if (hipGetDevice(&dev) != hipSuccess || hipDeviceGetAttribute(&cus, hipDeviceAttributeMultiprocessorCount, dev) != hipSuccess) { grid = -1; return; }
        if (hipFuncSetAttribute((const void*)trunk_fwd, hipFuncAttributeMaxDynamicSharedMemorySize, LDS_BYTES) != hipSuccess) { fprintf(stderr, "kernel_launch: hipFuncSetAttribute failed\n"); grid = -1; return; }
        if (hipOccupancyMaxActiveBlocksPerMultiprocessor(&per_cu, (const void*)trunk_fwd, 512, LDS_BYTES) != hipSuccess || per_cu < 1) { fprintf(stderr, "kernel_launch: occupancy query says %d blocks per CU\n", per_cu); }
        (void)hipGetLastError();
        grid = cus;
        if (grid != 256) { fprintf(stderr, "kernel_launch: built for a 256-CU device, found %d CUs\n", cus); grid = -1; return; }
    }
    if (grid < 0) return;
    (void)hipMemsetAsync((char*)d_ws + WS_CTL, 0, CTL_ZERO_BYTES, stream);
    Args a{};
    for (int i = 0; i < 26; ++i) a.in[i] = d_in[i];
    a.out = (float*)d_out; a.ws = (unsigned char*)d_ws; a.pad = 0;
    if (MK_N_LAUNCHES == 1) {
        a.ph_lo = 0; a.ph_hi = NPHASE; a.use_bar = 1;
        hipLaunchKernelGGL(trunk_fwd, dim3(grid), dim3(512), LDS_BYTES, stream, a);
    } else {
        for (int p = 0; p < NPHASE; ++p) { a.ph_lo = p; a.ph_hi = p + 1; a.use_bar = 0; hipLaunchKernelGGL(trunk_fwd, dim3(grid), dim3(512), LDS_BYTES, stream, a); }
    }
}
```

```cpp
#include <hip/hip_runtime.h>
#include <cstdio>
#include <cstdint>
namespace pg8 {
#define PG8_LAS __attribute__((address_space(3)))
typedef unsigned short bf16_t;
typedef short bf16x8 __attribute__((ext_vector_type(8)));
typedef float f32x4 __attribute__((ext_vector_type(4)));
typedef unsigned u32x4 __attribute__((ext_vector_type(4)));
constexpr int BM = 256, BK = 64, HALF = 128, HTB = HALF * BK * 2  , STAGE_BYTES = 8 * HTB, NXCD = 8, WGM = 8;

__host__ __device__ __forceinline__ int lds_byte(int r, int c) { const int st = (r >> 4) * 2 + (c >> 5), rr = r & 15, cc = c & 31, ob = rr * 64 + cc * 2; return st * 1024 + (ob ^ (((ob >> 9) & 1) << 5)); }
__host__ __device__ __forceinline__ void stage_rc(int b, int& R, int& C) { const int st = b / 1024, sb = b % 1024, swz = sb ^ (((sb >> 9) & 1) << 5); R = (st >> 1) * 16 + swz / 64; C = (st & 1) * 32 + (swz % 64) / 2; }
__host__ __device__ __forceinline__ int perm32(int rho) { const int n = rho >> 4, i = rho & 15; return 8 * (i >> 2) + 4 * n + (i & 3); }

struct Unit { int pm, pn; };
struct Gemm { const bf16_t* A; const bf16_t* Bt; int M, N, K; };

struct StaticOrder {
    int nM, nN, nwg, G, c;
    __host__ __device__ void init(int M, int N, int G_, int c_) { nM = M / BM; nN = N / BM; nwg = nM * nN; G = G_; c = c_; }
    __host__ __device__ bool next(int i, Unit& u) const {
        const long L = (long)i * G + c; if (L >= nwg) return false;
        int wgid = (int)L; { const int q = nwg / NXCD, r = nwg % NXCD, xcd = wgid % NXCD, off = wgid / NXCD; wgid = (xcd < r ? xcd * (q + 1) : r * (q + 1) + (xcd - r) * q) + off; }
        const int nig = WGM * nN, gid = wgid / nig, fm = gid * WGM, gsz = (nM - fm) < WGM ? (nM - fm) : WGM;
        u.pm = fm + ((wgid % nig) % gsz); u.pn = (wgid % nig) / gsz; return true;
    }
    __device__ __forceinline__ void a_ready(const Unit&) const {}
    __device__ __forceinline__ void done(const Unit&) const {}
};

__device__ __forceinline__ unsigned cvt_pk_bf16(float lo, float hi) { unsigned r; asm volatile("v_cvt_pk_bf16_f32 %0, %1, %2" : "=v"(r) : "v"(lo), "v"(hi)); return r; }
typedef float f32x2 __attribute__((ext_vector_type(2)));
__device__ __forceinline__ f32x2 gelu_pk(f32x2 v) {
    const f32x2 av = __builtin_elementwise_abs(v), d = av * 0.2316418882f + 1.0f;
    f32x2 t; t.x = __builtin_amdgcn_rcpf(d.x); t.y = __builtin_amdgcn_rcpf(d.y);
    f32x2 q = t * 0.5307027145f + (-0.7265760135f); q = q * t + 0.7107068705f; q = q * t + (-0.142248368f); q = q * t + 0.127414796f; q = q * t;
    const f32x2 s = (v * v) * (-0.72134752044f);
    f32x2 e; e.x = __builtin_amdgcn_exp2f(s.x); e.y = __builtin_amdgcn_exp2f(s.y);
    const f32x2 m = v * (q * e), r = v - m;
    f32x2 o; o.x = v.x < 0.f ? m.x : r.x; o.y = v.y < 0.f ? m.y : r.y; return o;
}

template <int ACT  > struct EpiBf16 {
    static constexpr bool PERM = true, AFTER_DRAIN = false; static_assert(ACT == 0 || ACT == 1, "EpiBf16: ACT is 0 (none) or 1 (gelu_pk)");
    bf16_t* O; int ldc; const float* bias; int split_cols; size_t split_stride; float scale0;
    __device__ __forceinline__ void operator()(const f32x4 (&acc)[2][2][4][2], const Unit& u, int wr, int wc, int fr, int fq) const {
        const int row0 = u.pm * BM + wr * 64 + fr; int colt = u.pn * BM; bf16_t* base = O;
        float sc = 1.f; if (split_cols) { const int t = colt / split_cols; base += (size_t)t * split_stride; colt -= t * split_cols; if (t == 0) sc = scale0; }
        const int col0 = colt + wc * 32 + 8 * fq, bcol0 = u.pn * BM + wc * 32 + 8 * fq;
        f32x4 bv[2][2];
#pragma unroll
        for (int bj = 0; bj < 2; ++bj)
#pragma unroll
            for (int n = 0; n < 2; ++n) bv[bj][n] = bias ? *(const f32x4*)(bias + bcol0 + bj * HALF + 4 * n) : (f32x4){0.f, 0.f, 0.f, 0.f};
#pragma unroll
        for (int ai = 0; ai < 2; ++ai)
#pragma unroll
            for (int m = 0; m < 4; ++m) { bf16_t* rowp = base + (size_t)(row0 + ai * HALF + m * 16) * ldc + col0;
#pragma unroll
                for (int bj = 0; bj < 2; ++bj) { f32x4 v0 = acc[ai][bj][m][0] + bv[bj][0], v1 = acc[ai][bj][m][1] + bv[bj][1];
                    if (ACT == 1) { f32x2 a = gelu_pk((f32x2){v0[0], v0[1]}), b = gelu_pk((f32x2){v0[2], v0[3]}), c = gelu_pk((f32x2){v1[0], v1[1]}), d = gelu_pk((f32x2){v1[2], v1[3]});
                        v0 = (f32x4){a.x, a.y, b.x, b.y}; v1 = (f32x4){c.x, c.y, d.x, d.y}; }
                    v0 = v0 * sc; v1 = v1 * sc; u32x4 w; w.x = cvt_pk_bf16(v0[0], v0[1]); w.y = cvt_pk_bf16(v0[2], v0[3]); w.z = cvt_pk_bf16(v1[0], v1[1]); w.w = cvt_pk_bf16(v1[2], v1[3]);
                    *(u32x4*)(rowp + bj * HALF) = w; } }
    }
};

template <class Epi, class Sched, bool ALIGN_EPI = false, bool SP2 = false>
__device__ __forceinline__ void gemm_phase(PG8_LAS unsigned char* lds, const Gemm g, const Sched& S, const Epi& E) {
    const int tid = threadIdx.x, wid = __builtin_amdgcn_readfirstlane(tid >> 6), lane = tid & 63, wr = wid >> 2, wc = wid & 3, fr = lane & 15, fq = lane >> 4;
    const int K = g.K, nt = K / BK;
    unsigned voffA[2], voffB[2];
#pragma unroll
    for (int i = 0; i < 2; ++i) { int R, C; stage_rc(tid * 16 + i * 8192, R, C); const int Rb = Epi::PERM ? ((R & ~31) + perm32(R & 31)) : R;
        voffA[i] = (unsigned)(R * K + C) * 2u; voffB[i] = (unsigned)(Rb * K + C) * 2u; }
    const size_t kstep = (size_t)(BK * 2);
    const size_t hstep = (size_t)HALF * K * 2;
    const size_t tstep = 2 * hstep;
    const unsigned ldsw = (unsigned)wid * 1024u;
    const int aoff = lds_byte(wr * 64 + fr, fq * 8), boff = lds_byte(wc * 32 + fr, fq * 8);
#define PG8_SA(b, h) (((b) * 2 + (h)) * HTB)
#define PG8_SB(b, h) ((4 + (b) * 2 + (h)) * HTB)
#define PG8_STAGE(bufoff, gbase, voff) do { _Pragma("unroll") for (int _i = 0; _i < 2; ++_i) \
        __builtin_amdgcn_global_load_lds((const unsigned*)((const char*)(gbase) + (voff)[_i]), (PG8_LAS unsigned*)(lds + (bufoff) + ldsw + _i * 8192), 16, 0, 0); } while (0)
#define PG8_LDA(dst, b, h) do { _Pragma("unroll") for (int m = 0; m < 4; ++m) _Pragma("unroll") for (int k = 0; k < 2; ++k) dst[m][k] = *(const PG8_LAS bf16x8*)(lds + PG8_SA(b, h) + aoff + m * 2048 + k * 1024); } while (0)
#define PG8_LDB(dst, b, h) do { _Pragma("unroll") for (int n = 0; n < 2; ++n) _Pragma("unroll") for (int k = 0; k < 2; ++k) dst[n][k] = *(const PG8_LAS bf16x8*)(lds + PG8_SB(b, h) + boff + n * 2048 + k * 1024); } while (0)
#define PG8_MMA(ai, bj, At, Bt) do { __builtin_amdgcn_s_setprio(1); _Pragma("unroll") for (int m = 0; m < 4; ++m) _Pragma("unroll") for (int n = 0; n < 2; ++n) _Pragma("unroll") for (int k = 0; k < 2; ++k) \
        acc[ai][bj][m][n] = __builtin_amdgcn_mfma_f32_16x16x32_bf16(Bt[n][k], At[m][k], acc[ai][bj][m][n], 0, 0, 0); __builtin_amdgcn_s_setprio(0); } while (0)
#define PG8_WAIT_V(n) asm volatile("s_waitcnt vmcnt(" #n ")" ::: "memory")
#define PG8_WAIT_L(n) asm volatile("s_waitcnt lgkmcnt(" #n ")" ::: "memory")
#define PG8_BAR __builtin_amdgcn_s_barrier()
#define PG8_SCHED __builtin_amdgcn_sched_barrier(0)
    Unit cur, nxt; int ui = 0;
    if (!S.next(0, cur)) return;
    f32x4 acc[2][2][4][2];
#pragma unroll
    for (int a = 0; a < 2; ++a)
#pragma unroll
        for (int b = 0; b < 2; ++b)
#pragma unroll
            for (int m = 0; m < 4; ++m)
#pragma unroll
                for (int n = 0; n < 2; ++n) acc[a][b][m][n] = (f32x4){0.f, 0.f, 0.f, 0.f};
    bf16x8 At[4][2], B0[2][2], B1[2][2];
    const char* cA = (const char*)g.A + (size_t)cur.pm * tstep; const char* cB = (const char*)g.Bt + (size_t)cur.pn * tstep;
    S.a_ready(cur);
    if constexpr (SP2) {
        PG8_STAGE(PG8_SB(0, 0), cB, voffB); PG8_STAGE(PG8_SB(0, 1), cB + hstep, voffB); PG8_STAGE(PG8_SA(0, 0), cA, voffA); PG8_STAGE(PG8_SA(0, 1), cA + hstep, voffA);
        if (wr == 1) PG8_BAR;
        PG8_WAIT_V(2); PG8_BAR;
        PG8_STAGE(PG8_SB(1, 0), cB + kstep, voffB); PG8_STAGE(PG8_SA(1, 0), cA + kstep, voffA); PG8_STAGE(PG8_SB(1, 1), cB + hstep + kstep, voffB);
        PG8_WAIT_V(6); PG8_BAR;
    } else {
        PG8_STAGE(PG8_SB(0, 0), cB, voffB); PG8_STAGE(PG8_SA(0, 0), cA, voffA); PG8_STAGE(PG8_SB(0, 1), cB + hstep, voffB); PG8_STAGE(PG8_SA(0, 1), cA + hstep, voffA);
        if (wr == 1) PG8_BAR;
        PG8_WAIT_V(4); PG8_BAR;
        PG8_STAGE(PG8_SB(1, 0), cB + kstep, voffB); PG8_STAGE(PG8_SA(1, 0), cA + kstep, voffA); PG8_STAGE(PG8_SB(1, 1), cB + hstep + kstep, voffB);
        PG8_WAIT_V(6); PG8_BAR;
    }
    for (;;) {
        const bool has_next = S.next(ui + 1, nxt);
        const char* nA = has_next ? (const char*)g.A + (size_t)nxt.pm * tstep : cA; const char* nB = has_next ? (const char*)g.Bt + (size_t)nxt.pn * tstep : cB;
        for (int t = 0; t < nt; t += 2) {
            const bool last = (t == nt - 2);
            const char* a1 = cA + (size_t)(t + 1) * kstep;
            const char* a2 = last ? nA : cA + (size_t)(t + 2) * kstep; const char* b2 = last ? nB : cB + (size_t)(t + 2) * kstep;
            const char* a3 = a2 + kstep; const char* b3 = b2 + kstep;
            if (last && has_next) S.a_ready(nxt);
            if constexpr (SP2) {
            PG8_LDB(B0, 0, 0); PG8_LDB(B1, 0, 1); PG8_SCHED; PG8_LDA(At, 0, 0); PG8_STAGE(PG8_SA(1, 1), a1 + hstep, voffA);
            PG8_WAIT_V(8); PG8_WAIT_L(0); PG8_BAR; PG8_MMA(0, 0, At, B0); PG8_MMA(0, 1, At, B1); PG8_BAR; PG8_SCHED;
            PG8_LDA(At, 0, 1); PG8_STAGE(PG8_SB(0, 0), b2, voffB); PG8_STAGE(PG8_SB(0, 1), b2 + hstep, voffB); PG8_STAGE(PG8_SA(0, 0), a2, voffA);
            PG8_WAIT_V(8); PG8_WAIT_L(0); PG8_BAR; PG8_MMA(1, 0, At, B0); PG8_MMA(1, 1, At, B1); PG8_BAR; PG8_SCHED;
            PG8_LDB(B0, 1, 0); PG8_LDB(B1, 1, 1); PG8_SCHED; PG8_LDA(At, 1, 0); PG8_STAGE(PG8_SA(0, 1), a2 + hstep, voffA);
            PG8_WAIT_V(8); PG8_WAIT_L(0); PG8_BAR; PG8_MMA(0, 0, At, B0); PG8_MMA(0, 1, At, B1); PG8_BAR; PG8_SCHED;
            PG8_LDA(At, 1, 1); PG8_STAGE(PG8_SB(1, 0), b3, voffB); PG8_STAGE(PG8_SB(1, 1), b3 + hstep, voffB); PG8_STAGE(PG8_SA(1, 0), a3, voffA);
            PG8_WAIT_V(8); PG8_WAIT_L(0); PG8_BAR; PG8_MMA(1, 0, At, B0); PG8_MMA(1, 1, At, B1); PG8_BAR; PG8_SCHED;
            } else {
            PG8_LDB(B0, 0, 0); PG8_SCHED; PG8_LDA(At, 0, 0); PG8_STAGE(PG8_SA(1, 1), a1 + hstep, voffA);
            PG8_WAIT_L(8); PG8_BAR; PG8_WAIT_L(0); PG8_MMA(0, 0, At, B0); PG8_BAR; PG8_SCHED;
            PG8_LDB(B1, 0, 1); PG8_STAGE(PG8_SB(0, 0), b2, voffB);
            PG8_BAR; PG8_WAIT_L(0); PG8_MMA(0, 1, At, B1); PG8_BAR;
            PG8_LDA(At, 0, 1); PG8_STAGE(PG8_SA(0, 0), a2, voffA);
            PG8_BAR; PG8_WAIT_L(0); PG8_MMA(1, 0, At, B0); PG8_BAR; PG8_SCHED;
            PG8_STAGE(PG8_SB(0, 1), b2 + hstep, voffB);
            PG8_WAIT_V(6); PG8_BAR; PG8_MMA(1, 1, At, B1); PG8_BAR;
            PG8_LDB(B0, 1, 0); PG8_SCHED; PG8_LDA(At, 1, 0); PG8_STAGE(PG8_SA(0, 1), a2 + hstep, voffA);
            PG8_WAIT_L(8); PG8_BAR; PG8_WAIT_L(0); PG8_MMA(0, 0, At, B0); PG8_BAR; PG8_SCHED;
            PG8_LDB(B1, 1, 1); PG8_STAGE(PG8_SB(1, 0), b3, voffB);
            PG8_BAR; PG8_WAIT_L(0); PG8_MMA(0, 1, At, B1); PG8_BAR;
            PG8_LDA(At, 1, 1); PG8_STAGE(PG8_SA(1, 0), a3, voffA);
            PG8_BAR; PG8_WAIT_L(0); PG8_MMA(1, 0, At, B0); PG8_BAR; PG8_SCHED;
            PG8_STAGE(PG8_SB(1, 1), b3 + hstep, voffB);
            PG8_WAIT_V(6); PG8_BAR; PG8_MMA(1, 1, At, B1); PG8_BAR;
            }
        }
        if constexpr (ALIGN_EPI) { if (wr == 0) PG8_BAR; }
        if constexpr (!Epi::AFTER_DRAIN) { E(acc, cur, wr, wc, fr, fq); S.done(cur); }
        if (!has_next) break;
#pragma unroll
        for (int a = 0; a < 2; ++a)
#pragma unroll
            for (int b = 0; b < 2; ++b)
#pragma unroll
                for (int m = 0; m < 4; ++m)
#pragma unroll
                    for (int n = 0; n < 2; ++n) acc[a][b][m][n] = (f32x4){0.f, 0.f, 0.f, 0.f};
        cur = nxt; cA = nA; cB = nB; ++ui;
        if constexpr (ALIGN_EPI) { if (wr == 1) PG8_BAR; }
    }
    PG8_WAIT_V(0);
    if constexpr (!ALIGN_EPI) { if (wr == 0) PG8_BAR; }
    PG8_BAR;
    if constexpr (Epi::AFTER_DRAIN) { E.fused(acc, cur, wr, wc, fr, fq, lds, wid, lane); S.done(cur); }
#undef PG8_SA
#undef PG8_SB
#undef PG8_STAGE
#undef PG8_LDA
#undef PG8_LDB
#undef PG8_MMA
#undef PG8_WAIT_V
#undef PG8_WAIT_L
#undef PG8_BAR
#undef PG8_SCHED
}
}

#ifndef PG8_SP2
#define PG8_SP2 true
#endif

constexpr int NB = 2, SEQ = 8192, DM = 1024, NTOK = NB * SEQ;
constexpr int NPROJ = 3072;
constexpr int C_GQ = 0, C_GK = 256, C_GV = 512, C_GR = 1024, C_NQ = 1536, C_KC = 2048, C_VC = 2176, C_KS = 2304, C_VS = 2432, C_KW = 2560, C_VW = 2688, C_GLR = 2816, C_NG = 2832, C_END = 2856;
constexpr int SGW = 2048;
constexpr int NEXP = 16, EHID = 512;
constexpr int MOE_ROWS = 36864;
constexpr float NORM_EPS = 1e-6f;
constexpr float NEGBIG = -1e30f;

constexpr size_t MiB = 1u << 20;
constexpr size_t WS_CTL = 0, CTL_ZERO_BYTES = 1 * MiB;
constexpr size_t WS_MOD = 1 * MiB;
constexpr size_t WS_ROUTE = 2 * MiB;
constexpr size_t WS_GATES = 3 * MiB;
constexpr size_t WS_STATS = 5 * MiB;
constexpr size_t WS_DEC = 7 * MiB;
constexpr size_t WS_WIN = 8 * MiB;
constexpr size_t WS_WOUT = 14 * MiB;
constexpr size_t WS_WINC = 16 * MiB;
constexpr size_t WS_WOUTC = 24 * MiB;
constexpr size_t WS_WCW1 = 28 * MiB;
constexpr size_t WS_WGU = 30 * MiB;
constexpr size_t WS_WDN = 94 * MiB;
constexpr size_t WS_A = 126 * MiB;
constexpr size_t WS_O = 254 * MiB;
constexpr size_t WS_END = 318 * MiB;
constexpr size_t A_HID_OFF = 72 * MiB;
constexpr size_t DO_QN = 0;
constexpr size_t DO_KSEL = 16 * MiB, DO_VSEL = 20 * MiB, DO_KWIN = 24 * MiB, DO_VWIN = 28 * MiB;
constexpr size_t DO_KC = 32 * MiB, DO_VC = 36 * MiB + 65536;
constexpr size_t DO_KCMP = 41 * MiB, DO_VCMP = 41 * MiB + 512 * 1024;

constexpr int CW_TMO = 0, CW_CODE = 1;
constexpr int CW_BAR = 4096;
constexpr int CW_CNT = 16384;

constexpr int RING_OFF = 0, RING_BYTES = 131072;
constexpr int LDSCTL_OFF = RING_BYTES, MISC_OFF = LDSCTL_OFF + 320;
constexpr int TAB_OFF = LDSCTL_OFF + 1024;
constexpr int LDS_BYTES = 147456;

#define GAS __attribute__((address_space(1)))
#define LAS __attribute__((address_space(3)))
typedef unsigned short bf16;
typedef unsigned v4u __attribute__((ext_vector_type(4)));
typedef unsigned v2u __attribute__((ext_vector_type(2)));
typedef float f32x4 __attribute__((ext_vector_type(4)));
typedef float f32x2 __attribute__((ext_vector_type(2)));
typedef float f32x16 __attribute__((ext_vector_type(16)));
typedef short bf16x8 __attribute__((ext_vector_type(8)));
typedef short s16x4 __attribute__((ext_vector_type(4)));
typedef GAS unsigned gu32;
#define RLX_AGENT __ATOMIC_RELAXED, __HIP_MEMORY_SCOPE_AGENT
#define LDS_WAIT() asm volatile("s_waitcnt lgkmcnt(0)" ::: "memory")
#define VM_WAIT() asm volatile("s_waitcnt vmcnt(0)" ::: "memory")
__device__ __forceinline__ unsigned f2bf(float f) { unsigned u = __builtin_bit_cast(unsigned, f); return (u + 0x7fffu + ((u >> 16) & 1u)) >> 16; }
__device__ __forceinline__ unsigned pk2(float lo, float hi) { return f2bf(lo) | (f2bf(hi) << 16); }
__device__ __forceinline__ float bf2f(unsigned short b) { return __builtin_bit_cast(float, (unsigned)b << 16); }
__device__ __forceinline__ float bflo(unsigned w) { return __builtin_bit_cast(float, w << 16); }
__device__ __forceinline__ float bfhi(unsigned w) { return __builtin_bit_cast(float, w & 0xffff0000u); }
__device__ __forceinline__ float fexp2(float x) { return __builtin_amdgcn_exp2f(x); }
__device__ __forceinline__ float fexp(float x) { return __builtin_amdgcn_exp2f(x * 1.4426950408889634f); }
__device__ __forceinline__ float frcp(float x) { return __builtin_amdgcn_rcpf(x); }
__device__ __forceinline__ float sigmoidf_(float x) { return 1.0f / (1.0f + __expf(-x)); }
__device__ __forceinline__ float siluf_(float x) { return x / (1.0f + __expf(-x)); }
__device__ __forceinline__ float gelu_tanh(float x) {
    const float u = 0.7978845608028654f * (x + 0.044715f * x * x * x);
    return x / (1.0f + __expf(-2.0f * u));
}
__device__ __forceinline__ float wave_sum(float v) {
#pragma unroll
    for (int o = 1; o < 64; o <<= 1) v += __shfl_xor(v, o);
    return v;
}
__device__ __forceinline__ void unpack8(const v4u w, float (&f)[8]) {
    f[0] = bflo(w.x); f[1] = bfhi(w.x); f[2] = bflo(w.y); f[3] = bfhi(w.y); f[4] = bflo(w.z); f[5] = bfhi(w.z); f[6] = bflo(w.w); f[7] = bfhi(w.w);
}
__device__ __forceinline__ v4u pack8(const float (&f)[8]) { v4u w; w.x = pk2(f[0], f[1]); w.y = pk2(f[2], f[3]); w.z = pk2(f[4], f[5]); w.w = pk2(f[6], f[7]); return w; }

#define XB_TMO      128
#define XB_XCNT(j)  (256  + 64 * (j))
#define XB_XSUB(j)  (1280 + 64 * (j))
#define XB_XGEN(j)  (2304 + 64 * (j))
#define XB_TOP      3328
#define XB_TOPGEN   3392
#define XCD_BAR_WORDS 3456
#define XB_SPIN_CAP (1u << 18)

__device__ __forceinline__ unsigned xb_ld(unsigned* p)              { return __hip_atomic_load(p, __ATOMIC_RELAXED, __HIP_MEMORY_SCOPE_AGENT); }
__device__ __forceinline__ unsigned xb_add(unsigned* p, unsigned v) { return __hip_atomic_fetch_add(p, v, __ATOMIC_RELAXED, __HIP_MEMORY_SCOPE_AGENT); }
__device__ __forceinline__ unsigned xb_xcc_id() { return (unsigned)__builtin_amdgcn_s_getreg((3 << 11) | 20) & 0xFu; }
#define XB_SPIN(cond, bar) do { unsigned _sp = 0; while (cond) { __builtin_amdgcn_s_sleep(1); \
    if ((++_sp & 255u) == 0u) { if (xb_ld(&(bar)[XB_TMO])) break; if (_sp > XB_SPIN_CAP) { atomicAdd(&(bar)[XB_TMO], 1u); break; } } } } while (0)

struct XcdBarrier {
    unsigned* bar; unsigned x;
    volatile LAS unsigned* st;
};
__device__ __forceinline__ XcdBarrier xcd_barrier_post(unsigned* bar, volatile LAS unsigned* st) {
    XcdBarrier b; b.bar = bar; b.x = xb_xcc_id(); b.st = st;
    if (threadIdx.x == 0) (void)xb_add(&bar[XB_XCNT(b.x)], 1u);
    return b;
}
__device__ __forceinline__ void xcd_barrier_complete(unsigned* bar, unsigned x, unsigned& nloc, unsigned& nx) {
    const unsigned G = gridDim.x * gridDim.y * gridDim.z;
    unsigned sum, cnt, mine, sp = 0u;
    for (;;) {
        sum = 0u; cnt = 0u; mine = 0u;
#pragma unroll
        for (unsigned j = 0; j < 16; ++j) { const unsigned c = xb_ld(&bar[XB_XCNT(j)]); sum += c; cnt += (c > 0u) ? 1u : 0u; mine = (j == x) ? c : mine; }
        if (sum == G) break;
        __builtin_amdgcn_s_sleep(1);
        if ((++sp & 255u) == 0u) { if (xb_ld(&bar[XB_TMO])) break; if (sp > XB_SPIN_CAP) { atomicAdd(&bar[XB_TMO], 1u); break; } }
    }
    nloc = mine > 0u ? mine : 1u; nx = cnt > 0u ? cnt : 1u;
}
__device__ __forceinline__ void xcd_barrier(const XcdBarrier& b) {
    asm volatile("s_waitcnt vmcnt(0)" ::: "memory");
    __syncthreads();
    if (threadIdx.x == 0) {
        unsigned* bar = b.bar;
        __builtin_amdgcn_s_waitcnt(0);
        unsigned nloc = b.st[0], nx = b.st[1];
        if (nloc == 0u) { xcd_barrier_complete(bar, b.x, nloc, nx); b.st[0] = nloc; b.st[1] = nx; }
        const unsigned old = xb_add(&bar[XB_XSUB(b.x)], 1u);
        const unsigned gen = old / nloc;
        if (old + 1u == (gen + 1u) * nloc) {
            __builtin_amdgcn_fence(__ATOMIC_RELEASE, "agent");
            asm volatile("s_waitcnt vmcnt(0)" ::: "memory");
            const unsigned og = xb_add(&bar[XB_TOP], 1u);
            const unsigned tg = og / nx;
            if (og + 1u == (tg + 1u) * nx) xb_add(&bar[XB_TOPGEN], 1u);
            else XB_SPIN(xb_ld(&bar[XB_TOPGEN]) == tg, bar);
            __builtin_amdgcn_fence(__ATOMIC_ACQUIRE, "agent");
            xb_add(&bar[XB_XGEN(b.x)], 1u);
            asm volatile("s_waitcnt vmcnt(0)" ::: "memory");
        } else {
            XB_SPIN(xb_ld(&bar[XB_XGEN(b.x)]) == gen, bar);
            __builtin_amdgcn_fence(__ATOMIC_ACQUIRE, "agent");
            asm volatile("s_waitcnt vmcnt(0)" ::: "memory");
        }
    }
    __syncthreads();
}

struct Frame {
    LAS unsigned char* lds;
    volatile LAS unsigned* MISC;
    gu32* ctl;
    int tid, lane, wave;
    int bid, G;
    unsigned char* ws;
    unsigned char* dout_b;
    float* out;
    const float *x, *c, *w_ada, *b_ada, *norm_g, *w_in_ab, *w_out_ab, *gla_w2, *gla_bg, *gla_ng, *q_gain, *k_gain, *cmp_pe, *cmp_w1, *cmp_w2, *w_in_c, *sgu_ng, *sgu_ws, *sgu_bs, *w_out_c, *w_router, *r_bias, *w_gate, *w_up, *w_down;
    const int* positions;
};

struct EpiResid {
    static constexpr bool PERM = false, AFTER_DRAIN = false;
    const float* xin; float* xout; const float* gate;
    __device__ __forceinline__ void operator()(const pg8::f32x4 (&acc)[2][2][4][2], const pg8::Unit& u, int wr, int wc, int fr, int fq) const {
        const int row0 = u.pm * 256 + wr * 64 + fr, col0 = u.pn * 256 + wc * 32 + 4 * fq;
        const float* gb = gate + ((u.pm * 256 >= SEQ) ? 6144 : 0);
        f32x4 gv[2][2];
#pragma unroll
        for (int bj = 0; bj < 2; ++bj)
#pragma unroll
            for (int n = 0; n < 2; ++n) gv[bj][n] = *(const f32x4*)(gb + col0 + bj * 128 + n * 16);
#pragma unroll
        for (int ai = 0; ai < 2; ++ai)
#pragma unroll
            for (int m = 0; m < 4; ++m) {
                const size_t rb = (size_t)(row0 + ai * 128 + m * 16) * DM;
#pragma unroll
                for (int bj = 0; bj < 2; ++bj)
#pragma unroll
                    for (int n = 0; n < 2; ++n) {
                        const size_t p = rb + col0 + bj * 128 + n * 16;
                        const f32x4 xi = *(const f32x4*)(xin + p);
                        *(f32x4*)(xout + p) = xi + gv[bj][n] * acc[ai][bj][m][n];
                    }
            }
    }
};
struct EpiGeluStats {
    static constexpr bool PERM = true, AFTER_DRAIN = false;
    bf16* Z; float* stats;
    __device__ __forceinline__ void operator()(const pg8::f32x4 (&acc)[2][2][4][2], const pg8::Unit& u, int wr, int wc, int fr, int fq) const {
        const int row0 = u.pm * 256 + wr * 64 + fr, col0 = u.pn * 256 + wc * 32 + 8 * fq;
#pragma unroll
        for (int ai = 0; ai < 2; ++ai)
#pragma unroll
            for (int m = 0; m < 4; ++m) {
                const int row = row0 + ai * 128 + m * 16; float ss = 0.f;
#pragma unroll
                for (int bj = 0; bj < 2; ++bj) {
                    float g[8];
#pragma unroll
                    for (int n = 0; n < 2; ++n)
#pragma unroll
                        for (int i = 0; i < 4; ++i) { g[n * 4 + i] = gelu_tanh(acc[ai][bj][m][n][i]); ss += g[n * 4 + i] * g[n * 4 + i]; }
                    *(v4u*)(Z + (size_t)row * 4096 + col0 + bj * 128) = pack8(g);
                }
                if (u.pn >= 8) {
                    ss += __shfl_xor(ss, 16); ss += __shfl_xor(ss, 32);
                    if (fq == 0) stats[(size_t)row * 32 + (u.pn - 8) * 4 + wc] = ss;
                }
            }
    }
};
struct EpiMoeGU {
    static constexpr bool PERM = true, AFTER_DRAIN = false;
    bf16* HID;
    __device__ __forceinline__ void operator()(const pg8::f32x4 (&acc)[2][2][4][2], const pg8::Unit& u, int wr, int wc, int fr, int fq) const {
        const int row0 = u.pm * 256 + wr * 64 + fr, col0 = (u.pn & 3) * 128 + wc * 32 + 8 * fq;
#pragma unroll
        for (int ai = 0; ai < 2; ++ai)
#pragma unroll
            for (int m = 0; m < 4; ++m) {
                float h[8];
#pragma unroll
                for (int n = 0; n < 2; ++n)
#pragma unroll
                    for (int i = 0; i < 4; ++i) h[n * 4 + i] = siluf_(acc[ai][0][m][n][i]) * acc[ai][1][m][n][i];
                *(v4u*)(HID + (size_t)(row0 + ai * 128 + m * 16) * EHID + col0) = pack8(h);
            }
    }
};
struct EpiMoeDn {
    static constexpr bool PERM = true, AFTER_DRAIN = false;
    bf16* YM;
    __device__ __forceinline__ void operator()(const pg8::f32x4 (&acc)[2][2][4][2], const pg8::Unit& u, int wr, int wc, int fr, int fq) const {
        const int row0 = u.pm * 256 + wr * 64 + fr, col0 = (u.pn & 3) * 256 + wc * 32 + 8 * fq;
#pragma unroll
        for (int ai = 0; ai < 2; ++ai)
#pragma unroll
            for (int m = 0; m < 4; ++m)
#pragma unroll
                for (int bj = 0; bj < 2; ++bj) {
                    float h[8];
#pragma unroll
                    for (int n = 0; n < 2; ++n)
#pragma unroll
                        for (int i = 0; i < 4; ++i) h[n * 4 + i] = acc[ai][bj][m][n][i];
                    *(v4u*)(YM + (size_t)(row0 + ai * 128 + m * 16) * DM + col0 + bj * 128) = pack8(h);
                }
    }
};
struct MoeOrder {
    const LAS int* ppre; int G, c;
    __device__ __forceinline__ bool next(int i, pg8::Unit& u) const {
        const int L = i * G + c, np = ppre[16];
        if (L >= np * 4) return false;
        const int pm = L >> 2; int e = 0;
#pragma unroll
        for (int k = 1; k < 16; ++k) e += (ppre[k] <= pm) ? 1 : 0;
        u.pm = pm; u.pn = e * 4 + (L & 3); return true;
    }
    __device__ __forceinline__ void a_ready(const pg8::Unit&) const {}
    __device__ __forceinline__ void done(const pg8::Unit&) const {}
};

__device__ __forceinline__ int dest_row(int mode, int n) {
    if (mode == 1) return (n < 1024) ? n : (n < 1040) ? n + 1792 : (n < 2832) ? n - 16 : n;
    if (mode == 2) return (n >> 7) * 256 + (n & 127);
    if (mode == 3) return (n >> 7) * 256 + 128 + (n & 127);
    return n;
}
__device__ __forceinline__ void transpose_item(const float* W, int K, int N, bf16* WT, int mode, LAS unsigned char* scr  , int item, int lane) {
    const int nblk = (N + 63) / 64, kb = item / nblk, nb = item % nblk, k0 = 64 * kb, n0 = 64 * nb;
    const int q = lane & 15, r4 = lane >> 4, col = n0 + 4 * q;
    f32x4 va[8], vb[8];
    const float* wp = W + (size_t)(k0 + 2 * r4) * N + col;
#pragma unroll
    for (int i = 0; i < 8; ++i) {
        if (col < N) { va[i] = *(const f32x4*)(wp + (size_t)(8 * i) * N); vb[i] = *(const f32x4*)(wp + (size_t)(8 * i + 1) * N); }
        else { va[i] = (f32x4){0.f, 0.f, 0.f, 0.f}; vb[i] = va[i]; }
    }
#pragma unroll
    for (int i = 0; i < 8; ++i) {
        const int kp = 4 * i + r4;
        LAS unsigned* t = (LAS unsigned*)(scr + (4 * q) * 144 + 4 * kp);
        t[0] = pk2(va[i].x, vb[i].x); t[36] = pk2(va[i].y, vb[i].y); t[72] = pk2(va[i].z, vb[i].z); t[108] = pk2(va[i].w, vb[i].w);
    }
    LDS_WAIT(); asm volatile("" ::: "memory");
    const int c = lane & 7;
#pragma unroll
    for (int j = 0; j < 8; ++j) { const int n = (lane >> 3) + 8 * j;
        const v4u o = *(const LAS v4u*)(scr + n * 144 + 16 * c);
        if (n0 + n < N) *(GAS v4u*)(WT + (size_t)dest_row(mode, n0 + n) * K + k0 + 8 * c) = o; }
    LDS_WAIT(); asm volatile("" ::: "memory");
}
__device__ __forceinline__ void p0_prologue(Frame& F) {
    LAS float* red = (LAS float*)(F.lds + RING_OFF);
    float* mod = (float*)(F.ws + WS_MOD);
    float* bias1 = (float*)(F.ws + WS_MOD + 131072);
    for (int bi = F.bid; bi < 200; bi += F.G) {
        if (bi < 192) {
            const int l = bi / 96, cg = bi % 96, j = cg * 64 + F.lane;
            float a0 = 0.f, a1 = 0.f;
            const float* wp = F.w_ada + ((size_t)l * 1024 + F.wave * 128) * 6144 + j;
#pragma unroll 16
            for (int k = 0; k < 128; ++k) { const float wv = wp[(size_t)k * 6144]; const float c0 = F.c[F.wave * 128 + k], c1 = F.c[1024 + F.wave * 128 + k];
                a0 += siluf_(c0) * wv; a1 += siluf_(c1) * wv; }
            red[(F.wave * 2 + 0) * 64 + F.lane] = a0; red[(F.wave * 2 + 1) * 64 + F.lane] = a1;
            __syncthreads();
            if (F.tid < 128) { const int b = F.tid >> 6, ln = F.tid & 63; float s = 0.f;
#pragma unroll
                for (int w = 0; w < 8; ++w) s += red[(w * 2 + b) * 64 + ln];
                mod[(size_t)(l * 2 + b) * 6144 + cg * 64 + ln] = s + F.b_ada[l * 6144 + cg * 64 + ln]; }
            __syncthreads();
        } else {
            const int kv = (bi - 192) >> 2, cg = (bi - 192) & 3, j = cg * 64 + F.lane;
            float a0 = 0.f;
            const float* wp = F.cmp_w1 + ((size_t)kv * 2048 + F.wave * 256) * 256 + j; const float* pe = F.cmp_pe + kv * 2048 + F.wave * 256;
#pragma unroll 16
            for (int k = 0; k < 256; ++k) a0 += pe[k] * wp[(size_t)k * 256];
            red[F.wave * 64 + F.lane] = a0;
            __syncthreads();
            if (F.tid < 64) { float s = 0.f;
#pragma unroll
                for (int w = 0; w < 8; ++w) s += red[w * 64 + F.tid];
                bias1[kv * 256 + cg * 64 + F.tid] = s; }
            __syncthreads();
        }
    }
    { bf16* wi = (bf16*)(F.ws + WS_WIN); const int npieces = (NPROJ - C_END) * (DM / 8);
      for (int p = F.bid * 512 + F.tid; p < npieces; p += F.G * 512) *(GAS v4u*)(wi + (size_t)C_END * DM + (size_t)p * 8) = (v4u){0u, 0u, 0u, 0u}; }
    LAS unsigned char* scr = F.lds + RING_OFF + 8192 + F.wave * 12288;
    const int gw = F.bid * 8 + F.wave, NGW = F.G * 8;
    constexpr int I_IN = 16 * 45, I_OUT = 16 * 16, I_INC = 16 * 64, I_OUTC = 32 * 16, I_CW1 = 2 * 32 * 4, I_G = 32 * 128, I_U = 32 * 128, I_D = 32 * 128;
    constexpr int NITEMS = I_IN + I_OUT + I_INC + I_OUTC + I_CW1 + I_G + I_U + I_D;
    for (int it = gw; it < NITEMS; it += NGW) {
        int r = it; const float* src; bf16* dst; int K, N, mode = 0;
        if (r < I_IN) { src = F.w_in_ab; dst = (bf16*)(F.ws + WS_WIN); K = 1024; N = 2856; mode = 1; }
        else if ((r -= I_IN) < I_OUT) { src = F.w_out_ab; dst = (bf16*)(F.ws + WS_WOUT); K = 1024; N = 1024; }
        else if ((r -= I_OUT) < I_INC) { src = F.w_in_c; dst = (bf16*)(F.ws + WS_WINC); K = 1024; N = 4096; }
        else if ((r -= I_INC) < I_OUTC) { src = F.w_out_c; dst = (bf16*)(F.ws + WS_WOUTC); K = 2048; N = 1024; }
        else if ((r -= I_OUTC) < I_CW1) { const int m = r >> 7; r &= 127; src = F.cmp_w1 + (size_t)m * 2048 * 256; dst = (bf16*)(F.ws + WS_WCW1) + (size_t)m * 256 * 2048; K = 2048; N = 256; }
        else if ((r -= I_CW1) < I_G) { const int m = r >> 7; r &= 127; src = F.w_gate + (size_t)m * 1024 * 512; dst = (bf16*)(F.ws + WS_WGU) + (size_t)m * 1024 * 1024; K = 1024; N = 512; mode = 2; }
        else if ((r -= I_G) < I_U) { const int m = r >> 7; r &= 127; src = F.w_up + (size_t)m * 1024 * 512; dst = (bf16*)(F.ws + WS_WGU) + (size_t)m * 1024 * 1024; K = 1024; N = 512; mode = 3; }
        else { r -= I_U; const int m = r >> 7; r &= 127; src = F.w_down + (size_t)m * 512 * 1024; dst = (bf16*)(F.ws + WS_WDN) + (size_t)m * 1024 * 512; K = 512; N = 1024; }
        transpose_item(src, K, N, dst, mode, scr, r, F.lane);
    }
}

struct RouteRec { int e0, e1, pos0, pos1; float w0, w1; int slot0, slot1; };
template <bool COMBINE, bool NORM, bool ROUTE>
__device__ __forceinline__ void row_pass(Frame& F, const float* xin, const float* modn  , int sh_off, const float* ng,
                                         const float* modc  , int layer) {
    float* xout = F.out; bf16* H = (bf16*)(F.ws + WS_O);
    const bf16* YM = (const bf16*)(F.ws + WS_A);
    RouteRec* route = (RouteRec*)(F.ws + WS_ROUTE);
    LAS float* wr = (LAS float*)(F.lds + RING_OFF);
    LAS unsigned* lcnt = (LAS unsigned*)(F.lds + TAB_OFF + 256);
    if (ROUTE) {
        for (int idx = F.tid; idx < 16384; idx += 512) wr[(idx & 15) * 1024 + (idx >> 4)] = F.w_router[idx];
        if (F.tid < 32) lcnt[F.tid] = 0u;
        __syncthreads();
    }
    const int gw = F.bid * 8 + F.wave, NGW = F.G * 8;
#pragma unroll 1
    for (int b = 0; b < NB; ++b) {
        f32x4 cs[4], sh[4], gc[4];
#pragma unroll
        for (int j = 0; j < 4; ++j) {
            const int col = 4 * F.lane + 256 * j;
            if (NORM) { const f32x4 g = *(const f32x4*)(ng + col), sc = *(const f32x4*)(modn + b * 6144 + sh_off + 1024 + col); cs[j] = g * (sc + 1.0f); sh[j] = *(const f32x4*)(modn + b * 6144 + sh_off + col); }
            if (COMBINE) gc[j] = *(const f32x4*)(modc + b * 6144 + 5 * 1024 + col);
        }
#pragma unroll 1
        for (int m = b * SEQ + gw; m < (b + 1) * SEQ; m += NGW) {
            f32x4 v[4];
#pragma unroll
            for (int j = 0; j < 4; ++j) v[j] = *(const f32x4*)(xin + (size_t)m * DM + 4 * F.lane + 256 * j);
            if (COMBINE) {
                const RouteRec rr = route[m];
#pragma unroll
                for (int j = 0; j < 4; ++j) {
                    const v2u y0 = *(const v2u*)(YM + (size_t)rr.slot0 * DM + 4 * F.lane + 256 * j), y1 = *(const v2u*)(YM + (size_t)rr.slot1 * DM + 4 * F.lane + 256 * j);
                    f32x4 yy; yy.x = rr.w0 * bflo(y0.x) + rr.w1 * bflo(y1.x); yy.y = rr.w0 * bfhi(y0.x) + rr.w1 * bfhi(y1.x); yy.z = rr.w0 * bflo(y0.y) + rr.w1 * bflo(y1.y); yy.w = rr.w0 * bfhi(y0.y) + rr.w1 * bfhi(y1.y);
                    v[j] = v[j] + gc[j] * yy;
                    *(f32x4*)(xout + (size_t)m * DM + 4 * F.lane + 256 * j) = v[j];
                }
            }
            if (NORM) {
                float s = 0.f;
#pragma unroll
                for (int j = 0; j < 4; ++j) s += (v[j].x * v[j].x + v[j].y * v[j].y) + (v[j].z * v[j].z + v[j].w * v[j].w);
                const float rstd = 1.0f / sqrtf(wave_sum(s) * (1.0f / DM) + NORM_EPS);
#pragma unroll
                for (int j = 0; j < 4; ++j) { v[j] = v[j] * rstd * cs[j] + sh[j];
                    v2u o; o.x = pk2(v[j].x, v[j].y); o.y = pk2(v[j].z, v[j].w);
                    *(v2u*)(H + (size_t)m * DM + 4 * F.lane + 256 * j) = o; }
            }
            if (ROUTE) {
                float lg[16];
#pragma unroll
                for (int eg = 0; eg < 4; ++eg) {
                    float a4[4] = {0.f, 0.f, 0.f, 0.f};
#pragma unroll
                    for (int j = 0; j < 4; ++j)
#pragma unroll
                        for (int ee = 0; ee < 4; ++ee) { const f32x4 w = *(const LAS f32x4*)(wr + (eg * 4 + ee) * 1024 + 4 * F.lane + 256 * j); a4[ee] += (v[j].x * w.x + v[j].y * w.y) + (v[j].z * w.z + v[j].w * w.w); }
#pragma unroll
                    for (int ee = 0; ee < 4; ++ee) lg[eg * 4 + ee] = wave_sum(a4[ee]);
                    __builtin_amdgcn_sched_barrier(0);
                }
                float sc[16], sl[16];
#pragma unroll
                for (int e = 0; e < 16; ++e) { sc[e] = 1.0f / (1.0f + expf(-lg[e])); sl[e] = sc[e] + F.r_bias[e]; }
                float gs[4]; int ge1[4], ge2[4]; float gw1[4], gw2[4];
#pragma unroll
                for (int g = 0; g < 4; ++g) {
                    int i1 = 0; float m1 = sl[4 * g];
#pragma unroll
                    for (int k = 1; k < 4; ++k) if (sl[4 * g + k] > m1) { m1 = sl[4 * g + k]; i1 = k; }
                    int i2 = -1; float m2 = 0.f;
#pragma unroll
                    for (int k = 0; k < 4; ++k) if (k != i1 && (i2 < 0 || sl[4 * g + k] > m2)) { m2 = sl[4 * g + k]; i2 = k; }
                    gs[g] = m1 + m2; ge1[g] = 4 * g + i1; ge2[g] = 4 * g + i2;
                    float w1 = 0.f, w2 = 0.f;
#pragma unroll
                    for (int k = 0; k < 4; ++k) { w1 = (k == i1) ? sc[4 * g + k] : w1; w2 = (k == i2) ? sc[4 * g + k] : w2; }
                    gw1[g] = w1; gw2[g] = w2;
                }
                int gi = 0; float gm = gs[0];
#pragma unroll
                for (int g = 1; g < 4; ++g) if (gs[g] > gm) { gm = gs[g]; gi = g; }
                int e1 = ge1[0], e2 = ge2[0]; float w1 = gw1[0], w2 = gw2[0];
#pragma unroll
                for (int g = 1; g < 4; ++g) if (gi == g) { e1 = ge1[g]; e2 = ge2[g]; w1 = gw1[g]; w2 = gw2[g]; }
                const float ws_ = w1 + w2;
                if (F.lane == 0) {
                    RouteRec rr; rr.e0 = e1; rr.e1 = e2;
                    rr.pos0 = (int)__hip_atomic_fetch_add(lcnt + e1, 1u, __ATOMIC_RELAXED, __HIP_MEMORY_SCOPE_WORKGROUP);
                    rr.pos1 = (int)__hip_atomic_fetch_add(lcnt + e2, 1u, __ATOMIC_RELAXED, __HIP_MEMORY_SCOPE_WORKGROUP);
                    rr.w0 = w1 / ws_; rr.w1 = w2 / ws_; rr.slot0 = 0; rr.slot1 = 0;
                    route[m] = rr;
                }
            }
        }
    }
    if (ROUTE) {
        __syncthreads();
        if (F.tid < 16) { unsigned* cnt = (unsigned*)(F.ctl + CW_CNT + 1024 * layer + 64 * F.tid); lcnt[16 + F.tid] = atomicAdd(cnt, lcnt[F.tid]); }
        __syncthreads();
        if (F.lane == 0) {
#pragma unroll 1
            for (int m = gw; m < NTOK; m += NGW) { route[m].pos0 += (int)lcnt[16 + route[m].e0]; route[m].pos1 += (int)lcnt[16 + route[m].e1]; }
        }
    }
}

__device__ __forceinline__ void moe_tables(Frame& F, int layer) {
    LAS int* ppre = (LAS int*)(F.lds + TAB_OFF);
    if (F.tid == 0) { const unsigned* cnt = (const unsigned*)(F.ctl + CW_CNT + 1024 * layer); int acc = 0;
        for (int e = 0; e < 16; ++e) { ppre[e] = acc; acc += ((int)cnt[64 * e] + 255) >> 8; }
        ppre[16] = acc; }
    __syncthreads();
}
__device__ __forceinline__ void moe_gather(Frame& F, int layer) {
    moe_tables(F, layer);
    const LAS int* ppre = (const LAS int*)(F.lds + TAB_OFF);
    RouteRec* route = (RouteRec*)(F.ws + WS_ROUTE);
    const bf16* H = (const bf16*)(F.ws + WS_O); bf16* HS = (bf16*)(F.ws + WS_A);
    const int gw = F.bid * 8 + F.wave, NGW = F.G * 8;
    for (int m = gw; m < NTOK; m += NGW) {
        RouteRec rr = route[m];
        int p0 = 0, p1 = 0;
#pragma unroll
        for (int e = 0; e < 16; ++e) { p0 = (rr.e0 == e) ? ppre[e] : p0; p1 = (rr.e1 == e) ? ppre[e] : p1; }
        const int s0 = p0 * 256 + rr.pos0, s1 = p1 * 256 + rr.pos1;
        const v4u a = *(const v4u*)(H + (size_t)m * DM + 8 * F.lane), b = *(const v4u*)(H + (size_t)m * DM + 512 + 8 * F.lane);
        *(v4u*)(HS + (size_t)s0 * DM + 8 * F.lane) = a; *(v4u*)(HS + (size_t)s0 * DM + 512 + 8 * F.lane) = b;
        *(v4u*)(HS + (size_t)s1 * DM + 8 * F.lane) = a; *(v4u*)(HS + (size_t)s1 * DM + 512 + 8 * F.lane) = b;
        if (F.lane == 0) { route[m].slot0 = s0; route[m].slot1 = s1; }
    }
}

__device__ __forceinline__ f32x4 mma16(const LAS bf16* A, int lda, const LAS bf16* Bt, int ldb, int K, f32x4 acc, int lane) {
    const LAS bf16* ap = A + (lane & 15) * lda + (lane >> 4) * 8;
    const LAS bf16* bp = Bt + (lane & 15) * ldb + (lane >> 4) * 8;
    for (int k = 0; k < K; k += 32) {
        const bf16x8 a = *(const LAS bf16x8*)(ap + k), b = *(const LAS bf16x8*)(bp + k);
        acc = __builtin_amdgcn_mfma_f32_16x16x32_bf16(a, b, acc, 0, 0, 0);
    }
    return acc;
}

__device__ __forceinline__ void gla_bcum(Frame& F, const bf16* prow  , int h, float (&bc)[8]) {
    float gl[16];
    { const v4u a = *(const v4u*)(prow + C_GLR), b = *(const v4u*)(prow + C_GLR + 8); float t0[8], t1[8]; unpack8(a, t0); unpack8(b, t1);
#pragma unroll
      for (int i = 0; i < 8; ++i) { gl[i] = t0[i]; gl[8 + i] = t1[i]; } }
#pragma unroll
    for (int i = 0; i < 8; ++i) {
        const int col = h * 64 + F.wave * 8 + i;
        float z = F.gla_bg[col];
#pragma unroll
        for (int r = 0; r < 16; ++r) z += gl[r] * F.gla_w2[r * 256 + col];
        const float ls = fminf(z, 0.f) - log1pf(__expf(-fabsf(z)));
        float v = ls * (1.0f / 16.0f);
#pragma unroll
        for (int off = 1; off < 64; off <<= 1) { const float o = __shfl_up(v, off); v += (F.lane >= off) ? o : 0.f; }
        bc[i] = v;
    }
}
__device__ __forceinline__ void gla_stage_vT(Frame& F, const bf16* prow, int h, LAS bf16* VT) {
    const v4u a = *(const v4u*)(prow + C_GV + h * 128 + F.wave * 16), b = *(const v4u*)(prow + C_GV + h * 128 + F.wave * 16 + 8);
    const unsigned w[8] = {a.x, a.y, a.z, a.w, b.x, b.y, b.z, b.w};
#pragma unroll
    for (int i = 0; i < 8; ++i) { VT[(F.wave * 16 + 2 * i) * 72 + F.lane] = (bf16)(w[i] & 0xffffu); VT[(F.wave * 16 + 2 * i + 1) * 72 + F.lane] = (bf16)(w[i] >> 16); }
}
__device__ __forceinline__ void gla_prep_item(Frame& F, int item) {
    const int h = item & 3, n = (item >> 2) & 127, b = item >> 9;
    const bf16* proj = (const bf16*)(F.ws + WS_A);
    const bf16* prow = proj + (size_t)(b * SEQ + n * 64 + F.lane) * NPROJ;
    LAS bf16* KT = (LAS bf16*)(F.lds + RING_OFF);
    LAS bf16* VT = (LAS bf16*)(F.lds + RING_OFF + 9216);
    float bc[8]; gla_bcum(F, prow, h, bc);
    float kf[8]; { const v4u kk = *(const v4u*)(prow + C_GK + h * 64 + F.wave * 8); unpack8(kk, kf); }
    float* DEC = (float*)(F.ws + WS_DEC) + ((size_t)(b * 128 + n) * 4 + h) * 64;
#pragma unroll
    for (int i = 0; i < 8; ++i) {
        const float bl = __shfl(bc[i], 63);
        KT[(F.wave * 8 + i) * 72 + F.lane] = (bf16)f2bf(kf[i] * __expf(bl - bc[i]));
        if (F.lane == 63) DEC[F.wave * 8 + i] = __expf(bl);
    }
    gla_stage_vT(F, prow, h, VT);
    __syncthreads();
    float* KV = (float*)(F.ws + WS_O) + ((size_t)(b * 128 + n) * 4 + h) * 8192;
    const int dt = F.wave >> 1;
#pragma unroll
    for (int j = 0; j < 4; ++j) {
        const int et = (F.wave & 1) * 4 + j;
        f32x4 acc = {0.f, 0.f, 0.f, 0.f};
        acc = mma16(KT + dt * 16 * 72, 72, VT + et * 16 * 72, 72, 64, acc, F.lane);
#pragma unroll
        for (int i = 0; i < 4; ++i) KV[(dt * 16 + 4 * (F.lane >> 4) + i) * 128 + et * 16 + (F.lane & 15)] = acc[i];
    }
    __syncthreads();
}
__device__ __forceinline__ void gla_scan(Frame& F, int gidx) {
    const int bh = gidx >> 13, de = gidx & 8191, b = bh >> 2, h = bh & 3;
    float* KV = (float*)(F.ws + WS_O) + ((size_t)(b * 128) * 4 + h) * 8192 + de;
    const float* DEC = (const float*)(F.ws + WS_DEC) + ((size_t)(b * 128) * 4 + h) * 64 + (de >> 7);
    float st = 0.f;
#pragma unroll 1
    for (int n0 = 0; n0 < 128; n0 += 8) {
        float kv[8], dc[8];
#pragma unroll
        for (int i = 0; i < 8; ++i) { kv[i] = KV[(size_t)(n0 + i) * 4 * 8192]; dc[i] = DEC[(size_t)(n0 + i) * 4 * 64]; }
#pragma unroll
        for (int i = 0; i < 8; ++i) { KV[(size_t)(n0 + i) * 4 * 8192] = st; st = dc[i] * st + kv[i]; }
    }
}
__device__ __forceinline__ void gla_out_item(Frame& F, int item) {
    const int h = item & 3, n = (item >> 2) & 127, b = item >> 9;
    const bf16* proj = (const bf16*)(F.ws + WS_A);
    const size_t tok = (size_t)b * SEQ + n * 64 + F.lane;
    const bf16* prow = proj + tok * NPROJ;
    LAS bf16* A1 = (LAS bf16*)(F.lds + RING_OFF);
    LAS bf16* B1 = (LAS bf16*)(F.lds + RING_OFF + 9216);
    LAS bf16* A2 = (LAS bf16*)(F.lds + RING_OFF + 18432);
    LAS bf16* SC = (LAS bf16*)(F.lds + RING_OFF + 27648);
    LAS bf16* VT = (LAS bf16*)(F.lds + RING_OFF + 36864);
    LAS bf16* ST = (LAS bf16*)(F.lds + RING_OFF + 55296);
    LAS float* OS = (LAS float*)(F.lds + RING_OFF + 73728);
    float bc[8]; gla_bcum(F, prow, h, bc);
    float qf[8], kf[8];
    { const v4u qq = *(const v4u*)(prow + C_GQ + h * 64 + F.wave * 8), kk = *(const v4u*)(prow + C_GK + h * 64 + F.wave * 8); unpack8(qq, qf); unpack8(kk, kf); }
    float a1[8], b1[8], a2[8];
#pragma unroll
    for (int i = 0; i < 8; ++i) {
        const float bm = __shfl(bc[i], 32);
        a1[i] = qf[i] * 0.125f * __expf(bc[i] - bm); b1[i] = kf[i] * __expf(bm - bc[i]); a2[i] = qf[i] * 0.125f * __expf(bc[i]);
    }
    *(LAS v4u*)(A1 + F.lane * 72 + F.wave * 8) = pack8(a1);
    *(LAS v4u*)(B1 + F.lane * 72 + F.wave * 8) = pack8(b1);
    *(LAS v4u*)(A2 + F.lane * 72 + F.wave * 8) = pack8(a2);
    gla_stage_vT(F, prow, h, VT);
    { const float* KV = (const float*)(F.ws + WS_O) + ((size_t)(b * 128 + n) * 4 + h) * 8192;
#pragma unroll
      for (int k = 0; k < 16; ++k) { const int p = F.tid + 512 * k, e = p & 127, d = p >> 7; ST[e * 72 + d] = (bf16)f2bf(KV[d * 128 + e]); } }
    __syncthreads();
    const int it = F.wave >> 1;
#pragma unroll
    for (int jj = 0; jj < 2; ++jj) {
        const int jt = (F.wave & 1) * 2 + jj;
        f32x4 acc = {0.f, 0.f, 0.f, 0.f};
        if (jt <= it) acc = mma16(A1 + it * 16 * 72, 72, B1 + jt * 16 * 72, 72, 64, acc, F.lane);
#pragma unroll
        for (int i = 0; i < 4; ++i) { const int ri = it * 16 + 4 * (F.lane >> 4) + i, cj = jt * 16 + (F.lane & 15); SC[ri * 72 + cj] = (bf16)f2bf((cj <= ri) ? acc[i] : 0.f); }
    }
    __syncthreads();
#pragma unroll
    for (int j = 0; j < 4; ++j) {
        const int et = (F.wave & 1) * 4 + j;
        f32x4 acc = {0.f, 0.f, 0.f, 0.f};
        acc = mma16(SC + it * 16 * 72, 72, VT + et * 16 * 72, 72, 64, acc, F.lane);
        acc = mma16(A2 + it * 16 * 72, 72, ST + et * 16 * 72, 72, 64, acc, F.lane);
#pragma unroll
        for (int i = 0; i < 4; ++i) OS[(it * 16 + 4 * (F.lane >> 4) + i) * 132 + et * 16 + (F.lane & 15)] = acc[i];
    }
    __syncthreads();
    { const int row = F.tid >> 3, c0 = (F.tid & 7) * 16;
      float v[16]; float ss = 0.f;
#pragma unroll
      for (int i = 0; i < 16; ++i) { v[i] = OS[row * 132 + c0 + i]; ss += v[i] * v[i]; }
      ss += __shfl_xor(ss, 1); ss += __shfl_xor(ss, 2); ss += __shfl_xor(ss, 4);
      const float rstd = 1.0f / sqrtf(ss * (1.0f / 128.0f) + NORM_EPS);
      const size_t tk = (size_t)b * SEQ + n * 64 + row;
      const bf16* rrow = proj + tk * NPROJ + C_GR + h * 128 + c0;
      float r0[8], r1[8]; unpack8(*(const v4u*)rrow, r0); unpack8(*(const v4u*)(rrow + 8), r1);
      float o0[8], o1[8];
#pragma unroll
      for (int i = 0; i < 8; ++i) { o0[i] = v[i] * rstd * F.gla_ng[c0 + i] * siluf_(r0[i]); o1[i] = v[8 + i] * rstd * F.gla_ng[c0 + 8 + i] * siluf_(r1[i]); }
      bf16* orow = (bf16*)(F.ws + WS_O + 32 * MiB) + tk * DM + h * 128 + c0;
      *(v4u*)orow = pack8(o0); *(v4u*)(orow + 8) = pack8(o1); }
    __syncthreads();
}

__device__ __forceinline__ double inv_freq_d(int i) {
    return (i == 0) ? 1.0 : (i == 1) ? 0.19392547740471268 : (i == 2) ? 0.037606090787015346 : (i == 3) ? 0.0072927791106285765 :
           (i == 4) ? 0.0014142135623730951 : (i == 5) ? 0.00027425197177757796 : (i == 6) ? 5.318404375373266e-05 : 1.0313741203148838e-05;
}
__device__ __forceinline__ void rope_sincos(int pos, int i, float& cs, float& sn) {
    const double rev = (double)pos * inv_freq_d(i) * 0.15915494309189535;
    const float fr = (float)(rev - rint(rev));
    cs = __builtin_amdgcn_cosf(fr); sn = __builtin_amdgcn_sinf(fr);
}
__device__ __forceinline__ void nsa_prep_token(Frame& F, int tok) {
    const int b = tok >> 13, t = tok & 8191, sub = F.lane & 7, vid = F.lane >> 3;
    const bf16* prow = (const bf16*)(F.ws + WS_A) + (size_t)tok * NPROJ;
    const int pos = F.positions[tok];
    float cs_l, sn_l; rope_sincos(pos, sub, cs_l, sn_l);
    float cs[8], sn[8];
#pragma unroll
    for (int i = 0; i < 8; ++i) { cs[i] = __shfl(cs_l, (F.lane & ~7) + i); sn[i] = __shfl(sn_l, (F.lane & ~7) + i); }
    unsigned char* dob = F.dout_b;
    const size_t ktile_off = (size_t)(t >> 6) * 8192 + sub * 1024 + (t & 63) * 16;
    const size_t vtile_off = (size_t)(t >> 6) * 8192 + (sub >> 2) * 4096 + (t & 63) * 64 + (sub & 3) * 16;
#pragma unroll
    for (int round = 0; round < 3; ++round) {
        int col; int kind; unsigned char* dst; const float* gain = nullptr;
        if (round == 0) { col = C_NQ + vid * 64; kind = 0; gain = F.q_gain; const int g = vid >> 2, hh = vid & 3;
            dst = dob + DO_QN + ((((size_t)(b * 2 + g) * SEQ + t) * 4 + hh) * 64 + sub * 8) * 2; }
        else if (round == 1) {
            const int g = vid & 1, which = vid >> 1;
            const size_t img = (size_t)(b * 2 + g) * (1u << 20);
            if (which == 0) { col = C_KS + g * 64; kind = 1; gain = F.k_gain + 64; dst = dob + DO_KSEL + img + ktile_off; }
            else if (which == 1) { col = C_KW + g * 64; kind = 1; gain = F.k_gain + 128; dst = dob + DO_KWIN + img + ktile_off; }
            else if (which == 2) { col = C_VS + g * 64; kind = 2; dst = dob + DO_VSEL + img + vtile_off; }
            else { col = C_VW + g * 64; kind = 2; dst = dob + DO_VWIN + img + vtile_off; }
        } else {
            const int g = vid & 1, which = (vid >> 1) & 1;
            col = (which ? C_VC : C_KC) + g * 64; kind = 2;
            dst = dob + (which ? DO_VC : DO_KC) + (((size_t)(b * 2 + g) * SEQ + t) * 64 + sub * 8) * 2;
        }
        float x[8]; unpack8(*(const v4u*)(prow + col + sub * 8), x);
        if (kind != 2) {
            float ss = 0.f;
#pragma unroll
            for (int i = 0; i < 8; ++i) ss += x[i] * x[i];
            ss += __shfl_xor(ss, 1); ss += __shfl_xor(ss, 2); ss += __shfl_xor(ss, 4);
            const float rstd = 1.0f / sqrtf(ss * (1.0f / 64.0f) + NORM_EPS);
#pragma unroll
            for (int i = 0; i < 8; ++i) x[i] = x[i] * rstd * gain[sub * 8 + i];
            float xo[8];
#pragma unroll
            for (int i = 0; i < 8; ++i) xo[i] = __shfl_xor(x[i], 1);
            if (sub == 0) {
#pragma unroll
                for (int i = 0; i < 8; ++i) x[i] = x[i] * cs[i] - xo[i] * sn[i];
            } else if (sub == 1) {
#pragma unroll
                for (int i = 0; i < 8; ++i) x[i] = x[i] * cs[i] + xo[i] * sn[i];
            }
            if (kind == 0) {
#pragma unroll
                for (int i = 0; i < 8; ++i) x[i] *= 0.125f * 1.4426950408889634f;
            }
        }
        if (round < 2 || F.lane < 32) *(v4u*)dst = pack8(x);
    }
    if (F.lane < 24) { float* gt = (float*)(F.ws + WS_GATES) + (size_t)tok * 24; gt[F.lane] = sigmoidf_(bf2f(prow[C_NG + F.lane])); }
}

__device__ __forceinline__ void nsa_compress_item(Frame& F, int item) {
    const int kv = item >> 6, b = (item >> 5) & 1, g = (item >> 4) & 1, rt = item & 15, n0 = rt * 32;
    const bf16* Asrc = (const bf16*)(F.dout_b + (kv ? DO_VC : DO_KC)) + ((size_t)(b * 2 + g) * SEQ + 16 * n0) * 64;
    const bf16* Bsrc = (const bf16*)(F.ws + WS_WCW1) + (size_t)kv * 256 * 2048;
    LAS bf16* As = (LAS bf16*)(F.lds + RING_OFF);
    LAS bf16* Bs = (LAS bf16*)(F.lds + RING_OFF + 2 * 32 * 72 * 2);
    LAS float* Hs = (LAS float*)(F.lds + RING_OFF + 86016);
    LAS float* W2s = (LAS float*)(F.lds + RING_OFF);
    const int ar = F.tid >> 3, ac = (F.tid & 7) * 8;
    v4u areg = {0u, 0u, 0u, 0u}, breg[4];
#define CMP_GLOAD(kc) do { if (F.tid < 256) areg = *(const v4u*)(Asrc + (size_t)ar * 1024 + (kc) * 64 + ac); \
        _Pragma("unroll") for (int i_ = 0; i_ < 4; ++i_) { const int p_ = F.tid + 512 * i_, br_ = p_ >> 3, bc_ = (p_ & 7) * 8; breg[i_] = *(const v4u*)(Bsrc + (size_t)br_ * 2048 + (kc) * 64 + bc_); } } while (0)
#define CMP_LSTORE(buf) do { if (F.tid < 256) *(LAS v4u*)(As + (buf) * 32 * 72 + ar * 72 + ac) = areg; \
        _Pragma("unroll") for (int i_ = 0; i_ < 4; ++i_) { const int p_ = F.tid + 512 * i_, br_ = p_ >> 3, bc_ = (p_ & 7) * 8; *(LAS v4u*)(Bs + (buf) * 256 * 72 + br_ * 72 + bc_) = breg[i_]; } } while (0)
    f32x4 acc[2][2];
#pragma unroll
    for (int mt = 0; mt < 2; ++mt)
#pragma unroll
        for (int nt = 0; nt < 2; ++nt) acc[mt][nt] = (f32x4){0.f, 0.f, 0.f, 0.f};
    CMP_GLOAD(0); CMP_LSTORE(0); __syncthreads();
#pragma unroll 1
    for (int kc = 0; kc < 32; ++kc) {
        const int buf = kc & 1;
        if (kc + 1 < 32) CMP_GLOAD(kc + 1);
#pragma unroll
        for (int mt = 0; mt < 2; ++mt)
#pragma unroll
            for (int nt = 0; nt < 2; ++nt)
                acc[mt][nt] = mma16(As + buf * 32 * 72 + mt * 16 * 72, 72, Bs + buf * 256 * 72 + (F.wave * 32 + nt * 16) * 72, 72, 64, acc[mt][nt], F.lane);
        if (kc + 1 < 32) CMP_LSTORE(buf ^ 1);
        __syncthreads();
    }
    const float* bias1 = (const float*)(F.ws + WS_MOD + 131072) + kv * 256;
#pragma unroll
    for (int mt = 0; mt < 2; ++mt)
#pragma unroll
        for (int nt = 0; nt < 2; ++nt) { const int col = F.wave * 32 + nt * 16 + (F.lane & 15);
#pragma unroll
            for (int i = 0; i < 4; ++i) Hs[(mt * 16 + 4 * (F.lane >> 4) + i) * 260 + col] = gelu_tanh(acc[mt][nt][i] + bias1[col]); }
    { const float* w2 = F.cmp_w2 + (size_t)kv * 256 * 64;
#pragma unroll
      for (int i = 0; i < 8; ++i) *(LAS f32x4*)(W2s + (F.tid + 512 * i) * 4) = *(const f32x4*)(w2 + (size_t)(F.tid + 512 * i) * 4); }
    __syncthreads();
    const int r = F.tid >> 4, dq = F.tid & 15;
    f32x4 o = {0.f, 0.f, 0.f, 0.f};
#pragma unroll 8
    for (int j = 0; j < 256; ++j) { const float hv = Hs[r * 260 + j]; const f32x4 w = *(const LAS f32x4*)(W2s + j * 64 + 4 * dq); o = o + w * hv; }
    const int n = n0 + r;
    if (kv == 0) {
        float ss = (o.x * o.x + o.y * o.y) + (o.z * o.z + o.w * o.w);
        ss += __shfl_xor(ss, 1); ss += __shfl_xor(ss, 2); ss += __shfl_xor(ss, 4); ss += __shfl_xor(ss, 8);
        const float rstd = 1.0f / sqrtf(ss * (1.0f / 64.0f) + NORM_EPS);
        const f32x4 gn = *(const f32x4*)(F.k_gain + 4 * dq);
        o = o * rstd * gn;
        const int tlast = (16 * n + 31 < SEQ) ? 16 * n + 31 : SEQ - 1;
        const int pos = F.positions[b * SEQ + tlast];
        f32x4 po; po.x = __shfl_xor(o.x, 2); po.y = __shfl_xor(o.y, 2); po.z = __shfl_xor(o.z, 2); po.w = __shfl_xor(o.w, 2);
        if (dq < 4) {
            const int i0 = 4 * (dq & 1);
            float c0, s0, c1, s1, c2, s2, c3, s3;
            rope_sincos(pos, i0, c0, s0); rope_sincos(pos, i0 + 1, c1, s1); rope_sincos(pos, i0 + 2, c2, s2); rope_sincos(pos, i0 + 3, c3, s3);
            if (dq < 2) { o.x = o.x * c0 - po.x * s0; o.y = o.y * c1 - po.y * s1; o.z = o.z * c2 - po.z * s2; o.w = o.w * c3 - po.w * s3; }
            else { o.x = o.x * c0 + po.x * s0; o.y = o.y * c1 + po.y * s1; o.z = o.z * c2 + po.z * s2; o.w = o.w * c3 + po.w * s3; }
        }
    }
    if (n == 511) o = (f32x4){0.f, 0.f, 0.f, 0.f};
    v2u pk; pk.x = pk2(o.x, o.y); pk.y = pk2(o.z, o.w);
    const int c = dq >> 1;
    unsigned char* img = F.dout_b + (kv ? DO_VCMP : DO_KCMP) + (size_t)(b * 2 + g) * 65536 + (size_t)(n >> 6) * 8192;
    if (kv == 0) *(v2u*)(img + c * 1024 + (n & 63) * 16 + (dq & 1) * 8) = pk;
    else *(v2u*)(img + (c >> 2) * 4096 + (n & 63) * 64 + (c & 3) * 16 + (dq & 1) * 8) = pk;
    __syncthreads();
}

constexpr int NSA_KB = 0, NSA_VB = 16384, NSA_IMP = 32768, NSA_SELM = 65536;
__device__ __forceinline__ int crow(int r, int hi) { return (r & 3) + 8 * (r >> 2) + 4 * hi; }
__device__ __forceinline__ s16x4 ds_tr16(const LAS unsigned char* p) { return __builtin_bit_cast(s16x4, __builtin_amdgcn_ds_read_tr16_b64_v4i16((LAS s16x4*)p)); }

template <int MODE>
__device__ __forceinline__ void nsa_branch(Frame& F, const unsigned char* Kimg, const unsigned char* Vimg, int kt0, int kt1, const bf16x8 (&qr)[4],
                                           float& m, float& l, f32x16 (&o)[2], int t, int tw0, int nv, int nvw,
                                           unsigned mk0, unsigned mk1, unsigned mk2, unsigned mk3, unsigned wo0, unsigned wo1, unsigned wo2, unsigned wo3,
                                           float inv_l, LAS float* impw) {
    const int r32 = F.lane & 31, hi = F.lane >> 5, tokl = r32 >> 2;
    LAS unsigned char* KB = F.lds + RING_OFF + NSA_KB; LAS unsigned char* VB = F.lds + RING_OFF + NSA_VB;
    const v4u* kg = (const v4u*)Kimg + F.tid; const v4u* vg = (const v4u*)Vimg + F.tid;
    v4u kreg = kg[(size_t)kt0 * 512], vreg = {0u, 0u, 0u, 0u};
    if (MODE != 0) vreg = vg[(size_t)kt0 * 512];
    *(LAS v4u*)(KB + F.tid * 16) = kreg; if (MODE != 0) *(LAS v4u*)(VB + F.tid * 16) = vreg;
    __syncthreads();
#pragma unroll 1
    for (int kt = kt0; kt < kt1; ++kt) {
        const int buf = (kt - kt0) & 1; const bool has_next = kt + 1 < kt1;
        if (has_next) { kreg = kg[(size_t)(kt + 1) * 512]; if (MODE != 0) vreg = vg[(size_t)(kt + 1) * 512]; }
        const LAS unsigned char* Kb = KB + buf * 8192; const LAS unsigned char* Vb = VB + buf * 8192;
        bool need;
        if (MODE <= 1) need = kt * 64 < nvw;
        else if (MODE == 2) { const unsigned w = (kt < 32) ? wo0 : (kt < 64) ? wo1 : (kt < 96) ? wo2 : wo3; need = (w >> (kt & 31)) & 1u; }
        else need = (kt * 64 <= tw0 + 7) && (kt * 64 + 63 + 512 > tw0);
        bool selbit = true;
        if (MODE == 2) { const unsigned w = (kt < 32) ? mk0 : (kt < 64) ? mk1 : (kt < 96) ? mk2 : mk3; selbit = (w >> (kt & 31)) & 1u; }
        if (need) {
#pragma unroll 1
            for (int kb = 0; kb < 2; ++kb) {
                const int key0 = kt * 64 + kb * 32;
                f32x16 p = {0.f, 0.f, 0.f, 0.f, 0.f, 0.f, 0.f, 0.f, 0.f, 0.f, 0.f, 0.f, 0.f, 0.f, 0.f, 0.f};
#pragma unroll
                for (int d0 = 0; d0 < 4; ++d0) {
                    const bf16x8 kf = *(const LAS bf16x8*)(Kb + (2 * d0 + hi) * 1024 + (32 * kb + r32) * 16);
                    p = __builtin_amdgcn_mfma_f32_32x32x16_bf16(kf, qr[d0], p, 0, 0, 0);
                }
                float pe[16];
                if (MODE == 1) {
#pragma unroll
                    for (int r = 0; r < 16; ++r) { const int key = key0 + crow(r, hi); pe[r] = (key < nv) ? fexp2(p[r] - m) * inv_l : 0.f; }
#pragma unroll
                    for (int rg = 0; rg < 4; ++rg) {
                        float a = (pe[4 * rg] + pe[4 * rg + 1]) + (pe[4 * rg + 2] + pe[4 * rg + 3]), sp = pe[4 * rg + 3];
                        a += __shfl_xor(a, 1); a += __shfl_xor(a, 2); sp += __shfl_xor(sp, 1); sp += __shfl_xor(sp, 2);
                        if ((r32 & 3) == 0) { const int jp = (key0 >> 2) + 2 * rg + hi;
                            __hip_atomic_fetch_add(impw + tokl * 128 + jp, a, __ATOMIC_RELAXED, __HIP_MEMORY_SCOPE_WORKGROUP);
                            if (jp + 1 < 128) __hip_atomic_fetch_add(impw + tokl * 128 + jp + 1, sp, __ATOMIC_RELAXED, __HIP_MEMORY_SCOPE_WORKGROUP); }
                    }
                } else {
                    float mx = NEGBIG;
#pragma unroll
                    for (int r = 0; r < 16; ++r) {
                        const int key = key0 + crow(r, hi); bool ok;
                        if (MODE == 0) ok = key < nv;
                        else if (MODE == 2) ok = selbit && (kt < (t >> 6) || key <= t);
                        else ok = (key <= t) && (key + 512 > t);
                        p[r] = ok ? p[r] : NEGBIG; mx = fmaxf(mx, p[r]);
                    }
                    mx = fmaxf(mx, __shfl_xor(mx, 32));
                    const float mn = fmaxf(m, mx), alpha = fexp2(m - mn);
                    float ps = 0.f;
#pragma unroll
                    for (int r = 0; r < 16; ++r) { pe[r] = (p[r] > -1e29f) ? fexp2(p[r] - mn) : 0.f; ps += pe[r]; }
                    l = l * alpha + ps; m = mn;
                    if (MODE != 0) {
#pragma unroll
                        for (int r = 0; r < 16; ++r) { o[0][r] *= alpha; o[1][r] *= alpha; }
                    }
                }
                if (MODE != 0) {
                    v4u pw0, pw1;
                    pw0.x = pk2(pe[0], pe[1]); pw0.y = pk2(pe[2], pe[3]); pw0.z = pk2(pe[4], pe[5]); pw0.w = pk2(pe[6], pe[7]);
                    pw1.x = pk2(pe[8], pe[9]); pw1.y = pk2(pe[10], pe[11]); pw1.z = pk2(pe[12], pe[13]); pw1.w = pk2(pe[14], pe[15]);
                    const bf16x8 pf0 = __builtin_bit_cast(bf16x8, pw0), pf1 = __builtin_bit_cast(bf16x8, pw1);
                    const LAS unsigned char* vb = Vb + (32 * kb + 4 * hi + ((F.lane & 15) >> 2)) * 64 + ((F.lane >> 4) & 1) * 32 + (F.lane & 3) * 8;
#pragma unroll
                    for (int dh = 0; dh < 2; ++dh) {
                        const s16x4 a0 = ds_tr16(vb + dh * 4096), a1 = ds_tr16(vb + dh * 4096 + 512), b0 = ds_tr16(vb + dh * 4096 + 1024), b1 = ds_tr16(vb + dh * 4096 + 1024 + 512);
                        const bf16x8 vf0 = {a0[0], a0[1], a0[2], a0[3], a1[0], a1[1], a1[2], a1[3]}, vf1 = {b0[0], b0[1], b0[2], b0[3], b1[0], b1[1], b1[2], b1[3]};
                        o[dh] = __builtin_amdgcn_mfma_f32_32x32x16_bf16(vf0, pf0, o[dh], 0, 0, 0);
                        o[dh] = __builtin_amdgcn_mfma_f32_32x32x16_bf16(vf1, pf1, o[dh], 0, 0, 0);
                    }
                }
            }
        }
        if (has_next) { *(LAS v4u*)(KB + (buf ^ 1) * 8192 + F.tid * 16) = kreg; if (MODE != 0) *(LAS v4u*)(VB + (buf ^ 1) * 8192 + F.tid * 16) = vreg; }
        __syncthreads();
    }
}

__device__ __forceinline__ void nsa_item(Frame& F, int b, int g, int qi) {
    const int r32 = F.lane & 31, hi = F.lane >> 5, tokl = r32 >> 2, hh = r32 & 3;
    const int t0 = qi * 64, tw0 = t0 + 8 * F.wave, t = tw0 + tokl;
    const unsigned char* dob = F.dout_b;
    const size_t img = (size_t)(b * 2 + g) * (1u << 20);
    LAS float* impw = (LAS float*)(F.lds + RING_OFF + NSA_IMP) + F.wave * 1024;
    LAS unsigned* selm = (LAS unsigned*)(F.lds + RING_OFF + NSA_SELM) + F.wave * 32;
#pragma unroll
    for (int i = 0; i < 16; ++i) impw[F.lane + 64 * i] = 0.f;
    bf16x8 qr[4];
    { const bf16* qrow = (const bf16*)(dob + DO_QN) + (((size_t)(b * 2 + g) * SEQ + tw0) * 4 + r32) * 64;
#pragma unroll
      for (int d0 = 0; d0 < 4; ++d0) qr[d0] = *(const bf16x8*)(qrow + 16 * d0 + 8 * hi); }
    const float* gt = (const float*)(F.ws + WS_GATES) + ((size_t)b * SEQ + t) * 24 + (g * 4 + hh) * 3;
    const float g0 = gt[0], g1 = gt[1], g2 = gt[2];
    f32x16 oacc[2], o[2];
#pragma unroll
    for (int r = 0; r < 16; ++r) { oacc[0][r] = 0.f; oacc[1][r] = 0.f; }
    const int nv = (t >= 31) ? ((t - 31) >> 4) + 1 : 0, nvw = (tw0 + 7 >= 31) ? ((tw0 + 7 - 31) >> 4) + 1 : 0;
    const int nct = (4 * qi + 3 + 63) >> 6;
    const unsigned char* Kc = dob + DO_KCMP + (size_t)(b * 2 + g) * 65536; const unsigned char* Vc = dob + DO_VCMP + (size_t)(b * 2 + g) * 65536;
    float m = NEGBIG, l = 0.f;
    nsa_branch<0>(F, Kc, Vc, 0, nct, qr, m, l, o, t, tw0, nv, nvw, 0u, 0u, 0u, 0u, 0u, 0u, 0u, 0u, 0.f, impw);
    { const float lt = l + __shfl_xor(l, 32); const float inv_l = (lt > 0.f) ? 1.0f / lt : 0.f;
#pragma unroll
      for (int r = 0; r < 16; ++r) { o[0][r] = 0.f; o[1][r] = 0.f; }
      nsa_branch<1>(F, Kc, Vc, 0, nct, qr, m, l, o, t, tw0, nv, nvw, 0u, 0u, 0u, 0u, 0u, 0u, 0u, 0u, inv_l, impw);
#pragma unroll
      for (int r = 0; r < 16; ++r) { oacc[0][r] += g0 * o[0][r]; oacc[1][r] += g0 * o[1][r]; } }
    __syncthreads();
#pragma unroll 1
    for (int tl = 0; tl < 8; ++tl) {
        const int tt = tw0 + tl, cur = tt >> 6, j0 = F.lane, j1 = F.lane + 64;
        const float NINF = -3.0e38f;
        float v0 = (j0 <= cur) ? impw[tl * 128 + j0] + ((j0 == 0 || j0 == cur || j0 == cur - 1) ? 1e4f : 0.f) : NINF;
        float v1 = (j1 <= cur) ? impw[tl * 128 + j1] + ((j1 == cur || j1 == cur - 1) ? 1e4f : 0.f) : NINF;
        bool s0 = false, s1 = false;
        if (cur < 16) { s0 = (j0 <= cur); }
        else {
#pragma unroll 1
            for (int round = 0; round < 16; ++round) {
                float bv; int bj;
                if (v0 >= v1) { bv = v0; bj = j0; } else { bv = v1; bj = j1; }
#pragma unroll
                for (int off = 32; off >= 1; off >>= 1) { const float ov = __shfl_xor(bv, off); const int oj = __shfl_xor(bj, off); if (ov > bv || (ov == bv && oj < bj)) { bv = ov; bj = oj; } }
                if (bj == j0) { s0 = true; v0 = NINF; }
                if (bj == j1) { s1 = true; v1 = NINF; }
            }
        }
        const unsigned long long m0 = __ballot(s0), m1 = __ballot(s1);
        if (F.lane == 0) { selm[tl * 4 + 0] = (unsigned)m0; selm[tl * 4 + 1] = (unsigned)(m0 >> 32); selm[tl * 4 + 2] = (unsigned)m1; selm[tl * 4 + 3] = (unsigned)(m1 >> 32); }
    }
    __syncthreads();
    const unsigned mk0 = selm[tokl * 4 + 0], mk1 = selm[tokl * 4 + 1], mk2 = selm[tokl * 4 + 2], mk3 = selm[tokl * 4 + 3];
    unsigned wo0 = 0u, wo1 = 0u, wo2 = 0u, wo3 = 0u;
#pragma unroll
    for (int tl = 0; tl < 8; ++tl) { wo0 |= selm[tl * 4 + 0]; wo1 |= selm[tl * 4 + 1]; wo2 |= selm[tl * 4 + 2]; wo3 |= selm[tl * 4 + 3]; }
    wo0 = __builtin_amdgcn_readfirstlane(wo0); wo1 = __builtin_amdgcn_readfirstlane(wo1); wo2 = __builtin_amdgcn_readfirstlane(wo2); wo3 = __builtin_amdgcn_readfirstlane(wo3);
    { m = NEGBIG; l = 0.f;
#pragma unroll
      for (int r = 0; r < 16; ++r) { o[0][r] = 0.f; o[1][r] = 0.f; }
      nsa_branch<2>(F, dob + DO_KSEL + img, dob + DO_VSEL + img, 0, qi + 1, qr, m, l, o, t, tw0, nv, nvw, mk0, mk1, mk2, mk3, wo0, wo1, wo2, wo3, 0.f, impw);
      const float lt = l + __shfl_xor(l, 32); const float sc = (lt > 0.f) ? g1 / lt : 0.f;
#pragma unroll
      for (int r = 0; r < 16; ++r) { oacc[0][r] += sc * o[0][r]; oacc[1][r] += sc * o[1][r]; } }
    { m = NEGBIG; l = 0.f;
#pragma unroll
      for (int r = 0; r < 16; ++r) { o[0][r] = 0.f; o[1][r] = 0.f; }
      nsa_branch<3>(F, dob + DO_KWIN + img, dob + DO_VWIN + img, (qi >= 8) ? qi - 8 : 0, qi + 1, qr, m, l, o, t, tw0, nv, nvw, 0u, 0u, 0u, 0u, 0u, 0u, 0u, 0u, 0.f, impw);
      const float lt = l + __shfl_xor(l, 32); const float sc = (lt > 0.f) ? g2 / lt : 0.f;
#pragma unroll
      for (int r = 0; r < 16; ++r) { oacc[0][r] += sc * o[0][r]; oacc[1][r] += sc * o[1][r]; } }
    bf16* orow = (bf16*)(F.ws + WS_O + 32 * MiB) + ((size_t)b * SEQ + t) * DM + 512 + (g * 4 + hh) * 64;
#pragma unroll
    for (int dh = 0; dh < 2; ++dh)
#pragma unroll
        for (int rg = 0; rg < 4; ++rg) { v2u w; w.x = pk2(oacc[dh][4 * rg], oacc[dh][4 * rg + 1]); w.y = pk2(oacc[dh][4 * rg + 2], oacc[dh][4 * rg + 3]);
            *(v2u*)(orow + 32 * dh + 8 * rg + 4 * hi) = w; }
    __syncthreads();
}

__device__ __forceinline__ void sgu_item(Frame& F, int item) {
    const int gg = item & 7, ck = (item >> 3) & 63, b = item >> 9;
    const size_t tok0 = (size_t)b * SEQ + ck * 128;
    const bf16* Z = (const bf16*)(F.ws + WS_A);
    LAS bf16* Ws = (LAS bf16*)(F.lds + RING_OFF);
    LAS bf16* VT = (LAS bf16*)(F.lds + RING_OFF + 34816);
    LAS float* rs = (LAS float*)(F.lds + RING_OFF + 34816 + 69632);
    if (F.tid < 128) { const float* st = (const float*)(F.ws + WS_STATS) + (tok0 + F.tid) * 32; float s = 0.f;
#pragma unroll
        for (int k = 0; k < 32; k += 4) { const f32x4 v = *(const f32x4*)(st + k); s += (v.x + v.y) + (v.z + v.w); }
        rs[F.tid] = 1.0f / sqrtf(s * (1.0f / SGW) + NORM_EPS); }
    { const float* wsrc = F.sgu_ws + (size_t)gg * 128 * 128;
#pragma unroll
      for (int k = 0; k < 8; ++k) { const int p = F.tid + 512 * k, tr = p >> 5, sc = (p & 31) * 4; const f32x4 w = *(const f32x4*)(wsrc + tr * 128 + sc);
          v2u o; o.x = pk2((sc <= tr) ? w.x : 0.f, (sc + 1 <= tr) ? w.y : 0.f); o.y = pk2((sc + 2 <= tr) ? w.z : 0.f, (sc + 3 <= tr) ? w.w : 0.f);
          *(LAS v2u*)(Ws + tr * 136 + sc) = o; } }
    __syncthreads();
#pragma unroll 2
    for (int k = 0; k < 8; ++k) {
        const int p = F.tid + 512 * k, s = p & 127, cc = p >> 7;
        float x[8]; unpack8(*(const v4u*)(Z + (tok0 + s) * 4096 + 2048 + gg * 256 + cc * 8), x);
        const float rr = rs[s];
#pragma unroll
        for (int i = 0; i < 8; ++i) VT[(cc * 8 + i) * 136 + s] = (bf16)f2bf(x[i] * rr * F.sgu_ng[gg * 256 + cc * 8 + i]);
    }
    __syncthreads();
    f32x4 acc[16];
#pragma unroll
    for (int nt = 0; nt < 16; ++nt) acc[nt] = (f32x4){0.f, 0.f, 0.f, 0.f};
    const int ksteps = (16 * F.wave + 16 + 31) >> 5;
    const LAS bf16* ap = Ws + (16 * F.wave + (F.lane & 15)) * 136 + (F.lane >> 4) * 8;
    const LAS bf16* bp = VT + (F.lane & 15) * 136 + (F.lane >> 4) * 8;
#pragma unroll 1
    for (int kk = 0; kk < ksteps; ++kk) {
        const bf16x8 a = *(const LAS bf16x8*)(ap + kk * 32);
#pragma unroll
        for (int nt = 0; nt < 16; ++nt) { const bf16x8 bb = *(const LAS bf16x8*)(bp + nt * 16 * 136 + kk * 32); acc[nt] = __builtin_amdgcn_mfma_f32_16x16x32_bf16(a, bb, acc[nt], 0, 0, 0); }
    }
    bf16* UM = (bf16*)(F.ws + WS_O);
#pragma unroll
    for (int i = 0; i < 4; ++i) {
        const int tr = 16 * F.wave + 4 * (F.lane >> 4) + i; const float bs = F.sgu_bs[gg * 128 + tr];
        const bf16* urow = Z + (tok0 + tr) * 4096 + gg * 256; bf16* orow = UM + (tok0 + tr) * SGW + gg * 256;
#pragma unroll
        for (int nt = 0; nt < 16; ++nt) { const int c = nt * 16 + (F.lane & 15); orow[c] = (bf16)f2bf(bf2f(urow[c]) * (acc[nt][i] + bs)); }
    }
    __syncthreads();
}

constexpr int NPHASE = 20;
struct Args { const void* in[26]; float* out; unsigned char* ws; int ph_lo, ph_hi, use_bar, pad; };
__global__ void __launch_bounds__(512, 2) trunk_fwd(Args args) {
    extern __shared__ __attribute__((aligned(16))) unsigned char lds[];
    Frame F;
    F.lds = (LAS unsigned char*)lds;
    F.MISC = (volatile LAS unsigned*)(F.lds + MISC_OFF);
    F.tid = threadIdx.x; F.lane = F.tid & 63; F.wave = __builtin_amdgcn_readfirstlane(F.tid >> 6);
    F.G = gridDim.x; F.bid = blockIdx.x;
    F.ws = args.ws; F.out = args.out; F.dout_b = (unsigned char*)args.out;
    F.ctl = (gu32*)(args.ws + WS_CTL);
    F.x = (const float*)args.in[0]; F.c = (const float*)args.in[1]; F.positions = (const int*)args.in[2]; F.w_ada = (const float*)args.in[3]; F.b_ada = (const float*)args.in[4];
    F.norm_g = (const float*)args.in[5]; F.w_in_ab = (const float*)args.in[6]; F.w_out_ab = (const float*)args.in[7]; F.gla_w2 = (const float*)args.in[8]; F.gla_bg = (const float*)args.in[9];
    F.gla_ng = (const float*)args.in[10]; F.q_gain = (const float*)args.in[11]; F.k_gain = (const float*)args.in[12]; F.cmp_pe = (const float*)args.in[13]; F.cmp_w1 = (const float*)args.in[14];
    F.cmp_w2 = (const float*)args.in[15]; F.w_in_c = (const float*)args.in[16]; F.sgu_ng = (const float*)args.in[17]; F.sgu_ws = (const float*)args.in[18]; F.sgu_bs = (const float*)args.in[19];
    F.w_out_c = (const float*)args.in[20]; F.w_router = (const float*)args.in[21]; F.r_bias = (const float*)args.in[22]; F.w_gate = (const float*)args.in[23]; F.w_up = (const float*)args.in[24];
    F.w_down = (const float*)args.in[25];
    for (int u = F.tid; u < (LDS_BYTES - LDSCTL_OFF) / 4; u += 512) ((LAS unsigned*)(F.lds + LDSCTL_OFF))[u] = 0u;
    __syncthreads();
    XcdBarrier bar; bar.bar = (unsigned*)(F.ctl + CW_BAR); bar.x = 0; bar.st = nullptr;
    if (args.use_bar) bar = xcd_barrier_post((unsigned*)(F.ctl + CW_BAR) + (args.use_bar - 1) * XCD_BAR_WORDS, F.MISC + 8);
    const int lo = args.ph_lo, hi = args.ph_hi;
#ifndef PH_MASK
#define PH_MASK 0xFFFFFu
#endif
#define IN(k) ((((PH_MASK) >> (k)) & 1u) && lo <= (k) && (k) < hi)
#if defined(SPIN_PHASE)
    unsigned long long t_mark = __builtin_amdgcn_s_memrealtime();
#define SPIN_HOOK(k) do { if ((k) == (SPIN_PHASE)) { const unsigned long long t1_ = __builtin_amdgcn_s_memrealtime(), dt_ = t1_ - t_mark; while (__builtin_amdgcn_s_memrealtime() - t1_ < dt_) __builtin_amdgcn_s_sleep(4); } } while (0)
#define SPIN_MARK() do { t_mark = __builtin_amdgcn_s_memrealtime(); } while (0)
#else
#define SPIN_HOOK(k) do { } while (0)
#define SPIN_MARK() do { } while (0)
#endif
#define SEAM(k) do { if (IN(k)) SPIN_HOOK(k); if (IN(k) && IN((k) + 1)) xcd_barrier(bar); SPIN_MARK(); } while (0)
    float* mod = (float*)(F.ws + WS_MOD);
    bf16* Hb = (bf16*)(F.ws + WS_O);
    bf16* Ab = (bf16*)(F.ws + WS_A);

    if (IN(0)) { p0_prologue(F); } SEAM(0);
    if (IN(1)) { row_pass<false, true, false>(F, F.x, mod, 0, F.norm_g, mod, 0); } SEAM(1);
    if (IN(2)) { pg8::Gemm g{Hb, (const bf16*)(F.ws + WS_WIN), NTOK, NPROJ, DM}; pg8::StaticOrder S; S.init(NTOK, NPROJ, F.G, F.bid);
        pg8::EpiBf16<0> E{Ab, NPROJ, nullptr, 0, 0, 1.f};
        pg8::gemm_phase<pg8::EpiBf16<0>, pg8::StaticOrder, true, true>(F.lds + RING_OFF, g, S, E); } SEAM(2);
    if (IN(3)) {
        for (int it = F.bid; it < 1024; it += F.G) gla_prep_item(F, it);
        for (int tok = F.bid * 8 + F.wave; tok < NTOK; tok += F.G * 8) nsa_prep_token(F, tok);
    } SEAM(3);
    if (IN(4)) {
        const int half = F.G >> 1;
        if (F.bid < half) { for (int it = F.bid; it < 128; it += half) nsa_compress_item(F, it); }
        else { for (int gi = (F.bid - half) * 512 + F.tid; gi < 65536; gi += (F.G - half) * 512) gla_scan(F, gi); }
    } SEAM(4);
    if (IN(5)) {
#ifndef NO_NSA
        for (int p = F.bid; p < 256; p += F.G) { const int bg = p >> 6, i = p & 63; nsa_item(F, bg >> 1, bg & 1, i); nsa_item(F, bg >> 1, bg & 1, 127 - i); }
#endif
#ifndef NO_GLAOUT
        for (int it = F.bid; it < 1024; it += F.G) gla_out_item(F, it);
#endif
    } SEAM(5);
    if (IN(6)) { pg8::Gemm g{(const bf16*)(F.ws + WS_O + 32 * MiB), (const bf16*)(F.ws + WS_WOUT), NTOK, DM, DM}; pg8::StaticOrder S; S.init(NTOK, DM, F.G, F.bid);
        EpiResid E{F.x, F.out, mod + 2 * 1024};
        pg8::gemm_phase<EpiResid, pg8::StaticOrder, true, true>(F.lds + RING_OFF, g, S, E); } SEAM(6);
#define MOE_BLOCK(P, LAYER) \
    if (IN(P)) { row_pass<false, true, true>(F, F.out, mod + (LAYER) * 2 * 6144, 3 * 1024, F.norm_g + ((LAYER) * 2 + 1) * 1024, mod, (LAYER)); } SEAM(P); \
    if (IN((P) + 1)) { moe_gather(F, (LAYER)); } SEAM((P) + 1); \
    if (IN((P) + 2)) { moe_tables(F, (LAYER)); MoeOrder S{(const LAS int*)(F.lds + TAB_OFF), F.G, F.bid}; \
        pg8::Gemm g{Ab, (const bf16*)(F.ws + WS_WGU) + (size_t)(LAYER) * 16 * 1024 * 1024, MOE_ROWS, 1024, DM}; EpiMoeGU E{(bf16*)(F.ws + WS_A + A_HID_OFF)}; \
        pg8::gemm_phase<EpiMoeGU, MoeOrder, true, true>(F.lds + RING_OFF, g, S, E); } SEAM((P) + 2); \
    if (IN((P) + 3)) { moe_tables(F, (LAYER)); MoeOrder S{(const LAS int*)(F.lds + TAB_OFF), F.G, F.bid}; \
        pg8::Gemm g{(const bf16*)(F.ws + WS_A + A_HID_OFF), (const bf16*)(F.ws + WS_WDN) + (size_t)(LAYER) * 16 * 1024 * 512, MOE_ROWS, 1024, EHID}; EpiMoeDn E{Ab}; \
        pg8::gemm_phase<EpiMoeDn, MoeOrder, true, true>(F.lds + RING_OFF, g, S, E); } SEAM((P) + 3);
    MOE_BLOCK(7, 0)
    if (IN(11)) { row_pass<true, true, false>(F, F.out, mod + 2 * 6144, 0, F.norm_g + 2 * 1024, mod, 1); } SEAM(11);
    if (IN(12)) { pg8::Gemm g{Hb, (const bf16*)(F.ws + WS_WINC), NTOK, 4096, DM}; pg8::StaticOrder S; S.init(NTOK, 4096, F.G, F.bid);
        EpiGeluStats E{Ab, (float*)(F.ws + WS_STATS)};
        pg8::gemm_phase<EpiGeluStats, pg8::StaticOrder, true, true>(F.lds + RING_OFF, g, S, E); } SEAM(12);
    if (IN(13)) { for (int it = F.bid; it < 1024; it += F.G) sgu_item(F, it); } SEAM(13);
    if (IN(14)) { pg8::Gemm g{Hb, (const bf16*)(F.ws + WS_WOUTC), NTOK, DM, SGW}; pg8::StaticOrder S; S.init(NTOK, DM, F.G, F.bid);
        EpiResid E{F.out, F.out, mod + 2 * 6144 + 2 * 1024};
        pg8::gemm_phase<EpiResid, pg8::StaticOrder, true, true>(F.lds + RING_OFF, g, S, E); } SEAM(14);
    MOE_BLOCK(15, 1)
    if (IN(19)) { row_pass<true, false, false>(F, F.out, mod, 0, F.norm_g, mod + 2 * 6144, 1); SPIN_HOOK(19); }
#undef IN
#undef SEAM
#undef MOE_BLOCK
}

#ifndef MK_N_LAUNCHES
#define MK_N_LAUNCHES 1
#endif
extern "C" void kernel_launch(void* const* d_in, const int* in_sizes, int n_in, void* d_out, int out_size, void* d_ws, size_t ws_size, hipStream_t stream) {
    static int grid = 0;
    if (grid == 0) {
        if (n_in != 26 || out_size != NTOK * DM || ws_size < WS_END) { fprintf(stderr, "kernel_launch: unexpected problem shape / workspace (%d inputs, out %d, ws %zu)\n", n_in, out_size, ws_size); grid = -1; return; }
        int dev = 0, cus = 0, per_cu = 0;
        if (hipGetDevice(&dev) != hipSuccess || hipDeviceGetAttribute(&cus, hipDeviceAttributeMultiprocessorCount, dev) != hipSuccess) { grid = -1; return; }
        if (hipFuncSetAttribute((const void*)trunk_fwd, hipFuncAttributeMaxDynamicSharedMemorySize, LDS_BYTES) != hipSuccess) { fprintf(stderr, "kernel_launch: hipFuncSetAttribute failed\n"); grid = -1; return; }
        if (hipOccupancyMaxActiveBlocksPerMultiprocessor(&per_cu, (const void*)trunk_fwd, 512, LDS_BYTES) != hipSuccess || per_cu < 1) { fprintf(stderr, "kernel_launch: occupancy query says %d blocks per CU\n", per_cu); }
        (void)hipGetLastError();
        grid = cus;
        if (grid != 256) { fprintf(stderr, "kernel_launch: built for a 256-CU device, found %d CUs\n", cus); grid = -1; return; }
    }
    if (grid < 0) return;
    (void)hipMemsetAsync((char*)d_ws + WS_CTL, 0, CTL_ZERO_BYTES, stream);
    Args a{};
    for (int i = 0; i < 26; ++i) a.in[i] = d_in[i];
    a.out = (float*)d_out; a.ws = (unsigned char*)d_ws; a.pad = 0;
    if (MK_N_LAUNCHES == 1) {
#if defined(REP_PHASE)
        a.ph_lo = 0; a.ph_hi = REP_PHASE + 1; a.use_bar = 1;
        hipLaunchKernelGGL(trunk_fwd, dim3(grid), dim3(512), LDS_BYTES, stream, a);
        a.ph_lo = REP_PHASE; a.ph_hi = NPHASE; a.use_bar = 2;
        hipLaunchKernelGGL(trunk_fwd, dim3(grid), dim3(512), LDS_BYTES, stream, a);
#else
        a.ph_lo = 0; a.ph_hi = NPHASE; a.use_bar = 1;
        hipLaunchKernelGGL(trunk_fwd, dim3(grid), dim3(512), LDS_BYTES, stream, a);
#endif
    } else {
        for (int p = 0; p < NPHASE; ++p) { a.ph_lo = p; a.ph_hi = p + 1; a.use_bar = 0; hipLaunchKernelGGL(trunk_fwd, dim3(grid), dim3(512), LDS_BYTES, stream, a); }
    }
}
```

```cpp
#include <hip/hip_runtime.h>
#include <cstdio>
#include <cstdint>
namespace pg8 {
#define PG8_LAS __attribute__((address_space(3)))
typedef unsigned short bf16_t;
typedef short bf16x8 __attribute__((ext_vector_type(8)));
typedef float f32x4 __attribute__((ext_vector_type(4)));
typedef unsigned u32x4 __attribute__((ext_vector_type(4)));
constexpr int BM = 256, BK = 64, HALF = 128, HTB = HALF * BK * 2  , STAGE_BYTES = 8 * HTB, NXCD = 8, WGM = 8;

__host__ __device__ __forceinline__ int lds_byte(int r, int c) { const int st = (r >> 4) * 2 + (c >> 5), rr = r & 15, cc = c & 31, ob = rr * 64 + cc * 2; return st * 1024 + (ob ^ (((ob >> 9) & 1) << 5)); }
__host__ __device__ __forceinline__ void stage_rc(int b, int& R, int& C) { const int st = b / 1024, sb = b % 1024, swz = sb ^ (((sb >> 9) & 1) << 5); R = (st >> 1) * 16 + swz / 64; C = (st & 1) * 32 + (swz % 64) / 2; }
__host__ __device__ __forceinline__ int perm32(int rho) { const int n = rho >> 4, i = rho & 15; return 8 * (i >> 2) + 4 * n + (i & 3); }

struct Unit { int pm, pn; };
struct Gemm { const bf16_t* A; const bf16_t* Bt; int M, N, K; };

struct StaticOrder {
    int nM, nN, nwg, G, c;
    __host__ __device__ void init(int M, int N, int G_, int c_) { nM = M / BM; nN = N / BM; nwg = nM * nN; G = G_; c = c_; }
    __host__ __device__ bool next(int i, Unit& u) const {
        const long L = (long)i * G + c; if (L >= nwg) return false;
        int wgid = (int)L; { const int q = nwg / NXCD, r = nwg % NXCD, xcd = wgid % NXCD, off = wgid / NXCD; wgid = (xcd < r ? xcd * (q + 1) : r * (q + 1) + (xcd - r) * q) + off; }
        const int nig = WGM * nN, gid = wgid / nig, fm = gid * WGM, gsz = (nM - fm) < WGM ? (nM - fm) : WGM;
        u.pm = fm + ((wgid % nig) % gsz); u.pn = (wgid % nig) / gsz; return true;
    }
    __device__ __forceinline__ void a_ready(const Unit&) const {}
    __device__ __forceinline__ void done(const Unit&) const {}
};

__device__ __forceinline__ unsigned cvt_pk_bf16(float lo, float hi) { unsigned r; asm volatile("v_cvt_pk_bf16_f32 %0, %1, %2" : "=v"(r) : "v"(lo), "v"(hi)); return r; }
typedef float f32x2 __attribute__((ext_vector_type(2)));
__device__ __forceinline__ f32x2 gelu_pk(f32x2 v) {
    const f32x2 av = __builtin_elementwise_abs(v), d = av * 0.2316418882f + 1.0f;
    f32x2 t; t.x = __builtin_amdgcn_rcpf(d.x); t.y = __builtin_amdgcn_rcpf(d.y);
    f32x2 q = t * 0.5307027145f + (-0.7265760135f); q = q * t + 0.7107068705f; q = q * t + (-0.142248368f); q = q * t + 0.127414796f; q = q * t;
    const f32x2 s = (v * v) * (-0.72134752044f);
    f32x2 e; e.x = __builtin_amdgcn_exp2f(s.x); e.y = __builtin_amdgcn_exp2f(s.y);
    const f32x2 m = v * (q * e), r = v - m;
    f32x2 o; o.x = v.x < 0.f ? m.x : r.x; o.y = v.y < 0.f ? m.y : r.y; return o;
}

template <int ACT  > struct EpiBf16 {
    static constexpr bool PERM = true, AFTER_DRAIN = false; static_assert(ACT == 0 || ACT == 1, "EpiBf16: ACT is 0 (none) or 1 (gelu_pk)");
    bf16_t* O; int ldc; const float* bias; int split_cols; size_t split_stride; float scale0;
    __device__ __forceinline__ void operator()(const f32x4 (&acc)[2][2][4][2], const Unit& u, int wr, int wc, int fr, int fq) const {
        const int row0 = u.pm * BM + wr * 64 + fr; int colt = u.pn * BM; bf16_t* base = O;
        float sc = 1.f; if (split_cols) { const int t = colt / split_cols; base += (size_t)t * split_stride; colt -= t * split_cols; if (t == 0) sc = scale0; }
        const int col0 = colt + wc * 32 + 8 * fq, bcol0 = u.pn * BM + wc * 32 + 8 * fq;
        f32x4 bv[2][2];
#pragma unroll
        for (int bj = 0; bj < 2; ++bj)
#pragma unroll
            for (int n = 0; n < 2; ++n) bv[bj][n] = bias ? *(const f32x4*)(bias + bcol0 + bj * HALF + 4 * n) : (f32x4){0.f, 0.f, 0.f, 0.f};
#pragma unroll
        for (int ai = 0; ai < 2; ++ai)
#pragma unroll
            for (int m = 0; m < 4; ++m) { bf16_t* rowp = base + (size_t)(row0 + ai * HALF + m * 16) * ldc + col0;
#pragma unroll
                for (int bj = 0; bj < 2; ++bj) { f32x4 v0 = acc[ai][bj][m][0] + bv[bj][0], v1 = acc[ai][bj][m][1] + bv[bj][1];
                    if (ACT == 1) { f32x2 a = gelu_pk((f32x2){v0[0], v0[1]}), b = gelu_pk((f32x2){v0[2], v0[3]}), c = gelu_pk((f32x2){v1[0], v1[1]}), d = gelu_pk((f32x2){v1[2], v1[3]});
                        v0 = (f32x4){a.x, a.y, b.x, b.y}; v1 = (f32x4){c.x, c.y, d.x, d.y}; }
                    v0 = v0 * sc; v1 = v1 * sc; u32x4 w; w.x = cvt_pk_bf16(v0[0], v0[1]); w.y = cvt_pk_bf16(v0[2], v0[3]); w.z = cvt_pk_bf16(v1[0], v1[1]); w.w = cvt_pk_bf16(v1[2], v1[3]);
                    *(u32x4*)(rowp + bj * HALF) = w; } }
    }
};

template <class Epi, class Sched, bool ALIGN_EPI = false, bool SP2 = false>
__device__ __forceinline__ void gemm_phase(PG8_LAS unsigned char* lds, const Gemm g, const Sched& S, const Epi& E) {
    const int tid = threadIdx.x, wid = __builtin_amdgcn_readfirstlane(tid >> 6), lane = tid & 63, wr = wid >> 2, wc = wid & 3, fr = lane & 15, fq = lane >> 4;
    const int K = g.K, nt = K / BK;
    unsigned voffA[2], voffB[2];
#pragma unroll
    for (int i = 0; i < 2; ++i) { int R, C; stage_rc(tid * 16 + i * 8192, R, C); const int Rb = Epi::PERM ? ((R & ~31) + perm32(R & 31)) : R;
        voffA[i] = (unsigned)(R * K + C) * 2u; voffB[i] = (unsigned)(Rb * K + C) * 2u; }
    const size_t kstep = (size_t)(BK * 2);
    const size_t hstep = (size_t)HALF * K * 2;
    const size_t tstep = 2 * hstep;
    const unsigned ldsw = (unsigned)wid * 1024u;
    const int aoff = lds_byte(wr * 64 + fr, fq * 8), boff = lds_byte(wc * 32 + fr, fq * 8);
#define PG8_SA(b, h) (((b) * 2 + (h)) * HTB)
#define PG8_SB(b, h) ((4 + (b) * 2 + (h)) * HTB)
#define PG8_STAGE(bufoff, gbase, voff) do { _Pragma("unroll") for (int _i = 0; _i < 2; ++_i) \
        __builtin_amdgcn_global_load_lds((const unsigned*)((const char*)(gbase) + (voff)[_i]), (PG8_LAS unsigned*)(lds + (bufoff) + ldsw + _i * 8192), 16, 0, 0); } while (0)
#define PG8_LDA(dst, b, h) do { _Pragma("unroll") for (int m = 0; m < 4; ++m) _Pragma("unroll") for (int k = 0; k < 2; ++k) dst[m][k] = *(const PG8_LAS bf16x8*)(lds + PG8_SA(b, h) + aoff + m * 2048 + k * 1024); } while (0)
#define PG8_LDB(dst, b, h) do { _Pragma("unroll") for (int n = 0; n < 2; ++n) _Pragma("unroll") for (int k = 0; k < 2; ++k) dst[n][k] = *(const PG8_LAS bf16x8*)(lds + PG8_SB(b, h) + boff + n * 2048 + k * 1024); } while (0)
#define PG8_MMA(ai, bj, At, Bt) do { __builtin_amdgcn_s_setprio(1); _Pragma("unroll") for (int m = 0; m < 4; ++m) _Pragma("unroll") for (int n = 0; n < 2; ++n) _Pragma("unroll") for (int k = 0; k < 2; ++k) \
        acc[ai][bj][m][n] = __builtin_amdgcn_mfma_f32_16x16x32_bf16(Bt[n][k], At[m][k], acc[ai][bj][m][n], 0, 0, 0); __builtin_amdgcn_s_setprio(0); } while (0)
#define PG8_WAIT_V(n) asm volatile("s_waitcnt vmcnt(" #n ")" ::: "memory")
#define PG8_WAIT_L(n) asm volatile("s_waitcnt lgkmcnt(" #n ")" ::: "memory")
#define PG8_BAR __builtin_amdgcn_s_barrier()
#define PG8_SCHED __builtin_amdgcn_sched_barrier(0)
    Unit cur, nxt; int ui = 0;
    if (!S.next(0, cur)) return;
    f32x4 acc[2][2][4][2];
#pragma unroll
    for (int a = 0; a < 2; ++a)
#pragma unroll
        for (int b = 0; b < 2; ++b)
#pragma unroll
            for (int m = 0; m < 4; ++m)
#pragma unroll
                for (int n = 0; n < 2; ++n) acc[a][b][m][n] = (f32x4){0.f, 0.f, 0.f, 0.f};
    bf16x8 At[4][2], B0[2][2], B1[2][2];
    const char* cA = (const char*)g.A + (size_t)cur.pm * tstep; const char* cB = (const char*)g.Bt + (size_t)cur.pn * tstep;
    S.a_ready(cur);
    if constexpr (SP2) {
        PG8_STAGE(PG8_SB(0, 0), cB, voffB); PG8_STAGE(PG8_SB(0, 1), cB + hstep, voffB); PG8_STAGE(PG8_SA(0, 0), cA, voffA); PG8_STAGE(PG8_SA(0, 1), cA + hstep, voffA);
        if (wr == 1) PG8_BAR;
        PG8_WAIT_V(2); PG8_BAR;
        PG8_STAGE(PG8_SB(1, 0), cB + kstep, voffB); PG8_STAGE(PG8_SA(1, 0), cA + kstep, voffA); PG8_STAGE(PG8_SB(1, 1), cB + hstep + kstep, voffB);
        PG8_WAIT_V(6); PG8_BAR;
    } else {
        PG8_STAGE(PG8_SB(0, 0), cB, voffB); PG8_STAGE(PG8_SA(0, 0), cA, voffA); PG8_STAGE(PG8_SB(0, 1), cB + hstep, voffB); PG8_STAGE(PG8_SA(0, 1), cA + hstep, voffA);
        if (wr == 1) PG8_BAR;
        PG8_WAIT_V(4); PG8_BAR;
        PG8_STAGE(PG8_SB(1, 0), cB + kstep, voffB); PG8_STAGE(PG8_SA(1, 0), cA + kstep, voffA); PG8_STAGE(PG8_SB(1, 1), cB + hstep + kstep, voffB);
        PG8_WAIT_V(6); PG8_BAR;
    }
    for (;;) {
        const bool has_next = S.next(ui + 1, nxt);
        const char* nA = has_next ? (const char*)g.A + (size_t)nxt.pm * tstep : cA; const char* nB = has_next ? (const char*)g.Bt + (size_t)nxt.pn * tstep : cB;
        for (int t = 0; t < nt; t += 2) {
            const bool last = (t == nt - 2);
            const char* a1 = cA + (size_t)(t + 1) * kstep;
            const char* a2 = last ? nA : cA + (size_t)(t + 2) * kstep; const char* b2 = last ? nB : cB + (size_t)(t + 2) * kstep;
            const char* a3 = a2 + kstep; const char* b3 = b2 + kstep;
            if (last && has_next) S.a_ready(nxt);
            if constexpr (SP2) {
            PG8_LDB(B0, 0, 0); PG8_LDB(B1, 0, 1); PG8_SCHED; PG8_LDA(At, 0, 0); PG8_STAGE(PG8_SA(1, 1), a1 + hstep, voffA);
            PG8_WAIT_V(8); PG8_WAIT_L(0); PG8_BAR; PG8_MMA(0, 0, At, B0); PG8_MMA(0, 1, At, B1); PG8_BAR; PG8_SCHED;
            PG8_LDA(At, 0, 1); PG8_STAGE(PG8_SB(0, 0), b2, voffB); PG8_STAGE(PG8_SB(0, 1), b2 + hstep, voffB); PG8_STAGE(PG8_SA(0, 0), a2, voffA);
            PG8_WAIT_V(8); PG8_WAIT_L(0); PG8_BAR; PG8_MMA(1, 0, At, B0); PG8_MMA(1, 1, At, B1); PG8_BAR; PG8_SCHED;
            PG8_LDB(B0, 1, 0); PG8_LDB(B1, 1, 1); PG8_SCHED; PG8_LDA(At, 1, 0); PG8_STAGE(PG8_SA(0, 1), a2 + hstep, voffA);
            PG8_WAIT_V(8); PG8_WAIT_L(0); PG8_BAR; PG8_MMA(0, 0, At, B0); PG8_MMA(0, 1, At, B1); PG8_BAR; PG8_SCHED;
            PG8_LDA(At, 1, 1); PG8_STAGE(PG8_SB(1, 0), b3, voffB); PG8_STAGE(PG8_SB(1, 1), b3 + hstep, voffB); PG8_STAGE(PG8_SA(1, 0), a3, voffA);
            PG8_WAIT_V(8); PG8_WAIT_L(0); PG8_BAR; PG8_MMA(1, 0, At, B0); PG8_MMA(1, 1, At, B1); PG8_BAR; PG8_SCHED;
            } else {
            PG8_LDB(B0, 0, 0); PG8_SCHED; PG8_LDA(At, 0, 0); PG8_STAGE(PG8_SA(1, 1), a1 + hstep, voffA);
            PG8_WAIT_L(8); PG8_BAR; PG8_WAIT_L(0); PG8_MMA(0, 0, At, B0); PG8_BAR; PG8_SCHED;
            PG8_LDB(B1, 0, 1); PG8_STAGE(PG8_SB(0, 0), b2, voffB);
            PG8_BAR; PG8_WAIT_L(0); PG8_MMA(0, 1, At, B1); PG8_BAR;
            PG8_LDA(At, 0, 1); PG8_STAGE(PG8_SA(0, 0), a2, voffA);
            PG8_BAR; PG8_WAIT_L(0); PG8_MMA(1, 0, At, B0); PG8_BAR; PG8_SCHED;
            PG8_STAGE(PG8_SB(0, 1), b2 + hstep, voffB);
            PG8_WAIT_V(6); PG8_BAR; PG8_MMA(1, 1, At, B1); PG8_BAR;
            PG8_LDB(B0, 1, 0); PG8_SCHED; PG8_LDA(At, 1, 0); PG8_STAGE(PG8_SA(0, 1), a2 + hstep, voffA);
            PG8_WAIT_L(8); PG8_BAR; PG8_WAIT_L(0); PG8_MMA(0, 0, At, B0); PG8_BAR; PG8_SCHED;
            PG8_LDB(B1, 1, 1); PG8_STAGE(PG8_SB(1, 0), b3, voffB);
            PG8_BAR; PG8_WAIT_L(0); PG8_MMA(0, 1, At, B1); PG8_BAR;
            PG8_LDA(At, 1, 1); PG8_STAGE(PG8_SA(1, 0), a3, voffA);
            PG8_BAR; PG8_WAIT_L(0); PG8_MMA(1, 0, At, B0); PG8_BAR; PG8_SCHED;
            PG8_STAGE(PG8_SB(1, 1), b3 + hstep, voffB);
            PG8_WAIT_V(6); PG8_BAR; PG8_MMA(1, 1, At, B1); PG8_BAR;
            }
        }
        if constexpr (ALIGN_EPI) { if (wr == 0) PG8_BAR; }
        if constexpr (!Epi::AFTER_DRAIN) { E(acc, cur, wr, wc, fr, fq); S.done(cur); }
        if (!has_next) break;
#pragma unroll
        for (int a = 0; a < 2; ++a)
#pragma unroll
            for (int b = 0; b < 2; ++b)
#pragma unroll
                for (int m = 0; m < 4; ++m)
#pragma unroll
                    for (int n = 0; n < 2; ++n) acc[a][b][m][n] = (f32x4){0.f, 0.f, 0.f, 0.f};
        cur = nxt; cA = nA; cB = nB; ++ui;
        if constexpr (ALIGN_EPI) { if (wr == 1) PG8_BAR; }
    }
    PG8_WAIT_V(0);
    if constexpr (!ALIGN_EPI) { if (wr == 0) PG8_BAR; }
    PG8_BAR;
    if constexpr (Epi::AFTER_DRAIN) { E.fused(acc, cur, wr, wc, fr, fq, lds, wid, lane); S.done(cur); }
#undef PG8_SA
#undef PG8_SB
#undef PG8_STAGE
#undef PG8_LDA
#undef PG8_LDB
#undef PG8_MMA
#undef PG8_WAIT_V
#undef PG8_WAIT_L
#undef PG8_BAR
#undef PG8_SCHED
}
}

#ifndef PG8_SP2
#define PG8_SP2 true
#endif

constexpr int NB = 2, SEQ = 8192, DM = 1024, NTOK = NB * SEQ;
constexpr int NPROJ = 3072;
constexpr int C_GQ = 0, C_GK = 256, C_GV = 512, C_GR = 1024, C_NQ = 1536, C_KC = 2048, C_VC = 2176, C_KS = 2304, C_VS = 2432, C_KW = 2560, C_VW = 2688, C_GLR = 2816, C_NG = 2832, C_END = 2856;
constexpr int SGW = 2048;
constexpr int NEXP = 16, EHID = 512;
constexpr int MOE_ROWS = 36864;
constexpr float NORM_EPS = 1e-6f;
constexpr float NEGBIG = -1e30f;

constexpr size_t MiB = 1u << 20;
constexpr size_t WS_CTL = 0, CTL_ZERO_BYTES = 1 * MiB;
constexpr size_t WS_MOD = 1 * MiB;
constexpr size_t WS_ROUTE = 2 * MiB;
constexpr size_t WS_GATES = 3 * MiB;
constexpr size_t WS_STATS = 5 * MiB;
constexpr size_t WS_DEC = 7 * MiB;
constexpr size_t WS_WIN = 8 * MiB;
constexpr size_t WS_WOUT = 14 * MiB;
constexpr size_t WS_WINC = 16 * MiB;
constexpr size_t WS_WOUTC = 24 * MiB;
constexpr size_t WS_WCW1 = 28 * MiB;
constexpr size_t WS_WGU = 30 * MiB;
constexpr size_t WS_WDN = 94 * MiB;
constexpr size_t WS_A = 126 * MiB;
constexpr size_t WS_O = 254 * MiB;
constexpr size_t WS_END = 318 * MiB;
constexpr size_t A_HID_OFF = 72 * MiB;
constexpr size_t DO_QN = 0;
constexpr size_t DO_KSEL = 16 * MiB, DO_VSEL = 20 * MiB, DO_KWIN = 24 * MiB, DO_VWIN = 28 * MiB;
constexpr size_t DO_KC = 32 * MiB, DO_VC = 36 * MiB + 65536;
constexpr size_t DO_KCMP = 41 * MiB, DO_VCMP = 41 * MiB + 512 * 1024;

constexpr int CW_TMO = 0, CW_CODE = 1;
constexpr int CW_BAR = 4096;
constexpr int CW_CNT = 16384;

constexpr int RING_OFF = 0, RING_BYTES = 131072;
constexpr int LDSCTL_OFF = RING_BYTES, MISC_OFF = LDSCTL_OFF + 320;
constexpr int TAB_OFF = LDSCTL_OFF + 1024;
constexpr int LDS_BYTES = 147456;

#define GAS __attribute__((address_space(1)))
#define LAS __attribute__((address_space(3)))
typedef unsigned short bf16;
typedef unsigned v4u __attribute__((ext_vector_type(4)));
typedef unsigned v2u __attribute__((ext_vector_type(2)));
typedef float f32x4 __attribute__((ext_vector_type(4)));
typedef float f32x2 __attribute__((ext_vector_type(2)));
typedef float f32x16 __attribute__((ext_vector_type(16)));
typedef short bf16x8 __attribute__((ext_vector_type(8)));
typedef short s16x4 __attribute__((ext_vector_type(4)));
typedef GAS unsigned gu32;
#define RLX_AGENT __ATOMIC_RELAXED, __HIP_MEMORY_SCOPE_AGENT
#define LDS_WAIT() asm volatile("s_waitcnt lgkmcnt(0)" ::: "memory")
#define VM_WAIT() asm volatile("s_waitcnt vmcnt(0)" ::: "memory")
__device__ __forceinline__ unsigned f2bf(float f) { unsigned u = __builtin_bit_cast(unsigned, f); return (u + 0x7fffu + ((u >> 16) & 1u)) >> 16; }
__device__ __forceinline__ unsigned pk2(float lo, float hi) { return f2bf(lo) | (f2bf(hi) << 16); }
__device__ __forceinline__ float bf2f(unsigned short b) { return __builtin_bit_cast(float, (unsigned)b << 16); }
__device__ __forceinline__ float bflo(unsigned w) { return __builtin_bit_cast(float, w << 16); }
__device__ __forceinline__ float bfhi(unsigned w) { return __builtin_bit_cast(float, w & 0xffff0000u); }
__device__ __forceinline__ float fexp2(float x) { return __builtin_amdgcn_exp2f(x); }
__device__ __forceinline__ float fexp(float x) { return __builtin_amdgcn_exp2f(x * 1.4426950408889634f); }
__device__ __forceinline__ float frcp(float x) { return __builtin_amdgcn_rcpf(x); }
__device__ __forceinline__ float sigmoidf_(float x) { return 1.0f / (1.0f + __expf(-x)); }
__device__ __forceinline__ float siluf_(float x) { return x / (1.0f + __expf(-x)); }
__device__ __forceinline__ float gelu_tanh(float x) {
    const float u = 0.7978845608028654f * (x + 0.044715f * x * x * x);
    return x / (1.0f + __expf(-2.0f * u));
}
__device__ __forceinline__ float wave_sum(float v) {
#pragma unroll
    for (int o = 1; o < 64; o <<= 1) v += __shfl_xor(v, o);
    return v;
}
__device__ __forceinline__ void unpack8(const v4u w, float (&f)[8]) {
    f[0] = bflo(w.x); f[1] = bfhi(w.x); f[2] = bflo(w.y); f[3] = bfhi(w.y); f[4] = bflo(w.z); f[5] = bfhi(w.z); f[6] = bflo(w.w); f[7] = bfhi(w.w);
}
__device__ __forceinline__ v4u pack8(const float (&f)[8]) { v4u w; w.x = pk2(f[0], f[1]); w.y = pk2(f[2], f[3]); w.z = pk2(f[4], f[5]); w.w = pk2(f[6], f[7]); return w; }

#define XB_TMO      128
#define XB_XCNT(j)  (256  + 64 * (j))
#define XB_XSUB(j)  (1280 + 64 * (j))
#define XB_XGEN(j)  (2304 + 64 * (j))
#define XB_TOP      3328
#define XB_TOPGEN   3392
#define XCD_BAR_WORDS 3456
#define XB_SPIN_CAP (1u << 18)

__device__ __forceinline__ unsigned xb_ld(unsigned* p)              { return __hip_atomic_load(p, __ATOMIC_RELAXED, __HIP_MEMORY_SCOPE_AGENT); }
__device__ __forceinline__ unsigned xb_add(unsigned* p, unsigned v) { return __hip_atomic_fetch_add(p, v, __ATOMIC_RELAXED, __HIP_MEMORY_SCOPE_AGENT); }
__device__ __forceinline__ unsigned xb_xcc_id() { return (unsigned)__builtin_amdgcn_s_getreg((3 << 11) | 20) & 0xFu; }
#define XB_SPIN(cond, bar) do { unsigned _sp = 0; while (cond) { __builtin_amdgcn_s_sleep(1); \
    if ((++_sp & 255u) == 0u) { if (xb_ld(&(bar)[XB_TMO])) break; if (_sp > XB_SPIN_CAP) { atomicAdd(&(bar)[XB_TMO], 1u); break; } } } } while (0)

struct XcdBarrier {
    unsigned* bar; unsigned x;
    volatile LAS unsigned* st;
};
__device__ __forceinline__ XcdBarrier xcd_barrier_post(unsigned* bar, volatile LAS unsigned* st) {
    XcdBarrier b; b.bar = bar; b.x = xb_xcc_id(); b.st = st;
    if (threadIdx.x == 0) (void)xb_add(&bar[XB_XCNT(b.x)], 1u);
    return b;
}
__device__ __forceinline__ void xcd_barrier_complete(unsigned* bar, unsigned x, unsigned& nloc, unsigned& nx) {
    const unsigned G = gridDim.x * gridDim.y * gridDim.z;
    unsigned sum, cnt, mine, sp = 0u;
    for (;;) {
        sum = 0u; cnt = 0u; mine = 0u;
#pragma unroll
        for (unsigned j = 0; j < 16; ++j) { const unsigned c = xb_ld(&bar[XB_XCNT(j)]); sum += c; cnt += (c > 0u) ? 1u : 0u; mine = (j == x) ? c : mine; }
        if (sum == G) break;
        __builtin_amdgcn_s_sleep(1);
        if ((++sp & 255u) == 0u) { if (xb_ld(&bar[XB_TMO])) break; if (sp > XB_SPIN_CAP) { atomicAdd(&bar[XB_TMO], 1u); break; } }
    }
    nloc = mine > 0u ? mine : 1u; nx = cnt > 0u ? cnt : 1u;
}
__device__ __forceinline__ void xcd_barrier(const XcdBarrier& b) {
    asm volatile("s_waitcnt vmcnt(0)" ::: "memory");
    __syncthreads();
    if (threadIdx.x == 0) {
        unsigned* bar = b.bar;
        __builtin_amdgcn_s_waitcnt(0);
        unsigned nloc = b.st[0], nx = b.st[1];
        if (nloc == 0u) { xcd_barrier_complete(bar, b.x, nloc, nx); b.st[0] = nloc; b.st[1] = nx; }
        const unsigned old = xb_add(&bar[XB_XSUB(b.x)], 1u);
        const unsigned gen = old / nloc;
        if (old + 1u == (gen + 1u) * nloc) {
            __builtin_amdgcn_fence(__ATOMIC_RELEASE, "agent");
            asm volatile("s_waitcnt vmcnt(0)" ::: "memory");
            const unsigned og = xb_add(&bar[XB_TOP], 1u);
            const unsigned tg = og / nx;
            if (og + 1u == (tg + 1u) * nx) xb_add(&bar[XB_TOPGEN], 1u);
            else XB_SPIN(xb_ld(&bar[XB_TOPGEN]) == tg, bar);
            __builtin_amdgcn_fence(__ATOMIC_ACQUIRE, "agent");
            xb_add(&bar[XB_XGEN(b.x)], 1u);
            asm volatile("s_waitcnt vmcnt(0)" ::: "memory");
        } else {
            XB_SPIN(xb_ld(&bar[XB_XGEN(b.x)]) == gen, bar);
            __builtin_amdgcn_fence(__ATOMIC_ACQUIRE, "agent");
            asm volatile("s_waitcnt vmcnt(0)" ::: "memory");
        }
    }
    __syncthreads();
}

struct Frame {
    LAS unsigned char* lds;
    volatile LAS unsigned* MISC;
    gu32* ctl;
    int tid, lane, wave;
    int bid, G;
    unsigned char* ws;
    unsigned char* dout_b;
    float* out;
    const float *x, *c, *w_ada, *b_ada, *norm_g, *w_in_ab, *w_out_ab, *gla_w2, *gla_bg, *gla_ng, *q_gain, *k_gain, *cmp_pe, *cmp_w1, *cmp_w2, *w_in_c, *sgu_ng, *sgu_ws, *sgu_bs, *w_out_c, *w_router, *r_bias, *w_gate, *w_up, *w_down;
    const int* positions;
};

struct EpiResid {
    static constexpr bool PERM = false, AFTER_DRAIN = false;
    const float* xin; float* xout; const float* gate;
    __device__ __forceinline__ void operator()(const pg8::f32x4 (&acc)[2][2][4][2], const pg8::Unit& u, int wr, int wc, int fr, int fq) const {
        const int row0 = u.pm * 256 + wr * 64 + fr, col0 = u.pn * 256 + wc * 32 + 4 * fq;
        const float* gb = gate + ((u.pm * 256 >= SEQ) ? 6144 : 0);
        f32x4 gv[2][2];
#pragma unroll
        for (int bj = 0; bj < 2; ++bj)
#pragma unroll
            for (int n = 0; n < 2; ++n) gv[bj][n] = *(const f32x4*)(gb + col0 + bj * 128 + n * 16);
#pragma unroll
        for (int ai = 0; ai < 2; ++ai)
#pragma unroll
            for (int m = 0; m < 4; ++m) {
                const size_t rb = (size_t)(row0 + ai * 128 + m * 16) * DM;
#pragma unroll
                for (int bj = 0; bj < 2; ++bj)
#pragma unroll
                    for (int n = 0; n < 2; ++n) {
                        const size_t p = rb + col0 + bj * 128 + n * 16;
                        const f32x4 xi = *(const f32x4*)(xin + p);
                        *(f32x4*)(xout + p) = xi + gv[bj][n] * acc[ai][bj][m][n];
                    }
            }
    }
};
struct EpiGeluStats {
    static constexpr bool PERM = true, AFTER_DRAIN = false;
    bf16* Z; float* stats;
    __device__ __forceinline__ void operator()(const pg8::f32x4 (&acc)[2][2][4][2], const pg8::Unit& u, int wr, int wc, int fr, int fq) const {
        const int row0 = u.pm * 256 + wr * 64 + fr, col0 = u.pn * 256 + wc * 32 + 8 * fq;
#pragma unroll
        for (int ai = 0; ai < 2; ++ai)
#pragma unroll
            for (int m = 0; m < 4; ++m) {
                const int row = row0 + ai * 128 + m * 16; float ss = 0.f;
#pragma unroll
                for (int bj = 0; bj < 2; ++bj) {
                    float g[8];
#pragma unroll
                    for (int n = 0; n < 2; ++n)
#pragma unroll
                        for (int i = 0; i < 4; ++i) { g[n * 4 + i] = gelu_tanh(acc[ai][bj][m][n][i]); ss += g[n * 4 + i] * g[n * 4 + i]; }
                    *(v4u*)(Z + (size_t)row * 4096 + col0 + bj * 128) = pack8(g);
                }
                if (u.pn >= 8) {
                    ss += __shfl_xor(ss, 16); ss += __shfl_xor(ss, 32);
                    if (fq == 0) stats[(size_t)row * 32 + (u.pn - 8) * 4 + wc] = ss;
                }
            }
    }
};
struct EpiMoeGU {
    static constexpr bool PERM = true, AFTER_DRAIN = false;
    bf16* HID;
    __device__ __forceinline__ void operator()(const pg8::f32x4 (&acc)[2][2][4][2], const pg8::Unit& u, int wr, int wc, int fr, int fq) const {
        const int row0 = u.pm * 256 + wr * 64 + fr, col0 = (u.pn & 3) * 128 + wc * 32 + 8 * fq;
#pragma unroll
        for (int ai = 0; ai < 2; ++ai)
#pragma unroll
            for (int m = 0; m < 4; ++m) {
                float h[8];
#pragma unroll
                for (int n = 0; n < 2; ++n)
#pragma unroll
                    for (int i = 0; i < 4; ++i) h[n * 4 + i] = siluf_(acc[ai][0][m][n][i]) * acc[ai][1][m][n][i];
                *(v4u*)(HID + (size_t)(row0 + ai * 128 + m * 16) * EHID + col0) = pack8(h);
            }
    }
};
struct EpiMoeDn {
    static constexpr bool PERM = true, AFTER_DRAIN = false;
    bf16* YM;
    __device__ __forceinline__ void operator()(const pg8::f32x4 (&acc)[2][2][4][2], const pg8::Unit& u, int wr, int wc, int fr, int fq) const {
        const int row0 = u.pm * 256 + wr * 64 + fr, col0 = (u.pn & 3) * 256 + wc * 32 + 8 * fq;
#pragma unroll
        for (int ai = 0; ai < 2; ++ai)
#pragma unroll
            for (int m = 0; m < 4; ++m)
#pragma unroll
                for (int bj = 0; bj < 2; ++bj) {
                    float h[8];
#pragma unroll
                    for (int n = 0; n < 2; ++n)
#pragma unroll
                        for (int i = 0; i < 4; ++i) h[n * 4 + i] = acc[ai][bj][m][n][i];
                    *(v4u*)(YM + (size_t)(row0 + ai * 128 + m * 16) * DM + col0 + bj * 128) = pack8(h);
                }
    }
};
struct MoeOrder {
    const LAS int* ppre; int G, c;
    __device__ __forceinline__ bool next(int i, pg8::Unit& u) const {
        const int L = i * G + c, np = ppre[16];
        if (L >= np * 4) return false;
        const int pm = L >> 2; int e = 0;
#pragma unroll
        for (int k = 1; k < 16; ++k) e += (ppre[k] <= pm) ? 1 : 0;
        u.pm = pm; u.pn = e * 4 + (L & 3); return true;
    }
    __device__ __forceinline__ void a_ready(const pg8::Unit&) const {}
    __device__ __forceinline__ void done(const pg8::Unit&) const {}
};

__device__ __forceinline__ int dest_row(int mode, int n) {
    if (mode == 1) return (n < 1024) ? n : (n < 1040) ? n + 1792 : (n < 2832) ? n - 16 : n;
    if (mode == 2) return (n >> 7) * 256 + (n & 127);
    if (mode == 3) return (n >> 7) * 256 + 128 + (n & 127);
    return n;
}
__device__ __forceinline__ void transpose_item(const float* W, int K, int N, bf16* WT, int mode, LAS unsigned char* scr  , int item, int lane) {
    const int nblk = (N + 63) / 64, kb = item / nblk, nb = item % nblk, k0 = 64 * kb, n0 = 64 * nb;
    const int q = lane & 15, r4 = lane >> 4, col = n0 + 4 * q;
    f32x4 va[8], vb[8];
    const float* wp = W + (size_t)(k0 + 2 * r4) * N + col;
#pragma unroll
    for (int i = 0; i < 8; ++i) {
        if (col < N) { va[i] = *(const f32x4*)(wp + (size_t)(8 * i) * N); vb[i] = *(const f32x4*)(wp + (size_t)(8 * i + 1) * N); }
        else { va[i] = (f32x4){0.f, 0.f, 0.f, 0.f}; vb[i] = va[i]; }
    }
#pragma unroll
    for (int i = 0; i < 8; ++i) {
        const int kp = 4 * i + r4;
        LAS unsigned* t = (LAS unsigned*)(scr + (4 * q) * 144 + 4 * kp);
        t[0] = pk2(va[i].x, vb[i].x); t[36] = pk2(va[i].y, vb[i].y); t[72] = pk2(va[i].z, vb[i].z); t[108] = pk2(va[i].w, vb[i].w);
    }
    LDS_WAIT(); asm volatile("" ::: "memory");
    const int c = lane & 7;
#pragma unroll
    for (int j = 0; j < 8; ++j) { const int n = (lane >> 3) + 8 * j;
        const v4u o = *(const LAS v4u*)(scr + n * 144 + 16 * c);
        if (n0 + n < N) *(GAS v4u*)(WT + (size_t)dest_row(mode, n0 + n) * K + k0 + 8 * c) = o; }
    LDS_WAIT(); asm volatile("" ::: "memory");
}
__device__ __forceinline__ void p0_prologue(Frame& F) {
    LAS float* red = (LAS float*)(F.lds + RING_OFF);
    float* mod = (float*)(F.ws + WS_MOD);
    float* bias1 = (float*)(F.ws + WS_MOD + 131072);
    for (int bi = F.bid; bi < 200; bi += F.G) {
        if (bi < 192) {
            const int l = bi / 96, cg = bi % 96, j = cg * 64 + F.lane;
            float a0 = 0.f, a1 = 0.f;
            const float* wp = F.w_ada + ((size_t)l * 1024 + F.wave * 128) * 6144 + j;
#pragma unroll 16
            for (int k = 0; k < 128; ++k) { const float wv = wp[(size_t)k * 6144]; const float c0 = F.c[F.wave * 128 + k], c1 = F.c[1024 + F.wave * 128 + k];
                a0 += siluf_(c0) * wv; a1 += siluf_(c1) * wv; }
            red[(F.wave * 2 + 0) * 64 + F.lane] = a0; red[(F.wave * 2 + 1) * 64 + F.lane] = a1;
            __syncthreads();
            if (F.tid < 128) { const int b = F.tid >> 6, ln = F.tid & 63; float s = 0.f;
#pragma unroll
                for (int w = 0; w < 8; ++w) s += red[(w * 2 + b) * 64 + ln];
                mod[(size_t)(l * 2 + b) * 6144 + cg * 64 + ln] = s + F.b_ada[l * 6144 + cg * 64 + ln]; }
            __syncthreads();
        } else {
            const int kv = (bi - 192) >> 2, cg = (bi - 192) & 3, j = cg * 64 + F.lane;
            float a0 = 0.f;
            const float* wp = F.cmp_w1 + ((size_t)kv * 2048 + F.wave * 256) * 256 + j; const float* pe = F.cmp_pe + kv * 2048 + F.wave * 256;
#pragma unroll 16
            for (int k = 0; k < 256; ++k) a0 += pe[k] * wp[(size_t)k * 256];
            red[F.wave * 64 + F.lane] = a0;
            __syncthreads();
            if (F.tid < 64) { float s = 0.f;
#pragma unroll
                for (int w = 0; w < 8; ++w) s += red[w * 64 + F.tid];
                bias1[kv * 256 + cg * 64 + F.tid] = s; }
            __syncthreads();
        }
    }
    { bf16* wi = (bf16*)(F.ws + WS_WIN); const int npieces = (NPROJ - C_END) * (DM / 8);
      for (int p = F.bid * 512 + F.tid; p < npieces; p += F.G * 512) *(GAS v4u*)(wi + (size_t)C_END * DM + (size_t)p * 8) = (v4u){0u, 0u, 0u, 0u}; }
    LAS unsigned char* scr = F.lds + RING_OFF + 8192 + F.wave * 12288;
    const int gw = F.bid * 8 + F.wave, NGW = F.G * 8;
    constexpr int I_IN = 16 * 45, I_OUT = 16 * 16, I_INC = 16 * 64, I_OUTC = 32 * 16, I_CW1 = 2 * 32 * 4, I_G = 32 * 128, I_U = 32 * 128, I_D = 32 * 128;
    constexpr int NITEMS = I_IN + I_OUT + I_INC + I_OUTC + I_CW1 + I_G + I_U + I_D;
    for (int it = gw; it < NITEMS; it += NGW) {
        int r = it; const float* src; bf16* dst; int K, N, mode = 0;
        if (r < I_IN) { src = F.w_in_ab; dst = (bf16*)(F.ws + WS_WIN); K = 1024; N = 2856; mode = 1; }
        else if ((r -= I_IN) < I_OUT) { src = F.w_out_ab; dst = (bf16*)(F.ws + WS_WOUT); K = 1024; N = 1024; }
        else if ((r -= I_OUT) < I_INC) { src = F.w_in_c; dst = (bf16*)(F.ws + WS_WINC); K = 1024; N = 4096; }
        else if ((r -= I_INC) < I_OUTC) { src = F.w_out_c; dst = (bf16*)(F.ws + WS_WOUTC); K = 2048; N = 1024; }
        else if ((r -= I_OUTC) < I_CW1) { const int m = r >> 7; r &= 127; src = F.cmp_w1 + (size_t)m * 2048 * 256; dst = (bf16*)(F.ws + WS_WCW1) + (size_t)m * 256 * 2048; K = 2048; N = 256; }
        else if ((r -= I_CW1) < I_G) { const int m = r >> 7; r &= 127; src = F.w_gate + (size_t)m * 1024 * 512; dst = (bf16*)(F.ws + WS_WGU) + (size_t)m * 1024 * 1024; K = 1024; N = 512; mode = 2; }
        else if ((r -= I_G) < I_U) { const int m = r >> 7; r &= 127; src = F.w_up + (size_t)m * 1024 * 512; dst = (bf16*)(F.ws + WS_WGU) + (size_t)m * 1024 * 1024; K = 1024; N = 512; mode = 3; }
        else { r -= I_U; const int m = r >> 7; r &= 127; src = F.w_down + (size_t)m * 512 * 1024; dst = (bf16*)(F.ws + WS_WDN) + (size_t)m * 1024 * 512; K = 512; N = 1024; }
        transpose_item(src, K, N, dst, mode, scr, r, F.lane);
    }
}

struct RouteRec { int e0, e1, pos0, pos1; float w0, w1; int slot0, slot1; };
template <bool COMBINE, bool NORM, bool ROUTE>
__device__ __forceinline__ void row_pass(Frame& F, const float* xin, const float* modn  , int sh_off, const float* ng,
                                         const float* modc  , int layer) {
    float* xout = F.out; bf16* H = (bf16*)(F.ws + WS_O);
    const bf16* YM = (const bf16*)(F.ws + WS_A);
    RouteRec* route = (RouteRec*)(F.ws + WS_ROUTE);
    LAS float* wr = (LAS float*)(F.lds + RING_OFF);
    LAS unsigned* lcnt = (LAS unsigned*)(F.lds + TAB_OFF + 256);
    if (ROUTE) {
        for (int idx = F.tid; idx < 16384; idx += 512) wr[(idx & 15) * 1024 + (idx >> 4)] = F.w_router[idx];
        if (F.tid < 32) lcnt[F.tid] = 0u;
        __syncthreads();
    }
    const int gw = F.bid * 8 + F.wave, NGW = F.G * 8;
#pragma unroll 1
    for (int b = 0; b < NB; ++b) {
        f32x4 cs[4], sh[4], gc[4];
#pragma unroll
        for (int j = 0; j < 4; ++j) {
            const int col = 4 * F.lane + 256 * j;
            if (NORM) { const f32x4 g = *(const f32x4*)(ng + col), sc = *(const f32x4*)(modn + b * 6144 + sh_off + 1024 + col); cs[j] = g * (sc + 1.0f); sh[j] = *(const f32x4*)(modn + b * 6144 + sh_off + col); }
            if (COMBINE) gc[j] = *(const f32x4*)(modc + b * 6144 + 5 * 1024 + col);
        }
#pragma unroll 1
        for (int m = b * SEQ + gw; m < (b + 1) * SEQ; m += NGW) {
            f32x4 v[4];
#pragma unroll
            for (int j = 0; j < 4; ++j) v[j] = *(const f32x4*)(xin + (size_t)m * DM + 4 * F.lane + 256 * j);
            if (COMBINE) {
                const RouteRec rr = route[m];
#pragma unroll
                for (int j = 0; j < 4; ++j) {
                    const v2u y0 = *(const v2u*)(YM + (size_t)rr.slot0 * DM + 4 * F.lane + 256 * j), y1 = *(const v2u*)(YM + (size_t)rr.slot1 * DM + 4 * F.lane + 256 * j);
                    f32x4 yy; yy.x = rr.w0 * bflo(y0.x) + rr.w1 * bflo(y1.x); yy.y = rr.w0 * bfhi(y0.x) + rr.w1 * bfhi(y1.x); yy.z = rr.w0 * bflo(y0.y) + rr.w1 * bflo(y1.y); yy.w = rr.w0 * bfhi(y0.y) + rr.w1 * bfhi(y1.y);
                    v[j] = v[j] + gc[j] * yy;
                    *(f32x4*)(xout + (size_t)m * DM + 4 * F.lane + 256 * j) = v[j];
                }
            }
            if (NORM) {
                float s = 0.f;
#pragma unroll
                for (int j = 0; j < 4; ++j) s += (v[j].x * v[j].x + v[j].y * v[j].y) + (v[j].z * v[j].z + v[j].w * v[j].w);
                const float rstd = 1.0f / sqrtf(wave_sum(s) * (1.0f / DM) + NORM_EPS);
#pragma unroll
                for (int j = 0; j < 4; ++j) { v[j] = v[j] * rstd * cs[j] + sh[j];
                    v2u o; o.x = pk2(v[j].x, v[j].y); o.y = pk2(v[j].z, v[j].w);
                    *(v2u*)(H + (size_t)m * DM + 4 * F.lane + 256 * j) = o; }
            }
            if (ROUTE) {
                float lg[16];
#pragma unroll
                for (int eg = 0; eg < 4; ++eg) {
                    float a4[4] = {0.f, 0.f, 0.f, 0.f};
#pragma unroll
                    for (int j = 0; j < 4; ++j)
#pragma unroll
                        for (int ee = 0; ee < 4; ++ee) { const f32x4 w = *(const LAS f32x4*)(wr + (eg * 4 + ee) * 1024 + 4 * F.lane + 256 * j); a4[ee] += (v[j].x * w.x + v[j].y * w.y) + (v[j].z * w.z + v[j].w * w.w); }
#pragma unroll
                    for (int ee = 0; ee < 4; ++ee) lg[eg * 4 + ee] = wave_sum(a4[ee]);
                    __builtin_amdgcn_sched_barrier(0);
                }
                float sc[16], sl[16];
#pragma unroll
                for (int e = 0; e < 16; ++e) { sc[e] = 1.0f / (1.0f + expf(-lg[e])); sl[e] = sc[e] + F.r_bias[e]; }
                float gs[4]; int ge1[4], ge2[4]; float gw1[4], gw2[4];
#pragma unroll
                for (int g = 0; g < 4; ++g) {
                    int i1 = 0; float m1 = sl[4 * g];
#pragma unroll
                    for (int k = 1; k < 4; ++k) if (sl[4 * g + k] > m1) { m1 = sl[4 * g + k]; i1 = k; }
                    int i2 = -1; float m2 = 0.f;
#pragma unroll
                    for (int k = 0; k < 4; ++k) if (k != i1 && (i2 < 0 || sl[4 * g + k] > m2)) { m2 = sl[4 * g + k]; i2 = k; }
                    gs[g] = m1 + m2; ge1[g] = 4 * g + i1; ge2[g] = 4 * g + i2;
                    float w1 = 0.f, w2 = 0.f;
#pragma unroll
                    for (int k = 0; k < 4; ++k) { w1 = (k == i1) ? sc[4 * g + k] : w1; w2 = (k == i2) ? sc[4 * g + k] : w2; }
                    gw1[g] = w1; gw2[g] = w2;
                }
                int gi = 0; float gm = gs[0];
#pragma unroll
                for (int g = 1; g < 4; ++g) if (gs[g] > gm) { gm = gs[g]; gi = g; }
                int e1 = ge1[0], e2 = ge2[0]; float w1 = gw1[0], w2 = gw2[0];
#pragma unroll
                for (int g = 1; g < 4; ++g) if (gi == g) { e1 = ge1[g]; e2 = ge2[g]; w1 = gw1[g]; w2 = gw2[g]; }
                const float ws_ = w1 + w2;
                if (F.lane == 0) {
                    RouteRec rr; rr.e0 = e1; rr.e1 = e2;
                    rr.pos0 = (int)__hip_atomic_fetch_add(lcnt + e1, 1u, __ATOMIC_RELAXED, __HIP_MEMORY_SCOPE_WORKGROUP);
                    rr.pos1 = (int)__hip_atomic_fetch_add(lcnt + e2, 1u, __ATOMIC_RELAXED, __HIP_MEMORY_SCOPE_WORKGROUP);
                    rr.w0 = w1 / ws_; rr.w1 = w2 / ws_; rr.slot0 = 0; rr.slot1 = 0;
                    route[m] = rr;
                }
            }
        }
    }
    if (ROUTE) {
        __syncthreads();
        if (F.tid < 16) { unsigned* cnt = (unsigned*)(F.ctl + CW_CNT + 1024 * layer + 64 * F.tid); lcnt[16 + F.tid] = atomicAdd(cnt, lcnt[F.tid]); }
        __syncthreads();
        if (F.lane == 0) {
#pragma unroll 1
            for (int m = gw; m < NTOK; m += NGW) { route[m].pos0 += (int)lcnt[16 + route[m].e0]; route[m].pos1 += (int)lcnt[16 + route[m].e1]; }
        }
    }
}

__device__ __forceinline__ void moe_tables(Frame& F, int layer) {
    LAS int* ppre = (LAS int*)(F.lds + TAB_OFF);
    if (F.tid == 0) { const unsigned* cnt = (const unsigned*)(F.ctl + CW_CNT + 1024 * layer); int acc = 0;
        for (int e = 0; e < 16; ++e) { ppre[e] = acc; acc += ((int)cnt[64 * e] + 255) >> 8; }
        ppre[16] = acc; }
    __syncthreads();
}
__device__ __forceinline__ void moe_gather(Frame& F, int layer) {
    moe_tables(F, layer);
    const LAS int* ppre = (const LAS int*)(F.lds + TAB_OFF);
    RouteRec* route = (RouteRec*)(F.ws + WS_ROUTE);
    const bf16* H = (const bf16*)(F.ws + WS_O); bf16* HS = (bf16*)(F.ws + WS_A);
    const int gw = F.bid * 8 + F.wave, NGW = F.G * 8;
    for (int m = gw; m < NTOK; m += NGW) {
        RouteRec rr = route[m];
        int p0 = 0, p1 = 0;
#pragma unroll
        for (int e = 0; e < 16; ++e) { p0 = (rr.e0 == e) ? ppre[e] : p0; p1 = (rr.e1 == e) ? ppre[e] : p1; }
        const int s0 = p0 * 256 + rr.pos0, s1 = p1 * 256 + rr.pos1;
        const v4u a = *(const v4u*)(H + (size_t)m * DM + 8 * F.lane), b = *(const v4u*)(H + (size_t)m * DM + 512 + 8 * F.lane);
        *(v4u*)(HS + (size_t)s0 * DM + 8 * F.lane) = a; *(v4u*)(HS + (size_t)s0 * DM + 512 + 8 * F.lane) = b;
        *(v4u*)(HS + (size_t)s1 * DM + 8 * F.lane) = a; *(v4u*)(HS + (size_t)s1 * DM + 512 + 8 * F.lane) = b;
        if (F.lane == 0) { route[m].slot0 = s0; route[m].slot1 = s1; }
    }
}

__device__ __forceinline__ f32x4 mma16(const LAS bf16* A, int lda, const LAS bf16* Bt, int ldb, int K, f32x4 acc, int lane) {
    const LAS bf16* ap = A + (lane & 15) * lda + (lane >> 4) * 8;
    const LAS bf16* bp = Bt + (lane & 15) * ldb + (lane >> 4) * 8;
    for (int k = 0; k < K; k += 32) {
        const bf16x8 a = *(const LAS bf16x8*)(ap + k), b = *(const LAS bf16x8*)(bp + k);
        acc = __builtin_amdgcn_mfma_f32_16x16x32_bf16(a, b, acc, 0, 0, 0);
    }
    return acc;
}

__device__ __forceinline__ void gla_bcum(Frame& F, const bf16* prow  , int h, float (&bc)[8]) {
    float gl[16];
    { const v4u a = *(const v4u*)(prow + C_GLR), b = *(const v4u*)(prow + C_GLR + 8); float t0[8], t1[8]; unpack8(a, t0); unpack8(b, t1);
#pragma unroll
      for (int i = 0; i < 8; ++i) { gl[i] = t0[i]; gl[8 + i] = t1[i]; } }
#pragma unroll
    for (int i = 0; i < 8; ++i) {
        const int col = h * 64 + F.wave * 8 + i;
        float z = F.gla_bg[col];
#pragma unroll
        for (int r = 0; r < 16; ++r) z += gl[r] * F.gla_w2[r * 256 + col];
        const float ls = fminf(z, 0.f) - log1pf(__expf(-fabsf(z)));
        float v = ls * (1.0f / 16.0f);
#pragma unroll
        for (int off = 1; off < 64; off <<= 1) { const float o = __shfl_up(v, off); v += (F.lane >= off) ? o : 0.f; }
        bc[i] = v;
    }
}
__device__ __forceinline__ void gla_stage_vT(Frame& F, const bf16* prow, int h, LAS bf16* VT) {
    const v4u a = *(const v4u*)(prow + C_GV + h * 128 + F.wave * 16), b = *(const v4u*)(prow + C_GV + h * 128 + F.wave * 16 + 8);
    const unsigned w[8] = {a.x, a.y, a.z, a.w, b.x, b.y, b.z, b.w};
#pragma unroll
    for (int i = 0; i < 8; ++i) { VT[(F.wave * 16 + 2 * i) * 72 + F.lane] = (bf16)(w[i] & 0xffffu); VT[(F.wave * 16 + 2 * i + 1) * 72 + F.lane] = (bf16)(w[i] >> 16); }
}
__device__ __forceinline__ void gla_prep_item(Frame& F, int item) {
    const int h = item & 3, n = (item >> 2) & 127, b = item >> 9;
    const bf16* proj = (const bf16*)(F.ws + WS_A);
    const bf16* prow = proj + (size_t)(b * SEQ + n * 64 + F.lane) * NPROJ;
    LAS bf16* KT = (LAS bf16*)(F.lds + RING_OFF);
    LAS bf16* VT = (LAS bf16*)(F.lds + RING_OFF + 9216);
    float bc[8]; gla_bcum(F, prow, h, bc);
    float kf[8]; { const v4u kk = *(const v4u*)(prow + C_GK + h * 64 + F.wave * 8); unpack8(kk, kf); }
    float* DEC = (float*)(F.ws + WS_DEC) + ((size_t)(b * 128 + n) * 4 + h) * 64;
#pragma unroll
    for (int i = 0; i < 8; ++i) {
        const float bl = __shfl(bc[i], 63);
        KT[(F.wave * 8 + i) * 72 + F.lane] = (bf16)f2bf(kf[i] * __expf(bl - bc[i]));
        if (F.lane == 63) DEC[F.wave * 8 + i] = __expf(bl);
    }
    gla_stage_vT(F, prow, h, VT);
    __syncthreads();
    float* KV = (float*)(F.ws + WS_O) + ((size_t)(b * 128 + n) * 4 + h) * 8192;
    const int dt = F.wave >> 1;
#pragma unroll
    for (int j = 0; j < 4; ++j) {
        const int et = (F.wave & 1) * 4 + j;
        f32x4 acc = {0.f, 0.f, 0.f, 0.f};
        acc = mma16(KT + dt * 16 * 72, 72, VT + et * 16 * 72, 72, 64, acc, F.lane);
#pragma unroll
        for (int i = 0; i < 4; ++i) KV[(dt * 16 + 4 * (F.lane >> 4) + i) * 128 + et * 16 + (F.lane & 15)] = acc[i];
    }
    __syncthreads();
}
__device__ __forceinline__ void gla_scan(Frame& F, int gidx) {
    const int bh = gidx >> 13, de = gidx & 8191, b = bh >> 2, h = bh & 3;
    float* KV = (float*)(F.ws + WS_O) + ((size_t)(b * 128) * 4 + h) * 8192 + de;
    const float* DEC = (const float*)(F.ws + WS_DEC) + ((size_t)(b * 128) * 4 + h) * 64 + (de >> 7);
    float st = 0.f;
#pragma unroll 1
    for (int n0 = 0; n0 < 128; n0 += 8) {
        float kv[8], dc[8];
#pragma unroll
        for (int i = 0; i < 8; ++i) { kv[i] = KV[(size_t)(n0 + i) * 4 * 8192]; dc[i] = DEC[(size_t)(n0 + i) * 4 * 64]; }
#pragma unroll
        for (int i = 0; i < 8; ++i) { KV[(size_t)(n0 + i) * 4 * 8192] = st; st = dc[i] * st + kv[i]; }
    }
}
__device__ __forceinline__ void gla_out_item(Frame& F, int item) {
    const int h = item & 3, n = (item >> 2) & 127, b = item >> 9;
    const bf16* proj = (const bf16*)(F.ws + WS_A);
    const size_t tok = (size_t)b * SEQ + n * 64 + F.lane;
    const bf16* prow = proj + tok * NPROJ;
    LAS bf16* A1 = (LAS bf16*)(F.lds + RING_OFF);
    LAS bf16* B1 = (LAS bf16*)(F.lds + RING_OFF + 9216);
    LAS bf16* A2 = (LAS bf16*)(F.lds + RING_OFF + 18432);
    LAS bf16* SC = (LAS bf16*)(F.lds + RING_OFF + 27648);
    LAS bf16* VT = (LAS bf16*)(F.lds + RING_OFF + 36864);
    LAS bf16* ST = (LAS bf16*)(F.lds + RING_OFF + 55296);
    LAS float* OS = (LAS float*)(F.lds + RING_OFF + 73728);
    float bc[8]; gla_bcum(F, prow, h, bc);
    float qf[8], kf[8];
    { const v4u qq = *(const v4u*)(prow + C_GQ + h * 64 + F.wave * 8), kk = *(const v4u*)(prow + C_GK + h * 64 + F.wave * 8); unpack8(qq, qf); unpack8(kk, kf); }
    float a1[8], b1[8], a2[8];
#pragma unroll
    for (int i = 0; i < 8; ++i) {
        const float bm = __shfl(bc[i], 32);
        a1[i] = qf[i] * 0.125f * __expf(bc[i] - bm); b1[i] = kf[i] * __expf(bm - bc[i]); a2[i] = qf[i] * 0.125f * __expf(bc[i]);
    }
    *(LAS v4u*)(A1 + F.lane * 72 + F.wave * 8) = pack8(a1);
    *(LAS v4u*)(B1 + F.lane * 72 + F.wave * 8) = pack8(b1);
    *(LAS v4u*)(A2 + F.lane * 72 + F.wave * 8) = pack8(a2);
    gla_stage_vT(F, prow, h, VT);
    { const float* KV = (const float*)(F.ws + WS_O) + ((size_t)(b * 128 + n) * 4 + h) * 8192;
#pragma unroll
      for (int k = 0; k < 16; ++k) { const int p = F.tid + 512 * k, e = p & 127, d = p >> 7; ST[e * 72 + d] = (bf16)f2bf(KV[d * 128 + e]); } }
    __syncthreads();
    const int it = F.wave >> 1;
#pragma unroll
    for (int jj = 0; jj < 2; ++jj) {
        const int jt = (F.wave & 1) * 2 + jj;
        f32x4 acc = {0.f, 0.f, 0.f, 0.f};
        if (jt <= it) acc = mma16(A1 + it * 16 * 72, 72, B1 + jt * 16 * 72, 72, 64, acc, F.lane);
#pragma unroll
        for (int i = 0; i < 4; ++i) { const int ri = it * 16 + 4 * (F.lane >> 4) + i, cj = jt * 16 + (F.lane & 15); SC[ri * 72 + cj] = (bf16)f2bf((cj <= ri) ? acc[i] : 0.f); }
    }
    __syncthreads();
#pragma unroll
    for (int j = 0; j < 4; ++j) {
        const int et = (F.wave & 1) * 4 + j;
        f32x4 acc = {0.f, 0.f, 0.f, 0.f};
        acc = mma16(SC + it * 16 * 72, 72, VT + et * 16 * 72, 72, 64, acc, F.lane);
        acc = mma16(A2 + it * 16 * 72, 72, ST + et * 16 * 72, 72, 64, acc, F.lane);
#pragma unroll
        for (int i = 0; i < 4; ++i) OS[(it * 16 + 4 * (F.lane >> 4) + i) * 132 + et * 16 + (F.lane & 15)] = acc[i];
    }
    __syncthreads();
    { const int row = F.tid >> 3, c0 = (F.tid & 7) * 16;
      float v[16]; float ss = 0.f;
#pragma unroll
      for (int i = 0; i < 16; ++i) { v[i] = OS[row * 132 + c0 + i]; ss += v[i] * v[i]; }
      ss += __shfl_xor(ss, 1); ss += __shfl_xor(ss, 2); ss += __shfl_xor(ss, 4);
      const float rstd = 1.0f / sqrtf(ss * (1.0f / 128.0f) + NORM_EPS);
      const size_t tk = (size_t)b * SEQ + n * 64 + row;
      const bf16* rrow = proj + tk * NPROJ + C_GR + h * 128 + c0;
      float r0[8], r1[8]; unpack8(*(const v4u*)rrow, r0); unpack8(*(const v4u*)(rrow + 8), r1);
      float o0[8], o1[8];
#pragma unroll
      for (int i = 0; i < 8; ++i) { o0[i] = v[i] * rstd * F.gla_ng[c0 + i] * siluf_(r0[i]); o1[i] = v[8 + i] * rstd * F.gla_ng[c0 + 8 + i] * siluf_(r1[i]); }
      bf16* orow = (bf16*)(F.ws + WS_O + 32 * MiB) + tk * DM + h * 128 + c0;
      *(v4u*)orow = pack8(o0); *(v4u*)(orow + 8) = pack8(o1); }
    __syncthreads();
}

__device__ __forceinline__ double inv_freq_d(int i) {
    return (i == 0) ? 1.0 : (i == 1) ? 0.19392547740471268 : (i == 2) ? 0.037606090787015346 : (i == 3) ? 0.0072927791106285765 :
           (i == 4) ? 0.0014142135623730951 : (i == 5) ? 0.00027425197177757796 : (i == 6) ? 5.318404375373266e-05 : 1.0313741203148838e-05;
}
__device__ __forceinline__ void rope_sincos(int pos, int i, float& cs, float& sn) {
    const double rev = (double)pos * inv_freq_d(i) * 0.15915494309189535;
    const float fr = (float)(rev - rint(rev));
    cs = __builtin_amdgcn_cosf(fr); sn = __builtin_amdgcn_sinf(fr);
}
__device__ __forceinline__ void nsa_prep_token(Frame& F, int tok) {
    const int b = tok >> 13, t = tok & 8191, sub = F.lane & 7, vid = F.lane >> 3;
    const bf16* prow = (const bf16*)(F.ws + WS_A) + (size_t)tok * NPROJ;
    const int pos = F.positions[tok];
    float cs_l, sn_l; rope_sincos(pos, sub, cs_l, sn_l);
    float cs[8], sn[8];
#pragma unroll
    for (int i = 0; i < 8; ++i) { cs[i] = __shfl(cs_l, (F.lane & ~7) + i); sn[i] = __shfl(sn_l, (F.lane & ~7) + i); }
    unsigned char* dob = F.dout_b;
    const size_t ktile_off = (size_t)(t >> 6) * 8192 + sub * 1024 + (t & 63) * 16;
    const size_t vtile_off = (size_t)(t >> 6) * 8192 + (sub >> 2) * 4096 + (t & 63) * 64 + (sub & 3) * 16;
#pragma unroll
    for (int round = 0; round < 3; ++round) {
        int col; int kind; unsigned char* dst; const float* gain = nullptr;
        if (round == 0) { col = C_NQ + vid * 64; kind = 0; gain = F.q_gain; const int g = vid >> 2, hh = vid & 3;
            dst = dob + DO_QN + ((((size_t)(b * 2 + g) * SEQ + t) * 4 + hh) * 64 + sub * 8) * 2; }
        else if (round == 1) {
            const int g = vid & 1, which = vid >> 1;
            const size_t img = (size_t)(b * 2 + g) * (1u << 20);
            if (which == 0) { col = C_KS + g * 64; kind = 1; gain = F.k_gain + 64; dst = dob + DO_KSEL + img + ktile_off; }
            else if (which == 1) { col = C_KW + g * 64; kind = 1; gain = F.k_gain + 128; dst = dob + DO_KWIN + img + ktile_off; }
            else if (which == 2) { col = C_VS + g * 64; kind = 2; dst = dob + DO_VSEL + img + vtile_off; }
            else { col = C_VW + g * 64; kind = 2; dst = dob + DO_VWIN + img + vtile_off; }
        } else {
            const int g = vid & 1, which = (vid >> 1) & 1;
            col = (which ? C_VC : C_KC) + g * 64; kind = 2;
            dst = dob + (which ? DO_VC : DO_KC) + (((size_t)(b * 2 + g) * SEQ + t) * 64 + sub * 8) * 2;
        }
        float x[8]; unpack8(*(const v4u*)(prow + col + sub * 8), x);
        if (kind != 2) {
            float ss = 0.f;
#pragma unroll
            for (int i = 0; i < 8; ++i) ss += x[i] * x[i];
            ss += __shfl_xor(ss, 1); ss += __shfl_xor(ss, 2); ss += __shfl_xor(ss, 4);
            const float rstd = 1.0f / sqrtf(ss * (1.0f / 64.0f) + NORM_EPS);
#pragma unroll
            for (int i = 0; i < 8; ++i) x[i] = x[i] * rstd * gain[sub * 8 + i];
            float xo[8];
#pragma unroll
            for (int i = 0; i < 8; ++i) xo[i] = __shfl_xor(x[i], 1);
            if (sub == 0) {
#pragma unroll
                for (int i = 0; i < 8; ++i) x[i] = x[i] * cs[i] - xo[i] * sn[i];
            } else if (sub == 1) {
#pragma unroll
                for (int i = 0; i < 8; ++i) x[i] = x[i] * cs[i] + xo[i] * sn[i];
            }
            if (kind == 0) {
#pragma unroll
                for (int i = 0; i < 8; ++i) x[i] *= 0.125f * 1.4426950408889634f;
            }
        }
        if (round < 2 || F.lane < 32) *(v4u*)dst = pack8(x);
    }
    if (F.lane < 24) { float* gt = (float*)(F.ws + WS_GATES) + (size_t)tok * 24; gt[F.lane] = sigmoidf_(bf2f(prow[C_NG + F.lane])); }
}

__device__ __forceinline__ void nsa_compress_item(Frame& F, int item) {
    const int kv = item >> 6, b = (item >> 5) & 1, g = (item >> 4) & 1, rt = item & 15, n0 = rt * 32;
    const bf16* Asrc = (const bf16*)(F.dout_b + (kv ? DO_VC : DO_KC)) + ((size_t)(b * 2 + g) * SEQ + 16 * n0) * 64;
    const bf16* Bsrc = (const bf16*)(F.ws + WS_WCW1) + (size_t)kv * 256 * 2048;
    LAS bf16* As = (LAS bf16*)(F.lds + RING_OFF);
    LAS bf16* Bs = (LAS bf16*)(F.lds + RING_OFF + 2 * 32 * 72 * 2);
    LAS float* Hs = (LAS float*)(F.lds + RING_OFF + 86016);
    LAS float* W2s = (LAS float*)(F.lds + RING_OFF);
    const int ar = F.tid >> 3, ac = (F.tid & 7) * 8;
    v4u areg = {0u, 0u, 0u, 0u}, breg[4];
#define CMP_GLOAD(kc) do { if (F.tid < 256) areg = *(const v4u*)(Asrc + (size_t)ar * 1024 + (kc) * 64 + ac); \
        _Pragma("unroll") for (int i_ = 0; i_ < 4; ++i_) { const int p_ = F.tid + 512 * i_, br_ = p_ >> 3, bc_ = (p_ & 7) * 8; breg[i_] = *(const v4u*)(Bsrc + (size_t)br_ * 2048 + (kc) * 64 + bc_); } } while (0)
#define CMP_LSTORE(buf) do { if (F.tid < 256) *(LAS v4u*)(As + (buf) * 32 * 72 + ar * 72 + ac) = areg; \
        _Pragma("unroll") for (int i_ = 0; i_ < 4; ++i_) { const int p_ = F.tid + 512 * i_, br_ = p_ >> 3, bc_ = (p_ & 7) * 8; *(LAS v4u*)(Bs + (buf) * 256 * 72 + br_ * 72 + bc_) = breg[i_]; } } while (0)
    f32x4 acc[2][2];
#pragma unroll
    for (int mt = 0; mt < 2; ++mt)
#pragma unroll
        for (int nt = 0; nt < 2; ++nt) acc[mt][nt] = (f32x4){0.f, 0.f, 0.f, 0.f};
    CMP_GLOAD(0); CMP_LSTORE(0); __syncthreads();
#pragma unroll 1
    for (int kc = 0; kc < 32; ++kc) {
        const int buf = kc & 1;
        if (kc + 1 < 32) CMP_GLOAD(kc + 1);
#pragma unroll
        for (int mt = 0; mt < 2; ++mt)
#pragma unroll
            for (int nt = 0; nt < 2; ++nt)
                acc[mt][nt] = mma16(As + buf * 32 * 72 + mt * 16 * 72, 72, Bs + buf * 256 * 72 + (F.wave * 32 + nt * 16) * 72, 72, 64, acc[mt][nt], F.lane);
        if (kc + 1 < 32) CMP_LSTORE(buf ^ 1);
        __syncthreads();
    }
    const float* bias1 = (const float*)(F.ws + WS_MOD + 131072) + kv * 256;
#pragma unroll
    for (int mt = 0; mt < 2; ++mt)
#pragma unroll
        for (int nt = 0; nt < 2; ++nt) { const int col = F.wave * 32 + nt * 16 + (F.lane & 15);
#pragma unroll
            for (int i = 0; i < 4; ++i) Hs[(mt * 16 + 4 * (F.lane >> 4) + i) * 260 + col] = gelu_tanh(acc[mt][nt][i] + bias1[col]); }
    { const float* w2 = F.cmp_w2 + (size_t)kv * 256 * 64;
#pragma unroll
      for (int i = 0; i < 8; ++i) *(LAS f32x4*)(W2s + (F.tid + 512 * i) * 4) = *(const f32x4*)(w2 + (size_t)(F.tid + 512 * i) * 4); }
    __syncthreads();
    const int r = F.tid >> 4, dq = F.tid & 15;
    f32x4 o = {0.f, 0.f, 0.f, 0.f};
#pragma unroll 8
    for (int j = 0; j < 256; ++j) { const float hv = Hs[r * 260 + j]; const f32x4 w = *(const LAS f32x4*)(W2s + j * 64 + 4 * dq); o = o + w * hv; }
    const int n = n0 + r;
    if (kv == 0) {
        float ss = (o.x * o.x + o.y * o.y) + (o.z * o.z + o.w * o.w);
        ss += __shfl_xor(ss, 1); ss += __shfl_xor(ss, 2); ss += __shfl_xor(ss, 4); ss += __shfl_xor(ss, 8);
        const float rstd = 1.0f / sqrtf(ss * (1.0f / 64.0f) + NORM_EPS);
        const f32x4 gn = *(const f32x4*)(F.k_gain + 4 * dq);
        o = o * rstd * gn;
        const int tlast = (16 * n + 31 < SEQ) ? 16 * n + 31 : SEQ - 1;
        const int pos = F.positions[b * SEQ + tlast];
        f32x4 po; po.x = __shfl_xor(o.x, 2); po.y = __shfl_xor(o.y, 2); po.z = __shfl_xor(o.z, 2); po.w = __shfl_xor(o.w, 2);
        if (dq < 4) {
            const int i0 = 4 * (dq & 1);
            float c0, s0, c1, s1, c2, s2, c3, s3;
            rope_sincos(pos, i0, c0, s0); rope_sincos(pos, i0 + 1, c1, s1); rope_sincos(pos, i0 + 2, c2, s2); rope_sincos(pos, i0 + 3, c3, s3);
            if (dq < 2) { o.x = o.x * c0 - po.x * s0; o.y = o.y * c1 - po.y * s1; o.z = o.z * c2 - po.z * s2; o.w = o.w * c3 - po.w * s3; }
            else { o.x = o.x * c0 + po.x * s0; o.y = o.y * c1 + po.y * s1; o.z = o.z * c2 + po.z * s2; o.w = o.w * c3 + po.w * s3; }
        }
    }
    if (n == 511) o = (f32x4){0.f, 0.f, 0.f, 0.f};
    v2u pk; pk.x = pk2(o.x, o.y); pk.y = pk2(o.z, o.w);
    const int c = dq >> 1;
    unsigned char* img = F.dout_b + (kv ? DO_VCMP : DO_KCMP) + (size_t)(b * 2 + g) * 65536 + (size_t)(n >> 6) * 8192;
    if (kv == 0) *(v2u*)(img + c * 1024 + (n & 63) * 16 + (dq & 1) * 8) = pk;
    else *(v2u*)(img + (c >> 2) * 4096 + (n & 63) * 64 + (c & 3) * 16 + (dq & 1) * 8) = pk;
    __syncthreads();
}

constexpr int NSA_KB = 0, NSA_VB = 16384, NSA_IMP = 32768, NSA_SELM = 65536;
__device__ __forceinline__ int crow(int r, int hi) { return (r & 3) + 8 * (r >> 2) + 4 * hi; }
__device__ __forceinline__ s16x4 ds_tr16(const LAS unsigned char* p) { return __builtin_bit_cast(s16x4, __builtin_amdgcn_ds_read_tr16_b64_v4i16((LAS s16x4*)p)); }

__device__ __forceinline__ unsigned cvtpk(float lo, float hi) { unsigned r; asm("v_cvt_pk_bf16_f32 %0, %1, %2" : "=v"(r) : "v"(lo), "v"(hi)); return r; }
__device__ __forceinline__ float xhalf_max(float v) { const auto rr = __builtin_amdgcn_permlane32_swap(__float_as_uint(v), __float_as_uint(v), false, false); return fmaxf(__uint_as_float(rr[0]), __uint_as_float(rr[1])); }
constexpr float NSA_THR = 8.0f;

template <int MODE>
__device__ __forceinline__ void nsa_branch(Frame& F, const unsigned char* Kimg, const unsigned char* Vimg, int kt0, int kt1, const bf16x8 (&qr)[4],
                                           float& m, float& l, f32x16 (&o)[2], int t, int tw0, int nv, int nvw, int nvmin,
                                           unsigned mk0, unsigned mk1, unsigned mk2, unsigned mk3, unsigned wo0, unsigned wo1, unsigned wo2, unsigned wo3,
                                           float cinit  , LAS float* impw) {
    const int r32 = F.lane & 31, hi = F.lane >> 5, tokl = r32 >> 2;
    LAS unsigned char* KB = F.lds + RING_OFF + NSA_KB; LAS unsigned char* VB = F.lds + RING_OFF + NSA_VB;
    const v4u* kg = (const v4u*)Kimg + F.tid; const v4u* vg = (const v4u*)Vimg + F.tid;
    v4u kreg = kg[(size_t)kt0 * 512], vreg = {0u, 0u, 0u, 0u};
    if (MODE != 0) vreg = vg[(size_t)kt0 * 512];
    *(LAS v4u*)(KB + F.tid * 16) = kreg; if (MODE != 0) *(LAS v4u*)(VB + F.tid * 16) = vreg;
    __syncthreads();
#pragma unroll 1
    for (int kt = kt0; kt < kt1; ++kt) {
        const int buf = (kt - kt0) & 1; const bool has_next = kt + 1 < kt1;
        if (has_next) { kreg = kg[(size_t)(kt + 1) * 512]; if (MODE != 0) vreg = vg[(size_t)(kt + 1) * 512]; }
        const LAS unsigned char* Kb = KB + buf * 8192; const LAS unsigned char* Vb = VB + buf * 8192;
        bool need;
        if (MODE <= 1) need = kt * 64 < nvw;
        else if (MODE == 2) { const unsigned w = (kt < 32) ? wo0 : (kt < 64) ? wo1 : (kt < 96) ? wo2 : wo3; need = (w >> (kt & 31)) & 1u; }
        else need = (kt * 64 <= tw0 + 7) && (kt * 64 + 63 + 512 > tw0);
        bool selbit = true;
        if (MODE == 2) { const unsigned w = (kt < 32) ? mk0 : (kt < 64) ? mk1 : (kt < 96) ? mk2 : mk3; selbit = (w >> (kt & 31)) & 1u; }
        if (need) {
#pragma unroll 1
            for (int kb = 0; kb < 2; ++kb) {
                const int key0 = kt * 64 + kb * 32;
                bool fast;
                if (MODE == 2) fast = kt < (tw0 >> 6);
                else if (MODE == 3) fast = (key0 + 31 <= tw0) && (key0 + 512 > tw0 + 7);
                else fast = key0 + 31 < nvmin;
                if (MODE != 1) fast = fast && !__any(m < -1e29f);
                float c0 = 0.f;
                if (fast) c0 = (MODE == 1) ? cinit : ((MODE == 2 && !selbit) ? -1e30f : -m);
                f32x16 p;
#pragma unroll
                for (int r = 0; r < 16; ++r) p[r] = c0;
#pragma unroll
                for (int d0 = 0; d0 < 4; ++d0) {
                    const bf16x8 kf = *(const LAS bf16x8*)(Kb + (2 * d0 + hi) * 1024 + (32 * kb + r32) * 16);
                    p = __builtin_amdgcn_mfma_f32_32x32x16_bf16(kf, qr[d0], p, 0, 0, 0);
                }
                float pe[16];
                if (fast) {
                    if (MODE != 1) {
                        float mx = fmaxf(fmaxf(p[0], p[1]), p[2]);
#pragma unroll
                        for (int r = 3; r < 15; r += 2) mx = fmaxf(fmaxf(mx, p[r]), p[r + 1]);
                        mx = xhalf_max(fmaxf(mx, p[15]));
                        if (__any(mx > NSA_THR)) {
                            const float dl = fmaxf(mx, 0.f), alpha = fexp2(-dl);
                            m += dl; l *= alpha;
#pragma unroll
                            for (int r = 0; r < 16; ++r) p[r] -= dl;
                            if (MODE != 0) {
#pragma unroll
                                for (int r = 0; r < 16; ++r) { o[0][r] *= alpha; o[1][r] *= alpha; }
                            }
                        }
                    }
                    float ps0 = 0.f, ps1 = 0.f;
#pragma unroll
                    for (int r = 0; r < 16; r += 2) { pe[r] = fexp2(p[r]); pe[r + 1] = fexp2(p[r + 1]); ps0 += pe[r]; ps1 += pe[r + 1]; }
                    if (MODE != 1) l += ps0 + ps1;
                } else if (MODE == 1) {
#pragma unroll
                    for (int r = 0; r < 16; ++r) { const int key = key0 + crow(r, hi); pe[r] = (key < nv) ? fexp2(p[r] + cinit) : 0.f; }
                } else {
                    float mx = NEGBIG;
#pragma unroll
                    for (int r = 0; r < 16; ++r) {
                        const int key = key0 + crow(r, hi); bool ok;
                        if (MODE == 0) ok = key < nv;
                        else if (MODE == 2) ok = selbit && (kt < (t >> 6) || key <= t);
                        else ok = (key <= t) && (key + 512 > t);
                        p[r] = ok ? p[r] : NEGBIG; mx = fmaxf(mx, p[r]);
                    }
                    mx = xhalf_max(mx);
                    const float mn = fmaxf(m, mx), alpha = fexp2(m - mn);
                    float ps = 0.f;
#pragma unroll
                    for (int r = 0; r < 16; ++r) { pe[r] = (p[r] > -1e29f) ? fexp2(p[r] - mn) : 0.f; ps += pe[r]; }
                    l = l * alpha + ps; m = mn;
                    if (MODE != 0) {
#pragma unroll
                        for (int r = 0; r < 16; ++r) { o[0][r] *= alpha; o[1][r] *= alpha; }
                    }
                }
                if (MODE == 1) {
#pragma unroll
                    for (int rg = 0; rg < 4; ++rg) {
                        float a = (pe[4 * rg] + pe[4 * rg + 1]) + (pe[4 * rg + 2] + pe[4 * rg + 3]), sp = pe[4 * rg + 3];
                        a += __shfl_xor(a, 1); a += __shfl_xor(a, 2); sp += __shfl_xor(sp, 1); sp += __shfl_xor(sp, 2);
                        if ((r32 & 3) == 0) { const int jp = (key0 >> 2) + 2 * rg + hi;
                            __hip_atomic_fetch_add(impw + tokl * 128 + jp, a, __ATOMIC_RELAXED, __HIP_MEMORY_SCOPE_WORKGROUP);
                            if (jp + 1 < 128) __hip_atomic_fetch_add(impw + tokl * 128 + jp + 1, sp, __ATOMIC_RELAXED, __HIP_MEMORY_SCOPE_WORKGROUP); }
                    }
                }
                if (MODE != 0) {
                    v4u pw0, pw1;
                    pw0.x = cvtpk(pe[0], pe[1]); pw0.y = cvtpk(pe[2], pe[3]); pw0.z = cvtpk(pe[4], pe[5]); pw0.w = cvtpk(pe[6], pe[7]);
                    pw1.x = cvtpk(pe[8], pe[9]); pw1.y = cvtpk(pe[10], pe[11]); pw1.z = cvtpk(pe[12], pe[13]); pw1.w = cvtpk(pe[14], pe[15]);
                    const bf16x8 pf0 = __builtin_bit_cast(bf16x8, pw0), pf1 = __builtin_bit_cast(bf16x8, pw1);
                    const LAS unsigned char* vb = Vb + (32 * kb + 4 * hi + ((F.lane & 15) >> 2)) * 64 + ((F.lane >> 4) & 1) * 32 + (F.lane & 3) * 8;
#pragma unroll
                    for (int dh = 0; dh < 2; ++dh) {
                        const s16x4 a0 = ds_tr16(vb + dh * 4096), a1 = ds_tr16(vb + dh * 4096 + 512), b0 = ds_tr16(vb + dh * 4096 + 1024), b1 = ds_tr16(vb + dh * 4096 + 1024 + 512);
                        const bf16x8 vf0 = {a0[0], a0[1], a0[2], a0[3], a1[0], a1[1], a1[2], a1[3]}, vf1 = {b0[0], b0[1], b0[2], b0[3], b1[0], b1[1], b1[2], b1[3]};
                        o[dh] = __builtin_amdgcn_mfma_f32_32x32x16_bf16(vf0, pf0, o[dh], 0, 0, 0);
                        o[dh] = __builtin_amdgcn_mfma_f32_32x32x16_bf16(vf1, pf1, o[dh], 0, 0, 0);
                    }
                }
            }
        }
        if (has_next) { *(LAS v4u*)(KB + (buf ^ 1) * 8192 + F.tid * 16) = kreg; if (MODE != 0) *(LAS v4u*)(VB + (buf ^ 1) * 8192 + F.tid * 16) = vreg; }
        __syncthreads();
    }
}

__device__ __forceinline__ void nsa_item(Frame& F, int b, int g, int qi) {
    const int r32 = F.lane & 31, hi = F.lane >> 5, tokl = r32 >> 2, hh = r32 & 3;
    const int t0 = qi * 64, tw0 = t0 + 8 * F.wave, t = tw0 + tokl;
    const unsigned char* dob = F.dout_b;
    const size_t img = (size_t)(b * 2 + g) * (1u << 20);
    LAS float* impw = (LAS float*)(F.lds + RING_OFF + NSA_IMP) + F.wave * 1024;
    LAS unsigned* selm = (LAS unsigned*)(F.lds + RING_OFF + NSA_SELM) + F.wave * 32;
#pragma unroll
    for (int i = 0; i < 16; ++i) impw[F.lane + 64 * i] = 0.f;
    bf16x8 qr[4];
    { const bf16* qrow = (const bf16*)(dob + DO_QN) + (((size_t)(b * 2 + g) * SEQ + tw0) * 4 + r32) * 64;
#pragma unroll
      for (int d0 = 0; d0 < 4; ++d0) qr[d0] = *(const bf16x8*)(qrow + 16 * d0 + 8 * hi); }
    const float* gt = (const float*)(F.ws + WS_GATES) + ((size_t)b * SEQ + t) * 24 + (g * 4 + hh) * 3;
#if defined(NSA_ZERO_CMP)
    const float g0 = 0.f, g1 = gt[1], g2 = gt[2];
#elif defined(NSA_ZERO_SEL)
    const float g0 = gt[0], g1 = 0.f, g2 = gt[2];
#elif defined(NSA_ZERO_WIN)
    const float g0 = gt[0], g1 = gt[1], g2 = 0.f;
#elif defined(NSA_ZERO_ALL)
    const float g0 = 0.f, g1 = 0.f, g2 = 0.f;
#else
    const float g0 = gt[0], g1 = gt[1], g2 = gt[2];
#endif
    f32x16 oacc[2], o[2];
#pragma unroll
    for (int r = 0; r < 16; ++r) { oacc[0][r] = 0.f; oacc[1][r] = 0.f; }
    const int nv = (t >= 31) ? ((t - 31) >> 4) + 1 : 0, nvw = (tw0 + 7 >= 31) ? ((tw0 + 7 - 31) >> 4) + 1 : 0, nvmin = (tw0 >= 31) ? ((tw0 - 31) >> 4) + 1 : 0;
    const int nct = (4 * qi + 3 + 63) >> 6;
    const unsigned char* Kc = dob + DO_KCMP + (size_t)(b * 2 + g) * 65536; const unsigned char* Vc = dob + DO_VCMP + (size_t)(b * 2 + g) * 65536;
    float m = NEGBIG, l = 0.f;
    nsa_branch<0>(F, Kc, Vc, 0, nct, qr, m, l, o, t, tw0, nv, nvw, nvmin, 0u, 0u, 0u, 0u, 0u, 0u, 0u, 0u, 0.f, impw);
    { const float lt = l + __shfl_xor(l, 32); const float cinit = (lt > 0.f) ? -__log2f(lt) - m : -1e30f;
#pragma unroll
      for (int r = 0; r < 16; ++r) { o[0][r] = 0.f; o[1][r] = 0.f; }
      nsa_branch<1>(F, Kc, Vc, 0, nct, qr, m, l, o, t, tw0, nv, nvw, nvmin, 0u, 0u, 0u, 0u, 0u, 0u, 0u, 0u, cinit, impw);
#pragma unroll
      for (int r = 0; r < 16; ++r) { oacc[0][r] += g0 * o[0][r]; oacc[1][r] += g0 * o[1][r]; } }
    __syncthreads();
#pragma unroll 1
    for (int tl = 0; tl < 8; ++tl) {
        const int tt = tw0 + tl, cur = tt >> 6, j0 = F.lane, j1 = F.lane + 64;
        const unsigned u0 = (j0 <= cur) ? (__float_as_uint(impw[tl * 128 + j0] + ((j0 == 0 || j0 == cur || j0 == cur - 1) ? 1e4f : 0.f)) + 1u) : 0u;
        const unsigned u1 = (j1 <= cur) ? (__float_as_uint(impw[tl * 128 + j1] + ((j1 == cur || j1 == cur - 1) ? 1e4f : 0.f)) + 1u) : 0u;
        bool s0, s1;
        if (cur < 16) { s0 = (j0 <= cur); s1 = false; }
        else {
            unsigned T = 0u;
#pragma unroll 1
            for (int bit = 31; bit >= 0; --bit) {
                const unsigned cand = T | (1u << bit);
                const int c = __popcll(__ballot(u0 >= cand)) + __popcll(__ballot(u1 >= cand));
                if (c >= 16) T = cand;
            }
            const unsigned long long g0 = __ballot(u0 > T), g1 = __ballot(u1 > T), e0 = __ballot(u0 == T), e1 = __ballot(u1 == T);
            const int need = 16 - (__popcll(g0) + __popcll(g1));
            const unsigned long long below = (F.lane == 0) ? 0ull : (~0ull >> (64 - F.lane));
            const int rank0 = __popcll(e0 & below), rank1 = __popcll(e0) + __popcll(e1 & below);
            s0 = (u0 > T) || (u0 == T && rank0 < need);
            s1 = (u1 > T) || (u1 == T && rank1 < need);
        }
        const unsigned long long m0 = __ballot(s0), m1 = __ballot(s1);
        if (F.lane == 0) { selm[tl * 4 + 0] = (unsigned)m0; selm[tl * 4 + 1] = (unsigned)(m0 >> 32); selm[tl * 4 + 2] = (unsigned)m1; selm[tl * 4 + 3] = (unsigned)(m1 >> 32); }
    }
    __syncthreads();
    const unsigned mk0 = selm[tokl * 4 + 0], mk1 = selm[tokl * 4 + 1], mk2 = selm[tokl * 4 + 2], mk3 = selm[tokl * 4 + 3];
    unsigned wo0 = 0u, wo1 = 0u, wo2 = 0u, wo3 = 0u;
#pragma unroll
    for (int tl = 0; tl < 8; ++tl) { wo0 |= selm[tl * 4 + 0]; wo1 |= selm[tl * 4 + 1]; wo2 |= selm[tl * 4 + 2]; wo3 |= selm[tl * 4 + 3]; }
    wo0 = __builtin_amdgcn_readfirstlane(wo0); wo1 = __builtin_amdgcn_readfirstlane(wo1); wo2 = __builtin_amdgcn_readfirstlane(wo2); wo3 = __builtin_amdgcn_readfirstlane(wo3);
    { m = NEGBIG; l = 0.f;
#pragma unroll
      for (int r = 0; r < 16; ++r) { o[0][r] = 0.f; o[1][r] = 0.f; }
      nsa_branch<2>(F, dob + DO_KSEL + img, dob + DO_VSEL + img, 0, qi + 1, qr, m, l, o, t, tw0, nv, nvw, nvmin, mk0, mk1, mk2, mk3, wo0, wo1, wo2, wo3, 0.f, impw);
      const float lt = l + __shfl_xor(l, 32); const float sc = (lt > 0.f) ? g1 / lt : 0.f;
#pragma unroll
      for (int r = 0; r < 16; ++r) { oacc[0][r] += sc * o[0][r]; oacc[1][r] += sc * o[1][r]; } }
    { m = NEGBIG; l = 0.f;
#pragma unroll
      for (int r = 0; r < 16; ++r) { o[0][r] = 0.f; o[1][r] = 0.f; }
      nsa_branch<3>(F, dob + DO_KWIN + img, dob + DO_VWIN + img, (qi >= 8) ? qi - 8 : 0, qi + 1, qr, m, l, o, t, tw0, nv, nvw, nvmin, 0u, 0u, 0u, 0u, 0u, 0u, 0u, 0u, 0.f, impw);
      const float lt = l + __shfl_xor(l, 32); const float sc = (lt > 0.f) ? g2 / lt : 0.f;
#pragma unroll
      for (int r = 0; r < 16; ++r) { oacc[0][r] += sc * o[0][r]; oacc[1][r] += sc * o[1][r]; } }
    bf16* orow = (bf16*)(F.ws + WS_O + 32 * MiB) + ((size_t)b * SEQ + t) * DM + 512 + (g * 4 + hh) * 64;
#pragma unroll
    for (int dh = 0; dh < 2; ++dh)
#pragma unroll
        for (int rg = 0; rg < 4; ++rg) { v2u w; w.x = pk2(oacc[dh][4 * rg], oacc[dh][4 * rg + 1]); w.y = pk2(oacc[dh][4 * rg + 2], oacc[dh][4 * rg + 3]);
            *(v2u*)(orow + 32 * dh + 8 * rg + 4 * hi) = w; }
    __syncthreads();
}

__device__ __forceinline__ void sgu_item(Frame& F, int item) {
    const int gg = item & 7, ck = (item >> 3) & 63, b = item >> 9;
    const size_t tok0 = (size_t)b * SEQ + ck * 128;
    const bf16* Z = (const bf16*)(F.ws + WS_A);
    LAS bf16* Ws = (LAS bf16*)(F.lds + RING_OFF);
    LAS bf16* VT = (LAS bf16*)(F.lds + RING_OFF + 34816);
    LAS float* rs = (LAS float*)(F.lds + RING_OFF + 34816 + 69632);
    if (F.tid < 128) { const float* st = (const float*)(F.ws + WS_STATS) + (tok0 + F.tid) * 32; float s = 0.f;
#pragma unroll
        for (int k = 0; k < 32; k += 4) { const f32x4 v = *(const f32x4*)(st + k); s += (v.x + v.y) + (v.z + v.w); }
        rs[F.tid] = 1.0f / sqrtf(s * (1.0f / SGW) + NORM_EPS); }
    { const float* wsrc = F.sgu_ws + (size_t)gg * 128 * 128;
#pragma unroll
      for (int k = 0; k < 8; ++k) { const int p = F.tid + 512 * k, tr = p >> 5, sc = (p & 31) * 4; const f32x4 w = *(const f32x4*)(wsrc + tr * 128 + sc);
          v2u o; o.x = pk2((sc <= tr) ? w.x : 0.f, (sc + 1 <= tr) ? w.y : 0.f); o.y = pk2((sc + 2 <= tr) ? w.z : 0.f, (sc + 3 <= tr) ? w.w : 0.f);
          *(LAS v2u*)(Ws + tr * 136 + sc) = o; } }
    __syncthreads();
#pragma unroll 2
    for (int k = 0; k < 8; ++k) {
        const int p = F.tid + 512 * k, s = p & 127, cc = p >> 7;
        float x[8]; unpack8(*(const v4u*)(Z + (tok0 + s) * 4096 + 2048 + gg * 256 + cc * 8), x);
        const float rr = rs[s];
#pragma unroll
        for (int i = 0; i < 8; ++i) VT[(cc * 8 + i) * 136 + s] = (bf16)f2bf(x[i] * rr * F.sgu_ng[gg * 256 + cc * 8 + i]);
    }
    __syncthreads();
    f32x4 acc[16];
#pragma unroll
    for (int nt = 0; nt < 16; ++nt) acc[nt] = (f32x4){0.f, 0.f, 0.f, 0.f};
    const int ksteps = (16 * F.wave + 16 + 31) >> 5;
    const LAS bf16* ap = Ws + (16 * F.wave + (F.lane & 15)) * 136 + (F.lane >> 4) * 8;
    const LAS bf16* bp = VT + (F.lane & 15) * 136 + (F.lane >> 4) * 8;
#pragma unroll 1
    for (int kk = 0; kk < ksteps; ++kk) {
        const bf16x8 a = *(const LAS bf16x8*)(ap + kk * 32);
#pragma unroll
        for (int nt = 0; nt < 16; ++nt) { const bf16x8 bb = *(const LAS bf16x8*)(bp + nt * 16 * 136 + kk * 32); acc[nt] = __builtin_amdgcn_mfma_f32_16x16x32_bf16(a, bb, acc[nt], 0, 0, 0); }
    }
    bf16* UM = (bf16*)(F.ws + WS_O);
#pragma unroll
    for (int i = 0; i < 4; ++i) {
        const int tr = 16 * F.wave + 4 * (F.lane >> 4) + i; const float bs = F.sgu_bs[gg * 128 + tr];
        const bf16* urow = Z + (tok0 + tr) * 4096 + gg * 256; bf16* orow = UM + (tok0 + tr) * SGW + gg * 256;
#pragma unroll
        for (int nt = 0; nt < 16; ++nt) { const int c = nt * 16 + (F.lane & 15); orow[c] = (bf16)f2bf(bf2f(urow[c]) * (acc[nt][i] + bs)); }
    }
    __syncthreads();
}

constexpr int NPHASE = 20;
struct Args { const void* in[26]; float* out; unsigned char* ws; int ph_lo, ph_hi, use_bar, pad; };
__global__ void __launch_bounds__(512, 2) trunk_fwd(Args args) {
    extern __shared__ __attribute__((aligned(16))) unsigned char lds[];
    Frame F;
    F.lds = (LAS unsigned char*)lds;
    F.MISC = (volatile LAS unsigned*)(F.lds + MISC_OFF);
    F.tid = threadIdx.x; F.lane = F.tid & 63; F.wave = __builtin_amdgcn_readfirstlane(F.tid >> 6);
    F.G = gridDim.x; F.bid = blockIdx.x;
    F.ws = args.ws; F.out = args.out; F.dout_b = (unsigned char*)args.out;
    F.ctl = (gu32*)(args.ws + WS_CTL);
    F.x = (const float*)args.in[0]; F.c = (const float*)args.in[1]; F.positions = (const int*)args.in[2]; F.w_ada = (const float*)args.in[3]; F.b_ada = (const float*)args.in[4];
    F.norm_g = (const float*)args.in[5]; F.w_in_ab = (const float*)args.in[6]; F.w_out_ab = (const float*)args.in[7]; F.gla_w2 = (const float*)args.in[8]; F.gla_bg = (const float*)args.in[9];
    F.gla_ng = (const float*)args.in[10]; F.q_gain = (const float*)args.in[11]; F.k_gain = (const float*)args.in[12]; F.cmp_pe = (const float*)args.in[13]; F.cmp_w1 = (const float*)args.in[14];
    F.cmp_w2 = (const float*)args.in[15]; F.w_in_c = (const float*)args.in[16]; F.sgu_ng = (const float*)args.in[17]; F.sgu_ws = (const float*)args.in[18]; F.sgu_bs = (const float*)args.in[19];
    F.w_out_c = (const float*)args.in[20]; F.w_router = (const float*)args.in[21]; F.r_bias = (const float*)args.in[22]; F.w_gate = (const float*)args.in[23]; F.w_up = (const float*)args.in[24];
    F.w_down = (const float*)args.in[25];
    for (int u = F.tid; u < (LDS_BYTES - LDSCTL_OFF) / 4; u += 512) ((LAS unsigned*)(F.lds + LDSCTL_OFF))[u] = 0u;
    __syncthreads();
    XcdBarrier bar; bar.bar = (unsigned*)(F.ctl + CW_BAR); bar.x = 0; bar.st = nullptr;
    if (args.use_bar) bar = xcd_barrier_post((unsigned*)(F.ctl + CW_BAR) + (args.use_bar - 1) * XCD_BAR_WORDS, F.MISC + 8);
    const int lo = args.ph_lo, hi = args.ph_hi;
#ifndef PH_MASK
#define PH_MASK 0xFFFFFu
#endif
#define IN(k) ((((PH_MASK) >> (k)) & 1u) && lo <= (k) && (k) < hi)
#if defined(SPIN_PHASE)
    unsigned long long t_mark = __builtin_amdgcn_s_memrealtime();
#define SPIN_HOOK(k) do { if ((k) == (SPIN_PHASE)) { const unsigned long long t1_ = __builtin_amdgcn_s_memrealtime(), dt_ = t1_ - t_mark; while (__builtin_amdgcn_s_memrealtime() - t1_ < dt_) __builtin_amdgcn_s_sleep(4); } } while (0)
#define SPIN_MARK() do { t_mark = __builtin_amdgcn_s_memrealtime(); } while (0)
#else
#define SPIN_HOOK(k) do { } while (0)
#define SPIN_MARK() do { } while (0)
#endif
#define SEAM(k) do { if (IN(k)) SPIN_HOOK(k); if (IN(k) && IN((k) + 1)) xcd_barrier(bar); SPIN_MARK(); } while (0)
    float* mod = (float*)(F.ws + WS_MOD);
    bf16* Hb = (bf16*)(F.ws + WS_O);
    bf16* Ab = (bf16*)(F.ws + WS_A);

    if (IN(0)) { p0_prologue(F); } SEAM(0);
    if (IN(1)) { row_pass<false, true, false>(F, F.x, mod, 0, F.norm_g, mod, 0); } SEAM(1);
    if (IN(2)) { pg8::Gemm g{Hb, (const bf16*)(F.ws + WS_WIN), NTOK, NPROJ, DM}; pg8::StaticOrder S; S.init(NTOK, NPROJ, F.G, F.bid);
        pg8::EpiBf16<0> E{Ab, NPROJ, nullptr, 0, 0, 1.f};
        pg8::gemm_phase<pg8::EpiBf16<0>, pg8::StaticOrder, true, true>(F.lds + RING_OFF, g, S, E); } SEAM(2);
    if (IN(3)) {
        for (int it = F.bid; it < 1024; it += F.G) gla_prep_item(F, it);
        for (int tok = F.bid * 8 + F.wave; tok < NTOK; tok += F.G * 8) nsa_prep_token(F, tok);
    } SEAM(3);
    if (IN(4)) {
        const int half = F.G >> 1;
        if (F.bid < half) { for (int it = F.bid; it < 128; it += half) nsa_compress_item(F, it); }
        else { for (int gi = (F.bid - half) * 512 + F.tid; gi < 65536; gi += (F.G - half) * 512) gla_scan(F, gi); }
    } SEAM(4);
    if (IN(5)) {
#ifndef NO_NSA
        for (int p = F.bid; p < 256; p += F.G) { const int bg = p >> 6, i = p & 63; nsa_item(F, bg >> 1, bg & 1, i); nsa_item(F, bg >> 1, bg & 1, 127 - i); }
#endif
#ifndef NO_GLAOUT
        for (int it = F.bid; it < 1024; it += F.G) gla_out_item(F, it);
#endif
    } SEAM(5);
    if (IN(6)) { pg8::Gemm g{(const bf16*)(F.ws + WS_O + 32 * MiB), (const bf16*)(F.ws + WS_WOUT), NTOK, DM, DM}; pg8::StaticOrder S; S.init(NTOK, DM, F.G, F.bid);
        EpiResid E{F.x, F.out, mod + 2 * 1024};
        pg8::gemm_phase<EpiResid, pg8::StaticOrder, true, true>(F.lds + RING_OFF, g, S, E); } SEAM(6);
#define MOE_BLOCK(P, LAYER) \
    if (IN(P)) { row_pass<false, true, true>(F, F.out, mod + (LAYER) * 2 * 6144, 3 * 1024, F.norm_g + ((LAYER) * 2 + 1) * 1024, mod, (LAYER)); } SEAM(P); \
    if (IN((P) + 1)) { moe_gather(F, (LAYER)); } SEAM((P) + 1); \
    if (IN((P) + 2)) { moe_tables(F, (LAYER)); MoeOrder S{(const LAS int*)(F.lds + TAB_OFF), F.G, F.bid}; \
        pg8::Gemm g{Ab, (const bf16*)(F.ws + WS_WGU) + (size_t)(LAYER) * 16 * 1024 * 1024, MOE_ROWS, 1024, DM}; EpiMoeGU E{(bf16*)(F.ws + WS_A + A_HID_OFF)}; \
        pg8::gemm_phase<EpiMoeGU, MoeOrder, true, true>(F.lds + RING_OFF, g, S, E); } SEAM((P) + 2); \
    if (IN((P) + 3)) { moe_tables(F, (LAYER)); MoeOrder S{(const LAS int*)(F.lds + TAB_OFF), F.G, F.bid}; \
        pg8::Gemm g{(const bf16*)(F.ws + WS_A + A_HID_OFF), (const bf16*)(F.ws + WS_WDN) + (size_t)(LAYER) * 16 * 1024 * 512, MOE_ROWS, 1024, EHID}; EpiMoeDn E{Ab}; \
        pg8::gemm_phase<EpiMoeDn, MoeOrder, true, true>(F.lds + RING_OFF, g, S, E); } SEAM((P) + 3);
    MOE_BLOCK(7, 0)
    if (IN(11)) { row_pass<true, true, false>(F, F.out, mod + 2 * 6144, 0, F.norm_g + 2 * 1024, mod, 1); } SEAM(11);
    if (IN(12)) { pg8::Gemm g{Hb, (const bf16*)(F.ws + WS_WINC), NTOK, 4096, DM}; pg8::StaticOrder S; S.init(NTOK, 4096, F.G, F.bid);
        EpiGeluStats E{Ab, (float*)(F.ws + WS_STATS)};
        pg8::gemm_phase<EpiGeluStats, pg8::StaticOrder, true, true>(F.lds + RING_OFF, g, S, E); } SEAM(12);
    if (IN(13)) { for (int it = F.bid; it < 1024; it += F.G) sgu_item(F, it); } SEAM(13);
    if (IN(14)) { pg8::Gemm g{Hb, (const bf16*)(F.ws + WS_WOUTC), NTOK, DM, SGW}; pg8::StaticOrder S; S.init(NTOK, DM, F.G, F.bid);
        EpiResid E{F.out, F.out, mod + 2 * 6144 + 2 * 1024};
        pg8::gemm_phase<EpiResid, pg8::StaticOrder, true, true>(F.lds + RING_OFF, g, S, E); } SEAM(14);
    MOE_BLOCK(15, 1)
    if (IN(19)) { row_pass<true, false, false>(F, F.out, mod, 0, F.norm_g, mod + 2 * 6144, 1); SPIN_HOOK(19); }
#undef IN
#undef SEAM
#undef MOE_BLOCK
}

#ifndef MK_N_LAUNCHES
#define MK_N_LAUNCHES 1
#endif
extern "C" void kernel_launch(void* const* d_in, const int* in_sizes, int n_in, void* d_out, int out_size, void* d_ws, size_t ws_size, hipStream_t stream) {
    static int grid = 0;
    if (grid == 0) {
        if (n_in != 26 || out_size != NTOK * DM || ws_size < WS_END) { fprintf(stderr, "kernel_launch: unexpected problem shape / workspace (%d inputs, out %d, ws %zu)\n", n_in, out_size, ws_size); grid = -1; return; }
        int dev = 0, cus = 0, per_cu = 0;
        if (hipGetDevice(&dev) != hipSuccess || hipDeviceGetAttribute(&cus, hipDeviceAttributeMultiprocessorCount, dev) != hipSuccess) { grid = -1; return; }
        if (hipFuncSetAttribute((const void*)trunk_fwd, hipFuncAttributeMaxDynamicSharedMemorySize, LDS_BYTES) != hipSuccess) { fprintf(stderr, "kernel_launch: hipFuncSetAttribute failed\n"); grid = -1; return; }
        if (hipOccupancyMaxActiveBlocksPerMultiprocessor(&per_cu, (const void*)trunk_fwd, 512, LDS_BYTES) != hipSuccess || per_cu < 1) { fprintf(stderr, "kernel_launch: occupancy query says %d blocks per CU\n", per_cu); }
        (void)hipGetLastError();
        grid = cus;
        if (grid != 256) { fprintf(stderr, "kernel_launch: built for a 256-CU device, found %d CUs\n", cus); grid = -1; return; }
    }
    if (grid < 0) return;
    (void)hipMemsetAsync((char*)d_ws + WS_CTL, 0, CTL_ZERO_BYTES, stream);
    Args a{};
    for (int i = 0; i < 26; ++i) a.in[i] = d_in[i];
    a.out = (float*)d_out; a.ws = (unsigned char*)d_ws; a.pad = 0;
    if (MK_N_LAUNCHES == 1) {
#if defined(REP_PHASE)
        a.ph_lo = 0; a.ph_hi = REP_PHASE + 1; a.use_bar = 1;
        hipLaunchKernelGGL(trunk_fwd, dim3(grid), dim3(512), LDS_BYTES, stream, a);
        a.ph_lo = REP_PHASE; a.ph_hi = NPHASE; a.use_bar = 2;
        hipLaunchKernelGGL(trunk_fwd, dim3(grid), dim3(512), LDS_BYTES, stream, a);
#else
        a.ph_lo = 0; a.ph_hi = NPHASE; a.use_bar = 1;
        hipLaunchKernelGGL(trunk_fwd, dim3(grid), dim3(512), LDS_BYTES, stream, a);
#endif
    } else {
        for (int p = 0; p < NPHASE; ++p) { a.ph_lo = p; a.ph_hi = p + 1; a.use_bar = 0; hipLaunchKernelGGL(trunk_fwd, dim3(grid), dim3(512), LDS_BYTES, stream, a); }
    }
}
```

```cpp
#include <hip/hip_runtime.h>
#include <cstdio>
#include <cstdint>
namespace pg8 {
#define PG8_LAS __attribute__((address_space(3)))
typedef unsigned short bf16_t;
typedef short bf16x8 __attribute__((ext_vector_type(8)));
typedef float f32x4 __attribute__((ext_vector_type(4)));
typedef unsigned u32x4 __attribute__((ext_vector_type(4)));
constexpr int BM = 256, BK = 64, HALF = 128, HTB = HALF * BK * 2  , STAGE_BYTES = 8 * HTB, NXCD = 8, WGM = 8;

__host__ __device__ __forceinline__ int lds_byte(int r, int c) { const int st = (r >> 4) * 2 + (c >> 5), rr = r & 15, cc = c & 31, ob = rr * 64 + cc * 2; return st * 1024 + (ob ^ (((ob >> 9) & 1) << 5)); }
__host__ __device__ __forceinline__ void stage_rc(int b, int& R, int& C) { const int st = b / 1024, sb = b % 1024, swz = sb ^ (((sb >> 9) & 1) << 5); R = (st >> 1) * 16 + swz / 64; C = (st & 1) * 32 + (swz % 64) / 2; }
__host__ __device__ __forceinline__ int perm32(int rho) { const int n = rho >> 4, i = rho & 15; return 8 * (i >> 2) + 4 * n + (i & 3); }

struct Unit { int pm, pn; };
struct Gemm { const bf16_t* A; const bf16_t* Bt; int M, N, K; };

struct StaticOrder {
    int nM, nN, nwg, G, c;
    __host__ __device__ void init(int M, int N, int G_, int c_) { nM = M / BM; nN = N / BM; nwg = nM * nN; G = G_; c = c_; }
    __host__ __device__ bool next(int i, Unit& u) const {
        const long L = (long)i * G + c; if (L >= nwg) return false;
        int wgid = (int)L; { const int q = nwg / NXCD, r = nwg % NXCD, xcd = wgid % NXCD, off = wgid / NXCD; wgid = (xcd < r ? xcd * (q + 1) : r * (q + 1) + (xcd - r) * q) + off; }
        const int nig = WGM * nN, gid = wgid / nig, fm = gid * WGM, gsz = (nM - fm) < WGM ? (nM - fm) : WGM;
        u.pm = fm + ((wgid % nig) % gsz); u.pn = (wgid % nig) / gsz; return true;
    }
    __device__ __forceinline__ void a_ready(const Unit&) const {}
    __device__ __forceinline__ void done(const Unit&) const {}
};

__device__ __forceinline__ unsigned cvt_pk_bf16(float lo, float hi) { unsigned r; asm volatile("v_cvt_pk_bf16_f32 %0, %1, %2" : "=v"(r) : "v"(lo), "v"(hi)); return r; }
typedef float f32x2 __attribute__((ext_vector_type(2)));
__device__ __forceinline__ f32x2 gelu_pk(f32x2 v) {
    const f32x2 av = __builtin_elementwise_abs(v), d = av * 0.2316418882f + 1.0f;
    f32x2 t; t.x = __builtin_amdgcn_rcpf(d.x); t.y = __builtin_amdgcn_rcpf(d.y);
    f32x2 q = t * 0.5307027145f + (-0.7265760135f); q = q * t + 0.7107068705f; q = q * t + (-0.142248368f); q = q * t + 0.127414796f; q = q * t;
    const f32x2 s = (v * v) * (-0.72134752044f);
    f32x2 e; e.x = __builtin_amdgcn_exp2f(s.x); e.y = __builtin_amdgcn_exp2f(s.y);
    const f32x2 m = v * (q * e), r = v - m;
    f32x2 o; o.x = v.x < 0.f ? m.x : r.x; o.y = v.y < 0.f ? m.y : r.y; return o;
}

template <int ACT  > struct EpiBf16 {
    static constexpr bool PERM = true, AFTER_DRAIN = false; static_assert(ACT == 0 || ACT == 1, "EpiBf16: ACT is 0 (none) or 1 (gelu_pk)");
    bf16_t* O; int ldc; const float* bias; int split_cols; size_t split_stride; float scale0;
    __device__ __forceinline__ void operator()(const f32x4 (&acc)[2][2][4][2], const Unit& u, int wr, int wc, int fr, int fq) const {
        const int row0 = u.pm * BM + wr * 64 + fr; int colt = u.pn * BM; bf16_t* base = O;
        float sc = 1.f; if (split_cols) { const int t = colt / split_cols; base += (size_t)t * split_stride; colt -= t * split_cols; if (t == 0) sc = scale0; }
        const int col0 = colt + wc * 32 + 8 * fq, bcol0 = u.pn * BM + wc * 32 + 8 * fq;
        f32x4 bv[2][2];
#pragma unroll
        for (int bj = 0; bj < 2; ++bj)
#pragma unroll
            for (int n = 0; n < 2; ++n) bv[bj][n] = bias ? *(const f32x4*)(bias + bcol0 + bj * HALF + 4 * n) : (f32x4){0.f, 0.f, 0.f, 0.f};
#pragma unroll
        for (int ai = 0; ai < 2; ++ai)
#pragma unroll
            for (int m = 0; m < 4; ++m) { bf16_t* rowp = base + (size_t)(row0 + ai * HALF + m * 16) * ldc + col0;
#pragma unroll
                for (int bj = 0; bj < 2; ++bj) { f32x4 v0 = acc[ai][bj][m][0] + bv[bj][0], v1 = acc[ai][bj][m][1] + bv[bj][1];
                    if (ACT == 1) { f32x2 a = gelu_pk((f32x2){v0[0], v0[1]}), b = gelu_pk((f32x2){v0[2], v0[3]}), c = gelu_pk((f32x2){v1[0], v1[1]}), d = gelu_pk((f32x2){v1[2], v1[3]});
                        v0 = (f32x4){a.x, a.y, b.x, b.y}; v1 = (f32x4){c.x, c.y, d.x, d.y}; }
                    v0 = v0 * sc; v1 = v1 * sc; u32x4 w; w.x = cvt_pk_bf16(v0[0], v0[1]); w.y = cvt_pk_bf16(v0[2], v0[3]); w.z = cvt_pk_bf16(v1[0], v1[1]); w.w = cvt_pk_bf16(v1[2], v1[3]);
                    *(u32x4*)(rowp + bj * HALF) = w; } }
    }
};

template <class Epi, class Sched, bool ALIGN_EPI = false, bool SP2 = false>
__device__ __forceinline__ void gemm_phase(PG8_LAS unsigned char* lds, const Gemm g, const Sched& S, const Epi& E) {
    const int tid = threadIdx.x, wid = __builtin_amdgcn_readfirstlane(tid >> 6), lane = tid & 63, wr = wid >> 2, wc = wid & 3, fr = lane & 15, fq = lane >> 4;
    const int K = g.K, nt = K / BK;
    unsigned voffA[2], voffB[2];
#pragma unroll
    for (int i = 0; i < 2; ++i) { int R, C; stage_rc(tid * 16 + i * 8192, R, C); const int Rb = Epi::PERM ? ((R & ~31) + perm32(R & 31)) : R;
        voffA[i] = (unsigned)(R * K + C) * 2u; voffB[i] = (unsigned)(Rb * K + C) * 2u; }
    const size_t kstep = (size_t)(BK * 2);
    const size_t hstep = (size_t)HALF * K * 2;
    const size_t tstep = 2 * hstep;
    const unsigned ldsw = (unsigned)wid * 1024u;
    const int aoff = lds_byte(wr * 64 + fr, fq * 8), boff = lds_byte(wc * 32 + fr, fq * 8);
#define PG8_SA(b, h) (((b) * 2 + (h)) * HTB)
#define PG8_SB(b, h) ((4 + (b) * 2 + (h)) * HTB)
#define PG8_STAGE(bufoff, gbase, voff) do { _Pragma("unroll") for (int _i = 0; _i < 2; ++_i) \
        __builtin_amdgcn_global_load_lds((const unsigned*)((const char*)(gbase) + (voff)[_i]), (PG8_LAS unsigned*)(lds + (bufoff) + ldsw + _i * 8192), 16, 0, 0); } while (0)
#define PG8_LDA(dst, b, h) do { _Pragma("unroll") for (int m = 0; m < 4; ++m) _Pragma("unroll") for (int k = 0; k < 2; ++k) dst[m][k] = *(const PG8_LAS bf16x8*)(lds + PG8_SA(b, h) + aoff + m * 2048 + k * 1024); } while (0)
#define PG8_LDB(dst, b, h) do { _Pragma("unroll") for (int n = 0; n < 2; ++n) _Pragma("unroll") for (int k = 0; k < 2; ++k) dst[n][k] = *(const PG8_LAS bf16x8*)(lds + PG8_SB(b, h) + boff + n * 2048 + k * 1024); } while (0)
#define PG8_MMA(ai, bj, At, Bt) do { __builtin_amdgcn_s_setprio(1); _Pragma("unroll") for (int m = 0; m < 4; ++m) _Pragma("unroll") for (int n = 0; n < 2; ++n) _Pragma("unroll") for (int k = 0; k < 2; ++k) \
        acc[ai][bj][m][n] = __builtin_amdgcn_mfma_f32_16x16x32_bf16(Bt[n][k], At[m][k], acc[ai][bj][m][n], 0, 0, 0); __builtin_amdgcn_s_setprio(0); } while (0)
#define PG8_WAIT_V(n) asm volatile("s_waitcnt vmcnt(" #n ")" ::: "memory")
#define PG8_WAIT_L(n) asm volatile("s_waitcnt lgkmcnt(" #n ")" ::: "memory")
#define PG8_BAR __builtin_amdgcn_s_barrier()
#define PG8_SCHED __builtin_amdgcn_sched_barrier(0)
    Unit cur, nxt; int ui = 0;
    if (!S.next(0, cur)) return;
    f32x4 acc[2][2][4][2];
#pragma unroll
    for (int a = 0; a < 2; ++a)
#pragma unroll
        for (int b = 0; b < 2; ++b)
#pragma unroll
            for (int m = 0; m < 4; ++m)
#pragma unroll
                for (int n = 0; n < 2; ++n) acc[a][b][m][n] = (f32x4){0.f, 0.f, 0.f, 0.f};
    bf16x8 At[4][2], B0[2][2], B1[2][2];
    const char* cA = (const char*)g.A + (size_t)cur.pm * tstep; const char* cB = (const char*)g.Bt + (size_t)cur.pn * tstep;
    S.a_ready(cur);
    if constexpr (SP2) {
        PG8_STAGE(PG8_SB(0, 0), cB, voffB); PG8_STAGE(PG8_SB(0, 1), cB + hstep, voffB); PG8_STAGE(PG8_SA(0, 0), cA, voffA); PG8_STAGE(PG8_SA(0, 1), cA + hstep, voffA);
        if (wr == 1) PG8_BAR;
        PG8_WAIT_V(2); PG8_BAR;
        PG8_STAGE(PG8_SB(1, 0), cB + kstep, voffB); PG8_STAGE(PG8_SA(1, 0), cA + kstep, voffA); PG8_STAGE(PG8_SB(1, 1), cB + hstep + kstep, voffB);
        PG8_WAIT_V(6); PG8_BAR;
    } else {
        PG8_STAGE(PG8_SB(0, 0), cB, voffB); PG8_STAGE(PG8_SA(0, 0), cA, voffA); PG8_STAGE(PG8_SB(0, 1), cB + hstep, voffB); PG8_STAGE(PG8_SA(0, 1), cA + hstep, voffA);
        if (wr == 1) PG8_BAR;
        PG8_WAIT_V(4); PG8_BAR;
        PG8_STAGE(PG8_SB(1, 0), cB + kstep, voffB); PG8_STAGE(PG8_SA(1, 0), cA + kstep, voffA); PG8_STAGE(PG8_SB(1, 1), cB + hstep + kstep, voffB);
        PG8_WAIT_V(6); PG8_BAR;
    }
    for (;;) {
        const bool has_next = S.next(ui + 1, nxt);
        const char* nA = has_next ? (const char*)g.A + (size_t)nxt.pm * tstep : cA; const char* nB = has_next ? (const char*)g.Bt + (size_t)nxt.pn * tstep : cB;
        for (int t = 0; t < nt; t += 2) {
            const bool last = (t == nt - 2);
            const char* a1 = cA + (size_t)(t + 1) * kstep;
            const char* a2 = last ? nA : cA + (size_t)(t + 2) * kstep; const char* b2 = last ? nB : cB + (size_t)(t + 2) * kstep;
            const char* a3 = a2 + kstep; const char* b3 = b2 + kstep;
            if (last && has_next) S.a_ready(nxt);
            if constexpr (SP2) {
            PG8_LDB(B0, 0, 0); PG8_LDB(B1, 0, 1); PG8_SCHED; PG8_LDA(At, 0, 0); PG8_STAGE(PG8_SA(1, 1), a1 + hstep, voffA);
            PG8_WAIT_V(8); PG8_WAIT_L(0); PG8_BAR; PG8_MMA(0, 0, At, B0); PG8_MMA(0, 1, At, B1); PG8_BAR; PG8_SCHED;
            PG8_LDA(At, 0, 1); PG8_STAGE(PG8_SB(0, 0), b2, voffB); PG8_STAGE(PG8_SB(0, 1), b2 + hstep, voffB); PG8_STAGE(PG8_SA(0, 0), a2, voffA);
            PG8_WAIT_V(8); PG8_WAIT_L(0); PG8_BAR; PG8_MMA(1, 0, At, B0); PG8_MMA(1, 1, At, B1); PG8_BAR; PG8_SCHED;
            PG8_LDB(B0, 1, 0); PG8_LDB(B1, 1, 1); PG8_SCHED; PG8_LDA(At, 1, 0); PG8_STAGE(PG8_SA(0, 1), a2 + hstep, voffA);
            PG8_WAIT_V(8); PG8_WAIT_L(0); PG8_BAR; PG8_MMA(0, 0, At, B0); PG8_MMA(0, 1, At, B1); PG8_BAR; PG8_SCHED;
            PG8_LDA(At, 1, 1); PG8_STAGE(PG8_SB(1, 0), b3, voffB); PG8_STAGE(PG8_SB(1, 1), b3 + hstep, voffB); PG8_STAGE(PG8_SA(1, 0), a3, voffA);
            PG8_WAIT_V(8); PG8_WAIT_L(0); PG8_BAR; PG8_MMA(1, 0, At, B0); PG8_MMA(1, 1, At, B1); PG8_BAR; PG8_SCHED;
            } else {
            PG8_LDB(B0, 0, 0); PG8_SCHED; PG8_LDA(At, 0, 0); PG8_STAGE(PG8_SA(1, 1), a1 + hstep, voffA);
            PG8_WAIT_L(8); PG8_BAR; PG8_WAIT_L(0); PG8_MMA(0, 0, At, B0); PG8_BAR; PG8_SCHED;
            PG8_LDB(B1, 0, 1); PG8_STAGE(PG8_SB(0, 0), b2, voffB);
            PG8_BAR; PG8_WAIT_L(0); PG8_MMA(0, 1, At, B1); PG8_BAR;
            PG8_LDA(At, 0, 1); PG8_STAGE(PG8_SA(0, 0), a2, voffA);
            PG8_BAR; PG8_WAIT_L(0); PG8_MMA(1, 0, At, B0); PG8_BAR; PG8_SCHED;
            PG8_STAGE(PG8_SB(0, 1), b2 + hstep, voffB);
            PG8_WAIT_V(6); PG8_BAR; PG8_MMA(1, 1, At, B1); PG8_BAR;
            PG8_LDB(B0, 1, 0); PG8_SCHED; PG8_LDA(At, 1, 0); PG8_STAGE(PG8_SA(0, 1), a2 + hstep, voffA);
            PG8_WAIT_L(8); PG8_BAR; PG8_WAIT_L(0); PG8_MMA(0, 0, At, B0); PG8_BAR; PG8_SCHED;
            PG8_LDB(B1, 1, 1); PG8_STAGE(PG8_SB(1, 0), b3, voffB);
            PG8_BAR; PG8_WAIT_L(0); PG8_MMA(0, 1, At, B1); PG8_BAR;
            PG8_LDA(At, 1, 1); PG8_STAGE(PG8_SA(1, 0), a3, voffA);
            PG8_BAR; PG8_WAIT_L(0); PG8_MMA(1, 0, At, B0); PG8_BAR; PG8_SCHED;
            PG8_STAGE(PG8_SB(1, 1), b3 + hstep, voffB);
            PG8_WAIT_V(6); PG8_BAR; PG8_MMA(1, 1, At, B1); PG8_BAR;
            }
        }
        if constexpr (ALIGN_EPI) { if (wr == 0) PG8_BAR; }
        if constexpr (!Epi::AFTER_DRAIN) { E(acc, cur, wr, wc, fr, fq); S.done(cur); }
        if (!has_next) break;
#pragma unroll
        for (int a = 0; a < 2; ++a)
#pragma unroll
            for (int b = 0; b < 2; ++b)
#pragma unroll
                for (int m = 0; m < 4; ++m)
#pragma unroll
                    for (int n = 0; n < 2; ++n) acc[a][b][m][n] = (f32x4){0.f, 0.f, 0.f, 0.f};
        cur = nxt; cA = nA; cB = nB; ++ui;
        if constexpr (ALIGN_EPI) { if (wr == 1) PG8_BAR; }
    }
    PG8_WAIT_V(0);
    if constexpr (!ALIGN_EPI) { if (wr == 0) PG8_BAR; }
    PG8_BAR;
    if constexpr (Epi::AFTER_DRAIN) { E.fused(acc, cur, wr, wc, fr, fq, lds, wid, lane); S.done(cur); }
#undef PG8_SA
#undef PG8_SB
#undef PG8_STAGE
#undef PG8_LDA
#undef PG8_LDB
#undef PG8_MMA
#undef PG8_WAIT_V
#undef PG8_WAIT_L
#undef PG8_BAR
#undef PG8_SCHED
}
}

#ifndef PG8_SP2
#define PG8_SP2 true
#endif

namespace pg8 {
template <class Epi, class Sched>
__device__ __forceinline__ void gemm_phase_gather(PG8_LAS unsigned char* lds, const Gemm g, const Sched& S, const Epi& E, const PG8_LAS unsigned* rofs) {
    const int tid = threadIdx.x, wid = __builtin_amdgcn_readfirstlane(tid >> 6), lane = tid & 63, wr = wid >> 2, wc = wid & 3, fr = lane & 15, fq = lane >> 4;
    const int K = g.K, nt = K / BK;
    unsigned voffB[2]; int RA[2]; unsigned CA[2];
#pragma unroll
    for (int i = 0; i < 2; ++i) { int R, C; stage_rc(tid * 16 + i * 8192, R, C); const int Rb = Epi::PERM ? ((R & ~31) + perm32(R & 31)) : R;
        RA[i] = R; CA[i] = (unsigned)C * 2u; voffB[i] = (unsigned)(Rb * K + C) * 2u; }
    const size_t kstep = (size_t)(BK * 2);
    const size_t hstep = (size_t)HALF * K * 2;
    const size_t tstep = 2 * hstep;
    const unsigned ldsw = (unsigned)wid * 1024u;
    const int aoff = lds_byte(wr * 64 + fr, fq * 8), boff = lds_byte(wc * 32 + fr, fq * 8);
#define PG8_SA(b, h) (((b) * 2 + (h)) * HTB)
#define PG8_SB(b, h) ((4 + (b) * 2 + (h)) * HTB)
#define PG8_STAGE(bufoff, gbase, voff) do { _Pragma("unroll") for (int _i = 0; _i < 2; ++_i) \
        __builtin_amdgcn_global_load_lds((const unsigned*)((const char*)(gbase) + (voff)[_i]), (PG8_LAS unsigned*)(lds + (bufoff) + ldsw + _i * 8192), 16, 0, 0); } while (0)
#define PG8_STAGE_A(bufoff, koff, v0, v1) do { \
        __builtin_amdgcn_global_load_lds((const unsigned*)((const char*)g.A + (koff) + (v0)), (PG8_LAS unsigned*)(lds + (bufoff) + ldsw), 16, 0, 0); \
        __builtin_amdgcn_global_load_lds((const unsigned*)((const char*)g.A + (koff) + (v1)), (PG8_LAS unsigned*)(lds + (bufoff) + ldsw + 8192), 16, 0, 0); } while (0)
#define PG8_LDA(dst, b, h) do { _Pragma("unroll") for (int m = 0; m < 4; ++m) _Pragma("unroll") for (int k = 0; k < 2; ++k) dst[m][k] = *(const PG8_LAS bf16x8*)(lds + PG8_SA(b, h) + aoff + m * 2048 + k * 1024); } while (0)
#define PG8_LDB(dst, b, h) do { _Pragma("unroll") for (int n = 0; n < 2; ++n) _Pragma("unroll") for (int k = 0; k < 2; ++k) dst[n][k] = *(const PG8_LAS bf16x8*)(lds + PG8_SB(b, h) + boff + n * 2048 + k * 1024); } while (0)
#define PG8_MMA(ai, bj, At, Bt) do { __builtin_amdgcn_s_setprio(1); _Pragma("unroll") for (int m = 0; m < 4; ++m) _Pragma("unroll") for (int n = 0; n < 2; ++n) _Pragma("unroll") for (int k = 0; k < 2; ++k) \
        acc[ai][bj][m][n] = __builtin_amdgcn_mfma_f32_16x16x32_bf16(Bt[n][k], At[m][k], acc[ai][bj][m][n], 0, 0, 0); __builtin_amdgcn_s_setprio(0); } while (0)
#define PG8_WAIT_V(n) asm volatile("s_waitcnt vmcnt(" #n ")" ::: "memory")
#define PG8_WAIT_L(n) asm volatile("s_waitcnt lgkmcnt(" #n ")" ::: "memory")
#define PG8_BAR __builtin_amdgcn_s_barrier()
#define PG8_SCHED __builtin_amdgcn_sched_barrier(0)
    Unit cur, nxt; int ui = 0;
    if (!S.next(0, cur)) return;
    f32x4 acc[2][2][4][2];
#pragma unroll
    for (int a = 0; a < 2; ++a)
#pragma unroll
        for (int b = 0; b < 2; ++b)
#pragma unroll
            for (int m = 0; m < 4; ++m)
#pragma unroll
                for (int n = 0; n < 2; ++n) acc[a][b][m][n] = (f32x4){0.f, 0.f, 0.f, 0.f};
    bf16x8 At[4][2], B0[2][2], B1[2][2];
    const char* cB = (const char*)g.Bt + (size_t)cur.pn * tstep;
    unsigned vc00 = rofs[RA[0]] + CA[0], vc01 = rofs[RA[1]] + CA[1], vc10 = rofs[128 + RA[0]] + CA[0], vc11 = rofs[128 + RA[1]] + CA[1];
    unsigned vn00 = vc00, vn01 = vc01, vn10 = vc10, vn11 = vc11;
    PG8_WAIT_L(0);
    PG8_STAGE(PG8_SB(0, 0), cB, voffB); PG8_STAGE(PG8_SB(0, 1), cB + hstep, voffB); PG8_STAGE_A(PG8_SA(0, 0), 0, vc00, vc01); PG8_STAGE_A(PG8_SA(0, 1), 0, vc10, vc11);
    if (wr == 1) PG8_BAR;
    PG8_WAIT_V(2); PG8_BAR;
    PG8_STAGE(PG8_SB(1, 0), cB + kstep, voffB); PG8_STAGE_A(PG8_SA(1, 0), kstep, vc00, vc01); PG8_STAGE(PG8_SB(1, 1), cB + hstep + kstep, voffB);
    PG8_WAIT_V(6); PG8_BAR;
    for (;;) {
        const bool has_next = S.next(ui + 1, nxt);
        const char* nB = has_next ? (const char*)g.Bt + (size_t)nxt.pn * tstep : cB;
        if (has_next) { const PG8_LAS unsigned* rn = rofs + (ui + 1) * 256; vn00 = rn[RA[0]] + CA[0]; vn01 = rn[RA[1]] + CA[1]; vn10 = rn[128 + RA[0]] + CA[0]; vn11 = rn[128 + RA[1]] + CA[1]; }
        else { vn00 = vc00; vn01 = vc01; vn10 = vc10; vn11 = vc11; }
        for (int t = 0; t < nt; t += 2) {
            const bool last = (t == nt - 2);
            const size_t k1 = (size_t)(t + 1) * kstep;
            const size_t k2 = last ? 0 : (size_t)(t + 2) * kstep; const char* b2 = last ? nB : cB + (size_t)(t + 2) * kstep;
            const size_t k3 = k2 + kstep; const char* b3 = b2 + kstep;
            const unsigned w00 = last ? vn00 : vc00, w01 = last ? vn01 : vc01, w10 = last ? vn10 : vc10, w11 = last ? vn11 : vc11;
            PG8_LDB(B0, 0, 0); PG8_LDB(B1, 0, 1); PG8_SCHED; PG8_LDA(At, 0, 0); PG8_STAGE_A(PG8_SA(1, 1), k1, vc10, vc11);
            PG8_WAIT_V(8); PG8_WAIT_L(0); PG8_BAR; PG8_MMA(0, 0, At, B0); PG8_MMA(0, 1, At, B1); PG8_BAR; PG8_SCHED;
            PG8_LDA(At, 0, 1); PG8_STAGE(PG8_SB(0, 0), b2, voffB); PG8_STAGE(PG8_SB(0, 1), b2 + hstep, voffB); PG8_STAGE_A(PG8_SA(0, 0), k2, w00, w01);
            PG8_WAIT_V(8); PG8_WAIT_L(0); PG8_BAR; PG8_MMA(1, 0, At, B0); PG8_MMA(1, 1, At, B1); PG8_BAR; PG8_SCHED;
            PG8_LDB(B0, 1, 0); PG8_LDB(B1, 1, 1); PG8_SCHED; PG8_LDA(At, 1, 0); PG8_STAGE_A(PG8_SA(0, 1), k2, w10, w11);
            PG8_WAIT_V(8); PG8_WAIT_L(0); PG8_BAR; PG8_MMA(0, 0, At, B0); PG8_MMA(0, 1, At, B1); PG8_BAR; PG8_SCHED;
            PG8_LDA(At, 1, 1); PG8_STAGE(PG8_SB(1, 0), b3, voffB); PG8_STAGE(PG8_SB(1, 1), b3 + hstep, voffB); PG8_STAGE_A(PG8_SA(1, 0), k3, w00, w01);
            PG8_WAIT_V(8); PG8_WAIT_L(0); PG8_BAR; PG8_MMA(1, 0, At, B0); PG8_MMA(1, 1, At, B1); PG8_BAR; PG8_SCHED;
        }
        if (wr == 0) PG8_BAR;
        E(acc, cur, wr, wc, fr, fq); S.done(cur);
        if (!has_next) break;
#pragma unroll
        for (int a = 0; a < 2; ++a)
#pragma unroll
            for (int b = 0; b < 2; ++b)
#pragma unroll
                for (int m = 0; m < 4; ++m)
#pragma unroll
                    for (int n = 0; n < 2; ++n) acc[a][b][m][n] = (f32x4){0.f, 0.f, 0.f, 0.f};
        cur = nxt; cB = nB; ++ui; vc00 = vn00; vc01 = vn01; vc10 = vn10; vc11 = vn11;
        if (wr == 1) PG8_BAR;
    }
    PG8_WAIT_V(0);
    PG8_BAR;
#undef PG8_SA
#undef PG8_SB
#undef PG8_STAGE
#undef PG8_STAGE_A
#undef PG8_LDA
#undef PG8_LDB
#undef PG8_MMA
#undef PG8_WAIT_V
#undef PG8_WAIT_L
#undef PG8_BAR
#undef PG8_SCHED
}
}

constexpr int NB = 2, SEQ = 8192, DM = 1024, NTOK = NB * SEQ;
constexpr int NPROJ = 3072;
constexpr int C_GQ = 0, C_GK = 256, C_GV = 512, C_GR = 1024, C_NQ = 1536, C_KC = 2048, C_VC = 2176, C_KS = 2304, C_VS = 2432, C_KW = 2560, C_VW = 2688, C_GLR = 2816, C_NG = 2832, C_END = 2856;
constexpr int SGW = 2048;
constexpr int NEXP = 16, EHID = 512;
constexpr int MOE_ROWS = 36864;
constexpr float NORM_EPS = 1e-6f;
constexpr float NEGBIG = -1e30f;

constexpr size_t MiB = 1u << 20;
constexpr size_t WS_CTL = 0, CTL_ZERO_BYTES = 1 * MiB;
constexpr size_t WS_MOD = 1 * MiB;
constexpr size_t WS_ROUTE = 2 * MiB;
constexpr size_t WS_GATES = 3 * MiB;
constexpr size_t WS_STATS = 5 * MiB;
constexpr size_t WS_DEC = 7 * MiB;
constexpr size_t WS_WIN = 8 * MiB;
constexpr size_t WS_WOUT = 14 * MiB;
constexpr size_t WS_WINC = 16 * MiB;
constexpr size_t WS_WOUTC = 24 * MiB;
constexpr size_t WS_WCW1 = 28 * MiB;
constexpr size_t WS_WGU = 30 * MiB;
constexpr size_t WS_WDN = 94 * MiB;
constexpr size_t WS_A = 126 * MiB;
constexpr size_t WS_O = 254 * MiB;
constexpr size_t WS_END = 318 * MiB;
constexpr size_t A_HID_OFF = 72 * MiB;
constexpr size_t DO_QN = 0;
constexpr size_t DO_KSEL = 16 * MiB, DO_VSEL = 20 * MiB, DO_KWIN = 24 * MiB, DO_VWIN = 28 * MiB;
constexpr size_t DO_KC = 32 * MiB, DO_VC = 36 * MiB + 65536;
constexpr size_t DO_KCMP = 41 * MiB, DO_VCMP = 41 * MiB + 512 * 1024;

constexpr int CW_TMO = 0, CW_CODE = 1;
constexpr int CW_BAR = 4096;
constexpr int CW_CNT = 16384;

constexpr int RING_OFF = 0, RING_BYTES = 131072;
constexpr int LDSCTL_OFF = RING_BYTES, MISC_OFF = LDSCTL_OFF + 320;
constexpr int TAB_OFF = LDSCTL_OFF + 1024;
constexpr int LDS_BYTES = 147456;

#define GAS __attribute__((address_space(1)))
#define LAS __attribute__((address_space(3)))
typedef unsigned short bf16;
typedef unsigned v4u __attribute__((ext_vector_type(4)));
typedef unsigned v2u __attribute__((ext_vector_type(2)));
typedef float f32x4 __attribute__((ext_vector_type(4)));
typedef float f32x2 __attribute__((ext_vector_type(2)));
typedef float f32x16 __attribute__((ext_vector_type(16)));
typedef short bf16x8 __attribute__((ext_vector_type(8)));
typedef short s16x4 __attribute__((ext_vector_type(4)));
typedef GAS unsigned gu32;
#define RLX_AGENT __ATOMIC_RELAXED, __HIP_MEMORY_SCOPE_AGENT
#define LDS_WAIT() asm volatile("s_waitcnt lgkmcnt(0)" ::: "memory")
#define VM_WAIT() asm volatile("s_waitcnt vmcnt(0)" ::: "memory")
__device__ __forceinline__ unsigned f2bf(float f) { unsigned u = __builtin_bit_cast(unsigned, f); return (u + 0x7fffu + ((u >> 16) & 1u)) >> 16; }
__device__ __forceinline__ unsigned pk2(float lo, float hi) { return f2bf(lo) | (f2bf(hi) << 16); }
__device__ __forceinline__ float bf2f(unsigned short b) { return __builtin_bit_cast(float, (unsigned)b << 16); }
__device__ __forceinline__ float bflo(unsigned w) { return __builtin_bit_cast(float, w << 16); }
__device__ __forceinline__ float bfhi(unsigned w) { return __builtin_bit_cast(float, w & 0xffff0000u); }
__device__ __forceinline__ float fexp2(float x) { return __builtin_amdgcn_exp2f(x); }
__device__ __forceinline__ float fexp(float x) { return __builtin_amdgcn_exp2f(x * 1.4426950408889634f); }
__device__ __forceinline__ float frcp(float x) { return __builtin_amdgcn_rcpf(x); }
__device__ __forceinline__ float sigmoidf_(float x) { return 1.0f / (1.0f + __expf(-x)); }
__device__ __forceinline__ float siluf_(float x) { return x / (1.0f + __expf(-x)); }
__device__ __forceinline__ float gelu_tanh(float x) {
    const float u = 0.7978845608028654f * (x + 0.044715f * x * x * x);
    return x / (1.0f + __expf(-2.0f * u));
}
__device__ __forceinline__ float wave_sum(float v) {
#pragma unroll
    for (int o = 1; o < 64; o <<= 1) v += __shfl_xor(v, o);
    return v;
}
__device__ __forceinline__ void unpack8(const v4u w, float (&f)[8]) {
    f[0] = bflo(w.x); f[1] = bfhi(w.x); f[2] = bflo(w.y); f[3] = bfhi(w.y); f[4] = bflo(w.z); f[5] = bfhi(w.z); f[6] = bflo(w.w); f[7] = bfhi(w.w);
}
__device__ __forceinline__ v4u pack8(const float (&f)[8]) { v4u w; w.x = pk2(f[0], f[1]); w.y = pk2(f[2], f[3]); w.z = pk2(f[4], f[5]); w.w = pk2(f[6], f[7]); return w; }

#define XB_TMO      128
#define XB_XCNT(j)  (256  + 64 * (j))
#define XB_XSUB(j)  (1280 + 64 * (j))
#define XB_XGEN(j)  (2304 + 64 * (j))
#define XB_TOP      3328
#define XB_TOPGEN   3392
#define XCD_BAR_WORDS 3456
#define XB_SPIN_CAP (1u << 18)

__device__ __forceinline__ unsigned xb_ld(unsigned* p)              { return __hip_atomic_load(p, __ATOMIC_RELAXED, __HIP_MEMORY_SCOPE_AGENT); }
__device__ __forceinline__ unsigned xb_add(unsigned* p, unsigned v) { return __hip_atomic_fetch_add(p, v, __ATOMIC_RELAXED, __HIP_MEMORY_SCOPE_AGENT); }
__device__ __forceinline__ unsigned xb_xcc_id() { return (unsigned)__builtin_amdgcn_s_getreg((3 << 11) | 20) & 0xFu; }
#define XB_SPIN(cond, bar) do { unsigned _sp = 0; while (cond) { __builtin_amdgcn_s_sleep(1); \
    if ((++_sp & 255u) == 0u) { if (xb_ld(&(bar)[XB_TMO])) break; if (_sp > XB_SPIN_CAP) { atomicAdd(&(bar)[XB_TMO], 1u); break; } } } } while (0)

struct XcdBarrier {
    unsigned* bar; unsigned x;
    volatile LAS unsigned* st;
};
__device__ __forceinline__ XcdBarrier xcd_barrier_post(unsigned* bar, volatile LAS unsigned* st) {
    XcdBarrier b; b.bar = bar; b.x = xb_xcc_id(); b.st = st;
    if (threadIdx.x == 0) (void)xb_add(&bar[XB_XCNT(b.x)], 1u);
    return b;
}
__device__ __forceinline__ void xcd_barrier_complete(unsigned* bar, unsigned x, unsigned& nloc, unsigned& nx) {
    const unsigned G = gridDim.x * gridDim.y * gridDim.z;
    unsigned sum, cnt, mine, sp = 0u;
    for (;;) {
        sum = 0u; cnt = 0u; mine = 0u;
#pragma unroll
        for (unsigned j = 0; j < 16; ++j) { const unsigned c = xb_ld(&bar[XB_XCNT(j)]); sum += c; cnt += (c > 0u) ? 1u : 0u; mine = (j == x) ? c : mine; }
        if (sum == G) break;
        __builtin_amdgcn_s_sleep(1);
        if ((++sp & 255u) == 0u) { if (xb_ld(&bar[XB_TMO])) break; if (sp > XB_SPIN_CAP) { atomicAdd(&bar[XB_TMO], 1u); break; } }
    }
    nloc = mine > 0u ? mine : 1u; nx = cnt > 0u ? cnt : 1u;
}
__device__ __forceinline__ void xcd_barrier(const XcdBarrier& b) {
    asm volatile("s_waitcnt vmcnt(0)" ::: "memory");
    __syncthreads();
    if (threadIdx.x == 0) {
        unsigned* bar = b.bar;
        __builtin_amdgcn_s_waitcnt(0);
        unsigned nloc = b.st[0], nx = b.st[1];
        if (nloc == 0u) { xcd_barrier_complete(bar, b.x, nloc, nx); b.st[0] = nloc; b.st[1] = nx; }
        const unsigned old = xb_add(&bar[XB_XSUB(b.x)], 1u);
        const unsigned gen = old / nloc;
        if (old + 1u == (gen + 1u) * nloc) {
            __builtin_amdgcn_fence(__ATOMIC_RELEASE, "agent");
            asm volatile("s_waitcnt vmcnt(0)" ::: "memory");
            const unsigned og = xb_add(&bar[XB_TOP], 1u);
            const unsigned tg = og / nx;
            if (og + 1u == (tg + 1u) * nx) xb_add(&bar[XB_TOPGEN], 1u);
            else XB_SPIN(xb_ld(&bar[XB_TOPGEN]) == tg, bar);
            __builtin_amdgcn_fence(__ATOMIC_ACQUIRE, "agent");
            xb_add(&bar[XB_XGEN(b.x)], 1u);
            asm volatile("s_waitcnt vmcnt(0)" ::: "memory");
        } else {
            XB_SPIN(xb_ld(&bar[XB_XGEN(b.x)]) == gen, bar);
            __builtin_amdgcn_fence(__ATOMIC_ACQUIRE, "agent");
            asm volatile("s_waitcnt vmcnt(0)" ::: "memory");
        }
    }
    __syncthreads();
}

struct Frame {
    LAS unsigned char* lds;
    volatile LAS unsigned* MISC;
    gu32* ctl;
    int tid, lane, wave;
    int bid, G;
    unsigned char* ws;
    unsigned char* dout_b;
    float* out;
    const float *x, *c, *w_ada, *b_ada, *norm_g, *w_in_ab, *w_out_ab, *gla_w2, *gla_bg, *gla_ng, *q_gain, *k_gain, *cmp_pe, *cmp_w1, *cmp_w2, *w_in_c, *sgu_ng, *sgu_ws, *sgu_bs, *w_out_c, *w_router, *r_bias, *w_gate, *w_up, *w_down;
    const int* positions;
};

struct EpiResid {
    static constexpr bool PERM = false, AFTER_DRAIN = false;
    const float* xin; float* xout; const float* gate;
    __device__ __forceinline__ void operator()(const pg8::f32x4 (&acc)[2][2][4][2], const pg8::Unit& u, int wr, int wc, int fr, int fq) const {
        const int row0 = u.pm * 256 + wr * 64 + fr, col0 = u.pn * 256 + wc * 32 + 4 * fq;
        const float* gb = gate + ((u.pm * 256 >= SEQ) ? 6144 : 0);
        f32x4 gv[2][2];
#pragma unroll
        for (int bj = 0; bj < 2; ++bj)
#pragma unroll
            for (int n = 0; n < 2; ++n) gv[bj][n] = *(const f32x4*)(gb + col0 + bj * 128 + n * 16);
#pragma unroll
        for (int ai = 0; ai < 2; ++ai)
#pragma unroll
            for (int m = 0; m < 4; ++m) {
                const size_t rb = (size_t)(row0 + ai * 128 + m * 16) * DM;
#pragma unroll
                for (int bj = 0; bj < 2; ++bj)
#pragma unroll
                    for (int n = 0; n < 2; ++n) {
                        const size_t p = rb + col0 + bj * 128 + n * 16;
                        const f32x4 xi = *(const f32x4*)(xin + p);
                        *(f32x4*)(xout + p) = xi + gv[bj][n] * acc[ai][bj][m][n];
                    }
            }
    }
};
struct EpiGeluStats {
    static constexpr bool PERM = true, AFTER_DRAIN = false;
    bf16* Z; float* stats;
    __device__ __forceinline__ void operator()(const pg8::f32x4 (&acc)[2][2][4][2], const pg8::Unit& u, int wr, int wc, int fr, int fq) const {
        const int row0 = u.pm * 256 + wr * 64 + fr, col0 = u.pn * 256 + wc * 32 + 8 * fq;
#pragma unroll
        for (int ai = 0; ai < 2; ++ai)
#pragma unroll
            for (int m = 0; m < 4; ++m) {
                const int row = row0 + ai * 128 + m * 16; float ss = 0.f;
#pragma unroll
                for (int bj = 0; bj < 2; ++bj) {
                    float g[8];
#pragma unroll
                    for (int n = 0; n < 2; ++n)
#pragma unroll
                        for (int i = 0; i < 4; ++i) { g[n * 4 + i] = gelu_tanh(acc[ai][bj][m][n][i]); ss += g[n * 4 + i] * g[n * 4 + i]; }
                    *(v4u*)(Z + (size_t)row * 4096 + col0 + bj * 128) = pack8(g);
                }
                if (u.pn >= 8) {
                    ss += __shfl_xor(ss, 16); ss += __shfl_xor(ss, 32);
                    if (fq == 0) stats[(size_t)row * 32 + (u.pn - 8) * 4 + wc] = ss;
                }
            }
    }
};
struct EpiMoeGU {
    static constexpr bool PERM = true, AFTER_DRAIN = false;
    bf16* HID;
    __device__ __forceinline__ void operator()(const pg8::f32x4 (&acc)[2][2][4][2], const pg8::Unit& u, int wr, int wc, int fr, int fq) const {
        const int row0 = u.pm * 256 + wr * 64 + fr, col0 = (u.pn & 3) * 128 + wc * 32 + 8 * fq;
#pragma unroll
        for (int ai = 0; ai < 2; ++ai)
#pragma unroll
            for (int m = 0; m < 4; ++m) {
                float h[8];
#pragma unroll
                for (int n = 0; n < 2; ++n)
#pragma unroll
                    for (int i = 0; i < 4; ++i) h[n * 4 + i] = siluf_(acc[ai][0][m][n][i]) * acc[ai][1][m][n][i];
                *(v4u*)(HID + (size_t)(row0 + ai * 128 + m * 16) * EHID + col0) = pack8(h);
            }
    }
};
struct EpiMoeDn {
    static constexpr bool PERM = true, AFTER_DRAIN = false;
    bf16* YM;
    __device__ __forceinline__ void operator()(const pg8::f32x4 (&acc)[2][2][4][2], const pg8::Unit& u, int wr, int wc, int fr, int fq) const {
        const int row0 = u.pm * 256 + wr * 64 + fr, col0 = (u.pn & 3) * 256 + wc * 32 + 8 * fq;
#pragma unroll
        for (int ai = 0; ai < 2; ++ai)
#pragma unroll
            for (int m = 0; m < 4; ++m)
#pragma unroll
                for (int bj = 0; bj < 2; ++bj) {
                    float h[8];
#pragma unroll
                    for (int n = 0; n < 2; ++n)
#pragma unroll
                        for (int i = 0; i < 4; ++i) h[n * 4 + i] = acc[ai][bj][m][n][i];
                    *(v4u*)(YM + (size_t)(row0 + ai * 128 + m * 16) * DM + col0 + bj * 128) = pack8(h);
                }
    }
};
struct MoeOrder {
    const LAS int* ppre; int G, c;
    __device__ __forceinline__ unsigned row_off(const pg8::Unit& u, int r, const int* elist) const {
        const int e = u.pn >> 2, li = (u.pm - ppre[e]) * 256 + r;
        const int tok = (li < ppre[32 + e]) ? elist[e * 16384 + li] : 0;
        return (unsigned)tok * 2048u;
    }
    __device__ __forceinline__ bool next(int i, pg8::Unit& u) const {
        const int L = i * G + c, np = ppre[16];
        if (L >= np * 4) return false;
        const int pm = L >> 2; int e = 0;
#pragma unroll
        for (int k = 1; k < 16; ++k) e += (ppre[k] <= pm) ? 1 : 0;
        u.pm = pm; u.pn = e * 4 + (L & 3); return true;
    }
    __device__ __forceinline__ void a_ready(const pg8::Unit&) const {}
    __device__ __forceinline__ void done(const pg8::Unit&) const {}
};

__device__ __forceinline__ int dest_row(int mode, int n) {
    if (mode == 1) return (n < 1024) ? n : (n < 1040) ? n + 1792 : (n < 2832) ? n - 16 : n;
    if (mode == 2) return (n >> 7) * 256 + (n & 127);
    if (mode == 3) return (n >> 7) * 256 + 128 + (n & 127);
    return n;
}
__device__ __forceinline__ void transpose_item(const float* W, int K, int N, bf16* WT, int mode, LAS unsigned char* scr  , int item, int lane) {
    const int nblk = (N + 63) / 64, kb = item / nblk, nb = item % nblk, k0 = 64 * kb, n0 = 64 * nb;
    const int q = lane & 15, r4 = lane >> 4, col = n0 + 4 * q;
    f32x4 va[8], vb[8];
    const float* wp = W + (size_t)(k0 + 2 * r4) * N + col;
#pragma unroll
    for (int i = 0; i < 8; ++i) {
        if (col < N) { va[i] = *(const f32x4*)(wp + (size_t)(8 * i) * N); vb[i] = *(const f32x4*)(wp + (size_t)(8 * i + 1) * N); }
        else { va[i] = (f32x4){0.f, 0.f, 0.f, 0.f}; vb[i] = va[i]; }
    }
#pragma unroll
    for (int i = 0; i < 8; ++i) {
        const int kp = 4 * i + r4;
        LAS unsigned* t = (LAS unsigned*)(scr + (4 * q) * 144 + 4 * kp);
        t[0] = pk2(va[i].x, vb[i].x); t[36] = pk2(va[i].y, vb[i].y); t[72] = pk2(va[i].z, vb[i].z); t[108] = pk2(va[i].w, vb[i].w);
    }
    LDS_WAIT(); asm volatile("" ::: "memory");
    const int c = lane & 7;
#pragma unroll
    for (int j = 0; j < 8; ++j) { const int n = (lane >> 3) + 8 * j;
        const v4u o = *(const LAS v4u*)(scr + n * 144 + 16 * c);
        if (n0 + n < N) *(GAS v4u*)(WT + (size_t)dest_row(mode, n0 + n) * K + k0 + 8 * c) = o; }
    LDS_WAIT(); asm volatile("" ::: "memory");
}
__device__ __forceinline__ void p0_prologue(Frame& F) {
    LAS float* red = (LAS float*)(F.lds + RING_OFF);
    float* mod = (float*)(F.ws + WS_MOD);
    float* bias1 = (float*)(F.ws + WS_MOD + 131072);
    for (int bi = F.bid; bi < 200; bi += F.G) {
        if (bi < 192) {
            const int l = bi / 96, cg = bi % 96, j = cg * 64 + F.lane;
            float a0 = 0.f, a1 = 0.f;
            const float* wp = F.w_ada + ((size_t)l * 1024 + F.wave * 128) * 6144 + j;
#pragma unroll 16
            for (int k = 0; k < 128; ++k) { const float wv = wp[(size_t)k * 6144]; const float c0 = F.c[F.wave * 128 + k], c1 = F.c[1024 + F.wave * 128 + k];
                a0 += siluf_(c0) * wv; a1 += siluf_(c1) * wv; }
            red[(F.wave * 2 + 0) * 64 + F.lane] = a0; red[(F.wave * 2 + 1) * 64 + F.lane] = a1;
            __syncthreads();
            if (F.tid < 128) { const int b = F.tid >> 6, ln = F.tid & 63; float s = 0.f;
#pragma unroll
                for (int w = 0; w < 8; ++w) s += red[(w * 2 + b) * 64 + ln];
                mod[(size_t)(l * 2 + b) * 6144 + cg * 64 + ln] = s + F.b_ada[l * 6144 + cg * 64 + ln]; }
            __syncthreads();
        } else {
            const int kv = (bi - 192) >> 2, cg = (bi - 192) & 3, j = cg * 64 + F.lane;
            float a0 = 0.f;
            const float* wp = F.cmp_w1 + ((size_t)kv * 2048 + F.wave * 256) * 256 + j; const float* pe = F.cmp_pe + kv * 2048 + F.wave * 256;
#pragma unroll 16
            for (int k = 0; k < 256; ++k) a0 += pe[k] * wp[(size_t)k * 256];
            red[F.wave * 64 + F.lane] = a0;
            __syncthreads();
            if (F.tid < 64) { float s = 0.f;
#pragma unroll
                for (int w = 0; w < 8; ++w) s += red[w * 64 + F.tid];
                bias1[kv * 256 + cg * 64 + F.tid] = s; }
            __syncthreads();
        }
    }
    { bf16* wi = (bf16*)(F.ws + WS_WIN); const int npieces = (NPROJ - C_END) * (DM / 8);
      for (int p = F.bid * 512 + F.tid; p < npieces; p += F.G * 512) *(GAS v4u*)(wi + (size_t)C_END * DM + (size_t)p * 8) = (v4u){0u, 0u, 0u, 0u}; }
    LAS unsigned char* scr = F.lds + RING_OFF + 8192 + F.wave * 12288;
    const int gw = F.bid * 8 + F.wave, NGW = F.G * 8;
    constexpr int I_IN = 16 * 45, I_OUT = 16 * 16, I_INC = 16 * 64, I_OUTC = 32 * 16, I_CW1 = 2 * 32 * 4, I_G = 32 * 128, I_U = 32 * 128, I_D = 32 * 128;
    constexpr int NITEMS = I_IN + I_OUT + I_INC + I_OUTC + I_CW1 + I_G + I_U + I_D;
    for (int it = gw; it < NITEMS; it += NGW) {
        int r = it; const float* src; bf16* dst; int K, N, mode = 0;
        if (r < I_IN) { src = F.w_in_ab; dst = (bf16*)(F.ws + WS_WIN); K = 1024; N = 2856; mode = 1; }
        else if ((r -= I_IN) < I_OUT) { src = F.w_out_ab; dst = (bf16*)(F.ws + WS_WOUT); K = 1024; N = 1024; }
        else if ((r -= I_OUT) < I_INC) { src = F.w_in_c; dst = (bf16*)(F.ws + WS_WINC); K = 1024; N = 4096; }
        else if ((r -= I_INC) < I_OUTC) { src = F.w_out_c; dst = (bf16*)(F.ws + WS_WOUTC); K = 2048; N = 1024; }
        else if ((r -= I_OUTC) < I_CW1) { const int m = r >> 7; r &= 127; src = F.cmp_w1 + (size_t)m * 2048 * 256; dst = (bf16*)(F.ws + WS_WCW1) + (size_t)m * 256 * 2048; K = 2048; N = 256; }
        else if ((r -= I_CW1) < I_G) { const int m = r >> 7; r &= 127; src = F.w_gate + (size_t)m * 1024 * 512; dst = (bf16*)(F.ws + WS_WGU) + (size_t)m * 1024 * 1024; K = 1024; N = 512; mode = 2; }
        else if ((r -= I_G) < I_U) { const int m = r >> 7; r &= 127; src = F.w_up + (size_t)m * 1024 * 512; dst = (bf16*)(F.ws + WS_WGU) + (size_t)m * 1024 * 1024; K = 1024; N = 512; mode = 3; }
        else { r -= I_U; const int m = r >> 7; r &= 127; src = F.w_down + (size_t)m * 512 * 1024; dst = (bf16*)(F.ws + WS_WDN) + (size_t)m * 1024 * 512; K = 512; N = 1024; }
        transpose_item(src, K, N, dst, mode, scr, r, F.lane);
    }
}

__device__ __forceinline__ void moe_tables(Frame& F, int layer) {
    LAS int* ppre = (LAS int*)(F.lds + TAB_OFF);
    if (F.tid == 0) { const unsigned* cnt = (const unsigned*)(F.ctl + CW_CNT + 1024 * layer); int acc = 0;
        for (int e = 0; e < 16; ++e) { const int c = (int)cnt[64 * e]; ppre[e] = acc; ppre[32 + e] = c; acc += (c + 255) >> 8; }
        ppre[16] = acc; }
    __syncthreads();
}

struct RouteRec { int e0, e1, pos0, pos1; float w0, w1; int slot0, slot1; };
template <bool COMBINE, bool NORM, bool ROUTE>
__device__ __forceinline__ void row_pass(Frame& F, const float* xin, const float* modn  , int sh_off, const float* ng,
                                         const float* modc  , int layer, int clayer  ) {
    if (COMBINE) moe_tables(F, clayer);
    float* xout = F.out; bf16* H = (bf16*)(F.ws + WS_O);
    const bf16* YM = (const bf16*)(F.ws + WS_A);
    RouteRec* route = (RouteRec*)(F.ws + WS_ROUTE);
    int* elist = (int*)(F.ws + WS_STATS);
    const LAS int* ppre = (const LAS int*)(F.lds + TAB_OFF);
    LAS float* wr = (LAS float*)(F.lds + RING_OFF);
    LAS unsigned* lcnt = (LAS unsigned*)(F.lds + TAB_OFF + 256);
    if (ROUTE) {
        for (int idx = F.tid; idx < 16384; idx += 512) wr[(idx & 15) * 1024 + (idx >> 4)] = F.w_router[idx];
        if (F.tid < 32) lcnt[F.tid] = 0u;
        __syncthreads();
    }
    const int gw = F.bid * 8 + F.wave, NGW = F.G * 8;
#pragma unroll 1
    for (int b = 0; b < NB; ++b) {
        f32x4 cs[4], sh[4], gc[4];
#pragma unroll
        for (int j = 0; j < 4; ++j) {
            const int col = 4 * F.lane + 256 * j;
            if (NORM) { const f32x4 g = *(const f32x4*)(ng + col), sc = *(const f32x4*)(modn + b * 6144 + sh_off + 1024 + col); cs[j] = g * (sc + 1.0f); sh[j] = *(const f32x4*)(modn + b * 6144 + sh_off + col); }
            if (COMBINE) gc[j] = *(const f32x4*)(modc + b * 6144 + 5 * 1024 + col);
        }
#pragma unroll 1
        for (int m = b * SEQ + gw; m < (b + 1) * SEQ; m += NGW) {
            f32x4 v[4];
#pragma unroll
            for (int j = 0; j < 4; ++j) v[j] = *(const f32x4*)(xin + (size_t)m * DM + 4 * F.lane + 256 * j);
            if (COMBINE) {
                const RouteRec rr = route[m];
                const int sl0 = ppre[rr.e0] * 256 + rr.pos0, sl1 = ppre[rr.e1] * 256 + rr.pos1;
#pragma unroll
                for (int j = 0; j < 4; ++j) {
                    const v2u y0 = *(const v2u*)(YM + (size_t)sl0 * DM + 4 * F.lane + 256 * j), y1 = *(const v2u*)(YM + (size_t)sl1 * DM + 4 * F.lane + 256 * j);
                    f32x4 yy; yy.x = rr.w0 * bflo(y0.x) + rr.w1 * bflo(y1.x); yy.y = rr.w0 * bfhi(y0.x) + rr.w1 * bfhi(y1.x); yy.z = rr.w0 * bflo(y0.y) + rr.w1 * bflo(y1.y); yy.w = rr.w0 * bfhi(y0.y) + rr.w1 * bfhi(y1.y);
                    v[j] = v[j] + gc[j] * yy;
                    *(f32x4*)(xout + (size_t)m * DM + 4 * F.lane + 256 * j) = v[j];
                }
            }
            if (NORM) {
                float s = 0.f;
#pragma unroll
                for (int j = 0; j < 4; ++j) s += (v[j].x * v[j].x + v[j].y * v[j].y) + (v[j].z * v[j].z + v[j].w * v[j].w);
                const float rstd = 1.0f / sqrtf(wave_sum(s) * (1.0f / DM) + NORM_EPS);
#pragma unroll
                for (int j = 0; j < 4; ++j) { v[j] = v[j] * rstd * cs[j] + sh[j];
                    v2u o; o.x = pk2(v[j].x, v[j].y); o.y = pk2(v[j].z, v[j].w);
                    *(v2u*)(H + (size_t)m * DM + 4 * F.lane + 256 * j) = o; }
            }
            if (ROUTE) {
                float lg[16];
#pragma unroll
                for (int eg = 0; eg < 4; ++eg) {
                    float a4[4] = {0.f, 0.f, 0.f, 0.f};
#pragma unroll
                    for (int j = 0; j < 4; ++j)
#pragma unroll
                        for (int ee = 0; ee < 4; ++ee) { const f32x4 w = *(const LAS f32x4*)(wr + (eg * 4 + ee) * 1024 + 4 * F.lane + 256 * j); a4[ee] += (v[j].x * w.x + v[j].y * w.y) + (v[j].z * w.z + v[j].w * w.w); }
#pragma unroll
                    for (int ee = 0; ee < 4; ++ee) lg[eg * 4 + ee] = wave_sum(a4[ee]);
                    __builtin_amdgcn_sched_barrier(0);
                }
                float sc[16], sl[16];
#pragma unroll
                for (int e = 0; e < 16; ++e) { sc[e] = 1.0f / (1.0f + expf(-lg[e])); sl[e] = sc[e] + F.r_bias[e]; }
                float gs[4]; int ge1[4], ge2[4]; float gw1[4], gw2[4];
#pragma unroll
                for (int g = 0; g < 4; ++g) {
                    int i1 = 0; float m1 = sl[4 * g];
#pragma unroll
                    for (int k = 1; k < 4; ++k) if (sl[4 * g + k] > m1) { m1 = sl[4 * g + k]; i1 = k; }
                    int i2 = -1; float m2 = 0.f;
#pragma unroll
                    for (int k = 0; k < 4; ++k) if (k != i1 && (i2 < 0 || sl[4 * g + k] > m2)) { m2 = sl[4 * g + k]; i2 = k; }
                    gs[g] = m1 + m2; ge1[g] = 4 * g + i1; ge2[g] = 4 * g + i2;
                    float w1 = 0.f, w2 = 0.f;
#pragma unroll
                    for (int k = 0; k < 4; ++k) { w1 = (k == i1) ? sc[4 * g + k] : w1; w2 = (k == i2) ? sc[4 * g + k] : w2; }
                    gw1[g] = w1; gw2[g] = w2;
                }
                int gi = 0; float gm = gs[0];
#pragma unroll
                for (int g = 1; g < 4; ++g) if (gs[g] > gm) { gm = gs[g]; gi = g; }
                int e1 = ge1[0], e2 = ge2[0]; float w1 = gw1[0], w2 = gw2[0];
#pragma unroll
                for (int g = 1; g < 4; ++g) if (gi == g) { e1 = ge1[g]; e2 = ge2[g]; w1 = gw1[g]; w2 = gw2[g]; }
                const float ws_ = w1 + w2;
                if (F.lane == 0) {
                    RouteRec rr; rr.e0 = e1; rr.e1 = e2;
                    rr.pos0 = (int)__hip_atomic_fetch_add(lcnt + e1, 1u, __ATOMIC_RELAXED, __HIP_MEMORY_SCOPE_WORKGROUP);
                    rr.pos1 = (int)__hip_atomic_fetch_add(lcnt + e2, 1u, __ATOMIC_RELAXED, __HIP_MEMORY_SCOPE_WORKGROUP);
                    rr.w0 = w1 / ws_; rr.w1 = w2 / ws_; rr.slot0 = 0; rr.slot1 = 0;
                    route[m] = rr;
                }
            }
        }
    }
    if (ROUTE) {
        __syncthreads();
        if (F.tid < 16) { unsigned* cnt = (unsigned*)(F.ctl + CW_CNT + 1024 * layer + 64 * F.tid); lcnt[16 + F.tid] = atomicAdd(cnt, lcnt[F.tid]); }
        __syncthreads();
        if (F.lane == 0) {
#pragma unroll 1
            for (int m = gw; m < NTOK; m += NGW) { RouteRec rr = route[m]; rr.pos0 += (int)lcnt[16 + rr.e0]; rr.pos1 += (int)lcnt[16 + rr.e1]; route[m] = rr;
                elist[rr.e0 * 16384 + rr.pos0] = m; elist[rr.e1 * 16384 + rr.pos1] = m; }
        }
    }
}


__device__ __forceinline__ f32x4 mma16(const LAS bf16* A, int lda, const LAS bf16* Bt, int ldb, int K, f32x4 acc, int lane) {
    const LAS bf16* ap = A + (lane & 15) * lda + (lane >> 4) * 8;
    const LAS bf16* bp = Bt + (lane & 15) * ldb + (lane >> 4) * 8;
    for (int k = 0; k < K; k += 32) {
        const bf16x8 a = *(const LAS bf16x8*)(ap + k), b = *(const LAS bf16x8*)(bp + k);
        acc = __builtin_amdgcn_mfma_f32_16x16x32_bf16(a, b, acc, 0, 0, 0);
    }
    return acc;
}

__device__ __forceinline__ void gla_bcum(Frame& F, const bf16* prow  , int h, float (&bc)[8]) {
    float gl[16];
    { const v4u a = *(const v4u*)(prow + C_GLR), b = *(const v4u*)(prow + C_GLR + 8); float t0[8], t1[8]; unpack8(a, t0); unpack8(b, t1);
#pragma unroll
      for (int i = 0; i < 8; ++i) { gl[i] = t0[i]; gl[8 + i] = t1[i]; } }
#pragma unroll
    for (int i = 0; i < 8; ++i) {
        const int col = h * 64 + F.wave * 8 + i;
        float z = F.gla_bg[col];
#pragma unroll
        for (int r = 0; r < 16; ++r) z += gl[r] * F.gla_w2[r * 256 + col];
        const float ls = fminf(z, 0.f) - log1pf(__expf(-fabsf(z)));
        float v = ls * (1.0f / 16.0f);
#pragma unroll
        for (int off = 1; off < 64; off <<= 1) { const float o = __shfl_up(v, off); v += (F.lane >= off) ? o : 0.f; }
        bc[i] = v;
    }
}
__device__ __forceinline__ void gla_stage_vT(Frame& F, const bf16* prow, int h, LAS bf16* VT) {
    const v4u a = *(const v4u*)(prow + C_GV + h * 128 + F.wave * 16), b = *(const v4u*)(prow + C_GV + h * 128 + F.wave * 16 + 8);
    const unsigned w[8] = {a.x, a.y, a.z, a.w, b.x, b.y, b.z, b.w};
#pragma unroll
    for (int i = 0; i < 8; ++i) { VT[(F.wave * 16 + 2 * i) * 72 + F.lane] = (bf16)(w[i] & 0xffffu); VT[(F.wave * 16 + 2 * i + 1) * 72 + F.lane] = (bf16)(w[i] >> 16); }
}
__device__ __forceinline__ void gla_prep_item(Frame& F, int item) {
    const int h = item & 3, n = (item >> 2) & 127, b = item >> 9;
    const bf16* proj = (const bf16*)(F.ws + WS_A);
    const bf16* prow = proj + (size_t)(b * SEQ + n * 64 + F.lane) * NPROJ;
    LAS bf16* KT = (LAS bf16*)(F.lds + RING_OFF);
    LAS bf16* VT = (LAS bf16*)(F.lds + RING_OFF + 9216);
    float bc[8]; gla_bcum(F, prow, h, bc);
    float kf[8]; { const v4u kk = *(const v4u*)(prow + C_GK + h * 64 + F.wave * 8); unpack8(kk, kf); }
    float* DEC = (float*)(F.ws + WS_DEC) + ((size_t)(b * 128 + n) * 4 + h) * 64;
#pragma unroll
    for (int i = 0; i < 8; ++i) {
        const float bl = __shfl(bc[i], 63);
        KT[(F.wave * 8 + i) * 72 + F.lane] = (bf16)f2bf(kf[i] * __expf(bl - bc[i]));
        if (F.lane == 63) DEC[F.wave * 8 + i] = __expf(bl);
    }
    gla_stage_vT(F, prow, h, VT);
    __syncthreads();
    float* KV = (float*)(F.ws + WS_O) + ((size_t)(b * 128 + n) * 4 + h) * 8192;
    const int dt = F.wave >> 1;
#pragma unroll
    for (int j = 0; j < 4; ++j) {
        const int et = (F.wave & 1) * 4 + j;
        f32x4 acc = {0.f, 0.f, 0.f, 0.f};
        acc = mma16(KT + dt * 16 * 72, 72, VT + et * 16 * 72, 72, 64, acc, F.lane);
#pragma unroll
        for (int i = 0; i < 4; ++i) KV[(dt * 16 + 4 * (F.lane >> 4) + i) * 128 + et * 16 + (F.lane & 15)] = acc[i];
    }
    __syncthreads();
}
__device__ __forceinline__ void gla_scan(Frame& F, int gidx) {
    const int bh = gidx >> 13, de = gidx & 8191, b = bh >> 2, h = bh & 3;
    float* KV = (float*)(F.ws + WS_O) + ((size_t)(b * 128) * 4 + h) * 8192 + de;
    const float* DEC = (const float*)(F.ws + WS_DEC) + ((size_t)(b * 128) * 4 + h) * 64 + (de >> 7);
    float st = 0.f;
#pragma unroll 1
    for (int n0 = 0; n0 < 128; n0 += 8) {
        float kv[8], dc[8];
#pragma unroll
        for (int i = 0; i < 8; ++i) { kv[i] = KV[(size_t)(n0 + i) * 4 * 8192]; dc[i] = DEC[(size_t)(n0 + i) * 4 * 64]; }
#pragma unroll
        for (int i = 0; i < 8; ++i) { KV[(size_t)(n0 + i) * 4 * 8192] = st; st = dc[i] * st + kv[i]; }
    }
}
__device__ __forceinline__ void gla_out_item(Frame& F, int item) {
    const int h = item & 3, n = (item >> 2) & 127, b = item >> 9;
    const bf16* proj = (const bf16*)(F.ws + WS_A);
    const size_t tok = (size_t)b * SEQ + n * 64 + F.lane;
    const bf16* prow = proj + tok * NPROJ;
    LAS bf16* A1 = (LAS bf16*)(F.lds + RING_OFF);
    LAS bf16* B1 = (LAS bf16*)(F.lds + RING_OFF + 9216);
    LAS bf16* A2 = (LAS bf16*)(F.lds + RING_OFF + 18432);
    LAS bf16* SC = (LAS bf16*)(F.lds + RING_OFF + 27648);
    LAS bf16* VT = (LAS bf16*)(F.lds + RING_OFF + 36864);
    LAS bf16* ST = (LAS bf16*)(F.lds + RING_OFF + 55296);
    LAS float* OS = (LAS float*)(F.lds + RING_OFF + 73728);
    float bc[8]; gla_bcum(F, prow, h, bc);
    float qf[8], kf[8];
    { const v4u qq = *(const v4u*)(prow + C_GQ + h * 64 + F.wave * 8), kk = *(const v4u*)(prow + C_GK + h * 64 + F.wave * 8); unpack8(qq, qf); unpack8(kk, kf); }
    float a1[8], b1[8], a2[8];
#pragma unroll
    for (int i = 0; i < 8; ++i) {
        const float bm = __shfl(bc[i], 32);
        a1[i] = qf[i] * 0.125f * __expf(bc[i] - bm); b1[i] = kf[i] * __expf(bm - bc[i]); a2[i] = qf[i] * 0.125f * __expf(bc[i]);
    }
    *(LAS v4u*)(A1 + F.lane * 72 + F.wave * 8) = pack8(a1);
    *(LAS v4u*)(B1 + F.lane * 72 + F.wave * 8) = pack8(b1);
    *(LAS v4u*)(A2 + F.lane * 72 + F.wave * 8) = pack8(a2);
    gla_stage_vT(F, prow, h, VT);
    { const float* KV = (const float*)(F.ws + WS_O) + ((size_t)(b * 128 + n) * 4 + h) * 8192;
#pragma unroll
      for (int k = 0; k < 16; ++k) { const int p = F.tid + 512 * k, e = p & 127, d = p >> 7; ST[e * 72 + d] = (bf16)f2bf(KV[d * 128 + e]); } }
    __syncthreads();
    const int it = F.wave >> 1;
#pragma unroll
    for (int jj = 0; jj < 2; ++jj) {
        const int jt = (F.wave & 1) * 2 + jj;
        f32x4 acc = {0.f, 0.f, 0.f, 0.f};
        if (jt <= it) acc = mma16(A1 + it * 16 * 72, 72, B1 + jt * 16 * 72, 72, 64, acc, F.lane);
#pragma unroll
        for (int i = 0; i < 4; ++i) { const int ri = it * 16 + 4 * (F.lane >> 4) + i, cj = jt * 16 + (F.lane & 15); SC[ri * 72 + cj] = (bf16)f2bf((cj <= ri) ? acc[i] : 0.f); }
    }
    __syncthreads();
#pragma unroll
    for (int j = 0; j < 4; ++j) {
        const int et = (F.wave & 1) * 4 + j;
        f32x4 acc = {0.f, 0.f, 0.f, 0.f};
        acc = mma16(SC + it * 16 * 72, 72, VT + et * 16 * 72, 72, 64, acc, F.lane);
        acc = mma16(A2 + it * 16 * 72, 72, ST + et * 16 * 72, 72, 64, acc, F.lane);
#pragma unroll
        for (int i = 0; i < 4; ++i) OS[(it * 16 + 4 * (F.lane >> 4) + i) * 132 + et * 16 + (F.lane & 15)] = acc[i];
    }
    __syncthreads();
    { const int row = F.tid >> 3, c0 = (F.tid & 7) * 16;
      float v[16]; float ss = 0.f;
#pragma unroll
      for (int i = 0; i < 16; ++i) { v[i] = OS[row * 132 + c0 + i]; ss += v[i] * v[i]; }
      ss += __shfl_xor(ss, 1); ss += __shfl_xor(ss, 2); ss += __shfl_xor(ss, 4);
      const float rstd = 1.0f / sqrtf(ss * (1.0f / 128.0f) + NORM_EPS);
      const size_t tk = (size_t)b * SEQ + n * 64 + row;
      const bf16* rrow = proj + tk * NPROJ + C_GR + h * 128 + c0;
      float r0[8], r1[8]; unpack8(*(const v4u*)rrow, r0); unpack8(*(const v4u*)(rrow + 8), r1);
      float o0[8], o1[8];
#pragma unroll
      for (int i = 0; i < 8; ++i) { o0[i] = v[i] * rstd * F.gla_ng[c0 + i] * siluf_(r0[i]); o1[i] = v[8 + i] * rstd * F.gla_ng[c0 + 8 + i] * siluf_(r1[i]); }
      bf16* orow = (bf16*)(F.ws + WS_O + 32 * MiB) + tk * DM + h * 128 + c0;
      *(v4u*)orow = pack8(o0); *(v4u*)(orow + 8) = pack8(o1); }
    __syncthreads();
}

__device__ __forceinline__ double inv_freq_d(int i) {
    return (i == 0) ? 1.0 : (i == 1) ? 0.19392547740471268 : (i == 2) ? 0.037606090787015346 : (i == 3) ? 0.0072927791106285765 :
           (i == 4) ? 0.0014142135623730951 : (i == 5) ? 0.00027425197177757796 : (i == 6) ? 5.318404375373266e-05 : 1.0313741203148838e-05;
}
__device__ __forceinline__ void rope_sincos(int pos, int i, float& cs, float& sn) {
    const double rev = (double)pos * inv_freq_d(i) * 0.15915494309189535;
    const float fr = (float)(rev - rint(rev));
    cs = __builtin_amdgcn_cosf(fr); sn = __builtin_amdgcn_sinf(fr);
}
__device__ __forceinline__ void nsa_prep_token(Frame& F, int tok) {
    const int b = tok >> 13, t = tok & 8191, sub = F.lane & 7, vid = F.lane >> 3;
    const bf16* prow = (const bf16*)(F.ws + WS_A) + (size_t)tok * NPROJ;
    const int pos = F.positions[tok];
    float cs_l, sn_l; rope_sincos(pos, sub, cs_l, sn_l);
    float cs[8], sn[8];
#pragma unroll
    for (int i = 0; i < 8; ++i) { cs[i] = __shfl(cs_l, (F.lane & ~7) + i); sn[i] = __shfl(sn_l, (F.lane & ~7) + i); }
    unsigned char* dob = F.dout_b;
    const size_t ktile_off = (size_t)(t >> 6) * 8192 + sub * 1024 + (t & 63) * 16;
    const size_t vtile_off = (size_t)(t >> 6) * 8192 + (sub >> 2) * 4096 + (t & 63) * 64 + (sub & 3) * 16;
#pragma unroll
    for (int round = 0; round < 3; ++round) {
        int col; int kind; unsigned char* dst; const float* gain = nullptr;
        if (round == 0) { col = C_NQ + vid * 64; kind = 0; gain = F.q_gain; const int g = vid >> 2, hh = vid & 3;
            dst = dob + DO_QN + ((((size_t)(b * 2 + g) * SEQ + t) * 4 + hh) * 64 + sub * 8) * 2; }
        else if (round == 1) {
            const int g = vid & 1, which = vid >> 1;
            const size_t img = (size_t)(b * 2 + g) * (1u << 20);
            if (which == 0) { col = C_KS + g * 64; kind = 1; gain = F.k_gain + 64; dst = dob + DO_KSEL + img + ktile_off; }
            else if (which == 1) { col = C_KW + g * 64; kind = 1; gain = F.k_gain + 128; dst = dob + DO_KWIN + img + ktile_off; }
            else if (which == 2) { col = C_VS + g * 64; kind = 2; dst = dob + DO_VSEL + img + vtile_off; }
            else { col = C_VW + g * 64; kind = 2; dst = dob + DO_VWIN + img + vtile_off; }
        } else {
            const int g = vid & 1, which = (vid >> 1) & 1;
            col = (which ? C_VC : C_KC) + g * 64; kind = 2;
            dst = dob + (which ? DO_VC : DO_KC) + (((size_t)(b * 2 + g) * SEQ + t) * 64 + sub * 8) * 2;
        }
        float x[8]; unpack8(*(const v4u*)(prow + col + sub * 8), x);
        if (kind != 2) {
            float ss = 0.f;
#pragma unroll
            for (int i = 0; i < 8; ++i) ss += x[i] * x[i];
            ss += __shfl_xor(ss, 1); ss += __shfl_xor(ss, 2); ss += __shfl_xor(ss, 4);
            const float rstd = 1.0f / sqrtf(ss * (1.0f / 64.0f) + NORM_EPS);
#pragma unroll
            for (int i = 0; i < 8; ++i) x[i] = x[i] * rstd * gain[sub * 8 + i];
            float xo[8];
#pragma unroll
            for (int i = 0; i < 8; ++i) xo[i] = __shfl_xor(x[i], 1);
            if (sub == 0) {
#pragma unroll
                for (int i = 0; i < 8; ++i) x[i] = x[i] * cs[i] - xo[i] * sn[i];
            } else if (sub == 1) {
#pragma unroll
                for (int i = 0; i < 8; ++i) x[i] = x[i] * cs[i] + xo[i] * sn[i];
            }
            if (kind == 0) {
#pragma unroll
                for (int i = 0; i < 8; ++i) x[i] *= 0.125f * 1.4426950408889634f;
            }
        }
        if (round < 2 || F.lane < 32) *(v4u*)dst = pack8(x);
    }
    if (F.lane < 24) { float* gt = (float*)(F.ws + WS_GATES) + (size_t)tok * 24; gt[F.lane] = sigmoidf_(bf2f(prow[C_NG + F.lane])); }
}

__device__ __forceinline__ void nsa_compress_item(Frame& F, int item) {
    const int kv = item >> 6, b = (item >> 5) & 1, g = (item >> 4) & 1, rt = item & 15, n0 = rt * 32;
    const bf16* Asrc = (const bf16*)(F.dout_b + (kv ? DO_VC : DO_KC)) + ((size_t)(b * 2 + g) * SEQ + 16 * n0) * 64;
    const bf16* Bsrc = (const bf16*)(F.ws + WS_WCW1) + (size_t)kv * 256 * 2048;
    LAS bf16* As = (LAS bf16*)(F.lds + RING_OFF);
    LAS bf16* Bs = (LAS bf16*)(F.lds + RING_OFF + 2 * 32 * 72 * 2);
    LAS float* Hs = (LAS float*)(F.lds + RING_OFF + 86016);
    LAS float* W2s = (LAS float*)(F.lds + RING_OFF);
    const int ar = F.tid >> 3, ac = (F.tid & 7) * 8;
    v4u areg = {0u, 0u, 0u, 0u}, breg[4];
#define CMP_GLOAD(kc) do { if (F.tid < 256) areg = *(const v4u*)(Asrc + (size_t)ar * 1024 + (kc) * 64 + ac); \
        _Pragma("unroll") for (int i_ = 0; i_ < 4; ++i_) { const int p_ = F.tid + 512 * i_, br_ = p_ >> 3, bc_ = (p_ & 7) * 8; breg[i_] = *(const v4u*)(Bsrc + (size_t)br_ * 2048 + (kc) * 64 + bc_); } } while (0)
#define CMP_LSTORE(buf) do { if (F.tid < 256) *(LAS v4u*)(As + (buf) * 32 * 72 + ar * 72 + ac) = areg; \
        _Pragma("unroll") for (int i_ = 0; i_ < 4; ++i_) { const int p_ = F.tid + 512 * i_, br_ = p_ >> 3, bc_ = (p_ & 7) * 8; *(LAS v4u*)(Bs + (buf) * 256 * 72 + br_ * 72 + bc_) = breg[i_]; } } while (0)
    f32x4 acc[2][2];
#pragma unroll
    for (int mt = 0; mt < 2; ++mt)
#pragma unroll
        for (int nt = 0; nt < 2; ++nt) acc[mt][nt] = (f32x4){0.f, 0.f, 0.f, 0.f};
    CMP_GLOAD(0); CMP_LSTORE(0); __syncthreads();
#pragma unroll 1
    for (int kc = 0; kc < 32; ++kc) {
        const int buf = kc & 1;
        if (kc + 1 < 32) CMP_GLOAD(kc + 1);
#pragma unroll
        for (int mt = 0; mt < 2; ++mt)
#pragma unroll
            for (int nt = 0; nt < 2; ++nt)
                acc[mt][nt] = mma16(As + buf * 32 * 72 + mt * 16 * 72, 72, Bs + buf * 256 * 72 + (F.wave * 32 + nt * 16) * 72, 72, 64, acc[mt][nt], F.lane);
        if (kc + 1 < 32) CMP_LSTORE(buf ^ 1);
        __syncthreads();
    }
    const float* bias1 = (const float*)(F.ws + WS_MOD + 131072) + kv * 256;
#pragma unroll
    for (int mt = 0; mt < 2; ++mt)
#pragma unroll
        for (int nt = 0; nt < 2; ++nt) { const int col = F.wave * 32 + nt * 16 + (F.lane & 15);
#pragma unroll
            for (int i = 0; i < 4; ++i) Hs[(mt * 16 + 4 * (F.lane >> 4) + i) * 260 + col] = gelu_tanh(acc[mt][nt][i] + bias1[col]); }
    { const float* w2 = F.cmp_w2 + (size_t)kv * 256 * 64;
#pragma unroll
      for (int i = 0; i < 8; ++i) *(LAS f32x4*)(W2s + (F.tid + 512 * i) * 4) = *(const f32x4*)(w2 + (size_t)(F.tid + 512 * i) * 4); }
    __syncthreads();
    const int r = F.tid >> 4, dq = F.tid & 15;
    f32x4 o = {0.f, 0.f, 0.f, 0.f};
#pragma unroll 8
    for (int j = 0; j < 256; ++j) { const float hv = Hs[r * 260 + j]; const f32x4 w = *(const LAS f32x4*)(W2s + j * 64 + 4 * dq); o = o + w * hv; }
    const int n = n0 + r;
    if (kv == 0) {
        float ss = (o.x * o.x + o.y * o.y) + (o.z * o.z + o.w * o.w);
        ss += __shfl_xor(ss, 1); ss += __shfl_xor(ss, 2); ss += __shfl_xor(ss, 4); ss += __shfl_xor(ss, 8);
        const float rstd = 1.0f / sqrtf(ss * (1.0f / 64.0f) + NORM_EPS);
        const f32x4 gn = *(const f32x4*)(F.k_gain + 4 * dq);
        o = o * rstd * gn;
        const int tlast = (16 * n + 31 < SEQ) ? 16 * n + 31 : SEQ - 1;
        const int pos = F.positions[b * SEQ + tlast];
        f32x4 po; po.x = __shfl_xor(o.x, 2); po.y = __shfl_xor(o.y, 2); po.z = __shfl_xor(o.z, 2); po.w = __shfl_xor(o.w, 2);
        if (dq < 4) {
            const int i0 = 4 * (dq & 1);
            float c0, s0, c1, s1, c2, s2, c3, s3;
            rope_sincos(pos, i0, c0, s0); rope_sincos(pos, i0 + 1, c1, s1); rope_sincos(pos, i0 + 2, c2, s2); rope_sincos(pos, i0 + 3, c3, s3);
            if (dq < 2) { o.x = o.x * c0 - po.x * s0; o.y = o.y * c1 - po.y * s1; o.z = o.z * c2 - po.z * s2; o.w = o.w * c3 - po.w * s3; }
            else { o.x = o.x * c0 + po.x * s0; o.y = o.y * c1 + po.y * s1; o.z = o.z * c2 + po.z * s2; o.w = o.w * c3 + po.w * s3; }
        }
    }
    if (n == 511) o = (f32x4){0.f, 0.f, 0.f, 0.f};
    v2u pk; pk.x = pk2(o.x, o.y); pk.y = pk2(o.z, o.w);
    const int c = dq >> 1;
    unsigned char* img = F.dout_b + (kv ? DO_VCMP : DO_KCMP) + (size_t)(b * 2 + g) * 65536 + (size_t)(n >> 6) * 8192;
    if (kv == 0) *(v2u*)(img + c * 1024 + (n & 63) * 16 + (dq & 1) * 8) = pk;
    else *(v2u*)(img + (c >> 2) * 4096 + (n & 63) * 64 + (c & 3) * 16 + (dq & 1) * 8) = pk;
    __syncthreads();
}

constexpr int NSA_KB = 0, NSA_VB = 16384, NSA_IMP = 32768, NSA_OACC = 65536;
__device__ __forceinline__ int crow(int r, int hi) { return (r & 3) + 8 * (r >> 2) + 4 * hi; }
__device__ __forceinline__ s16x4 ds_tr16(const LAS unsigned char* p) { return __builtin_bit_cast(s16x4, __builtin_amdgcn_ds_read_tr16_b64_v4i16((LAS s16x4*)p)); }

__device__ __forceinline__ unsigned cvtpk(float lo, float hi) { unsigned r; asm("v_cvt_pk_bf16_f32 %0, %1, %2" : "=v"(r) : "v"(lo), "v"(hi)); return r; }
__device__ __forceinline__ float xhalf_max(float v) { const auto rr = __builtin_amdgcn_permlane32_swap(__float_as_uint(v), __float_as_uint(v), false, false); return fmaxf(__uint_as_float(rr[0]), __uint_as_float(rr[1])); }
constexpr float NSA_THR = 8.0f;

template <int MODE>
__device__ __forceinline__ void nsa_branch(Frame& F, const unsigned char* Kimg, const unsigned char* Vimg, int kt0, int kt1, const bf16x8 (&qr)[4],
                                           float& m, float& l, f32x16 (&o)[2], int t, int tw0, int nv, int nvw, int nvmin,
                                           unsigned mk0, unsigned mk1, unsigned mk2, unsigned mk3, unsigned wo0, unsigned wo1, unsigned wo2, unsigned wo3,
                                           float cinit  , LAS float* impw) {
    const int r32 = F.lane & 31, hi = F.lane >> 5, tokl = r32 >> 2;
    LAS unsigned char* KB = F.lds + RING_OFF + NSA_KB; LAS unsigned char* VB = F.lds + RING_OFF + NSA_VB;
    const v4u* kg = (const v4u*)Kimg + F.tid; const v4u* vg = (const v4u*)Vimg + F.tid;
    v4u kreg = kg[(size_t)kt0 * 512], vreg = {0u, 0u, 0u, 0u};
    if (MODE != 0) vreg = vg[(size_t)kt0 * 512];
    *(LAS v4u*)(KB + F.tid * 16) = kreg; if (MODE != 0) *(LAS v4u*)(VB + F.tid * 16) = vreg;
    __syncthreads();
#pragma unroll 1
    for (int kt = kt0; kt < kt1; ++kt) {
        const int buf = (kt - kt0) & 1; const bool has_next = kt + 1 < kt1;
        if (has_next) { kreg = kg[(size_t)(kt + 1) * 512]; if (MODE != 0) vreg = vg[(size_t)(kt + 1) * 512]; }
        const LAS unsigned char* Kb = KB + buf * 8192; const LAS unsigned char* Vb = VB + buf * 8192;
        bool need;
        if (MODE <= 1) need = kt * 64 < nvw;
        else if (MODE == 2) { const unsigned w = (kt < 32) ? wo0 : (kt < 64) ? wo1 : (kt < 96) ? wo2 : wo3; need = (w >> (kt & 31)) & 1u; }
        else need = (kt * 64 <= tw0 + 7) && (kt * 64 + 63 + 512 > tw0);
        bool selbit = true;
        if (MODE == 2) { const unsigned w = (kt < 32) ? mk0 : (kt < 64) ? mk1 : (kt < 96) ? mk2 : mk3; selbit = (w >> (kt & 31)) & 1u; }
        bool joint = false;
        if (need) {
            if (MODE == 2) joint = kt < (tw0 >> 6);
            else if (MODE == 3) joint = (kt * 64 + 63 <= tw0) && (kt * 64 + 512 > tw0 + 7);
            else joint = kt * 64 + 63 < nvmin;
            if (MODE != 1) joint = joint && !__any(m < -1e29f);
        }
        if (need && joint) {
            const float c0 = (MODE == 1) ? cinit : ((MODE == 2 && !selbit) ? -1e30f : -m);
            f32x16 pa, pb;
#pragma unroll
            for (int r = 0; r < 16; ++r) { pa[r] = c0; pb[r] = c0; }
#pragma unroll
            for (int d0 = 0; d0 < 4; ++d0) {
                const bf16x8 kfa = *(const LAS bf16x8*)(Kb + (2 * d0 + hi) * 1024 + r32 * 16), kfb = *(const LAS bf16x8*)(Kb + (2 * d0 + hi) * 1024 + (32 + r32) * 16);
                pa = __builtin_amdgcn_mfma_f32_32x32x16_bf16(kfa, qr[d0], pa, 0, 0, 0);
                pb = __builtin_amdgcn_mfma_f32_32x32x16_bf16(kfb, qr[d0], pb, 0, 0, 0);
            }
            if (MODE != 1) {
                float mxa = fmaxf(fmaxf(pa[0], pa[1]), pa[2]), mxb = fmaxf(fmaxf(pb[0], pb[1]), pb[2]);
#pragma unroll
                for (int r = 3; r < 15; r += 2) { mxa = fmaxf(fmaxf(mxa, pa[r]), pa[r + 1]); mxb = fmaxf(fmaxf(mxb, pb[r]), pb[r + 1]); }
                const float mx = xhalf_max(fmaxf(fmaxf(mxa, pa[15]), fmaxf(mxb, pb[15])));
                if (__any(mx > NSA_THR)) {
                    const float dl = fmaxf(mx, 0.f), alpha = fexp2(-dl);
                    m += dl; l *= alpha;
#pragma unroll
                    for (int r = 0; r < 16; ++r) { pa[r] -= dl; pb[r] -= dl; }
                    if (MODE != 0) {
#pragma unroll
                        for (int r = 0; r < 16; ++r) { o[0][r] *= alpha; o[1][r] *= alpha; }
                    }
                }
            }
            float ps0 = 0.f, ps1 = 0.f;
#pragma unroll
            for (int r = 0; r < 16; ++r) { pa[r] = fexp2(pa[r]); pb[r] = fexp2(pb[r]); ps0 += pa[r]; ps1 += pb[r]; }
            if (MODE != 1) l += ps0 + ps1;
            if (MODE == 1) {
#pragma unroll
                for (int rg = 0; rg < 4; ++rg) {
                    float a = (pa[4 * rg] + pa[4 * rg + 1]) + (pa[4 * rg + 2] + pa[4 * rg + 3]), sp = pa[4 * rg + 3];
                    float a2 = (pb[4 * rg] + pb[4 * rg + 1]) + (pb[4 * rg + 2] + pb[4 * rg + 3]), sp2 = pb[4 * rg + 3];
                    a += __shfl_xor(a, 1); a += __shfl_xor(a, 2); sp += __shfl_xor(sp, 1); sp += __shfl_xor(sp, 2);
                    a2 += __shfl_xor(a2, 1); a2 += __shfl_xor(a2, 2); sp2 += __shfl_xor(sp2, 1); sp2 += __shfl_xor(sp2, 2);
                    if ((r32 & 3) == 0) { const int jp = kt * 16 + 2 * rg + hi;
                        __hip_atomic_fetch_add(impw + tokl * 128 + jp, a, __ATOMIC_RELAXED, __HIP_MEMORY_SCOPE_WORKGROUP);
                        __hip_atomic_fetch_add(impw + tokl * 128 + jp + 1, sp, __ATOMIC_RELAXED, __HIP_MEMORY_SCOPE_WORKGROUP);
                        __hip_atomic_fetch_add(impw + tokl * 128 + jp + 8, a2, __ATOMIC_RELAXED, __HIP_MEMORY_SCOPE_WORKGROUP);
                        if (jp + 9 < 128) __hip_atomic_fetch_add(impw + tokl * 128 + jp + 9, sp2, __ATOMIC_RELAXED, __HIP_MEMORY_SCOPE_WORKGROUP); }
                }
            }
            if (MODE != 0) {
                v4u wa0, wa1, wb0, wb1;
                wa0.x = cvtpk(pa[0], pa[1]); wa0.y = cvtpk(pa[2], pa[3]); wa0.z = cvtpk(pa[4], pa[5]); wa0.w = cvtpk(pa[6], pa[7]);
                wa1.x = cvtpk(pa[8], pa[9]); wa1.y = cvtpk(pa[10], pa[11]); wa1.z = cvtpk(pa[12], pa[13]); wa1.w = cvtpk(pa[14], pa[15]);
                wb0.x = cvtpk(pb[0], pb[1]); wb0.y = cvtpk(pb[2], pb[3]); wb0.z = cvtpk(pb[4], pb[5]); wb0.w = cvtpk(pb[6], pb[7]);
                wb1.x = cvtpk(pb[8], pb[9]); wb1.y = cvtpk(pb[10], pb[11]); wb1.z = cvtpk(pb[12], pb[13]); wb1.w = cvtpk(pb[14], pb[15]);
                const bf16x8 fa0 = __builtin_bit_cast(bf16x8, wa0), fa1 = __builtin_bit_cast(bf16x8, wa1), fb0 = __builtin_bit_cast(bf16x8, wb0), fb1 = __builtin_bit_cast(bf16x8, wb1);
                const LAS unsigned char* vb = Vb + (4 * hi + ((F.lane & 15) >> 2)) * 64 + ((F.lane >> 4) & 1) * 32 + (F.lane & 3) * 8;
#pragma unroll
                for (int dh = 0; dh < 2; ++dh) {
                    const LAS unsigned char* v0 = vb + dh * 4096;
                    const s16x4 a0 = ds_tr16(v0), a1 = ds_tr16(v0 + 512), b0 = ds_tr16(v0 + 1024), b1 = ds_tr16(v0 + 1536), c0_ = ds_tr16(v0 + 2048), c1 = ds_tr16(v0 + 2560), d0_ = ds_tr16(v0 + 3072), d1 = ds_tr16(v0 + 3584);
                    const bf16x8 vfa0 = {a0[0], a0[1], a0[2], a0[3], a1[0], a1[1], a1[2], a1[3]}, vfa1 = {b0[0], b0[1], b0[2], b0[3], b1[0], b1[1], b1[2], b1[3]};
                    const bf16x8 vfb0 = {c0_[0], c0_[1], c0_[2], c0_[3], c1[0], c1[1], c1[2], c1[3]}, vfb1 = {d0_[0], d0_[1], d0_[2], d0_[3], d1[0], d1[1], d1[2], d1[3]};
                    o[dh] = __builtin_amdgcn_mfma_f32_32x32x16_bf16(vfa0, fa0, o[dh], 0, 0, 0);
                    o[dh] = __builtin_amdgcn_mfma_f32_32x32x16_bf16(vfa1, fa1, o[dh], 0, 0, 0);
                    o[dh] = __builtin_amdgcn_mfma_f32_32x32x16_bf16(vfb0, fb0, o[dh], 0, 0, 0);
                    o[dh] = __builtin_amdgcn_mfma_f32_32x32x16_bf16(vfb1, fb1, o[dh], 0, 0, 0);
                }
            }
        } else if (need) {
#pragma unroll 1
            for (int kb = 0; kb < 2; ++kb) {
                const int key0 = kt * 64 + kb * 32;
                bool fast;
                if (MODE == 2) fast = kt < (tw0 >> 6);
                else if (MODE == 3) fast = (key0 + 31 <= tw0) && (key0 + 512 > tw0 + 7);
                else fast = key0 + 31 < nvmin;
                if (MODE != 1) fast = fast && !__any(m < -1e29f);
                float c0 = 0.f;
                if (fast) c0 = (MODE == 1) ? cinit : ((MODE == 2 && !selbit) ? -1e30f : -m);
                f32x16 p;
#pragma unroll
                for (int r = 0; r < 16; ++r) p[r] = c0;
#pragma unroll
                for (int d0 = 0; d0 < 4; ++d0) {
                    const bf16x8 kf = *(const LAS bf16x8*)(Kb + (2 * d0 + hi) * 1024 + (32 * kb + r32) * 16);
                    p = __builtin_amdgcn_mfma_f32_32x32x16_bf16(kf, qr[d0], p, 0, 0, 0);
                }
                float pe[16];
                if (fast) {
                    if (MODE != 1) {
                        float mx = fmaxf(fmaxf(p[0], p[1]), p[2]);
#pragma unroll
                        for (int r = 3; r < 15; r += 2) mx = fmaxf(fmaxf(mx, p[r]), p[r + 1]);
                        mx = xhalf_max(fmaxf(mx, p[15]));
                        if (__any(mx > NSA_THR)) {
                            const float dl = fmaxf(mx, 0.f), alpha = fexp2(-dl);
                            m += dl; l *= alpha;
#pragma unroll
                            for (int r = 0; r < 16; ++r) p[r] -= dl;
                            if (MODE != 0) {
#pragma unroll
                                for (int r = 0; r < 16; ++r) { o[0][r] *= alpha; o[1][r] *= alpha; }
                            }
                        }
                    }
                    float ps0 = 0.f, ps1 = 0.f;
#pragma unroll
                    for (int r = 0; r < 16; r += 2) { pe[r] = fexp2(p[r]); pe[r + 1] = fexp2(p[r + 1]); ps0 += pe[r]; ps1 += pe[r + 1]; }
                    if (MODE != 1) l += ps0 + ps1;
                } else if (MODE == 1) {
#pragma unroll
                    for (int r = 0; r < 16; ++r) { const int key = key0 + crow(r, hi); pe[r] = (key < nv) ? fexp2(p[r] + cinit) : 0.f; }
                } else {
                    float mx = NEGBIG;
#pragma unroll
                    for (int r = 0; r < 16; ++r) {
                        const int key = key0 + crow(r, hi); bool ok;
                        if (MODE == 0) ok = key < nv;
                        else if (MODE == 2) ok = selbit && (kt < (t >> 6) || key <= t);
                        else ok = (key <= t) && (key + 512 > t);
                        p[r] = ok ? p[r] : NEGBIG; mx = fmaxf(mx, p[r]);
                    }
                    mx = xhalf_max(mx);
                    const float mn = fmaxf(m, mx), alpha = fexp2(m - mn);
                    float ps = 0.f;
#pragma unroll
                    for (int r = 0; r < 16; ++r) { pe[r] = (p[r] > -1e29f) ? fexp2(p[r] - mn) : 0.f; ps += pe[r]; }
                    l = l * alpha + ps; m = mn;
                    if (MODE != 0) {
#pragma unroll
                        for (int r = 0; r < 16; ++r) { o[0][r] *= alpha; o[1][r] *= alpha; }
                    }
                }
                if (MODE == 1) {
#pragma unroll
                    for (int rg = 0; rg < 4; ++rg) {
                        float a = (pe[4 * rg] + pe[4 * rg + 1]) + (pe[4 * rg + 2] + pe[4 * rg + 3]), sp = pe[4 * rg + 3];
                        a += __shfl_xor(a, 1); a += __shfl_xor(a, 2); sp += __shfl_xor(sp, 1); sp += __shfl_xor(sp, 2);
                        if ((r32 & 3) == 0) { const int jp = (key0 >> 2) + 2 * rg + hi;
                            __hip_atomic_fetch_add(impw + tokl * 128 + jp, a, __ATOMIC_RELAXED, __HIP_MEMORY_SCOPE_WORKGROUP);
                            if (jp + 1 < 128) __hip_atomic_fetch_add(impw + tokl * 128 + jp + 1, sp, __ATOMIC_RELAXED, __HIP_MEMORY_SCOPE_WORKGROUP); }
                    }
                }
                if (MODE != 0) {
                    v4u pw0, pw1;
                    pw0.x = cvtpk(pe[0], pe[1]); pw0.y = cvtpk(pe[2], pe[3]); pw0.z = cvtpk(pe[4], pe[5]); pw0.w = cvtpk(pe[6], pe[7]);
                    pw1.x = cvtpk(pe[8], pe[9]); pw1.y = cvtpk(pe[10], pe[11]); pw1.z = cvtpk(pe[12], pe[13]); pw1.w = cvtpk(pe[14], pe[15]);
                    const bf16x8 pf0 = __builtin_bit_cast(bf16x8, pw0), pf1 = __builtin_bit_cast(bf16x8, pw1);
                    const LAS unsigned char* vb = Vb + (32 * kb + 4 * hi + ((F.lane & 15) >> 2)) * 64 + ((F.lane >> 4) & 1) * 32 + (F.lane & 3) * 8;
#pragma unroll
                    for (int dh = 0; dh < 2; ++dh) {
                        const s16x4 a0 = ds_tr16(vb + dh * 4096), a1 = ds_tr16(vb + dh * 4096 + 512), b0 = ds_tr16(vb + dh * 4096 + 1024), b1 = ds_tr16(vb + dh * 4096 + 1024 + 512);
                        const bf16x8 vf0 = {a0[0], a0[1], a0[2], a0[3], a1[0], a1[1], a1[2], a1[3]}, vf1 = {b0[0], b0[1], b0[2], b0[3], b1[0], b1[1], b1[2], b1[3]};
                        o[dh] = __builtin_amdgcn_mfma_f32_32x32x16_bf16(vf0, pf0, o[dh], 0, 0, 0);
                        o[dh] = __builtin_amdgcn_mfma_f32_32x32x16_bf16(vf1, pf1, o[dh], 0, 0, 0);
                    }
                }
            }
        }
        if (has_next) { *(LAS v4u*)(KB + (buf ^ 1) * 8192 + F.tid * 16) = kreg; if (MODE != 0) *(LAS v4u*)(VB + (buf ^ 1) * 8192 + F.tid * 16) = vreg; }
        __syncthreads();
    }
}

__device__ __forceinline__ void nsa_item(Frame& F, int b, int g, int qi) {
    const int r32 = F.lane & 31, hi = F.lane >> 5, tokl = r32 >> 2, hh = r32 & 3;
    const int t0 = qi * 64, tw0 = t0 + 8 * F.wave, t = tw0 + tokl;
    const unsigned char* dob = F.dout_b;
    const size_t img = (size_t)(b * 2 + g) * (1u << 20);
    LAS float* impw = (LAS float*)(F.lds + RING_OFF + NSA_IMP) + F.wave * 1024;
    LAS unsigned* selm = (LAS unsigned*)(F.lds + TAB_OFF + 1024) + F.wave * 32;
    LAS float* oaccw = (LAS float*)(F.lds + RING_OFF + NSA_OACC) + F.wave * 2048 + F.lane;
#pragma unroll
    for (int i = 0; i < 16; ++i) impw[F.lane + 64 * i] = 0.f;
    bf16x8 qr[4];
    { const bf16* qrow = (const bf16*)(dob + DO_QN) + (((size_t)(b * 2 + g) * SEQ + tw0) * 4 + r32) * 64;
#pragma unroll
      for (int d0 = 0; d0 < 4; ++d0) qr[d0] = *(const bf16x8*)(qrow + 16 * d0 + 8 * hi); }
    const float* gt = (const float*)(F.ws + WS_GATES) + ((size_t)b * SEQ + t) * 24 + (g * 4 + hh) * 3;
#if defined(NSA_ZERO_CMP)
    const float g0 = 0.f, g1 = gt[1], g2 = gt[2];
#elif defined(NSA_ZERO_SEL)
    const float g0 = gt[0], g1 = 0.f, g2 = gt[2];
#elif defined(NSA_ZERO_WIN)
    const float g0 = gt[0], g1 = gt[1], g2 = 0.f;
#elif defined(NSA_ZERO_ALL)
    const float g0 = 0.f, g1 = 0.f, g2 = 0.f;
#else
    const float g0 = gt[0], g1 = gt[1], g2 = gt[2];
#endif
    f32x16 o[2];
    const int nv = (t >= 31) ? ((t - 31) >> 4) + 1 : 0, nvw = (tw0 + 7 >= 31) ? ((tw0 + 7 - 31) >> 4) + 1 : 0, nvmin = (tw0 >= 31) ? ((tw0 - 31) >> 4) + 1 : 0;
    const int nct = (4 * qi + 3 + 63) >> 6;
    const unsigned char* Kc = dob + DO_KCMP + (size_t)(b * 2 + g) * 65536; const unsigned char* Vc = dob + DO_VCMP + (size_t)(b * 2 + g) * 65536;
#if defined(NSA_SPIN)
    unsigned long long tsp = __builtin_amdgcn_s_memrealtime();
#define NSPIN(k) do { if (NSA_SPIN == (k)) { const unsigned long long t1_ = __builtin_amdgcn_s_memrealtime(), dt_ = t1_ - tsp; while (__builtin_amdgcn_s_memrealtime() - t1_ < dt_) __builtin_amdgcn_s_sleep(4); } tsp = __builtin_amdgcn_s_memrealtime(); } while (0)
#else
#define NSPIN(k) do { } while (0)
#endif
    float m = NEGBIG, l = 0.f;
    nsa_branch<0>(F, Kc, Vc, 0, nct, qr, m, l, o, t, tw0, nv, nvw, nvmin, 0u, 0u, 0u, 0u, 0u, 0u, 0u, 0u, 0.f, impw);
    { const float lt = l + __shfl_xor(l, 32); const float cinit = (lt > 0.f) ? -__log2f(lt) - m : -1e30f;
#pragma unroll
      for (int r = 0; r < 16; ++r) { o[0][r] = 0.f; o[1][r] = 0.f; }
      nsa_branch<1>(F, Kc, Vc, 0, nct, qr, m, l, o, t, tw0, nv, nvw, nvmin, 0u, 0u, 0u, 0u, 0u, 0u, 0u, 0u, cinit, impw);
#pragma unroll
      for (int r = 0; r < 16; ++r) { oaccw[r * 64] = g0 * o[0][r]; oaccw[(16 + r) * 64] = g0 * o[1][r]; } }
    __syncthreads();
    NSPIN(1);
#pragma unroll 1
    for (int tl = 0; tl < 8; ++tl) {
        const int tt = tw0 + tl, cur = tt >> 6, j0 = F.lane, j1 = F.lane + 64;
        const unsigned u0 = (j0 <= cur) ? (__float_as_uint(impw[tl * 128 + j0] + ((j0 == 0 || j0 == cur || j0 == cur - 1) ? 1e4f : 0.f)) + 1u) : 0u;
        const unsigned u1 = (j1 <= cur) ? (__float_as_uint(impw[tl * 128 + j1] + ((j1 == cur || j1 == cur - 1) ? 1e4f : 0.f)) + 1u) : 0u;
        bool s0, s1;
        if (cur < 16) { s0 = (j0 <= cur); s1 = false; }
        else {
            unsigned T = 0u;
#pragma unroll 1
            for (int bit = 31; bit >= 0; --bit) {
                const unsigned cand = T | (1u << bit);
                const int c = __popcll(__ballot(u0 >= cand)) + __popcll(__ballot(u1 >= cand));
                if (c >= 16) T = cand;
            }
            const unsigned long long g0 = __ballot(u0 > T), g1 = __ballot(u1 > T), e0 = __ballot(u0 == T), e1 = __ballot(u1 == T);
            const int need = 16 - (__popcll(g0) + __popcll(g1));
            const unsigned long long below = (F.lane == 0) ? 0ull : (~0ull >> (64 - F.lane));
            const int rank0 = __popcll(e0 & below), rank1 = __popcll(e0) + __popcll(e1 & below);
            s0 = (u0 > T) || (u0 == T && rank0 < need);
            s1 = (u1 > T) || (u1 == T && rank1 < need);
        }
        const unsigned long long m0 = __ballot(s0), m1 = __ballot(s1);
        if (F.lane == 0) { selm[tl * 4 + 0] = (unsigned)m0; selm[tl * 4 + 1] = (unsigned)(m0 >> 32); selm[tl * 4 + 2] = (unsigned)m1; selm[tl * 4 + 3] = (unsigned)(m1 >> 32); }
    }
    __syncthreads();
    const unsigned mk0 = selm[tokl * 4 + 0], mk1 = selm[tokl * 4 + 1], mk2 = selm[tokl * 4 + 2], mk3 = selm[tokl * 4 + 3];
    unsigned wo0 = 0u, wo1 = 0u, wo2 = 0u, wo3 = 0u;
#pragma unroll
    for (int tl = 0; tl < 8; ++tl) { wo0 |= selm[tl * 4 + 0]; wo1 |= selm[tl * 4 + 1]; wo2 |= selm[tl * 4 + 2]; wo3 |= selm[tl * 4 + 3]; }
    wo0 = __builtin_amdgcn_readfirstlane(wo0); wo1 = __builtin_amdgcn_readfirstlane(wo1); wo2 = __builtin_amdgcn_readfirstlane(wo2); wo3 = __builtin_amdgcn_readfirstlane(wo3);
    NSPIN(2);
    { m = NEGBIG; l = 0.f;
#pragma unroll
      for (int r = 0; r < 16; ++r) { o[0][r] = 0.f; o[1][r] = 0.f; }
      nsa_branch<2>(F, dob + DO_KSEL + img, dob + DO_VSEL + img, 0, qi + 1, qr, m, l, o, t, tw0, nv, nvw, nvmin, mk0, mk1, mk2, mk3, wo0, wo1, wo2, wo3, 0.f, impw);
      const float lt = l + __shfl_xor(l, 32); const float sc = (lt > 0.f) ? g1 / lt : 0.f;
#pragma unroll
      for (int r = 0; r < 16; ++r) { oaccw[r * 64] += sc * o[0][r]; oaccw[(16 + r) * 64] += sc * o[1][r]; } }
    NSPIN(3);
    { m = NEGBIG; l = 0.f;
#pragma unroll
      for (int r = 0; r < 16; ++r) { o[0][r] = 0.f; o[1][r] = 0.f; }
      nsa_branch<3>(F, dob + DO_KWIN + img, dob + DO_VWIN + img, (qi >= 8) ? qi - 8 : 0, qi + 1, qr, m, l, o, t, tw0, nv, nvw, nvmin, 0u, 0u, 0u, 0u, 0u, 0u, 0u, 0u, 0.f, impw);
      const float lt = l + __shfl_xor(l, 32); const float sc = (lt > 0.f) ? g2 / lt : 0.f;
#pragma unroll
      for (int r = 0; r < 16; ++r) { o[0][r] = oaccw[r * 64] + sc * o[0][r]; o[1][r] = oaccw[(16 + r) * 64] + sc * o[1][r]; } }
    NSPIN(4);
    bf16* orow = (bf16*)(F.ws + WS_O + 32 * MiB) + ((size_t)b * SEQ + t) * DM + 512 + (g * 4 + hh) * 64;
#pragma unroll
    for (int dh = 0; dh < 2; ++dh)
#pragma unroll
        for (int rg = 0; rg < 4; ++rg) { v2u w; w.x = pk2(o[dh][4 * rg], o[dh][4 * rg + 1]); w.y = pk2(o[dh][4 * rg + 2], o[dh][4 * rg + 3]);
            *(v2u*)(orow + 32 * dh + 8 * rg + 4 * hi) = w; }
    __syncthreads();
}

__device__ __forceinline__ void sgu_item(Frame& F, int item) {
    const int gg = item & 7, ck = (item >> 3) & 63, b = item >> 9;
    const size_t tok0 = (size_t)b * SEQ + ck * 128;
    const bf16* Z = (const bf16*)(F.ws + WS_A);
    LAS bf16* Ws = (LAS bf16*)(F.lds + RING_OFF);
    LAS bf16* VT = (LAS bf16*)(F.lds + RING_OFF + 34816);
    LAS float* rs = (LAS float*)(F.lds + RING_OFF + 34816 + 69632);
    if (F.tid < 128) { const float* st = (const float*)(F.ws + WS_STATS) + (tok0 + F.tid) * 32; float s = 0.f;
#pragma unroll
        for (int k = 0; k < 32; k += 4) { const f32x4 v = *(const f32x4*)(st + k); s += (v.x + v.y) + (v.z + v.w); }
        rs[F.tid] = 1.0f / sqrtf(s * (1.0f / SGW) + NORM_EPS); }
    { const float* wsrc = F.sgu_ws + (size_t)gg * 128 * 128;
#pragma unroll
      for (int k = 0; k < 8; ++k) { const int p = F.tid + 512 * k, tr = p >> 5, sc = (p & 31) * 4; const f32x4 w = *(const f32x4*)(wsrc + tr * 128 + sc);
          v2u o; o.x = pk2((sc <= tr) ? w.x : 0.f, (sc + 1 <= tr) ? w.y : 0.f); o.y = pk2((sc + 2 <= tr) ? w.z : 0.f, (sc + 3 <= tr) ? w.w : 0.f);
          *(LAS v2u*)(Ws + tr * 136 + sc) = o; } }
    __syncthreads();
#pragma unroll 2
    for (int k = 0; k < 8; ++k) {
        const int p = F.tid + 512 * k, s = p & 127, cc = p >> 7;
        float x[8]; unpack8(*(const v4u*)(Z + (tok0 + s) * 4096 + 2048 + gg * 256 + cc * 8), x);
        const float rr = rs[s];
#pragma unroll
        for (int i = 0; i < 8; ++i) VT[(cc * 8 + i) * 136 + s] = (bf16)f2bf(x[i] * rr * F.sgu_ng[gg * 256 + cc * 8 + i]);
    }
    __syncthreads();
    f32x4 acc[16];
#pragma unroll
    for (int nt = 0; nt < 16; ++nt) acc[nt] = (f32x4){0.f, 0.f, 0.f, 0.f};
    const int ksteps = (16 * F.wave + 16 + 31) >> 5;
    const LAS bf16* ap = Ws + (16 * F.wave + (F.lane & 15)) * 136 + (F.lane >> 4) * 8;
    const LAS bf16* bp = VT + (F.lane & 15) * 136 + (F.lane >> 4) * 8;
#pragma unroll 1
    for (int kk = 0; kk < ksteps; ++kk) {
        const bf16x8 a = *(const LAS bf16x8*)(ap + kk * 32);
#pragma unroll
        for (int nt = 0; nt < 16; ++nt) { const bf16x8 bb = *(const LAS bf16x8*)(bp + nt * 16 * 136 + kk * 32); acc[nt] = __builtin_amdgcn_mfma_f32_16x16x32_bf16(a, bb, acc[nt], 0, 0, 0); }
    }
    bf16* UM = (bf16*)(F.ws + WS_O);
#pragma unroll
    for (int i = 0; i < 4; ++i) {
        const int tr = 16 * F.wave + 4 * (F.lane >> 4) + i; const float bs = F.sgu_bs[gg * 128 + tr];
        const bf16* urow = Z + (tok0 + tr) * 4096 + gg * 256; bf16* orow = UM + (tok0 + tr) * SGW + gg * 256;
#pragma unroll
        for (int nt = 0; nt < 16; ++nt) { const int c = nt * 16 + (F.lane & 15); orow[c] = (bf16)f2bf(bf2f(urow[c]) * (acc[nt][i] + bs)); }
    }
    __syncthreads();
}

constexpr int NPHASE = 18;
struct Args { const void* in[26]; float* out; unsigned char* ws; int ph_lo, ph_hi, use_bar, pad; };
__global__ void __launch_bounds__(512, 2) trunk_fwd(Args args) {
    extern __shared__ __attribute__((aligned(16))) unsigned char lds[];
    Frame F;
    F.lds = (LAS unsigned char*)lds;
    F.MISC = (volatile LAS unsigned*)(F.lds + MISC_OFF);
    F.tid = threadIdx.x; F.lane = F.tid & 63; F.wave = __builtin_amdgcn_readfirstlane(F.tid >> 6);
    F.G = gridDim.x; F.bid = blockIdx.x;
    F.ws = args.ws; F.out = args.out; F.dout_b = (unsigned char*)args.out;
    F.ctl = (gu32*)(args.ws + WS_CTL);
    F.x = (const float*)args.in[0]; F.c = (const float*)args.in[1]; F.positions = (const int*)args.in[2]; F.w_ada = (const float*)args.in[3]; F.b_ada = (const float*)args.in[4];
    F.norm_g = (const float*)args.in[5]; F.w_in_ab = (const float*)args.in[6]; F.w_out_ab = (const float*)args.in[7]; F.gla_w2 = (const float*)args.in[8]; F.gla_bg = (const float*)args.in[9];
    F.gla_ng = (const float*)args.in[10]; F.q_gain = (const float*)args.in[11]; F.k_gain = (const float*)args.in[12]; F.cmp_pe = (const float*)args.in[13]; F.cmp_w1 = (const float*)args.in[14];
    F.cmp_w2 = (const float*)args.in[15]; F.w_in_c = (const float*)args.in[16]; F.sgu_ng = (const float*)args.in[17]; F.sgu_ws = (const float*)args.in[18]; F.sgu_bs = (const float*)args.in[19];
    F.w_out_c = (const float*)args.in[20]; F.w_router = (const float*)args.in[21]; F.r_bias = (const float*)args.in[22]; F.w_gate = (const float*)args.in[23]; F.w_up = (const float*)args.in[24];
    F.w_down = (const float*)args.in[25];
    for (int u = F.tid; u < (LDS_BYTES - LDSCTL_OFF) / 4; u += 512) ((LAS unsigned*)(F.lds + LDSCTL_OFF))[u] = 0u;
    __syncthreads();
    XcdBarrier bar; bar.bar = (unsigned*)(F.ctl + CW_BAR); bar.x = 0; bar.st = nullptr;
    if (args.use_bar) bar = xcd_barrier_post((unsigned*)(F.ctl + CW_BAR) + (args.use_bar - 1) * XCD_BAR_WORDS, F.MISC + 8);
    const int lo = args.ph_lo, hi = args.ph_hi;
#ifndef PH_MASK
#define PH_MASK 0x3FFFFu
#endif
#define IN(k) ((((PH_MASK) >> (k)) & 1u) && lo <= (k) && (k) < hi)
#if defined(SPIN_PHASE)
    unsigned long long t_mark = __builtin_amdgcn_s_memrealtime();
#define SPIN_HOOK(k) do { if ((k) == (SPIN_PHASE)) { const unsigned long long t1_ = __builtin_amdgcn_s_memrealtime(), dt_ = t1_ - t_mark; while (__builtin_amdgcn_s_memrealtime() - t1_ < dt_) __builtin_amdgcn_s_sleep(4); } } while (0)
#define SPIN_MARK() do { t_mark = __builtin_amdgcn_s_memrealtime(); } while (0)
#else
#define SPIN_HOOK(k) do { } while (0)
#define SPIN_MARK() do { } while (0)
#endif
#define SEAM(k) do { if (IN(k)) SPIN_HOOK(k); if (IN(k) && IN((k) + 1)) xcd_barrier(bar); SPIN_MARK(); } while (0)
    float* mod = (float*)(F.ws + WS_MOD);
    bf16* Hb = (bf16*)(F.ws + WS_O);
    bf16* Ab = (bf16*)(F.ws + WS_A);

    if (IN(0)) { p0_prologue(F); } SEAM(0);
    if (IN(1)) { row_pass<false, true, false>(F, F.x, mod, 0, F.norm_g, mod, 0, 0); } SEAM(1);
    if (IN(2)) { pg8::Gemm g{Hb, (const bf16*)(F.ws + WS_WIN), NTOK, NPROJ, DM}; pg8::StaticOrder S; S.init(NTOK, NPROJ, F.G, F.bid);
        pg8::EpiBf16<0> E{Ab, NPROJ, nullptr, 0, 0, 1.f};
        pg8::gemm_phase<pg8::EpiBf16<0>, pg8::StaticOrder, true, true>(F.lds + RING_OFF, g, S, E); } SEAM(2);
    if (IN(3)) {
        for (int it = F.bid; it < 1024; it += F.G) gla_prep_item(F, it);
        for (int tok = F.bid * 8 + F.wave; tok < NTOK; tok += F.G * 8) nsa_prep_token(F, tok);
    } SEAM(3);
    if (IN(4)) {
        const int half = F.G >> 1;
        if (F.bid < half) { for (int it = F.bid; it < 128; it += half) nsa_compress_item(F, it); }
        else { for (int gi = (F.bid - half) * 512 + F.tid; gi < 65536; gi += (F.G - half) * 512) gla_scan(F, gi); }
    } SEAM(4);
    if (IN(5)) {
#ifndef NO_NSA
        for (int p = F.bid; p < 256; p += F.G) { const int bg = p >> 6, i = p & 63; nsa_item(F, bg >> 1, bg & 1, i); nsa_item(F, bg >> 1, bg & 1, 127 - i); }
#endif
#ifndef NO_GLAOUT
#if defined(GLA_SPIN)
        { const unsigned long long tg0 = __builtin_amdgcn_s_memrealtime();
#endif
        for (int it = F.bid; it < 1024; it += F.G) gla_out_item(F, it);
#if defined(GLA_SPIN)
          const unsigned long long t1_ = __builtin_amdgcn_s_memrealtime(), dt_ = t1_ - tg0; while (__builtin_amdgcn_s_memrealtime() - t1_ < dt_) __builtin_amdgcn_s_sleep(4); }
#endif
#endif
    } SEAM(5);
    if (IN(6)) { pg8::Gemm g{(const bf16*)(F.ws + WS_O + 32 * MiB), (const bf16*)(F.ws + WS_WOUT), NTOK, DM, DM}; pg8::StaticOrder S; S.init(NTOK, DM, F.G, F.bid);
        EpiResid E{F.x, F.out, mod + 2 * 1024};
        pg8::gemm_phase<EpiResid, pg8::StaticOrder, true, true>(F.lds + RING_OFF, g, S, E); } SEAM(6);
#define MOE_BLOCK(P, LAYER) \
    if (IN(P)) { row_pass<false, true, true>(F, F.out, mod + (LAYER) * 2 * 6144, 3 * 1024, F.norm_g + ((LAYER) * 2 + 1) * 1024, mod, (LAYER), 0); } SEAM(P); \
    if (IN((P) + 1)) { moe_tables(F, (LAYER)); MoeOrder S{(const LAS int*)(F.lds + TAB_OFF), F.G, F.bid}; \
        { LAS unsigned* rofs = (LAS unsigned*)(F.lds + TAB_OFF + 2048); const int* elist = (const int*)(F.ws + WS_STATS); pg8::Unit uu; \
          for (int ui = 0; ui < 3; ++ui) if (S.next(ui, uu)) { if (F.tid < 256) rofs[ui * 256 + F.tid] = S.row_off(uu, F.tid, elist); } \
          __syncthreads(); } \
        pg8::Gemm g{Hb, (const bf16*)(F.ws + WS_WGU) + (size_t)(LAYER) * 16 * 1024 * 1024, MOE_ROWS, 1024, DM}; EpiMoeGU E{(bf16*)(F.ws + WS_A + A_HID_OFF)}; \
        pg8::gemm_phase_gather<EpiMoeGU, MoeOrder>(F.lds + RING_OFF, g, S, E, (const LAS unsigned*)(F.lds + TAB_OFF + 2048)); } SEAM((P) + 1); \
    if (IN((P) + 2)) { moe_tables(F, (LAYER)); MoeOrder S{(const LAS int*)(F.lds + TAB_OFF), F.G, F.bid}; \
        pg8::Gemm g{(const bf16*)(F.ws + WS_A + A_HID_OFF), (const bf16*)(F.ws + WS_WDN) + (size_t)(LAYER) * 16 * 1024 * 512, MOE_ROWS, 1024, EHID}; EpiMoeDn E{Ab}; \
        pg8::gemm_phase<EpiMoeDn, MoeOrder, true, true>(F.lds + RING_OFF, g, S, E); } SEAM((P) + 2);
    MOE_BLOCK(7, 0)
    if (IN(10)) { row_pass<true, true, false>(F, F.out, mod + 2 * 6144, 0, F.norm_g + 2 * 1024, mod, 1, 0); } SEAM(10);
    if (IN(11)) { pg8::Gemm g{Hb, (const bf16*)(F.ws + WS_WINC), NTOK, 4096, DM}; pg8::StaticOrder S; S.init(NTOK, 4096, F.G, F.bid);
        EpiGeluStats E{Ab, (float*)(F.ws + WS_STATS)};
        pg8::gemm_phase<EpiGeluStats, pg8::StaticOrder, true, true>(F.lds + RING_OFF, g, S, E); } SEAM(11);
    if (IN(12)) { for (int it = F.bid; it < 1024; it += F.G) sgu_item(F, it); } SEAM(12);
    if (IN(13)) { pg8::Gemm g{Hb, (const bf16*)(F.ws + WS_WOUTC), NTOK, DM, SGW}; pg8::StaticOrder S; S.init(NTOK, DM, F.G, F.bid);
        EpiResid E{F.out, F.out, mod + 2 * 6144 + 2 * 1024};
        pg8::gemm_phase<EpiResid, pg8::StaticOrder, true, true>(F.lds + RING_OFF, g, S, E); } SEAM(13);
    MOE_BLOCK(14, 1)
    if (IN(17)) { row_pass<true, false, false>(F, F.out, mod, 0, F.norm_g, mod + 2 * 6144, 1, 1); SPIN_HOOK(17); }
#undef IN
#undef SEAM
#undef MOE_BLOCK
}

#ifndef MK_N_LAUNCHES
#define MK_N_LAUNCHES 1
#endif
extern "C" void kernel_launch(void* const* d_in, const int* in_sizes, int n_in, void* d_out, int out_size, void* d_ws, size_t ws_size, hipStream_t stream) {
    static int grid = 0;
    if (grid == 0) {
        if (n_in != 26 || out_size != NTOK * DM || ws_size < WS_END) { fprintf(stderr, "kernel_launch: unexpected problem shape / workspace (%d inputs, out %d, ws %zu)\n", n_in, out_size, ws_size); grid = -1; return; }
        int dev = 0, cus = 0, per_cu = 0;
        if (hipGetDevice(&dev) != hipSuccess || hipDeviceGetAttribute(&cus, hipDeviceAttributeMultiprocessorCount, dev) != hipSuccess) { grid = -1; return; }
        if (hipFuncSetAttribute((const void*)trunk_fwd, hipFuncAttributeMaxDynamicSharedMemorySize, LDS_BYTES) != hipSuccess) { fprintf(stderr, "kernel_launch: hipFuncSetAttribute failed\n"); grid = -1; return; }
        if (hipOccupancyMaxActiveBlocksPerMultiprocessor(&per_cu, (const void*)trunk_fwd, 512, LDS_BYTES) != hipSuccess || per_cu < 1) { fprintf(stderr, "kernel_launch: occupancy query says %d blocks per CU\n", per_cu); }
        (void)hipGetLastError();
        grid = cus;
        if (grid != 256) { fprintf(stderr, "kernel_launch: built for a 256-CU device, found %d CUs\n", cus); grid = -1; return; }
    }
    if (grid < 0) return;
    (void)hipMemsetAsync((char*)d_ws + WS_CTL, 0, CTL_ZERO_BYTES, stream);
    Args a{};
    for (int i = 0; i < 26; ++i) a.in[i] = d_in[i];
    a.out = (float*)d_out; a.ws = (unsigned char*)d_ws; a.pad = 0;
    if (MK_N_LAUNCHES == 1) {
#if defined(REP_PHASE)
        a.ph_lo = 0; a.ph_hi = REP_PHASE + 1; a.use_bar = 1;
        hipLaunchKernelGGL(trunk_fwd, dim3(grid), dim3(512), LDS_BYTES, stream, a);
        a.ph_lo = REP_PHASE; a.ph_hi = NPHASE; a.use_bar = 2;
        hipLaunchKernelGGL(trunk_fwd, dim3(grid), dim3(512), LDS_BYTES, stream, a);
#else
        a.ph_lo = 0; a.ph_hi = NPHASE; a.use_bar = 1;
        hipLaunchKernelGGL(trunk_fwd, dim3(grid), dim3(512), LDS_BYTES, stream, a);
#endif
    } else {
        for (int p = 0; p < NPHASE; ++p) { a.ph_lo = p; a.ph_hi = p + 1; a.use_bar = 0; hipLaunchKernelGGL(trunk_fwd, dim3(grid), dim3(512), LDS_BYTES, stream, a); }
    }
}
```

```cpp
#include <hip/hip_runtime.h>
#include <cstdio>
#include <cstdint>
namespace pg8 {
#define PG8_LAS __attribute__((address_space(3)))
typedef unsigned short bf16_t;
typedef short bf16x8 __attribute__((ext_vector_type(8)));
typedef float f32x4 __attribute__((ext_vector_type(4)));
typedef unsigned u32x4 __attribute__((ext_vector_type(4)));
constexpr int BM = 256, BK = 64, HALF = 128, HTB = HALF * BK * 2  , STAGE_BYTES = 8 * HTB, NXCD = 8, WGM = 8;

__host__ __device__ __forceinline__ int lds_byte(int r, int c) { const int st = (r >> 4) * 2 + (c >> 5), rr = r & 15, cc = c & 31, ob = rr * 64 + cc * 2; return st * 1024 + (ob ^ (((ob >> 9) & 1) << 5)); }
__host__ __device__ __forceinline__ void stage_rc(int b, int& R, int& C) { const int st = b / 1024, sb = b % 1024, swz = sb ^ (((sb >> 9) & 1) << 5); R = (st >> 1) * 16 + swz / 64; C = (st & 1) * 32 + (swz % 64) / 2; }
__host__ __device__ __forceinline__ int perm32(int rho) { const int n = rho >> 4, i = rho & 15; return 8 * (i >> 2) + 4 * n + (i & 3); }

struct Unit { int pm, pn; };
struct Gemm { const bf16_t* A; const bf16_t* Bt; int M, N, K; };

struct StaticOrder {
    int nM, nN, nwg, G, c;
    __host__ __device__ void init(int M, int N, int G_, int c_) { nM = M / BM; nN = N / BM; nwg = nM * nN; G = G_; c = c_; }
    __host__ __device__ bool next(int i, Unit& u) const {
        const long L = (long)i * G + c; if (L >= nwg) return false;
        int wgid = (int)L; { const int q = nwg / NXCD, r = nwg % NXCD, xcd = wgid % NXCD, off = wgid / NXCD; wgid = (xcd < r ? xcd * (q + 1) : r * (q + 1) + (xcd - r) * q) + off; }
        const int nig = WGM * nN, gid = wgid / nig, fm = gid * WGM, gsz = (nM - fm) < WGM ? (nM - fm) : WGM;
        u.pm = fm + ((wgid % nig) % gsz); u.pn = (wgid % nig) / gsz; return true;
    }
    __device__ __forceinline__ void a_ready(const Unit&) const {}
    __device__ __forceinline__ void done(const Unit&) const {}
};

__device__ __forceinline__ unsigned cvt_pk_bf16(float lo, float hi) { unsigned r; asm volatile("v_cvt_pk_bf16_f32 %0, %1, %2" : "=v"(r) : "v"(lo), "v"(hi)); return r; }
typedef float f32x2 __attribute__((ext_vector_type(2)));
__device__ __forceinline__ f32x2 gelu_pk(f32x2 v) {
    const f32x2 av = __builtin_elementwise_abs(v), d = av * 0.2316418882f + 1.0f;
    f32x2 t; t.x = __builtin_amdgcn_rcpf(d.x); t.y = __builtin_amdgcn_rcpf(d.y);
    f32x2 q = t * 0.5307027145f + (-0.7265760135f); q = q * t + 0.7107068705f; q = q * t + (-0.142248368f); q = q * t + 0.127414796f; q = q * t;
    const f32x2 s = (v * v) * (-0.72134752044f);
    f32x2 e; e.x = __builtin_amdgcn_exp2f(s.x); e.y = __builtin_amdgcn_exp2f(s.y);
    const f32x2 m = v * (q * e), r = v - m;
    f32x2 o; o.x = v.x < 0.f ? m.x : r.x; o.y = v.y < 0.f ? m.y : r.y; return o;
}

template <int ACT  > struct EpiBf16 {
    static constexpr bool PERM = true, AFTER_DRAIN = false; static_assert(ACT == 0 || ACT == 1, "EpiBf16: ACT is 0 (none) or 1 (gelu_pk)");
    bf16_t* O; int ldc; const float* bias; int split_cols; size_t split_stride; float scale0;
    __device__ __forceinline__ void operator()(const f32x4 (&acc)[2][2][4][2], const Unit& u, int wr, int wc, int fr, int fq) const {
        const int row0 = u.pm * BM + wr * 64 + fr; int colt = u.pn * BM; bf16_t* base = O;
        float sc = 1.f; if (split_cols) { const int t = colt / split_cols; base += (size_t)t * split_stride; colt -= t * split_cols; if (t == 0) sc = scale0; }
        const int col0 = colt + wc * 32 + 8 * fq, bcol0 = u.pn * BM + wc * 32 + 8 * fq;
        f32x4 bv[2][2];
#pragma unroll
        for (int bj = 0; bj < 2; ++bj)
#pragma unroll
            for (int n = 0; n < 2; ++n) bv[bj][n] = bias ? *(const f32x4*)(bias + bcol0 + bj * HALF + 4 * n) : (f32x4){0.f, 0.f, 0.f, 0.f};
#pragma unroll
        for (int ai = 0; ai < 2; ++ai)
#pragma unroll
            for (int m = 0; m < 4; ++m) { bf16_t* rowp = base + (size_t)(row0 + ai * HALF + m * 16) * ldc + col0;
#pragma unroll
                for (int bj = 0; bj < 2; ++bj) { f32x4 v0 = acc[ai][bj][m][0] + bv[bj][0], v1 = acc[ai][bj][m][1] + bv[bj][1];
                    if (ACT == 1) { f32x2 a = gelu_pk((f32x2){v0[0], v0[1]}), b = gelu_pk((f32x2){v0[2], v0[3]}), c = gelu_pk((f32x2){v1[0], v1[1]}), d = gelu_pk((f32x2){v1[2], v1[3]});
                        v0 = (f32x4){a.x, a.y, b.x, b.y}; v1 = (f32x4){c.x, c.y, d.x, d.y}; }
                    v0 = v0 * sc; v1 = v1 * sc; u32x4 w; w.x = cvt_pk_bf16(v0[0], v0[1]); w.y = cvt_pk_bf16(v0[2], v0[3]); w.z = cvt_pk_bf16(v1[0], v1[1]); w.w = cvt_pk_bf16(v1[2], v1[3]);
                    *(u32x4*)(rowp + bj * HALF) = w; } }
    }
};

template <class Epi, class Sched, bool ALIGN_EPI = false, bool SP2 = false>
__device__ __forceinline__ void gemm_phase(PG8_LAS unsigned char* lds, const Gemm g, const Sched& S, const Epi& E) {
    const int tid = threadIdx.x, wid = __builtin_amdgcn_readfirstlane(tid >> 6), lane = tid & 63, wr = wid >> 2, wc = wid & 3, fr = lane & 15, fq = lane >> 4;
    const int K = g.K, nt = K / BK;
    unsigned voffA[2], voffB[2];
#pragma unroll
    for (int i = 0; i < 2; ++i) { int R, C; stage_rc(tid * 16 + i * 8192, R, C); const int Rb = Epi::PERM ? ((R & ~31) + perm32(R & 31)) : R;
        voffA[i] = (unsigned)(R * K + C) * 2u; voffB[i] = (unsigned)(Rb * K + C) * 2u; }
    const size_t kstep = (size_t)(BK * 2);
    const size_t hstep = (size_t)HALF * K * 2;
    const size_t tstep = 2 * hstep;
    const unsigned ldsw = (unsigned)wid * 1024u;
    const int aoff = lds_byte(wr * 64 + fr, fq * 8), boff = lds_byte(wc * 32 + fr, fq * 8);
#define PG8_SA(b, h) (((b) * 2 + (h)) * HTB)
#define PG8_SB(b, h) ((4 + (b) * 2 + (h)) * HTB)
#define PG8_STAGE(bufoff, gbase, voff) do { _Pragma("unroll") for (int _i = 0; _i < 2; ++_i) \
        __builtin_amdgcn_global_load_lds((const unsigned*)((const char*)(gbase) + (voff)[_i]), (PG8_LAS unsigned*)(lds + (bufoff) + ldsw + _i * 8192), 16, 0, 0); } while (0)
#define PG8_LDA(dst, b, h) do { _Pragma("unroll") for (int m = 0; m < 4; ++m) _Pragma("unroll") for (int k = 0; k < 2; ++k) dst[m][k] = *(const PG8_LAS bf16x8*)(lds + PG8_SA(b, h) + aoff + m * 2048 + k * 1024); } while (0)
#define PG8_LDB(dst, b, h) do { _Pragma("unroll") for (int n = 0; n < 2; ++n) _Pragma("unroll") for (int k = 0; k < 2; ++k) dst[n][k] = *(const PG8_LAS bf16x8*)(lds + PG8_SB(b, h) + boff + n * 2048 + k * 1024); } while (0)
#define PG8_MMA(ai, bj, At, Bt) do { __builtin_amdgcn_s_setprio(1); _Pragma("unroll") for (int m = 0; m < 4; ++m) _Pragma("unroll") for (int n = 0; n < 2; ++n) _Pragma("unroll") for (int k = 0; k < 2; ++k) \
        acc[ai][bj][m][n] = __builtin_amdgcn_mfma_f32_16x16x32_bf16(Bt[n][k], At[m][k], acc[ai][bj][m][n], 0, 0, 0); __builtin_amdgcn_s_setprio(0); } while (0)
#define PG8_WAIT_V(n) asm volatile("s_waitcnt vmcnt(" #n ")" ::: "memory")
#define PG8_WAIT_L(n) asm volatile("s_waitcnt lgkmcnt(" #n ")" ::: "memory")
#define PG8_BAR __builtin_amdgcn_s_barrier()
#define PG8_SCHED __builtin_amdgcn_sched_barrier(0)
    Unit cur, nxt; int ui = 0;
    if (!S.next(0, cur)) return;
    f32x4 acc[2][2][4][2];
#pragma unroll
    for (int a = 0; a < 2; ++a)
#pragma unroll
        for (int b = 0; b < 2; ++b)
#pragma unroll
            for (int m = 0; m < 4; ++m)
#pragma unroll
                for (int n = 0; n < 2; ++n) acc[a][b][m][n] = (f32x4){0.f, 0.f, 0.f, 0.f};
    bf16x8 At[4][2], B0[2][2], B1[2][2];
    const char* cA = (const char*)g.A + (size_t)cur.pm * tstep; const char* cB = (const char*)g.Bt + (size_t)cur.pn * tstep;
    S.a_ready(cur);
    if constexpr (SP2) {
        PG8_STAGE(PG8_SB(0, 0), cB, voffB); PG8_STAGE(PG8_SB(0, 1), cB + hstep, voffB); PG8_STAGE(PG8_SA(0, 0), cA, voffA); PG8_STAGE(PG8_SA(0, 1), cA + hstep, voffA);
        if (wr == 1) PG8_BAR;
        PG8_WAIT_V(2); PG8_BAR;
        PG8_STAGE(PG8_SB(1, 0), cB + kstep, voffB); PG8_STAGE(PG8_SA(1, 0), cA + kstep, voffA); PG8_STAGE(PG8_SB(1, 1), cB + hstep + kstep, voffB);
        PG8_WAIT_V(6); PG8_BAR;
    } else {
        PG8_STAGE(PG8_SB(0, 0), cB, voffB); PG8_STAGE(PG8_SA(0, 0), cA, voffA); PG8_STAGE(PG8_SB(0, 1), cB + hstep, voffB); PG8_STAGE(PG8_SA(0, 1), cA + hstep, voffA);
        if (wr == 1) PG8_BAR;
        PG8_WAIT_V(4); PG8_BAR;
        PG8_STAGE(PG8_SB(1, 0), cB + kstep, voffB); PG8_STAGE(PG8_SA(1, 0), cA + kstep, voffA); PG8_STAGE(PG8_SB(1, 1), cB + hstep + kstep, voffB);
        PG8_WAIT_V(6); PG8_BAR;
    }
    for (;;) {
        const bool has_next = S.next(ui + 1, nxt);
        const char* nA = has_next ? (const char*)g.A + (size_t)nxt.pm * tstep : cA; const char* nB = has_next ? (const char*)g.Bt + (size_t)nxt.pn * tstep : cB;
        for (int t = 0; t < nt; t += 2) {
            const bool last = (t == nt - 2);
            const char* a1 = cA + (size_t)(t + 1) * kstep;
            const char* a2 = last ? nA : cA + (size_t)(t + 2) * kstep; const char* b2 = last ? nB : cB + (size_t)(t + 2) * kstep;
            const char* a3 = a2 + kstep; const char* b3 = b2 + kstep;
            if (last && has_next) S.a_ready(nxt);
            if constexpr (SP2) {
            PG8_LDB(B0, 0, 0); PG8_LDB(B1, 0, 1); PG8_SCHED; PG8_LDA(At, 0, 0); PG8_STAGE(PG8_SA(1, 1), a1 + hstep, voffA);
            PG8_WAIT_V(8); PG8_WAIT_L(0); PG8_BAR; PG8_MMA(0, 0, At, B0); PG8_MMA(0, 1, At, B1); PG8_BAR; PG8_SCHED;
            PG8_LDA(At, 0, 1); PG8_STAGE(PG8_SB(0, 0), b2, voffB); PG8_STAGE(PG8_SB(0, 1), b2 + hstep, voffB); PG8_STAGE(PG8_SA(0, 0), a2, voffA);
            PG8_WAIT_V(8); PG8_WAIT_L(0); PG8_BAR; PG8_MMA(1, 0, At, B0); PG8_MMA(1, 1, At, B1); PG8_BAR; PG8_SCHED;
            PG8_LDB(B0, 1, 0); PG8_LDB(B1, 1, 1); PG8_SCHED; PG8_LDA(At, 1, 0); PG8_STAGE(PG8_SA(0, 1), a2 + hstep, voffA);
            PG8_WAIT_V(8); PG8_WAIT_L(0); PG8_BAR; PG8_MMA(0, 0, At, B0); PG8_MMA(0, 1, At, B1); PG8_BAR; PG8_SCHED;
            PG8_LDA(At, 1, 1); PG8_STAGE(PG8_SB(1, 0), b3, voffB); PG8_STAGE(PG8_SB(1, 1), b3 + hstep, voffB); PG8_STAGE(PG8_SA(1, 0), a3, voffA);
            PG8_WAIT_V(8); PG8_WAIT_L(0); PG8_BAR; PG8_MMA(1, 0, At, B0); PG8_MMA(1, 1, At, B1); PG8_BAR; PG8_SCHED;
            } else {
            PG8_LDB(B0, 0, 0); PG8_SCHED; PG8_LDA(At, 0, 0); PG8_STAGE(PG8_SA(1, 1), a1 + hstep, voffA);
            PG8_WAIT_L(8); PG8_BAR; PG8_WAIT_L(0); PG8_MMA(0, 0, At, B0); PG8_BAR; PG8_SCHED;
            PG8_LDB(B1, 0, 1); PG8_STAGE(PG8_SB(0, 0), b2, voffB);
            PG8_BAR; PG8_WAIT_L(0); PG8_MMA(0, 1, At, B1); PG8_BAR;
            PG8_LDA(At, 0, 1); PG8_STAGE(PG8_SA(0, 0), a2, voffA);
            PG8_BAR; PG8_WAIT_L(0); PG8_MMA(1, 0, At, B0); PG8_BAR; PG8_SCHED;
            PG8_STAGE(PG8_SB(0, 1), b2 + hstep, voffB);
            PG8_WAIT_V(6); PG8_BAR; PG8_MMA(1, 1, At, B1); PG8_BAR;
            PG8_LDB(B0, 1, 0); PG8_SCHED; PG8_LDA(At, 1, 0); PG8_STAGE(PG8_SA(0, 1), a2 + hstep, voffA);
            PG8_WAIT_L(8); PG8_BAR; PG8_WAIT_L(0); PG8_MMA(0, 0, At, B0); PG8_BAR; PG8_SCHED;
            PG8_LDB(B1, 1, 1); PG8_STAGE(PG8_SB(1, 0), b3, voffB);
            PG8_BAR; PG8_WAIT_L(0); PG8_MMA(0, 1, At, B1); PG8_BAR;
            PG8_LDA(At, 1, 1); PG8_STAGE(PG8_SA(1, 0), a3, voffA);
            PG8_BAR; PG8_WAIT_L(0); PG8_MMA(1, 0, At, B0); PG8_BAR; PG8_SCHED;
            PG8_STAGE(PG8_SB(1, 1), b3 + hstep, voffB);
            PG8_WAIT_V(6); PG8_BAR; PG8_MMA(1, 1, At, B1); PG8_BAR;
            }
        }
        if constexpr (ALIGN_EPI) { if (wr == 0) PG8_BAR; }
        if constexpr (!Epi::AFTER_DRAIN) { E(acc, cur, wr, wc, fr, fq); S.done(cur); }
        if (!has_next) break;
#pragma unroll
        for (int a = 0; a < 2; ++a)
#pragma unroll
            for (int b = 0; b < 2; ++b)
#pragma unroll
                for (int m = 0; m < 4; ++m)
#pragma unroll
                    for (int n = 0; n < 2; ++n) acc[a][b][m][n] = (f32x4){0.f, 0.f, 0.f, 0.f};
        cur = nxt; cA = nA; cB = nB; ++ui;
        if constexpr (ALIGN_EPI) { if (wr == 1) PG8_BAR; }
    }
    PG8_WAIT_V(0);
    if constexpr (!ALIGN_EPI) { if (wr == 0) PG8_BAR; }
    PG8_BAR;
    if constexpr (Epi::AFTER_DRAIN) { E.fused(acc, cur, wr, wc, fr, fq, lds, wid, lane); S.done(cur); }
#undef PG8_SA
#undef PG8_SB
#undef PG8_STAGE
#undef PG8_LDA
#undef PG8_LDB
#undef PG8_MMA
#undef PG8_WAIT_V
#undef PG8_WAIT_L
#undef PG8_BAR
#undef PG8_SCHED
}
}

#ifndef PG8_SP2
#define PG8_SP2 true
#endif

namespace pg8 {
template <class Epi, class Sched>
__device__ __forceinline__ void gemm_phase_gather(PG8_LAS unsigned char* lds, const Gemm g, const Sched& S, const Epi& E, const PG8_LAS unsigned* rofs) {
    const int tid = threadIdx.x, wid = __builtin_amdgcn_readfirstlane(tid >> 6), lane = tid & 63, wr = wid >> 2, wc = wid & 3, fr = lane & 15, fq = lane >> 4;
    const int K = g.K, nt = K / BK;
    unsigned voffB[2]; int RA[2]; unsigned CA[2];
#pragma unroll
    for (int i = 0; i < 2; ++i) { int R, C; stage_rc(tid * 16 + i * 8192, R, C); const int Rb = Epi::PERM ? ((R & ~31) + perm32(R & 31)) : R;
        RA[i] = R; CA[i] = (unsigned)C * 2u; voffB[i] = (unsigned)(Rb * K + C) * 2u; }
    const size_t kstep = (size_t)(BK * 2);
    const size_t hstep = (size_t)HALF * K * 2;
    const size_t tstep = 2 * hstep;
    const unsigned ldsw = (unsigned)wid * 1024u;
    const int aoff = lds_byte(wr * 64 + fr, fq * 8), boff = lds_byte(wc * 32 + fr, fq * 8);
#define PG8_SA(b, h) (((b) * 2 + (h)) * HTB)
#define PG8_SB(b, h) ((4 + (b) * 2 + (h)) * HTB)
#define PG8_STAGE(bufoff, gbase, voff) do { _Pragma("unroll") for (int _i = 0; _i < 2; ++_i) \
        __builtin_amdgcn_global_load_lds((const unsigned*)((const char*)(gbase) + (voff)[_i]), (PG8_LAS unsigned*)(lds + (bufoff) + ldsw + _i * 8192), 16, 0, 0); } while (0)
#define PG8_STAGE_A(bufoff, koff, v0, v1) do { \
        __builtin_amdgcn_global_load_lds((const unsigned*)((const char*)g.A + (koff) + (v0)), (PG8_LAS unsigned*)(lds + (bufoff) + ldsw), 16, 0, 0); \
        __builtin_amdgcn_global_load_lds((const unsigned*)((const char*)g.A + (koff) + (v1)), (PG8_LAS unsigned*)(lds + (bufoff) + ldsw + 8192), 16, 0, 0); } while (0)
#define PG8_LDA(dst, b, h) do { _Pragma("unroll") for (int m = 0; m < 4; ++m) _Pragma("unroll") for (int k = 0; k < 2; ++k) dst[m][k] = *(const PG8_LAS bf16x8*)(lds + PG8_SA(b, h) + aoff + m * 2048 + k * 1024); } while (0)
#define PG8_LDB(dst, b, h) do { _Pragma("unroll") for (int n = 0; n < 2; ++n) _Pragma("unroll") for (int k = 0; k < 2; ++k) dst[n][k] = *(const PG8_LAS bf16x8*)(lds + PG8_SB(b, h) + boff + n * 2048 + k * 1024); } while (0)
#define PG8_MMA(ai, bj, At, Bt) do { __builtin_amdgcn_s_setprio(1); _Pragma("unroll") for (int m = 0; m < 4; ++m) _Pragma("unroll") for (int n = 0; n < 2; ++n) _Pragma("unroll") for (int k = 0; k < 2; ++k) \
        acc[ai][bj][m][n] = __builtin_amdgcn_mfma_f32_16x16x32_bf16(Bt[n][k], At[m][k], acc[ai][bj][m][n], 0, 0, 0); __builtin_amdgcn_s_setprio(0); } while (0)
#define PG8_WAIT_V(n) asm volatile("s_waitcnt vmcnt(" #n ")" ::: "memory")
#define PG8_WAIT_L(n) asm volatile("s_waitcnt lgkmcnt(" #n ")" ::: "memory")
#define PG8_BAR __builtin_amdgcn_s_barrier()
#define PG8_SCHED __builtin_amdgcn_sched_barrier(0)
    Unit cur, nxt; int ui = 0;
    if (!S.next(0, cur)) return;
    f32x4 acc[2][2][4][2];
#pragma unroll
    for (int a = 0; a < 2; ++a)
#pragma unroll
        for (int b = 0; b < 2; ++b)
#pragma unroll
            for (int m = 0; m < 4; ++m)
#pragma unroll
                for (int n = 0; n < 2; ++n) acc[a][b][m][n] = (f32x4){0.f, 0.f, 0.f, 0.f};
    bf16x8 At[4][2], B0[2][2], B1[2][2];
    const char* cB = (const char*)g.Bt + (size_t)cur.pn * tstep;
    unsigned vc00 = rofs[RA[0]] + CA[0], vc01 = rofs[RA[1]] + CA[1], vc10 = rofs[128 + RA[0]] + CA[0], vc11 = rofs[128 + RA[1]] + CA[1];
    unsigned vn00 = vc00, vn01 = vc01, vn10 = vc10, vn11 = vc11;
    PG8_WAIT_L(0);
    PG8_STAGE(PG8_SB(0, 0), cB, voffB); PG8_STAGE(PG8_SB(0, 1), cB + hstep, voffB); PG8_STAGE_A(PG8_SA(0, 0), 0, vc00, vc01); PG8_STAGE_A(PG8_SA(0, 1), 0, vc10, vc11);
    if (wr == 1) PG8_BAR;
    PG8_WAIT_V(2); PG8_BAR;
    PG8_STAGE(PG8_SB(1, 0), cB + kstep, voffB); PG8_STAGE_A(PG8_SA(1, 0), kstep, vc00, vc01); PG8_STAGE(PG8_SB(1, 1), cB + hstep + kstep, voffB);
    PG8_WAIT_V(6); PG8_BAR;
    for (;;) {
        const bool has_next = S.next(ui + 1, nxt);
        const char* nB = has_next ? (const char*)g.Bt + (size_t)nxt.pn * tstep : cB;
        if (has_next) { const PG8_LAS unsigned* rn = rofs + (ui + 1) * 256; vn00 = rn[RA[0]] + CA[0]; vn01 = rn[RA[1]] + CA[1]; vn10 = rn[128 + RA[0]] + CA[0]; vn11 = rn[128 + RA[1]] + CA[1]; }
        else { vn00 = vc00; vn01 = vc01; vn10 = vc10; vn11 = vc11; }
        for (int t = 0; t < nt; t += 2) {
            const bool last = (t == nt - 2);
            const size_t k1 = (size_t)(t + 1) * kstep;
            const size_t k2 = last ? 0 : (size_t)(t + 2) * kstep; const char* b2 = last ? nB : cB + (size_t)(t + 2) * kstep;
            const size_t k3 = k2 + kstep; const char* b3 = b2 + kstep;
            const unsigned w00 = last ? vn00 : vc00, w01 = last ? vn01 : vc01, w10 = last ? vn10 : vc10, w11 = last ? vn11 : vc11;
            PG8_LDB(B0, 0, 0); PG8_LDB(B1, 0, 1); PG8_SCHED; PG8_LDA(At, 0, 0); PG8_STAGE_A(PG8_SA(1, 1), k1, vc10, vc11);
            PG8_WAIT_V(8); PG8_WAIT_L(0); PG8_BAR; PG8_MMA(0, 0, At, B0); PG8_MMA(0, 1, At, B1); PG8_BAR; PG8_SCHED;
            PG8_LDA(At, 0, 1); PG8_STAGE(PG8_SB(0, 0), b2, voffB); PG8_STAGE(PG8_SB(0, 1), b2 + hstep, voffB); PG8_STAGE_A(PG8_SA(0, 0), k2, w00, w01);
            PG8_WAIT_V(8); PG8_WAIT_L(0); PG8_BAR; PG8_MMA(1, 0, At, B0); PG8_MMA(1, 1, At, B1); PG8_BAR; PG8_SCHED;
            PG8_LDB(B0, 1, 0); PG8_LDB(B1, 1, 1); PG8_SCHED; PG8_LDA(At, 1, 0); PG8_STAGE_A(PG8_SA(0, 1), k2, w10, w11);
            PG8_WAIT_V(8); PG8_WAIT_L(0); PG8_BAR; PG8_MMA(0, 0, At, B0); PG8_MMA(0, 1, At, B1); PG8_BAR; PG8_SCHED;
            PG8_LDA(At, 1, 1); PG8_STAGE(PG8_SB(1, 0), b3, voffB); PG8_STAGE(PG8_SB(1, 1), b3 + hstep, voffB); PG8_STAGE_A(PG8_SA(1, 0), k3, w00, w01);
            PG8_WAIT_V(8); PG8_WAIT_L(0); PG8_BAR; PG8_MMA(1, 0, At, B0); PG8_MMA(1, 1, At, B1); PG8_BAR; PG8_SCHED;
        }
        if (wr == 0) PG8_BAR;
        E(acc, cur, wr, wc, fr, fq); S.done(cur);
        if (!has_next) break;
#pragma unroll
        for (int a = 0; a < 2; ++a)
#pragma unroll
            for (int b = 0; b < 2; ++b)
#pragma unroll
                for (int m = 0; m < 4; ++m)
#pragma unroll
                    for (int n = 0; n < 2; ++n) acc[a][b][m][n] = (f32x4){0.f, 0.f, 0.f, 0.f};
        cur = nxt; cB = nB; ++ui; vc00 = vn00; vc01 = vn01; vc10 = vn10; vc11 = vn11;
        if (wr == 1) PG8_BAR;
    }
    PG8_WAIT_V(0);
    PG8_BAR;
#undef PG8_SA
#undef PG8_SB
#undef PG8_STAGE
#undef PG8_STAGE_A
#undef PG8_LDA
#undef PG8_LDB
#undef PG8_MMA
#undef PG8_WAIT_V
#undef PG8_WAIT_L
#undef PG8_BAR
#undef PG8_SCHED
}
}

constexpr int NB = 2, SEQ = 8192, DM = 1024, NTOK = NB * SEQ;
constexpr int NPROJ = 3072;
constexpr int C_GQ = 0, C_GK = 256, C_GV = 512, C_GR = 1024, C_NQ = 1536, C_KC = 2048, C_VC = 2176, C_KS = 2304, C_VS = 2432, C_KW = 2560, C_VW = 2688, C_GLR = 2816, C_NG = 2832, C_END = 2856;
constexpr int SGW = 2048;
constexpr int NEXP = 16, EHID = 512;
constexpr int MOE_ROWS = 36864;
constexpr float NORM_EPS = 1e-6f;
constexpr float NEGBIG = -1e30f;

constexpr size_t MiB = 1u << 20;
constexpr size_t WS_CTL = 0, CTL_ZERO_BYTES = 1 * MiB;
constexpr size_t WS_MOD = 1 * MiB;
constexpr size_t WS_ROUTE = 2 * MiB;
constexpr size_t WS_GATES = 3 * MiB;
constexpr size_t WS_STATS = 5 * MiB;
constexpr size_t WS_DEC = 7 * MiB;
constexpr size_t WS_WIN = 8 * MiB;
constexpr size_t WS_WOUT = 14 * MiB;
constexpr size_t WS_WINC = 16 * MiB;
constexpr size_t WS_WOUTC = 24 * MiB;
constexpr size_t WS_WCW1 = 28 * MiB;
constexpr size_t WS_WGU = 30 * MiB;
constexpr size_t WS_WDN = 94 * MiB;
constexpr size_t WS_A = 126 * MiB;
constexpr size_t WS_O = 254 * MiB;
constexpr size_t WS_END = 318 * MiB;
constexpr size_t A_HID_OFF = 72 * MiB;
constexpr size_t DO_QN = 0;
constexpr size_t DO_KSEL = 16 * MiB, DO_VSEL = 20 * MiB, DO_KWIN = 24 * MiB, DO_VWIN = 28 * MiB;
constexpr size_t DO_KC = 32 * MiB, DO_VC = 36 * MiB + 65536;
constexpr size_t DO_KCMP = 41 * MiB, DO_VCMP = 41 * MiB + 512 * 1024;

constexpr int CW_TMO = 0, CW_CODE = 1;
constexpr int CW_BAR = 4096;
constexpr int CW_CNT = 16384;

constexpr int RING_OFF = 0, RING_BYTES = 131072;
constexpr int LDSCTL_OFF = RING_BYTES, MISC_OFF = LDSCTL_OFF + 320;
constexpr int TAB_OFF = LDSCTL_OFF + 1024;
constexpr int LDS_BYTES = 147456;

#define GAS __attribute__((address_space(1)))
#define LAS __attribute__((address_space(3)))
typedef unsigned short bf16;
typedef unsigned v4u __attribute__((ext_vector_type(4)));
typedef unsigned v2u __attribute__((ext_vector_type(2)));
typedef float f32x4 __attribute__((ext_vector_type(4)));
typedef float f32x2 __attribute__((ext_vector_type(2)));
typedef float f32x16 __attribute__((ext_vector_type(16)));
typedef short bf16x8 __attribute__((ext_vector_type(8)));
typedef short s16x4 __attribute__((ext_vector_type(4)));
typedef GAS unsigned gu32;
#define RLX_AGENT __ATOMIC_RELAXED, __HIP_MEMORY_SCOPE_AGENT
#define LDS_WAIT() asm volatile("s_waitcnt lgkmcnt(0)" ::: "memory")
#define VM_WAIT() asm volatile("s_waitcnt vmcnt(0)" ::: "memory")
__device__ __forceinline__ unsigned f2bf(float f) { unsigned u = __builtin_bit_cast(unsigned, f); return (u + 0x7fffu + ((u >> 16) & 1u)) >> 16; }
__device__ __forceinline__ unsigned pk2(float lo, float hi) { return f2bf(lo) | (f2bf(hi) << 16); }
__device__ __forceinline__ float bf2f(unsigned short b) { return __builtin_bit_cast(float, (unsigned)b << 16); }
__device__ __forceinline__ float bflo(unsigned w) { return __builtin_bit_cast(float, w << 16); }
__device__ __forceinline__ float bfhi(unsigned w) { return __builtin_bit_cast(float, w & 0xffff0000u); }
__device__ __forceinline__ float fexp2(float x) { return __builtin_amdgcn_exp2f(x); }
__device__ __forceinline__ float fexp(float x) { return __builtin_amdgcn_exp2f(x * 1.4426950408889634f); }
__device__ __forceinline__ float frcp(float x) { return __builtin_amdgcn_rcpf(x); }
__device__ __forceinline__ float sigmoidf_(float x) { return 1.0f / (1.0f + __expf(-x)); }
__device__ __forceinline__ float siluf_(float x) { return x / (1.0f + __expf(-x)); }
__device__ __forceinline__ float gelu_tanh(float x) {
    const float u = 0.7978845608028654f * (x + 0.044715f * x * x * x);
    return x / (1.0f + __expf(-2.0f * u));
}
__device__ __forceinline__ float wave_sum(float v) {
#pragma unroll
    for (int o = 1; o < 64; o <<= 1) v += __shfl_xor(v, o);
    return v;
}
__device__ __forceinline__ void unpack8(const v4u w, float (&f)[8]) {
    f[0] = bflo(w.x); f[1] = bfhi(w.x); f[2] = bflo(w.y); f[3] = bfhi(w.y); f[4] = bflo(w.z); f[5] = bfhi(w.z); f[6] = bflo(w.w); f[7] = bfhi(w.w);
}
__device__ __forceinline__ v4u pack8(const float (&f)[8]) { v4u w; w.x = pk2(f[0], f[1]); w.y = pk2(f[2], f[3]); w.z = pk2(f[4], f[5]); w.w = pk2(f[6], f[7]); return w; }

#define XB_TMO      128
#define XB_XCNT(j)  (256  + 64 * (j))
#define XB_XSUB(j)  (1280 + 64 * (j))
#define XB_XGEN(j)  (2304 + 64 * (j))
#define XB_TOP      3328
#define XB_TOPGEN   3392
#define XCD_BAR_WORDS 3456
#define XB_SPIN_CAP (1u << 18)

__device__ __forceinline__ unsigned xb_ld(unsigned* p)              { return __hip_atomic_load(p, __ATOMIC_RELAXED, __HIP_MEMORY_SCOPE_AGENT); }
__device__ __forceinline__ unsigned xb_add(unsigned* p, unsigned v) { return __hip_atomic_fetch_add(p, v, __ATOMIC_RELAXED, __HIP_MEMORY_SCOPE_AGENT); }
__device__ __forceinline__ unsigned xb_xcc_id() { return (unsigned)__builtin_amdgcn_s_getreg((3 << 11) | 20) & 0xFu; }
#define XB_SPIN(cond, bar) do { unsigned _sp = 0; while (cond) { __builtin_amdgcn_s_sleep(1); \
    if ((++_sp & 255u) == 0u) { if (xb_ld(&(bar)[XB_TMO])) break; if (_sp > XB_SPIN_CAP) { atomicAdd(&(bar)[XB_TMO], 1u); break; } } } } while (0)

struct XcdBarrier {
    unsigned* bar; unsigned x;
    volatile LAS unsigned* st;
};
__device__ __forceinline__ XcdBarrier xcd_barrier_post(unsigned* bar, volatile LAS unsigned* st) {
    XcdBarrier b; b.bar = bar; b.x = xb_xcc_id(); b.st = st;
    if (threadIdx.x == 0) (void)xb_add(&bar[XB_XCNT(b.x)], 1u);
    return b;
}
__device__ __forceinline__ void xcd_barrier_complete(unsigned* bar, unsigned x, unsigned& nloc, unsigned& nx) {
    const unsigned G = gridDim.x * gridDim.y * gridDim.z;
    unsigned sum, cnt, mine, sp = 0u;
    for (;;) {
        sum = 0u; cnt = 0u; mine = 0u;
#pragma unroll
        for (unsigned j = 0; j < 16; ++j) { const unsigned c = xb_ld(&bar[XB_XCNT(j)]); sum += c; cnt += (c > 0u) ? 1u : 0u; mine = (j == x) ? c : mine; }
        if (sum == G) break;
        __builtin_amdgcn_s_sleep(1);
        if ((++sp & 255u) == 0u) { if (xb_ld(&bar[XB_TMO])) break; if (sp > XB_SPIN_CAP) { atomicAdd(&bar[XB_TMO], 1u); break; } }
    }
    nloc = mine > 0u ? mine : 1u; nx = cnt > 0u ? cnt : 1u;
}
__device__ __forceinline__ void xcd_barrier(const XcdBarrier& b) {
    asm volatile("s_waitcnt vmcnt(0)" ::: "memory");
    __syncthreads();
    if (threadIdx.x == 0) {
        unsigned* bar = b.bar;
        __builtin_amdgcn_s_waitcnt(0);
        unsigned nloc = b.st[0], nx = b.st[1];
        if (nloc == 0u) { xcd_barrier_complete(bar, b.x, nloc, nx); b.st[0] = nloc; b.st[1] = nx; }
        const unsigned old = xb_add(&bar[XB_XSUB(b.x)], 1u);
        const unsigned gen = old / nloc;
        if (old + 1u == (gen + 1u) * nloc) {
            __builtin_amdgcn_fence(__ATOMIC_RELEASE, "agent");
            asm volatile("s_waitcnt vmcnt(0)" ::: "memory");
            const unsigned og = xb_add(&bar[XB_TOP], 1u);
            const unsigned tg = og / nx;
            if (og + 1u == (tg + 1u) * nx) xb_add(&bar[XB_TOPGEN], 1u);
            else XB_SPIN(xb_ld(&bar[XB_TOPGEN]) == tg, bar);
            __builtin_amdgcn_fence(__ATOMIC_ACQUIRE, "agent");
            xb_add(&bar[XB_XGEN(b.x)], 1u);
            asm volatile("s_waitcnt vmcnt(0)" ::: "memory");
        } else {
            XB_SPIN(xb_ld(&bar[XB_XGEN(b.x)]) == gen, bar);
            __builtin_amdgcn_fence(__ATOMIC_ACQUIRE, "agent");
            asm volatile("s_waitcnt vmcnt(0)" ::: "memory");
        }
    }
    __syncthreads();
}

struct Frame {
    LAS unsigned char* lds;
    volatile LAS unsigned* MISC;
    gu32* ctl;
    int tid, lane, wave;
    int bid, G;
    unsigned char* ws;
    unsigned char* dout_b;
    float* out;
    const float *x, *c, *w_ada, *b_ada, *norm_g, *w_in_ab, *w_out_ab, *gla_w2, *gla_bg, *gla_ng, *q_gain, *k_gain, *cmp_pe, *cmp_w1, *cmp_w2, *w_in_c, *sgu_ng, *sgu_ws, *sgu_bs, *w_out_c, *w_router, *r_bias, *w_gate, *w_up, *w_down;
    const int* positions;
};

struct EpiResid {
    static constexpr bool PERM = false, AFTER_DRAIN = false;
    const float* xin; float* xout; const float* gate;
    __device__ __forceinline__ void operator()(const pg8::f32x4 (&acc)[2][2][4][2], const pg8::Unit& u, int wr, int wc, int fr, int fq) const {
        const int row0 = u.pm * 256 + wr * 64 + fr, col0 = u.pn * 256 + wc * 32 + 4 * fq;
        const float* gb = gate + ((u.pm * 256 >= SEQ) ? 6144 : 0);
        f32x4 gv[2][2];
#pragma unroll
        for (int bj = 0; bj < 2; ++bj)
#pragma unroll
            for (int n = 0; n < 2; ++n) gv[bj][n] = *(const f32x4*)(gb + col0 + bj * 128 + n * 16);
#pragma unroll
        for (int ai = 0; ai < 2; ++ai)
#pragma unroll
            for (int m = 0; m < 4; ++m) {
                const size_t rb = (size_t)(row0 + ai * 128 + m * 16) * DM;
#pragma unroll
                for (int bj = 0; bj < 2; ++bj)
#pragma unroll
                    for (int n = 0; n < 2; ++n) {
                        const size_t p = rb + col0 + bj * 128 + n * 16;
                        const f32x4 xi = *(const f32x4*)(xin + p);
                        *(f32x4*)(xout + p) = xi + gv[bj][n] * acc[ai][bj][m][n];
                    }
            }
    }
};
struct EpiGeluStats {
    static constexpr bool PERM = true, AFTER_DRAIN = false;
    bf16* Z; float* stats;
    __device__ __forceinline__ void operator()(const pg8::f32x4 (&acc)[2][2][4][2], const pg8::Unit& u, int wr, int wc, int fr, int fq) const {
        const int row0 = u.pm * 256 + wr * 64 + fr, col0 = u.pn * 256 + wc * 32 + 8 * fq;
#pragma unroll
        for (int ai = 0; ai < 2; ++ai)
#pragma unroll
            for (int m = 0; m < 4; ++m) {
                const int row = row0 + ai * 128 + m * 16; float ss = 0.f;
#pragma unroll
                for (int bj = 0; bj < 2; ++bj) {
                    float g[8];
#pragma unroll
                    for (int n = 0; n < 2; ++n)
#pragma unroll
                        for (int i = 0; i < 4; ++i) { g[n * 4 + i] = gelu_tanh(acc[ai][bj][m][n][i]); ss += g[n * 4 + i] * g[n * 4 + i]; }
                    *(v4u*)(Z + (size_t)row * 4096 + col0 + bj * 128) = pack8(g);
                }
                if (u.pn >= 8) {
                    ss += __shfl_xor(ss, 16); ss += __shfl_xor(ss, 32);
                    if (fq == 0) stats[(size_t)row * 32 + (u.pn - 8) * 4 + wc] = ss;
                }
            }
    }
};
struct EpiMoeGU {
    static constexpr bool PERM = true, AFTER_DRAIN = false;
    bf16* HID;
    __device__ __forceinline__ void operator()(const pg8::f32x4 (&acc)[2][2][4][2], const pg8::Unit& u, int wr, int wc, int fr, int fq) const {
        const int row0 = u.pm * 256 + wr * 64 + fr, col0 = (u.pn & 3) * 128 + wc * 32 + 8 * fq;
#pragma unroll
        for (int ai = 0; ai < 2; ++ai)
#pragma unroll
            for (int m = 0; m < 4; ++m) {
                float h[8];
#pragma unroll
                for (int n = 0; n < 2; ++n)
#pragma unroll
                    for (int i = 0; i < 4; ++i) h[n * 4 + i] = siluf_(acc[ai][0][m][n][i]) * acc[ai][1][m][n][i];
                *(v4u*)(HID + (size_t)(row0 + ai * 128 + m * 16) * EHID + col0) = pack8(h);
            }
    }
};
struct EpiMoeDn {
    static constexpr bool PERM = true, AFTER_DRAIN = false;
    bf16* YM;
    __device__ __forceinline__ void operator()(const pg8::f32x4 (&acc)[2][2][4][2], const pg8::Unit& u, int wr, int wc, int fr, int fq) const {
        const int row0 = u.pm * 256 + wr * 64 + fr, col0 = (u.pn & 3) * 256 + wc * 32 + 8 * fq;
#pragma unroll
        for (int ai = 0; ai < 2; ++ai)
#pragma unroll
            for (int m = 0; m < 4; ++m)
#pragma unroll
                for (int bj = 0; bj < 2; ++bj) {
                    float h[8];
#pragma unroll
                    for (int n = 0; n < 2; ++n)
#pragma unroll
                        for (int i = 0; i < 4; ++i) h[n * 4 + i] = acc[ai][bj][m][n][i];
                    *(v4u*)(YM + (size_t)(row0 + ai * 128 + m * 16) * DM + col0 + bj * 128) = pack8(h);
                }
    }
};
struct MoeOrder {
    const LAS int* ppre; int G, c;
    __device__ __forceinline__ unsigned row_off(const pg8::Unit& u, int r, const int* elist) const {
        const int e = u.pn >> 2, li = (u.pm - ppre[e]) * 256 + r;
        const int tok = (li < ppre[32 + e]) ? elist[e * 16384 + li] : 0;
        return (unsigned)tok * 2048u;
    }
    __device__ __forceinline__ bool next(int i, pg8::Unit& u) const {
        const int L = i * G + c, np = ppre[16];
        if (L >= np * 4) return false;
        const int pm = L >> 2; int e = 0;
#pragma unroll
        for (int k = 1; k < 16; ++k) e += (ppre[k] <= pm) ? 1 : 0;
        u.pm = pm; u.pn = e * 4 + (L & 3); return true;
    }
    __device__ __forceinline__ void a_ready(const pg8::Unit&) const {}
    __device__ __forceinline__ void done(const pg8::Unit&) const {}
};

__device__ __forceinline__ int dest_row(int mode, int n) {
    if (mode == 1) return (n < 1024) ? n : (n < 1040) ? n + 1792 : (n < 2832) ? n - 16 : n;
    if (mode == 2) return (n >> 7) * 256 + (n & 127);
    if (mode == 3) return (n >> 7) * 256 + 128 + (n & 127);
    return n;
}
struct TrItem { const float* src; bf16* dst; int K, N, mode, r; };
__device__ __forceinline__ bool tr_decode(Frame& F, int it, TrItem& t) {
    constexpr int I_IN = 16 * 45, I_OUT = 16 * 16, I_INC = 16 * 64, I_OUTC = 32 * 16, I_CW1 = 2 * 32 * 4, I_G = 32 * 128, I_U = 32 * 128, I_D = 32 * 128;
    constexpr int NITEMS = I_IN + I_OUT + I_INC + I_OUTC + I_CW1 + I_G + I_U + I_D;
    if (it >= NITEMS) return false;
    int r = it; t.mode = 0;
    if (r < I_IN) { t.src = F.w_in_ab; t.dst = (bf16*)(F.ws + WS_WIN); t.K = 1024; t.N = 2856; t.mode = 1; }
    else if ((r -= I_IN) < I_OUT) { t.src = F.w_out_ab; t.dst = (bf16*)(F.ws + WS_WOUT); t.K = 1024; t.N = 1024; }
    else if ((r -= I_OUT) < I_INC) { t.src = F.w_in_c; t.dst = (bf16*)(F.ws + WS_WINC); t.K = 1024; t.N = 4096; }
    else if ((r -= I_INC) < I_OUTC) { t.src = F.w_out_c; t.dst = (bf16*)(F.ws + WS_WOUTC); t.K = 2048; t.N = 1024; }
    else if ((r -= I_OUTC) < I_CW1) { const int m = r >> 7; r &= 127; t.src = F.cmp_w1 + (size_t)m * 2048 * 256; t.dst = (bf16*)(F.ws + WS_WCW1) + (size_t)m * 256 * 2048; t.K = 2048; t.N = 256; }
    else if ((r -= I_CW1) < I_G) { const int m = r >> 7; r &= 127; t.src = F.w_gate + (size_t)m * 1024 * 512; t.dst = (bf16*)(F.ws + WS_WGU) + (size_t)m * 1024 * 1024; t.K = 1024; t.N = 512; t.mode = 2; }
    else if ((r -= I_G) < I_U) { const int m = r >> 7; r &= 127; t.src = F.w_up + (size_t)m * 1024 * 512; t.dst = (bf16*)(F.ws + WS_WGU) + (size_t)m * 1024 * 1024; t.K = 1024; t.N = 512; t.mode = 3; }
    else { r -= I_U; const int m = r >> 7; r &= 127; t.src = F.w_down + (size_t)m * 512 * 1024; t.dst = (bf16*)(F.ws + WS_WDN) + (size_t)m * 1024 * 512; t.K = 512; t.N = 1024; }
    t.r = r; return true;
}
__device__ __forceinline__ void tr_load(const TrItem& t, int lane, f32x4 (&va)[8], f32x4 (&vb)[8]) {
    const int nblk = (t.N + 63) / 64, kb = t.r / nblk, nb = t.r % nblk, k0 = 64 * kb, n0 = 64 * nb;
    const int q = lane & 15, r4 = lane >> 4, col = n0 + 4 * q;
    const float* wp = t.src + (size_t)(k0 + 2 * r4) * t.N + col;
#pragma unroll
    for (int i = 0; i < 8; ++i) {
        if (col < t.N) { va[i] = *(const f32x4*)(wp + (size_t)(8 * i) * t.N); vb[i] = *(const f32x4*)(wp + (size_t)(8 * i + 1) * t.N); }
        else { va[i] = (f32x4){0.f, 0.f, 0.f, 0.f}; vb[i] = va[i]; }
    }
}
__device__ __forceinline__ void tr_finish(const TrItem& t, int lane, const f32x4 (&va)[8], const f32x4 (&vb)[8], LAS unsigned char* scr) {
    const int nblk = (t.N + 63) / 64, kb = t.r / nblk, nb = t.r % nblk, k0 = 64 * kb, n0 = 64 * nb;
    const int q = lane & 15, r4 = lane >> 4;
#pragma unroll
    for (int i = 0; i < 8; ++i) {
        const int kp = 4 * i + r4;
        LAS unsigned* tt = (LAS unsigned*)(scr + (4 * q) * 144 + 4 * kp);
        tt[0] = pk2(va[i].x, vb[i].x); tt[36] = pk2(va[i].y, vb[i].y); tt[72] = pk2(va[i].z, vb[i].z); tt[108] = pk2(va[i].w, vb[i].w);
    }
    LDS_WAIT(); asm volatile("" ::: "memory");
    const int c = lane & 7;
#pragma unroll
    for (int j = 0; j < 8; ++j) { const int n = (lane >> 3) + 8 * j;
        const v4u o = *(const LAS v4u*)(scr + n * 144 + 16 * c);
        if (n0 + n < t.N) *(GAS v4u*)(t.dst + (size_t)dest_row(t.mode, n0 + n) * t.K + k0 + 8 * c) = o; }
    LDS_WAIT(); asm volatile("" ::: "memory");
}
__device__ __forceinline__ void p0_prologue(Frame& F) {
    LAS float* red = (LAS float*)(F.lds + RING_OFF);
    float* mod = (float*)(F.ws + WS_MOD);
    float* bias1 = (float*)(F.ws + WS_MOD + 131072);
    for (int bi = F.bid; bi < 200; bi += F.G) {
        if (bi < 192) {
            const int l = bi / 96, cg = bi % 96, j = cg * 64 + F.lane;
            float a0 = 0.f, a1 = 0.f;
            const float* wp = F.w_ada + ((size_t)l * 1024 + F.wave * 128) * 6144 + j;
#pragma unroll 16
            for (int k = 0; k < 128; ++k) { const float wv = wp[(size_t)k * 6144]; const float c0 = F.c[F.wave * 128 + k], c1 = F.c[1024 + F.wave * 128 + k];
                a0 += siluf_(c0) * wv; a1 += siluf_(c1) * wv; }
            red[(F.wave * 2 + 0) * 64 + F.lane] = a0; red[(F.wave * 2 + 1) * 64 + F.lane] = a1;
            __syncthreads();
            if (F.tid < 128) { const int b = F.tid >> 6, ln = F.tid & 63; float s = 0.f;
#pragma unroll
                for (int w = 0; w < 8; ++w) s += red[(w * 2 + b) * 64 + ln];
                mod[(size_t)(l * 2 + b) * 6144 + cg * 64 + ln] = s + F.b_ada[l * 6144 + cg * 64 + ln]; }
            __syncthreads();
        } else {
            const int kv = (bi - 192) >> 2, cg = (bi - 192) & 3, j = cg * 64 + F.lane;
            float a0 = 0.f;
            const float* wp = F.cmp_w1 + ((size_t)kv * 2048 + F.wave * 256) * 256 + j; const float* pe = F.cmp_pe + kv * 2048 + F.wave * 256;
#pragma unroll 16
            for (int k = 0; k < 256; ++k) a0 += pe[k] * wp[(size_t)k * 256];
            red[F.wave * 64 + F.lane] = a0;
            __syncthreads();
            if (F.tid < 64) { float s = 0.f;
#pragma unroll
                for (int w = 0; w < 8; ++w) s += red[w * 64 + F.tid];
                bias1[kv * 256 + cg * 64 + F.tid] = s; }
            __syncthreads();
        }
    }
    { bf16* wi = (bf16*)(F.ws + WS_WIN); const int npieces = (NPROJ - C_END) * (DM / 8);
      for (int p = F.bid * 512 + F.tid; p < npieces; p += F.G * 512) *(GAS v4u*)(wi + (size_t)C_END * DM + (size_t)p * 8) = (v4u){0u, 0u, 0u, 0u}; }
    LAS unsigned char* scr = F.lds + RING_OFF + 8192 + F.wave * 12288;
    const int gw = F.bid * 8 + F.wave, NGW = F.G * 8;
    { TrItem ta, tb; f32x4 a0[8], a1[8], b0[8], b1[8];
      int it = gw; bool ha = tr_decode(F, it, ta);
      if (ha) tr_load(ta, F.lane, a0, a1);
      while (ha) {
          const bool hb = tr_decode(F, it + NGW, tb);
          if (hb) tr_load(tb, F.lane, b0, b1);
          tr_finish(ta, F.lane, a0, a1, scr);
          if (!hb) break;
          it += 2 * NGW; ha = tr_decode(F, it, ta);
          if (ha) tr_load(ta, F.lane, a0, a1);
          tr_finish(tb, F.lane, b0, b1, scr);
      }
    }
}

__device__ __forceinline__ void moe_tables(Frame& F, int layer) {
    LAS int* ppre = (LAS int*)(F.lds + TAB_OFF);
    if (F.tid == 0) { const unsigned* cnt = (const unsigned*)(F.ctl + CW_CNT + 1024 * layer); int acc = 0;
        for (int e = 0; e < 16; ++e) { const int c = (int)cnt[64 * e]; ppre[e] = acc; ppre[32 + e] = c; acc += (c + 255) >> 8; }
        ppre[16] = acc; }
    __syncthreads();
}

struct RouteRec { int e0, e1, pos0, pos1; float w0, w1; int slot0, slot1; };
template <bool COMBINE, bool NORM, bool ROUTE>
__device__ __forceinline__ void row_pass(Frame& F, const float* xin, const float* modn  , int sh_off, const float* ng,
                                         const float* modc  , int layer, int clayer  ) {
    if (COMBINE) moe_tables(F, clayer);
    float* xout = F.out; bf16* H = (bf16*)(F.ws + WS_O);
    const bf16* YM = (const bf16*)(F.ws + WS_A);
    RouteRec* route = (RouteRec*)(F.ws + WS_ROUTE);
    int* elist = (int*)(F.ws + WS_STATS);
    const LAS int* ppre = (const LAS int*)(F.lds + TAB_OFF);
    LAS float* wr = (LAS float*)(F.lds + RING_OFF);
    LAS unsigned* lcnt = (LAS unsigned*)(F.lds + TAB_OFF + 256);
    if (ROUTE) {
        for (int idx = F.tid; idx < 16384; idx += 512) wr[(idx & 15) * 1024 + (idx >> 4)] = F.w_router[idx];
        if (F.tid < 32) lcnt[F.tid] = 0u;
        __syncthreads();
    }
    const int gw = F.bid * 8 + F.wave, NGW = F.G * 8;
#pragma unroll 1
    for (int b = 0; b < NB; ++b) {
        f32x4 cs[4], sh[4], gc[4];
#pragma unroll
        for (int j = 0; j < 4; ++j) {
            const int col = 4 * F.lane + 256 * j;
            if (NORM) { const f32x4 g = *(const f32x4*)(ng + col), sc = *(const f32x4*)(modn + b * 6144 + sh_off + 1024 + col); cs[j] = g * (sc + 1.0f); sh[j] = *(const f32x4*)(modn + b * 6144 + sh_off + col); }
            if (COMBINE) gc[j] = *(const f32x4*)(modc + b * 6144 + 5 * 1024 + col);
        }
#pragma unroll 1
        for (int m = b * SEQ + gw; m < (b + 1) * SEQ; m += NGW) {
            f32x4 v[4];
#pragma unroll
            for (int j = 0; j < 4; ++j) v[j] = *(const f32x4*)(xin + (size_t)m * DM + 4 * F.lane + 256 * j);
            if (COMBINE) {
                const RouteRec rr = route[m];
                const int sl0 = ppre[rr.e0] * 256 + rr.pos0, sl1 = ppre[rr.e1] * 256 + rr.pos1;
#pragma unroll
                for (int j = 0; j < 4; ++j) {
                    const v2u y0 = *(const v2u*)(YM + (size_t)sl0 * DM + 4 * F.lane + 256 * j), y1 = *(const v2u*)(YM + (size_t)sl1 * DM + 4 * F.lane + 256 * j);
                    f32x4 yy; yy.x = rr.w0 * bflo(y0.x) + rr.w1 * bflo(y1.x); yy.y = rr.w0 * bfhi(y0.x) + rr.w1 * bfhi(y1.x); yy.z = rr.w0 * bflo(y0.y) + rr.w1 * bflo(y1.y); yy.w = rr.w0 * bfhi(y0.y) + rr.w1 * bfhi(y1.y);
                    v[j] = v[j] + gc[j] * yy;
                    *(f32x4*)(xout + (size_t)m * DM + 4 * F.lane + 256 * j) = v[j];
                }
            }
            if (NORM) {
                float s = 0.f;
#pragma unroll
                for (int j = 0; j < 4; ++j) s += (v[j].x * v[j].x + v[j].y * v[j].y) + (v[j].z * v[j].z + v[j].w * v[j].w);
                const float rstd = 1.0f / sqrtf(wave_sum(s) * (1.0f / DM) + NORM_EPS);
#pragma unroll
                for (int j = 0; j < 4; ++j) { v[j] = v[j] * rstd * cs[j] + sh[j];
                    v2u o; o.x = pk2(v[j].x, v[j].y); o.y = pk2(v[j].z, v[j].w);
                    *(v2u*)(H + (size_t)m * DM + 4 * F.lane + 256 * j) = o; }
            }
            if (ROUTE) {
                float lg[16];
#pragma unroll
                for (int eg = 0; eg < 4; ++eg) {
                    float a4[4] = {0.f, 0.f, 0.f, 0.f};
#pragma unroll
                    for (int j = 0; j < 4; ++j)
#pragma unroll
                        for (int ee = 0; ee < 4; ++ee) { const f32x4 w = *(const LAS f32x4*)(wr + (eg * 4 + ee) * 1024 + 4 * F.lane + 256 * j); a4[ee] += (v[j].x * w.x + v[j].y * w.y) + (v[j].z * w.z + v[j].w * w.w); }
#pragma unroll
                    for (int ee = 0; ee < 4; ++ee) lg[eg * 4 + ee] = wave_sum(a4[ee]);
                    __builtin_amdgcn_sched_barrier(0);
                }
                float sc[16], sl[16];
#pragma unroll
                for (int e = 0; e < 16; ++e) { sc[e] = 1.0f / (1.0f + expf(-lg[e])); sl[e] = sc[e] + F.r_bias[e]; }
                float gs[4]; int ge1[4], ge2[4]; float gw1[4], gw2[4];
#pragma unroll
                for (int g = 0; g < 4; ++g) {
                    int i1 = 0; float m1 = sl[4 * g];
#pragma unroll
                    for (int k = 1; k < 4; ++k) if (sl[4 * g + k] > m1) { m1 = sl[4 * g + k]; i1 = k; }
                    int i2 = -1; float m2 = 0.f;
#pragma unroll
                    for (int k = 0; k < 4; ++k) if (k != i1 && (i2 < 0 || sl[4 * g + k] > m2)) { m2 = sl[4 * g + k]; i2 = k; }
                    gs[g] = m1 + m2; ge1[g] = 4 * g + i1; ge2[g] = 4 * g + i2;
                    float w1 = 0.f, w2 = 0.f;
#pragma unroll
                    for (int k = 0; k < 4; ++k) { w1 = (k == i1) ? sc[4 * g + k] : w1; w2 = (k == i2) ? sc[4 * g + k] : w2; }
                    gw1[g] = w1; gw2[g] = w2;
                }
                int gi = 0; float gm = gs[0];
#pragma unroll
                for (int g = 1; g < 4; ++g) if (gs[g] > gm) { gm = gs[g]; gi = g; }
                int e1 = ge1[0], e2 = ge2[0]; float w1 = gw1[0], w2 = gw2[0];
#pragma unroll
                for (int g = 1; g < 4; ++g) if (gi == g) { e1 = ge1[g]; e2 = ge2[g]; w1 = gw1[g]; w2 = gw2[g]; }
                const float ws_ = w1 + w2;
                if (F.lane == 0) {
                    RouteRec rr; rr.e0 = e1; rr.e1 = e2;
                    rr.pos0 = (int)__hip_atomic_fetch_add(lcnt + e1, 1u, __ATOMIC_RELAXED, __HIP_MEMORY_SCOPE_WORKGROUP);
                    rr.pos1 = (int)__hip_atomic_fetch_add(lcnt + e2, 1u, __ATOMIC_RELAXED, __HIP_MEMORY_SCOPE_WORKGROUP);
                    rr.w0 = w1 / ws_; rr.w1 = w2 / ws_; rr.slot0 = 0; rr.slot1 = 0;
                    route[m] = rr;
                }
            }
        }
    }
    if (ROUTE) {
        __syncthreads();
        if (F.tid < 16) { unsigned* cnt = (unsigned*)(F.ctl + CW_CNT + 1024 * layer + 64 * F.tid); lcnt[16 + F.tid] = atomicAdd(cnt, lcnt[F.tid]); }
        __syncthreads();
        if (F.lane == 0) {
#pragma unroll 1
            for (int m = gw; m < NTOK; m += NGW) { RouteRec rr = route[m]; rr.pos0 += (int)lcnt[16 + rr.e0]; rr.pos1 += (int)lcnt[16 + rr.e1]; route[m] = rr;
                elist[rr.e0 * 16384 + rr.pos0] = m; elist[rr.e1 * 16384 + rr.pos1] = m; }
        }
    }
}


__device__ __forceinline__ f32x4 mma16(const LAS bf16* A, int lda, const LAS bf16* Bt, int ldb, int K, f32x4 acc, int lane) {
    const LAS bf16* ap = A + (lane & 15) * lda + (lane >> 4) * 8;
    const LAS bf16* bp = Bt + (lane & 15) * ldb + (lane >> 4) * 8;
    for (int k = 0; k < K; k += 32) {
        const bf16x8 a = *(const LAS bf16x8*)(ap + k), b = *(const LAS bf16x8*)(bp + k);
        acc = __builtin_amdgcn_mfma_f32_16x16x32_bf16(a, b, acc, 0, 0, 0);
    }
    return acc;
}

__device__ __forceinline__ void gla_bcum(Frame& F, const bf16* prow  , int h, float (&bc)[8]) {
    float gl[16];
    { const v4u a = *(const v4u*)(prow + C_GLR), b = *(const v4u*)(prow + C_GLR + 8); float t0[8], t1[8]; unpack8(a, t0); unpack8(b, t1);
#pragma unroll
      for (int i = 0; i < 8; ++i) { gl[i] = t0[i]; gl[8 + i] = t1[i]; } }
#pragma unroll
    for (int i = 0; i < 8; ++i) {
        const int col = h * 64 + F.wave * 8 + i;
        float z = F.gla_bg[col];
#pragma unroll
        for (int r = 0; r < 16; ++r) z += gl[r] * F.gla_w2[r * 256 + col];
        const float ls = fminf(z, 0.f) - log1pf(__expf(-fabsf(z)));
        float v = ls * (1.0f / 16.0f);
#pragma unroll
        for (int off = 1; off < 64; off <<= 1) { const float o = __shfl_up(v, off); v += (F.lane >= off) ? o : 0.f; }
        bc[i] = v;
    }
}
__device__ __forceinline__ void gla_stage_vT(Frame& F, const bf16* prow, int h, LAS bf16* VT) {
    const v4u a = *(const v4u*)(prow + C_GV + h * 128 + F.wave * 16), b = *(const v4u*)(prow + C_GV + h * 128 + F.wave * 16 + 8);
    const unsigned w[8] = {a.x, a.y, a.z, a.w, b.x, b.y, b.z, b.w};
#pragma unroll
    for (int i = 0; i < 8; ++i) { VT[(F.wave * 16 + 2 * i) * 72 + F.lane] = (bf16)(w[i] & 0xffffu); VT[(F.wave * 16 + 2 * i + 1) * 72 + F.lane] = (bf16)(w[i] >> 16); }
}
__device__ __forceinline__ void gla_prep_item(Frame& F, int item) {
    const int h = item & 3, n = (item >> 2) & 127, b = item >> 9;
    const bf16* proj = (const bf16*)(F.ws + WS_A);
    const bf16* prow = proj + (size_t)(b * SEQ + n * 64 + F.lane) * NPROJ;
    LAS bf16* KT = (LAS bf16*)(F.lds + RING_OFF);
    LAS bf16* VT = (LAS bf16*)(F.lds + RING_OFF + 9216);
    float bc[8]; gla_bcum(F, prow, h, bc);
    float kf[8]; { const v4u kk = *(const v4u*)(prow + C_GK + h * 64 + F.wave * 8); unpack8(kk, kf); }
    float* DEC = (float*)(F.ws + WS_DEC) + ((size_t)(b * 128 + n) * 4 + h) * 64;
#pragma unroll
    for (int i = 0; i < 8; ++i) {
        const float bl = __shfl(bc[i], 63);
        KT[(F.wave * 8 + i) * 72 + F.lane] = (bf16)f2bf(kf[i] * __expf(bl - bc[i]));
        if (F.lane == 63) DEC[F.wave * 8 + i] = __expf(bl);
    }
    gla_stage_vT(F, prow, h, VT);
    __syncthreads();
    float* KV = (float*)(F.ws + WS_O) + ((size_t)(b * 128 + n) * 4 + h) * 8192;
    const int dt = F.wave >> 1;
#pragma unroll
    for (int j = 0; j < 4; ++j) {
        const int et = (F.wave & 1) * 4 + j;
        f32x4 acc = {0.f, 0.f, 0.f, 0.f};
        acc = mma16(KT + dt * 16 * 72, 72, VT + et * 16 * 72, 72, 64, acc, F.lane);
#pragma unroll
        for (int i = 0; i < 4; ++i) KV[(dt * 16 + 4 * (F.lane >> 4) + i) * 128 + et * 16 + (F.lane & 15)] = acc[i];
    }
    __syncthreads();
}
__device__ __forceinline__ void gla_scan(Frame& F, int gidx) {
    const int bh = gidx >> 13, de = gidx & 8191, b = bh >> 2, h = bh & 3;
    float* KV = (float*)(F.ws + WS_O) + ((size_t)(b * 128) * 4 + h) * 8192 + de;
    const float* DEC = (const float*)(F.ws + WS_DEC) + ((size_t)(b * 128) * 4 + h) * 64 + (de >> 7);
    float st = 0.f;
#pragma unroll 1
    for (int n0 = 0; n0 < 128; n0 += 8) {
        float kv[8], dc[8];
#pragma unroll
        for (int i = 0; i < 8; ++i) { kv[i] = KV[(size_t)(n0 + i) * 4 * 8192]; dc[i] = DEC[(size_t)(n0 + i) * 4 * 64]; }
#pragma unroll
        for (int i = 0; i < 8; ++i) { KV[(size_t)(n0 + i) * 4 * 8192] = st; st = dc[i] * st + kv[i]; }
    }
}
__device__ __forceinline__ void gla_out_item(Frame& F, int item) {
    const int h = item & 3, n = (item >> 2) & 127, b = item >> 9;
    const bf16* proj = (const bf16*)(F.ws + WS_A);
    const size_t tok = (size_t)b * SEQ + n * 64 + F.lane;
    const bf16* prow = proj + tok * NPROJ;
    LAS bf16* A1 = (LAS bf16*)(F.lds + RING_OFF);
    LAS bf16* B1 = (LAS bf16*)(F.lds + RING_OFF + 9216);
    LAS bf16* A2 = (LAS bf16*)(F.lds + RING_OFF + 18432);
    LAS bf16* SC = (LAS bf16*)(F.lds + RING_OFF + 27648);
    LAS bf16* VT = (LAS bf16*)(F.lds + RING_OFF + 36864);
    LAS bf16* ST = (LAS bf16*)(F.lds + RING_OFF + 55296);
    LAS float* OS = (LAS float*)(F.lds + RING_OFF + 73728);
    float bc[8]; gla_bcum(F, prow, h, bc);
    float qf[8], kf[8];
    { const v4u qq = *(const v4u*)(prow + C_GQ + h * 64 + F.wave * 8), kk = *(const v4u*)(prow + C_GK + h * 64 + F.wave * 8); unpack8(qq, qf); unpack8(kk, kf); }
    float a1[8], b1[8], a2[8];
#pragma unroll
    for (int i = 0; i < 8; ++i) {
        const float bm = __shfl(bc[i], 32);
        a1[i] = qf[i] * 0.125f * __expf(bc[i] - bm); b1[i] = kf[i] * __expf(bm - bc[i]); a2[i] = qf[i] * 0.125f * __expf(bc[i]);
    }
    *(LAS v4u*)(A1 + F.lane * 72 + F.wave * 8) = pack8(a1);
    *(LAS v4u*)(B1 + F.lane * 72 + F.wave * 8) = pack8(b1);
    *(LAS v4u*)(A2 + F.lane * 72 + F.wave * 8) = pack8(a2);
    gla_stage_vT(F, prow, h, VT);
    { const float* KV = (const float*)(F.ws + WS_O) + ((size_t)(b * 128 + n) * 4 + h) * 8192;
#pragma unroll
      for (int k = 0; k < 16; ++k) { const int p = F.tid + 512 * k, e = p & 127, d = p >> 7; ST[e * 72 + d] = (bf16)f2bf(KV[d * 128 + e]); } }
    __syncthreads();
    const int it = F.wave >> 1;
#pragma unroll
    for (int jj = 0; jj < 2; ++jj) {
        const int jt = (F.wave & 1) * 2 + jj;
        f32x4 acc = {0.f, 0.f, 0.f, 0.f};
        if (jt <= it) acc = mma16(A1 + it * 16 * 72, 72, B1 + jt * 16 * 72, 72, 64, acc, F.lane);
#pragma unroll
        for (int i = 0; i < 4; ++i) { const int ri = it * 16 + 4 * (F.lane >> 4) + i, cj = jt * 16 + (F.lane & 15); SC[ri * 72 + cj] = (bf16)f2bf((cj <= ri) ? acc[i] : 0.f); }
    }
    __syncthreads();
#pragma unroll
    for (int j = 0; j < 4; ++j) {
        const int et = (F.wave & 1) * 4 + j;
        f32x4 acc = {0.f, 0.f, 0.f, 0.f};
        acc = mma16(SC + it * 16 * 72, 72, VT + et * 16 * 72, 72, 64, acc, F.lane);
        acc = mma16(A2 + it * 16 * 72, 72, ST + et * 16 * 72, 72, 64, acc, F.lane);
#pragma unroll
        for (int i = 0; i < 4; ++i) OS[(it * 16 + 4 * (F.lane >> 4) + i) * 132 + et * 16 + (F.lane & 15)] = acc[i];
    }
    __syncthreads();
    { const int row = F.tid >> 3, c0 = (F.tid & 7) * 16;
      float v[16]; float ss = 0.f;
#pragma unroll
      for (int i = 0; i < 16; ++i) { v[i] = OS[row * 132 + c0 + i]; ss += v[i] * v[i]; }
      ss += __shfl_xor(ss, 1); ss += __shfl_xor(ss, 2); ss += __shfl_xor(ss, 4);
      const float rstd = 1.0f / sqrtf(ss * (1.0f / 128.0f) + NORM_EPS);
      const size_t tk = (size_t)b * SEQ + n * 64 + row;
      const bf16* rrow = proj + tk * NPROJ + C_GR + h * 128 + c0;
      float r0[8], r1[8]; unpack8(*(const v4u*)rrow, r0); unpack8(*(const v4u*)(rrow + 8), r1);
      float o0[8], o1[8];
#pragma unroll
      for (int i = 0; i < 8; ++i) { o0[i] = v[i] * rstd * F.gla_ng[c0 + i] * siluf_(r0[i]); o1[i] = v[8 + i] * rstd * F.gla_ng[c0 + 8 + i] * siluf_(r1[i]); }
      bf16* orow = (bf16*)(F.ws + WS_O + 32 * MiB) + tk * DM + h * 128 + c0;
      *(v4u*)orow = pack8(o0); *(v4u*)(orow + 8) = pack8(o1); }
    __syncthreads();
}

__device__ __forceinline__ double inv_freq_d(int i) {
    return (i == 0) ? 1.0 : (i == 1) ? 0.19392547740471268 : (i == 2) ? 0.037606090787015346 : (i == 3) ? 0.0072927791106285765 :
           (i == 4) ? 0.0014142135623730951 : (i == 5) ? 0.00027425197177757796 : (i == 6) ? 5.318404375373266e-05 : 1.0313741203148838e-05;
}
__device__ __forceinline__ void rope_sincos(int pos, int i, float& cs, float& sn) {
    const double rev = (double)pos * inv_freq_d(i) * 0.15915494309189535;
    const float fr = (float)(rev - rint(rev));
    cs = __builtin_amdgcn_cosf(fr); sn = __builtin_amdgcn_sinf(fr);
}
__device__ __forceinline__ void nsa_prep_token(Frame& F, int tok) {
    const int b = tok >> 13, t = tok & 8191, sub = F.lane & 7, vid = F.lane >> 3;
    const bf16* prow = (const bf16*)(F.ws + WS_A) + (size_t)tok * NPROJ;
    const int pos = F.positions[tok];
    float cs_l, sn_l; rope_sincos(pos, sub, cs_l, sn_l);
    float cs[8], sn[8];
#pragma unroll
    for (int i = 0; i < 8; ++i) { cs[i] = __shfl(cs_l, (F.lane & ~7) + i); sn[i] = __shfl(sn_l, (F.lane & ~7) + i); }
    unsigned char* dob = F.dout_b;
    const size_t ktile_off = (size_t)(t >> 6) * 8192 + sub * 1024 + (t & 63) * 16;
    const size_t vtile_off = (size_t)(t >> 6) * 8192 + (sub >> 2) * 4096 + (t & 63) * 64 + (sub & 3) * 16;
#pragma unroll
    for (int round = 0; round < 3; ++round) {
        int col; int kind; unsigned char* dst; const float* gain = nullptr;
        if (round == 0) { col = C_NQ + vid * 64; kind = 0; gain = F.q_gain; const int g = vid >> 2, hh = vid & 3;
            dst = dob + DO_QN + ((((size_t)(b * 2 + g) * SEQ + t) * 4 + hh) * 64 + sub * 8) * 2; }
        else if (round == 1) {
            const int g = vid & 1, which = vid >> 1;
            const size_t img = (size_t)(b * 2 + g) * (1u << 20);
            if (which == 0) { col = C_KS + g * 64; kind = 1; gain = F.k_gain + 64; dst = dob + DO_KSEL + img + ktile_off; }
            else if (which == 1) { col = C_KW + g * 64; kind = 1; gain = F.k_gain + 128; dst = dob + DO_KWIN + img + ktile_off; }
            else if (which == 2) { col = C_VS + g * 64; kind = 2; dst = dob + DO_VSEL + img + vtile_off; }
            else { col = C_VW + g * 64; kind = 2; dst = dob + DO_VWIN + img + vtile_off; }
        } else {
            const int g = vid & 1, which = (vid >> 1) & 1;
            col = (which ? C_VC : C_KC) + g * 64; kind = 2;
            dst = dob + (which ? DO_VC : DO_KC) + (((size_t)(b * 2 + g) * SEQ + t) * 64 + sub * 8) * 2;
        }
        float x[8]; unpack8(*(const v4u*)(prow + col + sub * 8), x);
        if (kind != 2) {
            float ss = 0.f;
#pragma unroll
            for (int i = 0; i < 8; ++i) ss += x[i] * x[i];
            ss += __shfl_xor(ss, 1); ss += __shfl_xor(ss, 2); ss += __shfl_xor(ss, 4);
            const float rstd = 1.0f / sqrtf(ss * (1.0f / 64.0f) + NORM_EPS);
#pragma unroll
            for (int i = 0; i < 8; ++i) x[i] = x[i] * rstd * gain[sub * 8 + i];
            float xo[8];
#pragma unroll
            for (int i = 0; i < 8; ++i) xo[i] = __shfl_xor(x[i], 1);
            if (sub == 0) {
#pragma unroll
                for (int i = 0; i < 8; ++i) x[i] = x[i] * cs[i] - xo[i] * sn[i];
            } else if (sub == 1) {
#pragma unroll
                for (int i = 0; i < 8; ++i) x[i] = x[i] * cs[i] + xo[i] * sn[i];
            }
            if (kind == 0) {
#pragma unroll
                for (int i = 0; i < 8; ++i) x[i] *= 0.125f * 1.4426950408889634f;
            }
        }
        if (round < 2 || F.lane < 32) *(v4u*)dst = pack8(x);
    }
    if (F.lane < 24) { float* gt = (float*)(F.ws + WS_GATES) + (size_t)tok * 24; gt[F.lane] = sigmoidf_(bf2f(prow[C_NG + F.lane])); }
}

__device__ __forceinline__ void nsa_compress_item(Frame& F, int item) {
    const int kv = item >> 6, b = (item >> 5) & 1, g = (item >> 4) & 1, rt = item & 15, n0 = rt * 32;
    const bf16* Asrc = (const bf16*)(F.dout_b + (kv ? DO_VC : DO_KC)) + ((size_t)(b * 2 + g) * SEQ + 16 * n0) * 64;
    const bf16* Bsrc = (const bf16*)(F.ws + WS_WCW1) + (size_t)kv * 256 * 2048;
    LAS bf16* As = (LAS bf16*)(F.lds + RING_OFF);
    LAS bf16* Bs = (LAS bf16*)(F.lds + RING_OFF + 2 * 32 * 72 * 2);
    LAS float* Hs = (LAS float*)(F.lds + RING_OFF + 86016);
    LAS float* W2s = (LAS float*)(F.lds + RING_OFF);
    const int ar = F.tid >> 3, ac = (F.tid & 7) * 8;
    v4u areg = {0u, 0u, 0u, 0u}, breg[4];
#define CMP_GLOAD(kc) do { if (F.tid < 256) areg = *(const v4u*)(Asrc + (size_t)ar * 1024 + (kc) * 64 + ac); \
        _Pragma("unroll") for (int i_ = 0; i_ < 4; ++i_) { const int p_ = F.tid + 512 * i_, br_ = p_ >> 3, bc_ = (p_ & 7) * 8; breg[i_] = *(const v4u*)(Bsrc + (size_t)br_ * 2048 + (kc) * 64 + bc_); } } while (0)
#define CMP_LSTORE(buf) do { if (F.tid < 256) *(LAS v4u*)(As + (buf) * 32 * 72 + ar * 72 + ac) = areg; \
        _Pragma("unroll") for (int i_ = 0; i_ < 4; ++i_) { const int p_ = F.tid + 512 * i_, br_ = p_ >> 3, bc_ = (p_ & 7) * 8; *(LAS v4u*)(Bs + (buf) * 256 * 72 + br_ * 72 + bc_) = breg[i_]; } } while (0)
    f32x4 acc[2][2];
#pragma unroll
    for (int mt = 0; mt < 2; ++mt)
#pragma unroll
        for (int nt = 0; nt < 2; ++nt) acc[mt][nt] = (f32x4){0.f, 0.f, 0.f, 0.f};
    CMP_GLOAD(0); CMP_LSTORE(0); __syncthreads();
#pragma unroll 1
    for (int kc = 0; kc < 32; ++kc) {
        const int buf = kc & 1;
        if (kc + 1 < 32) CMP_GLOAD(kc + 1);
#pragma unroll
        for (int mt = 0; mt < 2; ++mt)
#pragma unroll
            for (int nt = 0; nt < 2; ++nt)
                acc[mt][nt] = mma16(As + buf * 32 * 72 + mt * 16 * 72, 72, Bs + buf * 256 * 72 + (F.wave * 32 + nt * 16) * 72, 72, 64, acc[mt][nt], F.lane);
        if (kc + 1 < 32) CMP_LSTORE(buf ^ 1);
        __syncthreads();
    }
    const float* bias1 = (const float*)(F.ws + WS_MOD + 131072) + kv * 256;
#pragma unroll
    for (int mt = 0; mt < 2; ++mt)
#pragma unroll
        for (int nt = 0; nt < 2; ++nt) { const int col = F.wave * 32 + nt * 16 + (F.lane & 15);
#pragma unroll
            for (int i = 0; i < 4; ++i) Hs[(mt * 16 + 4 * (F.lane >> 4) + i) * 260 + col] = gelu_tanh(acc[mt][nt][i] + bias1[col]); }
    { const float* w2 = F.cmp_w2 + (size_t)kv * 256 * 64;
#pragma unroll
      for (int i = 0; i < 8; ++i) *(LAS f32x4*)(W2s + (F.tid + 512 * i) * 4) = *(const f32x4*)(w2 + (size_t)(F.tid + 512 * i) * 4); }
    __syncthreads();
    const int r = F.tid >> 4, dq = F.tid & 15;
    f32x4 o = {0.f, 0.f, 0.f, 0.f};
#pragma unroll 8
    for (int j = 0; j < 256; ++j) { const float hv = Hs[r * 260 + j]; const f32x4 w = *(const LAS f32x4*)(W2s + j * 64 + 4 * dq); o = o + w * hv; }
    const int n = n0 + r;
    if (kv == 0) {
        float ss = (o.x * o.x + o.y * o.y) + (o.z * o.z + o.w * o.w);
        ss += __shfl_xor(ss, 1); ss += __shfl_xor(ss, 2); ss += __shfl_xor(ss, 4); ss += __shfl_xor(ss, 8);
        const float rstd = 1.0f / sqrtf(ss * (1.0f / 64.0f) + NORM_EPS);
        const f32x4 gn = *(const f32x4*)(F.k_gain + 4 * dq);
        o = o * rstd * gn;
        const int tlast = (16 * n + 31 < SEQ) ? 16 * n + 31 : SEQ - 1;
        const int pos = F.positions[b * SEQ + tlast];
        f32x4 po; po.x = __shfl_xor(o.x, 2); po.y = __shfl_xor(o.y, 2); po.z = __shfl_xor(o.z, 2); po.w = __shfl_xor(o.w, 2);
        if (dq < 4) {
            const int i0 = 4 * (dq & 1);
            float c0, s0, c1, s1, c2, s2, c3, s3;
            rope_sincos(pos, i0, c0, s0); rope_sincos(pos, i0 + 1, c1, s1); rope_sincos(pos, i0 + 2, c2, s2); rope_sincos(pos, i0 + 3, c3, s3);
            if (dq < 2) { o.x = o.x * c0 - po.x * s0; o.y = o.y * c1 - po.y * s1; o.z = o.z * c2 - po.z * s2; o.w = o.w * c3 - po.w * s3; }
            else { o.x = o.x * c0 + po.x * s0; o.y = o.y * c1 + po.y * s1; o.z = o.z * c2 + po.z * s2; o.w = o.w * c3 + po.w * s3; }
        }
    }
    if (n == 511) o = (f32x4){0.f, 0.f, 0.f, 0.f};
    v2u pk; pk.x = pk2(o.x, o.y); pk.y = pk2(o.z, o.w);
    const int c = dq >> 1;
    unsigned char* img = F.dout_b + (kv ? DO_VCMP : DO_KCMP) + (size_t)(b * 2 + g) * 65536 + (size_t)(n >> 6) * 8192;
    if (kv == 0) *(v2u*)(img + c * 1024 + (n & 63) * 16 + (dq & 1) * 8) = pk;
    else *(v2u*)(img + (c >> 2) * 4096 + (n & 63) * 64 + (c & 3) * 16 + (dq & 1) * 8) = pk;
    __syncthreads();
}

constexpr int NSA_KB = 0, NSA_VB = 16384, NSA_IMP = 32768, NSA_OACC = 65536;
__device__ __forceinline__ int crow(int r, int hi) { return (r & 3) + 8 * (r >> 2) + 4 * hi; }
__device__ __forceinline__ s16x4 ds_tr16(const LAS unsigned char* p) { return __builtin_bit_cast(s16x4, __builtin_amdgcn_ds_read_tr16_b64_v4i16((LAS s16x4*)p)); }

__device__ __forceinline__ unsigned cvtpk(float lo, float hi) { unsigned r; asm("v_cvt_pk_bf16_f32 %0, %1, %2" : "=v"(r) : "v"(lo), "v"(hi)); return r; }
__device__ __forceinline__ float xhalf_max(float v) { const auto rr = __builtin_amdgcn_permlane32_swap(__float_as_uint(v), __float_as_uint(v), false, false); return fmaxf(__uint_as_float(rr[0]), __uint_as_float(rr[1])); }
constexpr float NSA_THR = 8.0f;

template <int MODE>
__device__ __forceinline__ void nsa_branch(Frame& F, const unsigned char* Kimg, const unsigned char* Vimg, int kt0, int kt1, const bf16x8 (&qr)[4],
                                           float& m, float& l, f32x16 (&o)[2], int t, int tw0, int nv, int nvw, int nvmin,
                                           unsigned mk0, unsigned mk1, unsigned mk2, unsigned mk3, unsigned wo0, unsigned wo1, unsigned wo2, unsigned wo3,
                                           float cinit  , LAS float* impw) {
    const int r32 = F.lane & 31, hi = F.lane >> 5, tokl = r32 >> 2;
    LAS unsigned char* KB = F.lds + RING_OFF + NSA_KB; LAS unsigned char* VB = F.lds + RING_OFF + NSA_VB;
    const v4u* kg = (const v4u*)Kimg + F.tid; const v4u* vg = (const v4u*)Vimg + F.tid;
    v4u kreg = kg[(size_t)kt0 * 512], vreg = {0u, 0u, 0u, 0u};
    if (MODE != 0) vreg = vg[(size_t)kt0 * 512];
    *(LAS v4u*)(KB + F.tid * 16) = kreg; if (MODE != 0) *(LAS v4u*)(VB + F.tid * 16) = vreg;
    __syncthreads();
#pragma unroll 1
    for (int kt = kt0; kt < kt1; ++kt) {
        const int buf = (kt - kt0) & 1; const bool has_next = kt + 1 < kt1;
        if (has_next) { kreg = kg[(size_t)(kt + 1) * 512]; if (MODE != 0) vreg = vg[(size_t)(kt + 1) * 512]; }
        const LAS unsigned char* Kb = KB + buf * 8192; const LAS unsigned char* Vb = VB + buf * 8192;
        bool need;
        if (MODE <= 1) need = kt * 64 < nvw;
        else if (MODE == 2) { const unsigned w = (kt < 32) ? wo0 : (kt < 64) ? wo1 : (kt < 96) ? wo2 : wo3; need = (w >> (kt & 31)) & 1u; }
        else need = (kt * 64 <= tw0 + 7) && (kt * 64 + 63 + 512 > tw0);
        bool selbit = true;
        if (MODE == 2) { const unsigned w = (kt < 32) ? mk0 : (kt < 64) ? mk1 : (kt < 96) ? mk2 : mk3; selbit = (w >> (kt & 31)) & 1u; }
        bool joint = false;
        if (need) {
            if (MODE == 2) joint = kt < (tw0 >> 6);
            else if (MODE == 3) joint = (kt * 64 + 63 <= tw0) && (kt * 64 + 512 > tw0 + 7);
            else joint = kt * 64 + 63 < nvmin;
            if (MODE != 1) joint = joint && !__any(m < -1e29f);
        }
        if (need && joint) {
            const float c0 = (MODE == 1) ? cinit : ((MODE == 2 && !selbit) ? -1e30f : -m);
            f32x16 pa, pb;
#pragma unroll
            for (int r = 0; r < 16; ++r) { pa[r] = c0; pb[r] = c0; }
#pragma unroll
            for (int d0 = 0; d0 < 4; ++d0) {
                const bf16x8 kfa = *(const LAS bf16x8*)(Kb + (2 * d0 + hi) * 1024 + r32 * 16), kfb = *(const LAS bf16x8*)(Kb + (2 * d0 + hi) * 1024 + (32 + r32) * 16);
                pa = __builtin_amdgcn_mfma_f32_32x32x16_bf16(kfa, qr[d0], pa, 0, 0, 0);
                pb = __builtin_amdgcn_mfma_f32_32x32x16_bf16(kfb, qr[d0], pb, 0, 0, 0);
            }
            if (MODE != 1) {
                float mxa = fmaxf(fmaxf(pa[0], pa[1]), pa[2]), mxb = fmaxf(fmaxf(pb[0], pb[1]), pb[2]);
#pragma unroll
                for (int r = 3; r < 15; r += 2) { mxa = fmaxf(fmaxf(mxa, pa[r]), pa[r + 1]); mxb = fmaxf(fmaxf(mxb, pb[r]), pb[r + 1]); }
                const float mx = xhalf_max(fmaxf(fmaxf(mxa, pa[15]), fmaxf(mxb, pb[15])));
                if (__any(mx > NSA_THR)) {
                    const float dl = fmaxf(mx, 0.f), alpha = fexp2(-dl);
                    m += dl; l *= alpha;
#pragma unroll
                    for (int r = 0; r < 16; ++r) { pa[r] -= dl; pb[r] -= dl; }
                    if (MODE != 0) {
#pragma unroll
                        for (int r = 0; r < 16; ++r) { o[0][r] *= alpha; o[1][r] *= alpha; }
                    }
                }
            }
            float ps0 = 0.f, ps1 = 0.f;
#pragma unroll
            for (int r = 0; r < 16; ++r) { pa[r] = fexp2(pa[r]); pb[r] = fexp2(pb[r]); ps0 += pa[r]; ps1 += pb[r]; }
            if (MODE != 1) l += ps0 + ps1;
            if (MODE == 1) {
#pragma unroll
                for (int rg = 0; rg < 4; ++rg) {
                    float a = (pa[4 * rg] + pa[4 * rg + 1]) + (pa[4 * rg + 2] + pa[4 * rg + 3]), sp = pa[4 * rg + 3];
                    float a2 = (pb[4 * rg] + pb[4 * rg + 1]) + (pb[4 * rg + 2] + pb[4 * rg + 3]), sp2 = pb[4 * rg + 3];
                    a += __shfl_xor(a, 1); a += __shfl_xor(a, 2); sp += __shfl_xor(sp, 1); sp += __shfl_xor(sp, 2);
                    a2 += __shfl_xor(a2, 1); a2 += __shfl_xor(a2, 2); sp2 += __shfl_xor(sp2, 1); sp2 += __shfl_xor(sp2, 2);
                    if ((r32 & 3) == 0) { const int jp = kt * 16 + 2 * rg + hi;
                        __hip_atomic_fetch_add(impw + tokl * 128 + jp, a, __ATOMIC_RELAXED, __HIP_MEMORY_SCOPE_WORKGROUP);
                        __hip_atomic_fetch_add(impw + tokl * 128 + jp + 1, sp, __ATOMIC_RELAXED, __HIP_MEMORY_SCOPE_WORKGROUP);
                        __hip_atomic_fetch_add(impw + tokl * 128 + jp + 8, a2, __ATOMIC_RELAXED, __HIP_MEMORY_SCOPE_WORKGROUP);
                        if (jp + 9 < 128) __hip_atomic_fetch_add(impw + tokl * 128 + jp + 9, sp2, __ATOMIC_RELAXED, __HIP_MEMORY_SCOPE_WORKGROUP); }
                }
            }
            if (MODE != 0) {
                v4u wa0, wa1, wb0, wb1;
                wa0.x = cvtpk(pa[0], pa[1]); wa0.y = cvtpk(pa[2], pa[3]); wa0.z = cvtpk(pa[4], pa[5]); wa0.w = cvtpk(pa[6], pa[7]);
                wa1.x = cvtpk(pa[8], pa[9]); wa1.y = cvtpk(pa[10], pa[11]); wa1.z = cvtpk(pa[12], pa[13]); wa1.w = cvtpk(pa[14], pa[15]);
                wb0.x = cvtpk(pb[0], pb[1]); wb0.y = cvtpk(pb[2], pb[3]); wb0.z = cvtpk(pb[4], pb[5]); wb0.w = cvtpk(pb[6], pb[7]);
                wb1.x = cvtpk(pb[8], pb[9]); wb1.y = cvtpk(pb[10], pb[11]); wb1.z = cvtpk(pb[12], pb[13]); wb1.w = cvtpk(pb[14], pb[15]);
                const bf16x8 fa0 = __builtin_bit_cast(bf16x8, wa0), fa1 = __builtin_bit_cast(bf16x8, wa1), fb0 = __builtin_bit_cast(bf16x8, wb0), fb1 = __builtin_bit_cast(bf16x8, wb1);
                const LAS unsigned char* vb = Vb + (4 * hi + ((F.lane & 15) >> 2)) * 64 + ((F.lane >> 4) & 1) * 32 + (F.lane & 3) * 8;
#pragma unroll
                for (int dh = 0; dh < 2; ++dh) {
                    const LAS unsigned char* v0 = vb + dh * 4096;
                    const s16x4 a0 = ds_tr16(v0), a1 = ds_tr16(v0 + 512), b0 = ds_tr16(v0 + 1024), b1 = ds_tr16(v0 + 1536), c0_ = ds_tr16(v0 + 2048), c1 = ds_tr16(v0 + 2560), d0_ = ds_tr16(v0 + 3072), d1 = ds_tr16(v0 + 3584);
                    const bf16x8 vfa0 = {a0[0], a0[1], a0[2], a0[3], a1[0], a1[1], a1[2], a1[3]}, vfa1 = {b0[0], b0[1], b0[2], b0[3], b1[0], b1[1], b1[2], b1[3]};
                    const bf16x8 vfb0 = {c0_[0], c0_[1], c0_[2], c0_[3], c1[0], c1[1], c1[2], c1[3]}, vfb1 = {d0_[0], d0_[1], d0_[2], d0_[3], d1[0], d1[1], d1[2], d1[3]};
                    o[dh] = __builtin_amdgcn_mfma_f32_32x32x16_bf16(vfa0, fa0, o[dh], 0, 0, 0);
                    o[dh] = __builtin_amdgcn_mfma_f32_32x32x16_bf16(vfa1, fa1, o[dh], 0, 0, 0);
                    o[dh] = __builtin_amdgcn_mfma_f32_32x32x16_bf16(vfb0, fb0, o[dh], 0, 0, 0);
                    o[dh] = __builtin_amdgcn_mfma_f32_32x32x16_bf16(vfb1, fb1, o[dh], 0, 0, 0);
                }
            }
        } else if (need) {
#pragma unroll 1
            for (int kb = 0; kb < 2; ++kb) {
                const int key0 = kt * 64 + kb * 32;
                bool fast;
                if (MODE == 2) fast = kt < (tw0 >> 6);
                else if (MODE == 3) fast = (key0 + 31 <= tw0) && (key0 + 512 > tw0 + 7);
                else fast = key0 + 31 < nvmin;
                if (MODE != 1) fast = fast && !__any(m < -1e29f);
                float c0 = 0.f;
                if (fast) c0 = (MODE == 1) ? cinit : ((MODE == 2 && !selbit) ? -1e30f : -m);
                f32x16 p;
#pragma unroll
                for (int r = 0; r < 16; ++r) p[r] = c0;
#pragma unroll
                for (int d0 = 0; d0 < 4; ++d0) {
                    const bf16x8 kf = *(const LAS bf16x8*)(Kb + (2 * d0 + hi) * 1024 + (32 * kb + r32) * 16);
                    p = __builtin_amdgcn_mfma_f32_32x32x16_bf16(kf, qr[d0], p, 0, 0, 0);
                }
                float pe[16];
                if (fast) {
                    if (MODE != 1) {
                        float mx = fmaxf(fmaxf(p[0], p[1]), p[2]);
#pragma unroll
                        for (int r = 3; r < 15; r += 2) mx = fmaxf(fmaxf(mx, p[r]), p[r + 1]);
                        mx = xhalf_max(fmaxf(mx, p[15]));
                        if (__any(mx > NSA_THR)) {
                            const float dl = fmaxf(mx, 0.f), alpha = fexp2(-dl);
                            m += dl; l *= alpha;
#pragma unroll
                            for (int r = 0; r < 16; ++r) p[r] -= dl;
                            if (MODE != 0) {
#pragma unroll
                                for (int r = 0; r < 16; ++r) { o[0][r] *= alpha; o[1][r] *= alpha; }
                            }
                        }
                    }
                    float ps0 = 0.f, ps1 = 0.f;
#pragma unroll
                    for (int r = 0; r < 16; r += 2) { pe[r] = fexp2(p[r]); pe[r + 1] = fexp2(p[r + 1]); ps0 += pe[r]; ps1 += pe[r + 1]; }
                    if (MODE != 1) l += ps0 + ps1;
                } else if (MODE == 1) {
#pragma unroll
                    for (int r = 0; r < 16; ++r) { const int key = key0 + crow(r, hi); pe[r] = (key < nv) ? fexp2(p[r] + cinit) : 0.f; }
                } else {
                    float mx = NEGBIG;
#pragma unroll
                    for (int r = 0; r < 16; ++r) {
                        const int key = key0 + crow(r, hi); bool ok;
                        if (MODE == 0) ok = key < nv;
                        else if (MODE == 2) ok = selbit && (kt < (t >> 6) || key <= t);
                        else ok = (key <= t) && (key + 512 > t);
                        p[r] = ok ? p[r] : NEGBIG; mx = fmaxf(mx, p[r]);
                    }
                    mx = xhalf_max(mx);
                    const float mn = fmaxf(m, mx), alpha = fexp2(m - mn);
                    float ps = 0.f;
#pragma unroll
                    for (int r = 0; r < 16; ++r) { pe[r] = (p[r] > -1e29f) ? fexp2(p[r] - mn) : 0.f; ps += pe[r]; }
                    l = l * alpha + ps; m = mn;
                    if (MODE != 0) {
#pragma unroll
                        for (int r = 0; r < 16; ++r) { o[0][r] *= alpha; o[1][r] *= alpha; }
                    }
                }
                if (MODE == 1) {
#pragma unroll
                    for (int rg = 0; rg < 4; ++rg) {
                        float a = (pe[4 * rg] + pe[4 * rg + 1]) + (pe[4 * rg + 2] + pe[4 * rg + 3]), sp = pe[4 * rg + 3];
                        a += __shfl_xor(a, 1); a += __shfl_xor(a, 2); sp += __shfl_xor(sp, 1); sp += __shfl_xor(sp, 2);
                        if ((r32 & 3) == 0) { const int jp = (key0 >> 2) + 2 * rg + hi;
                            __hip_atomic_fetch_add(impw + tokl * 128 + jp, a, __ATOMIC_RELAXED, __HIP_MEMORY_SCOPE_WORKGROUP);
                            if (jp + 1 < 128) __hip_atomic_fetch_add(impw + tokl * 128 + jp + 1, sp, __ATOMIC_RELAXED, __HIP_MEMORY_SCOPE_WORKGROUP); }
                    }
                }
                if (MODE != 0) {
                    v4u pw0, pw1;
                    pw0.x = cvtpk(pe[0], pe[1]); pw0.y = cvtpk(pe[2], pe[3]); pw0.z = cvtpk(pe[4], pe[5]); pw0.w = cvtpk(pe[6], pe[7]);
                    pw1.x = cvtpk(pe[8], pe[9]); pw1.y = cvtpk(pe[10], pe[11]); pw1.z = cvtpk(pe[12], pe[13]); pw1.w = cvtpk(pe[14], pe[15]);
                    const bf16x8 pf0 = __builtin_bit_cast(bf16x8, pw0), pf1 = __builtin_bit_cast(bf16x8, pw1);
                    const LAS unsigned char* vb = Vb + (32 * kb + 4 * hi + ((F.lane & 15) >> 2)) * 64 + ((F.lane >> 4) & 1) * 32 + (F.lane & 3) * 8;
#pragma unroll
                    for (int dh = 0; dh < 2; ++dh) {
                        const s16x4 a0 = ds_tr16(vb + dh * 4096), a1 = ds_tr16(vb + dh * 4096 + 512), b0 = ds_tr16(vb + dh * 4096 + 1024), b1 = ds_tr16(vb + dh * 4096 + 1024 + 512);
                        const bf16x8 vf0 = {a0[0], a0[1], a0[2], a0[3], a1[0], a1[1], a1[2], a1[3]}, vf1 = {b0[0], b0[1], b0[2], b0[3], b1[0], b1[1], b1[2], b1[3]};
                        o[dh] = __builtin_amdgcn_mfma_f32_32x32x16_bf16(vf0, pf0, o[dh], 0, 0, 0);
                        o[dh] = __builtin_amdgcn_mfma_f32_32x32x16_bf16(vf1, pf1, o[dh], 0, 0, 0);
                    }
                }
            }
        }
        if (has_next) { *(LAS v4u*)(KB + (buf ^ 1) * 8192 + F.tid * 16) = kreg; if (MODE != 0) *(LAS v4u*)(VB + (buf ^ 1) * 8192 + F.tid * 16) = vreg; }
        __syncthreads();
    }
}

__device__ __forceinline__ void nsa_item(Frame& F, int b, int g, int qi) {
    const int r32 = F.lane & 31, hi = F.lane >> 5, tokl = r32 >> 2, hh = r32 & 3;
    const int t0 = qi * 64, tw0 = t0 + 8 * F.wave, t = tw0 + tokl;
    const unsigned char* dob = F.dout_b;
    const size_t img = (size_t)(b * 2 + g) * (1u << 20);
    LAS float* impw = (LAS float*)(F.lds + RING_OFF + NSA_IMP) + F.wave * 1024;
    LAS unsigned* selm = (LAS unsigned*)(F.lds + TAB_OFF + 1024) + F.wave * 32;
    LAS float* oaccw = (LAS float*)(F.lds + RING_OFF + NSA_OACC) + F.wave * 2048 + F.lane;
#pragma unroll
    for (int i = 0; i < 16; ++i) impw[F.lane + 64 * i] = 0.f;
    bf16x8 qr[4];
    { const bf16* qrow = (const bf16*)(dob + DO_QN) + (((size_t)(b * 2 + g) * SEQ + tw0) * 4 + r32) * 64;
#pragma unroll
      for (int d0 = 0; d0 < 4; ++d0) qr[d0] = *(const bf16x8*)(qrow + 16 * d0 + 8 * hi); }
    const float* gt = (const float*)(F.ws + WS_GATES) + ((size_t)b * SEQ + t) * 24 + (g * 4 + hh) * 3;
#if defined(NSA_ZERO_CMP)
    const float g0 = 0.f, g1 = gt[1], g2 = gt[2];
#elif defined(NSA_ZERO_SEL)
    const float g0 = gt[0], g1 = 0.f, g2 = gt[2];
#elif defined(NSA_ZERO_WIN)
    const float g0 = gt[0], g1 = gt[1], g2 = 0.f;
#elif defined(NSA_ZERO_ALL)
    const float g0 = 0.f, g1 = 0.f, g2 = 0.f;
#else
    const float g0 = gt[0], g1 = gt[1], g2 = gt[2];
#endif
    f32x16 o[2];
    const int nv = (t >= 31) ? ((t - 31) >> 4) + 1 : 0, nvw = (tw0 + 7 >= 31) ? ((tw0 + 7 - 31) >> 4) + 1 : 0, nvmin = (tw0 >= 31) ? ((tw0 - 31) >> 4) + 1 : 0;
    const int nct = (4 * qi + 3 + 63) >> 6;
    const unsigned char* Kc = dob + DO_KCMP + (size_t)(b * 2 + g) * 65536; const unsigned char* Vc = dob + DO_VCMP + (size_t)(b * 2 + g) * 65536;
#if defined(NSA_SPIN)
    unsigned long long tsp = __builtin_amdgcn_s_memrealtime();
#define NSPIN(k) do { if (NSA_SPIN == (k)) { const unsigned long long t1_ = __builtin_amdgcn_s_memrealtime(), dt_ = t1_ - tsp; while (__builtin_amdgcn_s_memrealtime() - t1_ < dt_) __builtin_amdgcn_s_sleep(4); } tsp = __builtin_amdgcn_s_memrealtime(); } while (0)
#else
#define NSPIN(k) do { } while (0)
#endif
    float m = NEGBIG, l = 0.f;
    nsa_branch<0>(F, Kc, Vc, 0, nct, qr, m, l, o, t, tw0, nv, nvw, nvmin, 0u, 0u, 0u, 0u, 0u, 0u, 0u, 0u, 0.f, impw);
    { const float lt = l + __shfl_xor(l, 32); const float cinit = (lt > 0.f) ? -__log2f(lt) - m : -1e30f;
#pragma unroll
      for (int r = 0; r < 16; ++r) { o[0][r] = 0.f; o[1][r] = 0.f; }
      nsa_branch<1>(F, Kc, Vc, 0, nct, qr, m, l, o, t, tw0, nv, nvw, nvmin, 0u, 0u, 0u, 0u, 0u, 0u, 0u, 0u, cinit, impw);
#pragma unroll
      for (int r = 0; r < 16; ++r) { oaccw[r * 64] = g0 * o[0][r]; oaccw[(16 + r) * 64] = g0 * o[1][r]; } }
    __syncthreads();
    NSPIN(1);
#pragma unroll 1
    for (int tl = 0; tl < 8; ++tl) {
        const int tt = tw0 + tl, cur = tt >> 6, j0 = F.lane, j1 = F.lane + 64;
        const unsigned u0 = (j0 <= cur) ? (__float_as_uint(impw[tl * 128 + j0] + ((j0 == 0 || j0 == cur || j0 == cur - 1) ? 1e4f : 0.f)) + 1u) : 0u;
        const unsigned u1 = (j1 <= cur) ? (__float_as_uint(impw[tl * 128 + j1] + ((j1 == cur || j1 == cur - 1) ? 1e4f : 0.f)) + 1u) : 0u;
        bool s0, s1;
        if (cur < 16) { s0 = (j0 <= cur); s1 = false; }
        else {
            unsigned T = 0u;
#pragma unroll 1
            for (int bit = 31; bit >= 0; --bit) {
                const unsigned cand = T | (1u << bit);
                const int c = __popcll(__ballot(u0 >= cand)) + __popcll(__ballot(u1 >= cand));
                if (c >= 16) T = cand;
            }
            const unsigned long long g0 = __ballot(u0 > T), g1 = __ballot(u1 > T), e0 = __ballot(u0 == T), e1 = __ballot(u1 == T);
            const int need = 16 - (__popcll(g0) + __popcll(g1));
            const unsigned long long below = (F.lane == 0) ? 0ull : (~0ull >> (64 - F.lane));
            const int rank0 = __popcll(e0 & below), rank1 = __popcll(e0) + __popcll(e1 & below);
            s0 = (u0 > T) || (u0 == T && rank0 < need);
            s1 = (u1 > T) || (u1 == T && rank1 < need);
        }
        const unsigned long long m0 = __ballot(s0), m1 = __ballot(s1);
        if (F.lane == 0) { selm[tl * 4 + 0] = (unsigned)m0; selm[tl * 4 + 1] = (unsigned)(m0 >> 32); selm[tl * 4 + 2] = (unsigned)m1; selm[tl * 4 + 3] = (unsigned)(m1 >> 32); }
    }
    __syncthreads();
    const unsigned mk0 = selm[tokl * 4 + 0], mk1 = selm[tokl * 4 + 1], mk2 = selm[tokl * 4 + 2], mk3 = selm[tokl * 4 + 3];
    unsigned wo0 = 0u, wo1 = 0u, wo2 = 0u, wo3 = 0u;
#pragma unroll
    for (int tl = 0; tl < 8; ++tl) { wo0 |= selm[tl * 4 + 0]; wo1 |= selm[tl * 4 + 1]; wo2 |= selm[tl * 4 + 2]; wo3 |= selm[tl * 4 + 3]; }
    wo0 = __builtin_amdgcn_readfirstlane(wo0); wo1 = __builtin_amdgcn_readfirstlane(wo1); wo2 = __builtin_amdgcn_readfirstlane(wo2); wo3 = __builtin_amdgcn_readfirstlane(wo3);
    NSPIN(2);
    { m = NEGBIG; l = 0.f;
#pragma unroll
      for (int r = 0; r < 16; ++r) { o[0][r] = 0.f; o[1][r] = 0.f; }
      nsa_branch<2>(F, dob + DO_KSEL + img, dob + DO_VSEL + img, 0, qi + 1, qr, m, l, o, t, tw0, nv, nvw, nvmin, mk0, mk1, mk2, mk3, wo0, wo1, wo2, wo3, 0.f, impw);
      const float lt = l + __shfl_xor(l, 32); const float sc = (lt > 0.f) ? g1 / lt : 0.f;
#pragma unroll
      for (int r = 0; r < 16; ++r) { oaccw[r * 64] += sc * o[0][r]; oaccw[(16 + r) * 64] += sc * o[1][r]; } }
    NSPIN(3);
    { m = NEGBIG; l = 0.f;
#pragma unroll
      for (int r = 0; r < 16; ++r) { o[0][r] = 0.f; o[1][r] = 0.f; }
      nsa_branch<3>(F, dob + DO_KWIN + img, dob + DO_VWIN + img, (qi >= 8) ? qi - 8 : 0, qi + 1, qr, m, l, o, t, tw0, nv, nvw, nvmin, 0u, 0u, 0u, 0u, 0u, 0u, 0u, 0u, 0.f, impw);
      const float lt = l + __shfl_xor(l, 32); const float sc = (lt > 0.f) ? g2 / lt : 0.f;
#pragma unroll
      for (int r = 0; r < 16; ++r) { o[0][r] = oaccw[r * 64] + sc * o[0][r]; o[1][r] = oaccw[(16 + r) * 64] + sc * o[1][r]; } }
    NSPIN(4);
    bf16* orow = (bf16*)(F.ws + WS_O + 32 * MiB) + ((size_t)b * SEQ + t) * DM + 512 + (g * 4 + hh) * 64;
#pragma unroll
    for (int dh = 0; dh < 2; ++dh)
#pragma unroll
        for (int rg = 0; rg < 4; ++rg) { v2u w; w.x = pk2(o[dh][4 * rg], o[dh][4 * rg + 1]); w.y = pk2(o[dh][4 * rg + 2], o[dh][4 * rg + 3]);
            *(v2u*)(orow + 32 * dh + 8 * rg + 4 * hi) = w; }
    __syncthreads();
}

__device__ __forceinline__ void sgu_item(Frame& F, int item) {
    const int gg = item & 7, ck = (item >> 3) & 63, b = item >> 9;
    const size_t tok0 = (size_t)b * SEQ + ck * 128;
    const bf16* Z = (const bf16*)(F.ws + WS_A);
    constexpr int RS = 544, BS = 136;
    LAS bf16* Ws = (LAS bf16*)(F.lds + RING_OFF);
    LAS unsigned char* Vs = F.lds + RING_OFF + 34816;
    LAS float* rs = (LAS float*)(F.lds + RING_OFF + 34816 + 128 * RS);
    if (F.tid < 128) { const float* st = (const float*)(F.ws + WS_STATS) + (tok0 + F.tid) * 32; float sum = 0.f;
#pragma unroll
        for (int k = 0; k < 32; k += 4) { const f32x4 v = *(const f32x4*)(st + k); sum += (v.x + v.y) + (v.z + v.w); }
        rs[F.tid] = 1.0f / sqrtf(sum * (1.0f / SGW) + NORM_EPS); }
    { const float* wsrc = F.sgu_ws + (size_t)gg * 128 * 128;
#pragma unroll
      for (int k = 0; k < 8; ++k) { const int p = F.tid + 512 * k, tr = p >> 5, sc = (p & 31) * 4; const f32x4 w = *(const f32x4*)(wsrc + tr * 128 + sc);
          v2u o; o.x = pk2((sc <= tr) ? w.x : 0.f, (sc + 1 <= tr) ? w.y : 0.f); o.y = pk2((sc + 2 <= tr) ? w.z : 0.f, (sc + 3 <= tr) ? w.w : 0.f);
          *(LAS v2u*)(Ws + tr * 136 + sc) = o; } }
    __syncthreads();
    { const int cc = F.tid & 31; float gn[8];
#pragma unroll
      for (int i = 0; i < 8; ++i) gn[i] = F.sgu_ng[gg * 256 + cc * 8 + i];
      v4u zr[8];
#pragma unroll
      for (int k = 0; k < 8; ++k) { const int sidx = (F.tid >> 5) + 16 * k; zr[k] = *(const v4u*)(Z + (tok0 + sidx) * 4096 + 2048 + gg * 256 + cc * 8); }
#pragma unroll
      for (int k = 0; k < 8; ++k) { const int sidx = (F.tid >> 5) + 16 * k; float x[8]; unpack8(zr[k], x); const float rr = rs[sidx];
#pragma unroll
          for (int i = 0; i < 8; ++i) x[i] *= rr * gn[i];
          const v4u o = pack8(x); LAS unsigned char* dst = Vs + sidx * RS + (cc >> 3) * BS + (cc & 7) * 16;
          *(LAS v2u*)dst = (v2u){o.x, o.y}; *(LAS v2u*)(dst + 8) = (v2u){o.z, o.w}; } }
    __syncthreads();
    f32x4 acc[16];
#pragma unroll
    for (int nt = 0; nt < 16; ++nt) acc[nt] = (f32x4){0.f, 0.f, 0.f, 0.f};
    const int ksteps = (16 * F.wave + 16 + 31) >> 5;
    const LAS bf16* wp = Ws + (16 * F.wave + (F.lane & 15)) * 136 + (F.lane >> 4) * 8;
    const LAS unsigned char* vp = Vs + (8 * (F.lane >> 4) + ((F.lane & 15) >> 2)) * RS + (F.lane & 3) * BS;
#pragma unroll 1
    for (int kk = 0; kk < ksteps; ++kk) {
        const bf16x8 wf = *(const LAS bf16x8*)(wp + kk * 32);
        const LAS unsigned char* vk = vp + kk * 32 * RS;
#pragma unroll
        for (int nt = 0; nt < 16; ++nt) {
            const s16x4 lo = ds_tr16(vk + 8 * nt), hi4 = ds_tr16(vk + 4 * RS + 8 * nt);
            const bf16x8 vf = {lo[0], lo[1], lo[2], lo[3], hi4[0], hi4[1], hi4[2], hi4[3]};
            acc[nt] = __builtin_amdgcn_mfma_f32_16x16x32_bf16(vf, wf, acc[nt], 0, 0, 0);
        }
    }
    { const int tr = 16 * F.wave + (F.lane & 15), g = F.lane >> 4; const float bs = F.sgu_bs[gg * 128 + tr];
      const bf16* urow = Z + (tok0 + tr) * 4096 + gg * 256 + 64 * g; bf16* orow = (bf16*)(F.ws + WS_O) + (tok0 + tr) * SGW + gg * 256 + 64 * g;
#pragma unroll
      for (int j = 0; j < 8; ++j) { float u[8]; unpack8(*(const v4u*)(urow + 8 * j), u);
#pragma unroll
          for (int i = 0; i < 4; ++i) { u[i] *= acc[2 * j][i] + bs; u[4 + i] *= acc[2 * j + 1][i] + bs; }
          *(v4u*)(orow + 8 * j) = pack8(u); } }
    __syncthreads();
}

constexpr int NPHASE = 18;
struct Args { const void* in[26]; float* out; unsigned char* ws; int ph_lo, ph_hi, use_bar, pad; };
__global__ void __launch_bounds__(512, 2) trunk_fwd(Args args) {
    extern __shared__ __attribute__((aligned(16))) unsigned char lds[];
    Frame F;
    F.lds = (LAS unsigned char*)lds;
    F.MISC = (volatile LAS unsigned*)(F.lds + MISC_OFF);
    F.tid = threadIdx.x; F.lane = F.tid & 63; F.wave = __builtin_amdgcn_readfirstlane(F.tid >> 6);
    F.G = gridDim.x; F.bid = blockIdx.x;
    F.ws = args.ws; F.out = args.out; F.dout_b = (unsigned char*)args.out;
    F.ctl = (gu32*)(args.ws + WS_CTL);
    F.x = (const float*)args.in[0]; F.c = (const float*)args.in[1]; F.positions = (const int*)args.in[2]; F.w_ada = (const float*)args.in[3]; F.b_ada = (const float*)args.in[4];
    F.norm_g = (const float*)args.in[5]; F.w_in_ab = (const float*)args.in[6]; F.w_out_ab = (const float*)args.in[7]; F.gla_w2 = (const float*)args.in[8]; F.gla_bg = (const float*)args.in[9];
    F.gla_ng = (const float*)args.in[10]; F.q_gain = (const float*)args.in[11]; F.k_gain = (const float*)args.in[12]; F.cmp_pe = (const float*)args.in[13]; F.cmp_w1 = (const float*)args.in[14];
    F.cmp_w2 = (const float*)args.in[15]; F.w_in_c = (const float*)args.in[16]; F.sgu_ng = (const float*)args.in[17]; F.sgu_ws = (const float*)args.in[18]; F.sgu_bs = (const float*)args.in[19];
    F.w_out_c = (const float*)args.in[20]; F.w_router = (const float*)args.in[21]; F.r_bias = (const float*)args.in[22]; F.w_gate = (const float*)args.in[23]; F.w_up = (const float*)args.in[24];
    F.w_down = (const float*)args.in[25];
    for (int u = F.tid; u < (LDS_BYTES - LDSCTL_OFF) / 4; u += 512) ((LAS unsigned*)(F.lds + LDSCTL_OFF))[u] = 0u;
    __syncthreads();
    XcdBarrier bar; bar.bar = (unsigned*)(F.ctl + CW_BAR); bar.x = 0; bar.st = nullptr;
    if (args.use_bar) bar = xcd_barrier_post((unsigned*)(F.ctl + CW_BAR) + (args.use_bar - 1) * XCD_BAR_WORDS, F.MISC + 8);
    const int lo = args.ph_lo, hi = args.ph_hi;
#ifndef PH_MASK
#define PH_MASK 0x3FFFFu
#endif
#define IN(k) ((((PH_MASK) >> (k)) & 1u) && lo <= (k) && (k) < hi)
#if defined(SPIN_PHASE)
    unsigned long long t_mark = __builtin_amdgcn_s_memrealtime();
#define SPIN_HOOK(k) do { if ((k) == (SPIN_PHASE)) { const unsigned long long t1_ = __builtin_amdgcn_s_memrealtime(), dt_ = t1_ - t_mark; while (__builtin_amdgcn_s_memrealtime() - t1_ < dt_) __builtin_amdgcn_s_sleep(4); } } while (0)
#define SPIN_MARK() do { t_mark = __builtin_amdgcn_s_memrealtime(); } while (0)
#else
#define SPIN_HOOK(k) do { } while (0)
#define SPIN_MARK() do { } while (0)
#endif
#define SEAM(k) do { if (IN(k)) SPIN_HOOK(k); if (IN(k) && IN((k) + 1)) xcd_barrier(bar); SPIN_MARK(); } while (0)
    float* mod = (float*)(F.ws + WS_MOD);
    bf16* Hb = (bf16*)(F.ws + WS_O);
    bf16* Ab = (bf16*)(F.ws + WS_A);

    if (IN(0)) { p0_prologue(F); } SEAM(0);
    if (IN(1)) { row_pass<false, true, false>(F, F.x, mod, 0, F.norm_g, mod, 0, 0); } SEAM(1);
    if (IN(2)) { pg8::Gemm g{Hb, (const bf16*)(F.ws + WS_WIN), NTOK, NPROJ, DM}; pg8::StaticOrder S; S.init(NTOK, NPROJ, F.G, F.bid);
        pg8::EpiBf16<0> E{Ab, NPROJ, nullptr, 0, 0, 1.f};
        pg8::gemm_phase<pg8::EpiBf16<0>, pg8::StaticOrder, true, true>(F.lds + RING_OFF, g, S, E); } SEAM(2);
    if (IN(3)) {
        for (int it = F.bid; it < 1024; it += F.G) gla_prep_item(F, it);
        for (int tok = F.bid * 8 + F.wave; tok < NTOK; tok += F.G * 8) nsa_prep_token(F, tok);
    } SEAM(3);
    if (IN(4)) {
        const int half = F.G >> 1;
        if (F.bid < half) { for (int it = F.bid; it < 128; it += half) nsa_compress_item(F, it); }
        else { for (int gi = (F.bid - half) * 512 + F.tid; gi < 65536; gi += (F.G - half) * 512) gla_scan(F, gi); }
    } SEAM(4);
    if (IN(5)) {
#ifndef NO_NSA
        for (int p = F.bid; p < 256; p += F.G) { const int bg = p >> 6, i = p & 63; nsa_item(F, bg >> 1, bg & 1, i); nsa_item(F, bg >> 1, bg & 1, 127 - i); }
#endif
#ifndef NO_GLAOUT
#if defined(GLA_SPIN)
        { const unsigned long long tg0 = __builtin_amdgcn_s_memrealtime();
#endif
        for (int it = F.bid; it < 1024; it += F.G) gla_out_item(F, it);
#if defined(GLA_SPIN)
          const unsigned long long t1_ = __builtin_amdgcn_s_memrealtime(), dt_ = t1_ - tg0; while (__builtin_amdgcn_s_memrealtime() - t1_ < dt_) __builtin_amdgcn_s_sleep(4); }
#endif
#endif
    } SEAM(5);
    if (IN(6)) { pg8::Gemm g{(const bf16*)(F.ws + WS_O + 32 * MiB), (const bf16*)(F.ws + WS_WOUT), NTOK, DM, DM}; pg8::StaticOrder S; S.init(NTOK, DM, F.G, F.bid);
        EpiResid E{F.x, F.out, mod + 2 * 1024};
        pg8::gemm_phase<EpiResid, pg8::StaticOrder, true, true>(F.lds + RING_OFF, g, S, E); } SEAM(6);
#define MOE_BLOCK(P, LAYER) \
    if (IN(P)) { row_pass<false, true, true>(F, F.out, mod + (LAYER) * 2 * 6144, 3 * 1024, F.norm_g + ((LAYER) * 2 + 1) * 1024, mod, (LAYER), 0); } SEAM(P); \
    if (IN((P) + 1)) { moe_tables(F, (LAYER)); MoeOrder S{(const LAS int*)(F.lds + TAB_OFF), F.G, F.bid}; \
        { LAS unsigned* rofs = (LAS unsigned*)(F.lds + TAB_OFF + 2048); const int* elist = (const int*)(F.ws + WS_STATS); pg8::Unit uu; \
          for (int ui = 0; ui < 3; ++ui) if (S.next(ui, uu)) { if (F.tid < 256) rofs[ui * 256 + F.tid] = S.row_off(uu, F.tid, elist); } \
          __syncthreads(); } \
        pg8::Gemm g{Hb, (const bf16*)(F.ws + WS_WGU) + (size_t)(LAYER) * 16 * 1024 * 1024, MOE_ROWS, 1024, DM}; EpiMoeGU E{(bf16*)(F.ws + WS_A + A_HID_OFF)}; \
        pg8::gemm_phase_gather<EpiMoeGU, MoeOrder>(F.lds + RING_OFF, g, S, E, (const LAS unsigned*)(F.lds + TAB_OFF + 2048)); } SEAM((P) + 1); \
    if (IN((P) + 2)) { moe_tables(F, (LAYER)); MoeOrder S{(const LAS int*)(F.lds + TAB_OFF), F.G, F.bid}; \
        pg8::Gemm g{(const bf16*)(F.ws + WS_A + A_HID_OFF), (const bf16*)(F.ws + WS_WDN) + (size_t)(LAYER) * 16 * 1024 * 512, MOE_ROWS, 1024, EHID}; EpiMoeDn E{Ab}; \
        pg8::gemm_phase<EpiMoeDn, MoeOrder, true, true>(F.lds + RING_OFF, g, S, E); } SEAM((P) + 2);
    MOE_BLOCK(7, 0)
    if (IN(10)) { row_pass<true, true, false>(F, F.out, mod + 2 * 6144, 0, F.norm_g + 2 * 1024, mod, 1, 0); } SEAM(10);
    if (IN(11)) { pg8::Gemm g{Hb, (const bf16*)(F.ws + WS_WINC), NTOK, 4096, DM}; pg8::StaticOrder S; S.init(NTOK, 4096, F.G, F.bid);
        EpiGeluStats E{Ab, (float*)(F.ws + WS_STATS)};
        pg8::gemm_phase<EpiGeluStats, pg8::StaticOrder, true, true>(F.lds + RING_OFF, g, S, E); } SEAM(11);
    if (IN(12)) { for (int it = F.bid; it < 1024; it += F.G) sgu_item(F, it); } SEAM(12);
    if (IN(13)) { pg8::Gemm g{Hb, (const bf16*)(F.ws + WS_WOUTC), NTOK, DM, SGW}; pg8::StaticOrder S; S.init(NTOK, DM, F.G, F.bid);
        EpiResid E{F.out, F.out, mod + 2 * 6144 + 2 * 1024};
        pg8::gemm_phase<EpiResid, pg8::StaticOrder, true, true>(F.lds + RING_OFF, g, S, E); } SEAM(13);
    MOE_BLOCK(14, 1)
    if (IN(17)) { row_pass<true, false, false>(F, F.out, mod, 0, F.norm_g, mod + 2 * 6144, 1, 1); SPIN_HOOK(17); }
#undef IN
#undef SEAM
#undef MOE_BLOCK
}

#ifndef MK_N_LAUNCHES
#define MK_N_LAUNCHES 1
#endif
extern "C" void kernel_launch(void* const* d_in, const int* in_sizes, int n_in, void* d_out, int out_size, void* d_ws, size_t ws_size, hipStream_t stream) {
    static int grid = 0;
    if (grid == 0) {
        if (n_in != 26 || out_size != NTOK * DM || ws_size < WS_END) { fprintf(stderr, "kernel_launch: unexpected problem shape / workspace (%d inputs, out %d, ws %zu)\n", n_in, out_size, ws_size); grid = -1; return; }
        int dev = 0, cus = 0, per_cu = 0;
        if (hipGetDevice(&dev) != hipSuccess || hipDeviceGetAttribute(&cus, hipDeviceAttributeMultiprocessorCount, dev) != hipSuccess) { grid = -1; return; }
        if (hipFuncSetAttribute((const void*)trunk_fwd, hipFuncAttributeMaxDynamicSharedMemorySize, LDS_BYTES) != hipSuccess) { fprintf(stderr, "kernel_launch: hipFuncSetAttribute failed\n"); grid = -1; return; }
        if (hipOccupancyMaxActiveBlocksPerMultiprocessor(&per_cu, (const void*)trunk_fwd, 512, LDS_BYTES) != hipSuccess || per_cu < 1) { fprintf(stderr, "kernel_launch: occupancy query says %d blocks per CU\n", per_cu); }
        (void)hipGetLastError();
        grid = cus;
        if (grid != 256) { fprintf(stderr, "kernel_launch: built for a 256-CU device, found %d CUs\n", cus); grid = -1; return; }
    }
    if (grid < 0) return;
    (void)hipMemsetAsync((char*)d_ws + WS_CTL, 0, CTL_ZERO_BYTES, stream);
    Args a{};
    for (int i = 0; i < 26; ++i) a.in[i] = d_in[i];
    a.out = (float*)d_out; a.ws = (unsigned char*)d_ws; a.pad = 0;
    if (MK_N_LAUNCHES == 1) {
#if defined(REP_PHASE)
        a.ph_lo = 0; a.ph_hi = REP_PHASE + 1; a.use_bar = 1;
        hipLaunchKernelGGL(trunk_fwd, dim3(grid), dim3(512), LDS_BYTES, stream, a);
        a.ph_lo = REP_PHASE; a.ph_hi = NPHASE; a.use_bar = 2;
        hipLaunchKernelGGL(trunk_fwd, dim3(grid), dim3(512), LDS_BYTES, stream, a);
#else
        a.ph_lo = 0; a.ph_hi = NPHASE; a.use_bar = 1;
        hipLaunchKernelGGL(trunk_fwd, dim3(grid), dim3(512), LDS_BYTES, stream, a);
#endif
    } else {
        for (int p = 0; p < NPHASE; ++p) { a.ph_lo = p; a.ph_hi = p + 1; a.use_bar = 0; hipLaunchKernelGGL(trunk_fwd, dim3(grid), dim3(512), LDS_BYTES, stream, a); }
    }
}
```

```cpp
#include <hip/hip_runtime.h>
#include <cstdio>
#include <cstdint>
namespace pg8 {
#define PG8_LAS __attribute__((address_space(3)))
typedef unsigned short bf16_t;
typedef short bf16x8 __attribute__((ext_vector_type(8)));
typedef float f32x4 __attribute__((ext_vector_type(4)));
typedef unsigned u32x4 __attribute__((ext_vector_type(4)));
constexpr int BM = 256, BK = 64, HALF = 128, HTB = HALF * BK * 2  , STAGE_BYTES = 8 * HTB, NXCD = 8, WGM = 8;

__host__ __device__ __forceinline__ int lds_byte(int r, int c) { const int st = (r >> 4) * 2 + (c >> 5), rr = r & 15, cc = c & 31, ob = rr * 64 + cc * 2; return st * 1024 + (ob ^ (((ob >> 9) & 1) << 5)); }
__host__ __device__ __forceinline__ void stage_rc(int b, int& R, int& C) { const int st = b / 1024, sb = b % 1024, swz = sb ^ (((sb >> 9) & 1) << 5); R = (st >> 1) * 16 + swz / 64; C = (st & 1) * 32 + (swz % 64) / 2; }
__host__ __device__ __forceinline__ int perm32(int rho) { const int n = rho >> 4, i = rho & 15; return 8 * (i >> 2) + 4 * n + (i & 3); }

struct Unit { int pm, pn; };
struct Gemm { const bf16_t* A; const bf16_t* Bt; int M, N, K; };

struct StaticOrder {
    int nM, nN, nwg, G, c;
    __host__ __device__ void init(int M, int N, int G_, int c_) { nM = M / BM; nN = N / BM; nwg = nM * nN; G = G_; c = c_; }
    __host__ __device__ bool next(int i, Unit& u) const {
        const long L = (long)i * G + c; if (L >= nwg) return false;
        int wgid = (int)L; { const int q = nwg / NXCD, r = nwg % NXCD, xcd = wgid % NXCD, off = wgid / NXCD; wgid = (xcd < r ? xcd * (q + 1) : r * (q + 1) + (xcd - r) * q) + off; }
        const int nig = WGM * nN, gid = wgid / nig, fm = gid * WGM, gsz = (nM - fm) < WGM ? (nM - fm) : WGM;
        u.pm = fm + ((wgid % nig) % gsz); u.pn = (wgid % nig) / gsz; return true;
    }
    __device__ __forceinline__ void a_ready(const Unit&) const {}
    __device__ __forceinline__ void done(const Unit&) const {}
};

__device__ __forceinline__ unsigned cvt_pk_bf16(float lo, float hi) { unsigned r; asm volatile("v_cvt_pk_bf16_f32 %0, %1, %2" : "=v"(r) : "v"(lo), "v"(hi)); return r; }
typedef float f32x2 __attribute__((ext_vector_type(2)));
__device__ __forceinline__ f32x2 gelu_pk(f32x2 v) {
    const f32x2 av = __builtin_elementwise_abs(v), d = av * 0.2316418882f + 1.0f;
    f32x2 t; t.x = __builtin_amdgcn_rcpf(d.x); t.y = __builtin_amdgcn_rcpf(d.y);
    f32x2 q = t * 0.5307027145f + (-0.7265760135f); q = q * t + 0.7107068705f; q = q * t + (-0.142248368f); q = q * t + 0.127414796f; q = q * t;
    const f32x2 s = (v * v) * (-0.72134752044f);
    f32x2 e; e.x = __builtin_amdgcn_exp2f(s.x); e.y = __builtin_amdgcn_exp2f(s.y);
    const f32x2 m = v * (q * e), r = v - m;
    f32x2 o; o.x = v.x < 0.f ? m.x : r.x; o.y = v.y < 0.f ? m.y : r.y; return o;
}

template <int ACT  > struct EpiBf16 {
    static constexpr bool PERM = true, AFTER_DRAIN = false; static_assert(ACT == 0 || ACT == 1, "EpiBf16: ACT is 0 (none) or 1 (gelu_pk)");
    bf16_t* O; int ldc; const float* bias; int split_cols; size_t split_stride; float scale0;
    __device__ __forceinline__ void operator()(const f32x4 (&acc)[2][2][4][2], const Unit& u, int wr, int wc, int fr, int fq) const {
        const int row0 = u.pm * BM + wr * 64 + fr; int colt = u.pn * BM; bf16_t* base = O;
        float sc = 1.f; if (split_cols) { const int t = colt / split_cols; base += (size_t)t * split_stride; colt -= t * split_cols; if (t == 0) sc = scale0; }
        const int col0 = colt + wc * 32 + 8 * fq, bcol0 = u.pn * BM + wc * 32 + 8 * fq;
        f32x4 bv[2][2];
#pragma unroll
        for (int bj = 0; bj < 2; ++bj)
#pragma unroll
            for (int n = 0; n < 2; ++n) bv[bj][n] = bias ? *(const f32x4*)(bias + bcol0 + bj * HALF + 4 * n) : (f32x4){0.f, 0.f, 0.f, 0.f};
#pragma unroll
        for (int ai = 0; ai < 2; ++ai)
#pragma unroll
            for (int m = 0; m < 4; ++m) { bf16_t* rowp = base + (size_t)(row0 + ai * HALF + m * 16) * ldc + col0;
#pragma unroll
                for (int bj = 0; bj < 2; ++bj) { f32x4 v0 = acc[ai][bj][m][0] + bv[bj][0], v1 = acc[ai][bj][m][1] + bv[bj][1];
                    if (ACT == 1) { f32x2 a = gelu_pk((f32x2){v0[0], v0[1]}), b = gelu_pk((f32x2){v0[2], v0[3]}), c = gelu_pk((f32x2){v1[0], v1[1]}), d = gelu_pk((f32x2){v1[2], v1[3]});
                        v0 = (f32x4){a.x, a.y, b.x, b.y}; v1 = (f32x4){c.x, c.y, d.x, d.y}; }
                    v0 = v0 * sc; v1 = v1 * sc; u32x4 w; w.x = cvt_pk_bf16(v0[0], v0[1]); w.y = cvt_pk_bf16(v0[2], v0[3]); w.z = cvt_pk_bf16(v1[0], v1[1]); w.w = cvt_pk_bf16(v1[2], v1[3]);
                    *(u32x4*)(rowp + bj * HALF) = w; } }
    }
};

template <class Epi, class Sched, bool ALIGN_EPI = false, bool SP2 = false>
__device__ __forceinline__ void gemm_phase(PG8_LAS unsigned char* lds, const Gemm g, const Sched& S, const Epi& E) {
    const int tid = threadIdx.x, wid = __builtin_amdgcn_readfirstlane(tid >> 6), lane = tid & 63, wr = wid >> 2, wc = wid & 3, fr = lane & 15, fq = lane >> 4;
    const int K = g.K, nt = K / BK;
    unsigned voffA[2], voffB[2];
#pragma unroll
    for (int i = 0; i < 2; ++i) { int R, C; stage_rc(tid * 16 + i * 8192, R, C); const int Rb = Epi::PERM ? ((R & ~31) + perm32(R & 31)) : R;
        voffA[i] = (unsigned)(R * K + C) * 2u; voffB[i] = (unsigned)(Rb * K + C) * 2u; }
    const size_t kstep = (size_t)(BK * 2);
    const size_t hstep = (size_t)HALF * K * 2;
    const size_t tstep = 2 * hstep;
    const unsigned ldsw = (unsigned)wid * 1024u;
    const int aoff = lds_byte(wr * 64 + fr, fq * 8), boff = lds_byte(wc * 32 + fr, fq * 8);
#define PG8_SA(b, h) (((b) * 2 + (h)) * HTB)
#define PG8_SB(b, h) ((4 + (b) * 2 + (h)) * HTB)
#define PG8_STAGE(bufoff, gbase, voff) do { _Pragma("unroll") for (int _i = 0; _i < 2; ++_i) \
        __builtin_amdgcn_global_load_lds((const unsigned*)((const char*)(gbase) + (voff)[_i]), (PG8_LAS unsigned*)(lds + (bufoff) + ldsw + _i * 8192), 16, 0, 0); } while (0)
#define PG8_LDA(dst, b, h) do { _Pragma("unroll") for (int m = 0; m < 4; ++m) _Pragma("unroll") for (int k = 0; k < 2; ++k) dst[m][k] = *(const PG8_LAS bf16x8*)(lds + PG8_SA(b, h) + aoff + m * 2048 + k * 1024); } while (0)
#define PG8_LDB(dst, b, h) do { _Pragma("unroll") for (int n = 0; n < 2; ++n) _Pragma("unroll") for (int k = 0; k < 2; ++k) dst[n][k] = *(const PG8_LAS bf16x8*)(lds + PG8_SB(b, h) + boff + n * 2048 + k * 1024); } while (0)
#define PG8_MMA(ai, bj, At, Bt) do { __builtin_amdgcn_s_setprio(1); _Pragma("unroll") for (int m = 0; m < 4; ++m) _Pragma("unroll") for (int n = 0; n < 2; ++n) _Pragma("unroll") for (int k = 0; k < 2; ++k) \
        acc[ai][bj][m][n] = __builtin_amdgcn_mfma_f32_16x16x32_bf16(Bt[n][k], At[m][k], acc[ai][bj][m][n], 0, 0, 0); __builtin_amdgcn_s_setprio(0); } while (0)
#define PG8_WAIT_V(n) asm volatile("s_waitcnt vmcnt(" #n ")" ::: "memory")
#define PG8_WAIT_L(n) asm volatile("s_waitcnt lgkmcnt(" #n ")" ::: "memory")
#define PG8_BAR __builtin_amdgcn_s_barrier()
#define PG8_SCHED __builtin_amdgcn_sched_barrier(0)
    Unit cur, nxt; int ui = 0;
    if (!S.next(0, cur)) return;
    f32x4 acc[2][2][4][2];
#pragma unroll
    for (int a = 0; a < 2; ++a)
#pragma unroll
        for (int b = 0; b < 2; ++b)
#pragma unroll
            for (int m = 0; m < 4; ++m)
#pragma unroll
                for (int n = 0; n < 2; ++n) acc[a][b][m][n] = (f32x4){0.f, 0.f, 0.f, 0.f};
    bf16x8 At[4][2], B0[2][2], B1[2][2];
    const char* cA = (const char*)g.A + (size_t)cur.pm * tstep; const char* cB = (const char*)g.Bt + (size_t)cur.pn * tstep;
    S.a_ready(cur);
    if constexpr (SP2) {
        PG8_STAGE(PG8_SB(0, 0), cB, voffB); PG8_STAGE(PG8_SB(0, 1), cB + hstep, voffB); PG8_STAGE(PG8_SA(0, 0), cA, voffA); PG8_STAGE(PG8_SA(0, 1), cA + hstep, voffA);
        if (wr == 1) PG8_BAR;
        PG8_WAIT_V(2); PG8_BAR;
        PG8_STAGE(PG8_SB(1, 0), cB + kstep, voffB); PG8_STAGE(PG8_SA(1, 0), cA + kstep, voffA); PG8_STAGE(PG8_SB(1, 1), cB + hstep + kstep, voffB);
        PG8_WAIT_V(6); PG8_BAR;
    } else {
        PG8_STAGE(PG8_SB(0, 0), cB, voffB); PG8_STAGE(PG8_SA(0, 0), cA, voffA); PG8_STAGE(PG8_SB(0, 1), cB + hstep, voffB); PG8_STAGE(PG8_SA(0, 1), cA + hstep, voffA);
        if (wr == 1) PG8_BAR;
        PG8_WAIT_V(4); PG8_BAR;
        PG8_STAGE(PG8_SB(1, 0), cB + kstep, voffB); PG8_STAGE(PG8_SA(1, 0), cA + kstep, voffA); PG8_STAGE(PG8_SB(1, 1), cB + hstep + kstep, voffB);
        PG8_WAIT_V(6); PG8_BAR;
    }
    for (;;) {
        const bool has_next = S.next(ui + 1, nxt);
        const char* nA = has_next ? (const char*)g.A + (size_t)nxt.pm * tstep : cA; const char* nB = has_next ? (const char*)g.Bt + (size_t)nxt.pn * tstep : cB;
        for (int t = 0; t < nt; t += 2) {
            const bool last = (t == nt - 2);
            const char* a1 = cA + (size_t)(t + 1) * kstep;
            const char* a2 = last ? nA : cA + (size_t)(t + 2) * kstep; const char* b2 = last ? nB : cB + (size_t)(t + 2) * kstep;
            const char* a3 = a2 + kstep; const char* b3 = b2 + kstep;
            if (last && has_next) S.a_ready(nxt);
            if constexpr (SP2) {
            PG8_LDB(B0, 0, 0); PG8_LDB(B1, 0, 1); PG8_SCHED; PG8_LDA(At, 0, 0); PG8_STAGE(PG8_SA(1, 1), a1 + hstep, voffA);
            PG8_WAIT_V(8); PG8_WAIT_L(0); PG8_BAR; PG8_MMA(0, 0, At, B0); PG8_MMA(0, 1, At, B1); PG8_BAR; PG8_SCHED;
            PG8_LDA(At, 0, 1); PG8_STAGE(PG8_SB(0, 0), b2, voffB); PG8_STAGE(PG8_SB(0, 1), b2 + hstep, voffB); PG8_STAGE(PG8_SA(0, 0), a2, voffA);
            PG8_WAIT_V(8); PG8_WAIT_L(0); PG8_BAR; PG8_MMA(1, 0, At, B0); PG8_MMA(1, 1, At, B1); PG8_BAR; PG8_SCHED;
            PG8_LDB(B0, 1, 0); PG8_LDB(B1, 1, 1); PG8_SCHED; PG8_LDA(At, 1, 0); PG8_STAGE(PG8_SA(0, 1), a2 + hstep, voffA);
            PG8_WAIT_V(8); PG8_WAIT_L(0); PG8_BAR; PG8_MMA(0, 0, At, B0); PG8_MMA(0, 1, At, B1); PG8_BAR; PG8_SCHED;
            PG8_LDA(At, 1, 1); PG8_STAGE(PG8_SB(1, 0), b3, voffB); PG8_STAGE(PG8_SB(1, 1), b3 + hstep, voffB); PG8_STAGE(PG8_SA(1, 0), a3, voffA);
            PG8_WAIT_V(8); PG8_WAIT_L(0); PG8_BAR; PG8_MMA(1, 0, At, B0); PG8_MMA(1, 1, At, B1); PG8_BAR; PG8_SCHED;
            } else {
            PG8_LDB(B0, 0, 0); PG8_SCHED; PG8_LDA(At, 0, 0); PG8_STAGE(PG8_SA(1, 1), a1 + hstep, voffA);
            PG8_WAIT_L(8); PG8_BAR; PG8_WAIT_L(0); PG8_MMA(0, 0, At, B0); PG8_BAR; PG8_SCHED;
            PG8_LDB(B1, 0, 1); PG8_STAGE(PG8_SB(0, 0), b2, voffB);
            PG8_BAR; PG8_WAIT_L(0); PG8_MMA(0, 1, At, B1); PG8_BAR;
            PG8_LDA(At, 0, 1); PG8_STAGE(PG8_SA(0, 0), a2, voffA);
            PG8_BAR; PG8_WAIT_L(0); PG8_MMA(1, 0, At, B0); PG8_BAR; PG8_SCHED;
            PG8_STAGE(PG8_SB(0, 1), b2 + hstep, voffB);
            PG8_WAIT_V(6); PG8_BAR; PG8_MMA(1, 1, At, B1); PG8_BAR;
            PG8_LDB(B0, 1, 0); PG8_SCHED; PG8_LDA(At, 1, 0); PG8_STAGE(PG8_SA(0, 1), a2 + hstep, voffA);
            PG8_WAIT_L(8); PG8_BAR; PG8_WAIT_L(0); PG8_MMA(0, 0, At, B0); PG8_BAR; PG8_SCHED;
            PG8_LDB(B1, 1, 1); PG8_STAGE(PG8_SB(1, 0), b3, voffB);
            PG8_BAR; PG8_WAIT_L(0); PG8_MMA(0, 1, At, B1); PG8_BAR;
            PG8_LDA(At, 1, 1); PG8_STAGE(PG8_SA(1, 0), a3, voffA);
            PG8_BAR; PG8_WAIT_L(0); PG8_MMA(1, 0, At, B0); PG8_BAR; PG8_SCHED;
            PG8_STAGE(PG8_SB(1, 1), b3 + hstep, voffB);
            PG8_WAIT_V(6); PG8_BAR; PG8_MMA(1, 1, At, B1); PG8_BAR;
            }
        }
        if constexpr (ALIGN_EPI) { if (wr == 0) PG8_BAR; }
        if constexpr (!Epi::AFTER_DRAIN) { E(acc, cur, wr, wc, fr, fq); S.done(cur); }
        if (!has_next) break;
#pragma unroll
        for (int a = 0; a < 2; ++a)
#pragma unroll
            for (int b = 0; b < 2; ++b)
#pragma unroll
                for (int m = 0; m < 4; ++m)
#pragma unroll
                    for (int n = 0; n < 2; ++n) acc[a][b][m][n] = (f32x4){0.f, 0.f, 0.f, 0.f};
        cur = nxt; cA = nA; cB = nB; ++ui;
        if constexpr (ALIGN_EPI) { if (wr == 1) PG8_BAR; }
    }
    PG8_WAIT_V(0);
    if constexpr (!ALIGN_EPI) { if (wr == 0) PG8_BAR; }
    PG8_BAR;
    if constexpr (Epi::AFTER_DRAIN) { E.fused(acc, cur, wr, wc, fr, fq, lds, wid, lane); S.done(cur); }
#undef PG8_SA
#undef PG8_SB
#undef PG8_STAGE
#undef PG8_LDA
#undef PG8_LDB
#undef PG8_MMA
#undef PG8_WAIT_V
#undef PG8_WAIT_L
#undef PG8_BAR
#undef PG8_SCHED
}
}

#ifndef PG8_SP2
#define PG8_SP2 true
#endif

namespace pg8 {
template <class Epi, class Sched>
__device__ __forceinline__ void gemm_phase_gather(PG8_LAS unsigned char* lds, const Gemm g, const Sched& S, const Epi& E, const PG8_LAS unsigned* rofs) {
    const int tid = threadIdx.x, wid = __builtin_amdgcn_readfirstlane(tid >> 6), lane = tid & 63, wr = wid >> 2, wc = wid & 3, fr = lane & 15, fq = lane >> 4;
    const int K = g.K, nt = K / BK;
    unsigned voffB[2]; int RA[2]; unsigned CA[2];
#pragma unroll
    for (int i = 0; i < 2; ++i) { int R, C; stage_rc(tid * 16 + i * 8192, R, C); const int Rb = Epi::PERM ? ((R & ~31) + perm32(R & 31)) : R;
        RA[i] = R; CA[i] = (unsigned)C * 2u; voffB[i] = (unsigned)(Rb * K + C) * 2u; }
    const size_t kstep = (size_t)(BK * 2);
    const size_t hstep = (size_t)HALF * K * 2;
    const size_t tstep = 2 * hstep;
    const unsigned ldsw = (unsigned)wid * 1024u;
    const int aoff = lds_byte(wr * 64 + fr, fq * 8), boff = lds_byte(wc * 32 + fr, fq * 8);
#define PG8_SA(b, h) (((b) * 2 + (h)) * HTB)
#define PG8_SB(b, h) ((4 + (b) * 2 + (h)) * HTB)
#define PG8_STAGE(bufoff, gbase, voff) do { _Pragma("unroll") for (int _i = 0; _i < 2; ++_i) \
        __builtin_amdgcn_global_load_lds((const unsigned*)((const char*)(gbase) + (voff)[_i]), (PG8_LAS unsigned*)(lds + (bufoff) + ldsw + _i * 8192), 16, 0, 0); } while (0)
#define PG8_STAGE_A(bufoff, koff, v0, v1) do { \
        __builtin_amdgcn_global_load_lds((const unsigned*)((const char*)g.A + (koff) + (v0)), (PG8_LAS unsigned*)(lds + (bufoff) + ldsw), 16, 0, 0); \
        __builtin_amdgcn_global_load_lds((const unsigned*)((const char*)g.A + (koff) + (v1)), (PG8_LAS unsigned*)(lds + (bufoff) + ldsw + 8192), 16, 0, 0); } while (0)
#define PG8_LDA(dst, b, h) do { _Pragma("unroll") for (int m = 0; m < 4; ++m) _Pragma("unroll") for (int k = 0; k < 2; ++k) dst[m][k] = *(const PG8_LAS bf16x8*)(lds + PG8_SA(b, h) + aoff + m * 2048 + k * 1024); } while (0)
#define PG8_LDB(dst, b, h) do { _Pragma("unroll") for (int n = 0; n < 2; ++n) _Pragma("unroll") for (int k = 0; k < 2; ++k) dst[n][k] = *(const PG8_LAS bf16x8*)(lds + PG8_SB(b, h) + boff + n * 2048 + k * 1024); } while (0)
#define PG8_MMA(ai, bj, At, Bt) do { __builtin_amdgcn_s_setprio(1); _Pragma("unroll") for (int m = 0; m < 4; ++m) _Pragma("unroll") for (int n = 0; n < 2; ++n) _Pragma("unroll") for (int k = 0; k < 2; ++k) \
        acc[ai][bj][m][n] = __builtin_amdgcn_mfma_f32_16x16x32_bf16(Bt[n][k], At[m][k], acc[ai][bj][m][n], 0, 0, 0); __builtin_amdgcn_s_setprio(0); } while (0)
#define PG8_WAIT_V(n) asm volatile("s_waitcnt vmcnt(" #n ")" ::: "memory")
#define PG8_WAIT_L(n) asm volatile("s_waitcnt lgkmcnt(" #n ")" ::: "memory")
#define PG8_BAR __builtin_amdgcn_s_barrier()
#define PG8_SCHED __builtin_amdgcn_sched_barrier(0)
    Unit cur, nxt; int ui = 0;
    if (!S.next(0, cur)) return;
    f32x4 acc[2][2][4][2];
#pragma unroll
    for (int a = 0; a < 2; ++a)
#pragma unroll
        for (int b = 0; b < 2; ++b)
#pragma unroll
            for (int m = 0; m < 4; ++m)
#pragma unroll
                for (int n = 0; n < 2; ++n) acc[a][b][m][n] = (f32x4){0.f, 0.f, 0.f, 0.f};
    bf16x8 At[4][2], B0[2][2], B1[2][2];
    const char* cB = (const char*)g.Bt + (size_t)cur.pn * tstep;
    unsigned vc00 = rofs[RA[0]] + CA[0], vc01 = rofs[RA[1]] + CA[1], vc10 = rofs[128 + RA[0]] + CA[0], vc11 = rofs[128 + RA[1]] + CA[1];
    unsigned vn00 = vc00, vn01 = vc01, vn10 = vc10, vn11 = vc11;
    PG8_WAIT_L(0);
    PG8_STAGE(PG8_SB(0, 0), cB, voffB); PG8_STAGE(PG8_SB(0, 1), cB + hstep, voffB); PG8_STAGE_A(PG8_SA(0, 0), 0, vc00, vc01); PG8_STAGE_A(PG8_SA(0, 1), 0, vc10, vc11);
    if (wr == 1) PG8_BAR;
    PG8_WAIT_V(2); PG8_BAR;
    PG8_STAGE(PG8_SB(1, 0), cB + kstep, voffB); PG8_STAGE_A(PG8_SA(1, 0), kstep, vc00, vc01); PG8_STAGE(PG8_SB(1, 1), cB + hstep + kstep, voffB);
    PG8_WAIT_V(6); PG8_BAR;
    for (;;) {
        const bool has_next = S.next(ui + 1, nxt);
        const char* nB = has_next ? (const char*)g.Bt + (size_t)nxt.pn * tstep : cB;
        if (has_next) { const PG8_LAS unsigned* rn = rofs + (ui + 1) * 256; vn00 = rn[RA[0]] + CA[0]; vn01 = rn[RA[1]] + CA[1]; vn10 = rn[128 + RA[0]] + CA[0]; vn11 = rn[128 + RA[1]] + CA[1]; }
        else { vn00 = vc00; vn01 = vc01; vn10 = vc10; vn11 = vc11; }
        for (int t = 0; t < nt; t += 2) {
            const bool last = (t == nt - 2);
            const size_t k1 = (size_t)(t + 1) * kstep;
            const size_t k2 = last ? 0 : (size_t)(t + 2) * kstep; const char* b2 = last ? nB : cB + (size_t)(t + 2) * kstep;
            const size_t k3 = k2 + kstep; const char* b3 = b2 + kstep;
            const unsigned w00 = last ? vn00 : vc00, w01 = last ? vn01 : vc01, w10 = last ? vn10 : vc10, w11 = last ? vn11 : vc11;
            PG8_LDB(B0, 0, 0); PG8_LDB(B1, 0, 1); PG8_SCHED; PG8_LDA(At, 0, 0); PG8_STAGE_A(PG8_SA(1, 1), k1, vc10, vc11);
            PG8_WAIT_V(8); PG8_WAIT_L(0); PG8_BAR; PG8_MMA(0, 0, At, B0); PG8_MMA(0, 1, At, B1); PG8_BAR; PG8_SCHED;
            PG8_LDA(At, 0, 1); PG8_STAGE(PG8_SB(0, 0), b2, voffB); PG8_STAGE(PG8_SB(0, 1), b2 + hstep, voffB); PG8_STAGE_A(PG8_SA(0, 0), k2, w00, w01);
            PG8_WAIT_V(8); PG8_WAIT_L(0); PG8_BAR; PG8_MMA(1, 0, At, B0); PG8_MMA(1, 1, At, B1); PG8_BAR; PG8_SCHED;
            PG8_LDB(B0, 1, 0); PG8_LDB(B1, 1, 1); PG8_SCHED; PG8_LDA(At, 1, 0); PG8_STAGE_A(PG8_SA(0, 1), k2, w10, w11);
            PG8_WAIT_V(8); PG8_WAIT_L(0); PG8_BAR; PG8_MMA(0, 0, At, B0); PG8_MMA(0, 1, At, B1); PG8_BAR; PG8_SCHED;
            PG8_LDA(At, 1, 1); PG8_STAGE(PG8_SB(1, 0), b3, voffB); PG8_STAGE(PG8_SB(1, 1), b3 + hstep, voffB); PG8_STAGE_A(PG8_SA(1, 0), k3, w00, w01);
            PG8_WAIT_V(8); PG8_WAIT_L(0); PG8_BAR; PG8_MMA(1, 0, At, B0); PG8_MMA(1, 1, At, B1); PG8_BAR; PG8_SCHED;
        }
        if (wr == 0) PG8_BAR;
        E(acc, cur, wr, wc, fr, fq); S.done(cur);
        if (!has_next) break;
#pragma unroll
        for (int a = 0; a < 2; ++a)
#pragma unroll
            for (int b = 0; b < 2; ++b)
#pragma unroll
                for (int m = 0; m < 4; ++m)
#pragma unroll
                    for (int n = 0; n < 2; ++n) acc[a][b][m][n] = (f32x4){0.f, 0.f, 0.f, 0.f};
        cur = nxt; cB = nB; ++ui; vc00 = vn00; vc01 = vn01; vc10 = vn10; vc11 = vn11;
        if (wr == 1) PG8_BAR;
    }
    PG8_WAIT_V(0);
    PG8_BAR;
#undef PG8_SA
#undef PG8_SB
#undef PG8_STAGE
#undef PG8_STAGE_A
#undef PG8_LDA
#undef PG8_LDB
#undef PG8_MMA
#undef PG8_WAIT_V
#undef PG8_WAIT_L
#undef PG8_BAR
#undef PG8_SCHED
}
}

constexpr int NB = 2, SEQ = 8192, DM = 1024, NTOK = NB * SEQ;
constexpr int NPROJ = 3072;
constexpr int C_GQ = 0, C_GK = 256, C_GV = 512, C_GR = 1024, C_NQ = 1536, C_KC = 2048, C_VC = 2176, C_KS = 2304, C_VS = 2432, C_KW = 2560, C_VW = 2688, C_GLR = 2816, C_NG = 2832, C_END = 2856;
constexpr int SGW = 2048;
constexpr int NEXP = 16, EHID = 512;
constexpr int MOE_ROWS = 36864;
constexpr float NORM_EPS = 1e-6f;
constexpr float NEGBIG = -1e30f;

constexpr size_t MiB = 1u << 20;
constexpr size_t WS_CTL = 0, CTL_ZERO_BYTES = 1 * MiB;
constexpr size_t WS_MOD = 1 * MiB;
constexpr size_t WS_ROUTE = 2 * MiB;
constexpr size_t WS_GATES = 3 * MiB;
constexpr size_t WS_STATS = 5 * MiB;
constexpr size_t WS_DEC = 7 * MiB;
constexpr size_t WS_WIN = 8 * MiB;
constexpr size_t WS_WOUT = 14 * MiB;
constexpr size_t WS_WINC = 16 * MiB;
constexpr size_t WS_WOUTC = 24 * MiB;
constexpr size_t WS_WCW1 = 28 * MiB;
constexpr size_t WS_WGU = 30 * MiB;
constexpr size_t WS_WDN = 94 * MiB;
constexpr size_t WS_A = 126 * MiB;
constexpr size_t WS_O = 254 * MiB;
constexpr size_t WS_END = 318 * MiB;
constexpr size_t A_HID_OFF = 72 * MiB;
constexpr size_t DO_QN = 0;
constexpr size_t DO_KSEL = 16 * MiB, DO_VSEL = 20 * MiB, DO_KWIN = 24 * MiB, DO_VWIN = 28 * MiB;
constexpr size_t DO_KC = 32 * MiB, DO_VC = 36 * MiB + 65536;
constexpr size_t DO_KCMP = 41 * MiB, DO_VCMP = 41 * MiB + 512 * 1024;

constexpr int CW_TMO = 0, CW_CODE = 1;
constexpr int CW_BAR = 4096;
constexpr int CW_CNT = 16384;

constexpr int RING_OFF = 0, RING_BYTES = 131072;
constexpr int LDSCTL_OFF = RING_BYTES, MISC_OFF = LDSCTL_OFF + 320;
constexpr int TAB_OFF = LDSCTL_OFF + 1024;
constexpr int LDS_BYTES = 147456;

#define GAS __attribute__((address_space(1)))
#define LAS __attribute__((address_space(3)))
typedef unsigned short bf16;
typedef unsigned v4u __attribute__((ext_vector_type(4)));
typedef unsigned v2u __attribute__((ext_vector_type(2)));
typedef float f32x4 __attribute__((ext_vector_type(4)));
typedef float f32x2 __attribute__((ext_vector_type(2)));
typedef float f32x16 __attribute__((ext_vector_type(16)));
typedef short bf16x8 __attribute__((ext_vector_type(8)));
typedef short s16x4 __attribute__((ext_vector_type(4)));
typedef GAS unsigned gu32;
#define RLX_AGENT __ATOMIC_RELAXED, __HIP_MEMORY_SCOPE_AGENT
#define LDS_WAIT() asm volatile("s_waitcnt lgkmcnt(0)" ::: "memory")
#define VM_WAIT() asm volatile("s_waitcnt vmcnt(0)" ::: "memory")
__device__ __forceinline__ unsigned f2bf(float f) { unsigned u = __builtin_bit_cast(unsigned, f); return (u + 0x7fffu + ((u >> 16) & 1u)) >> 16; }
__device__ __forceinline__ unsigned pk2(float lo, float hi) { return f2bf(lo) | (f2bf(hi) << 16); }
__device__ __forceinline__ float bf2f(unsigned short b) { return __builtin_bit_cast(float, (unsigned)b << 16); }
__device__ __forceinline__ float bflo(unsigned w) { return __builtin_bit_cast(float, w << 16); }
__device__ __forceinline__ float bfhi(unsigned w) { return __builtin_bit_cast(float, w & 0xffff0000u); }
__device__ __forceinline__ float fexp2(float x) { return __builtin_amdgcn_exp2f(x); }
__device__ __forceinline__ float fexp(float x) { return __builtin_amdgcn_exp2f(x * 1.4426950408889634f); }
__device__ __forceinline__ float frcp(float x) { return __builtin_amdgcn_rcpf(x); }
__device__ __forceinline__ float sigmoidf_(float x) { return frcp(1.0f + __expf(-x)); }
__device__ __forceinline__ float siluf_(float x) { return x * frcp(1.0f + __expf(-x)); }
__device__ __forceinline__ float gelu_tanh(float x) {
    const float u = 0.7978845608028654f * (x + 0.044715f * x * x * x);
    return x * frcp(1.0f + __expf(-2.0f * u));
}
__device__ __forceinline__ float wave_sum(float v) {
#pragma unroll
    for (int o = 1; o < 64; o <<= 1) v += __shfl_xor(v, o);
    return v;
}
__device__ __forceinline__ void unpack8(const v4u w, float (&f)[8]) {
    f[0] = bflo(w.x); f[1] = bfhi(w.x); f[2] = bflo(w.y); f[3] = bfhi(w.y); f[4] = bflo(w.z); f[5] = bfhi(w.z); f[6] = bflo(w.w); f[7] = bfhi(w.w);
}
__device__ __forceinline__ v4u pack8(const float (&f)[8]) { v4u w; w.x = pk2(f[0], f[1]); w.y = pk2(f[2], f[3]); w.z = pk2(f[4], f[5]); w.w = pk2(f[6], f[7]); return w; }

#define XB_TMO      128
#define XB_XCNT(j)  (256  + 64 * (j))
#define XB_XSUB(j)  (1280 + 64 * (j))
#define XB_XGEN(j)  (2304 + 64 * (j))
#define XB_TOP      3328
#define XB_TOPGEN   3392
#define XCD_BAR_WORDS 3456
#define XB_SPIN_CAP (1u << 18)

__device__ __forceinline__ unsigned xb_ld(unsigned* p)              { return __hip_atomic_load(p, __ATOMIC_RELAXED, __HIP_MEMORY_SCOPE_AGENT); }
__device__ __forceinline__ unsigned xb_add(unsigned* p, unsigned v) { return __hip_atomic_fetch_add(p, v, __ATOMIC_RELAXED, __HIP_MEMORY_SCOPE_AGENT); }
__device__ __forceinline__ unsigned xb_xcc_id() { return (unsigned)__builtin_amdgcn_s_getreg((3 << 11) | 20) & 0xFu; }
#define XB_SPIN(cond, bar) do { unsigned _sp = 0; while (cond) { __builtin_amdgcn_s_sleep(1); \
    if ((++_sp & 255u) == 0u) { if (xb_ld(&(bar)[XB_TMO])) break; if (_sp > XB_SPIN_CAP) { atomicAdd(&(bar)[XB_TMO], 1u); break; } } } } while (0)

struct XcdBarrier {
    unsigned* bar; unsigned x;
    volatile LAS unsigned* st;
};
__device__ __forceinline__ XcdBarrier xcd_barrier_post(unsigned* bar, volatile LAS unsigned* st) {
    XcdBarrier b; b.bar = bar; b.x = xb_xcc_id(); b.st = st;
    if (threadIdx.x == 0) (void)xb_add(&bar[XB_XCNT(b.x)], 1u);
    return b;
}
__device__ __forceinline__ void xcd_barrier_complete(unsigned* bar, unsigned x, unsigned& nloc, unsigned& nx) {
    const unsigned G = gridDim.x * gridDim.y * gridDim.z;
    unsigned sum, cnt, mine, sp = 0u;
    for (;;) {
        sum = 0u; cnt = 0u; mine = 0u;
#pragma unroll
        for (unsigned j = 0; j < 16; ++j) { const unsigned c = xb_ld(&bar[XB_XCNT(j)]); sum += c; cnt += (c > 0u) ? 1u : 0u; mine = (j == x) ? c : mine; }
        if (sum == G) break;
        __builtin_amdgcn_s_sleep(1);
        if ((++sp & 255u) == 0u) { if (xb_ld(&bar[XB_TMO])) break; if (sp > XB_SPIN_CAP) { atomicAdd(&bar[XB_TMO], 1u); break; } }
    }
    nloc = mine > 0u ? mine : 1u; nx = cnt > 0u ? cnt : 1u;
}
__device__ __forceinline__ void xcd_barrier(const XcdBarrier& b) {
    asm volatile("s_waitcnt vmcnt(0)" ::: "memory");
    __syncthreads();
    if (threadIdx.x == 0) {
        unsigned* bar = b.bar;
        __builtin_amdgcn_s_waitcnt(0);
        unsigned nloc = b.st[0], nx = b.st[1];
        if (nloc == 0u) { xcd_barrier_complete(bar, b.x, nloc, nx); b.st[0] = nloc; b.st[1] = nx; }
        const unsigned old = xb_add(&bar[XB_XSUB(b.x)], 1u);
        const unsigned gen = old / nloc;
        if (old + 1u == (gen + 1u) * nloc) {
            __builtin_amdgcn_fence(__ATOMIC_RELEASE, "agent");
            asm volatile("s_waitcnt vmcnt(0)" ::: "memory");
            const unsigned og = xb_add(&bar[XB_TOP], 1u);
            const unsigned tg = og / nx;
            if (og + 1u == (tg + 1u) * nx) xb_add(&bar[XB_TOPGEN], 1u);
            else XB_SPIN(xb_ld(&bar[XB_TOPGEN]) == tg, bar);
            __builtin_amdgcn_fence(__ATOMIC_ACQUIRE, "agent");
            xb_add(&bar[XB_XGEN(b.x)], 1u);
            asm volatile("s_waitcnt vmcnt(0)" ::: "memory");
        } else {
            XB_SPIN(xb_ld(&bar[XB_XGEN(b.x)]) == gen, bar);
            __builtin_amdgcn_fence(__ATOMIC_ACQUIRE, "agent");
            asm volatile("s_waitcnt vmcnt(0)" ::: "memory");
        }
    }
    __syncthreads();
}

struct Frame {
    LAS unsigned char* lds;
    volatile LAS unsigned* MISC;
    gu32* ctl;
    int tid, lane, wave;
    int bid, G;
    unsigned char* ws;
    unsigned char* dout_b;
    float* out;
    const float *x, *c, *w_ada, *b_ada, *norm_g, *w_in_ab, *w_out_ab, *gla_w2, *gla_bg, *gla_ng, *q_gain, *k_gain, *cmp_pe, *cmp_w1, *cmp_w2, *w_in_c, *sgu_ng, *sgu_ws, *sgu_bs, *w_out_c, *w_router, *r_bias, *w_gate, *w_up, *w_down;
    const int* positions;
};

struct EpiResid {
    static constexpr bool PERM = false, AFTER_DRAIN = false;
    const float* xin; float* xout; const float* gate;
    __device__ __forceinline__ void operator()(const pg8::f32x4 (&acc)[2][2][4][2], const pg8::Unit& u, int wr, int wc, int fr, int fq) const {
        const int row0 = u.pm * 256 + wr * 64 + fr, col0 = u.pn * 256 + wc * 32 + 4 * fq;
        const float* gb = gate + ((u.pm * 256 >= SEQ) ? 6144 : 0);
        f32x4 gv[2][2];
#pragma unroll
        for (int bj = 0; bj < 2; ++bj)
#pragma unroll
            for (int n = 0; n < 2; ++n) gv[bj][n] = *(const f32x4*)(gb + col0 + bj * 128 + n * 16);
#pragma unroll
        for (int ai = 0; ai < 2; ++ai)
#pragma unroll
            for (int m = 0; m < 4; ++m) {
                const size_t rb = (size_t)(row0 + ai * 128 + m * 16) * DM;
#pragma unroll
                for (int bj = 0; bj < 2; ++bj)
#pragma unroll
                    for (int n = 0; n < 2; ++n) {
                        const size_t p = rb + col0 + bj * 128 + n * 16;
                        const f32x4 xi = *(const f32x4*)(xin + p);
                        *(f32x4*)(xout + p) = xi + gv[bj][n] * acc[ai][bj][m][n];
                    }
            }
    }
};
struct EpiGeluStats {
    static constexpr bool PERM = true, AFTER_DRAIN = false;
    bf16* Z; float* stats;
    __device__ __forceinline__ void operator()(const pg8::f32x4 (&acc)[2][2][4][2], const pg8::Unit& u, int wr, int wc, int fr, int fq) const {
        const int row0 = u.pm * 256 + wr * 64 + fr, col0 = u.pn * 256 + wc * 32 + 8 * fq;
#pragma unroll
        for (int ai = 0; ai < 2; ++ai)
#pragma unroll
            for (int m = 0; m < 4; ++m) {
                const int row = row0 + ai * 128 + m * 16; float ss = 0.f;
#pragma unroll
                for (int bj = 0; bj < 2; ++bj) {
                    float g[8];
#pragma unroll
                    for (int n = 0; n < 2; ++n)
#pragma unroll
                        for (int i = 0; i < 4; ++i) { g[n * 4 + i] = gelu_tanh(acc[ai][bj][m][n][i]); ss += g[n * 4 + i] * g[n * 4 + i]; }
                    *(v4u*)(Z + (size_t)row * 4096 + col0 + bj * 128) = pack8(g);
                }
                if (u.pn >= 8) {
                    ss += __shfl_xor(ss, 16); ss += __shfl_xor(ss, 32);
                    if (fq == 0) stats[(size_t)row * 32 + (u.pn - 8) * 4 + wc] = ss;
                }
            }
    }
};
struct EpiMoeGU {
    static constexpr bool PERM = true, AFTER_DRAIN = false;
    bf16* HID;
    __device__ __forceinline__ void operator()(const pg8::f32x4 (&acc)[2][2][4][2], const pg8::Unit& u, int wr, int wc, int fr, int fq) const {
        const int row0 = u.pm * 256 + wr * 64 + fr, col0 = (u.pn & 3) * 128 + wc * 32 + 8 * fq;
#pragma unroll
        for (int ai = 0; ai < 2; ++ai)
#pragma unroll
            for (int m = 0; m < 4; ++m) {
                float h[8];
#pragma unroll
                for (int n = 0; n < 2; ++n)
#pragma unroll
                    for (int i = 0; i < 4; ++i) h[n * 4 + i] = siluf_(acc[ai][0][m][n][i]) * acc[ai][1][m][n][i];
                *(v4u*)(HID + (size_t)(row0 + ai * 128 + m * 16) * EHID + col0) = pack8(h);
            }
    }
};
struct EpiMoeDn {
    static constexpr bool PERM = true, AFTER_DRAIN = false;
    bf16* YM;
    __device__ __forceinline__ void operator()(const pg8::f32x4 (&acc)[2][2][4][2], const pg8::Unit& u, int wr, int wc, int fr, int fq) const {
        const int row0 = u.pm * 256 + wr * 64 + fr, col0 = (u.pn & 3) * 256 + wc * 32 + 8 * fq;
#pragma unroll
        for (int ai = 0; ai < 2; ++ai)
#pragma unroll
            for (int m = 0; m < 4; ++m)
#pragma unroll
                for (int bj = 0; bj < 2; ++bj) {
                    float h[8];
#pragma unroll
                    for (int n = 0; n < 2; ++n)
#pragma unroll
                        for (int i = 0; i < 4; ++i) h[n * 4 + i] = acc[ai][bj][m][n][i];
                    *(v4u*)(YM + (size_t)(row0 + ai * 128 + m * 16) * DM + col0 + bj * 128) = pack8(h);
                }
    }
};
struct MoeOrder {
    const LAS int* ppre; int G, c;
    __device__ __forceinline__ unsigned row_off(const pg8::Unit& u, int r, const int* elist) const {
        const int e = u.pn >> 2, li = (u.pm - ppre[e]) * 256 + r;
        const int tok = (li < ppre[32 + e]) ? elist[e * 16384 + li] : 0;
        return (unsigned)tok * 2048u;
    }
    __device__ __forceinline__ bool next(int i, pg8::Unit& u) const {
        const int L = i * G + c, np = ppre[16];
        if (L >= np * 4) return false;
        const int pm = L >> 2; int e = 0;
#pragma unroll
        for (int k = 1; k < 16; ++k) e += (ppre[k] <= pm) ? 1 : 0;
        u.pm = pm; u.pn = e * 4 + (L & 3); return true;
    }
    __device__ __forceinline__ void a_ready(const pg8::Unit&) const {}
    __device__ __forceinline__ void done(const pg8::Unit&) const {}
};

__device__ __forceinline__ int dest_row(int mode, int n) {
    if (mode == 1) return (n < 1024) ? n : (n < 1040) ? n + 1792 : (n < 2832) ? n - 16 : n;
    if (mode == 2) return (n >> 7) * 256 + (n & 127);
    if (mode == 3) return (n >> 7) * 256 + 128 + (n & 127);
    return n;
}
struct TrItem { const float* src; bf16* dst; int K, N, mode, r; };
__device__ __forceinline__ bool tr_decode(Frame& F, int it, TrItem& t) {
    constexpr int I_IN = 16 * 45, I_OUT = 16 * 16, I_INC = 16 * 64, I_OUTC = 32 * 16, I_CW1 = 2 * 32 * 4, I_G = 32 * 128, I_U = 32 * 128, I_D = 32 * 128;
    constexpr int NITEMS = I_IN + I_OUT + I_INC + I_OUTC + I_CW1 + I_G + I_U + I_D;
    if (it >= NITEMS) return false;
    int r = it; t.mode = 0;
    if (r < I_IN) { t.src = F.w_in_ab; t.dst = (bf16*)(F.ws + WS_WIN); t.K = 1024; t.N = 2856; t.mode = 1; }
    else if ((r -= I_IN) < I_OUT) { t.src = F.w_out_ab; t.dst = (bf16*)(F.ws + WS_WOUT); t.K = 1024; t.N = 1024; }
    else if ((r -= I_OUT) < I_INC) { t.src = F.w_in_c; t.dst = (bf16*)(F.ws + WS_WINC); t.K = 1024; t.N = 4096; }
    else if ((r -= I_INC) < I_OUTC) { t.src = F.w_out_c; t.dst = (bf16*)(F.ws + WS_WOUTC); t.K = 2048; t.N = 1024; }
    else if ((r -= I_OUTC) < I_CW1) { const int m = r >> 7; r &= 127; t.src = F.cmp_w1 + (size_t)m * 2048 * 256; t.dst = (bf16*)(F.ws + WS_WCW1) + (size_t)m * 256 * 2048; t.K = 2048; t.N = 256; }
    else if ((r -= I_CW1) < I_G) { const int m = r >> 7; r &= 127; t.src = F.w_gate + (size_t)m * 1024 * 512; t.dst = (bf16*)(F.ws + WS_WGU) + (size_t)m * 1024 * 1024; t.K = 1024; t.N = 512; t.mode = 2; }
    else if ((r -= I_G) < I_U) { const int m = r >> 7; r &= 127; t.src = F.w_up + (size_t)m * 1024 * 512; t.dst = (bf16*)(F.ws + WS_WGU) + (size_t)m * 1024 * 1024; t.K = 1024; t.N = 512; t.mode = 3; }
    else { r -= I_U; const int m = r >> 7; r &= 127; t.src = F.w_down + (size_t)m * 512 * 1024; t.dst = (bf16*)(F.ws + WS_WDN) + (size_t)m * 1024 * 512; t.K = 512; t.N = 1024; }
    t.r = r; return true;
}
__device__ __forceinline__ void tr_load(const TrItem& t, int lane, f32x4 (&va)[8], f32x4 (&vb)[8]) {
    const int nblk = (t.N + 63) / 64, kb = t.r / nblk, nb = t.r % nblk, k0 = 64 * kb, n0 = 64 * nb;
    const int q = lane & 15, r4 = lane >> 4, col = n0 + 4 * q;
    const float* wp = t.src + (size_t)(k0 + 2 * r4) * t.N + col;
#pragma unroll
    for (int i = 0; i < 8; ++i) {
        if (col < t.N) { va[i] = *(const f32x4*)(wp + (size_t)(8 * i) * t.N); vb[i] = *(const f32x4*)(wp + (size_t)(8 * i + 1) * t.N); }
        else { va[i] = (f32x4){0.f, 0.f, 0.f, 0.f}; vb[i] = va[i]; }
    }
}
__device__ __forceinline__ void tr_finish(const TrItem& t, int lane, const f32x4 (&va)[8], const f32x4 (&vb)[8], LAS unsigned char* scr) {
    const int nblk = (t.N + 63) / 64, kb = t.r / nblk, nb = t.r % nblk, k0 = 64 * kb, n0 = 64 * nb;
    const int q = lane & 15, r4 = lane >> 4;
#pragma unroll
    for (int i = 0; i < 8; ++i) {
        const int kp = 4 * i + r4;
        LAS unsigned* tt = (LAS unsigned*)(scr + (4 * q) * 144 + 4 * kp);
        tt[0] = pk2(va[i].x, vb[i].x); tt[36] = pk2(va[i].y, vb[i].y); tt[72] = pk2(va[i].z, vb[i].z); tt[108] = pk2(va[i].w, vb[i].w);
    }
    LDS_WAIT(); asm volatile("" ::: "memory");
    const int c = lane & 7;
#pragma unroll
    for (int j = 0; j < 8; ++j) { const int n = (lane >> 3) + 8 * j;
        const v4u o = *(const LAS v4u*)(scr + n * 144 + 16 * c);
        if (n0 + n < t.N) *(GAS v4u*)(t.dst + (size_t)dest_row(t.mode, n0 + n) * t.K + k0 + 8 * c) = o; }
    LDS_WAIT(); asm volatile("" ::: "memory");
}
__device__ __forceinline__ void p0_prologue(Frame& F) {
    LAS float* red = (LAS float*)(F.lds + RING_OFF);
    float* mod = (float*)(F.ws + WS_MOD);
    float* bias1 = (float*)(F.ws + WS_MOD + 131072);
    for (int bi = F.bid; bi < 200; bi += F.G) {
        if (bi < 192) {
            const int l = bi / 96, cg = bi % 96, j = cg * 64 + F.lane;
            float a0 = 0.f, a1 = 0.f;
            const float* wp = F.w_ada + ((size_t)l * 1024 + F.wave * 128) * 6144 + j;
#pragma unroll 16
            for (int k = 0; k < 128; ++k) { const float wv = wp[(size_t)k * 6144]; const float c0 = F.c[F.wave * 128 + k], c1 = F.c[1024 + F.wave * 128 + k];
                a0 += siluf_(c0) * wv; a1 += siluf_(c1) * wv; }
            red[(F.wave * 2 + 0) * 64 + F.lane] = a0; red[(F.wave * 2 + 1) * 64 + F.lane] = a1;
            __syncthreads();
            if (F.tid < 128) { const int b = F.tid >> 6, ln = F.tid & 63; float s = 0.f;
#pragma unroll
                for (int w = 0; w < 8; ++w) s += red[(w * 2 + b) * 64 + ln];
                mod[(size_t)(l * 2 + b) * 6144 + cg * 64 + ln] = s + F.b_ada[l * 6144 + cg * 64 + ln]; }
            __syncthreads();
        } else {
            const int kv = (bi - 192) >> 2, cg = (bi - 192) & 3, j = cg * 64 + F.lane;
            float a0 = 0.f;
            const float* wp = F.cmp_w1 + ((size_t)kv * 2048 + F.wave * 256) * 256 + j; const float* pe = F.cmp_pe + kv * 2048 + F.wave * 256;
#pragma unroll 16
            for (int k = 0; k < 256; ++k) a0 += pe[k] * wp[(size_t)k * 256];
            red[F.wave * 64 + F.lane] = a0;
            __syncthreads();
            if (F.tid < 64) { float s = 0.f;
#pragma unroll
                for (int w = 0; w < 8; ++w) s += red[w * 64 + F.tid];
                bias1[kv * 256 + cg * 64 + F.tid] = s; }
            __syncthreads();
        }
    }
    { bf16* wi = (bf16*)(F.ws + WS_WIN); const int npieces = (NPROJ - C_END) * (DM / 8);
      for (int p = F.bid * 512 + F.tid; p < npieces; p += F.G * 512) *(GAS v4u*)(wi + (size_t)C_END * DM + (size_t)p * 8) = (v4u){0u, 0u, 0u, 0u}; }
    LAS unsigned char* scr = F.lds + RING_OFF + 8192 + F.wave * 12288;
    const int gw = F.bid * 8 + F.wave, NGW = F.G * 8;
    { TrItem ta, tb; f32x4 a0[8], a1[8], b0[8], b1[8];
      int it = gw; bool ha = tr_decode(F, it, ta);
      if (ha) tr_load(ta, F.lane, a0, a1);
      while (ha) {
          const bool hb = tr_decode(F, it + NGW, tb);
          if (hb) tr_load(tb, F.lane, b0, b1);
          tr_finish(ta, F.lane, a0, a1, scr);
          if (!hb) break;
          it += 2 * NGW; ha = tr_decode(F, it, ta);
          if (ha) tr_load(ta, F.lane, a0, a1);
          tr_finish(tb, F.lane, b0, b1, scr);
      }
    }
}

__device__ __forceinline__ void moe_tables(Frame& F, int layer) {
    LAS int* ppre = (LAS int*)(F.lds + TAB_OFF);
    if (F.tid == 0) { const unsigned* cnt = (const unsigned*)(F.ctl + CW_CNT + 1024 * layer); int acc = 0;
        for (int e = 0; e < 16; ++e) { const int c = (int)cnt[64 * e]; ppre[e] = acc; ppre[32 + e] = c; acc += (c + 255) >> 8; }
        ppre[16] = acc; }
    __syncthreads();
}

struct RouteRec { int e0, e1, pos0, pos1; float w0, w1; int slot0, slot1; };
template <bool COMBINE, bool NORM, bool ROUTE>
__device__ __forceinline__ void row_pass(Frame& F, const float* xin, const float* modn  , int sh_off, const float* ng,
                                         const float* modc  , int layer, int clayer  ) {
    if (COMBINE) moe_tables(F, clayer);
    float* xout = F.out; bf16* H = (bf16*)(F.ws + WS_O);
    const bf16* YM = (const bf16*)(F.ws + WS_A);
    RouteRec* route = (RouteRec*)(F.ws + WS_ROUTE);
    int* elist = (int*)(F.ws + WS_STATS);
    const LAS int* ppre = (const LAS int*)(F.lds + TAB_OFF);
    LAS float* wr = (LAS float*)(F.lds + RING_OFF);
    LAS unsigned* lcnt = (LAS unsigned*)(F.lds + TAB_OFF + 256);
    if (ROUTE) {
        for (int idx = F.tid; idx < 16384; idx += 512) wr[(idx & 15) * 1024 + (idx >> 4)] = F.w_router[idx];
        if (F.tid < 32) lcnt[F.tid] = 0u;
        __syncthreads();
    }
    const int gw = F.bid * 8 + F.wave, NGW = F.G * 8;
    f32x4 cs[4], sh[4], gc[4];
    f32x4 vn[4]; v2u yn0[4], yn1[4]; RouteRec rn; rn.w0 = 0.f; rn.w1 = 0.f;
    int m = gw, bcur = -1;
#define RP_PREFETCH(mm) do { \
        _Pragma("unroll") for (int j = 0; j < 4; ++j) vn[j] = *(const f32x4*)(xin + (size_t)(mm) * DM + 4 * F.lane + 256 * j); \
        if (COMBINE) { rn = route[(mm)]; const int sl0_ = ppre[rn.e0] * 256 + rn.pos0, sl1_ = ppre[rn.e1] * 256 + rn.pos1; \
            _Pragma("unroll") for (int j = 0; j < 4; ++j) { yn0[j] = *(const v2u*)(YM + (size_t)sl0_ * DM + 4 * F.lane + 256 * j); yn1[j] = *(const v2u*)(YM + (size_t)sl1_ * DM + 4 * F.lane + 256 * j); } } } while (0)
    if (m < NTOK) RP_PREFETCH(m);
#pragma unroll 1
    while (m < NTOK) {
        f32x4 v[4]; v2u y0[4], y1[4];
#pragma unroll
        for (int j = 0; j < 4; ++j) { v[j] = vn[j]; if (COMBINE) { y0[j] = yn0[j]; y1[j] = yn1[j]; } }
        const float rw0 = rn.w0, rw1 = rn.w1;
        const int mc = m; m += NGW;
        if (m < NTOK) RP_PREFETCH(m);
        const int b = mc >> 13;
        if (b != bcur) { bcur = b;
#pragma unroll
            for (int j = 0; j < 4; ++j) {
                const int col = 4 * F.lane + 256 * j;
                if (NORM) { const f32x4 g = *(const f32x4*)(ng + col), sc = *(const f32x4*)(modn + b * 6144 + sh_off + 1024 + col); cs[j] = g * (sc + 1.0f); sh[j] = *(const f32x4*)(modn + b * 6144 + sh_off + col); }
                if (COMBINE) gc[j] = *(const f32x4*)(modc + b * 6144 + 5 * 1024 + col);
            } }
        {
            if (COMBINE) {
#pragma unroll
                for (int j = 0; j < 4; ++j) {
                    f32x4 yy; yy.x = rw0 * bflo(y0[j].x) + rw1 * bflo(y1[j].x); yy.y = rw0 * bfhi(y0[j].x) + rw1 * bfhi(y1[j].x); yy.z = rw0 * bflo(y0[j].y) + rw1 * bflo(y1[j].y); yy.w = rw0 * bfhi(y0[j].y) + rw1 * bfhi(y1[j].y);
                    v[j] = v[j] + gc[j] * yy;
                    *(f32x4*)(xout + (size_t)mc * DM + 4 * F.lane + 256 * j) = v[j];
                }
            }
            if (NORM) {
                float s = 0.f;
#pragma unroll
                for (int j = 0; j < 4; ++j) s += (v[j].x * v[j].x + v[j].y * v[j].y) + (v[j].z * v[j].z + v[j].w * v[j].w);
                const float rstd = 1.0f / sqrtf(wave_sum(s) * (1.0f / DM) + NORM_EPS);
#pragma unroll
                for (int j = 0; j < 4; ++j) { v[j] = v[j] * rstd * cs[j] + sh[j];
                    v2u o; o.x = pk2(v[j].x, v[j].y); o.y = pk2(v[j].z, v[j].w);
                    *(v2u*)(H + (size_t)mc * DM + 4 * F.lane + 256 * j) = o; }
            }
            if (ROUTE) {
                float a16[16];
#pragma unroll
                for (int eg = 0; eg < 4; ++eg) {
                    float a4[4] = {0.f, 0.f, 0.f, 0.f};
#pragma unroll
                    for (int j = 0; j < 4; ++j)
#pragma unroll
                        for (int ee = 0; ee < 4; ++ee) { const f32x4 w = *(const LAS f32x4*)(wr + (eg * 4 + ee) * 1024 + 4 * F.lane + 256 * j); a4[ee] += (v[j].x * w.x + v[j].y * w.y) + (v[j].z * w.z + v[j].w * w.w); }
#pragma unroll
                    for (int ee = 0; ee < 4; ++ee) a16[eg * 4 + ee] = a4[ee];
                    __builtin_amdgcn_sched_barrier(0);
                }
                float r8[8], r4[4], r2[2];
                { const bool hb = (F.lane & 32) != 0;
#pragma unroll
                  for (int i = 0; i < 8; ++i) { const float keep = hb ? a16[8 + i] : a16[i], send = hb ? a16[i] : a16[8 + i]; r8[i] = keep + __shfl_xor(send, 32); } }
                { const bool hb = (F.lane & 16) != 0;
#pragma unroll
                  for (int i = 0; i < 4; ++i) { const float keep = hb ? r8[4 + i] : r8[i], send = hb ? r8[i] : r8[4 + i]; r4[i] = keep + __shfl_xor(send, 16); } }
                { const bool hb = (F.lane & 8) != 0;
#pragma unroll
                  for (int i = 0; i < 2; ++i) { const float keep = hb ? r4[2 + i] : r4[i], send = hb ? r4[i] : r4[2 + i]; r2[i] = keep + __shfl_xor(send, 8); } }
                float lgo; { const bool hb = (F.lane & 4) != 0; const float keep = hb ? r2[1] : r2[0], send = hb ? r2[0] : r2[1]; lgo = keep + __shfl_xor(send, 4); }
                lgo += __shfl_xor(lgo, 1); lgo += __shfl_xor(lgo, 2);
                const int eown = ((F.lane >> 5) & 1) * 8 + ((F.lane >> 4) & 1) * 4 + ((F.lane >> 3) & 1) * 2 + ((F.lane >> 2) & 1);
                const float sco = frcp(1.0f + __expf(-lgo)), slo = sco + F.r_bias[eown];
                float sc[16], sl[16];
#pragma unroll
                for (int e = 0; e < 16; ++e) { const int src = (e >> 3) * 32 + ((e >> 2) & 1) * 16 + ((e >> 1) & 1) * 8 + (e & 1) * 4;
                    sc[e] = __builtin_bit_cast(float, __builtin_amdgcn_readlane(__builtin_bit_cast(int, sco), src)); sl[e] = __builtin_bit_cast(float, __builtin_amdgcn_readlane(__builtin_bit_cast(int, slo), src)); }
                float gs[4]; int ge1[4], ge2[4]; float gw1[4], gw2[4];
#pragma unroll
                for (int g = 0; g < 4; ++g) {
                    int i1 = 0; float m1 = sl[4 * g];
#pragma unroll
                    for (int k = 1; k < 4; ++k) if (sl[4 * g + k] > m1) { m1 = sl[4 * g + k]; i1 = k; }
                    int i2 = -1; float m2 = 0.f;
#pragma unroll
                    for (int k = 0; k < 4; ++k) if (k != i1 && (i2 < 0 || sl[4 * g + k] > m2)) { m2 = sl[4 * g + k]; i2 = k; }
                    gs[g] = m1 + m2; ge1[g] = 4 * g + i1; ge2[g] = 4 * g + i2;
                    float w1 = 0.f, w2 = 0.f;
#pragma unroll
                    for (int k = 0; k < 4; ++k) { w1 = (k == i1) ? sc[4 * g + k] : w1; w2 = (k == i2) ? sc[4 * g + k] : w2; }
                    gw1[g] = w1; gw2[g] = w2;
                }
                int gi = 0; float gm = gs[0];
#pragma unroll
                for (int g = 1; g < 4; ++g) if (gs[g] > gm) { gm = gs[g]; gi = g; }
                int e1 = ge1[0], e2 = ge2[0]; float w1 = gw1[0], w2 = gw2[0];
#pragma unroll
                for (int g = 1; g < 4; ++g) if (gi == g) { e1 = ge1[g]; e2 = ge2[g]; w1 = gw1[g]; w2 = gw2[g]; }
                const float ws_ = w1 + w2;
                if (F.lane == 0) {
                    RouteRec rr; rr.e0 = e1; rr.e1 = e2;
                    rr.pos0 = (int)__hip_atomic_fetch_add(lcnt + e1, 1u, __ATOMIC_RELAXED, __HIP_MEMORY_SCOPE_WORKGROUP);
                    rr.pos1 = (int)__hip_atomic_fetch_add(lcnt + e2, 1u, __ATOMIC_RELAXED, __HIP_MEMORY_SCOPE_WORKGROUP);
                    rr.w0 = w1 / ws_; rr.w1 = w2 / ws_; rr.slot0 = 0; rr.slot1 = 0;
                    route[mc] = rr;
                }
            }
        }
    }
#undef RP_PREFETCH
    if (ROUTE) {
        __syncthreads();
        if (F.tid < 16) { unsigned* cnt = (unsigned*)(F.ctl + CW_CNT + 1024 * layer + 64 * F.tid); lcnt[16 + F.tid] = atomicAdd(cnt, lcnt[F.tid]); }
        __syncthreads();
        if (F.lane == 0) {
#pragma unroll 1
            for (int m = gw; m < NTOK; m += NGW) { RouteRec rr = route[m]; rr.pos0 += (int)lcnt[16 + rr.e0]; rr.pos1 += (int)lcnt[16 + rr.e1]; route[m] = rr;
                elist[rr.e0 * 16384 + rr.pos0] = m; elist[rr.e1 * 16384 + rr.pos1] = m; }
        }
    }
}


__device__ __forceinline__ f32x4 mma16(const LAS bf16* A, int lda, const LAS bf16* Bt, int ldb, int K, f32x4 acc, int lane) {
    const LAS bf16* ap = A + (lane & 15) * lda + (lane >> 4) * 8;
    const LAS bf16* bp = Bt + (lane & 15) * ldb + (lane >> 4) * 8;
    for (int k = 0; k < K; k += 32) {
        const bf16x8 a = *(const LAS bf16x8*)(ap + k), b = *(const LAS bf16x8*)(bp + k);
        acc = __builtin_amdgcn_mfma_f32_16x16x32_bf16(a, b, acc, 0, 0, 0);
    }
    return acc;
}

__device__ __forceinline__ void gla_bcum(Frame& F, const bf16* prow  , int h, float (&bc)[8]) {
    float gl[16];
    { const v4u a = *(const v4u*)(prow + C_GLR), b = *(const v4u*)(prow + C_GLR + 8); float t0[8], t1[8]; unpack8(a, t0); unpack8(b, t1);
#pragma unroll
      for (int i = 0; i < 8; ++i) { gl[i] = t0[i]; gl[8 + i] = t1[i]; } }
#pragma unroll
    for (int i = 0; i < 8; ++i) {
        const int col = h * 64 + F.wave * 8 + i;
        float z = F.gla_bg[col];
#pragma unroll
        for (int r = 0; r < 16; ++r) z += gl[r] * F.gla_w2[r * 256 + col];
        const float ls = fminf(z, 0.f) - log1pf(__expf(-fabsf(z)));
        float v = ls * (1.0f / 16.0f);
#pragma unroll
        for (int off = 1; off < 64; off <<= 1) { const float o = __shfl_up(v, off); v += (F.lane >= off) ? o : 0.f; }
        bc[i] = v;
    }
}
__device__ __forceinline__ void gla_stage_vT(Frame& F, const bf16* prow, int h, LAS bf16* VT) {
    const v4u a = *(const v4u*)(prow + C_GV + h * 128 + F.wave * 16), b = *(const v4u*)(prow + C_GV + h * 128 + F.wave * 16 + 8);
    const unsigned w[8] = {a.x, a.y, a.z, a.w, b.x, b.y, b.z, b.w};
#pragma unroll
    for (int i = 0; i < 8; ++i) { VT[(F.wave * 16 + 2 * i) * 72 + F.lane] = (bf16)(w[i] & 0xffffu); VT[(F.wave * 16 + 2 * i + 1) * 72 + F.lane] = (bf16)(w[i] >> 16); }
}
__device__ __forceinline__ void gla_prep_item(Frame& F, int item) {
    const int h = item & 3, n = (item >> 2) & 127, b = item >> 9;
    const bf16* proj = (const bf16*)(F.ws + WS_A);
    const bf16* prow = proj + (size_t)(b * SEQ + n * 64 + F.lane) * NPROJ;
    LAS bf16* KT = (LAS bf16*)(F.lds + RING_OFF);
    LAS bf16* VT = (LAS bf16*)(F.lds + RING_OFF + 9216);
    float bc[8]; gla_bcum(F, prow, h, bc);
    float kf[8]; { const v4u kk = *(const v4u*)(prow + C_GK + h * 64 + F.wave * 8); unpack8(kk, kf); }
    float* DEC = (float*)(F.ws + WS_DEC) + ((size_t)(b * 128 + n) * 4 + h) * 64;
#pragma unroll
    for (int i = 0; i < 8; ++i) {
        const float bl = __shfl(bc[i], 63);
        KT[(F.wave * 8 + i) * 72 + F.lane] = (bf16)f2bf(kf[i] * __expf(bl - bc[i]));
        if (F.lane == 63) DEC[F.wave * 8 + i] = __expf(bl);
    }
    gla_stage_vT(F, prow, h, VT);
    __syncthreads();
    float* KV = (float*)(F.ws + WS_O) + ((size_t)(b * 128 + n) * 4 + h) * 8192;
    const int dt = F.wave >> 1;
#pragma unroll
    for (int j = 0; j < 4; ++j) {
        const int et = (F.wave & 1) * 4 + j;
        f32x4 acc = {0.f, 0.f, 0.f, 0.f};
        acc = mma16(KT + dt * 16 * 72, 72, VT + et * 16 * 72, 72, 64, acc, F.lane);
#pragma unroll
        for (int i = 0; i < 4; ++i) KV[(dt * 16 + 4 * (F.lane >> 4) + i) * 128 + et * 16 + (F.lane & 15)] = acc[i];
    }
    __syncthreads();
}
__device__ __forceinline__ void gla_scan(Frame& F, int gidx) {
    const int bh = gidx >> 13, de = gidx & 8191, b = bh >> 2, h = bh & 3;
    float* KV = (float*)(F.ws + WS_O) + ((size_t)(b * 128) * 4 + h) * 8192 + de;
    const float* DEC = (const float*)(F.ws + WS_DEC) + ((size_t)(b * 128) * 4 + h) * 64 + (de >> 7);
    float st = 0.f;
#pragma unroll 1
    for (int n0 = 0; n0 < 128; n0 += 8) {
        float kv[8], dc[8];
#pragma unroll
        for (int i = 0; i < 8; ++i) { kv[i] = KV[(size_t)(n0 + i) * 4 * 8192]; dc[i] = DEC[(size_t)(n0 + i) * 4 * 64]; }
#pragma unroll
        for (int i = 0; i < 8; ++i) { KV[(size_t)(n0 + i) * 4 * 8192] = st; st = dc[i] * st + kv[i]; }
    }
}
__device__ __forceinline__ void gla_out_item(Frame& F, int item) {
    const int h = item & 3, n = (item >> 2) & 127, b = item >> 9;
    const bf16* proj = (const bf16*)(F.ws + WS_A);
    const size_t tok = (size_t)b * SEQ + n * 64 + F.lane;
    const bf16* prow = proj + tok * NPROJ;
    LAS bf16* A1 = (LAS bf16*)(F.lds + RING_OFF);
    LAS bf16* B1 = (LAS bf16*)(F.lds + RING_OFF + 9216);
    LAS bf16* A2 = (LAS bf16*)(F.lds + RING_OFF + 18432);
    LAS bf16* SC = (LAS bf16*)(F.lds + RING_OFF + 27648);
    LAS bf16* VT = (LAS bf16*)(F.lds + RING_OFF + 36864);
    LAS bf16* ST = (LAS bf16*)(F.lds + RING_OFF + 55296);
    LAS float* OS = (LAS float*)(F.lds + RING_OFF + 73728);
    float bc[8]; gla_bcum(F, prow, h, bc);
    float qf[8], kf[8];
    { const v4u qq = *(const v4u*)(prow + C_GQ + h * 64 + F.wave * 8), kk = *(const v4u*)(prow + C_GK + h * 64 + F.wave * 8); unpack8(qq, qf); unpack8(kk, kf); }
    float a1[8], b1[8], a2[8];
#pragma unroll
    for (int i = 0; i < 8; ++i) {
        const float bm = __shfl(bc[i], 32);
        a1[i] = qf[i] * 0.125f * __expf(bc[i] - bm); b1[i] = kf[i] * __expf(bm - bc[i]); a2[i] = qf[i] * 0.125f * __expf(bc[i]);
    }
    *(LAS v4u*)(A1 + F.lane * 72 + F.wave * 8) = pack8(a1);
    *(LAS v4u*)(B1 + F.lane * 72 + F.wave * 8) = pack8(b1);
    *(LAS v4u*)(A2 + F.lane * 72 + F.wave * 8) = pack8(a2);
    gla_stage_vT(F, prow, h, VT);
    { const float* KV = (const float*)(F.ws + WS_O) + ((size_t)(b * 128 + n) * 4 + h) * 8192;
#pragma unroll
      for (int k = 0; k < 16; ++k) { const int p = F.tid + 512 * k, e = p & 127, d = p >> 7; ST[e * 72 + d] = (bf16)f2bf(KV[d * 128 + e]); } }
    __syncthreads();
    const int it = F.wave >> 1;
#pragma unroll
    for (int jj = 0; jj < 2; ++jj) {
        const int jt = (F.wave & 1) * 2 + jj;
        f32x4 acc = {0.f, 0.f, 0.f, 0.f};
        if (jt <= it) acc = mma16(A1 + it * 16 * 72, 72, B1 + jt * 16 * 72, 72, 64, acc, F.lane);
#pragma unroll
        for (int i = 0; i < 4; ++i) { const int ri = it * 16 + 4 * (F.lane >> 4) + i, cj = jt * 16 + (F.lane & 15); SC[ri * 72 + cj] = (bf16)f2bf((cj <= ri) ? acc[i] : 0.f); }
    }
    __syncthreads();
#pragma unroll
    for (int j = 0; j < 4; ++j) {
        const int et = (F.wave & 1) * 4 + j;
        f32x4 acc = {0.f, 0.f, 0.f, 0.f};
        acc = mma16(SC + it * 16 * 72, 72, VT + et * 16 * 72, 72, 64, acc, F.lane);
        acc = mma16(A2 + it * 16 * 72, 72, ST + et * 16 * 72, 72, 64, acc, F.lane);
#pragma unroll
        for (int i = 0; i < 4; ++i) OS[(it * 16 + 4 * (F.lane >> 4) + i) * 132 + et * 16 + (F.lane & 15)] = acc[i];
    }
    __syncthreads();
    { const int row = F.tid >> 3, c0 = (F.tid & 7) * 16;
      float v[16]; float ss = 0.f;
#pragma unroll
      for (int i = 0; i < 16; ++i) { v[i] = OS[row * 132 + c0 + i]; ss += v[i] * v[i]; }
      ss += __shfl_xor(ss, 1); ss += __shfl_xor(ss, 2); ss += __shfl_xor(ss, 4);
      const float rstd = 1.0f / sqrtf(ss * (1.0f / 128.0f) + NORM_EPS);
      const size_t tk = (size_t)b * SEQ + n * 64 + row;
      const bf16* rrow = proj + tk * NPROJ + C_GR + h * 128 + c0;
      float r0[8], r1[8]; unpack8(*(const v4u*)rrow, r0); unpack8(*(const v4u*)(rrow + 8), r1);
      float o0[8], o1[8];
#pragma unroll
      for (int i = 0; i < 8; ++i) { o0[i] = v[i] * rstd * F.gla_ng[c0 + i] * siluf_(r0[i]); o1[i] = v[8 + i] * rstd * F.gla_ng[c0 + 8 + i] * siluf_(r1[i]); }
      bf16* orow = (bf16*)(F.ws + WS_O + 32 * MiB) + tk * DM + h * 128 + c0;
      *(v4u*)orow = pack8(o0); *(v4u*)(orow + 8) = pack8(o1); }
    __syncthreads();
}

__device__ __forceinline__ double inv_freq_d(int i) {
    return (i == 0) ? 1.0 : (i == 1) ? 0.19392547740471268 : (i == 2) ? 0.037606090787015346 : (i == 3) ? 0.0072927791106285765 :
           (i == 4) ? 0.0014142135623730951 : (i == 5) ? 0.00027425197177757796 : (i == 6) ? 5.318404375373266e-05 : 1.0313741203148838e-05;
}
__device__ __forceinline__ void rope_sincos(int pos, int i, float& cs, float& sn) {
    const double rev = (double)pos * inv_freq_d(i) * 0.15915494309189535;
    const float fr = (float)(rev - rint(rev));
    cs = __builtin_amdgcn_cosf(fr); sn = __builtin_amdgcn_sinf(fr);
}
__device__ __forceinline__ void nsa_prep_token(Frame& F, int tok) {
    const int b = tok >> 13, t = tok & 8191, sub = F.lane & 7, vid = F.lane >> 3;
    const bf16* prow = (const bf16*)(F.ws + WS_A) + (size_t)tok * NPROJ;
    const int pos = F.positions[tok];
    float cs_l, sn_l; rope_sincos(pos, sub, cs_l, sn_l);
    float cs[8], sn[8];
#pragma unroll
    for (int i = 0; i < 8; ++i) { cs[i] = __shfl(cs_l, (F.lane & ~7) + i); sn[i] = __shfl(sn_l, (F.lane & ~7) + i); }
    unsigned char* dob = F.dout_b;
    const size_t ktile_off = (size_t)(t >> 6) * 8192 + sub * 1024 + (t & 63) * 16;
    const size_t vtile_off = (size_t)(t >> 6) * 8192 + (sub >> 2) * 4096 + (t & 63) * 64 + (sub & 3) * 16;
#pragma unroll
    for (int round = 0; round < 3; ++round) {
        int col; int kind; unsigned char* dst; const float* gain = nullptr;
        if (round == 0) { col = C_NQ + vid * 64; kind = 0; gain = F.q_gain; const int g = vid >> 2, hh = vid & 3;
            dst = dob + DO_QN + ((((size_t)(b * 2 + g) * SEQ + t) * 4 + hh) * 64 + sub * 8) * 2; }
        else if (round == 1) {
            const int g = vid & 1, which = vid >> 1;
            const size_t img = (size_t)(b * 2 + g) * (1u << 20);
            if (which == 0) { col = C_KS + g * 64; kind = 1; gain = F.k_gain + 64; dst = dob + DO_KSEL + img + ktile_off; }
            else if (which == 1) { col = C_KW + g * 64; kind = 1; gain = F.k_gain + 128; dst = dob + DO_KWIN + img + ktile_off; }
            else if (which == 2) { col = C_VS + g * 64; kind = 2; dst = dob + DO_VSEL + img + vtile_off; }
            else { col = C_VW + g * 64; kind = 2; dst = dob + DO_VWIN + img + vtile_off; }
        } else {
            const int g = vid & 1, which = (vid >> 1) & 1;
            col = (which ? C_VC : C_KC) + g * 64; kind = 2;
            dst = dob + (which ? DO_VC : DO_KC) + (((size_t)(b * 2 + g) * SEQ + t) * 64 + sub * 8) * 2;
        }
        float x[8]; unpack8(*(const v4u*)(prow + col + sub * 8), x);
        if (kind != 2) {
            float ss = 0.f;
#pragma unroll
            for (int i = 0; i < 8; ++i) ss += x[i] * x[i];
            ss += __shfl_xor(ss, 1); ss += __shfl_xor(ss, 2); ss += __shfl_xor(ss, 4);
            const float rstd = 1.0f / sqrtf(ss * (1.0f / 64.0f) + NORM_EPS);
#pragma unroll
            for (int i = 0; i < 8; ++i) x[i] = x[i] * rstd * gain[sub * 8 + i];
            float xo[8];
#pragma unroll
            for (int i = 0; i < 8; ++i) xo[i] = __shfl_xor(x[i], 1);
            if (sub == 0) {
#pragma unroll
                for (int i = 0; i < 8; ++i) x[i] = x[i] * cs[i] - xo[i] * sn[i];
            } else if (sub == 1) {
#pragma unroll
                for (int i = 0; i < 8; ++i) x[i] = x[i] * cs[i] + xo[i] * sn[i];
            }
            if (kind == 0) {
#pragma unroll
                for (int i = 0; i < 8; ++i) x[i] *= 0.125f * 1.4426950408889634f;
            }
        }
        if (round < 2 || F.lane < 32) *(v4u*)dst = pack8(x);
    }
    if (F.lane < 24) { float* gt = (float*)(F.ws + WS_GATES) + (size_t)tok * 24; gt[F.lane] = sigmoidf_(bf2f(prow[C_NG + F.lane])); }
}

__device__ __forceinline__ void nsa_compress_item(Frame& F, int item) {
    const int kv = item >> 6, b = (item >> 5) & 1, g = (item >> 4) & 1, rt = item & 15, n0 = rt * 32;
    const bf16* Asrc = (const bf16*)(F.dout_b + (kv ? DO_VC : DO_KC)) + ((size_t)(b * 2 + g) * SEQ + 16 * n0) * 64;
    const bf16* Bsrc = (const bf16*)(F.ws + WS_WCW1) + (size_t)kv * 256 * 2048;
    LAS bf16* As = (LAS bf16*)(F.lds + RING_OFF);
    LAS bf16* Bs = (LAS bf16*)(F.lds + RING_OFF + 2 * 32 * 72 * 2);
    LAS float* Hs = (LAS float*)(F.lds + RING_OFF + 86016);
    LAS float* W2s = (LAS float*)(F.lds + RING_OFF);
    const int ar = F.tid >> 3, ac = (F.tid & 7) * 8;
    v4u areg = {0u, 0u, 0u, 0u}, breg[4];
#define CMP_GLOAD(kc) do { if (F.tid < 256) areg = *(const v4u*)(Asrc + (size_t)ar * 1024 + (kc) * 64 + ac); \
        _Pragma("unroll") for (int i_ = 0; i_ < 4; ++i_) { const int p_ = F.tid + 512 * i_, br_ = p_ >> 3, bc_ = (p_ & 7) * 8; breg[i_] = *(const v4u*)(Bsrc + (size_t)br_ * 2048 + (kc) * 64 + bc_); } } while (0)
#define CMP_LSTORE(buf) do { if (F.tid < 256) *(LAS v4u*)(As + (buf) * 32 * 72 + ar * 72 + ac) = areg; \
        _Pragma("unroll") for (int i_ = 0; i_ < 4; ++i_) { const int p_ = F.tid + 512 * i_, br_ = p_ >> 3, bc_ = (p_ & 7) * 8; *(LAS v4u*)(Bs + (buf) * 256 * 72 + br_ * 72 + bc_) = breg[i_]; } } while (0)
    f32x4 acc[2][2];
#pragma unroll
    for (int mt = 0; mt < 2; ++mt)
#pragma unroll
        for (int nt = 0; nt < 2; ++nt) acc[mt][nt] = (f32x4){0.f, 0.f, 0.f, 0.f};
    CMP_GLOAD(0); CMP_LSTORE(0); __syncthreads();
#pragma unroll 1
    for (int kc = 0; kc < 32; ++kc) {
        const int buf = kc & 1;
        if (kc + 1 < 32) CMP_GLOAD(kc + 1);
#pragma unroll
        for (int mt = 0; mt < 2; ++mt)
#pragma unroll
            for (int nt = 0; nt < 2; ++nt)
                acc[mt][nt] = mma16(As + buf * 32 * 72 + mt * 16 * 72, 72, Bs + buf * 256 * 72 + (F.wave * 32 + nt * 16) * 72, 72, 64, acc[mt][nt], F.lane);
        if (kc + 1 < 32) CMP_LSTORE(buf ^ 1);
        __syncthreads();
    }
    const float* bias1 = (const float*)(F.ws + WS_MOD + 131072) + kv * 256;
#pragma unroll
    for (int mt = 0; mt < 2; ++mt)
#pragma unroll
        for (int nt = 0; nt < 2; ++nt) { const int col = F.wave * 32 + nt * 16 + (F.lane & 15);
#pragma unroll
            for (int i = 0; i < 4; ++i) Hs[(mt * 16 + 4 * (F.lane >> 4) + i) * 260 + col] = gelu_tanh(acc[mt][nt][i] + bias1[col]); }
    { const float* w2 = F.cmp_w2 + (size_t)kv * 256 * 64;
#pragma unroll
      for (int i = 0; i < 8; ++i) *(LAS f32x4*)(W2s + (F.tid + 512 * i) * 4) = *(const f32x4*)(w2 + (size_t)(F.tid + 512 * i) * 4); }
    __syncthreads();
    const int r = F.tid >> 4, dq = F.tid & 15;
    f32x4 o = {0.f, 0.f, 0.f, 0.f};
#pragma unroll 8
    for (int j = 0; j < 256; ++j) { const float hv = Hs[r * 260 + j]; const f32x4 w = *(const LAS f32x4*)(W2s + j * 64 + 4 * dq); o = o + w * hv; }
    const int n = n0 + r;
    if (kv == 0) {
        float ss = (o.x * o.x + o.y * o.y) + (o.z * o.z + o.w * o.w);
        ss += __shfl_xor(ss, 1); ss += __shfl_xor(ss, 2); ss += __shfl_xor(ss, 4); ss += __shfl_xor(ss, 8);
        const float rstd = 1.0f / sqrtf(ss * (1.0f / 64.0f) + NORM_EPS);
        const f32x4 gn = *(const f32x4*)(F.k_gain + 4 * dq);
        o = o * rstd * gn;
        const int tlast = (16 * n + 31 < SEQ) ? 16 * n + 31 : SEQ - 1;
        const int pos = F.positions[b * SEQ + tlast];
        f32x4 po; po.x = __shfl_xor(o.x, 2); po.y = __shfl_xor(o.y, 2); po.z = __shfl_xor(o.z, 2); po.w = __shfl_xor(o.w, 2);
        if (dq < 4) {
            const int i0 = 4 * (dq & 1);
            float c0, s0, c1, s1, c2, s2, c3, s3;
            rope_sincos(pos, i0, c0, s0); rope_sincos(pos, i0 + 1, c1, s1); rope_sincos(pos, i0 + 2, c2, s2); rope_sincos(pos, i0 + 3, c3, s3);
            if (dq < 2) { o.x = o.x * c0 - po.x * s0; o.y = o.y * c1 - po.y * s1; o.z = o.z * c2 - po.z * s2; o.w = o.w * c3 - po.w * s3; }
            else { o.x = o.x * c0 + po.x * s0; o.y = o.y * c1 + po.y * s1; o.z = o.z * c2 + po.z * s2; o.w = o.w * c3 + po.w * s3; }
        }
    }
    if (n == 511) o = (f32x4){0.f, 0.f, 0.f, 0.f};
    v2u pk; pk.x = pk2(o.x, o.y); pk.y = pk2(o.z, o.w);
    const int c = dq >> 1;
    unsigned char* img = F.dout_b + (kv ? DO_VCMP : DO_KCMP) + (size_t)(b * 2 + g) * 65536 + (size_t)(n >> 6) * 8192;
    if (kv == 0) *(v2u*)(img + c * 1024 + (n & 63) * 16 + (dq & 1) * 8) = pk;
    else *(v2u*)(img + (c >> 2) * 4096 + (n & 63) * 64 + (c & 3) * 16 + (dq & 1) * 8) = pk;
    __syncthreads();
}

constexpr int NSA_KB = 0, NSA_VB = 16384, NSA_IMP = 32768, NSA_OACC = 65536;
__device__ __forceinline__ int crow(int r, int hi) { return (r & 3) + 8 * (r >> 2) + 4 * hi; }
__device__ __forceinline__ s16x4 ds_tr16(const LAS unsigned char* p) { return __builtin_bit_cast(s16x4, __builtin_amdgcn_ds_read_tr16_b64_v4i16((LAS s16x4*)p)); }

__device__ __forceinline__ unsigned cvtpk(float lo, float hi) { unsigned r; asm("v_cvt_pk_bf16_f32 %0, %1, %2" : "=v"(r) : "v"(lo), "v"(hi)); return r; }
__device__ __forceinline__ float xhalf_max(float v) { const auto rr = __builtin_amdgcn_permlane32_swap(__float_as_uint(v), __float_as_uint(v), false, false); return fmaxf(__uint_as_float(rr[0]), __uint_as_float(rr[1])); }
constexpr float NSA_THR = 8.0f;

template <int MODE>
__device__ __forceinline__ void nsa_branch(Frame& F, const unsigned char* Kimg, const unsigned char* Vimg, int kt0, int kt1, const bf16x8 (&qr)[4],
                                           float& m, float& l, f32x16 (&o)[2], int t, int tw0, int nv, int nvw, int nvmin,
                                           unsigned mk0, unsigned mk1, unsigned mk2, unsigned mk3, unsigned wo0, unsigned wo1, unsigned wo2, unsigned wo3,
                                           float cinit  , LAS float* impw) {
    const int r32 = F.lane & 31, hi = F.lane >> 5, tokl = r32 >> 2;
    LAS unsigned char* KB = F.lds + RING_OFF + NSA_KB; LAS unsigned char* VB = F.lds + RING_OFF + NSA_VB;
    const v4u* kg = (const v4u*)Kimg + F.tid; const v4u* vg = (const v4u*)Vimg + F.tid;
    v4u kreg = kg[(size_t)kt0 * 512], vreg = {0u, 0u, 0u, 0u};
    if (MODE != 0) vreg = vg[(size_t)kt0 * 512];
    *(LAS v4u*)(KB + F.tid * 16) = kreg; if (MODE != 0) *(LAS v4u*)(VB + F.tid * 16) = vreg;
    __syncthreads();
#pragma unroll 1
    for (int kt = kt0; kt < kt1; ++kt) {
        const int buf = (kt - kt0) & 1; const bool has_next = kt + 1 < kt1;
        if (has_next) { kreg = kg[(size_t)(kt + 1) * 512]; if (MODE != 0) vreg = vg[(size_t)(kt + 1) * 512]; }
        const LAS unsigned char* Kb = KB + buf * 8192; const LAS unsigned char* Vb = VB + buf * 8192;
        bool need;
        if (MODE <= 1) need = kt * 64 < nvw;
        else if (MODE == 2) { const unsigned w = (kt < 32) ? wo0 : (kt < 64) ? wo1 : (kt < 96) ? wo2 : wo3; need = (w >> (kt & 31)) & 1u; }
        else need = (kt * 64 <= tw0 + 7) && (kt * 64 + 63 + 512 > tw0);
        bool selbit = true;
        if (MODE == 2) { const unsigned w = (kt < 32) ? mk0 : (kt < 64) ? mk1 : (kt < 96) ? mk2 : mk3; selbit = (w >> (kt & 31)) & 1u; }
        bool joint = false;
        if (need) {
            if (MODE == 2) joint = kt < (tw0 >> 6);
            else if (MODE == 3) joint = (kt * 64 + 63 <= tw0) && (kt * 64 + 512 > tw0 + 7);
            else joint = kt * 64 + 63 < nvmin;
            if (MODE != 1) joint = joint && !__any(m < -1e29f);
        }
        if (need && joint) {
            const float c0 = (MODE == 1) ? cinit : ((MODE == 2 && !selbit) ? -1e30f : -m);
            f32x16 pa, pb;
#pragma unroll
            for (int r = 0; r < 16; ++r) { pa[r] = c0; pb[r] = c0; }
#pragma unroll
            for (int d0 = 0; d0 < 4; ++d0) {
                const bf16x8 kfa = *(const LAS bf16x8*)(Kb + (2 * d0 + hi) * 1024 + r32 * 16), kfb = *(const LAS bf16x8*)(Kb + (2 * d0 + hi) * 1024 + (32 + r32) * 16);
                pa = __builtin_amdgcn_mfma_f32_32x32x16_bf16(kfa, qr[d0], pa, 0, 0, 0);
                pb = __builtin_amdgcn_mfma_f32_32x32x16_bf16(kfb, qr[d0], pb, 0, 0, 0);
            }
            if (MODE != 1) {
                float mxa = fmaxf(fmaxf(pa[0], pa[1]), pa[2]), mxb = fmaxf(fmaxf(pb[0], pb[1]), pb[2]);
#pragma unroll
                for (int r = 3; r < 15; r += 2) { mxa = fmaxf(fmaxf(mxa, pa[r]), pa[r + 1]); mxb = fmaxf(fmaxf(mxb, pb[r]), pb[r + 1]); }
                const float mx = xhalf_max(fmaxf(fmaxf(mxa, pa[15]), fmaxf(mxb, pb[15])));
                if (__any(mx > NSA_THR)) {
                    const float dl = fmaxf(mx, 0.f), alpha = fexp2(-dl);
                    m += dl; l *= alpha;
#pragma unroll
                    for (int r = 0; r < 16; ++r) { pa[r] -= dl; pb[r] -= dl; }
                    if (MODE != 0) {
#pragma unroll
                        for (int r = 0; r < 16; ++r) { o[0][r] *= alpha; o[1][r] *= alpha; }
                    }
                }
            }
            float ps0 = 0.f, ps1 = 0.f;
#pragma unroll
            for (int r = 0; r < 16; ++r) { pa[r] = fexp2(pa[r]); pb[r] = fexp2(pb[r]); ps0 += pa[r]; ps1 += pb[r]; }
            if (MODE != 1) l += ps0 + ps1;
            if (MODE == 1) {
#pragma unroll
                for (int rg = 0; rg < 4; ++rg) {
                    float a = (pa[4 * rg] + pa[4 * rg + 1]) + (pa[4 * rg + 2] + pa[4 * rg + 3]), sp = pa[4 * rg + 3];
                    float a2 = (pb[4 * rg] + pb[4 * rg + 1]) + (pb[4 * rg + 2] + pb[4 * rg + 3]), sp2 = pb[4 * rg + 3];
                    a += __shfl_xor(a, 1); a += __shfl_xor(a, 2); sp += __shfl_xor(sp, 1); sp += __shfl_xor(sp, 2);
                    a2 += __shfl_xor(a2, 1); a2 += __shfl_xor(a2, 2); sp2 += __shfl_xor(sp2, 1); sp2 += __shfl_xor(sp2, 2);
                    if ((r32 & 3) == 0) { const int jp = kt * 16 + 2 * rg + hi;
                        __hip_atomic_fetch_add(impw + tokl * 128 + jp, a, __ATOMIC_RELAXED, __HIP_MEMORY_SCOPE_WORKGROUP);
                        __hip_atomic_fetch_add(impw + tokl * 128 + jp + 1, sp, __ATOMIC_RELAXED, __HIP_MEMORY_SCOPE_WORKGROUP);
                        __hip_atomic_fetch_add(impw + tokl * 128 + jp + 8, a2, __ATOMIC_RELAXED, __HIP_MEMORY_SCOPE_WORKGROUP);
                        if (jp + 9 < 128) __hip_atomic_fetch_add(impw + tokl * 128 + jp + 9, sp2, __ATOMIC_RELAXED, __HIP_MEMORY_SCOPE_WORKGROUP); }
                }
            }
            if (MODE != 0) {
                v4u wa0, wa1, wb0, wb1;
                wa0.x = cvtpk(pa[0], pa[1]); wa0.y = cvtpk(pa[2], pa[3]); wa0.z = cvtpk(pa[4], pa[5]); wa0.w = cvtpk(pa[6], pa[7]);
                wa1.x = cvtpk(pa[8], pa[9]); wa1.y = cvtpk(pa[10], pa[11]); wa1.z = cvtpk(pa[12], pa[13]); wa1.w = cvtpk(pa[14], pa[15]);
                wb0.x = cvtpk(pb[0], pb[1]); wb0.y = cvtpk(pb[2], pb[3]); wb0.z = cvtpk(pb[4], pb[5]); wb0.w = cvtpk(pb[6], pb[7]);
                wb1.x = cvtpk(pb[8], pb[9]); wb1.y = cvtpk(pb[10], pb[11]); wb1.z = cvtpk(pb[12], pb[13]); wb1.w = cvtpk(pb[14], pb[15]);
                const bf16x8 fa0 = __builtin_bit_cast(bf16x8, wa0), fa1 = __builtin_bit_cast(bf16x8, wa1), fb0 = __builtin_bit_cast(bf16x8, wb0), fb1 = __builtin_bit_cast(bf16x8, wb1);
                const LAS unsigned char* vb = Vb + (4 * hi + ((F.lane & 15) >> 2)) * 64 + ((F.lane >> 4) & 1) * 32 + (F.lane & 3) * 8;
#pragma unroll
                for (int dh = 0; dh < 2; ++dh) {
                    const LAS unsigned char* v0 = vb + dh * 4096;
                    const s16x4 a0 = ds_tr16(v0), a1 = ds_tr16(v0 + 512), b0 = ds_tr16(v0 + 1024), b1 = ds_tr16(v0 + 1536), c0_ = ds_tr16(v0 + 2048), c1 = ds_tr16(v0 + 2560), d0_ = ds_tr16(v0 + 3072), d1 = ds_tr16(v0 + 3584);
                    const bf16x8 vfa0 = {a0[0], a0[1], a0[2], a0[3], a1[0], a1[1], a1[2], a1[3]}, vfa1 = {b0[0], b0[1], b0[2], b0[3], b1[0], b1[1], b1[2], b1[3]};
                    const bf16x8 vfb0 = {c0_[0], c0_[1], c0_[2], c0_[3], c1[0], c1[1], c1[2], c1[3]}, vfb1 = {d0_[0], d0_[1], d0_[2], d0_[3], d1[0], d1[1], d1[2], d1[3]};
                    o[dh] = __builtin_amdgcn_mfma_f32_32x32x16_bf16(vfa0, fa0, o[dh], 0, 0, 0);
                    o[dh] = __builtin_amdgcn_mfma_f32_32x32x16_bf16(vfa1, fa1, o[dh], 0, 0, 0);
                    o[dh] = __builtin_amdgcn_mfma_f32_32x32x16_bf16(vfb0, fb0, o[dh], 0, 0, 0);
                    o[dh] = __builtin_amdgcn_mfma_f32_32x32x16_bf16(vfb1, fb1, o[dh], 0, 0, 0);
                }
            }
        } else if (need) {
#pragma unroll 1
            for (int kb = 0; kb < 2; ++kb) {
                const int key0 = kt * 64 + kb * 32;
                bool fast;
                if (MODE == 2) fast = kt < (tw0 >> 6);
                else if (MODE == 3) fast = (key0 + 31 <= tw0) && (key0 + 512 > tw0 + 7);
                else fast = key0 + 31 < nvmin;
                if (MODE != 1) fast = fast && !__any(m < -1e29f);
                float c0 = 0.f;
                if (fast) c0 = (MODE == 1) ? cinit : ((MODE == 2 && !selbit) ? -1e30f : -m);
                f32x16 p;
#pragma unroll
                for (int r = 0; r < 16; ++r) p[r] = c0;
#pragma unroll
                for (int d0 = 0; d0 < 4; ++d0) {
                    const bf16x8 kf = *(const LAS bf16x8*)(Kb + (2 * d0 + hi) * 1024 + (32 * kb + r32) * 16);
                    p = __builtin_amdgcn_mfma_f32_32x32x16_bf16(kf, qr[d0], p, 0, 0, 0);
                }
                float pe[16];
                if (fast) {
                    if (MODE != 1) {
                        float mx = fmaxf(fmaxf(p[0], p[1]), p[2]);
#pragma unroll
                        for (int r = 3; r < 15; r += 2) mx = fmaxf(fmaxf(mx, p[r]), p[r + 1]);
                        mx = xhalf_max(fmaxf(mx, p[15]));
                        if (__any(mx > NSA_THR)) {
                            const float dl = fmaxf(mx, 0.f), alpha = fexp2(-dl);
                            m += dl; l *= alpha;
#pragma unroll
                            for (int r = 0; r < 16; ++r) p[r] -= dl;
                            if (MODE != 0) {
#pragma unroll
                                for (int r = 0; r < 16; ++r) { o[0][r] *= alpha; o[1][r] *= alpha; }
                            }
                        }
                    }
                    float ps0 = 0.f, ps1 = 0.f;
#pragma unroll
                    for (int r = 0; r < 16; r += 2) { pe[r] = fexp2(p[r]); pe[r + 1] = fexp2(p[r + 1]); ps0 += pe[r]; ps1 += pe[r + 1]; }
                    if (MODE != 1) l += ps0 + ps1;
                } else if (MODE == 1) {
#pragma unroll
                    for (int r = 0; r < 16; ++r) { const int key = key0 + crow(r, hi); pe[r] = (key < nv) ? fexp2(p[r] + cinit) : 0.f; }
                } else {
                    float mx = NEGBIG;
#pragma unroll
                    for (int r = 0; r < 16; ++r) {
                        const int key = key0 + crow(r, hi); bool ok;
                        if (MODE == 0) ok = key < nv;
                        else if (MODE == 2) ok = selbit && (kt < (t >> 6) || key <= t);
                        else ok = (key <= t) && (key + 512 > t);
                        p[r] = ok ? p[r] : NEGBIG; mx = fmaxf(mx, p[r]);
                    }
                    mx = xhalf_max(mx);
                    const float mn = fmaxf(m, mx), alpha = fexp2(m - mn);
                    float ps = 0.f;
#pragma unroll
                    for (int r = 0; r < 16; ++r) { pe[r] = (p[r] > -1e29f) ? fexp2(p[r] - mn) : 0.f; ps += pe[r]; }
                    l = l * alpha + ps; m = mn;
                    if (MODE != 0) {
#pragma unroll
                        for (int r = 0; r < 16; ++r) { o[0][r] *= alpha; o[1][r] *= alpha; }
                    }
                }
                if (MODE == 1) {
#pragma unroll
                    for (int rg = 0; rg < 4; ++rg) {
                        float a = (pe[4 * rg] + pe[4 * rg + 1]) + (pe[4 * rg + 2] + pe[4 * rg + 3]), sp = pe[4 * rg + 3];
                        a += __shfl_xor(a, 1); a += __shfl_xor(a, 2); sp += __shfl_xor(sp, 1); sp += __shfl_xor(sp, 2);
                        if ((r32 & 3) == 0) { const int jp = (key0 >> 2) + 2 * rg + hi;
                            __hip_atomic_fetch_add(impw + tokl * 128 + jp, a, __ATOMIC_RELAXED, __HIP_MEMORY_SCOPE_WORKGROUP);
                            if (jp + 1 < 128) __hip_atomic_fetch_add(impw + tokl * 128 + jp + 1, sp, __ATOMIC_RELAXED, __HIP_MEMORY_SCOPE_WORKGROUP); }
                    }
                }
                if (MODE != 0) {
                    v4u pw0, pw1;
                    pw0.x = cvtpk(pe[0], pe[1]); pw0.y = cvtpk(pe[2], pe[3]); pw0.z = cvtpk(pe[4], pe[5]); pw0.w = cvtpk(pe[6], pe[7]);
                    pw1.x = cvtpk(pe[8], pe[9]); pw1.y = cvtpk(pe[10], pe[11]); pw1.z = cvtpk(pe[12], pe[13]); pw1.w = cvtpk(pe[14], pe[15]);
                    const bf16x8 pf0 = __builtin_bit_cast(bf16x8, pw0), pf1 = __builtin_bit_cast(bf16x8, pw1);
                    const LAS unsigned char* vb = Vb + (32 * kb + 4 * hi + ((F.lane & 15) >> 2)) * 64 + ((F.lane >> 4) & 1) * 32 + (F.lane & 3) * 8;
#pragma unroll
                    for (int dh = 0; dh < 2; ++dh) {
                        const s16x4 a0 = ds_tr16(vb + dh * 4096), a1 = ds_tr16(vb + dh * 4096 + 512), b0 = ds_tr16(vb + dh * 4096 + 1024), b1 = ds_tr16(vb + dh * 4096 + 1024 + 512);
                        const bf16x8 vf0 = {a0[0], a0[1], a0[2], a0[3], a1[0], a1[1], a1[2], a1[3]}, vf1 = {b0[0], b0[1], b0[2], b0[3], b1[0], b1[1], b1[2], b1[3]};
                        o[dh] = __builtin_amdgcn_mfma_f32_32x32x16_bf16(vf0, pf0, o[dh], 0, 0, 0);
                        o[dh] = __builtin_amdgcn_mfma_f32_32x32x16_bf16(vf1, pf1, o[dh], 0, 0, 0);
                    }
                }
            }
        }
        if (has_next) { *(LAS v4u*)(KB + (buf ^ 1) * 8192 + F.tid * 16) = kreg; if (MODE != 0) *(LAS v4u*)(VB + (buf ^ 1) * 8192 + F.tid * 16) = vreg; }
        __syncthreads();
    }
}

__device__ __forceinline__ void nsa_item(Frame& F, int b, int g, int qi) {
    const int r32 = F.lane & 31, hi = F.lane >> 5, tokl = r32 >> 2, hh = r32 & 3;
    const int t0 = qi * 64, tw0 = t0 + 8 * F.wave, t = tw0 + tokl;
    const unsigned char* dob = F.dout_b;
    const size_t img = (size_t)(b * 2 + g) * (1u << 20);
    LAS float* impw = (LAS float*)(F.lds + RING_OFF + NSA_IMP) + F.wave * 1024;
    LAS unsigned* selm = (LAS unsigned*)(F.lds + TAB_OFF + 1024) + F.wave * 32;
    LAS float* oaccw = (LAS float*)(F.lds + RING_OFF + NSA_OACC) + F.wave * 2048 + F.lane;
#pragma unroll
    for (int i = 0; i < 16; ++i) impw[F.lane + 64 * i] = 0.f;
    bf16x8 qr[4];
    { const bf16* qrow = (const bf16*)(dob + DO_QN) + (((size_t)(b * 2 + g) * SEQ + tw0) * 4 + r32) * 64;
#pragma unroll
      for (int d0 = 0; d0 < 4; ++d0) qr[d0] = *(const bf16x8*)(qrow + 16 * d0 + 8 * hi); }
    const float* gt = (const float*)(F.ws + WS_GATES) + ((size_t)b * SEQ + t) * 24 + (g * 4 + hh) * 3;
#if defined(NSA_ZERO_CMP)
    const float g0 = 0.f, g1 = gt[1], g2 = gt[2];
#elif defined(NSA_ZERO_SEL)
    const float g0 = gt[0], g1 = 0.f, g2 = gt[2];
#elif defined(NSA_ZERO_WIN)
    const float g0 = gt[0], g1 = gt[1], g2 = 0.f;
#elif defined(NSA_ZERO_ALL)
    const float g0 = 0.f, g1 = 0.f, g2 = 0.f;
#else
    const float g0 = gt[0], g1 = gt[1], g2 = gt[2];
#endif
    f32x16 o[2];
    const int nv = (t >= 31) ? ((t - 31) >> 4) + 1 : 0, nvw = (tw0 + 7 >= 31) ? ((tw0 + 7 - 31) >> 4) + 1 : 0, nvmin = (tw0 >= 31) ? ((tw0 - 31) >> 4) + 1 : 0;
    const int nct = (4 * qi + 3 + 63) >> 6;
    const unsigned char* Kc = dob + DO_KCMP + (size_t)(b * 2 + g) * 65536; const unsigned char* Vc = dob + DO_VCMP + (size_t)(b * 2 + g) * 65536;
#if defined(NSA_SPIN)
    unsigned long long tsp = __builtin_amdgcn_s_memrealtime();
#define NSPIN(k) do { if (NSA_SPIN == (k)) { const unsigned long long t1_ = __builtin_amdgcn_s_memrealtime(), dt_ = t1_ - tsp; while (__builtin_amdgcn_s_memrealtime() - t1_ < dt_) __builtin_amdgcn_s_sleep(4); } tsp = __builtin_amdgcn_s_memrealtime(); } while (0)
#else
#define NSPIN(k) do { } while (0)
#endif
    float m = NEGBIG, l = 0.f;
    nsa_branch<0>(F, Kc, Vc, 0, nct, qr, m, l, o, t, tw0, nv, nvw, nvmin, 0u, 0u, 0u, 0u, 0u, 0u, 0u, 0u, 0.f, impw);
    { const float lt = l + __shfl_xor(l, 32); const float cinit = (lt > 0.f) ? -__log2f(lt) - m : -1e30f;
#pragma unroll
      for (int r = 0; r < 16; ++r) { o[0][r] = 0.f; o[1][r] = 0.f; }
      nsa_branch<1>(F, Kc, Vc, 0, nct, qr, m, l, o, t, tw0, nv, nvw, nvmin, 0u, 0u, 0u, 0u, 0u, 0u, 0u, 0u, cinit, impw);
#pragma unroll
      for (int r = 0; r < 16; ++r) { oaccw[r * 64] = g0 * o[0][r]; oaccw[(16 + r) * 64] = g0 * o[1][r]; } }
    __syncthreads();
    NSPIN(1);
#pragma unroll 1
    for (int tl = 0; tl < 8; ++tl) {
        const int tt = tw0 + tl, cur = tt >> 6, j0 = F.lane, j1 = F.lane + 64;
        const unsigned u0 = (j0 <= cur) ? (__float_as_uint(impw[tl * 128 + j0] + ((j0 == 0 || j0 == cur || j0 == cur - 1) ? 1e4f : 0.f)) + 1u) : 0u;
        const unsigned u1 = (j1 <= cur) ? (__float_as_uint(impw[tl * 128 + j1] + ((j1 == cur || j1 == cur - 1) ? 1e4f : 0.f)) + 1u) : 0u;
        bool s0, s1;
        if (cur < 16) { s0 = (j0 <= cur); s1 = false; }
        else {
            unsigned T = 0u;
#pragma unroll 1
            for (int bit = 31; bit >= 0; --bit) {
                const unsigned cand = T | (1u << bit);
                const int c = __popcll(__ballot(u0 >= cand)) + __popcll(__ballot(u1 >= cand));
                if (c >= 16) T = cand;
            }
            const unsigned long long g0 = __ballot(u0 > T), g1 = __ballot(u1 > T), e0 = __ballot(u0 == T), e1 = __ballot(u1 == T);
            const int need = 16 - (__popcll(g0) + __popcll(g1));
            const unsigned long long below = (F.lane == 0) ? 0ull : (~0ull >> (64 - F.lane));
            const int rank0 = __popcll(e0 & below), rank1 = __popcll(e0) + __popcll(e1 & below);
            s0 = (u0 > T) || (u0 == T && rank0 < need);
            s1 = (u1 > T) || (u1 == T && rank1 < need);
        }
        const unsigned long long m0 = __ballot(s0), m1 = __ballot(s1);
        if (F.lane == 0) { selm[tl * 4 + 0] = (unsigned)m0; selm[tl * 4 + 1] = (unsigned)(m0 >> 32); selm[tl * 4 + 2] = (unsigned)m1; selm[tl * 4 + 3] = (unsigned)(m1 >> 32); }
    }
    __syncthreads();
    const unsigned mk0 = selm[tokl * 4 + 0], mk1 = selm[tokl * 4 + 1], mk2 = selm[tokl * 4 + 2], mk3 = selm[tokl * 4 + 3];
    unsigned wo0 = 0u, wo1 = 0u, wo2 = 0u, wo3 = 0u;
#pragma unroll
    for (int tl = 0; tl < 8; ++tl) { wo0 |= selm[tl * 4 + 0]; wo1 |= selm[tl * 4 + 1]; wo2 |= selm[tl * 4 + 2]; wo3 |= selm[tl * 4 + 3]; }
    wo0 = __builtin_amdgcn_readfirstlane(wo0); wo1 = __builtin_amdgcn_readfirstlane(wo1); wo2 = __builtin_amdgcn_readfirstlane(wo2); wo3 = __builtin_amdgcn_readfirstlane(wo3);
    NSPIN(2);
    { m = NEGBIG; l = 0.f;
#pragma unroll
      for (int r = 0; r < 16; ++r) { o[0][r] = 0.f; o[1][r] = 0.f; }
      nsa_branch<2>(F, dob + DO_KSEL + img, dob + DO_VSEL + img, 0, qi + 1, qr, m, l, o, t, tw0, nv, nvw, nvmin, mk0, mk1, mk2, mk3, wo0, wo1, wo2, wo3, 0.f, impw);
      const float lt = l + __shfl_xor(l, 32); const float sc = (lt > 0.f) ? g1 / lt : 0.f;
#pragma unroll
      for (int r = 0; r < 16; ++r) { oaccw[r * 64] += sc * o[0][r]; oaccw[(16 + r) * 64] += sc * o[1][r]; } }
    NSPIN(3);
    { m = NEGBIG; l = 0.f;
#pragma unroll
      for (int r = 0; r < 16; ++r) { o[0][r] = 0.f; o[1][r] = 0.f; }
      nsa_branch<3>(F, dob + DO_KWIN + img, dob + DO_VWIN + img, (qi >= 8) ? qi - 8 : 0, qi + 1, qr, m, l, o, t, tw0, nv, nvw, nvmin, 0u, 0u, 0u, 0u, 0u, 0u, 0u, 0u, 0.f, impw);
      const float lt = l + __shfl_xor(l, 32); const float sc = (lt > 0.f) ? g2 / lt : 0.f;
#pragma unroll
      for (int r = 0; r < 16; ++r) { o[0][r] = oaccw[r * 64] + sc * o[0][r]; o[1][r] = oaccw[(16 + r) * 64] + sc * o[1][r]; } }
    NSPIN(4);
    bf16* orow = (bf16*)(F.ws + WS_O + 32 * MiB) + ((size_t)b * SEQ + t) * DM + 512 + (g * 4 + hh) * 64;
#pragma unroll
    for (int dh = 0; dh < 2; ++dh)
#pragma unroll
        for (int rg = 0; rg < 4; ++rg) { v2u w; w.x = pk2(o[dh][4 * rg], o[dh][4 * rg + 1]); w.y = pk2(o[dh][4 * rg + 2], o[dh][4 * rg + 3]);
            *(v2u*)(orow + 32 * dh + 8 * rg + 4 * hi) = w; }
    __syncthreads();
}

__device__ __forceinline__ void sgu_item(Frame& F, int item) {
    const int gg = item & 7, ck = (item >> 3) & 63, b = item >> 9;
    const size_t tok0 = (size_t)b * SEQ + ck * 128;
    const bf16* Z = (const bf16*)(F.ws + WS_A);
    constexpr int RS = 544, BS = 136;
    LAS bf16* Ws = (LAS bf16*)(F.lds + RING_OFF);
    LAS unsigned char* Vs = F.lds + RING_OFF + 34816;
    LAS float* rs = (LAS float*)(F.lds + RING_OFF + 34816 + 128 * RS);
    if (F.tid < 128) { const float* st = (const float*)(F.ws + WS_STATS) + (tok0 + F.tid) * 32; float sum = 0.f;
#pragma unroll
        for (int k = 0; k < 32; k += 4) { const f32x4 v = *(const f32x4*)(st + k); sum += (v.x + v.y) + (v.z + v.w); }
        rs[F.tid] = 1.0f / sqrtf(sum * (1.0f / SGW) + NORM_EPS); }
    { const float* wsrc = F.sgu_ws + (size_t)gg * 128 * 128;
#pragma unroll
      for (int k = 0; k < 8; ++k) { const int p = F.tid + 512 * k, tr = p >> 5, sc = (p & 31) * 4; const f32x4 w = *(const f32x4*)(wsrc + tr * 128 + sc);
          v2u o; o.x = pk2((sc <= tr) ? w.x : 0.f, (sc + 1 <= tr) ? w.y : 0.f); o.y = pk2((sc + 2 <= tr) ? w.z : 0.f, (sc + 3 <= tr) ? w.w : 0.f);
          *(LAS v2u*)(Ws + tr * 136 + sc) = o; } }
    __syncthreads();
    { const int cc = F.tid & 31; float gn[8];
#pragma unroll
      for (int i = 0; i < 8; ++i) gn[i] = F.sgu_ng[gg * 256 + cc * 8 + i];
      v4u zr[8];
#pragma unroll
      for (int k = 0; k < 8; ++k) { const int sidx = (F.tid >> 5) + 16 * k; zr[k] = *(const v4u*)(Z + (tok0 + sidx) * 4096 + 2048 + gg * 256 + cc * 8); }
#pragma unroll
      for (int k = 0; k < 8; ++k) { const int sidx = (F.tid >> 5) + 16 * k; float x[8]; unpack8(zr[k], x); const float rr = rs[sidx];
#pragma unroll
          for (int i = 0; i < 8; ++i) x[i] *= rr * gn[i];
          const v4u o = pack8(x); LAS unsigned char* dst = Vs + sidx * RS + (cc >> 3) * BS + (cc & 7) * 16;
          *(LAS v2u*)dst = (v2u){o.x, o.y}; *(LAS v2u*)(dst + 8) = (v2u){o.z, o.w}; } }
    __syncthreads();
    f32x4 acc[16];
#pragma unroll
    for (int nt = 0; nt < 16; ++nt) acc[nt] = (f32x4){0.f, 0.f, 0.f, 0.f};
    const int ksteps = (16 * F.wave + 16 + 31) >> 5;
    const LAS bf16* wp = Ws + (16 * F.wave + (F.lane & 15)) * 136 + (F.lane >> 4) * 8;
    const LAS unsigned char* vp = Vs + (8 * (F.lane >> 4) + ((F.lane & 15) >> 2)) * RS + (F.lane & 3) * BS;
#pragma unroll 1
    for (int kk = 0; kk < ksteps; ++kk) {
        const bf16x8 wf = *(const LAS bf16x8*)(wp + kk * 32);
        const LAS unsigned char* vk = vp + kk * 32 * RS;
#pragma unroll
        for (int nt = 0; nt < 16; ++nt) {
            const s16x4 lo = ds_tr16(vk + 8 * nt), hi4 = ds_tr16(vk + 4 * RS + 8 * nt);
            const bf16x8 vf = {lo[0], lo[1], lo[2], lo[3], hi4[0], hi4[1], hi4[2], hi4[3]};
            acc[nt] = __builtin_amdgcn_mfma_f32_16x16x32_bf16(vf, wf, acc[nt], 0, 0, 0);
        }
    }
    { const int tr = 16 * F.wave + (F.lane & 15), g = F.lane >> 4; const float bs = F.sgu_bs[gg * 128 + tr];
      const bf16* urow = Z + (tok0 + tr) * 4096 + gg * 256 + 64 * g; bf16* orow = (bf16*)(F.ws + WS_O) + (tok0 + tr) * SGW + gg * 256 + 64 * g;
#pragma unroll
      for (int j = 0; j < 8; ++j) { float u[8]; unpack8(*(const v4u*)(urow + 8 * j), u);
#pragma unroll
          for (int i = 0; i < 4; ++i) { u[i] *= acc[2 * j][i] + bs; u[4 + i] *= acc[2 * j + 1][i] + bs; }
          *(v4u*)(orow + 8 * j) = pack8(u); } }
    __syncthreads();
}


constexpr int NPHASE = 18;
struct Args { const void* in[26]; float* out; unsigned char* ws; int ph_lo, ph_hi, use_bar, pad; };
__global__ void __launch_bounds__(512, 2) trunk_fwd(Args args) {
    extern __shared__ __attribute__((aligned(16))) unsigned char lds[];
    Frame F;
    F.lds = (LAS unsigned char*)lds;
    F.MISC = (volatile LAS unsigned*)(F.lds + MISC_OFF);
    F.tid = threadIdx.x; F.lane = F.tid & 63; F.wave = __builtin_amdgcn_readfirstlane(F.tid >> 6);
    F.G = gridDim.x; F.bid = blockIdx.x;
    F.ws = args.ws; F.out = args.out; F.dout_b = (unsigned char*)args.out;
    F.ctl = (gu32*)(args.ws + WS_CTL);
    F.x = (const float*)args.in[0]; F.c = (const float*)args.in[1]; F.positions = (const int*)args.in[2]; F.w_ada = (const float*)args.in[3]; F.b_ada = (const float*)args.in[4];
    F.norm_g = (const float*)args.in[5]; F.w_in_ab = (const float*)args.in[6]; F.w_out_ab = (const float*)args.in[7]; F.gla_w2 = (const float*)args.in[8]; F.gla_bg = (const float*)args.in[9];
    F.gla_ng = (const float*)args.in[10]; F.q_gain = (const float*)args.in[11]; F.k_gain = (const float*)args.in[12]; F.cmp_pe = (const float*)args.in[13]; F.cmp_w1 = (const float*)args.in[14];
    F.cmp_w2 = (const float*)args.in[15]; F.w_in_c = (const float*)args.in[16]; F.sgu_ng = (const float*)args.in[17]; F.sgu_ws = (const float*)args.in[18]; F.sgu_bs = (const float*)args.in[19];
    F.w_out_c = (const float*)args.in[20]; F.w_router = (const float*)args.in[21]; F.r_bias = (const float*)args.in[22]; F.w_gate = (const float*)args.in[23]; F.w_up = (const float*)args.in[24];
    F.w_down = (const float*)args.in[25];
    for (int u = F.tid; u < (LDS_BYTES - LDSCTL_OFF) / 4; u += 512) ((LAS unsigned*)(F.lds + LDSCTL_OFF))[u] = 0u;
    __syncthreads();
    XcdBarrier bar; bar.bar = (unsigned*)(F.ctl + CW_BAR); bar.x = 0; bar.st = nullptr;
    if (args.use_bar) bar = xcd_barrier_post((unsigned*)(F.ctl + CW_BAR) + (args.use_bar - 1) * XCD_BAR_WORDS, F.MISC + 8);
    const int lo = args.ph_lo, hi = args.ph_hi;
#ifndef PH_MASK
#define PH_MASK 0x3FFFFu
#endif
#define IN(k) ((((PH_MASK) >> (k)) & 1u) && lo <= (k) && (k) < hi)
#if defined(SPIN_PHASE)
    unsigned long long t_mark = __builtin_amdgcn_s_memrealtime();
#define SPIN_HOOK(k) do { if ((k) == (SPIN_PHASE)) { const unsigned long long t1_ = __builtin_amdgcn_s_memrealtime(), dt_ = t1_ - t_mark; while (__builtin_amdgcn_s_memrealtime() - t1_ < dt_) __builtin_amdgcn_s_sleep(4); } } while (0)
#define SPIN_MARK() do { t_mark = __builtin_amdgcn_s_memrealtime(); } while (0)
#else
#define SPIN_HOOK(k) do { } while (0)
#define SPIN_MARK() do { } while (0)
#endif
#define SEAM(k) do { if (IN(k)) SPIN_HOOK(k); if (IN(k) && IN((k) + 1)) xcd_barrier(bar); SPIN_MARK(); } while (0)
    float* mod = (float*)(F.ws + WS_MOD);
    bf16* Hb = (bf16*)(F.ws + WS_O);
    bf16* Ab = (bf16*)(F.ws + WS_A);

    if (IN(0)) { p0_prologue(F); } SEAM(0);
    if (IN(1)) { row_pass<false, true, false>(F, F.x, mod, 0, F.norm_g, mod, 0, 0); } SEAM(1);
    if (IN(2)) { pg8::Gemm g{Hb, (const bf16*)(F.ws + WS_WIN), NTOK, NPROJ, DM}; pg8::StaticOrder S; S.init(NTOK, NPROJ, F.G, F.bid);
        pg8::EpiBf16<0> E{Ab, NPROJ, nullptr, 0, 0, 1.f};
        pg8::gemm_phase<pg8::EpiBf16<0>, pg8::StaticOrder, true, true>(F.lds + RING_OFF, g, S, E); } SEAM(2);
    if (IN(3)) {
        for (int it = F.bid; it < 1024; it += F.G) gla_prep_item(F, it);
        for (int tok = F.bid * 8 + F.wave; tok < NTOK; tok += F.G * 8) nsa_prep_token(F, tok);
    } SEAM(3);
    if (IN(4)) {
        const int half = F.G >> 1;
        if (F.bid < half) { for (int it = F.bid; it < 128; it += half) nsa_compress_item(F, it); }
        else { for (int gi = (F.bid - half) * 512 + F.tid; gi < 65536; gi += (F.G - half) * 512) gla_scan(F, gi); }
    } SEAM(4);
    if (IN(5)) {
#ifndef NO_NSA
        for (int p = F.bid; p < 256; p += F.G) { const int bg = p >> 6, i = p & 63; nsa_item(F, bg >> 1, bg & 1, i); nsa_item(F, bg >> 1, bg & 1, 127 - i); }
#endif
#ifndef NO_GLAOUT
#if defined(GLA_SPIN)
        { const unsigned long long tg0 = __builtin_amdgcn_s_memrealtime();
#endif
        for (int it = F.bid; it < 1024; it += F.G) gla_out_item(F, it);
#if defined(GLA_SPIN)
          const unsigned long long t1_ = __builtin_amdgcn_s_memrealtime(), dt_ = t1_ - tg0; while (__builtin_amdgcn_s_memrealtime() - t1_ < dt_) __builtin_amdgcn_s_sleep(4); }
#endif
#endif
    } SEAM(5);
    if (IN(6)) { pg8::Gemm g{(const bf16*)(F.ws + WS_O + 32 * MiB), (const bf16*)(F.ws + WS_WOUT), NTOK, DM, DM}; pg8::StaticOrder S; S.init(NTOK, DM, F.G, F.bid);
        EpiResid E{F.x, F.out, mod + 2 * 1024};
        pg8::gemm_phase<EpiResid, pg8::StaticOrder, true, true>(F.lds + RING_OFF, g, S, E); } SEAM(6);
#define MOE_BLOCK(P, LAYER) \
    if (IN(P)) { row_pass<false, true, true>(F, F.out, mod + (LAYER) * 2 * 6144, 3 * 1024, F.norm_g + ((LAYER) * 2 + 1) * 1024, mod, (LAYER), 0); } SEAM(P); \
    if (IN((P) + 1)) { moe_tables(F, (LAYER)); MoeOrder S{(const LAS int*)(F.lds + TAB_OFF), F.G, F.bid}; \
        { LAS unsigned* rofs = (LAS unsigned*)(F.lds + TAB_OFF + 2048); const int* elist = (const int*)(F.ws + WS_STATS); pg8::Unit uu; \
          for (int ui = 0; ui < 3; ++ui) if (S.next(ui, uu)) { if (F.tid < 256) rofs[ui * 256 + F.tid] = S.row_off(uu, F.tid, elist); } \
          __syncthreads(); } \
        pg8::Gemm g{Hb, (const bf16*)(F.ws + WS_WGU) + (size_t)(LAYER) * 16 * 1024 * 1024, MOE_ROWS, 1024, DM}; EpiMoeGU E{(bf16*)(F.ws + WS_A + A_HID_OFF)}; \
        pg8::gemm_phase_gather<EpiMoeGU, MoeOrder>(F.lds + RING_OFF, g, S, E, (const LAS unsigned*)(F.lds + TAB_OFF + 2048)); } SEAM((P) + 1); \
    if (IN((P) + 2)) { moe_tables(F, (LAYER)); MoeOrder S{(const LAS int*)(F.lds + TAB_OFF), F.G, F.bid}; \
        pg8::Gemm g{(const bf16*)(F.ws + WS_A + A_HID_OFF), (const bf16*)(F.ws + WS_WDN) + (size_t)(LAYER) * 16 * 1024 * 512, MOE_ROWS, 1024, EHID}; EpiMoeDn E{Ab}; \
        pg8::gemm_phase<EpiMoeDn, MoeOrder, true, true>(F.lds + RING_OFF, g, S, E); } SEAM((P) + 2);
    MOE_BLOCK(7, 0)
    if (IN(10)) { row_pass<true, true, false>(F, F.out, mod + 2 * 6144, 0, F.norm_g + 2 * 1024, mod, 1, 0); } SEAM(10);
    if (IN(11)) { pg8::Gemm g{Hb, (const bf16*)(F.ws + WS_WINC), NTOK, 4096, DM}; pg8::StaticOrder S; S.init(NTOK, 4096, F.G, F.bid);
        EpiGeluStats E{Ab, (float*)(F.ws + WS_STATS)};
        pg8::gemm_phase<EpiGeluStats, pg8::StaticOrder, true, true>(F.lds + RING_OFF, g, S, E); } SEAM(11);
    if (IN(12)) { for (int it = F.bid; it < 1024; it += F.G) sgu_item(F, it); } SEAM(12);
    if (IN(13)) { pg8::Gemm g{Hb, (const bf16*)(F.ws + WS_WOUTC), NTOK, DM, SGW}; pg8::StaticOrder S; S.init(NTOK, DM, F.G, F.bid);
        EpiResid E{F.out, F.out, mod + 2 * 6144 + 2 * 1024};
        pg8::gemm_phase<EpiResid, pg8::StaticOrder, true, true>(F.lds + RING_OFF, g, S, E); } SEAM(13);
    MOE_BLOCK(14, 1)
    if (IN(17)) { row_pass<true, false, false>(F, F.out, mod, 0, F.norm_g, mod + 2 * 6144, 1, 1); SPIN_HOOK(17); }
#undef IN
#undef SEAM
#undef MOE_BLOCK
}

#ifndef MK_N_LAUNCHES
#define MK_N_LAUNCHES 1
#endif
extern "C" void kernel_launch(void* const* d_in, const int* in_sizes, int n_in, void* d_out, int out_size, void* d_ws, size_t ws_size, hipStream_t stream) {
    static int grid = 0;
    if (grid == 0) {
        if (n_in != 26 || out_size != NTOK * DM || ws_size < WS_END) { fprintf(stderr, "kernel_launch: unexpected problem shape / workspace (%d inputs, out %d, ws %zu)\n", n_in, out_size, ws_size); grid = -1; return; }
        int dev = 0, cus = 0, per_cu = 0;
        if (hipGetDevice(&dev) != hipSuccess || hipDeviceGetAttribute(&cus, hipDeviceAttributeMultiprocessorCount, dev) != hipSuccess) { grid = -1; return; }
        if (hipFuncSetAttribute((const void*)trunk_fwd, hipFuncAttributeMaxDynamicSharedMemorySize, LDS_BYTES) != hipSuccess) { fprintf(stderr, "kernel_launch: hipFuncSetAttribute failed\n"); grid = -1; return; }
        if (hipOccupancyMaxActiveBlocksPerMultiprocessor(&per_cu, (const void*)trunk_fwd, 512, LDS_BYTES) != hipSuccess || per_cu < 1) { fprintf(stderr, "kernel_launch: occupancy query says %d blocks per CU\n", per_cu); }
        (void)hipGetLastError();
        grid = cus;
        if (grid != 256) { fprintf(stderr, "kernel_launch: built for a 256-CU device, found %d CUs\n", cus); grid = -1; return; }
    }
    if (grid < 0) return;
    (void)hipMemsetAsync((char*)d_ws + WS_CTL, 0, CTL_ZERO_BYTES, stream);
    Args a{};
    for (int i = 0; i < 26; ++i) a.in[i] = d_in[i];
    a.out = (float*)d_out; a.ws = (unsigned char*)d_ws; a.pad = 0;
    if (MK_N_LAUNCHES == 1) {
#if defined(REP_PHASE)
        a.ph_lo = 0; a.ph_hi = REP_PHASE + 1; a.use_bar = 1;
        hipLaunchKernelGGL(trunk_fwd, dim3(grid), dim3(512), LDS_BYTES, stream, a);
        a.ph_lo = REP_PHASE; a.ph_hi = NPHASE; a.use_bar = 2;
        hipLaunchKernelGGL(trunk_fwd, dim3(grid), dim3(512), LDS_BYTES, stream, a);
#else
        a.ph_lo = 0; a.ph_hi = NPHASE; a.use_bar = 1;
        hipLaunchKernelGGL(trunk_fwd, dim3(grid), dim3(512), LDS_BYTES, stream, a);
#endif
    } else {
        for (int p = 0; p < NPHASE; ++p) { a.ph_lo = p; a.ph_hi = p + 1; a.use_bar = 0; hipLaunchKernelGGL(trunk_fwd, dim3(grid), dim3(512), LDS_BYTES, stream, a); }
    }
}
```

```cpp
#include <hip/hip_runtime.h>
#include <cstdio>
#include <cstdint>
namespace pg8 {
#define PG8_LAS __attribute__((address_space(3)))
typedef unsigned short bf16_t;
typedef short bf16x8 __attribute__((ext_vector_type(8)));
typedef float f32x4 __attribute__((ext_vector_type(4)));
typedef unsigned u32x4 __attribute__((ext_vector_type(4)));
constexpr int BM = 256, BK = 64, HALF = 128, HTB = HALF * BK * 2  , STAGE_BYTES = 8 * HTB, NXCD = 8, WGM = 8;

__host__ __device__ __forceinline__ int lds_byte(int r, int c) { const int st = (r >> 4) * 2 + (c >> 5), rr = r & 15, cc = c & 31, ob = rr * 64 + cc * 2; return st * 1024 + (ob ^ (((ob >> 9) & 1) << 5)); }
__host__ __device__ __forceinline__ void stage_rc(int b, int& R, int& C) { const int st = b / 1024, sb = b % 1024, swz = sb ^ (((sb >> 9) & 1) << 5); R = (st >> 1) * 16 + swz / 64; C = (st & 1) * 32 + (swz % 64) / 2; }
__host__ __device__ __forceinline__ int perm32(int rho) { const int n = rho >> 4, i = rho & 15; return 8 * (i >> 2) + 4 * n + (i & 3); }

struct Unit { int pm, pn; };
struct Gemm { const bf16_t* A; const bf16_t* Bt; int M, N, K; };

struct StaticOrder {
    int nM, nN, nwg, G, c;
    __host__ __device__ void init(int M, int N, int G_, int c_) { nM = M / BM; nN = N / BM; nwg = nM * nN; G = G_; c = c_; }
    __host__ __device__ bool next(int i, Unit& u) const {
        const long L = (long)i * G + c; if (L >= nwg) return false;
        int wgid = (int)L; { const int q = nwg / NXCD, r = nwg % NXCD, xcd = wgid % NXCD, off = wgid / NXCD; wgid = (xcd < r ? xcd * (q + 1) : r * (q + 1) + (xcd - r) * q) + off; }
        const int nig = WGM * nN, gid = wgid / nig, fm = gid * WGM, gsz = (nM - fm) < WGM ? (nM - fm) : WGM;
        u.pm = fm + ((wgid % nig) % gsz); u.pn = (wgid % nig) / gsz; return true;
    }
    __device__ __forceinline__ void a_ready(const Unit&) const {}
    __device__ __forceinline__ void done(const Unit&) const {}
};

__device__ __forceinline__ unsigned cvt_pk_bf16(float lo, float hi) { unsigned r; asm volatile("v_cvt_pk_bf16_f32 %0, %1, %2" : "=v"(r) : "v"(lo), "v"(hi)); return r; }
typedef float f32x2 __attribute__((ext_vector_type(2)));
__device__ __forceinline__ f32x2 gelu_pk(f32x2 v) {
    const f32x2 av = __builtin_elementwise_abs(v), d = av * 0.2316418882f + 1.0f;
    f32x2 t; t.x = __builtin_amdgcn_rcpf(d.x); t.y = __builtin_amdgcn_rcpf(d.y);
    f32x2 q = t * 0.5307027145f + (-0.7265760135f); q = q * t + 0.7107068705f; q = q * t + (-0.142248368f); q = q * t + 0.127414796f; q = q * t;
    const f32x2 s = (v * v) * (-0.72134752044f);
    f32x2 e; e.x = __builtin_amdgcn_exp2f(s.x); e.y = __builtin_amdgcn_exp2f(s.y);
    const f32x2 m = v * (q * e), r = v - m;
    f32x2 o; o.x = v.x < 0.f ? m.x : r.x; o.y = v.y < 0.f ? m.y : r.y; return o;
}

template <int ACT  > struct EpiBf16 {
    static constexpr bool PERM = true, AFTER_DRAIN = false; static_assert(ACT == 0 || ACT == 1, "EpiBf16: ACT is 0 (none) or 1 (gelu_pk)");
    bf16_t* O; int ldc; const float* bias; int split_cols; size_t split_stride; float scale0;
    __device__ __forceinline__ void operator()(const f32x4 (&acc)[2][2][4][2], const Unit& u, int wr, int wc, int fr, int fq) const {
        const int row0 = u.pm * BM + wr * 64 + fr; int colt = u.pn * BM; bf16_t* base = O;
        float sc = 1.f; if (split_cols) { const int t = colt / split_cols; base += (size_t)t * split_stride; colt -= t * split_cols; if (t == 0) sc = scale0; }
        const int col0 = colt + wc * 32 + 8 * fq, bcol0 = u.pn * BM + wc * 32 + 8 * fq;
        f32x4 bv[2][2];
#pragma unroll
        for (int bj = 0; bj < 2; ++bj)
#pragma unroll
            for (int n = 0; n < 2; ++n) bv[bj][n] = bias ? *(const f32x4*)(bias + bcol0 + bj * HALF + 4 * n) : (f32x4){0.f, 0.f, 0.f, 0.f};
#pragma unroll
        for (int ai = 0; ai < 2; ++ai)
#pragma unroll
            for (int m = 0; m < 4; ++m) { bf16_t* rowp = base + (size_t)(row0 + ai * HALF + m * 16) * ldc + col0;
#pragma unroll
                for (int bj = 0; bj < 2; ++bj) { f32x4 v0 = acc[ai][bj][m][0] + bv[bj][0], v1 = acc[ai][bj][m][1] + bv[bj][1];
                    if (ACT == 1) { f32x2 a = gelu_pk((f32x2){v0[0], v0[1]}), b = gelu_pk((f32x2){v0[2], v0[3]}), c = gelu_pk((f32x2){v1[0], v1[1]}), d = gelu_pk((f32x2){v1[2], v1[3]});
                        v0 = (f32x4){a.x, a.y, b.x, b.y}; v1 = (f32x4){c.x, c.y, d.x, d.y}; }
                    v0 = v0 * sc; v1 = v1 * sc; u32x4 w; w.x = cvt_pk_bf16(v0[0], v0[1]); w.y = cvt_pk_bf16(v0[2], v0[3]); w.z = cvt_pk_bf16(v1[0], v1[1]); w.w = cvt_pk_bf16(v1[2], v1[3]);
                    *(u32x4*)(rowp + bj * HALF) = w; } }
    }
};

template <class Epi, class Sched, bool ALIGN_EPI = false, bool SP2 = false>
__device__ __forceinline__ void gemm_phase(PG8_LAS unsigned char* lds, const Gemm g, const Sched& S, const Epi& E) {
    const int tid = threadIdx.x, wid = __builtin_amdgcn_readfirstlane(tid >> 6), lane = tid & 63, wr = wid >> 2, wc = wid & 3, fr = lane & 15, fq = lane >> 4;
    const int K = g.K, nt = K / BK;
    unsigned voffA[2], voffB[2];
#pragma unroll
    for (int i = 0; i < 2; ++i) { int R, C; stage_rc(tid * 16 + i * 8192, R, C); const int Rb = Epi::PERM ? ((R & ~31) + perm32(R & 31)) : R;
        voffA[i] = (unsigned)(R * K + C) * 2u; voffB[i] = (unsigned)(Rb * K + C) * 2u; }
    const size_t kstep = (size_t)(BK * 2);
    const size_t hstep = (size_t)HALF * K * 2;
    const size_t tstep = 2 * hstep;
    const unsigned ldsw = (unsigned)wid * 1024u;
    const int aoff = lds_byte(wr * 64 + fr, fq * 8), boff = lds_byte(wc * 32 + fr, fq * 8);
#define PG8_SA(b, h) (((b) * 2 + (h)) * HTB)
#define PG8_SB(b, h) ((4 + (b) * 2 + (h)) * HTB)
#define PG8_STAGE(bufoff, gbase, voff) do { _Pragma("unroll") for (int _i = 0; _i < 2; ++_i) \
        __builtin_amdgcn_global_load_lds((const unsigned*)((const char*)(gbase) + (voff)[_i]), (PG8_LAS unsigned*)(lds + (bufoff) + ldsw + _i * 8192), 16, 0, 0); } while (0)
#define PG8_LDA(dst, b, h) do { _Pragma("unroll") for (int m = 0; m < 4; ++m) _Pragma("unroll") for (int k = 0; k < 2; ++k) dst[m][k] = *(const PG8_LAS bf16x8*)(lds + PG8_SA(b, h) + aoff + m * 2048 + k * 1024); } while (0)
#define PG8_LDB(dst, b, h) do { _Pragma("unroll") for (int n = 0; n < 2; ++n) _Pragma("unroll") for (int k = 0; k < 2; ++k) dst[n][k] = *(const PG8_LAS bf16x8*)(lds + PG8_SB(b, h) + boff + n * 2048 + k * 1024); } while (0)
#define PG8_MMA(ai, bj, At, Bt) do { __builtin_amdgcn_s_setprio(1); _Pragma("unroll") for (int m = 0; m < 4; ++m) _Pragma("unroll") for (int n = 0; n < 2; ++n) _Pragma("unroll") for (int k = 0; k < 2; ++k) \
        acc[ai][bj][m][n] = __builtin_amdgcn_mfma_f32_16x16x32_bf16(Bt[n][k], At[m][k], acc[ai][bj][m][n], 0, 0, 0); __builtin_amdgcn_s_setprio(0); } while (0)
#define PG8_WAIT_V(n) asm volatile("s_waitcnt vmcnt(" #n ")" ::: "memory")
#define PG8_WAIT_L(n) asm volatile("s_waitcnt lgkmcnt(" #n ")" ::: "memory")
#define PG8_BAR __builtin_amdgcn_s_barrier()
#define PG8_SCHED __builtin_amdgcn_sched_barrier(0)
    Unit cur, nxt; int ui = 0;
    if (!S.next(0, cur)) return;
    f32x4 acc[2][2][4][2];
#pragma unroll
    for (int a = 0; a < 2; ++a)
#pragma unroll
        for (int b = 0; b < 2; ++b)
#pragma unroll
            for (int m = 0; m < 4; ++m)
#pragma unroll
                for (int n = 0; n < 2; ++n) acc[a][b][m][n] = (f32x4){0.f, 0.f, 0.f, 0.f};
    bf16x8 At[4][2], B0[2][2], B1[2][2];
    const char* cA = (const char*)g.A + (size_t)cur.pm * tstep; const char* cB = (const char*)g.Bt + (size_t)cur.pn * tstep;
    S.a_ready(cur);
    if constexpr (SP2) {
        PG8_STAGE(PG8_SB(0, 0), cB, voffB); PG8_STAGE(PG8_SB(0, 1), cB + hstep, voffB); PG8_STAGE(PG8_SA(0, 0), cA, voffA); PG8_STAGE(PG8_SA(0, 1), cA + hstep, voffA);
        if (wr == 1) PG8_BAR;
        PG8_WAIT_V(2); PG8_BAR;
        PG8_STAGE(PG8_SB(1, 0), cB + kstep, voffB); PG8_STAGE(PG8_SA(1, 0), cA + kstep, voffA); PG8_STAGE(PG8_SB(1, 1), cB + hstep + kstep, voffB);
        PG8_WAIT_V(6); PG8_BAR;
    } else {
        PG8_STAGE(PG8_SB(0, 0), cB, voffB); PG8_STAGE(PG8_SA(0, 0), cA, voffA); PG8_STAGE(PG8_SB(0, 1), cB + hstep, voffB); PG8_STAGE(PG8_SA(0, 1), cA + hstep, voffA);
        if (wr == 1) PG8_BAR;
        PG8_WAIT_V(4); PG8_BAR;
        PG8_STAGE(PG8_SB(1, 0), cB + kstep, voffB); PG8_STAGE(PG8_SA(1, 0), cA + kstep, voffA); PG8_STAGE(PG8_SB(1, 1), cB + hstep + kstep, voffB);
        PG8_WAIT_V(6); PG8_BAR;
    }
    for (;;) {
        const bool has_next = S.next(ui + 1, nxt);
        const char* nA = has_next ? (const char*)g.A + (size_t)nxt.pm * tstep : cA; const char* nB = has_next ? (const char*)g.Bt + (size_t)nxt.pn * tstep : cB;
        for (int t = 0; t < nt; t += 2) {
            const bool last = (t == nt - 2);
            const char* a1 = cA + (size_t)(t + 1) * kstep;
            const char* a2 = last ? nA : cA + (size_t)(t + 2) * kstep; const char* b2 = last ? nB : cB + (size_t)(t + 2) * kstep;
            const char* a3 = a2 + kstep; const char* b3 = b2 + kstep;
            if (last && has_next) S.a_ready(nxt);
            if constexpr (SP2) {
            PG8_LDB(B0, 0, 0); PG8_LDB(B1, 0, 1); PG8_SCHED; PG8_LDA(At, 0, 0); PG8_STAGE(PG8_SA(1, 1), a1 + hstep, voffA);
            PG8_WAIT_V(8); PG8_WAIT_L(0); PG8_BAR; PG8_MMA(0, 0, At, B0); PG8_MMA(0, 1, At, B1); PG8_BAR; PG8_SCHED;
            PG8_LDA(At, 0, 1); PG8_STAGE(PG8_SB(0, 0), b2, voffB); PG8_STAGE(PG8_SB(0, 1), b2 + hstep, voffB); PG8_STAGE(PG8_SA(0, 0), a2, voffA);
            PG8_WAIT_V(8); PG8_WAIT_L(0); PG8_BAR; PG8_MMA(1, 0, At, B0); PG8_MMA(1, 1, At, B1); PG8_BAR; PG8_SCHED;
            PG8_LDB(B0, 1, 0); PG8_LDB(B1, 1, 1); PG8_SCHED; PG8_LDA(At, 1, 0); PG8_STAGE(PG8_SA(0, 1), a2 + hstep, voffA);
            PG8_WAIT_V(8); PG8_WAIT_L(0); PG8_BAR; PG8_MMA(0, 0, At, B0); PG8_MMA(0, 1, At, B1); PG8_BAR; PG8_SCHED;
            PG8_LDA(At, 1, 1); PG8_STAGE(PG8_SB(1, 0), b3, voffB); PG8_STAGE(PG8_SB(1, 1), b3 + hstep, voffB); PG8_STAGE(PG8_SA(1, 0), a3, voffA);
            PG8_WAIT_V(8); PG8_WAIT_L(0); PG8_BAR; PG8_MMA(1, 0, At, B0); PG8_MMA(1, 1, At, B1); PG8_BAR; PG8_SCHED;
            } else {
            PG8_LDB(B0, 0, 0); PG8_SCHED; PG8_LDA(At, 0, 0); PG8_STAGE(PG8_SA(1, 1), a1 + hstep, voffA);
            PG8_WAIT_L(8); PG8_BAR; PG8_WAIT_L(0); PG8_MMA(0, 0, At, B0); PG8_BAR; PG8_SCHED;
            PG8_LDB(B1, 0, 1); PG8_STAGE(PG8_SB(0, 0), b2, voffB);
            PG8_BAR; PG8_WAIT_L(0); PG8_MMA(0, 1, At, B1); PG8_BAR;
            PG8_LDA(At, 0, 1); PG8_STAGE(PG8_SA(0, 0), a2, voffA);
            PG8_BAR; PG8_WAIT_L(0); PG8_MMA(1, 0, At, B0); PG8_BAR; PG8_SCHED;
            PG8_STAGE(PG8_SB(0, 1), b2 + hstep, voffB);
            PG8_WAIT_V(6); PG8_BAR; PG8_MMA(1, 1, At, B1); PG8_BAR;
            PG8_LDB(B0, 1, 0); PG8_SCHED; PG8_LDA(At, 1, 0); PG8_STAGE(PG8_SA(0, 1), a2 + hstep, voffA);
            PG8_WAIT_L(8); PG8_BAR; PG8_WAIT_L(0); PG8_MMA(0, 0, At, B0); PG8_BAR; PG8_SCHED;
            PG8_LDB(B1, 1, 1); PG8_STAGE(PG8_SB(1, 0), b3, voffB);
            PG8_BAR; PG8_WAIT_L(0); PG8_MMA(0, 1, At, B1); PG8_BAR;
            PG8_LDA(At, 1, 1); PG8_STAGE(PG8_SA(1, 0), a3, voffA);
            PG8_BAR; PG8_WAIT_L(0); PG8_MMA(1, 0, At, B0); PG8_BAR; PG8_SCHED;
            PG8_STAGE(PG8_SB(1, 1), b3 + hstep, voffB);
            PG8_WAIT_V(6); PG8_BAR; PG8_MMA(1, 1, At, B1); PG8_BAR;
            }
        }
        if constexpr (ALIGN_EPI) { if (wr == 0) PG8_BAR; }
        if constexpr (!Epi::AFTER_DRAIN) { E(acc, cur, wr, wc, fr, fq); S.done(cur); }
        if (!has_next) break;
#pragma unroll
        for (int a = 0; a < 2; ++a)
#pragma unroll
            for (int b = 0; b < 2; ++b)
#pragma unroll
                for (int m = 0; m < 4; ++m)
#pragma unroll
                    for (int n = 0; n < 2; ++n) acc[a][b][m][n] = (f32x4){0.f, 0.f, 0.f, 0.f};
        cur = nxt; cA = nA; cB = nB; ++ui;
        if constexpr (ALIGN_EPI) { if (wr == 1) PG8_BAR; }
    }
    PG8_WAIT_V(0);
    if constexpr (!ALIGN_EPI) { if (wr == 0) PG8_BAR; }
    PG8_BAR;
    if constexpr (Epi::AFTER_DRAIN) { E.fused(acc, cur, wr, wc, fr, fq, lds, wid, lane); S.done(cur); }
#undef PG8_SA
#undef PG8_SB
#undef PG8_STAGE
#undef PG8_LDA
#undef PG8_LDB
#undef PG8_MMA
#undef PG8_WAIT_V
#undef PG8_WAIT_L
#undef PG8_BAR
#undef PG8_SCHED
}
}

#ifndef PG8_SP2
#define PG8_SP2 true
#endif

namespace pg8 {
template <class Epi, class Sched>
__device__ __forceinline__ void gemm_phase_gather(PG8_LAS unsigned char* lds, const Gemm g, const Sched& S, const Epi& E, const PG8_LAS unsigned* rofs) {
    const int tid = threadIdx.x, wid = __builtin_amdgcn_readfirstlane(tid >> 6), lane = tid & 63, wr = wid >> 2, wc = wid & 3, fr = lane & 15, fq = lane >> 4;
    const int K = g.K, nt = K / BK;
    unsigned voffB[2]; int RA[2]; unsigned CA[2];
#pragma unroll
    for (int i = 0; i < 2; ++i) { int R, C; stage_rc(tid * 16 + i * 8192, R, C); const int Rb = Epi::PERM ? ((R & ~31) + perm32(R & 31)) : R;
        RA[i] = R; CA[i] = (unsigned)C * 2u; voffB[i] = (unsigned)(Rb * K + C) * 2u; }
    const size_t kstep = (size_t)(BK * 2);
    const size_t hstep = (size_t)HALF * K * 2;
    const size_t tstep = 2 * hstep;
    const unsigned ldsw = (unsigned)wid * 1024u;
    const int aoff = lds_byte(wr * 64 + fr, fq * 8), boff = lds_byte(wc * 32 + fr, fq * 8);
#define PG8_SA(b, h) (((b) * 2 + (h)) * HTB)
#define PG8_SB(b, h) ((4 + (b) * 2 + (h)) * HTB)
#define PG8_STAGE(bufoff, gbase, voff) do { _Pragma("unroll") for (int _i = 0; _i < 2; ++_i) \
        __builtin_amdgcn_global_load_lds((const unsigned*)((const char*)(gbase) + (voff)[_i]), (PG8_LAS unsigned*)(lds + (bufoff) + ldsw + _i * 8192), 16, 0, 0); } while (0)
#define PG8_STAGE_A(bufoff, koff, v0, v1) do { \
        __builtin_amdgcn_global_load_lds((const unsigned*)((const char*)g.A + (koff) + (v0)), (PG8_LAS unsigned*)(lds + (bufoff) + ldsw), 16, 0, 0); \
        __builtin_amdgcn_global_load_lds((const unsigned*)((const char*)g.A + (koff) + (v1)), (PG8_LAS unsigned*)(lds + (bufoff) + ldsw + 8192), 16, 0, 0); } while (0)
#define PG8_LDA(dst, b, h) do { _Pragma("unroll") for (int m = 0; m < 4; ++m) _Pragma("unroll") for (int k = 0; k < 2; ++k) dst[m][k] = *(const PG8_LAS bf16x8*)(lds + PG8_SA(b, h) + aoff + m * 2048 + k * 1024); } while (0)
#define PG8_LDB(dst, b, h) do { _Pragma("unroll") for (int n = 0; n < 2; ++n) _Pragma("unroll") for (int k = 0; k < 2; ++k) dst[n][k] = *(const PG8_LAS bf16x8*)(lds + PG8_SB(b, h) + boff + n * 2048 + k * 1024); } while (0)
#define PG8_MMA(ai, bj, At, Bt) do { __builtin_amdgcn_s_setprio(1); _Pragma("unroll") for (int m = 0; m < 4; ++m) _Pragma("unroll") for (int n = 0; n < 2; ++n) _Pragma("unroll") for (int k = 0; k < 2; ++k) \
        acc[ai][bj][m][n] = __builtin_amdgcn_mfma_f32_16x16x32_bf16(Bt[n][k], At[m][k], acc[ai][bj][m][n], 0, 0, 0); __builtin_amdgcn_s_setprio(0); } while (0)
#define PG8_WAIT_V(n) asm volatile("s_waitcnt vmcnt(" #n ")" ::: "memory")
#define PG8_WAIT_L(n) asm volatile("s_waitcnt lgkmcnt(" #n ")" ::: "memory")
#define PG8_BAR __builtin_amdgcn_s_barrier()
#define PG8_SCHED __builtin_amdgcn_sched_barrier(0)
    Unit cur, nxt; int ui = 0;
    if (!S.next(0, cur)) return;
    f32x4 acc[2][2][4][2];
#pragma unroll
    for (int a = 0; a < 2; ++a)
#pragma unroll
        for (int b = 0; b < 2; ++b)
#pragma unroll
            for (int m = 0; m < 4; ++m)
#pragma unroll
                for (int n = 0; n < 2; ++n) acc[a][b][m][n] = (f32x4){0.f, 0.f, 0.f, 0.f};
    bf16x8 At[4][2], B0[2][2], B1[2][2];
    const char* cB = (const char*)g.Bt + (size_t)cur.pn * tstep;
    unsigned vc00 = rofs[RA[0]] + CA[0], vc01 = rofs[RA[1]] + CA[1], vc10 = rofs[128 + RA[0]] + CA[0], vc11 = rofs[128 + RA[1]] + CA[1];
    unsigned vn00 = vc00, vn01 = vc01, vn10 = vc10, vn11 = vc11;
    PG8_WAIT_L(0);
    PG8_STAGE(PG8_SB(0, 0), cB, voffB); PG8_STAGE(PG8_SB(0, 1), cB + hstep, voffB); PG8_STAGE_A(PG8_SA(0, 0), 0, vc00, vc01); PG8_STAGE_A(PG8_SA(0, 1), 0, vc10, vc11);
    if (wr == 1) PG8_BAR;
    PG8_WAIT_V(2); PG8_BAR;
    PG8_STAGE(PG8_SB(1, 0), cB + kstep, voffB); PG8_STAGE_A(PG8_SA(1, 0), kstep, vc00, vc01); PG8_STAGE(PG8_SB(1, 1), cB + hstep + kstep, voffB);
    PG8_WAIT_V(6); PG8_BAR;
    for (;;) {
        const bool has_next = S.next(ui + 1, nxt);
        const char* nB = has_next ? (const char*)g.Bt + (size_t)nxt.pn * tstep : cB;
        if (has_next) { const PG8_LAS unsigned* rn = rofs + (ui + 1) * 256; vn00 = rn[RA[0]] + CA[0]; vn01 = rn[RA[1]] + CA[1]; vn10 = rn[128 + RA[0]] + CA[0]; vn11 = rn[128 + RA[1]] + CA[1]; }
        else { vn00 = vc00; vn01 = vc01; vn10 = vc10; vn11 = vc11; }
        for (int t = 0; t < nt; t += 2) {
            const bool last = (t == nt - 2);
            const size_t k1 = (size_t)(t + 1) * kstep;
            const size_t k2 = last ? 0 : (size_t)(t + 2) * kstep; const char* b2 = last ? nB : cB + (size_t)(t + 2) * kstep;
            const size_t k3 = k2 + kstep; const char* b3 = b2 + kstep;
            const unsigned w00 = last ? vn00 : vc00, w01 = last ? vn01 : vc01, w10 = last ? vn10 : vc10, w11 = last ? vn11 : vc11;
            PG8_LDB(B0, 0, 0); PG8_LDB(B1, 0, 1); PG8_SCHED; PG8_LDA(At, 0, 0); PG8_STAGE_A(PG8_SA(1, 1), k1, vc10, vc11);
            PG8_WAIT_V(8); PG8_WAIT_L(0); PG8_BAR; PG8_MMA(0, 0, At, B0); PG8_MMA(0, 1, At, B1); PG8_BAR; PG8_SCHED;
            PG8_LDA(At, 0, 1); PG8_STAGE(PG8_SB(0, 0), b2, voffB); PG8_STAGE(PG8_SB(0, 1), b2 + hstep, voffB); PG8_STAGE_A(PG8_SA(0, 0), k2, w00, w01);
            PG8_WAIT_V(8); PG8_WAIT_L(0); PG8_BAR; PG8_MMA(1, 0, At, B0); PG8_MMA(1, 1, At, B1); PG8_BAR; PG8_SCHED;
            PG8_LDB(B0, 1, 0); PG8_LDB(B1, 1, 1); PG8_SCHED; PG8_LDA(At, 1, 0); PG8_STAGE_A(PG8_SA(0, 1), k2, w10, w11);
            PG8_WAIT_V(8); PG8_WAIT_L(0); PG8_BAR; PG8_MMA(0, 0, At, B0); PG8_MMA(0, 1, At, B1); PG8_BAR; PG8_SCHED;
            PG8_LDA(At, 1, 1); PG8_STAGE(PG8_SB(1, 0), b3, voffB); PG8_STAGE(PG8_SB(1, 1), b3 + hstep, voffB); PG8_STAGE_A(PG8_SA(1, 0), k3, w00, w01);
            PG8_WAIT_V(8); PG8_WAIT_L(0); PG8_BAR; PG8_MMA(1, 0, At, B0); PG8_MMA(1, 1, At, B1); PG8_BAR; PG8_SCHED;
        }
        if (wr == 0) PG8_BAR;
        E(acc, cur, wr, wc, fr, fq); S.done(cur);
        if (!has_next) break;
#pragma unroll
        for (int a = 0; a < 2; ++a)
#pragma unroll
            for (int b = 0; b < 2; ++b)
#pragma unroll
                for (int m = 0; m < 4; ++m)
#pragma unroll
                    for (int n = 0; n < 2; ++n) acc[a][b][m][n] = (f32x4){0.f, 0.f, 0.f, 0.f};
        cur = nxt; cB = nB; ++ui; vc00 = vn00; vc01 = vn01; vc10 = vn10; vc11 = vn11;
        if (wr == 1) PG8_BAR;
    }
    PG8_WAIT_V(0);
    PG8_BAR;
#undef PG8_SA
#undef PG8_SB
#undef PG8_STAGE
#undef PG8_STAGE_A
#undef PG8_LDA
#undef PG8_LDB
#undef PG8_MMA
#undef PG8_WAIT_V
#undef PG8_WAIT_L
#undef PG8_BAR
#undef PG8_SCHED
}
}

constexpr int NB = 2, SEQ = 8192, DM = 1024, NTOK = NB * SEQ;
constexpr int NPROJ = 3072;
constexpr int C_GQ = 0, C_GK = 256, C_GV = 512, C_GR = 1024, C_NQ = 1536, C_KC = 2048, C_VC = 2176, C_KS = 2304, C_VS = 2432, C_KW = 2560, C_VW = 2688, C_GLR = 2816, C_NG = 2832, C_END = 2856;
constexpr int SGW = 2048;
constexpr int NEXP = 16, EHID = 512;
constexpr int MOE_ROWS = 36864;
constexpr float NORM_EPS = 1e-6f;
constexpr float NEGBIG = -1e30f;

constexpr size_t MiB = 1u << 20;
constexpr size_t WS_CTL = 0, CTL_ZERO_BYTES = 1 * MiB;
constexpr size_t WS_MOD = 1 * MiB;
constexpr size_t WS_ROUTE = 2 * MiB;
constexpr size_t WS_GATES = 3 * MiB;
constexpr size_t WS_STATS = 5 * MiB;
constexpr size_t WS_DEC = 7 * MiB;
constexpr size_t WS_WIN = 8 * MiB;
constexpr size_t WS_WOUT = 14 * MiB;
constexpr size_t WS_WINC = 16 * MiB;
constexpr size_t WS_WOUTC = 24 * MiB;
constexpr size_t WS_WCW1 = 28 * MiB;
constexpr size_t WS_WGU = 30 * MiB;
constexpr size_t WS_WDN = 94 * MiB;
constexpr size_t WS_A = 126 * MiB;
constexpr size_t WS_O = 254 * MiB;
constexpr size_t WS_END = 318 * MiB;
constexpr size_t A_HID_OFF = 72 * MiB;
constexpr size_t DO_QN = 0;
constexpr size_t DO_KSEL = 16 * MiB, DO_VSEL = 20 * MiB, DO_KWIN = 24 * MiB, DO_VWIN = 28 * MiB;
constexpr size_t DO_KC = 32 * MiB, DO_VC = 36 * MiB + 65536;
constexpr size_t DO_KCMP = 41 * MiB, DO_VCMP = 41 * MiB + 512 * 1024;

constexpr int CW_TMO = 0, CW_CODE = 1;
constexpr int CW_BAR = 4096;
constexpr int CW_CNT = 16384;

constexpr int RING_OFF = 0, RING_BYTES = 131072;
constexpr int LDSCTL_OFF = RING_BYTES, MISC_OFF = LDSCTL_OFF + 320;
constexpr int TAB_OFF = LDSCTL_OFF + 1024;
constexpr int LDS_BYTES = 147456;

#define GAS __attribute__((address_space(1)))
#define LAS __attribute__((address_space(3)))
typedef unsigned short bf16;
typedef unsigned v4u __attribute__((ext_vector_type(4)));
typedef unsigned v2u __attribute__((ext_vector_type(2)));
typedef float f32x4 __attribute__((ext_vector_type(4)));
typedef float f32x2 __attribute__((ext_vector_type(2)));
typedef float f32x16 __attribute__((ext_vector_type(16)));
typedef short bf16x8 __attribute__((ext_vector_type(8)));
typedef short s16x4 __attribute__((ext_vector_type(4)));
typedef GAS unsigned gu32;
#define RLX_AGENT __ATOMIC_RELAXED, __HIP_MEMORY_SCOPE_AGENT
#define LDS_WAIT() asm volatile("s_waitcnt lgkmcnt(0)" ::: "memory")
#define VM_WAIT() asm volatile("s_waitcnt vmcnt(0)" ::: "memory")
__device__ __forceinline__ unsigned f2bf(float f) { unsigned u = __builtin_bit_cast(unsigned, f); return (u + 0x7fffu + ((u >> 16) & 1u)) >> 16; }
__device__ __forceinline__ unsigned pk2(float lo, float hi) { return f2bf(lo) | (f2bf(hi) << 16); }
__device__ __forceinline__ float bf2f(unsigned short b) { return __builtin_bit_cast(float, (unsigned)b << 16); }
__device__ __forceinline__ float bflo(unsigned w) { return __builtin_bit_cast(float, w << 16); }
__device__ __forceinline__ float bfhi(unsigned w) { return __builtin_bit_cast(float, w & 0xffff0000u); }
__device__ __forceinline__ float fexp2(float x) { return __builtin_amdgcn_exp2f(x); }
__device__ __forceinline__ float fexp(float x) { return __builtin_amdgcn_exp2f(x * 1.4426950408889634f); }
__device__ __forceinline__ float frcp(float x) { return __builtin_amdgcn_rcpf(x); }
__device__ __forceinline__ float sigmoidf_(float x) { return frcp(1.0f + __expf(-x)); }
__device__ __forceinline__ float siluf_(float x) { return x * frcp(1.0f + __expf(-x)); }
__device__ __forceinline__ float gelu_tanh(float x) {
    const float u = 0.7978845608028654f * (x + 0.044715f * x * x * x);
    return x * frcp(1.0f + __expf(-2.0f * u));
}
__device__ __forceinline__ float wave_sum(float v) {
#pragma unroll
    for (int o = 1; o < 64; o <<= 1) v += __shfl_xor(v, o);
    return v;
}
__device__ __forceinline__ void unpack8(const v4u w, float (&f)[8]) {
    f[0] = bflo(w.x); f[1] = bfhi(w.x); f[2] = bflo(w.y); f[3] = bfhi(w.y); f[4] = bflo(w.z); f[5] = bfhi(w.z); f[6] = bflo(w.w); f[7] = bfhi(w.w);
}
__device__ __forceinline__ v4u pack8(const float (&f)[8]) { v4u w; w.x = pk2(f[0], f[1]); w.y = pk2(f[2], f[3]); w.z = pk2(f[4], f[5]); w.w = pk2(f[6], f[7]); return w; }

#define XB_TMO      128
#define XB_XCNT(j)  (256  + 64 * (j))
#define XB_XSUB(j)  (1280 + 64 * (j))
#define XB_XGEN(j)  (2304 + 64 * (j))
#define XB_TOP      3328
#define XB_TOPGEN   3392
#define XCD_BAR_WORDS 3456
#define XB_SPIN_CAP (1u << 18)

__device__ __forceinline__ unsigned xb_ld(unsigned* p)              { return __hip_atomic_load(p, __ATOMIC_RELAXED, __HIP_MEMORY_SCOPE_AGENT); }
__device__ __forceinline__ unsigned xb_add(unsigned* p, unsigned v) { return __hip_atomic_fetch_add(p, v, __ATOMIC_RELAXED, __HIP_MEMORY_SCOPE_AGENT); }
__device__ __forceinline__ unsigned xb_xcc_id() { return (unsigned)__builtin_amdgcn_s_getreg((3 << 11) | 20) & 0xFu; }
#define XB_SPIN(cond, bar) do { unsigned _sp = 0; while (cond) { __builtin_amdgcn_s_sleep(1); \
    if ((++_sp & 255u) == 0u) { if (xb_ld(&(bar)[XB_TMO])) break; if (_sp > XB_SPIN_CAP) { atomicAdd(&(bar)[XB_TMO], 1u); break; } } } } while (0)

struct XcdBarrier {
    unsigned* bar; unsigned x;
    volatile LAS unsigned* st;
};
__device__ __forceinline__ XcdBarrier xcd_barrier_post(unsigned* bar, volatile LAS unsigned* st) {
    XcdBarrier b; b.bar = bar; b.x = xb_xcc_id(); b.st = st;
    if (threadIdx.x == 0) (void)xb_add(&bar[XB_XCNT(b.x)], 1u);
    return b;
}
__device__ __forceinline__ void xcd_barrier_complete(unsigned* bar, unsigned x, unsigned& nloc, unsigned& nx) {
    const unsigned G = gridDim.x * gridDim.y * gridDim.z;
    unsigned sum, cnt, mine, sp = 0u;
    for (;;) {
        sum = 0u; cnt = 0u; mine = 0u;
#pragma unroll
        for (unsigned j = 0; j < 16; ++j) { const unsigned c = xb_ld(&bar[XB_XCNT(j)]); sum += c; cnt += (c > 0u) ? 1u : 0u; mine = (j == x) ? c : mine; }
        if (sum == G) break;
        __builtin_amdgcn_s_sleep(1);
        if ((++sp & 255u) == 0u) { if (xb_ld(&bar[XB_TMO])) break; if (sp > XB_SPIN_CAP) { atomicAdd(&bar[XB_TMO], 1u); break; } }
    }
    nloc = mine > 0u ? mine : 1u; nx = cnt > 0u ? cnt : 1u;
}
__device__ __forceinline__ void xcd_barrier(const XcdBarrier& b) {
    asm volatile("s_waitcnt vmcnt(0)" ::: "memory");
    __syncthreads();
    if (threadIdx.x == 0) {
        unsigned* bar = b.bar;
        __builtin_amdgcn_s_waitcnt(0);
        unsigned nloc = b.st[0], nx = b.st[1];
        if (nloc == 0u) { xcd_barrier_complete(bar, b.x, nloc, nx); b.st[0] = nloc; b.st[1] = nx; }
        const unsigned old = xb_add(&bar[XB_XSUB(b.x)], 1u);
        const unsigned gen = old / nloc;
        if (old + 1u == (gen + 1u) * nloc) {
            __builtin_amdgcn_fence(__ATOMIC_RELEASE, "agent");
            asm volatile("s_waitcnt vmcnt(0)" ::: "memory");
            const unsigned og = xb_add(&bar[XB_TOP], 1u);
            const unsigned tg = og / nx;
            if (og + 1u == (tg + 1u) * nx) xb_add(&bar[XB_TOPGEN], 1u);
            else XB_SPIN(xb_ld(&bar[XB_TOPGEN]) == tg, bar);
            __builtin_amdgcn_fence(__ATOMIC_ACQUIRE, "agent");
            xb_add(&bar[XB_XGEN(b.x)], 1u);
            asm volatile("s_waitcnt vmcnt(0)" ::: "memory");
        } else {
            XB_SPIN(xb_ld(&bar[XB_XGEN(b.x)]) == gen, bar);
            __builtin_amdgcn_fence(__ATOMIC_ACQUIRE, "agent");
            asm volatile("s_waitcnt vmcnt(0)" ::: "memory");
        }
    }
    __syncthreads();
}

struct Frame {
    LAS unsigned char* lds;
    volatile LAS unsigned* MISC;
    gu32* ctl;
    int tid, lane, wave;
    int bid, G;
    unsigned char* ws;
    unsigned char* dout_b;
    float* out;
    const float *x, *c, *w_ada, *b_ada, *norm_g, *w_in_ab, *w_out_ab, *gla_w2, *gla_bg, *gla_ng, *q_gain, *k_gain, *cmp_pe, *cmp_w1, *cmp_w2, *w_in_c, *sgu_ng, *sgu_ws, *sgu_bs, *w_out_c, *w_router, *r_bias, *w_gate, *w_up, *w_down;
    const int* positions;
};

struct EpiResid {
    static constexpr bool PERM = false, AFTER_DRAIN = false;
    const float* xin; float* xout; const float* gate;
    __device__ __forceinline__ void operator()(const pg8::f32x4 (&acc)[2][2][4][2], const pg8::Unit& u, int wr, int wc, int fr, int fq) const {
        const int row0 = u.pm * 256 + wr * 64 + fr, col0 = u.pn * 256 + wc * 32 + 4 * fq;
        const float* gb = gate + ((u.pm * 256 >= SEQ) ? 6144 : 0);
        f32x4 gv[2][2];
#pragma unroll
        for (int bj = 0; bj < 2; ++bj)
#pragma unroll
            for (int n = 0; n < 2; ++n) gv[bj][n] = *(const f32x4*)(gb + col0 + bj * 128 + n * 16);
#pragma unroll
        for (int ai = 0; ai < 2; ++ai)
#pragma unroll
            for (int m = 0; m < 4; ++m) {
                const size_t rb = (size_t)(row0 + ai * 128 + m * 16) * DM;
#pragma unroll
                for (int bj = 0; bj < 2; ++bj)
#pragma unroll
                    for (int n = 0; n < 2; ++n) {
                        const size_t p = rb + col0 + bj * 128 + n * 16;
                        const f32x4 xi = *(const f32x4*)(xin + p);
                        *(f32x4*)(xout + p) = xi + gv[bj][n] * acc[ai][bj][m][n];
                    }
            }
    }
};
struct EpiGeluStats {
    static constexpr bool PERM = true, AFTER_DRAIN = false;
    bf16* Z; float* stats;
    __device__ __forceinline__ void operator()(const pg8::f32x4 (&acc)[2][2][4][2], const pg8::Unit& u, int wr, int wc, int fr, int fq) const {
        const int row0 = u.pm * 256 + wr * 64 + fr, col0 = u.pn * 256 + wc * 32 + 8 * fq;
#pragma unroll
        for (int ai = 0; ai < 2; ++ai)
#pragma unroll
            for (int m = 0; m < 4; ++m) {
                const int row = row0 + ai * 128 + m * 16; float ss = 0.f;
#pragma unroll
                for (int bj = 0; bj < 2; ++bj) {
                    float g[8];
#pragma unroll
                    for (int n = 0; n < 2; ++n)
#pragma unroll
                        for (int i = 0; i < 4; ++i) { g[n * 4 + i] = gelu_tanh(acc[ai][bj][m][n][i]); ss += g[n * 4 + i] * g[n * 4 + i]; }
                    *(v4u*)(Z + (size_t)row * 4096 + col0 + bj * 128) = pack8(g);
                }
                if (u.pn >= 8) {
                    ss += __shfl_xor(ss, 16); ss += __shfl_xor(ss, 32);
                    if (fq == 0) stats[(size_t)row * 32 + (u.pn - 8) * 4 + wc] = ss;
                }
            }
    }
};
struct EpiMoeGU {
    static constexpr bool PERM = true, AFTER_DRAIN = false;
    bf16* HID;
    __device__ __forceinline__ void operator()(const pg8::f32x4 (&acc)[2][2][4][2], const pg8::Unit& u, int wr, int wc, int fr, int fq) const {
        const int row0 = u.pm * 256 + wr * 64 + fr, col0 = (u.pn & 3) * 128 + wc * 32 + 8 * fq;
#pragma unroll
        for (int ai = 0; ai < 2; ++ai)
#pragma unroll
            for (int m = 0; m < 4; ++m) {
                float h[8];
#pragma unroll
                for (int n = 0; n < 2; ++n)
#pragma unroll
                    for (int i = 0; i < 4; ++i) h[n * 4 + i] = siluf_(acc[ai][0][m][n][i]) * acc[ai][1][m][n][i];
                *(v4u*)(HID + (size_t)(row0 + ai * 128 + m * 16) * EHID + col0) = pack8(h);
            }
    }
};
struct EpiMoeDn {
    static constexpr bool PERM = true, AFTER_DRAIN = false;
    bf16* YM;
    __device__ __forceinline__ void operator()(const pg8::f32x4 (&acc)[2][2][4][2], const pg8::Unit& u, int wr, int wc, int fr, int fq) const {
        const int row0 = u.pm * 256 + wr * 64 + fr, col0 = (u.pn & 3) * 256 + wc * 32 + 8 * fq;
#pragma unroll
        for (int ai = 0; ai < 2; ++ai)
#pragma unroll
            for (int m = 0; m < 4; ++m)
#pragma unroll
                for (int bj = 0; bj < 2; ++bj) {
                    float h[8];
#pragma unroll
                    for (int n = 0; n < 2; ++n)
#pragma unroll
                        for (int i = 0; i < 4; ++i) h[n * 4 + i] = acc[ai][bj][m][n][i];
                    *(v4u*)(YM + (size_t)(row0 + ai * 128 + m * 16) * DM + col0 + bj * 128) = pack8(h);
                }
    }
};
struct MoeOrder {
    const LAS int* ppre; int G, c;
    __device__ __forceinline__ unsigned row_off(const pg8::Unit& u, int r, const int* elist) const {
        const int e = u.pn >> 2, li = (u.pm - ppre[e]) * 256 + r;
        const int tok = (li < ppre[32 + e]) ? elist[e * 16384 + li] : 0;
        return (unsigned)tok * 2048u;
    }
    __device__ __forceinline__ bool next(int i, pg8::Unit& u) const {
        const int L = i * G + c, np = ppre[16];
        if (L >= np * 4) return false;
        const int pm = L >> 2; int e = 0;
#pragma unroll
        for (int k = 1; k < 16; ++k) e += (ppre[k] <= pm) ? 1 : 0;
        u.pm = pm; u.pn = e * 4 + (L & 3); return true;
    }
    __device__ __forceinline__ void a_ready(const pg8::Unit&) const {}
    __device__ __forceinline__ void done(const pg8::Unit&) const {}
};

__device__ __forceinline__ int dest_row(int mode, int n) {
    if (mode == 1) return (n < 1024) ? n : (n < 1040) ? n + 1792 : (n < 2832) ? n - 16 : n;
    if (mode == 2) return (n >> 7) * 256 + (n & 127);
    if (mode == 3) return (n >> 7) * 256 + 128 + (n & 127);
    return n;
}
struct TrItem { const float* src; bf16* dst; int K, N, mode, r; };
__device__ __forceinline__ int tr_count(int set) { return set == 0 ? (720 + 256 + 256 + 3 * 2048) : set == 1 ? (1024 + 512 + 2048 + 1024) : (1024 + 2048); }
__device__ __forceinline__ bool tr_decode(Frame& F, int set, int it, TrItem& t) {
    if (it >= tr_count(set)) return false;
    int r = it; t.mode = 0;
    if (set == 0) {
        constexpr int I_IN = 16 * 45, I_OUT = 16 * 16, I_CW1 = 2 * 32 * 4, I_E = 16 * 128;
        if (r < I_IN) { t.src = F.w_in_ab; t.dst = (bf16*)(F.ws + WS_WIN); t.K = 1024; t.N = 2856; t.mode = 1; }
        else if ((r -= I_IN) < I_OUT) { t.src = F.w_out_ab; t.dst = (bf16*)(F.ws + WS_WOUT); t.K = 1024; t.N = 1024; }
        else if ((r -= I_OUT) < I_CW1) { const int m = r >> 7; r &= 127; t.src = F.cmp_w1 + (size_t)m * 2048 * 256; t.dst = (bf16*)(F.ws + WS_WCW1) + (size_t)m * 256 * 2048; t.K = 2048; t.N = 256; }
        else if ((r -= I_CW1) < I_E) { const int m = r >> 7; r &= 127; t.src = F.w_gate + (size_t)m * 1024 * 512; t.dst = (bf16*)(F.ws + WS_WGU) + (size_t)m * 1024 * 1024; t.K = 1024; t.N = 512; t.mode = 2; }
        else if ((r -= I_E) < I_E) { const int m = r >> 7; r &= 127; t.src = F.w_up + (size_t)m * 1024 * 512; t.dst = (bf16*)(F.ws + WS_WGU) + (size_t)m * 1024 * 1024; t.K = 1024; t.N = 512; t.mode = 3; }
        else { r -= I_E; const int m = r >> 7; r &= 127; t.src = F.w_down + (size_t)m * 512 * 1024; t.dst = (bf16*)(F.ws + WS_WDN) + (size_t)m * 1024 * 512; t.K = 512; t.N = 1024; }
    } else if (set == 1) {
        constexpr int I_INC = 16 * 64, I_OUTC = 32 * 16;
        if (r < I_INC) { t.src = F.w_in_c; t.dst = (bf16*)(F.ws + WS_WINC); t.K = 1024; t.N = 4096; }
        else if ((r -= I_INC) < I_OUTC) { t.src = F.w_out_c; t.dst = (bf16*)(F.ws + WS_WOUTC); t.K = 2048; t.N = 1024; }
        else if ((r -= I_OUTC) < 2048) { const int m = 16 + (r >> 7); r &= 127; t.src = F.w_gate + (size_t)m * 1024 * 512; t.dst = (bf16*)(F.ws + WS_WGU) + (size_t)m * 1024 * 1024; t.K = 1024; t.N = 512; t.mode = 2; }
        else { r -= 2048; const int m = 16 + (r >> 7); r &= 127; t.src = F.w_up + (size_t)m * 1024 * 512; t.dst = (bf16*)(F.ws + WS_WGU) + (size_t)m * 1024 * 1024; t.K = 1024; t.N = 512; t.mode = 3; }
    } else {
        constexpr int I_E = 8 * 128;
        if (r < I_E) { const int m = 24 + (r >> 7); r &= 127; t.src = F.w_up + (size_t)m * 1024 * 512; t.dst = (bf16*)(F.ws + WS_WGU) + (size_t)m * 1024 * 1024; t.K = 1024; t.N = 512; t.mode = 3; }
        else { r -= I_E; const int m = 16 + (r >> 7); r &= 127; t.src = F.w_down + (size_t)m * 512 * 1024; t.dst = (bf16*)(F.ws + WS_WDN) + (size_t)m * 1024 * 512; t.K = 512; t.N = 1024; }
    }
    t.r = r; return true;
}
__device__ __forceinline__ void tr_load(const TrItem& t, int lane, f32x4 (&va)[8], f32x4 (&vb)[8]) {
    const int nblk = (t.N + 63) / 64, kb = t.r / nblk, nb = t.r % nblk, k0 = 64 * kb, n0 = 64 * nb;
    const int q = lane & 15, r4 = lane >> 4, col = n0 + 4 * q;
    const float* wp = t.src + (size_t)(k0 + 2 * r4) * t.N + col;
#pragma unroll
    for (int i = 0; i < 8; ++i) {
        if (col < t.N) { va[i] = *(const f32x4*)(wp + (size_t)(8 * i) * t.N); vb[i] = *(const f32x4*)(wp + (size_t)(8 * i + 1) * t.N); }
        else { va[i] = (f32x4){0.f, 0.f, 0.f, 0.f}; vb[i] = va[i]; }
    }
}
__device__ __forceinline__ void tr_finish(const TrItem& t, int lane, const f32x4 (&va)[8], const f32x4 (&vb)[8], LAS unsigned char* scr) {
    const int nblk = (t.N + 63) / 64, kb = t.r / nblk, nb = t.r % nblk, k0 = 64 * kb, n0 = 64 * nb;
    const int q = lane & 15, r4 = lane >> 4;
#pragma unroll
    for (int i = 0; i < 8; ++i) {
        const int kp = 4 * i + r4;
        LAS unsigned* tt = (LAS unsigned*)(scr + (4 * q) * 144 + 4 * kp);
        tt[0] = pk2(va[i].x, vb[i].x); tt[36] = pk2(va[i].y, vb[i].y); tt[72] = pk2(va[i].z, vb[i].z); tt[108] = pk2(va[i].w, vb[i].w);
    }
    LDS_WAIT(); asm volatile("" ::: "memory");
    const int c = lane & 7;
#pragma unroll
    for (int j = 0; j < 8; ++j) { const int n = (lane >> 3) + 8 * j;
        const v4u o = *(const LAS v4u*)(scr + n * 144 + 16 * c);
        if (n0 + n < t.N) *(GAS v4u*)(t.dst + (size_t)dest_row(t.mode, n0 + n) * t.K + k0 + 8 * c) = o; }
    LDS_WAIT(); asm volatile("" ::: "memory");
}
__device__ __forceinline__ void tr_run(Frame& F, int set, int w0, int nw) {
    LAS unsigned char* scr = F.lds + RING_OFF + 8192 + F.wave * 12288;
    TrItem ta, tb; f32x4 a0[8], a1[8], b0[8], b1[8];
    int it = w0; bool ha = tr_decode(F, set, it, ta);
    if (ha) tr_load(ta, F.lane, a0, a1);
    while (ha) {
        const bool hb = tr_decode(F, set, it + nw, tb);
        if (hb) tr_load(tb, F.lane, b0, b1);
        tr_finish(ta, F.lane, a0, a1, scr);
        if (!hb) break;
        it += 2 * nw; ha = tr_decode(F, set, it, ta);
        if (ha) tr_load(ta, F.lane, a0, a1);
        tr_finish(tb, F.lane, b0, b1, scr);
    }
}
__device__ __forceinline__ void p0_prologue(Frame& F) {
    LAS float* red = (LAS float*)(F.lds + RING_OFF);
    float* mod = (float*)(F.ws + WS_MOD);
    float* bias1 = (float*)(F.ws + WS_MOD + 131072);
    for (int bi = F.bid; bi < 200; bi += F.G) {
        if (bi < 192) {
            const int l = bi / 96, cg = bi % 96, j = cg * 64 + F.lane;
            float a0 = 0.f, a1 = 0.f;
            const float* wp = F.w_ada + ((size_t)l * 1024 + F.wave * 128) * 6144 + j;
#pragma unroll 16
            for (int k = 0; k < 128; ++k) { const float wv = wp[(size_t)k * 6144]; const float c0 = F.c[F.wave * 128 + k], c1 = F.c[1024 + F.wave * 128 + k];
                a0 += siluf_(c0) * wv; a1 += siluf_(c1) * wv; }
            red[(F.wave * 2 + 0) * 64 + F.lane] = a0; red[(F.wave * 2 + 1) * 64 + F.lane] = a1;
            __syncthreads();
            if (F.tid < 128) { const int b = F.tid >> 6, ln = F.tid & 63; float s = 0.f;
#pragma unroll
                for (int w = 0; w < 8; ++w) s += red[(w * 2 + b) * 64 + ln];
                mod[(size_t)(l * 2 + b) * 6144 + cg * 64 + ln] = s + F.b_ada[l * 6144 + cg * 64 + ln]; }
            __syncthreads();
        } else {
            const int kv = (bi - 192) >> 2, cg = (bi - 192) & 3, j = cg * 64 + F.lane;
            float a0 = 0.f;
            const float* wp = F.cmp_w1 + ((size_t)kv * 2048 + F.wave * 256) * 256 + j; const float* pe = F.cmp_pe + kv * 2048 + F.wave * 256;
#pragma unroll 16
            for (int k = 0; k < 256; ++k) a0 += pe[k] * wp[(size_t)k * 256];
            red[F.wave * 64 + F.lane] = a0;
            __syncthreads();
            if (F.tid < 64) { float s = 0.f;
#pragma unroll
                for (int w = 0; w < 8; ++w) s += red[w * 64 + F.tid];
                bias1[kv * 256 + cg * 64 + F.tid] = s; }
            __syncthreads();
        }
    }
    { bf16* wi = (bf16*)(F.ws + WS_WIN); const int npieces = (NPROJ - C_END) * (DM / 8);
      for (int p = F.bid * 512 + F.tid; p < npieces; p += F.G * 512) *(GAS v4u*)(wi + (size_t)C_END * DM + (size_t)p * 8) = (v4u){0u, 0u, 0u, 0u}; }
    const int gw = F.bid * 8 + F.wave, NGW = F.G * 8;
    tr_run(F, 0, gw, NGW);
}

__device__ __forceinline__ void moe_tables(Frame& F, int layer) {
    LAS int* ppre = (LAS int*)(F.lds + TAB_OFF);
    if (F.tid == 0) { const unsigned* cnt = (const unsigned*)(F.ctl + CW_CNT + 1024 * layer); int acc = 0;
        for (int e = 0; e < 16; ++e) { const int c = (int)cnt[64 * e]; ppre[e] = acc; ppre[32 + e] = c; acc += (c + 255) >> 8; }
        ppre[16] = acc; }
    __syncthreads();
}

struct RouteRec { int e0, e1, pos0, pos1; float w0, w1; int slot0, slot1; };
template <bool COMBINE, bool NORM, bool ROUTE>
__device__ __forceinline__ void row_pass(Frame& F, const float* xin, const float* modn  , int sh_off, const float* ng,
                                         const float* modc  , int layer, int clayer  ) {
    if (COMBINE) moe_tables(F, clayer);
    float* xout = F.out; bf16* H = (bf16*)(F.ws + WS_O);
    const bf16* YM = (const bf16*)(F.ws + WS_A);
    RouteRec* route = (RouteRec*)(F.ws + WS_ROUTE);
    int* elist = (int*)(F.ws + WS_STATS);
    const LAS int* ppre = (const LAS int*)(F.lds + TAB_OFF);
    LAS float* wr = (LAS float*)(F.lds + RING_OFF);
    LAS unsigned* lcnt = (LAS unsigned*)(F.lds + TAB_OFF + 256);
    if (ROUTE) {
        for (int idx = F.tid; idx < 16384; idx += 512) wr[(idx & 15) * 1024 + (idx >> 4)] = F.w_router[idx];
        if (F.tid < 32) lcnt[F.tid] = 0u;
        __syncthreads();
    }
    const int gw = F.bid * 8 + F.wave, NGW = F.G * 8;
    f32x4 cs[4], sh[4], gc[4];
    f32x4 vn[4]; v2u yn0[4], yn1[4]; RouteRec rn; rn.w0 = 0.f; rn.w1 = 0.f;
    int m = gw, bcur = -1;
#define RP_PREFETCH(mm) do { \
        _Pragma("unroll") for (int j = 0; j < 4; ++j) vn[j] = *(const f32x4*)(xin + (size_t)(mm) * DM + 4 * F.lane + 256 * j); \
        if (COMBINE) { rn = route[(mm)]; const int sl0_ = ppre[rn.e0] * 256 + rn.pos0, sl1_ = ppre[rn.e1] * 256 + rn.pos1; \
            _Pragma("unroll") for (int j = 0; j < 4; ++j) { yn0[j] = *(const v2u*)(YM + (size_t)sl0_ * DM + 4 * F.lane + 256 * j); yn1[j] = *(const v2u*)(YM + (size_t)sl1_ * DM + 4 * F.lane + 256 * j); } } } while (0)
    if (m < NTOK) RP_PREFETCH(m);
#pragma unroll 1
    while (m < NTOK) {
        f32x4 v[4]; v2u y0[4], y1[4];
#pragma unroll
        for (int j = 0; j < 4; ++j) { v[j] = vn[j]; if (COMBINE) { y0[j] = yn0[j]; y1[j] = yn1[j]; } }
        const float rw0 = rn.w0, rw1 = rn.w1;
        const int mc = m; m += NGW;
        if (m < NTOK) RP_PREFETCH(m);
        const int b = mc >> 13;
        if (b != bcur) { bcur = b;
#pragma unroll
            for (int j = 0; j < 4; ++j) {
                const int col = 4 * F.lane + 256 * j;
                if (NORM) { const f32x4 g = *(const f32x4*)(ng + col), sc = *(const f32x4*)(modn + b * 6144 + sh_off + 1024 + col); cs[j] = g * (sc + 1.0f); sh[j] = *(const f32x4*)(modn + b * 6144 + sh_off + col); }
                if (COMBINE) gc[j] = *(const f32x4*)(modc + b * 6144 + 5 * 1024 + col);
            } }
        {
            if (COMBINE) {
#pragma unroll
                for (int j = 0; j < 4; ++j) {
                    f32x4 yy; yy.x = rw0 * bflo(y0[j].x) + rw1 * bflo(y1[j].x); yy.y = rw0 * bfhi(y0[j].x) + rw1 * bfhi(y1[j].x); yy.z = rw0 * bflo(y0[j].y) + rw1 * bflo(y1[j].y); yy.w = rw0 * bfhi(y0[j].y) + rw1 * bfhi(y1[j].y);
                    v[j] = v[j] + gc[j] * yy;
                    *(f32x4*)(xout + (size_t)mc * DM + 4 * F.lane + 256 * j) = v[j];
                }
            }
            if (NORM) {
                float s = 0.f;
#pragma unroll
                for (int j = 0; j < 4; ++j) s += (v[j].x * v[j].x + v[j].y * v[j].y) + (v[j].z * v[j].z + v[j].w * v[j].w);
                const float rstd = 1.0f / sqrtf(wave_sum(s) * (1.0f / DM) + NORM_EPS);
#pragma unroll
                for (int j = 0; j < 4; ++j) { v[j] = v[j] * rstd * cs[j] + sh[j];
                    v2u o; o.x = pk2(v[j].x, v[j].y); o.y = pk2(v[j].z, v[j].w);
                    *(v2u*)(H + (size_t)mc * DM + 4 * F.lane + 256 * j) = o; }
            }
            if (ROUTE) {
                float a16[16];
#pragma unroll
                for (int eg = 0; eg < 4; ++eg) {
                    float a4[4] = {0.f, 0.f, 0.f, 0.f};
#pragma unroll
                    for (int j = 0; j < 4; ++j)
#pragma unroll
                        for (int ee = 0; ee < 4; ++ee) { const f32x4 w = *(const LAS f32x4*)(wr + (eg * 4 + ee) * 1024 + 4 * F.lane + 256 * j); a4[ee] += (v[j].x * w.x + v[j].y * w.y) + (v[j].z * w.z + v[j].w * w.w); }
#pragma unroll
                    for (int ee = 0; ee < 4; ++ee) a16[eg * 4 + ee] = a4[ee];
                    __builtin_amdgcn_sched_barrier(0);
                }
                float r8[8], r4[4], r2[2];
                { const bool hb = (F.lane & 32) != 0;
#pragma unroll
                  for (int i = 0; i < 8; ++i) { const float keep = hb ? a16[8 + i] : a16[i], send = hb ? a16[i] : a16[8 + i]; r8[i] = keep + __shfl_xor(send, 32); } }
                { const bool hb = (F.lane & 16) != 0;
#pragma unroll
                  for (int i = 0; i < 4; ++i) { const float keep = hb ? r8[4 + i] : r8[i], send = hb ? r8[i] : r8[4 + i]; r4[i] = keep + __shfl_xor(send, 16); } }
                { const bool hb = (F.lane & 8) != 0;
#pragma unroll
                  for (int i = 0; i < 2; ++i) { const float keep = hb ? r4[2 + i] : r4[i], send = hb ? r4[i] : r4[2 + i]; r2[i] = keep + __shfl_xor(send, 8); } }
                float lgo; { const bool hb = (F.lane & 4) != 0; const float keep = hb ? r2[1] : r2[0], send = hb ? r2[0] : r2[1]; lgo = keep + __shfl_xor(send, 4); }
                lgo += __shfl_xor(lgo, 1); lgo += __shfl_xor(lgo, 2);
                const int eown = ((F.lane >> 5) & 1) * 8 + ((F.lane >> 4) & 1) * 4 + ((F.lane >> 3) & 1) * 2 + ((F.lane >> 2) & 1);
                const float sco = frcp(1.0f + __expf(-lgo)), slo = sco + F.r_bias[eown];
                float sc[16], sl[16];
#pragma unroll
                for (int e = 0; e < 16; ++e) { const int src = (e >> 3) * 32 + ((e >> 2) & 1) * 16 + ((e >> 1) & 1) * 8 + (e & 1) * 4;
                    sc[e] = __builtin_bit_cast(float, __builtin_amdgcn_readlane(__builtin_bit_cast(int, sco), src)); sl[e] = __builtin_bit_cast(float, __builtin_amdgcn_readlane(__builtin_bit_cast(int, slo), src)); }
                float gs[4]; int ge1[4], ge2[4]; float gw1[4], gw2[4];
#pragma unroll
                for (int g = 0; g < 4; ++g) {
                    int i1 = 0; float m1 = sl[4 * g];
#pragma unroll
                    for (int k = 1; k < 4; ++k) if (sl[4 * g + k] > m1) { m1 = sl[4 * g + k]; i1 = k; }
                    int i2 = -1; float m2 = 0.f;
#pragma unroll
                    for (int k = 0; k < 4; ++k) if (k != i1 && (i2 < 0 || sl[4 * g + k] > m2)) { m2 = sl[4 * g + k]; i2 = k; }
                    gs[g] = m1 + m2; ge1[g] = 4 * g + i1; ge2[g] = 4 * g + i2;
                    float w1 = 0.f, w2 = 0.f;
#pragma unroll
                    for (int k = 0; k < 4; ++k) { w1 = (k == i1) ? sc[4 * g + k] : w1; w2 = (k == i2) ? sc[4 * g + k] : w2; }
                    gw1[g] = w1; gw2[g] = w2;
                }
                int gi = 0; float gm = gs[0];
#pragma unroll
                for (int g = 1; g < 4; ++g) if (gs[g] > gm) { gm = gs[g]; gi = g; }
                int e1 = ge1[0], e2 = ge2[0]; float w1 = gw1[0], w2 = gw2[0];
#pragma unroll
                for (int g = 1; g < 4; ++g) if (gi == g) { e1 = ge1[g]; e2 = ge2[g]; w1 = gw1[g]; w2 = gw2[g]; }
                const float ws_ = w1 + w2;
                if (F.lane == 0) {
                    RouteRec rr; rr.e0 = e1; rr.e1 = e2;
                    rr.pos0 = (int)__hip_atomic_fetch_add(lcnt + e1, 1u, __ATOMIC_RELAXED, __HIP_MEMORY_SCOPE_WORKGROUP);
                    rr.pos1 = (int)__hip_atomic_fetch_add(lcnt + e2, 1u, __ATOMIC_RELAXED, __HIP_MEMORY_SCOPE_WORKGROUP);
                    rr.w0 = w1 / ws_; rr.w1 = w2 / ws_; rr.slot0 = 0; rr.slot1 = 0;
                    route[mc] = rr;
                }
            }
        }
    }
#undef RP_PREFETCH
    if (ROUTE) {
        __syncthreads();
        if (F.tid < 16) { unsigned* cnt = (unsigned*)(F.ctl + CW_CNT + 1024 * layer + 64 * F.tid); lcnt[16 + F.tid] = atomicAdd(cnt, lcnt[F.tid]); }
        __syncthreads();
        if (F.lane == 0) {
#pragma unroll 1
            for (int m = gw; m < NTOK; m += NGW) { RouteRec rr = route[m]; rr.pos0 += (int)lcnt[16 + rr.e0]; rr.pos1 += (int)lcnt[16 + rr.e1]; route[m] = rr;
                elist[rr.e0 * 16384 + rr.pos0] = m; elist[rr.e1 * 16384 + rr.pos1] = m; }
        }
    }
}


__device__ __forceinline__ f32x4 mma16(const LAS bf16* A, int lda, const LAS bf16* Bt, int ldb, int K, f32x4 acc, int lane) {
    const LAS bf16* ap = A + (lane & 15) * lda + (lane >> 4) * 8;
    const LAS bf16* bp = Bt + (lane & 15) * ldb + (lane >> 4) * 8;
    for (int k = 0; k < K; k += 32) {
        const bf16x8 a = *(const LAS bf16x8*)(ap + k), b = *(const LAS bf16x8*)(bp + k);
        acc = __builtin_amdgcn_mfma_f32_16x16x32_bf16(a, b, acc, 0, 0, 0);
    }
    return acc;
}

__device__ __forceinline__ void gla_bcum(Frame& F, const bf16* prow  , int h, float (&bc)[8]) {
    float gl[16];
    { const v4u a = *(const v4u*)(prow + C_GLR), b = *(const v4u*)(prow + C_GLR + 8); float t0[8], t1[8]; unpack8(a, t0); unpack8(b, t1);
#pragma unroll
      for (int i = 0; i < 8; ++i) { gl[i] = t0[i]; gl[8 + i] = t1[i]; } }
#pragma unroll
    for (int i = 0; i < 8; ++i) {
        const int col = h * 64 + F.wave * 8 + i;
        float z = F.gla_bg[col];
#pragma unroll
        for (int r = 0; r < 16; ++r) z += gl[r] * F.gla_w2[r * 256 + col];
        const float ls = fminf(z, 0.f) - log1pf(__expf(-fabsf(z)));
        float v = ls * (1.0f / 16.0f);
#pragma unroll
        for (int off = 1; off < 64; off <<= 1) { const float o = __shfl_up(v, off); v += (F.lane >= off) ? o : 0.f; }
        bc[i] = v;
    }
}
__device__ __forceinline__ void gla_stage_vT(Frame& F, const bf16* prow, int h, LAS bf16* VT) {
    const v4u a = *(const v4u*)(prow + C_GV + h * 128 + F.wave * 16), b = *(const v4u*)(prow + C_GV + h * 128 + F.wave * 16 + 8);
    const unsigned w[8] = {a.x, a.y, a.z, a.w, b.x, b.y, b.z, b.w};
#pragma unroll
    for (int i = 0; i < 8; ++i) { VT[(F.wave * 16 + 2 * i) * 72 + F.lane] = (bf16)(w[i] & 0xffffu); VT[(F.wave * 16 + 2 * i + 1) * 72 + F.lane] = (bf16)(w[i] >> 16); }
}
__device__ __forceinline__ void gla_prep_item(Frame& F, int item) {
    const int h = item & 3, n = (item >> 2) & 127, b = item >> 9;
    const bf16* proj = (const bf16*)(F.ws + WS_A);
    const bf16* prow = proj + (size_t)(b * SEQ + n * 64 + F.lane) * NPROJ;
    LAS bf16* KT = (LAS bf16*)(F.lds + RING_OFF);
    LAS bf16* VT = (LAS bf16*)(F.lds + RING_OFF + 9216);
    float bc[8]; gla_bcum(F, prow, h, bc);
    float kf[8]; { const v4u kk = *(const v4u*)(prow + C_GK + h * 64 + F.wave * 8); unpack8(kk, kf); }
    float* DEC = (float*)(F.ws + WS_DEC) + ((size_t)(b * 128 + n) * 4 + h) * 64;
#pragma unroll
    for (int i = 0; i < 8; ++i) {
        const float bl = __shfl(bc[i], 63);
        KT[(F.wave * 8 + i) * 72 + F.lane] = (bf16)f2bf(kf[i] * __expf(bl - bc[i]));
        if (F.lane == 63) DEC[F.wave * 8 + i] = __expf(bl);
    }
    gla_stage_vT(F, prow, h, VT);
    __syncthreads();
    float* KV = (float*)(F.ws + WS_O) + ((size_t)(b * 128 + n) * 4 + h) * 8192;
    const int dt = F.wave >> 1;
#pragma unroll
    for (int j = 0; j < 4; ++j) {
        const int et = (F.wave & 1) * 4 + j;
        f32x4 acc = {0.f, 0.f, 0.f, 0.f};
        acc = mma16(KT + dt * 16 * 72, 72, VT + et * 16 * 72, 72, 64, acc, F.lane);
#pragma unroll
        for (int i = 0; i < 4; ++i) KV[(dt * 16 + 4 * (F.lane >> 4) + i) * 128 + et * 16 + (F.lane & 15)] = acc[i];
    }
    __syncthreads();
}
__device__ __forceinline__ void gla_scan(Frame& F, int gidx) {
    const int bh = gidx >> 13, de = gidx & 8191, b = bh >> 2, h = bh & 3;
    float* KV = (float*)(F.ws + WS_O) + ((size_t)(b * 128) * 4 + h) * 8192 + de;
    const float* DEC = (const float*)(F.ws + WS_DEC) + ((size_t)(b * 128) * 4 + h) * 64 + (de >> 7);
    float st = 0.f;
#pragma unroll 1
    for (int n0 = 0; n0 < 128; n0 += 8) {
        float kv[8], dc[8];
#pragma unroll
        for (int i = 0; i < 8; ++i) { kv[i] = KV[(size_t)(n0 + i) * 4 * 8192]; dc[i] = DEC[(size_t)(n0 + i) * 4 * 64]; }
#pragma unroll
        for (int i = 0; i < 8; ++i) { KV[(size_t)(n0 + i) * 4 * 8192] = st; st = dc[i] * st + kv[i]; }
    }
}
__device__ __forceinline__ void gla_out_item(Frame& F, int item) {
    const int h = item & 3, n = (item >> 2) & 127, b = item >> 9;
    const bf16* proj = (const bf16*)(F.ws + WS_A);
    const size_t tok = (size_t)b * SEQ + n * 64 + F.lane;
    const bf16* prow = proj + tok * NPROJ;
    LAS bf16* A1 = (LAS bf16*)(F.lds + RING_OFF);
    LAS bf16* B1 = (LAS bf16*)(F.lds + RING_OFF + 9216);
    LAS bf16* A2 = (LAS bf16*)(F.lds + RING_OFF + 18432);
    LAS bf16* SC = (LAS bf16*)(F.lds + RING_OFF + 27648);
    LAS bf16* VT = (LAS bf16*)(F.lds + RING_OFF + 36864);
    LAS bf16* ST = (LAS bf16*)(F.lds + RING_OFF + 55296);
    LAS float* OS = (LAS float*)(F.lds + RING_OFF + 73728);
    float bc[8]; gla_bcum(F, prow, h, bc);
    float qf[8], kf[8];
    { const v4u qq = *(const v4u*)(prow + C_GQ + h * 64 + F.wave * 8), kk = *(const v4u*)(prow + C_GK + h * 64 + F.wave * 8); unpack8(qq, qf); unpack8(kk, kf); }
    float a1[8], b1[8], a2[8];
#pragma unroll
    for (int i = 0; i < 8; ++i) {
        const float bm = __shfl(bc[i], 32);
        a1[i] = qf[i] * 0.125f * __expf(bc[i] - bm); b1[i] = kf[i] * __expf(bm - bc[i]); a2[i] = qf[i] * 0.125f * __expf(bc[i]);
    }
    *(LAS v4u*)(A1 + F.lane * 72 + F.wave * 8) = pack8(a1);
    *(LAS v4u*)(B1 + F.lane * 72 + F.wave * 8) = pack8(b1);
    *(LAS v4u*)(A2 + F.lane * 72 + F.wave * 8) = pack8(a2);
    gla_stage_vT(F, prow, h, VT);
    { const float* KV = (const float*)(F.ws + WS_O) + ((size_t)(b * 128 + n) * 4 + h) * 8192;
#pragma unroll
      for (int k = 0; k < 16; ++k) { const int p = F.tid + 512 * k, e = p & 127, d = p >> 7; ST[e * 72 + d] = (bf16)f2bf(KV[d * 128 + e]); } }
    __syncthreads();
    const int it = F.wave >> 1;
#pragma unroll
    for (int jj = 0; jj < 2; ++jj) {
        const int jt = (F.wave & 1) * 2 + jj;
        f32x4 acc = {0.f, 0.f, 0.f, 0.f};
        if (jt <= it) acc = mma16(A1 + it * 16 * 72, 72, B1 + jt * 16 * 72, 72, 64, acc, F.lane);
#pragma unroll
        for (int i = 0; i < 4; ++i) { const int ri = it * 16 + 4 * (F.lane >> 4) + i, cj = jt * 16 + (F.lane & 15); SC[ri * 72 + cj] = (bf16)f2bf((cj <= ri) ? acc[i] : 0.f); }
    }
    __syncthreads();
#pragma unroll
    for (int j = 0; j < 4; ++j) {
        const int et = (F.wave & 1) * 4 + j;
        f32x4 acc = {0.f, 0.f, 0.f, 0.f};
        acc = mma16(SC + it * 16 * 72, 72, VT + et * 16 * 72, 72, 64, acc, F.lane);
        acc = mma16(A2 + it * 16 * 72, 72, ST + et * 16 * 72, 72, 64, acc, F.lane);
#pragma unroll
        for (int i = 0; i < 4; ++i) OS[(it * 16 + 4 * (F.lane >> 4) + i) * 132 + et * 16 + (F.lane & 15)] = acc[i];
    }
    __syncthreads();
    { const int row = F.tid >> 3, c0 = (F.tid & 7) * 16;
      float v[16]; float ss = 0.f;
#pragma unroll
      for (int i = 0; i < 16; ++i) { v[i] = OS[row * 132 + c0 + i]; ss += v[i] * v[i]; }
      ss += __shfl_xor(ss, 1); ss += __shfl_xor(ss, 2); ss += __shfl_xor(ss, 4);
      const float rstd = 1.0f / sqrtf(ss * (1.0f / 128.0f) + NORM_EPS);
      const size_t tk = (size_t)b * SEQ + n * 64 + row;
      const bf16* rrow = proj + tk * NPROJ + C_GR + h * 128 + c0;
      float r0[8], r1[8]; unpack8(*(const v4u*)rrow, r0); unpack8(*(const v4u*)(rrow + 8), r1);
      float o0[8], o1[8];
#pragma unroll
      for (int i = 0; i < 8; ++i) { o0[i] = v[i] * rstd * F.gla_ng[c0 + i] * siluf_(r0[i]); o1[i] = v[8 + i] * rstd * F.gla_ng[c0 + 8 + i] * siluf_(r1[i]); }
      bf16* orow = (bf16*)(F.ws + WS_O + 32 * MiB) + tk * DM + h * 128 + c0;
      *(v4u*)orow = pack8(o0); *(v4u*)(orow + 8) = pack8(o1); }
    __syncthreads();
}

__device__ __forceinline__ double inv_freq_d(int i) {
    return (i == 0) ? 1.0 : (i == 1) ? 0.19392547740471268 : (i == 2) ? 0.037606090787015346 : (i == 3) ? 0.0072927791106285765 :
           (i == 4) ? 0.0014142135623730951 : (i == 5) ? 0.00027425197177757796 : (i == 6) ? 5.318404375373266e-05 : 1.0313741203148838e-05;
}
__device__ __forceinline__ void rope_sincos(int pos, int i, float& cs, float& sn) {
    const double rev = (double)pos * inv_freq_d(i) * 0.15915494309189535;
    const float fr = (float)(rev - rint(rev));
    cs = __builtin_amdgcn_cosf(fr); sn = __builtin_amdgcn_sinf(fr);
}
__device__ __forceinline__ void nsa_prep_token(Frame& F, int tok) {
    const int b = tok >> 13, t = tok & 8191, sub = F.lane & 7, vid = F.lane >> 3;
    const bf16* prow = (const bf16*)(F.ws + WS_A) + (size_t)tok * NPROJ;
    const int pos = F.positions[tok];
    float cs_l, sn_l; rope_sincos(pos, sub, cs_l, sn_l);
    float cs[8], sn[8];
#pragma unroll
    for (int i = 0; i < 8; ++i) { cs[i] = __shfl(cs_l, (F.lane & ~7) + i); sn[i] = __shfl(sn_l, (F.lane & ~7) + i); }
    unsigned char* dob = F.dout_b;
    const size_t ktile_off = (size_t)(t >> 6) * 8192 + sub * 1024 + (t & 63) * 16;
    const size_t vtile_off = (size_t)(t >> 6) * 8192 + (sub >> 2) * 4096 + (t & 63) * 64 + (sub & 3) * 16;
#pragma unroll
    for (int round = 0; round < 3; ++round) {
        int col; int kind; unsigned char* dst; const float* gain = nullptr;
        if (round == 0) { col = C_NQ + vid * 64; kind = 0; gain = F.q_gain; const int g = vid >> 2, hh = vid & 3;
            dst = dob + DO_QN + ((((size_t)(b * 2 + g) * SEQ + t) * 4 + hh) * 64 + sub * 8) * 2; }
        else if (round == 1) {
            const int g = vid & 1, which = vid >> 1;
            const size_t img = (size_t)(b * 2 + g) * (1u << 20);
            if (which == 0) { col = C_KS + g * 64; kind = 1; gain = F.k_gain + 64; dst = dob + DO_KSEL + img + ktile_off; }
            else if (which == 1) { col = C_KW + g * 64; kind = 1; gain = F.k_gain + 128; dst = dob + DO_KWIN + img + ktile_off; }
            else if (which == 2) { col = C_VS + g * 64; kind = 2; dst = dob + DO_VSEL + img + vtile_off; }
            else { col = C_VW + g * 64; kind = 2; dst = dob + DO_VWIN + img + vtile_off; }
        } else {
            const int g = vid & 1, which = (vid >> 1) & 1;
            col = (which ? C_VC : C_KC) + g * 64; kind = 2;
            dst = dob + (which ? DO_VC : DO_KC) + (((size_t)(b * 2 + g) * SEQ + t) * 64 + sub * 8) * 2;
        }
        float x[8]; unpack8(*(const v4u*)(prow + col + sub * 8), x);
        if (kind != 2) {
            float ss = 0.f;
#pragma unroll
            for (int i = 0; i < 8; ++i) ss += x[i] * x[i];
            ss += __shfl_xor(ss, 1); ss += __shfl_xor(ss, 2); ss += __shfl_xor(ss, 4);
            const float rstd = 1.0f / sqrtf(ss * (1.0f / 64.0f) + NORM_EPS);
#pragma unroll
            for (int i = 0; i < 8; ++i) x[i] = x[i] * rstd * gain[sub * 8 + i];
            float xo[8];
#pragma unroll
            for (int i = 0; i < 8; ++i) xo[i] = __shfl_xor(x[i], 1);
            if (sub == 0) {
#pragma unroll
                for (int i = 0; i < 8; ++i) x[i] = x[i] * cs[i] - xo[i] * sn[i];
            } else if (sub == 1) {
#pragma unroll
                for (int i = 0; i < 8; ++i) x[i] = x[i] * cs[i] + xo[i] * sn[i];
            }
            if (kind == 0) {
#pragma unroll
                for (int i = 0; i < 8; ++i) x[i] *= 0.125f * 1.4426950408889634f;
            }
        }
        if (round < 2 || F.lane < 32) *(v4u*)dst = pack8(x);
    }
    if (F.lane < 24) { float* gt = (float*)(F.ws + WS_GATES) + (size_t)tok * 24; gt[F.lane] = sigmoidf_(bf2f(prow[C_NG + F.lane])); }
}

__device__ __forceinline__ void nsa_compress_item(Frame& F, int item) {
    const int kv = item >> 6, b = (item >> 5) & 1, g = (item >> 4) & 1, rt = item & 15, n0 = rt * 32;
    const bf16* Asrc = (const bf16*)(F.dout_b + (kv ? DO_VC : DO_KC)) + ((size_t)(b * 2 + g) * SEQ + 16 * n0) * 64;
    const bf16* Bsrc = (const bf16*)(F.ws + WS_WCW1) + (size_t)kv * 256 * 2048;
    LAS bf16* As = (LAS bf16*)(F.lds + RING_OFF);
    LAS bf16* Bs = (LAS bf16*)(F.lds + RING_OFF + 2 * 32 * 72 * 2);
    LAS float* Hs = (LAS float*)(F.lds + RING_OFF + 86016);
    LAS float* W2s = (LAS float*)(F.lds + RING_OFF);
    const int ar = F.tid >> 3, ac = (F.tid & 7) * 8;
    v4u areg = {0u, 0u, 0u, 0u}, breg[4];
#define CMP_GLOAD(kc) do { if (F.tid < 256) areg = *(const v4u*)(Asrc + (size_t)ar * 1024 + (kc) * 64 + ac); \
        _Pragma("unroll") for (int i_ = 0; i_ < 4; ++i_) { const int p_ = F.tid + 512 * i_, br_ = p_ >> 3, bc_ = (p_ & 7) * 8; breg[i_] = *(const v4u*)(Bsrc + (size_t)br_ * 2048 + (kc) * 64 + bc_); } } while (0)
#define CMP_LSTORE(buf) do { if (F.tid < 256) *(LAS v4u*)(As + (buf) * 32 * 72 + ar * 72 + ac) = areg; \
        _Pragma("unroll") for (int i_ = 0; i_ < 4; ++i_) { const int p_ = F.tid + 512 * i_, br_ = p_ >> 3, bc_ = (p_ & 7) * 8; *(LAS v4u*)(Bs + (buf) * 256 * 72 + br_ * 72 + bc_) = breg[i_]; } } while (0)
    f32x4 acc[2][2];
#pragma unroll
    for (int mt = 0; mt < 2; ++mt)
#pragma unroll
        for (int nt = 0; nt < 2; ++nt) acc[mt][nt] = (f32x4){0.f, 0.f, 0.f, 0.f};
    CMP_GLOAD(0); CMP_LSTORE(0); __syncthreads();
#pragma unroll 1
    for (int kc = 0; kc < 32; ++kc) {
        const int buf = kc & 1;
        if (kc + 1 < 32) CMP_GLOAD(kc + 1);
#pragma unroll
        for (int mt = 0; mt < 2; ++mt)
#pragma unroll
            for (int nt = 0; nt < 2; ++nt)
                acc[mt][nt] = mma16(As + buf * 32 * 72 + mt * 16 * 72, 72, Bs + buf * 256 * 72 + (F.wave * 32 + nt * 16) * 72, 72, 64, acc[mt][nt], F.lane);
        if (kc + 1 < 32) CMP_LSTORE(buf ^ 1);
        __syncthreads();
    }
    const float* bias1 = (const float*)(F.ws + WS_MOD + 131072) + kv * 256;
#pragma unroll
    for (int mt = 0; mt < 2; ++mt)
#pragma unroll
        for (int nt = 0; nt < 2; ++nt) { const int col = F.wave * 32 + nt * 16 + (F.lane & 15);
#pragma unroll
            for (int i = 0; i < 4; ++i) Hs[(mt * 16 + 4 * (F.lane >> 4) + i) * 260 + col] = gelu_tanh(acc[mt][nt][i] + bias1[col]); }
    { const float* w2 = F.cmp_w2 + (size_t)kv * 256 * 64;
#pragma unroll
      for (int i = 0; i < 8; ++i) *(LAS f32x4*)(W2s + (F.tid + 512 * i) * 4) = *(const f32x4*)(w2 + (size_t)(F.tid + 512 * i) * 4); }
    __syncthreads();
    const int r = F.tid >> 4, dq = F.tid & 15;
    f32x4 o = {0.f, 0.f, 0.f, 0.f};
#pragma unroll 8
    for (int j = 0; j < 256; ++j) { const float hv = Hs[r * 260 + j]; const f32x4 w = *(const LAS f32x4*)(W2s + j * 64 + 4 * dq); o = o + w * hv; }
    const int n = n0 + r;
    if (kv == 0) {
        float ss = (o.x * o.x + o.y * o.y) + (o.z * o.z + o.w * o.w);
        ss += __shfl_xor(ss, 1); ss += __shfl_xor(ss, 2); ss += __shfl_xor(ss, 4); ss += __shfl_xor(ss, 8);
        const float rstd = 1.0f / sqrtf(ss * (1.0f / 64.0f) + NORM_EPS);
        const f32x4 gn = *(const f32x4*)(F.k_gain + 4 * dq);
        o = o * rstd * gn;
        const int tlast = (16 * n + 31 < SEQ) ? 16 * n + 31 : SEQ - 1;
        const int pos = F.positions[b * SEQ + tlast];
        f32x4 po; po.x = __shfl_xor(o.x, 2); po.y = __shfl_xor(o.y, 2); po.z = __shfl_xor(o.z, 2); po.w = __shfl_xor(o.w, 2);
        if (dq < 4) {
            const int i0 = 4 * (dq & 1);
            float c0, s0, c1, s1, c2, s2, c3, s3;
            rope_sincos(pos, i0, c0, s0); rope_sincos(pos, i0 + 1, c1, s1); rope_sincos(pos, i0 + 2, c2, s2); rope_sincos(pos, i0 + 3, c3, s3);
            if (dq < 2) { o.x = o.x * c0 - po.x * s0; o.y = o.y * c1 - po.y * s1; o.z = o.z * c2 - po.z * s2; o.w = o.w * c3 - po.w * s3; }
            else { o.x = o.x * c0 + po.x * s0; o.y = o.y * c1 + po.y * s1; o.z = o.z * c2 + po.z * s2; o.w = o.w * c3 + po.w * s3; }
        }
    }
    if (n == 511) o = (f32x4){0.f, 0.f, 0.f, 0.f};
    v2u pk; pk.x = pk2(o.x, o.y); pk.y = pk2(o.z, o.w);
    const int c = dq >> 1;
    unsigned char* img = F.dout_b + (kv ? DO_VCMP : DO_KCMP) + (size_t)(b * 2 + g) * 65536 + (size_t)(n >> 6) * 8192;
    if (kv == 0) *(v2u*)(img + c * 1024 + (n & 63) * 16 + (dq & 1) * 8) = pk;
    else *(v2u*)(img + (c >> 2) * 4096 + (n & 63) * 64 + (c & 3) * 16 + (dq & 1) * 8) = pk;
    __syncthreads();
}

constexpr int NSA_KB = 0, NSA_VB = 16384, NSA_IMP = 32768, NSA_OACC = 65536;
__device__ __forceinline__ int crow(int r, int hi) { return (r & 3) + 8 * (r >> 2) + 4 * hi; }
__device__ __forceinline__ s16x4 ds_tr16(const LAS unsigned char* p) { return __builtin_bit_cast(s16x4, __builtin_amdgcn_ds_read_tr16_b64_v4i16((LAS s16x4*)p)); }

__device__ __forceinline__ unsigned cvtpk(float lo, float hi) { unsigned r; asm("v_cvt_pk_bf16_f32 %0, %1, %2" : "=v"(r) : "v"(lo), "v"(hi)); return r; }
__device__ __forceinline__ float xhalf_max(float v) { const auto rr = __builtin_amdgcn_permlane32_swap(__float_as_uint(v), __float_as_uint(v), false, false); return fmaxf(__uint_as_float(rr[0]), __uint_as_float(rr[1])); }
constexpr float NSA_THR = 8.0f;

template <int MODE>
__device__ __forceinline__ void nsa_branch(Frame& F, const unsigned char* Kimg, const unsigned char* Vimg, int kt0, int kt1, const bf16x8 (&qr)[4],
                                           float& m, float& l, f32x16 (&o)[2], int t, int tw0, int nv, int nvw, int nvmin,
                                           unsigned mk0, unsigned mk1, unsigned mk2, unsigned mk3, unsigned wo0, unsigned wo1, unsigned wo2, unsigned wo3,
                                           float cinit  , LAS float* impw) {
    const int r32 = F.lane & 31, hi = F.lane >> 5, tokl = r32 >> 2;
    LAS unsigned char* KB = F.lds + RING_OFF + NSA_KB; LAS unsigned char* VB = F.lds + RING_OFF + NSA_VB;
    const v4u* kg = (const v4u*)Kimg + F.tid; const v4u* vg = (const v4u*)Vimg + F.tid;
    v4u kreg = kg[(size_t)kt0 * 512], vreg = {0u, 0u, 0u, 0u};
    if (MODE != 0) vreg = vg[(size_t)kt0 * 512];
    *(LAS v4u*)(KB + F.tid * 16) = kreg; if (MODE != 0) *(LAS v4u*)(VB + F.tid * 16) = vreg;
    __syncthreads();
#pragma unroll 1
    for (int kt = kt0; kt < kt1; ++kt) {
        const int buf = (kt - kt0) & 1; const bool has_next = kt + 1 < kt1;
        if (has_next) { kreg = kg[(size_t)(kt + 1) * 512]; if (MODE != 0) vreg = vg[(size_t)(kt + 1) * 512]; }
        const LAS unsigned char* Kb = KB + buf * 8192; const LAS unsigned char* Vb = VB + buf * 8192;
        bool need;
        if (MODE <= 1) need = kt * 64 < nvw;
        else if (MODE == 2) { const unsigned w = (kt < 32) ? wo0 : (kt < 64) ? wo1 : (kt < 96) ? wo2 : wo3; need = (w >> (kt & 31)) & 1u; }
        else need = (kt * 64 <= tw0 + 7) && (kt * 64 + 63 + 512 > tw0);
        bool selbit = true;
        if (MODE == 2) { const unsigned w = (kt < 32) ? mk0 : (kt < 64) ? mk1 : (kt < 96) ? mk2 : mk3; selbit = (w >> (kt & 31)) & 1u; }
        bool joint = false;
        if (need) {
            if (MODE == 2) joint = kt < (tw0 >> 6);
            else if (MODE == 3) joint = (kt * 64 + 63 <= tw0) && (kt * 64 + 512 > tw0 + 7);
            else joint = kt * 64 + 63 < nvmin;
            if (MODE != 1) joint = joint && !__any(m < -1e29f);
        }
        if (need && joint) {
            const float c0 = (MODE == 1) ? cinit : ((MODE == 2 && !selbit) ? -1e30f : -m);
            f32x16 pa, pb;
#pragma unroll
            for (int r = 0; r < 16; ++r) { pa[r] = c0; pb[r] = c0; }
#pragma unroll
            for (int d0 = 0; d0 < 4; ++d0) {
                const bf16x8 kfa = *(const LAS bf16x8*)(Kb + (2 * d0 + hi) * 1024 + r32 * 16), kfb = *(const LAS bf16x8*)(Kb + (2 * d0 + hi) * 1024 + (32 + r32) * 16);
                pa = __builtin_amdgcn_mfma_f32_32x32x16_bf16(kfa, qr[d0], pa, 0, 0, 0);
                pb = __builtin_amdgcn_mfma_f32_32x32x16_bf16(kfb, qr[d0], pb, 0, 0, 0);
            }
            if (MODE != 1) {
                float mxa = fmaxf(fmaxf(pa[0], pa[1]), pa[2]), mxb = fmaxf(fmaxf(pb[0], pb[1]), pb[2]);
#pragma unroll
                for (int r = 3; r < 15; r += 2) { mxa = fmaxf(fmaxf(mxa, pa[r]), pa[r + 1]); mxb = fmaxf(fmaxf(mxb, pb[r]), pb[r + 1]); }
                const float mx = xhalf_max(fmaxf(fmaxf(mxa, pa[15]), fmaxf(mxb, pb[15])));
                if (__any(mx > NSA_THR)) {
                    const float dl = fmaxf(mx, 0.f), alpha = fexp2(-dl);
                    m += dl; l *= alpha;
#pragma unroll
                    for (int r = 0; r < 16; ++r) { pa[r] -= dl; pb[r] -= dl; }
                    if (MODE != 0) {
#pragma unroll
                        for (int r = 0; r < 16; ++r) { o[0][r] *= alpha; o[1][r] *= alpha; }
                    }
                }
            }
            float ps0 = 0.f, ps1 = 0.f;
#pragma unroll
            for (int r = 0; r < 16; ++r) { pa[r] = fexp2(pa[r]); pb[r] = fexp2(pb[r]); ps0 += pa[r]; ps1 += pb[r]; }
            if (MODE != 1) l += ps0 + ps1;
            if (MODE == 1) {
#pragma unroll
                for (int rg = 0; rg < 4; ++rg) {
                    float a = (pa[4 * rg] + pa[4 * rg + 1]) + (pa[4 * rg + 2] + pa[4 * rg + 3]), sp = pa[4 * rg + 3];
                    float a2 = (pb[4 * rg] + pb[4 * rg + 1]) + (pb[4 * rg + 2] + pb[4 * rg + 3]), sp2 = pb[4 * rg + 3];
                    a += __shfl_xor(a, 1); a += __shfl_xor(a, 2); sp += __shfl_xor(sp, 1); sp += __shfl_xor(sp, 2);
                    a2 += __shfl_xor(a2, 1); a2 += __shfl_xor(a2, 2); sp2 += __shfl_xor(sp2, 1); sp2 += __shfl_xor(sp2, 2);
                    if ((r32 & 3) == 0) { const int jp = kt * 16 + 2 * rg + hi;
                        __hip_atomic_fetch_add(impw + tokl * 128 + jp, a, __ATOMIC_RELAXED, __HIP_MEMORY_SCOPE_WORKGROUP);
                        __hip_atomic_fetch_add(impw + tokl * 128 + jp + 1, sp, __ATOMIC_RELAXED, __HIP_MEMORY_SCOPE_WORKGROUP);
                        __hip_atomic_fetch_add(impw + tokl * 128 + jp + 8, a2, __ATOMIC_RELAXED, __HIP_MEMORY_SCOPE_WORKGROUP);
                        if (jp + 9 < 128) __hip_atomic_fetch_add(impw + tokl * 128 + jp + 9, sp2, __ATOMIC_RELAXED, __HIP_MEMORY_SCOPE_WORKGROUP); }
                }
            }
            if (MODE != 0) {
                v4u wa0, wa1, wb0, wb1;
                wa0.x = cvtpk(pa[0], pa[1]); wa0.y = cvtpk(pa[2], pa[3]); wa0.z = cvtpk(pa[4], pa[5]); wa0.w = cvtpk(pa[6], pa[7]);
                wa1.x = cvtpk(pa[8], pa[9]); wa1.y = cvtpk(pa[10], pa[11]); wa1.z = cvtpk(pa[12], pa[13]); wa1.w = cvtpk(pa[14], pa[15]);
                wb0.x = cvtpk(pb[0], pb[1]); wb0.y = cvtpk(pb[2], pb[3]); wb0.z = cvtpk(pb[4], pb[5]); wb0.w = cvtpk(pb[6], pb[7]);
                wb1.x = cvtpk(pb[8], pb[9]); wb1.y = cvtpk(pb[10], pb[11]); wb1.z = cvtpk(pb[12], pb[13]); wb1.w = cvtpk(pb[14], pb[15]);
                const bf16x8 fa0 = __builtin_bit_cast(bf16x8, wa0), fa1 = __builtin_bit_cast(bf16x8, wa1), fb0 = __builtin_bit_cast(bf16x8, wb0), fb1 = __builtin_bit_cast(bf16x8, wb1);
                const LAS unsigned char* vb = Vb + (4 * hi + ((F.lane & 15) >> 2)) * 64 + ((F.lane >> 4) & 1) * 32 + (F.lane & 3) * 8;
#pragma unroll
                for (int dh = 0; dh < 2; ++dh) {
                    const LAS unsigned char* v0 = vb + dh * 4096;
                    const s16x4 a0 = ds_tr16(v0), a1 = ds_tr16(v0 + 512), b0 = ds_tr16(v0 + 1024), b1 = ds_tr16(v0 + 1536), c0_ = ds_tr16(v0 + 2048), c1 = ds_tr16(v0 + 2560), d0_ = ds_tr16(v0 + 3072), d1 = ds_tr16(v0 + 3584);
                    const bf16x8 vfa0 = {a0[0], a0[1], a0[2], a0[3], a1[0], a1[1], a1[2], a1[3]}, vfa1 = {b0[0], b0[1], b0[2], b0[3], b1[0], b1[1], b1[2], b1[3]};
                    const bf16x8 vfb0 = {c0_[0], c0_[1], c0_[2], c0_[3], c1[0], c1[1], c1[2], c1[3]}, vfb1 = {d0_[0], d0_[1], d0_[2], d0_[3], d1[0], d1[1], d1[2], d1[3]};
                    o[dh] = __builtin_amdgcn_mfma_f32_32x32x16_bf16(vfa0, fa0, o[dh], 0, 0, 0);
                    o[dh] = __builtin_amdgcn_mfma_f32_32x32x16_bf16(vfa1, fa1, o[dh], 0, 0, 0);
                    o[dh] = __builtin_amdgcn_mfma_f32_32x32x16_bf16(vfb0, fb0, o[dh], 0, 0, 0);
                    o[dh] = __builtin_amdgcn_mfma_f32_32x32x16_bf16(vfb1, fb1, o[dh], 0, 0, 0);
                }
            }
        } else if (need) {
#pragma unroll 1
            for (int kb = 0; kb < 2; ++kb) {
                const int key0 = kt * 64 + kb * 32;
                bool fast;
                if (MODE == 2) fast = kt < (tw0 >> 6);
                else if (MODE == 3) fast = (key0 + 31 <= tw0) && (key0 + 512 > tw0 + 7);
                else fast = key0 + 31 < nvmin;
                if (MODE != 1) fast = fast && !__any(m < -1e29f);
                float c0 = 0.f;
                if (fast) c0 = (MODE == 1) ? cinit : ((MODE == 2 && !selbit) ? -1e30f : -m);
                f32x16 p;
#pragma unroll
                for (int r = 0; r < 16; ++r) p[r] = c0;
#pragma unroll
                for (int d0 = 0; d0 < 4; ++d0) {
                    const bf16x8 kf = *(const LAS bf16x8*)(Kb + (2 * d0 + hi) * 1024 + (32 * kb + r32) * 16);
                    p = __builtin_amdgcn_mfma_f32_32x32x16_bf16(kf, qr[d0], p, 0, 0, 0);
                }
                float pe[16];
                if (fast) {
                    if (MODE != 1) {
                        float mx = fmaxf(fmaxf(p[0], p[1]), p[2]);
#pragma unroll
                        for (int r = 3; r < 15; r += 2) mx = fmaxf(fmaxf(mx, p[r]), p[r + 1]);
                        mx = xhalf_max(fmaxf(mx, p[15]));
                        if (__any(mx > NSA_THR)) {
                            const float dl = fmaxf(mx, 0.f), alpha = fexp2(-dl);
                            m += dl; l *= alpha;
#pragma unroll
                            for (int r = 0; r < 16; ++r) p[r] -= dl;
                            if (MODE != 0) {
#pragma unroll
                                for (int r = 0; r < 16; ++r) { o[0][r] *= alpha; o[1][r] *= alpha; }
                            }
                        }
                    }
                    float ps0 = 0.f, ps1 = 0.f;
#pragma unroll
                    for (int r = 0; r < 16; r += 2) { pe[r] = fexp2(p[r]); pe[r + 1] = fexp2(p[r + 1]); ps0 += pe[r]; ps1 += pe[r + 1]; }
                    if (MODE != 1) l += ps0 + ps1;
                } else if (MODE == 1) {
#pragma unroll
                    for (int r = 0; r < 16; ++r) { const int key = key0 + crow(r, hi); pe[r] = (key < nv) ? fexp2(p[r] + cinit) : 0.f; }
                } else {
                    float mx = NEGBIG;
#pragma unroll
                    for (int r = 0; r < 16; ++r) {
                        const int key = key0 + crow(r, hi); bool ok;
                        if (MODE == 0) ok = key < nv;
                        else if (MODE == 2) ok = selbit && (kt < (t >> 6) || key <= t);
                        else ok = (key <= t) && (key + 512 > t);
                        p[r] = ok ? p[r] : NEGBIG; mx = fmaxf(mx, p[r]);
                    }
                    mx = xhalf_max(mx);
                    const float mn = fmaxf(m, mx), alpha = fexp2(m - mn);
                    float ps = 0.f;
#pragma unroll
                    for (int r = 0; r < 16; ++r) { pe[r] = (p[r] > -1e29f) ? fexp2(p[r] - mn) : 0.f; ps += pe[r]; }
                    l = l * alpha + ps; m = mn;
                    if (MODE != 0) {
#pragma unroll
                        for (int r = 0; r < 16; ++r) { o[0][r] *= alpha; o[1][r] *= alpha; }
                    }
                }
                if (MODE == 1) {
#pragma unroll
                    for (int rg = 0; rg < 4; ++rg) {
                        float a = (pe[4 * rg] + pe[4 * rg + 1]) + (pe[4 * rg + 2] + pe[4 * rg + 3]), sp = pe[4 * rg + 3];
                        a += __shfl_xor(a, 1); a += __shfl_xor(a, 2); sp += __shfl_xor(sp, 1); sp += __shfl_xor(sp, 2);
                        if ((r32 & 3) == 0) { const int jp = (key0 >> 2) + 2 * rg + hi;
                            __hip_atomic_fetch_add(impw + tokl * 128 + jp, a, __ATOMIC_RELAXED, __HIP_MEMORY_SCOPE_WORKGROUP);
                            if (jp + 1 < 128) __hip_atomic_fetch_add(impw + tokl * 128 + jp + 1, sp, __ATOMIC_RELAXED, __HIP_MEMORY_SCOPE_WORKGROUP); }
                    }
                }
                if (MODE != 0) {
                    v4u pw0, pw1;
                    pw0.x = cvtpk(pe[0], pe[1]); pw0.y = cvtpk(pe[2], pe[3]); pw0.z = cvtpk(pe[4], pe[5]); pw0.w = cvtpk(pe[6], pe[7]);
                    pw1.x = cvtpk(pe[8], pe[9]); pw1.y = cvtpk(pe[10], pe[11]); pw1.z = cvtpk(pe[12], pe[13]); pw1.w = cvtpk(pe[14], pe[15]);
                    const bf16x8 pf0 = __builtin_bit_cast(bf16x8, pw0), pf1 = __builtin_bit_cast(bf16x8, pw1);
                    const LAS unsigned char* vb = Vb + (32 * kb + 4 * hi + ((F.lane & 15) >> 2)) * 64 + ((F.lane >> 4) & 1) * 32 + (F.lane & 3) * 8;
#pragma unroll
                    for (int dh = 0; dh < 2; ++dh) {
                        const s16x4 a0 = ds_tr16(vb + dh * 4096), a1 = ds_tr16(vb + dh * 4096 + 512), b0 = ds_tr16(vb + dh * 4096 + 1024), b1 = ds_tr16(vb + dh * 4096 + 1024 + 512);
                        const bf16x8 vf0 = {a0[0], a0[1], a0[2], a0[3], a1[0], a1[1], a1[2], a1[3]}, vf1 = {b0[0], b0[1], b0[2], b0[3], b1[0], b1[1], b1[2], b1[3]};
                        o[dh] = __builtin_amdgcn_mfma_f32_32x32x16_bf16(vf0, pf0, o[dh], 0, 0, 0);
                        o[dh] = __builtin_amdgcn_mfma_f32_32x32x16_bf16(vf1, pf1, o[dh], 0, 0, 0);
                    }
                }
            }
        }
        if (has_next) { *(LAS v4u*)(KB + (buf ^ 1) * 8192 + F.tid * 16) = kreg; if (MODE != 0) *(LAS v4u*)(VB + (buf ^ 1) * 8192 + F.tid * 16) = vreg; }
        __syncthreads();
    }
}

__device__ __forceinline__ void nsa_item(Frame& F, int b, int g, int qi) {
    const int r32 = F.lane & 31, hi = F.lane >> 5, tokl = r32 >> 2, hh = r32 & 3;
    const int t0 = qi * 64, tw0 = t0 + 8 * F.wave, t = tw0 + tokl;
    const unsigned char* dob = F.dout_b;
    const size_t img = (size_t)(b * 2 + g) * (1u << 20);
    LAS float* impw = (LAS float*)(F.lds + RING_OFF + NSA_IMP) + F.wave * 1024;
    LAS unsigned* selm = (LAS unsigned*)(F.lds + TAB_OFF + 1024) + F.wave * 32;
    LAS float* oaccw = (LAS float*)(F.lds + RING_OFF + NSA_OACC) + F.wave * 2048 + F.lane;
#pragma unroll
    for (int i = 0; i < 16; ++i) impw[F.lane + 64 * i] = 0.f;
    bf16x8 qr[4];
    { const bf16* qrow = (const bf16*)(dob + DO_QN) + (((size_t)(b * 2 + g) * SEQ + tw0) * 4 + r32) * 64;
#pragma unroll
      for (int d0 = 0; d0 < 4; ++d0) qr[d0] = *(const bf16x8*)(qrow + 16 * d0 + 8 * hi); }
    const float* gt = (const float*)(F.ws + WS_GATES) + ((size_t)b * SEQ + t) * 24 + (g * 4 + hh) * 3;
#if defined(NSA_ZERO_CMP)
    const float g0 = 0.f, g1 = gt[1], g2 = gt[2];
#elif defined(NSA_ZERO_SEL)
    const float g0 = gt[0], g1 = 0.f, g2 = gt[2];
#elif defined(NSA_ZERO_WIN)
    const float g0 = gt[0], g1 = gt[1], g2 = 0.f;
#elif defined(NSA_ZERO_ALL)
    const float g0 = 0.f, g1 = 0.f, g2 = 0.f;
#else
    const float g0 = gt[0], g1 = gt[1], g2 = gt[2];
#endif
    f32x16 o[2];
    const int nv = (t >= 31) ? ((t - 31) >> 4) + 1 : 0, nvw = (tw0 + 7 >= 31) ? ((tw0 + 7 - 31) >> 4) + 1 : 0, nvmin = (tw0 >= 31) ? ((tw0 - 31) >> 4) + 1 : 0;
    const int nct = (4 * qi + 3 + 63) >> 6;
    const unsigned char* Kc = dob + DO_KCMP + (size_t)(b * 2 + g) * 65536; const unsigned char* Vc = dob + DO_VCMP + (size_t)(b * 2 + g) * 65536;
#if defined(NSA_SPIN)
    unsigned long long tsp = __builtin_amdgcn_s_memrealtime();
#define NSPIN(k) do { if (NSA_SPIN == (k)) { const unsigned long long t1_ = __builtin_amdgcn_s_memrealtime(), dt_ = t1_ - tsp; while (__builtin_amdgcn_s_memrealtime() - t1_ < dt_) __builtin_amdgcn_s_sleep(4); } tsp = __builtin_amdgcn_s_memrealtime(); } while (0)
#else
#define NSPIN(k) do { } while (0)
#endif
    float m = NEGBIG, l = 0.f;
    nsa_branch<0>(F, Kc, Vc, 0, nct, qr, m, l, o, t, tw0, nv, nvw, nvmin, 0u, 0u, 0u, 0u, 0u, 0u, 0u, 0u, 0.f, impw);
    { const float lt = l + __shfl_xor(l, 32); const float cinit = (lt > 0.f) ? -__log2f(lt) - m : -1e30f;
#pragma unroll
      for (int r = 0; r < 16; ++r) { o[0][r] = 0.f; o[1][r] = 0.f; }
      nsa_branch<1>(F, Kc, Vc, 0, nct, qr, m, l, o, t, tw0, nv, nvw, nvmin, 0u, 0u, 0u, 0u, 0u, 0u, 0u, 0u, cinit, impw);
#pragma unroll
      for (int r = 0; r < 16; ++r) { oaccw[r * 64] = g0 * o[0][r]; oaccw[(16 + r) * 64] = g0 * o[1][r]; } }
    __syncthreads();
    NSPIN(1);
#pragma unroll 1
    for (int tl = 0; tl < 8; ++tl) {
        const int tt = tw0 + tl, cur = tt >> 6, j0 = F.lane, j1 = F.lane + 64;
        const unsigned u0 = (j0 <= cur) ? (__float_as_uint(impw[tl * 128 + j0] + ((j0 == 0 || j0 == cur || j0 == cur - 1) ? 1e4f : 0.f)) + 1u) : 0u;
        const unsigned u1 = (j1 <= cur) ? (__float_as_uint(impw[tl * 128 + j1] + ((j1 == cur || j1 == cur - 1) ? 1e4f : 0.f)) + 1u) : 0u;
        bool s0, s1;
        if (cur < 16) { s0 = (j0 <= cur); s1 = false; }
        else {
            unsigned T = 0u;
#pragma unroll 1
            for (int bit = 31; bit >= 0; --bit) {
                const unsigned cand = T | (1u << bit);
                const int c = __popcll(__ballot(u0 >= cand)) + __popcll(__ballot(u1 >= cand));
                if (c >= 16) T = cand;
            }
            const unsigned long long g0 = __ballot(u0 > T), g1 = __ballot(u1 > T), e0 = __ballot(u0 == T), e1 = __ballot(u1 == T);
            const int need = 16 - (__popcll(g0) + __popcll(g1));
            const unsigned long long below = (F.lane == 0) ? 0ull : (~0ull >> (64 - F.lane));
            const int rank0 = __popcll(e0 & below), rank1 = __popcll(e0) + __popcll(e1 & below);
            s0 = (u0 > T) || (u0 == T && rank0 < need);
            s1 = (u1 > T) || (u1 == T && rank1 < need);
        }
        const unsigned long long m0 = __ballot(s0), m1 = __ballot(s1);
        if (F.lane == 0) { selm[tl * 4 + 0] = (unsigned)m0; selm[tl * 4 + 1] = (unsigned)(m0 >> 32); selm[tl * 4 + 2] = (unsigned)m1; selm[tl * 4 + 3] = (unsigned)(m1 >> 32); }
    }
    __syncthreads();
    const unsigned mk0 = selm[tokl * 4 + 0], mk1 = selm[tokl * 4 + 1], mk2 = selm[tokl * 4 + 2], mk3 = selm[tokl * 4 + 3];
    unsigned wo0 = 0u, wo1 = 0u, wo2 = 0u, wo3 = 0u;
#pragma unroll
    for (int tl = 0; tl < 8; ++tl) { wo0 |= selm[tl * 4 + 0]; wo1 |= selm[tl * 4 + 1]; wo2 |= selm[tl * 4 + 2]; wo3 |= selm[tl * 4 + 3]; }
    wo0 = __builtin_amdgcn_readfirstlane(wo0); wo1 = __builtin_amdgcn_readfirstlane(wo1); wo2 = __builtin_amdgcn_readfirstlane(wo2); wo3 = __builtin_amdgcn_readfirstlane(wo3);
    NSPIN(2);
    { m = NEGBIG; l = 0.f;
#pragma unroll
      for (int r = 0; r < 16; ++r) { o[0][r] = 0.f; o[1][r] = 0.f; }
      nsa_branch<2>(F, dob + DO_KSEL + img, dob + DO_VSEL + img, 0, qi + 1, qr, m, l, o, t, tw0, nv, nvw, nvmin, mk0, mk1, mk2, mk3, wo0, wo1, wo2, wo3, 0.f, impw);
      const float lt = l + __shfl_xor(l, 32); const float sc = (lt > 0.f) ? g1 / lt : 0.f;
#pragma unroll
      for (int r = 0; r < 16; ++r) { oaccw[r * 64] += sc * o[0][r]; oaccw[(16 + r) * 64] += sc * o[1][r]; } }
    NSPIN(3);
    { m = NEGBIG; l = 0.f;
#pragma unroll
      for (int r = 0; r < 16; ++r) { o[0][r] = 0.f; o[1][r] = 0.f; }
      nsa_branch<3>(F, dob + DO_KWIN + img, dob + DO_VWIN + img, (qi >= 8) ? qi - 8 : 0, qi + 1, qr, m, l, o, t, tw0, nv, nvw, nvmin, 0u, 0u, 0u, 0u, 0u, 0u, 0u, 0u, 0.f, impw);
      const float lt = l + __shfl_xor(l, 32); const float sc = (lt > 0.f) ? g2 / lt : 0.f;
#pragma unroll
      for (int r = 0; r < 16; ++r) { o[0][r] = oaccw[r * 64] + sc * o[0][r]; o[1][r] = oaccw[(16 + r) * 64] + sc * o[1][r]; } }
    NSPIN(4);
    bf16* orow = (bf16*)(F.ws + WS_O + 32 * MiB) + ((size_t)b * SEQ + t) * DM + 512 + (g * 4 + hh) * 64;
#pragma unroll
    for (int dh = 0; dh < 2; ++dh)
#pragma unroll
        for (int rg = 0; rg < 4; ++rg) { v2u w; w.x = pk2(o[dh][4 * rg], o[dh][4 * rg + 1]); w.y = pk2(o[dh][4 * rg + 2], o[dh][4 * rg + 3]);
            *(v2u*)(orow + 32 * dh + 8 * rg + 4 * hi) = w; }
    __syncthreads();
}

__device__ __forceinline__ void sgu_item(Frame& F, int item) {
    const int gg = item & 7, ck = (item >> 3) & 63, b = item >> 9;
    const size_t tok0 = (size_t)b * SEQ + ck * 128;
    const bf16* Z = (const bf16*)(F.ws + WS_A);
    constexpr int RS = 544, BS = 136;
    LAS bf16* Ws = (LAS bf16*)(F.lds + RING_OFF);
    LAS unsigned char* Vs = F.lds + RING_OFF + 34816;
    LAS float* rs = (LAS float*)(F.lds + RING_OFF + 34816 + 128 * RS);
    if (F.tid < 128) { const float* st = (const float*)(F.ws + WS_STATS) + (tok0 + F.tid) * 32; float sum = 0.f;
#pragma unroll
        for (int k = 0; k < 32; k += 4) { const f32x4 v = *(const f32x4*)(st + k); sum += (v.x + v.y) + (v.z + v.w); }
        rs[F.tid] = 1.0f / sqrtf(sum * (1.0f / SGW) + NORM_EPS); }
    { const float* wsrc = F.sgu_ws + (size_t)gg * 128 * 128;
#pragma unroll
      for (int k = 0; k < 8; ++k) { const int p = F.tid + 512 * k, tr = p >> 5, sc = (p & 31) * 4; const f32x4 w = *(const f32x4*)(wsrc + tr * 128 + sc);
          v2u o; o.x = pk2((sc <= tr) ? w.x : 0.f, (sc + 1 <= tr) ? w.y : 0.f); o.y = pk2((sc + 2 <= tr) ? w.z : 0.f, (sc + 3 <= tr) ? w.w : 0.f);
          *(LAS v2u*)(Ws + tr * 136 + sc) = o; } }
    __syncthreads();
    { const int cc = F.tid & 31; float gn[8];
#pragma unroll
      for (int i = 0; i < 8; ++i) gn[i] = F.sgu_ng[gg * 256 + cc * 8 + i];
      v4u zr[8];
#pragma unroll
      for (int k = 0; k < 8; ++k) { const int sidx = (F.tid >> 5) + 16 * k; zr[k] = *(const v4u*)(Z + (tok0 + sidx) * 4096 + 2048 + gg * 256 + cc * 8); }
#pragma unroll
      for (int k = 0; k < 8; ++k) { const int sidx = (F.tid >> 5) + 16 * k; float x[8]; unpack8(zr[k], x); const float rr = rs[sidx];
#pragma unroll
          for (int i = 0; i < 8; ++i) x[i] *= rr * gn[i];
          const v4u o = pack8(x); LAS unsigned char* dst = Vs + sidx * RS + (cc >> 3) * BS + (cc & 7) * 16;
          *(LAS v2u*)dst = (v2u){o.x, o.y}; *(LAS v2u*)(dst + 8) = (v2u){o.z, o.w}; } }
    __syncthreads();
    f32x4 acc[16];
#pragma unroll
    for (int nt = 0; nt < 16; ++nt) acc[nt] = (f32x4){0.f, 0.f, 0.f, 0.f};
    const int ksteps = (16 * F.wave + 16 + 31) >> 5;
    const LAS bf16* wp = Ws + (16 * F.wave + (F.lane & 15)) * 136 + (F.lane >> 4) * 8;
    const LAS unsigned char* vp = Vs + (8 * (F.lane >> 4) + ((F.lane & 15) >> 2)) * RS + (F.lane & 3) * BS;
#pragma unroll 1
    for (int kk = 0; kk < ksteps; ++kk) {
        const bf16x8 wf = *(const LAS bf16x8*)(wp + kk * 32);
        const LAS unsigned char* vk = vp + kk * 32 * RS;
#pragma unroll
        for (int nt = 0; nt < 16; ++nt) {
            const s16x4 lo = ds_tr16(vk + 8 * nt), hi4 = ds_tr16(vk + 4 * RS + 8 * nt);
            const bf16x8 vf = {lo[0], lo[1], lo[2], lo[3], hi4[0], hi4[1], hi4[2], hi4[3]};
            acc[nt] = __builtin_amdgcn_mfma_f32_16x16x32_bf16(vf, wf, acc[nt], 0, 0, 0);
        }
    }
    { const int tr = 16 * F.wave + (F.lane & 15), g = F.lane >> 4; const float bs = F.sgu_bs[gg * 128 + tr];
      const bf16* urow = Z + (tok0 + tr) * 4096 + gg * 256 + 64 * g; bf16* orow = (bf16*)(F.ws + WS_O) + (tok0 + tr) * SGW + gg * 256 + 64 * g;
#pragma unroll
      for (int j = 0; j < 8; ++j) { float u[8]; unpack8(*(const v4u*)(urow + 8 * j), u);
#pragma unroll
          for (int i = 0; i < 4; ++i) { u[i] *= acc[2 * j][i] + bs; u[4 + i] *= acc[2 * j + 1][i] + bs; }
          *(v4u*)(orow + 8 * j) = pack8(u); } }
    __syncthreads();
}


__device__ __forceinline__ void moe_tail_copies(Frame& F, int set) {
    const int np = ((const LAS int*)(F.lds + TAB_OFF))[16];
    int cthr = 4 * np - 2 * F.G; cthr = cthr < 0 ? 0 : (cthr > F.G - 64 ? F.G - 64 : cthr);
    __syncthreads();
    if (F.bid >= cthr) tr_run(F, set, (F.bid - cthr) * 8 + F.wave, (F.G - cthr) * 8);
}
constexpr int NPHASE = 18;
struct Args { const void* in[26]; float* out; unsigned char* ws; int ph_lo, ph_hi, use_bar, pad; };
__global__ void __launch_bounds__(512, 2) trunk_fwd(Args args) {
    extern __shared__ __attribute__((aligned(16))) unsigned char lds[];
    Frame F;
    F.lds = (LAS unsigned char*)lds;
    F.MISC = (volatile LAS unsigned*)(F.lds + MISC_OFF);
    F.tid = threadIdx.x; F.lane = F.tid & 63; F.wave = __builtin_amdgcn_readfirstlane(F.tid >> 6);
    F.G = gridDim.x; F.bid = blockIdx.x;
    F.ws = args.ws; F.out = args.out; F.dout_b = (unsigned char*)args.out;
    F.ctl = (gu32*)(args.ws + WS_CTL);
    F.x = (const float*)args.in[0]; F.c = (const float*)args.in[1]; F.positions = (const int*)args.in[2]; F.w_ada = (const float*)args.in[3]; F.b_ada = (const float*)args.in[4];
    F.norm_g = (const float*)args.in[5]; F.w_in_ab = (const float*)args.in[6]; F.w_out_ab = (const float*)args.in[7]; F.gla_w2 = (const float*)args.in[8]; F.gla_bg = (const float*)args.in[9];
    F.gla_ng = (const float*)args.in[10]; F.q_gain = (const float*)args.in[11]; F.k_gain = (const float*)args.in[12]; F.cmp_pe = (const float*)args.in[13]; F.cmp_w1 = (const float*)args.in[14];
    F.cmp_w2 = (const float*)args.in[15]; F.w_in_c = (const float*)args.in[16]; F.sgu_ng = (const float*)args.in[17]; F.sgu_ws = (const float*)args.in[18]; F.sgu_bs = (const float*)args.in[19];
    F.w_out_c = (const float*)args.in[20]; F.w_router = (const float*)args.in[21]; F.r_bias = (const float*)args.in[22]; F.w_gate = (const float*)args.in[23]; F.w_up = (const float*)args.in[24];
    F.w_down = (const float*)args.in[25];
    for (int u = F.tid; u < (LDS_BYTES - LDSCTL_OFF) / 4; u += 512) ((LAS unsigned*)(F.lds + LDSCTL_OFF))[u] = 0u;
    __syncthreads();
    XcdBarrier bar; bar.bar = (unsigned*)(F.ctl + CW_BAR); bar.x = 0; bar.st = nullptr;
    if (args.use_bar) bar = xcd_barrier_post((unsigned*)(F.ctl + CW_BAR) + (args.use_bar - 1) * XCD_BAR_WORDS, F.MISC + 8);
    const int lo = args.ph_lo, hi = args.ph_hi;
#ifndef PH_MASK
#define PH_MASK 0x3FFFFu
#endif
#define IN(k) ((((PH_MASK) >> (k)) & 1u) && lo <= (k) && (k) < hi)
#if defined(SPIN_PHASE)
    unsigned long long t_mark = __builtin_amdgcn_s_memrealtime();
#define SPIN_HOOK(k) do { if ((k) == (SPIN_PHASE)) { const unsigned long long t1_ = __builtin_amdgcn_s_memrealtime(), dt_ = t1_ - t_mark; while (__builtin_amdgcn_s_memrealtime() - t1_ < dt_) __builtin_amdgcn_s_sleep(4); } } while (0)
#define SPIN_MARK() do { t_mark = __builtin_amdgcn_s_memrealtime(); } while (0)
#else
#define SPIN_HOOK(k) do { } while (0)
#define SPIN_MARK() do { } while (0)
#endif
#define SEAM(k) do { if (IN(k)) SPIN_HOOK(k); if (IN(k) && IN((k) + 1)) xcd_barrier(bar); SPIN_MARK(); } while (0)
    float* mod = (float*)(F.ws + WS_MOD);
    bf16* Hb = (bf16*)(F.ws + WS_O);
    bf16* Ab = (bf16*)(F.ws + WS_A);

    if (IN(0)) { p0_prologue(F); } SEAM(0);
    if (IN(1)) { row_pass<false, true, false>(F, F.x, mod, 0, F.norm_g, mod, 0, 0); } SEAM(1);
    if (IN(2)) { pg8::Gemm g{Hb, (const bf16*)(F.ws + WS_WIN), NTOK, NPROJ, DM}; pg8::StaticOrder S; S.init(NTOK, NPROJ, F.G, F.bid);
        pg8::EpiBf16<0> E{Ab, NPROJ, nullptr, 0, 0, 1.f};
        pg8::gemm_phase<pg8::EpiBf16<0>, pg8::StaticOrder, true, true>(F.lds + RING_OFF, g, S, E); } SEAM(2);
    if (IN(3)) {
        for (int it = F.bid; it < 1024; it += F.G) gla_prep_item(F, it);
        for (int tok = F.bid * 8 + F.wave; tok < NTOK; tok += F.G * 8) nsa_prep_token(F, tok);
    } SEAM(3);
    if (IN(4)) {
        const int half = F.G >> 1;
        if (F.bid < half) { for (int it = F.bid; it < 128; it += half) nsa_compress_item(F, it); }
        else { for (int gi = (F.bid - half) * 512 + F.tid; gi < 65536; gi += (F.G - half) * 512) gla_scan(F, gi); }
    } SEAM(4);
    if (IN(5)) {
#ifndef NO_NSA
        for (int p = F.bid; p < 256; p += F.G) { const int bg = p >> 6, i = p & 63; nsa_item(F, bg >> 1, bg & 1, i); nsa_item(F, bg >> 1, bg & 1, 127 - i); }
#endif
#ifndef NO_GLAOUT
#if defined(GLA_SPIN)
        { const unsigned long long tg0 = __builtin_amdgcn_s_memrealtime();
#endif
        for (int it = F.bid; it < 1024; it += F.G) gla_out_item(F, it);
#if defined(GLA_SPIN)
          const unsigned long long t1_ = __builtin_amdgcn_s_memrealtime(), dt_ = t1_ - tg0; while (__builtin_amdgcn_s_memrealtime() - t1_ < dt_) __builtin_amdgcn_s_sleep(4); }
#endif
#endif
    } SEAM(5);
    if (IN(6)) { pg8::Gemm g{(const bf16*)(F.ws + WS_O + 32 * MiB), (const bf16*)(F.ws + WS_WOUT), NTOK, DM, DM}; pg8::StaticOrder S; S.init(NTOK, DM, F.G, F.bid);
        EpiResid E{F.x, F.out, mod + 2 * 1024};
        pg8::gemm_phase<EpiResid, pg8::StaticOrder, true, true>(F.lds + RING_OFF, g, S, E); } SEAM(6);
#define MOE_BLOCK(P, LAYER) \
    if (IN(P)) { row_pass<false, true, true>(F, F.out, mod + (LAYER) * 2 * 6144, 3 * 1024, F.norm_g + ((LAYER) * 2 + 1) * 1024, mod, (LAYER), 0); } SEAM(P); \
    if (IN((P) + 1)) { moe_tables(F, (LAYER)); MoeOrder S{(const LAS int*)(F.lds + TAB_OFF), F.G, F.bid}; \
        { LAS unsigned* rofs = (LAS unsigned*)(F.lds + TAB_OFF + 2048); const int* elist = (const int*)(F.ws + WS_STATS); pg8::Unit uu; \
          for (int ui = 0; ui < 3; ++ui) if (S.next(ui, uu)) { if (F.tid < 256) rofs[ui * 256 + F.tid] = S.row_off(uu, F.tid, elist); } \
          __syncthreads(); } \
        pg8::Gemm g{Hb, (const bf16*)(F.ws + WS_WGU) + (size_t)(LAYER) * 16 * 1024 * 1024, MOE_ROWS, 1024, DM}; EpiMoeGU E{(bf16*)(F.ws + WS_A + A_HID_OFF)}; \
        pg8::gemm_phase_gather<EpiMoeGU, MoeOrder>(F.lds + RING_OFF, g, S, E, (const LAS unsigned*)(F.lds + TAB_OFF + 2048)); \
        if ((LAYER) == 0) moe_tail_copies(F, 1); } SEAM((P) + 1); \
    if (IN((P) + 2)) { moe_tables(F, (LAYER)); MoeOrder S{(const LAS int*)(F.lds + TAB_OFF), F.G, F.bid}; \
        pg8::Gemm g{(const bf16*)(F.ws + WS_A + A_HID_OFF), (const bf16*)(F.ws + WS_WDN) + (size_t)(LAYER) * 16 * 1024 * 512, MOE_ROWS, 1024, EHID}; EpiMoeDn E{Ab}; \
        pg8::gemm_phase<EpiMoeDn, MoeOrder, true, true>(F.lds + RING_OFF, g, S, E); \
        if ((LAYER) == 0) moe_tail_copies(F, 2); } SEAM((P) + 2);
    MOE_BLOCK(7, 0)
    if (IN(10)) { row_pass<true, true, false>(F, F.out, mod + 2 * 6144, 0, F.norm_g + 2 * 1024, mod, 1, 0); } SEAM(10);
    if (IN(11)) { pg8::Gemm g{Hb, (const bf16*)(F.ws + WS_WINC), NTOK, 4096, DM}; pg8::StaticOrder S; S.init(NTOK, 4096, F.G, F.bid);
        EpiGeluStats E{Ab, (float*)(F.ws + WS_STATS)};
        pg8::gemm_phase<EpiGeluStats, pg8::StaticOrder, true, true>(F.lds + RING_OFF, g, S, E); } SEAM(11);
    if (IN(12)) { for (int it = F.bid; it < 1024; it += F.G) sgu_item(F, it); } SEAM(12);
    if (IN(13)) { pg8::Gemm g{Hb, (const bf16*)(F.ws + WS_WOUTC), NTOK, DM, SGW}; pg8::StaticOrder S; S.init(NTOK, DM, F.G, F.bid);
        EpiResid E{F.out, F.out, mod + 2 * 6144 + 2 * 1024};
        pg8::gemm_phase<EpiResid, pg8::StaticOrder, true, true>(F.lds + RING_OFF, g, S, E); } SEAM(13);
    MOE_BLOCK(14, 1)
    if (IN(17)) { row_pass<true, false, false>(F, F.out, mod, 0, F.norm_g, mod + 2 * 6144, 1, 1); SPIN_HOOK(17); }
#undef IN
#undef SEAM
#undef MOE_BLOCK
}

#ifndef MK_N_LAUNCHES
#define MK_N_LAUNCHES 1
#endif
extern "C" void kernel_launch(void* const* d_in, const int* in_sizes, int n_in, void* d_out, int out_size, void* d_ws, size_t ws_size, hipStream_t stream) {
    static int grid = 0;
    if (grid == 0) {
        if (n_in != 26 || out_size != NTOK * DM || ws_size < WS_END) { fprintf(stderr, "kernel_launch: unexpected problem shape / workspace (%d inputs, out %d, ws %zu)\n", n_in, out_size, ws_size); grid = -1; return; }
        int dev = 0, cus = 0, per_cu = 0;
        if (hipGetDevice(&dev) != hipSuccess || hipDeviceGetAttribute(&cus, hipDeviceAttributeMultiprocessorCount, dev) != hipSuccess) { grid = -1; return; }
        if (hipFuncSetAttribute((const void*)trunk_fwd, hipFuncAttributeMaxDynamicSharedMemorySize, LDS_BYTES) != hipSuccess) { fprintf(stderr, "kernel_launch: hipFuncSetAttribute failed\n"); grid = -1; return; }
        if (hipOccupancyMaxActiveBlocksPerMultiprocessor(&per_cu, (const void*)trunk_fwd, 512, LDS_BYTES) != hipSuccess || per_cu < 1) { fprintf(stderr, "kernel_launch: occupancy query says %d blocks per CU\n", per_cu); }
        (void)hipGetLastError();
        grid = cus;
        if (grid != 256) { fprintf(stderr, "kernel_launch: built for a 256-CU device, found %d CUs\n", cus); grid = -1; return; }
    }
    if (grid < 0) return;
    (void)hipMemsetAsync((char*)d_ws + WS_CTL, 0, CTL_ZERO_BYTES, stream);
    Args a{};
    for (int i = 0; i < 26; ++i) a.in[i] = d_in[i];
    a.out = (float*)d_out; a.ws = (unsigned char*)d_ws; a.pad = 0;
    if (MK_N_LAUNCHES == 1) {
#if defined(REP_PHASE)
        a.ph_lo = 0; a.ph_hi = REP_PHASE + 1; a.use_bar = 1;
        hipLaunchKernelGGL(trunk_fwd, dim3(grid), dim3(512), LDS_BYTES, stream, a);
        a.ph_lo = REP_PHASE; a.ph_hi = NPHASE; a.use_bar = 2;
        hipLaunchKernelGGL(trunk_fwd, dim3(grid), dim3(512), LDS_BYTES, stream, a);
#else
        a.ph_lo = 0; a.ph_hi = NPHASE; a.use_bar = 1;
        hipLaunchKernelGGL(trunk_fwd, dim3(grid), dim3(512), LDS_BYTES, stream, a);
#endif
    } else {
        for (int p = 0; p < NPHASE; ++p) { a.ph_lo = p; a.ph_hi = p + 1; a.use_bar = 0; hipLaunchKernelGGL(trunk_fwd, dim3(grid), dim3(512), LDS_BYTES, stream, a); }
    }
}
```

```cpp
#include <hip/hip_runtime.h>
#include <cstdio>
#include <cstdint>
namespace pg8 {
#define PG8_LAS __attribute__((address_space(3)))
typedef unsigned short bf16_t;
typedef short bf16x8 __attribute__((ext_vector_type(8)));
typedef float f32x4 __attribute__((ext_vector_type(4)));
typedef unsigned u32x4 __attribute__((ext_vector_type(4)));
constexpr int BM = 256, BK = 64, HALF = 128, HTB = HALF * BK * 2  , STAGE_BYTES = 8 * HTB, NXCD = 8, WGM = 8;

__host__ __device__ __forceinline__ int lds_byte(int r, int c) { const int st = (r >> 4) * 2 + (c >> 5), rr = r & 15, cc = c & 31, ob = rr * 64 + cc * 2; return st * 1024 + (ob ^ (((ob >> 9) & 1) << 5)); }
__host__ __device__ __forceinline__ void stage_rc(int b, int& R, int& C) { const int st = b / 1024, sb = b % 1024, swz = sb ^ (((sb >> 9) & 1) << 5); R = (st >> 1) * 16 + swz / 64; C = (st & 1) * 32 + (swz % 64) / 2; }
__host__ __device__ __forceinline__ int perm32(int rho) { const int n = rho >> 4, i = rho & 15; return 8 * (i >> 2) + 4 * n + (i & 3); }

struct Unit { int pm, pn; };
struct Gemm { const bf16_t* A; const bf16_t* Bt; int M, N, K; };

struct StaticOrder {
    int nM, nN, nwg, G, c;
    __host__ __device__ void init(int M, int N, int G_, int c_) { nM = M / BM; nN = N / BM; nwg = nM * nN; G = G_; c = c_; }
    __host__ __device__ bool next(int i, Unit& u) const {
        const long L = (long)i * G + c; if (L >= nwg) return false;
        int wgid = (int)L; { const int q = nwg / NXCD, r = nwg % NXCD, xcd = wgid % NXCD, off = wgid / NXCD; wgid = (xcd < r ? xcd * (q + 1) : r * (q + 1) + (xcd - r) * q) + off; }
        const int nig = WGM * nN, gid = wgid / nig, fm = gid * WGM, gsz = (nM - fm) < WGM ? (nM - fm) : WGM;
        u.pm = fm + ((wgid % nig) % gsz); u.pn = (wgid % nig) / gsz; return true;
    }
    __device__ __forceinline__ void a_ready(const Unit&) const {}
    __device__ __forceinline__ void done(const Unit&) const {}
};

__device__ __forceinline__ unsigned cvt_pk_bf16(float lo, float hi) { unsigned r; asm volatile("v_cvt_pk_bf16_f32 %0, %1, %2" : "=v"(r) : "v"(lo), "v"(hi)); return r; }
typedef float f32x2 __attribute__((ext_vector_type(2)));
__device__ __forceinline__ f32x2 gelu_pk(f32x2 v) {
    const f32x2 av = __builtin_elementwise_abs(v), d = av * 0.2316418882f + 1.0f;
    f32x2 t; t.x = __builtin_amdgcn_rcpf(d.x); t.y = __builtin_amdgcn_rcpf(d.y);
    f32x2 q = t * 0.5307027145f + (-0.7265760135f); q = q * t + 0.7107068705f; q = q * t + (-0.142248368f); q = q * t + 0.127414796f; q = q * t;
    const f32x2 s = (v * v) * (-0.72134752044f);
    f32x2 e; e.x = __builtin_amdgcn_exp2f(s.x); e.y = __builtin_amdgcn_exp2f(s.y);
    const f32x2 m = v * (q * e), r = v - m;
    f32x2 o; o.x = v.x < 0.f ? m.x : r.x; o.y = v.y < 0.f ? m.y : r.y; return o;
}

template <int ACT  > struct EpiBf16 {
    static constexpr bool PERM = true, AFTER_DRAIN = false; static_assert(ACT == 0 || ACT == 1, "EpiBf16: ACT is 0 (none) or 1 (gelu_pk)");
    bf16_t* O; int ldc; const float* bias; int split_cols; size_t split_stride; float scale0;
    __device__ __forceinline__ void operator()(const f32x4 (&acc)[2][2][4][2], const Unit& u, int wr, int wc, int fr, int fq) const {
        const int row0 = u.pm * BM + wr * 64 + fr; int colt = u.pn * BM; bf16_t* base = O;
        float sc = 1.f; if (split_cols) { const int t = colt / split_cols; base += (size_t)t * split_stride; colt -= t * split_cols; if (t == 0) sc = scale0; }
        const int col0 = colt + wc * 32 + 8 * fq, bcol0 = u.pn * BM + wc * 32 + 8 * fq;
        f32x4 bv[2][2];
#pragma unroll
        for (int bj = 0; bj < 2; ++bj)
#pragma unroll
            for (int n = 0; n < 2; ++n) bv[bj][n] = bias ? *(const f32x4*)(bias + bcol0 + bj * HALF + 4 * n) : (f32x4){0.f, 0.f, 0.f, 0.f};
#pragma unroll
        for (int ai = 0; ai < 2; ++ai)
#pragma unroll
            for (int m = 0; m < 4; ++m) { bf16_t* rowp = base + (size_t)(row0 + ai * HALF + m * 16) * ldc + col0;
#pragma unroll
                for (int bj = 0; bj < 2; ++bj) { f32x4 v0 = acc[ai][bj][m][0] + bv[bj][0], v1 = acc[ai][bj][m][1] + bv[bj][1];
                    if (ACT == 1) { f32x2 a = gelu_pk((f32x2){v0[0], v0[1]}), b = gelu_pk((f32x2){v0[2], v0[3]}), c = gelu_pk((f32x2){v1[0], v1[1]}), d = gelu_pk((f32x2){v1[2], v1[3]});
                        v0 = (f32x4){a.x, a.y, b.x, b.y}; v1 = (f32x4){c.x, c.y, d.x, d.y}; }
                    v0 = v0 * sc; v1 = v1 * sc; u32x4 w; w.x = cvt_pk_bf16(v0[0], v0[1]); w.y = cvt_pk_bf16(v0[2], v0[3]); w.z = cvt_pk_bf16(v1[0], v1[1]); w.w = cvt_pk_bf16(v1[2], v1[3]);
                    *(u32x4*)(rowp + bj * HALF) = w; } }
    }
};

template <class Epi, class Sched, bool ALIGN_EPI = false, bool SP2 = false>
__device__ __forceinline__ void gemm_phase(PG8_LAS unsigned char* lds, const Gemm g, const Sched& S, const Epi& E) {
    const int tid = threadIdx.x, wid = __builtin_amdgcn_readfirstlane(tid >> 6), lane = tid & 63, wr = wid >> 2, wc = wid & 3, fr = lane & 15, fq = lane >> 4;
    const int K = g.K, nt = K / BK;
    unsigned voffA[2], voffB[2];
#pragma unroll
    for (int i = 0; i < 2; ++i) { int R, C; stage_rc(tid * 16 + i * 8192, R, C); const int Rb = Epi::PERM ? ((R & ~31) + perm32(R & 31)) : R;
        voffA[i] = (unsigned)(R * K + C) * 2u; voffB[i] = (unsigned)(Rb * K + C) * 2u; }
    const size_t kstep = (size_t)(BK * 2);
    const size_t hstep = (size_t)HALF * K * 2;
    const size_t tstep = 2 * hstep;
    const unsigned ldsw = (unsigned)wid * 1024u;
    const int aoff = lds_byte(wr * 64 + fr, fq * 8), boff = lds_byte(wc * 32 + fr, fq * 8);
#define PG8_SA(b, h) (((b) * 2 + (h)) * HTB)
#define PG8_SB(b, h) ((4 + (b) * 2 + (h)) * HTB)
#define PG8_STAGE(bufoff, gbase, voff) do { _Pragma("unroll") for (int _i = 0; _i < 2; ++_i) \
        __builtin_amdgcn_global_load_lds((const unsigned*)((const char*)(gbase) + (voff)[_i]), (PG8_LAS unsigned*)(lds + (bufoff) + ldsw + _i * 8192), 16, 0, 0); } while (0)
#define PG8_LDA(dst, b, h) do { _Pragma("unroll") for (int m = 0; m < 4; ++m) _Pragma("unroll") for (int k = 0; k < 2; ++k) dst[m][k] = *(const PG8_LAS bf16x8*)(lds + PG8_SA(b, h) + aoff + m * 2048 + k * 1024); } while (0)
#define PG8_LDB(dst, b, h) do { _Pragma("unroll") for (int n = 0; n < 2; ++n) _Pragma("unroll") for (int k = 0; k < 2; ++k) dst[n][k] = *(const PG8_LAS bf16x8*)(lds + PG8_SB(b, h) + boff + n * 2048 + k * 1024); } while (0)
#define PG8_MMA(ai, bj, At, Bt) do { __builtin_amdgcn_s_setprio(1); _Pragma("unroll") for (int m = 0; m < 4; ++m) _Pragma("unroll") for (int n = 0; n < 2; ++n) _Pragma("unroll") for (int k = 0; k < 2; ++k) \
        acc[ai][bj][m][n] = __builtin_amdgcn_mfma_f32_16x16x32_bf16(Bt[n][k], At[m][k], acc[ai][bj][m][n], 0, 0, 0); __builtin_amdgcn_s_setprio(0); } while (0)
#define PG8_WAIT_V(n) asm volatile("s_waitcnt vmcnt(" #n ")" ::: "memory")
#define PG8_WAIT_L(n) asm volatile("s_waitcnt lgkmcnt(" #n ")" ::: "memory")
#define PG8_BAR __builtin_amdgcn_s_barrier()
#define PG8_SCHED __builtin_amdgcn_sched_barrier(0)
    Unit cur, nxt; int ui = 0;
    if (!S.next(0, cur)) return;
    f32x4 acc[2][2][4][2];
#pragma unroll
    for (int a = 0; a < 2; ++a)
#pragma unroll
        for (int b = 0; b < 2; ++b)
#pragma unroll
            for (int m = 0; m < 4; ++m)
#pragma unroll
                for (int n = 0; n < 2; ++n) acc[a][b][m][n] = (f32x4){0.f, 0.f, 0.f, 0.f};
    bf16x8 At[4][2], B0[2][2], B1[2][2];
    const char* cA = (const char*)g.A + (size_t)cur.pm * tstep; const char* cB = (const char*)g.Bt + (size_t)cur.pn * tstep;
    S.a_ready(cur);
    if constexpr (SP2) {
        PG8_STAGE(PG8_SB(0, 0), cB, voffB); PG8_STAGE(PG8_SB(0, 1), cB + hstep, voffB); PG8_STAGE(PG8_SA(0, 0), cA, voffA); PG8_STAGE(PG8_SA(0, 1), cA + hstep, voffA);
        if (wr == 1) PG8_BAR;
        PG8_WAIT_V(2); PG8_BAR;
        PG8_STAGE(PG8_SB(1, 0), cB + kstep, voffB); PG8_STAGE(PG8_SA(1, 0), cA + kstep, voffA); PG8_STAGE(PG8_SB(1, 1), cB + hstep + kstep, voffB);
        PG8_WAIT_V(6); PG8_BAR;
    } else {
        PG8_STAGE(PG8_SB(0, 0), cB, voffB); PG8_STAGE(PG8_SA(0, 0), cA, voffA); PG8_STAGE(PG8_SB(0, 1), cB + hstep, voffB); PG8_STAGE(PG8_SA(0, 1), cA + hstep, voffA);
        if (wr == 1) PG8_BAR;
        PG8_WAIT_V(4); PG8_BAR;
        PG8_STAGE(PG8_SB(1, 0), cB + kstep, voffB); PG8_STAGE(PG8_SA(1, 0), cA + kstep, voffA); PG8_STAGE(PG8_SB(1, 1), cB + hstep + kstep, voffB);
        PG8_WAIT_V(6); PG8_BAR;
    }
    for (;;) {
        const bool has_next = S.next(ui + 1, nxt);
        const char* nA = has_next ? (const char*)g.A + (size_t)nxt.pm * tstep : cA; const char* nB = has_next ? (const char*)g.Bt + (size_t)nxt.pn * tstep : cB;
        for (int t = 0; t < nt; t += 2) {
            const bool last = (t == nt - 2);
            const char* a1 = cA + (size_t)(t + 1) * kstep;
            const char* a2 = last ? nA : cA + (size_t)(t + 2) * kstep; const char* b2 = last ? nB : cB + (size_t)(t + 2) * kstep;
            const char* a3 = a2 + kstep; const char* b3 = b2 + kstep;
            if (last && has_next) S.a_ready(nxt);
            if constexpr (SP2) {
            PG8_LDB(B0, 0, 0); PG8_LDB(B1, 0, 1); PG8_SCHED; PG8_LDA(At, 0, 0); PG8_STAGE(PG8_SA(1, 1), a1 + hstep, voffA);
            PG8_WAIT_V(8); PG8_WAIT_L(0); PG8_BAR; PG8_MMA(0, 0, At, B0); PG8_MMA(0, 1, At, B1); PG8_BAR; PG8_SCHED;
            PG8_LDA(At, 0, 1); PG8_STAGE(PG8_SB(0, 0), b2, voffB); PG8_STAGE(PG8_SB(0, 1), b2 + hstep, voffB); PG8_STAGE(PG8_SA(0, 0), a2, voffA);
            PG8_WAIT_V(8); PG8_WAIT_L(0); PG8_BAR; PG8_MMA(1, 0, At, B0); PG8_MMA(1, 1, At, B1); PG8_BAR; PG8_SCHED;
            PG8_LDB(B0, 1, 0); PG8_LDB(B1, 1, 1); PG8_SCHED; PG8_LDA(At, 1, 0); PG8_STAGE(PG8_SA(0, 1), a2 + hstep, voffA);
            PG8_WAIT_V(8); PG8_WAIT_L(0); PG8_BAR; PG8_MMA(0, 0, At, B0); PG8_MMA(0, 1, At, B1); PG8_BAR; PG8_SCHED;
            PG8_LDA(At, 1, 1); PG8_STAGE(PG8_SB(1, 0), b3, voffB); PG8_STAGE(PG8_SB(1, 1), b3 + hstep, voffB); PG8_STAGE(PG8_SA(1, 0), a3, voffA);
            PG8_WAIT_V(8); PG8_WAIT_L(0); PG8_BAR; PG8_MMA(1, 0, At, B0); PG8_MMA(1, 1, At, B1); PG8_BAR; PG8_SCHED;
            } else {
            PG8_LDB(B0, 0, 0); PG8_SCHED; PG8_LDA(At, 0, 0); PG8_STAGE(PG8_SA(1, 1), a1 + hstep, voffA);
            PG8_WAIT_L(8); PG8_BAR; PG8_WAIT_L(0); PG8_MMA(0, 0, At, B0); PG8_BAR; PG8_SCHED;
            PG8_LDB(B1, 0, 1); PG8_STAGE(PG8_SB(0, 0), b2, voffB);
            PG8_BAR; PG8_WAIT_L(0); PG8_MMA(0, 1, At, B1); PG8_BAR;
            PG8_LDA(At, 0, 1); PG8_STAGE(PG8_SA(0, 0), a2, voffA);
            PG8_BAR; PG8_WAIT_L(0); PG8_MMA(1, 0, At, B0); PG8_BAR; PG8_SCHED;
            PG8_STAGE(PG8_SB(0, 1), b2 + hstep, voffB);
            PG8_WAIT_V(6); PG8_BAR; PG8_MMA(1, 1, At, B1); PG8_BAR;
            PG8_LDB(B0, 1, 0); PG8_SCHED; PG8_LDA(At, 1, 0); PG8_STAGE(PG8_SA(0, 1), a2 + hstep, voffA);
            PG8_WAIT_L(8); PG8_BAR; PG8_WAIT_L(0); PG8_MMA(0, 0, At, B0); PG8_BAR; PG8_SCHED;
            PG8_LDB(B1, 1, 1); PG8_STAGE(PG8_SB(1, 0), b3, voffB);
            PG8_BAR; PG8_WAIT_L(0); PG8_MMA(0, 1, At, B1); PG8_BAR;
            PG8_LDA(At, 1, 1); PG8_STAGE(PG8_SA(1, 0), a3, voffA);
            PG8_BAR; PG8_WAIT_L(0); PG8_MMA(1, 0, At, B0); PG8_BAR; PG8_SCHED;
            PG8_STAGE(PG8_SB(1, 1), b3 + hstep, voffB);
            PG8_WAIT_V(6); PG8_BAR; PG8_MMA(1, 1, At, B1); PG8_BAR;
            }
        }
        if constexpr (ALIGN_EPI) { if (wr == 0) PG8_BAR; }
        if constexpr (!Epi::AFTER_DRAIN) { E(acc, cur, wr, wc, fr, fq); S.done(cur); }
        if (!has_next) break;
#pragma unroll
        for (int a = 0; a < 2; ++a)
#pragma unroll
            for (int b = 0; b < 2; ++b)
#pragma unroll
                for (int m = 0; m < 4; ++m)
#pragma unroll
                    for (int n = 0; n < 2; ++n) acc[a][b][m][n] = (f32x4){0.f, 0.f, 0.f, 0.f};
        cur = nxt; cA = nA; cB = nB; ++ui;
        if constexpr (ALIGN_EPI) { if (wr == 1) PG8_BAR; }
    }
    PG8_WAIT_V(0);
    if constexpr (!ALIGN_EPI) { if (wr == 0) PG8_BAR; }
    PG8_BAR;
    if constexpr (Epi::AFTER_DRAIN) { E.fused(acc, cur, wr, wc, fr, fq, lds, wid, lane); S.done(cur); }
#undef PG8_SA
#undef PG8_SB
#undef PG8_STAGE
#undef PG8_LDA
#undef PG8_LDB
#undef PG8_MMA
#undef PG8_WAIT_V
#undef PG8_WAIT_L
#undef PG8_BAR
#undef PG8_SCHED
}
}

#ifndef PG8_SP2
#define PG8_SP2 true
#endif

namespace pg8 {
template <class Epi, class Sched>
__device__ __forceinline__ void gemm_phase_gather(PG8_LAS unsigned char* lds, const Gemm g, const Sched& S, const Epi& E, const PG8_LAS unsigned* rofs) {
    const int tid = threadIdx.x, wid = __builtin_amdgcn_readfirstlane(tid >> 6), lane = tid & 63, wr = wid >> 2, wc = wid & 3, fr = lane & 15, fq = lane >> 4;
    const int K = g.K, nt = K / BK;
    unsigned voffB[2]; int RA[2]; unsigned CA[2];
#pragma unroll
    for (int i = 0; i < 2; ++i) { int R, C; stage_rc(tid * 16 + i * 8192, R, C); const int Rb = Epi::PERM ? ((R & ~31) + perm32(R & 31)) : R;
        RA[i] = R; CA[i] = (unsigned)C * 2u; voffB[i] = (unsigned)(Rb * K + C) * 2u; }
    const size_t kstep = (size_t)(BK * 2);
    const size_t hstep = (size_t)HALF * K * 2;
    const size_t tstep = 2 * hstep;
    const unsigned ldsw = (unsigned)wid * 1024u;
    const int aoff = lds_byte(wr * 64 + fr, fq * 8), boff = lds_byte(wc * 32 + fr, fq * 8);
#define PG8_SA(b, h) (((b) * 2 + (h)) * HTB)
#define PG8_SB(b, h) ((4 + (b) * 2 + (h)) * HTB)
#define PG8_STAGE(bufoff, gbase, voff) do { _Pragma("unroll") for (int _i = 0; _i < 2; ++_i) \
        __builtin_amdgcn_global_load_lds((const unsigned*)((const char*)(gbase) + (voff)[_i]), (PG8_LAS unsigned*)(lds + (bufoff) + ldsw + _i * 8192), 16, 0, 0); } while (0)
#define PG8_STAGE_A(bufoff, koff, v0, v1) do { \
        __builtin_amdgcn_global_load_lds((const unsigned*)((const char*)g.A + (koff) + (v0)), (PG8_LAS unsigned*)(lds + (bufoff) + ldsw), 16, 0, 0); \
        __builtin_amdgcn_global_load_lds((const unsigned*)((const char*)g.A + (koff) + (v1)), (PG8_LAS unsigned*)(lds + (bufoff) + ldsw + 8192), 16, 0, 0); } while (0)
#define PG8_LDA(dst, b, h) do { _Pragma("unroll") for (int m = 0; m < 4; ++m) _Pragma("unroll") for (int k = 0; k < 2; ++k) dst[m][k] = *(const PG8_LAS bf16x8*)(lds + PG8_SA(b, h) + aoff + m * 2048 + k * 1024); } while (0)
#define PG8_LDB(dst, b, h) do { _Pragma("unroll") for (int n = 0; n < 2; ++n) _Pragma("unroll") for (int k = 0; k < 2; ++k) dst[n][k] = *(const PG8_LAS bf16x8*)(lds + PG8_SB(b, h) + boff + n * 2048 + k * 1024); } while (0)
#define PG8_MMA(ai, bj, At, Bt) do { __builtin_amdgcn_s_setprio(1); _Pragma("unroll") for (int m = 0; m < 4; ++m) _Pragma("unroll") for (int n = 0; n < 2; ++n) _Pragma("unroll") for (int k = 0; k < 2; ++k) \
        acc[ai][bj][m][n] = __builtin_amdgcn_mfma_f32_16x16x32_bf16(Bt[n][k], At[m][k], acc[ai][bj][m][n], 0, 0, 0); __builtin_amdgcn_s_setprio(0); } while (0)
#define PG8_WAIT_V(n) asm volatile("s_waitcnt vmcnt(" #n ")" ::: "memory")
#define PG8_WAIT_L(n) asm volatile("s_waitcnt lgkmcnt(" #n ")" ::: "memory")
#define PG8_BAR __builtin_amdgcn_s_barrier()
#define PG8_SCHED __builtin_amdgcn_sched_barrier(0)
    Unit cur, nxt; int ui = 0;
    if (!S.next(0, cur)) return;
    f32x4 acc[2][2][4][2];
#pragma unroll
    for (int a = 0; a < 2; ++a)
#pragma unroll
        for (int b = 0; b < 2; ++b)
#pragma unroll
            for (int m = 0; m < 4; ++m)
#pragma unroll
                for (int n = 0; n < 2; ++n) acc[a][b][m][n] = (f32x4){0.f, 0.f, 0.f, 0.f};
    bf16x8 At[4][2], B0[2][2], B1[2][2];
    const char* cB = (const char*)g.Bt + (size_t)cur.pn * tstep;
    unsigned vc00 = rofs[RA[0]] + CA[0], vc01 = rofs[RA[1]] + CA[1], vc10 = rofs[128 + RA[0]] + CA[0], vc11 = rofs[128 + RA[1]] + CA[1];
    unsigned vn00 = vc00, vn01 = vc01, vn10 = vc10, vn11 = vc11;
    PG8_WAIT_L(0);
    PG8_STAGE(PG8_SB(0, 0), cB, voffB); PG8_STAGE(PG8_SB(0, 1), cB + hstep, voffB); PG8_STAGE_A(PG8_SA(0, 0), 0, vc00, vc01); PG8_STAGE_A(PG8_SA(0, 1), 0, vc10, vc11);
    if (wr == 1) PG8_BAR;
    PG8_WAIT_V(2); PG8_BAR;
    PG8_STAGE(PG8_SB(1, 0), cB + kstep, voffB); PG8_STAGE_A(PG8_SA(1, 0), kstep, vc00, vc01); PG8_STAGE(PG8_SB(1, 1), cB + hstep + kstep, voffB);
    PG8_WAIT_V(6); PG8_BAR;
    for (;;) {
        const bool has_next = S.next(ui + 1, nxt);
        const char* nB = has_next ? (const char*)g.Bt + (size_t)nxt.pn * tstep : cB;
        if (has_next) { const PG8_LAS unsigned* rn = rofs + (ui + 1) * 256; vn00 = rn[RA[0]] + CA[0]; vn01 = rn[RA[1]] + CA[1]; vn10 = rn[128 + RA[0]] + CA[0]; vn11 = rn[128 + RA[1]] + CA[1]; }
        else { vn00 = vc00; vn01 = vc01; vn10 = vc10; vn11 = vc11; }
        for (int t = 0; t < nt; t += 2) {
            const bool last = (t == nt - 2);
            const size_t k1 = (size_t)(t + 1) * kstep;
            const size_t k2 = last ? 0 : (size_t)(t + 2) * kstep; const char* b2 = last ? nB : cB + (size_t)(t + 2) * kstep;
            const size_t k3 = k2 + kstep; const char* b3 = b2 + kstep;
            const unsigned w00 = last ? vn00 : vc00, w01 = last ? vn01 : vc01, w10 = last ? vn10 : vc10, w11 = last ? vn11 : vc11;
            PG8_LDB(B0, 0, 0); PG8_LDB(B1, 0, 1); PG8_SCHED; PG8_LDA(At, 0, 0); PG8_STAGE_A(PG8_SA(1, 1), k1, vc10, vc11);
            PG8_WAIT_V(8); PG8_WAIT_L(0); PG8_BAR; PG8_MMA(0, 0, At, B0); PG8_MMA(0, 1, At, B1); PG8_BAR; PG8_SCHED;
            PG8_LDA(At, 0, 1); PG8_STAGE(PG8_SB(0, 0), b2, voffB); PG8_STAGE(PG8_SB(0, 1), b2 + hstep, voffB); PG8_STAGE_A(PG8_SA(0, 0), k2, w00, w01);
            PG8_WAIT_V(8); PG8_WAIT_L(0); PG8_BAR; PG8_MMA(1, 0, At, B0); PG8_MMA(1, 1, At, B1); PG8_BAR; PG8_SCHED;
            PG8_LDB(B0, 1, 0); PG8_LDB(B1, 1, 1); PG8_SCHED; PG8_LDA(At, 1, 0); PG8_STAGE_A(PG8_SA(0, 1), k2, w10, w11);
            PG8_WAIT_V(8); PG8_WAIT_L(0); PG8_BAR; PG8_MMA(0, 0, At, B0); PG8_MMA(0, 1, At, B1); PG8_BAR; PG8_SCHED;
            PG8_LDA(At, 1, 1); PG8_STAGE(PG8_SB(1, 0), b3, voffB); PG8_STAGE(PG8_SB(1, 1), b3 + hstep, voffB); PG8_STAGE_A(PG8_SA(1, 0), k3, w00, w01);
            PG8_WAIT_V(8); PG8_WAIT_L(0); PG8_BAR; PG8_MMA(1, 0, At, B0); PG8_MMA(1, 1, At, B1); PG8_BAR; PG8_SCHED;
        }
        if (wr == 0) PG8_BAR;
        E(acc, cur, wr, wc, fr, fq); S.done(cur);
        if (!has_next) break;
#pragma unroll
        for (int a = 0; a < 2; ++a)
#pragma unroll
            for (int b = 0; b < 2; ++b)
#pragma unroll
                for (int m = 0; m < 4; ++m)
#pragma unroll
                    for (int n = 0; n < 2; ++n) acc[a][b][m][n] = (f32x4){0.f, 0.f, 0.f, 0.f};
        cur = nxt; cB = nB; ++ui; vc00 = vn00; vc01 = vn01; vc10 = vn10; vc11 = vn11;
        if (wr == 1) PG8_BAR;
    }
    PG8_WAIT_V(0);
    PG8_BAR;
#undef PG8_SA
#undef PG8_SB
#undef PG8_STAGE
#undef PG8_STAGE_A
#undef PG8_LDA
#undef PG8_LDB
#undef PG8_MMA
#undef PG8_WAIT_V
#undef PG8_WAIT_L
#undef PG8_BAR
#undef PG8_SCHED
}
}

constexpr int NB = 2, SEQ = 8192, DM = 1024, NTOK = NB * SEQ;
constexpr int NPROJ = 3072;
constexpr int C_GQ = 0, C_GK = 256, C_GV = 512, C_GR = 1024, C_NQ = 1536, C_KC = 2048, C_VC = 2176, C_KS = 2304, C_VS = 2432, C_KW = 2560, C_VW = 2688, C_GLR = 2816, C_NG = 2832, C_END = 2856;
constexpr int SGW = 2048;
constexpr int NEXP = 16, EHID = 512;
constexpr int MOE_ROWS = 36864;
constexpr float NORM_EPS = 1e-6f;
constexpr float NEGBIG = -1e30f;

constexpr size_t MiB = 1u << 20;
constexpr size_t WS_CTL = 0, CTL_ZERO_BYTES = 1 * MiB;
constexpr size_t WS_MOD = 1 * MiB;
constexpr size_t WS_ROUTE = 2 * MiB;
constexpr size_t WS_GATES = 3 * MiB;
constexpr size_t WS_STATS = 5 * MiB;
constexpr size_t WS_DEC = 7 * MiB;
constexpr size_t WS_WIN = 8 * MiB;
constexpr size_t WS_WOUT = 14 * MiB;
constexpr size_t WS_WINC = 16 * MiB;
constexpr size_t WS_WOUTC = 24 * MiB;
constexpr size_t WS_WCW1 = 28 * MiB;
constexpr size_t WS_WGU = 30 * MiB;
constexpr size_t WS_WDN = 94 * MiB;
constexpr size_t WS_A = 126 * MiB;
constexpr size_t WS_O = 254 * MiB;
constexpr size_t WS_END = 318 * MiB;
constexpr size_t A_HID_OFF = 72 * MiB;
constexpr size_t DO_QN = 0;
constexpr size_t DO_KSEL = 16 * MiB, DO_VSEL = 20 * MiB, DO_KWIN = 24 * MiB, DO_VWIN = 28 * MiB;
constexpr size_t DO_KC = 32 * MiB, DO_VC = 36 * MiB + 65536;
constexpr size_t DO_KCMP = 41 * MiB, DO_VCMP = 41 * MiB + 512 * 1024;

constexpr int CW_TMO = 0, CW_CODE = 1;
constexpr int CW_BAR = 4096;
constexpr int CW_CNT = 16384;

constexpr int RING_OFF = 0, RING_BYTES = 131072;
constexpr int LDSCTL_OFF = RING_BYTES, MISC_OFF = LDSCTL_OFF + 320;
constexpr int TAB_OFF = LDSCTL_OFF + 1024;
constexpr int LDS_BYTES = 147456;

#define GAS __attribute__((address_space(1)))
#define LAS __attribute__((address_space(3)))
typedef unsigned short bf16;
typedef unsigned v4u __attribute__((ext_vector_type(4)));
typedef unsigned v2u __attribute__((ext_vector_type(2)));
typedef float f32x4 __attribute__((ext_vector_type(4)));
typedef float f32x2 __attribute__((ext_vector_type(2)));
typedef float f32x16 __attribute__((ext_vector_type(16)));
typedef short bf16x8 __attribute__((ext_vector_type(8)));
typedef short s16x4 __attribute__((ext_vector_type(4)));
typedef GAS unsigned gu32;
#define RLX_AGENT __ATOMIC_RELAXED, __HIP_MEMORY_SCOPE_AGENT
#define LDS_WAIT() asm volatile("s_waitcnt lgkmcnt(0)" ::: "memory")
#define VM_WAIT() asm volatile("s_waitcnt vmcnt(0)" ::: "memory")
__device__ __forceinline__ unsigned f2bf(float f) { unsigned u = __builtin_bit_cast(unsigned, f); return (u + 0x7fffu + ((u >> 16) & 1u)) >> 16; }
__device__ __forceinline__ unsigned pk2(float lo, float hi) { return f2bf(lo) | (f2bf(hi) << 16); }
__device__ __forceinline__ float bf2f(unsigned short b) { return __builtin_bit_cast(float, (unsigned)b << 16); }
__device__ __forceinline__ float bflo(unsigned w) { return __builtin_bit_cast(float, w << 16); }
__device__ __forceinline__ float bfhi(unsigned w) { return __builtin_bit_cast(float, w & 0xffff0000u); }
__device__ __forceinline__ float fexp2(float x) { return __builtin_amdgcn_exp2f(x); }
__device__ __forceinline__ float fexp(float x) { return __builtin_amdgcn_exp2f(x * 1.4426950408889634f); }
__device__ __forceinline__ float frcp(float x) { return __builtin_amdgcn_rcpf(x); }
__device__ __forceinline__ float sigmoidf_(float x) { return frcp(1.0f + __expf(-x)); }
__device__ __forceinline__ float siluf_(float x) { return x * frcp(1.0f + __expf(-x)); }
__device__ __forceinline__ float gelu_tanh(float x) {
    const float u = 0.7978845608028654f * (x + 0.044715f * x * x * x);
    return x * frcp(1.0f + __expf(-2.0f * u));
}
__device__ __forceinline__ float dpp_xor1(float v) { return __builtin_bit_cast(float, __builtin_amdgcn_mov_dpp(__builtin_bit_cast(int, v), 0xB1, 0xF, 0xF, true)); }
__device__ __forceinline__ float dpp_xor2(float v) { return __builtin_bit_cast(float, __builtin_amdgcn_mov_dpp(__builtin_bit_cast(int, v), 0x4E, 0xF, 0xF, true)); }
__device__ __forceinline__ float wave_sum(float v) {
#pragma unroll
    for (int o = 1; o < 64; o <<= 1) v += __shfl_xor(v, o);
    return v;
}
__device__ __forceinline__ void unpack8(const v4u w, float (&f)[8]) {
    f[0] = bflo(w.x); f[1] = bfhi(w.x); f[2] = bflo(w.y); f[3] = bfhi(w.y); f[4] = bflo(w.z); f[5] = bfhi(w.z); f[6] = bflo(w.w); f[7] = bfhi(w.w);
}
__device__ __forceinline__ v4u pack8(const float (&f)[8]) { v4u w; w.x = pk2(f[0], f[1]); w.y = pk2(f[2], f[3]); w.z = pk2(f[4], f[5]); w.w = pk2(f[6], f[7]); return w; }

#define XB_TMO      128
#define XB_XCNT(j)  (256  + 64 * (j))
#define XB_XSUB(j)  (1280 + 64 * (j))
#define XB_XGEN(j)  (2304 + 64 * (j))
#define XB_TOP      3328
#define XB_TOPGEN   3392
#define XCD_BAR_WORDS 3456
#define XB_SPIN_CAP (1u << 18)

__device__ __forceinline__ unsigned xb_ld(unsigned* p)              { return __hip_atomic_load(p, __ATOMIC_RELAXED, __HIP_MEMORY_SCOPE_AGENT); }
__device__ __forceinline__ unsigned xb_add(unsigned* p, unsigned v) { return __hip_atomic_fetch_add(p, v, __ATOMIC_RELAXED, __HIP_MEMORY_SCOPE_AGENT); }
__device__ __forceinline__ unsigned xb_xcc_id() { return (unsigned)__builtin_amdgcn_s_getreg((3 << 11) | 20) & 0xFu; }
#define XB_SPIN(cond, bar) do { unsigned _sp = 0; while (cond) { __builtin_amdgcn_s_sleep(1); \
    if ((++_sp & 255u) == 0u) { if (xb_ld(&(bar)[XB_TMO])) break; if (_sp > XB_SPIN_CAP) { atomicAdd(&(bar)[XB_TMO], 1u); break; } } } } while (0)

struct XcdBarrier {
    unsigned* bar; unsigned x;
    volatile LAS unsigned* st;
};
__device__ __forceinline__ XcdBarrier xcd_barrier_post(unsigned* bar, volatile LAS unsigned* st) {
    XcdBarrier b; b.bar = bar; b.x = xb_xcc_id(); b.st = st;
    if (threadIdx.x == 0) (void)xb_add(&bar[XB_XCNT(b.x)], 1u);
    return b;
}
__device__ __forceinline__ void xcd_barrier_complete(unsigned* bar, unsigned x, unsigned& nloc, unsigned& nx) {
    const unsigned G = gridDim.x * gridDim.y * gridDim.z;
    unsigned sum, cnt, mine, sp = 0u;
    for (;;) {
        sum = 0u; cnt = 0u; mine = 0u;
#pragma unroll
        for (unsigned j = 0; j < 16; ++j) { const unsigned c = xb_ld(&bar[XB_XCNT(j)]); sum += c; cnt += (c > 0u) ? 1u : 0u; mine = (j == x) ? c : mine; }
        if (sum == G) break;
        __builtin_amdgcn_s_sleep(1);
        if ((++sp & 255u) == 0u) { if (xb_ld(&bar[XB_TMO])) break; if (sp > XB_SPIN_CAP) { atomicAdd(&bar[XB_TMO], 1u); break; } }
    }
    nloc = mine > 0u ? mine : 1u; nx = cnt > 0u ? cnt : 1u;
}
__device__ __forceinline__ void xcd_barrier(const XcdBarrier& b) {
    asm volatile("s_waitcnt vmcnt(0)" ::: "memory");
    __syncthreads();
    if (threadIdx.x == 0) {
        unsigned* bar = b.bar;
        __builtin_amdgcn_s_waitcnt(0);
        unsigned nloc = b.st[0], nx = b.st[1];
        if (nloc == 0u) { xcd_barrier_complete(bar, b.x, nloc, nx); b.st[0] = nloc; b.st[1] = nx; }
        const unsigned old = xb_add(&bar[XB_XSUB(b.x)], 1u);
        const unsigned gen = old / nloc;
        if (old + 1u == (gen + 1u) * nloc) {
            __builtin_amdgcn_fence(__ATOMIC_RELEASE, "agent");
            asm volatile("s_waitcnt vmcnt(0)" ::: "memory");
            const unsigned og = xb_add(&bar[XB_TOP], 1u);
            const unsigned tg = og / nx;
            if (og + 1u == (tg + 1u) * nx) xb_add(&bar[XB_TOPGEN], 1u);
            else XB_SPIN(xb_ld(&bar[XB_TOPGEN]) == tg, bar);
            __builtin_amdgcn_fence(__ATOMIC_ACQUIRE, "agent");
            xb_add(&bar[XB_XGEN(b.x)], 1u);
            asm volatile("s_waitcnt vmcnt(0)" ::: "memory");
        } else {
            XB_SPIN(xb_ld(&bar[XB_XGEN(b.x)]) == gen, bar);
            __builtin_amdgcn_fence(__ATOMIC_ACQUIRE, "agent");
            asm volatile("s_waitcnt vmcnt(0)" ::: "memory");
        }
    }
    __syncthreads();
}

struct Frame {
    LAS unsigned char* lds;
    volatile LAS unsigned* MISC;
    gu32* ctl;
    int tid, lane, wave;
    int bid, G;
    unsigned char* ws;
    unsigned char* dout_b;
    float* out;
    const float *x, *c, *w_ada, *b_ada, *norm_g, *w_in_ab, *w_out_ab, *gla_w2, *gla_bg, *gla_ng, *q_gain, *k_gain, *cmp_pe, *cmp_w1, *cmp_w2, *w_in_c, *sgu_ng, *sgu_ws, *sgu_bs, *w_out_c, *w_router, *r_bias, *w_gate, *w_up, *w_down;
    const int* positions;
};

struct EpiResid {
    static constexpr bool PERM = false, AFTER_DRAIN = false;
    const float* xin; float* xout; const float* gate;
    __device__ __forceinline__ void operator()(const pg8::f32x4 (&acc)[2][2][4][2], const pg8::Unit& u, int wr, int wc, int fr, int fq) const {
        const int row0 = u.pm * 256 + wr * 64 + fr, col0 = u.pn * 256 + wc * 32 + 4 * fq;
        const float* gb = gate + ((u.pm * 256 >= SEQ) ? 6144 : 0);
        f32x4 gv[2][2];
#pragma unroll
        for (int bj = 0; bj < 2; ++bj)
#pragma unroll
            for (int n = 0; n < 2; ++n) gv[bj][n] = *(const f32x4*)(gb + col0 + bj * 128 + n * 16);
#pragma unroll
        for (int ai = 0; ai < 2; ++ai)
#pragma unroll
            for (int m = 0; m < 4; ++m) {
                const size_t rb = (size_t)(row0 + ai * 128 + m * 16) * DM;
#pragma unroll
                for (int bj = 0; bj < 2; ++bj)
#pragma unroll
                    for (int n = 0; n < 2; ++n) {
                        const size_t p = rb + col0 + bj * 128 + n * 16;
                        const f32x4 xi = *(const f32x4*)(xin + p);
                        *(f32x4*)(xout + p) = xi + gv[bj][n] * acc[ai][bj][m][n];
                    }
            }
    }
};
struct EpiGeluStats {
    static constexpr bool PERM = true, AFTER_DRAIN = false;
    bf16* Z; float* stats;
    __device__ __forceinline__ void operator()(const pg8::f32x4 (&acc)[2][2][4][2], const pg8::Unit& u, int wr, int wc, int fr, int fq) const {
        const int row0 = u.pm * 256 + wr * 64 + fr, col0 = u.pn * 256 + wc * 32 + 8 * fq;
#pragma unroll
        for (int ai = 0; ai < 2; ++ai)
#pragma unroll
            for (int m = 0; m < 4; ++m) {
                const int row = row0 + ai * 128 + m * 16; float ss = 0.f;
#pragma unroll
                for (int bj = 0; bj < 2; ++bj) {
                    float g[8];
#pragma unroll
                    for (int n = 0; n < 2; ++n)
#pragma unroll
                        for (int i = 0; i < 4; ++i) { g[n * 4 + i] = gelu_tanh(acc[ai][bj][m][n][i]); ss += g[n * 4 + i] * g[n * 4 + i]; }
                    *(v4u*)(Z + (size_t)row * 4096 + col0 + bj * 128) = pack8(g);
                }
                if (u.pn >= 8) {
                    ss += __shfl_xor(ss, 16); ss += __shfl_xor(ss, 32);
                    if (fq == 0) stats[(size_t)row * 32 + (u.pn - 8) * 4 + wc] = ss;
                }
            }
    }
};
struct EpiMoeGU {
    static constexpr bool PERM = true, AFTER_DRAIN = false;
    bf16* HID;
    __device__ __forceinline__ void operator()(const pg8::f32x4 (&acc)[2][2][4][2], const pg8::Unit& u, int wr, int wc, int fr, int fq) const {
        const int row0 = u.pm * 256 + wr * 64 + fr, col0 = (u.pn & 3) * 128 + wc * 32 + 8 * fq;
#pragma unroll
        for (int ai = 0; ai < 2; ++ai)
#pragma unroll
            for (int m = 0; m < 4; ++m) {
                float h[8];
#pragma unroll
                for (int n = 0; n < 2; ++n)
#pragma unroll
                    for (int i = 0; i < 4; ++i) h[n * 4 + i] = siluf_(acc[ai][0][m][n][i]) * acc[ai][1][m][n][i];
                *(v4u*)(HID + (size_t)(row0 + ai * 128 + m * 16) * EHID + col0) = pack8(h);
            }
    }
};
struct EpiMoeDn {
    static constexpr bool PERM = true, AFTER_DRAIN = false;
    bf16* YM;
    __device__ __forceinline__ void operator()(const pg8::f32x4 (&acc)[2][2][4][2], const pg8::Unit& u, int wr, int wc, int fr, int fq) const {
        const int row0 = u.pm * 256 + wr * 64 + fr, col0 = (u.pn & 3) * 256 + wc * 32 + 8 * fq;
#pragma unroll
        for (int ai = 0; ai < 2; ++ai)
#pragma unroll
            for (int m = 0; m < 4; ++m)
#pragma unroll
                for (int bj = 0; bj < 2; ++bj) {
                    float h[8];
#pragma unroll
                    for (int n = 0; n < 2; ++n)
#pragma unroll
                        for (int i = 0; i < 4; ++i) h[n * 4 + i] = acc[ai][bj][m][n][i];
                    *(v4u*)(YM + (size_t)(row0 + ai * 128 + m * 16) * DM + col0 + bj * 128) = pack8(h);
                }
    }
};
struct MoeOrder {
    const LAS int* ppre; int G, c;
    __device__ __forceinline__ unsigned row_off(const pg8::Unit& u, int r, const int* elist) const {
        const int e = u.pn >> 2, li = (u.pm - ppre[e]) * 256 + r;
        const int tok = (li < ppre[32 + e]) ? elist[e * 16384 + li] : 0;
        return (unsigned)tok * 2048u;
    }
    __device__ __forceinline__ bool next(int i, pg8::Unit& u) const {
        const int L = i * G + c, np = ppre[16];
        if (L >= np * 4) return false;
        const int pm = L >> 2; int e = 0;
#pragma unroll
        for (int k = 1; k < 16; ++k) e += (ppre[k] <= pm) ? 1 : 0;
        u.pm = pm; u.pn = e * 4 + (L & 3); return true;
    }
    __device__ __forceinline__ void a_ready(const pg8::Unit&) const {}
    __device__ __forceinline__ void done(const pg8::Unit&) const {}
};

__device__ __forceinline__ int dest_row(int mode, int n) {
    if (mode == 1) return (n < 1024) ? n : (n < 1040) ? n + 1792 : (n < 2832) ? n - 16 : n;
    if (mode == 2) return (n >> 7) * 256 + (n & 127);
    if (mode == 3) return (n >> 7) * 256 + 128 + (n & 127);
    return n;
}
struct TrItem { const float* src; bf16* dst; int K, N, mode, r; };
__device__ __forceinline__ int tr_count(int set) { return set == 0 ? (720 + 256 + 256 + 3 * 2048) : set == 1 ? (1024 + 512 + 2048 + 1024) : (1024 + 2048); }
__device__ __forceinline__ bool tr_decode(Frame& F, int set, int it, TrItem& t) {
    if (it >= tr_count(set)) return false;
    int r = it; t.mode = 0;
    if (set == 0) {
        constexpr int I_IN = 16 * 45, I_OUT = 16 * 16, I_CW1 = 2 * 32 * 4, I_E = 16 * 128;
        if (r < I_IN) { t.src = F.w_in_ab; t.dst = (bf16*)(F.ws + WS_WIN); t.K = 1024; t.N = 2856; t.mode = 1; }
        else if ((r -= I_IN) < I_OUT) { t.src = F.w_out_ab; t.dst = (bf16*)(F.ws + WS_WOUT); t.K = 1024; t.N = 1024; }
        else if ((r -= I_OUT) < I_CW1) { const int m = r >> 7; r &= 127; t.src = F.cmp_w1 + (size_t)m * 2048 * 256; t.dst = (bf16*)(F.ws + WS_WCW1) + (size_t)m * 256 * 2048; t.K = 2048; t.N = 256; }
        else if ((r -= I_CW1) < I_E) { const int m = r >> 7; r &= 127; t.src = F.w_gate + (size_t)m * 1024 * 512; t.dst = (bf16*)(F.ws + WS_WGU) + (size_t)m * 1024 * 1024; t.K = 1024; t.N = 512; t.mode = 2; }
        else if ((r -= I_E) < I_E) { const int m = r >> 7; r &= 127; t.src = F.w_up + (size_t)m * 1024 * 512; t.dst = (bf16*)(F.ws + WS_WGU) + (size_t)m * 1024 * 1024; t.K = 1024; t.N = 512; t.mode = 3; }
        else { r -= I_E; const int m = r >> 7; r &= 127; t.src = F.w_down + (size_t)m * 512 * 1024; t.dst = (bf16*)(F.ws + WS_WDN) + (size_t)m * 1024 * 512; t.K = 512; t.N = 1024; }
    } else if (set == 1) {
        constexpr int I_INC = 16 * 64, I_OUTC = 32 * 16;
        if (r < I_INC) { t.src = F.w_in_c; t.dst = (bf16*)(F.ws + WS_WINC); t.K = 1024; t.N = 4096; }
        else if ((r -= I_INC) < I_OUTC) { t.src = F.w_out_c; t.dst = (bf16*)(F.ws + WS_WOUTC); t.K = 2048; t.N = 1024; }
        else if ((r -= I_OUTC) < 2048) { const int m = 16 + (r >> 7); r &= 127; t.src = F.w_gate + (size_t)m * 1024 * 512; t.dst = (bf16*)(F.ws + WS_WGU) + (size_t)m * 1024 * 1024; t.K = 1024; t.N = 512; t.mode = 2; }
        else { r -= 2048; const int m = 16 + (r >> 7); r &= 127; t.src = F.w_up + (size_t)m * 1024 * 512; t.dst = (bf16*)(F.ws + WS_WGU) + (size_t)m * 1024 * 1024; t.K = 1024; t.N = 512; t.mode = 3; }
    } else {
        constexpr int I_E = 8 * 128;
        if (r < I_E) { const int m = 24 + (r >> 7); r &= 127; t.src = F.w_up + (size_t)m * 1024 * 512; t.dst = (bf16*)(F.ws + WS_WGU) + (size_t)m * 1024 * 1024; t.K = 1024; t.N = 512; t.mode = 3; }
        else { r -= I_E; const int m = 16 + (r >> 7); r &= 127; t.src = F.w_down + (size_t)m * 512 * 1024; t.dst = (bf16*)(F.ws + WS_WDN) + (size_t)m * 1024 * 512; t.K = 512; t.N = 1024; }
    }
    t.r = r; return true;
}
__device__ __forceinline__ void tr_load(const TrItem& t, int lane, f32x4 (&va)[8], f32x4 (&vb)[8]) {
    const int nblk = (t.N + 63) / 64, kb = t.r / nblk, nb = t.r % nblk, k0 = 64 * kb, n0 = 64 * nb;
    const int q = lane & 15, r4 = lane >> 4, col = n0 + 4 * q;
    const float* wp = t.src + (size_t)(k0 + 2 * r4) * t.N + col;
#pragma unroll
    for (int i = 0; i < 8; ++i) {
        if (col < t.N) { va[i] = *(const f32x4*)(wp + (size_t)(8 * i) * t.N); vb[i] = *(const f32x4*)(wp + (size_t)(8 * i + 1) * t.N); }
        else { va[i] = (f32x4){0.f, 0.f, 0.f, 0.f}; vb[i] = va[i]; }
    }
}
__device__ __forceinline__ void tr_finish(const TrItem& t, int lane, const f32x4 (&va)[8], const f32x4 (&vb)[8], LAS unsigned char* scr) {
    const int nblk = (t.N + 63) / 64, kb = t.r / nblk, nb = t.r % nblk, k0 = 64 * kb, n0 = 64 * nb;
    const int q = lane & 15, r4 = lane >> 4;
#pragma unroll
    for (int i = 0; i < 8; ++i) {
        const int kp = 4 * i + r4;
        LAS unsigned* tt = (LAS unsigned*)(scr + (4 * q) * 144 + 4 * kp);
        tt[0] = pk2(va[i].x, vb[i].x); tt[36] = pk2(va[i].y, vb[i].y); tt[72] = pk2(va[i].z, vb[i].z); tt[108] = pk2(va[i].w, vb[i].w);
    }
    LDS_WAIT(); asm volatile("" ::: "memory");
    const int c = lane & 7;
#pragma unroll
    for (int j = 0; j < 8; ++j) { const int n = (lane >> 3) + 8 * j;
        const v4u o = *(const LAS v4u*)(scr + n * 144 + 16 * c);
        if (n0 + n < t.N) *(GAS v4u*)(t.dst + (size_t)dest_row(t.mode, n0 + n) * t.K + k0 + 8 * c) = o; }
    LDS_WAIT(); asm volatile("" ::: "memory");
}
__device__ __forceinline__ void tr_run(Frame& F, int set, int w0, int nw) {
    LAS unsigned char* scr = F.lds + RING_OFF + 8192 + F.wave * 12288;
    TrItem ta, tb; f32x4 a0[8], a1[8], b0[8], b1[8];
    int it = w0; bool ha = tr_decode(F, set, it, ta);
    if (ha) tr_load(ta, F.lane, a0, a1);
    while (ha) {
        const bool hb = tr_decode(F, set, it + nw, tb);
        if (hb) tr_load(tb, F.lane, b0, b1);
        tr_finish(ta, F.lane, a0, a1, scr);
        if (!hb) break;
        it += 2 * nw; ha = tr_decode(F, set, it, ta);
        if (ha) tr_load(ta, F.lane, a0, a1);
        tr_finish(tb, F.lane, b0, b1, scr);
    }
}
__device__ __forceinline__ void p0_prologue(Frame& F) {
    LAS float* red = (LAS float*)(F.lds + RING_OFF);
    float* mod = (float*)(F.ws + WS_MOD);
    float* bias1 = (float*)(F.ws + WS_MOD + 131072);
    for (int bi = F.bid; bi < 200; bi += F.G) {
        if (bi < 192) {
            const int l = bi / 96, cg = bi % 96, j = cg * 64 + F.lane;
            float a0 = 0.f, a1 = 0.f;
            const float* wp = F.w_ada + ((size_t)l * 1024 + F.wave * 128) * 6144 + j;
#pragma unroll 16
            for (int k = 0; k < 128; ++k) { const float wv = wp[(size_t)k * 6144]; const float c0 = F.c[F.wave * 128 + k], c1 = F.c[1024 + F.wave * 128 + k];
                a0 += siluf_(c0) * wv; a1 += siluf_(c1) * wv; }
            red[(F.wave * 2 + 0) * 64 + F.lane] = a0; red[(F.wave * 2 + 1) * 64 + F.lane] = a1;
            __syncthreads();
            if (F.tid < 128) { const int b = F.tid >> 6, ln = F.tid & 63; float s = 0.f;
#pragma unroll
                for (int w = 0; w < 8; ++w) s += red[(w * 2 + b) * 64 + ln];
                mod[(size_t)(l * 2 + b) * 6144 + cg * 64 + ln] = s + F.b_ada[l * 6144 + cg * 64 + ln]; }
            __syncthreads();
        } else {
            const int kv = (bi - 192) >> 2, cg = (bi - 192) & 3, j = cg * 64 + F.lane;
            float a0 = 0.f;
            const float* wp = F.cmp_w1 + ((size_t)kv * 2048 + F.wave * 256) * 256 + j; const float* pe = F.cmp_pe + kv * 2048 + F.wave * 256;
#pragma unroll 16
            for (int k = 0; k < 256; ++k) a0 += pe[k] * wp[(size_t)k * 256];
            red[F.wave * 64 + F.lane] = a0;
            __syncthreads();
            if (F.tid < 64) { float s = 0.f;
#pragma unroll
                for (int w = 0; w < 8; ++w) s += red[w * 64 + F.tid];
                bias1[kv * 256 + cg * 64 + F.tid] = s; }
            __syncthreads();
        }
    }
    { bf16* wi = (bf16*)(F.ws + WS_WIN); const int npieces = (NPROJ - C_END) * (DM / 8);
      for (int p = F.bid * 512 + F.tid; p < npieces; p += F.G * 512) *(GAS v4u*)(wi + (size_t)C_END * DM + (size_t)p * 8) = (v4u){0u, 0u, 0u, 0u}; }
    const int gw = F.bid * 8 + F.wave, NGW = F.G * 8;
    tr_run(F, 0, gw, NGW);
}

__device__ __forceinline__ void moe_tables(Frame& F, int layer) {
    LAS int* ppre = (LAS int*)(F.lds + TAB_OFF);
    if (F.tid == 0) { const unsigned* cnt = (const unsigned*)(F.ctl + CW_CNT + 1024 * layer); int acc = 0;
        for (int e = 0; e < 16; ++e) { const int c = (int)cnt[64 * e]; ppre[e] = acc; ppre[32 + e] = c; acc += (c + 255) >> 8; }
        ppre[16] = acc; }
    __syncthreads();
}

struct RouteRec { int e0, e1, pos0, pos1; float w0, w1; int slot0, slot1; };
template <bool COMBINE, bool NORM, bool ROUTE>
__device__ __forceinline__ void row_pass(Frame& F, const float* xin, const float* modn  , int sh_off, const float* ng,
                                         const float* modc  , int layer, int clayer  ) {
    if (COMBINE) moe_tables(F, clayer);
    float* xout = F.out; bf16* H = (bf16*)(F.ws + WS_O);
    const bf16* YM = (const bf16*)(F.ws + WS_A);
    RouteRec* route = (RouteRec*)(F.ws + WS_ROUTE);
    int* elist = (int*)(F.ws + WS_STATS);
    const LAS int* ppre = (const LAS int*)(F.lds + TAB_OFF);
    LAS float* wr = (LAS float*)(F.lds + RING_OFF);
    LAS unsigned* lcnt = (LAS unsigned*)(F.lds + TAB_OFF + 256);
    if (ROUTE) {
        for (int idx = F.tid; idx < 16384; idx += 512) wr[(idx & 15) * 1024 + (idx >> 4)] = F.w_router[idx];
        if (F.tid < 32) lcnt[F.tid] = 0u;
        __syncthreads();
    }
    const int gw = F.bid * 8 + F.wave, NGW = F.G * 8;
    f32x4 cs[4], sh[4], gc[4];
    f32x4 vn[4]; v2u yn0[4], yn1[4]; RouteRec rn; rn.w0 = 0.f; rn.w1 = 0.f;
    int m = gw, bcur = -1;
#define RP_PREFETCH(mm) do { \
        _Pragma("unroll") for (int j = 0; j < 4; ++j) vn[j] = *(const f32x4*)(xin + (size_t)(mm) * DM + 4 * F.lane + 256 * j); \
        if (COMBINE) { rn = route[(mm)]; const int sl0_ = ppre[rn.e0] * 256 + rn.pos0, sl1_ = ppre[rn.e1] * 256 + rn.pos1; \
            _Pragma("unroll") for (int j = 0; j < 4; ++j) { yn0[j] = *(const v2u*)(YM + (size_t)sl0_ * DM + 4 * F.lane + 256 * j); yn1[j] = *(const v2u*)(YM + (size_t)sl1_ * DM + 4 * F.lane + 256 * j); } } } while (0)
    if (m < NTOK) RP_PREFETCH(m);
#pragma unroll 1
    while (m < NTOK) {
        f32x4 v[4]; v2u y0[4], y1[4];
#pragma unroll
        for (int j = 0; j < 4; ++j) { v[j] = vn[j]; if (COMBINE) { y0[j] = yn0[j]; y1[j] = yn1[j]; } }
        const float rw0 = rn.w0, rw1 = rn.w1;
        const int mc = m; m += NGW;
        if (m < NTOK) RP_PREFETCH(m);
        const int b = mc >> 13;
        if (b != bcur) { bcur = b;
#pragma unroll
            for (int j = 0; j < 4; ++j) {
                const int col = 4 * F.lane + 256 * j;
                if (NORM) { const f32x4 g = *(const f32x4*)(ng + col), sc = *(const f32x4*)(modn + b * 6144 + sh_off + 1024 + col); cs[j] = g * (sc + 1.0f); sh[j] = *(const f32x4*)(modn + b * 6144 + sh_off + col); }
                if (COMBINE) gc[j] = *(const f32x4*)(modc + b * 6144 + 5 * 1024 + col);
            } }
        {
            if (COMBINE) {
#pragma unroll
                for (int j = 0; j < 4; ++j) {
                    f32x4 yy; yy.x = rw0 * bflo(y0[j].x) + rw1 * bflo(y1[j].x); yy.y = rw0 * bfhi(y0[j].x) + rw1 * bfhi(y1[j].x); yy.z = rw0 * bflo(y0[j].y) + rw1 * bflo(y1[j].y); yy.w = rw0 * bfhi(y0[j].y) + rw1 * bfhi(y1[j].y);
                    v[j] = v[j] + gc[j] * yy;
                    *(f32x4*)(xout + (size_t)mc * DM + 4 * F.lane + 256 * j) = v[j];
                }
            }
            if (NORM) {
                float s = 0.f;
#pragma unroll
                for (int j = 0; j < 4; ++j) s += (v[j].x * v[j].x + v[j].y * v[j].y) + (v[j].z * v[j].z + v[j].w * v[j].w);
                const float rstd = 1.0f / sqrtf(wave_sum(s) * (1.0f / DM) + NORM_EPS);
#pragma unroll
                for (int j = 0; j < 4; ++j) { v[j] = v[j] * rstd * cs[j] + sh[j];
                    v2u o; o.x = pk2(v[j].x, v[j].y); o.y = pk2(v[j].z, v[j].w);
                    *(v2u*)(H + (size_t)mc * DM + 4 * F.lane + 256 * j) = o; }
            }
            if (ROUTE) {
                float a16[16];
#pragma unroll
                for (int eg = 0; eg < 4; ++eg) {
                    float a4[4] = {0.f, 0.f, 0.f, 0.f};
#pragma unroll
                    for (int j = 0; j < 4; ++j)
#pragma unroll
                        for (int ee = 0; ee < 4; ++ee) { const f32x4 w = *(const LAS f32x4*)(wr + (eg * 4 + ee) * 1024 + 4 * F.lane + 256 * j); a4[ee] += (v[j].x * w.x + v[j].y * w.y) + (v[j].z * w.z + v[j].w * w.w); }
#pragma unroll
                    for (int ee = 0; ee < 4; ++ee) a16[eg * 4 + ee] = a4[ee];
                    __builtin_amdgcn_sched_barrier(0);
                }
                float r8[8], r4[4], r2[2];
                { const bool hb = (F.lane & 32) != 0;
#pragma unroll
                  for (int i = 0; i < 8; ++i) { const float keep = hb ? a16[8 + i] : a16[i], send = hb ? a16[i] : a16[8 + i]; r8[i] = keep + __shfl_xor(send, 32); } }
                { const bool hb = (F.lane & 16) != 0;
#pragma unroll
                  for (int i = 0; i < 4; ++i) { const float keep = hb ? r8[4 + i] : r8[i], send = hb ? r8[i] : r8[4 + i]; r4[i] = keep + __shfl_xor(send, 16); } }
                { const bool hb = (F.lane & 8) != 0;
#pragma unroll
                  for (int i = 0; i < 2; ++i) { const float keep = hb ? r4[2 + i] : r4[i], send = hb ? r4[i] : r4[2 + i]; r2[i] = keep + __shfl_xor(send, 8); } }
                float lgo; { const bool hb = (F.lane & 4) != 0; const float keep = hb ? r2[1] : r2[0], send = hb ? r2[0] : r2[1]; lgo = keep + __shfl_xor(send, 4); }
                lgo += __shfl_xor(lgo, 1); lgo += __shfl_xor(lgo, 2);
                const int eown = ((F.lane >> 5) & 1) * 8 + ((F.lane >> 4) & 1) * 4 + ((F.lane >> 3) & 1) * 2 + ((F.lane >> 2) & 1);
                const float sco = frcp(1.0f + __expf(-lgo)), slo = sco + F.r_bias[eown];
                float sc[16], sl[16];
#pragma unroll
                for (int e = 0; e < 16; ++e) { const int src = (e >> 3) * 32 + ((e >> 2) & 1) * 16 + ((e >> 1) & 1) * 8 + (e & 1) * 4;
                    sc[e] = __builtin_bit_cast(float, __builtin_amdgcn_readlane(__builtin_bit_cast(int, sco), src)); sl[e] = __builtin_bit_cast(float, __builtin_amdgcn_readlane(__builtin_bit_cast(int, slo), src)); }
                float gs[4]; int ge1[4], ge2[4]; float gw1[4], gw2[4];
#pragma unroll
                for (int g = 0; g < 4; ++g) {
                    int i1 = 0; float m1 = sl[4 * g];
#pragma unroll
                    for (int k = 1; k < 4; ++k) if (sl[4 * g + k] > m1) { m1 = sl[4 * g + k]; i1 = k; }
                    int i2 = -1; float m2 = 0.f;
#pragma unroll
                    for (int k = 0; k < 4; ++k) if (k != i1 && (i2 < 0 || sl[4 * g + k] > m2)) { m2 = sl[4 * g + k]; i2 = k; }
                    gs[g] = m1 + m2; ge1[g] = 4 * g + i1; ge2[g] = 4 * g + i2;
                    float w1 = 0.f, w2 = 0.f;
#pragma unroll
                    for (int k = 0; k < 4; ++k) { w1 = (k == i1) ? sc[4 * g + k] : w1; w2 = (k == i2) ? sc[4 * g + k] : w2; }
                    gw1[g] = w1; gw2[g] = w2;
                }
                int gi = 0; float gm = gs[0];
#pragma unroll
                for (int g = 1; g < 4; ++g) if (gs[g] > gm) { gm = gs[g]; gi = g; }
                int e1 = ge1[0], e2 = ge2[0]; float w1 = gw1[0], w2 = gw2[0];
#pragma unroll
                for (int g = 1; g < 4; ++g) if (gi == g) { e1 = ge1[g]; e2 = ge2[g]; w1 = gw1[g]; w2 = gw2[g]; }
                const float ws_ = w1 + w2;
                if (F.lane == 0) {
                    RouteRec rr; rr.e0 = e1; rr.e1 = e2;
                    rr.pos0 = (int)__hip_atomic_fetch_add(lcnt + e1, 1u, __ATOMIC_RELAXED, __HIP_MEMORY_SCOPE_WORKGROUP);
                    rr.pos1 = (int)__hip_atomic_fetch_add(lcnt + e2, 1u, __ATOMIC_RELAXED, __HIP_MEMORY_SCOPE_WORKGROUP);
                    rr.w0 = w1 / ws_; rr.w1 = w2 / ws_; rr.slot0 = 0; rr.slot1 = 0;
                    route[mc] = rr;
                }
            }
        }
    }
#undef RP_PREFETCH
    if (ROUTE) {
        __syncthreads();
        if (F.tid < 16) { unsigned* cnt = (unsigned*)(F.ctl + CW_CNT + 1024 * layer + 64 * F.tid); lcnt[16 + F.tid] = atomicAdd(cnt, lcnt[F.tid]); }
        __syncthreads();
        if (F.lane == 0) {
#pragma unroll 1
            for (int m = gw; m < NTOK; m += NGW) { RouteRec rr = route[m]; rr.pos0 += (int)lcnt[16 + rr.e0]; rr.pos1 += (int)lcnt[16 + rr.e1]; route[m] = rr;
                elist[rr.e0 * 16384 + rr.pos0] = m; elist[rr.e1 * 16384 + rr.pos1] = m; }
        }
    }
}


__device__ __forceinline__ f32x4 mma16(const LAS bf16* A, int lda, const LAS bf16* Bt, int ldb, int K, f32x4 acc, int lane) {
    const LAS bf16* ap = A + (lane & 15) * lda + (lane >> 4) * 8;
    const LAS bf16* bp = Bt + (lane & 15) * ldb + (lane >> 4) * 8;
    for (int k = 0; k < K; k += 32) {
        const bf16x8 a = *(const LAS bf16x8*)(ap + k), b = *(const LAS bf16x8*)(bp + k);
        acc = __builtin_amdgcn_mfma_f32_16x16x32_bf16(a, b, acc, 0, 0, 0);
    }
    return acc;
}

__device__ __forceinline__ float wave_incl_scan(float v) {
#define DPP_ADD(ctrl, rmask) v += __builtin_bit_cast(float, __builtin_amdgcn_update_dpp(0, __builtin_bit_cast(int, v), (ctrl), (rmask), 0xF, false))
    DPP_ADD(0x111, 0xF);
    DPP_ADD(0x112, 0xF);
    DPP_ADD(0x114, 0xF);
    DPP_ADD(0x118, 0xF);
    DPP_ADD(0x142, 0xA);
    DPP_ADD(0x143, 0xC);
#undef DPP_ADD
    return v;
}
__device__ __forceinline__ void gla_bcum(Frame& F, const bf16* prow  , int h, float (&bc)[8]) {
    float gl[16];
    { const v4u a = *(const v4u*)(prow + C_GLR), b = *(const v4u*)(prow + C_GLR + 8); float t0[8], t1[8]; unpack8(a, t0); unpack8(b, t1);
#pragma unroll
      for (int i = 0; i < 8; ++i) { gl[i] = t0[i]; gl[8 + i] = t1[i]; } }
#pragma unroll
    for (int i = 0; i < 8; ++i) {
        const int col = h * 64 + F.wave * 8 + i;
        float z = F.gla_bg[col];
#pragma unroll
        for (int r = 0; r < 16; ++r) z += gl[r] * F.gla_w2[r * 256 + col];
        const float ls = fminf(z, 0.f) - __logf(1.0f + __expf(-fabsf(z)));
        bc[i] = wave_incl_scan(ls * (1.0f / 16.0f));
    }
}
__device__ __forceinline__ void gla_stage_vT(Frame& F, const bf16* prow, int h, LAS bf16* VT) {
    const v4u a = *(const v4u*)(prow + C_GV + h * 128 + F.wave * 16), b = *(const v4u*)(prow + C_GV + h * 128 + F.wave * 16 + 8);
    const unsigned w[8] = {a.x, a.y, a.z, a.w, b.x, b.y, b.z, b.w};
#pragma unroll
    for (int i = 0; i < 8; ++i) { VT[(F.wave * 16 + 2 * i) * 72 + F.lane] = (bf16)(w[i] & 0xffffu); VT[(F.wave * 16 + 2 * i + 1) * 72 + F.lane] = (bf16)(w[i] >> 16); }
}
__device__ __forceinline__ void gla_prep_item(Frame& F, int item) {
    const int h = item & 3, n = (item >> 2) & 127, b = item >> 9;
    const bf16* proj = (const bf16*)(F.ws + WS_A);
    const bf16* prow = proj + (size_t)(b * SEQ + n * 64 + F.lane) * NPROJ;
    LAS bf16* KT = (LAS bf16*)(F.lds + RING_OFF);
    LAS bf16* VT = (LAS bf16*)(F.lds + RING_OFF + 9216);
    float bc[8]; gla_bcum(F, prow, h, bc);
    float kf[8]; { const v4u kk = *(const v4u*)(prow + C_GK + h * 64 + F.wave * 8); unpack8(kk, kf); }
    float* DEC = (float*)(F.ws + WS_DEC) + ((size_t)(b * 128 + n) * 4 + h) * 64;
#pragma unroll
    for (int i = 0; i < 8; ++i) {
        const float bl = __shfl(bc[i], 63);
        KT[(F.wave * 8 + i) * 72 + F.lane] = (bf16)f2bf(kf[i] * __expf(bl - bc[i]));
        if (F.lane == 63) DEC[F.wave * 8 + i] = __expf(bl);
    }
    gla_stage_vT(F, prow, h, VT);
    __syncthreads();
    float* KV = (float*)(F.ws + WS_O) + ((size_t)(b * 128 + n) * 4 + h) * 8192;
    const int dt = F.wave >> 1;
#pragma unroll
    for (int j = 0; j < 4; ++j) {
        const int et = (F.wave & 1) * 4 + j;
        f32x4 acc = {0.f, 0.f, 0.f, 0.f};
        acc = mma16(KT + dt * 16 * 72, 72, VT + et * 16 * 72, 72, 64, acc, F.lane);
#pragma unroll
        for (int i = 0; i < 4; ++i) KV[(dt * 16 + 4 * (F.lane >> 4) + i) * 128 + et * 16 + (F.lane & 15)] = acc[i];
    }
    __syncthreads();
}
__device__ __forceinline__ void gla_scan(Frame& F, int gidx) {
    const int bh = gidx >> 13, de = gidx & 8191, b = bh >> 2, h = bh & 3;
    float* KV = (float*)(F.ws + WS_O) + ((size_t)(b * 128) * 4 + h) * 8192 + de;
    const float* DEC = (const float*)(F.ws + WS_DEC) + ((size_t)(b * 128) * 4 + h) * 64 + (de >> 7);
    float st = 0.f;
#pragma unroll 1
    for (int n0 = 0; n0 < 128; n0 += 16) {
        float kv[16], dc[16];
#pragma unroll
        for (int i = 0; i < 16; ++i) { kv[i] = KV[(size_t)(n0 + i) * 4 * 8192]; dc[i] = DEC[(size_t)(n0 + i) * 4 * 64]; }
#pragma unroll
        for (int i = 0; i < 16; ++i) { KV[(size_t)(n0 + i) * 4 * 8192] = st; st = dc[i] * st + kv[i]; }
    }
}
__device__ __forceinline__ void gla_out_item(Frame& F, int item) {
    const int h = item & 3, n = (item >> 2) & 127, b = item >> 9;
    const bf16* proj = (const bf16*)(F.ws + WS_A);
    const size_t tok = (size_t)b * SEQ + n * 64 + F.lane;
    const bf16* prow = proj + tok * NPROJ;
    LAS bf16* A1 = (LAS bf16*)(F.lds + RING_OFF);
    LAS bf16* B1 = (LAS bf16*)(F.lds + RING_OFF + 9216);
    LAS bf16* A2 = (LAS bf16*)(F.lds + RING_OFF + 18432);
    LAS bf16* SC = (LAS bf16*)(F.lds + RING_OFF + 27648);
    LAS bf16* VT = (LAS bf16*)(F.lds + RING_OFF + 36864);
    LAS bf16* ST = (LAS bf16*)(F.lds + RING_OFF + 55296);
    LAS float* OS = (LAS float*)(F.lds + RING_OFF + 73728);
    const size_t tkn = (size_t)b * SEQ + n * 64 + (F.tid >> 3);
    const v4u rraw0 = *(const v4u*)(proj + tkn * NPROJ + C_GR + h * 128 + (F.tid & 7) * 16), rraw1 = *(const v4u*)(proj + tkn * NPROJ + C_GR + h * 128 + (F.tid & 7) * 16 + 8);
    float bc[8]; gla_bcum(F, prow, h, bc);
    float qf[8], kf[8];
    { const v4u qq = *(const v4u*)(prow + C_GQ + h * 64 + F.wave * 8), kk = *(const v4u*)(prow + C_GK + h * 64 + F.wave * 8); unpack8(qq, qf); unpack8(kk, kf); }
    float a1[8], b1[8], a2[8];
#pragma unroll
    for (int i = 0; i < 8; ++i) {
        const float bm = __shfl(bc[i], 32);
        a1[i] = qf[i] * 0.125f * __expf(bc[i] - bm); b1[i] = kf[i] * __expf(bm - bc[i]); a2[i] = qf[i] * 0.125f * __expf(bc[i]);
    }
    *(LAS v4u*)(A1 + F.lane * 72 + F.wave * 8) = pack8(a1);
    *(LAS v4u*)(B1 + F.lane * 72 + F.wave * 8) = pack8(b1);
    *(LAS v4u*)(A2 + F.lane * 72 + F.wave * 8) = pack8(a2);
    gla_stage_vT(F, prow, h, VT);
    { const float* KV = (const float*)(F.ws + WS_O) + ((size_t)(b * 128 + n) * 4 + h) * 8192;
#pragma unroll
      for (int k = 0; k < 16; ++k) { const int p = F.tid + 512 * k, e = p & 127, d = p >> 7; ST[e * 72 + d] = (bf16)f2bf(KV[d * 128 + e]); } }
    __syncthreads();
    const int it = F.wave >> 1;
#pragma unroll
    for (int jj = 0; jj < 2; ++jj) {
        const int jt = (F.wave & 1) * 2 + jj;
        f32x4 acc = {0.f, 0.f, 0.f, 0.f};
        if (jt <= it) acc = mma16(A1 + it * 16 * 72, 72, B1 + jt * 16 * 72, 72, 64, acc, F.lane);
#pragma unroll
        for (int i = 0; i < 4; ++i) { const int ri = it * 16 + 4 * (F.lane >> 4) + i, cj = jt * 16 + (F.lane & 15); SC[ri * 72 + cj] = (bf16)f2bf((cj <= ri) ? acc[i] : 0.f); }
    }
    __syncthreads();
#pragma unroll
    for (int j = 0; j < 4; ++j) {
        const int et = (F.wave & 1) * 4 + j;
        f32x4 acc = {0.f, 0.f, 0.f, 0.f};
        acc = mma16(SC + it * 16 * 72, 72, VT + et * 16 * 72, 72, 64, acc, F.lane);
        acc = mma16(A2 + it * 16 * 72, 72, ST + et * 16 * 72, 72, 64, acc, F.lane);
#pragma unroll
        for (int i = 0; i < 4; ++i) OS[(it * 16 + 4 * (F.lane >> 4) + i) * 132 + et * 16 + (F.lane & 15)] = acc[i];
    }
    __syncthreads();
    { const int row = F.tid >> 3, c0 = (F.tid & 7) * 16;
      float v[16]; float ss = 0.f;
#pragma unroll
      for (int i = 0; i < 16; ++i) { v[i] = OS[row * 132 + c0 + i]; ss += v[i] * v[i]; }
      ss += dpp_xor1(ss); ss += dpp_xor2(ss); ss += __shfl_xor(ss, 4);
      const float rstd = 1.0f / sqrtf(ss * (1.0f / 128.0f) + NORM_EPS);
      const size_t tk = (size_t)b * SEQ + n * 64 + row;
      float r0[8], r1[8]; unpack8(rraw0, r0); unpack8(rraw1, r1);
      float o0[8], o1[8];
#pragma unroll
      for (int i = 0; i < 8; ++i) { o0[i] = v[i] * rstd * F.gla_ng[c0 + i] * siluf_(r0[i]); o1[i] = v[8 + i] * rstd * F.gla_ng[c0 + 8 + i] * siluf_(r1[i]); }
      bf16* orow = (bf16*)(F.ws + WS_O + 32 * MiB) + tk * DM + h * 128 + c0;
      *(v4u*)orow = pack8(o0); *(v4u*)(orow + 8) = pack8(o1); }
    __syncthreads();
}

__device__ __forceinline__ double inv_freq_d(int i) {
    return (i == 0) ? 1.0 : (i == 1) ? 0.19392547740471268 : (i == 2) ? 0.037606090787015346 : (i == 3) ? 0.0072927791106285765 :
           (i == 4) ? 0.0014142135623730951 : (i == 5) ? 0.00027425197177757796 : (i == 6) ? 5.318404375373266e-05 : 1.0313741203148838e-05;
}
__device__ __forceinline__ void rope_sincos(int pos, int i, float& cs, float& sn) {
    const double rev = (double)pos * inv_freq_d(i) * 0.15915494309189535;
    const float fr = (float)(rev - rint(rev));
    cs = __builtin_amdgcn_cosf(fr); sn = __builtin_amdgcn_sinf(fr);
}
struct PrepRaw { v4u r0, r1, r2; unsigned ng; int pos; };
__device__ __forceinline__ void nsa_prep_load(Frame& F, int tok, PrepRaw& p) {
    const int sub = F.lane & 7, vid = F.lane >> 3;
    const bf16* prow = (const bf16*)(F.ws + WS_A) + (size_t)tok * NPROJ;
    const int g1 = vid & 1, w1 = vid >> 1, w2 = (vid >> 1) & 1;
    const int col1 = ((w1 == 0) ? C_KS : (w1 == 1) ? C_KW : (w1 == 2) ? C_VS : C_VW) + g1 * 64, col2 = (w2 ? C_VC : C_KC) + g1 * 64;
    p.r0 = *(const v4u*)(prow + C_NQ + vid * 64 + sub * 8); p.r1 = *(const v4u*)(prow + col1 + sub * 8); p.r2 = *(const v4u*)(prow + col2 + sub * 8);
    p.ng = (F.lane < 24) ? (unsigned)prow[C_NG + F.lane] : 0u; p.pos = F.positions[tok];
}
__device__ __forceinline__ void nsa_prep_token(Frame& F, int tok, const PrepRaw& p) {
    const int b = tok >> 13, t = tok & 8191, sub = F.lane & 7, vid = F.lane >> 3;
    float cs_l, sn_l; rope_sincos(p.pos, sub, cs_l, sn_l);
    float cs[8], sn[8];
#pragma unroll
    for (int i = 0; i < 8; ++i) { cs[i] = __shfl(cs_l, (F.lane & ~7) + i); sn[i] = __shfl(sn_l, (F.lane & ~7) + i); }
    unsigned char* dob = F.dout_b;
    const size_t ktile_off = (size_t)(t >> 6) * 8192 + sub * 1024 + (t & 63) * 16;
    const size_t vtile_off = (size_t)(t >> 6) * 8192 + (sub >> 2) * 4096 + (t & 63) * 64 + (sub & 3) * 16;
#pragma unroll
    for (int round = 0; round < 3; ++round) {
        int kind; unsigned char* dst; const float* gain = nullptr;
        if (round == 0) { kind = 0; gain = F.q_gain; const int g = vid >> 2, hh = vid & 3;
            dst = dob + DO_QN + ((((size_t)(b * 2 + g) * SEQ + t) * 4 + hh) * 64 + sub * 8) * 2; }
        else if (round == 1) {
            const int g = vid & 1, which = vid >> 1;
            const size_t img = (size_t)(b * 2 + g) * (1u << 20);
            if (which == 0) { kind = 1; gain = F.k_gain + 64; dst = dob + DO_KSEL + img + ktile_off; }
            else if (which == 1) { kind = 1; gain = F.k_gain + 128; dst = dob + DO_KWIN + img + ktile_off; }
            else if (which == 2) { kind = 2; dst = dob + DO_VSEL + img + vtile_off; }
            else { kind = 2; dst = dob + DO_VWIN + img + vtile_off; }
        } else {
            const int g = vid & 1, which = (vid >> 1) & 1;
            kind = 2;
            dst = dob + (which ? DO_VC : DO_KC) + (((size_t)(b * 2 + g) * SEQ + t) * 64 + sub * 8) * 2;
        }
        const v4u raw = (round == 0) ? p.r0 : (round == 1) ? p.r1 : p.r2;
        if (kind == 2) { if (round < 2 || F.lane < 32) *(v4u*)dst = raw; }
        else {
            float x[8]; unpack8(raw, x);
            float ss = 0.f;
#pragma unroll
            for (int i = 0; i < 8; ++i) ss += x[i] * x[i];
            ss += dpp_xor1(ss); ss += dpp_xor2(ss); ss += __shfl_xor(ss, 4);
            const float rstd = 1.0f / sqrtf(ss * (1.0f / 64.0f) + NORM_EPS);
#pragma unroll
            for (int i = 0; i < 8; ++i) x[i] = x[i] * rstd * gain[sub * 8 + i];
            float xo[8];
#pragma unroll
            for (int i = 0; i < 8; ++i) xo[i] = dpp_xor1(x[i]);
            if (sub == 0) {
#pragma unroll
                for (int i = 0; i < 8; ++i) x[i] = x[i] * cs[i] - xo[i] * sn[i];
            } else if (sub == 1) {
#pragma unroll
                for (int i = 0; i < 8; ++i) x[i] = x[i] * cs[i] + xo[i] * sn[i];
            }
            if (kind == 0) {
#pragma unroll
                for (int i = 0; i < 8; ++i) x[i] *= 0.125f * 1.4426950408889634f;
            }
            *(v4u*)dst = pack8(x);
        }
    }
    if (F.lane < 24) { float* gt = (float*)(F.ws + WS_GATES) + (size_t)tok * 24; gt[F.lane] = sigmoidf_(bf2f((bf16)p.ng)); }
}

__device__ __forceinline__ void nsa_compress_item(Frame& F, int item) {
    const int kv = item >> 6, b = (item >> 5) & 1, g = (item >> 4) & 1, rt = item & 15, n0 = rt * 32;
    const bf16* Asrc = (const bf16*)(F.dout_b + (kv ? DO_VC : DO_KC)) + ((size_t)(b * 2 + g) * SEQ + 16 * n0) * 64;
    const bf16* Bsrc = (const bf16*)(F.ws + WS_WCW1) + (size_t)kv * 256 * 2048;
    LAS bf16* As = (LAS bf16*)(F.lds + RING_OFF);
    LAS bf16* Bs = (LAS bf16*)(F.lds + RING_OFF + 2 * 32 * 72 * 2);
    LAS float* Hs = (LAS float*)(F.lds + RING_OFF + 86016);
    LAS float* W2s = (LAS float*)(F.lds + RING_OFF);
    const int ar = F.tid >> 3, ac = (F.tid & 7) * 8;
    v4u areg0 = {0u, 0u, 0u, 0u}, areg1 = {0u, 0u, 0u, 0u}, breg0[4], breg1[4];
#define CMP_GLOAD(A_, B_, kc) do { if (F.tid < 256) A_ = *(const v4u*)(Asrc + (size_t)ar * 1024 + (kc) * 64 + ac); \
        _Pragma("unroll") for (int i_ = 0; i_ < 4; ++i_) { const int p_ = F.tid + 512 * i_, br_ = p_ >> 3, bc_ = (p_ & 7) * 8; B_[i_] = *(const v4u*)(Bsrc + (size_t)br_ * 2048 + (kc) * 64 + bc_); } } while (0)
#define CMP_LSTORE(A_, B_, buf) do { if (F.tid < 256) *(LAS v4u*)(As + (buf) * 32 * 72 + ar * 72 + ac) = A_; \
        _Pragma("unroll") for (int i_ = 0; i_ < 4; ++i_) { const int p_ = F.tid + 512 * i_, br_ = p_ >> 3, bc_ = (p_ & 7) * 8; *(LAS v4u*)(Bs + (buf) * 256 * 72 + br_ * 72 + bc_) = B_[i_]; } } while (0)
#define CMP_MMA(buf) do { _Pragma("unroll") for (int mt = 0; mt < 2; ++mt) _Pragma("unroll") for (int nt = 0; nt < 2; ++nt) \
        acc[mt][nt] = mma16(As + (buf) * 32 * 72 + mt * 16 * 72, 72, Bs + (buf) * 256 * 72 + (F.wave * 32 + nt * 16) * 72, 72, 64, acc[mt][nt], F.lane); } while (0)
    f32x4 acc[2][2];
#pragma unroll
    for (int mt = 0; mt < 2; ++mt)
#pragma unroll
        for (int nt = 0; nt < 2; ++nt) acc[mt][nt] = (f32x4){0.f, 0.f, 0.f, 0.f};
    CMP_GLOAD(areg0, breg0, 0); CMP_GLOAD(areg1, breg1, 1); CMP_LSTORE(areg0, breg0, 0); __syncthreads();
#pragma unroll 1
    for (int kc = 0; kc < 32; kc += 2) {
        if (kc + 2 < 32) CMP_GLOAD(areg0, breg0, kc + 2);
        CMP_MMA(0);
        CMP_LSTORE(areg1, breg1, 1);
        __syncthreads();
        if (kc + 3 < 32) CMP_GLOAD(areg1, breg1, kc + 3);
        CMP_MMA(1);
        if (kc + 2 < 32) CMP_LSTORE(areg0, breg0, 0);
        __syncthreads();
    }
#undef CMP_MMA
    const float* bias1 = (const float*)(F.ws + WS_MOD + 131072) + kv * 256;
#pragma unroll
    for (int mt = 0; mt < 2; ++mt)
#pragma unroll
        for (int nt = 0; nt < 2; ++nt) { const int col = F.wave * 32 + nt * 16 + (F.lane & 15);
#pragma unroll
            for (int i = 0; i < 4; ++i) Hs[(mt * 16 + 4 * (F.lane >> 4) + i) * 260 + col] = gelu_tanh(acc[mt][nt][i] + bias1[col]); }
    { const float* w2 = F.cmp_w2 + (size_t)kv * 256 * 64;
#pragma unroll
      for (int i = 0; i < 8; ++i) *(LAS f32x4*)(W2s + (F.tid + 512 * i) * 4) = *(const f32x4*)(w2 + (size_t)(F.tid + 512 * i) * 4); }
    __syncthreads();
    const int r = F.tid >> 4, dq = F.tid & 15;
    f32x4 o = {0.f, 0.f, 0.f, 0.f};
#pragma unroll 8
    for (int j = 0; j < 256; ++j) { const float hv = Hs[r * 260 + j]; const f32x4 w = *(const LAS f32x4*)(W2s + j * 64 + 4 * dq); o = o + w * hv; }
    const int n = n0 + r;
    if (kv == 0) {
        float ss = (o.x * o.x + o.y * o.y) + (o.z * o.z + o.w * o.w);
        ss += dpp_xor1(ss); ss += dpp_xor2(ss); ss += __shfl_xor(ss, 4); ss += __shfl_xor(ss, 8);
        const float rstd = 1.0f / sqrtf(ss * (1.0f / 64.0f) + NORM_EPS);
        const f32x4 gn = *(const f32x4*)(F.k_gain + 4 * dq);
        o = o * rstd * gn;
        const int tlast = (16 * n + 31 < SEQ) ? 16 * n + 31 : SEQ - 1;
        const int pos = F.positions[b * SEQ + tlast];
        f32x4 po; po.x = dpp_xor2(o.x); po.y = dpp_xor2(o.y); po.z = dpp_xor2(o.z); po.w = dpp_xor2(o.w);
        if (dq < 4) {
            const int i0 = 4 * (dq & 1);
            float c0, s0, c1, s1, c2, s2, c3, s3;
            rope_sincos(pos, i0, c0, s0); rope_sincos(pos, i0 + 1, c1, s1); rope_sincos(pos, i0 + 2, c2, s2); rope_sincos(pos, i0 + 3, c3, s3);
            if (dq < 2) { o.x = o.x * c0 - po.x * s0; o.y = o.y * c1 - po.y * s1; o.z = o.z * c2 - po.z * s2; o.w = o.w * c3 - po.w * s3; }
            else { o.x = o.x * c0 + po.x * s0; o.y = o.y * c1 + po.y * s1; o.z = o.z * c2 + po.z * s2; o.w = o.w * c3 + po.w * s3; }
        }
    }
    if (n == 511) o = (f32x4){0.f, 0.f, 0.f, 0.f};
    v2u pk; pk.x = pk2(o.x, o.y); pk.y = pk2(o.z, o.w);
    const int c = dq >> 1;
    unsigned char* img = F.dout_b + (kv ? DO_VCMP : DO_KCMP) + (size_t)(b * 2 + g) * 65536 + (size_t)(n >> 6) * 8192;
    if (kv == 0) *(v2u*)(img + c * 1024 + (n & 63) * 16 + (dq & 1) * 8) = pk;
    else *(v2u*)(img + (c >> 2) * 4096 + (n & 63) * 64 + (c & 3) * 16 + (dq & 1) * 8) = pk;
    __syncthreads();
}

constexpr int NSA_KB = 0, NSA_VB = 16384, NSA_IMP = 32768, NSA_OACC = 65536;
__device__ __forceinline__ int crow(int r, int hi) { return (r & 3) + 8 * (r >> 2) + 4 * hi; }
__device__ __forceinline__ s16x4 ds_tr16(const LAS unsigned char* p) { return __builtin_bit_cast(s16x4, __builtin_amdgcn_ds_read_tr16_b64_v4i16((LAS s16x4*)p)); }

__device__ __forceinline__ unsigned cvtpk(float lo, float hi) { unsigned r; asm("v_cvt_pk_bf16_f32 %0, %1, %2" : "=v"(r) : "v"(lo), "v"(hi)); return r; }
__device__ __forceinline__ float xhalf_max(float v) { const auto rr = __builtin_amdgcn_permlane32_swap(__float_as_uint(v), __float_as_uint(v), false, false); return fmaxf(__uint_as_float(rr[0]), __uint_as_float(rr[1])); }
constexpr float NSA_THR = 8.0f;

template <int MODE>
__device__ __forceinline__ void nsa_branch(Frame& F, const unsigned char* Kimg, const unsigned char* Vimg, int kt0, int kt1, const bf16x8 (&qr)[4],
                                           float& m, float& l, f32x16 (&o)[2], int t, int tw0, int nv, int nvw, int nvmin,
                                           unsigned mk0, unsigned mk1, unsigned mk2, unsigned mk3, unsigned wo0, unsigned wo1, unsigned wo2, unsigned wo3,
                                           float cinit  , LAS float* impw) {
    const int r32 = F.lane & 31, hi = F.lane >> 5, tokl = r32 >> 2;
    LAS unsigned char* KB = F.lds + RING_OFF + NSA_KB; LAS unsigned char* VB = F.lds + RING_OFF + NSA_VB;
    const v4u* kg = (const v4u*)Kimg + F.tid; const v4u* vg = (const v4u*)Vimg + F.tid;
    v4u kreg = kg[(size_t)kt0 * 512], vreg = {0u, 0u, 0u, 0u};
    if (MODE != 0) vreg = vg[(size_t)kt0 * 512];
    *(LAS v4u*)(KB + F.tid * 16) = kreg; if (MODE != 0) *(LAS v4u*)(VB + F.tid * 16) = vreg;
    __syncthreads();
#pragma unroll 1
    for (int kt = kt0; kt < kt1; ++kt) {
        const int buf = (kt - kt0) & 1; const bool has_next = kt + 1 < kt1;
        if (has_next) { kreg = kg[(size_t)(kt + 1) * 512]; if (MODE != 0) vreg = vg[(size_t)(kt + 1) * 512]; }
        const LAS unsigned char* Kb = KB + buf * 8192; const LAS unsigned char* Vb = VB + buf * 8192;
        bool need;
        if (MODE <= 1) need = kt * 64 < nvw;
        else if (MODE == 2) { const unsigned w = (kt < 32) ? wo0 : (kt < 64) ? wo1 : (kt < 96) ? wo2 : wo3; need = (w >> (kt & 31)) & 1u; }
        else need = (kt * 64 <= tw0 + 7) && (kt * 64 + 63 + 512 > tw0);
        bool selbit = true;
        if (MODE == 2) { const unsigned w = (kt < 32) ? mk0 : (kt < 64) ? mk1 : (kt < 96) ? mk2 : mk3; selbit = (w >> (kt & 31)) & 1u; }
        bool joint = false;
        if (need) {
            if (MODE == 2) joint = kt < (tw0 >> 6);
            else if (MODE == 3) joint = (kt * 64 + 63 <= tw0) && (kt * 64 + 512 > tw0 + 7);
            else joint = kt * 64 + 63 < nvmin;
            if (MODE != 1) joint = joint && !__any(m < -1e29f);
        }
        if (need && joint) {
            const float c0 = (MODE == 1) ? cinit : ((MODE == 2 && !selbit) ? -1e30f : -m);
            f32x16 pa, pb;
#pragma unroll
            for (int r = 0; r < 16; ++r) { pa[r] = c0; pb[r] = c0; }
#pragma unroll
            for (int d0 = 0; d0 < 4; ++d0) {
                const bf16x8 kfa = *(const LAS bf16x8*)(Kb + (2 * d0 + hi) * 1024 + r32 * 16), kfb = *(const LAS bf16x8*)(Kb + (2 * d0 + hi) * 1024 + (32 + r32) * 16);
                pa = __builtin_amdgcn_mfma_f32_32x32x16_bf16(kfa, qr[d0], pa, 0, 0, 0);
                pb = __builtin_amdgcn_mfma_f32_32x32x16_bf16(kfb, qr[d0], pb, 0, 0, 0);
            }
            if (MODE != 1) {
                float mxa = fmaxf(fmaxf(pa[0], pa[1]), pa[2]), mxb = fmaxf(fmaxf(pb[0], pb[1]), pb[2]);
#pragma unroll
                for (int r = 3; r < 15; r += 2) { mxa = fmaxf(fmaxf(mxa, pa[r]), pa[r + 1]); mxb = fmaxf(fmaxf(mxb, pb[r]), pb[r + 1]); }
                const float mx = xhalf_max(fmaxf(fmaxf(mxa, pa[15]), fmaxf(mxb, pb[15])));
                if (__any(mx > NSA_THR)) {
                    const float dl = fmaxf(mx, 0.f), alpha = fexp2(-dl);
                    m += dl; l *= alpha;
#pragma unroll
                    for (int r = 0; r < 16; ++r) { pa[r] -= dl; pb[r] -= dl; }
                    if (MODE != 0) {
#pragma unroll
                        for (int r = 0; r < 16; ++r) { o[0][r] *= alpha; o[1][r] *= alpha; }
                    }
                }
            }
            float ps0 = 0.f, ps1 = 0.f;
#pragma unroll
            for (int r = 0; r < 16; ++r) { pa[r] = fexp2(pa[r]); pb[r] = fexp2(pb[r]); ps0 += pa[r]; ps1 += pb[r]; }
            if (MODE != 1) l += ps0 + ps1;
            if (MODE == 1) {
#pragma unroll
                for (int rg = 0; rg < 4; ++rg) {
                    float a = (pa[4 * rg] + pa[4 * rg + 1]) + (pa[4 * rg + 2] + pa[4 * rg + 3]), sp = pa[4 * rg + 3];
                    float a2 = (pb[4 * rg] + pb[4 * rg + 1]) + (pb[4 * rg + 2] + pb[4 * rg + 3]), sp2 = pb[4 * rg + 3];
                    a += dpp_xor1(a); a += dpp_xor2(a); sp += dpp_xor1(sp); sp += dpp_xor2(sp);
                    a2 += dpp_xor1(a2); a2 += dpp_xor2(a2); sp2 += dpp_xor1(sp2); sp2 += dpp_xor2(sp2);
                    if ((r32 & 3) == 0) { const int jp = kt * 16 + 2 * rg + hi;
                        __hip_atomic_fetch_add(impw + tokl * 128 + jp, a, __ATOMIC_RELAXED, __HIP_MEMORY_SCOPE_WORKGROUP);
                        __hip_atomic_fetch_add(impw + tokl * 128 + jp + 1, sp, __ATOMIC_RELAXED, __HIP_MEMORY_SCOPE_WORKGROUP);
                        __hip_atomic_fetch_add(impw + tokl * 128 + jp + 8, a2, __ATOMIC_RELAXED, __HIP_MEMORY_SCOPE_WORKGROUP);
                        if (jp + 9 < 128) __hip_atomic_fetch_add(impw + tokl * 128 + jp + 9, sp2, __ATOMIC_RELAXED, __HIP_MEMORY_SCOPE_WORKGROUP); }
                }
            }
            if (MODE != 0) {
                v4u wa0, wa1, wb0, wb1;
                wa0.x = cvtpk(pa[0], pa[1]); wa0.y = cvtpk(pa[2], pa[3]); wa0.z = cvtpk(pa[4], pa[5]); wa0.w = cvtpk(pa[6], pa[7]);
                wa1.x = cvtpk(pa[8], pa[9]); wa1.y = cvtpk(pa[10], pa[11]); wa1.z = cvtpk(pa[12], pa[13]); wa1.w = cvtpk(pa[14], pa[15]);
                wb0.x = cvtpk(pb[0], pb[1]); wb0.y = cvtpk(pb[2], pb[3]); wb0.z = cvtpk(pb[4], pb[5]); wb0.w = cvtpk(pb[6], pb[7]);
                wb1.x = cvtpk(pb[8], pb[9]); wb1.y = cvtpk(pb[10], pb[11]); wb1.z = cvtpk(pb[12], pb[13]); wb1.w = cvtpk(pb[14], pb[15]);
                const bf16x8 fa0 = __builtin_bit_cast(bf16x8, wa0), fa1 = __builtin_bit_cast(bf16x8, wa1), fb0 = __builtin_bit_cast(bf16x8, wb0), fb1 = __builtin_bit_cast(bf16x8, wb1);
                const LAS unsigned char* vb = Vb + (4 * hi + ((F.lane & 15) >> 2)) * 64 + ((F.lane >> 4) & 1) * 32 + (F.lane & 3) * 8;
#pragma unroll
                for (int dh = 0; dh < 2; ++dh) {
                    const LAS unsigned char* v0 = vb + dh * 4096;
                    const s16x4 a0 = ds_tr16(v0), a1 = ds_tr16(v0 + 512), b0 = ds_tr16(v0 + 1024), b1 = ds_tr16(v0 + 1536), c0_ = ds_tr16(v0 + 2048), c1 = ds_tr16(v0 + 2560), d0_ = ds_tr16(v0 + 3072), d1 = ds_tr16(v0 + 3584);
                    const bf16x8 vfa0 = {a0[0], a0[1], a0[2], a0[3], a1[0], a1[1], a1[2], a1[3]}, vfa1 = {b0[0], b0[1], b0[2], b0[3], b1[0], b1[1], b1[2], b1[3]};
                    const bf16x8 vfb0 = {c0_[0], c0_[1], c0_[2], c0_[3], c1[0], c1[1], c1[2], c1[3]}, vfb1 = {d0_[0], d0_[1], d0_[2], d0_[3], d1[0], d1[1], d1[2], d1[3]};
                    o[dh] = __builtin_amdgcn_mfma_f32_32x32x16_bf16(vfa0, fa0, o[dh], 0, 0, 0);
                    o[dh] = __builtin_amdgcn_mfma_f32_32x32x16_bf16(vfa1, fa1, o[dh], 0, 0, 0);
                    o[dh] = __builtin_amdgcn_mfma_f32_32x32x16_bf16(vfb0, fb0, o[dh], 0, 0, 0);
                    o[dh] = __builtin_amdgcn_mfma_f32_32x32x16_bf16(vfb1, fb1, o[dh], 0, 0, 0);
                }
            }
        } else if (need) {
#pragma unroll 1
            for (int kb = 0; kb < 2; ++kb) {
                const int key0 = kt * 64 + kb * 32;
                bool fast;
                if (MODE == 2) fast = kt < (tw0 >> 6);
                else if (MODE == 3) fast = (key0 + 31 <= tw0) && (key0 + 512 > tw0 + 7);
                else fast = key0 + 31 < nvmin;
                if (MODE != 1) fast = fast && !__any(m < -1e29f);
                float c0 = 0.f;
                if (fast) c0 = (MODE == 1) ? cinit : ((MODE == 2 && !selbit) ? -1e30f : -m);
                f32x16 p;
#pragma unroll
                for (int r = 0; r < 16; ++r) p[r] = c0;
#pragma unroll
                for (int d0 = 0; d0 < 4; ++d0) {
                    const bf16x8 kf = *(const LAS bf16x8*)(Kb + (2 * d0 + hi) * 1024 + (32 * kb + r32) * 16);
                    p = __builtin_amdgcn_mfma_f32_32x32x16_bf16(kf, qr[d0], p, 0, 0, 0);
                }
                float pe[16];
                if (fast) {
                    if (MODE != 1) {
                        float mx = fmaxf(fmaxf(p[0], p[1]), p[2]);
#pragma unroll
                        for (int r = 3; r < 15; r += 2) mx = fmaxf(fmaxf(mx, p[r]), p[r + 1]);
                        mx = xhalf_max(fmaxf(mx, p[15]));
                        if (__any(mx > NSA_THR)) {
                            const float dl = fmaxf(mx, 0.f), alpha = fexp2(-dl);
                            m += dl; l *= alpha;
#pragma unroll
                            for (int r = 0; r < 16; ++r) p[r] -= dl;
                            if (MODE != 0) {
#pragma unroll
                                for (int r = 0; r < 16; ++r) { o[0][r] *= alpha; o[1][r] *= alpha; }
                            }
                        }
                    }
                    float ps0 = 0.f, ps1 = 0.f;
#pragma unroll
                    for (int r = 0; r < 16; r += 2) { pe[r] = fexp2(p[r]); pe[r + 1] = fexp2(p[r + 1]); ps0 += pe[r]; ps1 += pe[r + 1]; }
                    if (MODE != 1) l += ps0 + ps1;
                } else if (MODE == 1) {
#pragma unroll
                    for (int r = 0; r < 16; ++r) { const int key = key0 + crow(r, hi); pe[r] = (key < nv) ? fexp2(p[r] + cinit) : 0.f; }
                } else {
                    float mx = NEGBIG;
#pragma unroll
                    for (int r = 0; r < 16; ++r) {
                        const int key = key0 + crow(r, hi); bool ok;
                        if (MODE == 0) ok = key < nv;
                        else if (MODE == 2) ok = selbit && (kt < (t >> 6) || key <= t);
                        else ok = (key <= t) && (key + 512 > t);
                        p[r] = ok ? p[r] : NEGBIG; mx = fmaxf(mx, p[r]);
                    }
                    mx = xhalf_max(mx);
                    const float mn = fmaxf(m, mx), alpha = fexp2(m - mn);
                    float ps = 0.f;
#pragma unroll
                    for (int r = 0; r < 16; ++r) { pe[r] = (p[r] > -1e29f) ? fexp2(p[r] - mn) : 0.f; ps += pe[r]; }
                    l = l * alpha + ps; m = mn;
                    if (MODE != 0) {
#pragma unroll
                        for (int r = 0; r < 16; ++r) { o[0][r] *= alpha; o[1][r] *= alpha; }
                    }
                }
                if (MODE == 1) {
#pragma unroll
                    for (int rg = 0; rg < 4; ++rg) {
                        float a = (pe[4 * rg] + pe[4 * rg + 1]) + (pe[4 * rg + 2] + pe[4 * rg + 3]), sp = pe[4 * rg + 3];
                        a += dpp_xor1(a); a += dpp_xor2(a); sp += dpp_xor1(sp); sp += dpp_xor2(sp);
                        if ((r32 & 3) == 0) { const int jp = (key0 >> 2) + 2 * rg + hi;
                            __hip_atomic_fetch_add(impw + tokl * 128 + jp, a, __ATOMIC_RELAXED, __HIP_MEMORY_SCOPE_WORKGROUP);
                            if (jp + 1 < 128) __hip_atomic_fetch_add(impw + tokl * 128 + jp + 1, sp, __ATOMIC_RELAXED, __HIP_MEMORY_SCOPE_WORKGROUP); }
                    }
                }
                if (MODE != 0) {
                    v4u pw0, pw1;
                    pw0.x = cvtpk(pe[0], pe[1]); pw0.y = cvtpk(pe[2], pe[3]); pw0.z = cvtpk(pe[4], pe[5]); pw0.w = cvtpk(pe[6], pe[7]);
                    pw1.x = cvtpk(pe[8], pe[9]); pw1.y = cvtpk(pe[10], pe[11]); pw1.z = cvtpk(pe[12], pe[13]); pw1.w = cvtpk(pe[14], pe[15]);
                    const bf16x8 pf0 = __builtin_bit_cast(bf16x8, pw0), pf1 = __builtin_bit_cast(bf16x8, pw1);
                    const LAS unsigned char* vb = Vb + (32 * kb + 4 * hi + ((F.lane & 15) >> 2)) * 64 + ((F.lane >> 4) & 1) * 32 + (F.lane & 3) * 8;
#pragma unroll
                    for (int dh = 0; dh < 2; ++dh) {
                        const s16x4 a0 = ds_tr16(vb + dh * 4096), a1 = ds_tr16(vb + dh * 4096 + 512), b0 = ds_tr16(vb + dh * 4096 + 1024), b1 = ds_tr16(vb + dh * 4096 + 1024 + 512);
                        const bf16x8 vf0 = {a0[0], a0[1], a0[2], a0[3], a1[0], a1[1], a1[2], a1[3]}, vf1 = {b0[0], b0[1], b0[2], b0[3], b1[0], b1[1], b1[2], b1[3]};
                        o[dh] = __builtin_amdgcn_mfma_f32_32x32x16_bf16(vf0, pf0, o[dh], 0, 0, 0);
                        o[dh] = __builtin_amdgcn_mfma_f32_32x32x16_bf16(vf1, pf1, o[dh], 0, 0, 0);
                    }
                }
            }
        }
        if (has_next) { *(LAS v4u*)(KB + (buf ^ 1) * 8192 + F.tid * 16) = kreg; if (MODE != 0) *(LAS v4u*)(VB + (buf ^ 1) * 8192 + F.tid * 16) = vreg; }
        __syncthreads();
    }
}

__device__ __forceinline__ void nsa_item(Frame& F, int b, int g, int qi) {
    const int r32 = F.lane & 31, hi = F.lane >> 5, tokl = r32 >> 2, hh = r32 & 3;
    const int t0 = qi * 64, tw0 = t0 + 8 * F.wave, t = tw0 + tokl;
    const unsigned char* dob = F.dout_b;
    const size_t img = (size_t)(b * 2 + g) * (1u << 20);
    LAS float* impw = (LAS float*)(F.lds + RING_OFF + NSA_IMP) + F.wave * 1024;
    LAS unsigned* selm = (LAS unsigned*)(F.lds + TAB_OFF + 1024) + F.wave * 32;
    LAS float* oaccw = (LAS float*)(F.lds + RING_OFF + NSA_OACC) + F.wave * 2048 + F.lane;
#pragma unroll
    for (int i = 0; i < 16; ++i) impw[F.lane + 64 * i] = 0.f;
    bf16x8 qr[4];
    { const bf16* qrow = (const bf16*)(dob + DO_QN) + (((size_t)(b * 2 + g) * SEQ + tw0) * 4 + r32) * 64;
#pragma unroll
      for (int d0 = 0; d0 < 4; ++d0) qr[d0] = *(const bf16x8*)(qrow + 16 * d0 + 8 * hi); }
    const float* gt = (const float*)(F.ws + WS_GATES) + ((size_t)b * SEQ + t) * 24 + (g * 4 + hh) * 3;
#if defined(NSA_ZERO_CMP)
    const float g0 = 0.f, g1 = gt[1], g2 = gt[2];
#elif defined(NSA_ZERO_SEL)
    const float g0 = gt[0], g1 = 0.f, g2 = gt[2];
#elif defined(NSA_ZERO_WIN)
    const float g0 = gt[0], g1 = gt[1], g2 = 0.f;
#elif defined(NSA_ZERO_ALL)
    const float g0 = 0.f, g1 = 0.f, g2 = 0.f;
#else
    const float g0 = gt[0], g1 = gt[1], g2 = gt[2];
#endif
    f32x16 o[2];
    const int nv = (t >= 31) ? ((t - 31) >> 4) + 1 : 0, nvw = (tw0 + 7 >= 31) ? ((tw0 + 7 - 31) >> 4) + 1 : 0, nvmin = (tw0 >= 31) ? ((tw0 - 31) >> 4) + 1 : 0;
    const int nct = (4 * qi + 3 + 63) >> 6;
    const unsigned char* Kc = dob + DO_KCMP + (size_t)(b * 2 + g) * 65536; const unsigned char* Vc = dob + DO_VCMP + (size_t)(b * 2 + g) * 65536;
#if defined(NSA_SPIN)
    unsigned long long tsp = __builtin_amdgcn_s_memrealtime();
#define NSPIN(k) do { if (NSA_SPIN == (k)) { const unsigned long long t1_ = __builtin_amdgcn_s_memrealtime(), dt_ = t1_ - tsp; while (__builtin_amdgcn_s_memrealtime() - t1_ < dt_) __builtin_amdgcn_s_sleep(4); } tsp = __builtin_amdgcn_s_memrealtime(); } while (0)
#else
#define NSPIN(k) do { } while (0)
#endif
    float m = NEGBIG, l = 0.f;
    nsa_branch<0>(F, Kc, Vc, 0, nct, qr, m, l, o, t, tw0, nv, nvw, nvmin, 0u, 0u, 0u, 0u, 0u, 0u, 0u, 0u, 0.f, impw);
    { const float lt = l + __shfl_xor(l, 32); const float cinit = (lt > 0.f) ? -__log2f(lt) - m : -1e30f;
#pragma unroll
      for (int r = 0; r < 16; ++r) { o[0][r] = 0.f; o[1][r] = 0.f; }
      nsa_branch<1>(F, Kc, Vc, 0, nct, qr, m, l, o, t, tw0, nv, nvw, nvmin, 0u, 0u, 0u, 0u, 0u, 0u, 0u, 0u, cinit, impw);
#pragma unroll
      for (int r = 0; r < 16; ++r) { oaccw[r * 64] = g0 * o[0][r]; oaccw[(16 + r) * 64] = g0 * o[1][r]; } }
    __syncthreads();
    NSPIN(1);
#pragma unroll 1
    for (int tl = 0; tl < 8; ++tl) {
        const int tt = tw0 + tl, cur = tt >> 6, j0 = F.lane, j1 = F.lane + 64;
        const unsigned u0 = (j0 <= cur) ? (__float_as_uint(impw[tl * 128 + j0] + ((j0 == 0 || j0 == cur || j0 == cur - 1) ? 1e4f : 0.f)) + 1u) : 0u;
        const unsigned u1 = (j1 <= cur) ? (__float_as_uint(impw[tl * 128 + j1] + ((j1 == cur || j1 == cur - 1) ? 1e4f : 0.f)) + 1u) : 0u;
        bool s0, s1;
        if (cur < 16) { s0 = (j0 <= cur); s1 = false; }
        else {
            unsigned T = 0u;
#pragma unroll 1
            for (int bit = 31; bit >= 0; --bit) {
                const unsigned cand = T | (1u << bit);
                const int c = __popcll(__ballot(u0 >= cand)) + __popcll(__ballot(u1 >= cand));
                if (c >= 16) T = cand;
            }
            const unsigned long long g0 = __ballot(u0 > T), g1 = __ballot(u1 > T), e0 = __ballot(u0 == T), e1 = __ballot(u1 == T);
            const int need = 16 - (__popcll(g0) + __popcll(g1));
            const unsigned long long below = (F.lane == 0) ? 0ull : (~0ull >> (64 - F.lane));
            const int rank0 = __popcll(e0 & below), rank1 = __popcll(e0) + __popcll(e1 & below);
            s0 = (u0 > T) || (u0 == T && rank0 < need);
            s1 = (u1 > T) || (u1 == T && rank1 < need);
        }
        const unsigned long long m0 = __ballot(s0), m1 = __ballot(s1);
        if (F.lane == 0) { selm[tl * 4 + 0] = (unsigned)m0; selm[tl * 4 + 1] = (unsigned)(m0 >> 32); selm[tl * 4 + 2] = (unsigned)m1; selm[tl * 4 + 3] = (unsigned)(m1 >> 32); }
    }
    __syncthreads();
    const unsigned mk0 = selm[tokl * 4 + 0], mk1 = selm[tokl * 4 + 1], mk2 = selm[tokl * 4 + 2], mk3 = selm[tokl * 4 + 3];
    unsigned wo0 = 0u, wo1 = 0u, wo2 = 0u, wo3 = 0u;
#pragma unroll
    for (int tl = 0; tl < 8; ++tl) { wo0 |= selm[tl * 4 + 0]; wo1 |= selm[tl * 4 + 1]; wo2 |= selm[tl * 4 + 2]; wo3 |= selm[tl * 4 + 3]; }
    wo0 = __builtin_amdgcn_readfirstlane(wo0); wo1 = __builtin_amdgcn_readfirstlane(wo1); wo2 = __builtin_amdgcn_readfirstlane(wo2); wo3 = __builtin_amdgcn_readfirstlane(wo3);
    NSPIN(2);
    { m = NEGBIG; l = 0.f;
#pragma unroll
      for (int r = 0; r < 16; ++r) { o[0][r] = 0.f; o[1][r] = 0.f; }
      nsa_branch<2>(F, dob + DO_KSEL + img, dob + DO_VSEL + img, 0, qi + 1, qr, m, l, o, t, tw0, nv, nvw, nvmin, mk0, mk1, mk2, mk3, wo0, wo1, wo2, wo3, 0.f, impw);
      const float lt = l + __shfl_xor(l, 32); const float sc = (lt > 0.f) ? g1 / lt : 0.f;
#pragma unroll
      for (int r = 0; r < 16; ++r) { oaccw[r * 64] += sc * o[0][r]; oaccw[(16 + r) * 64] += sc * o[1][r]; } }
    NSPIN(3);
    { m = NEGBIG; l = 0.f;
#pragma unroll
      for (int r = 0; r < 16; ++r) { o[0][r] = 0.f; o[1][r] = 0.f; }
      nsa_branch<3>(F, dob + DO_KWIN + img, dob + DO_VWIN + img, (qi >= 8) ? qi - 8 : 0, qi + 1, qr, m, l, o, t, tw0, nv, nvw, nvmin, 0u, 0u, 0u, 0u, 0u, 0u, 0u, 0u, 0.f, impw);
      const float lt = l + __shfl_xor(l, 32); const float sc = (lt > 0.f) ? g2 / lt : 0.f;
#pragma unroll
      for (int r = 0; r < 16; ++r) { o[0][r] = oaccw[r * 64] + sc * o[0][r]; o[1][r] = oaccw[(16 + r) * 64] + sc * o[1][r]; } }
    NSPIN(4);
    bf16* orow = (bf16*)(F.ws + WS_O + 32 * MiB) + ((size_t)b * SEQ + t) * DM + 512 + (g * 4 + hh) * 64;
#pragma unroll
    for (int dh = 0; dh < 2; ++dh)
#pragma unroll
        for (int rg = 0; rg < 4; ++rg) { v2u w; w.x = pk2(o[dh][4 * rg], o[dh][4 * rg + 1]); w.y = pk2(o[dh][4 * rg + 2], o[dh][4 * rg + 3]);
            *(v2u*)(orow + 32 * dh + 8 * rg + 4 * hi) = w; }
    __syncthreads();
}

__device__ __forceinline__ void sgu_item(Frame& F, int item) {
    const int gg = item & 7, ck = (item >> 3) & 63, b = item >> 9;
    const size_t tok0 = (size_t)b * SEQ + ck * 128;
    const bf16* Z = (const bf16*)(F.ws + WS_A);
    constexpr int RS = 544, BS = 136;
    LAS bf16* Ws = (LAS bf16*)(F.lds + RING_OFF);
    LAS unsigned char* Vs = F.lds + RING_OFF + 34816;
    LAS float* rs = (LAS float*)(F.lds + RING_OFF + 34816 + 128 * RS);
    if (F.tid < 128) { const float* st = (const float*)(F.ws + WS_STATS) + (tok0 + F.tid) * 32; float sum = 0.f;
#pragma unroll
        for (int k = 0; k < 32; k += 4) { const f32x4 v = *(const f32x4*)(st + k); sum += (v.x + v.y) + (v.z + v.w); }
        rs[F.tid] = 1.0f / sqrtf(sum * (1.0f / SGW) + NORM_EPS); }
    { const float* wsrc = F.sgu_ws + (size_t)gg * 128 * 128;
#pragma unroll
      for (int k = 0; k < 8; ++k) { const int p = F.tid + 512 * k, tr = p >> 5, sc = (p & 31) * 4; const f32x4 w = *(const f32x4*)(wsrc + tr * 128 + sc);
          v2u o; o.x = pk2((sc <= tr) ? w.x : 0.f, (sc + 1 <= tr) ? w.y : 0.f); o.y = pk2((sc + 2 <= tr) ? w.z : 0.f, (sc + 3 <= tr) ? w.w : 0.f);
          *(LAS v2u*)(Ws + tr * 136 + sc) = o; } }
    __syncthreads();
    { const int cc = F.tid & 31; float gn[8];
#pragma unroll
      for (int i = 0; i < 8; ++i) gn[i] = F.sgu_ng[gg * 256 + cc * 8 + i];
      v4u zr[8];
#pragma unroll
      for (int k = 0; k < 8; ++k) { const int sidx = (F.tid >> 5) + 16 * k; zr[k] = *(const v4u*)(Z + (tok0 + sidx) * 4096 + 2048 + gg * 256 + cc * 8); }
#pragma unroll
      for (int k = 0; k < 8; ++k) { const int sidx = (F.tid >> 5) + 16 * k; float x[8]; unpack8(zr[k], x); const float rr = rs[sidx];
#pragma unroll
          for (int i = 0; i < 8; ++i) x[i] *= rr * gn[i];
          const v4u o = pack8(x); LAS unsigned char* dst = Vs + sidx * RS + (cc >> 3) * BS + (cc & 7) * 16;
          *(LAS v2u*)dst = (v2u){o.x, o.y}; *(LAS v2u*)(dst + 8) = (v2u){o.z, o.w}; } }
    __syncthreads();
    v4u uraw[8];
    { const bf16* urow0 = Z + (tok0 + 16 * F.wave + (F.lane & 15)) * 4096 + gg * 256 + 64 * (F.lane >> 4);
#pragma unroll
      for (int j = 0; j < 8; ++j) uraw[j] = *(const v4u*)(urow0 + 8 * j); }
    f32x4 acc[16];
#pragma unroll
    for (int nt = 0; nt < 16; ++nt) acc[nt] = (f32x4){0.f, 0.f, 0.f, 0.f};
    const int ksteps = (16 * F.wave + 16 + 31) >> 5;
    const LAS bf16* wp = Ws + (16 * F.wave + (F.lane & 15)) * 136 + (F.lane >> 4) * 8;
    const LAS unsigned char* vp = Vs + (8 * (F.lane >> 4) + ((F.lane & 15) >> 2)) * RS + (F.lane & 3) * BS;
#pragma unroll 1
    for (int kk = 0; kk < ksteps; ++kk) {
        const bf16x8 wf = *(const LAS bf16x8*)(wp + kk * 32);
        const LAS unsigned char* vk = vp + kk * 32 * RS;
#pragma unroll
        for (int nt = 0; nt < 16; ++nt) {
            const s16x4 lo = ds_tr16(vk + 8 * nt), hi4 = ds_tr16(vk + 4 * RS + 8 * nt);
            const bf16x8 vf = {lo[0], lo[1], lo[2], lo[3], hi4[0], hi4[1], hi4[2], hi4[3]};
            acc[nt] = __builtin_amdgcn_mfma_f32_16x16x32_bf16(vf, wf, acc[nt], 0, 0, 0);
        }
    }
    { const int tr = 16 * F.wave + (F.lane & 15), g = F.lane >> 4; const float bs = F.sgu_bs[gg * 128 + tr];
      bf16* orow = (bf16*)(F.ws + WS_O) + (tok0 + tr) * SGW + gg * 256 + 64 * g;
#pragma unroll
      for (int j = 0; j < 8; ++j) { float u[8]; unpack8(uraw[j], u);
#pragma unroll
          for (int i = 0; i < 4; ++i) { u[i] *= acc[2 * j][i] + bs; u[4 + i] *= acc[2 * j + 1][i] + bs; }
          *(v4u*)(orow + 8 * j) = pack8(u); } }
    __syncthreads();
}


__device__ __forceinline__ void moe_tail_copies(Frame& F, int set) {
    const int np = ((const LAS int*)(F.lds + TAB_OFF))[16];
    int cthr = 4 * np - 2 * F.G; cthr = cthr < 0 ? 0 : (cthr > F.G - 64 ? F.G - 64 : cthr);
    __syncthreads();
    if (F.bid >= cthr) tr_run(F, set, (F.bid - cthr) * 8 + F.wave, (F.G - cthr) * 8);
}
constexpr int NPHASE = 18;
struct Args { const void* in[26]; float* out; unsigned char* ws; int ph_lo, ph_hi, use_bar, pad; };
__global__ void __launch_bounds__(512, 2) trunk_fwd(Args args) {
    extern __shared__ __attribute__((aligned(16))) unsigned char lds[];
    Frame F;
    F.lds = (LAS unsigned char*)lds;
    F.MISC = (volatile LAS unsigned*)(F.lds + MISC_OFF);
    F.tid = threadIdx.x; F.lane = F.tid & 63; F.wave = __builtin_amdgcn_readfirstlane(F.tid >> 6);
    F.G = gridDim.x; F.bid = blockIdx.x;
    F.ws = args.ws; F.out = args.out; F.dout_b = (unsigned char*)args.out;
    F.ctl = (gu32*)(args.ws + WS_CTL);
    F.x = (const float*)args.in[0]; F.c = (const float*)args.in[1]; F.positions = (const int*)args.in[2]; F.w_ada = (const float*)args.in[3]; F.b_ada = (const float*)args.in[4];
    F.norm_g = (const float*)args.in[5]; F.w_in_ab = (const float*)args.in[6]; F.w_out_ab = (const float*)args.in[7]; F.gla_w2 = (const float*)args.in[8]; F.gla_bg = (const float*)args.in[9];
    F.gla_ng = (const float*)args.in[10]; F.q_gain = (const float*)args.in[11]; F.k_gain = (const float*)args.in[12]; F.cmp_pe = (const float*)args.in[13]; F.cmp_w1 = (const float*)args.in[14];
    F.cmp_w2 = (const float*)args.in[15]; F.w_in_c = (const float*)args.in[16]; F.sgu_ng = (const float*)args.in[17]; F.sgu_ws = (const float*)args.in[18]; F.sgu_bs = (const float*)args.in[19];
    F.w_out_c = (const float*)args.in[20]; F.w_router = (const float*)args.in[21]; F.r_bias = (const float*)args.in[22]; F.w_gate = (const float*)args.in[23]; F.w_up = (const float*)args.in[24];
    F.w_down = (const float*)args.in[25];
    for (int u = F.tid; u < (LDS_BYTES - LDSCTL_OFF) / 4; u += 512) ((LAS unsigned*)(F.lds + LDSCTL_OFF))[u] = 0u;
    __syncthreads();
    XcdBarrier bar; bar.bar = (unsigned*)(F.ctl + CW_BAR); bar.x = 0; bar.st = nullptr;
    if (args.use_bar) bar = xcd_barrier_post((unsigned*)(F.ctl + CW_BAR) + (args.use_bar - 1) * XCD_BAR_WORDS, F.MISC + 8);
    const int lo = args.ph_lo, hi = args.ph_hi;
#ifndef PH_MASK
#define PH_MASK 0x3FFFFu
#endif
#define IN(k) ((((PH_MASK) >> (k)) & 1u) && lo <= (k) && (k) < hi)
#if defined(SPIN_PHASE)
    unsigned long long t_mark = __builtin_amdgcn_s_memrealtime();
#define SPIN_HOOK(k) do { if ((k) == (SPIN_PHASE)) { const unsigned long long t1_ = __builtin_amdgcn_s_memrealtime(), dt_ = t1_ - t_mark; while (__builtin_amdgcn_s_memrealtime() - t1_ < dt_) __builtin_amdgcn_s_sleep(4); } } while (0)
#define SPIN_MARK() do { t_mark = __builtin_amdgcn_s_memrealtime(); } while (0)
#else
#define SPIN_HOOK(k) do { } while (0)
#define SPIN_MARK() do { } while (0)
#endif
#define SEAM(k) do { if (IN(k)) SPIN_HOOK(k); if (IN(k) && IN((k) + 1)) xcd_barrier(bar); SPIN_MARK(); } while (0)
    float* mod = (float*)(F.ws + WS_MOD);
    bf16* Hb = (bf16*)(F.ws + WS_O);
    bf16* Ab = (bf16*)(F.ws + WS_A);

    if (IN(0)) { p0_prologue(F); } SEAM(0);
    if (IN(1)) { row_pass<false, true, false>(F, F.x, mod, 0, F.norm_g, mod, 0, 0); } SEAM(1);
    if (IN(2)) { pg8::Gemm g{Hb, (const bf16*)(F.ws + WS_WIN), NTOK, NPROJ, DM}; pg8::StaticOrder S; S.init(NTOK, NPROJ, F.G, F.bid);
        pg8::EpiBf16<0> E{Ab, NPROJ, nullptr, 0, 0, 1.f};
        pg8::gemm_phase<pg8::EpiBf16<0>, pg8::StaticOrder, true, true>(F.lds + RING_OFF, g, S, E); } SEAM(2);
    if (IN(3)) {
        for (int it = F.bid; it < 1024; it += F.G) gla_prep_item(F, it);
        { int tok = F.bid * 8 + F.wave; const int tstep = F.G * 8; PrepRaw cur, nxt; nxt.pos = 0; nxt.ng = 0u; nxt.r0 = (v4u){0u, 0u, 0u, 0u}; nxt.r1 = nxt.r0; nxt.r2 = nxt.r0;
          if (tok < NTOK) nsa_prep_load(F, tok, cur);
          while (tok < NTOK) { const int ntok = tok + tstep; if (ntok < NTOK) nsa_prep_load(F, ntok, nxt); nsa_prep_token(F, tok, cur); cur = nxt; tok = ntok; } }
    } SEAM(3);
    if (IN(4)) {
        const int half = F.G >> 1;
        if (F.bid < half) { for (int it = F.bid; it < 128; it += half) nsa_compress_item(F, it); }
        else { for (int gi = (F.bid - half) * 512 + F.tid; gi < 65536; gi += (F.G - half) * 512) gla_scan(F, gi); }
    } SEAM(4);
    if (IN(5)) {
#ifndef NO_NSA
        for (int p = F.bid; p < 256; p += F.G) { const int bg = p >> 6, i = p & 63; nsa_item(F, bg >> 1, bg & 1, i); nsa_item(F, bg >> 1, bg & 1, 127 - i); }
#endif
#ifndef NO_GLAOUT
#if defined(GLA_SPIN)
        { const unsigned long long tg0 = __builtin_amdgcn_s_memrealtime();
#endif
        for (int it = F.bid; it < 1024; it += F.G) gla_out_item(F, it);
#if defined(GLA_SPIN)
          const unsigned long long t1_ = __builtin_amdgcn_s_memrealtime(), dt_ = t1_ - tg0; while (__builtin_amdgcn_s_memrealtime() - t1_ < dt_) __builtin_amdgcn_s_sleep(4); }
#endif
#endif
    } SEAM(5);
    if (IN(6)) { pg8::Gemm g{(const bf16*)(F.ws + WS_O + 32 * MiB), (const bf16*)(F.ws + WS_WOUT), NTOK, DM, DM}; pg8::StaticOrder S; S.init(NTOK, DM, F.G, F.bid);
        EpiResid E{F.x, F.out, mod + 2 * 1024};
        pg8::gemm_phase<EpiResid, pg8::StaticOrder, true, true>(F.lds + RING_OFF, g, S, E); } SEAM(6);
#define MOE_BLOCK(P, LAYER) \
    if (IN(P)) { row_pass<false, true, true>(F, F.out, mod + (LAYER) * 2 * 6144, 3 * 1024, F.norm_g + ((LAYER) * 2 + 1) * 1024, mod, (LAYER), 0); } SEAM(P); \
    if (IN((P) + 1)) { moe_tables(F, (LAYER)); MoeOrder S{(const LAS int*)(F.lds + TAB_OFF), F.G, F.bid}; \
        { LAS unsigned* rofs = (LAS unsigned*)(F.lds + TAB_OFF + 2048); const int* elist = (const int*)(F.ws + WS_STATS); pg8::Unit uu; \
          for (int ui = 0; ui < 3; ++ui) if (S.next(ui, uu)) { if (F.tid < 256) rofs[ui * 256 + F.tid] = S.row_off(uu, F.tid, elist); } \
          __syncthreads(); } \
        pg8::Gemm g{Hb, (const bf16*)(F.ws + WS_WGU) + (size_t)(LAYER) * 16 * 1024 * 1024, MOE_ROWS, 1024, DM}; EpiMoeGU E{(bf16*)(F.ws + WS_A + A_HID_OFF)}; \
        pg8::gemm_phase_gather<EpiMoeGU, MoeOrder>(F.lds + RING_OFF, g, S, E, (const LAS unsigned*)(F.lds + TAB_OFF + 2048)); \
        if ((LAYER) == 0) moe_tail_copies(F, 1); } SEAM((P) + 1); \
    if (IN((P) + 2)) { moe_tables(F, (LAYER)); MoeOrder S{(const LAS int*)(F.lds + TAB_OFF), F.G, F.bid}; \
        pg8::Gemm g{(const bf16*)(F.ws + WS_A + A_HID_OFF), (const bf16*)(F.ws + WS_WDN) + (size_t)(LAYER) * 16 * 1024 * 512, MOE_ROWS, 1024, EHID}; EpiMoeDn E{Ab}; \
        pg8::gemm_phase<EpiMoeDn, MoeOrder, true, true>(F.lds + RING_OFF, g, S, E); \
        if ((LAYER) == 0) moe_tail_copies(F, 2); } SEAM((P) + 2);
    MOE_BLOCK(7, 0)
    if (IN(10)) { row_pass<true, true, false>(F, F.out, mod + 2 * 6144, 0, F.norm_g + 2 * 1024, mod, 1, 0); } SEAM(10);
    if (IN(11)) { pg8::Gemm g{Hb, (const bf16*)(F.ws + WS_WINC), NTOK, 4096, DM}; pg8::StaticOrder S; S.init(NTOK, 4096, F.G, F.bid);
        EpiGeluStats E{Ab, (float*)(F.ws + WS_STATS)};
        pg8::gemm_phase<EpiGeluStats, pg8::StaticOrder, true, true>(F.lds + RING_OFF, g, S, E); } SEAM(11);
    if (IN(12)) { for (int it = F.bid; it < 1024; it += F.G) sgu_item(F, it); } SEAM(12);
    if (IN(13)) { pg8::Gemm g{Hb, (const bf16*)(F.ws + WS_WOUTC), NTOK, DM, SGW}; pg8::StaticOrder S; S.init(NTOK, DM, F.G, F.bid);
        EpiResid E{F.out, F.out, mod + 2 * 6144 + 2 * 1024};
        pg8::gemm_phase<EpiResid, pg8::StaticOrder, true, true>(F.lds + RING_OFF, g, S, E); } SEAM(13);
    MOE_BLOCK(14, 1)
    if (IN(17)) { row_pass<true, false, false>(F, F.out, mod, 0, F.norm_g, mod + 2 * 6144, 1, 1); SPIN_HOOK(17); }
#undef IN
#undef SEAM
#undef MOE_BLOCK
}

#ifndef MK_N_LAUNCHES
#define MK_N_LAUNCHES 1
#endif
extern "C" void kernel_launch(void* const* d_in, const int* in_sizes, int n_in, void* d_out, int out_size, void* d_ws, size_t ws_size, hipStream_t stream) {
    static int grid = 0;
    if (grid == 0) {
        if (n_in != 26 || out_size != NTOK * DM || ws_size < WS_END) { fprintf(stderr, "kernel_launch: unexpected problem shape / workspace (%d inputs, out %d, ws %zu)\n", n_in, out_size, ws_size); grid = -1; return; }
        int dev = 0, cus = 0, per_cu = 0;
        if (hipGetDevice(&dev) != hipSuccess || hipDeviceGetAttribute(&cus, hipDeviceAttributeMultiprocessorCount, dev) != hipSuccess) { grid = -1; return; }
        if (hipFuncSetAttribute((const void*)trunk_fwd, hipFuncAttributeMaxDynamicSharedMemorySize, LDS_BYTES) != hipSuccess) { fprintf(stderr, "kernel_launch: hipFuncSetAttribute failed\n"); grid = -1; return; }
        if (hipOccupancyMaxActiveBlocksPerMultiprocessor(&per_cu, (const void*)trunk_fwd, 512, LDS_BYTES) != hipSuccess || per_cu < 1) { fprintf(stderr, "kernel_launch: occupancy query says %d blocks per CU\n", per_cu); }
        (void)hipGetLastError();
        grid = cus;
        if (grid != 256) { fprintf(stderr, "kernel_launch: built for a 256-CU device, found %d CUs\n", cus); grid = -1; return; }
    }
    if (grid < 0) return;
    (void)hipMemsetAsync((char*)d_ws + WS_CTL, 0, CTL_ZERO_BYTES, stream);
    Args a{};
    for (int i = 0; i < 26; ++i) a.in[i] = d_in[i];
    a.out = (float*)d_out; a.ws = (unsigned char*)d_ws; a.pad = 0;
    if (MK_N_LAUNCHES == 1) {
#if defined(REP_PHASE)
        a.ph_lo = 0; a.ph_hi = REP_PHASE + 1; a.use_bar = 1;
        hipLaunchKernelGGL(trunk_fwd, dim3(grid), dim3(512), LDS_BYTES, stream, a);
        a.ph_lo = REP_PHASE; a.ph_hi = NPHASE; a.use_bar = 2;
        hipLaunchKernelGGL(trunk_fwd, dim3(grid), dim3(512), LDS_BYTES, stream, a);
#else
        a.ph_lo = 0; a.ph_hi = NPHASE; a.use_bar = 1;
        hipLaunchKernelGGL(trunk_fwd, dim3(grid), dim3(512), LDS_BYTES, stream, a);
#endif
    } else {
        for (int p = 0; p < NPHASE; ++p) { a.ph_lo = p; a.ph_hi = p + 1; a.use_bar = 0; hipLaunchKernelGGL(trunk_fwd, dim3(grid), dim3(512), LDS_BYTES, stream, a); }
    }
}
```

```cpp
#include <hip/hip_runtime.h>
#include <cstdio>
#include <cstdint>
namespace pg8 {
#define PG8_LAS __attribute__((address_space(3)))
typedef unsigned short bf16_t;
typedef short bf16x8 __attribute__((ext_vector_type(8)));
typedef float f32x4 __attribute__((ext_vector_type(4)));
typedef unsigned u32x4 __attribute__((ext_vector_type(4)));
constexpr int BM = 256, BK = 64, HALF = 128, HTB = HALF * BK * 2  , STAGE_BYTES = 8 * HTB, NXCD = 8, WGM = 8;

__host__ __device__ __forceinline__ int lds_byte(int r, int c) { const int st = (r >> 4) * 2 + (c >> 5), rr = r & 15, cc = c & 31, ob = rr * 64 + cc * 2; return st * 1024 + (ob ^ (((ob >> 9) & 1) << 5)); }
__host__ __device__ __forceinline__ void stage_rc(int b, int& R, int& C) { const int st = b / 1024, sb = b % 1024, swz = sb ^ (((sb >> 9) & 1) << 5); R = (st >> 1) * 16 + swz / 64; C = (st & 1) * 32 + (swz % 64) / 2; }
__host__ __device__ __forceinline__ int perm32(int rho) { const int n = rho >> 4, i = rho & 15; return 8 * (i >> 2) + 4 * n + (i & 3); }

struct Unit { int pm, pn; };
struct Gemm { const bf16_t* A; const bf16_t* Bt; int M, N, K; };

struct StaticOrder {
    int nM, nN, nwg, G, c;
    __host__ __device__ void init(int M, int N, int G_, int c_) { nM = M / BM; nN = N / BM; nwg = nM * nN; G = G_; c = c_; }
    __host__ __device__ bool next(int i, Unit& u) const {
        const long L = (long)i * G + c; if (L >= nwg) return false;
        int wgid = (int)L; { const int q = nwg / NXCD, r = nwg % NXCD, xcd = wgid % NXCD, off = wgid / NXCD; wgid = (xcd < r ? xcd * (q + 1) : r * (q + 1) + (xcd - r) * q) + off; }
        const int nig = WGM * nN, gid = wgid / nig, fm = gid * WGM, gsz = (nM - fm) < WGM ? (nM - fm) : WGM;
        u.pm = fm + ((wgid % nig) % gsz); u.pn = (wgid % nig) / gsz; return true;
    }
    __device__ __forceinline__ void a_ready(const Unit&) const {}
    __device__ __forceinline__ void done(const Unit&) const {}
};

__device__ __forceinline__ unsigned cvt_pk_bf16(float lo, float hi) { unsigned r; asm volatile("v_cvt_pk_bf16_f32 %0, %1, %2" : "=v"(r) : "v"(lo), "v"(hi)); return r; }
typedef float f32x2 __attribute__((ext_vector_type(2)));
__device__ __forceinline__ f32x2 gelu_pk(f32x2 v) {
    const f32x2 av = __builtin_elementwise_abs(v), d = av * 0.2316418882f + 1.0f;
    f32x2 t; t.x = __builtin_amdgcn_rcpf(d.x); t.y = __builtin_amdgcn_rcpf(d.y);
    f32x2 q = t * 0.5307027145f + (-0.7265760135f); q = q * t + 0.7107068705f; q = q * t + (-0.142248368f); q = q * t + 0.127414796f; q = q * t;
    const f32x2 s = (v * v) * (-0.72134752044f);
    f32x2 e; e.x = __builtin_amdgcn_exp2f(s.x); e.y = __builtin_amdgcn_exp2f(s.y);
    const f32x2 m = v * (q * e), r = v - m;
    f32x2 o; o.x = v.x < 0.f ? m.x : r.x; o.y = v.y < 0.f ? m.y : r.y; return o;
}

template <int ACT  > struct EpiBf16 {
    static constexpr bool PERM = true, AFTER_DRAIN = false; static_assert(ACT == 0 || ACT == 1, "EpiBf16: ACT is 0 (none) or 1 (gelu_pk)");
    bf16_t* O; int ldc; const float* bias; int split_cols; size_t split_stride; float scale0;
    __device__ __forceinline__ void operator()(const f32x4 (&acc)[2][2][4][2], const Unit& u, int wr, int wc, int fr, int fq) const {
        const int row0 = u.pm * BM + wr * 64 + fr; int colt = u.pn * BM; bf16_t* base = O;
        float sc = 1.f; if (split_cols) { const int t = colt / split_cols; base += (size_t)t * split_stride; colt -= t * split_cols; if (t == 0) sc = scale0; }
        const int col0 = colt + wc * 32 + 8 * fq, bcol0 = u.pn * BM + wc * 32 + 8 * fq;
        f32x4 bv[2][2];
#pragma unroll
        for (int bj = 0; bj < 2; ++bj)
#pragma unroll
            for (int n = 0; n < 2; ++n) bv[bj][n] = bias ? *(const f32x4*)(bias + bcol0 + bj * HALF + 4 * n) : (f32x4){0.f, 0.f, 0.f, 0.f};
#pragma unroll
        for (int ai = 0; ai < 2; ++ai)
#pragma unroll
            for (int m = 0; m < 4; ++m) { bf16_t* rowp = base + (size_t)(row0 + ai * HALF + m * 16) * ldc + col0;
#pragma unroll
                for (int bj = 0; bj < 2; ++bj) { f32x4 v0 = acc[ai][bj][m][0] + bv[bj][0], v1 = acc[ai][bj][m][1] + bv[bj][1];
                    if (ACT == 1) { f32x2 a = gelu_pk((f32x2){v0[0], v0[1]}), b = gelu_pk((f32x2){v0[2], v0[3]}), c = gelu_pk((f32x2){v1[0], v1[1]}), d = gelu_pk((f32x2){v1[2], v1[3]});
                        v0 = (f32x4){a.x, a.y, b.x, b.y}; v1 = (f32x4){c.x, c.y, d.x, d.y}; }
                    v0 = v0 * sc; v1 = v1 * sc; u32x4 w; w.x = cvt_pk_bf16(v0[0], v0[1]); w.y = cvt_pk_bf16(v0[2], v0[3]); w.z = cvt_pk_bf16(v1[0], v1[1]); w.w = cvt_pk_bf16(v1[2], v1[3]);
                    *(u32x4*)(rowp + bj * HALF) = w; } }
    }
};

template <class Epi, class Sched, bool ALIGN_EPI = false, bool SP2 = false>
__device__ __forceinline__ void gemm_phase(PG8_LAS unsigned char* lds, const Gemm g, const Sched& S, const Epi& E) {
    const int tid = threadIdx.x, wid = __builtin_amdgcn_readfirstlane(tid >> 6), lane = tid & 63, wr = wid >> 2, wc = wid & 3, fr = lane & 15, fq = lane >> 4;
    const int K = g.K, nt = K / BK;
    unsigned voffA[2], voffB[2];
#pragma unroll
    for (int i = 0; i < 2; ++i) { int R, C; stage_rc(tid * 16 + i * 8192, R, C); const int Rb = Epi::PERM ? ((R & ~31) + perm32(R & 31)) : R;
        voffA[i] = (unsigned)(R * K + C) * 2u; voffB[i] = (unsigned)(Rb * K + C) * 2u; }
    const size_t kstep = (size_t)(BK * 2);
    const size_t hstep = (size_t)HALF * K * 2;
    const size_t tstep = 2 * hstep;
    const unsigned ldsw = (unsigned)wid * 1024u;
    const int aoff = lds_byte(wr * 64 + fr, fq * 8), boff = lds_byte(wc * 32 + fr, fq * 8);
#define PG8_SA(b, h) (((b) * 2 + (h)) * HTB)
#define PG8_SB(b, h) ((4 + (b) * 2 + (h)) * HTB)
#define PG8_STAGE(bufoff, gbase, voff) do { _Pragma("unroll") for (int _i = 0; _i < 2; ++_i) \
        __builtin_amdgcn_global_load_lds((const unsigned*)((const char*)(gbase) + (voff)[_i]), (PG8_LAS unsigned*)(lds + (bufoff) + ldsw + _i * 8192), 16, 0, 0); } while (0)
#define PG8_LDA(dst, b, h) do { _Pragma("unroll") for (int m = 0; m < 4; ++m) _Pragma("unroll") for (int k = 0; k < 2; ++k) dst[m][k] = *(const PG8_LAS bf16x8*)(lds + PG8_SA(b, h) + aoff + m * 2048 + k * 1024); } while (0)
#define PG8_LDB(dst, b, h) do { _Pragma("unroll") for (int n = 0; n < 2; ++n) _Pragma("unroll") for (int k = 0; k < 2; ++k) dst[n][k] = *(const PG8_LAS bf16x8*)(lds + PG8_SB(b, h) + boff + n * 2048 + k * 1024); } while (0)
#define PG8_MMA(ai, bj, At, Bt) do { __builtin_amdgcn_s_setprio(1); _Pragma("unroll") for (int m = 0; m < 4; ++m) _Pragma("unroll") for (int n = 0; n < 2; ++n) _Pragma("unroll") for (int k = 0; k < 2; ++k) \
        acc[ai][bj][m][n] = __builtin_amdgcn_mfma_f32_16x16x32_bf16(Bt[n][k], At[m][k], acc[ai][bj][m][n], 0, 0, 0); __builtin_amdgcn_s_setprio(0); } while (0)
#define PG8_WAIT_V(n) asm volatile("s_waitcnt vmcnt(" #n ")" ::: "memory")
#define PG8_WAIT_L(n) asm volatile("s_waitcnt lgkmcnt(" #n ")" ::: "memory")
#define PG8_BAR __builtin_amdgcn_s_barrier()
#define PG8_SCHED __builtin_amdgcn_sched_barrier(0)
    Unit cur, nxt; int ui = 0;
    if (!S.next(0, cur)) return;
    f32x4 acc[2][2][4][2];
#pragma unroll
    for (int a = 0; a < 2; ++a)
#pragma unroll
        for (int b = 0; b < 2; ++b)
#pragma unroll
            for (int m = 0; m < 4; ++m)
#pragma unroll
                for (int n = 0; n < 2; ++n) acc[a][b][m][n] = (f32x4){0.f, 0.f, 0.f, 0.f};
    bf16x8 At[4][2], B0[2][2], B1[2][2];
    const char* cA = (const char*)g.A + (size_t)cur.pm * tstep; const char* cB = (const char*)g.Bt + (size_t)cur.pn * tstep;
    S.a_ready(cur);
    if constexpr (SP2) {
        PG8_STAGE(PG8_SB(0, 0), cB, voffB); PG8_STAGE(PG8_SB(0, 1), cB + hstep, voffB); PG8_STAGE(PG8_SA(0, 0), cA, voffA); PG8_STAGE(PG8_SA(0, 1), cA + hstep, voffA);
        if (wr == 1) PG8_BAR;
        PG8_WAIT_V(2); PG8_BAR;
        PG8_STAGE(PG8_SB(1, 0), cB + kstep, voffB); PG8_STAGE(PG8_SA(1, 0), cA + kstep, voffA); PG8_STAGE(PG8_SB(1, 1), cB + hstep + kstep, voffB);
        PG8_WAIT_V(6); PG8_BAR;
    } else {
        PG8_STAGE(PG8_SB(0, 0), cB, voffB); PG8_STAGE(PG8_SA(0, 0), cA, voffA); PG8_STAGE(PG8_SB(0, 1), cB + hstep, voffB); PG8_STAGE(PG8_SA(0, 1), cA + hstep, voffA);
        if (wr == 1) PG8_BAR;
        PG8_WAIT_V(4); PG8_BAR;
        PG8_STAGE(PG8_SB(1, 0), cB + kstep, voffB); PG8_STAGE(PG8_SA(1, 0), cA + kstep, voffA); PG8_STAGE(PG8_SB(1, 1), cB + hstep + kstep, voffB);
        PG8_WAIT_V(6); PG8_BAR;
    }
    for (;;) {
        const bool has_next = S.next(ui + 1, nxt);
        const char* nA = has_next ? (const char*)g.A + (size_t)nxt.pm * tstep : cA; const char* nB = has_next ? (const char*)g.Bt + (size_t)nxt.pn * tstep : cB;
        for (int t = 0; t < nt; t += 2) {
            const bool last = (t == nt - 2);
            const char* a1 = cA + (size_t)(t + 1) * kstep;
            const char* a2 = last ? nA : cA + (size_t)(t + 2) * kstep; const char* b2 = last ? nB : cB + (size_t)(t + 2) * kstep;
            const char* a3 = a2 + kstep; const char* b3 = b2 + kstep;
            if (last && has_next) S.a_ready(nxt);
            if constexpr (SP2) {
            PG8_LDB(B0, 0, 0); PG8_LDB(B1, 0, 1); PG8_SCHED; PG8_LDA(At, 0, 0); PG8_STAGE(PG8_SA(1, 1), a1 + hstep, voffA);
            PG8_WAIT_V(8); PG8_WAIT_L(0); PG8_BAR; PG8_MMA(0, 0, At, B0); PG8_MMA(0, 1, At, B1); PG8_BAR; PG8_SCHED;
            PG8_LDA(At, 0, 1); PG8_STAGE(PG8_SB(0, 0), b2, voffB); PG8_STAGE(PG8_SB(0, 1), b2 + hstep, voffB); PG8_STAGE(PG8_SA(0, 0), a2, voffA);
            PG8_WAIT_V(8); PG8_WAIT_L(0); PG8_BAR; PG8_MMA(1, 0, At, B0); PG8_MMA(1, 1, At, B1); PG8_BAR; PG8_SCHED;
            PG8_LDB(B0, 1, 0); PG8_LDB(B1, 1, 1); PG8_SCHED; PG8_LDA(At, 1, 0); PG8_STAGE(PG8_SA(0, 1), a2 + hstep, voffA);
            PG8_WAIT_V(8); PG8_WAIT_L(0); PG8_BAR; PG8_MMA(0, 0, At, B0); PG8_MMA(0, 1, At, B1); PG8_BAR; PG8_SCHED;
            PG8_LDA(At, 1, 1); PG8_STAGE(PG8_SB(1, 0), b3, voffB); PG8_STAGE(PG8_SB(1, 1), b3 + hstep, voffB); PG8_STAGE(PG8_SA(1, 0), a3, voffA);
            PG8_WAIT_V(8); PG8_WAIT_L(0); PG8_BAR; PG8_MMA(1, 0, At, B0); PG8_MMA(1, 1, At, B1); PG8_BAR; PG8_SCHED;
            } else {
            PG8_LDB(B0, 0, 0); PG8_SCHED; PG8_LDA(At, 0, 0); PG8_STAGE(PG8_SA(1, 1), a1 + hstep, voffA);
            PG8_WAIT_L(8); PG8_BAR; PG8_WAIT_L(0); PG8_MMA(0, 0, At, B0); PG8_BAR; PG8_SCHED;
            PG8_LDB(B1, 0, 1); PG8_STAGE(PG8_SB(0, 0), b2, voffB);
            PG8_BAR; PG8_WAIT_L(0); PG8_MMA(0, 1, At, B1); PG8_BAR;
            PG8_LDA(At, 0, 1); PG8_STAGE(PG8_SA(0, 0), a2, voffA);
            PG8_BAR; PG8_WAIT_L(0); PG8_MMA(1, 0, At, B0); PG8_BAR; PG8_SCHED;
            PG8_STAGE(PG8_SB(0, 1), b2 + hstep, voffB);
            PG8_WAIT_V(6); PG8_BAR; PG8_MMA(1, 1, At, B1); PG8_BAR;
            PG8_LDB(B0, 1, 0); PG8_SCHED; PG8_LDA(At, 1, 0); PG8_STAGE(PG8_SA(0, 1), a2 + hstep, voffA);
            PG8_WAIT_L(8); PG8_BAR; PG8_WAIT_L(0); PG8_MMA(0, 0, At, B0); PG8_BAR; PG8_SCHED;
            PG8_LDB(B1, 1, 1); PG8_STAGE(PG8_SB(1, 0), b3, voffB);
            PG8_BAR; PG8_WAIT_L(0); PG8_MMA(0, 1, At, B1); PG8_BAR;
            PG8_LDA(At, 1, 1); PG8_STAGE(PG8_SA(1, 0), a3, voffA);
            PG8_BAR; PG8_WAIT_L(0); PG8_MMA(1, 0, At, B0); PG8_BAR; PG8_SCHED;
            PG8_STAGE(PG8_SB(1, 1), b3 + hstep, voffB);
            PG8_WAIT_V(6); PG8_BAR; PG8_MMA(1, 1, At, B1); PG8_BAR;
            }
        }
        if constexpr (ALIGN_EPI) { if (wr == 0) PG8_BAR; }
        if constexpr (!Epi::AFTER_DRAIN) { E(acc, cur, wr, wc, fr, fq); S.done(cur); }
        if (!has_next) break;
#pragma unroll
        for (int a = 0; a < 2; ++a)
#pragma unroll
            for (int b = 0; b < 2; ++b)
#pragma unroll
                for (int m = 0; m < 4; ++m)
#pragma unroll
                    for (int n = 0; n < 2; ++n) acc[a][b][m][n] = (f32x4){0.f, 0.f, 0.f, 0.f};
        cur = nxt; cA = nA; cB = nB; ++ui;
        if constexpr (ALIGN_EPI) { if (wr == 1) PG8_BAR; }
    }
    PG8_WAIT_V(0);
    if constexpr (!ALIGN_EPI) { if (wr == 0) PG8_BAR; }
    PG8_BAR;
    if constexpr (Epi::AFTER_DRAIN) { E.fused(acc, cur, wr, wc, fr, fq, lds, wid, lane); S.done(cur); }
#undef PG8_SA
#undef PG8_SB
#undef PG8_STAGE
#undef PG8_LDA
#undef PG8_LDB
#undef PG8_MMA
#undef PG8_WAIT_V
#undef PG8_WAIT_L
#undef PG8_BAR
#undef PG8_SCHED
}
}

#ifndef PG8_SP2
#define PG8_SP2 true
#endif

namespace pg8 {
template <class Epi, class Sched>
__device__ __forceinline__ void gemm_phase_gather(PG8_LAS unsigned char* lds, const Gemm g, const Sched& S, const Epi& E, const PG8_LAS unsigned* rofs) {
    const int tid = threadIdx.x, wid = __builtin_amdgcn_readfirstlane(tid >> 6), lane = tid & 63, wr = wid >> 2, wc = wid & 3, fr = lane & 15, fq = lane >> 4;
    const int K = g.K, nt = K / BK;
    unsigned voffB[2]; int RA[2]; unsigned CA[2];
#pragma unroll
    for (int i = 0; i < 2; ++i) { int R, C; stage_rc(tid * 16 + i * 8192, R, C); const int Rb = Epi::PERM ? ((R & ~31) + perm32(R & 31)) : R;
        RA[i] = R; CA[i] = (unsigned)C * 2u; voffB[i] = (unsigned)(Rb * K + C) * 2u; }
    const size_t kstep = (size_t)(BK * 2);
    const size_t hstep = (size_t)HALF * K * 2;
    const size_t tstep = 2 * hstep;
    const unsigned ldsw = (unsigned)wid * 1024u;
    const int aoff = lds_byte(wr * 64 + fr, fq * 8), boff = lds_byte(wc * 32 + fr, fq * 8);
#define PG8_SA(b, h) (((b) * 2 + (h)) * HTB)
#define PG8_SB(b, h) ((4 + (b) * 2 + (h)) * HTB)
#define PG8_STAGE(bufoff, gbase, voff) do { _Pragma("unroll") for (int _i = 0; _i < 2; ++_i) \
        __builtin_amdgcn_global_load_lds((const unsigned*)((const char*)(gbase) + (voff)[_i]), (PG8_LAS unsigned*)(lds + (bufoff) + ldsw + _i * 8192), 16, 0, 0); } while (0)
#define PG8_STAGE_A(bufoff, koff, v0, v1) do { \
        __builtin_amdgcn_global_load_lds((const unsigned*)((const char*)g.A + (koff) + (v0)), (PG8_LAS unsigned*)(lds + (bufoff) + ldsw), 16, 0, 0); \
        __builtin_amdgcn_global_load_lds((const unsigned*)((const char*)g.A + (koff) + (v1)), (PG8_LAS unsigned*)(lds + (bufoff) + ldsw + 8192), 16, 0, 0); } while (0)
#define PG8_LDA(dst, b, h) do { _Pragma("unroll") for (int m = 0; m < 4; ++m) _Pragma("unroll") for (int k = 0; k < 2; ++k) dst[m][k] = *(const PG8_LAS bf16x8*)(lds + PG8_SA(b, h) + aoff + m * 2048 + k * 1024); } while (0)
#define PG8_LDB(dst, b, h) do { _Pragma("unroll") for (int n = 0; n < 2; ++n) _Pragma("unroll") for (int k = 0; k < 2; ++k) dst[n][k] = *(const PG8_LAS bf16x8*)(lds + PG8_SB(b, h) + boff + n * 2048 + k * 1024); } while (0)
#define PG8_MMA(ai, bj, At, Bt) do { __builtin_amdgcn_s_setprio(1); _Pragma("unroll") for (int m = 0; m < 4; ++m) _Pragma("unroll") for (int n = 0; n < 2; ++n) _Pragma("unroll") for (int k = 0; k < 2; ++k) \
        acc[ai][bj][m][n] = __builtin_amdgcn_mfma_f32_16x16x32_bf16(Bt[n][k], At[m][k], acc[ai][bj][m][n], 0, 0, 0); __builtin_amdgcn_s_setprio(0); } while (0)
#define PG8_WAIT_V(n) asm volatile("s_waitcnt vmcnt(" #n ")" ::: "memory")
#define PG8_WAIT_L(n) asm volatile("s_waitcnt lgkmcnt(" #n ")" ::: "memory")
#define PG8_BAR __builtin_amdgcn_s_barrier()
#define PG8_SCHED __builtin_amdgcn_sched_barrier(0)
    Unit cur, nxt; int ui = 0;
    if (!S.next(0, cur)) return;
    f32x4 acc[2][2][4][2];
#pragma unroll
    for (int a = 0; a < 2; ++a)
#pragma unroll
        for (int b = 0; b < 2; ++b)
#pragma unroll
            for (int m = 0; m < 4; ++m)
#pragma unroll
                for (int n = 0; n < 2; ++n) acc[a][b][m][n] = (f32x4){0.f, 0.f, 0.f, 0.f};
    bf16x8 At[4][2], B0[2][2], B1[2][2];
    const char* cB = (const char*)g.Bt + (size_t)cur.pn * tstep;
    unsigned vc00 = rofs[RA[0]] + CA[0], vc01 = rofs[RA[1]] + CA[1], vc10 = rofs[128 + RA[0]] + CA[0], vc11 = rofs[128 + RA[1]] + CA[1];
    unsigned vn00 = vc00, vn01 = vc01, vn10 = vc10, vn11 = vc11;
    PG8_WAIT_L(0);
    PG8_STAGE(PG8_SB(0, 0), cB, voffB); PG8_STAGE(PG8_SB(0, 1), cB + hstep, voffB); PG8_STAGE_A(PG8_SA(0, 0), 0, vc00, vc01); PG8_STAGE_A(PG8_SA(0, 1), 0, vc10, vc11);
    if (wr == 1) PG8_BAR;
    PG8_WAIT_V(2); PG8_BAR;
    PG8_STAGE(PG8_SB(1, 0), cB + kstep, voffB); PG8_STAGE_A(PG8_SA(1, 0), kstep, vc00, vc01); PG8_STAGE(PG8_SB(1, 1), cB + hstep + kstep, voffB);
    PG8_WAIT_V(6); PG8_BAR;
    for (;;) {
        const bool has_next = S.next(ui + 1, nxt);
        const char* nB = has_next ? (const char*)g.Bt + (size_t)nxt.pn * tstep : cB;
        if (has_next) { const PG8_LAS unsigned* rn = rofs + (ui + 1) * 256; vn00 = rn[RA[0]] + CA[0]; vn01 = rn[RA[1]] + CA[1]; vn10 = rn[128 + RA[0]] + CA[0]; vn11 = rn[128 + RA[1]] + CA[1]; }
        else { vn00 = vc00; vn01 = vc01; vn10 = vc10; vn11 = vc11; }
        for (int t = 0; t < nt; t += 2) {
            const bool last = (t == nt - 2);
            const size_t k1 = (size_t)(t + 1) * kstep;
            const size_t k2 = last ? 0 : (size_t)(t + 2) * kstep; const char* b2 = last ? nB : cB + (size_t)(t + 2) * kstep;
            const size_t k3 = k2 + kstep; const char* b3 = b2 + kstep;
            const unsigned w00 = last ? vn00 : vc00, w01 = last ? vn01 : vc01, w10 = last ? vn10 : vc10, w11 = last ? vn11 : vc11;
            PG8_LDB(B0, 0, 0); PG8_LDB(B1, 0, 1); PG8_SCHED; PG8_LDA(At, 0, 0); PG8_STAGE_A(PG8_SA(1, 1), k1, vc10, vc11);
            PG8_WAIT_V(8); PG8_WAIT_L(0); PG8_BAR; PG8_MMA(0, 0, At, B0); PG8_MMA(0, 1, At, B1); PG8_BAR; PG8_SCHED;
            PG8_LDA(At, 0, 1); PG8_STAGE(PG8_SB(0, 0), b2, voffB); PG8_STAGE(PG8_SB(0, 1), b2 + hstep, voffB); PG8_STAGE_A(PG8_SA(0, 0), k2, w00, w01);
            PG8_WAIT_V(8); PG8_WAIT_L(0); PG8_BAR; PG8_MMA(1, 0, At, B0); PG8_MMA(1, 1, At, B1); PG8_BAR; PG8_SCHED;
            PG8_LDB(B0, 1, 0); PG8_LDB(B1, 1, 1); PG8_SCHED; PG8_LDA(At, 1, 0); PG8_STAGE_A(PG8_SA(0, 1), k2, w10, w11);
            PG8_WAIT_V(8); PG8_WAIT_L(0); PG8_BAR; PG8_MMA(0, 0, At, B0); PG8_MMA(0, 1, At, B1); PG8_BAR; PG8_SCHED;
            PG8_LDA(At, 1, 1); PG8_STAGE(PG8_SB(1, 0), b3, voffB); PG8_STAGE(PG8_SB(1, 1), b3 + hstep, voffB); PG8_STAGE_A(PG8_SA(1, 0), k3, w00, w01);
            PG8_WAIT_V(8); PG8_WAIT_L(0); PG8_BAR; PG8_MMA(1, 0, At, B0); PG8_MMA(1, 1, At, B1); PG8_BAR; PG8_SCHED;
        }
        if (wr == 0) PG8_BAR;
        E(acc, cur, wr, wc, fr, fq); S.done(cur);
        if (!has_next) break;
#pragma unroll
        for (int a = 0; a < 2; ++a)
#pragma unroll
            for (int b = 0; b < 2; ++b)
#pragma unroll
                for (int m = 0; m < 4; ++m)
#pragma unroll
                    for (int n = 0; n < 2; ++n) acc[a][b][m][n] = (f32x4){0.f, 0.f, 0.f, 0.f};
        cur = nxt; cB = nB; ++ui; vc00 = vn00; vc01 = vn01; vc10 = vn10; vc11 = vn11;
        if (wr == 1) PG8_BAR;
    }
    PG8_WAIT_V(0);
    PG8_BAR;
#undef PG8_SA
#undef PG8_SB
#undef PG8_STAGE
#undef PG8_STAGE_A
#undef PG8_LDA
#undef PG8_LDB
#undef PG8_MMA
#undef PG8_WAIT_V
#undef PG8_WAIT_L
#undef PG8_BAR
#undef PG8_SCHED
}
}

constexpr int NB = 2, SEQ = 8192, DM = 1024, NTOK = NB * SEQ;
constexpr int NPROJ = 3072;
constexpr int C_GQ = 0, C_GK = 256, C_GV = 512, C_GR = 1024, C_NQ = 1536, C_KC = 2048, C_VC = 2176, C_KS = 2304, C_VS = 2432, C_KW = 2560, C_VW = 2688, C_GLR = 2816, C_NG = 2832, C_END = 2856;
constexpr int SGW = 2048;
constexpr int NEXP = 16, EHID = 512;
constexpr int MOE_ROWS = 36864;
constexpr float NORM_EPS = 1e-6f;
constexpr float NEGBIG = -1e30f;

constexpr size_t MiB = 1u << 20;
constexpr size_t WS_CTL = 0, CTL_ZERO_BYTES = 1 * MiB;
constexpr size_t WS_MOD = 1 * MiB;
constexpr size_t WS_ROUTE = 2 * MiB;
constexpr size_t WS_GATES = 3 * MiB;
constexpr size_t WS_STATS = 5 * MiB;
constexpr size_t WS_DEC = 7 * MiB;
constexpr size_t WS_WIN = 8 * MiB;
constexpr size_t WS_WOUT = 14 * MiB;
constexpr size_t WS_WINC = 16 * MiB;
constexpr size_t WS_WOUTC = 24 * MiB;
constexpr size_t WS_WCW1 = 28 * MiB;
constexpr size_t WS_WGU = 30 * MiB;
constexpr size_t WS_WDN = 94 * MiB;
constexpr size_t WS_A = 126 * MiB;
constexpr size_t WS_O = 254 * MiB;
constexpr size_t WS_END = 318 * MiB;
constexpr size_t A_HID_OFF = 72 * MiB;
constexpr size_t DO_QN = 0;
constexpr size_t DO_KSEL = 16 * MiB, DO_VSEL = 20 * MiB, DO_KWIN = 24 * MiB, DO_VWIN = 28 * MiB;
constexpr size_t DO_KC = 32 * MiB, DO_VC = 36 * MiB + 65536;
constexpr size_t DO_KCMP = 41 * MiB, DO_VCMP = 41 * MiB + 512 * 1024;

constexpr int CW_TMO = 0, CW_CODE = 1;
constexpr int CW_BAR = 4096;
constexpr int CW_CNT = 16384;

constexpr int RING_OFF = 0, RING_BYTES = 131072;
constexpr int LDSCTL_OFF = RING_BYTES, MISC_OFF = LDSCTL_OFF + 320;
constexpr int TAB_OFF = LDSCTL_OFF + 1024;
constexpr int LDS_BYTES = 147456;

#define GAS __attribute__((address_space(1)))
#define LAS __attribute__((address_space(3)))
typedef unsigned short bf16;
typedef unsigned v4u __attribute__((ext_vector_type(4)));
typedef unsigned v2u __attribute__((ext_vector_type(2)));
typedef float f32x4 __attribute__((ext_vector_type(4)));
typedef float f32x2 __attribute__((ext_vector_type(2)));
typedef float f32x16 __attribute__((ext_vector_type(16)));
typedef short bf16x8 __attribute__((ext_vector_type(8)));
typedef short s16x4 __attribute__((ext_vector_type(4)));
typedef GAS unsigned gu32;
#define RLX_AGENT __ATOMIC_RELAXED, __HIP_MEMORY_SCOPE_AGENT
#define LDS_WAIT() asm volatile("s_waitcnt lgkmcnt(0)" ::: "memory")
#define VM_WAIT() asm volatile("s_waitcnt vmcnt(0)" ::: "memory")
__device__ __forceinline__ unsigned f2bf(float f) { unsigned u = __builtin_bit_cast(unsigned, f); return (u + 0x7fffu + ((u >> 16) & 1u)) >> 16; }
__device__ __forceinline__ unsigned pk2(float lo, float hi) { return f2bf(lo) | (f2bf(hi) << 16); }
__device__ __forceinline__ float bf2f(unsigned short b) { return __builtin_bit_cast(float, (unsigned)b << 16); }
__device__ __forceinline__ float bflo(unsigned w) { return __builtin_bit_cast(float, w << 16); }
__device__ __forceinline__ float bfhi(unsigned w) { return __builtin_bit_cast(float, w & 0xffff0000u); }
__device__ __forceinline__ float fexp2(float x) { return __builtin_amdgcn_exp2f(x); }
__device__ __forceinline__ float fexp(float x) { return __builtin_amdgcn_exp2f(x * 1.4426950408889634f); }
__device__ __forceinline__ float frcp(float x) { return __builtin_amdgcn_rcpf(x); }
__device__ __forceinline__ float sigmoidf_(float x) { return frcp(1.0f + __expf(-x)); }
__device__ __forceinline__ float siluf_(float x) { return x * frcp(1.0f + __expf(-x)); }
__device__ __forceinline__ float gelu_tanh(float x) {
    const float u = 0.7978845608028654f * (x + 0.044715f * x * x * x);
    return x * frcp(1.0f + __expf(-2.0f * u));
}
__device__ __forceinline__ float dpp_xor1(float v) { return __builtin_bit_cast(float, __builtin_amdgcn_mov_dpp(__builtin_bit_cast(int, v), 0xB1, 0xF, 0xF, true)); }
__device__ __forceinline__ float dpp_xor2(float v) { return __builtin_bit_cast(float, __builtin_amdgcn_mov_dpp(__builtin_bit_cast(int, v), 0x4E, 0xF, 0xF, true)); }
__device__ __forceinline__ float wave_sum(float v) {
#pragma unroll
    for (int o = 1; o < 64; o <<= 1) v += __shfl_xor(v, o);
    return v;
}
__device__ __forceinline__ void unpack8(const v4u w, float (&f)[8]) {
    f[0] = bflo(w.x); f[1] = bfhi(w.x); f[2] = bflo(w.y); f[3] = bfhi(w.y); f[4] = bflo(w.z); f[5] = bfhi(w.z); f[6] = bflo(w.w); f[7] = bfhi(w.w);
}
__device__ __forceinline__ v4u pack8(const float (&f)[8]) { v4u w; w.x = pk2(f[0], f[1]); w.y = pk2(f[2], f[3]); w.z = pk2(f[4], f[5]); w.w = pk2(f[6], f[7]); return w; }

#define XB_TMO      128
#define XB_XCNT(j)  (256  + 64 * (j))
#define XB_XSUB(j)  (1280 + 64 * (j))
#define XB_XGEN(j)  (2304 + 64 * (j))
#define XB_TOP      3328
#define XB_TOPGEN   3392
#define XCD_BAR_WORDS 3456
#define XB_SPIN_CAP (1u << 18)

__device__ __forceinline__ unsigned xb_ld(unsigned* p)              { return __hip_atomic_load(p, __ATOMIC_RELAXED, __HIP_MEMORY_SCOPE_AGENT); }
__device__ __forceinline__ unsigned xb_add(unsigned* p, unsigned v) { return __hip_atomic_fetch_add(p, v, __ATOMIC_RELAXED, __HIP_MEMORY_SCOPE_AGENT); }
__device__ __forceinline__ unsigned xb_xcc_id() { return (unsigned)__builtin_amdgcn_s_getreg((3 << 11) | 20) & 0xFu; }
#define XB_SPIN(cond, bar) do { unsigned _sp = 0; while (cond) { __builtin_amdgcn_s_sleep(1); \
    if ((++_sp & 255u) == 0u) { if (xb_ld(&(bar)[XB_TMO])) break; if (_sp > XB_SPIN_CAP) { atomicAdd(&(bar)[XB_TMO], 1u); break; } } } } while (0)

struct XcdBarrier {
    unsigned* bar; unsigned x;
    volatile LAS unsigned* st;
};
__device__ __forceinline__ XcdBarrier xcd_barrier_post(unsigned* bar, volatile LAS unsigned* st) {
    XcdBarrier b; b.bar = bar; b.x = xb_xcc_id(); b.st = st;
    if (threadIdx.x == 0) (void)xb_add(&bar[XB_XCNT(b.x)], 1u);
    return b;
}
__device__ __forceinline__ void xcd_barrier_complete(unsigned* bar, unsigned x, unsigned& nloc, unsigned& nx) {
    const unsigned G = gridDim.x * gridDim.y * gridDim.z;
    unsigned sum, cnt, mine, sp = 0u;
    for (;;) {
        sum = 0u; cnt = 0u; mine = 0u;
#pragma unroll
        for (unsigned j = 0; j < 16; ++j) { const unsigned c = xb_ld(&bar[XB_XCNT(j)]); sum += c; cnt += (c > 0u) ? 1u : 0u; mine = (j == x) ? c : mine; }
        if (sum == G) break;
        __builtin_amdgcn_s_sleep(1);
        if ((++sp & 255u) == 0u) { if (xb_ld(&bar[XB_TMO])) break; if (sp > XB_SPIN_CAP) { atomicAdd(&bar[XB_TMO], 1u); break; } }
    }
    nloc = mine > 0u ? mine : 1u; nx = cnt > 0u ? cnt : 1u;
}
__device__ __forceinline__ void xcd_barrier(const XcdBarrier& b) {
    asm volatile("s_waitcnt vmcnt(0)" ::: "memory");
    __syncthreads();
    if (threadIdx.x == 0) {
        unsigned* bar = b.bar;
        __builtin_amdgcn_s_waitcnt(0);
        unsigned nloc = b.st[0], nx = b.st[1];
        if (nloc == 0u) { xcd_barrier_complete(bar, b.x, nloc, nx); b.st[0] = nloc; b.st[1] = nx; }
        const unsigned old = xb_add(&bar[XB_XSUB(b.x)], 1u);
        const unsigned gen = old / nloc;
        if (old + 1u == (gen + 1u) * nloc) {
            __builtin_amdgcn_fence(__ATOMIC_RELEASE, "agent");
            asm volatile("s_waitcnt vmcnt(0)" ::: "memory");
            const unsigned og = xb_add(&bar[XB_TOP], 1u);
            const unsigned tg = og / nx;
            if (og + 1u == (tg + 1u) * nx) xb_add(&bar[XB_TOPGEN], 1u);
            else XB_SPIN(xb_ld(&bar[XB_TOPGEN]) == tg, bar);
            __builtin_amdgcn_fence(__ATOMIC_ACQUIRE, "agent");
            xb_add(&bar[XB_XGEN(b.x)], 1u);
            asm volatile("s_waitcnt vmcnt(0)" ::: "memory");
        } else {
            XB_SPIN(xb_ld(&bar[XB_XGEN(b.x)]) == gen, bar);
            __builtin_amdgcn_fence(__ATOMIC_ACQUIRE, "agent");
            asm volatile("s_waitcnt vmcnt(0)" ::: "memory");
        }
    }
    __syncthreads();
}

struct Frame {
    LAS unsigned char* lds;
    volatile LAS unsigned* MISC;
    gu32* ctl;
    int tid, lane, wave;
    int bid, G;
    unsigned char* ws;
    unsigned char* dout_b;
    float* out;
    const float *x, *c, *w_ada, *b_ada, *norm_g, *w_in_ab, *w_out_ab, *gla_w2, *gla_bg, *gla_ng, *q_gain, *k_gain, *cmp_pe, *cmp_w1, *cmp_w2, *w_in_c, *sgu_ng, *sgu_ws, *sgu_bs, *w_out_c, *w_router, *r_bias, *w_gate, *w_up, *w_down;
    const int* positions;
};

struct EpiResid {
    static constexpr bool PERM = false, AFTER_DRAIN = false;
    const float* xin; float* xout; const float* gate;
    __device__ __forceinline__ void operator()(const pg8::f32x4 (&acc)[2][2][4][2], const pg8::Unit& u, int wr, int wc, int fr, int fq) const {
        const int row0 = u.pm * 256 + wr * 64 + fr, col0 = u.pn * 256 + wc * 32 + 4 * fq;
        const float* gb = gate + ((u.pm * 256 >= SEQ) ? 6144 : 0);
        f32x4 gv[2][2];
#pragma unroll
        for (int bj = 0; bj < 2; ++bj)
#pragma unroll
            for (int n = 0; n < 2; ++n) gv[bj][n] = *(const f32x4*)(gb + col0 + bj * 128 + n * 16);
#pragma unroll
        for (int ai = 0; ai < 2; ++ai)
#pragma unroll
            for (int m = 0; m < 4; ++m) {
                const size_t rb = (size_t)(row0 + ai * 128 + m * 16) * DM;
#pragma unroll
                for (int bj = 0; bj < 2; ++bj)
#pragma unroll
                    for (int n = 0; n < 2; ++n) {
                        const size_t p = rb + col0 + bj * 128 + n * 16;
                        const f32x4 xi = *(const f32x4*)(xin + p);
                        *(f32x4*)(xout + p) = xi + gv[bj][n] * acc[ai][bj][m][n];
                    }
            }
    }
};
struct EpiGeluStats {
    static constexpr bool PERM = true, AFTER_DRAIN = false;
    bf16* Z; float* stats;
    __device__ __forceinline__ void operator()(const pg8::f32x4 (&acc)[2][2][4][2], const pg8::Unit& u, int wr, int wc, int fr, int fq) const {
        const int row0 = u.pm * 256 + wr * 64 + fr, col0 = u.pn * 256 + wc * 32 + 8 * fq;
#pragma unroll
        for (int ai = 0; ai < 2; ++ai)
#pragma unroll
            for (int m = 0; m < 4; ++m) {
                const int row = row0 + ai * 128 + m * 16; float ss = 0.f;
#pragma unroll
                for (int bj = 0; bj < 2; ++bj) {
                    float g[8];
#pragma unroll
                    for (int n = 0; n < 2; ++n)
#pragma unroll
                        for (int i = 0; i < 4; ++i) { g[n * 4 + i] = gelu_tanh(acc[ai][bj][m][n][i]); ss += g[n * 4 + i] * g[n * 4 + i]; }
                    *(v4u*)(Z + (size_t)row * 4096 + col0 + bj * 128) = pack8(g);
                }
                if (u.pn >= 8) {
                    ss += __shfl_xor(ss, 16); ss += __shfl_xor(ss, 32);
                    if (fq == 0) stats[(size_t)row * 32 + (u.pn - 8) * 4 + wc] = ss;
                }
            }
    }
};
struct EpiMoeGU {
    static constexpr bool PERM = true, AFTER_DRAIN = false;
    bf16* HID;
    __device__ __forceinline__ void operator()(const pg8::f32x4 (&acc)[2][2][4][2], const pg8::Unit& u, int wr, int wc, int fr, int fq) const {
        const int row0 = u.pm * 256 + wr * 64 + fr, col0 = (u.pn & 3) * 128 + wc * 32 + 8 * fq;
#pragma unroll
        for (int ai = 0; ai < 2; ++ai)
#pragma unroll
            for (int m = 0; m < 4; ++m) {
                float h[8];
#pragma unroll
                for (int n = 0; n < 2; ++n)
#pragma unroll
                    for (int i = 0; i < 4; ++i) h[n * 4 + i] = siluf_(acc[ai][0][m][n][i]) * acc[ai][1][m][n][i];
                *(v4u*)(HID + (size_t)(row0 + ai * 128 + m * 16) * EHID + col0) = pack8(h);
            }
    }
};
struct EpiMoeDn {
    static constexpr bool PERM = true, AFTER_DRAIN = false;
    bf16* YM;
    __device__ __forceinline__ void operator()(const pg8::f32x4 (&acc)[2][2][4][2], const pg8::Unit& u, int wr, int wc, int fr, int fq) const {
        const int row0 = u.pm * 256 + wr * 64 + fr, col0 = (u.pn & 3) * 256 + wc * 32 + 8 * fq;
#pragma unroll
        for (int ai = 0; ai < 2; ++ai)
#pragma unroll
            for (int m = 0; m < 4; ++m)
#pragma unroll
                for (int bj = 0; bj < 2; ++bj) {
                    float h[8];
#pragma unroll
                    for (int n = 0; n < 2; ++n)
#pragma unroll
                        for (int i = 0; i < 4; ++i) h[n * 4 + i] = acc[ai][bj][m][n][i];
                    *(v4u*)(YM + (size_t)(row0 + ai * 128 + m * 16) * DM + col0 + bj * 128) = pack8(h);
                }
    }
};
struct MoeOrder {
    const LAS int* ppre; int G, c;
    __device__ __forceinline__ unsigned row_off(const pg8::Unit& u, int r, const int* elist) const {
        const int e = u.pn >> 2, li = (u.pm - ppre[e]) * 256 + r;
        const int tok = (li < ppre[32 + e]) ? elist[e * 16384 + li] : 0;
        return (unsigned)tok * 2048u;
    }
    __device__ __forceinline__ bool next(int i, pg8::Unit& u) const {
        const int L = i * G + c, np = ppre[16];
        if (L >= np * 4) return false;
        const int pm = L >> 2; int e = 0;
#pragma unroll
        for (int k = 1; k < 16; ++k) e += (ppre[k] <= pm) ? 1 : 0;
        u.pm = pm; u.pn = e * 4 + (L & 3); return true;
    }
    __device__ __forceinline__ void a_ready(const pg8::Unit&) const {}
    __device__ __forceinline__ void done(const pg8::Unit&) const {}
};

__device__ __forceinline__ int dest_row(int mode, int n) {
    if (mode == 1) return (n < 1024) ? n : (n < 1040) ? n + 1792 : (n < 2832) ? n - 16 : n;
    if (mode == 2) return (n >> 7) * 256 + (n & 127);
    if (mode == 3) return (n >> 7) * 256 + 128 + (n & 127);
    return n;
}
struct TrItem { const float* src; bf16* dst; int K, N, mode, r; };
__device__ __forceinline__ int tr_count(int set) { return set == 0 ? (720 + 256 + 256 + 3 * 2048) : set == 1 ? (1024 + 512 + 2048 + 1024) : (1024 + 2048); }
__device__ __forceinline__ bool tr_decode(Frame& F, int set, int it, TrItem& t) {
    if (it >= tr_count(set)) return false;
    int r = it; t.mode = 0;
    if (set == 0) {
        constexpr int I_IN = 16 * 45, I_OUT = 16 * 16, I_CW1 = 2 * 32 * 4, I_E = 16 * 128;
        if (r < I_IN) { t.src = F.w_in_ab; t.dst = (bf16*)(F.ws + WS_WIN); t.K = 1024; t.N = 2856; t.mode = 1; }
        else if ((r -= I_IN) < I_OUT) { t.src = F.w_out_ab; t.dst = (bf16*)(F.ws + WS_WOUT); t.K = 1024; t.N = 1024; }
        else if ((r -= I_OUT) < I_CW1) { const int m = r >> 7; r &= 127; t.src = F.cmp_w1 + (size_t)m * 2048 * 256; t.dst = (bf16*)(F.ws + WS_WCW1) + (size_t)m * 256 * 2048; t.K = 2048; t.N = 256; }
        else if ((r -= I_CW1) < I_E) { const int m = r >> 7; r &= 127; t.src = F.w_gate + (size_t)m * 1024 * 512; t.dst = (bf16*)(F.ws + WS_WGU) + (size_t)m * 1024 * 1024; t.K = 1024; t.N = 512; t.mode = 2; }
        else if ((r -= I_E) < I_E) { const int m = r >> 7; r &= 127; t.src = F.w_up + (size_t)m * 1024 * 512; t.dst = (bf16*)(F.ws + WS_WGU) + (size_t)m * 1024 * 1024; t.K = 1024; t.N = 512; t.mode = 3; }
        else { r -= I_E; const int m = r >> 7; r &= 127; t.src = F.w_down + (size_t)m * 512 * 1024; t.dst = (bf16*)(F.ws + WS_WDN) + (size_t)m * 1024 * 512; t.K = 512; t.N = 1024; }
    } else if (set == 1) {
        constexpr int I_INC = 16 * 64, I_OUTC = 32 * 16;
        if (r < I_INC) { t.src = F.w_in_c; t.dst = (bf16*)(F.ws + WS_WINC); t.K = 1024; t.N = 4096; }
        else if ((r -= I_INC) < I_OUTC) { t.src = F.w_out_c; t.dst = (bf16*)(F.ws + WS_WOUTC); t.K = 2048; t.N = 1024; }
        else if ((r -= I_OUTC) < 2048) { const int m = 16 + (r >> 7); r &= 127; t.src = F.w_gate + (size_t)m * 1024 * 512; t.dst = (bf16*)(F.ws + WS_WGU) + (size_t)m * 1024 * 1024; t.K = 1024; t.N = 512; t.mode = 2; }
        else { r -= 2048; const int m = 16 + (r >> 7); r &= 127; t.src = F.w_up + (size_t)m * 1024 * 512; t.dst = (bf16*)(F.ws + WS_WGU) + (size_t)m * 1024 * 1024; t.K = 1024; t.N = 512; t.mode = 3; }
    } else {
        constexpr int I_E = 8 * 128;
        if (r < I_E) { const int m = 24 + (r >> 7); r &= 127; t.src = F.w_up + (size_t)m * 1024 * 512; t.dst = (bf16*)(F.ws + WS_WGU) + (size_t)m * 1024 * 1024; t.K = 1024; t.N = 512; t.mode = 3; }
        else { r -= I_E; const int m = 16 + (r >> 7); r &= 127; t.src = F.w_down + (size_t)m * 512 * 1024; t.dst = (bf16*)(F.ws + WS_WDN) + (size_t)m * 1024 * 512; t.K = 512; t.N = 1024; }
    }
    t.r = r; return true;
}
__device__ __forceinline__ void tr_load(const TrItem& t, int lane, f32x4 (&va)[8], f32x4 (&vb)[8]) {
    const int nblk = (t.N + 63) / 64, kb = t.r / nblk, nb = t.r % nblk, k0 = 64 * kb, n0 = 64 * nb;
    const int q = lane & 15, r4 = lane >> 4, col = n0 + 4 * q;
    const float* wp = t.src + (size_t)(k0 + 2 * r4) * t.N + col;
#pragma unroll
    for (int i = 0; i < 8; ++i) {
        if (col < t.N) { va[i] = *(const f32x4*)(wp + (size_t)(8 * i) * t.N); vb[i] = *(const f32x4*)(wp + (size_t)(8 * i + 1) * t.N); }
        else { va[i] = (f32x4){0.f, 0.f, 0.f, 0.f}; vb[i] = va[i]; }
    }
}
__device__ __forceinline__ void tr_finish(const TrItem& t, int lane, const f32x4 (&va)[8], const f32x4 (&vb)[8], LAS unsigned char* scr) {
    const int nblk = (t.N + 63) / 64, kb = t.r / nblk, nb = t.r % nblk, k0 = 64 * kb, n0 = 64 * nb;
    const int q = lane & 15, r4 = lane >> 4;
#pragma unroll
    for (int i = 0; i < 8; ++i) {
        const int kp = 4 * i + r4;
        LAS unsigned* tt = (LAS unsigned*)(scr + (4 * q) * 144 + 4 * kp);
        tt[0] = pk2(va[i].x, vb[i].x); tt[36] = pk2(va[i].y, vb[i].y); tt[72] = pk2(va[i].z, vb[i].z); tt[108] = pk2(va[i].w, vb[i].w);
    }
    LDS_WAIT(); asm volatile("" ::: "memory");
    const int c = lane & 7;
#pragma unroll
    for (int j = 0; j < 8; ++j) { const int n = (lane >> 3) + 8 * j;
        const v4u o = *(const LAS v4u*)(scr + n * 144 + 16 * c);
        if (n0 + n < t.N) *(GAS v4u*)(t.dst + (size_t)dest_row(t.mode, n0 + n) * t.K + k0 + 8 * c) = o; }
    LDS_WAIT(); asm volatile("" ::: "memory");
}
__device__ __forceinline__ void tr_run(Frame& F, int set, int w0, int nw) {
    LAS unsigned char* scr = F.lds + RING_OFF + 8192 + F.wave * 12288;
    TrItem ta, tb; f32x4 a0[8], a1[8], b0[8], b1[8];
    int it = w0; bool ha = tr_decode(F, set, it, ta);
    if (ha) tr_load(ta, F.lane, a0, a1);
    while (ha) {
        const bool hb = tr_decode(F, set, it + nw, tb);
        if (hb) tr_load(tb, F.lane, b0, b1);
        tr_finish(ta, F.lane, a0, a1, scr);
        if (!hb) break;
        it += 2 * nw; ha = tr_decode(F, set, it, ta);
        if (ha) tr_load(ta, F.lane, a0, a1);
        tr_finish(tb, F.lane, b0, b1, scr);
    }
}
__device__ __forceinline__ void p0_prologue(Frame& F) {
    LAS float* red = (LAS float*)(F.lds + RING_OFF);
    float* mod = (float*)(F.ws + WS_MOD);
    float* bias1 = (float*)(F.ws + WS_MOD + 131072);
    for (int bi = F.bid; bi < 200; bi += F.G) {
        if (bi < 192) {
            const int l = bi / 96, cg = bi % 96, j = cg * 64 + F.lane;
            float a0 = 0.f, a1 = 0.f;
            const float* wp = F.w_ada + ((size_t)l * 1024 + F.wave * 128) * 6144 + j;
#pragma unroll 16
            for (int k = 0; k < 128; ++k) { const float wv = wp[(size_t)k * 6144]; const float c0 = F.c[F.wave * 128 + k], c1 = F.c[1024 + F.wave * 128 + k];
                a0 += siluf_(c0) * wv; a1 += siluf_(c1) * wv; }
            red[(F.wave * 2 + 0) * 64 + F.lane] = a0; red[(F.wave * 2 + 1) * 64 + F.lane] = a1;
            __syncthreads();
            if (F.tid < 128) { const int b = F.tid >> 6, ln = F.tid & 63; float s = 0.f;
#pragma unroll
                for (int w = 0; w < 8; ++w) s += red[(w * 2 + b) * 64 + ln];
                mod[(size_t)(l * 2 + b) * 6144 + cg * 64 + ln] = s + F.b_ada[l * 6144 + cg * 64 + ln]; }
            __syncthreads();
        } else {
            const int kv = (bi - 192) >> 2, cg = (bi - 192) & 3, j = cg * 64 + F.lane;
            float a0 = 0.f;
            const float* wp = F.cmp_w1 + ((size_t)kv * 2048 + F.wave * 256) * 256 + j; const float* pe = F.cmp_pe + kv * 2048 + F.wave * 256;
#pragma unroll 16
            for (int k = 0; k < 256; ++k) a0 += pe[k] * wp[(size_t)k * 256];
            red[F.wave * 64 + F.lane] = a0;
            __syncthreads();
            if (F.tid < 64) { float s = 0.f;
#pragma unroll
                for (int w = 0; w < 8; ++w) s += red[w * 64 + F.tid];
                bias1[kv * 256 + cg * 64 + F.tid] = s; }
            __syncthreads();
        }
    }
    { bf16* wi = (bf16*)(F.ws + WS_WIN); const int npieces = (NPROJ - C_END) * (DM / 8);
      for (int p = F.bid * 512 + F.tid; p < npieces; p += F.G * 512) *(GAS v4u*)(wi + (size_t)C_END * DM + (size_t)p * 8) = (v4u){0u, 0u, 0u, 0u}; }
    const int gw = F.bid * 8 + F.wave, NGW = F.G * 8;
    tr_run(F, 0, gw, NGW);
}

__device__ __forceinline__ void moe_tables(Frame& F, int layer) {
    LAS int* ppre = (LAS int*)(F.lds + TAB_OFF);
    if (F.tid == 0) { const unsigned* cnt = (const unsigned*)(F.ctl + CW_CNT + 1024 * layer); int acc = 0;
        for (int e = 0; e < 16; ++e) { const int c = (int)cnt[64 * e]; ppre[e] = acc; ppre[32 + e] = c; acc += (c + 255) >> 8; }
        ppre[16] = acc; }
    __syncthreads();
}

struct RouteRec { int e0, e1, pos0, pos1; float w0, w1; int slot0, slot1; };
template <bool COMBINE, bool NORM, bool ROUTE>
__device__ __forceinline__ void row_pass(Frame& F, const float* xin, const float* modn  , int sh_off, const float* ng,
                                         const float* modc  , int layer, int clayer  ) {
    if (COMBINE) moe_tables(F, clayer);
    float* xout = F.out; bf16* H = (bf16*)(F.ws + WS_O);
    const bf16* YM = (const bf16*)(F.ws + WS_A);
    RouteRec* route = (RouteRec*)(F.ws + WS_ROUTE);
    int* elist = (int*)(F.ws + WS_STATS);
    const LAS int* ppre = (const LAS int*)(F.lds + TAB_OFF);
    LAS float* wr = (LAS float*)(F.lds + RING_OFF);
    LAS unsigned* lcnt = (LAS unsigned*)(F.lds + TAB_OFF + 256);
    if (ROUTE) {
        for (int idx = F.tid; idx < 16384; idx += 512) wr[(idx & 15) * 1024 + (idx >> 4)] = F.w_router[idx];
        if (F.tid < 32) lcnt[F.tid] = 0u;
        __syncthreads();
    }
    const int gw = F.bid * 8 + F.wave, NGW = F.G * 8;
    f32x4 cs[4], sh[4], gc[4];
    f32x4 vn[4]; v2u yn0[4], yn1[4]; RouteRec rn; rn.w0 = 0.f; rn.w1 = 0.f;
    int m = gw, bcur = -1;
#define RP_PREFETCH(mm) do { \
        _Pragma("unroll") for (int j = 0; j < 4; ++j) vn[j] = *(const f32x4*)(xin + (size_t)(mm) * DM + 4 * F.lane + 256 * j); \
        if (COMBINE) { rn = route[(mm)]; const int sl0_ = ppre[rn.e0] * 256 + rn.pos0, sl1_ = ppre[rn.e1] * 256 + rn.pos1; \
            _Pragma("unroll") for (int j = 0; j < 4; ++j) { yn0[j] = *(const v2u*)(YM + (size_t)sl0_ * DM + 4 * F.lane + 256 * j); yn1[j] = *(const v2u*)(YM + (size_t)sl1_ * DM + 4 * F.lane + 256 * j); } } } while (0)
    if (m < NTOK) RP_PREFETCH(m);
#pragma unroll 1
    while (m < NTOK) {
        f32x4 v[4]; v2u y0[4], y1[4];
#pragma unroll
        for (int j = 0; j < 4; ++j) { v[j] = vn[j]; if (COMBINE) { y0[j] = yn0[j]; y1[j] = yn1[j]; } }
        const float rw0 = rn.w0, rw1 = rn.w1;
        const int mc = m; m += NGW;
        if (m < NTOK) RP_PREFETCH(m);
        const int b = mc >> 13;
        if (b != bcur) { bcur = b;
#pragma unroll
            for (int j = 0; j < 4; ++j) {
                const int col = 4 * F.lane + 256 * j;
                if (NORM) { const f32x4 g = *(const f32x4*)(ng + col), sc = *(const f32x4*)(modn + b * 6144 + sh_off + 1024 + col); cs[j] = g * (sc + 1.0f); sh[j] = *(const f32x4*)(modn + b * 6144 + sh_off + col); }
                if (COMBINE) gc[j] = *(const f32x4*)(modc + b * 6144 + 5 * 1024 + col);
            } }
        {
            if (COMBINE) {
#pragma unroll
                for (int j = 0; j < 4; ++j) {
                    f32x4 yy; yy.x = rw0 * bflo(y0[j].x) + rw1 * bflo(y1[j].x); yy.y = rw0 * bfhi(y0[j].x) + rw1 * bfhi(y1[j].x); yy.z = rw0 * bflo(y0[j].y) + rw1 * bflo(y1[j].y); yy.w = rw0 * bfhi(y0[j].y) + rw1 * bfhi(y1[j].y);
                    v[j] = v[j] + gc[j] * yy;
                    *(f32x4*)(xout + (size_t)mc * DM + 4 * F.lane + 256 * j) = v[j];
                }
            }
            if (NORM) {
                float s = 0.f;
#pragma unroll
                for (int j = 0; j < 4; ++j) s += (v[j].x * v[j].x + v[j].y * v[j].y) + (v[j].z * v[j].z + v[j].w * v[j].w);
                const float rstd = 1.0f / sqrtf(wave_sum(s) * (1.0f / DM) + NORM_EPS);
#pragma unroll
                for (int j = 0; j < 4; ++j) { v[j] = v[j] * rstd * cs[j] + sh[j];
                    v2u o; o.x = pk2(v[j].x, v[j].y); o.y = pk2(v[j].z, v[j].w);
                    *(v2u*)(H + (size_t)mc * DM + 4 * F.lane + 256 * j) = o; }
            }
            if (ROUTE) {
                float a16[16];
#pragma unroll
                for (int eg = 0; eg < 4; ++eg) {
                    float a4[4] = {0.f, 0.f, 0.f, 0.f};
#pragma unroll
                    for (int j = 0; j < 4; ++j)
#pragma unroll
                        for (int ee = 0; ee < 4; ++ee) { const f32x4 w = *(const LAS f32x4*)(wr + (eg * 4 + ee) * 1024 + 4 * F.lane + 256 * j); a4[ee] += (v[j].x * w.x + v[j].y * w.y) + (v[j].z * w.z + v[j].w * w.w); }
#pragma unroll
                    for (int ee = 0; ee < 4; ++ee) a16[eg * 4 + ee] = a4[ee];
                    __builtin_amdgcn_sched_barrier(0);
                }
                float r8[8], r4[4], r2[2];
                { const bool hb = (F.lane & 32) != 0;
#pragma unroll
                  for (int i = 0; i < 8; ++i) { const float keep = hb ? a16[8 + i] : a16[i], send = hb ? a16[i] : a16[8 + i]; r8[i] = keep + __shfl_xor(send, 32); } }
                { const bool hb = (F.lane & 16) != 0;
#pragma unroll
                  for (int i = 0; i < 4; ++i) { const float keep = hb ? r8[4 + i] : r8[i], send = hb ? r8[i] : r8[4 + i]; r4[i] = keep + __shfl_xor(send, 16); } }
                { const bool hb = (F.lane & 8) != 0;
#pragma unroll
                  for (int i = 0; i < 2; ++i) { const float keep = hb ? r4[2 + i] : r4[i], send = hb ? r4[i] : r4[2 + i]; r2[i] = keep + __shfl_xor(send, 8); } }
                float lgo; { const bool hb = (F.lane & 4) != 0; const float keep = hb ? r2[1] : r2[0], send = hb ? r2[0] : r2[1]; lgo = keep + __shfl_xor(send, 4); }
                lgo += __shfl_xor(lgo, 1); lgo += __shfl_xor(lgo, 2);
                const int eown = ((F.lane >> 5) & 1) * 8 + ((F.lane >> 4) & 1) * 4 + ((F.lane >> 3) & 1) * 2 + ((F.lane >> 2) & 1);
                const float sco = frcp(1.0f + __expf(-lgo)), slo = sco + F.r_bias[eown];
                float sc[16], sl[16];
#pragma unroll
                for (int e = 0; e < 16; ++e) { const int src = (e >> 3) * 32 + ((e >> 2) & 1) * 16 + ((e >> 1) & 1) * 8 + (e & 1) * 4;
                    sc[e] = __builtin_bit_cast(float, __builtin_amdgcn_readlane(__builtin_bit_cast(int, sco), src)); sl[e] = __builtin_bit_cast(float, __builtin_amdgcn_readlane(__builtin_bit_cast(int, slo), src)); }
                float gs[4]; int ge1[4], ge2[4]; float gw1[4], gw2[4];
#pragma unroll
                for (int g = 0; g < 4; ++g) {
                    int i1 = 0; float m1 = sl[4 * g];
#pragma unroll
                    for (int k = 1; k < 4; ++k) if (sl[4 * g + k] > m1) { m1 = sl[4 * g + k]; i1 = k; }
                    int i2 = -1; float m2 = 0.f;
#pragma unroll
                    for (int k = 0; k < 4; ++k) if (k != i1 && (i2 < 0 || sl[4 * g + k] > m2)) { m2 = sl[4 * g + k]; i2 = k; }
                    gs[g] = m1 + m2; ge1[g] = 4 * g + i1; ge2[g] = 4 * g + i2;
                    float w1 = 0.f, w2 = 0.f;
#pragma unroll
                    for (int k = 0; k < 4; ++k) { w1 = (k == i1) ? sc[4 * g + k] : w1; w2 = (k == i2) ? sc[4 * g + k] : w2; }
                    gw1[g] = w1; gw2[g] = w2;
                }
                int gi = 0; float gm = gs[0];
#pragma unroll
                for (int g = 1; g < 4; ++g) if (gs[g] > gm) { gm = gs[g]; gi = g; }
                int e1 = ge1[0], e2 = ge2[0]; float w1 = gw1[0], w2 = gw2[0];
#pragma unroll
                for (int g = 1; g < 4; ++g) if (gi == g) { e1 = ge1[g]; e2 = ge2[g]; w1 = gw1[g]; w2 = gw2[g]; }
                const float ws_ = w1 + w2;
                if (F.lane == 0) {
                    RouteRec rr; rr.e0 = e1; rr.e1 = e2;
                    rr.pos0 = (int)__hip_atomic_fetch_add(lcnt + e1, 1u, __ATOMIC_RELAXED, __HIP_MEMORY_SCOPE_WORKGROUP);
                    rr.pos1 = (int)__hip_atomic_fetch_add(lcnt + e2, 1u, __ATOMIC_RELAXED, __HIP_MEMORY_SCOPE_WORKGROUP);
                    rr.w0 = w1 / ws_; rr.w1 = w2 / ws_; rr.slot0 = 0; rr.slot1 = 0;
                    route[mc] = rr;
                }
            }
        }
    }
#undef RP_PREFETCH
    if (ROUTE) {
        __syncthreads();
        if (F.tid < 16) { unsigned* cnt = (unsigned*)(F.ctl + CW_CNT + 1024 * layer + 64 * F.tid); lcnt[16 + F.tid] = atomicAdd(cnt, lcnt[F.tid]); }
        __syncthreads();
        if (F.lane == 0) {
#pragma unroll 1
            for (int m = gw; m < NTOK; m += NGW) { RouteRec rr = route[m]; rr.pos0 += (int)lcnt[16 + rr.e0]; rr.pos1 += (int)lcnt[16 + rr.e1]; route[m] = rr;
                elist[rr.e0 * 16384 + rr.pos0] = m; elist[rr.e1 * 16384 + rr.pos1] = m; }
        }
    }
}


__device__ __forceinline__ f32x4 mma16(const LAS bf16* A, int lda, const LAS bf16* Bt, int ldb, int K, f32x4 acc, int lane) {
    const LAS bf16* ap = A + (lane & 15) * lda + (lane >> 4) * 8;
    const LAS bf16* bp = Bt + (lane & 15) * ldb + (lane >> 4) * 8;
    for (int k = 0; k < K; k += 32) {
        const bf16x8 a = *(const LAS bf16x8*)(ap + k), b = *(const LAS bf16x8*)(bp + k);
        acc = __builtin_amdgcn_mfma_f32_16x16x32_bf16(a, b, acc, 0, 0, 0);
    }
    return acc;
}

__device__ __forceinline__ float wave_incl_scan(float v) {
#define DPP_ADD(ctrl, rmask) v += __builtin_bit_cast(float, __builtin_amdgcn_update_dpp(0, __builtin_bit_cast(int, v), (ctrl), (rmask), 0xF, false))
    DPP_ADD(0x111, 0xF);
    DPP_ADD(0x112, 0xF);
    DPP_ADD(0x114, 0xF);
    DPP_ADD(0x118, 0xF);
    DPP_ADD(0x142, 0xA);
    DPP_ADD(0x143, 0xC);
#undef DPP_ADD
    return v;
}
__device__ __forceinline__ void gla_bcum(Frame& F, const bf16* prow  , int h, float (&bc)[8]) {
    float gl[16];
    { const v4u a = *(const v4u*)(prow + C_GLR), b = *(const v4u*)(prow + C_GLR + 8); float t0[8], t1[8]; unpack8(a, t0); unpack8(b, t1);
#pragma unroll
      for (int i = 0; i < 8; ++i) { gl[i] = t0[i]; gl[8 + i] = t1[i]; } }
#pragma unroll
    for (int i = 0; i < 8; ++i) {
        const int col = h * 64 + F.wave * 8 + i;
        float z = F.gla_bg[col];
#pragma unroll
        for (int r = 0; r < 16; ++r) z += gl[r] * F.gla_w2[r * 256 + col];
        const float ls = fminf(z, 0.f) - __logf(1.0f + __expf(-fabsf(z)));
        bc[i] = wave_incl_scan(ls * (1.0f / 16.0f));
    }
}
__device__ __forceinline__ void gla_stage_vT(Frame& F, const bf16* prow, int h, LAS bf16* VT) {
    const v4u a = *(const v4u*)(prow + C_GV + h * 128 + F.wave * 16), b = *(const v4u*)(prow + C_GV + h * 128 + F.wave * 16 + 8);
    const unsigned w[8] = {a.x, a.y, a.z, a.w, b.x, b.y, b.z, b.w};
#pragma unroll
    for (int i = 0; i < 8; ++i) { VT[(F.wave * 16 + 2 * i) * 72 + F.lane] = (bf16)(w[i] & 0xffffu); VT[(F.wave * 16 + 2 * i + 1) * 72 + F.lane] = (bf16)(w[i] >> 16); }
}
__device__ __forceinline__ void gla_prep_item(Frame& F, int item) {
    const int h = item & 3, n = (item >> 2) & 127, b = item >> 9;
    const bf16* proj = (const bf16*)(F.ws + WS_A);
    const bf16* prow = proj + (size_t)(b * SEQ + n * 64 + F.lane) * NPROJ;
    LAS bf16* KT = (LAS bf16*)(F.lds + RING_OFF);
    LAS bf16* VT = (LAS bf16*)(F.lds + RING_OFF + 9216);
    float bc[8]; gla_bcum(F, prow, h, bc);
    float kf[8]; { const v4u kk = *(const v4u*)(prow + C_GK + h * 64 + F.wave * 8); unpack8(kk, kf); }
    float* DEC = (float*)(F.ws + WS_DEC) + ((size_t)(b * 128 + n) * 4 + h) * 64;
#pragma unroll
    for (int i = 0; i < 8; ++i) {
        const float bl = __shfl(bc[i], 63);
        KT[(F.wave * 8 + i) * 72 + F.lane] = (bf16)f2bf(kf[i] * __expf(bl - bc[i]));
        if (F.lane == 63) DEC[F.wave * 8 + i] = __expf(bl);
    }
    gla_stage_vT(F, prow, h, VT);
    __syncthreads();
    float* KV = (float*)(F.ws + WS_O) + ((size_t)(b * 128 + n) * 4 + h) * 8192;
    const int dt = F.wave >> 1;
#pragma unroll
    for (int j = 0; j < 4; ++j) {
        const int et = (F.wave & 1) * 4 + j;
        f32x4 acc = {0.f, 0.f, 0.f, 0.f};
        acc = mma16(KT + dt * 16 * 72, 72, VT + et * 16 * 72, 72, 64, acc, F.lane);
#pragma unroll
        for (int i = 0; i < 4; ++i) KV[(dt * 16 + 4 * (F.lane >> 4) + i) * 128 + et * 16 + (F.lane & 15)] = acc[i];
    }
    __syncthreads();
}
__device__ __forceinline__ void gla_scan(Frame& F, int gidx) {
    const int bh = gidx >> 13, de = gidx & 8191, b = bh >> 2, h = bh & 3;
    float* KV = (float*)(F.ws + WS_O) + ((size_t)(b * 128) * 4 + h) * 8192 + de;
    const float* DEC = (const float*)(F.ws + WS_DEC) + ((size_t)(b * 128) * 4 + h) * 64 + (de >> 7);
    float st = 0.f;
#pragma unroll 1
    for (int n0 = 0; n0 < 128; n0 += 16) {
        float kv[16], dc[16];
#pragma unroll
        for (int i = 0; i < 16; ++i) { kv[i] = KV[(size_t)(n0 + i) * 4 * 8192]; dc[i] = DEC[(size_t)(n0 + i) * 4 * 64]; }
#pragma unroll
        for (int i = 0; i < 16; ++i) { KV[(size_t)(n0 + i) * 4 * 8192] = st; st = dc[i] * st + kv[i]; }
    }
}
__device__ __forceinline__ void gla_out_item(Frame& F, int item) {
    const int h = item & 3, n = (item >> 2) & 127, b = item >> 9;
    const bf16* proj = (const bf16*)(F.ws + WS_A);
    const size_t tok = (size_t)b * SEQ + n * 64 + F.lane;
    const bf16* prow = proj + tok * NPROJ;
    LAS bf16* A1 = (LAS bf16*)(F.lds + RING_OFF);
    LAS bf16* B1 = (LAS bf16*)(F.lds + RING_OFF + 9216);
    LAS bf16* A2 = (LAS bf16*)(F.lds + RING_OFF + 18432);
    LAS bf16* SC = (LAS bf16*)(F.lds + RING_OFF + 27648);
    LAS bf16* VT = (LAS bf16*)(F.lds + RING_OFF + 36864);
    LAS bf16* ST = (LAS bf16*)(F.lds + RING_OFF + 55296);
    LAS float* OS = (LAS float*)(F.lds + RING_OFF + 73728);
    const size_t tkn = (size_t)b * SEQ + n * 64 + (F.tid >> 3);
    const v4u rraw0 = *(const v4u*)(proj + tkn * NPROJ + C_GR + h * 128 + (F.tid & 7) * 16), rraw1 = *(const v4u*)(proj + tkn * NPROJ + C_GR + h * 128 + (F.tid & 7) * 16 + 8);
    float bc[8]; gla_bcum(F, prow, h, bc);
    float qf[8], kf[8];
    { const v4u qq = *(const v4u*)(prow + C_GQ + h * 64 + F.wave * 8), kk = *(const v4u*)(prow + C_GK + h * 64 + F.wave * 8); unpack8(qq, qf); unpack8(kk, kf); }
    float a1[8], b1[8], a2[8];
#pragma unroll
    for (int i = 0; i < 8; ++i) {
        const float bm = __shfl(bc[i], 32);
        a1[i] = qf[i] * 0.125f * __expf(bc[i] - bm); b1[i] = kf[i] * __expf(bm - bc[i]); a2[i] = qf[i] * 0.125f * __expf(bc[i]);
    }
    *(LAS v4u*)(A1 + F.lane * 72 + F.wave * 8) = pack8(a1);
    *(LAS v4u*)(B1 + F.lane * 72 + F.wave * 8) = pack8(b1);
    *(LAS v4u*)(A2 + F.lane * 72 + F.wave * 8) = pack8(a2);
    gla_stage_vT(F, prow, h, VT);
    { const float* KV = (const float*)(F.ws + WS_O) + ((size_t)(b * 128 + n) * 4 + h) * 8192;
#pragma unroll
      for (int k = 0; k < 16; ++k) { const int p = F.tid + 512 * k, e = p & 127, d = p >> 7; ST[e * 72 + d] = (bf16)f2bf(KV[d * 128 + e]); } }
    __syncthreads();
    const int it = F.wave >> 1;
#pragma unroll
    for (int jj = 0; jj < 2; ++jj) {
        const int jt = (F.wave & 1) * 2 + jj;
        f32x4 acc = {0.f, 0.f, 0.f, 0.f};
        if (jt <= it) acc = mma16(A1 + it * 16 * 72, 72, B1 + jt * 16 * 72, 72, 64, acc, F.lane);
#pragma unroll
        for (int i = 0; i < 4; ++i) { const int ri = it * 16 + 4 * (F.lane >> 4) + i, cj = jt * 16 + (F.lane & 15); SC[ri * 72 + cj] = (bf16)f2bf((cj <= ri) ? acc[i] : 0.f); }
    }
    __syncthreads();
#pragma unroll
    for (int j = 0; j < 4; ++j) {
        const int et = (F.wave & 1) * 4 + j;
        f32x4 acc = {0.f, 0.f, 0.f, 0.f};
        acc = mma16(SC + it * 16 * 72, 72, VT + et * 16 * 72, 72, 64, acc, F.lane);
        acc = mma16(A2 + it * 16 * 72, 72, ST + et * 16 * 72, 72, 64, acc, F.lane);
#pragma unroll
        for (int i = 0; i < 4; ++i) OS[(it * 16 + 4 * (F.lane >> 4) + i) * 132 + et * 16 + (F.lane & 15)] = acc[i];
    }
    __syncthreads();
    { const int row = F.tid >> 3, c0 = (F.tid & 7) * 16;
      float v[16]; float ss = 0.f;
#pragma unroll
      for (int i = 0; i < 16; ++i) { v[i] = OS[row * 132 + c0 + i]; ss += v[i] * v[i]; }
      ss += dpp_xor1(ss); ss += dpp_xor2(ss); ss += __shfl_xor(ss, 4);
      const float rstd = 1.0f / sqrtf(ss * (1.0f / 128.0f) + NORM_EPS);
      const size_t tk = (size_t)b * SEQ + n * 64 + row;
      float r0[8], r1[8]; unpack8(rraw0, r0); unpack8(rraw1, r1);
      float o0[8], o1[8];
#pragma unroll
      for (int i = 0; i < 8; ++i) { o0[i] = v[i] * rstd * F.gla_ng[c0 + i] * siluf_(r0[i]); o1[i] = v[8 + i] * rstd * F.gla_ng[c0 + 8 + i] * siluf_(r1[i]); }
      bf16* orow = (bf16*)(F.ws + WS_O + 32 * MiB) + tk * DM + h * 128 + c0;
      *(v4u*)orow = pack8(o0); *(v4u*)(orow + 8) = pack8(o1); }
    __syncthreads();
}

__device__ __forceinline__ double inv_freq_d(int i) {
    return (i == 0) ? 1.0 : (i == 1) ? 0.19392547740471268 : (i == 2) ? 0.037606090787015346 : (i == 3) ? 0.0072927791106285765 :
           (i == 4) ? 0.0014142135623730951 : (i == 5) ? 0.00027425197177757796 : (i == 6) ? 5.318404375373266e-05 : 1.0313741203148838e-05;
}
__device__ __forceinline__ void rope_sincos(int pos, int i, float& cs, float& sn) {
    const double rev = (double)pos * inv_freq_d(i) * 0.15915494309189535;
    const float fr = (float)(rev - rint(rev));
    cs = __builtin_amdgcn_cosf(fr); sn = __builtin_amdgcn_sinf(fr);
}
struct PrepRaw { v4u r0, r1, r2; unsigned ng; int pos; };
__device__ __forceinline__ void nsa_prep_load(Frame& F, int tok, PrepRaw& p) {
    const int sub = F.lane & 7, vid = F.lane >> 3;
    const bf16* prow = (const bf16*)(F.ws + WS_A) + (size_t)tok * NPROJ;
    const int g1 = vid & 1, w1 = vid >> 1, w2 = (vid >> 1) & 1;
    const int col1 = ((w1 == 0) ? C_KS : (w1 == 1) ? C_KW : (w1 == 2) ? C_VS : C_VW) + g1 * 64, col2 = (w2 ? C_VC : C_KC) + g1 * 64;
    p.r0 = *(const v4u*)(prow + C_NQ + vid * 64 + sub * 8); p.r1 = *(const v4u*)(prow + col1 + sub * 8); p.r2 = *(const v4u*)(prow + col2 + sub * 8);
    p.ng = (F.lane < 24) ? (unsigned)prow[C_NG + F.lane] : 0u; p.pos = F.positions[tok];
}
__device__ __forceinline__ void nsa_prep_token(Frame& F, int tok, const PrepRaw& p) {
    const int b = tok >> 13, t = tok & 8191, sub = F.lane & 7, vid = F.lane >> 3;
    float cs_l, sn_l; rope_sincos(p.pos, sub, cs_l, sn_l);
    float cs[8], sn[8];
#pragma unroll
    for (int i = 0; i < 8; ++i) { cs[i] = __shfl(cs_l, (F.lane & ~7) + i); sn[i] = __shfl(sn_l, (F.lane & ~7) + i); }
    unsigned char* dob = F.dout_b;
    const size_t ktile_off = (size_t)(t >> 6) * 8192 + sub * 1024 + (t & 63) * 16;
    const size_t vtile_off = (size_t)(t >> 6) * 8192 + (sub >> 2) * 4096 + (t & 63) * 64 + (sub & 3) * 16;
#pragma unroll
    for (int round = 0; round < 3; ++round) {
        int kind; unsigned char* dst; const float* gain = nullptr;
        if (round == 0) { kind = 0; gain = F.q_gain; const int g = vid >> 2, hh = vid & 3;
            dst = dob + DO_QN + ((((size_t)(b * 2 + g) * SEQ + t) * 4 + hh) * 64 + sub * 8) * 2; }
        else if (round == 1) {
            const int g = vid & 1, which = vid >> 1;
            const size_t img = (size_t)(b * 2 + g) * (1u << 20);
            if (which == 0) { kind = 1; gain = F.k_gain + 64; dst = dob + DO_KSEL + img + ktile_off; }
            else if (which == 1) { kind = 1; gain = F.k_gain + 128; dst = dob + DO_KWIN + img + ktile_off; }
            else if (which == 2) { kind = 2; dst = dob + DO_VSEL + img + vtile_off; }
            else { kind = 2; dst = dob + DO_VWIN + img + vtile_off; }
        } else {
            const int g = vid & 1, which = (vid >> 1) & 1;
            kind = 2;
            dst = dob + (which ? DO_VC : DO_KC) + (((size_t)(b * 2 + g) * SEQ + t) * 64 + sub * 8) * 2;
        }
        const v4u raw = (round == 0) ? p.r0 : (round == 1) ? p.r1 : p.r2;
        if (kind == 2) { if (round < 2 || F.lane < 32) *(v4u*)dst = raw; }
        else {
            float x[8]; unpack8(raw, x);
            float ss = 0.f;
#pragma unroll
            for (int i = 0; i < 8; ++i) ss += x[i] * x[i];
            ss += dpp_xor1(ss); ss += dpp_xor2(ss); ss += __shfl_xor(ss, 4);
            const float rstd = 1.0f / sqrtf(ss * (1.0f / 64.0f) + NORM_EPS);
#pragma unroll
            for (int i = 0; i < 8; ++i) x[i] = x[i] * rstd * gain[sub * 8 + i];
            float xo[8];
#pragma unroll
            for (int i = 0; i < 8; ++i) xo[i] = dpp_xor1(x[i]);
            if (sub == 0) {
#pragma unroll
                for (int i = 0; i < 8; ++i) x[i] = x[i] * cs[i] - xo[i] * sn[i];
            } else if (sub == 1) {
#pragma unroll
                for (int i = 0; i < 8; ++i) x[i] = x[i] * cs[i] + xo[i] * sn[i];
            }
            if (kind == 0) {
#pragma unroll
                for (int i = 0; i < 8; ++i) x[i] *= 0.125f * 1.4426950408889634f;
            }
            *(v4u*)dst = pack8(x);
        }
    }
    if (F.lane < 24) { float* gt = (float*)(F.ws + WS_GATES) + (size_t)tok * 24; gt[F.lane] = sigmoidf_(bf2f((bf16)p.ng)); }
}

__device__ __forceinline__ void nsa_compress_item(Frame& F, int item) {
    const int kv = item >> 6, b = (item >> 5) & 1, g = (item >> 4) & 1, rt = item & 15, n0 = rt * 32;
    const bf16* Asrc = (const bf16*)(F.dout_b + (kv ? DO_VC : DO_KC)) + ((size_t)(b * 2 + g) * SEQ + 16 * n0) * 64;
    const bf16* Bsrc = (const bf16*)(F.ws + WS_WCW1) + (size_t)kv * 256 * 2048;
    LAS bf16* As = (LAS bf16*)(F.lds + RING_OFF);
    LAS bf16* Bs = (LAS bf16*)(F.lds + RING_OFF + 2 * 32 * 72 * 2);
    LAS float* Hs = (LAS float*)(F.lds + RING_OFF + 86016);
    LAS float* W2s = (LAS float*)(F.lds + RING_OFF);
    const int ar = F.tid >> 3, ac = (F.tid & 7) * 8;
    v4u areg0 = {0u, 0u, 0u, 0u}, areg1 = {0u, 0u, 0u, 0u}, breg0[4], breg1[4];
#define CMP_GLOAD(A_, B_, kc) do { if (F.tid < 256) A_ = *(const v4u*)(Asrc + (size_t)ar * 1024 + (kc) * 64 + ac); \
        _Pragma("unroll") for (int i_ = 0; i_ < 4; ++i_) { const int p_ = F.tid + 512 * i_, br_ = p_ >> 3, bc_ = (p_ & 7) * 8; B_[i_] = *(const v4u*)(Bsrc + (size_t)br_ * 2048 + (kc) * 64 + bc_); } } while (0)
#define CMP_LSTORE(A_, B_, buf) do { if (F.tid < 256) *(LAS v4u*)(As + (buf) * 32 * 72 + ar * 72 + ac) = A_; \
        _Pragma("unroll") for (int i_ = 0; i_ < 4; ++i_) { const int p_ = F.tid + 512 * i_, br_ = p_ >> 3, bc_ = (p_ & 7) * 8; *(LAS v4u*)(Bs + (buf) * 256 * 72 + br_ * 72 + bc_) = B_[i_]; } } while (0)
#define CMP_MMA(buf) do { _Pragma("unroll") for (int mt = 0; mt < 2; ++mt) _Pragma("unroll") for (int nt = 0; nt < 2; ++nt) \
        acc[mt][nt] = mma16(As + (buf) * 32 * 72 + mt * 16 * 72, 72, Bs + (buf) * 256 * 72 + (F.wave * 32 + nt * 16) * 72, 72, 64, acc[mt][nt], F.lane); } while (0)
    f32x4 acc[2][2];
#pragma unroll
    for (int mt = 0; mt < 2; ++mt)
#pragma unroll
        for (int nt = 0; nt < 2; ++nt) acc[mt][nt] = (f32x4){0.f, 0.f, 0.f, 0.f};
    CMP_GLOAD(areg0, breg0, 0); CMP_GLOAD(areg1, breg1, 1); CMP_LSTORE(areg0, breg0, 0); __syncthreads();
#pragma unroll 1
    for (int kc = 0; kc < 32; kc += 2) {
        if (kc + 2 < 32) CMP_GLOAD(areg0, breg0, kc + 2);
        CMP_MMA(0);
        CMP_LSTORE(areg1, breg1, 1);
        __syncthreads();
        if (kc + 3 < 32) CMP_GLOAD(areg1, breg1, kc + 3);
        CMP_MMA(1);
        if (kc + 2 < 32) CMP_LSTORE(areg0, breg0, 0);
        __syncthreads();
    }
#undef CMP_MMA
    const float* bias1 = (const float*)(F.ws + WS_MOD + 131072) + kv * 256;
#pragma unroll
    for (int mt = 0; mt < 2; ++mt)
#pragma unroll
        for (int nt = 0; nt < 2; ++nt) { const int col = F.wave * 32 + nt * 16 + (F.lane & 15);
#pragma unroll
            for (int i = 0; i < 4; ++i) Hs[(mt * 16 + 4 * (F.lane >> 4) + i) * 260 + col] = gelu_tanh(acc[mt][nt][i] + bias1[col]); }
    { const float* w2 = F.cmp_w2 + (size_t)kv * 256 * 64;
#pragma unroll
      for (int i = 0; i < 8; ++i) *(LAS f32x4*)(W2s + (F.tid + 512 * i) * 4) = *(const f32x4*)(w2 + (size_t)(F.tid + 512 * i) * 4); }
    __syncthreads();
    const int r = F.tid >> 4, dq = F.tid & 15;
    f32x4 o = {0.f, 0.f, 0.f, 0.f};
#pragma unroll 8
    for (int j = 0; j < 256; ++j) { const float hv = Hs[r * 260 + j]; const f32x4 w = *(const LAS f32x4*)(W2s + j * 64 + 4 * dq); o = o + w * hv; }
    const int n = n0 + r;
    if (kv == 0) {
        float ss = (o.x * o.x + o.y * o.y) + (o.z * o.z + o.w * o.w);
        ss += dpp_xor1(ss); ss += dpp_xor2(ss); ss += __shfl_xor(ss, 4); ss += __shfl_xor(ss, 8);
        const float rstd = 1.0f / sqrtf(ss * (1.0f / 64.0f) + NORM_EPS);
        const f32x4 gn = *(const f32x4*)(F.k_gain + 4 * dq);
        o = o * rstd * gn;
        const int tlast = (16 * n + 31 < SEQ) ? 16 * n + 31 : SEQ - 1;
        const int pos = F.positions[b * SEQ + tlast];
        f32x4 po; po.x = dpp_xor2(o.x); po.y = dpp_xor2(o.y); po.z = dpp_xor2(o.z); po.w = dpp_xor2(o.w);
        if (dq < 4) {
            const int i0 = 4 * (dq & 1);
            float c0, s0, c1, s1, c2, s2, c3, s3;
            rope_sincos(pos, i0, c0, s0); rope_sincos(pos, i0 + 1, c1, s1); rope_sincos(pos, i0 + 2, c2, s2); rope_sincos(pos, i0 + 3, c3, s3);
            if (dq < 2) { o.x = o.x * c0 - po.x * s0; o.y = o.y * c1 - po.y * s1; o.z = o.z * c2 - po.z * s2; o.w = o.w * c3 - po.w * s3; }
            else { o.x = o.x * c0 + po.x * s0; o.y = o.y * c1 + po.y * s1; o.z = o.z * c2 + po.z * s2; o.w = o.w * c3 + po.w * s3; }
        }
    }
    if (n == 511) o = (f32x4){0.f, 0.f, 0.f, 0.f};
    v2u pk; pk.x = pk2(o.x, o.y); pk.y = pk2(o.z, o.w);
    const int c = dq >> 1;
    unsigned char* img = F.dout_b + (kv ? DO_VCMP : DO_KCMP) + (size_t)(b * 2 + g) * 65536 + (size_t)(n >> 6) * 8192;
    if (kv == 0) *(v2u*)(img + c * 1024 + (n & 63) * 16 + (dq & 1) * 8) = pk;
    else *(v2u*)(img + (c >> 2) * 4096 + (n & 63) * 64 + (c & 3) * 16 + (dq & 1) * 8) = pk;
    __syncthreads();
}

constexpr int NSA_KB = 0, NSA_VB = 16384, NSA_IMP = 32768, NSA_OACC = 65536;
__device__ __forceinline__ int crow(int r, int hi) { return (r & 3) + 8 * (r >> 2) + 4 * hi; }
__device__ __forceinline__ s16x4 ds_tr16(const LAS unsigned char* p) { return __builtin_bit_cast(s16x4, __builtin_amdgcn_ds_read_tr16_b64_v4i16((LAS s16x4*)p)); }

__device__ __forceinline__ unsigned cvtpk(float lo, float hi) { unsigned r; asm("v_cvt_pk_bf16_f32 %0, %1, %2" : "=v"(r) : "v"(lo), "v"(hi)); return r; }
__device__ __forceinline__ float xhalf_max(float v) { const auto rr = __builtin_amdgcn_permlane32_swap(__float_as_uint(v), __float_as_uint(v), false, false); return fmaxf(__uint_as_float(rr[0]), __uint_as_float(rr[1])); }
constexpr float NSA_THR = 8.0f;

template <int MODE>
__device__ __forceinline__ void nsa_branch(Frame& F, const unsigned char* Kimg, const unsigned char* Vimg, int kt0, int kt1, const bf16x8 (&qr)[4],
                                           float& m, float& l, f32x16 (&o)[2], int t, int tw0, int nv, int nvw, int nvmin,
                                           unsigned mk0, unsigned mk1, unsigned mk2, unsigned mk3, unsigned wo0, unsigned wo1, unsigned wo2, unsigned wo3,
                                           float cinit  , LAS float* impw,
                                           bool bnd  ) {
    const int r32 = F.lane & 31, hi = F.lane >> 5, tokl = r32 >> 2;
    LAS unsigned char* KB = F.lds + RING_OFF + NSA_KB; LAS unsigned char* VB = F.lds + RING_OFF + NSA_VB;
    const v4u* kg = (const v4u*)Kimg + F.tid; const v4u* vg = (const v4u*)Vimg + F.tid;
    v4u kreg = kg[(size_t)kt0 * 512], vreg = {0u, 0u, 0u, 0u};
    if (MODE != 0) vreg = vg[(size_t)kt0 * 512];
    *(LAS v4u*)(KB + F.tid * 16) = kreg; if (MODE != 0) *(LAS v4u*)(VB + F.tid * 16) = vreg;
    __syncthreads();
#pragma unroll 1
    for (int kt = kt0; kt < kt1; ++kt) {
        const int buf = (kt - kt0) & 1; const bool has_next = kt + 1 < kt1;
        if (has_next) { kreg = kg[(size_t)(kt + 1) * 512]; if (MODE != 0) vreg = vg[(size_t)(kt + 1) * 512]; }
        const LAS unsigned char* Kb = KB + buf * 8192; const LAS unsigned char* Vb = VB + buf * 8192;
        bool need;
        if (MODE <= 1) need = kt * 64 < nvw;
        else if (MODE == 2) { const unsigned w = (kt < 32) ? wo0 : (kt < 64) ? wo1 : (kt < 96) ? wo2 : wo3; need = (w >> (kt & 31)) & 1u; }
        else need = (kt * 64 <= tw0 + 7) && (kt * 64 + 63 + 512 > tw0);
        bool selbit = true;
        if (MODE == 2) { const unsigned w = (kt < 32) ? mk0 : (kt < 64) ? mk1 : (kt < 96) ? mk2 : mk3; selbit = (w >> (kt & 31)) & 1u; }
        bool joint = false;
        if (need) {
            if (MODE == 2) joint = kt < (tw0 >> 6);
            else if (MODE == 3) joint = (kt * 64 + 63 <= tw0) && (kt * 64 + 512 > tw0 + 7);
            else joint = kt * 64 + 63 < nvmin;
            if (MODE != 1 && !bnd) joint = joint && !__any(m < -1e29f);
        }
        if (need && joint) {
            f32x16 pa, pb;
            if (bnd && MODE != 1) {
#pragma unroll
                for (int r = 0; r < 16; ++r) { pa[r] = 0.f; pb[r] = 0.f; }
#pragma unroll
                for (int d0 = 0; d0 < 4; ++d0) {
                    const bf16x8 kfa = *(const LAS bf16x8*)(Kb + (2 * d0 + hi) * 1024 + r32 * 16), kfb = *(const LAS bf16x8*)(Kb + (2 * d0 + hi) * 1024 + (32 + r32) * 16);
                    pa = __builtin_amdgcn_mfma_f32_32x32x16_bf16(kfa, qr[d0], pa, 0, 0, 0);
                    pb = __builtin_amdgcn_mfma_f32_32x32x16_bf16(kfb, qr[d0], pb, 0, 0, 0);
                }
            } else {
            const float c0 = (MODE == 1) ? cinit : ((MODE == 2 && !selbit) ? -1e30f : -m);
#pragma unroll
            for (int r = 0; r < 16; ++r) { pa[r] = c0; pb[r] = c0; }
#pragma unroll
            for (int d0 = 0; d0 < 4; ++d0) {
                const bf16x8 kfa = *(const LAS bf16x8*)(Kb + (2 * d0 + hi) * 1024 + r32 * 16), kfb = *(const LAS bf16x8*)(Kb + (2 * d0 + hi) * 1024 + (32 + r32) * 16);
                pa = __builtin_amdgcn_mfma_f32_32x32x16_bf16(kfa, qr[d0], pa, 0, 0, 0);
                pb = __builtin_amdgcn_mfma_f32_32x32x16_bf16(kfb, qr[d0], pb, 0, 0, 0);
            }
            if (MODE != 1) {
                float mxa = fmaxf(fmaxf(pa[0], pa[1]), pa[2]), mxb = fmaxf(fmaxf(pb[0], pb[1]), pb[2]);
#pragma unroll
                for (int r = 3; r < 15; r += 2) { mxa = fmaxf(fmaxf(mxa, pa[r]), pa[r + 1]); mxb = fmaxf(fmaxf(mxb, pb[r]), pb[r + 1]); }
                const float mx = xhalf_max(fmaxf(fmaxf(mxa, pa[15]), fmaxf(mxb, pb[15])));
                if (__any(mx > NSA_THR)) {
                    const float dl = fmaxf(mx, 0.f), alpha = fexp2(-dl);
                    m += dl; l *= alpha;
#pragma unroll
                    for (int r = 0; r < 16; ++r) { pa[r] -= dl; pb[r] -= dl; }
                    if (MODE != 0) {
#pragma unroll
                        for (int r = 0; r < 16; ++r) { o[0][r] *= alpha; o[1][r] *= alpha; }
                    }
                }
            }
            }
            float ps0 = 0.f, ps1 = 0.f;
#pragma unroll
            for (int r = 0; r < 16; ++r) { pa[r] = fexp2(pa[r]); pb[r] = fexp2(pb[r]); ps0 += pa[r]; ps1 += pb[r]; }
            if (MODE != 1) l += (bnd && MODE == 2 && !selbit) ? 0.f : (ps0 + ps1);
            if (MODE == 1) {
#pragma unroll
                for (int rg = 0; rg < 4; ++rg) {
                    float a = (pa[4 * rg] + pa[4 * rg + 1]) + (pa[4 * rg + 2] + pa[4 * rg + 3]), sp = pa[4 * rg + 3];
                    float a2 = (pb[4 * rg] + pb[4 * rg + 1]) + (pb[4 * rg + 2] + pb[4 * rg + 3]), sp2 = pb[4 * rg + 3];
                    a += dpp_xor1(a); a += dpp_xor2(a); sp += dpp_xor1(sp); sp += dpp_xor2(sp);
                    a2 += dpp_xor1(a2); a2 += dpp_xor2(a2); sp2 += dpp_xor1(sp2); sp2 += dpp_xor2(sp2);
                    if ((r32 & 3) == 0) { const int jp = kt * 16 + 2 * rg + hi;
                        __hip_atomic_fetch_add(impw + tokl * 128 + jp, a, __ATOMIC_RELAXED, __HIP_MEMORY_SCOPE_WORKGROUP);
                        __hip_atomic_fetch_add(impw + tokl * 128 + jp + 1, sp, __ATOMIC_RELAXED, __HIP_MEMORY_SCOPE_WORKGROUP);
                        __hip_atomic_fetch_add(impw + tokl * 128 + jp + 8, a2, __ATOMIC_RELAXED, __HIP_MEMORY_SCOPE_WORKGROUP);
                        if (jp + 9 < 128) __hip_atomic_fetch_add(impw + tokl * 128 + jp + 9, sp2, __ATOMIC_RELAXED, __HIP_MEMORY_SCOPE_WORKGROUP); }
                }
            }
            if (MODE != 0) {
                v4u wa0, wa1, wb0, wb1;
                wa0.x = cvtpk(pa[0], pa[1]); wa0.y = cvtpk(pa[2], pa[3]); wa0.z = cvtpk(pa[4], pa[5]); wa0.w = cvtpk(pa[6], pa[7]);
                wa1.x = cvtpk(pa[8], pa[9]); wa1.y = cvtpk(pa[10], pa[11]); wa1.z = cvtpk(pa[12], pa[13]); wa1.w = cvtpk(pa[14], pa[15]);
                wb0.x = cvtpk(pb[0], pb[1]); wb0.y = cvtpk(pb[2], pb[3]); wb0.z = cvtpk(pb[4], pb[5]); wb0.w = cvtpk(pb[6], pb[7]);
                wb1.x = cvtpk(pb[8], pb[9]); wb1.y = cvtpk(pb[10], pb[11]); wb1.z = cvtpk(pb[12], pb[13]); wb1.w = cvtpk(pb[14], pb[15]);
                if (MODE == 2 && bnd) { const unsigned km = selbit ? 0xffffffffu : 0u;
                    wa0.x &= km; wa0.y &= km; wa0.z &= km; wa0.w &= km; wa1.x &= km; wa1.y &= km; wa1.z &= km; wa1.w &= km; wb0.x &= km; wb0.y &= km; wb0.z &= km; wb0.w &= km; wb1.x &= km; wb1.y &= km; wb1.z &= km; wb1.w &= km; }
                const bf16x8 fa0 = __builtin_bit_cast(bf16x8, wa0), fa1 = __builtin_bit_cast(bf16x8, wa1), fb0 = __builtin_bit_cast(bf16x8, wb0), fb1 = __builtin_bit_cast(bf16x8, wb1);
                const LAS unsigned char* vb = Vb + (4 * hi + ((F.lane & 15) >> 2)) * 64 + ((F.lane >> 4) & 1) * 32 + (F.lane & 3) * 8;
#pragma unroll
                for (int dh = 0; dh < 2; ++dh) {
                    const LAS unsigned char* v0 = vb + dh * 4096;
                    const s16x4 a0 = ds_tr16(v0), a1 = ds_tr16(v0 + 512), b0 = ds_tr16(v0 + 1024), b1 = ds_tr16(v0 + 1536), c0_ = ds_tr16(v0 + 2048), c1 = ds_tr16(v0 + 2560), d0_ = ds_tr16(v0 + 3072), d1 = ds_tr16(v0 + 3584);
                    const bf16x8 vfa0 = {a0[0], a0[1], a0[2], a0[3], a1[0], a1[1], a1[2], a1[3]}, vfa1 = {b0[0], b0[1], b0[2], b0[3], b1[0], b1[1], b1[2], b1[3]};
                    const bf16x8 vfb0 = {c0_[0], c0_[1], c0_[2], c0_[3], c1[0], c1[1], c1[2], c1[3]}, vfb1 = {d0_[0], d0_[1], d0_[2], d0_[3], d1[0], d1[1], d1[2], d1[3]};
                    o[dh] = __builtin_amdgcn_mfma_f32_32x32x16_bf16(vfa0, fa0, o[dh], 0, 0, 0);
                    o[dh] = __builtin_amdgcn_mfma_f32_32x32x16_bf16(vfa1, fa1, o[dh], 0, 0, 0);
                    o[dh] = __builtin_amdgcn_mfma_f32_32x32x16_bf16(vfb0, fb0, o[dh], 0, 0, 0);
                    o[dh] = __builtin_amdgcn_mfma_f32_32x32x16_bf16(vfb1, fb1, o[dh], 0, 0, 0);
                }
            }
        } else if (need) {
#pragma unroll 1
            for (int kb = 0; kb < 2; ++kb) {
                const int key0 = kt * 64 + kb * 32;
                bool fast;
                if (MODE == 2) fast = kt < (tw0 >> 6);
                else if (MODE == 3) fast = (key0 + 31 <= tw0) && (key0 + 512 > tw0 + 7);
                else fast = key0 + 31 < nvmin;
                if (MODE != 1) fast = fast && !bnd && !__any(m < -1e29f);
                float c0 = 0.f;
                if (fast) c0 = (MODE == 1) ? cinit : ((MODE == 2 && !selbit) ? -1e30f : -m);
                f32x16 p;
#pragma unroll
                for (int r = 0; r < 16; ++r) p[r] = c0;
#pragma unroll
                for (int d0 = 0; d0 < 4; ++d0) {
                    const bf16x8 kf = *(const LAS bf16x8*)(Kb + (2 * d0 + hi) * 1024 + (32 * kb + r32) * 16);
                    p = __builtin_amdgcn_mfma_f32_32x32x16_bf16(kf, qr[d0], p, 0, 0, 0);
                }
                float pe[16];
                if (fast) {
                    if (MODE != 1) {
                        float mx = fmaxf(fmaxf(p[0], p[1]), p[2]);
#pragma unroll
                        for (int r = 3; r < 15; r += 2) mx = fmaxf(fmaxf(mx, p[r]), p[r + 1]);
                        mx = xhalf_max(fmaxf(mx, p[15]));
                        if (__any(mx > NSA_THR)) {
                            const float dl = fmaxf(mx, 0.f), alpha = fexp2(-dl);
                            m += dl; l *= alpha;
#pragma unroll
                            for (int r = 0; r < 16; ++r) p[r] -= dl;
                            if (MODE != 0) {
#pragma unroll
                                for (int r = 0; r < 16; ++r) { o[0][r] *= alpha; o[1][r] *= alpha; }
                            }
                        }
                    }
                    float ps0 = 0.f, ps1 = 0.f;
#pragma unroll
                    for (int r = 0; r < 16; r += 2) { pe[r] = fexp2(p[r]); pe[r + 1] = fexp2(p[r + 1]); ps0 += pe[r]; ps1 += pe[r + 1]; }
                    if (MODE != 1) l += ps0 + ps1;
                } else if (MODE == 1) {
#pragma unroll
                    for (int r = 0; r < 16; ++r) { const int key = key0 + crow(r, hi); pe[r] = (key < nv) ? fexp2(p[r] + cinit) : 0.f; }
                } else if (bnd) {
                    float ps = 0.f;
#pragma unroll
                    for (int r = 0; r < 16; ++r) {
                        const int key = key0 + crow(r, hi); bool ok;
                        if (MODE == 0) ok = key < nv;
                        else if (MODE == 2) ok = selbit && (kt < (t >> 6) || key <= t);
                        else ok = (key <= t) && (key + 512 > t);
                        pe[r] = ok ? fexp2(p[r]) : 0.f; ps += pe[r];
                    }
                    l += ps;
                } else {
                    float mx = NEGBIG;
#pragma unroll
                    for (int r = 0; r < 16; ++r) {
                        const int key = key0 + crow(r, hi); bool ok;
                        if (MODE == 0) ok = key < nv;
                        else if (MODE == 2) ok = selbit && (kt < (t >> 6) || key <= t);
                        else ok = (key <= t) && (key + 512 > t);
                        p[r] = ok ? p[r] : NEGBIG; mx = fmaxf(mx, p[r]);
                    }
                    mx = xhalf_max(mx);
                    const float mn = fmaxf(m, mx), alpha = fexp2(m - mn);
                    float ps = 0.f;
#pragma unroll
                    for (int r = 0; r < 16; ++r) { pe[r] = (p[r] > -1e29f) ? fexp2(p[r] - mn) : 0.f; ps += pe[r]; }
                    l = l * alpha + ps; m = mn;
                    if (MODE != 0) {
#pragma unroll
                        for (int r = 0; r < 16; ++r) { o[0][r] *= alpha; o[1][r] *= alpha; }
                    }
                }
                if (MODE == 1) {
#pragma unroll
                    for (int rg = 0; rg < 4; ++rg) {
                        float a = (pe[4 * rg] + pe[4 * rg + 1]) + (pe[4 * rg + 2] + pe[4 * rg + 3]), sp = pe[4 * rg + 3];
                        a += dpp_xor1(a); a += dpp_xor2(a); sp += dpp_xor1(sp); sp += dpp_xor2(sp);
                        if ((r32 & 3) == 0) { const int jp = (key0 >> 2) + 2 * rg + hi;
                            __hip_atomic_fetch_add(impw + tokl * 128 + jp, a, __ATOMIC_RELAXED, __HIP_MEMORY_SCOPE_WORKGROUP);
                            if (jp + 1 < 128) __hip_atomic_fetch_add(impw + tokl * 128 + jp + 1, sp, __ATOMIC_RELAXED, __HIP_MEMORY_SCOPE_WORKGROUP); }
                    }
                }
                if (MODE != 0) {
                    v4u pw0, pw1;
                    pw0.x = cvtpk(pe[0], pe[1]); pw0.y = cvtpk(pe[2], pe[3]); pw0.z = cvtpk(pe[4], pe[5]); pw0.w = cvtpk(pe[6], pe[7]);
                    pw1.x = cvtpk(pe[8], pe[9]); pw1.y = cvtpk(pe[10], pe[11]); pw1.z = cvtpk(pe[12], pe[13]); pw1.w = cvtpk(pe[14], pe[15]);
                    const bf16x8 pf0 = __builtin_bit_cast(bf16x8, pw0), pf1 = __builtin_bit_cast(bf16x8, pw1);
                    const LAS unsigned char* vb = Vb + (32 * kb + 4 * hi + ((F.lane & 15) >> 2)) * 64 + ((F.lane >> 4) & 1) * 32 + (F.lane & 3) * 8;
#pragma unroll
                    for (int dh = 0; dh < 2; ++dh) {
                        const s16x4 a0 = ds_tr16(vb + dh * 4096), a1 = ds_tr16(vb + dh * 4096 + 512), b0 = ds_tr16(vb + dh * 4096 + 1024), b1 = ds_tr16(vb + dh * 4096 + 1024 + 512);
                        const bf16x8 vf0 = {a0[0], a0[1], a0[2], a0[3], a1[0], a1[1], a1[2], a1[3]}, vf1 = {b0[0], b0[1], b0[2], b0[3], b1[0], b1[1], b1[2], b1[3]};
                        o[dh] = __builtin_amdgcn_mfma_f32_32x32x16_bf16(vf0, pf0, o[dh], 0, 0, 0);
                        o[dh] = __builtin_amdgcn_mfma_f32_32x32x16_bf16(vf1, pf1, o[dh], 0, 0, 0);
                    }
                }
            }
        }
        if (has_next) { *(LAS v4u*)(KB + (buf ^ 1) * 8192 + F.tid * 16) = kreg; if (MODE != 0) *(LAS v4u*)(VB + (buf ^ 1) * 8192 + F.tid * 16) = vreg; }
        __syncthreads();
    }
}

__device__ __forceinline__ void nsa_item(Frame& F, int b, int g, int qi) {
    const int r32 = F.lane & 31, hi = F.lane >> 5, tokl = r32 >> 2, hh = r32 & 3;
    const int t0 = qi * 64, tw0 = t0 + 8 * F.wave, t = tw0 + tokl;
    const unsigned char* dob = F.dout_b;
    const size_t img = (size_t)(b * 2 + g) * (1u << 20);
    LAS float* impw = (LAS float*)(F.lds + RING_OFF + NSA_IMP) + F.wave * 1024;
    LAS unsigned* selm = (LAS unsigned*)(F.lds + TAB_OFF + 1024) + F.wave * 32;
    LAS float* oaccw = (LAS float*)(F.lds + RING_OFF + NSA_OACC) + F.wave * 2048 + F.lane;
#pragma unroll
    for (int i = 0; i < 16; ++i) impw[F.lane + 64 * i] = 0.f;
    bf16x8 qr[4];
    { const bf16* qrow = (const bf16*)(dob + DO_QN) + (((size_t)(b * 2 + g) * SEQ + tw0) * 4 + r32) * 64;
#pragma unroll
      for (int d0 = 0; d0 < 4; ++d0) qr[d0] = *(const bf16x8*)(qrow + 16 * d0 + 8 * hi); }
    const float* gt = (const float*)(F.ws + WS_GATES) + ((size_t)b * SEQ + t) * 24 + (g * 4 + hh) * 3;
    f32x16 o[2];
    const int nv = (t >= 31) ? ((t - 31) >> 4) + 1 : 0, nvw = (tw0 + 7 >= 31) ? ((tw0 + 7 - 31) >> 4) + 1 : 0, nvmin = (tw0 >= 31) ? ((tw0 - 31) >> 4) + 1 : 0;
    const int nct = (4 * qi + 3 + 63) >> 6;
    const unsigned char* Kc = dob + DO_KCMP + (size_t)(b * 2 + g) * 65536; const unsigned char* Vc = dob + DO_VCMP + (size_t)(b * 2 + g) * 65536;
#if defined(NSA_SPIN)
    unsigned long long tsp = __builtin_amdgcn_s_memrealtime();
#define NSPIN(k) do { if (NSA_SPIN == (k)) { const unsigned long long t1_ = __builtin_amdgcn_s_memrealtime(), dt_ = t1_ - tsp; while (__builtin_amdgcn_s_memrealtime() - t1_ < dt_) __builtin_amdgcn_s_sleep(4); } tsp = __builtin_amdgcn_s_memrealtime(); } while (0)
#else
#define NSPIN(k) do { } while (0)
#endif
    bool bnd0, bnd1, bnd2;
    { float gq = fabsf(F.q_gain[F.lane]), g0k = fabsf(F.k_gain[F.lane]), g1k = fabsf(F.k_gain[64 + F.lane]), g2k = fabsf(F.k_gain[128 + F.lane]);
#pragma unroll
      for (int off = 1; off < 64; off <<= 1) { gq = fmaxf(gq, __shfl_xor(gq, off)); g0k = fmaxf(g0k, __shfl_xor(g0k, off)); g1k = fmaxf(g1k, __shfl_xor(g1k, off)); g2k = fmaxf(g2k, __shfl_xor(g2k, off)); }
      const float cb = 64.0f * 0.125f * 1.4426950408889634f * 1.03f * gq;
      bnd0 = __builtin_amdgcn_readfirstlane((int)(cb * g0k < 40.0f)) != 0; bnd1 = __builtin_amdgcn_readfirstlane((int)(cb * g1k < 40.0f)) != 0; bnd2 = __builtin_amdgcn_readfirstlane((int)(cb * g2k < 40.0f)) != 0; }
    float m = bnd0 ? 0.f : NEGBIG, l = 0.f;
    nsa_branch<0>(F, Kc, Vc, 0, nct, qr, m, l, o, t, tw0, nv, nvw, nvmin, 0u, 0u, 0u, 0u, 0u, 0u, 0u, 0u, 0.f, impw, bnd0);
    { const float lt = l + __shfl_xor(l, 32); const float cinit = (lt > 0.f) ? -__log2f(lt) - m : -1e30f;
#pragma unroll
      for (int r = 0; r < 16; ++r) { o[0][r] = 0.f; o[1][r] = 0.f; }
      nsa_branch<1>(F, Kc, Vc, 0, nct, qr, m, l, o, t, tw0, nv, nvw, nvmin, 0u, 0u, 0u, 0u, 0u, 0u, 0u, 0u, cinit, impw, bnd0);
#pragma unroll
      for (int r = 0; r < 16; ++r) { oaccw[r * 64] = gt[0] * o[0][r]; oaccw[(16 + r) * 64] = gt[0] * o[1][r]; } }
    __syncthreads();
    NSPIN(1);
#pragma unroll 1
    for (int tl = 0; tl < 8; ++tl) {
        const int tt = tw0 + tl, cur = tt >> 6, j0 = F.lane, j1 = F.lane + 64;
        const unsigned u0 = (j0 <= cur) ? (__float_as_uint(impw[tl * 128 + j0] + ((j0 == 0 || j0 == cur || j0 == cur - 1) ? 1e4f : 0.f)) + 1u) : 0u;
        const unsigned u1 = (j1 <= cur) ? (__float_as_uint(impw[tl * 128 + j1] + ((j1 == cur || j1 == cur - 1) ? 1e4f : 0.f)) + 1u) : 0u;
        bool s0, s1;
        if (cur < 16) { s0 = (j0 <= cur); s1 = false; }
        else {
            unsigned T = 0u;
#pragma unroll 1
            for (int bit = 31; bit >= 0; --bit) {
                const unsigned cand = T | (1u << bit);
                const int c = __popcll(__ballot(u0 >= cand)) + __popcll(__ballot(u1 >= cand));
                if (c >= 16) T = cand;
            }
            const unsigned long long g0 = __ballot(u0 > T), g1 = __ballot(u1 > T), e0 = __ballot(u0 == T), e1 = __ballot(u1 == T);
            const int need = 16 - (__popcll(g0) + __popcll(g1));
            const unsigned long long below = (F.lane == 0) ? 0ull : (~0ull >> (64 - F.lane));
            const int rank0 = __popcll(e0 & below), rank1 = __popcll(e0) + __popcll(e1 & below);
            s0 = (u0 > T) || (u0 == T && rank0 < need);
            s1 = (u1 > T) || (u1 == T && rank1 < need);
        }
        const unsigned long long m0 = __ballot(s0), m1 = __ballot(s1);
        if (F.lane == 0) { selm[tl * 4 + 0] = (unsigned)m0; selm[tl * 4 + 1] = (unsigned)(m0 >> 32); selm[tl * 4 + 2] = (unsigned)m1; selm[tl * 4 + 3] = (unsigned)(m1 >> 32); }
    }
    __syncthreads();
    const unsigned mk0 = selm[tokl * 4 + 0], mk1 = selm[tokl * 4 + 1], mk2 = selm[tokl * 4 + 2], mk3 = selm[tokl * 4 + 3];
    unsigned wo0 = 0u, wo1 = 0u, wo2 = 0u, wo3 = 0u;
#pragma unroll
    for (int tl = 0; tl < 8; ++tl) { wo0 |= selm[tl * 4 + 0]; wo1 |= selm[tl * 4 + 1]; wo2 |= selm[tl * 4 + 2]; wo3 |= selm[tl * 4 + 3]; }
    wo0 = __builtin_amdgcn_readfirstlane(wo0); wo1 = __builtin_amdgcn_readfirstlane(wo1); wo2 = __builtin_amdgcn_readfirstlane(wo2); wo3 = __builtin_amdgcn_readfirstlane(wo3);
    NSPIN(2);
    { m = bnd1 ? 0.f : NEGBIG; l = 0.f;
#pragma unroll
      for (int r = 0; r < 16; ++r) { o[0][r] = 0.f; o[1][r] = 0.f; }
      nsa_branch<2>(F, dob + DO_KSEL + img, dob + DO_VSEL + img, 0, qi + 1, qr, m, l, o, t, tw0, nv, nvw, nvmin, mk0, mk1, mk2, mk3, wo0, wo1, wo2, wo3, 0.f, impw, bnd1);
      const float lt = l + __shfl_xor(l, 32); const float sc = (lt > 0.f) ? gt[1] / lt : 0.f;
#pragma unroll
      for (int r = 0; r < 16; ++r) { oaccw[r * 64] += sc * o[0][r]; oaccw[(16 + r) * 64] += sc * o[1][r]; } }
    NSPIN(3);
    { m = bnd2 ? 0.f : NEGBIG; l = 0.f;
#pragma unroll
      for (int r = 0; r < 16; ++r) { o[0][r] = 0.f; o[1][r] = 0.f; }
      nsa_branch<3>(F, dob + DO_KWIN + img, dob + DO_VWIN + img, (qi >= 8) ? qi - 8 : 0, qi + 1, qr, m, l, o, t, tw0, nv, nvw, nvmin, 0u, 0u, 0u, 0u, 0u, 0u, 0u, 0u, 0.f, impw, bnd2);
      const float lt = l + __shfl_xor(l, 32); const float sc = (lt > 0.f) ? gt[2] / lt : 0.f;
#pragma unroll
      for (int r = 0; r < 16; ++r) { o[0][r] = oaccw[r * 64] + sc * o[0][r]; o[1][r] = oaccw[(16 + r) * 64] + sc * o[1][r]; } }
    NSPIN(4);
    bf16* orow = (bf16*)(F.ws + WS_O + 32 * MiB) + ((size_t)b * SEQ + t) * DM + 512 + (g * 4 + hh) * 64;
#pragma unroll
    for (int dh = 0; dh < 2; ++dh)
#pragma unroll
        for (int rg = 0; rg < 4; ++rg) { v2u w; w.x = pk2(o[dh][4 * rg], o[dh][4 * rg + 1]); w.y = pk2(o[dh][4 * rg + 2], o[dh][4 * rg + 3]);
            *(v2u*)(orow + 32 * dh + 8 * rg + 4 * hi) = w; }
    __syncthreads();
}

__device__ __forceinline__ void sgu_item(Frame& F, int item) {
    const int gg = item & 7, ck = (item >> 3) & 63, b = item >> 9;
    const size_t tok0 = (size_t)b * SEQ + ck * 128;
    const bf16* Z = (const bf16*)(F.ws + WS_A);
    constexpr int RS = 544, BS = 136;
    LAS bf16* Ws = (LAS bf16*)(F.lds + RING_OFF);
    LAS unsigned char* Vs = F.lds + RING_OFF + 34816;
    LAS float* rs = (LAS float*)(F.lds + RING_OFF + 34816 + 128 * RS);
    if (F.tid < 128) { const float* st = (const float*)(F.ws + WS_STATS) + (tok0 + F.tid) * 32; float sum = 0.f;
#pragma unroll
        for (int k = 0; k < 32; k += 4) { const f32x4 v = *(const f32x4*)(st + k); sum += (v.x + v.y) + (v.z + v.w); }
        rs[F.tid] = 1.0f / sqrtf(sum * (1.0f / SGW) + NORM_EPS); }
    { const float* wsrc = F.sgu_ws + (size_t)gg * 128 * 128;
#pragma unroll
      for (int k = 0; k < 8; ++k) { const int p = F.tid + 512 * k, tr = p >> 5, sc = (p & 31) * 4; const f32x4 w = *(const f32x4*)(wsrc + tr * 128 + sc);
          v2u o; o.x = pk2((sc <= tr) ? w.x : 0.f, (sc + 1 <= tr) ? w.y : 0.f); o.y = pk2((sc + 2 <= tr) ? w.z : 0.f, (sc + 3 <= tr) ? w.w : 0.f);
          *(LAS v2u*)(Ws + tr * 136 + sc) = o; } }
    __syncthreads();
    { const int cc = F.tid & 31; float gn[8];
#pragma unroll
      for (int i = 0; i < 8; ++i) gn[i] = F.sgu_ng[gg * 256 + cc * 8 + i];
      v4u zr[8];
#pragma unroll
      for (int k = 0; k < 8; ++k) { const int sidx = (F.tid >> 5) + 16 * k; zr[k] = *(const v4u*)(Z + (tok0 + sidx) * 4096 + 2048 + gg * 256 + cc * 8); }
#pragma unroll
      for (int k = 0; k < 8; ++k) { const int sidx = (F.tid >> 5) + 16 * k; float x[8]; unpack8(zr[k], x); const float rr = rs[sidx];
#pragma unroll
          for (int i = 0; i < 8; ++i) x[i] *= rr * gn[i];
          const v4u o = pack8(x); LAS unsigned char* dst = Vs + sidx * RS + (cc >> 3) * BS + (cc & 7) * 16;
          *(LAS v2u*)dst = (v2u){o.x, o.y}; *(LAS v2u*)(dst + 8) = (v2u){o.z, o.w}; } }
    __syncthreads();
    v4u uraw[8];
    { const bf16* urow0 = Z + (tok0 + 16 * F.wave + (F.lane & 15)) * 4096 + gg * 256 + 64 * (F.lane >> 4);
#pragma unroll
      for (int j = 0; j < 8; ++j) uraw[j] = *(const v4u*)(urow0 + 8 * j); }
    f32x4 acc[16];
#pragma unroll
    for (int nt = 0; nt < 16; ++nt) acc[nt] = (f32x4){0.f, 0.f, 0.f, 0.f};
    const int ksteps = (16 * F.wave + 16 + 31) >> 5;
    const LAS bf16* wp = Ws + (16 * F.wave + (F.lane & 15)) * 136 + (F.lane >> 4) * 8;
    const LAS unsigned char* vp = Vs + (8 * (F.lane >> 4) + ((F.lane & 15) >> 2)) * RS + (F.lane & 3) * BS;
#pragma unroll 1
    for (int kk = 0; kk < ksteps; ++kk) {
        const bf16x8 wf = *(const LAS bf16x8*)(wp + kk * 32);
        const LAS unsigned char* vk = vp + kk * 32 * RS;
#pragma unroll
        for (int nt = 0; nt < 16; ++nt) {
            const s16x4 lo = ds_tr16(vk + 8 * nt), hi4 = ds_tr16(vk + 4 * RS + 8 * nt);
            const bf16x8 vf = {lo[0], lo[1], lo[2], lo[3], hi4[0], hi4[1], hi4[2], hi4[3]};
            acc[nt] = __builtin_amdgcn_mfma_f32_16x16x32_bf16(vf, wf, acc[nt], 0, 0, 0);
        }
    }
    { const int tr = 16 * F.wave + (F.lane & 15), g = F.lane >> 4; const float bs = F.sgu_bs[gg * 128 + tr];
      bf16* orow = (bf16*)(F.ws + WS_O) + (tok0 + tr) * SGW + gg * 256 + 64 * g;
#pragma unroll
      for (int j = 0; j < 8; ++j) { float u[8]; unpack8(uraw[j], u);
#pragma unroll
          for (int i = 0; i < 4; ++i) { u[i] *= acc[2 * j][i] + bs; u[4 + i] *= acc[2 * j + 1][i] + bs; }
          *(v4u*)(orow + 8 * j) = pack8(u); } }
    __syncthreads();
}


__device__ __forceinline__ void moe_tail_copies(Frame& F, int set) {
    const int np = ((const LAS int*)(F.lds + TAB_OFF))[16];
    int cthr = 4 * np - 2 * F.G; cthr = cthr < 0 ? 0 : (cthr > F.G - 64 ? F.G - 64 : cthr);
    __syncthreads();
    if (F.bid >= cthr) tr_run(F, set, (F.bid - cthr) * 8 + F.wave, (F.G - cthr) * 8);
}
constexpr int NPHASE = 18;
struct Args { const void* in[26]; float* out; unsigned char* ws; int ph_lo, ph_hi, use_bar, pad; };
__global__ void __launch_bounds__(512, 2) trunk_fwd(Args args) {
    extern __shared__ __attribute__((aligned(16))) unsigned char lds[];
    Frame F;
    F.lds = (LAS unsigned char*)lds;
    F.MISC = (volatile LAS unsigned*)(F.lds + MISC_OFF);
    F.tid = threadIdx.x; F.lane = F.tid & 63; F.wave = __builtin_amdgcn_readfirstlane(F.tid >> 6);
    F.G = gridDim.x; F.bid = blockIdx.x;
    F.ws = args.ws; F.out = args.out; F.dout_b = (unsigned char*)args.out;
    F.ctl = (gu32*)(args.ws + WS_CTL);
    F.x = (const float*)args.in[0]; F.c = (const float*)args.in[1]; F.positions = (const int*)args.in[2]; F.w_ada = (const float*)args.in[3]; F.b_ada = (const float*)args.in[4];
    F.norm_g = (const float*)args.in[5]; F.w_in_ab = (const float*)args.in[6]; F.w_out_ab = (const float*)args.in[7]; F.gla_w2 = (const float*)args.in[8]; F.gla_bg = (const float*)args.in[9];
    F.gla_ng = (const float*)args.in[10]; F.q_gain = (const float*)args.in[11]; F.k_gain = (const float*)args.in[12]; F.cmp_pe = (const float*)args.in[13]; F.cmp_w1 = (const float*)args.in[14];
    F.cmp_w2 = (const float*)args.in[15]; F.w_in_c = (const float*)args.in[16]; F.sgu_ng = (const float*)args.in[17]; F.sgu_ws = (const float*)args.in[18]; F.sgu_bs = (const float*)args.in[19];
    F.w_out_c = (const float*)args.in[20]; F.w_router = (const float*)args.in[21]; F.r_bias = (const float*)args.in[22]; F.w_gate = (const float*)args.in[23]; F.w_up = (const float*)args.in[24];
    F.w_down = (const float*)args.in[25];
    for (int u = F.tid; u < (LDS_BYTES - LDSCTL_OFF) / 4; u += 512) ((LAS unsigned*)(F.lds + LDSCTL_OFF))[u] = 0u;
    __syncthreads();
    XcdBarrier bar; bar.bar = (unsigned*)(F.ctl + CW_BAR); bar.x = 0; bar.st = nullptr;
    if (args.use_bar) bar = xcd_barrier_post((unsigned*)(F.ctl + CW_BAR) + (args.use_bar - 1) * XCD_BAR_WORDS, F.MISC + 8);
    const int lo = args.ph_lo, hi = args.ph_hi;
#ifndef PH_MASK
#define PH_MASK 0x3FFFFu
#endif
#define IN(k) ((((PH_MASK) >> (k)) & 1u) && lo <= (k) && (k) < hi)
#if defined(SPIN_PHASE)
    unsigned long long t_mark = __builtin_amdgcn_s_memrealtime();
#define SPIN_HOOK(k) do { if ((k) == (SPIN_PHASE)) { const unsigned long long t1_ = __builtin_amdgcn_s_memrealtime(), dt_ = t1_ - t_mark; while (__builtin_amdgcn_s_memrealtime() - t1_ < dt_) __builtin_amdgcn_s_sleep(4); } } while (0)
#define SPIN_MARK() do { t_mark = __builtin_amdgcn_s_memrealtime(); } while (0)
#else
#define SPIN_HOOK(k) do { } while (0)
#define SPIN_MARK() do { } while (0)
#endif
#define SEAM(k) do { if (IN(k)) SPIN_HOOK(k); if (IN(k) && IN((k) + 1)) xcd_barrier(bar); SPIN_MARK(); } while (0)
    float* mod = (float*)(F.ws + WS_MOD);
    bf16* Hb = (bf16*)(F.ws + WS_O);
    bf16* Ab = (bf16*)(F.ws + WS_A);

    if (IN(0)) { p0_prologue(F); } SEAM(0);
    if (IN(1)) { row_pass<false, true, false>(F, F.x, mod, 0, F.norm_g, mod, 0, 0); } SEAM(1);
    if (IN(2)) { pg8::Gemm g{Hb, (const bf16*)(F.ws + WS_WIN), NTOK, NPROJ, DM}; pg8::StaticOrder S; S.init(NTOK, NPROJ, F.G, F.bid);
        pg8::EpiBf16<0> E{Ab, NPROJ, nullptr, 0, 0, 1.f};
        pg8::gemm_phase<pg8::EpiBf16<0>, pg8::StaticOrder, true, true>(F.lds + RING_OFF, g, S, E); } SEAM(2);
    if (IN(3)) {
        for (int it = F.bid; it < 1024; it += F.G) gla_prep_item(F, it);
        { int tok = F.bid * 8 + F.wave; const int tstep = F.G * 8; PrepRaw cur, nxt; nxt.pos = 0; nxt.ng = 0u; nxt.r0 = (v4u){0u, 0u, 0u, 0u}; nxt.r1 = nxt.r0; nxt.r2 = nxt.r0;
          if (tok < NTOK) nsa_prep_load(F, tok, cur);
          while (tok < NTOK) { const int ntok = tok + tstep; if (ntok < NTOK) nsa_prep_load(F, ntok, nxt); nsa_prep_token(F, tok, cur); cur = nxt; tok = ntok; } }
    } SEAM(3);
    if (IN(4)) {
        const int half = F.G >> 1;
        if (F.bid < half) { for (int it = F.bid; it < 128; it += half) nsa_compress_item(F, it); }
        else { for (int gi = (F.bid - half) * 512 + F.tid; gi < 65536; gi += (F.G - half) * 512) gla_scan(F, gi); }
    } SEAM(4);
    if (IN(5)) {
#ifndef NO_NSA
        { const int p = F.bid & 255, bg = p >> 6, i = p & 63; nsa_item(F, bg >> 1, bg & 1, i); nsa_item(F, bg >> 1, bg & 1, 127 - i); }
#endif
#ifndef NO_GLAOUT
#if defined(GLA_SPIN)
        { const unsigned long long tg0 = __builtin_amdgcn_s_memrealtime();
#endif
        for (int it = F.bid; it < 1024; it += F.G) gla_out_item(F, it);
#if defined(GLA_SPIN)
          const unsigned long long t1_ = __builtin_amdgcn_s_memrealtime(), dt_ = t1_ - tg0; while (__builtin_amdgcn_s_memrealtime() - t1_ < dt_) __builtin_amdgcn_s_sleep(4); }
#endif
#endif
    } SEAM(5);
    if (IN(6)) { pg8::Gemm g{(const bf16*)(F.ws + WS_O + 32 * MiB), (const bf16*)(F.ws + WS_WOUT), NTOK, DM, DM}; pg8::StaticOrder S; S.init(NTOK, DM, F.G, F.bid);
        EpiResid E{F.x, F.out, mod + 2 * 1024};
        pg8::gemm_phase<EpiResid, pg8::StaticOrder, true, true>(F.lds + RING_OFF, g, S, E); } SEAM(6);
#define MOE_BLOCK(P, LAYER) \
    if (IN(P)) { row_pass<false, true, true>(F, F.out, mod + (LAYER) * 2 * 6144, 3 * 1024, F.norm_g + ((LAYER) * 2 + 1) * 1024, mod, (LAYER), 0); } SEAM(P); \
    if (IN((P) + 1)) { moe_tables(F, (LAYER)); MoeOrder S{(const LAS int*)(F.lds + TAB_OFF), F.G, F.bid}; \
        { LAS unsigned* rofs = (LAS unsigned*)(F.lds + TAB_OFF + 2048); const int* elist = (const int*)(F.ws + WS_STATS); pg8::Unit uu; \
          for (int ui = 0; ui < 3; ++ui) if (S.next(ui, uu)) { if (F.tid < 256) rofs[ui * 256 + F.tid] = S.row_off(uu, F.tid, elist); } \
          __syncthreads(); } \
        pg8::Gemm g{Hb, (const bf16*)(F.ws + WS_WGU) + (size_t)(LAYER) * 16 * 1024 * 1024, MOE_ROWS, 1024, DM}; EpiMoeGU E{(bf16*)(F.ws + WS_A + A_HID_OFF)}; \
        pg8::gemm_phase_gather<EpiMoeGU, MoeOrder>(F.lds + RING_OFF, g, S, E, (const LAS unsigned*)(F.lds + TAB_OFF + 2048)); \
        if ((LAYER) == 0) moe_tail_copies(F, 1); } SEAM((P) + 1); \
    if (IN((P) + 2)) { moe_tables(F, (LAYER)); MoeOrder S{(const LAS int*)(F.lds + TAB_OFF), F.G, F.bid}; \
        pg8::Gemm g{(const bf16*)(F.ws + WS_A + A_HID_OFF), (const bf16*)(F.ws + WS_WDN) + (size_t)(LAYER) * 16 * 1024 * 512, MOE_ROWS, 1024, EHID}; EpiMoeDn E{Ab}; \
        pg8::gemm_phase<EpiMoeDn, MoeOrder, true, true>(F.lds + RING_OFF, g, S, E); \
        if ((LAYER) == 0) moe_tail_copies(F, 2); } SEAM((P) + 2);
    MOE_BLOCK(7, 0)
    if (IN(10)) { row_pass<true, true, false>(F, F.out, mod + 2 * 6144, 0, F.norm_g + 2 * 1024, mod, 1, 0); } SEAM(10);
    if (IN(11)) { pg8::Gemm g{Hb, (const bf16*)(F.ws + WS_WINC), NTOK, 4096, DM}; pg8::StaticOrder S; S.init(NTOK, 4096, F.G, F.bid);
        EpiGeluStats E{Ab, (float*)(F.ws + WS_STATS)};
        pg8::gemm_phase<EpiGeluStats, pg8::StaticOrder, true, true>(F.lds + RING_OFF, g, S, E); } SEAM(11);
    if (IN(12)) { for (int it = F.bid; it < 1024; it += F.G) sgu_item(F, it); } SEAM(12);
    if (IN(13)) { pg8::Gemm g{Hb, (const bf16*)(F.ws + WS_WOUTC), NTOK, DM, SGW}; pg8::StaticOrder S; S.init(NTOK, DM, F.G, F.bid);
        EpiResid E{F.out, F.out, mod + 2 * 6144 + 2 * 1024};
        pg8::gemm_phase<EpiResid, pg8::StaticOrder, true, true>(F.lds + RING_OFF, g, S, E); } SEAM(13);
    MOE_BLOCK(14, 1)
    if (IN(17)) { row_pass<true, false, false>(F, F.out, mod, 0, F.norm_g, mod + 2 * 6144, 1, 1); SPIN_HOOK(17); }
#undef IN
#undef SEAM
#undef MOE_BLOCK
}

#ifndef MK_N_LAUNCHES
#define MK_N_LAUNCHES 1
#endif
extern "C" void kernel_launch(void* const* d_in, const int* in_sizes, int n_in, void* d_out, int out_size, void* d_ws, size_t ws_size, hipStream_t stream) {
    static int grid = 0;
    if (grid == 0) {
        if (n_in != 26 || out_size != NTOK * DM || ws_size < WS_END) { fprintf(stderr, "kernel_launch: unexpected problem shape / workspace (%d inputs, out %d, ws %zu)\n", n_in, out_size, ws_size); grid = -1; return; }
        int dev = 0, cus = 0, per_cu = 0;
        if (hipGetDevice(&dev) != hipSuccess || hipDeviceGetAttribute(&cus, hipDeviceAttributeMultiprocessorCount, dev) != hipSuccess) { grid = -1; return; }
        if (hipFuncSetAttribute((const void*)trunk_fwd, hipFuncAttributeMaxDynamicSharedMemorySize, LDS_BYTES) != hipSuccess) { fprintf(stderr, "kernel_launch: hipFuncSetAttribute failed\n"); grid = -1; return; }
        if (hipOccupancyMaxActiveBlocksPerMultiprocessor(&per_cu, (const void*)trunk_fwd, 512, LDS_BYTES) != hipSuccess || per_cu < 1) { fprintf(stderr, "kernel_launch: occupancy query says %d blocks per CU\n", per_cu); }
        (void)hipGetLastError();
        grid = cus;
        if (grid != 256) { fprintf(stderr, "kernel_launch: built for a 256-CU device, found %d CUs\n", cus); grid = -1; return; }
    }
    if (grid < 0) return;
    (void)hipMemsetAsync((char*)d_ws + WS_CTL, 0, CTL_ZERO_BYTES, stream);
    Args a{};
    for (int i = 0; i < 26; ++i) a.in[i] = d_in[i];
    a.out = (float*)d_out; a.ws = (unsigned char*)d_ws; a.pad = 0;
    if (MK_N_LAUNCHES == 1) {
#if defined(REP_PHASE)
        a.ph_lo = 0; a.ph_hi = REP_PHASE + 1; a.use_bar = 1;
        hipLaunchKernelGGL(trunk_fwd, dim3(grid), dim3(512), LDS_BYTES, stream, a);
        a.ph_lo = REP_PHASE; a.ph_hi = NPHASE; a.use_bar = 2;
        hipLaunchKernelGGL(trunk_fwd, dim3(grid), dim3(512), LDS_BYTES, stream, a);
#else
        a.ph_lo = 0; a.ph_hi = NPHASE; a.use_bar = 1;
        hipLaunchKernelGGL(trunk_fwd, dim3(grid), dim3(512), LDS_BYTES, stream, a);
#endif
    } else {
        for (int p = 0; p < NPHASE; ++p) { a.ph_lo = p; a.ph_hi = p + 1; a.use_bar = 0; hipLaunchKernelGGL(trunk_fwd, dim3(grid), dim3(512), LDS_BYTES, stream, a); }
    }
}
```

```cpp
#include <hip/hip_runtime.h>
#include <cstdio>
#include <cstdint>
namespace pg8 {
#define PG8_LAS __attribute__((address_space(3)))
typedef unsigned short bf16_t;
typedef short bf16x8 __attribute__((ext_vector_type(8)));
typedef float f32x4 __attribute__((ext_vector_type(4)));
typedef unsigned u32x4 __attribute__((ext_vector_type(4)));
constexpr int BM = 256, BK = 64, HALF = 128, HTB = HALF * BK * 2  , STAGE_BYTES = 8 * HTB, NXCD = 8, WGM = 8;

__host__ __device__ __forceinline__ int lds_byte(int r, int c) { const int st = (r >> 4) * 2 + (c >> 5), rr = r & 15, cc = c & 31, ob = rr * 64 + cc * 2; return st * 1024 + (ob ^ (((ob >> 9) & 1) << 5)); }
__host__ __device__ __forceinline__ void stage_rc(int b, int& R, int& C) { const int st = b / 1024, sb = b % 1024, swz = sb ^ (((sb >> 9) & 1) << 5); R = (st >> 1) * 16 + swz / 64; C = (st & 1) * 32 + (swz % 64) / 2; }
__host__ __device__ __forceinline__ int perm32(int rho) { const int n = rho >> 4, i = rho & 15; return 8 * (i >> 2) + 4 * n + (i & 3); }

struct Unit { int pm, pn; };
struct Gemm { const bf16_t* A; const bf16_t* Bt; int M, N, K; };

struct StaticOrder {
    int nM, nN, nwg, G, c;
    __host__ __device__ void init(int M, int N, int G_, int c_) { nM = M / BM; nN = N / BM; nwg = nM * nN; G = G_; c = c_; }
    __host__ __device__ bool next(int i, Unit& u) const {
        const long L = (long)i * G + c; if (L >= nwg) return false;
        int wgid = (int)L; { const int q = nwg / NXCD, r = nwg % NXCD, xcd = wgid % NXCD, off = wgid / NXCD; wgid = (xcd < r ? xcd * (q + 1) : r * (q + 1) + (xcd - r) * q) + off; }
        const int nig = WGM * nN, gid = wgid / nig, fm = gid * WGM, gsz = (nM - fm) < WGM ? (nM - fm) : WGM;
        u.pm = fm + ((wgid % nig) % gsz); u.pn = (wgid % nig) / gsz; return true;
    }
    __device__ __forceinline__ void a_ready(const Unit&) const {}
    __device__ __forceinline__ void done(const Unit&) const {}
};

__device__ __forceinline__ unsigned cvt_pk_bf16(float lo, float hi) { unsigned r; asm volatile("v_cvt_pk_bf16_f32 %0, %1, %2" : "=v"(r) : "v"(lo), "v"(hi)); return r; }
typedef float f32x2 __attribute__((ext_vector_type(2)));
__device__ __forceinline__ f32x2 gelu_pk(f32x2 v) {
    const f32x2 av = __builtin_elementwise_abs(v), d = av * 0.2316418882f + 1.0f;
    f32x2 t; t.x = __builtin_amdgcn_rcpf(d.x); t.y = __builtin_amdgcn_rcpf(d.y);
    f32x2 q = t * 0.5307027145f + (-0.7265760135f); q = q * t + 0.7107068705f; q = q * t + (-0.142248368f); q = q * t + 0.127414796f; q = q * t;
    const f32x2 s = (v * v) * (-0.72134752044f);
    f32x2 e; e.x = __builtin_amdgcn_exp2f(s.x); e.y = __builtin_amdgcn_exp2f(s.y);
    const f32x2 m = v * (q * e), r = v - m;
    f32x2 o; o.x = v.x < 0.f ? m.x : r.x; o.y = v.y < 0.f ? m.y : r.y; return o;
}

template <int ACT  > struct EpiBf16 {
    static constexpr bool PERM = true, AFTER_DRAIN = false; static_assert(ACT == 0 || ACT == 1, "EpiBf16: ACT is 0 (none) or 1 (gelu_pk)");
    bf16_t* O; int ldc; const float* bias; int split_cols; size_t split_stride; float scale0;
    __device__ __forceinline__ void operator()(const f32x4 (&acc)[2][2][4][2], const Unit& u, int wr, int wc, int fr, int fq) const {
        const int row0 = u.pm * BM + wr * 64 + fr; int colt = u.pn * BM; bf16_t* base = O;
        float sc = 1.f; if (split_cols) { const int t = colt / split_cols; base += (size_t)t * split_stride; colt -= t * split_cols; if (t == 0) sc = scale0; }
        const int col0 = colt + wc * 32 + 8 * fq, bcol0 = u.pn * BM + wc * 32 + 8 * fq;
        f32x4 bv[2][2];
#pragma unroll
        for (int bj = 0; bj < 2; ++bj)
#pragma unroll
            for (int n = 0; n < 2; ++n) bv[bj][n] = bias ? *(const f32x4*)(bias + bcol0 + bj * HALF + 4 * n) : (f32x4){0.f, 0.f, 0.f, 0.f};
#pragma unroll
        for (int ai = 0; ai < 2; ++ai)
#pragma unroll
            for (int m = 0; m < 4; ++m) { bf16_t* rowp = base + (size_t)(row0 + ai * HALF + m * 16) * ldc + col0;
#pragma unroll
                for (int bj = 0; bj < 2; ++bj) { f32x4 v0 = acc[ai][bj][m][0] + bv[bj][0], v1 = acc[ai][bj][m][1] + bv[bj][1];
                    if (ACT == 1) { f32x2 a = gelu_pk((f32x2){v0[0], v0[1]}), b = gelu_pk((f32x2){v0[2], v0[3]}), c = gelu_pk((f32x2){v1[0], v1[1]}), d = gelu_pk((f32x2){v1[2], v1[3]});
                        v0 = (f32x4){a.x, a.y, b.x, b.y}; v1 = (f32x4){c.x, c.y, d.x, d.y}; }
                    v0 = v0 * sc; v1 = v1 * sc; u32x4 w; w.x = cvt_pk_bf16(v0[0], v0[1]); w.y = cvt_pk_bf16(v0[2], v0[3]); w.z = cvt_pk_bf16(v1[0], v1[1]); w.w = cvt_pk_bf16(v1[2], v1[3]);
                    *(u32x4*)(rowp + bj * HALF) = w; } }
    }
};

template <class Epi, class Sched, bool ALIGN_EPI = false, bool SP2 = false>
__device__ __forceinline__ void gemm_phase(PG8_LAS unsigned char* lds, const Gemm g, const Sched& S, const Epi& E) {
    const int tid = threadIdx.x, wid = __builtin_amdgcn_readfirstlane(tid >> 6), lane = tid & 63, wr = wid >> 2, wc = wid & 3, fr = lane & 15, fq = lane >> 4;
    const int K = g.K, nt = K / BK;
    unsigned voffA[2], voffB[2];
#pragma unroll
    for (int i = 0; i < 2; ++i) { int R, C; stage_rc(tid * 16 + i * 8192, R, C); const int Rb = Epi::PERM ? ((R & ~31) + perm32(R & 31)) : R;
        voffA[i] = (unsigned)(R * K + C) * 2u; voffB[i] = (unsigned)(Rb * K + C) * 2u; }
    const size_t kstep = (size_t)(BK * 2);
    const size_t hstep = (size_t)HALF * K * 2;
    const size_t tstep = 2 * hstep;
    const unsigned ldsw = (unsigned)wid * 1024u;
    const int aoff = lds_byte(wr * 64 + fr, fq * 8), boff = lds_byte(wc * 32 + fr, fq * 8);
#define PG8_SA(b, h) (((b) * 2 + (h)) * HTB)
#define PG8_SB(b, h) ((4 + (b) * 2 + (h)) * HTB)
#define PG8_STAGE(bufoff, gbase, voff) do { _Pragma("unroll") for (int _i = 0; _i < 2; ++_i) \
        __builtin_amdgcn_global_load_lds((const unsigned*)((const char*)(gbase) + (voff)[_i]), (PG8_LAS unsigned*)(lds + (bufoff) + ldsw + _i * 8192), 16, 0, 0); } while (0)
#define PG8_LDA(dst, b, h) do { _Pragma("unroll") for (int m = 0; m < 4; ++m) _Pragma("unroll") for (int k = 0; k < 2; ++k) dst[m][k] = *(const PG8_LAS bf16x8*)(lds + PG8_SA(b, h) + aoff + m * 2048 + k * 1024); } while (0)
#define PG8_LDB(dst, b, h) do { _Pragma("unroll") for (int n = 0; n < 2; ++n) _Pragma("unroll") for (int k = 0; k < 2; ++k) dst[n][k] = *(const PG8_LAS bf16x8*)(lds + PG8_SB(b, h) + boff + n * 2048 + k * 1024); } while (0)
#define PG8_MMA(ai, bj, At, Bt) do { __builtin_amdgcn_s_setprio(1); _Pragma("unroll") for (int m = 0; m < 4; ++m) _Pragma("unroll") for (int n = 0; n < 2; ++n) _Pragma("unroll") for (int k = 0; k < 2; ++k) \
        acc[ai][bj][m][n] = __builtin_amdgcn_mfma_f32_16x16x32_bf16(Bt[n][k], At[m][k], acc[ai][bj][m][n], 0, 0, 0); __builtin_amdgcn_s_setprio(0); } while (0)
#define PG8_WAIT_V(n) asm volatile("s_waitcnt vmcnt(" #n ")" ::: "memory")
#define PG8_WAIT_L(n) asm volatile("s_waitcnt lgkmcnt(" #n ")" ::: "memory")
#define PG8_BAR __builtin_amdgcn_s_barrier()
#define PG8_SCHED __builtin_amdgcn_sched_barrier(0)
    Unit cur, nxt; int ui = 0;
    if (!S.next(0, cur)) return;
    f32x4 acc[2][2][4][2];
#pragma unroll
    for (int a = 0; a < 2; ++a)
#pragma unroll
        for (int b = 0; b < 2; ++b)
#pragma unroll
            for (int m = 0; m < 4; ++m)
#pragma unroll
                for (int n = 0; n < 2; ++n) acc[a][b][m][n] = (f32x4){0.f, 0.f, 0.f, 0.f};
    bf16x8 At[4][2], B0[2][2], B1[2][2];
    const char* cA = (const char*)g.A + (size_t)cur.pm * tstep; const char* cB = (const char*)g.Bt + (size_t)cur.pn * tstep;
    S.a_ready(cur);
    if constexpr (SP2) {
        PG8_STAGE(PG8_SB(0, 0), cB, voffB); PG8_STAGE(PG8_SB(0, 1), cB + hstep, voffB); PG8_STAGE(PG8_SA(0, 0), cA, voffA); PG8_STAGE(PG8_SA(0, 1), cA + hstep, voffA);
        if (wr == 1) PG8_BAR;
        PG8_WAIT_V(2); PG8_BAR;
        PG8_STAGE(PG8_SB(1, 0), cB + kstep, voffB); PG8_STAGE(PG8_SA(1, 0), cA + kstep, voffA); PG8_STAGE(PG8_SB(1, 1), cB + hstep + kstep, voffB);
        PG8_WAIT_V(6); PG8_BAR;
    } else {
        PG8_STAGE(PG8_SB(0, 0), cB, voffB); PG8_STAGE(PG8_SA(0, 0), cA, voffA); PG8_STAGE(PG8_SB(0, 1), cB + hstep, voffB); PG8_STAGE(PG8_SA(0, 1), cA + hstep, voffA);
        if (wr == 1) PG8_BAR;
        PG8_WAIT_V(4); PG8_BAR;
        PG8_STAGE(PG8_SB(1, 0), cB + kstep, voffB); PG8_STAGE(PG8_SA(1, 0), cA + kstep, voffA); PG8_STAGE(PG8_SB(1, 1), cB + hstep + kstep, voffB);
        PG8_WAIT_V(6); PG8_BAR;
    }
    for (;;) {
        const bool has_next = S.next(ui + 1, nxt);
        const char* nA = has_next ? (const char*)g.A + (size_t)nxt.pm * tstep : cA; const char* nB = has_next ? (const char*)g.Bt + (size_t)nxt.pn * tstep : cB;
        for (int t = 0; t < nt; t += 2) {
            const bool last = (t == nt - 2);
            const char* a1 = cA + (size_t)(t + 1) * kstep;
            const char* a2 = last ? nA : cA + (size_t)(t + 2) * kstep; const char* b2 = last ? nB : cB + (size_t)(t + 2) * kstep;
            const char* a3 = a2 + kstep; const char* b3 = b2 + kstep;
            if (last && has_next) S.a_ready(nxt);
            if constexpr (SP2) {
            PG8_LDB(B0, 0, 0); PG8_LDB(B1, 0, 1); PG8_SCHED; PG8_LDA(At, 0, 0); PG8_STAGE(PG8_SA(1, 1), a1 + hstep, voffA);
            PG8_WAIT_V(8); PG8_WAIT_L(0); PG8_BAR; PG8_MMA(0, 0, At, B0); PG8_MMA(0, 1, At, B1); PG8_BAR; PG8_SCHED;
            PG8_LDA(At, 0, 1); PG8_STAGE(PG8_SB(0, 0), b2, voffB); PG8_STAGE(PG8_SB(0, 1), b2 + hstep, voffB); PG8_STAGE(PG8_SA(0, 0), a2, voffA);
            PG8_WAIT_V(8); PG8_WAIT_L(0); PG8_BAR; PG8_MMA(1, 0, At, B0); PG8_MMA(1, 1, At, B1); PG8_BAR; PG8_SCHED;
            PG8_LDB(B0, 1, 0); PG8_LDB(B1, 1, 1); PG8_SCHED; PG8_LDA(At, 1, 0); PG8_STAGE(PG8_SA(0, 1), a2 + hstep, voffA);
            PG8_WAIT_V(8); PG8_WAIT_L(0); PG8_BAR; PG8_MMA(0, 0, At, B0); PG8_MMA(0, 1, At, B1); PG8_BAR; PG8_SCHED;
            PG8_LDA(At, 1, 1); PG8_STAGE(PG8_SB(1, 0), b3, voffB); PG8_STAGE(PG8_SB(1, 1), b3 + hstep, voffB); PG8_STAGE(PG8_SA(1, 0), a3, voffA);
            PG8_WAIT_V(8); PG8_WAIT_L(0); PG8_BAR; PG8_MMA(1, 0, At, B0); PG8_MMA(1, 1, At, B1); PG8_BAR; PG8_SCHED;
            } else {
            PG8_LDB(B0, 0, 0); PG8_SCHED; PG8_LDA(At, 0, 0); PG8_STAGE(PG8_SA(1, 1), a1 + hstep, voffA);
            PG8_WAIT_L(8); PG8_BAR; PG8_WAIT_L(0); PG8_MMA(0, 0, At, B0); PG8_BAR; PG8_SCHED;
            PG8_LDB(B1, 0, 1); PG8_STAGE(PG8_SB(0, 0), b2, voffB);
            PG8_BAR; PG8_WAIT_L(0); PG8_MMA(0, 1, At, B1); PG8_BAR;
            PG8_LDA(At, 0, 1); PG8_STAGE(PG8_SA(0, 0), a2, voffA);
            PG8_BAR; PG8_WAIT_L(0); PG8_MMA(1, 0, At, B0); PG8_BAR; PG8_SCHED;
            PG8_STAGE(PG8_SB(0, 1), b2 + hstep, voffB);
            PG8_WAIT_V(6); PG8_BAR; PG8_MMA(1, 1, At, B1); PG8_BAR;
            PG8_LDB(B0, 1, 0); PG8_SCHED; PG8_LDA(At, 1, 0); PG8_STAGE(PG8_SA(0, 1), a2 + hstep, voffA);
            PG8_WAIT_L(8); PG8_BAR; PG8_WAIT_L(0); PG8_MMA(0, 0, At, B0); PG8_BAR; PG8_SCHED;
            PG8_LDB(B1, 1, 1); PG8_STAGE(PG8_SB(1, 0), b3, voffB);
            PG8_BAR; PG8_WAIT_L(0); PG8_MMA(0, 1, At, B1); PG8_BAR;
            PG8_LDA(At, 1, 1); PG8_STAGE(PG8_SA(1, 0), a3, voffA);
            PG8_BAR; PG8_WAIT_L(0); PG8_MMA(1, 0, At, B0); PG8_BAR; PG8_SCHED;
            PG8_STAGE(PG8_SB(1, 1), b3 + hstep, voffB);
            PG8_WAIT_V(6); PG8_BAR; PG8_MMA(1, 1, At, B1); PG8_BAR;
            }
        }
        if constexpr (ALIGN_EPI) { if (wr == 0) PG8_BAR; }
        if constexpr (!Epi::AFTER_DRAIN) { E(acc, cur, wr, wc, fr, fq); S.done(cur); }
        if (!has_next) break;
#pragma unroll
        for (int a = 0; a < 2; ++a)
#pragma unroll
            for (int b = 0; b < 2; ++b)
#pragma unroll
                for (int m = 0; m < 4; ++m)
#pragma unroll
                    for (int n = 0; n < 2; ++n) acc[a][b][m][n] = (f32x4){0.f, 0.f, 0.f, 0.f};
        cur = nxt; cA = nA; cB = nB; ++ui;
        if constexpr (ALIGN_EPI) { if (wr == 1) PG8_BAR; }
    }
    PG8_WAIT_V(0);
    if constexpr (!ALIGN_EPI) { if (wr == 0) PG8_BAR; }
    PG8_BAR;
    if constexpr (Epi::AFTER_DRAIN) { E.fused(acc, cur, wr, wc, fr, fq, lds, wid, lane); S.done(cur); }
#undef PG8_SA
#undef PG8_SB
#undef PG8_STAGE
#undef PG8_LDA
#undef PG8_LDB
#undef PG8_MMA
#undef PG8_WAIT_V
#undef PG8_WAIT_L
#undef PG8_BAR
#undef PG8_SCHED
}
}

#ifndef PG8_SP2
#define PG8_SP2 true
#endif

namespace pg8 {
template <class Epi, class Sched>
__device__ __forceinline__ void gemm_phase_gather(PG8_LAS unsigned char* lds, const Gemm g, const Sched& S, const Epi& E, const PG8_LAS unsigned* rofs) {
    const int tid = threadIdx.x, wid = __builtin_amdgcn_readfirstlane(tid >> 6), lane = tid & 63, wr = wid >> 2, wc = wid & 3, fr = lane & 15, fq = lane >> 4;
    const int K = g.K, nt = K / BK;
    unsigned voffB[2]; int RA[2]; unsigned CA[2];
#pragma unroll
    for (int i = 0; i < 2; ++i) { int R, C; stage_rc(tid * 16 + i * 8192, R, C); const int Rb = Epi::PERM ? ((R & ~31) + perm32(R & 31)) : R;
        RA[i] = R; CA[i] = (unsigned)C * 2u; voffB[i] = (unsigned)(Rb * K + C) * 2u; }
    const size_t kstep = (size_t)(BK * 2);
    const size_t hstep = (size_t)HALF * K * 2;
    const size_t tstep = 2 * hstep;
    const unsigned ldsw = (unsigned)wid * 1024u;
    const int aoff = lds_byte(wr * 64 + fr, fq * 8), boff = lds_byte(wc * 32 + fr, fq * 8);
#define PG8_SA(b, h) (((b) * 2 + (h)) * HTB)
#define PG8_SB(b, h) ((4 + (b) * 2 + (h)) * HTB)
#define PG8_STAGE(bufoff, gbase, voff) do { _Pragma("unroll") for (int _i = 0; _i < 2; ++_i) \
        __builtin_amdgcn_global_load_lds((const unsigned*)((const char*)(gbase) + (voff)[_i]), (PG8_LAS unsigned*)(lds + (bufoff) + ldsw + _i * 8192), 16, 0, 0); } while (0)
#define PG8_STAGE_A(bufoff, koff, v0, v1) do { \
        __builtin_amdgcn_global_load_lds((const unsigned*)((const char*)g.A + (koff) + (v0)), (PG8_LAS unsigned*)(lds + (bufoff) + ldsw), 16, 0, 0); \
        __builtin_amdgcn_global_load_lds((const unsigned*)((const char*)g.A + (koff) + (v1)), (PG8_LAS unsigned*)(lds + (bufoff) + ldsw + 8192), 16, 0, 0); } while (0)
#define PG8_LDA(dst, b, h) do { _Pragma("unroll") for (int m = 0; m < 4; ++m) _Pragma("unroll") for (int k = 0; k < 2; ++k) dst[m][k] = *(const PG8_LAS bf16x8*)(lds + PG8_SA(b, h) + aoff + m * 2048 + k * 1024); } while (0)
#define PG8_LDB(dst, b, h) do { _Pragma("unroll") for (int n = 0; n < 2; ++n) _Pragma("unroll") for (int k = 0; k < 2; ++k) dst[n][k] = *(const PG8_LAS bf16x8*)(lds + PG8_SB(b, h) + boff + n * 2048 + k * 1024); } while (0)
#define PG8_MMA(ai, bj, At, Bt) do { __builtin_amdgcn_s_setprio(1); _Pragma("unroll") for (int m = 0; m < 4; ++m) _Pragma("unroll") for (int n = 0; n < 2; ++n) _Pragma("unroll") for (int k = 0; k < 2; ++k) \
        acc[ai][bj][m][n] = __builtin_amdgcn_mfma_f32_16x16x32_bf16(Bt[n][k], At[m][k], acc[ai][bj][m][n], 0, 0, 0); __builtin_amdgcn_s_setprio(0); } while (0)
#define PG8_WAIT_V(n) asm volatile("s_waitcnt vmcnt(" #n ")" ::: "memory")
#define PG8_WAIT_L(n) asm volatile("s_waitcnt lgkmcnt(" #n ")" ::: "memory")
#define PG8_BAR __builtin_amdgcn_s_barrier()
#define PG8_SCHED __builtin_amdgcn_sched_barrier(0)
    Unit cur, nxt; int ui = 0;
    if (!S.next(0, cur)) return;
    f32x4 acc[2][2][4][2];
#pragma unroll
    for (int a = 0; a < 2; ++a)
#pragma unroll
        for (int b = 0; b < 2; ++b)
#pragma unroll
            for (int m = 0; m < 4; ++m)
#pragma unroll
                for (int n = 0; n < 2; ++n) acc[a][b][m][n] = (f32x4){0.f, 0.f, 0.f, 0.f};
    bf16x8 At[4][2], B0[2][2], B1[2][2];
    const char* cB = (const char*)g.Bt + (size_t)cur.pn * tstep;
    unsigned vc00 = rofs[RA[0]] + CA[0], vc01 = rofs[RA[1]] + CA[1], vc10 = rofs[128 + RA[0]] + CA[0], vc11 = rofs[128 + RA[1]] + CA[1];
    unsigned vn00 = vc00, vn01 = vc01, vn10 = vc10, vn11 = vc11;
    PG8_WAIT_L(0);
    PG8_STAGE(PG8_SB(0, 0), cB, voffB); PG8_STAGE(PG8_SB(0, 1), cB + hstep, voffB); PG8_STAGE_A(PG8_SA(0, 0), 0, vc00, vc01); PG8_STAGE_A(PG8_SA(0, 1), 0, vc10, vc11);
    if (wr == 1) PG8_BAR;
    PG8_WAIT_V(2); PG8_BAR;
    PG8_STAGE(PG8_SB(1, 0), cB + kstep, voffB); PG8_STAGE_A(PG8_SA(1, 0), kstep, vc00, vc01); PG8_STAGE(PG8_SB(1, 1), cB + hstep + kstep, voffB);
    PG8_WAIT_V(6); PG8_BAR;
    for (;;) {
        const bool has_next = S.next(ui + 1, nxt);
        const char* nB = has_next ? (const char*)g.Bt + (size_t)nxt.pn * tstep : cB;
        if (has_next) { const PG8_LAS unsigned* rn = rofs + (ui + 1) * 256; vn00 = rn[RA[0]] + CA[0]; vn01 = rn[RA[1]] + CA[1]; vn10 = rn[128 + RA[0]] + CA[0]; vn11 = rn[128 + RA[1]] + CA[1]; }
        else { vn00 = vc00; vn01 = vc01; vn10 = vc10; vn11 = vc11; }
        for (int t = 0; t < nt; t += 2) {
            const bool last = (t == nt - 2);
            const size_t k1 = (size_t)(t + 1) * kstep;
            const size_t k2 = last ? 0 : (size_t)(t + 2) * kstep; const char* b2 = last ? nB : cB + (size_t)(t + 2) * kstep;
            const size_t k3 = k2 + kstep; const char* b3 = b2 + kstep;
            const unsigned w00 = last ? vn00 : vc00, w01 = last ? vn01 : vc01, w10 = last ? vn10 : vc10, w11 = last ? vn11 : vc11;
            PG8_LDB(B0, 0, 0); PG8_LDB(B1, 0, 1); PG8_SCHED; PG8_LDA(At, 0, 0); PG8_STAGE_A(PG8_SA(1, 1), k1, vc10, vc11);
            PG8_WAIT_V(8); PG8_WAIT_L(0); PG8_BAR; PG8_MMA(0, 0, At, B0); PG8_MMA(0, 1, At, B1); PG8_BAR; PG8_SCHED;
            PG8_LDA(At, 0, 1); PG8_STAGE(PG8_SB(0, 0), b2, voffB); PG8_STAGE(PG8_SB(0, 1), b2 + hstep, voffB); PG8_STAGE_A(PG8_SA(0, 0), k2, w00, w01);
            PG8_WAIT_V(8); PG8_WAIT_L(0); PG8_BAR; PG8_MMA(1, 0, At, B0); PG8_MMA(1, 1, At, B1); PG8_BAR; PG8_SCHED;
            PG8_LDB(B0, 1, 0); PG8_LDB(B1, 1, 1); PG8_SCHED; PG8_LDA(At, 1, 0); PG8_STAGE_A(PG8_SA(0, 1), k2, w10, w11);
            PG8_WAIT_V(8); PG8_WAIT_L(0); PG8_BAR; PG8_MMA(0, 0, At, B0); PG8_MMA(0, 1, At, B1); PG8_BAR; PG8_SCHED;
            PG8_LDA(At, 1, 1); PG8_STAGE(PG8_SB(1, 0), b3, voffB); PG8_STAGE(PG8_SB(1, 1), b3 + hstep, voffB); PG8_STAGE_A(PG8_SA(1, 0), k3, w00, w01);
            PG8_WAIT_V(8); PG8_WAIT_L(0); PG8_BAR; PG8_MMA(1, 0, At, B0); PG8_MMA(1, 1, At, B1); PG8_BAR; PG8_SCHED;
        }
        if (wr == 0) PG8_BAR;
        E(acc, cur, wr, wc, fr, fq); S.done(cur);
        if (!has_next) break;
#pragma unroll
        for (int a = 0; a < 2; ++a)
#pragma unroll
            for (int b = 0; b < 2; ++b)
#pragma unroll
                for (int m = 0; m < 4; ++m)
#pragma unroll
                    for (int n = 0; n < 2; ++n) acc[a][b][m][n] = (f32x4){0.f, 0.f, 0.f, 0.f};
        cur = nxt; cB = nB; ++ui; vc00 = vn00; vc01 = vn01; vc10 = vn10; vc11 = vn11;
        if (wr == 1) PG8_BAR;
    }
    PG8_WAIT_V(0);
    PG8_BAR;
#undef PG8_SA
#undef PG8_SB
#undef PG8_STAGE
#undef PG8_STAGE_A
#undef PG8_LDA
#undef PG8_LDB
#undef PG8_MMA
#undef PG8_WAIT_V
#undef PG8_WAIT_L
#undef PG8_BAR
#undef PG8_SCHED
}
}

constexpr int NB = 2, SEQ = 8192, DM = 1024, NTOK = NB * SEQ;
constexpr int NPROJ = 3072;
constexpr int C_GQ = 0, C_GK = 256, C_GV = 512, C_GR = 1024, C_NQ = 1536, C_KC = 2048, C_VC = 2176, C_KS = 2304, C_VS = 2432, C_KW = 2560, C_VW = 2688, C_GLR = 2816, C_NG = 2832, C_END = 2856;
constexpr int SGW = 2048;
constexpr int NEXP = 16, EHID = 512;
constexpr int MOE_ROWS = 36864;
constexpr float NORM_EPS = 1e-6f;
constexpr float NEGBIG = -1e30f;

constexpr size_t MiB = 1u << 20;
constexpr size_t WS_CTL = 0, CTL_ZERO_BYTES = 1 * MiB;
constexpr size_t WS_MOD = 1 * MiB;
constexpr size_t WS_ROUTE = 2 * MiB;
constexpr size_t WS_GATES = 3 * MiB;
constexpr size_t WS_STATS = 5 * MiB;
constexpr size_t WS_DEC = 7 * MiB;
constexpr size_t WS_WIN = 8 * MiB;
constexpr size_t WS_WOUT = 14 * MiB;
constexpr size_t WS_WINC = 16 * MiB;
constexpr size_t WS_WOUTC = 24 * MiB;
constexpr size_t WS_WCW1 = 28 * MiB;
constexpr size_t WS_WGU = 30 * MiB;
constexpr size_t WS_WDN = 94 * MiB;
constexpr size_t WS_A = 126 * MiB;
constexpr size_t WS_O = 254 * MiB;
constexpr size_t WS_END = 318 * MiB;
constexpr size_t A_HID_OFF = 72 * MiB;
constexpr size_t DO_QN = 0;
constexpr size_t DO_KSEL = 16 * MiB, DO_VSEL = 20 * MiB, DO_KWIN = 24 * MiB, DO_VWIN = 28 * MiB;
constexpr size_t DO_KC = 32 * MiB, DO_VC = 36 * MiB + 65536;
constexpr size_t DO_KCMP = 41 * MiB, DO_VCMP = 41 * MiB + 512 * 1024;

constexpr int CW_TMO = 0, CW_CODE = 1;
constexpr int CW_BAR = 4096;
constexpr int CW_CNT = 16384;

constexpr int RING_OFF = 0, RING_BYTES = 131072;
constexpr int LDSCTL_OFF = RING_BYTES, MISC_OFF = LDSCTL_OFF + 320;
constexpr int TAB_OFF = LDSCTL_OFF + 1024;
constexpr int LDS_BYTES = 147456;

#define GAS __attribute__((address_space(1)))
#define LAS __attribute__((address_space(3)))
typedef unsigned short bf16;
typedef unsigned v4u __attribute__((ext_vector_type(4)));
typedef unsigned v2u __attribute__((ext_vector_type(2)));
typedef float f32x4 __attribute__((ext_vector_type(4)));
typedef float f32x2 __attribute__((ext_vector_type(2)));
typedef float f32x16 __attribute__((ext_vector_type(16)));
typedef short bf16x8 __attribute__((ext_vector_type(8)));
typedef short s16x4 __attribute__((ext_vector_type(4)));
typedef GAS unsigned gu32;
#define RLX_AGENT __ATOMIC_RELAXED, __HIP_MEMORY_SCOPE_AGENT
#define LDS_WAIT() asm volatile("s_waitcnt lgkmcnt(0)" ::: "memory")
#define VM_WAIT() asm volatile("s_waitcnt vmcnt(0)" ::: "memory")
__device__ __forceinline__ unsigned f2bf(float f) { unsigned u = __builtin_bit_cast(unsigned, f); return (u + 0x7fffu + ((u >> 16) & 1u)) >> 16; }
__device__ __forceinline__ unsigned pk2(float lo, float hi) { return f2bf(lo) | (f2bf(hi) << 16); }
__device__ __forceinline__ float bf2f(unsigned short b) { return __builtin_bit_cast(float, (unsigned)b << 16); }
__device__ __forceinline__ float bflo(unsigned w) { return __builtin_bit_cast(float, w << 16); }
__device__ __forceinline__ float bfhi(unsigned w) { return __builtin_bit_cast(float, w & 0xffff0000u); }
__device__ __forceinline__ float fexp2(float x) { return __builtin_amdgcn_exp2f(x); }
__device__ __forceinline__ float fexp(float x) { return __builtin_amdgcn_exp2f(x * 1.4426950408889634f); }
__device__ __forceinline__ float frcp(float x) { return __builtin_amdgcn_rcpf(x); }
__device__ __forceinline__ float sigmoidf_(float x) { return frcp(1.0f + __expf(-x)); }
__device__ __forceinline__ float siluf_(float x) { return x * frcp(1.0f + __expf(-x)); }
__device__ __forceinline__ float gelu_tanh(float x) {
    const float u = 0.7978845608028654f * (x + 0.044715f * x * x * x);
    return x * frcp(1.0f + __expf(-2.0f * u));
}
__device__ __forceinline__ float dpp_xor1(float v) { return __builtin_bit_cast(float, __builtin_amdgcn_mov_dpp(__builtin_bit_cast(int, v), 0xB1, 0xF, 0xF, true)); }
__device__ __forceinline__ float dpp_xor2(float v) { return __builtin_bit_cast(float, __builtin_amdgcn_mov_dpp(__builtin_bit_cast(int, v), 0x4E, 0xF, 0xF, true)); }
__device__ __forceinline__ float wave_sum(float v) {
#pragma unroll
    for (int o = 1; o < 64; o <<= 1) v += __shfl_xor(v, o);
    return v;
}
__device__ __forceinline__ void unpack8(const v4u w, float (&f)[8]) {
    f[0] = bflo(w.x); f[1] = bfhi(w.x); f[2] = bflo(w.y); f[3] = bfhi(w.y); f[4] = bflo(w.z); f[5] = bfhi(w.z); f[6] = bflo(w.w); f[7] = bfhi(w.w);
}
__device__ __forceinline__ v4u pack8(const float (&f)[8]) { v4u w; w.x = pk2(f[0], f[1]); w.y = pk2(f[2], f[3]); w.z = pk2(f[4], f[5]); w.w = pk2(f[6], f[7]); return w; }

#define XB_TMO      128
#define XB_XCNT(j)  (256  + 64 * (j))
#define XB_XSUB(j)  (1280 + 64 * (j))
#define XB_XGEN(j)  (2304 + 64 * (j))
#define XB_TOP      3328
#define XB_TOPGEN   3392
#define XCD_BAR_WORDS 3456
#define XB_SPIN_CAP (1u << 18)

__device__ __forceinline__ unsigned xb_ld(unsigned* p)              { return __hip_atomic_load(p, __ATOMIC_RELAXED, __HIP_MEMORY_SCOPE_AGENT); }
__device__ __forceinline__ unsigned xb_add(unsigned* p, unsigned v) { return __hip_atomic_fetch_add(p, v, __ATOMIC_RELAXED, __HIP_MEMORY_SCOPE_AGENT); }
__device__ __forceinline__ unsigned xb_xcc_id() { return (unsigned)__builtin_amdgcn_s_getreg((3 << 11) | 20) & 0xFu; }
#define XB_SPIN(cond, bar) do { unsigned _sp = 0; while (cond) { __builtin_amdgcn_s_sleep(1); \
    if ((++_sp & 255u) == 0u) { if (xb_ld(&(bar)[XB_TMO])) break; if (_sp > XB_SPIN_CAP) { atomicAdd(&(bar)[XB_TMO], 1u); break; } } } } while (0)

struct XcdBarrier {
    unsigned* bar; unsigned x;
    volatile LAS unsigned* st;
};
__device__ __forceinline__ XcdBarrier xcd_barrier_post(unsigned* bar, volatile LAS unsigned* st) {
    XcdBarrier b; b.bar = bar; b.x = xb_xcc_id(); b.st = st;
    if (threadIdx.x == 0) (void)xb_add(&bar[XB_XCNT(b.x)], 1u);
    return b;
}
__device__ __forceinline__ void xcd_barrier_complete(unsigned* bar, unsigned x, unsigned& nloc, unsigned& nx) {
    const unsigned G = gridDim.x * gridDim.y * gridDim.z;
    unsigned sum, cnt, mine, sp = 0u;
    for (;;) {
        sum = 0u; cnt = 0u; mine = 0u;
#pragma unroll
        for (unsigned j = 0; j < 16; ++j) { const unsigned c = xb_ld(&bar[XB_XCNT(j)]); sum += c; cnt += (c > 0u) ? 1u : 0u; mine = (j == x) ? c : mine; }
        if (sum == G) break;
        __builtin_amdgcn_s_sleep(1);
        if ((++sp & 255u) == 0u) { if (xb_ld(&bar[XB_TMO])) break; if (sp > XB_SPIN_CAP) { atomicAdd(&bar[XB_TMO], 1u); break; } }
    }
    nloc = mine > 0u ? mine : 1u; nx = cnt > 0u ? cnt : 1u;
}
__device__ __forceinline__ void xcd_barrier(const XcdBarrier& b) {
    asm volatile("s_waitcnt vmcnt(0)" ::: "memory");
    __syncthreads();
    if (threadIdx.x == 0) {
        unsigned* bar = b.bar;
        __builtin_amdgcn_s_waitcnt(0);
        unsigned nloc = b.st[0], nx = b.st[1];
        if (nloc == 0u) { xcd_barrier_complete(bar, b.x, nloc, nx); b.st[0] = nloc; b.st[1] = nx; }
        const unsigned old = xb_add(&bar[XB_XSUB(b.x)], 1u);
        const unsigned gen = old / nloc;
        if (old + 1u == (gen + 1u) * nloc) {
            __builtin_amdgcn_fence(__ATOMIC_RELEASE, "agent");
            asm volatile("s_waitcnt vmcnt(0)" ::: "memory");
            const unsigned og = xb_add(&bar[XB_TOP], 1u);
            const unsigned tg = og / nx;
            if (og + 1u == (tg + 1u) * nx) xb_add(&bar[XB_TOPGEN], 1u);
            else XB_SPIN(xb_ld(&bar[XB_TOPGEN]) == tg, bar);
            __builtin_amdgcn_fence(__ATOMIC_ACQUIRE, "agent");
            xb_add(&bar[XB_XGEN(b.x)], 1u);
            asm volatile("s_waitcnt vmcnt(0)" ::: "memory");
        } else {
            XB_SPIN(xb_ld(&bar[XB_XGEN(b.x)]) == gen, bar);
            __builtin_amdgcn_fence(__ATOMIC_ACQUIRE, "agent");
            asm volatile("s_waitcnt vmcnt(0)" ::: "memory");
        }
    }
    __syncthreads();
}

struct Frame {
    LAS unsigned char* lds;
    volatile LAS unsigned* MISC;
    gu32* ctl;
    int tid, lane, wave;
    int bid, G;
    unsigned char* ws;
    unsigned char* dout_b;
    float* out;
    const float *x, *c, *w_ada, *b_ada, *norm_g, *w_in_ab, *w_out_ab, *gla_w2, *gla_bg, *gla_ng, *q_gain, *k_gain, *cmp_pe, *cmp_w1, *cmp_w2, *w_in_c, *sgu_ng, *sgu_ws, *sgu_bs, *w_out_c, *w_router, *r_bias, *w_gate, *w_up, *w_down;
    const int* positions;
};

struct EpiResid {
    static constexpr bool PERM = false, AFTER_DRAIN = false;
    const float* xin; float* xout; const float* gate;
    __device__ __forceinline__ void operator()(const pg8::f32x4 (&acc)[2][2][4][2], const pg8::Unit& u, int wr, int wc, int fr, int fq) const {
        const int row0 = u.pm * 256 + wr * 64 + fr, col0 = u.pn * 256 + wc * 32 + 4 * fq;
        const float* gb = gate + ((u.pm * 256 >= SEQ) ? 6144 : 0);
        f32x4 gv[2][2];
#pragma unroll
        for (int bj = 0; bj < 2; ++bj)
#pragma unroll
            for (int n = 0; n < 2; ++n) gv[bj][n] = *(const f32x4*)(gb + col0 + bj * 128 + n * 16);
#pragma unroll
        for (int ai = 0; ai < 2; ++ai)
#pragma unroll
            for (int m = 0; m < 4; ++m) {
                const size_t rb = (size_t)(row0 + ai * 128 + m * 16) * DM;
#pragma unroll
                for (int bj = 0; bj < 2; ++bj)
#pragma unroll
                    for (int n = 0; n < 2; ++n) {
                        const size_t p = rb + col0 + bj * 128 + n * 16;
                        const f32x4 xi = *(const f32x4*)(xin + p);
                        *(f32x4*)(xout + p) = xi + gv[bj][n] * acc[ai][bj][m][n];
                    }
            }
    }
};
struct EpiGeluStats {
    static constexpr bool PERM = true, AFTER_DRAIN = false;
    bf16* Z; float* stats;
    __device__ __forceinline__ void operator()(const pg8::f32x4 (&acc)[2][2][4][2], const pg8::Unit& u, int wr, int wc, int fr, int fq) const {
        const int row0 = u.pm * 256 + wr * 64 + fr, col0 = u.pn * 256 + wc * 32 + 8 * fq;
#pragma unroll
        for (int ai = 0; ai < 2; ++ai)
#pragma unroll
            for (int m = 0; m < 4; ++m) {
                const int row = row0 + ai * 128 + m * 16; float ss = 0.f;
#pragma unroll
                for (int bj = 0; bj < 2; ++bj) {
                    float g[8];
#pragma unroll
                    for (int n = 0; n < 2; ++n)
#pragma unroll
                        for (int i = 0; i < 4; ++i) { g[n * 4 + i] = gelu_tanh(acc[ai][bj][m][n][i]); ss += g[n * 4 + i] * g[n * 4 + i]; }
                    *(v4u*)(Z + (size_t)row * 4096 + col0 + bj * 128) = pack8(g);
                }
                if (u.pn >= 8) {
                    ss += __shfl_xor(ss, 16); ss += __shfl_xor(ss, 32);
                    if (fq == 0) stats[(size_t)row * 32 + (u.pn - 8) * 4 + wc] = ss;
                }
            }
    }
};
struct EpiMoeGU {
    static constexpr bool PERM = true, AFTER_DRAIN = false;
    bf16* HID;
    __device__ __forceinline__ void operator()(const pg8::f32x4 (&acc)[2][2][4][2], const pg8::Unit& u, int wr, int wc, int fr, int fq) const {
        const int row0 = u.pm * 256 + wr * 64 + fr, col0 = (u.pn & 3) * 128 + wc * 32 + 8 * fq;
#pragma unroll
        for (int ai = 0; ai < 2; ++ai)
#pragma unroll
            for (int m = 0; m < 4; ++m) {
                float h[8];
#pragma unroll
                for (int n = 0; n < 2; ++n)
#pragma unroll
                    for (int i = 0; i < 4; ++i) h[n * 4 + i] = siluf_(acc[ai][0][m][n][i]) * acc[ai][1][m][n][i];
                *(v4u*)(HID + (size_t)(row0 + ai * 128 + m * 16) * EHID + col0) = pack8(h);
            }
    }
};
struct EpiMoeDn {
    static constexpr bool PERM = true, AFTER_DRAIN = false;
    bf16* YM;
    __device__ __forceinline__ void operator()(const pg8::f32x4 (&acc)[2][2][4][2], const pg8::Unit& u, int wr, int wc, int fr, int fq) const {
        const int row0 = u.pm * 256 + wr * 64 + fr, col0 = (u.pn & 3) * 256 + wc * 32 + 8 * fq;
#pragma unroll
        for (int ai = 0; ai < 2; ++ai)
#pragma unroll
            for (int m = 0; m < 4; ++m)
#pragma unroll
                for (int bj = 0; bj < 2; ++bj) {
                    float h[8];
#pragma unroll
                    for (int n = 0; n < 2; ++n)
#pragma unroll
                        for (int i = 0; i < 4; ++i) h[n * 4 + i] = acc[ai][bj][m][n][i];
                    *(v4u*)(YM + (size_t)(row0 + ai * 128 + m * 16) * DM + col0 + bj * 128) = pack8(h);
                }
    }
};
struct MoeOrder {
    const LAS int* ppre; int G, c;
    __device__ __forceinline__ unsigned row_off(const pg8::Unit& u, int r, const int* elist) const {
        const int e = u.pn >> 2, li = (u.pm - ppre[e]) * 256 + r;
        const int tok = (li < ppre[32 + e]) ? elist[e * 16384 + li] : 0;
        return (unsigned)tok * 2048u;
    }
    __device__ __forceinline__ bool next(int i, pg8::Unit& u) const {
        const int L = i * G + c, np = ppre[16];
        if (L >= np * 4) return false;
        const int pm = L >> 2; int e = 0;
#pragma unroll
        for (int k = 1; k < 16; ++k) e += (ppre[k] <= pm) ? 1 : 0;
        u.pm = pm; u.pn = e * 4 + (L & 3); return true;
    }
    __device__ __forceinline__ void a_ready(const pg8::Unit&) const {}
    __device__ __forceinline__ void done(const pg8::Unit&) const {}
};

__device__ __forceinline__ int dest_row(int mode, int n) {
    if (mode == 1) return (n < 1024) ? n : (n < 1040) ? n + 1792 : (n < 2832) ? n - 16 : n;
    if (mode == 2) return (n >> 7) * 256 + (n & 127);
    if (mode == 3) return (n >> 7) * 256 + 128 + (n & 127);
    return n;
}
struct TrItem { const float* src; bf16* dst; int K, N, mode, r; };
__device__ __forceinline__ int tr_count(int set) { return set == 0 ? (720 + 256 + 256 + 3 * 2048) : set == 1 ? (1024 + 512 + 2048 + 1024) : (1024 + 2048); }
__device__ __forceinline__ bool tr_decode(Frame& F, int set, int it, TrItem& t) {
    if (it >= tr_count(set)) return false;
    int r = it; t.mode = 0;
    if (set == 0) {
        constexpr int I_IN = 16 * 45, I_OUT = 16 * 16, I_CW1 = 2 * 32 * 4, I_E = 16 * 128;
        if (r < I_IN) { t.src = F.w_in_ab; t.dst = (bf16*)(F.ws + WS_WIN); t.K = 1024; t.N = 2856; t.mode = 1; }
        else if ((r -= I_IN) < I_OUT) { t.src = F.w_out_ab; t.dst = (bf16*)(F.ws + WS_WOUT); t.K = 1024; t.N = 1024; }
        else if ((r -= I_OUT) < I_CW1) { const int m = r >> 7; r &= 127; t.src = F.cmp_w1 + (size_t)m * 2048 * 256; t.dst = (bf16*)(F.ws + WS_WCW1) + (size_t)m * 256 * 2048; t.K = 2048; t.N = 256; }
        else if ((r -= I_CW1) < I_E) { const int m = r >> 7; r &= 127; t.src = F.w_gate + (size_t)m * 1024 * 512; t.dst = (bf16*)(F.ws + WS_WGU) + (size_t)m * 1024 * 1024; t.K = 1024; t.N = 512; t.mode = 2; }
        else if ((r -= I_E) < I_E) { const int m = r >> 7; r &= 127; t.src = F.w_up + (size_t)m * 1024 * 512; t.dst = (bf16*)(F.ws + WS_WGU) + (size_t)m * 1024 * 1024; t.K = 1024; t.N = 512; t.mode = 3; }
        else { r -= I_E; const int m = r >> 7; r &= 127; t.src = F.w_down + (size_t)m * 512 * 1024; t.dst = (bf16*)(F.ws + WS_WDN) + (size_t)m * 1024 * 512; t.K = 512; t.N = 1024; }
    } else if (set == 1) {
        constexpr int I_INC = 16 * 64, I_OUTC = 32 * 16;
        if (r < I_INC) { t.src = F.w_in_c; t.dst = (bf16*)(F.ws + WS_WINC); t.K = 1024; t.N = 4096; }
        else if ((r -= I_INC) < I_OUTC) { t.src = F.w_out_c; t.dst = (bf16*)(F.ws + WS_WOUTC); t.K = 2048; t.N = 1024; }
        else if ((r -= I_OUTC) < 2048) { const int m = 16 + (r >> 7); r &= 127; t.src = F.w_gate + (size_t)m * 1024 * 512; t.dst = (bf16*)(F.ws + WS_WGU) + (size_t)m * 1024 * 1024; t.K = 1024; t.N = 512; t.mode = 2; }
        else { r -= 2048; const int m = 16 + (r >> 7); r &= 127; t.src = F.w_up + (size_t)m * 1024 * 512; t.dst = (bf16*)(F.ws + WS_WGU) + (size_t)m * 1024 * 1024; t.K = 1024; t.N = 512; t.mode = 3; }
    } else {
        constexpr int I_E = 8 * 128;
        if (r < I_E) { const int m = 24 + (r >> 7); r &= 127; t.src = F.w_up + (size_t)m * 1024 * 512; t.dst = (bf16*)(F.ws + WS_WGU) + (size_t)m * 1024 * 1024; t.K = 1024; t.N = 512; t.mode = 3; }
        else { r -= I_E; const int m = 16 + (r >> 7); r &= 127; t.src = F.w_down + (size_t)m * 512 * 1024; t.dst = (bf16*)(F.ws + WS_WDN) + (size_t)m * 1024 * 512; t.K = 512; t.N = 1024; }
    }
    t.r = r; return true;
}
__device__ __forceinline__ void tr_load(const TrItem& t, int lane, f32x4 (&va)[8], f32x4 (&vb)[8]) {
    const int nblk = (t.N + 63) / 64, kb = t.r / nblk, nb = t.r % nblk, k0 = 64 * kb, n0 = 64 * nb;
    const int q = lane & 15, r4 = lane >> 4, col = n0 + 4 * q;
    const float* wp = t.src + (size_t)(k0 + 2 * r4) * t.N + col;
#pragma unroll
    for (int i = 0; i < 8; ++i) {
        if (col < t.N) { va[i] = *(const f32x4*)(wp + (size_t)(8 * i) * t.N); vb[i] = *(const f32x4*)(wp + (size_t)(8 * i + 1) * t.N); }
        else { va[i] = (f32x4){0.f, 0.f, 0.f, 0.f}; vb[i] = va[i]; }
    }
}
__device__ __forceinline__ void tr_finish(const TrItem& t, int lane, const f32x4 (&va)[8], const f32x4 (&vb)[8], LAS unsigned char* scr) {
    const int nblk = (t.N + 63) / 64, kb = t.r / nblk, nb = t.r % nblk, k0 = 64 * kb, n0 = 64 * nb;
    const int q = lane & 15, r4 = lane >> 4;
#pragma unroll
    for (int i = 0; i < 8; ++i) {
        const int kp = 4 * i + r4;
        LAS unsigned* tt = (LAS unsigned*)(scr + (4 * q) * 144 + 4 * kp);
        tt[0] = pk2(va[i].x, vb[i].x); tt[36] = pk2(va[i].y, vb[i].y); tt[72] = pk2(va[i].z, vb[i].z); tt[108] = pk2(va[i].w, vb[i].w);
    }
    LDS_WAIT(); asm volatile("" ::: "memory");
    const int c = lane & 7;
#pragma unroll
    for (int j = 0; j < 8; ++j) { const int n = (lane >> 3) + 8 * j;
        const v4u o = *(const LAS v4u*)(scr + n * 144 + 16 * c);
        if (n0 + n < t.N) *(GAS v4u*)(t.dst + (size_t)dest_row(t.mode, n0 + n) * t.K + k0 + 8 * c) = o; }
    LDS_WAIT(); asm volatile("" ::: "memory");
}
__device__ __forceinline__ void tr_run(Frame& F, int set, int w0, int nw) {
    LAS unsigned char* scr = F.lds + RING_OFF + 8192 + F.wave * 12288;
    TrItem ta, tb; f32x4 a0[8], a1[8], b0[8], b1[8];
    int it = w0; bool ha = tr_decode(F, set, it, ta);
    if (ha) tr_load(ta, F.lane, a0, a1);
    while (ha) {
        const bool hb = tr_decode(F, set, it + nw, tb);
        if (hb) tr_load(tb, F.lane, b0, b1);
        tr_finish(ta, F.lane, a0, a1, scr);
        if (!hb) break;
        it += 2 * nw; ha = tr_decode(F, set, it, ta);
        if (ha) tr_load(ta, F.lane, a0, a1);
        tr_finish(tb, F.lane, b0, b1, scr);
    }
}
__device__ __forceinline__ void p0_prologue(Frame& F) {
    LAS float* red = (LAS float*)(F.lds + RING_OFF);
    float* mod = (float*)(F.ws + WS_MOD);
    float* bias1 = (float*)(F.ws + WS_MOD + 131072);
    for (int bi = F.bid; bi < 200; bi += F.G) {
        if (bi < 192) {
            const int l = bi / 96, cg = bi % 96, j = cg * 64 + F.lane;
            float a0 = 0.f, a1 = 0.f;
            const float* wp = F.w_ada + ((size_t)l * 1024 + F.wave * 128) * 6144 + j;
#pragma unroll 16
            for (int k = 0; k < 128; ++k) { const float wv = wp[(size_t)k * 6144]; const float c0 = F.c[F.wave * 128 + k], c1 = F.c[1024 + F.wave * 128 + k];
                a0 += siluf_(c0) * wv; a1 += siluf_(c1) * wv; }
            red[(F.wave * 2 + 0) * 64 + F.lane] = a0; red[(F.wave * 2 + 1) * 64 + F.lane] = a1;
            __syncthreads();
            if (F.tid < 128) { const int b = F.tid >> 6, ln = F.tid & 63; float s = 0.f;
#pragma unroll
                for (int w = 0; w < 8; ++w) s += red[(w * 2 + b) * 64 + ln];
                mod[(size_t)(l * 2 + b) * 6144 + cg * 64 + ln] = s + F.b_ada[l * 6144 + cg * 64 + ln]; }
            __syncthreads();
        } else {
            const int kv = (bi - 192) >> 2, cg = (bi - 192) & 3, j = cg * 64 + F.lane;
            float a0 = 0.f;
            const float* wp = F.cmp_w1 + ((size_t)kv * 2048 + F.wave * 256) * 256 + j; const float* pe = F.cmp_pe + kv * 2048 + F.wave * 256;
#pragma unroll 16
            for (int k = 0; k < 256; ++k) a0 += pe[k] * wp[(size_t)k * 256];
            red[F.wave * 64 + F.lane] = a0;
            __syncthreads();
            if (F.tid < 64) { float s = 0.f;
#pragma unroll
                for (int w = 0; w < 8; ++w) s += red[w * 64 + F.tid];
                bias1[kv * 256 + cg * 64 + F.tid] = s; }
            __syncthreads();
        }
    }
    { bf16* wi = (bf16*)(F.ws + WS_WIN); const int npieces = (NPROJ - C_END) * (DM / 8);
      for (int p = F.bid * 512 + F.tid; p < npieces; p += F.G * 512) *(GAS v4u*)(wi + (size_t)C_END * DM + (size_t)p * 8) = (v4u){0u, 0u, 0u, 0u}; }
    const int gw = F.bid * 8 + F.wave, NGW = F.G * 8;
    tr_run(F, 0, gw, NGW);
}

__device__ __forceinline__ void moe_tables(Frame& F, int layer) {
    LAS int* ppre = (LAS int*)(F.lds + TAB_OFF);
    if (F.tid == 0) { const unsigned* cnt = (const unsigned*)(F.ctl + CW_CNT + 1024 * layer); int acc = 0;
        for (int e = 0; e < 16; ++e) { const int c = (int)cnt[64 * e]; ppre[e] = acc; ppre[32 + e] = c; acc += (c + 255) >> 8; }
        ppre[16] = acc; }
    __syncthreads();
}

struct RouteRec { int e0, e1, pos0, pos1; float w0, w1; int slot0, slot1; };
template <bool COMBINE, bool NORM, bool ROUTE>
__device__ __forceinline__ void row_pass(Frame& F, const float* xin, const float* modn  , int sh_off, const float* ng,
                                         const float* modc  , int layer, int clayer  ) {
    if (COMBINE) moe_tables(F, clayer);
    float* xout = F.out; bf16* H = (bf16*)(F.ws + WS_O);
    const bf16* YM = (const bf16*)(F.ws + WS_A);
    RouteRec* route = (RouteRec*)(F.ws + WS_ROUTE);
    int* elist = (int*)(F.ws + WS_STATS);
    const LAS int* ppre = (const LAS int*)(F.lds + TAB_OFF);
    LAS float* wr = (LAS float*)(F.lds + RING_OFF);
    LAS unsigned* lcnt = (LAS unsigned*)(F.lds + TAB_OFF + 256);
    LAS int* recs = (LAS int*)(F.lds + TAB_OFF + 8192);
    if (ROUTE) {
        for (int idx = F.tid; idx < 16384; idx += 512) wr[(idx & 15) * 1024 + (idx >> 4)] = F.w_router[idx];
        if (F.tid < 32) lcnt[F.tid] = 0u;
        __syncthreads();
    }
    const int gw = F.bid * 8 + F.wave, NGW = F.G * 8;
    f32x4 cs[4], sh[4], gc[4];
    f32x4 vn[4]; v2u yn0[4], yn1[4]; RouteRec rn; rn.w0 = 0.f; rn.w1 = 0.f;
    int m = gw, bcur = -1;
#define RP_PREFETCH(mm) do { \
        _Pragma("unroll") for (int j = 0; j < 4; ++j) vn[j] = *(const f32x4*)(xin + (size_t)(mm) * DM + 4 * F.lane + 256 * j); \
        if (COMBINE) { rn = route[(mm)]; const int sl0_ = ppre[rn.e0] * 256 + rn.pos0, sl1_ = ppre[rn.e1] * 256 + rn.pos1; \
            _Pragma("unroll") for (int j = 0; j < 4; ++j) { yn0[j] = *(const v2u*)(YM + (size_t)sl0_ * DM + 4 * F.lane + 256 * j); yn1[j] = *(const v2u*)(YM + (size_t)sl1_ * DM + 4 * F.lane + 256 * j); } } } while (0)
    if (m < NTOK) RP_PREFETCH(m);
#pragma unroll 1
    while (m < NTOK) {
        f32x4 v[4]; v2u y0[4], y1[4];
#pragma unroll
        for (int j = 0; j < 4; ++j) { v[j] = vn[j]; if (COMBINE) { y0[j] = yn0[j]; y1[j] = yn1[j]; } }
        const float rw0 = rn.w0, rw1 = rn.w1;
        const int mc = m; m += NGW;
        if (m < NTOK) RP_PREFETCH(m);
        const int b = mc >> 13;
        if (b != bcur) { bcur = b;
#pragma unroll
            for (int j = 0; j < 4; ++j) {
                const int col = 4 * F.lane + 256 * j;
                if (NORM) { const f32x4 g = *(const f32x4*)(ng + col), sc = *(const f32x4*)(modn + b * 6144 + sh_off + 1024 + col); cs[j] = g * (sc + 1.0f); sh[j] = *(const f32x4*)(modn + b * 6144 + sh_off + col); }
                if (COMBINE) gc[j] = *(const f32x4*)(modc + b * 6144 + 5 * 1024 + col);
            } }
        {
            if (COMBINE) {
#pragma unroll
                for (int j = 0; j < 4; ++j) {
                    f32x4 yy; yy.x = rw0 * bflo(y0[j].x) + rw1 * bflo(y1[j].x); yy.y = rw0 * bfhi(y0[j].x) + rw1 * bfhi(y1[j].x); yy.z = rw0 * bflo(y0[j].y) + rw1 * bflo(y1[j].y); yy.w = rw0 * bfhi(y0[j].y) + rw1 * bfhi(y1[j].y);
                    v[j] = v[j] + gc[j] * yy;
                    *(f32x4*)(xout + (size_t)mc * DM + 4 * F.lane + 256 * j) = v[j];
                }
            }
            if (NORM) {
                float s = 0.f;
#pragma unroll
                for (int j = 0; j < 4; ++j) s += (v[j].x * v[j].x + v[j].y * v[j].y) + (v[j].z * v[j].z + v[j].w * v[j].w);
                const float rstd = 1.0f / sqrtf(wave_sum(s) * (1.0f / DM) + NORM_EPS);
#pragma unroll
                for (int j = 0; j < 4; ++j) { v[j] = v[j] * rstd * cs[j] + sh[j];
                    v2u o; o.x = pk2(v[j].x, v[j].y); o.y = pk2(v[j].z, v[j].w);
                    *(v2u*)(H + (size_t)mc * DM + 4 * F.lane + 256 * j) = o; }
            }
            if (ROUTE) {
                float a16[16];
#pragma unroll
                for (int eg = 0; eg < 4; ++eg) {
                    float a4[4] = {0.f, 0.f, 0.f, 0.f};
#pragma unroll
                    for (int j = 0; j < 4; ++j)
#pragma unroll
                        for (int ee = 0; ee < 4; ++ee) { const f32x4 w = *(const LAS f32x4*)(wr + (eg * 4 + ee) * 1024 + 4 * F.lane + 256 * j); a4[ee] += (v[j].x * w.x + v[j].y * w.y) + (v[j].z * w.z + v[j].w * w.w); }
#pragma unroll
                    for (int ee = 0; ee < 4; ++ee) a16[eg * 4 + ee] = a4[ee];
                    __builtin_amdgcn_sched_barrier(0);
                }
                float r8[8], r4[4], r2[2];
                { const bool hb = (F.lane & 32) != 0;
#pragma unroll
                  for (int i = 0; i < 8; ++i) { const float keep = hb ? a16[8 + i] : a16[i], send = hb ? a16[i] : a16[8 + i]; r8[i] = keep + __shfl_xor(send, 32); } }
                { const bool hb = (F.lane & 16) != 0;
#pragma unroll
                  for (int i = 0; i < 4; ++i) { const float keep = hb ? r8[4 + i] : r8[i], send = hb ? r8[i] : r8[4 + i]; r4[i] = keep + __shfl_xor(send, 16); } }
                { const bool hb = (F.lane & 8) != 0;
#pragma unroll
                  for (int i = 0; i < 2; ++i) { const float keep = hb ? r4[2 + i] : r4[i], send = hb ? r4[i] : r4[2 + i]; r2[i] = keep + __shfl_xor(send, 8); } }
                float lgo; { const bool hb = (F.lane & 4) != 0; const float keep = hb ? r2[1] : r2[0], send = hb ? r2[0] : r2[1]; lgo = keep + __shfl_xor(send, 4); }
                lgo += __shfl_xor(lgo, 1); lgo += __shfl_xor(lgo, 2);
                const int eown = ((F.lane >> 5) & 1) * 8 + ((F.lane >> 4) & 1) * 4 + ((F.lane >> 3) & 1) * 2 + ((F.lane >> 2) & 1);
                const float sco = frcp(1.0f + __expf(-lgo)), slo = sco + F.r_bias[eown];
                float sc[16], sl[16];
#pragma unroll
                for (int e = 0; e < 16; ++e) { const int src = (e >> 3) * 32 + ((e >> 2) & 1) * 16 + ((e >> 1) & 1) * 8 + (e & 1) * 4;
                    sc[e] = __builtin_bit_cast(float, __builtin_amdgcn_readlane(__builtin_bit_cast(int, sco), src)); sl[e] = __builtin_bit_cast(float, __builtin_amdgcn_readlane(__builtin_bit_cast(int, slo), src)); }
                float gs[4]; int ge1[4], ge2[4]; float gw1[4], gw2[4];
#pragma unroll
                for (int g = 0; g < 4; ++g) {
                    int i1 = 0; float m1 = sl[4 * g];
#pragma unroll
                    for (int k = 1; k < 4; ++k) if (sl[4 * g + k] > m1) { m1 = sl[4 * g + k]; i1 = k; }
                    int i2 = -1; float m2 = 0.f;
#pragma unroll
                    for (int k = 0; k < 4; ++k) if (k != i1 && (i2 < 0 || sl[4 * g + k] > m2)) { m2 = sl[4 * g + k]; i2 = k; }
                    gs[g] = m1 + m2; ge1[g] = 4 * g + i1; ge2[g] = 4 * g + i2;
                    float w1 = 0.f, w2 = 0.f;
#pragma unroll
                    for (int k = 0; k < 4; ++k) { w1 = (k == i1) ? sc[4 * g + k] : w1; w2 = (k == i2) ? sc[4 * g + k] : w2; }
                    gw1[g] = w1; gw2[g] = w2;
                }
                int gi = 0; float gm = gs[0];
#pragma unroll
                for (int g = 1; g < 4; ++g) if (gs[g] > gm) { gm = gs[g]; gi = g; }
                int e1 = ge1[0], e2 = ge2[0]; float w1 = gw1[0], w2 = gw2[0];
#pragma unroll
                for (int g = 1; g < 4; ++g) if (gi == g) { e1 = ge1[g]; e2 = ge2[g]; w1 = gw1[g]; w2 = gw2[g]; }
                const float ws_ = w1 + w2;
                if (F.lane == 0) {
                    const int p0 = (int)__hip_atomic_fetch_add(lcnt + e1, 1u, __ATOMIC_RELAXED, __HIP_MEMORY_SCOPE_WORKGROUP);
                    const int p1 = (int)__hip_atomic_fetch_add(lcnt + e2, 1u, __ATOMIC_RELAXED, __HIP_MEMORY_SCOPE_WORKGROUP);
                    LAS int* rs = recs + (F.wave * 8 + ((mc - gw) / NGW)) * 8;
                    rs[0] = e1; rs[1] = e2; rs[2] = p0; rs[3] = p1; rs[4] = __float_as_int(w1 / ws_); rs[5] = __float_as_int(w2 / ws_);
                }
            }
        }
    }
#undef RP_PREFETCH
    if (ROUTE) {
        __syncthreads();
        if (F.tid < 16) { unsigned* cnt = (unsigned*)(F.ctl + CW_CNT + 1024 * layer + 64 * F.tid); lcnt[16 + F.tid] = atomicAdd(cnt, lcnt[F.tid]); }
        __syncthreads();
        { const int k = F.lane, mrow = gw + k * NGW;
          if (k < 8 && mrow < NTOK) { const LAS int* rs = recs + (F.wave * 8 + k) * 8;
              RouteRec rr; rr.e0 = rs[0]; rr.e1 = rs[1]; rr.pos0 = rs[2] + (int)lcnt[16 + rr.e0]; rr.pos1 = rs[3] + (int)lcnt[16 + rr.e1]; rr.w0 = __int_as_float(rs[4]); rr.w1 = __int_as_float(rs[5]); rr.slot0 = 0; rr.slot1 = 0;
              route[mrow] = rr; elist[rr.e0 * 16384 + rr.pos0] = mrow; elist[rr.e1 * 16384 + rr.pos1] = mrow; } }
    }
}


__device__ __forceinline__ f32x4 mma16(const LAS bf16* A, int lda, const LAS bf16* Bt, int ldb, int K, f32x4 acc, int lane) {
    const LAS bf16* ap = A + (lane & 15) * lda + (lane >> 4) * 8;
    const LAS bf16* bp = Bt + (lane & 15) * ldb + (lane >> 4) * 8;
    for (int k = 0; k < K; k += 32) {
        const bf16x8 a = *(const LAS bf16x8*)(ap + k), b = *(const LAS bf16x8*)(bp + k);
        acc = __builtin_amdgcn_mfma_f32_16x16x32_bf16(a, b, acc, 0, 0, 0);
    }
    return acc;
}

__device__ __forceinline__ float wave_incl_scan(float v) {
#define DPP_ADD(ctrl, rmask) v += __builtin_bit_cast(float, __builtin_amdgcn_update_dpp(0, __builtin_bit_cast(int, v), (ctrl), (rmask), 0xF, false))
    DPP_ADD(0x111, 0xF);
    DPP_ADD(0x112, 0xF);
    DPP_ADD(0x114, 0xF);
    DPP_ADD(0x118, 0xF);
    DPP_ADD(0x142, 0xA);
    DPP_ADD(0x143, 0xC);
#undef DPP_ADD
    return v;
}
__device__ __forceinline__ void gla_bcum(Frame& F, const bf16* prow  , int h, float (&bc)[8]) {
    float gl[16];
    { const v4u a = *(const v4u*)(prow + C_GLR), b = *(const v4u*)(prow + C_GLR + 8); float t0[8], t1[8]; unpack8(a, t0); unpack8(b, t1);
#pragma unroll
      for (int i = 0; i < 8; ++i) { gl[i] = t0[i]; gl[8 + i] = t1[i]; } }
#pragma unroll
    for (int i = 0; i < 8; ++i) {
        const int col = h * 64 + F.wave * 8 + i;
        float z = F.gla_bg[col];
#pragma unroll
        for (int r = 0; r < 16; ++r) z += gl[r] * F.gla_w2[r * 256 + col];
        const float ls = fminf(z, 0.f) - __logf(1.0f + __expf(-fabsf(z)));
        bc[i] = wave_incl_scan(ls * (1.0f / 16.0f));
    }
}
__device__ __forceinline__ void gla_stage_vT(Frame& F, const bf16* prow, int h, LAS bf16* VT) {
    const v4u a = *(const v4u*)(prow + C_GV + h * 128 + F.wave * 16), b = *(const v4u*)(prow + C_GV + h * 128 + F.wave * 16 + 8);
    const unsigned w[8] = {a.x, a.y, a.z, a.w, b.x, b.y, b.z, b.w};
#pragma unroll
    for (int i = 0; i < 8; ++i) { VT[(F.wave * 16 + 2 * i) * 72 + F.lane] = (bf16)(w[i] & 0xffffu); VT[(F.wave * 16 + 2 * i + 1) * 72 + F.lane] = (bf16)(w[i] >> 16); }
}
__device__ __forceinline__ void gla_prep_item(Frame& F, int item) {
    const int h = item & 3, n = (item >> 2) & 127, b = item >> 9;
    const bf16* proj = (const bf16*)(F.ws + WS_A);
    const bf16* prow = proj + (size_t)(b * SEQ + n * 64 + F.lane) * NPROJ;
    LAS bf16* KT = (LAS bf16*)(F.lds + RING_OFF);
    LAS bf16* VT = (LAS bf16*)(F.lds + RING_OFF + 9216);
    float bc[8]; gla_bcum(F, prow, h, bc);
    float kf[8]; { const v4u kk = *(const v4u*)(prow + C_GK + h * 64 + F.wave * 8); unpack8(kk, kf); }
    float* DEC = (float*)(F.ws + WS_DEC) + ((size_t)(b * 128 + n) * 4 + h) * 64;
#pragma unroll
    for (int i = 0; i < 8; ++i) {
        const float bl = __shfl(bc[i], 63);
        KT[(F.wave * 8 + i) * 72 + F.lane] = (bf16)f2bf(kf[i] * __expf(bl - bc[i]));
        if (F.lane == 63) DEC[F.wave * 8 + i] = __expf(bl);
    }
    gla_stage_vT(F, prow, h, VT);
    __syncthreads();
    float* KV = (float*)(F.ws + WS_O) + ((size_t)(b * 128 + n) * 4 + h) * 8192;
    const int dt = F.wave >> 1;
#pragma unroll
    for (int j = 0; j < 4; ++j) {
        const int et = (F.wave & 1) * 4 + j;
        f32x4 acc = {0.f, 0.f, 0.f, 0.f};
        acc = mma16(KT + dt * 16 * 72, 72, VT + et * 16 * 72, 72, 64, acc, F.lane);
#pragma unroll
        for (int i = 0; i < 4; ++i) KV[(dt * 16 + 4 * (F.lane >> 4) + i) * 128 + et * 16 + (F.lane & 15)] = acc[i];
    }
    __syncthreads();
}
__device__ __forceinline__ void gla_scan(Frame& F, int gidx) {
    const int bh = gidx >> 13, de = gidx & 8191, b = bh >> 2, h = bh & 3;
    float* KV = (float*)(F.ws + WS_O) + ((size_t)(b * 128) * 4 + h) * 8192 + de;
    const float* DEC = (const float*)(F.ws + WS_DEC) + ((size_t)(b * 128) * 4 + h) * 64 + (de >> 7);
    float st = 0.f;
#pragma unroll 1
    for (int n0 = 0; n0 < 128; n0 += 16) {
        float kv[16], dc[16];
#pragma unroll
        for (int i = 0; i < 16; ++i) { kv[i] = KV[(size_t)(n0 + i) * 4 * 8192]; dc[i] = DEC[(size_t)(n0 + i) * 4 * 64]; }
#pragma unroll
        for (int i = 0; i < 16; ++i) { KV[(size_t)(n0 + i) * 4 * 8192] = st; st = dc[i] * st + kv[i]; }
    }
}
__device__ __forceinline__ void gla_out_item(Frame& F, int item) {
    const int h = item & 3, n = (item >> 2) & 127, b = item >> 9;
    const bf16* proj = (const bf16*)(F.ws + WS_A);
    const size_t tok = (size_t)b * SEQ + n * 64 + F.lane;
    const bf16* prow = proj + tok * NPROJ;
    LAS bf16* A1 = (LAS bf16*)(F.lds + RING_OFF);
    LAS bf16* B1 = (LAS bf16*)(F.lds + RING_OFF + 9216);
    LAS bf16* A2 = (LAS bf16*)(F.lds + RING_OFF + 18432);
    LAS bf16* SC = (LAS bf16*)(F.lds + RING_OFF + 27648);
    LAS bf16* VT = (LAS bf16*)(F.lds + RING_OFF + 36864);
    LAS bf16* ST = (LAS bf16*)(F.lds + RING_OFF + 55296);
    LAS float* OS = (LAS float*)(F.lds + RING_OFF + 73728);
    const size_t tkn = (size_t)b * SEQ + n * 64 + (F.tid >> 3);
    const v4u rraw0 = *(const v4u*)(proj + tkn * NPROJ + C_GR + h * 128 + (F.tid & 7) * 16), rraw1 = *(const v4u*)(proj + tkn * NPROJ + C_GR + h * 128 + (F.tid & 7) * 16 + 8);
    float bc[8]; gla_bcum(F, prow, h, bc);
    float qf[8], kf[8];
    { const v4u qq = *(const v4u*)(prow + C_GQ + h * 64 + F.wave * 8), kk = *(const v4u*)(prow + C_GK + h * 64 + F.wave * 8); unpack8(qq, qf); unpack8(kk, kf); }
    float a1[8], b1[8], a2[8];
#pragma unroll
    for (int i = 0; i < 8; ++i) {
        const float bm = __shfl(bc[i], 32);
        a1[i] = qf[i] * 0.125f * __expf(bc[i] - bm); b1[i] = kf[i] * __expf(bm - bc[i]); a2[i] = qf[i] * 0.125f * __expf(bc[i]);
    }
    *(LAS v4u*)(A1 + F.lane * 72 + F.wave * 8) = pack8(a1);
    *(LAS v4u*)(B1 + F.lane * 72 + F.wave * 8) = pack8(b1);
    *(LAS v4u*)(A2 + F.lane * 72 + F.wave * 8) = pack8(a2);
    gla_stage_vT(F, prow, h, VT);
    { const float* KV = (const float*)(F.ws + WS_O) + ((size_t)(b * 128 + n) * 4 + h) * 8192;
#pragma unroll
      for (int k = 0; k < 16; ++k) { const int p = F.tid + 512 * k, e = p & 127, d = p >> 7; ST[e * 72 + d] = (bf16)f2bf(KV[d * 128 + e]); } }
    __syncthreads();
    const int it = F.wave >> 1;
#pragma unroll
    for (int jj = 0; jj < 2; ++jj) {
        const int jt = (F.wave & 1) * 2 + jj;
        f32x4 acc = {0.f, 0.f, 0.f, 0.f};
        if (jt <= it) acc = mma16(A1 + it * 16 * 72, 72, B1 + jt * 16 * 72, 72, 64, acc, F.lane);
#pragma unroll
        for (int i = 0; i < 4; ++i) { const int ri = it * 16 + 4 * (F.lane >> 4) + i, cj = jt * 16 + (F.lane & 15); SC[ri * 72 + cj] = (bf16)f2bf((cj <= ri) ? acc[i] : 0.f); }
    }
    __syncthreads();
#pragma unroll
    for (int j = 0; j < 4; ++j) {
        const int et = (F.wave & 1) * 4 + j;
        f32x4 acc = {0.f, 0.f, 0.f, 0.f};
        acc = mma16(SC + it * 16 * 72, 72, VT + et * 16 * 72, 72, 64, acc, F.lane);
        acc = mma16(A2 + it * 16 * 72, 72, ST + et * 16 * 72, 72, 64, acc, F.lane);
#pragma unroll
        for (int i = 0; i < 4; ++i) OS[(it * 16 + 4 * (F.lane >> 4) + i) * 132 + et * 16 + (F.lane & 15)] = acc[i];
    }
    __syncthreads();
    { const int row = F.tid >> 3, c0 = (F.tid & 7) * 16;
      float v[16]; float ss = 0.f;
#pragma unroll
      for (int i = 0; i < 16; ++i) { v[i] = OS[row * 132 + c0 + i]; ss += v[i] * v[i]; }
      ss += dpp_xor1(ss); ss += dpp_xor2(ss); ss += __shfl_xor(ss, 4);
      const float rstd = 1.0f / sqrtf(ss * (1.0f / 128.0f) + NORM_EPS);
      const size_t tk = (size_t)b * SEQ + n * 64 + row;
      float r0[8], r1[8]; unpack8(rraw0, r0); unpack8(rraw1, r1);
      float o0[8], o1[8];
#pragma unroll
      for (int i = 0; i < 8; ++i) { o0[i] = v[i] * rstd * F.gla_ng[c0 + i] * siluf_(r0[i]); o1[i] = v[8 + i] * rstd * F.gla_ng[c0 + 8 + i] * siluf_(r1[i]); }
      bf16* orow = (bf16*)(F.ws + WS_O + 32 * MiB) + tk * DM + h * 128 + c0;
      *(v4u*)orow = pack8(o0); *(v4u*)(orow + 8) = pack8(o1); }
    __syncthreads();
}

__device__ __forceinline__ double inv_freq_d(int i) {
    return (i == 0) ? 1.0 : (i == 1) ? 0.19392547740471268 : (i == 2) ? 0.037606090787015346 : (i == 3) ? 0.0072927791106285765 :
           (i == 4) ? 0.0014142135623730951 : (i == 5) ? 0.00027425197177757796 : (i == 6) ? 5.318404375373266e-05 : 1.0313741203148838e-05;
}
__device__ __forceinline__ void rope_sincos(int pos, int i, float& cs, float& sn) {
    const double rev = (double)pos * inv_freq_d(i) * 0.15915494309189535;
    const float fr = (float)(rev - rint(rev));
    cs = __builtin_amdgcn_cosf(fr); sn = __builtin_amdgcn_sinf(fr);
}
struct PrepRaw { v4u r0, r1, r2; unsigned ng; int pos; };
__device__ __forceinline__ void nsa_prep_load(Frame& F, int tok, PrepRaw& p) {
    const int sub = F.lane & 7, vid = F.lane >> 3;
    const bf16* prow = (const bf16*)(F.ws + WS_A) + (size_t)tok * NPROJ;
    const int g1 = vid & 1, w1 = vid >> 1, w2 = (vid >> 1) & 1;
    const int col1 = ((w1 == 0) ? C_KS : (w1 == 1) ? C_KW : (w1 == 2) ? C_VS : C_VW) + g1 * 64, col2 = (w2 ? C_VC : C_KC) + g1 * 64;
    p.r0 = *(const v4u*)(prow + C_NQ + vid * 64 + sub * 8); p.r1 = *(const v4u*)(prow + col1 + sub * 8); p.r2 = *(const v4u*)(prow + col2 + sub * 8);
    p.ng = (F.lane < 24) ? (unsigned)prow[C_NG + F.lane] : 0u; p.pos = F.positions[tok];
}
__device__ __forceinline__ void nsa_prep_token(Frame& F, int tok, const PrepRaw& p) {
    const int b = tok >> 13, t = tok & 8191, sub = F.lane & 7, vid = F.lane >> 3;
    float cs_l, sn_l; rope_sincos(p.pos, sub, cs_l, sn_l);
    float cs[8], sn[8];
#pragma unroll
    for (int i = 0; i < 8; ++i) { cs[i] = __shfl(cs_l, (F.lane & ~7) + i); sn[i] = __shfl(sn_l, (F.lane & ~7) + i); }
    unsigned char* dob = F.dout_b;
    const size_t ktile_off = (size_t)(t >> 6) * 8192 + sub * 1024 + (t & 63) * 16;
    const size_t vtile_off = (size_t)(t >> 6) * 8192 + (sub >> 2) * 4096 + (t & 63) * 64 + (sub & 3) * 16;
#pragma unroll
    for (int round = 0; round < 3; ++round) {
        int kind; unsigned char* dst; const float* gain = nullptr;
        if (round == 0) { kind = 0; gain = F.q_gain; const int g = vid >> 2, hh = vid & 3;
            dst = dob + DO_QN + ((((size_t)(b * 2 + g) * SEQ + t) * 4 + hh) * 64 + sub * 8) * 2; }
        else if (round == 1) {
            const int g = vid & 1, which = vid >> 1;
            const size_t img = (size_t)(b * 2 + g) * (1u << 20);
            if (which == 0) { kind = 1; gain = F.k_gain + 64; dst = dob + DO_KSEL + img + ktile_off; }
            else if (which == 1) { kind = 1; gain = F.k_gain + 128; dst = dob + DO_KWIN + img + ktile_off; }
            else if (which == 2) { kind = 2; dst = dob + DO_VSEL + img + vtile_off; }
            else { kind = 2; dst = dob + DO_VWIN + img + vtile_off; }
        } else {
            const int g = vid & 1, which = (vid >> 1) & 1;
            kind = 2;
            dst = dob + (which ? DO_VC : DO_KC) + (((size_t)(b * 2 + g) * SEQ + t) * 64 + sub * 8) * 2;
        }
        const v4u raw = (round == 0) ? p.r0 : (round == 1) ? p.r1 : p.r2;
        if (kind == 2) { if (round < 2 || F.lane < 32) *(v4u*)dst = raw; }
        else {
            float x[8]; unpack8(raw, x);
            float ss = 0.f;
#pragma unroll
            for (int i = 0; i < 8; ++i) ss += x[i] * x[i];
            ss += dpp_xor1(ss); ss += dpp_xor2(ss); ss += __shfl_xor(ss, 4);
            const float rstd = 1.0f / sqrtf(ss * (1.0f / 64.0f) + NORM_EPS);
#pragma unroll
            for (int i = 0; i < 8; ++i) x[i] = x[i] * rstd * gain[sub * 8 + i];
            float xo[8];
#pragma unroll
            for (int i = 0; i < 8; ++i) xo[i] = dpp_xor1(x[i]);
            if (sub == 0) {
#pragma unroll
                for (int i = 0; i < 8; ++i) x[i] = x[i] * cs[i] - xo[i] * sn[i];
            } else if (sub == 1) {
#pragma unroll
                for (int i = 0; i < 8; ++i) x[i] = x[i] * cs[i] + xo[i] * sn[i];
            }
            if (kind == 0) {
#pragma unroll
                for (int i = 0; i < 8; ++i) x[i] *= 0.125f * 1.4426950408889634f;
            }
            *(v4u*)dst = pack8(x);
        }
    }
    if (F.lane < 24) { float* gt = (float*)(F.ws + WS_GATES) + (size_t)tok * 24; gt[F.lane] = sigmoidf_(bf2f((bf16)p.ng)); }
}

__device__ __forceinline__ void nsa_compress_item(Frame& F, int item) {
    const int kv = item >> 6, b = (item >> 5) & 1, g = (item >> 4) & 1, rt = item & 15, n0 = rt * 32;
    const bf16* Asrc = (const bf16*)(F.dout_b + (kv ? DO_VC : DO_KC)) + ((size_t)(b * 2 + g) * SEQ + 16 * n0) * 64;
    const bf16* Bsrc = (const bf16*)(F.ws + WS_WCW1) + (size_t)kv * 256 * 2048;
    LAS bf16* As = (LAS bf16*)(F.lds + RING_OFF);
    LAS bf16* Bs = (LAS bf16*)(F.lds + RING_OFF + 2 * 32 * 72 * 2);
    LAS float* Hs = (LAS float*)(F.lds + RING_OFF + 86016);
    LAS float* W2s = (LAS float*)(F.lds + RING_OFF);
    const int ar = F.tid >> 3, ac = (F.tid & 7) * 8;
    v4u areg0 = {0u, 0u, 0u, 0u}, areg1 = {0u, 0u, 0u, 0u}, breg0[4], breg1[4];
#define CMP_GLOAD(A_, B_, kc) do { if (F.tid < 256) A_ = *(const v4u*)(Asrc + (size_t)ar * 1024 + (kc) * 64 + ac); \
        _Pragma("unroll") for (int i_ = 0; i_ < 4; ++i_) { const int p_ = F.tid + 512 * i_, br_ = p_ >> 3, bc_ = (p_ & 7) * 8; B_[i_] = *(const v4u*)(Bsrc + (size_t)br_ * 2048 + (kc) * 64 + bc_); } } while (0)
#define CMP_LSTORE(A_, B_, buf) do { if (F.tid < 256) *(LAS v4u*)(As + (buf) * 32 * 72 + ar * 72 + ac) = A_; \
        _Pragma("unroll") for (int i_ = 0; i_ < 4; ++i_) { const int p_ = F.tid + 512 * i_, br_ = p_ >> 3, bc_ = (p_ & 7) * 8; *(LAS v4u*)(Bs + (buf) * 256 * 72 + br_ * 72 + bc_) = B_[i_]; } } while (0)
#define CMP_MMA(buf) do { _Pragma("unroll") for (int mt = 0; mt < 2; ++mt) _Pragma("unroll") for (int nt = 0; nt < 2; ++nt) \
        acc[mt][nt] = mma16(As + (buf) * 32 * 72 + mt * 16 * 72, 72, Bs + (buf) * 256 * 72 + (F.wave * 32 + nt * 16) * 72, 72, 64, acc[mt][nt], F.lane); } while (0)
    f32x4 acc[2][2];
#pragma unroll
    for (int mt = 0; mt < 2; ++mt)
#pragma unroll
        for (int nt = 0; nt < 2; ++nt) acc[mt][nt] = (f32x4){0.f, 0.f, 0.f, 0.f};
    CMP_GLOAD(areg0, breg0, 0); CMP_GLOAD(areg1, breg1, 1); CMP_LSTORE(areg0, breg0, 0); __syncthreads();
#pragma unroll 1
    for (int kc = 0; kc < 32; kc += 2) {
        if (kc + 2 < 32) CMP_GLOAD(areg0, breg0, kc + 2);
        CMP_MMA(0);
        CMP_LSTORE(areg1, breg1, 1);
        __syncthreads();
        if (kc + 3 < 32) CMP_GLOAD(areg1, breg1, kc + 3);
        CMP_MMA(1);
        if (kc + 2 < 32) CMP_LSTORE(areg0, breg0, 0);
        __syncthreads();
    }
#undef CMP_MMA
    const float* bias1 = (const float*)(F.ws + WS_MOD + 131072) + kv * 256;
#pragma unroll
    for (int mt = 0; mt < 2; ++mt)
#pragma unroll
        for (int nt = 0; nt < 2; ++nt) { const int col = F.wave * 32 + nt * 16 + (F.lane & 15);
#pragma unroll
            for (int i = 0; i < 4; ++i) Hs[(mt * 16 + 4 * (F.lane >> 4) + i) * 260 + col] = gelu_tanh(acc[mt][nt][i] + bias1[col]); }
    { const float* w2 = F.cmp_w2 + (size_t)kv * 256 * 64;
#pragma unroll
      for (int i = 0; i < 8; ++i) *(LAS f32x4*)(W2s + (F.tid + 512 * i) * 4) = *(const f32x4*)(w2 + (size_t)(F.tid + 512 * i) * 4); }
    __syncthreads();
    const int r = F.tid >> 4, dq = F.tid & 15;
    f32x4 o = {0.f, 0.f, 0.f, 0.f};
#pragma unroll 8
    for (int j = 0; j < 256; ++j) { const float hv = Hs[r * 260 + j]; const f32x4 w = *(const LAS f32x4*)(W2s + j * 64 + 4 * dq); o = o + w * hv; }
    const int n = n0 + r;
    if (kv == 0) {
        float ss = (o.x * o.x + o.y * o.y) + (o.z * o.z + o.w * o.w);
        ss += dpp_xor1(ss); ss += dpp_xor2(ss); ss += __shfl_xor(ss, 4); ss += __shfl_xor(ss, 8);
        const float rstd = 1.0f / sqrtf(ss * (1.0f / 64.0f) + NORM_EPS);
        const f32x4 gn = *(const f32x4*)(F.k_gain + 4 * dq);
        o = o * rstd * gn;
        const int tlast = (16 * n + 31 < SEQ) ? 16 * n + 31 : SEQ - 1;
        const int pos = F.positions[b * SEQ + tlast];
        f32x4 po; po.x = dpp_xor2(o.x); po.y = dpp_xor2(o.y); po.z = dpp_xor2(o.z); po.w = dpp_xor2(o.w);
        if (dq < 4) {
            const int i0 = 4 * (dq & 1);
            float c0, s0, c1, s1, c2, s2, c3, s3;
            rope_sincos(pos, i0, c0, s0); rope_sincos(pos, i0 + 1, c1, s1); rope_sincos(pos, i0 + 2, c2, s2); rope_sincos(pos, i0 + 3, c3, s3);
            if (dq < 2) { o.x = o.x * c0 - po.x * s0; o.y = o.y * c1 - po.y * s1; o.z = o.z * c2 - po.z * s2; o.w = o.w * c3 - po.w * s3; }
            else { o.x = o.x * c0 + po.x * s0; o.y = o.y * c1 + po.y * s1; o.z = o.z * c2 + po.z * s2; o.w = o.w * c3 + po.w * s3; }
        }
    }
    if (n == 511) o = (f32x4){0.f, 0.f, 0.f, 0.f};
    v2u pk; pk.x = pk2(o.x, o.y); pk.y = pk2(o.z, o.w);
    const int c = dq >> 1;
    unsigned char* img = F.dout_b + (kv ? DO_VCMP : DO_KCMP) + (size_t)(b * 2 + g) * 65536 + (size_t)(n >> 6) * 8192;
    if (kv == 0) *(v2u*)(img + c * 1024 + (n & 63) * 16 + (dq & 1) * 8) = pk;
    else *(v2u*)(img + (c >> 2) * 4096 + (n & 63) * 64 + (c & 3) * 16 + (dq & 1) * 8) = pk;
    __syncthreads();
}

constexpr int NSA_KB = 0, NSA_VB = 16384, NSA_IMP = 32768, NSA_OACC = 65536;
__device__ __forceinline__ int crow(int r, int hi) { return (r & 3) + 8 * (r >> 2) + 4 * hi; }
__device__ __forceinline__ s16x4 ds_tr16(const LAS unsigned char* p) { return __builtin_bit_cast(s16x4, __builtin_amdgcn_ds_read_tr16_b64_v4i16((LAS s16x4*)p)); }

__device__ __forceinline__ unsigned cvtpk(float lo, float hi) { unsigned r; asm("v_cvt_pk_bf16_f32 %0, %1, %2" : "=v"(r) : "v"(lo), "v"(hi)); return r; }
__device__ __forceinline__ float xhalf_max(float v) { const auto rr = __builtin_amdgcn_permlane32_swap(__float_as_uint(v), __float_as_uint(v), false, false); return fmaxf(__uint_as_float(rr[0]), __uint_as_float(rr[1])); }
constexpr float NSA_THR = 8.0f;

template <int MODE>
__device__ __forceinline__ void nsa_branch(Frame& F, const unsigned char* Kimg, const unsigned char* Vimg, int kt0, int kt1, const bf16x8 (&qr)[4],
                                           float& m, float& l, f32x16 (&o)[2], int t, int tw0, int nv, int nvw, int nvmin,
                                           unsigned mk0, unsigned mk1, unsigned mk2, unsigned mk3, unsigned wo0, unsigned wo1, unsigned wo2, unsigned wo3,
                                           float cinit  , LAS float* impw,
                                           bool bnd  ) {
    const int r32 = F.lane & 31, hi = F.lane >> 5, tokl = r32 >> 2;
    LAS unsigned char* KB = F.lds + RING_OFF + NSA_KB; LAS unsigned char* VB = F.lds + RING_OFF + NSA_VB;
    const v4u* kg = (const v4u*)Kimg + F.tid; const v4u* vg = (const v4u*)Vimg + F.tid;
    v4u kreg = kg[(size_t)kt0 * 512], vreg = {0u, 0u, 0u, 0u};
    if (MODE != 0) vreg = vg[(size_t)kt0 * 512];
    *(LAS v4u*)(KB + F.tid * 16) = kreg; if (MODE != 0) *(LAS v4u*)(VB + F.tid * 16) = vreg;
    __syncthreads();
#pragma unroll 1
    for (int kt = kt0; kt < kt1; ++kt) {
        const int buf = (kt - kt0) & 1; const bool has_next = kt + 1 < kt1;
        if (has_next) { kreg = kg[(size_t)(kt + 1) * 512]; if (MODE != 0) vreg = vg[(size_t)(kt + 1) * 512]; }
        const LAS unsigned char* Kb = KB + buf * 8192; const LAS unsigned char* Vb = VB + buf * 8192;
        bool need;
        if (MODE <= 1) need = kt * 64 < nvw;
        else if (MODE == 2) { const unsigned w = (kt < 32) ? wo0 : (kt < 64) ? wo1 : (kt < 96) ? wo2 : wo3; need = (w >> (kt & 31)) & 1u; }
        else need = (kt * 64 <= tw0 + 7) && (kt * 64 + 63 + 512 > tw0);
        bool selbit = true;
        if (MODE == 2) { const unsigned w = (kt < 32) ? mk0 : (kt < 64) ? mk1 : (kt < 96) ? mk2 : mk3; selbit = (w >> (kt & 31)) & 1u; }
        bool joint = false;
        if (need) {
            if (MODE == 2) joint = kt < (tw0 >> 6);
            else if (MODE == 3) joint = (kt * 64 + 63 <= tw0) && (kt * 64 + 512 > tw0 + 7);
            else joint = kt * 64 + 63 < nvmin;
            if (MODE != 1 && !bnd) joint = joint && !__any(m < -1e29f);
        }
        if (need && joint) {
            f32x16 pa, pb;
            if (bnd && MODE != 1) {
#pragma unroll
                for (int r = 0; r < 16; ++r) { pa[r] = 0.f; pb[r] = 0.f; }
#pragma unroll
                for (int d0 = 0; d0 < 4; ++d0) {
                    const bf16x8 kfa = *(const LAS bf16x8*)(Kb + (2 * d0 + hi) * 1024 + r32 * 16), kfb = *(const LAS bf16x8*)(Kb + (2 * d0 + hi) * 1024 + (32 + r32) * 16);
                    pa = __builtin_amdgcn_mfma_f32_32x32x16_bf16(kfa, qr[d0], pa, 0, 0, 0);
                    pb = __builtin_amdgcn_mfma_f32_32x32x16_bf16(kfb, qr[d0], pb, 0, 0, 0);
                }
            } else {
            const float c0 = (MODE == 1) ? cinit : ((MODE == 2 && !selbit) ? -1e30f : -m);
#pragma unroll
            for (int r = 0; r < 16; ++r) { pa[r] = c0; pb[r] = c0; }
#pragma unroll
            for (int d0 = 0; d0 < 4; ++d0) {
                const bf16x8 kfa = *(const LAS bf16x8*)(Kb + (2 * d0 + hi) * 1024 + r32 * 16), kfb = *(const LAS bf16x8*)(Kb + (2 * d0 + hi) * 1024 + (32 + r32) * 16);
                pa = __builtin_amdgcn_mfma_f32_32x32x16_bf16(kfa, qr[d0], pa, 0, 0, 0);
                pb = __builtin_amdgcn_mfma_f32_32x32x16_bf16(kfb, qr[d0], pb, 0, 0, 0);
            }
            if (MODE != 1) {
                float mxa = fmaxf(fmaxf(pa[0], pa[1]), pa[2]), mxb = fmaxf(fmaxf(pb[0], pb[1]), pb[2]);
#pragma unroll
                for (int r = 3; r < 15; r += 2) { mxa = fmaxf(fmaxf(mxa, pa[r]), pa[r + 1]); mxb = fmaxf(fmaxf(mxb, pb[r]), pb[r + 1]); }
                const float mx = xhalf_max(fmaxf(fmaxf(mxa, pa[15]), fmaxf(mxb, pb[15])));
                if (__any(mx > NSA_THR)) {
                    const float dl = fmaxf(mx, 0.f), alpha = fexp2(-dl);
                    m += dl; l *= alpha;
#pragma unroll
                    for (int r = 0; r < 16; ++r) { pa[r] -= dl; pb[r] -= dl; }
                    if (MODE != 0) {
#pragma unroll
                        for (int r = 0; r < 16; ++r) { o[0][r] *= alpha; o[1][r] *= alpha; }
                    }
                }
            }
            }
            float ps0 = 0.f, ps1 = 0.f;
#pragma unroll
            for (int r = 0; r < 16; ++r) { pa[r] = fexp2(pa[r]); pb[r] = fexp2(pb[r]); ps0 += pa[r]; ps1 += pb[r]; }
            if (MODE != 1) l += (bnd && MODE == 2 && !selbit) ? 0.f : (ps0 + ps1);
            if (MODE == 1) {
#pragma unroll
                for (int rg = 0; rg < 4; ++rg) {
                    float a = (pa[4 * rg] + pa[4 * rg + 1]) + (pa[4 * rg + 2] + pa[4 * rg + 3]), sp = pa[4 * rg + 3];
                    float a2 = (pb[4 * rg] + pb[4 * rg + 1]) + (pb[4 * rg + 2] + pb[4 * rg + 3]), sp2 = pb[4 * rg + 3];
                    a += dpp_xor1(a); a += dpp_xor2(a); sp += dpp_xor1(sp); sp += dpp_xor2(sp);
                    a2 += dpp_xor1(a2); a2 += dpp_xor2(a2); sp2 += dpp_xor1(sp2); sp2 += dpp_xor2(sp2);
                    if ((r32 & 3) == 0) { const int jp = kt * 16 + 2 * rg + hi;
                        __hip_atomic_fetch_add(impw + tokl * 128 + jp, a, __ATOMIC_RELAXED, __HIP_MEMORY_SCOPE_WORKGROUP);
                        __hip_atomic_fetch_add(impw + tokl * 128 + jp + 1, sp, __ATOMIC_RELAXED, __HIP_MEMORY_SCOPE_WORKGROUP);
                        __hip_atomic_fetch_add(impw + tokl * 128 + jp + 8, a2, __ATOMIC_RELAXED, __HIP_MEMORY_SCOPE_WORKGROUP);
                        if (jp + 9 < 128) __hip_atomic_fetch_add(impw + tokl * 128 + jp + 9, sp2, __ATOMIC_RELAXED, __HIP_MEMORY_SCOPE_WORKGROUP); }
                }
            }
            if (MODE != 0) {
                v4u wa0, wa1, wb0, wb1;
                wa0.x = cvtpk(pa[0], pa[1]); wa0.y = cvtpk(pa[2], pa[3]); wa0.z = cvtpk(pa[4], pa[5]); wa0.w = cvtpk(pa[6], pa[7]);
                wa1.x = cvtpk(pa[8], pa[9]); wa1.y = cvtpk(pa[10], pa[11]); wa1.z = cvtpk(pa[12], pa[13]); wa1.w = cvtpk(pa[14], pa[15]);
                wb0.x = cvtpk(pb[0], pb[1]); wb0.y = cvtpk(pb[2], pb[3]); wb0.z = cvtpk(pb[4], pb[5]); wb0.w = cvtpk(pb[6], pb[7]);
                wb1.x = cvtpk(pb[8], pb[9]); wb1.y = cvtpk(pb[10], pb[11]); wb1.z = cvtpk(pb[12], pb[13]); wb1.w = cvtpk(pb[14], pb[15]);
                if (MODE == 2 && bnd) { const unsigned km = selbit ? 0xffffffffu : 0u;
                    wa0.x &= km; wa0.y &= km; wa0.z &= km; wa0.w &= km; wa1.x &= km; wa1.y &= km; wa1.z &= km; wa1.w &= km; wb0.x &= km; wb0.y &= km; wb0.z &= km; wb0.w &= km; wb1.x &= km; wb1.y &= km; wb1.z &= km; wb1.w &= km; }
                const bf16x8 fa0 = __builtin_bit_cast(bf16x8, wa0), fa1 = __builtin_bit_cast(bf16x8, wa1), fb0 = __builtin_bit_cast(bf16x8, wb0), fb1 = __builtin_bit_cast(bf16x8, wb1);
                const LAS unsigned char* vb = Vb + (4 * hi + ((F.lane & 15) >> 2)) * 64 + ((F.lane >> 4) & 1) * 32 + (F.lane & 3) * 8;
#pragma unroll
                for (int dh = 0; dh < 2; ++dh) {
                    const LAS unsigned char* v0 = vb + dh * 4096;
                    const s16x4 a0 = ds_tr16(v0), a1 = ds_tr16(v0 + 512), b0 = ds_tr16(v0 + 1024), b1 = ds_tr16(v0 + 1536), c0_ = ds_tr16(v0 + 2048), c1 = ds_tr16(v0 + 2560), d0_ = ds_tr16(v0 + 3072), d1 = ds_tr16(v0 + 3584);
                    const bf16x8 vfa0 = {a0[0], a0[1], a0[2], a0[3], a1[0], a1[1], a1[2], a1[3]}, vfa1 = {b0[0], b0[1], b0[2], b0[3], b1[0], b1[1], b1[2], b1[3]};
                    const bf16x8 vfb0 = {c0_[0], c0_[1], c0_[2], c0_[3], c1[0], c1[1], c1[2], c1[3]}, vfb1 = {d0_[0], d0_[1], d0_[2], d0_[3], d1[0], d1[1], d1[2], d1[3]};
                    o[dh] = __builtin_amdgcn_mfma_f32_32x32x16_bf16(vfa0, fa0, o[dh], 0, 0, 0);
                    o[dh] = __builtin_amdgcn_mfma_f32_32x32x16_bf16(vfa1, fa1, o[dh], 0, 0, 0);
                    o[dh] = __builtin_amdgcn_mfma_f32_32x32x16_bf16(vfb0, fb0, o[dh], 0, 0, 0);
                    o[dh] = __builtin_amdgcn_mfma_f32_32x32x16_bf16(vfb1, fb1, o[dh], 0, 0, 0);
                }
            }
        } else if (need) {
#pragma unroll 1
            for (int kb = 0; kb < 2; ++kb) {
                const int key0 = kt * 64 + kb * 32;
                bool fast;
                if (MODE == 2) fast = kt < (tw0 >> 6);
                else if (MODE == 3) fast = (key0 + 31 <= tw0) && (key0 + 512 > tw0 + 7);
                else fast = key0 + 31 < nvmin;
                if (MODE != 1) fast = fast && !bnd && !__any(m < -1e29f);
                float c0 = 0.f;
                if (fast) c0 = (MODE == 1) ? cinit : ((MODE == 2 && !selbit) ? -1e30f : -m);
                f32x16 p;
#pragma unroll
                for (int r = 0; r < 16; ++r) p[r] = c0;
#pragma unroll
                for (int d0 = 0; d0 < 4; ++d0) {
                    const bf16x8 kf = *(const LAS bf16x8*)(Kb + (2 * d0 + hi) * 1024 + (32 * kb + r32) * 16);
                    p = __builtin_amdgcn_mfma_f32_32x32x16_bf16(kf, qr[d0], p, 0, 0, 0);
                }
                float pe[16];
                if (fast) {
                    if (MODE != 1) {
                        float mx = fmaxf(fmaxf(p[0], p[1]), p[2]);
#pragma unroll
                        for (int r = 3; r < 15; r += 2) mx = fmaxf(fmaxf(mx, p[r]), p[r + 1]);
                        mx = xhalf_max(fmaxf(mx, p[15]));
                        if (__any(mx > NSA_THR)) {
                            const float dl = fmaxf(mx, 0.f), alpha = fexp2(-dl);
                            m += dl; l *= alpha;
#pragma unroll
                            for (int r = 0; r < 16; ++r) p[r] -= dl;
                            if (MODE != 0) {
#pragma unroll
                                for (int r = 0; r < 16; ++r) { o[0][r] *= alpha; o[1][r] *= alpha; }
                            }
                        }
                    }
                    float ps0 = 0.f, ps1 = 0.f;
#pragma unroll
                    for (int r = 0; r < 16; r += 2) { pe[r] = fexp2(p[r]); pe[r + 1] = fexp2(p[r + 1]); ps0 += pe[r]; ps1 += pe[r + 1]; }
                    if (MODE != 1) l += ps0 + ps1;
                } else if (MODE == 1) {
#pragma unroll
                    for (int r = 0; r < 16; ++r) { const int key = key0 + crow(r, hi); pe[r] = (key < nv) ? fexp2(p[r] + cinit) : 0.f; }
                } else if (bnd) {
                    float ps = 0.f;
#pragma unroll
                    for (int r = 0; r < 16; ++r) {
                        const int key = key0 + crow(r, hi); bool ok;
                        if (MODE == 0) ok = key < nv;
                        else if (MODE == 2) ok = selbit && (kt < (t >> 6) || key <= t);
                        else ok = (key <= t) && (key + 512 > t);
                        pe[r] = ok ? fexp2(p[r]) : 0.f; ps += pe[r];
                    }
                    l += ps;
                } else {
                    float mx = NEGBIG;
#pragma unroll
                    for (int r = 0; r < 16; ++r) {
                        const int key = key0 + crow(r, hi); bool ok;
                        if (MODE == 0) ok = key < nv;
                        else if (MODE == 2) ok = selbit && (kt < (t >> 6) || key <= t);
                        else ok = (key <= t) && (key + 512 > t);
                        p[r] = ok ? p[r] : NEGBIG; mx = fmaxf(mx, p[r]);
                    }
                    mx = xhalf_max(mx);
                    const float mn = fmaxf(m, mx), alpha = fexp2(m - mn);
                    float ps = 0.f;
#pragma unroll
                    for (int r = 0; r < 16; ++r) { pe[r] = (p[r] > -1e29f) ? fexp2(p[r] - mn) : 0.f; ps += pe[r]; }
                    l = l * alpha + ps; m = mn;
                    if (MODE != 0) {
#pragma unroll
                        for (int r = 0; r < 16; ++r) { o[0][r] *= alpha; o[1][r] *= alpha; }
                    }
                }
                if (MODE == 1) {
#pragma unroll
                    for (int rg = 0; rg < 4; ++rg) {
                        float a = (pe[4 * rg] + pe[4 * rg + 1]) + (pe[4 * rg + 2] + pe[4 * rg + 3]), sp = pe[4 * rg + 3];
                        a += dpp_xor1(a); a += dpp_xor2(a); sp += dpp_xor1(sp); sp += dpp_xor2(sp);
                        if ((r32 & 3) == 0) { const int jp = (key0 >> 2) + 2 * rg + hi;
                            __hip_atomic_fetch_add(impw + tokl * 128 + jp, a, __ATOMIC_RELAXED, __HIP_MEMORY_SCOPE_WORKGROUP);
                            if (jp + 1 < 128) __hip_atomic_fetch_add(impw + tokl * 128 + jp + 1, sp, __ATOMIC_RELAXED, __HIP_MEMORY_SCOPE_WORKGROUP); }
                    }
                }
                if (MODE != 0) {
                    v4u pw0, pw1;
                    pw0.x = cvtpk(pe[0], pe[1]); pw0.y = cvtpk(pe[2], pe[3]); pw0.z = cvtpk(pe[4], pe[5]); pw0.w = cvtpk(pe[6], pe[7]);
                    pw1.x = cvtpk(pe[8], pe[9]); pw1.y = cvtpk(pe[10], pe[11]); pw1.z = cvtpk(pe[12], pe[13]); pw1.w = cvtpk(pe[14], pe[15]);
                    const bf16x8 pf0 = __builtin_bit_cast(bf16x8, pw0), pf1 = __builtin_bit_cast(bf16x8, pw1);
                    const LAS unsigned char* vb = Vb + (32 * kb + 4 * hi + ((F.lane & 15) >> 2)) * 64 + ((F.lane >> 4) & 1) * 32 + (F.lane & 3) * 8;
#pragma unroll
                    for (int dh = 0; dh < 2; ++dh) {
                        const s16x4 a0 = ds_tr16(vb + dh * 4096), a1 = ds_tr16(vb + dh * 4096 + 512), b0 = ds_tr16(vb + dh * 4096 + 1024), b1 = ds_tr16(vb + dh * 4096 + 1024 + 512);
                        const bf16x8 vf0 = {a0[0], a0[1], a0[2], a0[3], a1[0], a1[1], a1[2], a1[3]}, vf1 = {b0[0], b0[1], b0[2], b0[3], b1[0], b1[1], b1[2], b1[3]};
                        o[dh] = __builtin_amdgcn_mfma_f32_32x32x16_bf16(vf0, pf0, o[dh], 0, 0, 0);
                        o[dh] = __builtin_amdgcn_mfma_f32_32x32x16_bf16(vf1, pf1, o[dh], 0, 0, 0);
                    }
                }
            }
        }
        if (has_next) { *(LAS v4u*)(KB + (buf ^ 1) * 8192 + F.tid * 16) = kreg; if (MODE != 0) *(LAS v4u*)(VB + (buf ^ 1) * 8192 + F.tid * 16) = vreg; }
        __syncthreads();
    }
}

__device__ __forceinline__ void nsa_item(Frame& F, int b, int g, int qi) {
    const int r32 = F.lane & 31, hi = F.lane >> 5, tokl = r32 >> 2, hh = r32 & 3;
    const int t0 = qi * 64, tw0 = t0 + 8 * F.wave, t = tw0 + tokl;
    const unsigned char* dob = F.dout_b;
    const size_t img = (size_t)(b * 2 + g) * (1u << 20);
    LAS float* impw = (LAS float*)(F.lds + RING_OFF + NSA_IMP) + F.wave * 1024;
    LAS unsigned* selm = (LAS unsigned*)(F.lds + TAB_OFF + 1024) + F.wave * 32;
    LAS float* oaccw = (LAS float*)(F.lds + RING_OFF + NSA_OACC) + F.wave * 2048 + F.lane;
#pragma unroll
    for (int i = 0; i < 16; ++i) impw[F.lane + 64 * i] = 0.f;
    bf16x8 qr[4];
    { const bf16* qrow = (const bf16*)(dob + DO_QN) + (((size_t)(b * 2 + g) * SEQ + tw0) * 4 + r32) * 64;
#pragma unroll
      for (int d0 = 0; d0 < 4; ++d0) qr[d0] = *(const bf16x8*)(qrow + 16 * d0 + 8 * hi); }
    const float* gt = (const float*)(F.ws + WS_GATES) + ((size_t)b * SEQ + t) * 24 + (g * 4 + hh) * 3;
    f32x16 o[2];
    const int nv = (t >= 31) ? ((t - 31) >> 4) + 1 : 0, nvw = (tw0 + 7 >= 31) ? ((tw0 + 7 - 31) >> 4) + 1 : 0, nvmin = (tw0 >= 31) ? ((tw0 - 31) >> 4) + 1 : 0;
    const int nct = (4 * qi + 3 + 63) >> 6;
    const unsigned char* Kc = dob + DO_KCMP + (size_t)(b * 2 + g) * 65536; const unsigned char* Vc = dob + DO_VCMP + (size_t)(b * 2 + g) * 65536;
#if defined(NSA_SPIN)
    unsigned long long tsp = __builtin_amdgcn_s_memrealtime();
#define NSPIN(k) do { if (NSA_SPIN == (k)) { const unsigned long long t1_ = __builtin_amdgcn_s_memrealtime(), dt_ = t1_ - tsp; while (__builtin_amdgcn_s_memrealtime() - t1_ < dt_) __builtin_amdgcn_s_sleep(4); } tsp = __builtin_amdgcn_s_memrealtime(); } while (0)
#else
#define NSPIN(k) do { } while (0)
#endif
    bool bnd0, bnd1, bnd2;
    { float gq = fabsf(F.q_gain[F.lane]), g0k = fabsf(F.k_gain[F.lane]), g1k = fabsf(F.k_gain[64 + F.lane]), g2k = fabsf(F.k_gain[128 + F.lane]);
#pragma unroll
      for (int off = 1; off < 64; off <<= 1) { gq = fmaxf(gq, __shfl_xor(gq, off)); g0k = fmaxf(g0k, __shfl_xor(g0k, off)); g1k = fmaxf(g1k, __shfl_xor(g1k, off)); g2k = fmaxf(g2k, __shfl_xor(g2k, off)); }
      const float cb = 64.0f * 0.125f * 1.4426950408889634f * 1.03f * gq;
      bnd0 = __builtin_amdgcn_readfirstlane((int)(cb * g0k < 40.0f)) != 0; bnd1 = __builtin_amdgcn_readfirstlane((int)(cb * g1k < 40.0f)) != 0; bnd2 = __builtin_amdgcn_readfirstlane((int)(cb * g2k < 40.0f)) != 0; }
    float m = bnd0 ? 0.f : NEGBIG, l = 0.f;
    nsa_branch<0>(F, Kc, Vc, 0, nct, qr, m, l, o, t, tw0, nv, nvw, nvmin, 0u, 0u, 0u, 0u, 0u, 0u, 0u, 0u, 0.f, impw, bnd0);
    { const float lt = l + __shfl_xor(l, 32); const float cinit = (lt > 0.f) ? -__log2f(lt) - m : -1e30f;
#pragma unroll
      for (int r = 0; r < 16; ++r) { o[0][r] = 0.f; o[1][r] = 0.f; }
      nsa_branch<1>(F, Kc, Vc, 0, nct, qr, m, l, o, t, tw0, nv, nvw, nvmin, 0u, 0u, 0u, 0u, 0u, 0u, 0u, 0u, cinit, impw, bnd0);
#pragma unroll
      for (int r = 0; r < 16; ++r) { oaccw[r * 64] = gt[0] * o[0][r]; oaccw[(16 + r) * 64] = gt[0] * o[1][r]; } }
    __syncthreads();
    NSPIN(1);
#pragma unroll 1
    for (int tl = 0; tl < 4; ++tl) {
        const int j0 = F.lane, j1 = F.lane + 64;
        const int curA = (tw0 + tl) >> 6, curB = (tw0 + tl + 4) >> 6;
        const unsigned uA0 = (j0 <= curA) ? (__float_as_uint(impw[tl * 128 + j0] + ((j0 == 0 || j0 == curA || j0 == curA - 1) ? 1e4f : 0.f)) + 1u) : 0u;
        const unsigned uA1 = (j1 <= curA) ? (__float_as_uint(impw[tl * 128 + j1] + ((j1 == curA || j1 == curA - 1) ? 1e4f : 0.f)) + 1u) : 0u;
        const unsigned uB0 = (j0 <= curB) ? (__float_as_uint(impw[(tl + 4) * 128 + j0] + ((j0 == 0 || j0 == curB || j0 == curB - 1) ? 1e4f : 0.f)) + 1u) : 0u;
        const unsigned uB1 = (j1 <= curB) ? (__float_as_uint(impw[(tl + 4) * 128 + j1] + ((j1 == curB || j1 == curB - 1) ? 1e4f : 0.f)) + 1u) : 0u;
        bool sA0, sA1, sB0, sB1;
        if (curA < 16) { sA0 = (j0 <= curA); sA1 = false; sB0 = (j0 <= curB); sB1 = false; }
        else {
            unsigned TA = 0u, TB = 0u;
#pragma unroll 1
            for (int bit = 31; bit >= 0; --bit) {
                const unsigned candA = TA | (1u << bit), candB = TB | (1u << bit);
                const int cA = __popcll(__ballot(uA0 >= candA)) + __popcll(__ballot(uA1 >= candA));
                const int cB = __popcll(__ballot(uB0 >= candB)) + __popcll(__ballot(uB1 >= candB));
                if (cA >= 16) TA = candA;
                if (cB >= 16) TB = candB;
            }
            const unsigned long long below = (F.lane == 0) ? 0ull : (~0ull >> (64 - F.lane));
            { const unsigned long long g0 = __ballot(uA0 > TA), g1 = __ballot(uA1 > TA), e0 = __ballot(uA0 == TA), e1 = __ballot(uA1 == TA);
              const int need = 16 - (__popcll(g0) + __popcll(g1));
              const int rank0 = __popcll(e0 & below), rank1 = __popcll(e0) + __popcll(e1 & below);
              sA0 = (uA0 > TA) || (uA0 == TA && rank0 < need); sA1 = (uA1 > TA) || (uA1 == TA && rank1 < need); }
            { const unsigned long long g0 = __ballot(uB0 > TB), g1 = __ballot(uB1 > TB), e0 = __ballot(uB0 == TB), e1 = __ballot(uB1 == TB);
              const int need = 16 - (__popcll(g0) + __popcll(g1));
              const int rank0 = __popcll(e0 & below), rank1 = __popcll(e0) + __popcll(e1 & below);
              sB0 = (uB0 > TB) || (uB0 == TB && rank0 < need); sB1 = (uB1 > TB) || (uB1 == TB && rank1 < need); }
        }
        const unsigned long long mA0 = __ballot(sA0), mA1 = __ballot(sA1), mB0 = __ballot(sB0), mB1 = __ballot(sB1);
        if (F.lane == 0) { selm[tl * 4 + 0] = (unsigned)mA0; selm[tl * 4 + 1] = (unsigned)(mA0 >> 32); selm[tl * 4 + 2] = (unsigned)mA1; selm[tl * 4 + 3] = (unsigned)(mA1 >> 32);
            selm[(tl + 4) * 4 + 0] = (unsigned)mB0; selm[(tl + 4) * 4 + 1] = (unsigned)(mB0 >> 32); selm[(tl + 4) * 4 + 2] = (unsigned)mB1; selm[(tl + 4) * 4 + 3] = (unsigned)(mB1 >> 32); }
    }
    __syncthreads();
    const unsigned mk0 = selm[tokl * 4 + 0], mk1 = selm[tokl * 4 + 1], mk2 = selm[tokl * 4 + 2], mk3 = selm[tokl * 4 + 3];
    unsigned wo0 = 0u, wo1 = 0u, wo2 = 0u, wo3 = 0u;
#pragma unroll
    for (int tl = 0; tl < 8; ++tl) { wo0 |= selm[tl * 4 + 0]; wo1 |= selm[tl * 4 + 1]; wo2 |= selm[tl * 4 + 2]; wo3 |= selm[tl * 4 + 3]; }
    wo0 = __builtin_amdgcn_readfirstlane(wo0); wo1 = __builtin_amdgcn_readfirstlane(wo1); wo2 = __builtin_amdgcn_readfirstlane(wo2); wo3 = __builtin_amdgcn_readfirstlane(wo3);
    NSPIN(2);
    { m = bnd1 ? 0.f : NEGBIG; l = 0.f;
#pragma unroll
      for (int r = 0; r < 16; ++r) { o[0][r] = 0.f; o[1][r] = 0.f; }
      nsa_branch<2>(F, dob + DO_KSEL + img, dob + DO_VSEL + img, 0, qi + 1, qr, m, l, o, t, tw0, nv, nvw, nvmin, mk0, mk1, mk2, mk3, wo0, wo1, wo2, wo3, 0.f, impw, bnd1);
      const float lt = l + __shfl_xor(l, 32); const float sc = (lt > 0.f) ? gt[1] / lt : 0.f;
#pragma unroll
      for (int r = 0; r < 16; ++r) { oaccw[r * 64] += sc * o[0][r]; oaccw[(16 + r) * 64] += sc * o[1][r]; } }
    NSPIN(3);
    { m = bnd2 ? 0.f : NEGBIG; l = 0.f;
#pragma unroll
      for (int r = 0; r < 16; ++r) { o[0][r] = 0.f; o[1][r] = 0.f; }
      nsa_branch<3>(F, dob + DO_KWIN + img, dob + DO_VWIN + img, (qi >= 8) ? qi - 8 : 0, qi + 1, qr, m, l, o, t, tw0, nv, nvw, nvmin, 0u, 0u, 0u, 0u, 0u, 0u, 0u, 0u, 0.f, impw, bnd2);
      const float lt = l + __shfl_xor(l, 32); const float sc = (lt > 0.f) ? gt[2] / lt : 0.f;
#pragma unroll
      for (int r = 0; r < 16; ++r) { o[0][r] = oaccw[r * 64] + sc * o[0][r]; o[1][r] = oaccw[(16 + r) * 64] + sc * o[1][r]; } }
    NSPIN(4);
    bf16* orow = (bf16*)(F.ws + WS_O + 32 * MiB) + ((size_t)b * SEQ + t) * DM + 512 + (g * 4 + hh) * 64;
#pragma unroll
    for (int dh = 0; dh < 2; ++dh)
#pragma unroll
        for (int rg = 0; rg < 4; ++rg) { v2u w; w.x = pk2(o[dh][4 * rg], o[dh][4 * rg + 1]); w.y = pk2(o[dh][4 * rg + 2], o[dh][4 * rg + 3]);
            *(v2u*)(orow + 32 * dh + 8 * rg + 4 * hi) = w; }
    __syncthreads();
}

__device__ __forceinline__ void sgu_item(Frame& F, int item) {
    const int gg = item & 7, ck = (item >> 3) & 63, b = item >> 9;
    const size_t tok0 = (size_t)b * SEQ + ck * 128;
    const bf16* Z = (const bf16*)(F.ws + WS_A);
    constexpr int RS = 544, BS = 136;
    LAS bf16* Ws = (LAS bf16*)(F.lds + RING_OFF);
    LAS unsigned char* Vs = F.lds + RING_OFF + 34816;
    LAS float* rs = (LAS float*)(F.lds + RING_OFF + 34816 + 128 * RS);
    if (F.tid < 128) { const float* st = (const float*)(F.ws + WS_STATS) + (tok0 + F.tid) * 32; float sum = 0.f;
#pragma unroll
        for (int k = 0; k < 32; k += 4) { const f32x4 v = *(const f32x4*)(st + k); sum += (v.x + v.y) + (v.z + v.w); }
        rs[F.tid] = 1.0f / sqrtf(sum * (1.0f / SGW) + NORM_EPS); }
    { const float* wsrc = F.sgu_ws + (size_t)gg * 128 * 128;
#pragma unroll
      for (int k = 0; k < 8; ++k) { const int p = F.tid + 512 * k, tr = p >> 5, sc = (p & 31) * 4; const f32x4 w = *(const f32x4*)(wsrc + tr * 128 + sc);
          v2u o; o.x = pk2((sc <= tr) ? w.x : 0.f, (sc + 1 <= tr) ? w.y : 0.f); o.y = pk2((sc + 2 <= tr) ? w.z : 0.f, (sc + 3 <= tr) ? w.w : 0.f);
          *(LAS v2u*)(Ws + tr * 136 + sc) = o; } }
    __syncthreads();
    { const int cc = F.tid & 31; float gn[8];
#pragma unroll
      for (int i = 0; i < 8; ++i) gn[i] = F.sgu_ng[gg * 256 + cc * 8 + i];
      v4u zr[8];
#pragma unroll
      for (int k = 0; k < 8; ++k) { const int sidx = (F.tid >> 5) + 16 * k; zr[k] = *(const v4u*)(Z + (tok0 + sidx) * 4096 + 2048 + gg * 256 + cc * 8); }
#pragma unroll
      for (int k = 0; k < 8; ++k) { const int sidx = (F.tid >> 5) + 16 * k; float x[8]; unpack8(zr[k], x); const float rr = rs[sidx];
#pragma unroll
          for (int i = 0; i < 8; ++i) x[i] *= rr * gn[i];
          const v4u o = pack8(x); LAS unsigned char* dst = Vs + sidx * RS + (cc >> 3) * BS + (cc & 7) * 16;
          *(LAS v2u*)dst = (v2u){o.x, o.y}; *(LAS v2u*)(dst + 8) = (v2u){o.z, o.w}; } }
    __syncthreads();
    v4u uraw[8];
    { const bf16* urow0 = Z + (tok0 + 16 * F.wave + (F.lane & 15)) * 4096 + gg * 256 + 64 * (F.lane >> 4);
#pragma unroll
      for (int j = 0; j < 8; ++j) uraw[j] = *(const v4u*)(urow0 + 8 * j); }
    f32x4 acc[16];
#pragma unroll
    for (int nt = 0; nt < 16; ++nt) acc[nt] = (f32x4){0.f, 0.f, 0.f, 0.f};
    const int ksteps = (16 * F.wave + 16 + 31) >> 5;
    const LAS bf16* wp = Ws + (16 * F.wave + (F.lane & 15)) * 136 + (F.lane >> 4) * 8;
    const LAS unsigned char* vp = Vs + (8 * (F.lane >> 4) + ((F.lane & 15) >> 2)) * RS + (F.lane & 3) * BS;
#pragma unroll 1
    for (int kk = 0; kk < ksteps; ++kk) {
        const bf16x8 wf = *(const LAS bf16x8*)(wp + kk * 32);
        const LAS unsigned char* vk = vp + kk * 32 * RS;
#pragma unroll
        for (int nt = 0; nt < 16; ++nt) {
            const s16x4 lo = ds_tr16(vk + 8 * nt), hi4 = ds_tr16(vk + 4 * RS + 8 * nt);
            const bf16x8 vf = {lo[0], lo[1], lo[2], lo[3], hi4[0], hi4[1], hi4[2], hi4[3]};
            acc[nt] = __builtin_amdgcn_mfma_f32_16x16x32_bf16(vf, wf, acc[nt], 0, 0, 0);
        }
    }
    { const int tr = 16 * F.wave + (F.lane & 15), g = F.lane >> 4; const float bs = F.sgu_bs[gg * 128 + tr];
      bf16* orow = (bf16*)(F.ws + WS_O) + (tok0 + tr) * SGW + gg * 256 + 64 * g;
#pragma unroll
      for (int j = 0; j < 8; ++j) { float u[8]; unpack8(uraw[j], u);
#pragma unroll
          for (int i = 0; i < 4; ++i) { u[i] *= acc[2 * j][i] + bs; u[4 + i] *= acc[2 * j + 1][i] + bs; }
          *(v4u*)(orow + 8 * j) = pack8(u); } }
    __syncthreads();
}


__device__ __forceinline__ void moe_tail_copies(Frame& F, int set) {
    const int np = ((const LAS int*)(F.lds + TAB_OFF))[16];
    int cthr = 4 * np - 2 * F.G; cthr = cthr < 0 ? 0 : (cthr > F.G - 64 ? F.G - 64 : cthr);
    __syncthreads();
    if (F.bid >= cthr) tr_run(F, set, (F.bid - cthr) * 8 + F.wave, (F.G - cthr) * 8);
}
constexpr int NPHASE = 18;
struct Args { const void* in[26]; float* out; unsigned char* ws; int ph_lo, ph_hi, use_bar, pad; };
__global__ void __launch_bounds__(512, 2) trunk_fwd(Args args) {
    extern __shared__ __attribute__((aligned(16))) unsigned char lds[];
    Frame F;
    F.lds = (LAS unsigned char*)lds;
    F.MISC = (volatile LAS unsigned*)(F.lds + MISC_OFF);
    F.tid = threadIdx.x; F.lane = F.tid & 63; F.wave = __builtin_amdgcn_readfirstlane(F.tid >> 6);
    F.G = gridDim.x; F.bid = blockIdx.x;
    F.ws = args.ws; F.out = args.out; F.dout_b = (unsigned char*)args.out;
    F.ctl = (gu32*)(args.ws + WS_CTL);
    F.x = (const float*)args.in[0]; F.c = (const float*)args.in[1]; F.positions = (const int*)args.in[2]; F.w_ada = (const float*)args.in[3]; F.b_ada = (const float*)args.in[4];
    F.norm_g = (const float*)args.in[5]; F.w_in_ab = (const float*)args.in[6]; F.w_out_ab = (const float*)args.in[7]; F.gla_w2 = (const float*)args.in[8]; F.gla_bg = (const float*)args.in[9];
    F.gla_ng = (const float*)args.in[10]; F.q_gain = (const float*)args.in[11]; F.k_gain = (const float*)args.in[12]; F.cmp_pe = (const float*)args.in[13]; F.cmp_w1 = (const float*)args.in[14];
    F.cmp_w2 = (const float*)args.in[15]; F.w_in_c = (const float*)args.in[16]; F.sgu_ng = (const float*)args.in[17]; F.sgu_ws = (const float*)args.in[18]; F.sgu_bs = (const float*)args.in[19];
    F.w_out_c = (const float*)args.in[20]; F.w_router = (const float*)args.in[21]; F.r_bias = (const float*)args.in[22]; F.w_gate = (const float*)args.in[23]; F.w_up = (const float*)args.in[24];
    F.w_down = (const float*)args.in[25];
    for (int u = F.tid; u < (LDS_BYTES - LDSCTL_OFF) / 4; u += 512) ((LAS unsigned*)(F.lds + LDSCTL_OFF))[u] = 0u;
    __syncthreads();
    XcdBarrier bar; bar.bar = (unsigned*)(F.ctl + CW_BAR); bar.x = 0; bar.st = nullptr;
    if (args.use_bar) bar = xcd_barrier_post((unsigned*)(F.ctl + CW_BAR) + (args.use_bar - 1) * XCD_BAR_WORDS, F.MISC + 8);
    const int lo = args.ph_lo, hi = args.ph_hi;
#ifndef PH_MASK
#define PH_MASK 0x3FFFFu
#endif
#define IN(k) ((((PH_MASK) >> (k)) & 1u) && lo <= (k) && (k) < hi)
#if defined(SPIN_PHASE)
    unsigned long long t_mark = __builtin_amdgcn_s_memrealtime();
#define SPIN_HOOK(k) do { if ((k) == (SPIN_PHASE)) { const unsigned long long t1_ = __builtin_amdgcn_s_memrealtime(), dt_ = t1_ - t_mark; while (__builtin_amdgcn_s_memrealtime() - t1_ < dt_) __builtin_amdgcn_s_sleep(4); } } while (0)
#define SPIN_MARK() do { t_mark = __builtin_amdgcn_s_memrealtime(); } while (0)
#else
#define SPIN_HOOK(k) do { } while (0)
#define SPIN_MARK() do { } while (0)
#endif
#define SEAM(k) do { if (IN(k)) SPIN_HOOK(k); if (IN(k) && IN((k) + 1)) xcd_barrier(bar); SPIN_MARK(); } while (0)
    float* mod = (float*)(F.ws + WS_MOD);
    bf16* Hb = (bf16*)(F.ws + WS_O);
    bf16* Ab = (bf16*)(F.ws + WS_A);

    if (IN(0)) { p0_prologue(F); } SEAM(0);
    if (IN(1)) { row_pass<false, true, false>(F, F.x, mod, 0, F.norm_g, mod, 0, 0); } SEAM(1);
    if (IN(2)) { pg8::Gemm g{Hb, (const bf16*)(F.ws + WS_WIN), NTOK, NPROJ, DM}; pg8::StaticOrder S; S.init(NTOK, NPROJ, F.G, F.bid);
        pg8::EpiBf16<0> E{Ab, NPROJ, nullptr, 0, 0, 1.f};
        pg8::gemm_phase<pg8::EpiBf16<0>, pg8::StaticOrder, true, true>(F.lds + RING_OFF, g, S, E); } SEAM(2);
    if (IN(3)) {
        for (int it = F.bid; it < 1024; it += F.G) gla_prep_item(F, it);
        { int tok = F.bid * 8 + F.wave; const int tstep = F.G * 8; PrepRaw cur, nxt; nxt.pos = 0; nxt.ng = 0u; nxt.r0 = (v4u){0u, 0u, 0u, 0u}; nxt.r1 = nxt.r0; nxt.r2 = nxt.r0;
          if (tok < NTOK) nsa_prep_load(F, tok, cur);
          while (tok < NTOK) { const int ntok = tok + tstep; if (ntok < NTOK) nsa_prep_load(F, ntok, nxt); nsa_prep_token(F, tok, cur); cur = nxt; tok = ntok; } }
    } SEAM(3);
    if (IN(4)) {
        const int half = F.G >> 1;
        if (F.bid < half) { for (int it = F.bid; it < 128; it += half) nsa_compress_item(F, it); }
        else { for (int gi = (F.bid - half) * 512 + F.tid; gi < 65536; gi += (F.G - half) * 512) gla_scan(F, gi); }
    } SEAM(4);
    if (IN(5)) {
#ifndef NO_NSA
        { const int p = F.bid & 255, bg = p >> 6, i = p & 63; nsa_item(F, bg >> 1, bg & 1, i); nsa_item(F, bg >> 1, bg & 1, 127 - i); }
#endif
#ifndef NO_GLAOUT
#if defined(GLA_SPIN)
        { const unsigned long long tg0 = __builtin_amdgcn_s_memrealtime();
#endif
        for (int it = F.bid; it < 1024; it += F.G) gla_out_item(F, it);
#if defined(GLA_SPIN)
          const unsigned long long t1_ = __builtin_amdgcn_s_memrealtime(), dt_ = t1_ - tg0; while (__builtin_amdgcn_s_memrealtime() - t1_ < dt_) __builtin_amdgcn_s_sleep(4); }
#endif
#endif
    } SEAM(5);
    if (IN(6)) { pg8::Gemm g{(const bf16*)(F.ws + WS_O + 32 * MiB), (const bf16*)(F.ws + WS_WOUT), NTOK, DM, DM}; pg8::StaticOrder S; S.init(NTOK, DM, F.G, F.bid);
        EpiResid E{F.x, F.out, mod + 2 * 1024};
        pg8::gemm_phase<EpiResid, pg8::StaticOrder, true, true>(F.lds + RING_OFF, g, S, E); } SEAM(6);
#define MOE_BLOCK(P, LAYER) \
    if (IN(P)) { row_pass<false, true, true>(F, F.out, mod + (LAYER) * 2 * 6144, 3 * 1024, F.norm_g + ((LAYER) * 2 + 1) * 1024, mod, (LAYER), 0); } SEAM(P); \
    if (IN((P) + 1)) { moe_tables(F, (LAYER)); MoeOrder S{(const LAS int*)(F.lds + TAB_OFF), F.G, F.bid}; \
        { LAS unsigned* rofs = (LAS unsigned*)(F.lds + TAB_OFF + 2048); const int* elist = (const int*)(F.ws + WS_STATS); pg8::Unit uu; \
          for (int ui = 0; ui < 3; ++ui) if (S.next(ui, uu)) { if (F.tid < 256) rofs[ui * 256 + F.tid] = S.row_off(uu, F.tid, elist); } \
          __syncthreads(); } \
        pg8::Gemm g{Hb, (const bf16*)(F.ws + WS_WGU) + (size_t)(LAYER) * 16 * 1024 * 1024, MOE_ROWS, 1024, DM}; EpiMoeGU E{(bf16*)(F.ws + WS_A + A_HID_OFF)}; \
        pg8::gemm_phase_gather<EpiMoeGU, MoeOrder>(F.lds + RING_OFF, g, S, E, (const LAS unsigned*)(F.lds + TAB_OFF + 2048)); \
        if ((LAYER) == 0) moe_tail_copies(F, 1); } SEAM((P) + 1); \
    if (IN((P) + 2)) { moe_tables(F, (LAYER)); MoeOrder S{(const LAS int*)(F.lds + TAB_OFF), F.G, F.bid}; \
        pg8::Gemm g{(const bf16*)(F.ws + WS_A + A_HID_OFF), (const bf16*)(F.ws + WS_WDN) + (size_t)(LAYER) * 16 * 1024 * 512, MOE_ROWS, 1024, EHID}; EpiMoeDn E{Ab}; \
        pg8::gemm_phase<EpiMoeDn, MoeOrder, true, true>(F.lds + RING_OFF, g, S, E); \
        if ((LAYER) == 0) moe_tail_copies(F, 2); } SEAM((P) + 2);
    MOE_BLOCK(7, 0)
    if (IN(10)) { row_pass<true, true, false>(F, F.out, mod + 2 * 6144, 0, F.norm_g + 2 * 1024, mod, 1, 0); } SEAM(10);
    if (IN(11)) { pg8::Gemm g{Hb, (const bf16*)(F.ws + WS_WINC), NTOK, 4096, DM}; pg8::StaticOrder S; S.init(NTOK, 4096, F.G, F.bid);
        EpiGeluStats E{Ab, (float*)(F.ws + WS_STATS)};
        pg8::gemm_phase<EpiGeluStats, pg8::StaticOrder, true, true>(F.lds + RING_OFF, g, S, E); } SEAM(11);
    if (IN(12)) { for (int it = F.bid; it < 1024; it += F.G) sgu_item(F, it); } SEAM(12);
    if (IN(13)) { pg8::Gemm g{Hb, (const bf16*)(F.ws + WS_WOUTC), NTOK, DM, SGW}; pg8::StaticOrder S; S.init(NTOK, DM, F.G, F.bid);
        EpiResid E{F.out, F.out, mod + 2 * 6144 + 2 * 1024};
        pg8::gemm_phase<EpiResid, pg8::StaticOrder, true, true>(F.lds + RING_OFF, g, S, E); } SEAM(13);
    MOE_BLOCK(14, 1)
    if (IN(17)) { row_pass<true, false, false>(F, F.out, mod, 0, F.norm_g, mod + 2 * 6144, 1, 1); SPIN_HOOK(17); }
#undef IN
#undef SEAM
#undef MOE_BLOCK
}

#ifndef MK_N_LAUNCHES
#define MK_N_LAUNCHES 1
#endif
extern "C" void kernel_launch(void* const* d_in, const int* in_sizes, int n_in, void* d_out, int out_size, void* d_ws, size_t ws_size, hipStream_t stream) {
    static int grid = 0;
    if (grid == 0) {
        if (n_in != 26 || out_size != NTOK * DM || ws_size < WS_END) { fprintf(stderr, "kernel_launch: unexpected problem shape / workspace (%d inputs, out %d, ws %zu)\n", n_in, out_size, ws_size); grid = -1; return; }
        int dev = 0, cus = 0, per_cu = 0;
        if (hipGetDevice(&dev) != hipSuccess || hipDeviceGetAttribute(&cus, hipDeviceAttributeMultiprocessorCount, dev) != hipSuccess) { grid = -1; return; }
        if (hipFuncSetAttribute((const void*)trunk_fwd, hipFuncAttributeMaxDynamicSharedMemorySize, LDS_BYTES) != hipSuccess) { fprintf(stderr, "kernel_launch: hipFuncSetAttribute failed\n"); grid = -1; return; }
        if (hipOccupancyMaxActiveBlocksPerMultiprocessor(&per_cu, (const void*)trunk_fwd, 512, LDS_BYTES) != hipSuccess || per_cu < 1) { fprintf(stderr, "kernel_launch: occupancy query says %d blocks per CU\n", per_cu); }
        (void)hipGetLastError();
        grid = cus;
        if (grid != 256) { fprintf(stderr, "kernel_launch: built for a 256-CU device, found %d CUs\n", cus); grid = -1; return; }
    }
    if (grid < 0) return;
    (void)hipMemsetAsync((char*)d_ws + WS_CTL, 0, CTL_ZERO_BYTES, stream);
    Args a{};
    for (int i = 0; i < 26; ++i) a.in[i] = d_in[i];
    a.out = (float*)d_out; a.ws = (unsigned char*)d_ws; a.pad = 0;
    if (MK_N_LAUNCHES == 1) {
#if defined(REP_PHASE)
        a.ph_lo = 0; a.ph_hi = REP_PHASE + 1; a.use_bar = 1;
        hipLaunchKernelGGL(trunk_fwd, dim3(grid), dim3(512), LDS_BYTES, stream, a);
        a.ph_lo = REP_PHASE; a.ph_hi = NPHASE; a.use_bar = 2;
        hipLaunchKernelGGL(trunk_fwd, dim3(grid), dim3(512), LDS_BYTES, stream, a);
#else
        a.ph_lo = 0; a.ph_hi = NPHASE; a.use_bar = 1;
        hipLaunchKernelGGL(trunk_fwd, dim3(grid), dim3(512), LDS_BYTES, stream, a);
#endif
    } else {
        for (int p = 0; p < NPHASE; ++p) { a.ph_lo = p; a.ph_hi = p + 1; a.use_bar = 0; hipLaunchKernelGGL(trunk_fwd, dim3(grid), dim3(512), LDS_BYTES, stream, a); }
    }
}
```

```cpp
#include <hip/hip_runtime.h>
#include <cstdio>
#include <cstdint>
namespace pg8 {
#define PG8_LAS __attribute__((address_space(3)))
typedef unsigned short bf16_t;
typedef short bf16x8 __attribute__((ext_vector_type(8)));
typedef float f32x4 __attribute__((ext_vector_type(4)));
typedef unsigned u32x4 __attribute__((ext_vector_type(4)));
constexpr int BM = 256, BK = 64, HALF = 128, HTB = HALF * BK * 2  , STAGE_BYTES = 8 * HTB, NXCD = 8, WGM = 8;

__host__ __device__ __forceinline__ int lds_byte(int r, int c) { const int st = (r >> 4) * 2 + (c >> 5), rr = r & 15, cc = c & 31, ob = rr * 64 + cc * 2; return st * 1024 + (ob ^ (((ob >> 9) & 1) << 5)); }
__host__ __device__ __forceinline__ void stage_rc(int b, int& R, int& C) { const int st = b / 1024, sb = b % 1024, swz = sb ^ (((sb >> 9) & 1) << 5); R = (st >> 1) * 16 + swz / 64; C = (st & 1) * 32 + (swz % 64) / 2; }
__host__ __device__ __forceinline__ int perm32(int rho) { const int n = rho >> 4, i = rho & 15; return 8 * (i >> 2) + 4 * n + (i & 3); }

struct Unit { int pm, pn; };
struct Gemm { const bf16_t* A; const bf16_t* Bt; int M, N, K; };

struct StaticOrder {
    int nM, nN, nwg, G, c;
    __host__ __device__ void init(int M, int N, int G_, int c_) { nM = M / BM; nN = N / BM; nwg = nM * nN; G = G_; c = c_; }
    __host__ __device__ bool next(int i, Unit& u) const {
        const long L = (long)i * G + c; if (L >= nwg) return false;
        int wgid = (int)L; { const int q = nwg / NXCD, r = nwg % NXCD, xcd = wgid % NXCD, off = wgid / NXCD; wgid = (xcd < r ? xcd * (q + 1) : r * (q + 1) + (xcd - r) * q) + off; }
        const int nig = WGM * nN, gid = wgid / nig, fm = gid * WGM, gsz = (nM - fm) < WGM ? (nM - fm) : WGM;
        u.pm = fm + ((wgid % nig) % gsz); u.pn = (wgid % nig) / gsz; return true;
    }
    __device__ __forceinline__ void a_ready(const Unit&) const {}
    __device__ __forceinline__ void done(const Unit&) const {}
    __device__ __forceinline__ bool half_only(const Unit&) const { return false; }
};

__device__ __forceinline__ unsigned cvt_pk_bf16(float lo, float hi) { unsigned r; asm volatile("v_cvt_pk_bf16_f32 %0, %1, %2" : "=v"(r) : "v"(lo), "v"(hi)); return r; }
typedef float f32x2 __attribute__((ext_vector_type(2)));
__device__ __forceinline__ f32x2 gelu_pk(f32x2 v) {
    const f32x2 av = __builtin_elementwise_abs(v), d = av * 0.2316418882f + 1.0f;
    f32x2 t; t.x = __builtin_amdgcn_rcpf(d.x); t.y = __builtin_amdgcn_rcpf(d.y);
    f32x2 q = t * 0.5307027145f + (-0.7265760135f); q = q * t + 0.7107068705f; q = q * t + (-0.142248368f); q = q * t + 0.127414796f; q = q * t;
    const f32x2 s = (v * v) * (-0.72134752044f);
    f32x2 e; e.x = __builtin_amdgcn_exp2f(s.x); e.y = __builtin_amdgcn_exp2f(s.y);
    const f32x2 m = v * (q * e), r = v - m;
    f32x2 o; o.x = v.x < 0.f ? m.x : r.x; o.y = v.y < 0.f ? m.y : r.y; return o;
}

template <int ACT  > struct EpiBf16 {
    static constexpr bool PERM = true, AFTER_DRAIN = false; static_assert(ACT == 0 || ACT == 1, "EpiBf16: ACT is 0 (none) or 1 (gelu_pk)");
    bf16_t* O; int ldc; const float* bias; int split_cols; size_t split_stride; float scale0;
    __device__ __forceinline__ void operator()(const f32x4 (&acc)[2][2][4][2], const Unit& u, int wr, int wc, int fr, int fq) const {
        const int row0 = u.pm * BM + wr * 64 + fr; int colt = u.pn * BM; bf16_t* base = O;
        float sc = 1.f; if (split_cols) { const int t = colt / split_cols; base += (size_t)t * split_stride; colt -= t * split_cols; if (t == 0) sc = scale0; }
        const int col0 = colt + wc * 32 + 8 * fq, bcol0 = u.pn * BM + wc * 32 + 8 * fq;
        f32x4 bv[2][2];
#pragma unroll
        for (int bj = 0; bj < 2; ++bj)
#pragma unroll
            for (int n = 0; n < 2; ++n) bv[bj][n] = bias ? *(const f32x4*)(bias + bcol0 + bj * HALF + 4 * n) : (f32x4){0.f, 0.f, 0.f, 0.f};
#pragma unroll
        for (int ai = 0; ai < 2; ++ai)
#pragma unroll
            for (int m = 0; m < 4; ++m) { bf16_t* rowp = base + (size_t)(row0 + ai * HALF + m * 16) * ldc + col0;
#pragma unroll
                for (int bj = 0; bj < 2; ++bj) { f32x4 v0 = acc[ai][bj][m][0] + bv[bj][0], v1 = acc[ai][bj][m][1] + bv[bj][1];
                    if (ACT == 1) { f32x2 a = gelu_pk((f32x2){v0[0], v0[1]}), b = gelu_pk((f32x2){v0[2], v0[3]}), c = gelu_pk((f32x2){v1[0], v1[1]}), d = gelu_pk((f32x2){v1[2], v1[3]});
                        v0 = (f32x4){a.x, a.y, b.x, b.y}; v1 = (f32x4){c.x, c.y, d.x, d.y}; }
                    v0 = v0 * sc; v1 = v1 * sc; u32x4 w; w.x = cvt_pk_bf16(v0[0], v0[1]); w.y = cvt_pk_bf16(v0[2], v0[3]); w.z = cvt_pk_bf16(v1[0], v1[1]); w.w = cvt_pk_bf16(v1[2], v1[3]);
                    *(u32x4*)(rowp + bj * HALF) = w; } }
    }
};

template <class Epi, class Sched, bool ALIGN_EPI = false, bool SP2 = false>
__device__ __forceinline__ void gemm_phase(PG8_LAS unsigned char* lds, const Gemm g, const Sched& S, const Epi& E) {
    const int tid = threadIdx.x, wid = __builtin_amdgcn_readfirstlane(tid >> 6), lane = tid & 63, wr = wid >> 2, wc = wid & 3, fr = lane & 15, fq = lane >> 4;
    const int K = g.K, nt = K / BK;
    unsigned voffA[2], voffB[2];
#pragma unroll
    for (int i = 0; i < 2; ++i) { int R, C; stage_rc(tid * 16 + i * 8192, R, C); const int Rb = Epi::PERM ? ((R & ~31) + perm32(R & 31)) : R;
        voffA[i] = (unsigned)(R * K + C) * 2u; voffB[i] = (unsigned)(Rb * K + C) * 2u; }
    const size_t kstep = (size_t)(BK * 2);
    const size_t hstep = (size_t)HALF * K * 2;
    const size_t tstep = 2 * hstep;
    const unsigned ldsw = (unsigned)wid * 1024u;
    const int aoff = lds_byte(wr * 64 + fr, fq * 8), boff = lds_byte(wc * 32 + fr, fq * 8);
#define PG8_SA(b, h) (((b) * 2 + (h)) * HTB)
#define PG8_SB(b, h) ((4 + (b) * 2 + (h)) * HTB)
#define PG8_STAGE(bufoff, gbase, voff) do { _Pragma("unroll") for (int _i = 0; _i < 2; ++_i) \
        __builtin_amdgcn_global_load_lds((const unsigned*)((const char*)(gbase) + (voff)[_i]), (PG8_LAS unsigned*)(lds + (bufoff) + ldsw + _i * 8192), 16, 0, 0); } while (0)
#define PG8_LDA(dst, b, h) do { _Pragma("unroll") for (int m = 0; m < 4; ++m) _Pragma("unroll") for (int k = 0; k < 2; ++k) dst[m][k] = *(const PG8_LAS bf16x8*)(lds + PG8_SA(b, h) + aoff + m * 2048 + k * 1024); } while (0)
#define PG8_LDB(dst, b, h) do { _Pragma("unroll") for (int n = 0; n < 2; ++n) _Pragma("unroll") for (int k = 0; k < 2; ++k) dst[n][k] = *(const PG8_LAS bf16x8*)(lds + PG8_SB(b, h) + boff + n * 2048 + k * 1024); } while (0)
#define PG8_MMA(ai, bj, At, Bt) do { __builtin_amdgcn_s_setprio(1); _Pragma("unroll") for (int m = 0; m < 4; ++m) _Pragma("unroll") for (int n = 0; n < 2; ++n) _Pragma("unroll") for (int k = 0; k < 2; ++k) \
        acc[ai][bj][m][n] = __builtin_amdgcn_mfma_f32_16x16x32_bf16(Bt[n][k], At[m][k], acc[ai][bj][m][n], 0, 0, 0); __builtin_amdgcn_s_setprio(0); } while (0)
#define PG8_WAIT_V(n) asm volatile("s_waitcnt vmcnt(" #n ")" ::: "memory")
#define PG8_WAIT_L(n) asm volatile("s_waitcnt lgkmcnt(" #n ")" ::: "memory")
#define PG8_BAR __builtin_amdgcn_s_barrier()
#define PG8_SCHED __builtin_amdgcn_sched_barrier(0)
    Unit cur, nxt; int ui = 0;
    if (!S.next(0, cur)) return;
    f32x4 acc[2][2][4][2];
    bool both = !S.half_only(cur);
#pragma unroll
    for (int a = 0; a < 2; ++a)
#pragma unroll
        for (int b = 0; b < 2; ++b)
#pragma unroll
            for (int m = 0; m < 4; ++m)
#pragma unroll
                for (int n = 0; n < 2; ++n) acc[a][b][m][n] = (f32x4){0.f, 0.f, 0.f, 0.f};
    bf16x8 At[4][2], B0[2][2], B1[2][2];
    const char* cA = (const char*)g.A + (size_t)cur.pm * tstep; const char* cB = (const char*)g.Bt + (size_t)cur.pn * tstep;
    S.a_ready(cur);
    if constexpr (SP2) {
        PG8_STAGE(PG8_SB(0, 0), cB, voffB); PG8_STAGE(PG8_SB(0, 1), cB + hstep, voffB); PG8_STAGE(PG8_SA(0, 0), cA, voffA); PG8_STAGE(PG8_SA(0, 1), cA + hstep, voffA);
        if (wr == 1) PG8_BAR;
        PG8_WAIT_V(2); PG8_BAR;
        PG8_STAGE(PG8_SB(1, 0), cB + kstep, voffB); PG8_STAGE(PG8_SA(1, 0), cA + kstep, voffA); PG8_STAGE(PG8_SB(1, 1), cB + hstep + kstep, voffB);
        PG8_WAIT_V(6); PG8_BAR;
    } else {
        PG8_STAGE(PG8_SB(0, 0), cB, voffB); PG8_STAGE(PG8_SA(0, 0), cA, voffA); PG8_STAGE(PG8_SB(0, 1), cB + hstep, voffB); PG8_STAGE(PG8_SA(0, 1), cA + hstep, voffA);
        if (wr == 1) PG8_BAR;
        PG8_WAIT_V(4); PG8_BAR;
        PG8_STAGE(PG8_SB(1, 0), cB + kstep, voffB); PG8_STAGE(PG8_SA(1, 0), cA + kstep, voffA); PG8_STAGE(PG8_SB(1, 1), cB + hstep + kstep, voffB);
        PG8_WAIT_V(6); PG8_BAR;
    }
    for (;;) {
        const bool has_next = S.next(ui + 1, nxt);
        const char* nA = has_next ? (const char*)g.A + (size_t)nxt.pm * tstep : cA; const char* nB = has_next ? (const char*)g.Bt + (size_t)nxt.pn * tstep : cB;
        for (int t = 0; t < nt; t += 2) {
            const bool last = (t == nt - 2);
            const char* a1 = cA + (size_t)(t + 1) * kstep;
            const char* a2 = last ? nA : cA + (size_t)(t + 2) * kstep; const char* b2 = last ? nB : cB + (size_t)(t + 2) * kstep;
            const char* a3 = a2 + kstep; const char* b3 = b2 + kstep;
            if (last && has_next) S.a_ready(nxt);
            if constexpr (SP2) {
            PG8_LDB(B0, 0, 0); PG8_LDB(B1, 0, 1); PG8_SCHED; PG8_LDA(At, 0, 0); PG8_STAGE(PG8_SA(1, 1), a1 + hstep, voffA);
            PG8_WAIT_V(8); PG8_WAIT_L(0); PG8_BAR; PG8_MMA(0, 0, At, B0); PG8_MMA(0, 1, At, B1); PG8_BAR; PG8_SCHED;
            PG8_LDA(At, 0, 1); PG8_STAGE(PG8_SB(0, 0), b2, voffB); PG8_STAGE(PG8_SB(0, 1), b2 + hstep, voffB); PG8_STAGE(PG8_SA(0, 0), a2, voffA);
            PG8_WAIT_V(8); PG8_WAIT_L(0); PG8_BAR; if (both) { PG8_MMA(1, 0, At, B0); PG8_MMA(1, 1, At, B1); } PG8_BAR; PG8_SCHED;
            PG8_LDB(B0, 1, 0); PG8_LDB(B1, 1, 1); PG8_SCHED; PG8_LDA(At, 1, 0); PG8_STAGE(PG8_SA(0, 1), a2 + hstep, voffA);
            PG8_WAIT_V(8); PG8_WAIT_L(0); PG8_BAR; PG8_MMA(0, 0, At, B0); PG8_MMA(0, 1, At, B1); PG8_BAR; PG8_SCHED;
            PG8_LDA(At, 1, 1); PG8_STAGE(PG8_SB(1, 0), b3, voffB); PG8_STAGE(PG8_SB(1, 1), b3 + hstep, voffB); PG8_STAGE(PG8_SA(1, 0), a3, voffA);
            PG8_WAIT_V(8); PG8_WAIT_L(0); PG8_BAR; if (both) { PG8_MMA(1, 0, At, B0); PG8_MMA(1, 1, At, B1); } PG8_BAR; PG8_SCHED;
            } else {
            PG8_LDB(B0, 0, 0); PG8_SCHED; PG8_LDA(At, 0, 0); PG8_STAGE(PG8_SA(1, 1), a1 + hstep, voffA);
            PG8_WAIT_L(8); PG8_BAR; PG8_WAIT_L(0); PG8_MMA(0, 0, At, B0); PG8_BAR; PG8_SCHED;
            PG8_LDB(B1, 0, 1); PG8_STAGE(PG8_SB(0, 0), b2, voffB);
            PG8_BAR; PG8_WAIT_L(0); PG8_MMA(0, 1, At, B1); PG8_BAR;
            PG8_LDA(At, 0, 1); PG8_STAGE(PG8_SA(0, 0), a2, voffA);
            PG8_BAR; PG8_WAIT_L(0); PG8_MMA(1, 0, At, B0); PG8_BAR; PG8_SCHED;
            PG8_STAGE(PG8_SB(0, 1), b2 + hstep, voffB);
            PG8_WAIT_V(6); PG8_BAR; PG8_MMA(1, 1, At, B1); PG8_BAR;
            PG8_LDB(B0, 1, 0); PG8_SCHED; PG8_LDA(At, 1, 0); PG8_STAGE(PG8_SA(0, 1), a2 + hstep, voffA);
            PG8_WAIT_L(8); PG8_BAR; PG8_WAIT_L(0); PG8_MMA(0, 0, At, B0); PG8_BAR; PG8_SCHED;
            PG8_LDB(B1, 1, 1); PG8_STAGE(PG8_SB(1, 0), b3, voffB);
            PG8_BAR; PG8_WAIT_L(0); PG8_MMA(0, 1, At, B1); PG8_BAR;
            PG8_LDA(At, 1, 1); PG8_STAGE(PG8_SA(1, 0), a3, voffA);
            PG8_BAR; PG8_WAIT_L(0); PG8_MMA(1, 0, At, B0); PG8_BAR; PG8_SCHED;
            PG8_STAGE(PG8_SB(1, 1), b3 + hstep, voffB);
            PG8_WAIT_V(6); PG8_BAR; PG8_MMA(1, 1, At, B1); PG8_BAR;
            }
        }
        if constexpr (ALIGN_EPI) { if (wr == 0) PG8_BAR; }
        if constexpr (!Epi::AFTER_DRAIN) { E(acc, cur, wr, wc, fr, fq); S.done(cur); }
        if (!has_next) break;
#pragma unroll
        for (int a = 0; a < 2; ++a)
#pragma unroll
            for (int b = 0; b < 2; ++b)
#pragma unroll
                for (int m = 0; m < 4; ++m)
#pragma unroll
                    for (int n = 0; n < 2; ++n) acc[a][b][m][n] = (f32x4){0.f, 0.f, 0.f, 0.f};
        cur = nxt; cA = nA; cB = nB; ++ui; both = !S.half_only(cur);
        if constexpr (ALIGN_EPI) { if (wr == 1) PG8_BAR; }
    }
    PG8_WAIT_V(0);
    if constexpr (!ALIGN_EPI) { if (wr == 0) PG8_BAR; }
    PG8_BAR;
    if constexpr (Epi::AFTER_DRAIN) { E.fused(acc, cur, wr, wc, fr, fq, lds, wid, lane); S.done(cur); }
#undef PG8_SA
#undef PG8_SB
#undef PG8_STAGE
#undef PG8_LDA
#undef PG8_LDB
#undef PG8_MMA
#undef PG8_WAIT_V
#undef PG8_WAIT_L
#undef PG8_BAR
#undef PG8_SCHED
}
}

#ifndef PG8_SP2
#define PG8_SP2 true
#endif

namespace pg8 {
template <class Epi, class Sched>
__device__ __forceinline__ void gemm_phase_gather(PG8_LAS unsigned char* lds, const Gemm g, const Sched& S, const Epi& E, const PG8_LAS unsigned* rofs) {
    const int tid = threadIdx.x, wid = __builtin_amdgcn_readfirstlane(tid >> 6), lane = tid & 63, wr = wid >> 2, wc = wid & 3, fr = lane & 15, fq = lane >> 4;
    const int K = g.K, nt = K / BK;
    unsigned voffB[2]; int RA[2]; unsigned CA[2];
#pragma unroll
    for (int i = 0; i < 2; ++i) { int R, C; stage_rc(tid * 16 + i * 8192, R, C); const int Rb = Epi::PERM ? ((R & ~31) + perm32(R & 31)) : R;
        RA[i] = R; CA[i] = (unsigned)C * 2u; voffB[i] = (unsigned)(Rb * K + C) * 2u; }
    const size_t kstep = (size_t)(BK * 2);
    const size_t hstep = (size_t)HALF * K * 2;
    const size_t tstep = 2 * hstep;
    const unsigned ldsw = (unsigned)wid * 1024u;
    const int aoff = lds_byte(wr * 64 + fr, fq * 8), boff = lds_byte(wc * 32 + fr, fq * 8);
#define PG8_SA(b, h) (((b) * 2 + (h)) * HTB)
#define PG8_SB(b, h) ((4 + (b) * 2 + (h)) * HTB)
#define PG8_STAGE(bufoff, gbase, voff) do { _Pragma("unroll") for (int _i = 0; _i < 2; ++_i) \
        __builtin_amdgcn_global_load_lds((const unsigned*)((const char*)(gbase) + (voff)[_i]), (PG8_LAS unsigned*)(lds + (bufoff) + ldsw + _i * 8192), 16, 0, 0); } while (0)
#define PG8_STAGE_A(bufoff, koff, v0, v1) do { \
        __builtin_amdgcn_global_load_lds((const unsigned*)((const char*)g.A + (koff) + (v0)), (PG8_LAS unsigned*)(lds + (bufoff) + ldsw), 16, 0, 0); \
        __builtin_amdgcn_global_load_lds((const unsigned*)((const char*)g.A + (koff) + (v1)), (PG8_LAS unsigned*)(lds + (bufoff) + ldsw + 8192), 16, 0, 0); } while (0)
#define PG8_LDA(dst, b, h) do { _Pragma("unroll") for (int m = 0; m < 4; ++m) _Pragma("unroll") for (int k = 0; k < 2; ++k) dst[m][k] = *(const PG8_LAS bf16x8*)(lds + PG8_SA(b, h) + aoff + m * 2048 + k * 1024); } while (0)
#define PG8_LDB(dst, b, h) do { _Pragma("unroll") for (int n = 0; n < 2; ++n) _Pragma("unroll") for (int k = 0; k < 2; ++k) dst[n][k] = *(const PG8_LAS bf16x8*)(lds + PG8_SB(b, h) + boff + n * 2048 + k * 1024); } while (0)
#define PG8_MMA(ai, bj, At, Bt) do { __builtin_amdgcn_s_setprio(1); _Pragma("unroll") for (int m = 0; m < 4; ++m) _Pragma("unroll") for (int n = 0; n < 2; ++n) _Pragma("unroll") for (int k = 0; k < 2; ++k) \
        acc[ai][bj][m][n] = __builtin_amdgcn_mfma_f32_16x16x32_bf16(Bt[n][k], At[m][k], acc[ai][bj][m][n], 0, 0, 0); __builtin_amdgcn_s_setprio(0); } while (0)
#define PG8_WAIT_V(n) asm volatile("s_waitcnt vmcnt(" #n ")" ::: "memory")
#define PG8_WAIT_L(n) asm volatile("s_waitcnt lgkmcnt(" #n ")" ::: "memory")
#define PG8_BAR __builtin_amdgcn_s_barrier()
#define PG8_SCHED __builtin_amdgcn_sched_barrier(0)
    Unit cur, nxt; int ui = 0;
    if (!S.next(0, cur)) return;
    f32x4 acc[2][2][4][2];
    bool both = !S.half_only(cur);
#pragma unroll
    for (int a = 0; a < 2; ++a)
#pragma unroll
        for (int b = 0; b < 2; ++b)
#pragma unroll
            for (int m = 0; m < 4; ++m)
#pragma unroll
                for (int n = 0; n < 2; ++n) acc[a][b][m][n] = (f32x4){0.f, 0.f, 0.f, 0.f};
    bf16x8 At[4][2], B0[2][2], B1[2][2];
    const char* cB = (const char*)g.Bt + (size_t)cur.pn * tstep;
    unsigned vc00 = rofs[RA[0]] + CA[0], vc01 = rofs[RA[1]] + CA[1], vc10 = rofs[128 + RA[0]] + CA[0], vc11 = rofs[128 + RA[1]] + CA[1];
    unsigned vn00 = vc00, vn01 = vc01, vn10 = vc10, vn11 = vc11;
    PG8_WAIT_L(0);
    PG8_STAGE(PG8_SB(0, 0), cB, voffB); PG8_STAGE(PG8_SB(0, 1), cB + hstep, voffB); PG8_STAGE_A(PG8_SA(0, 0), 0, vc00, vc01); PG8_STAGE_A(PG8_SA(0, 1), 0, vc10, vc11);
    if (wr == 1) PG8_BAR;
    PG8_WAIT_V(2); PG8_BAR;
    PG8_STAGE(PG8_SB(1, 0), cB + kstep, voffB); PG8_STAGE_A(PG8_SA(1, 0), kstep, vc00, vc01); PG8_STAGE(PG8_SB(1, 1), cB + hstep + kstep, voffB);
    PG8_WAIT_V(6); PG8_BAR;
    for (;;) {
        const bool has_next = S.next(ui + 1, nxt);
        const char* nB = has_next ? (const char*)g.Bt + (size_t)nxt.pn * tstep : cB;
        if (has_next) { const PG8_LAS unsigned* rn = rofs + (ui + 1) * 256; vn00 = rn[RA[0]] + CA[0]; vn01 = rn[RA[1]] + CA[1]; vn10 = rn[128 + RA[0]] + CA[0]; vn11 = rn[128 + RA[1]] + CA[1]; }
        else { vn00 = vc00; vn01 = vc01; vn10 = vc10; vn11 = vc11; }
        for (int t = 0; t < nt; t += 2) {
            const bool last = (t == nt - 2);
            const size_t k1 = (size_t)(t + 1) * kstep;
            const size_t k2 = last ? 0 : (size_t)(t + 2) * kstep; const char* b2 = last ? nB : cB + (size_t)(t + 2) * kstep;
            const size_t k3 = k2 + kstep; const char* b3 = b2 + kstep;
            const unsigned w00 = last ? vn00 : vc00, w01 = last ? vn01 : vc01, w10 = last ? vn10 : vc10, w11 = last ? vn11 : vc11;
            PG8_LDB(B0, 0, 0); PG8_LDB(B1, 0, 1); PG8_SCHED; PG8_LDA(At, 0, 0); PG8_STAGE_A(PG8_SA(1, 1), k1, vc10, vc11);
            PG8_WAIT_V(8); PG8_WAIT_L(0); PG8_BAR; PG8_MMA(0, 0, At, B0); PG8_MMA(0, 1, At, B1); PG8_BAR; PG8_SCHED;
            PG8_LDA(At, 0, 1); PG8_STAGE(PG8_SB(0, 0), b2, voffB); PG8_STAGE(PG8_SB(0, 1), b2 + hstep, voffB); PG8_STAGE_A(PG8_SA(0, 0), k2, w00, w01);
            PG8_WAIT_V(8); PG8_WAIT_L(0); PG8_BAR; if (both) { PG8_MMA(1, 0, At, B0); PG8_MMA(1, 1, At, B1); } PG8_BAR; PG8_SCHED;
            PG8_LDB(B0, 1, 0); PG8_LDB(B1, 1, 1); PG8_SCHED; PG8_LDA(At, 1, 0); PG8_STAGE_A(PG8_SA(0, 1), k2, w10, w11);
            PG8_WAIT_V(8); PG8_WAIT_L(0); PG8_BAR; PG8_MMA(0, 0, At, B0); PG8_MMA(0, 1, At, B1); PG8_BAR; PG8_SCHED;
            PG8_LDA(At, 1, 1); PG8_STAGE(PG8_SB(1, 0), b3, voffB); PG8_STAGE(PG8_SB(1, 1), b3 + hstep, voffB); PG8_STAGE_A(PG8_SA(1, 0), k3, w00, w01);
            PG8_WAIT_V(8); PG8_WAIT_L(0); PG8_BAR; if (both) { PG8_MMA(1, 0, At, B0); PG8_MMA(1, 1, At, B1); } PG8_BAR; PG8_SCHED;
        }
        if (wr == 0) PG8_BAR;
        E(acc, cur, wr, wc, fr, fq); S.done(cur);
        if (!has_next) break;
#pragma unroll
        for (int a = 0; a < 2; ++a)
#pragma unroll
            for (int b = 0; b < 2; ++b)
#pragma unroll
                for (int m = 0; m < 4; ++m)
#pragma unroll
                    for (int n = 0; n < 2; ++n) acc[a][b][m][n] = (f32x4){0.f, 0.f, 0.f, 0.f};
        cur = nxt; cB = nB; ++ui; both = !S.half_only(cur); vc00 = vn00; vc01 = vn01; vc10 = vn10; vc11 = vn11;
        if (wr == 1) PG8_BAR;
    }
    PG8_WAIT_V(0);
    PG8_BAR;
#undef PG8_SA
#undef PG8_SB
#undef PG8_STAGE
#undef PG8_STAGE_A
#undef PG8_LDA
#undef PG8_LDB
#undef PG8_MMA
#undef PG8_WAIT_V
#undef PG8_WAIT_L
#undef PG8_BAR
#undef PG8_SCHED
}
}

constexpr int NB = 2, SEQ = 8192, DM = 1024, NTOK = NB * SEQ;
constexpr int NPROJ = 3072;
constexpr int C_GQ = 0, C_GK = 256, C_GV = 512, C_GR = 1024, C_NQ = 1536, C_KC = 2048, C_VC = 2176, C_KS = 2304, C_VS = 2432, C_KW = 2560, C_VW = 2688, C_GLR = 2816, C_NG = 2832, C_END = 2856;
constexpr int SGW = 2048;
constexpr int NEXP = 16, EHID = 512;
constexpr int MOE_ROWS = 36864;
constexpr float NORM_EPS = 1e-6f;
constexpr float NEGBIG = -1e30f;

constexpr size_t MiB = 1u << 20;
constexpr size_t WS_CTL = 0, CTL_ZERO_BYTES = 1 * MiB;
constexpr size_t WS_MOD = 1 * MiB;
constexpr size_t WS_ROUTE = 2 * MiB;
constexpr size_t WS_GATES = 3 * MiB;
constexpr size_t WS_STATS = 5 * MiB;
constexpr size_t WS_DEC = 7 * MiB;
constexpr size_t WS_WIN = 8 * MiB;
constexpr size_t WS_WOUT = 14 * MiB;
constexpr size_t WS_WINC = 16 * MiB;
constexpr size_t WS_WOUTC = 24 * MiB;
constexpr size_t WS_WCW1 = 28 * MiB;
constexpr size_t WS_WGU = 30 * MiB;
constexpr size_t WS_WDN = 94 * MiB;
constexpr size_t WS_A = 126 * MiB;
constexpr size_t WS_O = 254 * MiB;
constexpr size_t WS_END = 318 * MiB;
constexpr size_t A_HID_OFF = 72 * MiB;
constexpr size_t DO_QN = 0;
constexpr size_t DO_KSEL = 16 * MiB, DO_VSEL = 20 * MiB, DO_KWIN = 24 * MiB, DO_VWIN = 28 * MiB;
constexpr size_t DO_KC = 32 * MiB, DO_VC = 36 * MiB + 65536;
constexpr size_t DO_KCMP = 41 * MiB, DO_VCMP = 41 * MiB + 512 * 1024;

constexpr int CW_TMO = 0, CW_CODE = 1;
constexpr int CW_BAR = 4096;
constexpr int CW_CNT = 16384;

constexpr int RING_OFF = 0, RING_BYTES = 131072;
constexpr int LDSCTL_OFF = RING_BYTES, MISC_OFF = LDSCTL_OFF + 320;
constexpr int TAB_OFF = LDSCTL_OFF + 1024;
constexpr int LDS_BYTES = 147456;

#define GAS __attribute__((address_space(1)))
#define LAS __attribute__((address_space(3)))
typedef unsigned short bf16;
typedef unsigned v4u __attribute__((ext_vector_type(4)));
typedef unsigned v2u __attribute__((ext_vector_type(2)));
typedef float f32x4 __attribute__((ext_vector_type(4)));
typedef float f32x2 __attribute__((ext_vector_type(2)));
typedef float f32x16 __attribute__((ext_vector_type(16)));
typedef short bf16x8 __attribute__((ext_vector_type(8)));
typedef short s16x4 __attribute__((ext_vector_type(4)));
typedef GAS unsigned gu32;
#define RLX_AGENT __ATOMIC_RELAXED, __HIP_MEMORY_SCOPE_AGENT
#define LDS_WAIT() asm volatile("s_waitcnt lgkmcnt(0)" ::: "memory")
#define VM_WAIT() asm volatile("s_waitcnt vmcnt(0)" ::: "memory")
__device__ __forceinline__ unsigned f2bf(float f) { unsigned u = __builtin_bit_cast(unsigned, f); return (u + 0x7fffu + ((u >> 16) & 1u)) >> 16; }
__device__ __forceinline__ unsigned pk2(float lo, float hi) { return f2bf(lo) | (f2bf(hi) << 16); }
__device__ __forceinline__ float bf2f(unsigned short b) { return __builtin_bit_cast(float, (unsigned)b << 16); }
__device__ __forceinline__ float bflo(unsigned w) { return __builtin_bit_cast(float, w << 16); }
__device__ __forceinline__ float bfhi(unsigned w) { return __builtin_bit_cast(float, w & 0xffff0000u); }
__device__ __forceinline__ float fexp2(float x) { return __builtin_amdgcn_exp2f(x); }
__device__ __forceinline__ float fexp(float x) { return __builtin_amdgcn_exp2f(x * 1.4426950408889634f); }
__device__ __forceinline__ float frcp(float x) { return __builtin_amdgcn_rcpf(x); }
__device__ __forceinline__ float sigmoidf_(float x) { return frcp(1.0f + __expf(-x)); }
__device__ __forceinline__ float siluf_(float x) { return x * frcp(1.0f + __expf(-x)); }
__device__ __forceinline__ float gelu_tanh(float x) {
    const float u = 0.7978845608028654f * (x + 0.044715f * x * x * x);
    return x * frcp(1.0f + __expf(-2.0f * u));
}
__device__ __forceinline__ float dpp_xor1(float v) { return __builtin_bit_cast(float, __builtin_amdgcn_mov_dpp(__builtin_bit_cast(int, v), 0xB1, 0xF, 0xF, true)); }
__device__ __forceinline__ float dpp_xor2(float v) { return __builtin_bit_cast(float, __builtin_amdgcn_mov_dpp(__builtin_bit_cast(int, v), 0x4E, 0xF, 0xF, true)); }
__device__ __forceinline__ float wave_sum(float v) {
#pragma unroll
    for (int o = 1; o < 64; o <<= 1) v += __shfl_xor(v, o);
    return v;
}
__device__ __forceinline__ void unpack8(const v4u w, float (&f)[8]) {
    f[0] = bflo(w.x); f[1] = bfhi(w.x); f[2] = bflo(w.y); f[3] = bfhi(w.y); f[4] = bflo(w.z); f[5] = bfhi(w.z); f[6] = bflo(w.w); f[7] = bfhi(w.w);
}
__device__ __forceinline__ v4u pack8(const float (&f)[8]) { v4u w; w.x = pk2(f[0], f[1]); w.y = pk2(f[2], f[3]); w.z = pk2(f[4], f[5]); w.w = pk2(f[6], f[7]); return w; }

#define XB_TMO      128
#define XB_XCNT(j)  (256  + 64 * (j))
#define XB_XSUB(j)  (1280 + 64 * (j))
#define XB_XGEN(j)  (2304 + 64 * (j))
#define XB_TOP      3328
#define XB_TOPGEN   3392
#define XCD_BAR_WORDS 3456
#define XB_SPIN_CAP (1u << 18)

__device__ __forceinline__ unsigned xb_ld(unsigned* p)              { return __hip_atomic_load(p, __ATOMIC_RELAXED, __HIP_MEMORY_SCOPE_AGENT); }
__device__ __forceinline__ unsigned xb_add(unsigned* p, unsigned v) { return __hip_atomic_fetch_add(p, v, __ATOMIC_RELAXED, __HIP_MEMORY_SCOPE_AGENT); }
__device__ __forceinline__ unsigned xb_xcc_id() { return (unsigned)__builtin_amdgcn_s_getreg((3 << 11) | 20) & 0xFu; }
#define XB_SPIN(cond, bar) do { unsigned _sp = 0; while (cond) { __builtin_amdgcn_s_sleep(1); \
    if ((++_sp & 255u) == 0u) { if (xb_ld(&(bar)[XB_TMO])) break; if (_sp > XB_SPIN_CAP) { atomicAdd(&(bar)[XB_TMO], 1u); break; } } } } while (0)

struct XcdBarrier {
    unsigned* bar; unsigned x;
    volatile LAS unsigned* st;
};
__device__ __forceinline__ XcdBarrier xcd_barrier_post(unsigned* bar, volatile LAS unsigned* st) {
    XcdBarrier b; b.bar = bar; b.x = xb_xcc_id(); b.st = st;
    if (threadIdx.x == 0) (void)xb_add(&bar[XB_XCNT(b.x)], 1u);
    return b;
}
__device__ __forceinline__ void xcd_barrier_complete(unsigned* bar, unsigned x, unsigned& nloc, unsigned& nx) {
    const unsigned G = gridDim.x * gridDim.y * gridDim.z;
    unsigned sum, cnt, mine, sp = 0u;
    for (;;) {
        sum = 0u; cnt = 0u; mine = 0u;
#pragma unroll
        for (unsigned j = 0; j < 16; ++j) { const unsigned c = xb_ld(&bar[XB_XCNT(j)]); sum += c; cnt += (c > 0u) ? 1u : 0u; mine = (j == x) ? c : mine; }
        if (sum == G) break;
        __builtin_amdgcn_s_sleep(1);
        if ((++sp & 255u) == 0u) { if (xb_ld(&bar[XB_TMO])) break; if (sp > XB_SPIN_CAP) { atomicAdd(&bar[XB_TMO], 1u); break; } }
    }
    nloc = mine > 0u ? mine : 1u; nx = cnt > 0u ? cnt : 1u;
}
__device__ __forceinline__ void xcd_barrier(const XcdBarrier& b) {
    asm volatile("s_waitcnt vmcnt(0)" ::: "memory");
    __syncthreads();
    if (threadIdx.x == 0) {
        unsigned* bar = b.bar;
        __builtin_amdgcn_s_waitcnt(0);
        unsigned nloc = b.st[0], nx = b.st[1];
        if (nloc == 0u) { xcd_barrier_complete(bar, b.x, nloc, nx); b.st[0] = nloc; b.st[1] = nx; }
        const unsigned old = xb_add(&bar[XB_XSUB(b.x)], 1u);
        const unsigned gen = old / nloc;
        if (old + 1u == (gen + 1u) * nloc) {
            __builtin_amdgcn_fence(__ATOMIC_RELEASE, "agent");
            asm volatile("s_waitcnt vmcnt(0)" ::: "memory");
            const unsigned og = xb_add(&bar[XB_TOP], 1u);
            const unsigned tg = og / nx;
            if (og + 1u == (tg + 1u) * nx) xb_add(&bar[XB_TOPGEN], 1u);
            else XB_SPIN(xb_ld(&bar[XB_TOPGEN]) == tg, bar);
            __builtin_amdgcn_fence(__ATOMIC_ACQUIRE, "agent");
            xb_add(&bar[XB_XGEN(b.x)], 1u);
            asm volatile("s_waitcnt vmcnt(0)" ::: "memory");
        } else {
            XB_SPIN(xb_ld(&bar[XB_XGEN(b.x)]) == gen, bar);
            __builtin_amdgcn_fence(__ATOMIC_ACQUIRE, "agent");
            asm volatile("s_waitcnt vmcnt(0)" ::: "memory");
        }
    }
    __syncthreads();
}

struct Frame {
    LAS unsigned char* lds;
    volatile LAS unsigned* MISC;
    gu32* ctl;
    int tid, lane, wave;
    int bid, G;
    unsigned char* ws;
    unsigned char* dout_b;
    float* out;
    const float *x, *c, *w_ada, *b_ada, *norm_g, *w_in_ab, *w_out_ab, *gla_w2, *gla_bg, *gla_ng, *q_gain, *k_gain, *cmp_pe, *cmp_w1, *cmp_w2, *w_in_c, *sgu_ng, *sgu_ws, *sgu_bs, *w_out_c, *w_router, *r_bias, *w_gate, *w_up, *w_down;
    const int* positions;
};

struct EpiResid {
    static constexpr bool PERM = false, AFTER_DRAIN = false;
    const float* xin; float* xout; const float* gate;
    __device__ __forceinline__ void operator()(const pg8::f32x4 (&acc)[2][2][4][2], const pg8::Unit& u, int wr, int wc, int fr, int fq) const {
        const int row0 = u.pm * 256 + wr * 64 + fr, col0 = u.pn * 256 + wc * 32 + 4 * fq;
        const float* gb = gate + ((u.pm * 256 >= SEQ) ? 6144 : 0);
        f32x4 gv[2][2];
#pragma unroll
        for (int bj = 0; bj < 2; ++bj)
#pragma unroll
            for (int n = 0; n < 2; ++n) gv[bj][n] = *(const f32x4*)(gb + col0 + bj * 128 + n * 16);
#pragma unroll
        for (int ai = 0; ai < 2; ++ai)
#pragma unroll
            for (int m = 0; m < 4; ++m) {
                const size_t rb = (size_t)(row0 + ai * 128 + m * 16) * DM;
#pragma unroll
                for (int bj = 0; bj < 2; ++bj)
#pragma unroll
                    for (int n = 0; n < 2; ++n) {
                        const size_t p = rb + col0 + bj * 128 + n * 16;
                        const f32x4 xi = *(const f32x4*)(xin + p);
                        *(f32x4*)(xout + p) = xi + gv[bj][n] * acc[ai][bj][m][n];
                    }
            }
    }
};
struct EpiGeluStats {
    static constexpr bool PERM = true, AFTER_DRAIN = false;
    bf16* Z; float* stats;
    __device__ __forceinline__ void operator()(const pg8::f32x4 (&acc)[2][2][4][2], const pg8::Unit& u, int wr, int wc, int fr, int fq) const {
        const int row0 = u.pm * 256 + wr * 64 + fr, col0 = u.pn * 256 + wc * 32 + 8 * fq;
#pragma unroll
        for (int ai = 0; ai < 2; ++ai)
#pragma unroll
            for (int m = 0; m < 4; ++m) {
                const int row = row0 + ai * 128 + m * 16; float ss = 0.f;
#pragma unroll
                for (int bj = 0; bj < 2; ++bj) {
                    float g[8];
#pragma unroll
                    for (int n = 0; n < 2; ++n)
#pragma unroll
                        for (int i = 0; i < 4; ++i) { g[n * 4 + i] = gelu_tanh(acc[ai][bj][m][n][i]); ss += g[n * 4 + i] * g[n * 4 + i]; }
                    *(v4u*)(Z + (size_t)row * 4096 + col0 + bj * 128) = pack8(g);
                }
                if (u.pn >= 8) {
                    ss += __shfl_xor(ss, 16); ss += __shfl_xor(ss, 32);
                    if (fq == 0) stats[(size_t)row * 32 + (u.pn - 8) * 4 + wc] = ss;
                }
            }
    }
};
struct EpiMoeGU {
    static constexpr bool PERM = true, AFTER_DRAIN = false;
    bf16* HID;
    __device__ __forceinline__ void operator()(const pg8::f32x4 (&acc)[2][2][4][2], const pg8::Unit& u, int wr, int wc, int fr, int fq) const {
        const int row0 = u.pm * 256 + wr * 64 + fr, col0 = (u.pn & 3) * 128 + wc * 32 + 8 * fq;
#pragma unroll
        for (int ai = 0; ai < 2; ++ai)
#pragma unroll
            for (int m = 0; m < 4; ++m) {
                float h[8];
#pragma unroll
                for (int n = 0; n < 2; ++n)
#pragma unroll
                    for (int i = 0; i < 4; ++i) h[n * 4 + i] = siluf_(acc[ai][0][m][n][i]) * acc[ai][1][m][n][i];
                *(v4u*)(HID + (size_t)(row0 + ai * 128 + m * 16) * EHID + col0) = pack8(h);
            }
    }
};
struct EpiMoeDn {
    static constexpr bool PERM = true, AFTER_DRAIN = false;
    bf16* YM;
    __device__ __forceinline__ void operator()(const pg8::f32x4 (&acc)[2][2][4][2], const pg8::Unit& u, int wr, int wc, int fr, int fq) const {
        const int row0 = u.pm * 256 + wr * 64 + fr, col0 = (u.pn & 3) * 256 + wc * 32 + 8 * fq;
#pragma unroll
        for (int ai = 0; ai < 2; ++ai)
#pragma unroll
            for (int m = 0; m < 4; ++m)
#pragma unroll
                for (int bj = 0; bj < 2; ++bj) {
                    float h[8];
#pragma unroll
                    for (int n = 0; n < 2; ++n)
#pragma unroll
                        for (int i = 0; i < 4; ++i) h[n * 4 + i] = acc[ai][bj][m][n][i];
                    *(v4u*)(YM + (size_t)(row0 + ai * 128 + m * 16) * DM + col0 + bj * 128) = pack8(h);
                }
    }
};
struct MoeOrder {
    const LAS int* ppre; int G, c;
    __device__ __forceinline__ unsigned row_off(const pg8::Unit& u, int r, const int* elist) const {
        const int e = u.pn >> 2, li = (u.pm - ppre[e]) * 256 + r;
        const int tok = (li < ppre[32 + e]) ? elist[e * 16384 + li] : 0;
        return (unsigned)tok * 2048u;
    }
    __device__ __forceinline__ bool next(int i, pg8::Unit& u) const {
        const int L = i * G + c, np = ppre[16];
        if (L >= np * 4) return false;
        const int pm = L >> 2; int e = 0;
#pragma unroll
        for (int k = 1; k < 16; ++k) e += (ppre[k] <= pm) ? 1 : 0;
        u.pm = pm; u.pn = e * 4 + (L & 3); return true;
    }
    __device__ __forceinline__ void a_ready(const pg8::Unit&) const {}
    __device__ __forceinline__ void done(const pg8::Unit&) const {}
    __device__ __forceinline__ bool half_only(const pg8::Unit& u) const { const int e = u.pn >> 2; return (u.pm - ppre[e]) * 256 + 128 >= ppre[32 + e]; }
};

__device__ __forceinline__ int dest_row(int mode, int n) {
    if (mode == 1) return (n < 1024) ? n : (n < 1040) ? n + 1792 : (n < 2832) ? n - 16 : n;
    if (mode == 2) return (n >> 7) * 256 + (n & 127);
    if (mode == 3) return (n >> 7) * 256 + 128 + (n & 127);
    return n;
}
struct TrItem { const float* src; bf16* dst; int K, N, mode, r; };
__device__ __forceinline__ int tr_count(int set) { return set == 0 ? (720 + 256 + 256 + 3 * 2048) : set == 1 ? (1024 + 512 + 2048 + 1024) : (1024 + 2048); }
__device__ __forceinline__ bool tr_decode(Frame& F, int set, int it, TrItem& t) {
    if (it >= tr_count(set)) return false;
    int r = it; t.mode = 0;
    if (set == 0) {
        constexpr int I_IN = 16 * 45, I_OUT = 16 * 16, I_CW1 = 2 * 32 * 4, I_E = 16 * 128;
        if (r < I_IN) { t.src = F.w_in_ab; t.dst = (bf16*)(F.ws + WS_WIN); t.K = 1024; t.N = 2856; t.mode = 1; }
        else if ((r -= I_IN) < I_OUT) { t.src = F.w_out_ab; t.dst = (bf16*)(F.ws + WS_WOUT); t.K = 1024; t.N = 1024; }
        else if ((r -= I_OUT) < I_CW1) { const int m = r >> 7; r &= 127; t.src = F.cmp_w1 + (size_t)m * 2048 * 256; t.dst = (bf16*)(F.ws + WS_WCW1) + (size_t)m * 256 * 2048; t.K = 2048; t.N = 256; }
        else if ((r -= I_CW1) < I_E) { const int m = r >> 7; r &= 127; t.src = F.w_gate + (size_t)m * 1024 * 512; t.dst = (bf16*)(F.ws + WS_WGU) + (size_t)m * 1024 * 1024; t.K = 1024; t.N = 512; t.mode = 2; }
        else if ((r -= I_E) < I_E) { const int m = r >> 7; r &= 127; t.src = F.w_up + (size_t)m * 1024 * 512; t.dst = (bf16*)(F.ws + WS_WGU) + (size_t)m * 1024 * 1024; t.K = 1024; t.N = 512; t.mode = 3; }
        else { r -= I_E; const int m = r >> 7; r &= 127; t.src = F.w_down + (size_t)m * 512 * 1024; t.dst = (bf16*)(F.ws + WS_WDN) + (size_t)m * 1024 * 512; t.K = 512; t.N = 1024; }
    } else if (set == 1) {
        constexpr int I_INC = 16 * 64, I_OUTC = 32 * 16;
        if (r < I_INC) { t.src = F.w_in_c; t.dst = (bf16*)(F.ws + WS_WINC); t.K = 1024; t.N = 4096; }
        else if ((r -= I_INC) < I_OUTC) { t.src = F.w_out_c; t.dst = (bf16*)(F.ws + WS_WOUTC); t.K = 2048; t.N = 1024; }
        else if ((r -= I_OUTC) < 2048) { const int m = 16 + (r >> 7); r &= 127; t.src = F.w_gate + (size_t)m * 1024 * 512; t.dst = (bf16*)(F.ws + WS_WGU) + (size_t)m * 1024 * 1024; t.K = 1024; t.N = 512; t.mode = 2; }
        else { r -= 2048; const int m = 16 + (r >> 7); r &= 127; t.src = F.w_up + (size_t)m * 1024 * 512; t.dst = (bf16*)(F.ws + WS_WGU) + (size_t)m * 1024 * 1024; t.K = 1024; t.N = 512; t.mode = 3; }
    } else {
        constexpr int I_E = 8 * 128;
        if (r < I_E) { const int m = 24 + (r >> 7); r &= 127; t.src = F.w_up + (size_t)m * 1024 * 512; t.dst = (bf16*)(F.ws + WS_WGU) + (size_t)m * 1024 * 1024; t.K = 1024; t.N = 512; t.mode = 3; }
        else { r -= I_E; const int m = 16 + (r >> 7); r &= 127; t.src = F.w_down + (size_t)m * 512 * 1024; t.dst = (bf16*)(F.ws + WS_WDN) + (size_t)m * 1024 * 512; t.K = 512; t.N = 1024; }
    }
    t.r = r; return true;
}
__device__ __forceinline__ void tr_load(const TrItem& t, int lane, f32x4 (&va)[8], f32x4 (&vb)[8]) {
    const int nblk = (t.N + 63) / 64, kb = t.r / nblk, nb = t.r % nblk, k0 = 64 * kb, n0 = 64 * nb;
    const int q = lane & 15, r4 = lane >> 4, col = n0 + 4 * q;
    const float* wp = t.src + (size_t)(k0 + 2 * r4) * t.N + col;
#pragma unroll
    for (int i = 0; i < 8; ++i) {
        if (col < t.N) { va[i] = *(const f32x4*)(wp + (size_t)(8 * i) * t.N); vb[i] = *(const f32x4*)(wp + (size_t)(8 * i + 1) * t.N); }
        else { va[i] = (f32x4){0.f, 0.f, 0.f, 0.f}; vb[i] = va[i]; }
    }
}
__device__ __forceinline__ void tr_finish(const TrItem& t, int lane, const f32x4 (&va)[8], const f32x4 (&vb)[8], LAS unsigned char* scr) {
    const int nblk = (t.N + 63) / 64, kb = t.r / nblk, nb = t.r % nblk, k0 = 64 * kb, n0 = 64 * nb;
    const int q = lane & 15, r4 = lane >> 4;
#pragma unroll
    for (int i = 0; i < 8; ++i) {
        const int kp = 4 * i + r4;
        LAS unsigned* tt = (LAS unsigned*)(scr + (4 * q) * 144 + 4 * kp);
        tt[0] = pk2(va[i].x, vb[i].x); tt[36] = pk2(va[i].y, vb[i].y); tt[72] = pk2(va[i].z, vb[i].z); tt[108] = pk2(va[i].w, vb[i].w);
    }
    LDS_WAIT(); asm volatile("" ::: "memory");
    const int c = lane & 7;
#pragma unroll
    for (int j = 0; j < 8; ++j) { const int n = (lane >> 3) + 8 * j;
        const v4u o = *(const LAS v4u*)(scr + n * 144 + 16 * c);
        if (n0 + n < t.N) *(GAS v4u*)(t.dst + (size_t)dest_row(t.mode, n0 + n) * t.K + k0 + 8 * c) = o; }
    LDS_WAIT(); asm volatile("" ::: "memory");
}
__device__ __forceinline__ void tr_run(Frame& F, int set, int w0, int nw) {
    LAS unsigned char* scr = F.lds + RING_OFF + 8192 + F.wave * 12288;
    TrItem ta, tb, td; f32x4 a0[8], a1[8], b0[8], b1[8];
    (void)tr_decode(F, set, 0, td);
    int it = w0; bool ha = tr_decode(F, set, it, ta);
    if (!ha) return;
    tr_load(ta, F.lane, a0, a1);
    while (ha) {
        const bool hb = tr_decode(F, set, it + nw, tb);
        if (!hb) tb = td;
        tr_load(tb, F.lane, b0, b1);
        tr_finish(ta, F.lane, a0, a1, scr);
        if (!hb) break;
        it += 2 * nw; ha = tr_decode(F, set, it, ta);
        if (!ha) ta = td;
        tr_load(ta, F.lane, a0, a1);
        tr_finish(tb, F.lane, b0, b1, scr);
    }
}
__device__ __forceinline__ void p0_prologue(Frame& F) {
    LAS float* red = (LAS float*)(F.lds + RING_OFF);
    float* mod = (float*)(F.ws + WS_MOD);
    float* bias1 = (float*)(F.ws + WS_MOD + 131072);
    for (int bi = F.bid; bi < 200; bi += F.G) {
        if (bi < 192) {
            const int l = bi / 96, cg = bi % 96, j = cg * 64 + F.lane;
            float a0 = 0.f, a1 = 0.f;
            const float* wp = F.w_ada + ((size_t)l * 1024 + F.wave * 128) * 6144 + j;
#pragma unroll 16
            for (int k = 0; k < 128; ++k) { const float wv = wp[(size_t)k * 6144]; const float c0 = F.c[F.wave * 128 + k], c1 = F.c[1024 + F.wave * 128 + k];
                a0 += siluf_(c0) * wv; a1 += siluf_(c1) * wv; }
            red[(F.wave * 2 + 0) * 64 + F.lane] = a0; red[(F.wave * 2 + 1) * 64 + F.lane] = a1;
            __syncthreads();
            if (F.tid < 128) { const int b = F.tid >> 6, ln = F.tid & 63; float s = 0.f;
#pragma unroll
                for (int w = 0; w < 8; ++w) s += red[(w * 2 + b) * 64 + ln];
                mod[(size_t)(l * 2 + b) * 6144 + cg * 64 + ln] = s + F.b_ada[l * 6144 + cg * 64 + ln]; }
            __syncthreads();
        } else {
            const int kv = (bi - 192) >> 2, cg = (bi - 192) & 3, j = cg * 64 + F.lane;
            float a0 = 0.f;
            const float* wp = F.cmp_w1 + ((size_t)kv * 2048 + F.wave * 256) * 256 + j; const float* pe = F.cmp_pe + kv * 2048 + F.wave * 256;
#pragma unroll 16
            for (int k = 0; k < 256; ++k) a0 += pe[k] * wp[(size_t)k * 256];
            red[F.wave * 64 + F.lane] = a0;
            __syncthreads();
            if (F.tid < 64) { float s = 0.f;
#pragma unroll
                for (int w = 0; w < 8; ++w) s += red[w * 64 + F.tid];
                bias1[kv * 256 + cg * 64 + F.tid] = s; }
            __syncthreads();
        }
    }
    { bf16* wi = (bf16*)(F.ws + WS_WIN); const int npieces = (NPROJ - C_END) * (DM / 8);
      for (int p = F.bid * 512 + F.tid; p < npieces; p += F.G * 512) *(GAS v4u*)(wi + (size_t)C_END * DM + (size_t)p * 8) = (v4u){0u, 0u, 0u, 0u}; }
    const int gw = F.bid * 8 + F.wave, NGW = F.G * 8;
    tr_run(F, 0, gw, NGW);
}

__device__ __forceinline__ void moe_tables(Frame& F, int layer) {
    LAS int* ppre = (LAS int*)(F.lds + TAB_OFF);
    if (F.tid == 0) { const unsigned* cnt = (const unsigned*)(F.ctl + CW_CNT + 1024 * layer); int acc = 0;
        for (int e = 0; e < 16; ++e) { const int c = (int)cnt[64 * e]; ppre[e] = acc; ppre[32 + e] = c; acc += (c + 255) >> 8; }
        ppre[16] = acc; }
    __syncthreads();
}

struct RouteRec { int e0, e1, pos0, pos1; float w0, w1; int slot0, slot1; };
template <bool COMBINE, bool NORM, bool ROUTE>
__device__ __forceinline__ void row_pass(Frame& F, const float* xin, const float* modn  , int sh_off, const float* ng,
                                         const float* modc  , int layer, int clayer  ) {
    if (COMBINE) moe_tables(F, clayer);
    float* xout = F.out; bf16* H = (bf16*)(F.ws + WS_O);
    const bf16* YM = (const bf16*)(F.ws + WS_A);
    RouteRec* route = (RouteRec*)(F.ws + WS_ROUTE);
    int* elist = (int*)(F.ws + WS_STATS);
    const LAS int* ppre = (const LAS int*)(F.lds + TAB_OFF);
    LAS float* wr = (LAS float*)(F.lds + RING_OFF);
    LAS unsigned* lcnt = (LAS unsigned*)(F.lds + TAB_OFF + 256);
    LAS int* recs = (LAS int*)(F.lds + TAB_OFF + 8192);
    if (ROUTE) {
        for (int idx = F.tid; idx < 16384; idx += 512) wr[(idx & 15) * 1024 + (idx >> 4)] = F.w_router[idx];
        if (F.tid < 32) lcnt[F.tid] = 0u;
        __syncthreads();
    }
    const int gw = F.bid * 8 + F.wave, NGW = F.G * 8;
    f32x4 cs[4], sh[4], gc[4];
    f32x4 vn[4]; v2u yn0[4], yn1[4]; RouteRec rn; rn.w0 = 0.f; rn.w1 = 0.f;
    int m = gw, bcur = -1;
#define RP_PREFETCH(mm) do { \
        _Pragma("unroll") for (int j = 0; j < 4; ++j) vn[j] = *(const f32x4*)(xin + (size_t)(mm) * DM + 4 * F.lane + 256 * j); \
        if (COMBINE) { rn = route[(mm)]; const int sl0_ = ppre[rn.e0] * 256 + rn.pos0, sl1_ = ppre[rn.e1] * 256 + rn.pos1; \
            _Pragma("unroll") for (int j = 0; j < 4; ++j) { yn0[j] = *(const v2u*)(YM + (size_t)sl0_ * DM + 4 * F.lane + 256 * j); yn1[j] = *(const v2u*)(YM + (size_t)sl1_ * DM + 4 * F.lane + 256 * j); } } } while (0)
    if (m < NTOK) RP_PREFETCH(m);
#pragma unroll 1
    while (m < NTOK) {
        f32x4 v[4]; v2u y0[4], y1[4];
#pragma unroll
        for (int j = 0; j < 4; ++j) { v[j] = vn[j]; if (COMBINE) { y0[j] = yn0[j]; y1[j] = yn1[j]; } }
        const float rw0 = rn.w0, rw1 = rn.w1;
        const int mc = m; m += NGW;
        if (m < NTOK) RP_PREFETCH(m);
        const int b = mc >> 13;
        if (b != bcur) { bcur = b;
#pragma unroll
            for (int j = 0; j < 4; ++j) {
                const int col = 4 * F.lane + 256 * j;
                if (NORM) { const f32x4 g = *(const f32x4*)(ng + col), sc = *(const f32x4*)(modn + b * 6144 + sh_off + 1024 + col); cs[j] = g * (sc + 1.0f); sh[j] = *(const f32x4*)(modn + b * 6144 + sh_off + col); }
                if (COMBINE) gc[j] = *(const f32x4*)(modc + b * 6144 + 5 * 1024 + col);
            } }
        {
            if (COMBINE) {
#pragma unroll
                for (int j = 0; j < 4; ++j) {
                    f32x4 yy; yy.x = rw0 * bflo(y0[j].x) + rw1 * bflo(y1[j].x); yy.y = rw0 * bfhi(y0[j].x) + rw1 * bfhi(y1[j].x); yy.z = rw0 * bflo(y0[j].y) + rw1 * bflo(y1[j].y); yy.w = rw0 * bfhi(y0[j].y) + rw1 * bfhi(y1[j].y);
                    v[j] = v[j] + gc[j] * yy;
                    *(f32x4*)(xout + (size_t)mc * DM + 4 * F.lane + 256 * j) = v[j];
                }
            }
            if (NORM) {
                float s = 0.f;
#pragma unroll
                for (int j = 0; j < 4; ++j) s += (v[j].x * v[j].x + v[j].y * v[j].y) + (v[j].z * v[j].z + v[j].w * v[j].w);
                const float rstd = 1.0f / sqrtf(wave_sum(s) * (1.0f / DM) + NORM_EPS);
#pragma unroll
                for (int j = 0; j < 4; ++j) { v[j] = v[j] * rstd * cs[j] + sh[j];
                    v2u o; o.x = pk2(v[j].x, v[j].y); o.y = pk2(v[j].z, v[j].w);
                    *(v2u*)(H + (size_t)mc * DM + 4 * F.lane + 256 * j) = o; }
            }
            if (ROUTE) {
                float a16[16];
#pragma unroll
                for (int eg = 0; eg < 4; ++eg) {
                    float a4[4] = {0.f, 0.f, 0.f, 0.f};
#pragma unroll
                    for (int j = 0; j < 4; ++j)
#pragma unroll
                        for (int ee = 0; ee < 4; ++ee) { const f32x4 w = *(const LAS f32x4*)(wr + (eg * 4 + ee) * 1024 + 4 * F.lane + 256 * j); a4[ee] += (v[j].x * w.x + v[j].y * w.y) + (v[j].z * w.z + v[j].w * w.w); }
#pragma unroll
                    for (int ee = 0; ee < 4; ++ee) a16[eg * 4 + ee] = a4[ee];
                    __builtin_amdgcn_sched_barrier(0);
                }
                float r8[8], r4[4], r2[2];
                { const bool hb = (F.lane & 32) != 0;
#pragma unroll
                  for (int i = 0; i < 8; ++i) { const float keep = hb ? a16[8 + i] : a16[i], send = hb ? a16[i] : a16[8 + i]; r8[i] = keep + __shfl_xor(send, 32); } }
                { const bool hb = (F.lane & 16) != 0;
#pragma unroll
                  for (int i = 0; i < 4; ++i) { const float keep = hb ? r8[4 + i] : r8[i], send = hb ? r8[i] : r8[4 + i]; r4[i] = keep + __shfl_xor(send, 16); } }
                { const bool hb = (F.lane & 8) != 0;
#pragma unroll
                  for (int i = 0; i < 2; ++i) { const float keep = hb ? r4[2 + i] : r4[i], send = hb ? r4[i] : r4[2 + i]; r2[i] = keep + __shfl_xor(send, 8); } }
                float lgo; { const bool hb = (F.lane & 4) != 0; const float keep = hb ? r2[1] : r2[0], send = hb ? r2[0] : r2[1]; lgo = keep + __shfl_xor(send, 4); }
                lgo += __shfl_xor(lgo, 1); lgo += __shfl_xor(lgo, 2);
                const int eown = ((F.lane >> 5) & 1) * 8 + ((F.lane >> 4) & 1) * 4 + ((F.lane >> 3) & 1) * 2 + ((F.lane >> 2) & 1);
                const float sco = frcp(1.0f + __expf(-lgo)), slo = sco + F.r_bias[eown];
                float sc[16], sl[16];
#pragma unroll
                for (int e = 0; e < 16; ++e) { const int src = (e >> 3) * 32 + ((e >> 2) & 1) * 16 + ((e >> 1) & 1) * 8 + (e & 1) * 4;
                    sc[e] = __builtin_bit_cast(float, __builtin_amdgcn_readlane(__builtin_bit_cast(int, sco), src)); sl[e] = __builtin_bit_cast(float, __builtin_amdgcn_readlane(__builtin_bit_cast(int, slo), src)); }
                float gs[4]; int ge1[4], ge2[4]; float gw1[4], gw2[4];
#pragma unroll
                for (int g = 0; g < 4; ++g) {
                    int i1 = 0; float m1 = sl[4 * g];
#pragma unroll
                    for (int k = 1; k < 4; ++k) if (sl[4 * g + k] > m1) { m1 = sl[4 * g + k]; i1 = k; }
                    int i2 = -1; float m2 = 0.f;
#pragma unroll
                    for (int k = 0; k < 4; ++k) if (k != i1 && (i2 < 0 || sl[4 * g + k] > m2)) { m2 = sl[4 * g + k]; i2 = k; }
                    gs[g] = m1 + m2; ge1[g] = 4 * g + i1; ge2[g] = 4 * g + i2;
                    float w1 = 0.f, w2 = 0.f;
#pragma unroll
                    for (int k = 0; k < 4; ++k) { w1 = (k == i1) ? sc[4 * g + k] : w1; w2 = (k == i2) ? sc[4 * g + k] : w2; }
                    gw1[g] = w1; gw2[g] = w2;
                }
                int gi = 0; float gm = gs[0];
#pragma unroll
                for (int g = 1; g < 4; ++g) if (gs[g] > gm) { gm = gs[g]; gi = g; }
                int e1 = ge1[0], e2 = ge2[0]; float w1 = gw1[0], w2 = gw2[0];
#pragma unroll
                for (int g = 1; g < 4; ++g) if (gi == g) { e1 = ge1[g]; e2 = ge2[g]; w1 = gw1[g]; w2 = gw2[g]; }
                const float ws_ = w1 + w2;
                if (F.lane == 0) {
                    const int p0 = (int)__hip_atomic_fetch_add(lcnt + e1, 1u, __ATOMIC_RELAXED, __HIP_MEMORY_SCOPE_WORKGROUP);
                    const int p1 = (int)__hip_atomic_fetch_add(lcnt + e2, 1u, __ATOMIC_RELAXED, __HIP_MEMORY_SCOPE_WORKGROUP);
                    LAS int* rs = recs + (F.wave * 8 + ((mc - gw) / NGW)) * 8;
                    rs[0] = e1; rs[1] = e2; rs[2] = p0; rs[3] = p1; rs[4] = __float_as_int(w1 / ws_); rs[5] = __float_as_int(w2 / ws_);
                }
            }
        }
    }
#undef RP_PREFETCH
    if (ROUTE) {
        __syncthreads();
        if (F.tid < 16) { unsigned* cnt = (unsigned*)(F.ctl + CW_CNT + 1024 * layer + 64 * F.tid); lcnt[16 + F.tid] = atomicAdd(cnt, lcnt[F.tid]); }
        __syncthreads();
        { const int k = F.lane, mrow = gw + k * NGW;
          if (k < 8 && mrow < NTOK) { const LAS int* rs = recs + (F.wave * 8 + k) * 8;
              RouteRec rr; rr.e0 = rs[0]; rr.e1 = rs[1]; rr.pos0 = rs[2] + (int)lcnt[16 + rr.e0]; rr.pos1 = rs[3] + (int)lcnt[16 + rr.e1]; rr.w0 = __int_as_float(rs[4]); rr.w1 = __int_as_float(rs[5]); rr.slot0 = 0; rr.slot1 = 0;
              route[mrow] = rr; elist[rr.e0 * 16384 + rr.pos0] = mrow; elist[rr.e1 * 16384 + rr.pos1] = mrow; } }
    }
}


__device__ __forceinline__ f32x4 mma16(const LAS bf16* A, int lda, const LAS bf16* Bt, int ldb, int K, f32x4 acc, int lane) {
    const LAS bf16* ap = A + (lane & 15) * lda + (lane >> 4) * 8;
    const LAS bf16* bp = Bt + (lane & 15) * ldb + (lane >> 4) * 8;
    for (int k = 0; k < K; k += 32) {
        const bf16x8 a = *(const LAS bf16x8*)(ap + k), b = *(const LAS bf16x8*)(bp + k);
        acc = __builtin_amdgcn_mfma_f32_16x16x32_bf16(a, b, acc, 0, 0, 0);
    }
    return acc;
}

__device__ __forceinline__ float wave_incl_scan(float v) {
#define DPP_ADD(ctrl, rmask) v += __builtin_bit_cast(float, __builtin_amdgcn_update_dpp(0, __builtin_bit_cast(int, v), (ctrl), (rmask), 0xF, false))
    DPP_ADD(0x111, 0xF);
    DPP_ADD(0x112, 0xF);
    DPP_ADD(0x114, 0xF);
    DPP_ADD(0x118, 0xF);
    DPP_ADD(0x142, 0xA);
    DPP_ADD(0x143, 0xC);
#undef DPP_ADD
    return v;
}
__device__ __forceinline__ void gla_bcum(Frame& F, const bf16* prow  , int h, float (&bc)[8]) {
    float gl[16];
    { const v4u a = *(const v4u*)(prow + C_GLR), b = *(const v4u*)(prow + C_GLR + 8); float t0[8], t1[8]; unpack8(a, t0); unpack8(b, t1);
#pragma unroll
      for (int i = 0; i < 8; ++i) { gl[i] = t0[i]; gl[8 + i] = t1[i]; } }
#pragma unroll
    for (int i = 0; i < 8; ++i) {
        const int col = h * 64 + F.wave * 8 + i;
        float z = F.gla_bg[col];
#pragma unroll
        for (int r = 0; r < 16; ++r) z += gl[r] * F.gla_w2[r * 256 + col];
        const float ls = fminf(z, 0.f) - __logf(1.0f + __expf(-fabsf(z)));
        bc[i] = wave_incl_scan(ls * (1.0f / 16.0f));
    }
}
__device__ __forceinline__ void gla_stage_vT(Frame& F, const bf16* prow, int h, LAS bf16* VT) {
    const v4u a = *(const v4u*)(prow + C_GV + h * 128 + F.wave * 16), b = *(const v4u*)(prow + C_GV + h * 128 + F.wave * 16 + 8);
    const unsigned w[8] = {a.x, a.y, a.z, a.w, b.x, b.y, b.z, b.w};
#pragma unroll
    for (int i = 0; i < 8; ++i) { VT[(F.wave * 16 + 2 * i) * 72 + F.lane] = (bf16)(w[i] & 0xffffu); VT[(F.wave * 16 + 2 * i + 1) * 72 + F.lane] = (bf16)(w[i] >> 16); }
}
__device__ __forceinline__ void gla_prep_item(Frame& F, int item) {
    const int h = item & 3, n = (item >> 2) & 127, b = item >> 9;
    const bf16* proj = (const bf16*)(F.ws + WS_A);
    const bf16* prow = proj + (size_t)(b * SEQ + n * 64 + F.lane) * NPROJ;
    LAS bf16* KT = (LAS bf16*)(F.lds + RING_OFF);
    LAS bf16* VT = (LAS bf16*)(F.lds + RING_OFF + 9216);
    float bc[8]; gla_bcum(F, prow, h, bc);
    float kf[8]; { const v4u kk = *(const v4u*)(prow + C_GK + h * 64 + F.wave * 8); unpack8(kk, kf); }
    float* DEC = (float*)(F.ws + WS_DEC) + ((size_t)(b * 128 + n) * 4 + h) * 64;
#pragma unroll
    for (int i = 0; i < 8; ++i) {
        const float bl = __shfl(bc[i], 63);
        KT[(F.wave * 8 + i) * 72 + F.lane] = (bf16)f2bf(kf[i] * __expf(bl - bc[i]));
        if (F.lane == 63) DEC[F.wave * 8 + i] = __expf(bl);
    }
    gla_stage_vT(F, prow, h, VT);
    __syncthreads();
    float* KV = (float*)(F.ws + WS_O) + ((size_t)(b * 128 + n) * 4 + h) * 8192;
    const int dt = F.wave >> 1;
#pragma unroll
    for (int j = 0; j < 4; ++j) {
        const int et = (F.wave & 1) * 4 + j;
        f32x4 acc = {0.f, 0.f, 0.f, 0.f};
        acc = mma16(KT + dt * 16 * 72, 72, VT + et * 16 * 72, 72, 64, acc, F.lane);
#pragma unroll
        for (int i = 0; i < 4; ++i) KV[(dt * 16 + 4 * (F.lane >> 4) + i) * 128 + et * 16 + (F.lane & 15)] = acc[i];
    }
    __syncthreads();
}
__device__ __forceinline__ void gla_scan(Frame& F, int gidx) {
    const int bh = gidx >> 13, de = gidx & 8191, b = bh >> 2, h = bh & 3;
    float* KV = (float*)(F.ws + WS_O) + ((size_t)(b * 128) * 4 + h) * 8192 + de;
    const float* DEC = (const float*)(F.ws + WS_DEC) + ((size_t)(b * 128) * 4 + h) * 64 + (de >> 7);
    float st = 0.f;
#pragma unroll 1
    for (int n0 = 0; n0 < 128; n0 += 16) {
        float kv[16], dc[16];
#pragma unroll
        for (int i = 0; i < 16; ++i) { kv[i] = KV[(size_t)(n0 + i) * 4 * 8192]; dc[i] = DEC[(size_t)(n0 + i) * 4 * 64]; }
#pragma unroll
        for (int i = 0; i < 16; ++i) { KV[(size_t)(n0 + i) * 4 * 8192] = st; st = dc[i] * st + kv[i]; }
    }
}
__device__ __forceinline__ void gla_out_item(Frame& F, int item) {
    const int h = item & 3, n = (item >> 2) & 127, b = item >> 9;
    const bf16* proj = (const bf16*)(F.ws + WS_A);
    const size_t tok = (size_t)b * SEQ + n * 64 + F.lane;
    const bf16* prow = proj + tok * NPROJ;
    LAS bf16* A1 = (LAS bf16*)(F.lds + RING_OFF);
    LAS bf16* B1 = (LAS bf16*)(F.lds + RING_OFF + 9216);
    LAS bf16* A2 = (LAS bf16*)(F.lds + RING_OFF + 18432);
    LAS bf16* SC = (LAS bf16*)(F.lds + RING_OFF + 27648);
    LAS bf16* VT = (LAS bf16*)(F.lds + RING_OFF + 36864);
    LAS bf16* ST = (LAS bf16*)(F.lds + RING_OFF + 55296);
    LAS float* OS = (LAS float*)(F.lds + RING_OFF + 73728);
    const size_t tkn = (size_t)b * SEQ + n * 64 + (F.tid >> 3);
    const v4u rraw0 = *(const v4u*)(proj + tkn * NPROJ + C_GR + h * 128 + (F.tid & 7) * 16), rraw1 = *(const v4u*)(proj + tkn * NPROJ + C_GR + h * 128 + (F.tid & 7) * 16 + 8);
    float bc[8]; gla_bcum(F, prow, h, bc);
    float qf[8], kf[8];
    { const v4u qq = *(const v4u*)(prow + C_GQ + h * 64 + F.wave * 8), kk = *(const v4u*)(prow + C_GK + h * 64 + F.wave * 8); unpack8(qq, qf); unpack8(kk, kf); }
    float a1[8], b1[8], a2[8];
#pragma unroll
    for (int i = 0; i < 8; ++i) {
        const float bm = __shfl(bc[i], 32);
        a1[i] = qf[i] * 0.125f * __expf(bc[i] - bm); b1[i] = kf[i] * __expf(bm - bc[i]); a2[i] = qf[i] * 0.125f * __expf(bc[i]);
    }
    *(LAS v4u*)(A1 + F.lane * 72 + F.wave * 8) = pack8(a1);
    *(LAS v4u*)(B1 + F.lane * 72 + F.wave * 8) = pack8(b1);
    *(LAS v4u*)(A2 + F.lane * 72 + F.wave * 8) = pack8(a2);
    gla_stage_vT(F, prow, h, VT);
    { const float* KV = (const float*)(F.ws + WS_O) + ((size_t)(b * 128 + n) * 4 + h) * 8192;
#pragma unroll
      for (int k = 0; k < 16; ++k) { const int p = F.tid + 512 * k, e = p & 127, d = p >> 7; ST[e * 72 + d] = (bf16)f2bf(KV[d * 128 + e]); } }
    __syncthreads();
    const int it = F.wave >> 1;
#pragma unroll
    for (int jj = 0; jj < 2; ++jj) {
        const int jt = (F.wave & 1) * 2 + jj;
        f32x4 acc = {0.f, 0.f, 0.f, 0.f};
        if (jt <= it) acc = mma16(A1 + it * 16 * 72, 72, B1 + jt * 16 * 72, 72, 64, acc, F.lane);
#pragma unroll
        for (int i = 0; i < 4; ++i) { const int ri = it * 16 + 4 * (F.lane >> 4) + i, cj = jt * 16 + (F.lane & 15); SC[ri * 72 + cj] = (bf16)f2bf((cj <= ri) ? acc[i] : 0.f); }
    }
    __syncthreads();
#pragma unroll
    for (int j = 0; j < 4; ++j) {
        const int et = (F.wave & 1) * 4 + j;
        f32x4 acc = {0.f, 0.f, 0.f, 0.f};
        acc = mma16(SC + it * 16 * 72, 72, VT + et * 16 * 72, 72, 64, acc, F.lane);
        acc = mma16(A2 + it * 16 * 72, 72, ST + et * 16 * 72, 72, 64, acc, F.lane);
#pragma unroll
        for (int i = 0; i < 4; ++i) OS[(it * 16 + 4 * (F.lane >> 4) + i) * 132 + et * 16 + (F.lane & 15)] = acc[i];
    }
    __syncthreads();
    { const int row = F.tid >> 3, c0 = (F.tid & 7) * 16;
      float v[16]; float ss = 0.f;
#pragma unroll
      for (int i = 0; i < 16; ++i) { v[i] = OS[row * 132 + c0 + i]; ss += v[i] * v[i]; }
      ss += dpp_xor1(ss); ss += dpp_xor2(ss); ss += __shfl_xor(ss, 4);
      const float rstd = 1.0f / sqrtf(ss * (1.0f / 128.0f) + NORM_EPS);
      const size_t tk = (size_t)b * SEQ + n * 64 + row;
      float r0[8], r1[8]; unpack8(rraw0, r0); unpack8(rraw1, r1);
      float o0[8], o1[8];
#pragma unroll
      for (int i = 0; i < 8; ++i) { o0[i] = v[i] * rstd * F.gla_ng[c0 + i] * siluf_(r0[i]); o1[i] = v[8 + i] * rstd * F.gla_ng[c0 + 8 + i] * siluf_(r1[i]); }
      bf16* orow = (bf16*)(F.ws + WS_O + 32 * MiB) + tk * DM + h * 128 + c0;
      *(v4u*)orow = pack8(o0); *(v4u*)(orow + 8) = pack8(o1); }
    __syncthreads();
}

__device__ __forceinline__ double inv_freq_d(int i) {
    return (i == 0) ? 1.0 : (i == 1) ? 0.19392547740471268 : (i == 2) ? 0.037606090787015346 : (i == 3) ? 0.0072927791106285765 :
           (i == 4) ? 0.0014142135623730951 : (i == 5) ? 0.00027425197177757796 : (i == 6) ? 5.318404375373266e-05 : 1.0313741203148838e-05;
}
__device__ __forceinline__ void rope_sincos(int pos, int i, float& cs, float& sn) {
    const double rev = (double)pos * inv_freq_d(i) * 0.15915494309189535;
    const float fr = (float)(rev - rint(rev));
    cs = __builtin_amdgcn_cosf(fr); sn = __builtin_amdgcn_sinf(fr);
}
struct PrepRaw { v4u r0, r1, r2; unsigned ng; int pos; };
__device__ __forceinline__ void nsa_prep_load(Frame& F, int tok, PrepRaw& p) {
    const int sub = F.lane & 7, vid = F.lane >> 3;
    const bf16* prow = (const bf16*)(F.ws + WS_A) + (size_t)tok * NPROJ;
    const int g1 = vid & 1, w1 = vid >> 1, w2 = (vid >> 1) & 1;
    const int col1 = ((w1 == 0) ? C_KS : (w1 == 1) ? C_KW : (w1 == 2) ? C_VS : C_VW) + g1 * 64, col2 = (w2 ? C_VC : C_KC) + g1 * 64;
    p.r0 = *(const v4u*)(prow + C_NQ + vid * 64 + sub * 8); p.r1 = *(const v4u*)(prow + col1 + sub * 8); p.r2 = *(const v4u*)(prow + col2 + sub * 8);
    p.ng = (F.lane < 24) ? (unsigned)prow[C_NG + F.lane] : 0u; p.pos = F.positions[tok];
}
__device__ __forceinline__ void nsa_prep_token(Frame& F, int tok, const PrepRaw& p) {
    const int b = tok >> 13, t = tok & 8191, sub = F.lane & 7, vid = F.lane >> 3;
    float cs_l, sn_l; rope_sincos(p.pos, sub, cs_l, sn_l);
    float cs[8], sn[8];
#pragma unroll
    for (int i = 0; i < 8; ++i) { cs[i] = __shfl(cs_l, (F.lane & ~7) + i); sn[i] = __shfl(sn_l, (F.lane & ~7) + i); }
    unsigned char* dob = F.dout_b;
    const size_t ktile_off = (size_t)(t >> 6) * 8192 + sub * 1024 + (t & 63) * 16;
    const size_t vtile_off = (size_t)(t >> 6) * 8192 + (sub >> 2) * 4096 + (t & 63) * 64 + (sub & 3) * 16;
#pragma unroll
    for (int round = 0; round < 3; ++round) {
        int kind; unsigned char* dst; const float* gain = nullptr;
        if (round == 0) { kind = 0; gain = F.q_gain; const int g = vid >> 2, hh = vid & 3;
            dst = dob + DO_QN + ((((size_t)(b * 2 + g) * SEQ + t) * 4 + hh) * 64 + sub * 8) * 2; }
        else if (round == 1) {
            const int g = vid & 1, which = vid >> 1;
            const size_t img = (size_t)(b * 2 + g) * (1u << 20);
            if (which == 0) { kind = 1; gain = F.k_gain + 64; dst = dob + DO_KSEL + img + ktile_off; }
            else if (which == 1) { kind = 1; gain = F.k_gain + 128; dst = dob + DO_KWIN + img + ktile_off; }
            else if (which == 2) { kind = 2; dst = dob + DO_VSEL + img + vtile_off; }
            else { kind = 2; dst = dob + DO_VWIN + img + vtile_off; }
        } else {
            const int g = vid & 1, which = (vid >> 1) & 1;
            kind = 2;
            dst = dob + (which ? DO_VC : DO_KC) + (((size_t)(b * 2 + g) * SEQ + t) * 64 + sub * 8) * 2;
        }
        const v4u raw = (round == 0) ? p.r0 : (round == 1) ? p.r1 : p.r2;
        if (kind == 2) { if (round < 2 || F.lane < 32) *(v4u*)dst = raw; }
        else {
            float x[8]; unpack8(raw, x);
            float ss = 0.f;
#pragma unroll
            for (int i = 0; i < 8; ++i) ss += x[i] * x[i];
            ss += dpp_xor1(ss); ss += dpp_xor2(ss); ss += __shfl_xor(ss, 4);
            const float rstd = 1.0f / sqrtf(ss * (1.0f / 64.0f) + NORM_EPS);
#pragma unroll
            for (int i = 0; i < 8; ++i) x[i] = x[i] * rstd * gain[sub * 8 + i];
            float xo[8];
#pragma unroll
            for (int i = 0; i < 8; ++i) xo[i] = dpp_xor1(x[i]);
            if (sub == 0) {
#pragma unroll
                for (int i = 0; i < 8; ++i) x[i] = x[i] * cs[i] - xo[i] * sn[i];
            } else if (sub == 1) {
#pragma unroll
                for (int i = 0; i < 8; ++i) x[i] = x[i] * cs[i] + xo[i] * sn[i];
            }
            if (kind == 0) {
#pragma unroll
                for (int i = 0; i < 8; ++i) x[i] *= 0.125f * 1.4426950408889634f;
            }
            *(v4u*)dst = pack8(x);
        }
    }
    if (F.lane < 24) { float* gt = (float*)(F.ws + WS_GATES) + (size_t)tok * 24; gt[F.lane] = sigmoidf_(bf2f((bf16)p.ng)); }
}

__device__ __forceinline__ void nsa_compress_item(Frame& F, int item) {
    const int kv = item >> 6, b = (item >> 5) & 1, g = (item >> 4) & 1, rt = item & 15, n0 = rt * 32;
    const bf16* Asrc = (const bf16*)(F.dout_b + (kv ? DO_VC : DO_KC)) + ((size_t)(b * 2 + g) * SEQ + 16 * n0) * 64;
    const bf16* Bsrc = (const bf16*)(F.ws + WS_WCW1) + (size_t)kv * 256 * 2048;
    LAS bf16* As = (LAS bf16*)(F.lds + RING_OFF);
    LAS bf16* Bs = (LAS bf16*)(F.lds + RING_OFF + 2 * 32 * 72 * 2);
    LAS float* Hs = (LAS float*)(F.lds + RING_OFF + 86016);
    LAS float* W2s = (LAS float*)(F.lds + RING_OFF);
    const int ar = F.tid >> 3, ac = (F.tid & 7) * 8;
    v4u areg0 = {0u, 0u, 0u, 0u}, areg1 = {0u, 0u, 0u, 0u}, breg0[4], breg1[4];
#define CMP_GLOAD(A_, B_, kc) do { if (F.tid < 256) A_ = *(const v4u*)(Asrc + (size_t)ar * 1024 + (kc) * 64 + ac); \
        _Pragma("unroll") for (int i_ = 0; i_ < 4; ++i_) { const int p_ = F.tid + 512 * i_, br_ = p_ >> 3, bc_ = (p_ & 7) * 8; B_[i_] = *(const v4u*)(Bsrc + (size_t)br_ * 2048 + (kc) * 64 + bc_); } } while (0)
#define CMP_LSTORE(A_, B_, buf) do { if (F.tid < 256) *(LAS v4u*)(As + (buf) * 32 * 72 + ar * 72 + ac) = A_; \
        _Pragma("unroll") for (int i_ = 0; i_ < 4; ++i_) { const int p_ = F.tid + 512 * i_, br_ = p_ >> 3, bc_ = (p_ & 7) * 8; *(LAS v4u*)(Bs + (buf) * 256 * 72 + br_ * 72 + bc_) = B_[i_]; } } while (0)
#define CMP_MMA(buf) do { const LAS bf16* ap_ = As + (buf) * 32 * 72 + (F.lane & 15) * 72 + (F.lane >> 4) * 8; const LAS bf16* bp_ = Bs + (buf) * 256 * 72 + (F.wave * 32 + (F.lane & 15)) * 72 + (F.lane >> 4) * 8; \
        _Pragma("unroll") for (int k_ = 0; k_ < 64; k_ += 32) { \
            const bf16x8 a0_ = *(const LAS bf16x8*)(ap_ + k_), a1_ = *(const LAS bf16x8*)(ap_ + 16 * 72 + k_), b0_ = *(const LAS bf16x8*)(bp_ + k_), b1_ = *(const LAS bf16x8*)(bp_ + 16 * 72 + k_); \
            acc[0][0] = __builtin_amdgcn_mfma_f32_16x16x32_bf16(a0_, b0_, acc[0][0], 0, 0, 0); acc[0][1] = __builtin_amdgcn_mfma_f32_16x16x32_bf16(a0_, b1_, acc[0][1], 0, 0, 0); \
            acc[1][0] = __builtin_amdgcn_mfma_f32_16x16x32_bf16(a1_, b0_, acc[1][0], 0, 0, 0); acc[1][1] = __builtin_amdgcn_mfma_f32_16x16x32_bf16(a1_, b1_, acc[1][1], 0, 0, 0); } } while (0)
    f32x4 acc[2][2];
#pragma unroll
    for (int mt = 0; mt < 2; ++mt)
#pragma unroll
        for (int nt = 0; nt < 2; ++nt) acc[mt][nt] = (f32x4){0.f, 0.f, 0.f, 0.f};
#if defined(CMP_SPIN)
    const unsigned long long tc0 = __builtin_amdgcn_s_memrealtime();
#endif
    CMP_GLOAD(areg0, breg0, 0); CMP_GLOAD(areg1, breg1, 1); CMP_LSTORE(areg0, breg0, 0); __syncthreads();
#pragma unroll 1
    for (int kc = 0; kc < 32; kc += 2) {
        CMP_GLOAD(areg0, breg0, (kc + 2 < 32) ? kc + 2 : 31);
        CMP_MMA(0);
        CMP_LSTORE(areg1, breg1, 1);
        __syncthreads();
        CMP_GLOAD(areg1, breg1, (kc + 3 < 32) ? kc + 3 : 31);
        CMP_MMA(1);
        CMP_LSTORE(areg0, breg0, 0);
        __syncthreads();
    }
#undef CMP_MMA
#if defined(CMP_SPIN)
    if (CMP_SPIN == 1) { const unsigned long long t1_ = __builtin_amdgcn_s_memrealtime(), dt_ = t1_ - tc0; while (__builtin_amdgcn_s_memrealtime() - t1_ < dt_) __builtin_amdgcn_s_sleep(4); }
#endif
    const float* bias1 = (const float*)(F.ws + WS_MOD + 131072) + kv * 256;
#pragma unroll
    for (int mt = 0; mt < 2; ++mt)
#pragma unroll
        for (int nt = 0; nt < 2; ++nt) { const int col = F.wave * 32 + nt * 16 + (F.lane & 15);
#pragma unroll
            for (int i = 0; i < 4; ++i) Hs[(mt * 16 + 4 * (F.lane >> 4) + i) * 260 + col] = gelu_tanh(acc[mt][nt][i] + bias1[col]); }
    { const float* w2 = F.cmp_w2 + (size_t)kv * 256 * 64;
#pragma unroll
      for (int i = 0; i < 8; ++i) *(LAS f32x4*)(W2s + (F.tid + 512 * i) * 4) = *(const f32x4*)(w2 + (size_t)(F.tid + 512 * i) * 4); }
    __syncthreads();
    const int r = F.tid >> 4, dq = F.tid & 15;
    f32x4 o = {0.f, 0.f, 0.f, 0.f};
#pragma unroll 8
    for (int j = 0; j < 256; ++j) { const float hv = Hs[r * 260 + j]; const f32x4 w = *(const LAS f32x4*)(W2s + j * 64 + 4 * dq); o = o + w * hv; }
    const int n = n0 + r;
    if (kv == 0) {
        float ss = (o.x * o.x + o.y * o.y) + (o.z * o.z + o.w * o.w);
        ss += dpp_xor1(ss); ss += dpp_xor2(ss); ss += __shfl_xor(ss, 4); ss += __shfl_xor(ss, 8);
        const float rstd = 1.0f / sqrtf(ss * (1.0f / 64.0f) + NORM_EPS);
        const f32x4 gn = *(const f32x4*)(F.k_gain + 4 * dq);
        o = o * rstd * gn;
        const int tlast = (16 * n + 31 < SEQ) ? 16 * n + 31 : SEQ - 1;
        const int pos = F.positions[b * SEQ + tlast];
        f32x4 po; po.x = dpp_xor2(o.x); po.y = dpp_xor2(o.y); po.z = dpp_xor2(o.z); po.w = dpp_xor2(o.w);
        if (dq < 4) {
            const int i0 = 4 * (dq & 1);
            float c0, s0, c1, s1, c2, s2, c3, s3;
            rope_sincos(pos, i0, c0, s0); rope_sincos(pos, i0 + 1, c1, s1); rope_sincos(pos, i0 + 2, c2, s2); rope_sincos(pos, i0 + 3, c3, s3);
            if (dq < 2) { o.x = o.x * c0 - po.x * s0; o.y = o.y * c1 - po.y * s1; o.z = o.z * c2 - po.z * s2; o.w = o.w * c3 - po.w * s3; }
            else { o.x = o.x * c0 + po.x * s0; o.y = o.y * c1 + po.y * s1; o.z = o.z * c2 + po.z * s2; o.w = o.w * c3 + po.w * s3; }
        }
    }
    if (n == 511) o = (f32x4){0.f, 0.f, 0.f, 0.f};
    v2u pk; pk.x = pk2(o.x, o.y); pk.y = pk2(o.z, o.w);
    const int c = dq >> 1;
    unsigned char* img = F.dout_b + (kv ? DO_VCMP : DO_KCMP) + (size_t)(b * 2 + g) * 65536 + (size_t)(n >> 6) * 8192;
    if (kv == 0) *(v2u*)(img + c * 1024 + (n & 63) * 16 + (dq & 1) * 8) = pk;
    else *(v2u*)(img + (c >> 2) * 4096 + (n & 63) * 64 + (c & 3) * 16 + (dq & 1) * 8) = pk;
    __syncthreads();
}

constexpr int NSA_KB = 0, NSA_VB = 16384, NSA_IMP = 32768, NSA_OACC = 65536;
__device__ __forceinline__ int crow(int r, int hi) { return (r & 3) + 8 * (r >> 2) + 4 * hi; }
__device__ __forceinline__ s16x4 ds_tr16(const LAS unsigned char* p) { return __builtin_bit_cast(s16x4, __builtin_amdgcn_ds_read_tr16_b64_v4i16((LAS s16x4*)p)); }

__device__ __forceinline__ unsigned cvtpk(float lo, float hi) { unsigned r; asm("v_cvt_pk_bf16_f32 %0, %1, %2" : "=v"(r) : "v"(lo), "v"(hi)); return r; }
__device__ __forceinline__ float xhalf_max(float v) { const auto rr = __builtin_amdgcn_permlane32_swap(__float_as_uint(v), __float_as_uint(v), false, false); return fmaxf(__uint_as_float(rr[0]), __uint_as_float(rr[1])); }
constexpr float NSA_THR = 8.0f;

template <int MODE>
__device__ __forceinline__ void nsa_branch(Frame& F, const unsigned char* Kimg, const unsigned char* Vimg, int kt0, int kt1, const bf16x8 (&qr)[4],
                                           float& m, float& l, f32x16 (&o)[2], int t, int tw0, int nv, int nvw, int nvmin,
                                           unsigned mk0, unsigned mk1, unsigned mk2, unsigned mk3, unsigned wo0, unsigned wo1, unsigned wo2, unsigned wo3,
                                           float cinit  , LAS float* impw,
                                           bool bnd  ) {
    const int r32 = F.lane & 31, hi = F.lane >> 5, tokl = r32 >> 2;
    LAS unsigned char* KB = F.lds + RING_OFF + NSA_KB; LAS unsigned char* VB = F.lds + RING_OFF + NSA_VB;
    const v4u* kg = (const v4u*)Kimg + F.tid; const v4u* vg = (const v4u*)Vimg + F.tid;
    v4u kreg = kg[(size_t)kt0 * 512], vreg = {0u, 0u, 0u, 0u};
    if (MODE != 0) vreg = vg[(size_t)kt0 * 512];
    *(LAS v4u*)(KB + F.tid * 16) = kreg; if (MODE != 0) *(LAS v4u*)(VB + F.tid * 16) = vreg;
    __syncthreads();
#pragma unroll 1
    for (int kt = kt0; kt < kt1; ++kt) {
        const int buf = (kt - kt0) & 1; const bool has_next = kt + 1 < kt1;
        if (has_next) { kreg = kg[(size_t)(kt + 1) * 512]; if (MODE != 0) vreg = vg[(size_t)(kt + 1) * 512]; }
        const LAS unsigned char* Kb = KB + buf * 8192; const LAS unsigned char* Vb = VB + buf * 8192;
        bool need;
        if (MODE <= 1) need = kt * 64 < nvw;
        else if (MODE == 2) { const unsigned w = (kt < 32) ? wo0 : (kt < 64) ? wo1 : (kt < 96) ? wo2 : wo3; need = (w >> (kt & 31)) & 1u; }
        else need = (kt * 64 <= tw0 + 7) && (kt * 64 + 63 + 512 > tw0);
        bool selbit = true;
        if (MODE == 2) { const unsigned w = (kt < 32) ? mk0 : (kt < 64) ? mk1 : (kt < 96) ? mk2 : mk3; selbit = (w >> (kt & 31)) & 1u; }
        bool joint = false;
        if (need) {
            if (MODE == 2) joint = kt < (tw0 >> 6);
            else if (MODE == 3) joint = (kt * 64 + 63 <= tw0) && (kt * 64 + 512 > tw0 + 7);
            else joint = kt * 64 + 63 < nvmin;
            if (MODE != 1 && !bnd) joint = joint && !__any(m < -1e29f);
        }
        if (need && joint) {
            f32x16 pa, pb;
            if (bnd && MODE != 1) {
#pragma unroll
                for (int r = 0; r < 16; ++r) { pa[r] = 0.f; pb[r] = 0.f; }
#pragma unroll
                for (int d0 = 0; d0 < 4; ++d0) {
                    const bf16x8 kfa = *(const LAS bf16x8*)(Kb + (2 * d0 + hi) * 1024 + r32 * 16), kfb = *(const LAS bf16x8*)(Kb + (2 * d0 + hi) * 1024 + (32 + r32) * 16);
                    pa = __builtin_amdgcn_mfma_f32_32x32x16_bf16(kfa, qr[d0], pa, 0, 0, 0);
                    pb = __builtin_amdgcn_mfma_f32_32x32x16_bf16(kfb, qr[d0], pb, 0, 0, 0);
                }
            } else {
            const float c0 = (MODE == 1) ? cinit : ((MODE == 2 && !selbit) ? -1e30f : -m);
#pragma unroll
            for (int r = 0; r < 16; ++r) { pa[r] = c0; pb[r] = c0; }
#pragma unroll
            for (int d0 = 0; d0 < 4; ++d0) {
                const bf16x8 kfa = *(const LAS bf16x8*)(Kb + (2 * d0 + hi) * 1024 + r32 * 16), kfb = *(const LAS bf16x8*)(Kb + (2 * d0 + hi) * 1024 + (32 + r32) * 16);
                pa = __builtin_amdgcn_mfma_f32_32x32x16_bf16(kfa, qr[d0], pa, 0, 0, 0);
                pb = __builtin_amdgcn_mfma_f32_32x32x16_bf16(kfb, qr[d0], pb, 0, 0, 0);
            }
            if (MODE != 1) {
                float mxa = fmaxf(fmaxf(pa[0], pa[1]), pa[2]), mxb = fmaxf(fmaxf(pb[0], pb[1]), pb[2]);
#pragma unroll
                for (int r = 3; r < 15; r += 2) { mxa = fmaxf(fmaxf(mxa, pa[r]), pa[r + 1]); mxb = fmaxf(fmaxf(mxb, pb[r]), pb[r + 1]); }
                const float mx = xhalf_max(fmaxf(fmaxf(mxa, pa[15]), fmaxf(mxb, pb[15])));
                if (__any(mx > NSA_THR)) {
                    const float dl = fmaxf(mx, 0.f), alpha = fexp2(-dl);
                    m += dl; l *= alpha;
#pragma unroll
                    for (int r = 0; r < 16; ++r) { pa[r] -= dl; pb[r] -= dl; }
                    if (MODE != 0) {
#pragma unroll
                        for (int r = 0; r < 16; ++r) { o[0][r] *= alpha; o[1][r] *= alpha; }
                    }
                }
            }
            }
            float ps0 = 0.f, ps1 = 0.f;
#pragma unroll
            for (int r = 0; r < 16; ++r) { pa[r] = fexp2(pa[r]); pb[r] = fexp2(pb[r]); ps0 += pa[r]; ps1 += pb[r]; }
            if (MODE != 1) l += (bnd && MODE == 2 && !selbit) ? 0.f : (ps0 + ps1);
            if (MODE == 1) {
#pragma unroll
                for (int rg = 0; rg < 4; ++rg) {
                    float a = (pa[4 * rg] + pa[4 * rg + 1]) + (pa[4 * rg + 2] + pa[4 * rg + 3]), sp = pa[4 * rg + 3];
                    float a2 = (pb[4 * rg] + pb[4 * rg + 1]) + (pb[4 * rg + 2] + pb[4 * rg + 3]), sp2 = pb[4 * rg + 3];
                    a += dpp_xor1(a); a += dpp_xor2(a); sp += dpp_xor1(sp); sp += dpp_xor2(sp);
                    a2 += dpp_xor1(a2); a2 += dpp_xor2(a2); sp2 += dpp_xor1(sp2); sp2 += dpp_xor2(sp2);
                    if ((r32 & 3) == 0) { const int jp = kt * 16 + 2 * rg + hi;
                        __hip_atomic_fetch_add(impw + tokl * 128 + jp, a, __ATOMIC_RELAXED, __HIP_MEMORY_SCOPE_WORKGROUP);
                        __hip_atomic_fetch_add(impw + tokl * 128 + jp + 1, sp, __ATOMIC_RELAXED, __HIP_MEMORY_SCOPE_WORKGROUP);
                        __hip_atomic_fetch_add(impw + tokl * 128 + jp + 8, a2, __ATOMIC_RELAXED, __HIP_MEMORY_SCOPE_WORKGROUP);
                        if (jp + 9 < 128) __hip_atomic_fetch_add(impw + tokl * 128 + jp + 9, sp2, __ATOMIC_RELAXED, __HIP_MEMORY_SCOPE_WORKGROUP); }
                }
            }
            if (MODE != 0) {
                v4u wa0, wa1, wb0, wb1;
                wa0.x = cvtpk(pa[0], pa[1]); wa0.y = cvtpk(pa[2], pa[3]); wa0.z = cvtpk(pa[4], pa[5]); wa0.w = cvtpk(pa[6], pa[7]);
                wa1.x = cvtpk(pa[8], pa[9]); wa1.y = cvtpk(pa[10], pa[11]); wa1.z = cvtpk(pa[12], pa[13]); wa1.w = cvtpk(pa[14], pa[15]);
                wb0.x = cvtpk(pb[0], pb[1]); wb0.y = cvtpk(pb[2], pb[3]); wb0.z = cvtpk(pb[4], pb[5]); wb0.w = cvtpk(pb[6], pb[7]);
                wb1.x = cvtpk(pb[8], pb[9]); wb1.y = cvtpk(pb[10], pb[11]); wb1.z = cvtpk(pb[12], pb[13]); wb1.w = cvtpk(pb[14], pb[15]);
                if (MODE == 2 && bnd) { const unsigned km = selbit ? 0xffffffffu : 0u;
                    wa0.x &= km; wa0.y &= km; wa0.z &= km; wa0.w &= km; wa1.x &= km; wa1.y &= km; wa1.z &= km; wa1.w &= km; wb0.x &= km; wb0.y &= km; wb0.z &= km; wb0.w &= km; wb1.x &= km; wb1.y &= km; wb1.z &= km; wb1.w &= km; }
                const bf16x8 fa0 = __builtin_bit_cast(bf16x8, wa0), fa1 = __builtin_bit_cast(bf16x8, wa1), fb0 = __builtin_bit_cast(bf16x8, wb0), fb1 = __builtin_bit_cast(bf16x8, wb1);
                const LAS unsigned char* vb = Vb + (4 * hi + ((F.lane & 15) >> 2)) * 64 + ((F.lane >> 4) & 1) * 32 + (F.lane & 3) * 8;
#pragma unroll
                for (int dh = 0; dh < 2; ++dh) {
                    const LAS unsigned char* v0 = vb + dh * 4096;
                    const s16x4 a0 = ds_tr16(v0), a1 = ds_tr16(v0 + 512), b0 = ds_tr16(v0 + 1024), b1 = ds_tr16(v0 + 1536), c0_ = ds_tr16(v0 + 2048), c1 = ds_tr16(v0 + 2560), d0_ = ds_tr16(v0 + 3072), d1 = ds_tr16(v0 + 3584);
                    const bf16x8 vfa0 = {a0[0], a0[1], a0[2], a0[3], a1[0], a1[1], a1[2], a1[3]}, vfa1 = {b0[0], b0[1], b0[2], b0[3], b1[0], b1[1], b1[2], b1[3]};
                    const bf16x8 vfb0 = {c0_[0], c0_[1], c0_[2], c0_[3], c1[0], c1[1], c1[2], c1[3]}, vfb1 = {d0_[0], d0_[1], d0_[2], d0_[3], d1[0], d1[1], d1[2], d1[3]};
                    o[dh] = __builtin_amdgcn_mfma_f32_32x32x16_bf16(vfa0, fa0, o[dh], 0, 0, 0);
                    o[dh] = __builtin_amdgcn_mfma_f32_32x32x16_bf16(vfa1, fa1, o[dh], 0, 0, 0);
                    o[dh] = __builtin_amdgcn_mfma_f32_32x32x16_bf16(vfb0, fb0, o[dh], 0, 0, 0);
                    o[dh] = __builtin_amdgcn_mfma_f32_32x32x16_bf16(vfb1, fb1, o[dh], 0, 0, 0);
                }
            }
        } else if (need) {
#pragma unroll 1
            for (int kb = 0; kb < 2; ++kb) {
                const int key0 = kt * 64 + kb * 32;
                bool fast;
                if (MODE == 2) fast = kt < (tw0 >> 6);
                else if (MODE == 3) fast = (key0 + 31 <= tw0) && (key0 + 512 > tw0 + 7);
                else fast = key0 + 31 < nvmin;
                if (MODE != 1) fast = fast && !bnd && !__any(m < -1e29f);
                float c0 = 0.f;
                if (fast) c0 = (MODE == 1) ? cinit : ((MODE == 2 && !selbit) ? -1e30f : -m);
                f32x16 p;
#pragma unroll
                for (int r = 0; r < 16; ++r) p[r] = c0;
#pragma unroll
                for (int d0 = 0; d0 < 4; ++d0) {
                    const bf16x8 kf = *(const LAS bf16x8*)(Kb + (2 * d0 + hi) * 1024 + (32 * kb + r32) * 16);
                    p = __builtin_amdgcn_mfma_f32_32x32x16_bf16(kf, qr[d0], p, 0, 0, 0);
                }
                float pe[16];
                if (fast) {
                    if (MODE != 1) {
                        float mx = fmaxf(fmaxf(p[0], p[1]), p[2]);
#pragma unroll
                        for (int r = 3; r < 15; r += 2) mx = fmaxf(fmaxf(mx, p[r]), p[r + 1]);
                        mx = xhalf_max(fmaxf(mx, p[15]));
                        if (__any(mx > NSA_THR)) {
                            const float dl = fmaxf(mx, 0.f), alpha = fexp2(-dl);
                            m += dl; l *= alpha;
#pragma unroll
                            for (int r = 0; r < 16; ++r) p[r] -= dl;
                            if (MODE != 0) {
#pragma unroll
                                for (int r = 0; r < 16; ++r) { o[0][r] *= alpha; o[1][r] *= alpha; }
                            }
                        }
                    }
                    float ps0 = 0.f, ps1 = 0.f;
#pragma unroll
                    for (int r = 0; r < 16; r += 2) { pe[r] = fexp2(p[r]); pe[r + 1] = fexp2(p[r + 1]); ps0 += pe[r]; ps1 += pe[r + 1]; }
                    if (MODE != 1) l += ps0 + ps1;
                } else if (MODE == 1) {
#pragma unroll
                    for (int r = 0; r < 16; ++r) { const int key = key0 + crow(r, hi); pe[r] = (key < nv) ? fexp2(p[r] + cinit) : 0.f; }
                } else if (bnd) {
                    float ps = 0.f;
#pragma unroll
                    for (int r = 0; r < 16; ++r) {
                        const int key = key0 + crow(r, hi); bool ok;
                        if (MODE == 0) ok = key < nv;
                        else if (MODE == 2) ok = selbit && (kt < (t >> 6) || key <= t);
                        else ok = (key <= t) && (key + 512 > t);
                        pe[r] = ok ? fexp2(p[r]) : 0.f; ps += pe[r];
                    }
                    l += ps;
                } else {
                    float mx = NEGBIG;
#pragma unroll
                    for (int r = 0; r < 16; ++r) {
                        const int key = key0 + crow(r, hi); bool ok;
                        if (MODE == 0) ok = key < nv;
                        else if (MODE == 2) ok = selbit && (kt < (t >> 6) || key <= t);
                        else ok = (key <= t) && (key + 512 > t);
                        p[r] = ok ? p[r] : NEGBIG; mx = fmaxf(mx, p[r]);
                    }
                    mx = xhalf_max(mx);
                    const float mn = fmaxf(m, mx), alpha = fexp2(m - mn);
                    float ps = 0.f;
#pragma unroll
                    for (int r = 0; r < 16; ++r) { pe[r] = (p[r] > -1e29f) ? fexp2(p[r] - mn) : 0.f; ps += pe[r]; }
                    l = l * alpha + ps; m = mn;
                    if (MODE != 0) {
#pragma unroll
                        for (int r = 0; r < 16; ++r) { o[0][r] *= alpha; o[1][r] *= alpha; }
                    }
                }
                if (MODE == 1) {
#pragma unroll
                    for (int rg = 0; rg < 4; ++rg) {
                        float a = (pe[4 * rg] + pe[4 * rg + 1]) + (pe[4 * rg + 2] + pe[4 * rg + 3]), sp = pe[4 * rg + 3];
                        a += dpp_xor1(a); a += dpp_xor2(a); sp += dpp_xor1(sp); sp += dpp_xor2(sp);
                        if ((r32 & 3) == 0) { const int jp = (key0 >> 2) + 2 * rg + hi;
                            __hip_atomic_fetch_add(impw + tokl * 128 + jp, a, __ATOMIC_RELAXED, __HIP_MEMORY_SCOPE_WORKGROUP);
                            if (jp + 1 < 128) __hip_atomic_fetch_add(impw + tokl * 128 + jp + 1, sp, __ATOMIC_RELAXED, __HIP_MEMORY_SCOPE_WORKGROUP); }
                    }
                }
                if (MODE != 0) {
                    v4u pw0, pw1;
                    pw0.x = cvtpk(pe[0], pe[1]); pw0.y = cvtpk(pe[2], pe[3]); pw0.z = cvtpk(pe[4], pe[5]); pw0.w = cvtpk(pe[6], pe[7]);
                    pw1.x = cvtpk(pe[8], pe[9]); pw1.y = cvtpk(pe[10], pe[11]); pw1.z = cvtpk(pe[12], pe[13]); pw1.w = cvtpk(pe[14], pe[15]);
                    const bf16x8 pf0 = __builtin_bit_cast(bf16x8, pw0), pf1 = __builtin_bit_cast(bf16x8, pw1);
                    const LAS unsigned char* vb = Vb + (32 * kb + 4 * hi + ((F.lane & 15) >> 2)) * 64 + ((F.lane >> 4) & 1) * 32 + (F.lane & 3) * 8;
#pragma unroll
                    for (int dh = 0; dh < 2; ++dh) {
                        const s16x4 a0 = ds_tr16(vb + dh * 4096), a1 = ds_tr16(vb + dh * 4096 + 512), b0 = ds_tr16(vb + dh * 4096 + 1024), b1 = ds_tr16(vb + dh * 4096 + 1024 + 512);
                        const bf16x8 vf0 = {a0[0], a0[1], a0[2], a0[3], a1[0], a1[1], a1[2], a1[3]}, vf1 = {b0[0], b0[1], b0[2], b0[3], b1[0], b1[1], b1[2], b1[3]};
                        o[dh] = __builtin_amdgcn_mfma_f32_32x32x16_bf16(vf0, pf0, o[dh], 0, 0, 0);
                        o[dh] = __builtin_amdgcn_mfma_f32_32x32x16_bf16(vf1, pf1, o[dh], 0, 0, 0);
                    }
                }
            }
        }
        if (has_next) { *(LAS v4u*)(KB + (buf ^ 1) * 8192 + F.tid * 16) = kreg; if (MODE != 0) *(LAS v4u*)(VB + (buf ^ 1) * 8192 + F.tid * 16) = vreg; }
        __syncthreads();
    }
}

__device__ __forceinline__ void nsa_item(Frame& F, int b, int g, int qi) {
    const int r32 = F.lane & 31, hi = F.lane >> 5, tokl = r32 >> 2, hh = r32 & 3;
    const int t0 = qi * 64, tw0 = t0 + 8 * F.wave, t = tw0 + tokl;
    const unsigned char* dob = F.dout_b;
    const size_t img = (size_t)(b * 2 + g) * (1u << 20);
    LAS float* impw = (LAS float*)(F.lds + RING_OFF + NSA_IMP) + F.wave * 1024;
    LAS unsigned* selm = (LAS unsigned*)(F.lds + TAB_OFF + 1024) + F.wave * 32;
    LAS float* oaccw = (LAS float*)(F.lds + RING_OFF + NSA_OACC) + F.wave * 2048 + F.lane;
#pragma unroll
    for (int i = 0; i < 16; ++i) impw[F.lane + 64 * i] = 0.f;
    bf16x8 qr[4];
    { const bf16* qrow = (const bf16*)(dob + DO_QN) + (((size_t)(b * 2 + g) * SEQ + tw0) * 4 + r32) * 64;
#pragma unroll
      for (int d0 = 0; d0 < 4; ++d0) qr[d0] = *(const bf16x8*)(qrow + 16 * d0 + 8 * hi); }
    const float* gt = (const float*)(F.ws + WS_GATES) + ((size_t)b * SEQ + t) * 24 + (g * 4 + hh) * 3;
    f32x16 o[2];
    const int nv = (t >= 31) ? ((t - 31) >> 4) + 1 : 0, nvw = (tw0 + 7 >= 31) ? ((tw0 + 7 - 31) >> 4) + 1 : 0, nvmin = (tw0 >= 31) ? ((tw0 - 31) >> 4) + 1 : 0;
    const int nct = (4 * qi + 3 + 63) >> 6;
    const unsigned char* Kc = dob + DO_KCMP + (size_t)(b * 2 + g) * 65536; const unsigned char* Vc = dob + DO_VCMP + (size_t)(b * 2 + g) * 65536;
#if defined(NSA_SPIN)
    unsigned long long tsp = __builtin_amdgcn_s_memrealtime();
#define NSPIN(k) do { if (NSA_SPIN == (k)) { const unsigned long long t1_ = __builtin_amdgcn_s_memrealtime(), dt_ = t1_ - tsp; while (__builtin_amdgcn_s_memrealtime() - t1_ < dt_) __builtin_amdgcn_s_sleep(4); } tsp = __builtin_amdgcn_s_memrealtime(); } while (0)
#else
#define NSPIN(k) do { } while (0)
#endif
    bool bnd0, bnd1, bnd2;
    { float gq = fabsf(F.q_gain[F.lane]), g0k = fabsf(F.k_gain[F.lane]), g1k = fabsf(F.k_gain[64 + F.lane]), g2k = fabsf(F.k_gain[128 + F.lane]);
#pragma unroll
      for (int off = 1; off < 64; off <<= 1) { gq = fmaxf(gq, __shfl_xor(gq, off)); g0k = fmaxf(g0k, __shfl_xor(g0k, off)); g1k = fmaxf(g1k, __shfl_xor(g1k, off)); g2k = fmaxf(g2k, __shfl_xor(g2k, off)); }
      const float cb = 64.0f * 0.125f * 1.4426950408889634f * 1.03f * gq;
      bnd0 = __builtin_amdgcn_readfirstlane((int)(cb * g0k < 40.0f)) != 0; bnd1 = __builtin_amdgcn_readfirstlane((int)(cb * g1k < 40.0f)) != 0; bnd2 = __builtin_amdgcn_readfirstlane((int)(cb * g2k < 40.0f)) != 0; }
    float m = bnd0 ? 0.f : NEGBIG, l = 0.f;
    nsa_branch<0>(F, Kc, Vc, 0, nct, qr, m, l, o, t, tw0, nv, nvw, nvmin, 0u, 0u, 0u, 0u, 0u, 0u, 0u, 0u, 0.f, impw, bnd0);
    { const float lt = l + __shfl_xor(l, 32); const float cinit = (lt > 0.f) ? -__log2f(lt) - m : -1e30f;
#pragma unroll
      for (int r = 0; r < 16; ++r) { o[0][r] = 0.f; o[1][r] = 0.f; }
      nsa_branch<1>(F, Kc, Vc, 0, nct, qr, m, l, o, t, tw0, nv, nvw, nvmin, 0u, 0u, 0u, 0u, 0u, 0u, 0u, 0u, cinit, impw, bnd0);
#pragma unroll
      for (int r = 0; r < 16; ++r) { oaccw[r * 64] = gt[0] * o[0][r]; oaccw[(16 + r) * 64] = gt[0] * o[1][r]; } }
    __syncthreads();
    NSPIN(1);
#pragma unroll 1
    for (int tl = 0; tl < 4; ++tl) {
        const int j0 = F.lane, j1 = F.lane + 64;
        const int curA = (tw0 + tl) >> 6, curB = (tw0 + tl + 4) >> 6;
        const unsigned uA0 = (j0 <= curA) ? (__float_as_uint(impw[tl * 128 + j0] + ((j0 == 0 || j0 == curA || j0 == curA - 1) ? 1e4f : 0.f)) + 1u) : 0u;
        const unsigned uA1 = (j1 <= curA) ? (__float_as_uint(impw[tl * 128 + j1] + ((j1 == curA || j1 == curA - 1) ? 1e4f : 0.f)) + 1u) : 0u;
        const unsigned uB0 = (j0 <= curB) ? (__float_as_uint(impw[(tl + 4) * 128 + j0] + ((j0 == 0 || j0 == curB || j0 == curB - 1) ? 1e4f : 0.f)) + 1u) : 0u;
        const unsigned uB1 = (j1 <= curB) ? (__float_as_uint(impw[(tl + 4) * 128 + j1] + ((j1 == curB || j1 == curB - 1) ? 1e4f : 0.f)) + 1u) : 0u;
        bool sA0, sA1, sB0, sB1;
        if (curA < 16) { sA0 = (j0 <= curA); sA1 = false; sB0 = (j0 <= curB); sB1 = false; }
        else {
            unsigned TA = 0u, TB = 0u;
#pragma unroll 1
            for (int bit = 31; bit >= 0; --bit) {
                const unsigned candA = TA | (1u << bit), candB = TB | (1u << bit);
                const int cA = __popcll(__ballot(uA0 >= candA)) + __popcll(__ballot(uA1 >= candA));
                const int cB = __popcll(__ballot(uB0 >= candB)) + __popcll(__ballot(uB1 >= candB));
                if (cA >= 16) TA = candA;
                if (cB >= 16) TB = candB;
            }
            const unsigned long long below = (F.lane == 0) ? 0ull : (~0ull >> (64 - F.lane));
            { const unsigned long long g0 = __ballot(uA0 > TA), g1 = __ballot(uA1 > TA), e0 = __ballot(uA0 == TA), e1 = __ballot(uA1 == TA);
              const int need = 16 - (__popcll(g0) + __popcll(g1));
              const int rank0 = __popcll(e0 & below), rank1 = __popcll(e0) + __popcll(e1 & below);
              sA0 = (uA0 > TA) || (uA0 == TA && rank0 < need); sA1 = (uA1 > TA) || (uA1 == TA && rank1 < need); }
            { const unsigned long long g0 = __ballot(uB0 > TB), g1 = __ballot(uB1 > TB), e0 = __ballot(uB0 == TB), e1 = __ballot(uB1 == TB);
              const int need = 16 - (__popcll(g0) + __popcll(g1));
              const int rank0 = __popcll(e0 & below), rank1 = __popcll(e0) + __popcll(e1 & below);
              sB0 = (uB0 > TB) || (uB0 == TB && rank0 < need); sB1 = (uB1 > TB) || (uB1 == TB && rank1 < need); }
        }
        const unsigned long long mA0 = __ballot(sA0), mA1 = __ballot(sA1), mB0 = __ballot(sB0), mB1 = __ballot(sB1);
        if (F.lane == 0) { selm[tl * 4 + 0] = (unsigned)mA0; selm[tl * 4 + 1] = (unsigned)(mA0 >> 32); selm[tl * 4 + 2] = (unsigned)mA1; selm[tl * 4 + 3] = (unsigned)(mA1 >> 32);
            selm[(tl + 4) * 4 + 0] = (unsigned)mB0; selm[(tl + 4) * 4 + 1] = (unsigned)(mB0 >> 32); selm[(tl + 4) * 4 + 2] = (unsigned)mB1; selm[(tl + 4) * 4 + 3] = (unsigned)(mB1 >> 32); }
    }
    __syncthreads();
    const unsigned mk0 = selm[tokl * 4 + 0], mk1 = selm[tokl * 4 + 1], mk2 = selm[tokl * 4 + 2], mk3 = selm[tokl * 4 + 3];
    unsigned wo0 = 0u, wo1 = 0u, wo2 = 0u, wo3 = 0u;
#pragma unroll
    for (int tl = 0; tl < 8; ++tl) { wo0 |= selm[tl * 4 + 0]; wo1 |= selm[tl * 4 + 1]; wo2 |= selm[tl * 4 + 2]; wo3 |= selm[tl * 4 + 3]; }
    wo0 = __builtin_amdgcn_readfirstlane(wo0); wo1 = __builtin_amdgcn_readfirstlane(wo1); wo2 = __builtin_amdgcn_readfirstlane(wo2); wo3 = __builtin_amdgcn_readfirstlane(wo3);
    NSPIN(2);
    { m = bnd1 ? 0.f : NEGBIG; l = 0.f;
#pragma unroll
      for (int r = 0; r < 16; ++r) { o[0][r] = 0.f; o[1][r] = 0.f; }
      nsa_branch<2>(F, dob + DO_KSEL + img, dob + DO_VSEL + img, 0, qi + 1, qr, m, l, o, t, tw0, nv, nvw, nvmin, mk0, mk1, mk2, mk3, wo0, wo1, wo2, wo3, 0.f, impw, bnd1);
      const float lt = l + __shfl_xor(l, 32); const float sc = (lt > 0.f) ? gt[1] / lt : 0.f;
#pragma unroll
      for (int r = 0; r < 16; ++r) { oaccw[r * 64] += sc * o[0][r]; oaccw[(16 + r) * 64] += sc * o[1][r]; } }
    NSPIN(3);
    { m = bnd2 ? 0.f : NEGBIG; l = 0.f;
#pragma unroll
      for (int r = 0; r < 16; ++r) { o[0][r] = 0.f; o[1][r] = 0.f; }
      nsa_branch<3>(F, dob + DO_KWIN + img, dob + DO_VWIN + img, (qi >= 8) ? qi - 8 : 0, qi + 1, qr, m, l, o, t, tw0, nv, nvw, nvmin, 0u, 0u, 0u, 0u, 0u, 0u, 0u, 0u, 0.f, impw, bnd2);
      const float lt = l + __shfl_xor(l, 32); const float sc = (lt > 0.f) ? gt[2] / lt : 0.f;
#pragma unroll
      for (int r = 0; r < 16; ++r) { o[0][r] = oaccw[r * 64] + sc * o[0][r]; o[1][r] = oaccw[(16 + r) * 64] + sc * o[1][r]; } }
    NSPIN(4);
    bf16* orow = (bf16*)(F.ws + WS_O + 32 * MiB) + ((size_t)b * SEQ + t) * DM + 512 + (g * 4 + hh) * 64;
#pragma unroll
    for (int dh = 0; dh < 2; ++dh)
#pragma unroll
        for (int rg = 0; rg < 4; ++rg) { v2u w; w.x = pk2(o[dh][4 * rg], o[dh][4 * rg + 1]); w.y = pk2(o[dh][4 * rg + 2], o[dh][4 * rg + 3]);
            *(v2u*)(orow + 32 * dh + 8 * rg + 4 * hi) = w; }
    __syncthreads();
}

__device__ __forceinline__ void sgu_item(Frame& F, int item) {
    const int gg = item & 7, ck = (item >> 3) & 63, b = item >> 9;
    const size_t tok0 = (size_t)b * SEQ + ck * 128;
    const bf16* Z = (const bf16*)(F.ws + WS_A);
    constexpr int RS = 544, BS = 136;
    LAS bf16* Ws = (LAS bf16*)(F.lds + RING_OFF);
    LAS unsigned char* Vs = F.lds + RING_OFF + 34816;
    LAS float* rs = (LAS float*)(F.lds + RING_OFF + 34816 + 128 * RS);
    if (F.tid < 128) { const float* st = (const float*)(F.ws + WS_STATS) + (tok0 + F.tid) * 32; float sum = 0.f;
#pragma unroll
        for (int k = 0; k < 32; k += 4) { const f32x4 v = *(const f32x4*)(st + k); sum += (v.x + v.y) + (v.z + v.w); }
        rs[F.tid] = 1.0f / sqrtf(sum * (1.0f / SGW) + NORM_EPS); }
    { const float* wsrc = F.sgu_ws + (size_t)gg * 128 * 128;
#pragma unroll
      for (int k = 0; k < 8; ++k) { const int p = F.tid + 512 * k, tr = p >> 5, sc = (p & 31) * 4; const f32x4 w = *(const f32x4*)(wsrc + tr * 128 + sc);
          v2u o; o.x = pk2((sc <= tr) ? w.x : 0.f, (sc + 1 <= tr) ? w.y : 0.f); o.y = pk2((sc + 2 <= tr) ? w.z : 0.f, (sc + 3 <= tr) ? w.w : 0.f);
          *(LAS v2u*)(Ws + tr * 136 + sc) = o; } }
    __syncthreads();
    { const int cc = F.tid & 31; float gn[8];
#pragma unroll
      for (int i = 0; i < 8; ++i) gn[i] = F.sgu_ng[gg * 256 + cc * 8 + i];
      v4u zr[8];
#pragma unroll
      for (int k = 0; k < 8; ++k) { const int sidx = (F.tid >> 5) + 16 * k; zr[k] = *(const v4u*)(Z + (tok0 + sidx) * 4096 + 2048 + gg * 256 + cc * 8); }
#pragma unroll
      for (int k = 0; k < 8; ++k) { const int sidx = (F.tid >> 5) + 16 * k; float x[8]; unpack8(zr[k], x); const float rr = rs[sidx];
#pragma unroll
          for (int i = 0; i < 8; ++i) x[i] *= rr * gn[i];
          const v4u o = pack8(x); LAS unsigned char* dst = Vs + sidx * RS + (cc >> 3) * BS + (cc & 7) * 16;
          *(LAS v2u*)dst = (v2u){o.x, o.y}; *(LAS v2u*)(dst + 8) = (v2u){o.z, o.w}; } }
    __syncthreads();
    v4u uraw[8];
    { const bf16* urow0 = Z + (tok0 + 16 * F.wave + (F.lane & 15)) * 4096 + gg * 256 + 64 * (F.lane >> 4);
#pragma unroll
      for (int j = 0; j < 8; ++j) uraw[j] = *(const v4u*)(urow0 + 8 * j); }
    f32x4 acc[16];
#pragma unroll
    for (int nt = 0; nt < 16; ++nt) acc[nt] = (f32x4){0.f, 0.f, 0.f, 0.f};
    const int ksteps = (16 * F.wave + 16 + 31) >> 5;
    const LAS bf16* wp = Ws + (16 * F.wave + (F.lane & 15)) * 136 + (F.lane >> 4) * 8;
    const LAS unsigned char* vp = Vs + (8 * (F.lane >> 4) + ((F.lane & 15) >> 2)) * RS + (F.lane & 3) * BS;
#pragma unroll 1
    for (int kk = 0; kk < ksteps; ++kk) {
        const bf16x8 wf = *(const LAS bf16x8*)(wp + kk * 32);
        const LAS unsigned char* vk = vp + kk * 32 * RS;
#pragma unroll
        for (int nt = 0; nt < 16; ++nt) {
            const s16x4 lo = ds_tr16(vk + 8 * nt), hi4 = ds_tr16(vk + 4 * RS + 8 * nt);
            const bf16x8 vf = {lo[0], lo[1], lo[2], lo[3], hi4[0], hi4[1], hi4[2], hi4[3]};
            acc[nt] = __builtin_amdgcn_mfma_f32_16x16x32_bf16(vf, wf, acc[nt], 0, 0, 0);
        }
    }
    { const int tr = 16 * F.wave + (F.lane & 15), g = F.lane >> 4; const float bs = F.sgu_bs[gg * 128 + tr];
      bf16* orow = (bf16*)(F.ws + WS_O) + (tok0 + tr) * SGW + gg * 256 + 64 * g;
#pragma unroll
      for (int j = 0; j < 8; ++j) { float u[8]; unpack8(uraw[j], u);
#pragma unroll
          for (int i = 0; i < 4; ++i) { u[i] *= acc[2 * j][i] + bs; u[4 + i] *= acc[2 * j + 1][i] + bs; }
          *(v4u*)(orow + 8 * j) = pack8(u); } }
    __syncthreads();
}


__device__ __forceinline__ void moe_tail_copies(Frame& F, int set) {
    const int np = ((const LAS int*)(F.lds + TAB_OFF))[16];
    int cthr = 4 * np - 2 * F.G; cthr = cthr < 0 ? 0 : (cthr > F.G - 64 ? F.G - 64 : cthr);
    __syncthreads();
    if (F.bid >= cthr) tr_run(F, set, (F.bid - cthr) * 8 + F.wave, (F.G - cthr) * 8);
}
constexpr int NPHASE = 18;
struct Args { const void* in[26]; float* out; unsigned char* ws; int ph_lo, ph_hi, use_bar, pad; };
__global__ void __launch_bounds__(512, 2) trunk_fwd(Args args) {
    extern __shared__ __attribute__((aligned(16))) unsigned char lds[];
    Frame F;
    F.lds = (LAS unsigned char*)lds;
    F.MISC = (volatile LAS unsigned*)(F.lds + MISC_OFF);
    F.tid = threadIdx.x; F.lane = F.tid & 63; F.wave = __builtin_amdgcn_readfirstlane(F.tid >> 6);
    F.G = gridDim.x; F.bid = blockIdx.x;
    F.ws = args.ws; F.out = args.out; F.dout_b = (unsigned char*)args.out;
    F.ctl = (gu32*)(args.ws + WS_CTL);
    F.x = (const float*)args.in[0]; F.c = (const float*)args.in[1]; F.positions = (const int*)args.in[2]; F.w_ada = (const float*)args.in[3]; F.b_ada = (const float*)args.in[4];
    F.norm_g = (const float*)args.in[5]; F.w_in_ab = (const float*)args.in[6]; F.w_out_ab = (const float*)args.in[7]; F.gla_w2 = (const float*)args.in[8]; F.gla_bg = (const float*)args.in[9];
    F.gla_ng = (const float*)args.in[10]; F.q_gain = (const float*)args.in[11]; F.k_gain = (const float*)args.in[12]; F.cmp_pe = (const float*)args.in[13]; F.cmp_w1 = (const float*)args.in[14];
    F.cmp_w2 = (const float*)args.in[15]; F.w_in_c = (const float*)args.in[16]; F.sgu_ng = (const float*)args.in[17]; F.sgu_ws = (const float*)args.in[18]; F.sgu_bs = (const float*)args.in[19];
    F.w_out_c = (const float*)args.in[20]; F.w_router = (const float*)args.in[21]; F.r_bias = (const float*)args.in[22]; F.w_gate = (const float*)args.in[23]; F.w_up = (const float*)args.in[24];
    F.w_down = (const float*)args.in[25];
    for (int u = F.tid; u < (LDS_BYTES - LDSCTL_OFF) / 4; u += 512) ((LAS unsigned*)(F.lds + LDSCTL_OFF))[u] = 0u;
    __syncthreads();
    XcdBarrier bar; bar.bar = (unsigned*)(F.ctl + CW_BAR); bar.x = 0; bar.st = nullptr;
    if (args.use_bar) bar = xcd_barrier_post((unsigned*)(F.ctl + CW_BAR) + (args.use_bar - 1) * XCD_BAR_WORDS, F.MISC + 8);
    const int lo = args.ph_lo, hi = args.ph_hi;
#ifndef PH_MASK
#define PH_MASK 0x3FFFFu
#endif
#define IN(k) ((((PH_MASK) >> (k)) & 1u) && lo <= (k) && (k) < hi)
#if defined(SPIN_PHASE)
    unsigned long long t_mark = __builtin_amdgcn_s_memrealtime();
#define SPIN_HOOK(k) do { if ((k) == (SPIN_PHASE)) { const unsigned long long t1_ = __builtin_amdgcn_s_memrealtime(), dt_ = t1_ - t_mark; while (__builtin_amdgcn_s_memrealtime() - t1_ < dt_) __builtin_amdgcn_s_sleep(4); } } while (0)
#define SPIN_MARK() do { t_mark = __builtin_amdgcn_s_memrealtime(); } while (0)
#else
#define SPIN_HOOK(k) do { } while (0)
#define SPIN_MARK() do { } while (0)
#endif
#define SEAM(k) do { if (IN(k)) SPIN_HOOK(k); if (IN(k) && IN((k) + 1)) xcd_barrier(bar); SPIN_MARK(); } while (0)
    float* mod = (float*)(F.ws + WS_MOD);
    bf16* Hb = (bf16*)(F.ws + WS_O);
    bf16* Ab = (bf16*)(F.ws + WS_A);

    if (IN(0)) { p0_prologue(F); } SEAM(0);
    if (IN(1)) { row_pass<false, true, false>(F, F.x, mod, 0, F.norm_g, mod, 0, 0); } SEAM(1);
    if (IN(2)) { pg8::Gemm g{Hb, (const bf16*)(F.ws + WS_WIN), NTOK, NPROJ, DM}; pg8::StaticOrder S; S.init(NTOK, NPROJ, F.G, F.bid);
        pg8::EpiBf16<0> E{Ab, NPROJ, nullptr, 0, 0, 1.f};
        pg8::gemm_phase<pg8::EpiBf16<0>, pg8::StaticOrder, true, true>(F.lds + RING_OFF, g, S, E); } SEAM(2);
    if (IN(3)) {
        for (int it = F.bid; it < 1024; it += F.G) gla_prep_item(F, it);
        { int tok = F.bid * 8 + F.wave; const int tstep = F.G * 8; PrepRaw cur, nxt; nxt.pos = 0; nxt.ng = 0u; nxt.r0 = (v4u){0u, 0u, 0u, 0u}; nxt.r1 = nxt.r0; nxt.r2 = nxt.r0;
          if (tok < NTOK) nsa_prep_load(F, tok, cur);
          while (tok < NTOK) { const int ntok = tok + tstep; if (ntok < NTOK) nsa_prep_load(F, ntok, nxt); nsa_prep_token(F, tok, cur); cur = nxt; tok = ntok; } }
    } SEAM(3);
    if (IN(4)) {
        const int half = F.G >> 1;
#if defined(P4_SPIN)
        const unsigned long long tp4 = __builtin_amdgcn_s_memrealtime();
#endif
        if (F.bid < half) { for (int it = F.bid; it < 128; it += half) nsa_compress_item(F, it); }
        else { for (int gi = (F.bid - half) * 512 + F.tid; gi < 65536; gi += (F.G - half) * 512) gla_scan(F, gi); }
#if defined(P4_SPIN)
        if ((P4_SPIN == 1) == (F.bid < half)) { const unsigned long long t1_ = __builtin_amdgcn_s_memrealtime(), dt_ = t1_ - tp4; while (__builtin_amdgcn_s_memrealtime() - t1_ < dt_) __builtin_amdgcn_s_sleep(4); }
#endif
    } SEAM(4);
    if (IN(5)) {
#ifndef NO_NSA
        { const int p = F.bid & 255, bg = p >> 6, i = p & 63; nsa_item(F, bg >> 1, bg & 1, i); nsa_item(F, bg >> 1, bg & 1, 127 - i); }
#endif
#ifndef NO_GLAOUT
#if defined(GLA_SPIN)
        { const unsigned long long tg0 = __builtin_amdgcn_s_memrealtime();
#endif
        for (int it = F.bid; it < 1024; it += F.G) gla_out_item(F, it);
#if defined(GLA_SPIN)
          const unsigned long long t1_ = __builtin_amdgcn_s_memrealtime(), dt_ = t1_ - tg0; while (__builtin_amdgcn_s_memrealtime() - t1_ < dt_) __builtin_amdgcn_s_sleep(4); }
#endif
#endif
    } SEAM(5);
    if (IN(6)) { pg8::Gemm g{(const bf16*)(F.ws + WS_O + 32 * MiB), (const bf16*)(F.ws + WS_WOUT), NTOK, DM, DM}; pg8::StaticOrder S; S.init(NTOK, DM, F.G, F.bid);
        EpiResid E{F.x, F.out, mod + 2 * 1024};
        pg8::gemm_phase<EpiResid, pg8::StaticOrder, true, true>(F.lds + RING_OFF, g, S, E); } SEAM(6);
#define MOE_BLOCK(P, LAYER) \
    if (IN(P)) { row_pass<false, true, true>(F, F.out, mod + (LAYER) * 2 * 6144, 3 * 1024, F.norm_g + ((LAYER) * 2 + 1) * 1024, mod, (LAYER), 0); } SEAM(P); \
    if (IN((P) + 1)) { moe_tables(F, (LAYER)); MoeOrder S{(const LAS int*)(F.lds + TAB_OFF), F.G, F.bid}; \
        { LAS unsigned* rofs = (LAS unsigned*)(F.lds + TAB_OFF + 2048); const int* elist = (const int*)(F.ws + WS_STATS); pg8::Unit uu; \
          for (int ui = 0; ui < 3; ++ui) if (S.next(ui, uu)) { if (F.tid < 256) rofs[ui * 256 + F.tid] = S.row_off(uu, F.tid, elist); } \
          __syncthreads(); } \
        pg8::Gemm g{Hb, (const bf16*)(F.ws + WS_WGU) + (size_t)(LAYER) * 16 * 1024 * 1024, MOE_ROWS, 1024, DM}; EpiMoeGU E{(bf16*)(F.ws + WS_A + A_HID_OFF)}; \
        pg8::gemm_phase_gather<EpiMoeGU, MoeOrder>(F.lds + RING_OFF, g, S, E, (const LAS unsigned*)(F.lds + TAB_OFF + 2048)); \
        if ((LAYER) == 0) moe_tail_copies(F, 1); } SEAM((P) + 1); \
    if (IN((P) + 2)) { moe_tables(F, (LAYER)); MoeOrder S{(const LAS int*)(F.lds + TAB_OFF), F.G, F.bid}; \
        pg8::Gemm g{(const bf16*)(F.ws + WS_A + A_HID_OFF), (const bf16*)(F.ws + WS_WDN) + (size_t)(LAYER) * 16 * 1024 * 512, MOE_ROWS, 1024, EHID}; EpiMoeDn E{Ab}; \
        pg8::gemm_phase<EpiMoeDn, MoeOrder, true, true>(F.lds + RING_OFF, g, S, E); \
        if ((LAYER) == 0) moe_tail_copies(F, 2); } SEAM((P) + 2);
    MOE_BLOCK(7, 0)
    if (IN(10)) { row_pass<true, true, false>(F, F.out, mod + 2 * 6144, 0, F.norm_g + 2 * 1024, mod, 1, 0); } SEAM(10);
    if (IN(11)) { pg8::Gemm g{Hb, (const bf16*)(F.ws + WS_WINC), NTOK, 4096, DM}; pg8::StaticOrder S; S.init(NTOK, 4096, F.G, F.bid);
        EpiGeluStats E{Ab, (float*)(F.ws + WS_STATS)};
        pg8::gemm_phase<EpiGeluStats, pg8::StaticOrder, true, true>(F.lds + RING_OFF, g, S, E); } SEAM(11);
    if (IN(12)) { for (int it = F.bid; it < 1024; it += F.G) sgu_item(F, it); } SEAM(12);
    if (IN(13)) { pg8::Gemm g{Hb, (const bf16*)(F.ws + WS_WOUTC), NTOK, DM, SGW}; pg8::StaticOrder S; S.init(NTOK, DM, F.G, F.bid);
        EpiResid E{F.out, F.out, mod + 2 * 6144 + 2 * 1024};
        pg8::gemm_phase<EpiResid, pg8::StaticOrder, true, true>(F.lds + RING_OFF, g, S, E); } SEAM(13);
    MOE_BLOCK(14, 1)
    if (IN(17)) { row_pass<true, false, false>(F, F.out, mod, 0, F.norm_g, mod + 2 * 6144, 1, 1); SPIN_HOOK(17); }
#undef IN
#undef SEAM
#undef MOE_BLOCK
}

#ifndef MK_N_LAUNCHES
#define MK_N_LAUNCHES 1
#endif
extern "C" void kernel_launch(void* const* d_in, const int* in_sizes, int n_in, void* d_out, int out_size, void* d_ws, size_t ws_size, hipStream_t stream) {
    static int grid = 0;
    if (grid == 0) {
        if (n_in != 26 || out_size != NTOK * DM || ws_size < WS_END) { fprintf(stderr, "kernel_launch: unexpected problem shape / workspace (%d inputs, out %d, ws %zu)\n", n_in, out_size, ws_size); grid = -1; return; }
        int dev = 0, cus = 0, per_cu = 0;
        if (hipGetDevice(&dev) != hipSuccess || hipDeviceGetAttribute(&cus, hipDeviceAttributeMultiprocessorCount, dev) != hipSuccess) { grid = -1; return; }
        if (hipFuncSetAttribute((const void*)trunk_fwd, hipFuncAttributeMaxDynamicSharedMemorySize, LDS_BYTES) != hipSuccess) { fprintf(stderr, "kernel_launch: hipFuncSetAttribute failed\n"); grid = -1; return; }
        if (hipOccupancyMaxActiveBlocksPerMultiprocessor(&per_cu, (const void*)trunk_fwd, 512, LDS_BYTES) != hipSuccess || per_cu < 1) { fprintf(stderr, "kernel_launch: occupancy query says %d blocks per CU\n", per_cu); }
        (void)hipGetLastError();
        grid = cus;
        if (grid != 256) { fprintf(stderr, "kernel_launch: built for a 256-CU device, found %d CUs\n", cus); grid = -1; return; }
    }
    if (grid < 0) return;
    (void)hipMemsetAsync((char*)d_ws + WS_CTL, 0, CTL_ZERO_BYTES, stream);
    Args a{};
    for (int i = 0; i < 26; ++i) a.in[i] = d_in[i];
    a.out = (float*)d_out; a.ws = (unsigned char*)d_ws; a.pad = 0;
    if (MK_N_LAUNCHES == 1) {
#if defined(REP_PHASE)
        a.ph_lo = 0; a.ph_hi = REP_PHASE + 1; a.use_bar = 1;
        hipLaunchKernelGGL(trunk_fwd, dim3(grid), dim3(512), LDS_BYTES, stream, a);
        a.ph_lo = REP_PHASE; a.ph_hi = NPHASE; a.use_bar = 2;
        hipLaunchKernelGGL(trunk_fwd, dim3(grid), dim3(512), LDS_BYTES, stream, a);
#else
        a.ph_lo = 0; a.ph_hi = NPHASE; a.use_bar = 1;
        hipLaunchKernelGGL(trunk_fwd, dim3(grid), dim3(512), LDS_BYTES, stream, a);
#endif
    } else {
        for (int p = 0; p < NPHASE; ++p) { a.ph_lo = p; a.ph_hi = p + 1; a.use_bar = 0; hipLaunchKernelGGL(trunk_fwd, dim3(grid), dim3(512), LDS_BYTES, stream, a); }
    }
}
```

```cpp
#include <hip/hip_runtime.h>
#include <cstdio>
#include <cstdint>
namespace pg8 {
#define PG8_LAS __attribute__((address_space(3)))
typedef unsigned short bf16_t;
typedef short bf16x8 __attribute__((ext_vector_type(8)));
typedef float f32x4 __attribute__((ext_vector_type(4)));
typedef unsigned u32x4 __attribute__((ext_vector_type(4)));
constexpr int BM = 256, BK = 64, HALF = 128, HTB = HALF * BK * 2  , STAGE_BYTES = 8 * HTB, NXCD = 8, WGM = 8;

__host__ __device__ __forceinline__ int lds_byte(int r, int c) { const int st = (r >> 4) * 2 + (c >> 5), rr = r & 15, cc = c & 31, ob = rr * 64 + cc * 2; return st * 1024 + (ob ^ (((ob >> 9) & 1) << 5)); }
__host__ __device__ __forceinline__ void stage_rc(int b, int& R, int& C) { const int st = b / 1024, sb = b % 1024, swz = sb ^ (((sb >> 9) & 1) << 5); R = (st >> 1) * 16 + swz / 64; C = (st & 1) * 32 + (swz % 64) / 2; }
__host__ __device__ __forceinline__ int perm32(int rho) { const int n = rho >> 4, i = rho & 15; return 8 * (i >> 2) + 4 * n + (i & 3); }

struct Unit { int pm, pn; };
struct Gemm { const bf16_t* A; const bf16_t* Bt; int M, N, K; };

struct StaticOrder {
    int nM, nN, nwg, G, c;
    __host__ __device__ void init(int M, int N, int G_, int c_) { nM = M / BM; nN = N / BM; nwg = nM * nN; G = G_; c = c_; }
    __host__ __device__ bool next(int i, Unit& u) const {
        const long L = (long)i * G + c; if (L >= nwg) return false;
        int wgid = (int)L; { const int q = nwg / NXCD, r = nwg % NXCD, xcd = wgid % NXCD, off = wgid / NXCD; wgid = (xcd < r ? xcd * (q + 1) : r * (q + 1) + (xcd - r) * q) + off; }
        const int nig = WGM * nN, gid = wgid / nig, fm = gid * WGM, gsz = (nM - fm) < WGM ? (nM - fm) : WGM;
        u.pm = fm + ((wgid % nig) % gsz); u.pn = (wgid % nig) / gsz; return true;
    }
    __device__ __forceinline__ void a_ready(const Unit&) const {}
    __device__ __forceinline__ void done(const Unit&) const {}
    __device__ __forceinline__ bool half_only(const Unit&) const { return false; }
};

__device__ __forceinline__ unsigned cvt_pk_bf16(float lo, float hi) { unsigned r; asm volatile("v_cvt_pk_bf16_f32 %0, %1, %2" : "=v"(r) : "v"(lo), "v"(hi)); return r; }
typedef float f32x2 __attribute__((ext_vector_type(2)));
__device__ __forceinline__ f32x2 gelu_pk(f32x2 v) {
    const f32x2 av = __builtin_elementwise_abs(v), d = av * 0.2316418882f + 1.0f;
    f32x2 t; t.x = __builtin_amdgcn_rcpf(d.x); t.y = __builtin_amdgcn_rcpf(d.y);
    f32x2 q = t * 0.5307027145f + (-0.7265760135f); q = q * t + 0.7107068705f; q = q * t + (-0.142248368f); q = q * t + 0.127414796f; q = q * t;
    const f32x2 s = (v * v) * (-0.72134752044f);
    f32x2 e; e.x = __builtin_amdgcn_exp2f(s.x); e.y = __builtin_amdgcn_exp2f(s.y);
    const f32x2 m = v * (q * e), r = v - m;
    f32x2 o; o.x = v.x < 0.f ? m.x : r.x; o.y = v.y < 0.f ? m.y : r.y; return o;
}

template <int ACT  > struct EpiBf16 {
    static constexpr bool PERM = true, AFTER_DRAIN = false; static_assert(ACT == 0 || ACT == 1, "EpiBf16: ACT is 0 (none) or 1 (gelu_pk)");
    bf16_t* O; int ldc; const float* bias; int split_cols; size_t split_stride; float scale0;
    __device__ __forceinline__ void operator()(const f32x4 (&acc)[2][2][4][2], const Unit& u, int wr, int wc, int fr, int fq) const {
        const int row0 = u.pm * BM + wr * 64 + fr; int colt = u.pn * BM; bf16_t* base = O;
        float sc = 1.f; if (split_cols) { const int t = colt / split_cols; base += (size_t)t * split_stride; colt -= t * split_cols; if (t == 0) sc = scale0; }
        const int col0 = colt + wc * 32 + 8 * fq, bcol0 = u.pn * BM + wc * 32 + 8 * fq;
        f32x4 bv[2][2];
#pragma unroll
        for (int bj = 0; bj < 2; ++bj)
#pragma unroll
            for (int n = 0; n < 2; ++n) bv[bj][n] = bias ? *(const f32x4*)(bias + bcol0 + bj * HALF + 4 * n) : (f32x4){0.f, 0.f, 0.f, 0.f};
#pragma unroll
        for (int ai = 0; ai < 2; ++ai)
#pragma unroll
            for (int m = 0; m < 4; ++m) { bf16_t* rowp = base + (size_t)(row0 + ai * HALF + m * 16) * ldc + col0;
#pragma unroll
                for (int bj = 0; bj < 2; ++bj) { f32x4 v0 = acc[ai][bj][m][0] + bv[bj][0], v1 = acc[ai][bj][m][1] + bv[bj][1];
                    if (ACT == 1) { f32x2 a = gelu_pk((f32x2){v0[0], v0[1]}), b = gelu_pk((f32x2){v0[2], v0[3]}), c = gelu_pk((f32x2){v1[0], v1[1]}), d = gelu_pk((f32x2){v1[2], v1[3]});
                        v0 = (f32x4){a.x, a.y, b.x, b.y}; v1 = (f32x4){c.x, c.y, d.x, d.y}; }
                    v0 = v0 * sc; v1 = v1 * sc; u32x4 w; w.x = cvt_pk_bf16(v0[0], v0[1]); w.y = cvt_pk_bf16(v0[2], v0[3]); w.z = cvt_pk_bf16(v1[0], v1[1]); w.w = cvt_pk_bf16(v1[2], v1[3]);
                    *(u32x4*)(rowp + bj * HALF) = w; } }
    }
};

template <class Epi, class Sched, bool ALIGN_EPI = false, bool SP2 = false>
__device__ __forceinline__ void gemm_phase(PG8_LAS unsigned char* lds, const Gemm g, const Sched& S, const Epi& E) {
    const int tid = threadIdx.x, wid = __builtin_amdgcn_readfirstlane(tid >> 6), lane = tid & 63, wr = wid >> 2, wc = wid & 3, fr = lane & 15, fq = lane >> 4;
    const int K = g.K, nt = K / BK;
    unsigned voffA[2], voffB[2];
#pragma unroll
    for (int i = 0; i < 2; ++i) { int R, C; stage_rc(tid * 16 + i * 8192, R, C); const int Rb = Epi::PERM ? ((R & ~31) + perm32(R & 31)) : R;
        voffA[i] = (unsigned)(R * K + C) * 2u; voffB[i] = (unsigned)(Rb * K + C) * 2u; }
    const size_t kstep = (size_t)(BK * 2);
    const size_t hstep = (size_t)HALF * K * 2;
    const size_t tstep = 2 * hstep;
    const unsigned ldsw = (unsigned)wid * 1024u;
    const int aoff = lds_byte(wr * 64 + fr, fq * 8), boff = lds_byte(wc * 32 + fr, fq * 8);
#define PG8_SA(b, h) (((b) * 2 + (h)) * HTB)
#define PG8_SB(b, h) ((4 + (b) * 2 + (h)) * HTB)
#define PG8_STAGE(bufoff, gbase, voff) do { _Pragma("unroll") for (int _i = 0; _i < 2; ++_i) \
        __builtin_amdgcn_global_load_lds((const unsigned*)((const char*)(gbase) + (voff)[_i]), (PG8_LAS unsigned*)(lds + (bufoff) + ldsw + _i * 8192), 16, 0, 0); } while (0)
#define PG8_LDA(dst, b, h) do { _Pragma("unroll") for (int m = 0; m < 4; ++m) _Pragma("unroll") for (int k = 0; k < 2; ++k) dst[m][k] = *(const PG8_LAS bf16x8*)(lds + PG8_SA(b, h) + aoff + m * 2048 + k * 1024); } while (0)
#define PG8_LDB(dst, b, h) do { _Pragma("unroll") for (int n = 0; n < 2; ++n) _Pragma("unroll") for (int k = 0; k < 2; ++k) dst[n][k] = *(const PG8_LAS bf16x8*)(lds + PG8_SB(b, h) + boff + n * 2048 + k * 1024); } while (0)
#define PG8_MMA(ai, bj, At, Bt) do { __builtin_amdgcn_s_setprio(1); _Pragma("unroll") for (int m = 0; m < 4; ++m) _Pragma("unroll") for (int n = 0; n < 2; ++n) _Pragma("unroll") for (int k = 0; k < 2; ++k) \
        acc[ai][bj][m][n] = __builtin_amdgcn_mfma_f32_16x16x32_bf16(Bt[n][k], At[m][k], acc[ai][bj][m][n], 0, 0, 0); __builtin_amdgcn_s_setprio(0); } while (0)
#define PG8_WAIT_V(n) asm volatile("s_waitcnt vmcnt(" #n ")" ::: "memory")
#define PG8_WAIT_L(n) asm volatile("s_waitcnt lgkmcnt(" #n ")" ::: "memory")
#define PG8_BAR __builtin_amdgcn_s_barrier()
#define PG8_SCHED __builtin_amdgcn_sched_barrier(0)
    Unit cur, nxt; int ui = 0;
    if (!S.next(0, cur)) return;
    f32x4 acc[2][2][4][2];
    bool both = !S.half_only(cur);
#pragma unroll
    for (int a = 0; a < 2; ++a)
#pragma unroll
        for (int b = 0; b < 2; ++b)
#pragma unroll
            for (int m = 0; m < 4; ++m)
#pragma unroll
                for (int n = 0; n < 2; ++n) acc[a][b][m][n] = (f32x4){0.f, 0.f, 0.f, 0.f};
    bf16x8 At[4][2], B0[2][2], B1[2][2];
    const char* cA = (const char*)g.A + (size_t)cur.pm * tstep; const char* cB = (const char*)g.Bt + (size_t)cur.pn * tstep;
    S.a_ready(cur);
    if constexpr (SP2) {
        PG8_STAGE(PG8_SB(0, 0), cB, voffB); PG8_STAGE(PG8_SB(0, 1), cB + hstep, voffB); PG8_STAGE(PG8_SA(0, 0), cA, voffA); PG8_STAGE(PG8_SA(0, 1), cA + hstep, voffA);
        if (wr == 1) PG8_BAR;
        PG8_WAIT_V(2); PG8_BAR;
        PG8_STAGE(PG8_SB(1, 0), cB + kstep, voffB); PG8_STAGE(PG8_SA(1, 0), cA + kstep, voffA); PG8_STAGE(PG8_SB(1, 1), cB + hstep + kstep, voffB);
        PG8_WAIT_V(6); PG8_BAR;
    } else {
        PG8_STAGE(PG8_SB(0, 0), cB, voffB); PG8_STAGE(PG8_SA(0, 0), cA, voffA); PG8_STAGE(PG8_SB(0, 1), cB + hstep, voffB); PG8_STAGE(PG8_SA(0, 1), cA + hstep, voffA);
        if (wr == 1) PG8_BAR;
        PG8_WAIT_V(4); PG8_BAR;
        PG8_STAGE(PG8_SB(1, 0), cB + kstep, voffB); PG8_STAGE(PG8_SA(1, 0), cA + kstep, voffA); PG8_STAGE(PG8_SB(1, 1), cB + hstep + kstep, voffB);
        PG8_WAIT_V(6); PG8_BAR;
    }
    for (;;) {
        const bool has_next = S.next(ui + 1, nxt);
        const char* nA = has_next ? (const char*)g.A + (size_t)nxt.pm * tstep : cA; const char* nB = has_next ? (const char*)g.Bt + (size_t)nxt.pn * tstep : cB;
        for (int t = 0; t < nt; t += 2) {
            const bool last = (t == nt - 2);
            const char* a1 = cA + (size_t)(t + 1) * kstep;
            const char* a2 = last ? nA : cA + (size_t)(t + 2) * kstep; const char* b2 = last ? nB : cB + (size_t)(t + 2) * kstep;
            const char* a3 = a2 + kstep; const char* b3 = b2 + kstep;
            if (last && has_next) S.a_ready(nxt);
            if constexpr (SP2) {
            PG8_LDB(B0, 0, 0); PG8_LDB(B1, 0, 1); PG8_SCHED; PG8_LDA(At, 0, 0); PG8_STAGE(PG8_SA(1, 1), a1 + hstep, voffA);
            PG8_WAIT_V(8); PG8_WAIT_L(0); PG8_BAR; PG8_MMA(0, 0, At, B0); PG8_MMA(0, 1, At, B1); PG8_BAR; PG8_SCHED;
            PG8_LDA(At, 0, 1); PG8_STAGE(PG8_SB(0, 0), b2, voffB); PG8_STAGE(PG8_SB(0, 1), b2 + hstep, voffB); PG8_STAGE(PG8_SA(0, 0), a2, voffA);
            PG8_WAIT_V(8); PG8_WAIT_L(0); PG8_BAR; if (both) { PG8_MMA(1, 0, At, B0); PG8_MMA(1, 1, At, B1); } PG8_BAR; PG8_SCHED;
            PG8_LDB(B0, 1, 0); PG8_LDB(B1, 1, 1); PG8_SCHED; PG8_LDA(At, 1, 0); PG8_STAGE(PG8_SA(0, 1), a2 + hstep, voffA);
            PG8_WAIT_V(8); PG8_WAIT_L(0); PG8_BAR; PG8_MMA(0, 0, At, B0); PG8_MMA(0, 1, At, B1); PG8_BAR; PG8_SCHED;
            PG8_LDA(At, 1, 1); PG8_STAGE(PG8_SB(1, 0), b3, voffB); PG8_STAGE(PG8_SB(1, 1), b3 + hstep, voffB); PG8_STAGE(PG8_SA(1, 0), a3, voffA);
            PG8_WAIT_V(8); PG8_WAIT_L(0); PG8_BAR; if (both) { PG8_MMA(1, 0, At, B0); PG8_MMA(1, 1, At, B1); } PG8_BAR; PG8_SCHED;
            } else {
            PG8_LDB(B0, 0, 0); PG8_SCHED; PG8_LDA(At, 0, 0); PG8_STAGE(PG8_SA(1, 1), a1 + hstep, voffA);
            PG8_WAIT_L(8); PG8_BAR; PG8_WAIT_L(0); PG8_MMA(0, 0, At, B0); PG8_BAR; PG8_SCHED;
            PG8_LDB(B1, 0, 1); PG8_STAGE(PG8_SB(0, 0), b2, voffB);
            PG8_BAR; PG8_WAIT_L(0); PG8_MMA(0, 1, At, B1); PG8_BAR;
            PG8_LDA(At, 0, 1); PG8_STAGE(PG8_SA(0, 0), a2, voffA);
            PG8_BAR; PG8_WAIT_L(0); PG8_MMA(1, 0, At, B0); PG8_BAR; PG8_SCHED;
            PG8_STAGE(PG8_SB(0, 1), b2 + hstep, voffB);
            PG8_WAIT_V(6); PG8_BAR; PG8_MMA(1, 1, At, B1); PG8_BAR;
            PG8_LDB(B0, 1, 0); PG8_SCHED; PG8_LDA(At, 1, 0); PG8_STAGE(PG8_SA(0, 1), a2 + hstep, voffA);
            PG8_WAIT_L(8); PG8_BAR; PG8_WAIT_L(0); PG8_MMA(0, 0, At, B0); PG8_BAR; PG8_SCHED;
            PG8_LDB(B1, 1, 1); PG8_STAGE(PG8_SB(1, 0), b3, voffB);
            PG8_BAR; PG8_WAIT_L(0); PG8_MMA(0, 1, At, B1); PG8_BAR;
            PG8_LDA(At, 1, 1); PG8_STAGE(PG8_SA(1, 0), a3, voffA);
            PG8_BAR; PG8_WAIT_L(0); PG8_MMA(1, 0, At, B0); PG8_BAR; PG8_SCHED;
            PG8_STAGE(PG8_SB(1, 1), b3 + hstep, voffB);
            PG8_WAIT_V(6); PG8_BAR; PG8_MMA(1, 1, At, B1); PG8_BAR;
            }
        }
        if constexpr (ALIGN_EPI) { if (wr == 0) PG8_BAR; }
        if constexpr (!Epi::AFTER_DRAIN) { E(acc, cur, wr, wc, fr, fq); S.done(cur); }
        if (!has_next) break;
#pragma unroll
        for (int a = 0; a < 2; ++a)
#pragma unroll
            for (int b = 0; b < 2; ++b)
#pragma unroll
                for (int m = 0; m < 4; ++m)
#pragma unroll
                    for (int n = 0; n < 2; ++n) acc[a][b][m][n] = (f32x4){0.f, 0.f, 0.f, 0.f};
        cur = nxt; cA = nA; cB = nB; ++ui; both = !S.half_only(cur);
        if constexpr (ALIGN_EPI) { if (wr == 1) PG8_BAR; }
    }
    PG8_WAIT_V(0);
    if constexpr (!ALIGN_EPI) { if (wr == 0) PG8_BAR; }
    PG8_BAR;
    if constexpr (Epi::AFTER_DRAIN) { E.fused(acc, cur, wr, wc, fr, fq, lds, wid, lane); S.done(cur); }
#undef PG8_SA
#undef PG8_SB
#undef PG8_STAGE
#undef PG8_LDA
#undef PG8_LDB
#undef PG8_MMA
#undef PG8_WAIT_V
#undef PG8_WAIT_L
#undef PG8_BAR
#undef PG8_SCHED
}
}

#ifndef PG8_SP2
#define PG8_SP2 true
#endif

namespace pg8 {
template <class Epi, class Sched>
__device__ __forceinline__ void gemm_phase_gather(PG8_LAS unsigned char* lds, const Gemm g, const Sched& S, const Epi& E, const PG8_LAS unsigned* rofs) {
    const int tid = threadIdx.x, wid = __builtin_amdgcn_readfirstlane(tid >> 6), lane = tid & 63, wr = wid >> 2, wc = wid & 3, fr = lane & 15, fq = lane >> 4;
    const int K = g.K, nt = K / BK;
    unsigned voffB[2]; int RA[2]; unsigned CA[2];
#pragma unroll
    for (int i = 0; i < 2; ++i) { int R, C; stage_rc(tid * 16 + i * 8192, R, C); const int Rb = Epi::PERM ? ((R & ~31) + perm32(R & 31)) : R;
        RA[i] = R; CA[i] = (unsigned)C * 2u; voffB[i] = (unsigned)(Rb * K + C) * 2u; }
    const size_t kstep = (size_t)(BK * 2);
    const size_t hstep = (size_t)HALF * K * 2;
    const size_t tstep = 2 * hstep;
    const unsigned ldsw = (unsigned)wid * 1024u;
    const int aoff = lds_byte(wr * 64 + fr, fq * 8), boff = lds_byte(wc * 32 + fr, fq * 8);
#define PG8_SA(b, h) (((b) * 2 + (h)) * HTB)
#define PG8_SB(b, h) ((4 + (b) * 2 + (h)) * HTB)
#define PG8_STAGE(bufoff, gbase, voff) do { _Pragma("unroll") for (int _i = 0; _i < 2; ++_i) \
        __builtin_amdgcn_global_load_lds((const unsigned*)((const char*)(gbase) + (voff)[_i]), (PG8_LAS unsigned*)(lds + (bufoff) + ldsw + _i * 8192), 16, 0, 0); } while (0)
#define PG8_STAGE_A(bufoff, koff, v0, v1) do { \
        __builtin_amdgcn_global_load_lds((const unsigned*)((const char*)g.A + (koff) + (v0)), (PG8_LAS unsigned*)(lds + (bufoff) + ldsw), 16, 0, 0); \
        __builtin_amdgcn_global_load_lds((const unsigned*)((const char*)g.A + (koff) + (v1)), (PG8_LAS unsigned*)(lds + (bufoff) + ldsw + 8192), 16, 0, 0); } while (0)
#define PG8_LDA(dst, b, h) do { _Pragma("unroll") for (int m = 0; m < 4; ++m) _Pragma("unroll") for (int k = 0; k < 2; ++k) dst[m][k] = *(const PG8_LAS bf16x8*)(lds + PG8_SA(b, h) + aoff + m * 2048 + k * 1024); } while (0)
#define PG8_LDB(dst, b, h) do { _Pragma("unroll") for (int n = 0; n < 2; ++n) _Pragma("unroll") for (int k = 0; k < 2; ++k) dst[n][k] = *(const PG8_LAS bf16x8*)(lds + PG8_SB(b, h) + boff + n * 2048 + k * 1024); } while (0)
#define PG8_MMA(ai, bj, At, Bt) do { __builtin_amdgcn_s_setprio(1); _Pragma("unroll") for (int m = 0; m < 4; ++m) _Pragma("unroll") for (int n = 0; n < 2; ++n) _Pragma("unroll") for (int k = 0; k < 2; ++k) \
        acc[ai][bj][m][n] = __builtin_amdgcn_mfma_f32_16x16x32_bf16(Bt[n][k], At[m][k], acc[ai][bj][m][n], 0, 0, 0); __builtin_amdgcn_s_setprio(0); } while (0)
#define PG8_WAIT_V(n) asm volatile("s_waitcnt vmcnt(" #n ")" ::: "memory")
#define PG8_WAIT_L(n) asm volatile("s_waitcnt lgkmcnt(" #n ")" ::: "memory")
#define PG8_BAR __builtin_amdgcn_s_barrier()
#define PG8_SCHED __builtin_amdgcn_sched_barrier(0)
    Unit cur, nxt; int ui = 0;
    if (!S.next(0, cur)) return;
    f32x4 acc[2][2][4][2];
    bool both = !S.half_only(cur);
#pragma unroll
    for (int a = 0; a < 2; ++a)
#pragma unroll
        for (int b = 0; b < 2; ++b)
#pragma unroll
            for (int m = 0; m < 4; ++m)
#pragma unroll
                for (int n = 0; n < 2; ++n) acc[a][b][m][n] = (f32x4){0.f, 0.f, 0.f, 0.f};
    bf16x8 At[4][2], B0[2][2], B1[2][2];
    const char* cB = (const char*)g.Bt + (size_t)cur.pn * tstep;
    unsigned vc00 = rofs[RA[0]] + CA[0], vc01 = rofs[RA[1]] + CA[1], vc10 = rofs[128 + RA[0]] + CA[0], vc11 = rofs[128 + RA[1]] + CA[1];
    unsigned vn00 = vc00, vn01 = vc01, vn10 = vc10, vn11 = vc11;
    PG8_WAIT_L(0);
    PG8_STAGE(PG8_SB(0, 0), cB, voffB); PG8_STAGE(PG8_SB(0, 1), cB + hstep, voffB); PG8_STAGE_A(PG8_SA(0, 0), 0, vc00, vc01); PG8_STAGE_A(PG8_SA(0, 1), 0, vc10, vc11);
    if (wr == 1) PG8_BAR;
    PG8_WAIT_V(2); PG8_BAR;
    PG8_STAGE(PG8_SB(1, 0), cB + kstep, voffB); PG8_STAGE_A(PG8_SA(1, 0), kstep, vc00, vc01); PG8_STAGE(PG8_SB(1, 1), cB + hstep + kstep, voffB);
    PG8_WAIT_V(6); PG8_BAR;
    for (;;) {
        const bool has_next = S.next(ui + 1, nxt);
        const char* nB = has_next ? (const char*)g.Bt + (size_t)nxt.pn * tstep : cB;
        if (has_next) { const PG8_LAS unsigned* rn = rofs + (ui + 1) * 256; vn00 = rn[RA[0]] + CA[0]; vn01 = rn[RA[1]] + CA[1]; vn10 = rn[128 + RA[0]] + CA[0]; vn11 = rn[128 + RA[1]] + CA[1]; }
        else { vn00 = vc00; vn01 = vc01; vn10 = vc10; vn11 = vc11; }
        for (int t = 0; t < nt; t += 2) {
            const bool last = (t == nt - 2);
            const size_t k1 = (size_t)(t + 1) * kstep;
            const size_t k2 = last ? 0 : (size_t)(t + 2) * kstep; const char* b2 = last ? nB : cB + (size_t)(t + 2) * kstep;
            const size_t k3 = k2 + kstep; const char* b3 = b2 + kstep;
            const unsigned w00 = last ? vn00 : vc00, w01 = last ? vn01 : vc01, w10 = last ? vn10 : vc10, w11 = last ? vn11 : vc11;
            PG8_LDB(B0, 0, 0); PG8_LDB(B1, 0, 1); PG8_SCHED; PG8_LDA(At, 0, 0); PG8_STAGE_A(PG8_SA(1, 1), k1, vc10, vc11);
            PG8_WAIT_V(8); PG8_WAIT_L(0); PG8_BAR; PG8_MMA(0, 0, At, B0); PG8_MMA(0, 1, At, B1); PG8_BAR; PG8_SCHED;
            PG8_LDA(At, 0, 1); PG8_STAGE(PG8_SB(0, 0), b2, voffB); PG8_STAGE(PG8_SB(0, 1), b2 + hstep, voffB); PG8_STAGE_A(PG8_SA(0, 0), k2, w00, w01);
            PG8_WAIT_V(8); PG8_WAIT_L(0); PG8_BAR; if (both) { PG8_MMA(1, 0, At, B0); PG8_MMA(1, 1, At, B1); } PG8_BAR; PG8_SCHED;
            PG8_LDB(B0, 1, 0); PG8_LDB(B1, 1, 1); PG8_SCHED; PG8_LDA(At, 1, 0); PG8_STAGE_A(PG8_SA(0, 1), k2, w10, w11);
            PG8_WAIT_V(8); PG8_WAIT_L(0); PG8_BAR; PG8_MMA(0, 0, At, B0); PG8_MMA(0, 1, At, B1); PG8_BAR; PG8_SCHED;
            PG8_LDA(At, 1, 1); PG8_STAGE(PG8_SB(1, 0), b3, voffB); PG8_STAGE(PG8_SB(1, 1), b3 + hstep, voffB); PG8_STAGE_A(PG8_SA(1, 0), k3, w00, w01);
            PG8_WAIT_V(8); PG8_WAIT_L(0); PG8_BAR; if (both) { PG8_MMA(1, 0, At, B0); PG8_MMA(1, 1, At, B1); } PG8_BAR; PG8_SCHED;
        }
        if (wr == 0) PG8_BAR;
        E(acc, cur, wr, wc, fr, fq); S.done(cur);
        if (!has_next) break;
#pragma unroll
        for (int a = 0; a < 2; ++a)
#pragma unroll
            for (int b = 0; b < 2; ++b)
#pragma unroll
                for (int m = 0; m < 4; ++m)
#pragma unroll
                    for (int n = 0; n < 2; ++n) acc[a][b][m][n] = (f32x4){0.f, 0.f, 0.f, 0.f};
        cur = nxt; cB = nB; ++ui; both = !S.half_only(cur); vc00 = vn00; vc01 = vn01; vc10 = vn10; vc11 = vn11;
        if (wr == 1) PG8_BAR;
    }
    PG8_WAIT_V(0);
    PG8_BAR;
#undef PG8_SA
#undef PG8_SB
#undef PG8_STAGE
#undef PG8_STAGE_A
#undef PG8_LDA
#undef PG8_LDB
#undef PG8_MMA
#undef PG8_WAIT_V
#undef PG8_WAIT_L
#undef PG8_BAR
#undef PG8_SCHED
}
}

constexpr int NB = 2, SEQ = 8192, DM = 1024, NTOK = NB * SEQ;
constexpr int NPROJ = 3072;
constexpr int C_GQ = 0, C_GK = 256, C_GV = 512, C_GR = 1024, C_NQ = 1536, C_KC = 2048, C_VC = 2176, C_KS = 2304, C_VS = 2432, C_KW = 2560, C_VW = 2688, C_GLR = 2816, C_NG = 2832, C_END = 2856;
constexpr int SGW = 2048;
constexpr int NEXP = 16, EHID = 512;
constexpr int MOE_ROWS = 36864;
constexpr float NORM_EPS = 1e-6f;
constexpr float NEGBIG = -1e30f;

constexpr size_t MiB = 1u << 20;
constexpr size_t WS_CTL = 0, CTL_ZERO_BYTES = 1 * MiB;
constexpr size_t WS_MOD = 1 * MiB;
constexpr size_t WS_ROUTE = 2 * MiB;
constexpr size_t WS_GATES = 3 * MiB;
constexpr size_t WS_STATS = 5 * MiB;
constexpr size_t WS_DEC = 7 * MiB;
constexpr size_t WS_WIN = 8 * MiB;
constexpr size_t WS_WOUT = 14 * MiB;
constexpr size_t WS_WINC = 16 * MiB;
constexpr size_t WS_WOUTC = 24 * MiB;
constexpr size_t WS_WCW1 = 28 * MiB;
constexpr size_t WS_WGU = 30 * MiB;
constexpr size_t WS_WDN = 94 * MiB;
constexpr size_t WS_A = 126 * MiB;
constexpr size_t WS_O = 254 * MiB;
constexpr size_t WS_END = 318 * MiB;
constexpr size_t A_HID_OFF = 72 * MiB;
constexpr size_t DO_QN = 0;
constexpr size_t DO_KSEL = 16 * MiB, DO_VSEL = 20 * MiB, DO_KWIN = 24 * MiB, DO_VWIN = 28 * MiB;
constexpr size_t DO_KC = 32 * MiB, DO_VC = 36 * MiB + 65536;
constexpr size_t DO_KCMP = 41 * MiB, DO_VCMP = 41 * MiB + 512 * 1024;

constexpr int CW_TMO = 0, CW_CODE = 1;
constexpr int CW_BAR = 4096;
constexpr int CW_CNT = 16384;

constexpr int RING_OFF = 0, RING_BYTES = 131072;
constexpr int LDSCTL_OFF = RING_BYTES, MISC_OFF = LDSCTL_OFF + 320;
constexpr int TAB_OFF = LDSCTL_OFF + 1024;
constexpr int LDS_BYTES = 147456;

#define GAS __attribute__((address_space(1)))
#define LAS __attribute__((address_space(3)))
typedef unsigned short bf16;
typedef unsigned v4u __attribute__((ext_vector_type(4)));
typedef unsigned v2u __attribute__((ext_vector_type(2)));
typedef float f32x4 __attribute__((ext_vector_type(4)));
typedef float f32x2 __attribute__((ext_vector_type(2)));
typedef float f32x16 __attribute__((ext_vector_type(16)));
typedef short bf16x8 __attribute__((ext_vector_type(8)));
typedef short s16x4 __attribute__((ext_vector_type(4)));
typedef GAS unsigned gu32;
#define RLX_AGENT __ATOMIC_RELAXED, __HIP_MEMORY_SCOPE_AGENT
#define LDS_WAIT() asm volatile("s_waitcnt lgkmcnt(0)" ::: "memory")
#define VM_WAIT() asm volatile("s_waitcnt vmcnt(0)" ::: "memory")
__device__ __forceinline__ unsigned f2bf(float f) { unsigned u = __builtin_bit_cast(unsigned, f); return (u + 0x7fffu + ((u >> 16) & 1u)) >> 16; }
__device__ __forceinline__ unsigned pk2(float lo, float hi) { return f2bf(lo) | (f2bf(hi) << 16); }
__device__ __forceinline__ float bf2f(unsigned short b) { return __builtin_bit_cast(float, (unsigned)b << 16); }
__device__ __forceinline__ float bflo(unsigned w) { return __builtin_bit_cast(float, w << 16); }
__device__ __forceinline__ float bfhi(unsigned w) { return __builtin_bit_cast(float, w & 0xffff0000u); }
__device__ __forceinline__ float fexp2(float x) { return __builtin_amdgcn_exp2f(x); }
__device__ __forceinline__ float fexp(float x) { return __builtin_amdgcn_exp2f(x * 1.4426950408889634f); }
__device__ __forceinline__ float frcp(float x) { return __builtin_amdgcn_rcpf(x); }
__device__ __forceinline__ float sigmoidf_(float x) { return frcp(1.0f + __expf(-x)); }
__device__ __forceinline__ float siluf_(float x) { return x * frcp(1.0f + __expf(-x)); }
__device__ __forceinline__ float gelu_tanh(float x) {
    const float u = 0.7978845608028654f * (x + 0.044715f * x * x * x);
    return x * frcp(1.0f + __expf(-2.0f * u));
}
__device__ __forceinline__ float dpp_xor1(float v) { return __builtin_bit_cast(float, __builtin_amdgcn_mov_dpp(__builtin_bit_cast(int, v), 0xB1, 0xF, 0xF, true)); }
__device__ __forceinline__ float dpp_xor2(float v) { return __builtin_bit_cast(float, __builtin_amdgcn_mov_dpp(__builtin_bit_cast(int, v), 0x4E, 0xF, 0xF, true)); }
__device__ __forceinline__ float wave_sum(float v) {
#pragma unroll
    for (int o = 1; o < 64; o <<= 1) v += __shfl_xor(v, o);
    return v;
}
__device__ __forceinline__ void unpack8(const v4u w, float (&f)[8]) {
    f[0] = bflo(w.x); f[1] = bfhi(w.x); f[2] = bflo(w.y); f[3] = bfhi(w.y); f[4] = bflo(w.z); f[5] = bfhi(w.z); f[6] = bflo(w.w); f[7] = bfhi(w.w);
}
__device__ __forceinline__ v4u pack8(const float (&f)[8]) { v4u w; w.x = pk2(f[0], f[1]); w.y = pk2(f[2], f[3]); w.z = pk2(f[4], f[5]); w.w = pk2(f[6], f[7]); return w; }

#define XB_TMO      128
#define XB_XCNT(j)  (256  + 64 * (j))
#define XB_XSUB(j)  (1280 + 64 * (j))
#define XB_XGEN(j)  (2304 + 64 * (j))
#define XB_TOP      3328
#define XB_TOPGEN   3392
#define XCD_BAR_WORDS 3456
#define XB_SPIN_CAP (1u << 18)

__device__ __forceinline__ unsigned xb_ld(unsigned* p)              { return __hip_atomic_load(p, __ATOMIC_RELAXED, __HIP_MEMORY_SCOPE_AGENT); }
__device__ __forceinline__ unsigned xb_add(unsigned* p, unsigned v) { return __hip_atomic_fetch_add(p, v, __ATOMIC_RELAXED, __HIP_MEMORY_SCOPE_AGENT); }
__device__ __forceinline__ unsigned xb_xcc_id() { return (unsigned)__builtin_amdgcn_s_getreg((3 << 11) | 20) & 0xFu; }
#define XB_SPIN(cond, bar) do { unsigned _sp = 0; while (cond) { __builtin_amdgcn_s_sleep(1); \
    if ((++_sp & 255u) == 0u) { if (xb_ld(&(bar)[XB_TMO])) break; if (_sp > XB_SPIN_CAP) { atomicAdd(&(bar)[XB_TMO], 1u); break; } } } } while (0)

struct XcdBarrier {
    unsigned* bar; unsigned x;
    volatile LAS unsigned* st;
};
__device__ __forceinline__ XcdBarrier xcd_barrier_post(unsigned* bar, volatile LAS unsigned* st) {
    XcdBarrier b; b.bar = bar; b.x = xb_xcc_id(); b.st = st;
    if (threadIdx.x == 0) (void)xb_add(&bar[XB_XCNT(b.x)], 1u);
    return b;
}
__device__ __forceinline__ void xcd_barrier_complete(unsigned* bar, unsigned x, unsigned& nloc, unsigned& nx) {
    const unsigned G = gridDim.x * gridDim.y * gridDim.z;
    unsigned sum, cnt, mine, sp = 0u;
    for (;;) {
        sum = 0u; cnt = 0u; mine = 0u;
#pragma unroll
        for (unsigned j = 0; j < 16; ++j) { const unsigned c = xb_ld(&bar[XB_XCNT(j)]); sum += c; cnt += (c > 0u) ? 1u : 0u; mine = (j == x) ? c : mine; }
        if (sum == G) break;
        __builtin_amdgcn_s_sleep(1);
        if ((++sp & 255u) == 0u) { if (xb_ld(&bar[XB_TMO])) break; if (sp > XB_SPIN_CAP) { atomicAdd(&bar[XB_TMO], 1u); break; } }
    }
    nloc = mine > 0u ? mine : 1u; nx = cnt > 0u ? cnt : 1u;
}
__device__ __forceinline__ void xcd_barrier(const XcdBarrier& b) {
    asm volatile("s_waitcnt vmcnt(0)" ::: "memory");
    __syncthreads();
    if (threadIdx.x == 0) {
        unsigned* bar = b.bar;
        __builtin_amdgcn_s_waitcnt(0);
        unsigned nloc = b.st[0], nx = b.st[1];
        if (nloc == 0u) { xcd_barrier_complete(bar, b.x, nloc, nx); b.st[0] = nloc; b.st[1] = nx; }
        const unsigned old = xb_add(&bar[XB_XSUB(b.x)], 1u);
        const unsigned gen = old / nloc;
        if (old + 1u == (gen + 1u) * nloc) {
            __builtin_amdgcn_fence(__ATOMIC_RELEASE, "agent");
            asm volatile("s_waitcnt vmcnt(0)" ::: "memory");
            const unsigned og = xb_add(&bar[XB_TOP], 1u);
            const unsigned tg = og / nx;
            if (og + 1u == (tg + 1u) * nx) xb_add(&bar[XB_TOPGEN], 1u);
            else XB_SPIN(xb_ld(&bar[XB_TOPGEN]) == tg, bar);
            __builtin_amdgcn_fence(__ATOMIC_ACQUIRE, "agent");
            xb_add(&bar[XB_XGEN(b.x)], 1u);
            asm volatile("s_waitcnt vmcnt(0)" ::: "memory");
        } else {
            XB_SPIN(xb_ld(&bar[XB_XGEN(b.x)]) == gen, bar);
            __builtin_amdgcn_fence(__ATOMIC_ACQUIRE, "agent");
            asm volatile("s_waitcnt vmcnt(0)" ::: "memory");
        }
    }
    __syncthreads();
}

struct Frame {
    LAS unsigned char* lds;
    volatile LAS unsigned* MISC;
    gu32* ctl;
    int tid, lane, wave;
    int bid, G;
    unsigned char* ws;
    unsigned char* dout_b;
    float* out;
    const float *x, *c, *w_ada, *b_ada, *norm_g, *w_in_ab, *w_out_ab, *gla_w2, *gla_bg, *gla_ng, *q_gain, *k_gain, *cmp_pe, *cmp_w1, *cmp_w2, *w_in_c, *sgu_ng, *sgu_ws, *sgu_bs, *w_out_c, *w_router, *r_bias, *w_gate, *w_up, *w_down;
    const int* positions;
};

struct EpiResid {
    static constexpr bool PERM = false, AFTER_DRAIN = false;
    const float* xin; float* xout; const float* gate;
    __device__ __forceinline__ void operator()(const pg8::f32x4 (&acc)[2][2][4][2], const pg8::Unit& u, int wr, int wc, int fr, int fq) const {
        const int row0 = u.pm * 256 + wr * 64 + fr, col0 = u.pn * 256 + wc * 32 + 4 * fq;
        const float* gb = gate + ((u.pm * 256 >= SEQ) ? 6144 : 0);
        f32x4 gv[2][2];
#pragma unroll
        for (int bj = 0; bj < 2; ++bj)
#pragma unroll
            for (int n = 0; n < 2; ++n) gv[bj][n] = *(const f32x4*)(gb + col0 + bj * 128 + n * 16);
#pragma unroll
        for (int ai = 0; ai < 2; ++ai)
#pragma unroll
            for (int m = 0; m < 4; ++m) {
                const size_t rb = (size_t)(row0 + ai * 128 + m * 16) * DM;
#pragma unroll
                for (int bj = 0; bj < 2; ++bj)
#pragma unroll
                    for (int n = 0; n < 2; ++n) {
                        const size_t p = rb + col0 + bj * 128 + n * 16;
                        const f32x4 xi = *(const f32x4*)(xin + p);
                        *(f32x4*)(xout + p) = xi + gv[bj][n] * acc[ai][bj][m][n];
                    }
            }
    }
};
struct EpiGeluStats {
    static constexpr bool PERM = true, AFTER_DRAIN = false;
    bf16* Z; float* stats;
    __device__ __forceinline__ void operator()(const pg8::f32x4 (&acc)[2][2][4][2], const pg8::Unit& u, int wr, int wc, int fr, int fq) const {
        const int row0 = u.pm * 256 + wr * 64 + fr, col0 = u.pn * 256 + wc * 32 + 8 * fq;
#pragma unroll
        for (int ai = 0; ai < 2; ++ai)
#pragma unroll
            for (int m = 0; m < 4; ++m) {
                const int row = row0 + ai * 128 + m * 16; float ss = 0.f;
#pragma unroll
                for (int bj = 0; bj < 2; ++bj) {
                    float g[8];
#pragma unroll
                    for (int n = 0; n < 2; ++n)
#pragma unroll
                        for (int i = 0; i < 4; ++i) { g[n * 4 + i] = gelu_tanh(acc[ai][bj][m][n][i]); ss += g[n * 4 + i] * g[n * 4 + i]; }
                    *(v4u*)(Z + (size_t)row * 4096 + col0 + bj * 128) = pack8(g);
                }
                if (u.pn >= 8) {
                    ss += __shfl_xor(ss, 16); ss += __shfl_xor(ss, 32);
                    if (fq == 0) stats[(size_t)row * 32 + (u.pn - 8) * 4 + wc] = ss;
                }
            }
    }
};
struct EpiMoeGU {
    static constexpr bool PERM = true, AFTER_DRAIN = false;
    bf16* HID;
    __device__ __forceinline__ void operator()(const pg8::f32x4 (&acc)[2][2][4][2], const pg8::Unit& u, int wr, int wc, int fr, int fq) const {
        const int row0 = u.pm * 256 + wr * 64 + fr, col0 = (u.pn & 3) * 128 + wc * 32 + 8 * fq;
#pragma unroll
        for (int ai = 0; ai < 2; ++ai)
#pragma unroll
            for (int m = 0; m < 4; ++m) {
                float h[8];
#pragma unroll
                for (int n = 0; n < 2; ++n)
#pragma unroll
                    for (int i = 0; i < 4; ++i) h[n * 4 + i] = siluf_(acc[ai][0][m][n][i]) * acc[ai][1][m][n][i];
                *(v4u*)(HID + (size_t)(row0 + ai * 128 + m * 16) * EHID + col0) = pack8(h);
            }
    }
};
struct EpiMoeDn {
    static constexpr bool PERM = true, AFTER_DRAIN = false;
    bf16* YM;
    __device__ __forceinline__ void operator()(const pg8::f32x4 (&acc)[2][2][4][2], const pg8::Unit& u, int wr, int wc, int fr, int fq) const {
        const int row0 = u.pm * 256 + wr * 64 + fr, col0 = (u.pn & 3) * 256 + wc * 32 + 8 * fq;
#pragma unroll
        for (int ai = 0; ai < 2; ++ai)
#pragma unroll
            for (int m = 0; m < 4; ++m)
#pragma unroll
                for (int bj = 0; bj < 2; ++bj) {
                    float h[8];
#pragma unroll
                    for (int n = 0; n < 2; ++n)
#pragma unroll
                        for (int i = 0; i < 4; ++i) h[n * 4 + i] = acc[ai][bj][m][n][i];
                    *(v4u*)(YM + (size_t)(row0 + ai * 128 + m * 16) * DM + col0 + bj * 128) = pack8(h);
                }
    }
};
struct MoeOrder {
    const LAS int* ppre; int G, c;
    __device__ __forceinline__ unsigned row_off(const pg8::Unit& u, int r, const int* elist) const {
        const int e = u.pn >> 2, li = (u.pm - ppre[e]) * 256 + r;
        const int tok = (li < ppre[32 + e]) ? elist[e * 16384 + li] : 0;
        return (unsigned)tok * 2048u;
    }
    __device__ __forceinline__ int xcd_units(int x) const { return 4 * (ppre[2 * x + 2] - ppre[2 * x]); }
    __device__ __forceinline__ bool next(int i, pg8::Unit& u) const {
        const int x = c & 7, r = c >> 3, Ll = i * 32 + r;
        if (Ll >= xcd_units(x)) return false;
        const int pm = ppre[2 * x] + (Ll >> 2);
        u.pm = pm; u.pn = ((pm >= ppre[2 * x + 1]) ? 2 * x + 1 : 2 * x) * 4 + (Ll & 3); return true;
    }
    __device__ __forceinline__ void a_ready(const pg8::Unit&) const {}
    __device__ __forceinline__ void done(const pg8::Unit&) const {}
    __device__ __forceinline__ bool half_only(const pg8::Unit& u) const { const int e = u.pn >> 2; return (u.pm - ppre[e]) * 256 + 128 >= ppre[32 + e]; }
};

__device__ __forceinline__ int dest_row(int mode, int n) {
    if (mode == 1) return (n < 1024) ? n : (n < 1040) ? n + 1792 : (n < 2832) ? n - 16 : n;
    if (mode == 2) return (n >> 7) * 256 + (n & 127);
    if (mode == 3) return (n >> 7) * 256 + 128 + (n & 127);
    return n;
}
struct TrItem { const float* src; bf16* dst; int K, N, mode, r; };
__device__ __forceinline__ int tr_count(int set) { return set == 0 ? (720 + 256 + 256 + 3 * 2048) : set == 1 ? (1024 + 512 + 2048 + 1024) : (1024 + 2048); }
__device__ __forceinline__ bool tr_decode(Frame& F, int set, int it, TrItem& t) {
    if (it >= tr_count(set)) return false;
    int r = it; t.mode = 0;
    if (set == 0) {
        constexpr int I_IN = 16 * 45, I_OUT = 16 * 16, I_CW1 = 2 * 32 * 4, I_E = 16 * 128;
        if (r < I_IN) { t.src = F.w_in_ab; t.dst = (bf16*)(F.ws + WS_WIN); t.K = 1024; t.N = 2856; t.mode = 1; }
        else if ((r -= I_IN) < I_OUT) { t.src = F.w_out_ab; t.dst = (bf16*)(F.ws + WS_WOUT); t.K = 1024; t.N = 1024; }
        else if ((r -= I_OUT) < I_CW1) { const int m = r >> 7; r &= 127; t.src = F.cmp_w1 + (size_t)m * 2048 * 256; t.dst = (bf16*)(F.ws + WS_WCW1) + (size_t)m * 256 * 2048; t.K = 2048; t.N = 256; }
        else if ((r -= I_CW1) < I_E) { const int m = r >> 7; r &= 127; t.src = F.w_gate + (size_t)m * 1024 * 512; t.dst = (bf16*)(F.ws + WS_WGU) + (size_t)m * 1024 * 1024; t.K = 1024; t.N = 512; t.mode = 2; }
        else if ((r -= I_E) < I_E) { const int m = r >> 7; r &= 127; t.src = F.w_up + (size_t)m * 1024 * 512; t.dst = (bf16*)(F.ws + WS_WGU) + (size_t)m * 1024 * 1024; t.K = 1024; t.N = 512; t.mode = 3; }
        else { r -= I_E; const int m = r >> 7; r &= 127; t.src = F.w_down + (size_t)m * 512 * 1024; t.dst = (bf16*)(F.ws + WS_WDN) + (size_t)m * 1024 * 512; t.K = 512; t.N = 1024; }
    } else if (set == 1) {
        constexpr int I_INC = 16 * 64, I_OUTC = 32 * 16;
        if (r < I_INC) { t.src = F.w_in_c; t.dst = (bf16*)(F.ws + WS_WINC); t.K = 1024; t.N = 4096; }
        else if ((r -= I_INC) < I_OUTC) { t.src = F.w_out_c; t.dst = (bf16*)(F.ws + WS_WOUTC); t.K = 2048; t.N = 1024; }
        else if ((r -= I_OUTC) < 2048) { const int m = 16 + (r >> 7); r &= 127; t.src = F.w_gate + (size_t)m * 1024 * 512; t.dst = (bf16*)(F.ws + WS_WGU) + (size_t)m * 1024 * 1024; t.K = 1024; t.N = 512; t.mode = 2; }
        else { r -= 2048; const int m = 16 + (r >> 7); r &= 127; t.src = F.w_up + (size_t)m * 1024 * 512; t.dst = (bf16*)(F.ws + WS_WGU) + (size_t)m * 1024 * 1024; t.K = 1024; t.N = 512; t.mode = 3; }
    } else {
        constexpr int I_E = 8 * 128;
        if (r < I_E) { const int m = 24 + (r >> 7); r &= 127; t.src = F.w_up + (size_t)m * 1024 * 512; t.dst = (bf16*)(F.ws + WS_WGU) + (size_t)m * 1024 * 1024; t.K = 1024; t.N = 512; t.mode = 3; }
        else { r -= I_E; const int m = 16 + (r >> 7); r &= 127; t.src = F.w_down + (size_t)m * 512 * 1024; t.dst = (bf16*)(F.ws + WS_WDN) + (size_t)m * 1024 * 512; t.K = 512; t.N = 1024; }
    }
    t.r = r; return true;
}
__device__ __forceinline__ void tr_load(const TrItem& t, int lane, f32x4 (&va)[8], f32x4 (&vb)[8]) {
    const int nblk = (t.N + 63) / 64, kb = t.r / nblk, nb = t.r % nblk, k0 = 64 * kb, n0 = 64 * nb;
    const int q = lane & 15, r4 = lane >> 4, col = n0 + 4 * q;
    const float* wp = t.src + (size_t)(k0 + 2 * r4) * t.N + col;
#pragma unroll
    for (int i = 0; i < 8; ++i) {
        if (col < t.N) { va[i] = *(const f32x4*)(wp + (size_t)(8 * i) * t.N); vb[i] = *(const f32x4*)(wp + (size_t)(8 * i + 1) * t.N); }
        else { va[i] = (f32x4){0.f, 0.f, 0.f, 0.f}; vb[i] = va[i]; }
    }
}
__device__ __forceinline__ void tr_finish(const TrItem& t, int lane, const f32x4 (&va)[8], const f32x4 (&vb)[8], LAS unsigned char* scr) {
    const int nblk = (t.N + 63) / 64, kb = t.r / nblk, nb = t.r % nblk, k0 = 64 * kb, n0 = 64 * nb;
    const int q = lane & 15, r4 = lane >> 4;
#pragma unroll
    for (int i = 0; i < 8; ++i) {
        const int kp = 4 * i + r4;
        LAS unsigned* tt = (LAS unsigned*)(scr + (4 * q) * 144 + 4 * kp);
        tt[0] = pk2(va[i].x, vb[i].x); tt[36] = pk2(va[i].y, vb[i].y); tt[72] = pk2(va[i].z, vb[i].z); tt[108] = pk2(va[i].w, vb[i].w);
    }
    LDS_WAIT(); asm volatile("" ::: "memory");
    const int c = lane & 7;
#pragma unroll
    for (int j = 0; j < 8; ++j) { const int n = (lane >> 3) + 8 * j;
        const v4u o = *(const LAS v4u*)(scr + n * 144 + 16 * c);
        if (n0 + n < t.N) *(GAS v4u*)(t.dst + (size_t)dest_row(t.mode, n0 + n) * t.K + k0 + 8 * c) = o; }
    LDS_WAIT(); asm volatile("" ::: "memory");
}
__device__ __forceinline__ void tr_run(Frame& F, int set, int w0, int nw) {
    LAS unsigned char* scr = F.lds + RING_OFF + 8192 + F.wave * 12288;
    TrItem ta, tb, td; f32x4 a0[8], a1[8], b0[8], b1[8];
    (void)tr_decode(F, set, 0, td);
    int it = w0; bool ha = tr_decode(F, set, it, ta);
    if (!ha) return;
    tr_load(ta, F.lane, a0, a1);
    while (ha) {
        const bool hb = tr_decode(F, set, it + nw, tb);
        if (!hb) tb = td;
        tr_load(tb, F.lane, b0, b1);
        tr_finish(ta, F.lane, a0, a1, scr);
        if (!hb) break;
        it += 2 * nw; ha = tr_decode(F, set, it, ta);
        if (!ha) ta = td;
        tr_load(ta, F.lane, a0, a1);
        tr_finish(tb, F.lane, b0, b1, scr);
    }
}
__device__ __forceinline__ void p0_prologue(Frame& F) {
    LAS float* red = (LAS float*)(F.lds + RING_OFF);
    float* mod = (float*)(F.ws + WS_MOD);
    float* bias1 = (float*)(F.ws + WS_MOD + 131072);
    for (int bi = F.bid; bi < 200; bi += F.G) {
        if (bi < 192) {
            const int l = bi / 96, cg = bi % 96, j = cg * 64 + F.lane;
            float a0 = 0.f, a1 = 0.f;
            const float* wp = F.w_ada + ((size_t)l * 1024 + F.wave * 128) * 6144 + j;
#pragma unroll 16
            for (int k = 0; k < 128; ++k) { const float wv = wp[(size_t)k * 6144]; const float c0 = F.c[F.wave * 128 + k], c1 = F.c[1024 + F.wave * 128 + k];
                a0 += siluf_(c0) * wv; a1 += siluf_(c1) * wv; }
            red[(F.wave * 2 + 0) * 64 + F.lane] = a0; red[(F.wave * 2 + 1) * 64 + F.lane] = a1;
            __syncthreads();
            if (F.tid < 128) { const int b = F.tid >> 6, ln = F.tid & 63; float s = 0.f;
#pragma unroll
                for (int w = 0; w < 8; ++w) s += red[(w * 2 + b) * 64 + ln];
                mod[(size_t)(l * 2 + b) * 6144 + cg * 64 + ln] = s + F.b_ada[l * 6144 + cg * 64 + ln]; }
            __syncthreads();
        } else {
            const int kv = (bi - 192) >> 2, cg = (bi - 192) & 3, j = cg * 64 + F.lane;
            float a0 = 0.f;
            const float* wp = F.cmp_w1 + ((size_t)kv * 2048 + F.wave * 256) * 256 + j; const float* pe = F.cmp_pe + kv * 2048 + F.wave * 256;
#pragma unroll 16
            for (int k = 0; k < 256; ++k) a0 += pe[k] * wp[(size_t)k * 256];
            red[F.wave * 64 + F.lane] = a0;
            __syncthreads();
            if (F.tid < 64) { float s = 0.f;
#pragma unroll
                for (int w = 0; w < 8; ++w) s += red[w * 64 + F.tid];
                bias1[kv * 256 + cg * 64 + F.tid] = s; }
            __syncthreads();
        }
    }
    { bf16* wi = (bf16*)(F.ws + WS_WIN); const int npieces = (NPROJ - C_END) * (DM / 8);
      for (int p = F.bid * 512 + F.tid; p < npieces; p += F.G * 512) *(GAS v4u*)(wi + (size_t)C_END * DM + (size_t)p * 8) = (v4u){0u, 0u, 0u, 0u}; }
    const int gw = F.bid * 8 + F.wave, NGW = F.G * 8;
    tr_run(F, 0, gw, NGW);
}


struct RouteRec { int e0, e1, pos0, pos1; float w0, w1; int slot0, slot1; };
__device__ __forceinline__ float route_reduce(const float (&a16)[16], int lane) {
    float r8[8], r4[4], r2[2];
    { const bool hb = (lane & 32) != 0;
#pragma unroll
      for (int i = 0; i < 8; ++i) { const float keep = hb ? a16[8 + i] : a16[i], send = hb ? a16[i] : a16[8 + i]; r8[i] = keep + __shfl_xor(send, 32); } }
    { const bool hb = (lane & 16) != 0;
#pragma unroll
      for (int i = 0; i < 4; ++i) { const float keep = hb ? r8[4 + i] : r8[i], send = hb ? r8[i] : r8[4 + i]; r4[i] = keep + __shfl_xor(send, 16); } }
    { const bool hb = (lane & 8) != 0;
#pragma unroll
      for (int i = 0; i < 2; ++i) { const float keep = hb ? r4[2 + i] : r4[i], send = hb ? r4[i] : r4[2 + i]; r2[i] = keep + __shfl_xor(send, 8); } }
    float lgo; { const bool hb = (lane & 4) != 0; const float keep = hb ? r2[1] : r2[0], send = hb ? r2[0] : r2[1]; lgo = keep + __shfl_xor(send, 4); }
    lgo += dpp_xor1(lgo); lgo += dpp_xor2(lgo);
    return lgo;
}
__device__ __forceinline__ void route_decide(Frame& F, float lgo, LAS unsigned* lcnt, LAS int* rs) {
    const int eown = ((F.lane >> 5) & 1) * 8 + ((F.lane >> 4) & 1) * 4 + ((F.lane >> 3) & 1) * 2 + ((F.lane >> 2) & 1);
    const float sco = frcp(1.0f + __expf(-lgo)), slo = sco + F.r_bias[eown];
    float sc[16], sl[16];
#pragma unroll
    for (int e = 0; e < 16; ++e) { const int src = (e >> 3) * 32 + ((e >> 2) & 1) * 16 + ((e >> 1) & 1) * 8 + (e & 1) * 4;
        sc[e] = __builtin_bit_cast(float, __builtin_amdgcn_readlane(__builtin_bit_cast(int, sco), src)); sl[e] = __builtin_bit_cast(float, __builtin_amdgcn_readlane(__builtin_bit_cast(int, slo), src)); }
    float gs[4]; int ge1[4], ge2[4]; float gw1[4], gw2[4];
#pragma unroll
    for (int g = 0; g < 4; ++g) {
        int i1 = 0; float m1 = sl[4 * g];
#pragma unroll
        for (int k = 1; k < 4; ++k) if (sl[4 * g + k] > m1) { m1 = sl[4 * g + k]; i1 = k; }
        int i2 = -1; float m2 = 0.f;
#pragma unroll
        for (int k = 0; k < 4; ++k) if (k != i1 && (i2 < 0 || sl[4 * g + k] > m2)) { m2 = sl[4 * g + k]; i2 = k; }
        gs[g] = m1 + m2; ge1[g] = 4 * g + i1; ge2[g] = 4 * g + i2;
        float w1 = 0.f, w2 = 0.f;
#pragma unroll
        for (int k = 0; k < 4; ++k) { w1 = (k == i1) ? sc[4 * g + k] : w1; w2 = (k == i2) ? sc[4 * g + k] : w2; }
        gw1[g] = w1; gw2[g] = w2;
    }
    int gi = 0; float gm = gs[0];
#pragma unroll
    for (int g = 1; g < 4; ++g) if (gs[g] > gm) { gm = gs[g]; gi = g; }
    int e1 = ge1[0], e2 = ge2[0]; float w1 = gw1[0], w2 = gw2[0];
#pragma unroll
    for (int g = 1; g < 4; ++g) if (gi == g) { e1 = ge1[g]; e2 = ge2[g]; w1 = gw1[g]; w2 = gw2[g]; }
    const float ws_ = w1 + w2;
    if (F.lane == 0) {
        const int p0 = (int)__hip_atomic_fetch_add(lcnt + e1, 1u, __ATOMIC_RELAXED, __HIP_MEMORY_SCOPE_WORKGROUP);
        const int p1 = (int)__hip_atomic_fetch_add(lcnt + e2, 1u, __ATOMIC_RELAXED, __HIP_MEMORY_SCOPE_WORKGROUP);
        rs[0] = e1; rs[1] = e2; rs[2] = p0; rs[3] = p1; rs[4] = __float_as_int(w1 / ws_); rs[5] = __float_as_int(w2 / ws_);
    }
}
__device__ __forceinline__ void router_pass(Frame& F, const float* xin, const float* modn  , const float* ng, int layer) {
    bf16* H = (bf16*)(F.ws + WS_O);
    RouteRec* route = (RouteRec*)(F.ws + WS_ROUTE);
    int* elist = (int*)(F.ws + WS_STATS);
    LAS float* wr = (LAS float*)(F.lds + RING_OFF);
    LAS unsigned* lcnt = (LAS unsigned*)(F.lds + TAB_OFF + 256);
    LAS int* recs = (LAS int*)(F.lds + TAB_OFF + 8192);
    for (int idx = F.tid; idx < 16384; idx += 512) wr[(idx & 15) * 1024 + (idx >> 4)] = F.w_router[idx];
    if (F.tid < 32) lcnt[F.tid] = 0u;
    __syncthreads();
    const int gw = F.bid * 8 + F.wave, NGW = F.G * 8;
    f32x4 cs[4], sh[4], nA[4], nB[4];
    int bcur = -1;
#define RT_PREFETCH(kp_) do { const size_t ma_ = (size_t)gw + (size_t)(2 * (kp_)) * NGW; \
        _Pragma("unroll") for (int j = 0; j < 4; ++j) { nA[j] = *(const f32x4*)(xin + ma_ * DM + 4 * F.lane + 256 * j); nB[j] = *(const f32x4*)(xin + (ma_ + NGW) * DM + 4 * F.lane + 256 * j); } } while (0)
    RT_PREFETCH(0);
#pragma unroll 1
    for (int kp = 0; kp < 4; ++kp) {
        const int mA = gw + 2 * kp * NGW, mB = mA + NGW;
        f32x4 vA[4], vB[4];
#pragma unroll
        for (int j = 0; j < 4; ++j) { vA[j] = nA[j]; vB[j] = nB[j]; }
        if (kp + 1 < 4) RT_PREFETCH(kp + 1);
        const int b = mA >> 13;
        if (b != bcur) { bcur = b;
#pragma unroll
            for (int j = 0; j < 4; ++j) { const int col = 4 * F.lane + 256 * j;
                const f32x4 g = *(const f32x4*)(ng + col), sc = *(const f32x4*)(modn + b * 6144 + 4 * 1024 + col); cs[j] = g * (sc + 1.0f); sh[j] = *(const f32x4*)(modn + b * 6144 + 3 * 1024 + col); } }
        float sA = 0.f, sB = 0.f;
#pragma unroll
        for (int j = 0; j < 4; ++j) { sA += (vA[j].x * vA[j].x + vA[j].y * vA[j].y) + (vA[j].z * vA[j].z + vA[j].w * vA[j].w); sB += (vB[j].x * vB[j].x + vB[j].y * vB[j].y) + (vB[j].z * vB[j].z + vB[j].w * vB[j].w); }
#pragma unroll
        for (int o = 1; o < 64; o <<= 1) { sA += __shfl_xor(sA, o); sB += __shfl_xor(sB, o); }
        const float rA = 1.0f / sqrtf(sA * (1.0f / DM) + NORM_EPS), rB = 1.0f / sqrtf(sB * (1.0f / DM) + NORM_EPS);
#pragma unroll
        for (int j = 0; j < 4; ++j) {
            vA[j] = vA[j] * rA * cs[j] + sh[j]; vB[j] = vB[j] * rB * cs[j] + sh[j];
            v2u oA, oB; oA.x = pk2(vA[j].x, vA[j].y); oA.y = pk2(vA[j].z, vA[j].w); oB.x = pk2(vB[j].x, vB[j].y); oB.y = pk2(vB[j].z, vB[j].w);
            *(v2u*)(H + (size_t)mA * DM + 4 * F.lane + 256 * j) = oA; *(v2u*)(H + (size_t)mB * DM + 4 * F.lane + 256 * j) = oB;
        }
        float aA[16], aB[16];
#pragma unroll
        for (int eg = 0; eg < 4; ++eg) {
            float a4[4] = {0.f, 0.f, 0.f, 0.f}, b4[4] = {0.f, 0.f, 0.f, 0.f};
#pragma unroll
            for (int j = 0; j < 4; ++j)
#pragma unroll
                for (int ee = 0; ee < 4; ++ee) { const f32x4 w = *(const LAS f32x4*)(wr + (eg * 4 + ee) * 1024 + 4 * F.lane + 256 * j);
                    a4[ee] += (vA[j].x * w.x + vA[j].y * w.y) + (vA[j].z * w.z + vA[j].w * w.w); b4[ee] += (vB[j].x * w.x + vB[j].y * w.y) + (vB[j].z * w.z + vB[j].w * w.w); }
#pragma unroll
            for (int ee = 0; ee < 4; ++ee) { aA[eg * 4 + ee] = a4[ee]; aB[eg * 4 + ee] = b4[ee]; }
            __builtin_amdgcn_sched_barrier(0);
        }
        const float lgA = route_reduce(aA, F.lane), lgB = route_reduce(aB, F.lane);
        route_decide(F, lgA, lcnt, recs + (F.wave * 8 + 2 * kp) * 8);
        route_decide(F, lgB, lcnt, recs + (F.wave * 8 + 2 * kp + 1) * 8);
    }
#undef RT_PREFETCH
    __syncthreads();
    if (F.tid < 16) { unsigned* cnt = (unsigned*)(F.ctl + CW_CNT + 1024 * layer + 64 * F.tid); lcnt[16 + F.tid] = atomicAdd(cnt, lcnt[F.tid]); }
    __syncthreads();
    { const int k = F.lane, mrow = gw + k * NGW;
      if (k < 8 && mrow < NTOK) { const LAS int* rs = recs + (F.wave * 8 + k) * 8;
          RouteRec rr; rr.e0 = rs[0]; rr.e1 = rs[1]; rr.pos0 = rs[2] + (int)lcnt[16 + rr.e0]; rr.pos1 = rs[3] + (int)lcnt[16 + rr.e1]; rr.w0 = __int_as_float(rs[4]); rr.w1 = __int_as_float(rs[5]); rr.slot0 = 0; rr.slot1 = 0;
          route[mrow] = rr; elist[rr.e0 * 16384 + rr.pos0] = mrow; elist[rr.e1 * 16384 + rr.pos1] = mrow; } }
}

__device__ __forceinline__ void moe_tables(Frame& F, int layer) {
    LAS int* ppre = (LAS int*)(F.lds + TAB_OFF);
    if (F.tid == 0) { const unsigned* cnt = (const unsigned*)(F.ctl + CW_CNT + 1024 * layer); int acc = 0;
        for (int e = 0; e < 16; ++e) { const int c = (int)cnt[64 * e]; ppre[e] = acc; ppre[32 + e] = c; acc += (c + 255) >> 8; }
        ppre[16] = acc; }
    __syncthreads();
}

template <bool COMBINE, bool NORM, bool ROUTE>
__device__ __forceinline__ void row_pass(Frame& F, const float* xin, const float* modn  , int sh_off, const float* ng,
                                         const float* modc  , int layer, int clayer  ) {
    if (COMBINE) moe_tables(F, clayer);
    float* xout = F.out; bf16* H = (bf16*)(F.ws + WS_O);
    const bf16* YM = (const bf16*)(F.ws + WS_A);
    RouteRec* route = (RouteRec*)(F.ws + WS_ROUTE);
    int* elist = (int*)(F.ws + WS_STATS);
    const LAS int* ppre = (const LAS int*)(F.lds + TAB_OFF);
    LAS float* wr = (LAS float*)(F.lds + RING_OFF);
    LAS unsigned* lcnt = (LAS unsigned*)(F.lds + TAB_OFF + 256);
    LAS int* recs = (LAS int*)(F.lds + TAB_OFF + 8192);
    if (ROUTE) {
        for (int idx = F.tid; idx < 16384; idx += 512) wr[(idx & 15) * 1024 + (idx >> 4)] = F.w_router[idx];
        if (F.tid < 32) lcnt[F.tid] = 0u;
        __syncthreads();
    }
    const int gw = F.bid * 8 + F.wave, NGW = F.G * 8;
    f32x4 cs[4], sh[4], gc[4];
    f32x4 vn[4]; v2u yn0[4], yn1[4]; RouteRec rn; rn.w0 = 0.f; rn.w1 = 0.f;
    int m = gw, bcur = -1;
#define RP_PREFETCH(mm) do { \
        _Pragma("unroll") for (int j = 0; j < 4; ++j) vn[j] = *(const f32x4*)(xin + (size_t)(mm) * DM + 4 * F.lane + 256 * j); \
        if (COMBINE) { rn = route[(mm)]; const int sl0_ = ppre[rn.e0] * 256 + rn.pos0, sl1_ = ppre[rn.e1] * 256 + rn.pos1; \
            _Pragma("unroll") for (int j = 0; j < 4; ++j) { yn0[j] = *(const v2u*)(YM + (size_t)sl0_ * DM + 4 * F.lane + 256 * j); yn1[j] = *(const v2u*)(YM + (size_t)sl1_ * DM + 4 * F.lane + 256 * j); } } } while (0)
    if (m < NTOK) RP_PREFETCH(m);
#pragma unroll 1
    while (m < NTOK) {
        f32x4 v[4]; v2u y0[4], y1[4];
#pragma unroll
        for (int j = 0; j < 4; ++j) { v[j] = vn[j]; if (COMBINE) { y0[j] = yn0[j]; y1[j] = yn1[j]; } }
        const float rw0 = rn.w0, rw1 = rn.w1;
        const int mc = m; m += NGW;
        if (m < NTOK) RP_PREFETCH(m);
        const int b = mc >> 13;
        if (b != bcur) { bcur = b;
#pragma unroll
            for (int j = 0; j < 4; ++j) {
                const int col = 4 * F.lane + 256 * j;
                if (NORM) { const f32x4 g = *(const f32x4*)(ng + col), sc = *(const f32x4*)(modn + b * 6144 + sh_off + 1024 + col); cs[j] = g * (sc + 1.0f); sh[j] = *(const f32x4*)(modn + b * 6144 + sh_off + col); }
                if (COMBINE) gc[j] = *(const f32x4*)(modc + b * 6144 + 5 * 1024 + col);
            } }
        {
            if (COMBINE) {
#pragma unroll
                for (int j = 0; j < 4; ++j) {
                    f32x4 yy; yy.x = rw0 * bflo(y0[j].x) + rw1 * bflo(y1[j].x); yy.y = rw0 * bfhi(y0[j].x) + rw1 * bfhi(y1[j].x); yy.z = rw0 * bflo(y0[j].y) + rw1 * bflo(y1[j].y); yy.w = rw0 * bfhi(y0[j].y) + rw1 * bfhi(y1[j].y);
                    v[j] = v[j] + gc[j] * yy;
                    *(f32x4*)(xout + (size_t)mc * DM + 4 * F.lane + 256 * j) = v[j];
                }
            }
            if (NORM) {
                float s = 0.f;
#pragma unroll
                for (int j = 0; j < 4; ++j) s += (v[j].x * v[j].x + v[j].y * v[j].y) + (v[j].z * v[j].z + v[j].w * v[j].w);
                const float rstd = 1.0f / sqrtf(wave_sum(s) * (1.0f / DM) + NORM_EPS);
#pragma unroll
                for (int j = 0; j < 4; ++j) { v[j] = v[j] * rstd * cs[j] + sh[j];
                    v2u o; o.x = pk2(v[j].x, v[j].y); o.y = pk2(v[j].z, v[j].w);
                    *(v2u*)(H + (size_t)mc * DM + 4 * F.lane + 256 * j) = o; }
            }
            if (ROUTE) {
                float a16[16];
#pragma unroll
                for (int eg = 0; eg < 4; ++eg) {
                    float a4[4] = {0.f, 0.f, 0.f, 0.f};
#pragma unroll
                    for (int j = 0; j < 4; ++j)
#pragma unroll
                        for (int ee = 0; ee < 4; ++ee) { const f32x4 w = *(const LAS f32x4*)(wr + (eg * 4 + ee) * 1024 + 4 * F.lane + 256 * j); a4[ee] += (v[j].x * w.x + v[j].y * w.y) + (v[j].z * w.z + v[j].w * w.w); }
#pragma unroll
                    for (int ee = 0; ee < 4; ++ee) a16[eg * 4 + ee] = a4[ee];
                    __builtin_amdgcn_sched_barrier(0);
                }
                float r8[8], r4[4], r2[2];
                { const bool hb = (F.lane & 32) != 0;
#pragma unroll
                  for (int i = 0; i < 8; ++i) { const float keep = hb ? a16[8 + i] : a16[i], send = hb ? a16[i] : a16[8 + i]; r8[i] = keep + __shfl_xor(send, 32); } }
                { const bool hb = (F.lane & 16) != 0;
#pragma unroll
                  for (int i = 0; i < 4; ++i) { const float keep = hb ? r8[4 + i] : r8[i], send = hb ? r8[i] : r8[4 + i]; r4[i] = keep + __shfl_xor(send, 16); } }
                { const bool hb = (F.lane & 8) != 0;
#pragma unroll
                  for (int i = 0; i < 2; ++i) { const float keep = hb ? r4[2 + i] : r4[i], send = hb ? r4[i] : r4[2 + i]; r2[i] = keep + __shfl_xor(send, 8); } }
                float lgo; { const bool hb = (F.lane & 4) != 0; const float keep = hb ? r2[1] : r2[0], send = hb ? r2[0] : r2[1]; lgo = keep + __shfl_xor(send, 4); }
                lgo += __shfl_xor(lgo, 1); lgo += __shfl_xor(lgo, 2);
                const int eown = ((F.lane >> 5) & 1) * 8 + ((F.lane >> 4) & 1) * 4 + ((F.lane >> 3) & 1) * 2 + ((F.lane >> 2) & 1);
                const float sco = frcp(1.0f + __expf(-lgo)), slo = sco + F.r_bias[eown];
                float sc[16], sl[16];
#pragma unroll
                for (int e = 0; e < 16; ++e) { const int src = (e >> 3) * 32 + ((e >> 2) & 1) * 16 + ((e >> 1) & 1) * 8 + (e & 1) * 4;
                    sc[e] = __builtin_bit_cast(float, __builtin_amdgcn_readlane(__builtin_bit_cast(int, sco), src)); sl[e] = __builtin_bit_cast(float, __builtin_amdgcn_readlane(__builtin_bit_cast(int, slo), src)); }
                float gs[4]; int ge1[4], ge2[4]; float gw1[4], gw2[4];
#pragma unroll
                for (int g = 0; g < 4; ++g) {
                    int i1 = 0; float m1 = sl[4 * g];
#pragma unroll
                    for (int k = 1; k < 4; ++k) if (sl[4 * g + k] > m1) { m1 = sl[4 * g + k]; i1 = k; }
                    int i2 = -1; float m2 = 0.f;
#pragma unroll
                    for (int k = 0; k < 4; ++k) if (k != i1 && (i2 < 0 || sl[4 * g + k] > m2)) { m2 = sl[4 * g + k]; i2 = k; }
                    gs[g] = m1 + m2; ge1[g] = 4 * g + i1; ge2[g] = 4 * g + i2;
                    float w1 = 0.f, w2 = 0.f;
#pragma unroll
                    for (int k = 0; k < 4; ++k) { w1 = (k == i1) ? sc[4 * g + k] : w1; w2 = (k == i2) ? sc[4 * g + k] : w2; }
                    gw1[g] = w1; gw2[g] = w2;
                }
                int gi = 0; float gm = gs[0];
#pragma unroll
                for (int g = 1; g < 4; ++g) if (gs[g] > gm) { gm = gs[g]; gi = g; }
                int e1 = ge1[0], e2 = ge2[0]; float w1 = gw1[0], w2 = gw2[0];
#pragma unroll
                for (int g = 1; g < 4; ++g) if (gi == g) { e1 = ge1[g]; e2 = ge2[g]; w1 = gw1[g]; w2 = gw2[g]; }
                const float ws_ = w1 + w2;
                if (F.lane == 0) {
                    const int p0 = (int)__hip_atomic_fetch_add(lcnt + e1, 1u, __ATOMIC_RELAXED, __HIP_MEMORY_SCOPE_WORKGROUP);
                    const int p1 = (int)__hip_atomic_fetch_add(lcnt + e2, 1u, __ATOMIC_RELAXED, __HIP_MEMORY_SCOPE_WORKGROUP);
                    LAS int* rs = recs + (F.wave * 8 + ((mc - gw) / NGW)) * 8;
                    rs[0] = e1; rs[1] = e2; rs[2] = p0; rs[3] = p1; rs[4] = __float_as_int(w1 / ws_); rs[5] = __float_as_int(w2 / ws_);
                }
            }
        }
    }
#undef RP_PREFETCH
    if (ROUTE) {
        __syncthreads();
        if (F.tid < 16) { unsigned* cnt = (unsigned*)(F.ctl + CW_CNT + 1024 * layer + 64 * F.tid); lcnt[16 + F.tid] = atomicAdd(cnt, lcnt[F.tid]); }
        __syncthreads();
        { const int k = F.lane, mrow = gw + k * NGW;
          if (k < 8 && mrow < NTOK) { const LAS int* rs = recs + (F.wave * 8 + k) * 8;
              RouteRec rr; rr.e0 = rs[0]; rr.e1 = rs[1]; rr.pos0 = rs[2] + (int)lcnt[16 + rr.e0]; rr.pos1 = rs[3] + (int)lcnt[16 + rr.e1]; rr.w0 = __int_as_float(rs[4]); rr.w1 = __int_as_float(rs[5]); rr.slot0 = 0; rr.slot1 = 0;
              route[mrow] = rr; elist[rr.e0 * 16384 + rr.pos0] = mrow; elist[rr.e1 * 16384 + rr.pos1] = mrow; } }
    }
}


__device__ __forceinline__ f32x4 mma16(const LAS bf16* A, int lda, const LAS bf16* Bt, int ldb, int K, f32x4 acc, int lane) {
    const LAS bf16* ap = A + (lane & 15) * lda + (lane >> 4) * 8;
    const LAS bf16* bp = Bt + (lane & 15) * ldb + (lane >> 4) * 8;
    for (int k = 0; k < K; k += 32) {
        const bf16x8 a = *(const LAS bf16x8*)(ap + k), b = *(const LAS bf16x8*)(bp + k);
        acc = __builtin_amdgcn_mfma_f32_16x16x32_bf16(a, b, acc, 0, 0, 0);
    }
    return acc;
}

__device__ __forceinline__ float wave_incl_scan(float v) {
#define DPP_ADD(ctrl, rmask) v += __builtin_bit_cast(float, __builtin_amdgcn_update_dpp(0, __builtin_bit_cast(int, v), (ctrl), (rmask), 0xF, false))
    DPP_ADD(0x111, 0xF);
    DPP_ADD(0x112, 0xF);
    DPP_ADD(0x114, 0xF);
    DPP_ADD(0x118, 0xF);
    DPP_ADD(0x142, 0xA);
    DPP_ADD(0x143, 0xC);
#undef DPP_ADD
    return v;
}
__device__ __forceinline__ void gla_bcum(Frame& F, const bf16* prow  , int h, float (&bc)[8]) {
    float gl[16];
    { const v4u a = *(const v4u*)(prow + C_GLR), b = *(const v4u*)(prow + C_GLR + 8); float t0[8], t1[8]; unpack8(a, t0); unpack8(b, t1);
#pragma unroll
      for (int i = 0; i < 8; ++i) { gl[i] = t0[i]; gl[8 + i] = t1[i]; } }
#pragma unroll
    for (int i = 0; i < 8; ++i) {
        const int col = h * 64 + F.wave * 8 + i;
        float z = F.gla_bg[col];
#pragma unroll
        for (int r = 0; r < 16; ++r) z += gl[r] * F.gla_w2[r * 256 + col];
        const float ls = fminf(z, 0.f) - __logf(1.0f + __expf(-fabsf(z)));
        bc[i] = wave_incl_scan(ls * (1.0f / 16.0f));
    }
}
__device__ __forceinline__ void gla_stage_vT(Frame& F, const bf16* prow, int h, LAS bf16* VT) {
    const v4u a = *(const v4u*)(prow + C_GV + h * 128 + F.wave * 16), b = *(const v4u*)(prow + C_GV + h * 128 + F.wave * 16 + 8);
    const unsigned w[8] = {a.x, a.y, a.z, a.w, b.x, b.y, b.z, b.w};
#pragma unroll
    for (int i = 0; i < 8; ++i) { VT[(F.wave * 16 + 2 * i) * 72 + F.lane] = (bf16)(w[i] & 0xffffu); VT[(F.wave * 16 + 2 * i + 1) * 72 + F.lane] = (bf16)(w[i] >> 16); }
}
__device__ __forceinline__ void gla_prep_item(Frame& F, int item) {
    const int h = item & 3, n = (item >> 2) & 127, b = item >> 9;
    const bf16* proj = (const bf16*)(F.ws + WS_A);
    const bf16* prow = proj + (size_t)(b * SEQ + n * 64 + F.lane) * NPROJ;
    LAS bf16* KT = (LAS bf16*)(F.lds + RING_OFF);
    LAS bf16* VT = (LAS bf16*)(F.lds + RING_OFF + 9216);
    float bc[8]; gla_bcum(F, prow, h, bc);
    float kf[8]; { const v4u kk = *(const v4u*)(prow + C_GK + h * 64 + F.wave * 8); unpack8(kk, kf); }
    float* DEC = (float*)(F.ws + WS_DEC) + ((size_t)(b * 128 + n) * 4 + h) * 64;
#pragma unroll
    for (int i = 0; i < 8; ++i) {
        const float bl = __shfl(bc[i], 63);
        KT[(F.wave * 8 + i) * 72 + F.lane] = (bf16)f2bf(kf[i] * __expf(bl - bc[i]));
        if (F.lane == 63) DEC[F.wave * 8 + i] = __expf(bl);
    }
    gla_stage_vT(F, prow, h, VT);
    __syncthreads();
    float* KV = (float*)(F.ws + WS_O) + ((size_t)(b * 128 + n) * 4 + h) * 8192;
    const int dt = F.wave >> 1;
#pragma unroll
    for (int j = 0; j < 4; ++j) {
        const int et = (F.wave & 1) * 4 + j;
        f32x4 acc = {0.f, 0.f, 0.f, 0.f};
        acc = mma16(KT + dt * 16 * 72, 72, VT + et * 16 * 72, 72, 64, acc, F.lane);
#pragma unroll
        for (int i = 0; i < 4; ++i) KV[(dt * 16 + 4 * (F.lane >> 4) + i) * 128 + et * 16 + (F.lane & 15)] = acc[i];
    }
    __syncthreads();
}
__device__ __forceinline__ void gla_scan(Frame& F, int gidx) {
    const int bh = gidx >> 13, de = gidx & 8191, b = bh >> 2, h = bh & 3;
    float* KV = (float*)(F.ws + WS_O) + ((size_t)(b * 128) * 4 + h) * 8192 + de;
    const float* DEC = (const float*)(F.ws + WS_DEC) + ((size_t)(b * 128) * 4 + h) * 64 + (de >> 7);
    float st = 0.f;
#pragma unroll 1
    for (int n0 = 0; n0 < 128; n0 += 16) {
        float kv[16], dc[16];
#pragma unroll
        for (int i = 0; i < 16; ++i) { kv[i] = KV[(size_t)(n0 + i) * 4 * 8192]; dc[i] = DEC[(size_t)(n0 + i) * 4 * 64]; }
#pragma unroll
        for (int i = 0; i < 16; ++i) { KV[(size_t)(n0 + i) * 4 * 8192] = st; st = dc[i] * st + kv[i]; }
    }
}
__device__ __forceinline__ void gla_out_item(Frame& F, int item) {
    const int h = item & 3, n = (item >> 2) & 127, b = item >> 9;
    const bf16* proj = (const bf16*)(F.ws + WS_A);
    const size_t tok = (size_t)b * SEQ + n * 64 + F.lane;
    const bf16* prow = proj + tok * NPROJ;
    LAS bf16* A1 = (LAS bf16*)(F.lds + RING_OFF);
    LAS bf16* B1 = (LAS bf16*)(F.lds + RING_OFF + 9216);
    LAS bf16* A2 = (LAS bf16*)(F.lds + RING_OFF + 18432);
    LAS bf16* SC = (LAS bf16*)(F.lds + RING_OFF + 27648);
    LAS bf16* VT = (LAS bf16*)(F.lds + RING_OFF + 36864);
    LAS bf16* ST = (LAS bf16*)(F.lds + RING_OFF + 55296);
    LAS float* OS = (LAS float*)(F.lds + RING_OFF + 73728);
    const size_t tkn = (size_t)b * SEQ + n * 64 + (F.tid >> 3);
    const v4u rraw0 = *(const v4u*)(proj + tkn * NPROJ + C_GR + h * 128 + (F.tid & 7) * 16), rraw1 = *(const v4u*)(proj + tkn * NPROJ + C_GR + h * 128 + (F.tid & 7) * 16 + 8);
    float bc[8]; gla_bcum(F, prow, h, bc);
    float qf[8], kf[8];
    { const v4u qq = *(const v4u*)(prow + C_GQ + h * 64 + F.wave * 8), kk = *(const v4u*)(prow + C_GK + h * 64 + F.wave * 8); unpack8(qq, qf); unpack8(kk, kf); }
    float a1[8], b1[8], a2[8];
#pragma unroll
    for (int i = 0; i < 8; ++i) {
        const float bm = __shfl(bc[i], 32);
        a1[i] = qf[i] * 0.125f * __expf(bc[i] - bm); b1[i] = kf[i] * __expf(bm - bc[i]); a2[i] = qf[i] * 0.125f * __expf(bc[i]);
    }
    *(LAS v4u*)(A1 + F.lane * 72 + F.wave * 8) = pack8(a1);
    *(LAS v4u*)(B1 + F.lane * 72 + F.wave * 8) = pack8(b1);
    *(LAS v4u*)(A2 + F.lane * 72 + F.wave * 8) = pack8(a2);
    gla_stage_vT(F, prow, h, VT);
    { const float* KV = (const float*)(F.ws + WS_O) + ((size_t)(b * 128 + n) * 4 + h) * 8192;
#pragma unroll
      for (int k = 0; k < 16; ++k) { const int p = F.tid + 512 * k, e = p & 127, d = p >> 7; ST[e * 72 + d] = (bf16)f2bf(KV[d * 128 + e]); } }
    __syncthreads();
    const int it = F.wave >> 1;
#pragma unroll
    for (int jj = 0; jj < 2; ++jj) {
        const int jt = (F.wave & 1) * 2 + jj;
        f32x4 acc = {0.f, 0.f, 0.f, 0.f};
        if (jt <= it) acc = mma16(A1 + it * 16 * 72, 72, B1 + jt * 16 * 72, 72, 64, acc, F.lane);
#pragma unroll
        for (int i = 0; i < 4; ++i) { const int ri = it * 16 + 4 * (F.lane >> 4) + i, cj = jt * 16 + (F.lane & 15); SC[ri * 72 + cj] = (bf16)f2bf((cj <= ri) ? acc[i] : 0.f); }
    }
    __syncthreads();
#pragma unroll
    for (int j = 0; j < 4; ++j) {
        const int et = (F.wave & 1) * 4 + j;
        f32x4 acc = {0.f, 0.f, 0.f, 0.f};
        acc = mma16(SC + it * 16 * 72, 72, VT + et * 16 * 72, 72, 64, acc, F.lane);
        acc = mma16(A2 + it * 16 * 72, 72, ST + et * 16 * 72, 72, 64, acc, F.lane);
#pragma unroll
        for (int i = 0; i < 4; ++i) OS[(it * 16 + 4 * (F.lane >> 4) + i) * 132 + et * 16 + (F.lane & 15)] = acc[i];
    }
    __syncthreads();
    { const int row = F.tid >> 3, c0 = (F.tid & 7) * 16;
      float v[16]; float ss = 0.f;
#pragma unroll
      for (int i = 0; i < 16; ++i) { v[i] = OS[row * 132 + c0 + i]; ss += v[i] * v[i]; }
      ss += dpp_xor1(ss); ss += dpp_xor2(ss); ss += __shfl_xor(ss, 4);
      const float rstd = 1.0f / sqrtf(ss * (1.0f / 128.0f) + NORM_EPS);
      const size_t tk = (size_t)b * SEQ + n * 64 + row;
      float r0[8], r1[8]; unpack8(rraw0, r0); unpack8(rraw1, r1);
      float o0[8], o1[8];
#pragma unroll
      for (int i = 0; i < 8; ++i) { o0[i] = v[i] * rstd * F.gla_ng[c0 + i] * siluf_(r0[i]); o1[i] = v[8 + i] * rstd * F.gla_ng[c0 + 8 + i] * siluf_(r1[i]); }
      bf16* orow = (bf16*)(F.ws + WS_O + 32 * MiB) + tk * DM + h * 128 + c0;
      *(v4u*)orow = pack8(o0); *(v4u*)(orow + 8) = pack8(o1); }
    __syncthreads();
}

__device__ __forceinline__ double inv_freq_d(int i) {
    return (i == 0) ? 1.0 : (i == 1) ? 0.19392547740471268 : (i == 2) ? 0.037606090787015346 : (i == 3) ? 0.0072927791106285765 :
           (i == 4) ? 0.0014142135623730951 : (i == 5) ? 0.00027425197177757796 : (i == 6) ? 5.318404375373266e-05 : 1.0313741203148838e-05;
}
__device__ __forceinline__ void rope_sincos(int pos, int i, float& cs, float& sn) {
    const double rev = (double)pos * inv_freq_d(i) * 0.15915494309189535;
    const float fr = (float)(rev - rint(rev));
    cs = __builtin_amdgcn_cosf(fr); sn = __builtin_amdgcn_sinf(fr);
}
struct PrepRaw { v4u r0, r1, r2; unsigned ng; int pos; };
__device__ __forceinline__ void nsa_prep_load(Frame& F, int tok, PrepRaw& p) {
    const int sub = F.lane & 7, vid = F.lane >> 3;
    const bf16* prow = (const bf16*)(F.ws + WS_A) + (size_t)tok * NPROJ;
    const int g1 = vid & 1, w1 = vid >> 1, w2 = (vid >> 1) & 1;
    const int col1 = ((w1 == 0) ? C_KS : (w1 == 1) ? C_KW : (w1 == 2) ? C_VS : C_VW) + g1 * 64, col2 = (w2 ? C_VC : C_KC) + g1 * 64;
    p.r0 = *(const v4u*)(prow + C_NQ + vid * 64 + sub * 8); p.r1 = *(const v4u*)(prow + col1 + sub * 8); p.r2 = *(const v4u*)(prow + col2 + sub * 8);
    p.ng = (F.lane < 24) ? (unsigned)prow[C_NG + F.lane] : 0u; p.pos = F.positions[tok];
}
__device__ __forceinline__ void nsa_prep_token(Frame& F, int tok, const PrepRaw& p) {
    const int b = tok >> 13, t = tok & 8191, sub = F.lane & 7, vid = F.lane >> 3;
    float cs_l, sn_l; rope_sincos(p.pos, sub, cs_l, sn_l);
    float cs[8], sn[8];
#pragma unroll
    for (int i = 0; i < 8; ++i) { cs[i] = __shfl(cs_l, (F.lane & ~7) + i); sn[i] = __shfl(sn_l, (F.lane & ~7) + i); }
    unsigned char* dob = F.dout_b;
    const size_t ktile_off = (size_t)(t >> 6) * 8192 + sub * 1024 + (t & 63) * 16;
    const size_t vtile_off = (size_t)(t >> 6) * 8192 + (sub >> 2) * 4096 + (t & 63) * 64 + (sub & 3) * 16;
#pragma unroll
    for (int round = 0; round < 3; ++round) {
        int kind; unsigned char* dst; const float* gain = nullptr;
        if (round == 0) { kind = 0; gain = F.q_gain; const int g = vid >> 2, hh = vid & 3;
            dst = dob + DO_QN + ((((size_t)(b * 2 + g) * SEQ + t) * 4 + hh) * 64 + sub * 8) * 2; }
        else if (round == 1) {
            const int g = vid & 1, which = vid >> 1;
            const size_t img = (size_t)(b * 2 + g) * (1u << 20);
            if (which == 0) { kind = 1; gain = F.k_gain + 64; dst = dob + DO_KSEL + img + ktile_off; }
            else if (which == 1) { kind = 1; gain = F.k_gain + 128; dst = dob + DO_KWIN + img + ktile_off; }
            else if (which == 2) { kind = 2; dst = dob + DO_VSEL + img + vtile_off; }
            else { kind = 2; dst = dob + DO_VWIN + img + vtile_off; }
        } else {
            const int g = vid & 1, which = (vid >> 1) & 1;
            kind = 2;
            dst = dob + (which ? DO_VC : DO_KC) + (((size_t)(b * 2 + g) * SEQ + t) * 64 + sub * 8) * 2;
        }
        const v4u raw = (round == 0) ? p.r0 : (round == 1) ? p.r1 : p.r2;
        if (kind == 2) { if (round < 2 || F.lane < 32) *(v4u*)dst = raw; }
        else {
            float x[8]; unpack8(raw, x);
            float ss = 0.f;
#pragma unroll
            for (int i = 0; i < 8; ++i) ss += x[i] * x[i];
            ss += dpp_xor1(ss); ss += dpp_xor2(ss); ss += __shfl_xor(ss, 4);
            const float rstd = 1.0f / sqrtf(ss * (1.0f / 64.0f) + NORM_EPS);
#pragma unroll
            for (int i = 0; i < 8; ++i) x[i] = x[i] * rstd * gain[sub * 8 + i];
            float xo[8];
#pragma unroll
            for (int i = 0; i < 8; ++i) xo[i] = dpp_xor1(x[i]);
            if (sub == 0) {
#pragma unroll
                for (int i = 0; i < 8; ++i) x[i] = x[i] * cs[i] - xo[i] * sn[i];
            } else if (sub == 1) {
#pragma unroll
                for (int i = 0; i < 8; ++i) x[i] = x[i] * cs[i] + xo[i] * sn[i];
            }
            if (kind == 0) {
#pragma unroll
                for (int i = 0; i < 8; ++i) x[i] *= 0.125f * 1.4426950408889634f;
            }
            *(v4u*)dst = pack8(x);
        }
    }
    if (F.lane < 24) { float* gt = (float*)(F.ws + WS_GATES) + (size_t)tok * 24; gt[F.lane] = sigmoidf_(bf2f((bf16)p.ng)); }
}

__device__ __forceinline__ void nsa_compress_item(Frame& F, int item) {
    const int kv = item >> 6, b = (item >> 5) & 1, g = (item >> 4) & 1, rt = item & 15, n0 = rt * 32;
    const bf16* Asrc = (const bf16*)(F.dout_b + (kv ? DO_VC : DO_KC)) + ((size_t)(b * 2 + g) * SEQ + 16 * n0) * 64;
    const bf16* Bsrc = (const bf16*)(F.ws + WS_WCW1) + (size_t)kv * 256 * 2048;
    LAS bf16* As = (LAS bf16*)(F.lds + RING_OFF);
    LAS bf16* Bs = (LAS bf16*)(F.lds + RING_OFF + 2 * 32 * 72 * 2);
    LAS float* Hs = (LAS float*)(F.lds + RING_OFF + 86016);
    LAS float* W2s = (LAS float*)(F.lds + RING_OFF);
    const int ar = F.tid >> 3, ac = (F.tid & 7) * 8;
    v4u areg0 = {0u, 0u, 0u, 0u}, areg1 = {0u, 0u, 0u, 0u}, breg0[4], breg1[4];
#define CMP_GLOAD(A_, B_, kc) do { if (F.tid < 256) A_ = *(const v4u*)(Asrc + (size_t)ar * 1024 + (kc) * 64 + ac); \
        _Pragma("unroll") for (int i_ = 0; i_ < 4; ++i_) { const int p_ = F.tid + 512 * i_, br_ = p_ >> 3, bc_ = (p_ & 7) * 8; B_[i_] = *(const v4u*)(Bsrc + (size_t)br_ * 2048 + (kc) * 64 + bc_); } } while (0)
#define CMP_LSTORE(A_, B_, buf) do { if (F.tid < 256) *(LAS v4u*)(As + (buf) * 32 * 72 + ar * 72 + ac) = A_; \
        _Pragma("unroll") for (int i_ = 0; i_ < 4; ++i_) { const int p_ = F.tid + 512 * i_, br_ = p_ >> 3, bc_ = (p_ & 7) * 8; *(LAS v4u*)(Bs + (buf) * 256 * 72 + br_ * 72 + bc_) = B_[i_]; } } while (0)
#define CMP_MMA(buf) do { const LAS bf16* ap_ = As + (buf) * 32 * 72 + (F.lane & 15) * 72 + (F.lane >> 4) * 8; const LAS bf16* bp_ = Bs + (buf) * 256 * 72 + (F.wave * 32 + (F.lane & 15)) * 72 + (F.lane >> 4) * 8; \
        _Pragma("unroll") for (int k_ = 0; k_ < 64; k_ += 32) { \
            const bf16x8 a0_ = *(const LAS bf16x8*)(ap_ + k_), a1_ = *(const LAS bf16x8*)(ap_ + 16 * 72 + k_), b0_ = *(const LAS bf16x8*)(bp_ + k_), b1_ = *(const LAS bf16x8*)(bp_ + 16 * 72 + k_); \
            acc[0][0] = __builtin_amdgcn_mfma_f32_16x16x32_bf16(a0_, b0_, acc[0][0], 0, 0, 0); acc[0][1] = __builtin_amdgcn_mfma_f32_16x16x32_bf16(a0_, b1_, acc[0][1], 0, 0, 0); \
            acc[1][0] = __builtin_amdgcn_mfma_f32_16x16x32_bf16(a1_, b0_, acc[1][0], 0, 0, 0); acc[1][1] = __builtin_amdgcn_mfma_f32_16x16x32_bf16(a1_, b1_, acc[1][1], 0, 0, 0); } } while (0)
    f32x4 acc[2][2];
#pragma unroll
    for (int mt = 0; mt < 2; ++mt)
#pragma unroll
        for (int nt = 0; nt < 2; ++nt) acc[mt][nt] = (f32x4){0.f, 0.f, 0.f, 0.f};
#if defined(CMP_SPIN)
    const unsigned long long tc0 = __builtin_amdgcn_s_memrealtime();
#endif
    CMP_GLOAD(areg0, breg0, 0); CMP_GLOAD(areg1, breg1, 1); CMP_LSTORE(areg0, breg0, 0); __syncthreads();
#pragma unroll 1
    for (int kc = 0; kc < 32; kc += 2) {
        CMP_GLOAD(areg0, breg0, (kc + 2 < 32) ? kc + 2 : 31);
        CMP_MMA(0);
        CMP_LSTORE(areg1, breg1, 1);
        __syncthreads();
        CMP_GLOAD(areg1, breg1, (kc + 3 < 32) ? kc + 3 : 31);
        CMP_MMA(1);
        CMP_LSTORE(areg0, breg0, 0);
        __syncthreads();
    }
#undef CMP_MMA
#if defined(CMP_SPIN)
    if (CMP_SPIN == 1) { const unsigned long long t1_ = __builtin_amdgcn_s_memrealtime(), dt_ = t1_ - tc0; while (__builtin_amdgcn_s_memrealtime() - t1_ < dt_) __builtin_amdgcn_s_sleep(4); }
#endif
    const float* bias1 = (const float*)(F.ws + WS_MOD + 131072) + kv * 256;
#pragma unroll
    for (int mt = 0; mt < 2; ++mt)
#pragma unroll
        for (int nt = 0; nt < 2; ++nt) { const int col = F.wave * 32 + nt * 16 + (F.lane & 15);
#pragma unroll
            for (int i = 0; i < 4; ++i) Hs[(mt * 16 + 4 * (F.lane >> 4) + i) * 260 + col] = gelu_tanh(acc[mt][nt][i] + bias1[col]); }
    { const float* w2 = F.cmp_w2 + (size_t)kv * 256 * 64;
#pragma unroll
      for (int i = 0; i < 8; ++i) *(LAS f32x4*)(W2s + (F.tid + 512 * i) * 4) = *(const f32x4*)(w2 + (size_t)(F.tid + 512 * i) * 4); }
    __syncthreads();
    const int r = F.tid >> 4, dq = F.tid & 15;
    f32x4 o = {0.f, 0.f, 0.f, 0.f};
#pragma unroll 8
    for (int j = 0; j < 256; ++j) { const float hv = Hs[r * 260 + j]; const f32x4 w = *(const LAS f32x4*)(W2s + j * 64 + 4 * dq); o = o + w * hv; }
    const int n = n0 + r;
    if (kv == 0) {
        float ss = (o.x * o.x + o.y * o.y) + (o.z * o.z + o.w * o.w);
        ss += dpp_xor1(ss); ss += dpp_xor2(ss); ss += __shfl_xor(ss, 4); ss += __shfl_xor(ss, 8);
        const float rstd = 1.0f / sqrtf(ss * (1.0f / 64.0f) + NORM_EPS);
        const f32x4 gn = *(const f32x4*)(F.k_gain + 4 * dq);
        o = o * rstd * gn;
        const int tlast = (16 * n + 31 < SEQ) ? 16 * n + 31 : SEQ - 1;
        const int pos = F.positions[b * SEQ + tlast];
        f32x4 po; po.x = dpp_xor2(o.x); po.y = dpp_xor2(o.y); po.z = dpp_xor2(o.z); po.w = dpp_xor2(o.w);
        if (dq < 4) {
            const int i0 = 4 * (dq & 1);
            float c0, s0, c1, s1, c2, s2, c3, s3;
            rope_sincos(pos, i0, c0, s0); rope_sincos(pos, i0 + 1, c1, s1); rope_sincos(pos, i0 + 2, c2, s2); rope_sincos(pos, i0 + 3, c3, s3);
            if (dq < 2) { o.x = o.x * c0 - po.x * s0; o.y = o.y * c1 - po.y * s1; o.z = o.z * c2 - po.z * s2; o.w = o.w * c3 - po.w * s3; }
            else { o.x = o.x * c0 + po.x * s0; o.y = o.y * c1 + po.y * s1; o.z = o.z * c2 + po.z * s2; o.w = o.w * c3 + po.w * s3; }
        }
    }
    if (n == 511) o = (f32x4){0.f, 0.f, 0.f, 0.f};
    v2u pk; pk.x = pk2(o.x, o.y); pk.y = pk2(o.z, o.w);
    const int c = dq >> 1;
    unsigned char* img = F.dout_b + (kv ? DO_VCMP : DO_KCMP) + (size_t)(b * 2 + g) * 65536 + (size_t)(n >> 6) * 8192;
    if (kv == 0) *(v2u*)(img + c * 1024 + (n & 63) * 16 + (dq & 1) * 8) = pk;
    else *(v2u*)(img + (c >> 2) * 4096 + (n & 63) * 64 + (c & 3) * 16 + (dq & 1) * 8) = pk;
    __syncthreads();
}


constexpr int NSA_KB = 0, NSA_VB = 16384, NSA_IMP = 32768, NSA_OACC = 65536;
__device__ __forceinline__ int crow(int r, int hi) { return (r & 3) + 8 * (r >> 2) + 4 * hi; }
__device__ __forceinline__ s16x4 ds_tr16(const LAS unsigned char* p) { return __builtin_bit_cast(s16x4, __builtin_amdgcn_ds_read_tr16_b64_v4i16((LAS s16x4*)p)); }

__device__ __forceinline__ unsigned cvtpk(float lo, float hi) { unsigned r; asm("v_cvt_pk_bf16_f32 %0, %1, %2" : "=v"(r) : "v"(lo), "v"(hi)); return r; }
__device__ __forceinline__ float xhalf_max(float v) { const auto rr = __builtin_amdgcn_permlane32_swap(__float_as_uint(v), __float_as_uint(v), false, false); return fmaxf(__uint_as_float(rr[0]), __uint_as_float(rr[1])); }
constexpr float NSA_THR = 8.0f;

template <int MODE>
__device__ __forceinline__ void nsa_branch(Frame& F, const unsigned char* Kimg, const unsigned char* Vimg, int kt0, int kt1, const bf16x8 (&qr)[4],
                                           float& m, float& l, f32x16 (&o)[2], int t, int tw0, int nv, int nvw, int nvmin,
                                           unsigned mk0, unsigned mk1, unsigned mk2, unsigned mk3, unsigned wo0, unsigned wo1, unsigned wo2, unsigned wo3,
                                           float cinit  , LAS float* impw,
                                           bool bnd  ) {
    const int r32 = F.lane & 31, hi = F.lane >> 5, tokl = r32 >> 2;
    LAS unsigned char* KB = F.lds + RING_OFF + NSA_KB; LAS unsigned char* VB = F.lds + RING_OFF + NSA_VB;
    const v4u* kg = (const v4u*)Kimg + F.tid; const v4u* vg = (const v4u*)Vimg + F.tid;
    v4u kreg = kg[(size_t)kt0 * 512], vreg = {0u, 0u, 0u, 0u};
    if (MODE != 0) vreg = vg[(size_t)kt0 * 512];
    *(LAS v4u*)(KB + F.tid * 16) = kreg; if (MODE != 0) *(LAS v4u*)(VB + F.tid * 16) = vreg;
    __syncthreads();
#pragma unroll 1
    for (int kt = kt0; kt < kt1; ++kt) {
        const int buf = (kt - kt0) & 1; const bool has_next = kt + 1 < kt1;
        if (has_next) { kreg = kg[(size_t)(kt + 1) * 512]; if (MODE != 0) vreg = vg[(size_t)(kt + 1) * 512]; }
        const LAS unsigned char* Kb = KB + buf * 8192; const LAS unsigned char* Vb = VB + buf * 8192;
        bool need;
        if (MODE <= 1) need = kt * 64 < nvw;
        else if (MODE == 2) { const unsigned w = (kt < 32) ? wo0 : (kt < 64) ? wo1 : (kt < 96) ? wo2 : wo3; need = (w >> (kt & 31)) & 1u; }
        else need = (kt * 64 <= tw0 + 7) && (kt * 64 + 63 + 512 > tw0);
        bool selbit = true;
        if (MODE == 2) { const unsigned w = (kt < 32) ? mk0 : (kt < 64) ? mk1 : (kt < 96) ? mk2 : mk3; selbit = (w >> (kt & 31)) & 1u; }
        bool joint = false;
        if (need) {
            if (MODE == 2) joint = kt < (tw0 >> 6);
            else if (MODE == 3) joint = (kt * 64 + 63 <= tw0) && (kt * 64 + 512 > tw0 + 7);
            else joint = kt * 64 + 63 < nvmin;
            if (MODE != 1 && !bnd) joint = joint && !__any(m < -1e29f);
        }
        if (need && joint) {
            f32x16 pa, pb;
            if (bnd && MODE != 1) {
#pragma unroll
                for (int r = 0; r < 16; ++r) { pa[r] = 0.f; pb[r] = 0.f; }
#pragma unroll
                for (int d0 = 0; d0 < 4; ++d0) {
                    const bf16x8 kfa = *(const LAS bf16x8*)(Kb + (2 * d0 + hi) * 1024 + r32 * 16), kfb = *(const LAS bf16x8*)(Kb + (2 * d0 + hi) * 1024 + (32 + r32) * 16);
                    pa = __builtin_amdgcn_mfma_f32_32x32x16_bf16(kfa, qr[d0], pa, 0, 0, 0);
                    pb = __builtin_amdgcn_mfma_f32_32x32x16_bf16(kfb, qr[d0], pb, 0, 0, 0);
                }
            } else {
            const float c0 = (MODE == 1) ? cinit : ((MODE == 2 && !selbit) ? -1e30f : -m);
#pragma unroll
            for (int r = 0; r < 16; ++r) { pa[r] = c0; pb[r] = c0; }
#pragma unroll
            for (int d0 = 0; d0 < 4; ++d0) {
                const bf16x8 kfa = *(const LAS bf16x8*)(Kb + (2 * d0 + hi) * 1024 + r32 * 16), kfb = *(const LAS bf16x8*)(Kb + (2 * d0 + hi) * 1024 + (32 + r32) * 16);
                pa = __builtin_amdgcn_mfma_f32_32x32x16_bf16(kfa, qr[d0], pa, 0, 0, 0);
                pb = __builtin_amdgcn_mfma_f32_32x32x16_bf16(kfb, qr[d0], pb, 0, 0, 0);
            }
            if (MODE != 1) {
                float mxa = fmaxf(fmaxf(pa[0], pa[1]), pa[2]), mxb = fmaxf(fmaxf(pb[0], pb[1]), pb[2]);
#pragma unroll
                for (int r = 3; r < 15; r += 2) { mxa = fmaxf(fmaxf(mxa, pa[r]), pa[r + 1]); mxb = fmaxf(fmaxf(mxb, pb[r]), pb[r + 1]); }
                const float mx = xhalf_max(fmaxf(fmaxf(mxa, pa[15]), fmaxf(mxb, pb[15])));
                if (__any(mx > NSA_THR)) {
                    const float dl = fmaxf(mx, 0.f), alpha = fexp2(-dl);
                    m += dl; l *= alpha;
#pragma unroll
                    for (int r = 0; r < 16; ++r) { pa[r] -= dl; pb[r] -= dl; }
                    if (MODE != 0) {
#pragma unroll
                        for (int r = 0; r < 16; ++r) { o[0][r] *= alpha; o[1][r] *= alpha; }
                    }
                }
            }
            }
            float ps0 = 0.f, ps1 = 0.f;
#pragma unroll
            for (int r = 0; r < 16; ++r) { pa[r] = fexp2(pa[r]); pb[r] = fexp2(pb[r]); ps0 += pa[r]; ps1 += pb[r]; }
            if (MODE != 1) l += (bnd && MODE == 2 && !selbit) ? 0.f : (ps0 + ps1);
            if (MODE == 1) {
#pragma unroll
                for (int rg = 0; rg < 4; ++rg) {
                    float a = (pa[4 * rg] + pa[4 * rg + 1]) + (pa[4 * rg + 2] + pa[4 * rg + 3]), sp = pa[4 * rg + 3];
                    float a2 = (pb[4 * rg] + pb[4 * rg + 1]) + (pb[4 * rg + 2] + pb[4 * rg + 3]), sp2 = pb[4 * rg + 3];
                    a += dpp_xor1(a); a += dpp_xor2(a); sp += dpp_xor1(sp); sp += dpp_xor2(sp);
                    a2 += dpp_xor1(a2); a2 += dpp_xor2(a2); sp2 += dpp_xor1(sp2); sp2 += dpp_xor2(sp2);
                    if ((r32 & 3) == 0) { const int jp = kt * 16 + 2 * rg + hi;
                        __hip_atomic_fetch_add(impw + tokl * 128 + jp, a, __ATOMIC_RELAXED, __HIP_MEMORY_SCOPE_WORKGROUP);
                        __hip_atomic_fetch_add(impw + tokl * 128 + jp + 1, sp, __ATOMIC_RELAXED, __HIP_MEMORY_SCOPE_WORKGROUP);
                        __hip_atomic_fetch_add(impw + tokl * 128 + jp + 8, a2, __ATOMIC_RELAXED, __HIP_MEMORY_SCOPE_WORKGROUP);
                        if (jp + 9 < 128) __hip_atomic_fetch_add(impw + tokl * 128 + jp + 9, sp2, __ATOMIC_RELAXED, __HIP_MEMORY_SCOPE_WORKGROUP); }
                }
            }
            if (MODE != 0) {
                v4u wa0, wa1, wb0, wb1;
                wa0.x = cvtpk(pa[0], pa[1]); wa0.y = cvtpk(pa[2], pa[3]); wa0.z = cvtpk(pa[4], pa[5]); wa0.w = cvtpk(pa[6], pa[7]);
                wa1.x = cvtpk(pa[8], pa[9]); wa1.y = cvtpk(pa[10], pa[11]); wa1.z = cvtpk(pa[12], pa[13]); wa1.w = cvtpk(pa[14], pa[15]);
                wb0.x = cvtpk(pb[0], pb[1]); wb0.y = cvtpk(pb[2], pb[3]); wb0.z = cvtpk(pb[4], pb[5]); wb0.w = cvtpk(pb[6], pb[7]);
                wb1.x = cvtpk(pb[8], pb[9]); wb1.y = cvtpk(pb[10], pb[11]); wb1.z = cvtpk(pb[12], pb[13]); wb1.w = cvtpk(pb[14], pb[15]);
                if (MODE == 2 && bnd) { const unsigned km = selbit ? 0xffffffffu : 0u;
                    wa0.x &= km; wa0.y &= km; wa0.z &= km; wa0.w &= km; wa1.x &= km; wa1.y &= km; wa1.z &= km; wa1.w &= km; wb0.x &= km; wb0.y &= km; wb0.z &= km; wb0.w &= km; wb1.x &= km; wb1.y &= km; wb1.z &= km; wb1.w &= km; }
                const bf16x8 fa0 = __builtin_bit_cast(bf16x8, wa0), fa1 = __builtin_bit_cast(bf16x8, wa1), fb0 = __builtin_bit_cast(bf16x8, wb0), fb1 = __builtin_bit_cast(bf16x8, wb1);
                const LAS unsigned char* vb = Vb + (4 * hi + ((F.lane & 15) >> 2)) * 64 + ((F.lane >> 4) & 1) * 32 + (F.lane & 3) * 8;
#pragma unroll
                for (int dh = 0; dh < 2; ++dh) {
                    const LAS unsigned char* v0 = vb + dh * 4096;
                    const s16x4 a0 = ds_tr16(v0), a1 = ds_tr16(v0 + 512), b0 = ds_tr16(v0 + 1024), b1 = ds_tr16(v0 + 1536), c0_ = ds_tr16(v0 + 2048), c1 = ds_tr16(v0 + 2560), d0_ = ds_tr16(v0 + 3072), d1 = ds_tr16(v0 + 3584);
                    const bf16x8 vfa0 = {a0[0], a0[1], a0[2], a0[3], a1[0], a1[1], a1[2], a1[3]}, vfa1 = {b0[0], b0[1], b0[2], b0[3], b1[0], b1[1], b1[2], b1[3]};
                    const bf16x8 vfb0 = {c0_[0], c0_[1], c0_[2], c0_[3], c1[0], c1[1], c1[2], c1[3]}, vfb1 = {d0_[0], d0_[1], d0_[2], d0_[3], d1[0], d1[1], d1[2], d1[3]};
                    o[dh] = __builtin_amdgcn_mfma_f32_32x32x16_bf16(vfa0, fa0, o[dh], 0, 0, 0);
                    o[dh] = __builtin_amdgcn_mfma_f32_32x32x16_bf16(vfa1, fa1, o[dh], 0, 0, 0);
                    o[dh] = __builtin_amdgcn_mfma_f32_32x32x16_bf16(vfb0, fb0, o[dh], 0, 0, 0);
                    o[dh] = __builtin_amdgcn_mfma_f32_32x32x16_bf16(vfb1, fb1, o[dh], 0, 0, 0);
                }
            }
        } else if (need) {
#pragma unroll 1
            for (int kb = 0; kb < 2; ++kb) {
                const int key0 = kt * 64 + kb * 32;
                bool fast;
                if (MODE == 2) fast = kt < (tw0 >> 6);
                else if (MODE == 3) fast = (key0 + 31 <= tw0) && (key0 + 512 > tw0 + 7);
                else fast = key0 + 31 < nvmin;
                if (MODE != 1) fast = fast && !bnd && !__any(m < -1e29f);
                float c0 = 0.f;
                if (fast) c0 = (MODE == 1) ? cinit : ((MODE == 2 && !selbit) ? -1e30f : -m);
                f32x16 p;
#pragma unroll
                for (int r = 0; r < 16; ++r) p[r] = c0;
#pragma unroll
                for (int d0 = 0; d0 < 4; ++d0) {
                    const bf16x8 kf = *(const LAS bf16x8*)(Kb + (2 * d0 + hi) * 1024 + (32 * kb + r32) * 16);
                    p = __builtin_amdgcn_mfma_f32_32x32x16_bf16(kf, qr[d0], p, 0, 0, 0);
                }
                float pe[16];
                if (fast) {
                    if (MODE != 1) {
                        float mx = fmaxf(fmaxf(p[0], p[1]), p[2]);
#pragma unroll
                        for (int r = 3; r < 15; r += 2) mx = fmaxf(fmaxf(mx, p[r]), p[r + 1]);
                        mx = xhalf_max(fmaxf(mx, p[15]));
                        if (__any(mx > NSA_THR)) {
                            const float dl = fmaxf(mx, 0.f), alpha = fexp2(-dl);
                            m += dl; l *= alpha;
#pragma unroll
                            for (int r = 0; r < 16; ++r) p[r] -= dl;
                            if (MODE != 0) {
#pragma unroll
                                for (int r = 0; r < 16; ++r) { o[0][r] *= alpha; o[1][r] *= alpha; }
                            }
                        }
                    }
                    float ps0 = 0.f, ps1 = 0.f;
#pragma unroll
                    for (int r = 0; r < 16; r += 2) { pe[r] = fexp2(p[r]); pe[r + 1] = fexp2(p[r + 1]); ps0 += pe[r]; ps1 += pe[r + 1]; }
                    if (MODE != 1) l += ps0 + ps1;
                } else if (MODE == 1) {
#pragma unroll
                    for (int r = 0; r < 16; ++r) { const int key = key0 + crow(r, hi); pe[r] = (key < nv) ? fexp2(p[r] + cinit) : 0.f; }
                } else if (bnd) {
                    float ps = 0.f;
#pragma unroll
                    for (int r = 0; r < 16; ++r) {
                        const int key = key0 + crow(r, hi); bool ok;
                        if (MODE == 0) ok = key < nv;
                        else if (MODE == 2) ok = selbit && (kt < (t >> 6) || key <= t);
                        else ok = (key <= t) && (key + 512 > t);
                        pe[r] = ok ? fexp2(p[r]) : 0.f; ps += pe[r];
                    }
                    l += ps;
                } else {
                    float mx = NEGBIG;
#pragma unroll
                    for (int r = 0; r < 16; ++r) {
                        const int key = key0 + crow(r, hi); bool ok;
                        if (MODE == 0) ok = key < nv;
                        else if (MODE == 2) ok = selbit && (kt < (t >> 6) || key <= t);
                        else ok = (key <= t) && (key + 512 > t);
                        p[r] = ok ? p[r] : NEGBIG; mx = fmaxf(mx, p[r]);
                    }
                    mx = xhalf_max(mx);
                    const float mn = fmaxf(m, mx), alpha = fexp2(m - mn);
                    float ps = 0.f;
#pragma unroll
                    for (int r = 0; r < 16; ++r) { pe[r] = (p[r] > -1e29f) ? fexp2(p[r] - mn) : 0.f; ps += pe[r]; }
                    l = l * alpha + ps; m = mn;
                    if (MODE != 0) {
#pragma unroll
                        for (int r = 0; r < 16; ++r) { o[0][r] *= alpha; o[1][r] *= alpha; }
                    }
                }
                if (MODE == 1) {
#pragma unroll
                    for (int rg = 0; rg < 4; ++rg) {
                        float a = (pe[4 * rg] + pe[4 * rg + 1]) + (pe[4 * rg + 2] + pe[4 * rg + 3]), sp = pe[4 * rg + 3];
                        a += dpp_xor1(a); a += dpp_xor2(a); sp += dpp_xor1(sp); sp += dpp_xor2(sp);
                        if ((r32 & 3) == 0) { const int jp = (key0 >> 2) + 2 * rg + hi;
                            __hip_atomic_fetch_add(impw + tokl * 128 + jp, a, __ATOMIC_RELAXED, __HIP_MEMORY_SCOPE_WORKGROUP);
                            if (jp + 1 < 128) __hip_atomic_fetch_add(impw + tokl * 128 + jp + 1, sp, __ATOMIC_RELAXED, __HIP_MEMORY_SCOPE_WORKGROUP); }
                    }
                }
                if (MODE != 0) {
                    v4u pw0, pw1;
                    pw0.x = cvtpk(pe[0], pe[1]); pw0.y = cvtpk(pe[2], pe[3]); pw0.z = cvtpk(pe[4], pe[5]); pw0.w = cvtpk(pe[6], pe[7]);
                    pw1.x = cvtpk(pe[8], pe[9]); pw1.y = cvtpk(pe[10], pe[11]); pw1.z = cvtpk(pe[12], pe[13]); pw1.w = cvtpk(pe[14], pe[15]);
                    const bf16x8 pf0 = __builtin_bit_cast(bf16x8, pw0), pf1 = __builtin_bit_cast(bf16x8, pw1);
                    const LAS unsigned char* vb = Vb + (32 * kb + 4 * hi + ((F.lane & 15) >> 2)) * 64 + ((F.lane >> 4) & 1) * 32 + (F.lane & 3) * 8;
#pragma unroll
                    for (int dh = 0; dh < 2; ++dh) {
                        const s16x4 a0 = ds_tr16(vb + dh * 4096), a1 = ds_tr16(vb + dh * 4096 + 512), b0 = ds_tr16(vb + dh * 4096 + 1024), b1 = ds_tr16(vb + dh * 4096 + 1024 + 512);
                        const bf16x8 vf0 = {a0[0], a0[1], a0[2], a0[3], a1[0], a1[1], a1[2], a1[3]}, vf1 = {b0[0], b0[1], b0[2], b0[3], b1[0], b1[1], b1[2], b1[3]};
                        o[dh] = __builtin_amdgcn_mfma_f32_32x32x16_bf16(vf0, pf0, o[dh], 0, 0, 0);
                        o[dh] = __builtin_amdgcn_mfma_f32_32x32x16_bf16(vf1, pf1, o[dh], 0, 0, 0);
                    }
                }
            }
        }
        if (has_next) { *(LAS v4u*)(KB + (buf ^ 1) * 8192 + F.tid * 16) = kreg; if (MODE != 0) *(LAS v4u*)(VB + (buf ^ 1) * 8192 + F.tid * 16) = vreg; }
        __syncthreads();
    }
}

__device__ __forceinline__ void nsa_item(Frame& F, int b, int g, int qi) {
    const int r32 = F.lane & 31, hi = F.lane >> 5, tokl = r32 >> 2, hh = r32 & 3;
    const int t0 = qi * 64, tw0 = t0 + 8 * F.wave, t = tw0 + tokl;
    const unsigned char* dob = F.dout_b;
    const size_t img = (size_t)(b * 2 + g) * (1u << 20);
    LAS float* impw = (LAS float*)(F.lds + RING_OFF + NSA_IMP) + F.wave * 1024;
    LAS unsigned* selm = (LAS unsigned*)(F.lds + TAB_OFF + 1024) + F.wave * 32;
    LAS float* oaccw = (LAS float*)(F.lds + RING_OFF + NSA_OACC) + F.wave * 2048 + F.lane;
#pragma unroll
    for (int i = 0; i < 16; ++i) impw[F.lane + 64 * i] = 0.f;
    bf16x8 qr[4];
    { const bf16* qrow = (const bf16*)(dob + DO_QN) + (((size_t)(b * 2 + g) * SEQ + tw0) * 4 + r32) * 64;
#pragma unroll
      for (int d0 = 0; d0 < 4; ++d0) qr[d0] = *(const bf16x8*)(qrow + 16 * d0 + 8 * hi); }
    const float* gt = (const float*)(F.ws + WS_GATES) + ((size_t)b * SEQ + t) * 24 + (g * 4 + hh) * 3;
    f32x16 o[2];
    const int nv = (t >= 31) ? ((t - 31) >> 4) + 1 : 0, nvw = (tw0 + 7 >= 31) ? ((tw0 + 7 - 31) >> 4) + 1 : 0, nvmin = (tw0 >= 31) ? ((tw0 - 31) >> 4) + 1 : 0;
    const int nct = (4 * qi + 3 + 63) >> 6;
    const unsigned char* Kc = dob + DO_KCMP + (size_t)(b * 2 + g) * 65536; const unsigned char* Vc = dob + DO_VCMP + (size_t)(b * 2 + g) * 65536;
#if defined(NSA_SPIN)
    unsigned long long tsp = __builtin_amdgcn_s_memrealtime();
#define NSPIN(k) do { if (NSA_SPIN == (k)) { const unsigned long long t1_ = __builtin_amdgcn_s_memrealtime(), dt_ = t1_ - tsp; while (__builtin_amdgcn_s_memrealtime() - t1_ < dt_) __builtin_amdgcn_s_sleep(4); } tsp = __builtin_amdgcn_s_memrealtime(); } while (0)
#else
#define NSPIN(k) do { } while (0)
#endif
    bool bnd0, bnd1, bnd2;
    { float gq = fabsf(F.q_gain[F.lane]), g0k = fabsf(F.k_gain[F.lane]), g1k = fabsf(F.k_gain[64 + F.lane]), g2k = fabsf(F.k_gain[128 + F.lane]);
#pragma unroll
      for (int off = 1; off < 64; off <<= 1) { gq = fmaxf(gq, __shfl_xor(gq, off)); g0k = fmaxf(g0k, __shfl_xor(g0k, off)); g1k = fmaxf(g1k, __shfl_xor(g1k, off)); g2k = fmaxf(g2k, __shfl_xor(g2k, off)); }
      const float cb = 64.0f * 0.125f * 1.4426950408889634f * 1.03f * gq;
      bnd0 = __builtin_amdgcn_readfirstlane((int)(cb * g0k < 40.0f)) != 0; bnd1 = __builtin_amdgcn_readfirstlane((int)(cb * g1k < 40.0f)) != 0; bnd2 = __builtin_amdgcn_readfirstlane((int)(cb * g2k < 40.0f)) != 0; }
    float m = bnd0 ? 0.f : NEGBIG, l = 0.f;
    nsa_branch<0>(F, Kc, Vc, 0, nct, qr, m, l, o, t, tw0, nv, nvw, nvmin, 0u, 0u, 0u, 0u, 0u, 0u, 0u, 0u, 0.f, impw, bnd0);
    { const float lt = l + __shfl_xor(l, 32); const float cinit = (lt > 0.f) ? -__log2f(lt) - m : -1e30f;
#pragma unroll
      for (int r = 0; r < 16; ++r) { o[0][r] = 0.f; o[1][r] = 0.f; }
      nsa_branch<1>(F, Kc, Vc, 0, nct, qr, m, l, o, t, tw0, nv, nvw, nvmin, 0u, 0u, 0u, 0u, 0u, 0u, 0u, 0u, cinit, impw, bnd0);
#pragma unroll
      for (int r = 0; r < 16; ++r) { oaccw[r * 64] = gt[0] * o[0][r]; oaccw[(16 + r) * 64] = gt[0] * o[1][r]; } }
    __syncthreads();
    NSPIN(1);
#pragma unroll 1
    for (int tl = 0; tl < 4; ++tl) {
        const int j0 = F.lane, j1 = F.lane + 64;
        const int curA = (tw0 + tl) >> 6, curB = (tw0 + tl + 4) >> 6;
        const unsigned uA0 = (j0 <= curA) ? (__float_as_uint(impw[tl * 128 + j0] + ((j0 == 0 || j0 == curA || j0 == curA - 1) ? 1e4f : 0.f)) + 1u) : 0u;
        const unsigned uA1 = (j1 <= curA) ? (__float_as_uint(impw[tl * 128 + j1] + ((j1 == curA || j1 == curA - 1) ? 1e4f : 0.f)) + 1u) : 0u;
        const unsigned uB0 = (j0 <= curB) ? (__float_as_uint(impw[(tl + 4) * 128 + j0] + ((j0 == 0 || j0 == curB || j0 == curB - 1) ? 1e4f : 0.f)) + 1u) : 0u;
        const unsigned uB1 = (j1 <= curB) ? (__float_as_uint(impw[(tl + 4) * 128 + j1] + ((j1 == curB || j1 == curB - 1) ? 1e4f : 0.f)) + 1u) : 0u;
        bool sA0, sA1, sB0, sB1;
        if (curA < 16) { sA0 = (j0 <= curA); sA1 = false; sB0 = (j0 <= curB); sB1 = false; }
        else {
            unsigned TA = 0u, TB = 0u;
#pragma unroll 1
            for (int bit = 31; bit >= 0; --bit) {
                const unsigned candA = TA | (1u << bit), candB = TB | (1u << bit);
                const int cA = __popcll(__ballot(uA0 >= candA)) + __popcll(__ballot(uA1 >= candA));
                const int cB = __popcll(__ballot(uB0 >= candB)) + __popcll(__ballot(uB1 >= candB));
                if (cA >= 16) TA = candA;
                if (cB >= 16) TB = candB;
            }
            const unsigned long long below = (F.lane == 0) ? 0ull : (~0ull >> (64 - F.lane));
            { const unsigned long long g0 = __ballot(uA0 > TA), g1 = __ballot(uA1 > TA), e0 = __ballot(uA0 == TA), e1 = __ballot(uA1 == TA);
              const int need = 16 - (__popcll(g0) + __popcll(g1));
              const int rank0 = __popcll(e0 & below), rank1 = __popcll(e0) + __popcll(e1 & below);
              sA0 = (uA0 > TA) || (uA0 == TA && rank0 < need); sA1 = (uA1 > TA) || (uA1 == TA && rank1 < need); }
            { const unsigned long long g0 = __ballot(uB0 > TB), g1 = __ballot(uB1 > TB), e0 = __ballot(uB0 == TB), e1 = __ballot(uB1 == TB);
              const int need = 16 - (__popcll(g0) + __popcll(g1));
              const int rank0 = __popcll(e0 & below), rank1 = __popcll(e0) + __popcll(e1 & below);
              sB0 = (uB0 > TB) || (uB0 == TB && rank0 < need); sB1 = (uB1 > TB) || (uB1 == TB && rank1 < need); }
        }
        const unsigned long long mA0 = __ballot(sA0), mA1 = __ballot(sA1), mB0 = __ballot(sB0), mB1 = __ballot(sB1);
        if (F.lane == 0) { selm[tl * 4 + 0] = (unsigned)mA0; selm[tl * 4 + 1] = (unsigned)(mA0 >> 32); selm[tl * 4 + 2] = (unsigned)mA1; selm[tl * 4 + 3] = (unsigned)(mA1 >> 32);
            selm[(tl + 4) * 4 + 0] = (unsigned)mB0; selm[(tl + 4) * 4 + 1] = (unsigned)(mB0 >> 32); selm[(tl + 4) * 4 + 2] = (unsigned)mB1; selm[(tl + 4) * 4 + 3] = (unsigned)(mB1 >> 32); }
    }
    __syncthreads();
    const unsigned mk0 = selm[tokl * 4 + 0], mk1 = selm[tokl * 4 + 1], mk2 = selm[tokl * 4 + 2], mk3 = selm[tokl * 4 + 3];
    unsigned wo0 = 0u, wo1 = 0u, wo2 = 0u, wo3 = 0u;
#pragma unroll
    for (int tl = 0; tl < 8; ++tl) { wo0 |= selm[tl * 4 + 0]; wo1 |= selm[tl * 4 + 1]; wo2 |= selm[tl * 4 + 2]; wo3 |= selm[tl * 4 + 3]; }
    wo0 = __builtin_amdgcn_readfirstlane(wo0); wo1 = __builtin_amdgcn_readfirstlane(wo1); wo2 = __builtin_amdgcn_readfirstlane(wo2); wo3 = __builtin_amdgcn_readfirstlane(wo3);
    NSPIN(2);
    { m = bnd1 ? 0.f : NEGBIG; l = 0.f;
#pragma unroll
      for (int r = 0; r < 16; ++r) { o[0][r] = 0.f; o[1][r] = 0.f; }
      nsa_branch<2>(F, dob + DO_KSEL + img, dob + DO_VSEL + img, 0, qi + 1, qr, m, l, o, t, tw0, nv, nvw, nvmin, mk0, mk1, mk2, mk3, wo0, wo1, wo2, wo3, 0.f, impw, bnd1);
      const float lt = l + __shfl_xor(l, 32); const float sc = (lt > 0.f) ? gt[1] / lt : 0.f;
#pragma unroll
      for (int r = 0; r < 16; ++r) { oaccw[r * 64] += sc * o[0][r]; oaccw[(16 + r) * 64] += sc * o[1][r]; } }
    NSPIN(3);
    { m = bnd2 ? 0.f : NEGBIG; l = 0.f;
#pragma unroll
      for (int r = 0; r < 16; ++r) { o[0][r] = 0.f; o[1][r] = 0.f; }
      nsa_branch<3>(F, dob + DO_KWIN + img, dob + DO_VWIN + img, (qi >= 8) ? qi - 8 : 0, qi + 1, qr, m, l, o, t, tw0, nv, nvw, nvmin, 0u, 0u, 0u, 0u, 0u, 0u, 0u, 0u, 0.f, impw, bnd2);
      const float lt = l + __shfl_xor(l, 32); const float sc = (lt > 0.f) ? gt[2] / lt : 0.f;
#pragma unroll
      for (int r = 0; r < 16; ++r) { o[0][r] = oaccw[r * 64] + sc * o[0][r]; o[1][r] = oaccw[(16 + r) * 64] + sc * o[1][r]; } }
    NSPIN(4);
    bf16* orow = (bf16*)(F.ws + WS_O + 32 * MiB) + ((size_t)b * SEQ + t) * DM + 512 + (g * 4 + hh) * 64;
#pragma unroll
    for (int dh = 0; dh < 2; ++dh)
#pragma unroll
        for (int rg = 0; rg < 4; ++rg) { v2u w; w.x = pk2(o[dh][4 * rg], o[dh][4 * rg + 1]); w.y = pk2(o[dh][4 * rg + 2], o[dh][4 * rg + 3]);
            *(v2u*)(orow + 32 * dh + 8 * rg + 4 * hi) = w; }
    __syncthreads();
}

__device__ __forceinline__ void sgu_item(Frame& F, int item) {
    const int gg = item & 7, ck = (item >> 3) & 63, b = item >> 9;
    const size_t tok0 = (size_t)b * SEQ + ck * 128;
    const bf16* Z = (const bf16*)(F.ws + WS_A);
    constexpr int RS = 544, BS = 136;
    LAS bf16* Ws = (LAS bf16*)(F.lds + RING_OFF);
    LAS unsigned char* Vs = F.lds + RING_OFF + 34816;
    LAS float* rs = (LAS float*)(F.lds + RING_OFF + 34816 + 128 * RS);
    if (F.tid < 128) { const float* st = (const float*)(F.ws + WS_STATS) + (tok0 + F.tid) * 32; float sum = 0.f;
#pragma unroll
        for (int k = 0; k < 32; k += 4) { const f32x4 v = *(const f32x4*)(st + k); sum += (v.x + v.y) + (v.z + v.w); }
        rs[F.tid] = 1.0f / sqrtf(sum * (1.0f / SGW) + NORM_EPS); }
    { const float* wsrc = F.sgu_ws + (size_t)gg * 128 * 128;
#pragma unroll
      for (int k = 0; k < 8; ++k) { const int p = F.tid + 512 * k, tr = p >> 5, sc = (p & 31) * 4; const f32x4 w = *(const f32x4*)(wsrc + tr * 128 + sc);
          v2u o; o.x = pk2((sc <= tr) ? w.x : 0.f, (sc + 1 <= tr) ? w.y : 0.f); o.y = pk2((sc + 2 <= tr) ? w.z : 0.f, (sc + 3 <= tr) ? w.w : 0.f);
          *(LAS v2u*)(Ws + tr * 136 + sc) = o; } }
    __syncthreads();
    { const int cc = F.tid & 31; float gn[8];
#pragma unroll
      for (int i = 0; i < 8; ++i) gn[i] = F.sgu_ng[gg * 256 + cc * 8 + i];
      v4u zr[8];
#pragma unroll
      for (int k = 0; k < 8; ++k) { const int sidx = (F.tid >> 5) + 16 * k; zr[k] = *(const v4u*)(Z + (tok0 + sidx) * 4096 + 2048 + gg * 256 + cc * 8); }
#pragma unroll
      for (int k = 0; k < 8; ++k) { const int sidx = (F.tid >> 5) + 16 * k; float x[8]; unpack8(zr[k], x); const float rr = rs[sidx];
#pragma unroll
          for (int i = 0; i < 8; ++i) x[i] *= rr * gn[i];
          const v4u o = pack8(x); LAS unsigned char* dst = Vs + sidx * RS + (cc >> 3) * BS + (cc & 7) * 16;
          *(LAS v2u*)dst = (v2u){o.x, o.y}; *(LAS v2u*)(dst + 8) = (v2u){o.z, o.w}; } }
    __syncthreads();
    v4u uraw[8];
    { const bf16* urow0 = Z + (tok0 + 16 * F.wave + (F.lane & 15)) * 4096 + gg * 256 + 64 * (F.lane >> 4);
#pragma unroll
      for (int j = 0; j < 8; ++j) uraw[j] = *(const v4u*)(urow0 + 8 * j); }
    f32x4 acc[16];
#pragma unroll
    for (int nt = 0; nt < 16; ++nt) acc[nt] = (f32x4){0.f, 0.f, 0.f, 0.f};
    const int ksteps = (16 * F.wave + 16 + 31) >> 5;
    const LAS bf16* wp = Ws + (16 * F.wave + (F.lane & 15)) * 136 + (F.lane >> 4) * 8;
    const LAS unsigned char* vp = Vs + (8 * (F.lane >> 4) + ((F.lane & 15) >> 2)) * RS + (F.lane & 3) * BS;
#pragma unroll 1
    for (int kk = 0; kk < ksteps; ++kk) {
        const bf16x8 wf = *(const LAS bf16x8*)(wp + kk * 32);
        const LAS unsigned char* vk = vp + kk * 32 * RS;
#pragma unroll
        for (int nt = 0; nt < 16; ++nt) {
            const s16x4 lo = ds_tr16(vk + 8 * nt), hi4 = ds_tr16(vk + 4 * RS + 8 * nt);
            const bf16x8 vf = {lo[0], lo[1], lo[2], lo[3], hi4[0], hi4[1], hi4[2], hi4[3]};
            acc[nt] = __builtin_amdgcn_mfma_f32_16x16x32_bf16(vf, wf, acc[nt], 0, 0, 0);
        }
    }
    { const int tr = 16 * F.wave + (F.lane & 15), g = F.lane >> 4; const float bs = F.sgu_bs[gg * 128 + tr];
      bf16* orow = (bf16*)(F.ws + WS_O) + (tok0 + tr) * SGW + gg * 256 + 64 * g;
#pragma unroll
      for (int j = 0; j < 8; ++j) { float u[8]; unpack8(uraw[j], u);
#pragma unroll
          for (int i = 0; i < 4; ++i) { u[i] *= acc[2 * j][i] + bs; u[4 + i] *= acc[2 * j + 1][i] + bs; }
          *(v4u*)(orow + 8 * j) = pack8(u); } }
    __syncthreads();
}


__device__ __forceinline__ void moe_tail_copies(Frame& F, int set) {
    const LAS int* ppre = (const LAS int*)(F.lds + TAB_OFF);
    int before = 0, total = 0; const int x = F.bid & 7, r = F.bid >> 3;
#pragma unroll
    for (int xx = 0; xx < 8; ++xx) { int n3 = 4 * (ppre[2 * xx + 2] - ppre[2 * xx]) - 64; n3 = n3 < 0 ? 0 : (n3 > 32 ? 32 : n3); if (xx < x) before += 32 - n3; total += 32 - n3; }
    int n3x = 4 * (ppre[2 * x + 2] - ppre[2 * x]) - 64; n3x = n3x < 0 ? 0 : (n3x > 32 ? 32 : n3x);
    __syncthreads();
    if (total < 64) { tr_run(F, set, F.bid * 8 + F.wave, F.G * 8); return; }
    if (r >= n3x) tr_run(F, set, (before + r - n3x) * 8 + F.wave, total * 8);
}
constexpr int NPHASE = 18;
struct Args { const void* in[26]; float* out; unsigned char* ws; int ph_lo, ph_hi, use_bar, pad; };
__global__ void __launch_bounds__(512, 2) trunk_fwd(Args args) {
    extern __shared__ __attribute__((aligned(16))) unsigned char lds[];
    Frame F;
    F.lds = (LAS unsigned char*)lds;
    F.MISC = (volatile LAS unsigned*)(F.lds + MISC_OFF);
    F.tid = threadIdx.x; F.lane = F.tid & 63; F.wave = __builtin_amdgcn_readfirstlane(F.tid >> 6);
    F.G = gridDim.x; F.bid = blockIdx.x;
    F.ws = args.ws; F.out = args.out; F.dout_b = (unsigned char*)args.out;
    F.ctl = (gu32*)(args.ws + WS_CTL);
    F.x = (const float*)args.in[0]; F.c = (const float*)args.in[1]; F.positions = (const int*)args.in[2]; F.w_ada = (const float*)args.in[3]; F.b_ada = (const float*)args.in[4];
    F.norm_g = (const float*)args.in[5]; F.w_in_ab = (const float*)args.in[6]; F.w_out_ab = (const float*)args.in[7]; F.gla_w2 = (const float*)args.in[8]; F.gla_bg = (const float*)args.in[9];
    F.gla_ng = (const float*)args.in[10]; F.q_gain = (const float*)args.in[11]; F.k_gain = (const float*)args.in[12]; F.cmp_pe = (const float*)args.in[13]; F.cmp_w1 = (const float*)args.in[14];
    F.cmp_w2 = (const float*)args.in[15]; F.w_in_c = (const float*)args.in[16]; F.sgu_ng = (const float*)args.in[17]; F.sgu_ws = (const float*)args.in[18]; F.sgu_bs = (const float*)args.in[19];
    F.w_out_c = (const float*)args.in[20]; F.w_router = (const float*)args.in[21]; F.r_bias = (const float*)args.in[22]; F.w_gate = (const float*)args.in[23]; F.w_up = (const float*)args.in[24];
    F.w_down = (const float*)args.in[25];
    for (int u = F.tid; u < (LDS_BYTES - LDSCTL_OFF) / 4; u += 512) ((LAS unsigned*)(F.lds + LDSCTL_OFF))[u] = 0u;
    __syncthreads();
    XcdBarrier bar; bar.bar = (unsigned*)(F.ctl + CW_BAR); bar.x = 0; bar.st = nullptr;
    if (args.use_bar) bar = xcd_barrier_post((unsigned*)(F.ctl + CW_BAR) + (args.use_bar - 1) * XCD_BAR_WORDS, F.MISC + 8);
    const int lo = args.ph_lo, hi = args.ph_hi;
#ifndef PH_MASK
#define PH_MASK 0x3FFFFu
#endif
#define IN(k) ((((PH_MASK) >> (k)) & 1u) && lo <= (k) && (k) < hi)
#if defined(SPIN_PHASE)
    unsigned long long t_mark = __builtin_amdgcn_s_memrealtime();
#define SPIN_HOOK(k) do { if ((k) == (SPIN_PHASE)) { const unsigned long long t1_ = __builtin_amdgcn_s_memrealtime(), dt_ = t1_ - t_mark; while (__builtin_amdgcn_s_memrealtime() - t1_ < dt_) __builtin_amdgcn_s_sleep(4); } } while (0)
#define SPIN_MARK() do { t_mark = __builtin_amdgcn_s_memrealtime(); } while (0)
#else
#define SPIN_HOOK(k) do { } while (0)
#define SPIN_MARK() do { } while (0)
#endif
#define SEAM(k) do { if (IN(k)) SPIN_HOOK(k); if (IN(k) && IN((k) + 1)) xcd_barrier(bar); SPIN_MARK(); } while (0)
    float* mod = (float*)(F.ws + WS_MOD);
    bf16* Hb = (bf16*)(F.ws + WS_O);
    bf16* Ab = (bf16*)(F.ws + WS_A);

    if (IN(0)) { p0_prologue(F); } SEAM(0);
    if (IN(1)) { row_pass<false, true, false>(F, F.x, mod, 0, F.norm_g, mod, 0, 0); } SEAM(1);
    if (IN(2)) { pg8::Gemm g{Hb, (const bf16*)(F.ws + WS_WIN), NTOK, NPROJ, DM}; pg8::StaticOrder S; S.init(NTOK, NPROJ, F.G, F.bid);
        pg8::EpiBf16<0> E{Ab, NPROJ, nullptr, 0, 0, 1.f};
        pg8::gemm_phase<pg8::EpiBf16<0>, pg8::StaticOrder, true, true>(F.lds + RING_OFF, g, S, E); } SEAM(2);
    if (IN(3)) {
        for (int it = F.bid; it < 1024; it += F.G) gla_prep_item(F, it);
        { int tok = F.bid * 8 + F.wave; const int tstep = F.G * 8; PrepRaw cur, nxt; nxt.pos = 0; nxt.ng = 0u; nxt.r0 = (v4u){0u, 0u, 0u, 0u}; nxt.r1 = nxt.r0; nxt.r2 = nxt.r0;
          if (tok < NTOK) nsa_prep_load(F, tok, cur);
          while (tok < NTOK) { const int ntok = tok + tstep; if (ntok < NTOK) nsa_prep_load(F, ntok, nxt); nsa_prep_token(F, tok, cur); cur = nxt; tok = ntok; } }
    } SEAM(3);
    if (IN(4)) {
        const int half = F.G >> 1;
#if defined(P4_SPIN)
        const unsigned long long tp4 = __builtin_amdgcn_s_memrealtime();
#endif
        if (F.bid < half) { for (int it = F.bid; it < 128; it += half) nsa_compress_item(F, it); }
        else { for (int gi = (F.bid - half) * 512 + F.tid; gi < 65536; gi += (F.G - half) * 512) gla_scan(F, gi); }
#if defined(P4_SPIN)
        if ((P4_SPIN == 1) == (F.bid < half)) { const unsigned long long t1_ = __builtin_amdgcn_s_memrealtime(), dt_ = t1_ - tp4; while (__builtin_amdgcn_s_memrealtime() - t1_ < dt_) __builtin_amdgcn_s_sleep(4); }
#endif
    } SEAM(4);
    if (IN(5)) {
#ifndef NO_NSA
        { const int p = F.bid & 255, bg = p >> 6, i = p & 63; nsa_item(F, bg >> 1, bg & 1, i); nsa_item(F, bg >> 1, bg & 1, 127 - i); }
#endif
#ifndef NO_GLAOUT
#if defined(GLA_SPIN)
        { const unsigned long long tg0 = __builtin_amdgcn_s_memrealtime();
#endif
        for (int it = F.bid; it < 1024; it += F.G) gla_out_item(F, it);
#if defined(GLA_SPIN)
          const unsigned long long t1_ = __builtin_amdgcn_s_memrealtime(), dt_ = t1_ - tg0; while (__builtin_amdgcn_s_memrealtime() - t1_ < dt_) __builtin_amdgcn_s_sleep(4); }
#endif
#endif
    } SEAM(5);
    if (IN(6)) { pg8::Gemm g{(const bf16*)(F.ws + WS_O + 32 * MiB), (const bf16*)(F.ws + WS_WOUT), NTOK, DM, DM}; pg8::StaticOrder S; S.init(NTOK, DM, F.G, F.bid);
        EpiResid E{F.x, F.out, mod + 2 * 1024};
        pg8::gemm_phase<EpiResid, pg8::StaticOrder, true, true>(F.lds + RING_OFF, g, S, E); } SEAM(6);
#define MOE_BLOCK(P, LAYER) \
    if (IN(P)) { router_pass(F, F.out, mod + (LAYER) * 2 * 6144, F.norm_g + ((LAYER) * 2 + 1) * 1024, (LAYER)); } SEAM(P); \
    if (IN((P) + 1)) { moe_tables(F, (LAYER)); MoeOrder S{(const LAS int*)(F.lds + TAB_OFF), F.G, F.bid}; \
        { LAS unsigned* rofs = (LAS unsigned*)(F.lds + TAB_OFF + 2048); const int* elist = (const int*)(F.ws + WS_STATS); pg8::Unit uu; \
          for (int ui = 0; ui < 6; ++ui) if (S.next(ui, uu)) { if (F.tid < 256) rofs[ui * 256 + F.tid] = S.row_off(uu, F.tid, elist); } \
          __syncthreads(); } \
        pg8::Gemm g{Hb, (const bf16*)(F.ws + WS_WGU) + (size_t)(LAYER) * 16 * 1024 * 1024, MOE_ROWS, 1024, DM}; EpiMoeGU E{(bf16*)(F.ws + WS_A + A_HID_OFF)}; \
        pg8::gemm_phase_gather<EpiMoeGU, MoeOrder>(F.lds + RING_OFF, g, S, E, (const LAS unsigned*)(F.lds + TAB_OFF + 2048)); \
        if ((LAYER) == 0) moe_tail_copies(F, 1); } SEAM((P) + 1); \
    if (IN((P) + 2)) { moe_tables(F, (LAYER)); MoeOrder S{(const LAS int*)(F.lds + TAB_OFF), F.G, F.bid}; \
        pg8::Gemm g{(const bf16*)(F.ws + WS_A + A_HID_OFF), (const bf16*)(F.ws + WS_WDN) + (size_t)(LAYER) * 16 * 1024 * 512, MOE_ROWS, 1024, EHID}; EpiMoeDn E{Ab}; \
        pg8::gemm_phase<EpiMoeDn, MoeOrder, true, true>(F.lds + RING_OFF, g, S, E); \
        if ((LAYER) == 0) moe_tail_copies(F, 2); } SEAM((P) + 2);
    MOE_BLOCK(7, 0)
    if (IN(10)) { row_pass<true, true, false>(F, F.out, mod + 2 * 6144, 0, F.norm_g + 2 * 1024, mod, 1, 0); } SEAM(10);
    if (IN(11)) { pg8::Gemm g{Hb, (const bf16*)(F.ws + WS_WINC), NTOK, 4096, DM}; pg8::StaticOrder S; S.init(NTOK, 4096, F.G, F.bid);
        EpiGeluStats E{Ab, (float*)(F.ws + WS_STATS)};
        pg8::gemm_phase<EpiGeluStats, pg8::StaticOrder, true, true>(F.lds + RING_OFF, g, S, E); } SEAM(11);
    if (IN(12)) { for (int it = F.bid; it < 1024; it += F.G) sgu_item(F, it); } SEAM(12);
    if (IN(13)) { pg8::Gemm g{Hb, (const bf16*)(F.ws + WS_WOUTC), NTOK, DM, SGW}; pg8::StaticOrder S; S.init(NTOK, DM, F.G, F.bid);
        EpiResid E{F.out, F.out, mod + 2 * 6144 + 2 * 1024};
        pg8::gemm_phase<EpiResid, pg8::StaticOrder, true, true>(F.lds + RING_OFF, g, S, E); } SEAM(13);
    MOE_BLOCK(14, 1)
    if (IN(17)) { row_pass<true, false, false>(F, F.out, mod, 0, F.norm_g, mod + 2 * 6144, 1, 1); SPIN_HOOK(17); }
#undef IN
#undef SEAM
#undef MOE_BLOCK
}

#ifndef MK_N_LAUNCHES
#define MK_N_LAUNCHES 1
#endif
extern "C" void kernel_launch(void* const* d_in, const int* in_sizes, int n_in, void* d_out, int out_size, void* d_ws, size_t ws_size, hipStream_t stream) {
    static int grid = 0;
    if (grid == 0) {
        if (n_in != 26 || out_size != NTOK * DM || ws_size < WS_END) { fprintf(stderr, "kernel_launch: unexpected problem shape / workspace (%d inputs, out %d, ws %zu)\n", n_in, out_size, ws_size); grid = -1; return; }
        int dev = 0, cus = 0, per_cu = 0;
        if (hipGetDevice(&dev) != hipSuccess || hipDeviceGetAttribute(&cus, hipDeviceAttributeMultiprocessorCount, dev) != hipSuccess) { grid = -1; return; }
        if (hipFuncSetAttribute((const void*)trunk_fwd, hipFuncAttributeMaxDynamicSharedMemorySize, LDS_BYTES) != hipSuccess) { fprintf(stderr, "kernel_launch: hipFuncSetAttribute failed\n"); grid = -1; return; }
        if (hipOccupancyMaxActiveBlocksPerMultiprocessor(&per_cu, (const void*)trunk_fwd, 512, LDS_BYTES) != hipSuccess || per_cu < 1) { fprintf(stderr, "kernel_launch: occupancy query says %d blocks per CU\n", per_cu); }
        (void)hipGetLastError();
        grid = cus;
        if (grid != 256) { fprintf(stderr, "kernel_launch: built for a 256-CU device, found %d CUs\n", cus); grid = -1; return; }
    }
    if (grid < 0) return;
    (void)hipMemsetAsync((char*)d_ws + WS_CTL, 0, CTL_ZERO_BYTES, stream);
    Args a{};
    for (int i = 0; i < 26; ++i) a.in[i] = d_in[i];
    a.out = (float*)d_out; a.ws = (unsigned char*)d_ws; a.pad = 0;
    if (MK_N_LAUNCHES == 1) {
#if defined(REP_PHASE)
        a.ph_lo = 0; a.ph_hi = REP_PHASE + 1; a.use_bar = 1;
        hipLaunchKernelGGL(trunk_fwd, dim3(grid), dim3(512), LDS_BYTES, stream, a);
        a.ph_lo = REP_PHASE; a.ph_hi = NPHASE; a.use_bar = 2;
        hipLaunchKernelGGL(trunk_fwd, dim3(grid), dim3(512), LDS_BYTES, stream, a);
#else
        a.ph_lo = 0; a.ph_hi = NPHASE; a.use_bar = 1;
        hipLaunchKernelGGL(trunk_fwd, dim3(grid), dim3(512), LDS_BYTES, stream, a);
#endif
    } else {
        for (int p = 0; p < NPHASE; ++p) { a.ph_lo = p; a.ph_hi = p + 1; a.use_bar = 0; hipLaunchKernelGGL(trunk_fwd, dim3(grid), dim3(512), LDS_BYTES, stream, a); }
    }
}
```
